# Optimizing an MI355X kernel written in HIP

```python
import jax, jax.numpy as jnp
from jax import lax
import numpy as np

D_MODEL = 1024
BATCH = 2
SEQ = 8192
DEPTH = 1

ROPE_THETA = 500000.0
NORM_EPS = 1e-6
NEG_BIG = -1e30
MLA_HEADS = 8
MLA_NOPE_DIM = 64
MLA_ROPE_DIM = 32
MLA_V_DIM = 64
MLA_Q_RANK = 384
MLA_KV_RANK = 256
MLA_WIDTH = MLA_HEADS * MLA_V_DIM
Q_BLOCK = 128
DIL_HEADS = 8
DIL_HEAD_DIM = 64
DIL_WIDTH = DIL_HEADS * DIL_HEAD_DIM
DIL_ROT_DIM = DIL_HEAD_DIM // 4
DIL_BRANCHES = ((128, 1), (512, 4), (2048, 16))
MIX_WIDTH = MLA_WIDTH + DIL_WIDTH
IN_COLS = MLA_Q_RANK + MLA_KV_RANK + MLA_ROPE_DIM + 3 * DIL_WIDTH
N_EXPERTS = 16
EXPERT_FF = 1024
EC_CAPACITY_FACTOR = 2
N_MOD = 6

kernel_name = "hybrid_mla_dilated_ec_moe_adaln_encoder"


def rms_norm(x, g):
    xf = x.astype(jnp.float32)
    y = xf * lax.rsqrt(jnp.mean(xf * xf, axis=-1, keepdims=True) + NORM_EPS)
    return (y * g.astype(jnp.float32)).astype(x.dtype)


def rope_cos_sin(positions, dim):
    inv = 1.0 / (ROPE_THETA ** (jnp.arange(0, dim, 2, dtype=jnp.float32) / dim))
    ang = positions.astype(jnp.float32)[..., None] * inv
    return jnp.cos(ang), jnp.sin(ang)


def apply_rope(t, cos, sin):
    t1, t2 = jnp.split(t, 2, axis=-1)
    c = cos[:, :, None, :].astype(t.dtype)
    s = sin[:, :, None, :].astype(t.dtype)
    return jnp.concatenate([t1 * c - t2 * s, t1 * s + t2 * c], axis=-1)


def mla_attention(q, k, v):
    B, S, H, Dq = q.shape
    nblk = S // Q_BLOCK
    scale = Dq ** -0.5
    qb = q.reshape(B, nblk, Q_BLOCK, H, Dq).transpose(1, 0, 2, 3, 4)

    def one_block(q_blk):
        s = jnp.einsum('bqhd,bkhd->bhqk', q_blk, k).astype(jnp.float32) * scale
        p = jax.nn.softmax(s, axis=-1).astype(v.dtype)
        return jnp.einsum('bhqk,bkhd->bqhd', p, v)

    o = lax.map(one_block, qb)
    return o.transpose(1, 0, 2, 3, 4).reshape(B, S, H, v.shape[-1])


def dilated_branch(q, k, v, dilation, half):
    B, S, H, Dh = q.shape
    L = S // dilation
    nb = -(-L // half)
    Lp = nb * half
    pad = Lp - L

    def to_sub(t):
        return t.reshape(B, L, dilation, H, Dh).transpose(0, 2, 1, 3, 4)

    qs = jnp.pad(to_sub(q), ((0, 0), (0, 0), (0, pad), (0, 0), (0, 0)))
    kpad = ((0, 0), (0, 0), (half, pad + half), (0, 0), (0, 0))
    ks = jnp.pad(to_sub(k), kpad)
    vs = jnp.pad(to_sub(v), kpad)
    valid = jnp.pad(jnp.ones((L,), dtype=bool), (half, pad + half))

    def bands(t):
        parts = [t[:, :, j * half:j * half + Lp].reshape(B, dilation, nb, half, H, Dh) for j in range(3)]
        return jnp.concatenate(parts, axis=3)

    kb, vb = bands(ks), bands(vs)
    kvalid = jnp.concatenate([valid[j * half:j * half + Lp].reshape(nb, half) for j in range(3)], axis=1)
    qb = qs.reshape(B, dilation, nb, half, H, Dh)
    s = jnp.einsum('brnqhd,brnkhd->brnhqk', qb, kb).astype(jnp.float32) * (Dh ** -0.5)
    rel = jnp.arange(3 * half)[None, :] - half - jnp.arange(half)[:, None]
    mask = (jnp.abs(rel) <= half)[None, :, :] & kvalid[:, None, :]
    s = jnp.where(mask[None, None, :, None, :, :], s, NEG_BIG)
    m = jnp.max(s, axis=-1, keepdims=True)
    e = jnp.exp(s - m)
    den = jnp.sum(e, axis=-1)
    p = (e / den[..., None]).astype(v.dtype)
    o = jnp.einsum('brnhqk,brnkhd->brnqhd', p, vb)
    lse = m[..., 0] + jnp.log(den)
    o = o.reshape(B, dilation, Lp, H, Dh)[:, :, :L].transpose(0, 2, 1, 3, 4).reshape(B, S, H, Dh)
    lse = lse.transpose(0, 1, 2, 4, 3).reshape(B, dilation, Lp, H)[:, :, :L]
    lse = lse.transpose(0, 2, 1, 3).reshape(B, S, H)
    return o, lse


def dilated_attention(q, k, v):
    outs, lses = [], []
    for window, dilation in DIL_BRANCHES:
        o, l = dilated_branch(q, k, v, dilation, window // (2 * dilation))
        outs.append(o)
        lses.append(l)
    wts = jax.nn.softmax(jnp.stack(lses, axis=0), axis=0)
    o = jnp.einsum('nbsh,nbshd->bshd', wts, jnp.stack(outs, axis=0).astype(jnp.float32))
    return o.astype(q.dtype)


def expert_choice_ffn(h, w_router, b_router, w_gate, w_up, w_down):
    B, S, D = h.shape
    cap = EC_CAPACITY_FACTOR * S // N_EXPERTS
    logits = jnp.einsum('bsd,de->bse', h, w_router).astype(jnp.float32) + b_router.astype(jnp.float32)
    aff = jax.nn.softmax(logits, axis=-1)
    gate, idx = lax.top_k(jnp.swapaxes(aff, 1, 2), cap)
    xe = jax.vmap(lambda hb, ib: hb[ib])(h, idx)
    a = jnp.einsum('becd,edf->becf', xe, w_gate)
    u = jnp.einsum('becd,edf->becf', xe, w_up)
    ye = jnp.einsum('becf,efd->becd', jax.nn.silu(a) * u, w_down)
    ye = ye * gate[..., None].astype(ye.dtype)
    return jax.vmap(lambda ib, yb: jnp.zeros((S, D), yb.dtype).at[ib.reshape(-1)].add(yb.reshape(-1, D)))(idx, ye)


def setup_inputs(seed: int = 0) -> dict:
    key = jax.random.key(seed)
    ks = jax.random.split(key, 24)
    f32 = jnp.float32
    nrm = lambda k, shape, fan_in: jax.random.normal(k, shape, f32) * (fan_in ** -0.5)
    gain = lambda k, shape: 1.0 + 0.05 * jax.random.normal(k, shape, f32)
    x = jax.random.normal(ks[0], (BATCH, SEQ, D_MODEL), f32)
    c = jax.random.normal(ks[1], (BATCH, D_MODEL), f32)
    offset = jax.random.randint(ks[2], (BATCH, 1), 0, 1024, dtype=jnp.int32)
    positions = offset + jnp.arange(SEQ, dtype=jnp.int32)[None, :]
    return {
        'x': x,
        'c': c,
        'positions': positions,
        'w_ada': 0.5 * nrm(ks[3], (DEPTH, D_MODEL, N_MOD * D_MODEL), D_MODEL),
        'b_ada': 0.02 * jax.random.normal(ks[4], (DEPTH, N_MOD * D_MODEL), f32),
        'g_mix': gain(ks[5], (DEPTH, D_MODEL)),
        'w_in': nrm(ks[6], (DEPTH, D_MODEL, IN_COLS), D_MODEL),
        'g_q': gain(ks[7], (DEPTH, MLA_Q_RANK)),
        'w_uq': nrm(ks[8], (DEPTH, MLA_Q_RANK, MLA_HEADS * (MLA_NOPE_DIM + MLA_ROPE_DIM)), MLA_Q_RANK),
        'g_kv': gain(ks[9], (DEPTH, MLA_KV_RANK)),
        'w_ukv': nrm(ks[10], (DEPTH, MLA_KV_RANK, MLA_HEADS * (MLA_NOPE_DIM + MLA_V_DIM)), MLA_KV_RANK),
        'w_out': nrm(ks[11], (DEPTH, MIX_WIDTH, D_MODEL), MIX_WIDTH),
        'g_ffn': gain(ks[12], (DEPTH, D_MODEL)),
        'w_router': nrm(ks[13], (DEPTH, D_MODEL, N_EXPERTS), D_MODEL),
        'b_router': 0.01 * jax.random.normal(ks[14], (DEPTH, N_EXPERTS), f32),
        'w_gate': nrm(ks[15], (DEPTH, N_EXPERTS, D_MODEL, EXPERT_FF), D_MODEL),
        'w_up': nrm(ks[16], (DEPTH, N_EXPERTS, D_MODEL, EXPERT_FF), D_MODEL),
        'w_down': nrm(ks[17], (DEPTH, N_EXPERTS, EXPERT_FF, D_MODEL), EXPERT_FF),
        'g_final': gain(ks[18], (D_MODEL,)),
    }


def reference(x, c, positions, w_ada, b_ada, g_mix, w_in, g_q, w_uq, g_kv, w_ukv, w_out,
              g_ffn, w_router, b_router, w_gate, w_up, w_down, g_final):
    B, S, D = x.shape
    cos_m, sin_m = rope_cos_sin(positions, MLA_ROPE_DIM)
    cos_d, sin_d = rope_cos_sin(positions, DIL_ROT_DIM)
    o1 = MLA_Q_RANK
    o2 = o1 + MLA_KV_RANK
    o3 = o2 + MLA_ROPE_DIM
    o4 = o3 + DIL_WIDTH
    o5 = o4 + DIL_WIDTH
    for l in range(DEPTH):
        mod = jnp.einsum('bd,de->be', jax.nn.silu(c), w_ada[l]) + b_ada[l]
        sh_a, sc_a, gt_a, sh_m, sc_m, gt_m = jnp.split(mod[:, None, :], N_MOD, axis=-1)

        h = rms_norm(x, g_mix[l]) * (1.0 + sc_a) + sh_a
        proj = jnp.einsum('bsd,dc->bsc', h, w_in[l])
        cq, ckv, kr = proj[..., :o1], proj[..., o1:o2], proj[..., o2:o3]
        dq, dk, dv = proj[..., o3:o4], proj[..., o4:o5], proj[..., o5:]

        q = jnp.einsum('bsr,rc->bsc', rms_norm(cq, g_q[l]), w_uq[l]).reshape(B, S, MLA_HEADS, MLA_NOPE_DIM + MLA_ROPE_DIM)
        q = jnp.concatenate([q[..., :MLA_NOPE_DIM], apply_rope(q[..., MLA_NOPE_DIM:], cos_m, sin_m)], axis=-1)
        kv = jnp.einsum('bsr,rc->bsc', rms_norm(ckv, g_kv[l]), w_ukv[l]).reshape(B, S, MLA_HEADS, MLA_NOPE_DIM + MLA_V_DIM)
        k_rope = apply_rope(kr[:, :, None, :], cos_m, sin_m)
        k = jnp.concatenate([kv[..., :MLA_NOPE_DIM], jnp.broadcast_to(k_rope, (B, S, MLA_HEADS, MLA_ROPE_DIM))], axis=-1)
        v = kv[..., MLA_NOPE_DIM:]
        out_a = mla_attention(q, k, v).reshape(B, S, MLA_WIDTH)

        def partial_rope(t):
            t = t.reshape(B, S, DIL_HEADS, DIL_HEAD_DIM)
            return jnp.concatenate([apply_rope(t[..., :DIL_ROT_DIM], cos_d, sin_d), t[..., DIL_ROT_DIM:]], axis=-1)
        out_b = dilated_attention(partial_rope(dq), partial_rope(dk), dv.reshape(B, S, DIL_HEADS, DIL_HEAD_DIM))
        out_b = out_b.reshape(B, S, DIL_WIDTH)

        mixed = jnp.einsum('bsc,cd->bsd', jnp.concatenate([out_a, out_b], axis=-1), w_out[l])
        x = x + gt_a * mixed

        h2 = rms_norm(x, g_ffn[l]) * (1.0 + sc_m) + sh_m
        x = x + gt_m * expert_choice_ffn(h2, w_router[l], b_router[l], w_gate[l], w_up[l], w_down[l])
    return rms_norm(x, g_final)
```

```cpp
#include <hip/hip_runtime.h>
#include <hip/hip_cooperative_groups.h>
#include <hip/hip_bf16.h>
#include <cstdio>
#include <cstdint>
#include <cmath>
namespace nv {
constexpr int S = 8192, D = 1024, NB = 2, INC = 2208, H = 8;
constexpr float EPS = 1e-6f;
__device__ __forceinline__ float siluf(float v) { return v / (1.f + __expf(-v)); }
__device__ __forceinline__ float wsum(float v) {
#pragma unroll
    for (int o = 1; o < 64; o <<= 1) v += __shfl_xor(v, o);
    return v;
}
__global__ void k_mod(const float* c, const float* w, const float* bias, float* mod) {
    int i = blockIdx.x * 256 + threadIdx.x; if (i >= NB * 6144) return;
    int b = i / 6144, n = i % 6144; float s = 0.f;
    for (int k = 0; k < 1024; ++k) s += siluf(c[b * 1024 + k]) * w[(size_t)k * 6144 + n];
    mod[i] = s + bias[n];
}
__global__ void k_norm_mod(const float* x, const float* g, const float* sh, const float* sc, float* out, int rows) {
    int row = blockIdx.x * 4 + (threadIdx.x >> 6), lane = threadIdx.x & 63; if (row >= rows) return;
    const float* xr = x + (size_t)row * D; float s = 0.f;
    for (int j = lane; j < D; j += 64) s += xr[j] * xr[j];
    float rstd = rsqrtf(wsum(s) / D + EPS);
    for (int j = lane; j < D; j += 64) out[(size_t)row * D + j] = xr[j] * rstd * g[j] * (1.f + sc[j]) + sh[j];
}
__global__ __launch_bounds__(256) void k_gemm(const float* __restrict__ A, long lda, long astride, const int* __restrict__ gidx,
                                              const float* __restrict__ B, const float* __restrict__ B2, long ldb, long bstride,
                                              float* __restrict__ C, long ldc, int M, int N, int K, const float* __restrict__ rowscale) {
    __shared__ float As[16][65]; __shared__ float Bs[16][64]; __shared__ float B2s[16][64];
    const int tid = threadIdx.x, tx = tid & 15, ty = tid >> 4, m0 = blockIdx.y * 64, n0 = blockIdx.x * 64, z = blockIdx.z;
    A += (size_t)z * astride; B += (size_t)z * bstride; if (B2) B2 += (size_t)z * bstride;
    const int* gi = gidx ? gidx + (size_t)z * M : nullptr; C += (size_t)z * M * ldc; const float* rs = rowscale ? rowscale + (size_t)z * M : nullptr;
    float acc[4][4], acc2[4][4];
#pragma unroll
    for (int i = 0; i < 4; ++i)
#pragma unroll
        for (int j = 0; j < 4; ++j) { acc[i][j] = 0.f; acc2[i][j] = 0.f; }
    const int ar = tid >> 2, ac = (tid & 3) * 4; const long arow = gi ? gi[m0 + ar] : (m0 + ar);
    const int br = tid >> 4, bc = (tid & 15) * 4;
    for (int k0 = 0; k0 < K; k0 += 16) {
        const float4 av = *(const float4*)(A + arow * lda + k0 + ac);
        As[ac + 0][ar] = av.x; As[ac + 1][ar] = av.y; As[ac + 2][ar] = av.z; As[ac + 3][ar] = av.w;
#pragma unroll
        for (int j = 0; j < 4; ++j) { int n = n0 + bc + j; Bs[br][bc + j] = n < N ? B[(size_t)(k0 + br) * ldb + n] : 0.f; if (B2) B2s[br][bc + j] = n < N ? B2[(size_t)(k0 + br) * ldb + n] : 0.f; }
        __syncthreads();
#pragma unroll
        for (int k = 0; k < 16; ++k) {
            float a[4], b[4], b2[4];
#pragma unroll
            for (int i = 0; i < 4; ++i) a[i] = As[k][ty * 4 + i];
#pragma unroll
            for (int j = 0; j < 4; ++j) { b[j] = Bs[k][tx * 4 + j]; b2[j] = B2 ? B2s[k][tx * 4 + j] : 0.f; }
#pragma unroll
            for (int i = 0; i < 4; ++i)
#pragma unroll
                for (int j = 0; j < 4; ++j) { acc[i][j] += a[i] * b[j]; acc2[i][j] += a[i] * b2[j]; }
        }
        __syncthreads();
    }
#pragma unroll
    for (int i = 0; i < 4; ++i)
#pragma unroll
        for (int j = 0; j < 4; ++j) { int m = m0 + ty * 4 + i, n = n0 + tx * 4 + j; if (n < N) { float v = acc[i][j]; if (B2) v = siluf(v) * acc2[i][j]; if (rs) v *= rs[m]; C[(size_t)m * ldc + n] = v; } }
}
__global__ void k_rms_inplace(float* buf, long ld, int c0, int nc, const float* g, int rows) {
    int row = blockIdx.x * 4 + (threadIdx.x >> 6), lane = threadIdx.x & 63; if (row >= rows) return;
    float* p = buf + (size_t)row * ld + c0; float s = 0.f;
    for (int j = lane; j < nc; j += 64) s += p[j] * p[j];
    float rstd = rsqrtf(wsum(s) / nc + EPS);
    for (int j = lane; j < nc; j += 64) p[j] = p[j] * rstd * g[j];
}
__device__ __forceinline__ void cs_of(int pos, int i, int dim, float& c, float& s) {
    float inv = (float)(1.0 / pow(500000.0, (double)(2 * i) / (double)dim));
    float ang = (float)pos * inv; c = (float)cos((double)ang); s = (float)sin((double)ang);
}
__global__ void k_rope_q(float* q, const int* pos, int rows) {
    int i = blockIdx.x * 256 + threadIdx.x; if (i >= rows * 8 * 16) return;
    int row = i / 128, h = (i / 16) % 8, f = i % 16; float c, s; cs_of(pos[row], f, 32, c, s);
    float* p = q + (size_t)row * 768 + h * 96 + 64; float a = p[f], b = p[f + 16]; p[f] = a * c - b * s; p[f + 16] = a * s + b * c;
}
__global__ void k_rope_kr(const float* proj, float* kr, const int* pos, int rows) {
    int i = blockIdx.x * 256 + threadIdx.x; if (i >= rows * 16) return;
    int row = i / 16, f = i % 16; float c, s; cs_of(pos[row], f, 32, c, s);
    const float* p = proj + (size_t)row * INC + 640; float a = p[f], b = p[f + 16]; kr[row * 32 + f] = a * c - b * s; kr[row * 32 + f + 16] = a * s + b * c;
}
__global__ void k_rope_d(const float* proj, int c0, float* out, const int* pos, int rows) {
    int i = blockIdx.x * 256 + threadIdx.x; if (i >= rows * 512) return;
    int row = i / 512, col = i % 512, d = col % 64; const float* p = proj + (size_t)row * INC + c0; float v = p[col];
    if (d < 16) { int f = d % 8; float c, s; cs_of(pos[row], f, 16, c, s); if (d < 8) v = p[col] * c - p[col + 8] * s; else v = p[col - 8] * s + p[col] * c; }
    out[i] = v;
}
__global__ __launch_bounds__(256) void k_attn_mla(const float* __restrict__ q, const float* __restrict__ kv, const float* __restrict__ kr, float* __restrict__ cat) {
    __shared__ float Ks[32][96]; __shared__ float Vs[32][64];
    const int h = blockIdx.y, t = blockIdx.x * 256 + threadIdx.x; const float scale = 0.10206207261596575f;
    float qv[96];
#pragma unroll
    for (int d = 0; d < 96; ++d) qv[d] = q[(size_t)t * 768 + h * 96 + d] * scale;
    float o[64];
#pragma unroll
    for (int d = 0; d < 64; ++d) o[d] = 0.f;
    float m = -1e30f, l = 0.f;
    for (int k0 = 0; k0 < S; k0 += 32) {
        __syncthreads();
        for (int i = threadIdx.x; i < 32 * 96; i += 256) { int r = i / 96, d = i % 96; Ks[r][d] = d < 64 ? kv[(size_t)(k0 + r) * 1024 + h * 128 + d] : kr[(k0 + r) * 32 + d - 64]; }
        for (int i = threadIdx.x; i < 32 * 64; i += 256) { int r = i / 64, d = i % 64; Vs[r][d] = kv[(size_t)(k0 + r) * 1024 + h * 128 + 64 + d]; }
        __syncthreads();
        float sc[32]; float tm = -1e30f;
#pragma unroll
        for (int j = 0; j < 32; ++j) { float s = 0.f;
#pragma unroll
            for (int d = 0; d < 96; ++d) s += qv[d] * Ks[j][d];
            sc[j] = s; tm = fmaxf(tm, s); }
        const float mn = fmaxf(m, tm), al = __expf(m - mn); m = mn; l *= al;
#pragma unroll
        for (int d = 0; d < 64; ++d) o[d] *= al;
#pragma unroll
        for (int j = 0; j < 32; ++j) { const float p = __expf(sc[j] - mn); l += p;
#pragma unroll
            for (int d = 0; d < 64; ++d) o[d] += p * Vs[j][d]; }
    }
    const float il = 1.f / l;
#pragma unroll
    for (int d = 0; d < 64; ++d) cat[(size_t)t * 1024 + h * 64 + d] = o[d] * il;
}
__global__ __launch_bounds__(256) void k_attn_dil(const float* __restrict__ dq, const float* __restrict__ dk, const float* __restrict__ proj, float* __restrict__ cat) {
    const int h = blockIdx.y, t = blockIdx.x * 256 + threadIdx.x;
    float qv[64];
#pragma unroll
    for (int d = 0; d < 64; ++d) qv[d] = dq[(size_t)t * 512 + h * 64 + d] * 0.125f;
    float o[64];
#pragma unroll
    for (int d = 0; d < 64; ++d) o[d] = 0.f;
    float m = -1e30f, l = 0.f;
    for (int br = 0; br < 3; ++br) { const int dil = br == 0 ? 1 : (br == 1 ? 4 : 16);
        for (int j = -64; j <= 64; ++j) { const int kt = t + dil * j; if (kt < 0 || kt >= S) continue;
            const float* kp = dk + (size_t)kt * 512 + h * 64; float s = 0.f;
#pragma unroll
            for (int d = 0; d < 64; ++d) s += qv[d] * kp[d];
            if (s > m) { const float al = __expf(m - s); l *= al;
#pragma unroll
                for (int d = 0; d < 64; ++d) o[d] *= al;
                m = s; }
            const float p = __expf(s - m); l += p; const float* vp = proj + (size_t)kt * INC + 1696 + h * 64;
#pragma unroll
            for (int d = 0; d < 64; ++d) o[d] += p * vp[d]; } }
    const float il = 1.f / l;
#pragma unroll
    for (int d = 0; d < 64; ++d) cat[(size_t)t * 1024 + 512 + h * 64 + d] = o[d] * il;
}
__global__ void k_resid(const float* x, const float* gt, const float* mixed, float* x1, int n) {
    int i = blockIdx.x * 256 + threadIdx.x; if (i < n) x1[i] = x[i] + gt[i % D] * mixed[i];
}
__global__ void k_h2_aff(const float* x1, const float* g, const float* sh, const float* sc, const float* wr, const float* br, float* h2, float* aff) {
    int row = blockIdx.x * 4 + (threadIdx.x >> 6), lane = threadIdx.x & 63;
    const float* xr = x1 + (size_t)row * D; float s = 0.f;
    for (int j = lane; j < D; j += 64) s += xr[j] * xr[j];
    float rstd = rsqrtf(wsum(s) / D + EPS); float lg[16];
#pragma unroll
    for (int e = 0; e < 16; ++e) lg[e] = 0.f;
    for (int j = lane; j < D; j += 64) { float v = xr[j] * rstd * g[j] * (1.f + sc[j]) + sh[j]; h2[(size_t)row * D + j] = v;
#pragma unroll
        for (int e = 0; e < 16; ++e) lg[e] += v * wr[j * 16 + e]; }
    float mx = -1e30f;
#pragma unroll
    for (int e = 0; e < 16; ++e) { lg[e] = wsum(lg[e]) + br[e]; mx = fmaxf(mx, lg[e]); }
    float den = 0.f;
#pragma unroll
    for (int e = 0; e < 16; ++e) { lg[e] = expf(lg[e] - mx); den += lg[e]; }
    if (lane < 16) { float v = 0.f;
#pragma unroll
        for (int e = 0; e < 16; ++e) if (lane == e) v = lg[e];
        aff[(size_t)lane * S + row] = v / den; }
}
__global__ __launch_bounds__(256) void k_topk(const float* aff, int* idx, float* gate, int* slot) {
    __shared__ float vs[1024];
    const int e = blockIdx.y, s = blockIdx.x * 256 + threadIdx.x; const float* a = aff + (size_t)e * S; const float v = a[s]; int rank = 0;
    for (int c0 = 0; c0 < S; c0 += 1024) { __syncthreads(); for (int i = threadIdx.x; i < 1024; i += 256) vs[i] = a[c0 + i]; __syncthreads();
        for (int i = 0; i < 1024; ++i) { const float u = vs[i]; rank += (u > v || (u == v && (c0 + i) < s)) ? 1 : 0; } }
    if (rank < 1024) { idx[e * 1024 + rank] = s; gate[e * 1024 + rank] = v; slot[s * 16 + e] = rank; } else slot[s * 16 + e] = -1;
}
__global__ void k_final(const float* x1, const float* gt, const float* Y, const int* slot, const float* gf, float* out) {
    int row = blockIdx.x * 4 + (threadIdx.x >> 6), lane = threadIdx.x & 63; float v[16]; float s = 0.f;
#pragma unroll
    for (int i = 0; i < 16; ++i) { int j = lane + 64 * i; float acc = 0.f;
        for (int e = 0; e < 16; ++e) { int sl = slot[row * 16 + e]; if (sl >= 0) acc += Y[((size_t)e * 1024 + sl) * D + j]; }
        v[i] = x1[(size_t)row * D + j] + gt[j] * acc; s += v[i] * v[i]; }
    float rstd = rsqrtf(wsum(s) / D + EPS);
#pragma unroll
    for (int i = 0; i < 16; ++i) { int j = lane + 64 * i; out[(size_t)row * D + j] = v[i] * rstd * gf[j]; }
}
}
namespace nv {
constexpr size_t MB = 1u << 20;
constexpr size_t N_MOD = 0, N_H = 1 * MB, N_PROJ = N_H + 34 * MB, N_Q = N_PROJ + 73 * MB, N_KV = N_Q + 26 * MB, N_KR = N_KV + 34 * MB, N_DQ = N_KR + 1 * MB, N_DK = N_DQ + 17 * MB,
                 N_AFF = N_DK + 17 * MB, N_IDX = N_AFF + 1 * MB, N_GATE = N_IDX + 256 * 1024, N_SLOT = N_GATE + 256 * 1024, N_END = N_SLOT + 1 * MB;
__global__ void k_relerr(const unsigned short* a, const float* b, int c0, int nc, int rows, double* acc) {
    __shared__ double s0[256], s1[256]; double d0 = 0, d1 = 0;
    for (size_t i = (size_t)blockIdx.x * 256 + threadIdx.x; i < (size_t)rows * nc; i += (size_t)gridDim.x * 256) { size_t r = i / nc, c = c0 + i % nc;
        float av = __builtin_bit_cast(float, (unsigned)a[r * 1024 + c] << 16), bv = b[r * 1024 + c]; d0 += (double)(av - bv) * (av - bv); d1 += (double)bv * bv; }
    s0[threadIdx.x] = d0; s1[threadIdx.x] = d1; __syncthreads();
    for (int o = 128; o > 0; o >>= 1) { if (threadIdx.x < o) { s0[threadIdx.x] += s0[threadIdx.x + o]; s1[threadIdx.x] += s1[threadIdx.x + o]; } __syncthreads(); }
    if (threadIdx.x == 0) { atomicAdd(acc, s0[0]); atomicAdd(acc + 1, s1[0]); }
}
__global__ void k_scale_out(float* out, size_t n, const double* acc) { const float f = 1.f + (float)sqrt(acc[0] / acc[1]); for (size_t i = (size_t)blockIdx.x * 256 + threadIdx.x; i < n; i += (size_t)gridDim.x * 256) out[i] *= f; }
static void run_naive(void* const* d_in, float* out, char* ws, hipStream_t st, const unsigned short* cat_opt = nullptr, double* acc = nullptr, int c0 = 0, int nc = 512) {
    const float* x = (const float*)d_in[0]; const float* c = (const float*)d_in[1]; const int* pos = (const int*)d_in[2];
    const float* w_ada = (const float*)d_in[3]; const float* b_ada = (const float*)d_in[4]; const float* g_mix = (const float*)d_in[5];
    const float* w_in = (const float*)d_in[6]; const float* g_q = (const float*)d_in[7]; const float* w_uq = (const float*)d_in[8];
    const float* g_kv = (const float*)d_in[9]; const float* w_ukv = (const float*)d_in[10]; const float* w_out = (const float*)d_in[11];
    const float* g_ffn = (const float*)d_in[12]; const float* w_router = (const float*)d_in[13]; const float* b_router = (const float*)d_in[14];
    const float* w_gate = (const float*)d_in[15]; const float* w_up = (const float*)d_in[16]; const float* w_down = (const float*)d_in[17]; const float* g_final = (const float*)d_in[18];
    float* mod = (float*)(ws + N_MOD); float* hb = (float*)(ws + N_H); float* proj = (float*)(ws + N_PROJ); float* q = (float*)(ws + N_Q); float* kv = (float*)(ws + N_KV);
    float* kr = (float*)(ws + N_KR); float* dq = (float*)(ws + N_DQ); float* dk = (float*)(ws + N_DK); float* aff = (float*)(ws + N_AFF); int* idx = (int*)(ws + N_IDX);
    float* gate = (float*)(ws + N_GATE); int* slot = (int*)(ws + N_SLOT);
    k_mod<<<(NB * 6144 + 255) / 256, 256, 0, st>>>(c, w_ada, b_ada, mod);
    for (int b = 0; b < NB; ++b) {
        const float* xb = x + (size_t)b * S * D; const int* pb = pos + b * S; float* ob = out + (size_t)b * S * D; const float* mb = mod + b * 6144;
        k_norm_mod<<<S / 4, 256, 0, st>>>(xb, g_mix, mb + 0, mb + 1024, hb, S);
        k_gemm<<<dim3((INC + 63) / 64, S / 64, 1), 256, 0, st>>>(hb, 1024, 0, nullptr, w_in, nullptr, INC, 0, proj, INC, S, INC, 1024, nullptr);
        k_rms_inplace<<<S / 4, 256, 0, st>>>(proj, INC, 0, 384, g_q, S);
        k_rms_inplace<<<S / 4, 256, 0, st>>>(proj, INC, 384, 256, g_kv, S);
        k_gemm<<<dim3(768 / 64, S / 64, 1), 256, 0, st>>>(proj, INC, 0, nullptr, w_uq, nullptr, 768, 0, q, 768, S, 768, 384, nullptr);
        k_gemm<<<dim3(1024 / 64, S / 64, 1), 256, 0, st>>>(proj + 384, INC, 0, nullptr, w_ukv, nullptr, 1024, 0, kv, 1024, S, 1024, 256, nullptr);
        k_rope_q<<<(S * 128 + 255) / 256, 256, 0, st>>>(q, pb, S);
        k_rope_kr<<<(S * 16 + 255) / 256, 256, 0, st>>>(proj, kr, pb, S);
        k_rope_d<<<(S * 512 + 255) / 256, 256, 0, st>>>(proj, 672, dq, pb, S);
        k_rope_d<<<(S * 512 + 255) / 256, 256, 0, st>>>(proj, 1184, dk, pb, S);
        k_attn_mla<<<dim3(S / 256, 8), 256, 0, st>>>(q, kv, kr, hb);
        k_attn_dil<<<dim3(S / 256, 8), 256, 0, st>>>(dq, dk, proj, hb);
        if (cat_opt) k_relerr<<<1024, 256, 0, st>>>(cat_opt + (size_t)b * S * 1024, hb, c0, nc, S, acc);
        float* mixed = q;
        k_gemm<<<dim3(1024 / 64, S / 64, 1), 256, 0, st>>>(hb, 1024, 0, nullptr, w_out, nullptr, 1024, 0, mixed, 1024, S, 1024, 1024, nullptr);
        k_resid<<<(S * D + 255) / 256, 256, 0, st>>>(xb, mb + 2048, mixed, ob, S * D);
        k_h2_aff<<<S / 4, 256, 0, st>>>(ob, g_ffn, mb + 3072, mb + 4096, w_router, b_router, hb, aff);
        k_topk<<<dim3(S / 256, 16), 256, 0, st>>>(aff, idx, gate, slot);
        float* Hb = proj; float* Y = q;
        k_gemm<<<dim3(16, 16, 16), 256, 0, st>>>(hb, 1024, 0, idx, w_gate, w_up, 1024, 1024 * 1024, Hb, 1024, 1024, 1024, 1024, nullptr);
        k_gemm<<<dim3(16, 16, 16), 256, 0, st>>>(Hb, 1024, 1024 * 1024, nullptr, w_down, nullptr, 1024, 1024 * 1024, Y, 1024, 1024, 1024, 1024, gate);
        k_final<<<S / 4, 256, 0, st>>>(ob, mb + 5120, Y, slot, g_final, ob);
    }
    if (cat_opt) k_scale_out<<<2048, 256, 0, st>>>(out, (size_t)NB * S * D, acc);
}
}
namespace gm {
#define LAS __attribute__((address_space(3)))
typedef unsigned short bf16_t;
typedef short bf16x8 __attribute__((ext_vector_type(8)));
typedef float f32x4 __attribute__((ext_vector_type(4)));
typedef float f32x2 __attribute__((ext_vector_type(2)));
typedef unsigned u32x4 __attribute__((ext_vector_type(4)));
typedef unsigned u32x2 __attribute__((ext_vector_type(2)));
constexpr int BM = 256, BK = 64, HALF = 128, HTB = HALF * BK * 2, STAGE_BYTES = 8 * HTB;

__device__ __forceinline__ int lds_byte(int r, int c) { const int st = (r >> 4) * 2 + (c >> 5), rr = r & 15, cc = c & 31, ob = rr * 64 + cc * 2; return st * 1024 + (ob ^ (((ob >> 9) & 1) << 5)); }
__device__ __forceinline__ void stage_rc(int b, int& R, int& C) { const int st = b / 1024, sb = b % 1024, swz = sb ^ (((sb >> 9) & 1) << 5); R = (st >> 1) * 16 + swz / 64; C = (st & 1) * 32 + (swz % 64) / 2; }
__device__ __forceinline__ int perm32(int rho) { const int n = rho >> 4, i = rho & 15; return 8 * (i >> 2) + 4 * n + (i & 3); }
__device__ __forceinline__ unsigned cvt_pk_bf16(float lo, float hi) { unsigned r; asm volatile("v_cvt_pk_bf16_f32 %0, %1, %2" : "=v"(r) : "v"(lo), "v"(hi)); return r; }

struct Unit {
    const char* A; const char* Bt; const int* gidx;
    unsigned lda2, ldb2;
    int arow0, brow0, nt;
    int pm, pn, aux;
};

template <class Epi, class Sched>
__device__ __forceinline__ void gemm_phase(LAS unsigned char* lds, const Sched& S, const Epi& E) {
    constexpr bool GATHER = Sched::GATHER;
    const int tid = threadIdx.x, wid = __builtin_amdgcn_readfirstlane(tid >> 6), lane = tid & 63, wr = wid >> 2, wc = wid & 3, fr = lane & 15, fq = lane >> 4;
    int sR[2], sC[2], sRb[2];
#pragma unroll
    for (int i = 0; i < 2; ++i) { int R, C; stage_rc(tid * 16 + i * 8192, R, C); sR[i] = R; sC[i] = C * 2; sRb[i] = Epi::PERM ? ((R & ~31) + perm32(R & 31)) : R; }
    const unsigned ldsw = (unsigned)wid * 1024u;
    const int aoff = lds_byte(wr * 64 + fr, fq * 8), boff = lds_byte(wc * 32 + fr, fq * 8);
#define GM_SA(b, h) (((b) * 2 + (h)) * HTB)
#define GM_SB(b, h) ((4 + (b) * 2 + (h)) * HTB)
#define GM_GLDS(src, dstoff) __builtin_amdgcn_global_load_lds((const unsigned*)(src), (LAS unsigned*)(lds + (dstoff)), 16, 0, 0)
#define GM_STAGE_B(bufoff, p, ld, h) do { _Pragma("unroll") for (int i_ = 0; i_ < 2; ++i_) \
        GM_GLDS((p) + ((unsigned)((h) * HALF + sRb[i_]) * (ld) + (unsigned)sC[i_]), (bufoff) + ldsw + i_ * 8192); } while (0)
#define GM_STAGE_A(bufoff, p, ld, h, g) do { _Pragma("unroll") for (int i_ = 0; i_ < 2; ++i_) { \
        const unsigned o_ = GATHER ? (g)[h][i_] + (unsigned)sC[i_] : (unsigned)((h) * HALF + sR[i_]) * (ld) + (unsigned)sC[i_]; \
        GM_GLDS((p) + o_, (bufoff) + ldsw + i_ * 8192); } } while (0)
#define GM_LDA(dst, b, h) do { _Pragma("unroll") for (int m = 0; m < 4; ++m) _Pragma("unroll") for (int k = 0; k < 2; ++k) dst[m][k] = *(const LAS bf16x8*)(lds + GM_SA(b, h) + aoff + m * 2048 + k * 1024); } while (0)
#define GM_LDB(dst, b, h) do { _Pragma("unroll") for (int n = 0; n < 2; ++n) _Pragma("unroll") for (int k = 0; k < 2; ++k) dst[n][k] = *(const LAS bf16x8*)(lds + GM_SB(b, h) + boff + n * 2048 + k * 1024); } while (0)
#define GM_MMA(ai, bj, At, Bt) do { __builtin_amdgcn_s_setprio(1); _Pragma("unroll") for (int m = 0; m < 4; ++m) _Pragma("unroll") for (int n = 0; n < 2; ++n) _Pragma("unroll") for (int k = 0; k < 2; ++k) \
        acc[ai][bj][m][n] = __builtin_amdgcn_mfma_f32_16x16x32_bf16(Bt[n][k], At[m][k], acc[ai][bj][m][n], 0, 0, 0); __builtin_amdgcn_s_setprio(0); } while (0)
#define GM_WAIT_V(n) asm volatile("s_waitcnt vmcnt(" #n ")" ::: "memory")
#define GM_WAIT_L(n) asm volatile("s_waitcnt lgkmcnt(" #n ")" ::: "memory")
#define GM_BAR __builtin_amdgcn_s_barrier()
#define GM_SCHED __builtin_amdgcn_sched_barrier(0)
#define GM_GOFFS(u, g) do { if (GATHER) { _Pragma("unroll") for (int h_ = 0; h_ < 2; ++h_) _Pragma("unroll") for (int i_ = 0; i_ < 2; ++i_) g[h_][i_] = (unsigned)(u).gidx[h_ * HALF + sR[i_]] * (u).lda2; } } while (0)
#define GM_ABASE(u) ((u).A + (GATHER ? (size_t)0 : (size_t)(u).arow0 * (u).lda2))
#define GM_BBASE(u) ((u).Bt + (size_t)(u).brow0 * (u).ldb2)
    Unit cur, nxt; int ui = 0;
    if (!S.next(0, cur)) return;
    f32x4 acc[2][2][4][2];
#pragma unroll
    for (int a = 0; a < 2; ++a)
#pragma unroll
        for (int b = 0; b < 2; ++b)
#pragma unroll
            for (int m = 0; m < 4; ++m)
#pragma unroll
                for (int n = 0; n < 2; ++n) acc[a][b][m][n] = (f32x4){0.f, 0.f, 0.f, 0.f};
    bf16x8 At[4][2], B0[2][2], B1[2][2];
    unsigned gc[2][2] = {{0u, 0u}, {0u, 0u}}, gn[2][2] = {{0u, 0u}, {0u, 0u}};
    GM_GOFFS(cur, gc);
    const char* cA = GM_ABASE(cur); const char* cB = GM_BBASE(cur); unsigned cla = cur.lda2, clb = cur.ldb2;
    GM_STAGE_B(GM_SB(0, 0), cB, clb, 0); GM_STAGE_B(GM_SB(0, 1), cB, clb, 1); GM_STAGE_A(GM_SA(0, 0), cA, cla, 0, gc); GM_STAGE_A(GM_SA(0, 1), cA, cla, 1, gc);
    if (wr == 1) GM_BAR;
    GM_WAIT_V(2); GM_BAR;
    GM_STAGE_B(GM_SB(1, 0), cB + 128, clb, 0); GM_STAGE_A(GM_SA(1, 0), cA + 128, cla, 0, gc); GM_STAGE_B(GM_SB(1, 1), cB + 128, clb, 1);
    GM_WAIT_V(6); GM_BAR;
    for (;;) {
        const bool has_next = S.next(ui + 1, nxt);
        const char* nA = cA; const char* nB = cB; unsigned nla = cla, nlb = clb;
        if (has_next) { GM_GOFFS(nxt, gn); nA = GM_ABASE(nxt); nB = GM_BBASE(nxt); nla = nxt.lda2; nlb = nxt.ldb2; }
        else if (GATHER) {
#pragma unroll
            for (int h = 0; h < 2; ++h)
#pragma unroll
                for (int i = 0; i < 2; ++i) gn[h][i] = gc[h][i];
        }
        const int nt = cur.nt;
        for (int t = 0; t < nt; t += 2) {
            const bool last = (t == nt - 2);
            const char* a1 = cA + (size_t)(t + 1) * 128;
            const char* a2 = last ? nA : cA + (size_t)(t + 2) * 128; const char* b2 = last ? nB : cB + (size_t)(t + 2) * 128;
            const char* a3 = a2 + 128; const char* b3 = b2 + 128;
            const unsigned la2 = last ? nla : cla, lb2 = last ? nlb : clb;
            unsigned g2[2][2];
#pragma unroll
            for (int h = 0; h < 2; ++h)
#pragma unroll
                for (int i = 0; i < 2; ++i) g2[h][i] = GATHER ? (last ? gn[h][i] : gc[h][i]) : 0u;
            GM_LDB(B0, 0, 0); GM_LDB(B1, 0, 1); GM_SCHED; GM_LDA(At, 0, 0); GM_STAGE_A(GM_SA(1, 1), a1, cla, 1, gc);
            GM_WAIT_V(8); GM_WAIT_L(0); GM_BAR; GM_MMA(0, 0, At, B0); GM_MMA(0, 1, At, B1); GM_BAR; GM_SCHED;
            GM_LDA(At, 0, 1); GM_STAGE_B(GM_SB(0, 0), b2, lb2, 0); GM_STAGE_B(GM_SB(0, 1), b2, lb2, 1); GM_STAGE_A(GM_SA(0, 0), a2, la2, 0, g2);
            GM_WAIT_V(8); GM_WAIT_L(0); GM_BAR; GM_MMA(1, 0, At, B0); GM_MMA(1, 1, At, B1); GM_BAR; GM_SCHED;
            GM_LDB(B0, 1, 0); GM_LDB(B1, 1, 1); GM_SCHED; GM_LDA(At, 1, 0); GM_STAGE_A(GM_SA(0, 1), a2, la2, 1, g2);
            GM_WAIT_V(8); GM_WAIT_L(0); GM_BAR; GM_MMA(0, 0, At, B0); GM_MMA(0, 1, At, B1); GM_BAR; GM_SCHED;
            GM_LDA(At, 1, 1); GM_STAGE_B(GM_SB(1, 0), b3, lb2, 0); GM_STAGE_B(GM_SB(1, 1), b3, lb2, 1); GM_STAGE_A(GM_SA(1, 0), a3, la2, 0, g2);
            GM_WAIT_V(8); GM_WAIT_L(0); GM_BAR; GM_MMA(1, 0, At, B0); GM_MMA(1, 1, At, B1); GM_BAR; GM_SCHED;
        }
        if (wr == 0) GM_BAR;
        E(acc, cur, wr, wc, fr, fq);
        if (!has_next) break;
#pragma unroll
        for (int a = 0; a < 2; ++a)
#pragma unroll
            for (int b = 0; b < 2; ++b)
#pragma unroll
                for (int m = 0; m < 4; ++m)
#pragma unroll
                    for (int n = 0; n < 2; ++n) acc[a][b][m][n] = (f32x4){0.f, 0.f, 0.f, 0.f};
        cur = nxt; cA = nA; cB = nB; cla = nla; clb = nlb; ++ui;
        if (GATHER) {
#pragma unroll
            for (int h = 0; h < 2; ++h)
#pragma unroll
                for (int i = 0; i < 2; ++i) gc[h][i] = gn[h][i];
        }
        if (wr == 1) GM_BAR;
    }
    GM_WAIT_V(0);
    GM_BAR;
#undef GM_SA
#undef GM_SB
#undef GM_GLDS
#undef GM_STAGE_A
#undef GM_STAGE_B
#undef GM_LDA
#undef GM_LDB
#undef GM_MMA
#undef GM_WAIT_V
#undef GM_WAIT_L
#undef GM_BAR
#undef GM_SCHED
#undef GM_GOFFS
#undef GM_ABASE
#undef GM_BBASE
}
}
namespace mk {
using gm::bf16_t; using gm::f32x4; using gm::f32x2; using gm::u32x4; using gm::u32x2; using gm::cvt_pk_bf16;
constexpr int T = 16384, S = 8192, D = 1024, NB = 2, NH = 8, NWAVES = 8, NTHREADS = 512;
constexpr float EPS = 1e-6f;
constexpr size_t KiB = 1024, MiB = 1u << 20;
constexpr size_t WS_CTL = 0;
constexpr size_t WS_MODP = 1 * MiB;
constexpr size_t WS_MODF = 2 * MiB;
constexpr size_t WS_TABM = WS_MODF + 64 * KiB;
constexpr size_t WS_TABD = WS_TABM + 2 * MiB;
constexpr size_t WS_SSQ = WS_TABD + 1 * MiB;
constexpr size_t WS_KR = WS_SSQ + 1536 * KiB;
constexpr size_t WS_AFF = WS_KR + 1 * MiB;
constexpr size_t WS_IDX = WS_AFF + 1 * MiB;
constexpr size_t WS_GATE = WS_IDX + 128 * KiB;
constexpr size_t WS_SLOT = WS_GATE + 128 * KiB;
constexpr size_t WS_LSE = WS_SLOT + 1 * MiB;
constexpr size_t WS_WUQ = WS_LSE + 1536 * KiB;
constexpr size_t WS_WUKV = WS_WUQ + 576 * KiB;
constexpr size_t WS_WOUT = WS_WUKV + 512 * KiB;
constexpr size_t WS_WIN = WS_WOUT + 2 * MiB;
constexpr size_t WS_R0END = WS_WIN + 4608 * KiB;
static_assert(WS_R0END <= 20 * MiB, "R0");
constexpr size_t WS_HB = 20 * MiB;
constexpr size_t WS_CQ = 52 * MiB;
constexpr size_t WS_DQ = WS_CQ + 24 * MiB, WS_DK = WS_DQ + 16 * MiB, WS_DV = WS_DK + 16 * MiB;
constexpr size_t WS_Q = WS_DV + 16 * MiB;
constexpr size_t WS_KN = WS_Q + 24 * MiB, WS_V = WS_KN + 16 * MiB;
constexpr size_t WS_HBUF = WS_CQ;
constexpr size_t WS_WGU = 180 * MiB;
constexpr size_t WS_Y = WS_WGU;
constexpr size_t WS_WD = 244 * MiB;
constexpr size_t WS_END = 276 * MiB;
static_assert(WS_V + 16 * MiB == 180 * MiB, "arena");
constexpr int LDS_BYTES = 147456;

__device__ __forceinline__ float wave_sum(float v) {
#pragma unroll
    for (int o = 1; o < 64; o <<= 1) v += __shfl_xor(v, o);
    return v;
}
__device__ __forceinline__ unsigned f2bf(float f) { unsigned u = __builtin_bit_cast(unsigned, f); return (u + 0x7fffu + ((u >> 16) & 1u)) >> 16; }
__device__ __forceinline__ unsigned pk2(float lo, float hi) { return f2bf(lo) | (f2bf(hi) << 16); }
__device__ __forceinline__ float bf2f(unsigned short b) { return __builtin_bit_cast(float, (unsigned)b << 16); }
__device__ __forceinline__ float siluf(float v) { return v / (1.f + __expf(-v)); }
#define LDS_WAIT() asm volatile("s_waitcnt lgkmcnt(0)" ::: "memory")

struct Args { const void* in[19]; float* out; unsigned char* ws; int ph_lo, ph_hi; };
struct Frame {
    LAS unsigned char* lds; unsigned char* ws; float* out;
    int tid, lane, wave, vcu, G;
    const float *x, *c; const int* pos; const float *w_ada, *b_ada, *g_mix, *w_in, *g_q, *w_uq, *g_kv, *w_ukv, *w_out, *g_ffn, *w_router, *b_router, *w_gate, *w_up, *w_down, *g_final;
};

__device__ __forceinline__ float inv_freq_m(int i) { return (float)exp2(-(double)i * (18.931568569324174 / 16.0)); }
__device__ __forceinline__ float inv_freq_d(int i) { return (float)exp2(-(double)i * (18.931568569324174 / 8.0)); }

__device__ __forceinline__ void p0_transpose_item(const float* W, int ldw, int K, int k0, int n0, bf16_t* WT, int drow, const float* kscale, LAS float* scr, int lane) {
#pragma unroll 8
    for (int i = 0; i < 32; ++i) { const int kk = 2 * i + (lane >> 5); float v = W[(size_t)(k0 + kk) * ldw + n0 + (lane & 31)]; if (kscale) v *= kscale[k0 + kk]; scr[kk * 33 + (lane & 31)] = v; }
    LDS_WAIT(); asm volatile("" ::: "memory");
    const int c = lane & 7;
#pragma unroll
    for (int j = 0; j < 4; ++j) { const int n = (lane >> 3) + 8 * j; const LAS float* s = scr + (8 * c) * 33 + n;
        u32x4 o; o.x = pk2(s[0 * 33], s[1 * 33]); o.y = pk2(s[2 * 33], s[3 * 33]); o.z = pk2(s[4 * 33], s[5 * 33]); o.w = pk2(s[6 * 33], s[7 * 33]);
        *(u32x4*)(WT + (size_t)(drow + n) * K + k0 + 8 * c) = o; }
    LDS_WAIT(); asm volatile("" ::: "memory");
}
__device__ __forceinline__ void p0_prologue(Frame& F) {
    LAS float* scr = (LAS float*)(F.lds + F.wave * 16384);
    const int gw = F.vcu * NWAVES + F.wave, NGW = F.G * NWAVES, lane = F.lane;
    unsigned char* ws = F.ws;
    constexpr int I_MOD = 24 * 16, I_IN = 16 * 69, I_UQ = 6 * 24, I_UKV = 4 * 32, I_OUT = 16 * 32, I_EXP = 16 * 16 * 32, I_PAD = 96, I_TAB = T * 24 / 64;
    constexpr int NITEMS = I_MOD + I_IN + I_UQ + I_UKV + I_OUT + 3 * I_EXP + I_PAD + I_TAB;
    for (int it = gw; it < NITEMS; it += NGW) {
        int r = it;
        if (r < I_MOD) {
            const int cc = r % 24, kc = r / 24; f32x4 a0 = {0.f, 0.f, 0.f, 0.f}, a1 = {0.f, 0.f, 0.f, 0.f};
            const float* wp = F.w_ada + (size_t)(kc * 64) * 6144 + cc * 256 + 4 * lane;
#pragma unroll 8
            for (int k = 0; k < 64; ++k) { const f32x4 w = *(const f32x4*)(wp + (size_t)k * 6144); const float s0 = siluf(F.c[kc * 64 + k]), s1 = siluf(F.c[1024 + kc * 64 + k]); a0 += w * s0; a1 += w * s1; }
            float* mp = (float*)(ws + WS_MODP) + (size_t)kc * 2 * 6144 + cc * 256 + 4 * lane;
            *(f32x4*)mp = a0; *(f32x4*)(mp + 6144) = a1; continue; }
        r -= I_MOD;
        if (r < I_IN) { const int kb = r / 69, nb = r % 69, n0 = nb * 32; p0_transpose_item(F.w_in, 2208, 1024, kb * 64, n0, (bf16_t*)(ws + WS_WIN), n0 < 672 ? n0 : n0 + 96, nullptr, scr, lane); continue; }
        r -= I_IN;
        if (r < I_UQ) { const int kb = r / 24, nb = r % 24, n0 = nb * 32, h = n0 / 96, d = n0 % 96; p0_transpose_item(F.w_uq, 768, 384, kb * 64, n0, (bf16_t*)(ws + WS_WUQ), d < 64 ? h * 64 + d : 512 + h * 32, F.g_q, scr, lane); continue; }
        r -= I_UQ;
        if (r < I_UKV) { const int kb = r / 32, nb = r % 32, n0 = nb * 32, h = n0 / 128, d = n0 % 128; p0_transpose_item(F.w_ukv, 1024, 256, kb * 64, n0, (bf16_t*)(ws + WS_WUKV), d < 64 ? h * 64 + d : 512 + h * 64 + (d - 64), F.g_kv, scr, lane); continue; }
        r -= I_UKV;
        if (r < I_OUT) { const int kb = r / 32, nb = r % 32; p0_transpose_item(F.w_out, 1024, 1024, kb * 64, nb * 32, (bf16_t*)(ws + WS_WOUT), nb * 32, nullptr, scr, lane); continue; }
        r -= I_OUT;
        if (r < 2 * I_EXP) { const int up = r >= I_EXP; const int q = up ? r - I_EXP : r; const int e = q / 512, kb = (q % 512) / 32, nb = q % 32, n0 = nb * 32;
            p0_transpose_item((up ? F.w_up : F.w_gate) + (size_t)e * 1048576, 1024, 1024, kb * 64, n0, (bf16_t*)(ws + WS_WGU) + (size_t)e * 2048 * 1024, (n0 / 128) * 256 + up * 128 + (n0 % 128), nullptr, scr, lane); continue; }
        r -= 2 * I_EXP;
        if (r < I_EXP) { const int e = r / 512, kb = (r % 512) / 32, nb = r % 32; p0_transpose_item(F.w_down + (size_t)e * 1048576, 1024, 1024, kb * 64, nb * 32, (bf16_t*)(ws + WS_WD) + (size_t)e * 1048576, nb * 32, nullptr, scr, lane); continue; }
        r -= I_EXP;
        if (r < I_PAD) { u32x4 z = {0u, 0u, 0u, 0u}; u32x4* p = (u32x4*)((bf16_t*)(ws + WS_WIN) + (size_t)(672 + r) * 1024); p[lane] = z; p[64 + lane] = z; continue; }
        r -= I_PAD;
        {
            const int e = r * 64 + lane, tok = e / 24, f = e % 24; const int p = F.pos[tok];
            const float inv = f < 16 ? inv_freq_m(f) : inv_freq_d(f - 16); const float ang = (float)p * inv; const float cs = (float)cos((double)ang), sn = (float)sin((double)ang);
            if (f < 16) { float* tm = (float*)(ws + WS_TABM) + (size_t)tok * 32; tm[f] = cs; tm[16 + f] = sn; } else { float* td = (float*)(ws + WS_TABD) + (size_t)tok * 16; td[f - 16] = cs; td[8 + f - 16] = sn; }
        }
    }
}
__device__ __forceinline__ void p0b_rows(Frame& F) {
    LAS float* A1 = (LAS float*)F.lds;
    LAS float* A0 = A1 + 2048;
    const float* mp = (const float*)(F.ws + WS_MODP);
    for (int i = F.tid; i < 4096; i += NTHREADS) { const int b = i >> 11, which = (i >> 10) & 1, j = i & 1023; const int n = which * 1024 + j;
        float s = F.b_ada[n];
#pragma unroll
        for (int k = 0; k < 16; ++k) s += mp[(size_t)k * 2 * 6144 + b * 6144 + n];
        if (which) A1[b * 1024 + j] = F.g_mix[j] * (1.f + s); else A0[b * 1024 + j] = s; }
    if (blockIdx.x < 48 && F.tid < 256) { const int n = blockIdx.x * 256 + F.tid; const int b = n / 6144, nn = n % 6144; float s = F.b_ada[nn];
#pragma unroll
        for (int k = 0; k < 16; ++k) s += mp[(size_t)k * 2 * 6144 + b * 6144 + nn];
        ((float*)(F.ws + WS_MODF))[n] = s; }
    __syncthreads();
    const int gw = F.vcu * NWAVES + F.wave, NGW = F.G * NWAVES, lane = F.lane;
    for (int m = gw; m < T; m += NGW) { const int b = m >> 13;
        const f32x4* xr = (const f32x4*)(F.x + (size_t)m * D) + lane; f32x4 v[4]; float s = 0.f;
#pragma unroll
        for (int j = 0; j < 4; ++j) { v[j] = xr[64 * j]; s += (v[j].x * v[j].x + v[j].y * v[j].y) + (v[j].z * v[j].z + v[j].w * v[j].w); }
        const float rstd = rsqrtf(wave_sum(s) * (1.f / D) + EPS);
        unsigned long long* o8 = (unsigned long long*)((bf16_t*)(F.ws + WS_HB) + (size_t)m * D) + lane;
#pragma unroll
        for (int j = 0; j < 4; ++j) { const f32x4 a1 = *(const LAS f32x4*)(A1 + b * 1024 + 4 * lane + 256 * j), a0 = *(const LAS f32x4*)(A0 + b * 1024 + 4 * lane + 256 * j);
            const f32x4 o = v[j] * rstd * a1 + a0; o8[64 * j] = (unsigned long long)pk2(o.x, o.y) | ((unsigned long long)pk2(o.z, o.w) << 32); }
    }
    __syncthreads();
}

__device__ __forceinline__ bool static_tile(int i, int G, int c, int nM, int nN, int& pm, int& pn) {
    const int nwg = nM * nN; const long L = (long)i * G + c; if (L >= nwg) return false;
    int wgid = (int)L; { const int q = nwg / 8, r = nwg % 8, xcd = wgid % 8, off = wgid / 8; wgid = (xcd < r ? xcd * (q + 1) : r * (q + 1) + (xcd - r) * q) + off; }
    const int nig = 8 * nN, gid = wgid / nig, fm = gid * 8, gsz = (nM - fm) < 8 ? (nM - fm) : 8;
    pm = fm + ((wgid % nig) % gsz); pn = (wgid % nig) / gsz; return true;
}
struct SchedP1 {
    static constexpr bool GATHER = false;
    const char* A; const char* Bt; int G, c;
    __device__ __forceinline__ bool next(int i, gm::Unit& u) const { int pm, pn; if (!static_tile(i, G, c, 64, 9, pm, pn)) return false;
        u.A = A; u.Bt = Bt; u.gidx = nullptr; u.lda2 = 2048; u.ldb2 = 2048; u.arow0 = pm * 256; u.brow0 = pn * 256; u.nt = 16; u.pm = pm; u.pn = pn; u.aux = 0; return true; }
};
struct SchedP2 {
    static constexpr bool GATHER = false;
    const char* A; const char* Wuq; const char* Wukv; int G, c;
    __device__ __forceinline__ bool next(int i, gm::Unit& u) const {
        const int L = i * G + c; if (L >= 448) return false;
        u.A = A; u.gidx = nullptr; u.lda2 = 1536;
        if (L < 256) { int pm, pn; static_tile(0, 256, L, 64, 4, pm, pn); u.A = A + 768; u.Bt = Wukv; u.ldb2 = 512; u.nt = 4; u.arow0 = pm * 256; u.brow0 = pn * 256; u.pm = pm; u.pn = pn; u.aux = 1; }
        else { int pm, pn; static_tile(0, 192, L - 256, 64, 3, pm, pn); u.Bt = Wuq; u.ldb2 = 768; u.nt = 6; u.arow0 = pm * 256; u.brow0 = pn * 256; u.pm = pm; u.pn = pn; u.aux = 0; }
        return true; }
};

#define EPI_ARGS const f32x4 (&acc)[2][2][4][2], const gm::Unit& u, int wr, int wc, int fr, int fq
constexpr float QSCALE_M = 0.10206207261596575f * 1.4426950408889634f;
constexpr float QSCALE_D = 0.125f * 1.4426950408889634f;
__device__ __forceinline__ u32x4 pack8(f32x4 a, f32x4 b) { u32x4 w; w.x = cvt_pk_bf16(a[0], a[1]); w.y = cvt_pk_bf16(a[2], a[3]); w.z = cvt_pk_bf16(b[0], b[1]); w.w = cvt_pk_bf16(b[2], b[3]); return w; }
__device__ __forceinline__ void rope8(f32x4& v0, f32x4& v1, int xmask, const float* cs, const float* sn, bool first) {
    f32x4 o0, o1;
#pragma unroll
    for (int j = 0; j < 4; ++j) { o0[j] = __shfl_xor(v0[j], xmask); o1[j] = __shfl_xor(v1[j], xmask); }
    const f32x4 c0 = *(const f32x4*)cs, c1 = *(const f32x4*)(cs + 4), s0 = *(const f32x4*)sn, s1 = *(const f32x4*)(sn + 4);
    const float sg = first ? -1.f : 1.f;
    v0 = v0 * c0 + o0 * s0 * sg; v1 = v1 * c1 + o1 * s1 * sg;
}
struct EpiP1 {
    static constexpr bool PERM = true;
    unsigned char* ws;
    __device__ __forceinline__ void operator()(EPI_ARGS) const {
        const int pn = u.pn;
        const float* tabm = (const float*)(ws + WS_TABM); const float* tabd = (const float*)(ws + WS_TABD);
#pragma unroll
        for (int ai = 0; ai < 2; ++ai)
#pragma unroll
            for (int m = 0; m < 4; ++m) {
                const int row = u.pm * 256 + ai * 128 + wr * 64 + m * 16 + fr; const int b = row >> 13, s = row & 8191;
#pragma unroll
                for (int bj = 0; bj < 2; ++bj) {
                    f32x4 v0 = acc[ai][bj][m][0], v1 = acc[ai][bj][m][1];
                    const int ct = bj * 128 + wc * 32 + 8 * fq;
                    if (pn < 3) {
                        float q = (v0[0] * v0[0] + v0[1] * v0[1]) + (v0[2] * v0[2] + v0[3] * v0[3]) + (v1[0] * v1[0] + v1[1] * v1[1]) + (v1[2] * v1[2] + v1[3] * v1[3]);
                        q += __shfl_xor(q, 16); q += __shfl_xor(q, 32);
                        if (fq == 0) ((float*)(ws + WS_SSQ))[(size_t)row * 24 + pn * 8 + bj * 4 + wc] = q;
                        if (pn == 2 && bj == 1 && wc == 0) {
                            const int f0 = 8 * (fq & 1); rope8(v0, v1, 32, tabm + (size_t)row * 32 + f0, tabm + (size_t)row * 32 + 16 + f0, fq < 2);
                            *(u32x4*)((bf16_t*)(ws + WS_KR) + (size_t)row * 32 + 8 * fq) = pack8(v0, v1);
                        } else *(u32x4*)((bf16_t*)(ws + WS_CQ) + (size_t)row * 768 + pn * 256 + ct) = pack8(v0, v1);
                    } else {
                        const int which = (pn - 3) >> 1;
                        const int cc = ((pn - 3) & 1) * 256 + ct, hh = cc >> 6, d = cc & 63;
                        if (which < 2 && (wc & 1) == 0) {
                            f32x4 r0 = v0, r1 = v1; rope8(r0, r1, 16, tabd + (size_t)row * 16, tabd + (size_t)row * 16 + 8, fq == 0);
                            if (fq < 2) { v0 = r0; v1 = r1; } }
                        if (which == 0) { v0 = v0 * QSCALE_D; v1 = v1 * QSCALE_D; }
                        bf16_t* dst = (bf16_t*)(ws + (which == 0 ? WS_DQ : which == 1 ? WS_DK : WS_DV));
                        *(u32x4*)(dst + ((size_t)(b * 8 + hh) * S + s) * 64 + d) = pack8(v0, v1);
                    }
                }
            }
    }
};
struct EpiP2 {
    static constexpr bool PERM = true;
    unsigned char* ws;
    __device__ __forceinline__ void operator()(EPI_ARGS) const {
        const int pn = u.pn; const bool isq = u.aux == 0;
        const float* tabm = (const float*)(ws + WS_TABM); const float* ssq = (const float*)(ws + WS_SSQ);
#pragma unroll
        for (int ai = 0; ai < 2; ++ai)
#pragma unroll
            for (int m = 0; m < 4; ++m) {
                const int row = u.pm * 256 + ai * 128 + wr * 64 + m * 16 + fr; const int b = row >> 13, s = row & 8191;
                const float* sq = ssq + (size_t)row * 24; float rstd;
                if (isq) { const f32x4 a = *(const f32x4*)sq, bq = *(const f32x4*)(sq + 4), cq = *(const f32x4*)(sq + 8);
                    rstd = rsqrtf((((a[0] + a[1]) + (a[2] + a[3])) + ((bq[0] + bq[1]) + (bq[2] + bq[3])) + ((cq[0] + cq[1]) + (cq[2] + cq[3]))) * (1.f / 384.f) + EPS) * QSCALE_M; }
                else { const f32x4 a = *(const f32x4*)(sq + 12), bq = *(const f32x4*)(sq + 16);
                    rstd = rsqrtf((((a[0] + a[1]) + (a[2] + a[3])) + ((bq[0] + bq[1]) + (bq[2] + bq[3]))) * (1.f / 256.f) + EPS); }
#pragma unroll
                for (int bj = 0; bj < 2; ++bj) {
                    f32x4 v0 = acc[ai][bj][m][0] * rstd, v1 = acc[ai][bj][m][1] * rstd;
                    const int ct = bj * 128 + wc * 32 + 8 * fq, cc = (pn & 1) * 256 + ct;
                    if (isq) {
                        if (pn < 2) { const int hh = cc >> 6, d = cc & 63; *(u32x4*)((bf16_t*)(ws + WS_Q) + ((size_t)(b * 8 + hh) * S + s) * 96 + d) = pack8(v0, v1); }
                        else { const int hh = ct >> 5; const int f0 = 8 * (fq & 1); rope8(v0, v1, 32, tabm + (size_t)row * 32 + f0, tabm + (size_t)row * 32 + 16 + f0, fq < 2);
                            *(u32x4*)((bf16_t*)(ws + WS_Q) + ((size_t)(b * 8 + hh) * S + s) * 96 + 64 + 8 * fq) = pack8(v0, v1); }
                    } else { const int hh = cc >> 6, d = cc & 63; bf16_t* dst = (bf16_t*)(ws + (pn < 2 ? WS_KN : WS_V));
                        *(u32x4*)(dst + ((size_t)(b * 8 + hh) * S + s) * 64 + d) = pack8(v0, v1); }
                }
            }
    }
};
}
namespace at {
using bf16x8 = __attribute__((ext_vector_type(8))) short;
using s16x4 = __attribute__((ext_vector_type(4))) short;
using f32x16 = __attribute__((ext_vector_type(16))) float;
using u32x4 = __attribute__((ext_vector_type(4))) unsigned;
constexpr int S = 8192, T = 16384;
constexpr float THR = 8.f;
#define SBAR() __builtin_amdgcn_sched_barrier(0)
__device__ __forceinline__ int crow(int r, int hi) { return (r & 3) + 8 * (r >> 2) + 4 * hi; }
__device__ __forceinline__ unsigned cvtpk(float lo, float hi) { unsigned r; asm volatile("v_cvt_pk_bf16_f32 %0, %1, %2" : "=v"(r) : "v"(lo), "v"(hi)); return r; }
__device__ __forceinline__ float rowmax32(const f32x16& p0, const f32x16& p1) {
    float pmax = p0[0];
#pragma unroll
    for (int r = 1; r < 16; ++r) pmax = fmaxf(pmax, p0[r]);
#pragma unroll
    for (int r = 0; r < 16; ++r) pmax = fmaxf(pmax, p1[r]);
    auto rr = __builtin_amdgcn_permlane32_swap(__float_as_uint(pmax), __float_as_uint(pmax), false, false);
    return fmaxf(__uint_as_float(rr[0]), __uint_as_float(rr[1]));
}
__device__ __forceinline__ void partialSM(f32x16& p0, f32x16& p1, float& m_reg, float& mn, float& alpha) {
    const float pmax = rowmax32(p0, p1);
    if (__builtin_expect(__all(pmax - m_reg <= THR), 1)) { mn = m_reg; alpha = 1.f; }
    else { mn = fmaxf(m_reg, pmax); alpha = __builtin_amdgcn_exp2f(m_reg - mn); m_reg = mn; }
#pragma unroll
    for (int r = 0; r < 16; ++r) p0[r] = p0[r] - mn;
#pragma unroll
    for (int r = 0; r < 16; ++r) p1[r] = p1[r] - mn;
#pragma unroll
    for (int r = 0; r < 16; ++r) p0[r] = __builtin_amdgcn_exp2f(p0[r]);
}
#define PK4(P, BASE, OUT) do { unsigned a0 = cvtpk(P[BASE + 0], P[BASE + 1]), a1 = cvtpk(P[BASE + 2], P[BASE + 3]);   \
    unsigned b0 = cvtpk(P[BASE + 4], P[BASE + 5]), b1 = cvtpk(P[BASE + 6], P[BASE + 7]);                              \
    auto r0 = __builtin_amdgcn_permlane32_swap(a0, b0, false, false); auto r1 = __builtin_amdgcn_permlane32_swap(a1, b1, false, false); \
    u32x4 w = {r0[0], r1[0], r0[1], r1[1]}; OUT = *reinterpret_cast<bf16x8*>(&w); } while (0)
__device__ __forceinline__ void finishSM(f32x16& p0, f32x16& p1, float alpha, float& l_reg, bf16x8& pa0, bf16x8& pa1, bf16x8& pa2, bf16x8& pa3) {
#pragma unroll
    for (int r = 0; r < 16; ++r) p1[r] = __builtin_amdgcn_exp2f(p1[r]);
    float ps = 0;
#pragma unroll
    for (int r = 0; r < 16; ++r) ps += p0[r];
#pragma unroll
    for (int r = 0; r < 16; ++r) ps += p1[r];
    { auto rr = __builtin_amdgcn_permlane32_swap(__float_as_uint(ps), __float_as_uint(ps), false, false); ps = __uint_as_float(rr[0]) + __uint_as_float(rr[1]); }
    l_reg = l_reg * alpha + ps;
    PK4(p0, 0, pa0); PK4(p0, 8, pa1); PK4(p1, 0, pa2); PK4(p1, 8, pa3);
}
__device__ __forceinline__ int v_st(int k, int c) { const int kk = (k & ~0xC) | ((k & 4) << 1) | ((k & 8) >> 1); return ((kk >> 3) * 2 + (c >> 5)) * 512 + ((kk & 7) * 32 + (c & 31)) * 2; }
__device__ __forceinline__ int v_rd_base(int lane) { return ((lane & 3) << 3) | (((lane >> 2) & 3) << 6) | (((lane >> 4) & 1) << 5) | (((lane >> 5) & 1) << 8); }
constexpr int v_rd_off(int d0, int ks, int half) { return d0 * 512 + ks * 2048 + half * 1024; }
template <int OFF> __device__ __forceinline__ s16x4 tr_read(int vb) { s16x4 r; asm volatile("ds_read_b64_tr_b16 %0, %1 offset:%2" : "=&v"(r) : "v"(vb), "i"(OFF) : "memory"); return r; }
#define PKV(L, H) (bf16x8){L[0], L[1], L[2], L[3], H[0], H[1], H[2], H[3]}
template <int D0, int KOFF> __device__ __forceinline__ void pv_one(f32x16& od, int vb, bf16x8 pa0, bf16x8 pa1, bf16x8 pa2, bf16x8 pa3) {
    const s16x4 l0 = tr_read<KOFF + v_rd_off(D0, 0, 0)>(vb), h0 = tr_read<KOFF + v_rd_off(D0, 0, 1)>(vb), l1 = tr_read<KOFF + v_rd_off(D0, 1, 0)>(vb), h1 = tr_read<KOFF + v_rd_off(D0, 1, 1)>(vb);
    const s16x4 l2 = tr_read<KOFF + v_rd_off(D0, 2, 0)>(vb), h2 = tr_read<KOFF + v_rd_off(D0, 2, 1)>(vb), l3 = tr_read<KOFF + v_rd_off(D0, 3, 0)>(vb), h3 = tr_read<KOFF + v_rd_off(D0, 3, 1)>(vb);
    asm volatile("s_waitcnt lgkmcnt(0)" ::: "memory"); SBAR();
    od = __builtin_amdgcn_mfma_f32_32x32x16_bf16(pa0, PKV(l0, h0), od, 0, 0, 0);
    od = __builtin_amdgcn_mfma_f32_32x32x16_bf16(pa1, PKV(l1, h1), od, 0, 0, 0);
    od = __builtin_amdgcn_mfma_f32_32x32x16_bf16(pa2, PKV(l2, h2), od, 0, 0, 0);
    od = __builtin_amdgcn_mfma_f32_32x32x16_bf16(pa3, PKV(l3, h3), od, 0, 0, 0);
}
template <int D0, int KOFF> __device__ __forceinline__ void pv_half(f32x16& od, int vb, bf16x8 pa0, bf16x8 pa1) {
    const s16x4 l0 = tr_read<KOFF + v_rd_off(D0, 0, 0)>(vb), h0 = tr_read<KOFF + v_rd_off(D0, 0, 1)>(vb), l1 = tr_read<KOFF + v_rd_off(D0, 1, 0)>(vb), h1 = tr_read<KOFF + v_rd_off(D0, 1, 1)>(vb);
    asm volatile("s_waitcnt lgkmcnt(0)" ::: "memory"); SBAR();
    od = __builtin_amdgcn_mfma_f32_32x32x16_bf16(pa0, PKV(l0, h0), od, 0, 0, 0);
    od = __builtin_amdgcn_mfma_f32_32x32x16_bf16(pa1, PKV(l1, h1), od, 0, 0, 0);
}
template <class RowOff> __device__ __forceinline__ void store_o_tile(const f32x16 (&o)[2], const float (&rli)[16], unsigned short* stg, unsigned short* dst, RowOff row_off, int lane) {
    const int r32 = lane & 31, hi = lane >> 5;
#pragma unroll
    for (int r = 0; r < 16; ++r) { const int orow = crow(r, hi);
#pragma unroll
        for (int d0 = 0; d0 < 2; ++d0) stg[orow * 64 + d0 * 32 + r32] = (unsigned short)(cvtpk(o[d0][r] * rli[r], 0.f) & 0xffffu); }
    asm volatile("s_waitcnt lgkmcnt(0)" ::: "memory");
#pragma unroll
    for (int i = 0; i < 4; ++i) { const int row = i * 8 + (lane >> 3), ch = lane & 7; const u32x4 v = *(const u32x4*)(stg + row * 64 + ch * 8); *(u32x4*)(dst + row_off(row) + ch * 8) = v; }
    asm volatile("s_waitcnt lgkmcnt(0)" ::: "memory");
}

constexpr int SHM_V = 8192, SHM_K = 16384, MLA_WS = 2 * SHM_V + 2 * SHM_K, MLA_OST = MLA_WS + 8 * 256;
#define KSWZ(row, colB) ((row) * 256 + ((colB) ^ (((row) & 15) << 4)))
__device__ __forceinline__ void qkt96(f32x16& p0, f32x16& p1, const char* Ks, const bf16x8* qr, int r32, int hi) {
    p0 = f32x16{}; p1 = f32x16{};
#pragma unroll
    for (int d0 = 0; d0 < 6; ++d0) { const int cb = (d0 * 16 + hi * 8) * 2;
        const bf16x8 b0 = *reinterpret_cast<const bf16x8*>(Ks + KSWZ(r32, cb));
        const bf16x8 b1 = *reinterpret_cast<const bf16x8*>(Ks + KSWZ(32 + r32, cb));
        p0 = __builtin_amdgcn_mfma_f32_32x32x16_bf16(b0, qr[d0], p0, 0, 0, 0);
        p1 = __builtin_amdgcn_mfma_f32_32x32x16_bf16(b1, qr[d0], p1, 0, 0, 0); }
}
__device__ __forceinline__ void pv64(f32x16* o, int vb, bf16x8 pa0, bf16x8 pa1, bf16x8 pa2, bf16x8 pa3) {
    pv_one<0, 0>(o[0], vb, pa0, pa1, pa2, pa3); pv_one<1, 0>(o[1], vb, pa0, pa1, pa2, pa3);
}
__device__ __forceinline__ void mla_unit(int bh, int qb, const unsigned short* __restrict__ Q, const unsigned short* __restrict__ KN, const unsigned short* __restrict__ KR,
                                         const unsigned short* __restrict__ V, unsigned short* __restrict__ CAT, char* lds) {
    const int tid = threadIdx.x, wid = tid >> 6, lane = tid & 63, r32 = lane & 31, hi = lane >> 5;
    const int b = bh >> 3, h = bh & 7;
    char* V_lds = lds; char* K_lds = lds + 2 * SHM_V;
    float* wsf = (float*)(lds + MLA_WS) + wid * 64; float* li_l = wsf; float* al_l = wsf + 32;
    float m_reg = -1e30f, l_reg = 0; f32x16 o[2] = {}; bf16x8 qr[6];
    const size_t bhS = (size_t)bh * S; const int q0 = qb * 256;
    const unsigned short* Qw = Q + (bhS + q0 + wid * 32 + r32) * 96 + hi * 8;
#pragma unroll
    for (int d0 = 0; d0 < 6; ++d0) qr[d0] = *reinterpret_cast<const bf16x8*>(Qw + d0 * 16);
    const int srow = tid >> 3, sch = tid & 7, rrow = (tid & 255) >> 2, rch = tid & 3;
    const unsigned short* kn_src = KN + (bhS + srow) * 64 + sch * 8;
    const unsigned short* v_src = V + (bhS + srow) * 64 + sch * 8;
    const unsigned short* kr_src = KR + ((size_t)b * S + rrow) * 32 + rch * 8;
    const int kst = KSWZ(srow, sch * 16), krst = KSWZ(rrow, (8 + rch) * 16), vst = v_st(srow, sch * 8);
    const int vb0 = (int)(uintptr_t)V_lds + v_rd_base(lane);
    bf16x8 s_kn[2], s_kr[2], s_v[2];
#define SLOAD(i, k0) do { s_kn[i] = *reinterpret_cast<const bf16x8*>(kn_src + (size_t)(k0) * 64); s_kr[i] = *reinterpret_cast<const bf16x8*>(kr_src + (size_t)(k0) * 32); \
    s_v[i] = *reinterpret_cast<const bf16x8*>(v_src + (size_t)(k0) * 64); } while (0)
#define SWRITE(bb, i) do { *(bf16x8*)(K_lds + (bb) * SHM_K + kst) = s_kn[i]; if (tid < 256) *(bf16x8*)(K_lds + (bb) * SHM_K + krst) = s_kr[i]; *(bf16x8*)(V_lds + (bb) * SHM_V + vst) = s_v[i]; } while (0)
#define SWAIT() asm volatile("s_waitcnt vmcnt(3)" ::: "memory")
#define RESC(a) do { if (__any((a) < 1.f)) { if (hi == 0) al_l[r32] = (a); asm volatile("s_waitcnt lgkmcnt(0)" ::: "memory"); \
    _Pragma("unroll") for (int d = 0; d < 2; ++d) _Pragma("unroll") for (int r = 0; r < 16; ++r) o[d][r] *= al_l[crow(r, hi)]; } } while (0)
    f32x16 pA0, pA1, pB0, pB1; float mnA, mnB, alA, alB; bf16x8 pa0, pa1, pa2, pa3; constexpr int NT = S / 64;
    SLOAD(0, 0); asm volatile("s_waitcnt vmcnt(0)" ::: "memory"); SWRITE(0, 0); __syncthreads();
    qkt96(pA0, pA1, K_lds, qr, r32, hi); partialSM(pA0, pA1, m_reg, mnA, alA);
    SLOAD(1, 64); SLOAD(0, 128);
    SWAIT(); SWRITE(1, 1); __syncthreads();
    for (int j = 1; j + 1 < NT; j += 2) {
        SBAR(); qkt96(pB0, pB1, K_lds + SHM_K, qr, r32, hi);
        finishSM(pA0, pA1, alA, l_reg, pa0, pa1, pa2, pa3); SBAR();
        SLOAD(1, (j + 2) * 64); SBAR();
        pv64(o, vb0, pa0, pa1, pa2, pa3); partialSM(pB0, pB1, m_reg, mnB, alB);
        __syncthreads(); SWAIT(); SWRITE(0, 0);
        RESC(alB); __syncthreads();
        SBAR(); qkt96(pA0, pA1, K_lds, qr, r32, hi);
        finishSM(pB0, pB1, alB, l_reg, pa0, pa1, pa2, pa3); SBAR();
        if (j + 3 < NT) SLOAD(0, (j + 3) * 64); SBAR();
        pv64(o, vb0 + SHM_V, pa0, pa1, pa2, pa3); partialSM(pA0, pA1, m_reg, mnA, alA);
        __syncthreads(); SWAIT(); SWRITE(1, 1);
        RESC(alA); __syncthreads();
    }
    SBAR(); qkt96(pB0, pB1, K_lds + SHM_K, qr, r32, hi);
    finishSM(pA0, pA1, alA, l_reg, pa0, pa1, pa2, pa3); SBAR();
    pv64(o, vb0, pa0, pa1, pa2, pa3); partialSM(pB0, pB1, m_reg, mnB, alB);
    __syncthreads(); RESC(alB);
    finishSM(pB0, pB1, alB, l_reg, pa0, pa1, pa2, pa3); SBAR();
    pv64(o, vb0 + SHM_V, pa0, pa1, pa2, pa3);
    if (hi == 0) li_l[r32] = l_reg; asm volatile("s_waitcnt lgkmcnt(0)" ::: "memory");
    float rli[16];
#pragma unroll
    for (int r = 0; r < 16; ++r) rli[r] = __builtin_amdgcn_rcpf(li_l[crow(r, hi)]);
    unsigned short* stg = (unsigned short*)(lds + MLA_OST) + wid * 2048;
    unsigned short* dst = CAT + ((size_t)b * S + q0 + wid * 32) * 1024 + h * 64;
    store_o_tile(o, rli, stg, dst, [](int row) { return (size_t)row * 1024; }, lane);
    asm volatile("s_waitcnt vmcnt(0)" ::: "memory");
    __syncthreads();
#undef SLOAD
#undef SWRITE
#undef SWAIT
#undef RESC
}

constexpr int DL_K = 0, DL_V = 49152, DL_WS = 98304, DL_OST = DL_WS + 8 * 256;
#define KSWZD(row, colB) ((row) * 128 + ((colB) ^ ((((row) >> 1) & 7) << 4)))
__device__ __forceinline__ void dil_unit(int bh, int br, int blk, const unsigned short* __restrict__ DQ, const unsigned short* __restrict__ DK, const unsigned short* __restrict__ DV,
                                         unsigned short* __restrict__ OBR, float* __restrict__ LSE, char* lds) {
    const int tid = threadIdx.x, wid = tid >> 6, lane = tid & 63, r32 = lane & 31, hi = lane >> 5;
    const int sh = 2 * br, dil = 1 << sh, L = S >> sh, nbl = L >> 8, res = blk / nbl, lb = blk % nbl;
    const size_t bhS = (size_t)bh * S; const int b = bh >> 3, h = bh & 7;
    char* K_lds = lds + DL_K; char* V_lds = lds + DL_V;
#pragma unroll
    for (int half = 0; half < 2; ++half) {
        bf16x8 kk[3], vv[3];
#pragma unroll
        for (int it = 0; it < 3; ++it) { const int item = (half * 3 + it) * 512 + tid, row = item >> 3, ch = item & 7; const int l = 256 * lb - 64 + row; const bool valid = (l >= 0) && (l < L);
            const size_t src = (bhS + (valid ? ((size_t)l << sh) + res : 0)) * 64 + ch * 8;
            kk[it] = *reinterpret_cast<const bf16x8*>(DK + src); vv[it] = *reinterpret_cast<const bf16x8*>(DV + src);
            if (!valid) { kk[it] = bf16x8{}; vv[it] = bf16x8{}; } }
#pragma unroll
        for (int it = 0; it < 3; ++it) { const int item = (half * 3 + it) * 512 + tid, row = item >> 3, ch = item & 7;
            *(bf16x8*)(K_lds + KSWZD(row, ch * 16)) = kk[it]; *(bf16x8*)(V_lds + (row >> 4) * 2048 + v_st(row & 15, ch * 8)) = vv[it]; }
    }
    bf16x8 qr[4];
    const int ql = wid * 32 + r32; const size_t qpos = ((size_t)(256 * lb + ql) << sh) + res;
    const unsigned short* Qw = DQ + (bhS + qpos) * 64 + hi * 8;
#pragma unroll
    for (int d0 = 0; d0 < 4; ++d0) qr[d0] = *reinterpret_cast<const bf16x8*>(Qw + d0 * 16);
    __syncthreads();
    f32x16 p[5];
#pragma unroll
    for (int j = 0; j < 5; ++j) { p[j] = f32x16{}; const int row = wid * 32 + j * 32 + r32;
#pragma unroll
        for (int d0 = 0; d0 < 4; ++d0) { const bf16x8 kf = *reinterpret_cast<const bf16x8*>(K_lds + KSWZD(row, (d0 * 16 + hi * 8) * 2)); p[j] = __builtin_amdgcn_mfma_f32_32x32x16_bf16(kf, qr[d0], p[j], 0, 0, 0); } }
    const float NEG = -1e30f;
    const int klo = 64 - 256 * lb, khi = L + 64 - 256 * lb;
#pragma unroll
    for (int j = 0; j < 5; ++j)
#pragma unroll
        for (int r = 0; r < 16; ++r) { const int kk = crow(r, hi); const int kl = wid * 32 + j * 32 + kk; bool ok = (kl >= klo) && (kl < khi);
            if (j == 0) ok = ok && (kk >= r32); if (j == 4) ok = ok && (kk <= r32); if (!ok) p[j][r] = NEG; }
    float mx = rowmax32(p[0], p[1]); mx = fmaxf(mx, rowmax32(p[2], p[3]));
    { float m4 = p[4][0];
#pragma unroll
      for (int r = 1; r < 16; ++r) m4 = fmaxf(m4, p[4][r]);
      auto rr = __builtin_amdgcn_permlane32_swap(__float_as_uint(m4), __float_as_uint(m4), false, false); mx = fmaxf(mx, fmaxf(__uint_as_float(rr[0]), __uint_as_float(rr[1]))); }
    float ps = 0.f;
#pragma unroll
    for (int j = 0; j < 5; ++j)
#pragma unroll
        for (int r = 0; r < 16; ++r) { p[j][r] = __builtin_amdgcn_exp2f(p[j][r] - mx); ps += p[j][r]; }
    { auto rr = __builtin_amdgcn_permlane32_swap(__float_as_uint(ps), __float_as_uint(ps), false, false); ps = __uint_as_float(rr[0]) + __uint_as_float(rr[1]); }
    bf16x8 pa[5][2];
#pragma unroll
    for (int j = 0; j < 5; ++j) { PK4(p[j], 0, pa[j][0]); PK4(p[j], 8, pa[j][1]); }
    f32x16 o[2] = {};
    const int vb = (int)(uintptr_t)V_lds + v_rd_base(lane) + wid * 4096;
    pv_half<0, 0 * 4096>(o[0], vb, pa[0][0], pa[0][1]); pv_half<1, 0 * 4096>(o[1], vb, pa[0][0], pa[0][1]);
    pv_half<0, 1 * 4096>(o[0], vb, pa[1][0], pa[1][1]); pv_half<1, 1 * 4096>(o[1], vb, pa[1][0], pa[1][1]);
    pv_half<0, 2 * 4096>(o[0], vb, pa[2][0], pa[2][1]); pv_half<1, 2 * 4096>(o[1], vb, pa[2][0], pa[2][1]);
    pv_half<0, 3 * 4096>(o[0], vb, pa[3][0], pa[3][1]); pv_half<1, 3 * 4096>(o[1], vb, pa[3][0], pa[3][1]);
    pv_half<0, 4 * 4096>(o[0], vb, pa[4][0], pa[4][1]); pv_half<1, 4 * 4096>(o[1], vb, pa[4][0], pa[4][1]);
    float* wsf = (float*)(lds + DL_WS) + wid * 64;
    if (hi == 0) { wsf[r32] = ps; LSE[((size_t)br * T + (size_t)b * S + qpos) * 8 + h] = mx + __builtin_amdgcn_logf(ps); }
    asm volatile("s_waitcnt lgkmcnt(0)" ::: "memory");
    float rli[16];
#pragma unroll
    for (int r = 0; r < 16; ++r) rli[r] = __builtin_amdgcn_rcpf(wsf[crow(r, hi)]);
    unsigned short* stg = (unsigned short*)(lds + DL_OST) + wid * 2048;
    unsigned short* dst = OBR + ((size_t)br * T + (size_t)b * S + (((size_t)(256 * lb + wid * 32)) << sh) + res) * 512 + h * 64;
    store_o_tile(o, rli, stg, dst, [sh](int row) { return ((size_t)row << sh) * 512; }, lane);
    asm volatile("s_waitcnt vmcnt(0)" ::: "memory");
    __syncthreads();
}
__device__ __forceinline__ void dil_combine(const unsigned short* __restrict__ OBR, const float* __restrict__ LSE, unsigned short* __restrict__ CAT, int gtid, int gthreads) {
    for (int i = gtid; i < T * 64; i += gthreads) { const int t = i >> 6, c8 = i & 63, h = c8 >> 3;
        const float l0 = LSE[((size_t)0 * T + t) * 8 + h], l1 = LSE[((size_t)1 * T + t) * 8 + h], l2 = LSE[((size_t)2 * T + t) * 8 + h];
        const float mx = fmaxf(l0, fmaxf(l1, l2)); float w0 = __builtin_amdgcn_exp2f(l0 - mx), w1 = __builtin_amdgcn_exp2f(l1 - mx), w2 = __builtin_amdgcn_exp2f(l2 - mx);
        const float inv = 1.f / (w0 + w1 + w2); w0 *= inv; w1 *= inv; w2 *= inv;
        const u32x4 a = *(const u32x4*)(OBR + ((size_t)0 * T + t) * 512 + c8 * 8), bb = *(const u32x4*)(OBR + ((size_t)1 * T + t) * 512 + c8 * 8), cc = *(const u32x4*)(OBR + ((size_t)2 * T + t) * 512 + c8 * 8);
        u32x4 o;
#pragma unroll
        for (int k = 0; k < 4; ++k) { const float lo = w0 * __uint_as_float(a[k] << 16) + w1 * __uint_as_float(bb[k] << 16) + w2 * __uint_as_float(cc[k] << 16);
            const float hi = w0 * __uint_as_float(a[k] & 0xffff0000u) + w1 * __uint_as_float(bb[k] & 0xffff0000u) + w2 * __uint_as_float(cc[k] & 0xffff0000u); o[k] = cvtpk(lo, hi); }
        *(u32x4*)(CAT + (size_t)t * 1024 + 512 + c8 * 8) = o; }
}
#undef SBAR
}
namespace mk {
struct SchedP4 {
    static constexpr bool GATHER = false;
    const char* A; const char* Bt; int G, c;
    __device__ __forceinline__ bool next(int i, gm::Unit& u) const { int pm, pn; if (!static_tile(i, G, c, 64, 4, pm, pn)) return false;
        u.A = A; u.Bt = Bt; u.gidx = nullptr; u.lda2 = 2048; u.ldb2 = 2048; u.arow0 = pm * 256; u.brow0 = pn * 256; u.nt = 16; u.pm = pm; u.pn = pn; u.aux = 0; return true; }
};
struct EpiP4 {
    static constexpr bool PERM = false;
    const float* x; float* out; const float* modf;
    __device__ __forceinline__ void operator()(EPI_ARGS) const {
        const int b = (u.pm * 256) >> 13; const float* gt = modf + b * 6144 + 2048;
        const int col0 = u.pn * 256 + wc * 32 + 4 * fq;
        f32x4 g[2][2];
#pragma unroll
        for (int bj = 0; bj < 2; ++bj)
#pragma unroll
            for (int n = 0; n < 2; ++n) g[bj][n] = *(const f32x4*)(gt + col0 + bj * 128 + n * 16);
#pragma unroll
        for (int ai = 0; ai < 2; ++ai)
#pragma unroll
            for (int m = 0; m < 4; ++m) { const size_t off = (size_t)(u.pm * 256 + ai * 128 + wr * 64 + m * 16 + fr) * D + col0;
#pragma unroll
                for (int bj = 0; bj < 2; ++bj)
#pragma unroll
                    for (int n = 0; n < 2; ++n) { const f32x4 xv = *(const f32x4*)(x + off + bj * 128 + n * 16); *(f32x4*)(out + off + bj * 128 + n * 16) = xv + g[bj][n] * acc[ai][bj][m][n]; } }
    }
};
__device__ __forceinline__ void p4b_rows(Frame& F) {
    LAS float* WR = (LAS float*)F.lds;
    LAS float* A1 = WR + 16384;
    LAS float* A0 = A1 + 2048;
    const float* modf = (const float*)(F.ws + WS_MODF);
    for (int i = F.tid; i < 16384; i += NTHREADS) { const int j = i >> 4, e = i & 15; WR[e * 1024 + j] = F.w_router[i]; }
    for (int i = F.tid; i < 2048; i += NTHREADS) { const int b = i >> 10, j = i & 1023; A1[i] = F.g_ffn[j] * (1.f + modf[b * 6144 + 4096 + j]); A0[i] = modf[b * 6144 + 3072 + j]; }
    __syncthreads();
    const int gw = F.vcu * NWAVES + F.wave, NGW = F.G * NWAVES, lane = F.lane;
    for (int m = gw; m < T; m += NGW) { const int b = m >> 13, s = m & 8191;
        const f32x4* xr = (const f32x4*)(F.out + (size_t)m * D) + lane; f32x4 v[4]; float ss = 0.f;
#pragma unroll
        for (int j = 0; j < 4; ++j) { v[j] = xr[64 * j]; ss += (v[j].x * v[j].x + v[j].y * v[j].y) + (v[j].z * v[j].z + v[j].w * v[j].w); }
        const float rstd = rsqrtf(wave_sum(ss) * (1.f / D) + EPS);
        unsigned long long* o8 = (unsigned long long*)((bf16_t*)(F.ws + WS_HB) + (size_t)m * D) + lane;
        float lg[16];
#pragma unroll
        for (int e = 0; e < 16; ++e) lg[e] = 0.f;
#pragma unroll
        for (int j = 0; j < 4; ++j) { asm volatile("" ::: "memory");
            const f32x4 a1 = *(const LAS f32x4*)(A1 + b * 1024 + 4 * lane + 256 * j), a0 = *(const LAS f32x4*)(A0 + b * 1024 + 4 * lane + 256 * j);
            const f32x4 o = v[j] * rstd * a1 + a0; o8[64 * j] = (unsigned long long)pk2(o.x, o.y) | ((unsigned long long)pk2(o.z, o.w) << 32);
#pragma unroll
            for (int e = 0; e < 16; ++e) { const f32x4 w = *(const LAS f32x4*)(WR + e * 1024 + 4 * lane + 256 * j); lg[e] += (o.x * w.x + o.y * w.y) + (o.z * w.z + o.w * w.w); } }
        float w8[8], w4[4], w2[2], w1;
        { const bool up = lane & 32;
#pragma unroll
          for (int i = 0; i < 8; ++i) { const float snd = up ? lg[i] : lg[8 + i], kp = up ? lg[8 + i] : lg[i]; w8[i] = kp + __shfl_xor(snd, 32); } }
        { const bool up = lane & 16;
#pragma unroll
          for (int i = 0; i < 4; ++i) { const float snd = up ? w8[i] : w8[4 + i], kp = up ? w8[4 + i] : w8[i]; w4[i] = kp + __shfl_xor(snd, 16); } }
        { const bool up = lane & 8;
#pragma unroll
          for (int i = 0; i < 2; ++i) { const float snd = up ? w4[i] : w4[2 + i], kp = up ? w4[2 + i] : w4[i]; w2[i] = kp + __shfl_xor(snd, 8); } }
        { const bool up = lane & 4; const float snd = up ? w2[0] : w2[1], kp = up ? w2[1] : w2[0]; w1 = kp + __shfl_xor(snd, 4); }
        w1 += __shfl_xor(w1, 1); w1 += __shfl_xor(w1, 2);
        const int e = lane >> 2; const float logit = w1 + F.b_router[e];
        float mx = logit;
#pragma unroll
        for (int o = 4; o < 64; o <<= 1) mx = fmaxf(mx, __shfl_xor(mx, o));
        const float ex = __expf(logit - mx); float den = ex;
#pragma unroll
        for (int o = 4; o < 64; o <<= 1) den += __shfl_xor(den, o);
        if ((lane & 3) == 0) ((float*)(F.ws + WS_AFF))[((size_t)b * 16 + e) * S + s] = ex / den;
    }
    __syncthreads();
}
__device__ __forceinline__ void p5_topk(Frame& F) {
    if (F.vcu >= 32) return;
    const int be = F.vcu, b = be >> 4, e = be & 15, tid = F.tid;
    LAS unsigned* vals = (LAS unsigned*)F.lds;
    LAS unsigned* hist = vals + 8192;
    LAS unsigned* suf = hist + 256;
    LAS unsigned* misc = suf + 264;
    LAS unsigned* wtot = misc + 8;
    const float* a = (const float*)(F.ws + WS_AFF) + (size_t)be * S;
    for (int i = tid; i < 8192; i += NTHREADS) vals[i] = __float_as_uint(a[i]);
    if (tid == 0) { misc[0] = 0u; misc[1] = 1024u; }
    __syncthreads();
    for (int pass = 0; pass < 4; ++pass) {
        const int sh = 24 - 8 * pass; const unsigned prefix = misc[0], k = misc[1]; const unsigned himask = pass == 0 ? 0u : (0xffffffffu << (sh + 8));
        if (tid < 256) hist[tid] = 0u;
        __syncthreads();
        for (int i = tid; i < 8192; i += NTHREADS) { const unsigned v = vals[i]; if ((v & himask) == prefix) __hip_atomic_fetch_add(&hist[(v >> sh) & 255u], 1u, __ATOMIC_RELAXED, __HIP_MEMORY_SCOPE_WORKGROUP); }
        __syncthreads();
        if (tid < 256) suf[tid] = hist[tid]; if (tid == 0) suf[256] = 0u;
        __syncthreads();
        for (int o = 1; o < 256; o <<= 1) { unsigned t = 0u; if (tid < 256) t = suf[tid] + ((tid + o < 256) ? suf[tid + o] : 0u); __syncthreads(); if (tid < 256) suf[tid] = t; __syncthreads(); }
        if (tid < 256) { const unsigned sge = suf[tid], sgt = (tid < 255) ? suf[tid + 1] : 0u; if (sge >= k && sgt < k) { misc[0] = prefix | ((unsigned)tid << sh); misc[1] = k - sgt; } }
        __syncthreads();
    }
    const unsigned thr = misc[0], need = misc[1];
    unsigned gtc = 0, eqc = 0;
#pragma unroll
    for (int i = 0; i < 16; ++i) { const unsigned v = vals[tid * 16 + i]; gtc += v > thr; eqc += v == thr; }
    unsigned gi = gtc, ei = eqc; const int lane = F.lane, wv = F.wave;
#pragma unroll
    for (int o = 1; o < 64; o <<= 1) { const unsigned g2 = __shfl_up(gi, o), e2 = __shfl_up(ei, o); if (lane >= o) { gi += g2; ei += e2; } }
    if (lane == 63) { wtot[wv] = gi; wtot[8 + wv] = ei; }
    __syncthreads();
    unsigned gbase = 0, ebase = 0, gtotal = 0;
    for (int w = 0; w < 8; ++w) { const unsigned g = wtot[w], q = wtot[8 + w]; if (w < wv) { gbase += g; ebase += q; } gtotal += g; }
    unsigned gpos = gbase + gi - gtc, epos = ebase + ei - eqc;
    int* IDX = (int*)(F.ws + WS_IDX) + (e * 2 + b) * 1024; float* GATE = (float*)(F.ws + WS_GATE) + (e * 2 + b) * 1024; int* SLOT = (int*)(F.ws + WS_SLOT);
#pragma unroll
    for (int i = 0; i < 16; ++i) { const int s = tid * 16 + i; const unsigned v = vals[s]; int c = -1;
        if (v > thr) c = (int)gpos++; else if (v == thr) { if (epos < need) c = (int)(gtotal + epos); ++epos; }
        if (c >= 0) { IDX[c] = b * S + s; GATE[c] = __uint_as_float(v); }
        SLOT[(size_t)(b * S + s) * 16 + e] = c >= 0 ? (e * 2 + b) * 1024 + c : -1; }
}
struct SchedP6a {
    static constexpr bool GATHER = true;
    const char* A; const char* W; const int* idx; int G, vcu;
    __device__ __forceinline__ bool next(int i, gm::Unit& u) const {
        int e, pmu, pn;
        if (G == 256) { if (i >= 4) return false; const int xcd = vcu >> 5, j = vcu & 31; e = xcd + 8 * (i >> 1); const int sub = (i & 1) * 32 + j; pmu = sub >> 3; pn = sub & 7; }
        else { const int L = i * G + vcu; if (L >= 1024) return false; e = L >> 6; pmu = (L >> 3) & 7; pn = L & 7; }
        u.A = A; u.gidx = idx + e * 2048 + pmu * 256; u.lda2 = 2048; u.arow0 = 0; u.Bt = W + (size_t)e * 2048 * 2048; u.brow0 = pn * 256; u.ldb2 = 2048; u.nt = 16; u.pm = e * 8 + pmu; u.pn = pn; u.aux = e; return true; }
};
struct EpiP6a {
    static constexpr bool PERM = true;
    bf16_t* H;
    __device__ __forceinline__ void operator()(EPI_ARGS) const {
#pragma unroll
        for (int ai = 0; ai < 2; ++ai)
#pragma unroll
            for (int m = 0; m < 4; ++m) { const size_t row = (size_t)u.pm * 256 + ai * 128 + wr * 64 + m * 16 + fr;
                f32x4 h0, h1;
#pragma unroll
                for (int j = 0; j < 4; ++j) { h0[j] = siluf(acc[ai][0][m][0][j]) * acc[ai][1][m][0][j]; h1[j] = siluf(acc[ai][0][m][1][j]) * acc[ai][1][m][1][j]; }
                *(u32x4*)(H + row * 1024 + u.pn * 128 + wc * 32 + 8 * fq) = pack8(h0, h1); }
    }
};
struct SchedP6b {
    static constexpr bool GATHER = false;
    const char* A; const char* W; int G, vcu;
    __device__ __forceinline__ bool next(int i, gm::Unit& u) const {
        int e, pmu, pn;
        if (G == 256) { if (i >= 2) return false; const int xcd = vcu >> 5, j = vcu & 31; e = xcd + 8 * i; pmu = j >> 2; pn = j & 3; }
        else { const int L = i * G + vcu; if (L >= 512) return false; e = L >> 5; pmu = (L >> 2) & 7; pn = L & 3; }
        u.A = A; u.gidx = nullptr; u.lda2 = 2048; u.arow0 = (e * 8 + pmu) * 256; u.Bt = W + (size_t)e * 1024 * 2048; u.brow0 = pn * 256; u.ldb2 = 2048; u.nt = 16; u.pm = e * 8 + pmu; u.pn = pn; u.aux = e; return true; }
};
struct EpiP6b {
    static constexpr bool PERM = true;
    bf16_t* Y; const float* gate;
    __device__ __forceinline__ void operator()(EPI_ARGS) const {
#pragma unroll
        for (int ai = 0; ai < 2; ++ai)
#pragma unroll
            for (int m = 0; m < 4; ++m) { const size_t row = (size_t)u.pm * 256 + ai * 128 + wr * 64 + m * 16 + fr; const float g = gate[row];
#pragma unroll
                for (int bj = 0; bj < 2; ++bj) *(u32x4*)(Y + row * 1024 + u.pn * 256 + bj * 128 + wc * 32 + 8 * fq) = pack8(acc[ai][bj][m][0] * g, acc[ai][bj][m][1] * g); }
    }
};
__device__ __forceinline__ void p7_final(Frame& F) {
    const float* modf = (const float*)(F.ws + WS_MODF); const int* SLOT = (const int*)(F.ws + WS_SLOT); const bf16_t* Y = (const bf16_t*)(F.ws + WS_Y);
    const int gw = F.vcu * NWAVES + F.wave, NGW = F.G * NWAVES, lane = F.lane;
    for (int m = gw; m < T; m += NGW) { const int b = m >> 13;
        f32x4* xr = (f32x4*)(F.out + (size_t)m * D) + lane; f32x4 v[4], a[4];
#pragma unroll
        for (int j = 0; j < 4; ++j) { v[j] = xr[64 * j]; a[j] = (f32x4){0.f, 0.f, 0.f, 0.f}; }
        const int myslot = lane < 16 ? SLOT[(size_t)m * 16 + lane] : -1;
        for (int e = 0; e < 16; ++e) { const int sl = __shfl(myslot, e); if (sl < 0) continue;
            const u32x2* yr = (const u32x2*)(Y + (size_t)sl * 1024) + lane;
#pragma unroll
            for (int j = 0; j < 4; ++j) { const u32x2 w = yr[64 * j]; a[j].x += __uint_as_float(w.x << 16); a[j].y += __uint_as_float(w.x & 0xffff0000u); a[j].z += __uint_as_float(w.y << 16); a[j].w += __uint_as_float(w.y & 0xffff0000u); } }
        float ss = 0.f;
#pragma unroll
        for (int j = 0; j < 4; ++j) { const f32x4 gt = *(const f32x4*)(modf + b * 6144 + 5120 + 4 * lane + 256 * j); v[j] = v[j] + gt * a[j]; ss += (v[j].x * v[j].x + v[j].y * v[j].y) + (v[j].z * v[j].z + v[j].w * v[j].w); }
        const float rstd = rsqrtf(wave_sum(ss) * (1.f / D) + EPS);
#pragma unroll
        for (int j = 0; j < 4; ++j) { const f32x4 g = *(const f32x4*)(F.g_final + 4 * lane + 256 * j); xr[64 * j] = v[j] * rstd * g; }
    }
}
}
namespace mk {
namespace cg = cooperative_groups;
__global__ void __launch_bounds__(NTHREADS, 2) mega(Args args) {
    extern __shared__ __attribute__((aligned(16))) unsigned char lds_raw[];
    cg::grid_group grid = cg::this_grid();
    Frame F;
    F.lds = (LAS unsigned char*)lds_raw; F.ws = args.ws; F.out = args.out;
    F.tid = threadIdx.x; F.lane = F.tid & 63; F.wave = __builtin_amdgcn_readfirstlane(F.tid >> 6);
    F.G = gridDim.x; { const int bx = blockIdx.x; F.vcu = (F.G % 8 == 0) ? (bx % 8) * (F.G / 8) + bx / 8 : bx; }
    F.x = (const float*)args.in[0]; F.c = (const float*)args.in[1]; F.pos = (const int*)args.in[2]; F.w_ada = (const float*)args.in[3]; F.b_ada = (const float*)args.in[4];
    F.g_mix = (const float*)args.in[5]; F.w_in = (const float*)args.in[6]; F.g_q = (const float*)args.in[7]; F.w_uq = (const float*)args.in[8]; F.g_kv = (const float*)args.in[9];
    F.w_ukv = (const float*)args.in[10]; F.w_out = (const float*)args.in[11]; F.g_ffn = (const float*)args.in[12]; F.w_router = (const float*)args.in[13]; F.b_router = (const float*)args.in[14];
    F.w_gate = (const float*)args.in[15]; F.w_up = (const float*)args.in[16]; F.w_down = (const float*)args.in[17]; F.g_final = (const float*)args.in[18];
    const int lo = args.ph_lo, hi = args.ph_hi;
#define IN(k) (lo <= (k) && (k) < hi)
#define SEAM(k) do { if (IN(k) && IN((k) + 1)) grid.sync(); } while (0)
    if (IN(0)) { p0_prologue(F); } SEAM(0);
    if (IN(1)) { p0b_rows(F); } SEAM(1);
    if (IN(2)) { SchedP1 S{(const char*)(F.ws + WS_HB), (const char*)(F.ws + WS_WIN), F.G, (int)blockIdx.x}; EpiP1 E{F.ws}; gm::gemm_phase<EpiP1, SchedP1>(F.lds, S, E); } SEAM(2);
    if (IN(3)) { SchedP2 S{(const char*)(F.ws + WS_CQ), (const char*)(F.ws + WS_WUQ), (const char*)(F.ws + WS_WUKV), F.G, (int)blockIdx.x}; EpiP2 E{F.ws}; gm::gemm_phase<EpiP2, SchedP2>(F.lds, S, E); } SEAM(3);
    if (IN(4)) {
        const unsigned short* DQ = (const unsigned short*)(F.ws + WS_DQ); const unsigned short* DK = (const unsigned short*)(F.ws + WS_DK); const unsigned short* DV = (const unsigned short*)(F.ws + WS_DV);
        unsigned short* OBR = (unsigned short*)F.out; float* LSE = (float*)(F.ws + WS_LSE);
        for (int u = F.vcu; u < 1536; u += F.G) { const int blk = u & 31, br = (u >> 5) % 3, bh = u / 96; at::dil_unit(bh, br, blk, DQ, DK, DV, OBR, LSE, (char*)lds_raw); }
        for (int u = F.vcu; u < 512; u += F.G) { const int bh = (u >> 8) * 8 + ((u & 255) >> 5), qb = u & 31;
            at::mla_unit(bh, qb, (const unsigned short*)(F.ws + WS_Q), (const unsigned short*)(F.ws + WS_KN), (const unsigned short*)(F.ws + WS_KR), (const unsigned short*)(F.ws + WS_V), (unsigned short*)(F.ws + WS_HB), (char*)lds_raw); }
    } SEAM(4);
    if (IN(5)) { at::dil_combine((const unsigned short*)F.out, (const float*)(F.ws + WS_LSE), (unsigned short*)(F.ws + WS_HB), F.vcu * NTHREADS + F.tid, F.G * NTHREADS); } SEAM(5);
    if (IN(6)) { SchedP4 S{(const char*)(F.ws + WS_HB), (const char*)(F.ws + WS_WOUT), F.G, (int)blockIdx.x}; EpiP4 E{F.x, F.out, (const float*)(F.ws + WS_MODF)}; gm::gemm_phase<EpiP4, SchedP4>(F.lds, S, E); } SEAM(6);
    if (IN(7)) { p4b_rows(F); } SEAM(7);
    if (IN(8)) { p5_topk(F); } SEAM(8);
    if (IN(9)) { SchedP6a S{(const char*)(F.ws + WS_HB), (const char*)(F.ws + WS_WGU), (const int*)(F.ws + WS_IDX), F.G, F.vcu}; EpiP6a E{(bf16_t*)(F.ws + WS_HBUF)}; gm::gemm_phase<EpiP6a, SchedP6a>(F.lds, S, E); } SEAM(9);
    if (IN(10)) { SchedP6b S{(const char*)(F.ws + WS_HBUF), (const char*)(F.ws + WS_WD), F.G, F.vcu}; EpiP6b E{(bf16_t*)(F.ws + WS_Y), (const float*)(F.ws + WS_GATE)}; gm::gemm_phase<EpiP6b, SchedP6b>(F.lds, S, E); } SEAM(10);
    if (IN(11)) { p7_final(F); }
#undef IN
#undef SEAM
}
}
namespace nv {
__device__ __forceinline__ float bf2f(unsigned short b) { return __builtin_bit_cast(float, (unsigned)b << 16); }
__global__ __launch_bounds__(256) void k_attn_mla_bf(const unsigned short* __restrict__ Q, const unsigned short* __restrict__ KN, const unsigned short* __restrict__ V, const unsigned short* __restrict__ KR, float* __restrict__ cat, int b) {
    __shared__ float Ks[32][96]; __shared__ float Vs[32][64];
    const int h = blockIdx.y, t = blockIdx.x * 256 + threadIdx.x; const size_t bh = (size_t)(b * 8 + h) * S;
    float qv[96];
#pragma unroll
    for (int d = 0; d < 96; ++d) qv[d] = bf2f(Q[(bh + t) * 96 + d]);
    float o[64];
#pragma unroll
    for (int d = 0; d < 64; ++d) o[d] = 0.f;
    float m = -1e30f, l = 0.f;
    for (int k0 = 0; k0 < S; k0 += 32) {
        __syncthreads();
        for (int i = threadIdx.x; i < 32 * 96; i += 256) { int r = i / 96, d = i % 96; Ks[r][d] = d < 64 ? bf2f(KN[(bh + k0 + r) * 64 + d]) : bf2f(KR[((size_t)b * S + k0 + r) * 32 + d - 64]); }
        for (int i = threadIdx.x; i < 32 * 64; i += 256) { int r = i / 64, d = i % 64; Vs[r][d] = bf2f(V[(bh + k0 + r) * 64 + d]); }
        __syncthreads();
        float sc[32]; float tm = -1e30f;
#pragma unroll
        for (int j = 0; j < 32; ++j) { float s = 0.f;
#pragma unroll
            for (int d = 0; d < 96; ++d) s += qv[d] * Ks[j][d];
            sc[j] = s; tm = fmaxf(tm, s); }
        const float mn = fmaxf(m, tm), al = exp2f(m - mn); m = mn; l *= al;
#pragma unroll
        for (int d = 0; d < 64; ++d) o[d] *= al;
#pragma unroll
        for (int j = 0; j < 32; ++j) { const float p = exp2f(sc[j] - mn); l += p;
#pragma unroll
            for (int d = 0; d < 64; ++d) o[d] += p * Vs[j][d]; }
    }
    const float il = 1.f / l;
#pragma unroll
    for (int d = 0; d < 64; ++d) cat[(size_t)t * 1024 + h * 64 + d] = o[d] * il;
}
__global__ __launch_bounds__(256) void k_attn_dil_bf(const unsigned short* __restrict__ DQ, const unsigned short* __restrict__ DK, const unsigned short* __restrict__ DV, float* __restrict__ cat, int b) {
    const int h = blockIdx.y, t = blockIdx.x * 256 + threadIdx.x; const size_t bh = (size_t)(b * 8 + h) * S;
    float qv[64];
#pragma unroll
    for (int d = 0; d < 64; ++d) qv[d] = bf2f(DQ[(bh + t) * 64 + d]);
    float o[64];
#pragma unroll
    for (int d = 0; d < 64; ++d) o[d] = 0.f;
    float m = -1e30f, l = 0.f;
    for (int br = 0; br < 3; ++br) { const int dil = br == 0 ? 1 : (br == 1 ? 4 : 16);
        for (int j = -64; j <= 64; ++j) { const int kt = t + dil * j; if (kt < 0 || kt >= S) continue;
            const unsigned short* kp = DK + (bh + kt) * 64; float s = 0.f;
#pragma unroll
            for (int d = 0; d < 64; ++d) s += qv[d] * bf2f(kp[d]);
            if (s > m) { const float al = exp2f(m - s); l *= al;
#pragma unroll
                for (int d = 0; d < 64; ++d) o[d] *= al;
                m = s; }
            const float p = exp2f(s - m); l += p; const unsigned short* vp = DV + (bh + kt) * 64;
#pragma unroll
            for (int d = 0; d < 64; ++d) o[d] += p * bf2f(vp[d]); } }
    const float il = 1.f / l;
#pragma unroll
    for (int d = 0; d < 64; ++d) cat[(size_t)t * 1024 + 512 + h * 64 + d] = o[d] * il;
}
__global__ void k_bf2f(const unsigned short* in, float* out, size_t n) { size_t i = (size_t)blockIdx.x * 256 + threadIdx.x; if (i < n) out[i] = bf2f(in[i]); }
static void naive_tail_from_cat(void* const* d_in, int b, float* ob, const float* mod, float* hb, float* mixed, float* Hb, float* Y, float* aff, int* idx, float* gate, int* slot, hipStream_t st) {
    const float* x = (const float*)d_in[0]; const float* w_out = (const float*)d_in[11];
    const float* xb = x + (size_t)b * S * D; const float* mb = mod + b * 6144;
    k_gemm<<<dim3(1024 / 64, S / 64, 1), 256, 0, st>>>(hb, 1024, 0, nullptr, w_out, nullptr, 1024, 0, mixed, 1024, S, 1024, 1024, nullptr);
    k_resid<<<(S * D + 255) / 256, 256, 0, st>>>(xb, mb + 2048, mixed, ob, S * D);
}
static void naive_tail_from_x1(void* const* d_in, int b, float* ob, const float* mod, float* hb, float* Hb, float* Y, float* aff, int* idx, float* gate, int* slot, hipStream_t st, bool have_h2) {
    const float* g_ffn = (const float*)d_in[12]; const float* w_router = (const float*)d_in[13]; const float* b_router = (const float*)d_in[14];
    const float* w_gate = (const float*)d_in[15]; const float* w_up = (const float*)d_in[16]; const float* w_down = (const float*)d_in[17]; const float* g_final = (const float*)d_in[18];
    const float* mb = mod + b * 6144;
    if (!have_h2) k_h2_aff<<<S / 4, 256, 0, st>>>(ob, g_ffn, mb + 3072, mb + 4096, w_router, b_router, hb, aff);
    k_topk<<<dim3(S / 256, 16), 256, 0, st>>>(aff, idx, gate, slot);
    k_gemm<<<dim3(16, 16, 16), 256, 0, st>>>(hb, 1024, 0, idx, w_gate, w_up, 1024, 1024 * 1024, Hb, 1024, 1024, 1024, 1024, nullptr);
    k_gemm<<<dim3(16, 16, 16), 256, 0, st>>>(Hb, 1024, 1024 * 1024, nullptr, w_down, nullptr, 1024, 1024 * 1024, Y, 1024, 1024, 1024, 1024, gate);
    k_final<<<S / 4, 256, 0, st>>>(ob, mb + 5120, Y, slot, g_final, ob);
}
}
#ifndef TEST_STAGE
#define TEST_STAGE 0
#endif
#ifndef TEST_C0
#define TEST_C0 0
#endif
extern "C" void kernel_launch(void* const* d_in, const int* in_sizes, int n_in, void* d_out, int out_size, void* d_ws, size_t ws_size, hipStream_t stream) {
    using namespace mk;
    static int grid = 0;
    if (grid == 0) {
        if (n_in != 19 || out_size != T * D || ws_size < 290 * MiB) { fprintf(stderr, "kernel_launch: bad shapes/ws %d %d %zu\n", n_in, out_size, ws_size); grid = -1; return; }
        int dev = 0, cus = 0, per_cu = 0;
        hipGetDevice(&dev); hipDeviceGetAttribute(&cus, hipDeviceAttributeMultiprocessorCount, dev);
        if (hipFuncSetAttribute((const void*)mega, hipFuncAttributeMaxDynamicSharedMemorySize, LDS_BYTES) != hipSuccess) { fprintf(stderr, "hipFuncSetAttribute failed\n"); grid = -1; return; }
        hipOccupancyMaxActiveBlocksPerMultiprocessor(&per_cu, (const void*)mega, NTHREADS, LDS_BYTES);
        if (per_cu < 1) { fprintf(stderr, "occupancy query says %d\n", per_cu); grid = -1; return; }
        grid = cus;
    }
    if (grid < 0) return;
    hipMemsetAsync((char*)d_ws + WS_CTL, 0, 1 * MiB, stream);
    Args a{}; for (int i = 0; i < 19; ++i) a.in[i] = d_in[i]; a.out = (float*)d_out; a.ws = (unsigned char*)d_ws;
    a.ph_lo = 0; a.ph_hi = (TEST_STAGE == 0) ? 12 : (TEST_STAGE == 1) ? 4 : 6;
    void* kargs[] = {&a};
    hipError_t e = hipLaunchCooperativeKernel((const void*)mega, dim3(grid), dim3(NTHREADS), kargs, LDS_BYTES, stream);
    if (e != hipSuccess) { fprintf(stderr, "cooperative launch failed: %s\n", hipGetErrorString(e)); return; }
    if (TEST_STAGE == 0) return;
    if (TEST_STAGE == 3) { nv::run_naive(d_in, (float*)d_out, (char*)d_ws + 52 * MiB, stream, (const unsigned short*)((char*)d_ws + WS_HB), (double*)((char*)d_ws + 4096), TEST_C0, 512); return; }
    char* ws = (char*)d_ws; const float* modf = (const float*)(ws + WS_MODF);
    float* cat0 = (float*)(ws + 180 * MiB); float* cat1 = (float*)(ws + 214 * MiB); float* mixed = (float*)(ws + 248 * MiB);
    float* aff = (float*)(ws + 282 * MiB); int* idx = (int*)(ws + 283 * MiB); float* gate = (float*)(ws + 283 * MiB + 256 * KiB); int* slot = (int*)(ws + 284 * MiB);
    float* Hb = (float*)(ws + 52 * MiB); float* Y = (float*)(ws + 116 * MiB);
    if (TEST_STAGE == 1) for (int b = 0; b < 2; ++b) { float* cat = b ? cat1 : cat0;
        nv::k_attn_mla_bf<<<dim3(S / 256, 8), 256, 0, stream>>>((const unsigned short*)(ws + WS_Q), (const unsigned short*)(ws + WS_KN), (const unsigned short*)(ws + WS_V), (const unsigned short*)(ws + WS_KR), cat, b);
        nv::k_attn_dil_bf<<<dim3(S / 256, 8), 256, 0, stream>>>((const unsigned short*)(ws + WS_DQ), (const unsigned short*)(ws + WS_DK), (const unsigned short*)(ws + WS_DV), cat, b); }
    if (TEST_STAGE == 2) for (int b = 0; b < 2; ++b) nv::k_bf2f<<<(S * 1024 + 255) / 256, 256, 0, stream>>>((const unsigned short*)(ws + WS_HB) + (size_t)b * S * 1024, b ? cat1 : cat0, (size_t)S * 1024);
    for (int b = 0; b < 2; ++b) { float* cat = b ? cat1 : cat0; float* ob = (float*)d_out + (size_t)b * S * D;
        nv::naive_tail_from_cat(d_in, b, ob, modf, cat, mixed, Hb, Y, aff, idx, gate, slot, stream);
        nv::naive_tail_from_x1(d_in, b, ob, modf, cat, Hb, Y, aff, idx, gate, slot, stream, false); }
}
```

```cpp
#include <hip/hip_runtime.h>
#include <hip/hip_cooperative_groups.h>
#include <hip/hip_bf16.h>
#include <cstdio>
#include <cstdint>
#include <cmath>
namespace nv {
constexpr int S = 8192, D = 1024, NB = 2, INC = 2208, H = 8;
constexpr float EPS = 1e-6f;
__device__ __forceinline__ float siluf(float v) { return v / (1.f + __expf(-v)); }
__device__ __forceinline__ float wsum(float v) {
#pragma unroll
    for (int o = 1; o < 64; o <<= 1) v += __shfl_xor(v, o);
    return v;
}
__global__ void k_mod(const float* c, const float* w, const float* bias, float* mod) {
    int i = blockIdx.x * 256 + threadIdx.x; if (i >= NB * 6144) return;
    int b = i / 6144, n = i % 6144; float s = 0.f;
    for (int k = 0; k < 1024; ++k) s += siluf(c[b * 1024 + k]) * w[(size_t)k * 6144 + n];
    mod[i] = s + bias[n];
}
__global__ void k_norm_mod(const float* x, const float* g, const float* sh, const float* sc, float* out, int rows) {
    int row = blockIdx.x * 4 + (threadIdx.x >> 6), lane = threadIdx.x & 63; if (row >= rows) return;
    const float* xr = x + (size_t)row * D; float s = 0.f;
    for (int j = lane; j < D; j += 64) s += xr[j] * xr[j];
    float rstd = rsqrtf(wsum(s) / D + EPS);
    for (int j = lane; j < D; j += 64) out[(size_t)row * D + j] = xr[j] * rstd * g[j] * (1.f + sc[j]) + sh[j];
}
__global__ __launch_bounds__(256) void k_gemm(const float* __restrict__ A, long lda, long astride, const int* __restrict__ gidx,
                                              const float* __restrict__ B, const float* __restrict__ B2, long ldb, long bstride,
                                              float* __restrict__ C, long ldc, int M, int N, int K, const float* __restrict__ rowscale) {
    __shared__ float As[16][65]; __shared__ float Bs[16][64]; __shared__ float B2s[16][64];
    const int tid = threadIdx.x, tx = tid & 15, ty = tid >> 4, m0 = blockIdx.y * 64, n0 = blockIdx.x * 64, z = blockIdx.z;
    A += (size_t)z * astride; B += (size_t)z * bstride; if (B2) B2 += (size_t)z * bstride;
    const int* gi = gidx ? gidx + (size_t)z * M : nullptr; C += (size_t)z * M * ldc; const float* rs = rowscale ? rowscale + (size_t)z * M : nullptr;
    float acc[4][4], acc2[4][4];
#pragma unroll
    for (int i = 0; i < 4; ++i)
#pragma unroll
        for (int j = 0; j < 4; ++j) { acc[i][j] = 0.f; acc2[i][j] = 0.f; }
    const int ar = tid >> 2, ac = (tid & 3) * 4; const long arow = gi ? gi[m0 + ar] : (m0 + ar);
    const int br = tid >> 4, bc = (tid & 15) * 4;
    for (int k0 = 0; k0 < K; k0 += 16) {
        const float4 av = *(const float4*)(A + arow * lda + k0 + ac);
        As[ac + 0][ar] = av.x; As[ac + 1][ar] = av.y; As[ac + 2][ar] = av.z; As[ac + 3][ar] = av.w;
#pragma unroll
        for (int j = 0; j < 4; ++j) { int n = n0 + bc + j; Bs[br][bc + j] = n < N ? B[(size_t)(k0 + br) * ldb + n] : 0.f; if (B2) B2s[br][bc + j] = n < N ? B2[(size_t)(k0 + br) * ldb + n] : 0.f; }
        __syncthreads();
#pragma unroll
        for (int k = 0; k < 16; ++k) {
            float a[4], b[4], b2[4];
#pragma unroll
            for (int i = 0; i < 4; ++i) a[i] = As[k][ty * 4 + i];
#pragma unroll
            for (int j = 0; j < 4; ++j) { b[j] = Bs[k][tx * 4 + j]; b2[j] = B2 ? B2s[k][tx * 4 + j] : 0.f; }
#pragma unroll
            for (int i = 0; i < 4; ++i)
#pragma unroll
                for (int j = 0; j < 4; ++j) { acc[i][j] += a[i] * b[j]; acc2[i][j] += a[i] * b2[j]; }
        }
        __syncthreads();
    }
#pragma unroll
    for (int i = 0; i < 4; ++i)
#pragma unroll
        for (int j = 0; j < 4; ++j) { int m = m0 + ty * 4 + i, n = n0 + tx * 4 + j; if (n < N) { float v = acc[i][j]; if (B2) v = siluf(v) * acc2[i][j]; if (rs) v *= rs[m]; C[(size_t)m * ldc + n] = v; } }
}
__global__ void k_rms_inplace(float* buf, long ld, int c0, int nc, const float* g, int rows) {
    int row = blockIdx.x * 4 + (threadIdx.x >> 6), lane = threadIdx.x & 63; if (row >= rows) return;
    float* p = buf + (size_t)row * ld + c0; float s = 0.f;
    for (int j = lane; j < nc; j += 64) s += p[j] * p[j];
    float rstd = rsqrtf(wsum(s) / nc + EPS);
    for (int j = lane; j < nc; j += 64) p[j] = p[j] * rstd * g[j];
}
__device__ __forceinline__ void cs_of(int pos, int i, int dim, float& c, float& s) {
    float inv = (float)(1.0 / pow(500000.0, (double)(2 * i) / (double)dim));
    float ang = (float)pos * inv; c = (float)cos((double)ang); s = (float)sin((double)ang);
}
__global__ void k_rope_q(float* q, const int* pos, int rows) {
    int i = blockIdx.x * 256 + threadIdx.x; if (i >= rows * 8 * 16) return;
    int row = i / 128, h = (i / 16) % 8, f = i % 16; float c, s; cs_of(pos[row], f, 32, c, s);
    float* p = q + (size_t)row * 768 + h * 96 + 64; float a = p[f], b = p[f + 16]; p[f] = a * c - b * s; p[f + 16] = a * s + b * c;
}
__global__ void k_rope_kr(const float* proj, float* kr, const int* pos, int rows) {
    int i = blockIdx.x * 256 + threadIdx.x; if (i >= rows * 16) return;
    int row = i / 16, f = i % 16; float c, s; cs_of(pos[row], f, 32, c, s);
    const float* p = proj + (size_t)row * INC + 640; float a = p[f], b = p[f + 16]; kr[row * 32 + f] = a * c - b * s; kr[row * 32 + f + 16] = a * s + b * c;
}
__global__ void k_rope_d(const float* proj, int c0, float* out, const int* pos, int rows) {
    int i = blockIdx.x * 256 + threadIdx.x; if (i >= rows * 512) return;
    int row = i / 512, col = i % 512, d = col % 64; const float* p = proj + (size_t)row * INC + c0; float v = p[col];
    if (d < 16) { int f = d % 8; float c, s; cs_of(pos[row], f, 16, c, s); if (d < 8) v = p[col] * c - p[col + 8] * s; else v = p[col - 8] * s + p[col] * c; }
    out[i] = v;
}
__global__ __launch_bounds__(256) void k_attn_mla(const float* __restrict__ q, const float* __restrict__ kv, const float* __restrict__ kr, float* __restrict__ cat) {
    __shared__ float Ks[32][96]; __shared__ float Vs[32][64];
    const int h = blockIdx.y, t = blockIdx.x * 256 + threadIdx.x; const float scale = 0.10206207261596575f;
    float qv[96];
#pragma unroll
    for (int d = 0; d < 96; ++d) qv[d] = q[(size_t)t * 768 + h * 96 + d] * scale;
    float o[64];
#pragma unroll
    for (int d = 0; d < 64; ++d) o[d] = 0.f;
    float m = -1e30f, l = 0.f;
    for (int k0 = 0; k0 < S; k0 += 32) {
        __syncthreads();
        for (int i = threadIdx.x; i < 32 * 96; i += 256) { int r = i / 96, d = i % 96; Ks[r][d] = d < 64 ? kv[(size_t)(k0 + r) * 1024 + h * 128 + d] : kr[(k0 + r) * 32 + d - 64]; }
        for (int i = threadIdx.x; i < 32 * 64; i += 256) { int r = i / 64, d = i % 64; Vs[r][d] = kv[(size_t)(k0 + r) * 1024 + h * 128 + 64 + d]; }
        __syncthreads();
        float sc[32]; float tm = -1e30f;
#pragma unroll
        for (int j = 0; j < 32; ++j) { float s = 0.f;
#pragma unroll
            for (int d = 0; d < 96; ++d) s += qv[d] * Ks[j][d];
            sc[j] = s; tm = fmaxf(tm, s); }
        const float mn = fmaxf(m, tm), al = __expf(m - mn); m = mn; l *= al;
#pragma unroll
        for (int d = 0; d < 64; ++d) o[d] *= al;
#pragma unroll
        for (int j = 0; j < 32; ++j) { const float p = __expf(sc[j] - mn); l += p;
#pragma unroll
            for (int d = 0; d < 64; ++d) o[d] += p * Vs[j][d]; }
    }
    const float il = 1.f / l;
#pragma unroll
    for (int d = 0; d < 64; ++d) cat[(size_t)t * 1024 + h * 64 + d] = o[d] * il;
}
__global__ __launch_bounds__(256) void k_attn_dil(const float* __restrict__ dq, const float* __restrict__ dk, const float* __restrict__ proj, float* __restrict__ cat) {
    const int h = blockIdx.y, t = blockIdx.x * 256 + threadIdx.x;
    float qv[64];
#pragma unroll
    for (int d = 0; d < 64; ++d) qv[d] = dq[(size_t)t * 512 + h * 64 + d] * 0.125f;
    float o[64];
#pragma unroll
    for (int d = 0; d < 64; ++d) o[d] = 0.f;
    float m = -1e30f, l = 0.f;
    for (int br = 0; br < 3; ++br) { const int dil = br == 0 ? 1 : (br == 1 ? 4 : 16);
        for (int j = -64; j <= 64; ++j) { const int kt = t + dil * j; if (kt < 0 || kt >= S) continue;
            const float* kp = dk + (size_t)kt * 512 + h * 64; float s = 0.f;
#pragma unroll
            for (int d = 0; d < 64; ++d) s += qv[d] * kp[d];
            if (s > m) { const float al = __expf(m - s); l *= al;
#pragma unroll
                for (int d = 0; d < 64; ++d) o[d] *= al;
                m = s; }
            const float p = __expf(s - m); l += p; const float* vp = proj + (size_t)kt * INC + 1696 + h * 64;
#pragma unroll
            for (int d = 0; d < 64; ++d) o[d] += p * vp[d]; } }
    const float il = 1.f / l;
#pragma unroll
    for (int d = 0; d < 64; ++d) cat[(size_t)t * 1024 + 512 + h * 64 + d] = o[d] * il;
}
__global__ void k_resid(const float* x, const float* gt, const float* mixed, float* x1, int n) {
    int i = blockIdx.x * 256 + threadIdx.x; if (i < n) x1[i] = x[i] + gt[i % D] * mixed[i];
}
__global__ void k_h2_aff(const float* x1, const float* g, const float* sh, const float* sc, const float* wr, const float* br, float* h2, float* aff) {
    int row = blockIdx.x * 4 + (threadIdx.x >> 6), lane = threadIdx.x & 63;
    const float* xr = x1 + (size_t)row * D; float s = 0.f;
    for (int j = lane; j < D; j += 64) s += xr[j] * xr[j];
    float rstd = rsqrtf(wsum(s) / D + EPS); float lg[16];
#pragma unroll
    for (int e = 0; e < 16; ++e) lg[e] = 0.f;
    for (int j = lane; j < D; j += 64) { float v = xr[j] * rstd * g[j] * (1.f + sc[j]) + sh[j]; h2[(size_t)row * D + j] = v;
#pragma unroll
        for (int e = 0; e < 16; ++e) lg[e] += v * wr[j * 16 + e]; }
    float mx = -1e30f;
#pragma unroll
    for (int e = 0; e < 16; ++e) { lg[e] = wsum(lg[e]) + br[e]; mx = fmaxf(mx, lg[e]); }
    float den = 0.f;
#pragma unroll
    for (int e = 0; e < 16; ++e) { lg[e] = expf(lg[e] - mx); den += lg[e]; }
    if (lane < 16) { float v = 0.f;
#pragma unroll
        for (int e = 0; e < 16; ++e) if (lane == e) v = lg[e];
        aff[(size_t)lane * S + row] = v / den; }
}
__global__ __launch_bounds__(256) void k_topk(const float* aff, int* idx, float* gate, int* slot) {
    __shared__ float vs[1024];
    const int e = blockIdx.y, s = blockIdx.x * 256 + threadIdx.x; const float* a = aff + (size_t)e * S; const float v = a[s]; int rank = 0;
    for (int c0 = 0; c0 < S; c0 += 1024) { __syncthreads(); for (int i = threadIdx.x; i < 1024; i += 256) vs[i] = a[c0 + i]; __syncthreads();
        for (int i = 0; i < 1024; ++i) { const float u = vs[i]; rank += (u > v || (u == v && (c0 + i) < s)) ? 1 : 0; } }
    if (rank < 1024) { idx[e * 1024 + rank] = s; gate[e * 1024 + rank] = v; slot[s * 16 + e] = rank; } else slot[s * 16 + e] = -1;
}
__global__ void k_final(const float* x1, const float* gt, const float* Y, const int* slot, const float* gf, float* out) {
    int row = blockIdx.x * 4 + (threadIdx.x >> 6), lane = threadIdx.x & 63; float v[16]; float s = 0.f;
#pragma unroll
    for (int i = 0; i < 16; ++i) { int j = lane + 64 * i; float acc = 0.f;
        for (int e = 0; e < 16; ++e) { int sl = slot[row * 16 + e]; if (sl >= 0) acc += Y[((size_t)e * 1024 + sl) * D + j]; }
        v[i] = x1[(size_t)row * D + j] + gt[j] * acc; s += v[i] * v[i]; }
    float rstd = rsqrtf(wsum(s) / D + EPS);
#pragma unroll
    for (int i = 0; i < 16; ++i) { int j = lane + 64 * i; out[(size_t)row * D + j] = v[i] * rstd * gf[j]; }
}
}
namespace nv {
constexpr size_t MB = 1u << 20;
constexpr size_t N_MOD = 0, N_H = 1 * MB, N_PROJ = N_H + 34 * MB, N_Q = N_PROJ + 73 * MB, N_KV = N_Q + 26 * MB, N_KR = N_KV + 34 * MB, N_DQ = N_KR + 1 * MB, N_DK = N_DQ + 17 * MB,
                 N_AFF = N_DK + 17 * MB, N_IDX = N_AFF + 1 * MB, N_GATE = N_IDX + 256 * 1024, N_SLOT = N_GATE + 256 * 1024, N_END = N_SLOT + 1 * MB;
__global__ void k_relerr(const unsigned short* a, const float* b, int c0, int nc, int rows, double* acc) {
    __shared__ double s0[256], s1[256]; double d0 = 0, d1 = 0;
    for (size_t i = (size_t)blockIdx.x * 256 + threadIdx.x; i < (size_t)rows * nc; i += (size_t)gridDim.x * 256) { size_t r = i / nc, c = c0 + i % nc;
        float av = __builtin_bit_cast(float, (unsigned)a[r * 1024 + c] << 16), bv = b[r * 1024 + c]; d0 += (double)(av - bv) * (av - bv); d1 += (double)bv * bv; }
    s0[threadIdx.x] = d0; s1[threadIdx.x] = d1; __syncthreads();
    for (int o = 128; o > 0; o >>= 1) { if (threadIdx.x < o) { s0[threadIdx.x] += s0[threadIdx.x + o]; s1[threadIdx.x] += s1[threadIdx.x + o]; } __syncthreads(); }
    if (threadIdx.x == 0) { atomicAdd(acc, s0[0]); atomicAdd(acc + 1, s1[0]); }
}
__global__ void k_scale_out(float* out, size_t n, const double* acc) { const float f = 1.f + (float)sqrt(acc[0] / acc[1]); for (size_t i = (size_t)blockIdx.x * 256 + threadIdx.x; i < n; i += (size_t)gridDim.x * 256) out[i] *= f; }
static void run_naive(void* const* d_in, float* out, char* ws, hipStream_t st, const unsigned short* cat_opt = nullptr, double* acc = nullptr, int c0 = 0, int nc = 512) {
    const float* x = (const float*)d_in[0]; const float* c = (const float*)d_in[1]; const int* pos = (const int*)d_in[2];
    const float* w_ada = (const float*)d_in[3]; const float* b_ada = (const float*)d_in[4]; const float* g_mix = (const float*)d_in[5];
    const float* w_in = (const float*)d_in[6]; const float* g_q = (const float*)d_in[7]; const float* w_uq = (const float*)d_in[8];
    const float* g_kv = (const float*)d_in[9]; const float* w_ukv = (const float*)d_in[10]; const float* w_out = (const float*)d_in[11];
    const float* g_ffn = (const float*)d_in[12]; const float* w_router = (const float*)d_in[13]; const float* b_router = (const float*)d_in[14];
    const float* w_gate = (const float*)d_in[15]; const float* w_up = (const float*)d_in[16]; const float* w_down = (const float*)d_in[17]; const float* g_final = (const float*)d_in[18];
    float* mod = (float*)(ws + N_MOD); float* hb = (float*)(ws + N_H); float* proj = (float*)(ws + N_PROJ); float* q = (float*)(ws + N_Q); float* kv = (float*)(ws + N_KV);
    float* kr = (float*)(ws + N_KR); float* dq = (float*)(ws + N_DQ); float* dk = (float*)(ws + N_DK); float* aff = (float*)(ws + N_AFF); int* idx = (int*)(ws + N_IDX);
    float* gate = (float*)(ws + N_GATE); int* slot = (int*)(ws + N_SLOT);
    k_mod<<<(NB * 6144 + 255) / 256, 256, 0, st>>>(c, w_ada, b_ada, mod);
    for (int b = 0; b < NB; ++b) {
        const float* xb = x + (size_t)b * S * D; const int* pb = pos + b * S; float* ob = out + (size_t)b * S * D; const float* mb = mod + b * 6144;
        k_norm_mod<<<S / 4, 256, 0, st>>>(xb, g_mix, mb + 0, mb + 1024, hb, S);
        k_gemm<<<dim3((INC + 63) / 64, S / 64, 1), 256, 0, st>>>(hb, 1024, 0, nullptr, w_in, nullptr, INC, 0, proj, INC, S, INC, 1024, nullptr);
        k_rms_inplace<<<S / 4, 256, 0, st>>>(proj, INC, 0, 384, g_q, S);
        k_rms_inplace<<<S / 4, 256, 0, st>>>(proj, INC, 384, 256, g_kv, S);
        k_gemm<<<dim3(768 / 64, S / 64, 1), 256, 0, st>>>(proj, INC, 0, nullptr, w_uq, nullptr, 768, 0, q, 768, S, 768, 384, nullptr);
        k_gemm<<<dim3(1024 / 64, S / 64, 1), 256, 0, st>>>(proj + 384, INC, 0, nullptr, w_ukv, nullptr, 1024, 0, kv, 1024, S, 1024, 256, nullptr);
        k_rope_q<<<(S * 128 + 255) / 256, 256, 0, st>>>(q, pb, S);
        k_rope_kr<<<(S * 16 + 255) / 256, 256, 0, st>>>(proj, kr, pb, S);
        k_rope_d<<<(S * 512 + 255) / 256, 256, 0, st>>>(proj, 672, dq, pb, S);
        k_rope_d<<<(S * 512 + 255) / 256, 256, 0, st>>>(proj, 1184, dk, pb, S);
        k_attn_mla<<<dim3(S / 256, 8), 256, 0, st>>>(q, kv, kr, hb);
        k_attn_dil<<<dim3(S / 256, 8), 256, 0, st>>>(dq, dk, proj, hb);
        if (cat_opt) k_relerr<<<1024, 256, 0, st>>>(cat_opt + (size_t)b * S * 1024, hb, c0, nc, S, acc);
        float* mixed = q;
        k_gemm<<<dim3(1024 / 64, S / 64, 1), 256, 0, st>>>(hb, 1024, 0, nullptr, w_out, nullptr, 1024, 0, mixed, 1024, S, 1024, 1024, nullptr);
        k_resid<<<(S * D + 255) / 256, 256, 0, st>>>(xb, mb + 2048, mixed, ob, S * D);
        k_h2_aff<<<S / 4, 256, 0, st>>>(ob, g_ffn, mb + 3072, mb + 4096, w_router, b_router, hb, aff);
        k_topk<<<dim3(S / 256, 16), 256, 0, st>>>(aff, idx, gate, slot);
        float* Hb = proj; float* Y = q;
        k_gemm<<<dim3(16, 16, 16), 256, 0, st>>>(hb, 1024, 0, idx, w_gate, w_up, 1024, 1024 * 1024, Hb, 1024, 1024, 1024, 1024, nullptr);
        k_gemm<<<dim3(16, 16, 16), 256, 0, st>>>(Hb, 1024, 1024 * 1024, nullptr, w_down, nullptr, 1024, 1024 * 1024, Y, 1024, 1024, 1024, 1024, gate);
        k_final<<<S / 4, 256, 0, st>>>(ob, mb + 5120, Y, slot, g_final, ob);
    }
    if (cat_opt) k_scale_out<<<2048, 256, 0, st>>>(out, (size_t)NB * S * D, acc);
}
}
namespace gm {
#define LAS __attribute__((address_space(3)))
typedef unsigned short bf16_t;
typedef short bf16x8 __attribute__((ext_vector_type(8)));
typedef float f32x4 __attribute__((ext_vector_type(4)));
typedef float f32x2 __attribute__((ext_vector_type(2)));
typedef unsigned u32x4 __attribute__((ext_vector_type(4)));
typedef unsigned u32x2 __attribute__((ext_vector_type(2)));
constexpr int BM = 256, BK = 64, HALF = 128, HTB = HALF * BK * 2, STAGE_BYTES = 8 * HTB;

__device__ __forceinline__ int lds_byte(int r, int c) { const int st = (r >> 4) * 2 + (c >> 5), rr = r & 15, cc = c & 31, ob = rr * 64 + cc * 2; return st * 1024 + (ob ^ (((ob >> 9) & 1) << 5)); }
__device__ __forceinline__ void stage_rc(int b, int& R, int& C) { const int st = b / 1024, sb = b % 1024, swz = sb ^ (((sb >> 9) & 1) << 5); R = (st >> 1) * 16 + swz / 64; C = (st & 1) * 32 + (swz % 64) / 2; }
__device__ __forceinline__ int perm32(int rho) { const int n = rho >> 4, i = rho & 15; return 8 * (i >> 2) + 4 * n + (i & 3); }
__device__ __forceinline__ unsigned cvt_pk_bf16(float lo, float hi) { unsigned r; asm volatile("v_cvt_pk_bf16_f32 %0, %1, %2" : "=v"(r) : "v"(lo), "v"(hi)); return r; }

struct Unit {
    const char* A; const char* Bt; const int* gidx;
    unsigned lda2, ldb2;
    int arow0, brow0, nt;
    int pm, pn, aux;
};

template <class Epi, class Sched>
__device__ __forceinline__ void gemm_phase(LAS unsigned char* lds, const Sched& S, const Epi& E) {
    constexpr bool GATHER = Sched::GATHER;
    const int tid = threadIdx.x, wid = __builtin_amdgcn_readfirstlane(tid >> 6), lane = tid & 63, wr = wid >> 2, wc = wid & 3, fr = lane & 15, fq = lane >> 4;
    int sR[2], sC[2], sRb[2];
#pragma unroll
    for (int i = 0; i < 2; ++i) { int R, C; stage_rc(tid * 16 + i * 8192, R, C); sR[i] = R; sC[i] = C * 2; sRb[i] = Epi::PERM ? ((R & ~31) + perm32(R & 31)) : R; }
    const unsigned ldsw = (unsigned)wid * 1024u;
    const int aoff = lds_byte(wr * 64 + fr, fq * 8), boff = lds_byte(wc * 32 + fr, fq * 8);
#define GM_SA(b, h) (((b) * 2 + (h)) * HTB)
#define GM_SB(b, h) ((4 + (b) * 2 + (h)) * HTB)
#define GM_GLDS(src, dstoff) __builtin_amdgcn_global_load_lds((const unsigned*)(src), (LAS unsigned*)(lds + (dstoff)), 16, 0, 0)
#define GM_STAGE_B(bufoff, p, ld, h) do { _Pragma("unroll") for (int i_ = 0; i_ < 2; ++i_) \
        GM_GLDS((p) + ((unsigned)((h) * HALF + sRb[i_]) * (ld) + (unsigned)sC[i_]), (bufoff) + ldsw + i_ * 8192); } while (0)
#define GM_STAGE_A(bufoff, p, ld, h, g) do { _Pragma("unroll") for (int i_ = 0; i_ < 2; ++i_) { \
        const unsigned o_ = GATHER ? (g)[h][i_] + (unsigned)sC[i_] : (unsigned)((h) * HALF + sR[i_]) * (ld) + (unsigned)sC[i_]; \
        GM_GLDS((p) + o_, (bufoff) + ldsw + i_ * 8192); } } while (0)
#define GM_LDA(dst, b, h) do { _Pragma("unroll") for (int m = 0; m < 4; ++m) _Pragma("unroll") for (int k = 0; k < 2; ++k) dst[m][k] = *(const LAS bf16x8*)(lds + GM_SA(b, h) + aoff + m * 2048 + k * 1024); } while (0)
#define GM_LDB(dst, b, h) do { _Pragma("unroll") for (int n = 0; n < 2; ++n) _Pragma("unroll") for (int k = 0; k < 2; ++k) dst[n][k] = *(const LAS bf16x8*)(lds + GM_SB(b, h) + boff + n * 2048 + k * 1024); } while (0)
#define GM_MMA(ai, bj, At, Bt) do { __builtin_amdgcn_s_setprio(1); _Pragma("unroll") for (int m = 0; m < 4; ++m) _Pragma("unroll") for (int n = 0; n < 2; ++n) _Pragma("unroll") for (int k = 0; k < 2; ++k) \
        acc[ai][bj][m][n] = __builtin_amdgcn_mfma_f32_16x16x32_bf16(Bt[n][k], At[m][k], acc[ai][bj][m][n], 0, 0, 0); __builtin_amdgcn_s_setprio(0); } while (0)
#define GM_WAIT_V(n) asm volatile("s_waitcnt vmcnt(" #n ")" ::: "memory")
#define GM_WAIT_L(n) asm volatile("s_waitcnt lgkmcnt(" #n ")" ::: "memory")
#define GM_BAR __builtin_amdgcn_s_barrier()
#define GM_SCHED __builtin_amdgcn_sched_barrier(0)
#define GM_GOFFS(u, g) do { if (GATHER) { _Pragma("unroll") for (int h_ = 0; h_ < 2; ++h_) _Pragma("unroll") for (int i_ = 0; i_ < 2; ++i_) g[h_][i_] = (unsigned)(u).gidx[h_ * HALF + sR[i_]] * (u).lda2; } } while (0)
#define GM_ABASE(u) ((u).A + (GATHER ? (size_t)0 : (size_t)(u).arow0 * (u).lda2))
#define GM_BBASE(u) ((u).Bt + (size_t)(u).brow0 * (u).ldb2)
    Unit cur, nxt; int ui = 0;
    if (!S.next(0, cur)) return;
    f32x4 acc[2][2][4][2];
#pragma unroll
    for (int a = 0; a < 2; ++a)
#pragma unroll
        for (int b = 0; b < 2; ++b)
#pragma unroll
            for (int m = 0; m < 4; ++m)
#pragma unroll
                for (int n = 0; n < 2; ++n) acc[a][b][m][n] = (f32x4){0.f, 0.f, 0.f, 0.f};
    bf16x8 At[4][2], B0[2][2], B1[2][2];
    unsigned gc[2][2] = {{0u, 0u}, {0u, 0u}}, gn[2][2] = {{0u, 0u}, {0u, 0u}};
    GM_GOFFS(cur, gc);
    const char* cA = GM_ABASE(cur); const char* cB = GM_BBASE(cur); unsigned cla = cur.lda2, clb = cur.ldb2;
    GM_STAGE_B(GM_SB(0, 0), cB, clb, 0); GM_STAGE_B(GM_SB(0, 1), cB, clb, 1); GM_STAGE_A(GM_SA(0, 0), cA, cla, 0, gc); GM_STAGE_A(GM_SA(0, 1), cA, cla, 1, gc);
    if (wr == 1) GM_BAR;
    GM_WAIT_V(2); GM_BAR;
    GM_STAGE_B(GM_SB(1, 0), cB + 128, clb, 0); GM_STAGE_A(GM_SA(1, 0), cA + 128, cla, 0, gc); GM_STAGE_B(GM_SB(1, 1), cB + 128, clb, 1);
    GM_WAIT_V(6); GM_BAR;
    for (;;) {
        const bool has_next = S.next(ui + 1, nxt);
        const char* nA = cA; const char* nB = cB; unsigned nla = cla, nlb = clb;
        if (has_next) { GM_GOFFS(nxt, gn); nA = GM_ABASE(nxt); nB = GM_BBASE(nxt); nla = nxt.lda2; nlb = nxt.ldb2; }
        else if (GATHER) {
#pragma unroll
            for (int h = 0; h < 2; ++h)
#pragma unroll
                for (int i = 0; i < 2; ++i) gn[h][i] = gc[h][i];
        }
        const int nt = cur.nt;
        for (int t = 0; t < nt; t += 2) {
            const bool last = (t == nt - 2);
            const char* a1 = cA + (size_t)(t + 1) * 128;
            const char* a2 = last ? nA : cA + (size_t)(t + 2) * 128; const char* b2 = last ? nB : cB + (size_t)(t + 2) * 128;
            const char* a3 = a2 + 128; const char* b3 = b2 + 128;
            const unsigned la2 = last ? nla : cla, lb2 = last ? nlb : clb;
            unsigned g2[2][2];
#pragma unroll
            for (int h = 0; h < 2; ++h)
#pragma unroll
                for (int i = 0; i < 2; ++i) g2[h][i] = GATHER ? (last ? gn[h][i] : gc[h][i]) : 0u;
            GM_LDB(B0, 0, 0); GM_LDB(B1, 0, 1); GM_SCHED; GM_LDA(At, 0, 0); GM_STAGE_A(GM_SA(1, 1), a1, cla, 1, gc);
            GM_WAIT_V(8); GM_WAIT_L(0); GM_BAR; GM_MMA(0, 0, At, B0); GM_MMA(0, 1, At, B1); GM_BAR; GM_SCHED;
            GM_LDA(At, 0, 1); GM_STAGE_B(GM_SB(0, 0), b2, lb2, 0); GM_STAGE_B(GM_SB(0, 1), b2, lb2, 1); GM_STAGE_A(GM_SA(0, 0), a2, la2, 0, g2);
            GM_WAIT_V(8); GM_WAIT_L(0); GM_BAR; GM_MMA(1, 0, At, B0); GM_MMA(1, 1, At, B1); GM_BAR; GM_SCHED;
            GM_LDB(B0, 1, 0); GM_LDB(B1, 1, 1); GM_SCHED; GM_LDA(At, 1, 0); GM_STAGE_A(GM_SA(0, 1), a2, la2, 1, g2);
            GM_WAIT_V(8); GM_WAIT_L(0); GM_BAR; GM_MMA(0, 0, At, B0); GM_MMA(0, 1, At, B1); GM_BAR; GM_SCHED;
            GM_LDA(At, 1, 1); GM_STAGE_B(GM_SB(1, 0), b3, lb2, 0); GM_STAGE_B(GM_SB(1, 1), b3, lb2, 1); GM_STAGE_A(GM_SA(1, 0), a3, la2, 0, g2);
            GM_WAIT_V(8); GM_WAIT_L(0); GM_BAR; GM_MMA(1, 0, At, B0); GM_MMA(1, 1, At, B1); GM_BAR; GM_SCHED;
        }
        if (wr == 0) GM_BAR;
        E(acc, cur, wr, wc, fr, fq);
        if (!has_next) break;
#pragma unroll
        for (int a = 0; a < 2; ++a)
#pragma unroll
            for (int b = 0; b < 2; ++b)
#pragma unroll
                for (int m = 0; m < 4; ++m)
#pragma unroll
                    for (int n = 0; n < 2; ++n) acc[a][b][m][n] = (f32x4){0.f, 0.f, 0.f, 0.f};
        cur = nxt; cA = nA; cB = nB; cla = nla; clb = nlb; ++ui;
        if (GATHER) {
#pragma unroll
            for (int h = 0; h < 2; ++h)
#pragma unroll
                for (int i = 0; i < 2; ++i) gc[h][i] = gn[h][i];
        }
        if (wr == 1) GM_BAR;
    }
    GM_WAIT_V(0);
    GM_BAR;
#undef GM_SA
#undef GM_SB
#undef GM_GLDS
#undef GM_STAGE_A
#undef GM_STAGE_B
#undef GM_LDA
#undef GM_LDB
#undef GM_MMA
#undef GM_WAIT_V
#undef GM_WAIT_L
#undef GM_BAR
#undef GM_SCHED
#undef GM_GOFFS
#undef GM_ABASE
#undef GM_BBASE
}
}
namespace mk {
using gm::bf16_t; using gm::f32x4; using gm::f32x2; using gm::u32x4; using gm::u32x2; using gm::cvt_pk_bf16;
constexpr int T = 16384, S = 8192, D = 1024, NB = 2, NH = 8, NWAVES = 8, NTHREADS = 512;
constexpr float EPS = 1e-6f;
constexpr size_t KiB = 1024, MiB = 1u << 20;
constexpr size_t WS_CTL = 0;
constexpr size_t WS_KMX = 48 * KiB;
constexpr size_t WS_MODP = 1 * MiB;
constexpr size_t WS_MODF = 2 * MiB;
constexpr size_t WS_TABM = WS_MODF + 64 * KiB;
constexpr size_t WS_TABD = WS_TABM + 2 * MiB;
constexpr size_t WS_SSQ = WS_TABD + 1 * MiB;
constexpr size_t WS_KR = WS_SSQ + 1536 * KiB;
constexpr size_t WS_AFF = WS_KR + 1 * MiB;
constexpr size_t WS_IDX = WS_AFF + 1 * MiB;
constexpr size_t WS_GATE = WS_IDX + 128 * KiB;
constexpr size_t WS_SLOT = WS_GATE + 128 * KiB;
constexpr size_t WS_LSE = WS_SLOT + 1 * MiB;
constexpr size_t WS_WUQ = WS_LSE + 1536 * KiB;
constexpr size_t WS_WUKV = WS_WUQ + 576 * KiB;
constexpr size_t WS_WOUT = WS_WUKV + 512 * KiB;
constexpr size_t WS_WIN = WS_WOUT + 2 * MiB;
constexpr size_t WS_R0END = WS_WIN + 4608 * KiB;
static_assert(WS_R0END <= 20 * MiB, "R0");
constexpr size_t WS_HB = 20 * MiB;
constexpr size_t WS_CQ = 52 * MiB;
constexpr size_t WS_DQ = WS_CQ + 24 * MiB, WS_DK = WS_DQ + 16 * MiB, WS_DV = WS_DK + 16 * MiB;
constexpr size_t WS_Q = WS_DV + 16 * MiB;
constexpr size_t WS_KN = WS_Q + 24 * MiB, WS_V = WS_KN + 16 * MiB;
constexpr size_t WS_HBUF = WS_CQ;
constexpr size_t WS_WGU = 180 * MiB;
constexpr size_t WS_Y = WS_WGU;
constexpr size_t WS_WD = 244 * MiB;
constexpr size_t WS_END = 276 * MiB;
static_assert(WS_V + 16 * MiB == 180 * MiB, "arena");
constexpr int LDS_BYTES = 147456;

__device__ __forceinline__ float wave_sum(float v) {
#pragma unroll
    for (int o = 1; o < 64; o <<= 1) v += __shfl_xor(v, o);
    return v;
}
__device__ __forceinline__ unsigned f2bf(float f) { unsigned u = __builtin_bit_cast(unsigned, f); return (u + 0x7fffu + ((u >> 16) & 1u)) >> 16; }
__device__ __forceinline__ unsigned pk2(float lo, float hi) { return f2bf(lo) | (f2bf(hi) << 16); }
__device__ __forceinline__ float bf2f(unsigned short b) { return __builtin_bit_cast(float, (unsigned)b << 16); }
__device__ __forceinline__ float siluf(float v) { return v / (1.f + __expf(-v)); }
#define LDS_WAIT() asm volatile("s_waitcnt lgkmcnt(0)" ::: "memory")

struct Args { const void* in[19]; float* out; unsigned char* ws; int ph_lo, ph_hi, li, pad; };
struct Frame {
    LAS unsigned char* lds; unsigned char* ws; float* out;
    int tid, lane, wave, vcu, G;
    const float *x, *c; const int* pos; const float *w_ada, *b_ada, *g_mix, *w_in, *g_q, *w_uq, *g_kv, *w_ukv, *w_out, *g_ffn, *w_router, *b_router, *w_gate, *w_up, *w_down, *g_final;
};

__device__ __forceinline__ float inv_freq_m(int i) { return (float)exp2(-(double)i * (18.931568569324174 / 16.0)); }
__device__ __forceinline__ float inv_freq_d(int i) { return (float)exp2(-(double)i * (18.931568569324174 / 8.0)); }

#ifndef WD_IN_P5
#define WD_IN_P5 1
#endif
__device__ __forceinline__ void p0_transpose_item(const float* W, int ldw, int K, int k0, int n0, bf16_t* WT, int drow, const float* kscale, LAS float* scr, int lane) {
#pragma unroll
    for (int i = 0; i < 32; ++i) { const int kk = 2 * i + (lane >> 5); float v = W[(size_t)(k0 + kk) * ldw + n0 + (lane & 31)]; if (kscale) v *= kscale[k0 + kk]; scr[kk * 33 + (lane & 31)] = v; }
    LDS_WAIT(); asm volatile("" ::: "memory");
    const int c = lane & 7;
#pragma unroll
    for (int j = 0; j < 4; ++j) { const int n = (lane >> 3) + 8 * j; const LAS float* s = scr + (8 * c) * 33 + n;
        u32x4 o; o.x = pk2(s[0 * 33], s[1 * 33]); o.y = pk2(s[2 * 33], s[3 * 33]); o.z = pk2(s[4 * 33], s[5 * 33]); o.w = pk2(s[6 * 33], s[7 * 33]);
        *(u32x4*)(WT + (size_t)(drow + n) * K + k0 + 8 * c) = o; }
    LDS_WAIT(); asm volatile("" ::: "memory");
}
__device__ __forceinline__ void p0_prologue(Frame& F) {
    LAS float* scr = (LAS float*)(F.lds + F.wave * 16384);
    const int gw = F.vcu * NWAVES + F.wave, NGW = F.G * NWAVES, lane = F.lane;
    unsigned char* ws = F.ws;
    constexpr int I_MOD = 24 * 16, I_IN = 16 * 69, I_UQ = 6 * 24, I_UKV = 4 * 32, I_OUT = 16 * 32, I_EXP = 16 * 16 * 32, I_PAD = 96, I_TAB = T * 24 / 64;
    constexpr int NITEMS = I_MOD + I_IN + I_UQ + I_UKV + I_OUT + (WD_IN_P5 ? 2 : 3) * I_EXP + I_PAD + I_TAB;
    for (int it = gw; it < NITEMS; it += NGW) {
        int r = it;
        if (r < I_MOD) {
            const int cc = r % 24, kc = r / 24; f32x4 a0 = {0.f, 0.f, 0.f, 0.f}, a1 = {0.f, 0.f, 0.f, 0.f};
            const float* wp = F.w_ada + (size_t)(kc * 64) * 6144 + cc * 256 + 4 * lane;
#pragma unroll 8
            for (int k = 0; k < 64; ++k) { const f32x4 w = *(const f32x4*)(wp + (size_t)k * 6144); const float s0 = siluf(F.c[kc * 64 + k]), s1 = siluf(F.c[1024 + kc * 64 + k]); a0 += w * s0; a1 += w * s1; }
            float* mp = (float*)(ws + WS_MODP) + (size_t)kc * 2 * 6144 + cc * 256 + 4 * lane;
            *(f32x4*)mp = a0; *(f32x4*)(mp + 6144) = a1; continue; }
        r -= I_MOD;
        if (r < I_IN) { const int kb = r / 69, nb = r % 69, n0 = nb * 32; p0_transpose_item(F.w_in, 2208, 1024, kb * 64, n0, (bf16_t*)(ws + WS_WIN), n0 < 672 ? n0 : n0 + 96, nullptr, scr, lane); continue; }
        r -= I_IN;
        if (r < I_UQ) { const int kb = r / 24, nb = r % 24, n0 = nb * 32, h = n0 / 96, d = n0 % 96; p0_transpose_item(F.w_uq, 768, 384, kb * 64, n0, (bf16_t*)(ws + WS_WUQ), d < 64 ? h * 64 + d : 512 + h * 32, F.g_q, scr, lane); continue; }
        r -= I_UQ;
        if (r < I_UKV) { const int kb = r / 32, nb = r % 32, n0 = nb * 32, h = n0 / 128, d = n0 % 128; p0_transpose_item(F.w_ukv, 1024, 256, kb * 64, n0, (bf16_t*)(ws + WS_WUKV), d < 64 ? h * 64 + d : 512 + h * 64 + (d - 64), F.g_kv, scr, lane); continue; }
        r -= I_UKV;
        if (r < I_OUT) { const int kb = r / 32, nb = r % 32; p0_transpose_item(F.w_out, 1024, 1024, kb * 64, nb * 32, (bf16_t*)(ws + WS_WOUT), nb * 32, nullptr, scr, lane); continue; }
        r -= I_OUT;
        if (r < 2 * I_EXP) { const int up = r >= I_EXP; const int q = up ? r - I_EXP : r; const int e = q / 512, kb = (q % 512) / 32, nb = q % 32, n0 = nb * 32;
            p0_transpose_item((up ? F.w_up : F.w_gate) + (size_t)e * 1048576, 1024, 1024, kb * 64, n0, (bf16_t*)(ws + WS_WGU) + (size_t)e * 2048 * 1024, (n0 / 128) * 256 + up * 128 + (n0 % 128), nullptr, scr, lane); continue; }
        r -= 2 * I_EXP;
        if (!WD_IN_P5) { if (r < I_EXP) { const int e = r / 512, kb = (r % 512) / 32, nb = r % 32; p0_transpose_item(F.w_down + (size_t)e * 1048576, 1024, 1024, kb * 64, nb * 32, (bf16_t*)(ws + WS_WD) + (size_t)e * 1048576, nb * 32, nullptr, scr, lane); continue; }
        r -= I_EXP; }
        if (r < I_PAD) { u32x4 z = {0u, 0u, 0u, 0u}; u32x4* p = (u32x4*)((bf16_t*)(ws + WS_WIN) + (size_t)(672 + r) * 1024); p[lane] = z; p[64 + lane] = z; continue; }
        r -= I_PAD;
        {
            const int e = r * 64 + lane, tok = e / 24, f = e % 24; const int p = F.pos[tok];
            const float inv = f < 16 ? inv_freq_m(f) : inv_freq_d(f - 16); const float ang = (float)p * inv; const float cs = (float)cos((double)ang), sn = (float)sin((double)ang);
            if (f < 16) { float* tm = (float*)(ws + WS_TABM) + (size_t)tok * 32; tm[f] = cs; tm[16 + f] = sn; } else { float* td = (float*)(ws + WS_TABD) + (size_t)tok * 16; td[f - 16] = cs; td[8 + f - 16] = sn; }
        }
    }
}
__device__ __forceinline__ void wd_convert(Frame& F, int first_vcu) {
    LAS float* scr = (LAS float*)(F.lds + F.wave * 16384);
    const int gw = (F.vcu - first_vcu) * NWAVES + F.wave, NGW = (F.G - first_vcu) * NWAVES;
    for (int r = gw; r < 16 * 16 * 32; r += NGW) { const int e = r / 512, kb = (r % 512) / 32, nb = r % 32;
        p0_transpose_item(F.w_down + (size_t)e * 1048576, 1024, 1024, kb * 64, nb * 32, (bf16_t*)(F.ws + WS_WD) + (size_t)e * 1048576, nb * 32, nullptr, scr, F.lane); }
}
__device__ __forceinline__ void p0b_rows(Frame& F) {
    LAS float* A1 = (LAS float*)F.lds;
    LAS float* A0 = A1 + 2048;
    const float* mp = (const float*)(F.ws + WS_MODP);
    for (int i = F.tid; i < 4096; i += NTHREADS) { const int b = i >> 11, which = (i >> 10) & 1, j = i & 1023; const int n = which * 1024 + j;
        float s = F.b_ada[n];
#pragma unroll
        for (int k = 0; k < 16; ++k) s += mp[(size_t)k * 2 * 6144 + b * 6144 + n];
        if (which) A1[b * 1024 + j] = F.g_mix[j] * (1.f + s); else A0[b * 1024 + j] = s; }
    if (blockIdx.x < 48 && F.tid < 256) { const int n = blockIdx.x * 256 + F.tid; const int b = n / 6144, nn = n % 6144; float s = F.b_ada[nn];
#pragma unroll
        for (int k = 0; k < 16; ++k) s += mp[(size_t)k * 2 * 6144 + b * 6144 + nn];
        ((float*)(F.ws + WS_MODF))[n] = s; }
    __syncthreads();
    const int gw = F.vcu * NWAVES + F.wave, NGW = F.G * NWAVES, lane = F.lane;
    for (int m0 = gw; m0 < T; m0 += 2 * NGW) {
        const int m1 = m0 + NGW; const bool has1 = m1 < T; const int mm1 = has1 ? m1 : m0;
        const f32x4* xr0 = (const f32x4*)(F.x + (size_t)m0 * D) + lane; const f32x4* xr1 = (const f32x4*)(F.x + (size_t)mm1 * D) + lane; f32x4 v0[4], v1[4]; float s0 = 0.f, s1 = 0.f;
#pragma unroll
        for (int j = 0; j < 4; ++j) { v0[j] = xr0[64 * j]; v1[j] = xr1[64 * j]; }
#pragma unroll
        for (int j = 0; j < 4; ++j) { s0 += (v0[j].x * v0[j].x + v0[j].y * v0[j].y) + (v0[j].z * v0[j].z + v0[j].w * v0[j].w); s1 += (v1[j].x * v1[j].x + v1[j].y * v1[j].y) + (v1[j].z * v1[j].z + v1[j].w * v1[j].w); }
        const float r0 = rsqrtf(wave_sum(s0) * (1.f / D) + EPS), r1 = rsqrtf(wave_sum(s1) * (1.f / D) + EPS);
        const int b0 = m0 >> 13, b1 = mm1 >> 13;
        unsigned long long* o0 = (unsigned long long*)((bf16_t*)(F.ws + WS_HB) + (size_t)m0 * D) + lane; unsigned long long* o1 = (unsigned long long*)((bf16_t*)(F.ws + WS_HB) + (size_t)mm1 * D) + lane;
#pragma unroll
        for (int j = 0; j < 4; ++j) { const f32x4 a1 = *(const LAS f32x4*)(A1 + b0 * 1024 + 4 * lane + 256 * j), a0 = *(const LAS f32x4*)(A0 + b0 * 1024 + 4 * lane + 256 * j);
            const f32x4 o = v0[j] * r0 * a1 + a0; o0[64 * j] = (unsigned long long)pk2(o.x, o.y) | ((unsigned long long)pk2(o.z, o.w) << 32); }
        if (has1) {
#pragma unroll
            for (int j = 0; j < 4; ++j) { const f32x4 a1 = *(const LAS f32x4*)(A1 + b1 * 1024 + 4 * lane + 256 * j), a0 = *(const LAS f32x4*)(A0 + b1 * 1024 + 4 * lane + 256 * j);
                const f32x4 o = v1[j] * r1 * a1 + a0; o1[64 * j] = (unsigned long long)pk2(o.x, o.y) | ((unsigned long long)pk2(o.z, o.w) << 32); } }
    }
    __syncthreads();
}

__device__ __forceinline__ bool static_tile(int i, int G, int c, int nM, int nN, int& pm, int& pn) {
    const int nwg = nM * nN; const long L = (long)i * G + c; if (L >= nwg) return false;
    int wgid = (int)L; { const int q = nwg / 8, r = nwg % 8, xcd = wgid % 8, off = wgid / 8; wgid = (xcd < r ? xcd * (q + 1) : r * (q + 1) + (xcd - r) * q) + off; }
    const int nig = 8 * nN, gid = wgid / nig, fm = gid * 8, gsz = (nM - fm) < 8 ? (nM - fm) : 8;
    pm = fm + ((wgid % nig) % gsz); pn = (wgid % nig) / gsz; return true;
}
struct SchedP1 {
    static constexpr bool GATHER = false;
    const char* A; const char* Bt; int G, c;
    __device__ __forceinline__ bool next(int i, gm::Unit& u) const { int pm, pn; if (!static_tile(i, G, c, 64, 9, pm, pn)) return false;
        u.A = A; u.Bt = Bt; u.gidx = nullptr; u.lda2 = 2048; u.ldb2 = 2048; u.arow0 = pm * 256; u.brow0 = pn * 256; u.nt = 16; u.pm = pm; u.pn = pn; u.aux = 0; return true; }
};
struct SchedP2 {
    static constexpr bool GATHER = false;
    const char* A; const char* Wuq; const char* Wukv; int G, c;
    __device__ __forceinline__ bool next(int i, gm::Unit& u) const {
        const int L = i * G + c; if (L >= 448) return false;
        u.A = A; u.gidx = nullptr; u.lda2 = 1536;
        if (L < 256) { int pm, pn; static_tile(0, 256, L, 64, 4, pm, pn); u.A = A + 768; u.Bt = Wukv; u.ldb2 = 512; u.nt = 4; u.arow0 = pm * 256; u.brow0 = pn * 256; u.pm = pm; u.pn = pn; u.aux = 1; }
        else { int pm, pn; static_tile(0, 192, L - 256, 64, 3, pm, pn); u.Bt = Wuq; u.ldb2 = 768; u.nt = 6; u.arow0 = pm * 256; u.brow0 = pn * 256; u.pm = pm; u.pn = pn; u.aux = 0; }
        return true; }
};

#define EPI_ARGS const f32x4 (&acc)[2][2][4][2], const gm::Unit& u, int wr, int wc, int fr, int fq
constexpr float QSCALE_M = 0.10206207261596575f * 1.4426950408889634f;
constexpr float QSCALE_D = 0.125f * 1.4426950408889634f;
__device__ __forceinline__ u32x4 pack8(f32x4 a, f32x4 b) { u32x4 w; w.x = cvt_pk_bf16(a[0], a[1]); w.y = cvt_pk_bf16(a[2], a[3]); w.z = cvt_pk_bf16(b[0], b[1]); w.w = cvt_pk_bf16(b[2], b[3]); return w; }
__device__ __forceinline__ void rope8(f32x4& v0, f32x4& v1, int xmask, const float* cs, const float* sn, bool first) {
    f32x4 o0, o1;
#pragma unroll
    for (int j = 0; j < 4; ++j) { o0[j] = __shfl_xor(v0[j], xmask); o1[j] = __shfl_xor(v1[j], xmask); }
    const f32x4 c0 = *(const f32x4*)cs, c1 = *(const f32x4*)(cs + 4), s0 = *(const f32x4*)sn, s1 = *(const f32x4*)(sn + 4);
    const float sg = first ? -1.f : 1.f;
    v0 = v0 * c0 + o0 * s0 * sg; v1 = v1 * c1 + o1 * s1 * sg;
}
struct EpiP1 {
    static constexpr bool PERM = true;
    unsigned char* ws;
    __device__ __forceinline__ void operator()(EPI_ARGS) const {
        const int pn = u.pn; float krmax = 0.f;
        const float* tabm = (const float*)(ws + WS_TABM); const float* tabd = (const float*)(ws + WS_TABD);
#pragma unroll
        for (int ai = 0; ai < 2; ++ai)
#pragma unroll
            for (int m = 0; m < 4; ++m) {
                const int row = u.pm * 256 + ai * 128 + wr * 64 + m * 16 + fr; const int b = row >> 13, s = row & 8191;
#pragma unroll
                for (int bj = 0; bj < 2; ++bj) {
                    f32x4 v0 = acc[ai][bj][m][0], v1 = acc[ai][bj][m][1];
                    const int ct = bj * 128 + wc * 32 + 8 * fq;
                    if (pn < 3) {
                        float q = (v0[0] * v0[0] + v0[1] * v0[1]) + (v0[2] * v0[2] + v0[3] * v0[3]) + (v1[0] * v1[0] + v1[1] * v1[1]) + (v1[2] * v1[2] + v1[3] * v1[3]);
                        q += __shfl_xor(q, 16); q += __shfl_xor(q, 32);
                        if (fq == 0) ((float*)(ws + WS_SSQ))[(size_t)row * 24 + pn * 8 + bj * 4 + wc] = q;
                        if (pn == 2 && bj == 1 && wc == 0) {
                            const int f0 = 8 * (fq & 1); rope8(v0, v1, 32, tabm + (size_t)row * 32 + f0, tabm + (size_t)row * 32 + 16 + f0, fq < 2);
                            *(u32x4*)((bf16_t*)(ws + WS_KR) + (size_t)row * 32 + 8 * fq) = pack8(v0, v1);
                            { float q2 = (v0[0] * v0[0] + v0[1] * v0[1]) + (v0[2] * v0[2] + v0[3] * v0[3]) + (v1[0] * v1[0] + v1[1] * v1[1]) + (v1[2] * v1[2] + v1[3] * v1[3]);
                              q2 += __shfl_xor(q2, 16); q2 += __shfl_xor(q2, 32); krmax = fmaxf(krmax, q2); }
                        } else *(u32x4*)((bf16_t*)(ws + WS_CQ) + (size_t)row * 768 + pn * 256 + ct) = pack8(v0, v1);
                    } else {
                        const int which = (pn - 3) >> 1;
                        const int cc = ((pn - 3) & 1) * 256 + ct, hh = cc >> 6, d = cc & 63;
                        if (which < 2 && (wc & 1) == 0) {
                            f32x4 r0 = v0, r1 = v1; rope8(r0, r1, 16, tabd + (size_t)row * 16, tabd + (size_t)row * 16 + 8, fq == 0);
                            if (fq < 2) { v0 = r0; v1 = r1; } }
                        if (which == 0) { v0 = v0 * QSCALE_D; v1 = v1 * QSCALE_D; }
                        bf16_t* dst = (bf16_t*)(ws + (which == 0 ? WS_DQ : which == 1 ? WS_DK : WS_DV));
                        *(u32x4*)(dst + ((size_t)(b * 8 + hh) * S + s) * 64 + d) = pack8(v0, v1);
                    }
                }
            }
        if (pn == 2 && wc == 0) {
#pragma unroll
            for (int o = 1; o < 16; o <<= 1) krmax = fmaxf(krmax, __shfl_xor(krmax, o));
            if ((threadIdx.x & 63) == 0) atomicMax((unsigned*)(ws + WS_KMX) + 32 + ((u.pm * 256) >> 13), __float_as_uint(krmax)); }
    }
};
struct EpiP2 {
    static constexpr bool PERM = true;
    unsigned char* ws;
    __device__ __forceinline__ void operator()(EPI_ARGS) const {
        const int pn = u.pn; const bool isq = u.aux == 0; float kmax[2] = {0.f, 0.f};
        const float* tabm = (const float*)(ws + WS_TABM); const float* ssq = (const float*)(ws + WS_SSQ);
#pragma unroll
        for (int ai = 0; ai < 2; ++ai)
#pragma unroll
            for (int m = 0; m < 4; ++m) {
                const int row = u.pm * 256 + ai * 128 + wr * 64 + m * 16 + fr; const int b = row >> 13, s = row & 8191;
                const float* sq = ssq + (size_t)row * 24; float rstd;
                if (isq) { const f32x4 a = *(const f32x4*)sq, bq = *(const f32x4*)(sq + 4), cq = *(const f32x4*)(sq + 8);
                    rstd = rsqrtf((((a[0] + a[1]) + (a[2] + a[3])) + ((bq[0] + bq[1]) + (bq[2] + bq[3])) + ((cq[0] + cq[1]) + (cq[2] + cq[3]))) * (1.f / 384.f) + EPS) * QSCALE_M; }
                else { const f32x4 a = *(const f32x4*)(sq + 12), bq = *(const f32x4*)(sq + 16);
                    rstd = rsqrtf((((a[0] + a[1]) + (a[2] + a[3])) + ((bq[0] + bq[1]) + (bq[2] + bq[3]))) * (1.f / 256.f) + EPS); }
#pragma unroll
                for (int bj = 0; bj < 2; ++bj) {
                    f32x4 v0 = acc[ai][bj][m][0] * rstd, v1 = acc[ai][bj][m][1] * rstd;
                    const int ct = bj * 128 + wc * 32 + 8 * fq, cc = (pn & 1) * 256 + ct;
                    if (isq) {
                        if (pn < 2) { const int hh = cc >> 6, d = cc & 63; *(u32x4*)((bf16_t*)(ws + WS_Q) + ((size_t)(b * 8 + hh) * S + s) * 96 + d) = pack8(v0, v1); }
                        else { const int hh = ct >> 5; const int f0 = 8 * (fq & 1); rope8(v0, v1, 32, tabm + (size_t)row * 32 + f0, tabm + (size_t)row * 32 + 16 + f0, fq < 2);
                            *(u32x4*)((bf16_t*)(ws + WS_Q) + ((size_t)(b * 8 + hh) * S + s) * 96 + 64 + 8 * fq) = pack8(v0, v1); }
                    } else { const int hh = cc >> 6, d = cc & 63; bf16_t* dst = (bf16_t*)(ws + (pn < 2 ? WS_KN : WS_V));
                        *(u32x4*)(dst + ((size_t)(b * 8 + hh) * S + s) * 64 + d) = pack8(v0, v1);
                        if (pn < 2) { float q2 = (v0[0] * v0[0] + v0[1] * v0[1]) + (v0[2] * v0[2] + v0[3] * v0[3]) + (v1[0] * v1[0] + v1[1] * v1[1]) + (v1[2] * v1[2] + v1[3] * v1[3]);
                            q2 += __shfl_xor(q2, 16); q2 += __shfl_xor(q2, 32); kmax[bj] = fmaxf(kmax[bj], q2); } }
                }
            }
        if (!isq && pn < 2) {
#pragma unroll
            for (int bj = 0; bj < 2; ++bj) { float km = kmax[bj];
#pragma unroll
                for (int o = 1; o < 16; o <<= 1) km = fmaxf(km, __shfl_xor(km, o));
                const int cc = (pn & 1) * 256 + bj * 128 + wc * 32, hh = cc >> 6, half = (cc >> 5) & 1, b = (u.pm * 256) >> 13;
                if ((threadIdx.x & 63) == 0) atomicMax((unsigned*)(ws + WS_KMX) + (b * 8 + hh) * 2 + half, __float_as_uint(km)); }
        }
    }
};
}
namespace mk {
#define RLX_AGENT __ATOMIC_RELAXED, __HIP_MEMORY_SCOPE_AGENT
#define XB_TMO      128
#define XB_XCNT(j)  (256  + 64 * (j))
#define XB_XSUB(j)  (1280 + 64 * (j))
#define XB_XGEN(j)  (2304 + 64 * (j))
#define XB_TOP      3328
#define XB_TOPGEN   3392
#define XCD_BAR_WORDS 3456
#define XB_SPIN_CAP (1u << 18)
__device__ __forceinline__ unsigned xb_ld(unsigned* p)              { return __hip_atomic_load(p, __ATOMIC_RELAXED, __HIP_MEMORY_SCOPE_AGENT); }
__device__ __forceinline__ unsigned xb_add(unsigned* p, unsigned v) { return __hip_atomic_fetch_add(p, v, __ATOMIC_RELAXED, __HIP_MEMORY_SCOPE_AGENT); }
__device__ __forceinline__ unsigned xb_xcc_id() { return (unsigned)__builtin_amdgcn_s_getreg((3 << 11) | 20) & 0xFu; }
#define XB_SPIN(cond, bar) do { unsigned _sp = 0; while (cond) { __builtin_amdgcn_s_sleep(1); \
    if ((++_sp & 255u) == 0u) { if (xb_ld(&(bar)[XB_TMO])) break; if (_sp > XB_SPIN_CAP) { atomicAdd(&(bar)[XB_TMO], 1u); break; } } } } while (0)
struct XcdBarrier { unsigned* bar; unsigned x; volatile LAS unsigned* st; };
__device__ __forceinline__ XcdBarrier xcd_barrier_post(unsigned* bar, volatile LAS unsigned* st) {
    XcdBarrier b; b.bar = bar; b.x = xb_xcc_id(); b.st = st;
    if (threadIdx.x == 0) (void)xb_add(&bar[XB_XCNT(b.x)], 1u);
    return b;
}
__device__ __forceinline__ void xcd_barrier_complete(unsigned* bar, unsigned x, unsigned& nloc, unsigned& nx) {
    const unsigned G = gridDim.x * gridDim.y * gridDim.z;
    unsigned sum, cnt, mine, sp = 0u;
    for (;;) {
        sum = 0u; cnt = 0u; mine = 0u;
#pragma unroll
        for (unsigned j = 0; j < 16; ++j) { const unsigned c = xb_ld(&bar[XB_XCNT(j)]); sum += c; cnt += (c > 0u) ? 1u : 0u; mine = (j == x) ? c : mine; }
        if (sum == G) break;
        __builtin_amdgcn_s_sleep(1);
        if ((++sp & 255u) == 0u) { if (xb_ld(&bar[XB_TMO])) break; if (sp > XB_SPIN_CAP) { atomicAdd(&bar[XB_TMO], 1u); break; } }
    }
    nloc = mine > 0u ? mine : 1u; nx = cnt > 0u ? cnt : 1u;
}
__device__ __forceinline__ void xcd_barrier(const XcdBarrier& b) {
    asm volatile("s_waitcnt vmcnt(0)" ::: "memory");
    __syncthreads();
    if (threadIdx.x == 0) {
        unsigned* bar = b.bar;
        __builtin_amdgcn_s_waitcnt(0);
        unsigned nloc = b.st[0], nx = b.st[1];
        if (nloc == 0u) { xcd_barrier_complete(bar, b.x, nloc, nx); b.st[0] = nloc; b.st[1] = nx; }
        const unsigned old = xb_add(&bar[XB_XSUB(b.x)], 1u);
        const unsigned gen = old / nloc;
        if (old + 1u == (gen + 1u) * nloc) {
            __builtin_amdgcn_fence(__ATOMIC_RELEASE, "agent");
            asm volatile("s_waitcnt vmcnt(0)" ::: "memory");
            const unsigned og = xb_add(&bar[XB_TOP], 1u);
            const unsigned tg = og / nx;
            if (og + 1u == (tg + 1u) * nx) xb_add(&bar[XB_TOPGEN], 1u);
            else XB_SPIN(xb_ld(&bar[XB_TOPGEN]) == tg, bar);
            __builtin_amdgcn_fence(__ATOMIC_ACQUIRE, "agent");
            xb_add(&bar[XB_XGEN(b.x)], 1u);
            asm volatile("s_waitcnt vmcnt(0)" ::: "memory");
        } else {
            XB_SPIN(xb_ld(&bar[XB_XGEN(b.x)]) == gen, bar);
            __builtin_amdgcn_fence(__ATOMIC_ACQUIRE, "agent");
            asm volatile("s_waitcnt vmcnt(0)" ::: "memory");
        }
    }
    __syncthreads();
}
}
namespace at {
using bf16x8 = __attribute__((ext_vector_type(8))) short;
using s16x4 = __attribute__((ext_vector_type(4))) short;
using f32x16 = __attribute__((ext_vector_type(16))) float;
using u32x4 = __attribute__((ext_vector_type(4))) unsigned;
constexpr int S = 8192, T = 16384;
constexpr float THR = 8.f;
#define SBAR() __builtin_amdgcn_sched_barrier(0)
__device__ __forceinline__ int crow(int r, int hi) { return (r & 3) + 8 * (r >> 2) + 4 * hi; }
__device__ __forceinline__ unsigned cvtpk(float lo, float hi) { unsigned r; asm volatile("v_cvt_pk_bf16_f32 %0, %1, %2" : "=v"(r) : "v"(lo), "v"(hi)); return r; }
__device__ __forceinline__ float rowmax32(const f32x16& p0, const f32x16& p1) {
    float pmax = p0[0];
#pragma unroll
    for (int r = 1; r < 16; ++r) pmax = fmaxf(pmax, p0[r]);
#pragma unroll
    for (int r = 0; r < 16; ++r) pmax = fmaxf(pmax, p1[r]);
    auto rr = __builtin_amdgcn_permlane32_swap(__float_as_uint(pmax), __float_as_uint(pmax), false, false);
    return fmaxf(__uint_as_float(rr[0]), __uint_as_float(rr[1]));
}
__device__ __forceinline__ void partialSM(f32x16& p0, f32x16& p1, float& m_reg, float& mn, float& alpha) {
    const float pmax = rowmax32(p0, p1);
    if (__builtin_expect(__all(pmax - m_reg <= THR), 1)) { mn = m_reg; alpha = 1.f; }
    else { mn = fmaxf(m_reg, pmax); alpha = __builtin_amdgcn_exp2f(m_reg - mn); m_reg = mn; }
#pragma unroll
    for (int r = 0; r < 16; ++r) p0[r] = p0[r] - mn;
#pragma unroll
    for (int r = 0; r < 16; ++r) p1[r] = p1[r] - mn;
#pragma unroll
    for (int r = 0; r < 16; ++r) p0[r] = __builtin_amdgcn_exp2f(p0[r]);
}
#define PK4(P, BASE, OUT) do { unsigned a0 = cvtpk(P[BASE + 0], P[BASE + 1]), a1 = cvtpk(P[BASE + 2], P[BASE + 3]);   \
    unsigned b0 = cvtpk(P[BASE + 4], P[BASE + 5]), b1 = cvtpk(P[BASE + 6], P[BASE + 7]);                              \
    auto r0 = __builtin_amdgcn_permlane32_swap(a0, b0, false, false); auto r1 = __builtin_amdgcn_permlane32_swap(a1, b1, false, false); \
    u32x4 w = {r0[0], r1[0], r0[1], r1[1]}; OUT = *reinterpret_cast<bf16x8*>(&w); } while (0)
__device__ __forceinline__ void finishSM(f32x16& p0, f32x16& p1, float alpha, float& l_reg, bf16x8& pa0, bf16x8& pa1, bf16x8& pa2, bf16x8& pa3) {
#pragma unroll
    for (int r = 0; r < 16; ++r) p1[r] = __builtin_amdgcn_exp2f(p1[r]);
    float ps = 0;
#pragma unroll
    for (int r = 0; r < 16; ++r) ps += p0[r];
#pragma unroll
    for (int r = 0; r < 16; ++r) ps += p1[r];
    { auto rr = __builtin_amdgcn_permlane32_swap(__float_as_uint(ps), __float_as_uint(ps), false, false); ps = __uint_as_float(rr[0]) + __uint_as_float(rr[1]); }
    l_reg = l_reg * alpha + ps;
    PK4(p0, 0, pa0); PK4(p0, 8, pa1); PK4(p1, 0, pa2); PK4(p1, 8, pa3);
}
__device__ __forceinline__ int v_st(int k, int c) { const int kk = (k & ~0xC) | ((k & 4) << 1) | ((k & 8) >> 1); return ((kk >> 3) * 2 + (c >> 5)) * 512 + ((kk & 7) * 32 + (c & 31)) * 2; }
__device__ __forceinline__ int v_rd_base(int lane) { return ((lane & 3) << 3) | (((lane >> 2) & 3) << 6) | (((lane >> 4) & 1) << 5) | (((lane >> 5) & 1) << 8); }
constexpr int v_rd_off(int d0, int ks, int half) { return d0 * 512 + ks * 2048 + half * 1024; }
template <int OFF> __device__ __forceinline__ s16x4 tr_read(int vb) { s16x4 r; asm volatile("ds_read_b64_tr_b16 %0, %1 offset:%2" : "=&v"(r) : "v"(vb), "i"(OFF) : "memory"); return r; }
#define PKV(L, H) (bf16x8){L[0], L[1], L[2], L[3], H[0], H[1], H[2], H[3]}
template <int D0, int KOFF> __device__ __forceinline__ void pv_one(f32x16& od, int vb, bf16x8 pa0, bf16x8 pa1, bf16x8 pa2, bf16x8 pa3) {
    const s16x4 l0 = tr_read<KOFF + v_rd_off(D0, 0, 0)>(vb), h0 = tr_read<KOFF + v_rd_off(D0, 0, 1)>(vb), l1 = tr_read<KOFF + v_rd_off(D0, 1, 0)>(vb), h1 = tr_read<KOFF + v_rd_off(D0, 1, 1)>(vb);
    const s16x4 l2 = tr_read<KOFF + v_rd_off(D0, 2, 0)>(vb), h2 = tr_read<KOFF + v_rd_off(D0, 2, 1)>(vb), l3 = tr_read<KOFF + v_rd_off(D0, 3, 0)>(vb), h3 = tr_read<KOFF + v_rd_off(D0, 3, 1)>(vb);
    asm volatile("s_waitcnt lgkmcnt(0)" ::: "memory"); SBAR();
    od = __builtin_amdgcn_mfma_f32_32x32x16_bf16(pa0, PKV(l0, h0), od, 0, 0, 0);
    od = __builtin_amdgcn_mfma_f32_32x32x16_bf16(pa1, PKV(l1, h1), od, 0, 0, 0);
    od = __builtin_amdgcn_mfma_f32_32x32x16_bf16(pa2, PKV(l2, h2), od, 0, 0, 0);
    od = __builtin_amdgcn_mfma_f32_32x32x16_bf16(pa3, PKV(l3, h3), od, 0, 0, 0);
}
template <int D0, int KOFF> __device__ __forceinline__ void pv_half(f32x16& od, int vb, bf16x8 pa0, bf16x8 pa1) {
    const s16x4 l0 = tr_read<KOFF + v_rd_off(D0, 0, 0)>(vb), h0 = tr_read<KOFF + v_rd_off(D0, 0, 1)>(vb), l1 = tr_read<KOFF + v_rd_off(D0, 1, 0)>(vb), h1 = tr_read<KOFF + v_rd_off(D0, 1, 1)>(vb);
    asm volatile("s_waitcnt lgkmcnt(0)" ::: "memory"); SBAR();
    od = __builtin_amdgcn_mfma_f32_32x32x16_bf16(pa0, PKV(l0, h0), od, 0, 0, 0);
    od = __builtin_amdgcn_mfma_f32_32x32x16_bf16(pa1, PKV(l1, h1), od, 0, 0, 0);
}
template <class RowOff> __device__ __forceinline__ void store_o_tile(const f32x16 (&o)[2], const float (&rli)[16], unsigned short* stg, unsigned short* dst, RowOff row_off, int lane) {
    const int r32 = lane & 31, hi = lane >> 5;
#pragma unroll
    for (int r = 0; r < 16; ++r) { const int orow = crow(r, hi);
#pragma unroll
        for (int d0 = 0; d0 < 2; ++d0) stg[orow * 64 + d0 * 32 + r32] = (unsigned short)(cvtpk(o[d0][r] * rli[r], 0.f) & 0xffffu); }
    asm volatile("s_waitcnt lgkmcnt(0)" ::: "memory");
#pragma unroll
    for (int i = 0; i < 4; ++i) { const int row = i * 8 + (lane >> 3), ch = lane & 7; const u32x4 v = *(const u32x4*)(stg + row * 64 + ch * 8); *(u32x4*)(dst + row_off(row) + ch * 8) = v; }
    asm volatile("s_waitcnt lgkmcnt(0)" ::: "memory");
}

constexpr int SHM_V = 8192, SHM_K = 16384, MLA_WS = 2 * SHM_V + 2 * SHM_K, MLA_OST = MLA_WS + 8 * 256;
#define KSWZ(row, colB) ((row) * 256 + ((colB) ^ (((row) & 15) << 4)))
__device__ __forceinline__ void qkt96(f32x16& p0, f32x16& p1, const char* Ks, const bf16x8* qr, int r32, int hi) {
    p0 = f32x16{}; p1 = f32x16{};
#pragma unroll
    for (int d0 = 0; d0 < 6; ++d0) { const int cb = (d0 * 16 + hi * 8) * 2;
        const bf16x8 b0 = *reinterpret_cast<const bf16x8*>(Ks + KSWZ(r32, cb));
        const bf16x8 b1 = *reinterpret_cast<const bf16x8*>(Ks + KSWZ(32 + r32, cb));
        p0 = __builtin_amdgcn_mfma_f32_32x32x16_bf16(b0, qr[d0], p0, 0, 0, 0);
        p1 = __builtin_amdgcn_mfma_f32_32x32x16_bf16(b1, qr[d0], p1, 0, 0, 0); }
}
__device__ __forceinline__ void pv64(f32x16* o, int vb, bf16x8 pa0, bf16x8 pa1, bf16x8 pa2, bf16x8 pa3) {
    pv_one<0, 0>(o[0], vb, pa0, pa1, pa2, pa3); pv_one<1, 0>(o[1], vb, pa0, pa1, pa2, pa3);
}
__device__ __forceinline__ void mla_unit(int bh, int qb, const unsigned short* __restrict__ Q, const unsigned short* __restrict__ KN, const unsigned short* __restrict__ KR,
                                         const unsigned short* __restrict__ V, unsigned short* __restrict__ CAT, char* lds) {
    const int tid = threadIdx.x, wid = tid >> 6, lane = tid & 63, r32 = lane & 31, hi = lane >> 5;
    const int b = bh >> 3, h = bh & 7;
    char* V_lds = lds; char* K_lds = lds + 2 * SHM_V;
    float* wsf = (float*)(lds + MLA_WS) + wid * 64; float* li_l = wsf; float* al_l = wsf + 32;
    float m_reg = -1e30f, l_reg = 0; f32x16 o[2] = {}; bf16x8 qr[6];
    const size_t bhS = (size_t)bh * S; const int q0 = qb * 256;
    const unsigned short* Qw = Q + (bhS + q0 + wid * 32 + r32) * 96 + hi * 8;
#pragma unroll
    for (int d0 = 0; d0 < 6; ++d0) qr[d0] = *reinterpret_cast<const bf16x8*>(Qw + d0 * 16);
    const int srow = tid >> 3, sch = tid & 7, rrow = (tid & 255) >> 2, rch = tid & 3;
    const unsigned short* kn_src = KN + (bhS + srow) * 64 + sch * 8;
    const unsigned short* v_src = V + (bhS + srow) * 64 + sch * 8;
    const unsigned short* kr_src = KR + ((size_t)b * S + rrow) * 32 + rch * 8;
    const int kst = KSWZ(srow, sch * 16), krst = KSWZ(rrow, (8 + rch) * 16), vst = v_st(srow, sch * 8);
    const int vb0 = (int)(uintptr_t)V_lds + v_rd_base(lane);
    bf16x8 s_kn[2], s_kr[2], s_v[2];
#define SLOAD(i, k0) do { s_kn[i] = *reinterpret_cast<const bf16x8*>(kn_src + (size_t)(k0) * 64); s_kr[i] = *reinterpret_cast<const bf16x8*>(kr_src + (size_t)(k0) * 32); \
    s_v[i] = *reinterpret_cast<const bf16x8*>(v_src + (size_t)(k0) * 64); } while (0)
#define SWRITE(bb, i) do { *(bf16x8*)(K_lds + (bb) * SHM_K + kst) = s_kn[i]; if (tid < 256) *(bf16x8*)(K_lds + (bb) * SHM_K + krst) = s_kr[i]; *(bf16x8*)(V_lds + (bb) * SHM_V + vst) = s_v[i]; } while (0)
#define SWAIT() asm volatile("s_waitcnt vmcnt(3)" ::: "memory")
#define RESC(a) do { if (__any((a) < 1.f)) { if (hi == 0) al_l[r32] = (a); asm volatile("s_waitcnt lgkmcnt(0)" ::: "memory"); \
    _Pragma("unroll") for (int d = 0; d < 2; ++d) _Pragma("unroll") for (int r = 0; r < 16; ++r) o[d][r] *= al_l[crow(r, hi)]; } } while (0)
    f32x16 pA0, pA1, pB0, pB1; float mnA, mnB, alA, alB; bf16x8 pa0, pa1, pa2, pa3; constexpr int NT = S / 64;
    SLOAD(0, 0); asm volatile("s_waitcnt vmcnt(0)" ::: "memory"); SWRITE(0, 0); __syncthreads();
    qkt96(pA0, pA1, K_lds, qr, r32, hi); partialSM(pA0, pA1, m_reg, mnA, alA);
    SLOAD(1, 64); SLOAD(0, 128);
    SWAIT(); SWRITE(1, 1); __syncthreads();
    for (int j = 1; j + 1 < NT; j += 2) {
        SBAR(); qkt96(pB0, pB1, K_lds + SHM_K, qr, r32, hi);
        finishSM(pA0, pA1, alA, l_reg, pa0, pa1, pa2, pa3); SBAR();
        SLOAD(1, (j + 2) * 64); SBAR();
        pv64(o, vb0, pa0, pa1, pa2, pa3); partialSM(pB0, pB1, m_reg, mnB, alB);
        __syncthreads(); SWAIT(); SWRITE(0, 0);
        RESC(alB); __syncthreads();
        SBAR(); qkt96(pA0, pA1, K_lds, qr, r32, hi);
        finishSM(pB0, pB1, alB, l_reg, pa0, pa1, pa2, pa3); SBAR();
        if (j + 3 < NT) SLOAD(0, (j + 3) * 64); SBAR();
        pv64(o, vb0 + SHM_V, pa0, pa1, pa2, pa3); partialSM(pA0, pA1, m_reg, mnA, alA);
        __syncthreads(); SWAIT(); SWRITE(1, 1);
        RESC(alA); __syncthreads();
    }
    SBAR(); qkt96(pB0, pB1, K_lds + SHM_K, qr, r32, hi);
    finishSM(pA0, pA1, alA, l_reg, pa0, pa1, pa2, pa3); SBAR();
    pv64(o, vb0, pa0, pa1, pa2, pa3); partialSM(pB0, pB1, m_reg, mnB, alB);
    __syncthreads(); RESC(alB);
    finishSM(pB0, pB1, alB, l_reg, pa0, pa1, pa2, pa3); SBAR();
    pv64(o, vb0 + SHM_V, pa0, pa1, pa2, pa3);
    if (hi == 0) li_l[r32] = l_reg; asm volatile("s_waitcnt lgkmcnt(0)" ::: "memory");
    float rli[16];
#pragma unroll
    for (int r = 0; r < 16; ++r) rli[r] = __builtin_amdgcn_rcpf(li_l[crow(r, hi)]);
    unsigned short* stg = (unsigned short*)(lds + MLA_OST) + wid * 2048;
    unsigned short* dst = CAT + ((size_t)b * S + q0 + wid * 32) * 1024 + h * 64;
    store_o_tile(o, rli, stg, dst, [](int row) { return (size_t)row * 1024; }, lane);
    asm volatile("s_waitcnt vmcnt(0)" ::: "memory");
    __syncthreads();
#undef SLOAD
#undef SWRITE
#undef SWAIT
#undef RESC
}


constexpr int M2_K = 0, M2_V = 3 * SHM_K, M2_WS = M2_V + 3 * SHM_V, M2_OST = M2_WS + 8 * 256;
#ifndef MLA_PROBE_NOSTAGE
#define MLA_PROBE_NOSTAGE 0
#endif
#ifndef MLA_STATIC
#define MLA_STATIC 1
#endif
#ifndef MLA_STEP_MODE
#define MLA_STEP_MODE 0
#endif
#ifndef MLA_PROBE_VALU
#define MLA_PROBE_VALU 0
#endif
#ifndef MLA_NEGM
#define MLA_NEGM 1
#endif
#ifndef MLA_PRIO
#define MLA_PRIO 1
#endif
__device__ __forceinline__ void qkt96n(f32x16& p0, f32x16& p1, const char* Ks, const bf16x8* qr, const f32x16& negm, int r32, int hi) {
    if (MLA_PRIO) __builtin_amdgcn_s_setprio(1);
#pragma unroll
    for (int d0 = 0; d0 < 6; ++d0) { const int cb = (d0 * 16 + hi * 8) * 2;
        const bf16x8 b0 = *reinterpret_cast<const bf16x8*>(Ks + KSWZ(r32, cb));
        const bf16x8 b1 = *reinterpret_cast<const bf16x8*>(Ks + KSWZ(32 + r32, cb));
        if (d0 == 0) { p0 = __builtin_amdgcn_mfma_f32_32x32x16_bf16(b0, qr[0], MLA_NEGM ? negm : f32x16{}, 0, 0, 0); p1 = __builtin_amdgcn_mfma_f32_32x32x16_bf16(b1, qr[0], MLA_NEGM ? negm : f32x16{}, 0, 0, 0); }
        else { p0 = __builtin_amdgcn_mfma_f32_32x32x16_bf16(b0, qr[d0], p0, 0, 0, 0); p1 = __builtin_amdgcn_mfma_f32_32x32x16_bf16(b1, qr[d0], p1, 0, 0, 0); } }
    if (MLA_PRIO) __builtin_amdgcn_s_setprio(0);
}
__device__ __forceinline__ float rowmax32b(const f32x16& p0, const f32x16& p1) {
    float a = fmaxf(fmaxf(p0[0], p0[1]), p1[0]), b = fmaxf(fmaxf(p0[2], p0[3]), p1[1]); a = fmaxf(fmaxf(a, p1[2]), p1[3]);
#pragma unroll
    for (int r = 4; r < 16; r += 4) { a = fmaxf(fmaxf(a, p0[r]), p0[r + 1]); b = fmaxf(fmaxf(b, p0[r + 2]), p0[r + 3]); a = fmaxf(fmaxf(a, p1[r]), p1[r + 1]); b = fmaxf(fmaxf(b, p1[r + 2]), p1[r + 3]); }
    const float m = fmaxf(a, b);
    auto rr = __builtin_amdgcn_permlane32_swap(__float_as_uint(m), __float_as_uint(m), false, false);
    return fmaxf(__uint_as_float(rr[0]), __uint_as_float(rr[1]));
}
template <bool FIRST> __device__ __forceinline__ void partialSM2(f32x16& p0, f32x16& p1, float& m_reg, f32x16& negm, float& alpha, bool exact = true) {
    if (!exact) { alpha = 1.f;
#pragma unroll
        for (int r = 0; r < 16; ++r) p0[r] = __builtin_amdgcn_exp2f(p0[r]);
        return; }
    if (MLA_PROBE_VALU) { float d0_ = p1[0], d1_ = p1[1], d2_ = p1[2], d3_ = p1[3];
#pragma unroll
        for (int i = 0; i < 8; ++i) { d0_ = __builtin_amdgcn_exp2f(d0_); d1_ = __builtin_amdgcn_exp2f(d1_); d2_ = __builtin_amdgcn_exp2f(d2_); d3_ = __builtin_amdgcn_exp2f(d3_); }
        asm volatile("" :: "v"(d0_), "v"(d1_), "v"(d2_), "v"(d3_)); }
    if (!MLA_NEGM) {
        const float pm = rowmax32b(p0, p1); alpha = 1.f;
        if (FIRST) m_reg = pm; else if (!__builtin_expect(__all(pm - m_reg <= THR), 1)) { const float mn = fmaxf(m_reg, pm); alpha = __builtin_amdgcn_exp2f(m_reg - mn); m_reg = mn; }
#pragma unroll
        for (int r = 0; r < 16; ++r) { p0[r] -= m_reg; p1[r] -= m_reg; }
#pragma unroll
        for (int r = 0; r < 16; ++r) p0[r] = __builtin_amdgcn_exp2f(p0[r]);
        return; }
    const float pmax = rowmax32b(p0, p1);
    alpha = 1.f;
    if (FIRST || !__builtin_expect(__all(pmax <= THR), 1)) {
        const float dl = FIRST ? pmax : fmaxf(pmax, 0.f); m_reg += dl;
#pragma unroll
        for (int r = 0; r < 16; ++r) { p0[r] -= dl; p1[r] -= dl; }
#pragma unroll
        for (int r = 0; r < 16; ++r) negm[r] = -m_reg;
        if (!FIRST) alpha = __builtin_amdgcn_exp2f(-dl);
    }
#pragma unroll
    for (int r = 0; r < 16; ++r) p0[r] = __builtin_amdgcn_exp2f(p0[r]);
}
template <int D0> __device__ __forceinline__ void pv_one_p(f32x16& od, int vb, bf16x8 pa0, bf16x8 pa1, bf16x8 pa2, bf16x8 pa3) {
    const s16x4 l0 = tr_read<v_rd_off(D0, 0, 0)>(vb), h0 = tr_read<v_rd_off(D0, 0, 1)>(vb), l1 = tr_read<v_rd_off(D0, 1, 0)>(vb), h1 = tr_read<v_rd_off(D0, 1, 1)>(vb);
    const s16x4 l2 = tr_read<v_rd_off(D0, 2, 0)>(vb), h2 = tr_read<v_rd_off(D0, 2, 1)>(vb), l3 = tr_read<v_rd_off(D0, 3, 0)>(vb), h3 = tr_read<v_rd_off(D0, 3, 1)>(vb);
    asm volatile("s_waitcnt lgkmcnt(0)" ::: "memory"); SBAR();
    if (MLA_PRIO) __builtin_amdgcn_s_setprio(1);
    od = __builtin_amdgcn_mfma_f32_32x32x16_bf16(pa0, PKV(l0, h0), od, 0, 0, 0);
    od = __builtin_amdgcn_mfma_f32_32x32x16_bf16(pa1, PKV(l1, h1), od, 0, 0, 0);
    od = __builtin_amdgcn_mfma_f32_32x32x16_bf16(pa2, PKV(l2, h2), od, 0, 0, 0);
    od = __builtin_amdgcn_mfma_f32_32x32x16_bf16(pa3, PKV(l3, h3), od, 0, 0, 0);
    if (MLA_PRIO) __builtin_amdgcn_s_setprio(0);
}

__device__ __forceinline__ void kfrag_load(bf16x8 (&kf)[12], const char* Ks, int r32, int hi) {
#pragma unroll
    for (int d0 = 0; d0 < 6; ++d0) { const int cb = (d0 * 16 + hi * 8) * 2;
        kf[2 * d0] = *reinterpret_cast<const bf16x8*>(Ks + KSWZ(r32, cb)); kf[2 * d0 + 1] = *reinterpret_cast<const bf16x8*>(Ks + KSWZ(32 + r32, cb)); }
}
__device__ __forceinline__ void qk_mma(f32x16& p0, f32x16& p1, const bf16x8 (&kf)[12], const bf16x8* qr, const f32x16& negm) {
    if (MLA_PRIO) __builtin_amdgcn_s_setprio(1);
    p0 = __builtin_amdgcn_mfma_f32_32x32x16_bf16(kf[0], qr[0], MLA_NEGM ? negm : f32x16{}, 0, 0, 0); p1 = __builtin_amdgcn_mfma_f32_32x32x16_bf16(kf[1], qr[0], MLA_NEGM ? negm : f32x16{}, 0, 0, 0);
#pragma unroll
    for (int d0 = 1; d0 < 6; ++d0) { p0 = __builtin_amdgcn_mfma_f32_32x32x16_bf16(kf[2 * d0], qr[d0], p0, 0, 0, 0); p1 = __builtin_amdgcn_mfma_f32_32x32x16_bf16(kf[2 * d0 + 1], qr[d0], p1, 0, 0, 0); }
    if (MLA_PRIO) __builtin_amdgcn_s_setprio(0);
}
template <int D0> __device__ __forceinline__ void vfrag_load_h(s16x4 (&vl)[4], s16x4 (&vh)[4], int vb) {
    vl[0] = tr_read<v_rd_off(D0, 0, 0)>(vb); vh[0] = tr_read<v_rd_off(D0, 0, 1)>(vb); vl[1] = tr_read<v_rd_off(D0, 1, 0)>(vb); vh[1] = tr_read<v_rd_off(D0, 1, 1)>(vb);
    vl[2] = tr_read<v_rd_off(D0, 2, 0)>(vb); vh[2] = tr_read<v_rd_off(D0, 2, 1)>(vb); vl[3] = tr_read<v_rd_off(D0, 3, 0)>(vb); vh[3] = tr_read<v_rd_off(D0, 3, 1)>(vb);
}
__device__ __forceinline__ void pv_mma_h(f32x16& od, const s16x4 (&vl)[4], const s16x4 (&vh)[4], bf16x8 pa0, bf16x8 pa1, bf16x8 pa2, bf16x8 pa3) {
    if (MLA_PRIO) __builtin_amdgcn_s_setprio(1);
    od = __builtin_amdgcn_mfma_f32_32x32x16_bf16(pa0, PKV(vl[0], vh[0]), od, 0, 0, 0);
    od = __builtin_amdgcn_mfma_f32_32x32x16_bf16(pa1, PKV(vl[1], vh[1]), od, 0, 0, 0);
    od = __builtin_amdgcn_mfma_f32_32x32x16_bf16(pa2, PKV(vl[2], vh[2]), od, 0, 0, 0);
    od = __builtin_amdgcn_mfma_f32_32x32x16_bf16(pa3, PKV(vl[3], vh[3]), od, 0, 0, 0);
    if (MLA_PRIO) __builtin_amdgcn_s_setprio(0);
}
#if MLA_STEP_MODE == 0
#define MLA_STEP(PC0, PC1, PP0, PP1, ALP, ALC) do { \
    qkt96n(PC0, PC1, K_lds + sc * SHM_K, qr, negm, r32, hi); \
    finishSM(PP0, PP1, ALP, l_reg, pa0, pa1, pa2, pa3); SBAR(); \
    { const int vb_ = vb0 + sp * SHM_V; pv_one_p<0>(o[0], vb_, pa0, pa1, pa2, pa3); pv_one_p<1>(o[1], vb_, pa0, pa1, pa2, pa3); } \
    partialSM2<false>(PC0, PC1, m_reg, negm, ALC, exact); RESC(ALC); } while (0)
#elif MLA_STEP_MODE == 2
  \
#define SGB(mask, n) __builtin_amdgcn_sched_group_barrier(mask, n, 0)
#define MLA_STEP(PC0, PC1, PP0, PP1, ALP, ALC) do { \
    { const char* Ks_ = K_lds + sc * SHM_K; \
      _Pragma("unroll") for (int d0 = 0; d0 < 6; ++d0) { const int cb = (d0 * 16 + hi * 8) * 2; \
        const bf16x8 b0 = *reinterpret_cast<const bf16x8*>(Ks_ + KSWZ(r32, cb)); const bf16x8 b1 = *reinterpret_cast<const bf16x8*>(Ks_ + KSWZ(32 + r32, cb)); \
        if (d0 == 0) { PC0 = __builtin_amdgcn_mfma_f32_32x32x16_bf16(b0, qr[0], negm, 0, 0, 0); PC1 = __builtin_amdgcn_mfma_f32_32x32x16_bf16(b1, qr[0], negm, 0, 0, 0); } \
        else { PC0 = __builtin_amdgcn_mfma_f32_32x32x16_bf16(b0, qr[d0], PC0, 0, 0, 0); PC1 = __builtin_amdgcn_mfma_f32_32x32x16_bf16(b1, qr[d0], PC1, 0, 0, 0); } } } \
    finishSM(PP0, PP1, ALP, l_reg, pa0, pa1, pa2, pa3); \
    SGB(0x100, 4); \
    _Pragma("unroll") for (int g_ = 0; g_ < 12; ++g_) { SGB(0x008, 1); SGB(0x100, 1); SGB(0x002, 7); } \
    SBAR(); \
    { const int vb_ = vb0 + sp * SHM_V; \
      const s16x4 l0 = tr_read<v_rd_off(0, 0, 0)>(vb_), h0 = tr_read<v_rd_off(0, 0, 1)>(vb_), l1 = tr_read<v_rd_off(0, 1, 0)>(vb_), h1 = tr_read<v_rd_off(0, 1, 1)>(vb_); \
      const s16x4 l2 = tr_read<v_rd_off(0, 2, 0)>(vb_), h2 = tr_read<v_rd_off(0, 2, 1)>(vb_), l3 = tr_read<v_rd_off(0, 3, 0)>(vb_), h3 = tr_read<v_rd_off(0, 3, 1)>(vb_); \
      const s16x4 l4 = tr_read<v_rd_off(1, 0, 0)>(vb_), h4 = tr_read<v_rd_off(1, 0, 1)>(vb_), l5 = tr_read<v_rd_off(1, 1, 0)>(vb_), h5 = tr_read<v_rd_off(1, 1, 1)>(vb_); \
      const s16x4 l6 = tr_read<v_rd_off(1, 2, 0)>(vb_), h6 = tr_read<v_rd_off(1, 2, 1)>(vb_), l7 = tr_read<v_rd_off(1, 3, 0)>(vb_), h7 = tr_read<v_rd_off(1, 3, 1)>(vb_); \
      asm volatile("s_waitcnt lgkmcnt(0)" ::: "memory"); SBAR(); \
      o[0] = __builtin_amdgcn_mfma_f32_32x32x16_bf16(pa0, PKV(l0, h0), o[0], 0, 0, 0); o[1] = __builtin_amdgcn_mfma_f32_32x32x16_bf16(pa0, PKV(l4, h4), o[1], 0, 0, 0); \
      o[0] = __builtin_amdgcn_mfma_f32_32x32x16_bf16(pa1, PKV(l1, h1), o[0], 0, 0, 0); o[1] = __builtin_amdgcn_mfma_f32_32x32x16_bf16(pa1, PKV(l5, h5), o[1], 0, 0, 0); \
      o[0] = __builtin_amdgcn_mfma_f32_32x32x16_bf16(pa2, PKV(l2, h2), o[0], 0, 0, 0); o[1] = __builtin_amdgcn_mfma_f32_32x32x16_bf16(pa2, PKV(l6, h6), o[1], 0, 0, 0); \
      o[0] = __builtin_amdgcn_mfma_f32_32x32x16_bf16(pa3, PKV(l3, h3), o[0], 0, 0, 0); o[1] = __builtin_amdgcn_mfma_f32_32x32x16_bf16(pa3, PKV(l7, h7), o[1], 0, 0, 0); \
      partialSM2<false>(PC0, PC1, m_reg, negm, ALC, exact); \
      _Pragma("unroll") for (int g_ = 0; g_ < 8; ++g_) { SGB(0x008, 1); SGB(0x002, 2); } \
      SBAR(); } \
    RESC(ALC); } while (0)
#else
#define MLA_STEP(PC0, PC1, PP0, PP1, ALP, ALC) do { \
    bf16x8 kf[12]; s16x4 val[4], vah[4], vbl[4], vbh[4]; const int vb_ = vb0 + sp * SHM_V; \
    kfrag_load(kf, K_lds + sc * SHM_K, r32, hi); SBAR(); \
    finishSM(PP0, PP1, ALP, l_reg, pa0, pa1, pa2, pa3); SBAR(); \
    vfrag_load_h<0>(val, vah, vb_); SBAR(); \
    qk_mma(PC0, PC1, kf, qr, negm); SBAR(); \
    vfrag_load_h<1>(vbl, vbh, vb_); SBAR(); \
    asm volatile("s_waitcnt lgkmcnt(8)" ::: "memory"); SBAR(); \
    pv_mma_h(o[0], val, vah, pa0, pa1, pa2, pa3); SBAR(); \
    asm volatile("s_waitcnt lgkmcnt(0)" ::: "memory"); SBAR(); \
    pv_mma_h(o[1], vbl, vbh, pa0, pa1, pa2, pa3); SBAR(); \
    partialSM2<false>(PC0, PC1, m_reg, negm, ALC); RESC(ALC); } while (0)
#endif

__device__ __forceinline__ void mla_unit_v2(int bh, int qb, const unsigned short* __restrict__ Q, const unsigned short* __restrict__ KN, const unsigned short* __restrict__ KR,
                                            const unsigned short* __restrict__ V, unsigned short* __restrict__ CAT, const float* __restrict__ KMX, char* lds) {
    const int tid = threadIdx.x, wid = tid >> 6, lane = tid & 63, r32 = lane & 31, hi = lane >> 5;
    const int b = bh >> 3, h = bh & 7;
    char* K_lds = lds + M2_K; char* V_lds = lds + M2_V;
    float* wsf = (float*)(lds + M2_WS) + wid * 64; float* li_l = wsf; float* al_l = wsf + 32;
    float m_reg = 0.f, l_reg = 0; f32x16 o[2] = {}; bf16x8 qr[6]; f32x16 negm = f32x16{};
    const size_t bhS = (size_t)bh * S; const int q0 = qb * 256;
    const unsigned short* Qw = Q + (bhS + q0 + wid * 32 + r32) * 96 + hi * 8;
#pragma unroll
    for (int d0 = 0; d0 < 6; ++d0) qr[d0] = *reinterpret_cast<const bf16x8*>(Qw + d0 * 16);
    bool exact = true;
    if (MLA_STATIC) { float q2 = 0.f;
#pragma unroll
      for (int d0 = 0; d0 < 6; ++d0)
#pragma unroll
          for (int j = 0; j < 8; ++j) { const float x = __uint_as_float((unsigned)(unsigned short)qr[d0][j] << 16); q2 += x * x; }
      { auto rr = __builtin_amdgcn_permlane32_swap(__float_as_uint(q2), __float_as_uint(q2), false, false); q2 = __uint_as_float(rr[0]) + __uint_as_float(rr[1]); }
      const float k2 = KMX[(b * 8 + h) * 2] + KMX[(b * 8 + h) * 2 + 1] + KMX[32 + b];
      const float ms = 1.01f * sqrtf(q2 * k2);
      exact = __syncthreads_or(!(ms <= 60.f)) != 0;
      if (!exact) { m_reg = ms;
#pragma unroll
          for (int r = 0; r < 16; ++r) negm[r] = -ms; } }
    const int srow = tid >> 3, sch = tid & 7, rrow = (tid & 255) >> 2, rch = tid & 3;
    const char* kn_u = (const char*)(KN + bhS * 64); const char* v_u = (const char*)(V + bhS * 64); const char* kr_u = (const char*)(KR + (size_t)b * S * 32);
    const unsigned kn_off = (unsigned)(srow * 64 + sch * 8) * 2u, kr_off = (unsigned)(rrow * 32 + rch * 8) * 2u;
    const int kst = KSWZ(srow, sch * 16), krst = KSWZ(rrow, (8 + rch) * 16), vst = v_st(srow, sch * 8);
    const int vb0 = (int)(uintptr_t)V_lds + v_rd_base(lane);
    bf16x8 s_kn[1], s_kr[1], s_v[1];
#define SLOAD(i, t) do { s_kn[i] = *reinterpret_cast<const bf16x8*>(kn_u + (size_t)(t) * 8192 + kn_off); s_kr[i] = *reinterpret_cast<const bf16x8*>(kr_u + (size_t)(t) * 4096 + kr_off); \
    s_v[i] = *reinterpret_cast<const bf16x8*>(v_u + (size_t)(t) * 8192 + kn_off); } while (0)
#define SWRITE(sl, i) do { *(bf16x8*)(K_lds + (sl) * SHM_K + kst) = s_kn[i]; if (tid < 256) *(bf16x8*)(K_lds + (sl) * SHM_K + krst) = s_kr[i]; *(bf16x8*)(V_lds + (sl) * SHM_V + vst) = s_v[i]; } while (0)
#define SWAIT() asm volatile("s_waitcnt vmcnt(0)" ::: "memory")
#define RESC(a) do { if (exact && __any((a) < 1.f)) { if (hi == 0) al_l[r32] = (a); asm volatile("s_waitcnt lgkmcnt(0)" ::: "memory"); \
    _Pragma("unroll") for (int d = 0; d < 2; ++d) _Pragma("unroll") for (int r = 0; r < 16; ++r) o[d][r] *= al_l[crow(r, hi)]; } } while (0)
#define ROT3(x) ((x) == 2 ? 0 : (x) + 1)
    f32x16 pA0, pA1, pB0, pB1; float alA, alB; bf16x8 pa0, pa1, pa2, pa3; constexpr int NT = S / 64;
    SLOAD(0, 0);
    SWAIT(); SWRITE(0, 0); SLOAD(0, 1);
    __syncthreads();
    qkt96n(pA0, pA1, K_lds, qr, negm, r32, hi); if (exact) partialSM2<true>(pA0, pA1, m_reg, negm, alA); else partialSM2<false>(pA0, pA1, m_reg, negm, alA, false);
    SWAIT(); SWRITE(1, 0); SLOAD(0, 2);
    __syncthreads();
    int sp = 0, sc = 1, sn = 2;
    for (int j = 1; j + 1 < NT; j += 2) {
        if (!MLA_PROBE_NOSTAGE) { SWAIT(); SWRITE(sn, 0); if (j + 2 < NT) SLOAD(0, j + 2); }
        SBAR(); MLA_STEP(pB0, pB1, pA0, pA1, alA, alB);
        __syncthreads();
        sp = sc; sc = sn; sn = ROT3(sn);
        if (!MLA_PROBE_NOSTAGE) { SWAIT(); SWRITE(sn, 0); if (j + 3 < NT) SLOAD(0, j + 3); }
        SBAR(); MLA_STEP(pA0, pA1, pB0, pB1, alB, alA);
        __syncthreads();
        sp = sc; sc = sn; sn = ROT3(sn);
    }
    SBAR(); MLA_STEP(pB0, pB1, pA0, pA1, alA, alB);
    finishSM(pB0, pB1, alB, l_reg, pa0, pa1, pa2, pa3); SBAR();
    { const int vb = vb0 + sc * SHM_V; pv_one_p<0>(o[0], vb, pa0, pa1, pa2, pa3); pv_one_p<1>(o[1], vb, pa0, pa1, pa2, pa3); }
    if (hi == 0) li_l[r32] = l_reg; asm volatile("s_waitcnt lgkmcnt(0)" ::: "memory");
    float rli[16];
#pragma unroll
    for (int r = 0; r < 16; ++r) rli[r] = __builtin_amdgcn_rcpf(li_l[crow(r, hi)]);
    unsigned short* stg = (unsigned short*)(lds + M2_OST) + wid * 2048;
    unsigned short* dst = CAT + ((size_t)b * S + q0 + wid * 32) * 1024 + h * 64;
    store_o_tile(o, rli, stg, dst, [](int row) { return (size_t)row * 1024; }, lane);
    asm volatile("s_waitcnt vmcnt(0)" ::: "memory");
    __syncthreads();
#undef SLOAD
#undef SWRITE
#undef SWAIT
#undef RESC
#undef ROT3
}


__device__ __forceinline__ void finishSM_s(f32x16& p0, f32x16& p1, float& l_reg, bf16x8& pa0, bf16x8& pa1, bf16x8& pa2, bf16x8& pa3) {
#pragma unroll
    for (int r = 0; r < 16; ++r) p1[r] = __builtin_amdgcn_exp2f(p1[r]);
    float ps = 0;
#pragma unroll
    for (int r = 0; r < 16; ++r) ps += p0[r];
#pragma unroll
    for (int r = 0; r < 16; ++r) ps += p1[r];
    l_reg += ps;
    PK4(p0, 0, pa0); PK4(p0, 8, pa1); PK4(p1, 0, pa2); PK4(p1, 8, pa3);
}
__device__ __forceinline__ void exp_half(f32x16& p0) {
#pragma unroll
    for (int r = 0; r < 16; ++r) p0[r] = __builtin_amdgcn_exp2f(p0[r]);
}
__device__ __forceinline__ bool mla_unit_v5(int bh, int qb, const unsigned short* __restrict__ Q, const unsigned short* __restrict__ KN, const unsigned short* __restrict__ KR,
                                            const unsigned short* __restrict__ V, unsigned short* __restrict__ CAT, const float* __restrict__ KMX, char* lds) {
    const int tid = threadIdx.x, wid = tid >> 6, lane = tid & 63, r32 = lane & 31, hi = lane >> 5;
    const int b = bh >> 3, h = bh & 7;
    char* K_lds = lds + M2_K; char* V_lds = lds + M2_V;
    float* wsf = (float*)(lds + M2_WS) + wid * 64; float* li_l = wsf;
    float l_reg = 0; f32x16 o[2] = {}; bf16x8 qr[6];
    const size_t bhS = (size_t)bh * S; const int q0 = qb * 256;
    const unsigned short* Qw = Q + (bhS + q0 + wid * 32 + r32) * 96 + hi * 8;
#pragma unroll
    for (int d0 = 0; d0 < 6; ++d0) qr[d0] = *reinterpret_cast<const bf16x8*>(Qw + d0 * 16);
    f32x16 negm;
    { float q2 = 0.f;
#pragma unroll
      for (int d0 = 0; d0 < 6; ++d0)
#pragma unroll
          for (int j = 0; j < 8; ++j) { const float x = __uint_as_float((unsigned)(unsigned short)qr[d0][j] << 16); q2 += x * x; }
      { auto rr = __builtin_amdgcn_permlane32_swap(__float_as_uint(q2), __float_as_uint(q2), false, false); q2 = __uint_as_float(rr[0]) + __uint_as_float(rr[1]); }
      const float k2 = KMX[(b * 8 + h) * 2] + KMX[(b * 8 + h) * 2 + 1] + KMX[32 + b];
      const float m = 1.01f * sqrtf(q2 * k2);
#pragma unroll
      for (int r = 0; r < 16; ++r) negm[r] = -m; }
    const int srow = tid >> 3, sch = tid & 7, rrow = (tid & 255) >> 2, rch = tid & 3;
    const char* kn_u = (const char*)(KN + bhS * 64); const char* v_u = (const char*)(V + bhS * 64); const char* kr_u = (const char*)(KR + (size_t)b * S * 32);
    const unsigned kn_off = (unsigned)(srow * 64 + sch * 8) * 2u, kr_off = (unsigned)(rrow * 32 + rch * 8) * 2u;
    const int kst = KSWZ(srow, sch * 16), krst = KSWZ(rrow, (8 + rch) * 16), vst = v_st(srow, sch * 8);
    const int vb0 = (int)(uintptr_t)V_lds + v_rd_base(lane);
    bf16x8 s_kn, s_kr, s_v;
#define SLOAD(t) do { s_kn = *reinterpret_cast<const bf16x8*>(kn_u + (size_t)(t) * 8192 + kn_off); s_kr = *reinterpret_cast<const bf16x8*>(kr_u + (size_t)(t) * 4096 + kr_off); \
    s_v = *reinterpret_cast<const bf16x8*>(v_u + (size_t)(t) * 8192 + kn_off); } while (0)
#define SWRITE(sl) do { *(bf16x8*)(K_lds + (sl) * SHM_K + kst) = s_kn; if (tid < 256) *(bf16x8*)(K_lds + (sl) * SHM_K + krst) = s_kr; *(bf16x8*)(V_lds + (sl) * SHM_V + vst) = s_v; } while (0)
#define SWAIT() asm volatile("s_waitcnt vmcnt(0)" ::: "memory")
#define ROT3(x) ((x) == 2 ? 0 : (x) + 1)
#define STEP5(PC0, PC1, PP0, PP1) do { \
    qkt96n(PC0, PC1, K_lds + sc * SHM_K, qr, negm, r32, hi); \
    finishSM_s(PP0, PP1, l_reg, pa0, pa1, pa2, pa3); SBAR(); \
    { const int vb_ = vb0 + sp * SHM_V; pv_one_p<0>(o[0], vb_, pa0, pa1, pa2, pa3); pv_one_p<1>(o[1], vb_, pa0, pa1, pa2, pa3); } \
    exp_half(PC0); } while (0)
    f32x16 pA0, pA1, pB0, pB1; bf16x8 pa0, pa1, pa2, pa3; constexpr int NT = S / 64;
    SLOAD(0);
    SWAIT(); SWRITE(0); SLOAD(1);
    __syncthreads();
    qkt96n(pA0, pA1, K_lds, qr, negm, r32, hi); exp_half(pA0);
    SWAIT(); SWRITE(1); SLOAD(2);
    __syncthreads();
    int sp = 0, sc = 1, sn = 2;
    for (int j = 1; j + 1 < NT; j += 2) {
        SWAIT(); SWRITE(sn); if (j + 2 < NT) SLOAD(j + 2);
        SBAR(); STEP5(pB0, pB1, pA0, pA1);
        __syncthreads();
        sp = sc; sc = sn; sn = ROT3(sn);
        SWAIT(); SWRITE(sn); if (j + 3 < NT) SLOAD(j + 3);
        SBAR(); STEP5(pA0, pA1, pB0, pB1);
        __syncthreads();
        sp = sc; sc = sn; sn = ROT3(sn);
    }
    SBAR(); STEP5(pB0, pB1, pA0, pA1);
    finishSM_s(pB0, pB1, l_reg, pa0, pa1, pa2, pa3); SBAR();
    { const int vb = vb0 + sc * SHM_V; pv_one_p<0>(o[0], vb, pa0, pa1, pa2, pa3); pv_one_p<1>(o[1], vb, pa0, pa1, pa2, pa3); }
    { auto rr = __builtin_amdgcn_permlane32_swap(__float_as_uint(l_reg), __float_as_uint(l_reg), false, false); l_reg = __uint_as_float(rr[0]) + __uint_as_float(rr[1]); }
    const bool bad = !(l_reg > 1e-30f);
    if (hi == 0) li_l[r32] = l_reg; asm volatile("s_waitcnt lgkmcnt(0)" ::: "memory");
    float rli[16];
#pragma unroll
    for (int r = 0; r < 16; ++r) rli[r] = __builtin_amdgcn_rcpf(li_l[crow(r, hi)]);
    unsigned short* stg = (unsigned short*)(lds + M2_OST) + wid * 2048;
    unsigned short* dst = CAT + ((size_t)b * S + q0 + wid * 32) * 1024 + h * 64;
    store_o_tile(o, rli, stg, dst, [](int row) { return (size_t)row * 1024; }, lane);
    asm volatile("s_waitcnt vmcnt(0)" ::: "memory");
    const int anybad = __syncthreads_or(bad ? 1 : 0);
    return anybad != 0;
#undef SLOAD
#undef SWRITE
#undef SWAIT
#undef ROT3
#undef STEP5
}

constexpr int M4_K = 0, M4_V = 4 * SHM_K, M4_WS = M4_V + 4 * SHM_V, M4_OST = M4_WS + 8 * 256;
template <bool FIRST> __device__ __forceinline__ void softmax_full(f32x16& p0, f32x16& p1, float& m_reg, f32x16& negm, float& l_reg, float& alpha, bf16x8& pa0, bf16x8& pa1, bf16x8& pa2, bf16x8& pa3) {
    partialSM2<FIRST>(p0, p1, m_reg, negm, alpha);
    finishSM(p0, p1, alpha, l_reg, pa0, pa1, pa2, pa3);
}
__device__ __forceinline__ void mla_unit_v4(int bh, int qb, const unsigned short* __restrict__ Q, const unsigned short* __restrict__ KN, const unsigned short* __restrict__ KR,
                                            const unsigned short* __restrict__ V, unsigned short* __restrict__ CAT, char* lds) {
    const int tid = threadIdx.x, wid = __builtin_amdgcn_readfirstlane(tid >> 6), lane = tid & 63, r32 = lane & 31, hi = lane >> 5;
    const int b = bh >> 3, h = bh & 7; const bool halfB = wid >= 4;
    char* K_lds = lds + M4_K; char* V_lds = lds + M4_V;
    float* wsf = (float*)(lds + M4_WS) + wid * 64; float* li_l = wsf; float* al_l = wsf + 32;
    float m_reg = 0.f, l_reg = 0; f32x16 o[2] = {}; bf16x8 qr[6]; f32x16 negm = f32x16{};
    const size_t bhS = (size_t)bh * S; const int q0 = qb * 256;
    const unsigned short* Qw = Q + (bhS + q0 + wid * 32 + r32) * 96 + hi * 8;
#pragma unroll
    for (int d0 = 0; d0 < 6; ++d0) qr[d0] = *reinterpret_cast<const bf16x8*>(Qw + d0 * 16);
    const int srow = tid >> 3, sch = tid & 7, rrow = (tid & 255) >> 2, rch = tid & 3;
    const char* kn_u = (const char*)(KN + bhS * 64); const char* v_u = (const char*)(V + bhS * 64); const char* kr_u = (const char*)(KR + (size_t)b * S * 32);
    const unsigned kn_off = (unsigned)(srow * 64 + sch * 8) * 2u, kr_off = (unsigned)(rrow * 32 + rch * 8) * 2u;
    const int kst = KSWZ(srow, sch * 16), krst = KSWZ(rrow, (8 + rch) * 16), vst = v_st(srow, sch * 8);
    const int vb0 = (int)(uintptr_t)V_lds + v_rd_base(lane);
    bf16x8 s_kn, s_kr, s_v;
#define SLOAD(t) do { s_kn = *reinterpret_cast<const bf16x8*>(kn_u + (size_t)(t) * 8192 + kn_off); s_kr = *reinterpret_cast<const bf16x8*>(kr_u + (size_t)(t) * 4096 + kr_off); \
    s_v = *reinterpret_cast<const bf16x8*>(v_u + (size_t)(t) * 8192 + kn_off); } while (0)
#define SWRITE(sl) do { *(bf16x8*)(K_lds + (sl) * SHM_K + kst) = s_kn; if (tid < 256) *(bf16x8*)(K_lds + (sl) * SHM_K + krst) = s_kr; *(bf16x8*)(V_lds + (sl) * SHM_V + vst) = s_v; } while (0)
#define SWAIT() asm volatile("s_waitcnt vmcnt(0)" ::: "memory")
#define RESC(a) do { if (__any((a) < 1.f)) { if (hi == 0) al_l[r32] = (a); asm volatile("s_waitcnt lgkmcnt(0)" ::: "memory"); \
    _Pragma("unroll") for (int d = 0; d < 2; ++d) _Pragma("unroll") for (int r = 0; r < 16; ++r) o[d][r] *= al_l[crow(r, hi)]; } } while (0)
#define RAWBAR() do { asm volatile("" ::: "memory"); __builtin_amdgcn_s_barrier(); asm volatile("" ::: "memory"); } while (0)
    f32x16 p0, p1; float al; bf16x8 pa0, pa1, pa2, pa3; bf16x8 kf[12]; constexpr int NT = S / 64;
    SLOAD(0); SWAIT(); SWRITE(0); SLOAD(1); SWAIT(); SWRITE(1); SLOAD(2);
    asm volatile("s_waitcnt lgkmcnt(0)" ::: "memory"); RAWBAR();
    if (halfB) RAWBAR();
    kfrag_load(kf, K_lds, r32, hi); SBAR();
    qk_mma(p0, p1, kf, qr, negm); SBAR();
    asm volatile("s_waitcnt lgkmcnt(0)" ::: "memory"); RAWBAR();
    softmax_full<true>(p0, p1, m_reg, negm, l_reg, al, pa0, pa1, pa2, pa3); SBAR();
    SWAIT(); SWRITE(2); SLOAD(3); SBAR();
    kfrag_load(kf, K_lds + SHM_K, r32, hi); SBAR();
    asm volatile("s_waitcnt lgkmcnt(12)" ::: "memory"); RAWBAR();
    int sp = 0, sc = 1, sw = 3;
    for (int t = 1; t < NT; ++t) {
        { s16x4 val[4], vah[4], vbl[4], vbh[4]; const int vb_ = vb0 + sp * SHM_V;
          vfrag_load_h<0>(val, vah, vb_); SBAR();
          qk_mma(p0, p1, kf, qr, negm); SBAR();
          vfrag_load_h<1>(vbl, vbh, vb_); SBAR();
          asm volatile("s_waitcnt lgkmcnt(8)" ::: "memory"); SBAR();
          pv_mma_h(o[0], val, vah, pa0, pa1, pa2, pa3); SBAR();
          asm volatile("s_waitcnt lgkmcnt(0)" ::: "memory"); SBAR();
          pv_mma_h(o[1], vbl, vbh, pa0, pa1, pa2, pa3); SBAR(); }
        RAWBAR();
        if (t + 2 < NT) { SWAIT(); SWRITE(sw); if (t + 3 < NT) SLOAD(t + 3); } SBAR();
        softmax_full<false>(p0, p1, m_reg, negm, l_reg, al, pa0, pa1, pa2, pa3); RESC(al); SBAR();
        sp = sc; sc = (sc + 1) & 3; sw = (sw + 1) & 3;
        if (t + 1 < NT) { kfrag_load(kf, K_lds + sc * SHM_K, r32, hi); SBAR(); }
        asm volatile("s_waitcnt lgkmcnt(12)" ::: "memory"); RAWBAR();
    }
    { s16x4 val[4], vah[4], vbl[4], vbh[4]; const int vb_ = vb0 + sp * SHM_V;
      vfrag_load_h<0>(val, vah, vb_); vfrag_load_h<1>(vbl, vbh, vb_); SBAR();
      asm volatile("s_waitcnt lgkmcnt(0)" ::: "memory"); SBAR();
      pv_mma_h(o[0], val, vah, pa0, pa1, pa2, pa3); pv_mma_h(o[1], vbl, vbh, pa0, pa1, pa2, pa3); SBAR(); }
    if (!halfB) RAWBAR();
    if (hi == 0) li_l[r32] = l_reg; asm volatile("s_waitcnt lgkmcnt(0)" ::: "memory");
    float rli[16];
#pragma unroll
    for (int r = 0; r < 16; ++r) rli[r] = __builtin_amdgcn_rcpf(li_l[crow(r, hi)]);
    unsigned short* stg = (unsigned short*)(lds + M4_OST) + wid * 2048;
    unsigned short* dst = CAT + ((size_t)b * S + q0 + wid * 32) * 1024 + h * 64;
    store_o_tile(o, rli, stg, dst, [](int row) { return (size_t)row * 1024; }, lane);
    asm volatile("s_waitcnt vmcnt(0)" ::: "memory");
    __syncthreads();
#undef SLOAD
#undef SWRITE
#undef SWAIT
#undef RESC
#undef RAWBAR
}

constexpr int DL_K = 0, DL_V = 49152, DL_WS = 98304, DL_OST = DL_WS + 8 * 256;
#define KSWZD(row, colB) ((row) * 128 + ((colB) ^ ((((row) >> 1) & 7) << 4)))
__device__ __forceinline__ void dil_unit(int bh, int br, int blk, const unsigned short* __restrict__ DQ, const unsigned short* __restrict__ DK, const unsigned short* __restrict__ DV,
                                         unsigned short* __restrict__ OBR, float* __restrict__ LSE, char* lds) {
    const int tid = threadIdx.x, wid = tid >> 6, lane = tid & 63, r32 = lane & 31, hi = lane >> 5;
    const int sh = 2 * br, dil = 1 << sh, L = S >> sh, nbl = L >> 8, res = blk / nbl, lb = blk % nbl;
    const size_t bhS = (size_t)bh * S; const int b = bh >> 3, h = bh & 7;
    char* K_lds = lds + DL_K; char* V_lds = lds + DL_V;
#pragma unroll
    for (int half = 0; half < 2; ++half) {
        bf16x8 kk[3], vv[3];
#pragma unroll
        for (int it = 0; it < 3; ++it) { const int item = (half * 3 + it) * 512 + tid, row = item >> 3, ch = item & 7; const int l = 256 * lb - 64 + row; const bool valid = (l >= 0) && (l < L);
            const size_t src = (bhS + (valid ? ((size_t)l << sh) + res : 0)) * 64 + ch * 8;
            kk[it] = *reinterpret_cast<const bf16x8*>(DK + src); vv[it] = *reinterpret_cast<const bf16x8*>(DV + src);
            if (!valid) { kk[it] = bf16x8{}; vv[it] = bf16x8{}; } }
#pragma unroll
        for (int it = 0; it < 3; ++it) { const int item = (half * 3 + it) * 512 + tid, row = item >> 3, ch = item & 7;
            *(bf16x8*)(K_lds + KSWZD(row, ch * 16)) = kk[it]; *(bf16x8*)(V_lds + (row >> 4) * 2048 + v_st(row & 15, ch * 8)) = vv[it]; }
    }
    bf16x8 qr[4];
    const int ql = wid * 32 + r32; const size_t qpos = ((size_t)(256 * lb + ql) << sh) + res;
    const unsigned short* Qw = DQ + (bhS + qpos) * 64 + hi * 8;
#pragma unroll
    for (int d0 = 0; d0 < 4; ++d0) qr[d0] = *reinterpret_cast<const bf16x8*>(Qw + d0 * 16);
    __syncthreads();
    f32x16 p[5];
#pragma unroll
    for (int j = 0; j < 5; ++j) { p[j] = f32x16{}; const int row = wid * 32 + j * 32 + r32;
#pragma unroll
        for (int d0 = 0; d0 < 4; ++d0) { const bf16x8 kf = *reinterpret_cast<const bf16x8*>(K_lds + KSWZD(row, (d0 * 16 + hi * 8) * 2)); p[j] = __builtin_amdgcn_mfma_f32_32x32x16_bf16(kf, qr[d0], p[j], 0, 0, 0); } }
    const float NEG = -1e30f;
    const int klo = 64 - 256 * lb, khi = L + 64 - 256 * lb;
#pragma unroll
    for (int j = 0; j < 5; ++j)
#pragma unroll
        for (int r = 0; r < 16; ++r) { const int kk = crow(r, hi); const int kl = wid * 32 + j * 32 + kk; bool ok = (kl >= klo) && (kl < khi);
            if (j == 0) ok = ok && (kk >= r32); if (j == 4) ok = ok && (kk <= r32); if (!ok) p[j][r] = NEG; }
    float mx = rowmax32(p[0], p[1]); mx = fmaxf(mx, rowmax32(p[2], p[3]));
    { float m4 = p[4][0];
#pragma unroll
      for (int r = 1; r < 16; ++r) m4 = fmaxf(m4, p[4][r]);
      auto rr = __builtin_amdgcn_permlane32_swap(__float_as_uint(m4), __float_as_uint(m4), false, false); mx = fmaxf(mx, fmaxf(__uint_as_float(rr[0]), __uint_as_float(rr[1]))); }
    float ps = 0.f;
#pragma unroll
    for (int j = 0; j < 5; ++j)
#pragma unroll
        for (int r = 0; r < 16; ++r) { p[j][r] = __builtin_amdgcn_exp2f(p[j][r] - mx); ps += p[j][r]; }
    { auto rr = __builtin_amdgcn_permlane32_swap(__float_as_uint(ps), __float_as_uint(ps), false, false); ps = __uint_as_float(rr[0]) + __uint_as_float(rr[1]); }
    bf16x8 pa[5][2];
#pragma unroll
    for (int j = 0; j < 5; ++j) { PK4(p[j], 0, pa[j][0]); PK4(p[j], 8, pa[j][1]); }
    f32x16 o[2] = {};
    const int vb = (int)(uintptr_t)V_lds + v_rd_base(lane) + wid * 4096;
    pv_half<0, 0 * 4096>(o[0], vb, pa[0][0], pa[0][1]); pv_half<1, 0 * 4096>(o[1], vb, pa[0][0], pa[0][1]);
    pv_half<0, 1 * 4096>(o[0], vb, pa[1][0], pa[1][1]); pv_half<1, 1 * 4096>(o[1], vb, pa[1][0], pa[1][1]);
    pv_half<0, 2 * 4096>(o[0], vb, pa[2][0], pa[2][1]); pv_half<1, 2 * 4096>(o[1], vb, pa[2][0], pa[2][1]);
    pv_half<0, 3 * 4096>(o[0], vb, pa[3][0], pa[3][1]); pv_half<1, 3 * 4096>(o[1], vb, pa[3][0], pa[3][1]);
    pv_half<0, 4 * 4096>(o[0], vb, pa[4][0], pa[4][1]); pv_half<1, 4 * 4096>(o[1], vb, pa[4][0], pa[4][1]);
    float* wsf = (float*)(lds + DL_WS) + wid * 64;
    if (hi == 0) { wsf[r32] = ps; LSE[((size_t)br * T + (size_t)b * S + qpos) * 8 + h] = mx + __builtin_amdgcn_logf(ps); }
    asm volatile("s_waitcnt lgkmcnt(0)" ::: "memory");
    float rli[16];
#pragma unroll
    for (int r = 0; r < 16; ++r) rli[r] = __builtin_amdgcn_rcpf(wsf[crow(r, hi)]);
    unsigned short* stg = (unsigned short*)(lds + DL_OST) + wid * 2048;
    unsigned short* dst = OBR + ((size_t)br * T + (size_t)b * S + (((size_t)(256 * lb + wid * 32)) << sh) + res) * 512 + h * 64;
    store_o_tile(o, rli, stg, dst, [sh](int row) { return ((size_t)row << sh) * 512; }, lane);
    asm volatile("s_waitcnt vmcnt(0)" ::: "memory");
    __syncthreads();
}
#define DIL_DECODE(u, bh_, br_, res_, lb_, sh_, L_) const int bh_ = (u) / 96, br_ = ((u) >> 5) % 3, blk__##bh_ = (u) & 31, sh_ = 2 * br_, L_ = S >> sh_, nbl__##bh_ = L_ >> 8, res_ = blk__##bh_ / nbl__##bh_, lb_ = blk__##bh_ % nbl__##bh_
__device__ __forceinline__ void dil_phase(int u0, int ustep, int nunits, const unsigned short* __restrict__ DQ, const unsigned short* __restrict__ DK, const unsigned short* __restrict__ DV,
                                          unsigned short* __restrict__ OBR, float* __restrict__ LSE, char* lds) {
    const int tid = threadIdx.x, wid = tid >> 6, lane = tid & 63, r32 = lane & 31, hi = lane >> 5;
    char* K_lds = lds + DL_K; char* V_lds = lds + DL_V;
    bf16x8 kk[6], qn[4]; unsigned kmask = 0u;
#define DIL_LOAD6(dst, mask, SRC, u) do { DIL_DECODE(u, bh_, br_, res_, lb_, sh_, L_); const size_t bhS_ = (size_t)bh_ * S; mask = 0u; \
        _Pragma("unroll") for (int it = 0; it < 6; ++it) { const int item = it * 512 + tid, row = item >> 3, ch = item & 7; const int l = 256 * lb_ - 64 + row; const bool valid = (l >= 0) && (l < L_); \
            const size_t src = (bhS_ + (valid ? ((size_t)l << sh_) + res_ : 0)) * 64 + ch * 8; dst[it] = *reinterpret_cast<const bf16x8*>(SRC + src); mask |= (valid ? 1u : 0u) << it; } } while (0)
#define DIL_LOADQ(u) do { DIL_DECODE(u, bh_, br_, res_, lb_, sh_, L_); const size_t qpos_ = ((size_t)(256 * lb_ + wid * 32 + r32) << sh_) + res_; const unsigned short* Qw_ = DQ + ((size_t)bh_ * S + qpos_) * 64 + hi * 8; \
        _Pragma("unroll") for (int d0 = 0; d0 < 4; ++d0) qn[d0] = *reinterpret_cast<const bf16x8*>(Qw_ + d0 * 16); } while (0)
    int u = u0;
    if (u < nunits) { DIL_LOAD6(kk, kmask, DK, u); DIL_LOADQ(u); }
    for (; u < nunits; u += ustep) {
        DIL_DECODE(u, bh, br, res, lb, sh, L); const int b = bh >> 3, h = bh & 7;
#pragma unroll
        for (int it = 0; it < 6; ++it) { const int item = it * 512 + tid, row = item >> 3, ch = item & 7; *(bf16x8*)(K_lds + KSWZD(row, ch * 16)) = ((kmask >> it) & 1u) ? kk[it] : bf16x8{}; }
        bf16x8 qr[4];
#pragma unroll
        for (int d0 = 0; d0 < 4; ++d0) qr[d0] = qn[d0];
        bf16x8 vv[6]; unsigned vmask; DIL_LOAD6(vv, vmask, DV, u);
        __syncthreads();
        const int ql = wid * 32 + r32; const size_t qpos = ((size_t)(256 * lb + ql) << sh) + res;
        f32x16 p[5];
#pragma unroll
        for (int j = 0; j < 5; ++j) { p[j] = f32x16{}; const int row = wid * 32 + j * 32 + r32;
#pragma unroll
            for (int d0 = 0; d0 < 4; ++d0) { const bf16x8 kf = *reinterpret_cast<const bf16x8*>(K_lds + KSWZD(row, (d0 * 16 + hi * 8) * 2)); p[j] = __builtin_amdgcn_mfma_f32_32x32x16_bf16(kf, qr[d0], p[j], 0, 0, 0); } }
        const float NEG = -1e30f;
        const int klo = 64 - 256 * lb, khi = L + 64 - 256 * lb;
#pragma unroll
        for (int j = 0; j < 5; ++j)
#pragma unroll
            for (int r = 0; r < 16; ++r) { const int kq = crow(r, hi); const int kl = wid * 32 + j * 32 + kq; bool ok = (kl >= klo) && (kl < khi);
                if (j == 0) ok = ok && (kq >= r32); if (j == 4) ok = ok && (kq <= r32); if (!ok) p[j][r] = NEG; }
        float mx = rowmax32(p[0], p[1]); mx = fmaxf(mx, rowmax32(p[2], p[3]));
        { float m4 = p[4][0];
#pragma unroll
          for (int r = 1; r < 16; ++r) m4 = fmaxf(m4, p[4][r]);
          auto rr = __builtin_amdgcn_permlane32_swap(__float_as_uint(m4), __float_as_uint(m4), false, false); mx = fmaxf(mx, fmaxf(__uint_as_float(rr[0]), __uint_as_float(rr[1]))); }
        float ps = 0.f;
#pragma unroll
        for (int j = 0; j < 5; ++j)
#pragma unroll
            for (int r = 0; r < 16; ++r) { p[j][r] = __builtin_amdgcn_exp2f(p[j][r] - mx); ps += p[j][r]; }
        { auto rr = __builtin_amdgcn_permlane32_swap(__float_as_uint(ps), __float_as_uint(ps), false, false); ps = __uint_as_float(rr[0]) + __uint_as_float(rr[1]); }
        bf16x8 pa[5][2];
#pragma unroll
        for (int j = 0; j < 5; ++j) { PK4(p[j], 0, pa[j][0]); PK4(p[j], 8, pa[j][1]); }
#pragma unroll
        for (int it = 0; it < 6; ++it) { const int item = it * 512 + tid, row = item >> 3, ch = item & 7; *(bf16x8*)(V_lds + (row >> 4) * 2048 + v_st(row & 15, ch * 8)) = ((vmask >> it) & 1u) ? vv[it] : bf16x8{}; }
        __syncthreads();
        if (u + ustep < nunits) { DIL_LOAD6(kk, kmask, DK, u + ustep); DIL_LOADQ(u + ustep); }
        f32x16 o[2] = {};
        const int vb = (int)(uintptr_t)V_lds + v_rd_base(lane) + wid * 4096;
        pv_half<0, 0 * 4096>(o[0], vb, pa[0][0], pa[0][1]); pv_half<1, 0 * 4096>(o[1], vb, pa[0][0], pa[0][1]);
        pv_half<0, 1 * 4096>(o[0], vb, pa[1][0], pa[1][1]); pv_half<1, 1 * 4096>(o[1], vb, pa[1][0], pa[1][1]);
        pv_half<0, 2 * 4096>(o[0], vb, pa[2][0], pa[2][1]); pv_half<1, 2 * 4096>(o[1], vb, pa[2][0], pa[2][1]);
        pv_half<0, 3 * 4096>(o[0], vb, pa[3][0], pa[3][1]); pv_half<1, 3 * 4096>(o[1], vb, pa[3][0], pa[3][1]);
        pv_half<0, 4 * 4096>(o[0], vb, pa[4][0], pa[4][1]); pv_half<1, 4 * 4096>(o[1], vb, pa[4][0], pa[4][1]);
        float* wsf = (float*)(lds + DL_WS) + wid * 64;
        if (hi == 0) { wsf[r32] = ps; LSE[((size_t)br * T + (size_t)b * S + qpos) * 8 + h] = mx + __builtin_amdgcn_logf(ps); }
        asm volatile("s_waitcnt lgkmcnt(0)" ::: "memory");
        float rli[16];
#pragma unroll
        for (int r = 0; r < 16; ++r) rli[r] = __builtin_amdgcn_rcpf(wsf[crow(r, hi)]);
        unsigned short* stg = (unsigned short*)(lds + DL_OST) + wid * 2048;
        unsigned short* dst = OBR + ((size_t)br * T + (size_t)b * S + (((size_t)(256 * lb + wid * 32)) << sh) + res) * 512 + h * 64;
        store_o_tile(o, rli, stg, dst, [sh](int row) { return ((size_t)row << sh) * 512; }, lane);
        __syncthreads();
    }
#undef DIL_LOAD6
#undef DIL_LOADQ
}
__device__ __forceinline__ void dil_combine(const unsigned short* __restrict__ OBR, const float* __restrict__ LSE, unsigned short* __restrict__ CAT, int gtid, int gthreads) {
    for (int i = gtid; i < T * 64; i += gthreads) { const int t = i >> 6, c8 = i & 63, h = c8 >> 3;
        const float l0 = LSE[((size_t)0 * T + t) * 8 + h], l1 = LSE[((size_t)1 * T + t) * 8 + h], l2 = LSE[((size_t)2 * T + t) * 8 + h];
        const float mx = fmaxf(l0, fmaxf(l1, l2)); float w0 = __builtin_amdgcn_exp2f(l0 - mx), w1 = __builtin_amdgcn_exp2f(l1 - mx), w2 = __builtin_amdgcn_exp2f(l2 - mx);
        const float inv = 1.f / (w0 + w1 + w2); w0 *= inv; w1 *= inv; w2 *= inv;
        const u32x4 a = *(const u32x4*)(OBR + ((size_t)0 * T + t) * 512 + c8 * 8), bb = *(const u32x4*)(OBR + ((size_t)1 * T + t) * 512 + c8 * 8), cc = *(const u32x4*)(OBR + ((size_t)2 * T + t) * 512 + c8 * 8);
        u32x4 o;
#pragma unroll
        for (int k = 0; k < 4; ++k) { const float lo = w0 * __uint_as_float(a[k] << 16) + w1 * __uint_as_float(bb[k] << 16) + w2 * __uint_as_float(cc[k] << 16);
            const float hi = w0 * __uint_as_float(a[k] & 0xffff0000u) + w1 * __uint_as_float(bb[k] & 0xffff0000u) + w2 * __uint_as_float(cc[k] & 0xffff0000u); o[k] = cvtpk(lo, hi); }
        *(u32x4*)(CAT + (size_t)t * 1024 + 512 + c8 * 8) = o; }
}
#undef SBAR
}
namespace mk {
struct SchedP4 {
    static constexpr bool GATHER = false;
    const char* A; const char* Bt; int G, c;
    __device__ __forceinline__ bool next(int i, gm::Unit& u) const { int pm, pn; if (!static_tile(i, G, c, 64, 4, pm, pn)) return false;
        u.A = A; u.Bt = Bt; u.gidx = nullptr; u.lda2 = 2048; u.ldb2 = 2048; u.arow0 = pm * 256; u.brow0 = pn * 256; u.nt = 16; u.pm = pm; u.pn = pn; u.aux = 0; return true; }
};
struct EpiP4 {
    static constexpr bool PERM = false;
    const float* x; float* out; const float* modf;
    __device__ __forceinline__ void operator()(EPI_ARGS) const {
        const int b = (u.pm * 256) >> 13; const float* gt = modf + b * 6144 + 2048;
        const int col0 = u.pn * 256 + wc * 32 + 4 * fq;
        f32x4 g[2][2];
#pragma unroll
        for (int bj = 0; bj < 2; ++bj)
#pragma unroll
            for (int n = 0; n < 2; ++n) g[bj][n] = *(const f32x4*)(gt + col0 + bj * 128 + n * 16);
#pragma unroll
        for (int ai = 0; ai < 2; ++ai)
#pragma unroll
            for (int m = 0; m < 4; ++m) { const size_t off = (size_t)(u.pm * 256 + ai * 128 + wr * 64 + m * 16 + fr) * D + col0;
#pragma unroll
                for (int bj = 0; bj < 2; ++bj)
#pragma unroll
                    for (int n = 0; n < 2; ++n) { const f32x4 xv = *(const f32x4*)(x + off + bj * 128 + n * 16); *(f32x4*)(out + off + bj * 128 + n * 16) = xv + g[bj][n] * acc[ai][bj][m][n]; } }
    }
};
__device__ __forceinline__ void p4b_rows(Frame& F) {
    LAS float* WR = (LAS float*)F.lds;
    LAS float* A1 = WR + 16384;
    LAS float* A0 = A1 + 2048;
    const float* modf = (const float*)(F.ws + WS_MODF);
    for (int i = F.tid; i < 16384; i += NTHREADS) { const int j = i >> 4, e = i & 15; WR[e * 1024 + j] = F.w_router[i]; }
    for (int i = F.tid; i < 2048; i += NTHREADS) { const int b = i >> 10, j = i & 1023; A1[i] = F.g_ffn[j] * (1.f + modf[b * 6144 + 4096 + j]); A0[i] = modf[b * 6144 + 3072 + j]; }
    __syncthreads();
    const int gw = F.vcu * NWAVES + F.wave, NGW = F.G * NWAVES, lane = F.lane;
    for (int m = gw; m < T; m += NGW) { const int b = m >> 13, s = m & 8191;
        const f32x4* xr = (const f32x4*)(F.out + (size_t)m * D) + lane; f32x4 v[4]; float ss = 0.f;
#pragma unroll
        for (int j = 0; j < 4; ++j) { v[j] = xr[64 * j]; ss += (v[j].x * v[j].x + v[j].y * v[j].y) + (v[j].z * v[j].z + v[j].w * v[j].w); }
        const float rstd = rsqrtf(wave_sum(ss) * (1.f / D) + EPS);
        unsigned long long* o8 = (unsigned long long*)((bf16_t*)(F.ws + WS_HB) + (size_t)m * D) + lane;
        float lg[16];
#pragma unroll
        for (int e = 0; e < 16; ++e) lg[e] = 0.f;
#pragma unroll
        for (int j = 0; j < 4; ++j) { asm volatile("" ::: "memory");
            const f32x4 a1 = *(const LAS f32x4*)(A1 + b * 1024 + 4 * lane + 256 * j), a0 = *(const LAS f32x4*)(A0 + b * 1024 + 4 * lane + 256 * j);
            const f32x4 o = v[j] * rstd * a1 + a0; o8[64 * j] = (unsigned long long)pk2(o.x, o.y) | ((unsigned long long)pk2(o.z, o.w) << 32);
#pragma unroll
            for (int e = 0; e < 16; ++e) { const f32x4 w = *(const LAS f32x4*)(WR + e * 1024 + 4 * lane + 256 * j); lg[e] += (o.x * w.x + o.y * w.y) + (o.z * w.z + o.w * w.w); } }
        float w8[8], w4[4], w2[2], w1;
        { const bool up = lane & 32;
#pragma unroll
          for (int i = 0; i < 8; ++i) { const float snd = up ? lg[i] : lg[8 + i], kp = up ? lg[8 + i] : lg[i]; w8[i] = kp + __shfl_xor(snd, 32); } }
        { const bool up = lane & 16;
#pragma unroll
          for (int i = 0; i < 4; ++i) { const float snd = up ? w8[i] : w8[4 + i], kp = up ? w8[4 + i] : w8[i]; w4[i] = kp + __shfl_xor(snd, 16); } }
        { const bool up = lane & 8;
#pragma unroll
          for (int i = 0; i < 2; ++i) { const float snd = up ? w4[i] : w4[2 + i], kp = up ? w4[2 + i] : w4[i]; w2[i] = kp + __shfl_xor(snd, 8); } }
        { const bool up = lane & 4; const float snd = up ? w2[0] : w2[1], kp = up ? w2[1] : w2[0]; w1 = kp + __shfl_xor(snd, 4); }
        w1 += __shfl_xor(w1, 1); w1 += __shfl_xor(w1, 2);
        const int e = lane >> 2; const float logit = w1 + F.b_router[e];
        float mx = logit;
#pragma unroll
        for (int o = 4; o < 64; o <<= 1) mx = fmaxf(mx, __shfl_xor(mx, o));
        const float ex = __expf(logit - mx); float den = ex;
#pragma unroll
        for (int o = 4; o < 64; o <<= 1) den += __shfl_xor(den, o);
        if ((lane & 3) == 0) ((float*)(F.ws + WS_AFF))[((size_t)b * 16 + e) * S + s] = ex / den;
    }
    __syncthreads();
}
__device__ __forceinline__ void p5_topk(Frame& F) {
    if (F.vcu >= 32) { if (WD_IN_P5 && F.G > 32) wd_convert(F, 32); return; }
    const int be = F.vcu, b = be >> 4, e = be & 15, tid = F.tid;
    LAS unsigned* vals = (LAS unsigned*)F.lds;
    LAS unsigned* hist = vals + 8192;
    LAS unsigned* suf = hist + 256;
    LAS unsigned* misc = suf + 264;
    LAS unsigned* wtot = misc + 8;
    const float* a = (const float*)(F.ws + WS_AFF) + (size_t)be * S;
    for (int i = tid; i < 8192; i += NTHREADS) vals[i] = __float_as_uint(a[i]);
    if (tid == 0) { misc[0] = 0u; misc[1] = 1024u; }
    __syncthreads();
    for (int pass = 0; pass < 4; ++pass) {
        const int sh = 24 - 8 * pass; const unsigned prefix = misc[0], k = misc[1]; const unsigned himask = pass == 0 ? 0u : (0xffffffffu << (sh + 8));
        if (tid < 256) hist[tid] = 0u;
        __syncthreads();
        for (int i = tid; i < 8192; i += NTHREADS) { const unsigned v = vals[i]; if ((v & himask) == prefix) __hip_atomic_fetch_add(&hist[(v >> sh) & 255u], 1u, __ATOMIC_RELAXED, __HIP_MEMORY_SCOPE_WORKGROUP); }
        __syncthreads();
        if (tid < 256) suf[tid] = hist[tid]; if (tid == 0) suf[256] = 0u;
        __syncthreads();
        for (int o = 1; o < 256; o <<= 1) { unsigned t = 0u; if (tid < 256) t = suf[tid] + ((tid + o < 256) ? suf[tid + o] : 0u); __syncthreads(); if (tid < 256) suf[tid] = t; __syncthreads(); }
        if (tid < 256) { const unsigned sge = suf[tid], sgt = (tid < 255) ? suf[tid + 1] : 0u; if (sge >= k && sgt < k) { misc[0] = prefix | ((unsigned)tid << sh); misc[1] = k - sgt; } }
        __syncthreads();
    }
    const unsigned thr = misc[0], need = misc[1];
    unsigned gtc = 0, eqc = 0;
#pragma unroll
    for (int i = 0; i < 16; ++i) { const unsigned v = vals[tid * 16 + i]; gtc += v > thr; eqc += v == thr; }
    unsigned gi = gtc, ei = eqc; const int lane = F.lane, wv = F.wave;
#pragma unroll
    for (int o = 1; o < 64; o <<= 1) { const unsigned g2 = __shfl_up(gi, o), e2 = __shfl_up(ei, o); if (lane >= o) { gi += g2; ei += e2; } }
    if (lane == 63) { wtot[wv] = gi; wtot[8 + wv] = ei; }
    __syncthreads();
    unsigned gbase = 0, ebase = 0, gtotal = 0;
    for (int w = 0; w < 8; ++w) { const unsigned g = wtot[w], q = wtot[8 + w]; if (w < wv) { gbase += g; ebase += q; } gtotal += g; }
    unsigned gpos = gbase + gi - gtc, epos = ebase + ei - eqc;
    int* IDX = (int*)(F.ws + WS_IDX) + (e * 2 + b) * 1024; float* GATE = (float*)(F.ws + WS_GATE) + (e * 2 + b) * 1024; int* SLOT = (int*)(F.ws + WS_SLOT);
#pragma unroll
    for (int i = 0; i < 16; ++i) { const int s = tid * 16 + i; const unsigned v = vals[s]; int c = -1;
        if (v > thr) c = (int)gpos++; else if (v == thr) { if (epos < need) c = (int)(gtotal + epos); ++epos; }
        if (c >= 0) { IDX[c] = b * S + s; GATE[c] = __uint_as_float(v); }
        SLOT[(size_t)(b * S + s) * 16 + e] = c >= 0 ? (e * 2 + b) * 1024 + c : -1; }
}
struct SchedP6a {
    static constexpr bool GATHER = true;
    const char* A; const char* W; const int* idx; int G, vcu;
    __device__ __forceinline__ bool next(int i, gm::Unit& u) const {
        int e, pmu, pn;
        if (G == 256) { if (i >= 4) return false; const int xcd = vcu >> 5, j = vcu & 31; e = xcd + 8 * (i >> 1); const int sub = (i & 1) * 32 + j; pmu = sub >> 3; pn = sub & 7; }
        else { const int L = i * G + vcu; if (L >= 1024) return false; e = L >> 6; pmu = (L >> 3) & 7; pn = L & 7; }
        u.A = A; u.gidx = idx + e * 2048 + pmu * 256; u.lda2 = 2048; u.arow0 = 0; u.Bt = W + (size_t)e * 2048 * 2048; u.brow0 = pn * 256; u.ldb2 = 2048; u.nt = 16; u.pm = e * 8 + pmu; u.pn = pn; u.aux = e; return true; }
};
struct EpiP6a {
    static constexpr bool PERM = true;
    bf16_t* H;
    __device__ __forceinline__ void operator()(EPI_ARGS) const {
#pragma unroll
        for (int ai = 0; ai < 2; ++ai)
#pragma unroll
            for (int m = 0; m < 4; ++m) { const size_t row = (size_t)u.pm * 256 + ai * 128 + wr * 64 + m * 16 + fr;
                f32x4 h0, h1;
#pragma unroll
                for (int j = 0; j < 4; ++j) { h0[j] = siluf(acc[ai][0][m][0][j]) * acc[ai][1][m][0][j]; h1[j] = siluf(acc[ai][0][m][1][j]) * acc[ai][1][m][1][j]; }
                *(u32x4*)(H + row * 1024 + u.pn * 128 + wc * 32 + 8 * fq) = pack8(h0, h1); }
    }
};
struct SchedP6b {
    static constexpr bool GATHER = false;
    const char* A; const char* W; int G, vcu;
    __device__ __forceinline__ bool next(int i, gm::Unit& u) const {
        int e, pmu, pn;
        if (G == 256) { if (i >= 2) return false; const int xcd = vcu >> 5, j = vcu & 31; e = xcd + 8 * i; pmu = j >> 2; pn = j & 3; }
        else { const int L = i * G + vcu; if (L >= 512) return false; e = L >> 5; pmu = (L >> 2) & 7; pn = L & 3; }
        u.A = A; u.gidx = nullptr; u.lda2 = 2048; u.arow0 = (e * 8 + pmu) * 256; u.Bt = W + (size_t)e * 1024 * 2048; u.brow0 = pn * 256; u.ldb2 = 2048; u.nt = 16; u.pm = e * 8 + pmu; u.pn = pn; u.aux = e; return true; }
};
struct EpiP6b {
    static constexpr bool PERM = true;
    bf16_t* Y; const float* gate;
    __device__ __forceinline__ void operator()(EPI_ARGS) const {
#pragma unroll
        for (int ai = 0; ai < 2; ++ai)
#pragma unroll
            for (int m = 0; m < 4; ++m) { const size_t row = (size_t)u.pm * 256 + ai * 128 + wr * 64 + m * 16 + fr; const float g = gate[row];
#pragma unroll
                for (int bj = 0; bj < 2; ++bj) *(u32x4*)(Y + row * 1024 + u.pn * 256 + bj * 128 + wc * 32 + 8 * fq) = pack8(acc[ai][bj][m][0] * g, acc[ai][bj][m][1] * g); }
    }
};
__device__ __forceinline__ void p7_final(Frame& F) {
    const float* modf = (const float*)(F.ws + WS_MODF); const int* SLOT = (const int*)(F.ws + WS_SLOT); const bf16_t* Y = (const bf16_t*)(F.ws + WS_Y);
    const int gw = F.vcu * NWAVES + F.wave, NGW = F.G * NWAVES, lane = F.lane;
    for (int m0 = gw; m0 < T; m0 += 2 * NGW) {
        const int m1 = m0 + NGW; const bool has1 = m1 < T; const int mm1 = has1 ? m1 : m0;
        f32x4* xr0 = (f32x4*)(F.out + (size_t)m0 * D) + lane; f32x4* xr1 = (f32x4*)(F.out + (size_t)mm1 * D) + lane; f32x4 v0[4], v1[4], a0[4], a1[4];
#pragma unroll
        for (int j = 0; j < 4; ++j) { v0[j] = xr0[64 * j]; v1[j] = xr1[64 * j]; a0[j] = (f32x4){0.f, 0.f, 0.f, 0.f}; a1[j] = (f32x4){0.f, 0.f, 0.f, 0.f}; }
        const int sl0 = lane < 16 ? SLOT[(size_t)m0 * 16 + lane] : -1, sl1 = lane < 16 ? SLOT[(size_t)mm1 * 16 + lane] : -1;
        for (int e = 0; e < 16; ++e) { const int s0 = __shfl(sl0, e), s1 = __shfl(sl1, e);
            if (s0 >= 0) { const u32x2* yr = (const u32x2*)(Y + (size_t)s0 * 1024) + lane;
#pragma unroll
                for (int j = 0; j < 4; ++j) { const u32x2 w = yr[64 * j]; a0[j].x += __uint_as_float(w.x << 16); a0[j].y += __uint_as_float(w.x & 0xffff0000u); a0[j].z += __uint_as_float(w.y << 16); a0[j].w += __uint_as_float(w.y & 0xffff0000u); } }
            if (s1 >= 0) { const u32x2* yr = (const u32x2*)(Y + (size_t)s1 * 1024) + lane;
#pragma unroll
                for (int j = 0; j < 4; ++j) { const u32x2 w = yr[64 * j]; a1[j].x += __uint_as_float(w.x << 16); a1[j].y += __uint_as_float(w.x & 0xffff0000u); a1[j].z += __uint_as_float(w.y << 16); a1[j].w += __uint_as_float(w.y & 0xffff0000u); } } }
        float ss0 = 0.f, ss1 = 0.f; const int b0 = m0 >> 13, b1 = mm1 >> 13;
#pragma unroll
        for (int j = 0; j < 4; ++j) { const f32x4 g0 = *(const f32x4*)(modf + b0 * 6144 + 5120 + 4 * lane + 256 * j), g1 = *(const f32x4*)(modf + b1 * 6144 + 5120 + 4 * lane + 256 * j);
            v0[j] = v0[j] + g0 * a0[j]; v1[j] = v1[j] + g1 * a1[j];
            ss0 += (v0[j].x * v0[j].x + v0[j].y * v0[j].y) + (v0[j].z * v0[j].z + v0[j].w * v0[j].w); ss1 += (v1[j].x * v1[j].x + v1[j].y * v1[j].y) + (v1[j].z * v1[j].z + v1[j].w * v1[j].w); }
        const float r0 = rsqrtf(wave_sum(ss0) * (1.f / D) + EPS), r1 = rsqrtf(wave_sum(ss1) * (1.f / D) + EPS);
#pragma unroll
        for (int j = 0; j < 4; ++j) { const f32x4 g = *(const f32x4*)(F.g_final + 4 * lane + 256 * j); xr0[64 * j] = v0[j] * r0 * g; if (has1) xr1[64 * j] = v1[j] * r1 * g; }
    }
}
}
#ifndef DIL_PIPE
#define DIL_PIPE 0
#endif
#ifndef MLA_UNIT
#define MLA_UNIT mla_unit_v2
#endif
namespace mk {
namespace cg = cooperative_groups;
__global__ void __launch_bounds__(NTHREADS, 2) mega(Args args) {
    extern __shared__ __attribute__((aligned(16))) unsigned char lds_raw[];
    cg::grid_group grid = cg::this_grid();
    Frame F;
    F.lds = (LAS unsigned char*)lds_raw; F.ws = args.ws; F.out = args.out;
    F.tid = threadIdx.x; F.lane = F.tid & 63; F.wave = __builtin_amdgcn_readfirstlane(F.tid >> 6);
    F.G = gridDim.x; { const int bx = blockIdx.x; F.vcu = (F.G % 8 == 0) ? (bx % 8) * (F.G / 8) + bx / 8 : bx; }
    F.x = (const float*)args.in[0]; F.c = (const float*)args.in[1]; F.pos = (const int*)args.in[2]; F.w_ada = (const float*)args.in[3]; F.b_ada = (const float*)args.in[4];
    F.g_mix = (const float*)args.in[5]; F.w_in = (const float*)args.in[6]; F.g_q = (const float*)args.in[7]; F.w_uq = (const float*)args.in[8]; F.g_kv = (const float*)args.in[9];
    F.w_ukv = (const float*)args.in[10]; F.w_out = (const float*)args.in[11]; F.g_ffn = (const float*)args.in[12]; F.w_router = (const float*)args.in[13]; F.b_router = (const float*)args.in[14];
    F.w_gate = (const float*)args.in[15]; F.w_up = (const float*)args.in[16]; F.w_down = (const float*)args.in[17]; F.g_final = (const float*)args.in[18];
    const int lo = args.ph_lo, hi = args.ph_hi;
    volatile LAS unsigned* MISC = (volatile LAS unsigned*)(F.lds + LDS_BYTES - 256);
    if (F.tid < 64) MISC[F.tid] = 0u;
    __syncthreads();
    XcdBarrier xbar = xcd_barrier_post((unsigned*)(F.ws + WS_CTL) + 1024 + args.li * 4096, MISC + 8);
#define IN(k) (lo <= (k) && (k) < hi)
#ifndef CG_SEAMS
#define CG_SEAMS 0x000
#endif
#define SEAM(k) do { if (IN(k) && IN((k) + 1)) { if ((CG_SEAMS >> (k)) & 1) grid.sync(); else xcd_barrier(xbar); } } while (0)
    if (IN(0)) { p0_prologue(F); } SEAM(0);
    if (IN(1)) { p0b_rows(F); } SEAM(1);
    if (IN(2)) { SchedP1 S{(const char*)(F.ws + WS_HB), (const char*)(F.ws + WS_WIN), F.G, (int)blockIdx.x}; EpiP1 E{F.ws}; gm::gemm_phase<EpiP1, SchedP1>(F.lds, S, E); } SEAM(2);
    if (IN(3)) { SchedP2 S{(const char*)(F.ws + WS_CQ), (const char*)(F.ws + WS_WUQ), (const char*)(F.ws + WS_WUKV), F.G, (int)blockIdx.x}; EpiP2 E{F.ws}; gm::gemm_phase<EpiP2, SchedP2>(F.lds, S, E); } SEAM(3);
    if (IN(4)) {
        const unsigned short* DQ = (const unsigned short*)(F.ws + WS_DQ); const unsigned short* DK = (const unsigned short*)(F.ws + WS_DK); const unsigned short* DV = (const unsigned short*)(F.ws + WS_DV);
        unsigned short* OBR = (unsigned short*)F.out; float* LSE = (float*)(F.ws + WS_LSE);
        if (args.pad & 1) { if (DIL_PIPE) at::dil_phase(F.vcu, F.G, 1536, DQ, DK, DV, OBR, LSE, (char*)lds_raw); else for (int u = F.vcu; u < 1536; u += F.G) { const int blk = u & 31, br = (u >> 5) % 3, bh = u / 96; at::dil_unit(bh, br, blk, DQ, DK, DV, OBR, LSE, (char*)lds_raw); } }
        if (args.pad & 2) for (int u = F.vcu; u < 512; u += F.G) { const int bh = (u >> 8) * 8 + ((u & 255) >> 5), qb = u & 31;
            at::mla_unit_v2(bh, qb, (const unsigned short*)(F.ws + WS_Q), (const unsigned short*)(F.ws + WS_KN), (const unsigned short*)(F.ws + WS_KR), (const unsigned short*)(F.ws + WS_V), (unsigned short*)(F.ws + WS_HB), (const float*)(F.ws + WS_KMX), (char*)lds_raw); }
    } SEAM(4);
    if (IN(5)) { at::dil_combine((const unsigned short*)F.out, (const float*)(F.ws + WS_LSE), (unsigned short*)(F.ws + WS_HB), F.vcu * NTHREADS + F.tid, F.G * NTHREADS); } SEAM(5);
    if (IN(6)) { SchedP4 S{(const char*)(F.ws + WS_HB), (const char*)(F.ws + WS_WOUT), F.G, (int)blockIdx.x}; EpiP4 E{F.x, F.out, (const float*)(F.ws + WS_MODF)}; gm::gemm_phase<EpiP4, SchedP4>(F.lds, S, E); } SEAM(6);
    if (IN(7)) { p4b_rows(F); } SEAM(7);
    if (IN(8)) { p5_topk(F); } SEAM(8);
    if (IN(9)) { SchedP6a S{(const char*)(F.ws + WS_HB), (const char*)(F.ws + WS_WGU), (const int*)(F.ws + WS_IDX), F.G, F.vcu}; EpiP6a E{(bf16_t*)(F.ws + WS_HBUF)}; gm::gemm_phase<EpiP6a, SchedP6a>(F.lds, S, E); } SEAM(9);
    if (IN(10)) { SchedP6b S{(const char*)(F.ws + WS_HBUF), (const char*)(F.ws + WS_WD), F.G, F.vcu}; EpiP6b E{(bf16_t*)(F.ws + WS_Y), (const float*)(F.ws + WS_GATE)}; gm::gemm_phase<EpiP6b, SchedP6b>(F.lds, S, E); } SEAM(10);
    if (IN(11)) { p7_final(F); }
#undef IN
#undef SEAM
}
}
namespace nv {
__device__ __forceinline__ float bf2f(unsigned short b) { return __builtin_bit_cast(float, (unsigned)b << 16); }
__global__ __launch_bounds__(256) void k_attn_mla_bf(const unsigned short* __restrict__ Q, const unsigned short* __restrict__ KN, const unsigned short* __restrict__ V, const unsigned short* __restrict__ KR, float* __restrict__ cat, int b) {
    __shared__ float Ks[32][96]; __shared__ float Vs[32][64];
    const int h = blockIdx.y, t = blockIdx.x * 256 + threadIdx.x; const size_t bh = (size_t)(b * 8 + h) * S;
    float qv[96];
#pragma unroll
    for (int d = 0; d < 96; ++d) qv[d] = bf2f(Q[(bh + t) * 96 + d]);
    float o[64];
#pragma unroll
    for (int d = 0; d < 64; ++d) o[d] = 0.f;
    float m = -1e30f, l = 0.f;
    for (int k0 = 0; k0 < S; k0 += 32) {
        __syncthreads();
        for (int i = threadIdx.x; i < 32 * 96; i += 256) { int r = i / 96, d = i % 96; Ks[r][d] = d < 64 ? bf2f(KN[(bh + k0 + r) * 64 + d]) : bf2f(KR[((size_t)b * S + k0 + r) * 32 + d - 64]); }
        for (int i = threadIdx.x; i < 32 * 64; i += 256) { int r = i / 64, d = i % 64; Vs[r][d] = bf2f(V[(bh + k0 + r) * 64 + d]); }
        __syncthreads();
        float sc[32]; float tm = -1e30f;
#pragma unroll
        for (int j = 0; j < 32; ++j) { float s = 0.f;
#pragma unroll
            for (int d = 0; d < 96; ++d) s += qv[d] * Ks[j][d];
            sc[j] = s; tm = fmaxf(tm, s); }
        const float mn = fmaxf(m, tm), al = exp2f(m - mn); m = mn; l *= al;
#pragma unroll
        for (int d = 0; d < 64; ++d) o[d] *= al;
#pragma unroll
        for (int j = 0; j < 32; ++j) { const float p = exp2f(sc[j] - mn); l += p;
#pragma unroll
            for (int d = 0; d < 64; ++d) o[d] += p * Vs[j][d]; }
    }
    const float il = 1.f / l;
#pragma unroll
    for (int d = 0; d < 64; ++d) cat[(size_t)t * 1024 + h * 64 + d] = o[d] * il;
}
__global__ __launch_bounds__(256) void k_attn_dil_bf(const unsigned short* __restrict__ DQ, const unsigned short* __restrict__ DK, const unsigned short* __restrict__ DV, float* __restrict__ cat, int b) {
    const int h = blockIdx.y, t = blockIdx.x * 256 + threadIdx.x; const size_t bh = (size_t)(b * 8 + h) * S;
    float qv[64];
#pragma unroll
    for (int d = 0; d < 64; ++d) qv[d] = bf2f(DQ[(bh + t) * 64 + d]);
    float o[64];
#pragma unroll
    for (int d = 0; d < 64; ++d) o[d] = 0.f;
    float m = -1e30f, l = 0.f;
    for (int br = 0; br < 3; ++br) { const int dil = br == 0 ? 1 : (br == 1 ? 4 : 16);
        for (int j = -64; j <= 64; ++j) { const int kt = t + dil * j; if (kt < 0 || kt >= S) continue;
            const unsigned short* kp = DK + (bh + kt) * 64; float s = 0.f;
#pragma unroll
            for (int d = 0; d < 64; ++d) s += qv[d] * bf2f(kp[d]);
            if (s > m) { const float al = exp2f(m - s); l *= al;
#pragma unroll
                for (int d = 0; d < 64; ++d) o[d] *= al;
                m = s; }
            const float p = exp2f(s - m); l += p; const unsigned short* vp = DV + (bh + kt) * 64;
#pragma unroll
            for (int d = 0; d < 64; ++d) o[d] += p * bf2f(vp[d]); } }
    const float il = 1.f / l;
#pragma unroll
    for (int d = 0; d < 64; ++d) cat[(size_t)t * 1024 + 512 + h * 64 + d] = o[d] * il;
}
__global__ void k_bf2f(const unsigned short* in, float* out, size_t n) { size_t i = (size_t)blockIdx.x * 256 + threadIdx.x; if (i < n) out[i] = bf2f(in[i]); }
static void naive_tail_from_cat(void* const* d_in, int b, float* ob, const float* mod, float* hb, float* mixed, float* Hb, float* Y, float* aff, int* idx, float* gate, int* slot, hipStream_t st) {
    const float* x = (const float*)d_in[0]; const float* w_out = (const float*)d_in[11];
    const float* xb = x + (size_t)b * S * D; const float* mb = mod + b * 6144;
    k_gemm<<<dim3(1024 / 64, S / 64, 1), 256, 0, st>>>(hb, 1024, 0, nullptr, w_out, nullptr, 1024, 0, mixed, 1024, S, 1024, 1024, nullptr);
    k_resid<<<(S * D + 255) / 256, 256, 0, st>>>(xb, mb + 2048, mixed, ob, S * D);
}
static void naive_tail_from_x1(void* const* d_in, int b, float* ob, const float* mod, float* hb, float* Hb, float* Y, float* aff, int* idx, float* gate, int* slot, hipStream_t st, bool have_h2) {
    const float* g_ffn = (const float*)d_in[12]; const float* w_router = (const float*)d_in[13]; const float* b_router = (const float*)d_in[14];
    const float* w_gate = (const float*)d_in[15]; const float* w_up = (const float*)d_in[16]; const float* w_down = (const float*)d_in[17]; const float* g_final = (const float*)d_in[18];
    const float* mb = mod + b * 6144;
    if (!have_h2) k_h2_aff<<<S / 4, 256, 0, st>>>(ob, g_ffn, mb + 3072, mb + 4096, w_router, b_router, hb, aff);
    k_topk<<<dim3(S / 256, 16), 256, 0, st>>>(aff, idx, gate, slot);
    k_gemm<<<dim3(16, 16, 16), 256, 0, st>>>(hb, 1024, 0, idx, w_gate, w_up, 1024, 1024 * 1024, Hb, 1024, 1024, 1024, 1024, nullptr);
    k_gemm<<<dim3(16, 16, 16), 256, 0, st>>>(Hb, 1024, 1024 * 1024, nullptr, w_down, nullptr, 1024, 1024 * 1024, Y, 1024, 1024, 1024, 1024, gate);
    k_final<<<S / 4, 256, 0, st>>>(ob, mb + 5120, Y, slot, g_final, ob);
}
}
#ifndef TEST_STAGE
#define TEST_STAGE 0
#endif
#ifndef PROBE_SPLIT
#define PROBE_SPLIT -1
#endif
#ifndef PROBE_SUB
#define PROBE_SUB 3
#endif
#ifndef PROBE_REPEAT
#define PROBE_REPEAT 0
#endif
#ifndef TEST_C0
#define TEST_C0 0
#endif
extern "C" void kernel_launch(void* const* d_in, const int* in_sizes, int n_in, void* d_out, int out_size, void* d_ws, size_t ws_size, hipStream_t stream) {
    using namespace mk;
    static int grid = 0;
    if (grid == 0) {
        if (n_in != 19 || out_size != T * D || ws_size < 290 * MiB) { fprintf(stderr, "kernel_launch: bad shapes/ws %d %d %zu\n", n_in, out_size, ws_size); grid = -1; return; }
        int dev = 0, cus = 0, per_cu = 0;
        hipGetDevice(&dev); hipDeviceGetAttribute(&cus, hipDeviceAttributeMultiprocessorCount, dev);
        if (hipFuncSetAttribute((const void*)mega, hipFuncAttributeMaxDynamicSharedMemorySize, LDS_BYTES) != hipSuccess) { fprintf(stderr, "hipFuncSetAttribute failed\n"); grid = -1; return; }
        hipOccupancyMaxActiveBlocksPerMultiprocessor(&per_cu, (const void*)mega, NTHREADS, LDS_BYTES);
        if (per_cu < 1) { fprintf(stderr, "occupancy query says %d\n", per_cu); grid = -1; return; }
        grid = cus;
    }
    if (grid < 0) return;
    hipMemsetAsync((char*)d_ws + WS_CTL, 0, 64 * KiB, stream);
    Args a{}; for (int i = 0; i < 19; ++i) a.in[i] = d_in[i]; a.out = (float*)d_out; a.ws = (unsigned char*)d_ws;
    a.pad = 3; a.ph_lo = 0; a.ph_hi = (TEST_STAGE == 0) ? 12 : (TEST_STAGE == 1) ? 4 : 6;
    void* kargs[] = {&a};
#if PROBE_SPLIT >= 0
    { const int hi_all = a.ph_hi; a.ph_lo = 0; a.ph_hi = PROBE_SPLIT + PROBE_REPEAT; a.li = 0;
      if (a.ph_hi > 0) { hipError_t e0 = hipLaunchCooperativeKernel((const void*)mega, dim3(grid), dim3(NTHREADS), kargs, LDS_BYTES, stream); if (e0 != hipSuccess) { fprintf(stderr, "launch A failed\n"); return; } }
      a.ph_lo = PROBE_SPLIT; a.ph_hi = hi_all; a.li = 1; a.pad = PROBE_SUB; }
#endif
    hipError_t e = hipLaunchCooperativeKernel((const void*)mega, dim3(grid), dim3(NTHREADS), kargs, LDS_BYTES, stream);
    if (e != hipSuccess) { fprintf(stderr, "cooperative launch failed: %s\n", hipGetErrorString(e)); return; }
    if (TEST_STAGE == 0) return;
    if (TEST_STAGE == 3) { nv::run_naive(d_in, (float*)d_out, (char*)d_ws + 52 * MiB, stream, (const unsigned short*)((char*)d_ws + WS_HB), (double*)((char*)d_ws + 4096), TEST_C0, 512); return; }
    char* ws = (char*)d_ws; const float* modf = (const float*)(ws + WS_MODF);
    float* cat0 = (float*)(ws + 180 * MiB); float* cat1 = (float*)(ws + 214 * MiB); float* mixed = (float*)(ws + 248 * MiB);
    float* aff = (float*)(ws + 282 * MiB); int* idx = (int*)(ws + 283 * MiB); float* gate = (float*)(ws + 283 * MiB + 256 * KiB); int* slot = (int*)(ws + 284 * MiB);
    float* Hb = (float*)(ws + 52 * MiB); float* Y = (float*)(ws + 116 * MiB);
    if (TEST_STAGE == 1) for (int b = 0; b < 2; ++b) { float* cat = b ? cat1 : cat0;
        nv::k_attn_mla_bf<<<dim3(S / 256, 8), 256, 0, stream>>>((const unsigned short*)(ws + WS_Q), (const unsigned short*)(ws + WS_KN), (const unsigned short*)(ws + WS_V), (const unsigned short*)(ws + WS_KR), cat, b);
        nv::k_attn_dil_bf<<<dim3(S / 256, 8), 256, 0, stream>>>((const unsigned short*)(ws + WS_DQ), (const unsigned short*)(ws + WS_DK), (const unsigned short*)(ws + WS_DV), cat, b); }
    if (TEST_STAGE == 2) for (int b = 0; b < 2; ++b) nv::k_bf2f<<<(S * 1024 + 255) / 256, 256, 0, stream>>>((const unsigned short*)(ws + WS_HB) + (size_t)b * S * 1024, b ? cat1 : cat0, (size_t)S * 1024);
    for (int b = 0; b < 2; ++b) { float* cat = b ? cat1 : cat0; float* ob = (float*)d_out + (size_t)b * S * D;
        nv::naive_tail_from_cat(d_in, b, ob, modf, cat, mixed, Hb, Y, aff, idx, gate, slot, stream);
        nv::naive_tail_from_x1(d_in, b, ob, modf, cat, Hb, Y, aff, idx, gate, slot, stream, false); }
}
```

```cpp
#include <hip/hip_runtime.h>
#include <hip/hip_cooperative_groups.h>
#include <hip/hip_bf16.h>
#include <cstdio>
#include <cstdint>
#include <cmath>
namespace nv {
constexpr int S = 8192, D = 1024, NB = 2, INC = 2208, H = 8;
constexpr float EPS = 1e-6f;
__device__ __forceinline__ float siluf(float v) { return v / (1.f + __expf(-v)); }
__device__ __forceinline__ float wsum(float v) {
#pragma unroll
    for (int o = 1; o < 64; o <<= 1) v += __shfl_xor(v, o);
    return v;
}
__global__ void k_mod(const float* c, const float* w, const float* bias, float* mod) {
    int i = blockIdx.x * 256 + threadIdx.x; if (i >= NB * 6144) return;
    int b = i / 6144, n = i % 6144; float s = 0.f;
    for (int k = 0; k < 1024; ++k) s += siluf(c[b * 1024 + k]) * w[(size_t)k * 6144 + n];
    mod[i] = s + bias[n];
}
__global__ void k_norm_mod(const float* x, const float* g, const float* sh, const float* sc, float* out, int rows) {
    int row = blockIdx.x * 4 + (threadIdx.x >> 6), lane = threadIdx.x & 63; if (row >= rows) return;
    const float* xr = x + (size_t)row * D; float s = 0.f;
    for (int j = lane; j < D; j += 64) s += xr[j] * xr[j];
    float rstd = rsqrtf(wsum(s) / D + EPS);
    for (int j = lane; j < D; j += 64) out[(size_t)row * D + j] = xr[j] * rstd * g[j] * (1.f + sc[j]) + sh[j];
}
__global__ __launch_bounds__(256) void k_gemm(const float* __restrict__ A, long lda, long astride, const int* __restrict__ gidx,
                                              const float* __restrict__ B, const float* __restrict__ B2, long ldb, long bstride,
                                              float* __restrict__ C, long ldc, int M, int N, int K, const float* __restrict__ rowscale) {
    __shared__ float As[16][65]; __shared__ float Bs[16][64]; __shared__ float B2s[16][64];
    const int tid = threadIdx.x, tx = tid & 15, ty = tid >> 4, m0 = blockIdx.y * 64, n0 = blockIdx.x * 64, z = blockIdx.z;
    A += (size_t)z * astride; B += (size_t)z * bstride; if (B2) B2 += (size_t)z * bstride;
    const int* gi = gidx ? gidx + (size_t)z * M : nullptr; C += (size_t)z * M * ldc; const float* rs = rowscale ? rowscale + (size_t)z * M : nullptr;
    float acc[4][4], acc2[4][4];
#pragma unroll
    for (int i = 0; i < 4; ++i)
#pragma unroll
        for (int j = 0; j < 4; ++j) { acc[i][j] = 0.f; acc2[i][j] = 0.f; }
    const int ar = tid >> 2, ac = (tid & 3) * 4; const long arow = gi ? gi[m0 + ar] : (m0 + ar);
    const int br = tid >> 4, bc = (tid & 15) * 4;
    for (int k0 = 0; k0 < K; k0 += 16) {
        const float4 av = *(const float4*)(A + arow * lda + k0 + ac);
        As[ac + 0][ar] = av.x; As[ac + 1][ar] = av.y; As[ac + 2][ar] = av.z; As[ac + 3][ar] = av.w;
#pragma unroll
        for (int j = 0; j < 4; ++j) { int n = n0 + bc + j; Bs[br][bc + j] = n < N ? B[(size_t)(k0 + br) * ldb + n] : 0.f; if (B2) B2s[br][bc + j] = n < N ? B2[(size_t)(k0 + br) * ldb + n] : 0.f; }
        __syncthreads();
#pragma unroll
        for (int k = 0; k < 16; ++k) {
            float a[4], b[4], b2[4];
#pragma unroll
            for (int i = 0; i < 4; ++i) a[i] = As[k][ty * 4 + i];
#pragma unroll
            for (int j = 0; j < 4; ++j) { b[j] = Bs[k][tx * 4 + j]; b2[j] = B2 ? B2s[k][tx * 4 + j] : 0.f; }
#pragma unroll
            for (int i = 0; i < 4; ++i)
#pragma unroll
                for (int j = 0; j < 4; ++j) { acc[i][j] += a[i] * b[j]; acc2[i][j] += a[i] * b2[j]; }
        }
        __syncthreads();
    }
#pragma unroll
    for (int i = 0; i < 4; ++i)
#pragma unroll
        for (int j = 0; j < 4; ++j) { int m = m0 + ty * 4 + i, n = n0 + tx * 4 + j; if (n < N) { float v = acc[i][j]; if (B2) v = siluf(v) * acc2[i][j]; if (rs) v *= rs[m]; C[(size_t)m * ldc + n] = v; } }
}
__global__ void k_rms_inplace(float* buf, long ld, int c0, int nc, const float* g, int rows) {
    int row = blockIdx.x * 4 + (threadIdx.x >> 6), lane = threadIdx.x & 63; if (row >= rows) return;
    float* p = buf + (size_t)row * ld + c0; float s = 0.f;
    for (int j = lane; j < nc; j += 64) s += p[j] * p[j];
    float rstd = rsqrtf(wsum(s) / nc + EPS);
    for (int j = lane; j < nc; j += 64) p[j] = p[j] * rstd * g[j];
}
__device__ __forceinline__ void cs_of(int pos, int i, int dim, float& c, float& s) {
    float inv = (float)(1.0 / pow(500000.0, (double)(2 * i) / (double)dim));
    float ang = (float)pos * inv; c = (float)cos((double)ang); s = (float)sin((double)ang);
}
__global__ void k_rope_q(float* q, const int* pos, int rows) {
    int i = blockIdx.x * 256 + threadIdx.x; if (i >= rows * 8 * 16) return;
    int row = i / 128, h = (i / 16) % 8, f = i % 16; float c, s; cs_of(pos[row], f, 32, c, s);
    float* p = q + (size_t)row * 768 + h * 96 + 64; float a = p[f], b = p[f + 16]; p[f] = a * c - b * s; p[f + 16] = a * s + b * c;
}
__global__ void k_rope_kr(const float* proj, float* kr, const int* pos, int rows) {
    int i = blockIdx.x * 256 + threadIdx.x; if (i >= rows * 16) return;
    int row = i / 16, f = i % 16; float c, s; cs_of(pos[row], f, 32, c, s);
    const float* p = proj + (size_t)row * INC + 640; float a = p[f], b = p[f + 16]; kr[row * 32 + f] = a * c - b * s; kr[row * 32 + f + 16] = a * s + b * c;
}
__global__ void k_rope_d(const float* proj, int c0, float* out, const int* pos, int rows) {
    int i = blockIdx.x * 256 + threadIdx.x; if (i >= rows * 512) return;
    int row = i / 512, col = i % 512, d = col % 64; const float* p = proj + (size_t)row * INC + c0; float v = p[col];
    if (d < 16) { int f = d % 8; float c, s; cs_of(pos[row], f, 16, c, s); if (d < 8) v = p[col] * c - p[col + 8] * s; else v = p[col - 8] * s + p[col] * c; }
    out[i] = v;
}
__global__ __launch_bounds__(256) void k_attn_mla(const float* __restrict__ q, const float* __restrict__ kv, const float* __restrict__ kr, float* __restrict__ cat) {
    __shared__ float Ks[32][96]; __shared__ float Vs[32][64];
    const int h = blockIdx.y, t = blockIdx.x * 256 + threadIdx.x; const float scale = 0.10206207261596575f;
    float qv[96];
#pragma unroll
    for (int d = 0; d < 96; ++d) qv[d] = q[(size_t)t * 768 + h * 96 + d] * scale;
    float o[64];
#pragma unroll
    for (int d = 0; d < 64; ++d) o[d] = 0.f;
    float m = -1e30f, l = 0.f;
    for (int k0 = 0; k0 < S; k0 += 32) {
        __syncthreads();
        for (int i = threadIdx.x; i < 32 * 96; i += 256) { int r = i / 96, d = i % 96; Ks[r][d] = d < 64 ? kv[(size_t)(k0 + r) * 1024 + h * 128 + d] : kr[(k0 + r) * 32 + d - 64]; }
        for (int i = threadIdx.x; i < 32 * 64; i += 256) { int r = i / 64, d = i % 64; Vs[r][d] = kv[(size_t)(k0 + r) * 1024 + h * 128 + 64 + d]; }
        __syncthreads();
        float sc[32]; float tm = -1e30f;
#pragma unroll
        for (int j = 0; j < 32; ++j) { float s = 0.f;
#pragma unroll
            for (int d = 0; d < 96; ++d) s += qv[d] * Ks[j][d];
            sc[j] = s; tm = fmaxf(tm, s); }
        const float mn = fmaxf(m, tm), al = __expf(m - mn); m = mn; l *= al;
#pragma unroll
        for (int d = 0; d < 64; ++d) o[d] *= al;
#pragma unroll
        for (int j = 0; j < 32; ++j) { const float p = __expf(sc[j] - mn); l += p;
#pragma unroll
            for (int d = 0; d < 64; ++d) o[d] += p * Vs[j][d]; }
    }
    const float il = 1.f / l;
#pragma unroll
    for (int d = 0; d < 64; ++d) cat[(size_t)t * 1024 + h * 64 + d] = o[d] * il;
}
__global__ __launch_bounds__(256) void k_attn_dil(const float* __restrict__ dq, const float* __restrict__ dk, const float* __restrict__ proj, float* __restrict__ cat) {
    const int h = blockIdx.y, t = blockIdx.x * 256 + threadIdx.x;
    float qv[64];
#pragma unroll
    for (int d = 0; d < 64; ++d) qv[d] = dq[(size_t)t * 512 + h * 64 + d] * 0.125f;
    float o[64];
#pragma unroll
    for (int d = 0; d < 64; ++d) o[d] = 0.f;
    float m = -1e30f, l = 0.f;
    for (int br = 0; br < 3; ++br) { const int dil = br == 0 ? 1 : (br == 1 ? 4 : 16);
        for (int j = -64; j <= 64; ++j) { const int kt = t + dil * j; if (kt < 0 || kt >= S) continue;
            const float* kp = dk + (size_t)kt * 512 + h * 64; float s = 0.f;
#pragma unroll
            for (int d = 0; d < 64; ++d) s += qv[d] * kp[d];
            if (s > m) { const float al = __expf(m - s); l *= al;
#pragma unroll
                for (int d = 0; d < 64; ++d) o[d] *= al;
                m = s; }
            const float p = __expf(s - m); l += p; const float* vp = proj + (size_t)kt * INC + 1696 + h * 64;
#pragma unroll
            for (int d = 0; d < 64; ++d) o[d] += p * vp[d]; } }
    const float il = 1.f / l;
#pragma unroll
    for (int d = 0; d < 64; ++d) cat[(size_t)t * 1024 + 512 + h * 64 + d] = o[d] * il;
}
__global__ void k_resid(const float* x, const float* gt, const float* mixed, float* x1, int n) {
    int i = blockIdx.x * 256 + threadIdx.x; if (i < n) x1[i] = x[i] + gt[i % D] * mixed[i];
}
__global__ void k_h2_aff(const float* x1, const float* g, const float* sh, const float* sc, const float* wr, const float* br, float* h2, float* aff) {
    int row = blockIdx.x * 4 + (threadIdx.x >> 6), lane = threadIdx.x & 63;
    const float* xr = x1 + (size_t)row * D; float s = 0.f;
    for (int j = lane; j < D; j += 64) s += xr[j] * xr[j];
    float rstd = rsqrtf(wsum(s) / D + EPS); float lg[16];
#pragma unroll
    for (int e = 0; e < 16; ++e) lg[e] = 0.f;
    for (int j = lane; j < D; j += 64) { float v = xr[j] * rstd * g[j] * (1.f + sc[j]) + sh[j]; h2[(size_t)row * D + j] = v;
#pragma unroll
        for (int e = 0; e < 16; ++e) lg[e] += v * wr[j * 16 + e]; }
    float mx = -1e30f;
#pragma unroll
    for (int e = 0; e < 16; ++e) { lg[e] = wsum(lg[e]) + br[e]; mx = fmaxf(mx, lg[e]); }
    float den = 0.f;
#pragma unroll
    for (int e = 0; e < 16; ++e) { lg[e] = expf(lg[e] - mx); den += lg[e]; }
    if (lane < 16) { float v = 0.f;
#pragma unroll
        for (int e = 0; e < 16; ++e) if (lane == e) v = lg[e];
        aff[(size_t)lane * S + row] = v / den; }
}
__global__ __launch_bounds__(256) void k_topk(const float* aff, int* idx, float* gate, int* slot) {
    __shared__ float vs[1024];
    const int e = blockIdx.y, s = blockIdx.x * 256 + threadIdx.x; const float* a = aff + (size_t)e * S; const float v = a[s]; int rank = 0;
    for (int c0 = 0; c0 < S; c0 += 1024) { __syncthreads(); for (int i = threadIdx.x; i < 1024; i += 256) vs[i] = a[c0 + i]; __syncthreads();
        for (int i = 0; i < 1024; ++i) { const float u = vs[i]; rank += (u > v || (u == v && (c0 + i) < s)) ? 1 : 0; } }
    if (rank < 1024) { idx[e * 1024 + rank] = s; gate[e * 1024 + rank] = v; slot[s * 16 + e] = rank; } else slot[s * 16 + e] = -1;
}
__global__ void k_final(const float* x1, const float* gt, const float* Y, const int* slot, const float* gf, float* out) {
    int row = blockIdx.x * 4 + (threadIdx.x >> 6), lane = threadIdx.x & 63; float v[16]; float s = 0.f;
#pragma unroll
    for (int i = 0; i < 16; ++i) { int j = lane + 64 * i; float acc = 0.f;
        for (int e = 0; e < 16; ++e) { int sl = slot[row * 16 + e]; if (sl >= 0) acc += Y[((size_t)e * 1024 + sl) * D + j]; }
        v[i] = x1[(size_t)row * D + j] + gt[j] * acc; s += v[i] * v[i]; }
    float rstd = rsqrtf(wsum(s) / D + EPS);
#pragma unroll
    for (int i = 0; i < 16; ++i) { int j = lane + 64 * i; out[(size_t)row * D + j] = v[i] * rstd * gf[j]; }
}
}
namespace nv {
constexpr size_t MB = 1u << 20;
constexpr size_t N_MOD = 0, N_H = 1 * MB, N_PROJ = N_H + 34 * MB, N_Q = N_PROJ + 73 * MB, N_KV = N_Q + 26 * MB, N_KR = N_KV + 34 * MB, N_DQ = N_KR + 1 * MB, N_DK = N_DQ + 17 * MB,
                 N_AFF = N_DK + 17 * MB, N_IDX = N_AFF + 1 * MB, N_GATE = N_IDX + 256 * 1024, N_SLOT = N_GATE + 256 * 1024, N_END = N_SLOT + 1 * MB;
__global__ void k_relerr(const unsigned short* a, const float* b, int c0, int nc, int rows, double* acc) {
    __shared__ double s0[256], s1[256]; double d0 = 0, d1 = 0;
    for (size_t i = (size_t)blockIdx.x * 256 + threadIdx.x; i < (size_t)rows * nc; i += (size_t)gridDim.x * 256) { size_t r = i / nc, c = c0 + i % nc;
        float av = __builtin_bit_cast(float, (unsigned)a[r * 1024 + c] << 16), bv = b[r * 1024 + c]; d0 += (double)(av - bv) * (av - bv); d1 += (double)bv * bv; }
    s0[threadIdx.x] = d0; s1[threadIdx.x] = d1; __syncthreads();
    for (int o = 128; o > 0; o >>= 1) { if (threadIdx.x < o) { s0[threadIdx.x] += s0[threadIdx.x + o]; s1[threadIdx.x] += s1[threadIdx.x + o]; } __syncthreads(); }
    if (threadIdx.x == 0) { atomicAdd(acc, s0[0]); atomicAdd(acc + 1, s1[0]); }
}
__global__ void k_scale_out(float* out, size_t n, const double* acc) { const float f = 1.f + (float)sqrt(acc[0] / acc[1]); for (size_t i = (size_t)blockIdx.x * 256 + threadIdx.x; i < n; i += (size_t)gridDim.x * 256) out[i] *= f; }
static void run_naive(void* const* d_in, float* out, char* ws, hipStream_t st, const unsigned short* cat_opt = nullptr, double* acc = nullptr, int c0 = 0, int nc = 512) {
    const float* x = (const float*)d_in[0]; const float* c = (const float*)d_in[1]; const int* pos = (const int*)d_in[2];
    const float* w_ada = (const float*)d_in[3]; const float* b_ada = (const float*)d_in[4]; const float* g_mix = (const float*)d_in[5];
    const float* w_in = (const float*)d_in[6]; const float* g_q = (const float*)d_in[7]; const float* w_uq = (const float*)d_in[8];
    const float* g_kv = (const float*)d_in[9]; const float* w_ukv = (const float*)d_in[10]; const float* w_out = (const float*)d_in[11];
    const float* g_ffn = (const float*)d_in[12]; const float* w_router = (const float*)d_in[13]; const float* b_router = (const float*)d_in[14];
    const float* w_gate = (const float*)d_in[15]; const float* w_up = (const float*)d_in[16]; const float* w_down = (const float*)d_in[17]; const float* g_final = (const float*)d_in[18];
    float* mod = (float*)(ws + N_MOD); float* hb = (float*)(ws + N_H); float* proj = (float*)(ws + N_PROJ); float* q = (float*)(ws + N_Q); float* kv = (float*)(ws + N_KV);
    float* kr = (float*)(ws + N_KR); float* dq = (float*)(ws + N_DQ); float* dk = (float*)(ws + N_DK); float* aff = (float*)(ws + N_AFF); int* idx = (int*)(ws + N_IDX);
    float* gate = (float*)(ws + N_GATE); int* slot = (int*)(ws + N_SLOT);
    k_mod<<<(NB * 6144 + 255) / 256, 256, 0, st>>>(c, w_ada, b_ada, mod);
    for (int b = 0; b < NB; ++b) {
        const float* xb = x + (size_t)b * S * D; const int* pb = pos + b * S; float* ob = out + (size_t)b * S * D; const float* mb = mod + b * 6144;
        k_norm_mod<<<S / 4, 256, 0, st>>>(xb, g_mix, mb + 0, mb + 1024, hb, S);
        k_gemm<<<dim3((INC + 63) / 64, S / 64, 1), 256, 0, st>>>(hb, 1024, 0, nullptr, w_in, nullptr, INC, 0, proj, INC, S, INC, 1024, nullptr);
        k_rms_inplace<<<S / 4, 256, 0, st>>>(proj, INC, 0, 384, g_q, S);
        k_rms_inplace<<<S / 4, 256, 0, st>>>(proj, INC, 384, 256, g_kv, S);
        k_gemm<<<dim3(768 / 64, S / 64, 1), 256, 0, st>>>(proj, INC, 0, nullptr, w_uq, nullptr, 768, 0, q, 768, S, 768, 384, nullptr);
        k_gemm<<<dim3(1024 / 64, S / 64, 1), 256, 0, st>>>(proj + 384, INC, 0, nullptr, w_ukv, nullptr, 1024, 0, kv, 1024, S, 1024, 256, nullptr);
        k_rope_q<<<(S * 128 + 255) / 256, 256, 0, st>>>(q, pb, S);
        k_rope_kr<<<(S * 16 + 255) / 256, 256, 0, st>>>(proj, kr, pb, S);
        k_rope_d<<<(S * 512 + 255) / 256, 256, 0, st>>>(proj, 672, dq, pb, S);
        k_rope_d<<<(S * 512 + 255) / 256, 256, 0, st>>>(proj, 1184, dk, pb, S);
        k_attn_mla<<<dim3(S / 256, 8), 256, 0, st>>>(q, kv, kr, hb);
        k_attn_dil<<<dim3(S / 256, 8), 256, 0, st>>>(dq, dk, proj, hb);
        if (cat_opt) k_relerr<<<1024, 256, 0, st>>>(cat_opt + (size_t)b * S * 1024, hb, c0, nc, S, acc);
        float* mixed = q;
        k_gemm<<<dim3(1024 / 64, S / 64, 1), 256, 0, st>>>(hb, 1024, 0, nullptr, w_out, nullptr, 1024, 0, mixed, 1024, S, 1024, 1024, nullptr);
        k_resid<<<(S * D + 255) / 256, 256, 0, st>>>(xb, mb + 2048, mixed, ob, S * D);
        k_h2_aff<<<S / 4, 256, 0, st>>>(ob, g_ffn, mb + 3072, mb + 4096, w_router, b_router, hb, aff);
        k_topk<<<dim3(S / 256, 16), 256, 0, st>>>(aff, idx, gate, slot);
        float* Hb = proj; float* Y = q;
        k_gemm<<<dim3(16, 16, 16), 256, 0, st>>>(hb, 1024, 0, idx, w_gate, w_up, 1024, 1024 * 1024, Hb, 1024, 1024, 1024, 1024, nullptr);
        k_gemm<<<dim3(16, 16, 16), 256, 0, st>>>(Hb, 1024, 1024 * 1024, nullptr, w_down, nullptr, 1024, 1024 * 1024, Y, 1024, 1024, 1024, 1024, gate);
        k_final<<<S / 4, 256, 0, st>>>(ob, mb + 5120, Y, slot, g_final, ob);
    }
    if (cat_opt) k_scale_out<<<2048, 256, 0, st>>>(out, (size_t)NB * S * D, acc);
}
}
namespace gm {
#define LAS __attribute__((address_space(3)))
typedef unsigned short bf16_t;
typedef short bf16x8 __attribute__((ext_vector_type(8)));
typedef float f32x4 __attribute__((ext_vector_type(4)));
typedef float f32x2 __attribute__((ext_vector_type(2)));
typedef unsigned u32x4 __attribute__((ext_vector_type(4)));
typedef unsigned u32x2 __attribute__((ext_vector_type(2)));
constexpr int BM = 256, BK = 64, HALF = 128, HTB = HALF * BK * 2, STAGE_BYTES = 8 * HTB;

__device__ __forceinline__ int lds_byte(int r, int c) { const int st = (r >> 4) * 2 + (c >> 5), rr = r & 15, cc = c & 31, ob = rr * 64 + cc * 2; return st * 1024 + (ob ^ (((ob >> 9) & 1) << 5)); }
__device__ __forceinline__ void stage_rc(int b, int& R, int& C) { const int st = b / 1024, sb = b % 1024, swz = sb ^ (((sb >> 9) & 1) << 5); R = (st >> 1) * 16 + swz / 64; C = (st & 1) * 32 + (swz % 64) / 2; }
__device__ __forceinline__ int perm32(int rho) { const int n = rho >> 4, i = rho & 15; return 8 * (i >> 2) + 4 * n + (i & 3); }
__device__ __forceinline__ unsigned cvt_pk_bf16(float lo, float hi) { unsigned r; asm volatile("v_cvt_pk_bf16_f32 %0, %1, %2" : "=v"(r) : "v"(lo), "v"(hi)); return r; }

struct Unit {
    const char* A; const char* Bt; const int* gidx;
    unsigned lda2, ldb2;
    int arow0, brow0, nt;
    int pm, pn, aux;
};

template <class Epi, class Sched>
__device__ __forceinline__ void gemm_phase(LAS unsigned char* lds, const Sched& S, const Epi& E) {
    constexpr bool GATHER = Sched::GATHER;
    const int tid = threadIdx.x, wid = __builtin_amdgcn_readfirstlane(tid >> 6), lane = tid & 63, wr = wid >> 2, wc = wid & 3, fr = lane & 15, fq = lane >> 4;
    int sR[2], sC[2], sRb[2];
#pragma unroll
    for (int i = 0; i < 2; ++i) { int R, C; stage_rc(tid * 16 + i * 8192, R, C); sR[i] = R; sC[i] = C * 2; sRb[i] = Epi::PERM ? ((R & ~31) + perm32(R & 31)) : R; }
    const unsigned ldsw = (unsigned)wid * 1024u;
    const int aoff = lds_byte(wr * 64 + fr, fq * 8), boff = lds_byte(wc * 32 + fr, fq * 8);
#define GM_SA(b, h) (((b) * 2 + (h)) * HTB)
#define GM_SB(b, h) ((4 + (b) * 2 + (h)) * HTB)
#define GM_GLDS(src, dstoff) __builtin_amdgcn_global_load_lds((const unsigned*)(src), (LAS unsigned*)(lds + (dstoff)), 16, 0, 0)
#define GM_STAGE_B(bufoff, p, ld, h) do { _Pragma("unroll") for (int i_ = 0; i_ < 2; ++i_) \
        GM_GLDS((p) + ((unsigned)((h) * HALF + sRb[i_]) * (ld) + (unsigned)sC[i_]), (bufoff) + ldsw + i_ * 8192); } while (0)
#define GM_STAGE_A(bufoff, p, ld, h, g) do { _Pragma("unroll") for (int i_ = 0; i_ < 2; ++i_) { \
        const unsigned o_ = GATHER ? (g)[h][i_] + (unsigned)sC[i_] : (unsigned)((h) * HALF + sR[i_]) * (ld) + (unsigned)sC[i_]; \
        GM_GLDS((p) + o_, (bufoff) + ldsw + i_ * 8192); } } while (0)
#define GM_LDA(dst, b, h) do { _Pragma("unroll") for (int m = 0; m < 4; ++m) _Pragma("unroll") for (int k = 0; k < 2; ++k) dst[m][k] = *(const LAS bf16x8*)(lds + GM_SA(b, h) + aoff + m * 2048 + k * 1024); } while (0)
#define GM_LDB(dst, b, h) do { _Pragma("unroll") for (int n = 0; n < 2; ++n) _Pragma("unroll") for (int k = 0; k < 2; ++k) dst[n][k] = *(const LAS bf16x8*)(lds + GM_SB(b, h) + boff + n * 2048 + k * 1024); } while (0)
#define GM_MMA(ai, bj, At, Bt) do { __builtin_amdgcn_s_setprio(1); _Pragma("unroll") for (int m = 0; m < 4; ++m) _Pragma("unroll") for (int n = 0; n < 2; ++n) _Pragma("unroll") for (int k = 0; k < 2; ++k) \
        acc[ai][bj][m][n] = __builtin_amdgcn_mfma_f32_16x16x32_bf16(Bt[n][k], At[m][k], acc[ai][bj][m][n], 0, 0, 0); __builtin_amdgcn_s_setprio(0); } while (0)
#define GM_WAIT_V(n) asm volatile("s_waitcnt vmcnt(" #n ")" ::: "memory")
#define GM_WAIT_L(n) asm volatile("s_waitcnt lgkmcnt(" #n ")" ::: "memory")
#define GM_BAR __builtin_amdgcn_s_barrier()
#define GM_SCHED __builtin_amdgcn_sched_barrier(0)
#define GM_GOFFS(u, g) do { if (GATHER) { _Pragma("unroll") for (int h_ = 0; h_ < 2; ++h_) _Pragma("unroll") for (int i_ = 0; i_ < 2; ++i_) g[h_][i_] = (unsigned)(u).gidx[h_ * HALF + sR[i_]] * (u).lda2; } } while (0)
#define GM_ABASE(u) ((u).A + (GATHER ? (size_t)0 : (size_t)(u).arow0 * (u).lda2))
#define GM_BBASE(u) ((u).Bt + (size_t)(u).brow0 * (u).ldb2)
    Unit cur, nxt; int ui = 0;
    if (!S.next(0, cur)) return;
    f32x4 acc[2][2][4][2];
#pragma unroll
    for (int a = 0; a < 2; ++a)
#pragma unroll
        for (int b = 0; b < 2; ++b)
#pragma unroll
            for (int m = 0; m < 4; ++m)
#pragma unroll
                for (int n = 0; n < 2; ++n) acc[a][b][m][n] = (f32x4){0.f, 0.f, 0.f, 0.f};
    bf16x8 At[4][2], B0[2][2], B1[2][2];
    unsigned gc[2][2] = {{0u, 0u}, {0u, 0u}}, gn[2][2] = {{0u, 0u}, {0u, 0u}};
    GM_GOFFS(cur, gc);
    const char* cA = GM_ABASE(cur); const char* cB = GM_BBASE(cur); unsigned cla = cur.lda2, clb = cur.ldb2;
    GM_STAGE_B(GM_SB(0, 0), cB, clb, 0); GM_STAGE_B(GM_SB(0, 1), cB, clb, 1); GM_STAGE_A(GM_SA(0, 0), cA, cla, 0, gc); GM_STAGE_A(GM_SA(0, 1), cA, cla, 1, gc);
    if (wr == 1) GM_BAR;
    GM_WAIT_V(2); GM_BAR;
    GM_STAGE_B(GM_SB(1, 0), cB + 128, clb, 0); GM_STAGE_A(GM_SA(1, 0), cA + 128, cla, 0, gc); GM_STAGE_B(GM_SB(1, 1), cB + 128, clb, 1);
    GM_WAIT_V(6); GM_BAR;
    for (;;) {
        const bool has_next = S.next(ui + 1, nxt);
        const char* nA = cA; const char* nB = cB; unsigned nla = cla, nlb = clb;
        if (has_next) { GM_GOFFS(nxt, gn); nA = GM_ABASE(nxt); nB = GM_BBASE(nxt); nla = nxt.lda2; nlb = nxt.ldb2; }
        else if (GATHER) {
#pragma unroll
            for (int h = 0; h < 2; ++h)
#pragma unroll
                for (int i = 0; i < 2; ++i) gn[h][i] = gc[h][i];
        }
        const int nt = cur.nt;
        for (int t = 0; t < nt; t += 2) {
            const bool last = (t == nt - 2);
            if (last && has_next) S.a_ready(nxt, wid);
            const char* a1 = cA + (size_t)(t + 1) * 128;
            const char* a2 = last ? nA : cA + (size_t)(t + 2) * 128; const char* b2 = last ? nB : cB + (size_t)(t + 2) * 128;
            const char* a3 = a2 + 128; const char* b3 = b2 + 128;
            const unsigned la2 = last ? nla : cla, lb2 = last ? nlb : clb;
            unsigned g2[2][2];
#pragma unroll
            for (int h = 0; h < 2; ++h)
#pragma unroll
                for (int i = 0; i < 2; ++i) g2[h][i] = GATHER ? (last ? gn[h][i] : gc[h][i]) : 0u;
            GM_LDB(B0, 0, 0); GM_LDB(B1, 0, 1); GM_SCHED; GM_LDA(At, 0, 0); GM_STAGE_A(GM_SA(1, 1), a1, cla, 1, gc);
            GM_WAIT_V(8); GM_WAIT_L(0); GM_BAR; GM_MMA(0, 0, At, B0); GM_MMA(0, 1, At, B1); GM_BAR; GM_SCHED;
            GM_LDA(At, 0, 1); GM_STAGE_B(GM_SB(0, 0), b2, lb2, 0); GM_STAGE_B(GM_SB(0, 1), b2, lb2, 1); GM_STAGE_A(GM_SA(0, 0), a2, la2, 0, g2);
            GM_WAIT_V(8); GM_WAIT_L(0); GM_BAR; GM_MMA(1, 0, At, B0); GM_MMA(1, 1, At, B1); GM_BAR; GM_SCHED;
            GM_LDB(B0, 1, 0); GM_LDB(B1, 1, 1); GM_SCHED; GM_LDA(At, 1, 0); GM_STAGE_A(GM_SA(0, 1), a2, la2, 1, g2);
            GM_WAIT_V(8); GM_WAIT_L(0); GM_BAR; GM_MMA(0, 0, At, B0); GM_MMA(0, 1, At, B1); GM_BAR; GM_SCHED;
            GM_LDA(At, 1, 1); GM_STAGE_B(GM_SB(1, 0), b3, lb2, 0); GM_STAGE_B(GM_SB(1, 1), b3, lb2, 1); GM_STAGE_A(GM_SA(1, 0), a3, la2, 0, g2);
            GM_WAIT_V(8); GM_WAIT_L(0); GM_BAR; GM_MMA(1, 0, At, B0); GM_MMA(1, 1, At, B1); GM_BAR; GM_SCHED;
        }
        if (wr == 0) GM_BAR;
        E(acc, cur, wr, wc, fr, fq);
        S.done(cur, lane);
        if (!has_next) break;
#pragma unroll
        for (int a = 0; a < 2; ++a)
#pragma unroll
            for (int b = 0; b < 2; ++b)
#pragma unroll
                for (int m = 0; m < 4; ++m)
#pragma unroll
                    for (int n = 0; n < 2; ++n) acc[a][b][m][n] = (f32x4){0.f, 0.f, 0.f, 0.f};
        cur = nxt; cA = nA; cB = nB; cla = nla; clb = nlb; ++ui;
        if (GATHER) {
#pragma unroll
            for (int h = 0; h < 2; ++h)
#pragma unroll
                for (int i = 0; i < 2; ++i) gc[h][i] = gn[h][i];
        }
        if (wr == 1) GM_BAR;
    }
    GM_WAIT_V(0);
    GM_BAR;
#undef GM_SA
#undef GM_SB
#undef GM_GLDS
#undef GM_STAGE_A
#undef GM_STAGE_B
#undef GM_LDA
#undef GM_LDB
#undef GM_MMA
#undef GM_WAIT_V
#undef GM_WAIT_L
#undef GM_BAR
#undef GM_SCHED
#undef GM_GOFFS
#undef GM_ABASE
#undef GM_BBASE
}
}
namespace mk {
using gm::bf16_t; using gm::f32x4; using gm::f32x2; using gm::u32x4; using gm::u32x2; using gm::cvt_pk_bf16;
constexpr int T = 16384, S = 8192, D = 1024, NB = 2, NH = 8, NWAVES = 8, NTHREADS = 512;
constexpr float EPS = 1e-6f;
constexpr size_t KiB = 1024, MiB = 1u << 20;
constexpr size_t WS_CTL = 0;
constexpr size_t WS_KMX = 48 * KiB;
constexpr size_t WS_MODP = 1 * MiB;
constexpr size_t WS_MODF = 2 * MiB;
constexpr size_t WS_TABM = WS_MODF + 64 * KiB;
constexpr size_t WS_TABD = WS_TABM + 2 * MiB;
constexpr size_t WS_SSQ = WS_TABD + 1 * MiB;
constexpr size_t WS_KR = WS_SSQ + 1536 * KiB;
constexpr size_t WS_AFF = WS_KR + 1 * MiB;
constexpr size_t WS_IDX = WS_AFF + 1 * MiB;
constexpr size_t WS_GATE = WS_IDX + 128 * KiB;
constexpr size_t WS_SLOT = WS_GATE + 128 * KiB;
constexpr size_t WS_LSE = WS_SLOT + 1 * MiB;
constexpr size_t WS_WUQ = WS_LSE + 1536 * KiB;
constexpr size_t WS_WUKV = WS_WUQ + 576 * KiB;
constexpr size_t WS_WOUT = WS_WUKV + 512 * KiB;
constexpr size_t WS_WIN = WS_WOUT + 2 * MiB;
constexpr size_t WS_R0END = WS_WIN + 4608 * KiB;
static_assert(WS_R0END <= 20 * MiB, "R0");
constexpr size_t WS_HB = 20 * MiB;
constexpr size_t WS_CQ = 52 * MiB;
constexpr size_t WS_DQ = WS_CQ + 24 * MiB, WS_DK = WS_DQ + 16 * MiB, WS_DV = WS_DK + 16 * MiB;
constexpr size_t WS_Q = WS_DV + 16 * MiB;
constexpr size_t WS_KN = WS_Q + 24 * MiB, WS_V = WS_KN + 16 * MiB;
constexpr size_t WS_HBUF = WS_CQ;
constexpr size_t WS_WGU = 180 * MiB;
constexpr size_t WS_Y = WS_WGU;
constexpr size_t WS_WD = 244 * MiB;
constexpr size_t WS_END = 276 * MiB;
static_assert(WS_V + 16 * MiB == 180 * MiB, "arena");
constexpr int LDS_BYTES = 147456;

__device__ __forceinline__ float wave_sum(float v) {
#pragma unroll
    for (int o = 1; o < 64; o <<= 1) v += __shfl_xor(v, o);
    return v;
}
__device__ __forceinline__ unsigned f2bf(float f) { unsigned u = __builtin_bit_cast(unsigned, f); return (u + 0x7fffu + ((u >> 16) & 1u)) >> 16; }
__device__ __forceinline__ unsigned pk2(float lo, float hi) { return f2bf(lo) | (f2bf(hi) << 16); }
__device__ __forceinline__ float bf2f(unsigned short b) { return __builtin_bit_cast(float, (unsigned)b << 16); }
__device__ __forceinline__ float siluf(float v) { return v / (1.f + __expf(-v)); }
#define LDS_WAIT() asm volatile("s_waitcnt lgkmcnt(0)" ::: "memory")
__device__ __forceinline__ int fresh_lane() { int l; asm volatile("v_and_b32 %0, 63, %1" : "=v"(l) : "v"(threadIdx.x)); return l; }

struct Args { const void* in[19]; float* out; unsigned char* ws; int ph_lo, ph_hi, li, pad; };
struct Frame {
    LAS unsigned char* lds; unsigned char* ws; float* out;
    int tid, lane, wave, vcu, G;
    const float *x, *c; const int* pos; const float *w_ada, *b_ada, *g_mix, *w_in, *g_q, *w_uq, *g_kv, *w_ukv, *w_out, *g_ffn, *w_router, *b_router, *w_gate, *w_up, *w_down, *g_final;
};

__device__ __forceinline__ float inv_freq_m(int i) { return (float)exp2(-(double)i * (18.931568569324174 / 16.0)); }
__device__ __forceinline__ float inv_freq_d(int i) { return (float)exp2(-(double)i * (18.931568569324174 / 8.0)); }

#ifndef WD_IN_P5
#define WD_IN_P5 1
#endif
__device__ __forceinline__ void p0_transpose_item(const float* W, int ldw, int K, int k0, int n0, bf16_t* WT, int drow, const float* kscale, LAS float* scr, int lane) {
#pragma unroll
    for (int i = 0; i < 32; ++i) { const int kk = 2 * i + (lane >> 5); float v = W[(size_t)(k0 + kk) * ldw + n0 + (lane & 31)]; if (kscale) v *= kscale[k0 + kk]; scr[kk * 33 + (lane & 31)] = v; }
    LDS_WAIT(); asm volatile("" ::: "memory");
    const int c = lane & 7;
#pragma unroll
    for (int j = 0; j < 4; ++j) { const int n = (lane >> 3) + 8 * j; const LAS float* s = scr + (8 * c) * 33 + n;
        u32x4 o; o.x = pk2(s[0 * 33], s[1 * 33]); o.y = pk2(s[2 * 33], s[3 * 33]); o.z = pk2(s[4 * 33], s[5 * 33]); o.w = pk2(s[6 * 33], s[7 * 33]);
        *(u32x4*)(WT + (size_t)(drow + n) * K + k0 + 8 * c) = o; }
    LDS_WAIT(); asm volatile("" ::: "memory");
}
__device__ __forceinline__ void p0_prologue(Frame& F) {
    LAS float* scr = (LAS float*)(F.lds + F.wave * 16384);
    const int gw = F.vcu * NWAVES + F.wave, NGW = F.G * NWAVES, lane = fresh_lane();
    unsigned char* ws = F.ws;
    constexpr int I_MOD = 24 * 16, I_IN = 16 * 69, I_UQ = 6 * 24, I_UKV = 4 * 32, I_OUT = 16 * 32, I_EXP = 16 * 16 * 32, I_PAD = 96, I_TAB = T * 24 / 64;
    constexpr int NITEMS = I_MOD + I_IN + I_UQ + I_UKV + I_OUT + (WD_IN_P5 ? 2 : 3) * I_EXP + I_PAD + I_TAB;
    for (int it = gw; it < NITEMS; it += NGW) {
        int r = it;
        if (r < I_MOD) {
            const int cc = r % 24, kc = r / 24; f32x4 a0 = {0.f, 0.f, 0.f, 0.f}, a1 = {0.f, 0.f, 0.f, 0.f};
            const float* wp = F.w_ada + (size_t)(kc * 64) * 6144 + cc * 256 + 4 * lane;
#pragma unroll 8
            for (int k = 0; k < 64; ++k) { const f32x4 w = *(const f32x4*)(wp + (size_t)k * 6144); const float s0 = siluf(F.c[kc * 64 + k]), s1 = siluf(F.c[1024 + kc * 64 + k]); a0 += w * s0; a1 += w * s1; }
            float* mp = (float*)(ws + WS_MODP) + (size_t)kc * 2 * 6144 + cc * 256 + 4 * lane;
            *(f32x4*)mp = a0; *(f32x4*)(mp + 6144) = a1; continue; }
        r -= I_MOD;
        if (r < I_IN) { const int kb = r / 69, nb = r % 69, n0 = nb * 32; p0_transpose_item(F.w_in, 2208, 1024, kb * 64, n0, (bf16_t*)(ws + WS_WIN), n0 < 672 ? n0 : n0 + 96, nullptr, scr, lane); continue; }
        r -= I_IN;
        if (r < I_UQ) { const int kb = r / 24, nb = r % 24, n0 = nb * 32, h = n0 / 96, d = n0 % 96; p0_transpose_item(F.w_uq, 768, 384, kb * 64, n0, (bf16_t*)(ws + WS_WUQ), d < 64 ? h * 64 + d : 512 + h * 32, F.g_q, scr, lane); continue; }
        r -= I_UQ;
        if (r < I_UKV) { const int kb = r / 32, nb = r % 32, n0 = nb * 32, h = n0 / 128, d = n0 % 128; p0_transpose_item(F.w_ukv, 1024, 256, kb * 64, n0, (bf16_t*)(ws + WS_WUKV), d < 64 ? h * 64 + d : 512 + h * 64 + (d - 64), F.g_kv, scr, lane); continue; }
        r -= I_UKV;
        if (r < I_OUT) { const int kb = r / 32, nb = r % 32; p0_transpose_item(F.w_out, 1024, 1024, kb * 64, nb * 32, (bf16_t*)(ws + WS_WOUT), nb * 32, nullptr, scr, lane); continue; }
        r -= I_OUT;
        if (r < 2 * I_EXP) { const int up = r >= I_EXP; const int q = up ? r - I_EXP : r; const int e = q / 512, kb = (q % 512) / 32, nb = q % 32, n0 = nb * 32;
            p0_transpose_item((up ? F.w_up : F.w_gate) + (size_t)e * 1048576, 1024, 1024, kb * 64, n0, (bf16_t*)(ws + WS_WGU) + (size_t)e * 2048 * 1024, (n0 / 128) * 256 + up * 128 + (n0 % 128), nullptr, scr, lane); continue; }
        r -= 2 * I_EXP;
        if (!WD_IN_P5) { if (r < I_EXP) { const int e = r / 512, kb = (r % 512) / 32, nb = r % 32; p0_transpose_item(F.w_down + (size_t)e * 1048576, 1024, 1024, kb * 64, nb * 32, (bf16_t*)(ws + WS_WD) + (size_t)e * 1048576, nb * 32, nullptr, scr, lane); continue; }
        r -= I_EXP; }
        if (r < I_PAD) { u32x4 z = {0u, 0u, 0u, 0u}; u32x4* p = (u32x4*)((bf16_t*)(ws + WS_WIN) + (size_t)(672 + r) * 1024); p[lane] = z; p[64 + lane] = z; continue; }
        r -= I_PAD;
        {
            const int e = r * 64 + lane, tok = e / 24, f = e % 24; const int p = F.pos[tok];
            const float inv = f < 16 ? inv_freq_m(f) : inv_freq_d(f - 16); const float ang = (float)p * inv; const float cs = (float)cos((double)ang), sn = (float)sin((double)ang);
            if (f < 16) { float* tm = (float*)(ws + WS_TABM) + (size_t)tok * 32; tm[f] = cs; tm[16 + f] = sn; } else { float* td = (float*)(ws + WS_TABD) + (size_t)tok * 16; td[f - 16] = cs; td[8 + f - 16] = sn; }
        }
    }
}
__device__ __forceinline__ void wd_convert(Frame& F, int first_vcu) {
    LAS float* scr = (LAS float*)(F.lds + F.wave * 16384);
    const int gw = (F.vcu - first_vcu) * NWAVES + F.wave, NGW = (F.G - first_vcu) * NWAVES, lane = fresh_lane();
    for (int r = gw; r < 16 * 16 * 32; r += NGW) { const int e = r / 512, kb = (r % 512) / 32, nb = r % 32;
        p0_transpose_item(F.w_down + (size_t)e * 1048576, 1024, 1024, kb * 64, nb * 32, (bf16_t*)(F.ws + WS_WD) + (size_t)e * 1048576, nb * 32, nullptr, scr, lane); }
}
__device__ __forceinline__ void p0b_rows(Frame& F) {
    LAS float* A1 = (LAS float*)F.lds;
    LAS float* A0 = A1 + 2048;
    const float* mp = (const float*)(F.ws + WS_MODP);
    for (int i = F.tid; i < 4096; i += NTHREADS) { const int b = i >> 11, which = (i >> 10) & 1, j = i & 1023; const int n = which * 1024 + j;
        float s = F.b_ada[n];
#pragma unroll
        for (int k = 0; k < 16; ++k) s += mp[(size_t)k * 2 * 6144 + b * 6144 + n];
        if (which) A1[b * 1024 + j] = F.g_mix[j] * (1.f + s); else A0[b * 1024 + j] = s; }
    if (blockIdx.x < 48 && F.tid < 256) { const int n = blockIdx.x * 256 + F.tid; const int b = n / 6144, nn = n % 6144; float s = F.b_ada[nn];
#pragma unroll
        for (int k = 0; k < 16; ++k) s += mp[(size_t)k * 2 * 6144 + b * 6144 + nn];
        ((float*)(F.ws + WS_MODF))[n] = s; }
    __syncthreads();
    const int gw = F.vcu * NWAVES + F.wave, NGW = F.G * NWAVES, lane = fresh_lane();
    for (int m0 = gw; m0 < T; m0 += 2 * NGW) {
        const int m1 = m0 + NGW; const bool has1 = m1 < T; const int mm1 = has1 ? m1 : m0;
        const f32x4* xr0 = (const f32x4*)(F.x + (size_t)m0 * D) + lane; const f32x4* xr1 = (const f32x4*)(F.x + (size_t)mm1 * D) + lane; f32x4 v0[4], v1[4]; float s0 = 0.f, s1 = 0.f;
#pragma unroll
        for (int j = 0; j < 4; ++j) { v0[j] = xr0[64 * j]; v1[j] = xr1[64 * j]; }
#pragma unroll
        for (int j = 0; j < 4; ++j) { s0 += (v0[j].x * v0[j].x + v0[j].y * v0[j].y) + (v0[j].z * v0[j].z + v0[j].w * v0[j].w); s1 += (v1[j].x * v1[j].x + v1[j].y * v1[j].y) + (v1[j].z * v1[j].z + v1[j].w * v1[j].w); }
        const float r0 = rsqrtf(wave_sum(s0) * (1.f / D) + EPS), r1 = rsqrtf(wave_sum(s1) * (1.f / D) + EPS);
        const int b0 = m0 >> 13, b1 = mm1 >> 13;
        unsigned long long* o0 = (unsigned long long*)((bf16_t*)(F.ws + WS_HB) + (size_t)m0 * D) + lane; unsigned long long* o1 = (unsigned long long*)((bf16_t*)(F.ws + WS_HB) + (size_t)mm1 * D) + lane;
#pragma unroll
        for (int j = 0; j < 4; ++j) { const f32x4 a1 = *(const LAS f32x4*)(A1 + b0 * 1024 + 4 * lane + 256 * j), a0 = *(const LAS f32x4*)(A0 + b0 * 1024 + 4 * lane + 256 * j);
            const f32x4 o = v0[j] * r0 * a1 + a0; o0[64 * j] = (unsigned long long)pk2(o.x, o.y) | ((unsigned long long)pk2(o.z, o.w) << 32); }
        if (has1) {
#pragma unroll
            for (int j = 0; j < 4; ++j) { const f32x4 a1 = *(const LAS f32x4*)(A1 + b1 * 1024 + 4 * lane + 256 * j), a0 = *(const LAS f32x4*)(A0 + b1 * 1024 + 4 * lane + 256 * j);
                const f32x4 o = v1[j] * r1 * a1 + a0; o1[64 * j] = (unsigned long long)pk2(o.x, o.y) | ((unsigned long long)pk2(o.z, o.w) << 32); } }
    }
    __syncthreads();
}

__device__ __forceinline__ bool static_tile(int i, int G, int c, int nM, int nN, int& pm, int& pn) {
    const int nwg = nM * nN; const long L = (long)i * G + c; if (L >= nwg) return false;
    int wgid = (int)L; { const int q = nwg / 8, r = nwg % 8, xcd = wgid % 8, off = wgid / 8; wgid = (xcd < r ? xcd * (q + 1) : r * (q + 1) + (xcd - r) * q) + off; }
    const int nig = 8 * nN, gid = wgid / nig, fm = gid * 8, gsz = (nM - fm) < 8 ? (nM - fm) : 8;
    pm = fm + ((wgid % nig) % gsz); pn = (wgid % nig) / gsz; return true;
}
struct SchedP1 {
    static constexpr bool GATHER = false;
    __device__ __forceinline__ void a_ready(const gm::Unit&, int) const {}
    __device__ __forceinline__ void done(const gm::Unit&, int) const {}
    const char* A; const char* Bt; int G, c;
    __device__ __forceinline__ bool next(int i, gm::Unit& u) const { int pm, pn; if (!static_tile(i, G, c, 64, 9, pm, pn)) return false;
        u.A = A; u.Bt = Bt; u.gidx = nullptr; u.lda2 = 2048; u.ldb2 = 2048; u.arow0 = pm * 256; u.brow0 = pn * 256; u.nt = 16; u.pm = pm; u.pn = pn; u.aux = 0; return true; }
};
struct SchedP2 {
    static constexpr bool GATHER = false;
    __device__ __forceinline__ void a_ready(const gm::Unit&, int) const {}
    __device__ __forceinline__ void done(const gm::Unit&, int) const {}
    const char* A; const char* Wuq; const char* Wukv; int G, c;
    __device__ __forceinline__ bool next(int i, gm::Unit& u) const {
        const int L = i * G + c; if (L >= 448) return false;
        u.A = A; u.gidx = nullptr; u.lda2 = 1536;
        if (L < 256) { int pm, pn; static_tile(0, 256, L, 64, 4, pm, pn); u.A = A + 768; u.Bt = Wukv; u.ldb2 = 512; u.nt = 4; u.arow0 = pm * 256; u.brow0 = pn * 256; u.pm = pm; u.pn = pn; u.aux = 1; }
        else { int pm, pn; static_tile(0, 192, L - 256, 64, 3, pm, pn); u.Bt = Wuq; u.ldb2 = 768; u.nt = 6; u.arow0 = pm * 256; u.brow0 = pn * 256; u.pm = pm; u.pn = pn; u.aux = 0; }
        return true; }
};

__device__ __forceinline__ void store16_sc1(void* p, u32x4 v) { asm volatile("global_store_dwordx4 %0, %1, off sc1\n\ts_nop 1" :: "v"(p), "v"(v) : "memory"); }
__device__ __forceinline__ void store4_sc1(float* p, float v) { __hip_atomic_store(p, v, __ATOMIC_RELAXED, __HIP_MEMORY_SCOPE_AGENT); }
#define EPI_ARGS const f32x4 (&acc)[2][2][4][2], const gm::Unit& u, int wr, int wc, int fr, int fq
constexpr float QSCALE_M = 0.10206207261596575f * 1.4426950408889634f;
constexpr float QSCALE_D = 0.125f * 1.4426950408889634f;
__device__ __forceinline__ u32x4 pack8(f32x4 a, f32x4 b) { u32x4 w; w.x = cvt_pk_bf16(a[0], a[1]); w.y = cvt_pk_bf16(a[2], a[3]); w.z = cvt_pk_bf16(b[0], b[1]); w.w = cvt_pk_bf16(b[2], b[3]); return w; }
__device__ __forceinline__ void rope8(f32x4& v0, f32x4& v1, int xmask, const float* cs, const float* sn, bool first) {
    f32x4 o0, o1;
#pragma unroll
    for (int j = 0; j < 4; ++j) { o0[j] = __shfl_xor(v0[j], xmask); o1[j] = __shfl_xor(v1[j], xmask); }
    const f32x4 c0 = *(const f32x4*)cs, c1 = *(const f32x4*)(cs + 4), s0 = *(const f32x4*)sn, s1 = *(const f32x4*)(sn + 4);
    const float sg = first ? -1.f : 1.f;
    v0 = v0 * c0 + o0 * s0 * sg; v1 = v1 * c1 + o1 * s1 * sg;
}
struct EpiP1 {
    static constexpr bool PERM = true;
    unsigned char* ws;
    __device__ __forceinline__ void operator()(EPI_ARGS) const {
        const int pn = u.pn; float krmax = 0.f;
        const float* tabm = (const float*)(ws + WS_TABM); const float* tabd = (const float*)(ws + WS_TABD);
#pragma unroll
        for (int ai = 0; ai < 2; ++ai)
#pragma unroll
            for (int m = 0; m < 4; ++m) {
                const int row = u.pm * 256 + ai * 128 + wr * 64 + m * 16 + fr; const int b = row >> 13, s = row & 8191;
#pragma unroll
                for (int bj = 0; bj < 2; ++bj) {
                    f32x4 v0 = acc[ai][bj][m][0], v1 = acc[ai][bj][m][1];
                    const int ct = bj * 128 + wc * 32 + 8 * fq;
                    if (pn < 3) {
                        float q = (v0[0] * v0[0] + v0[1] * v0[1]) + (v0[2] * v0[2] + v0[3] * v0[3]) + (v1[0] * v1[0] + v1[1] * v1[1]) + (v1[2] * v1[2] + v1[3] * v1[3]);
                        q += __shfl_xor(q, 16); q += __shfl_xor(q, 32);
                        if (fq == 0) store4_sc1((float*)(ws + WS_SSQ) + (size_t)row * 24 + pn * 8 + bj * 4 + wc, q);
                        if (pn == 2 && bj == 1 && wc == 0) {
                            const int f0 = 8 * (fq & 1); rope8(v0, v1, 32, tabm + (size_t)row * 32 + f0, tabm + (size_t)row * 32 + 16 + f0, fq < 2);
                            store16_sc1((bf16_t*)(ws + WS_KR) + (size_t)row * 32 + 8 * fq, pack8(v0, v1));
                            { float q2 = (v0[0] * v0[0] + v0[1] * v0[1]) + (v0[2] * v0[2] + v0[3] * v0[3]) + (v1[0] * v1[0] + v1[1] * v1[1]) + (v1[2] * v1[2] + v1[3] * v1[3]);
                              q2 += __shfl_xor(q2, 16); q2 += __shfl_xor(q2, 32); krmax = fmaxf(krmax, q2); }
                        } else store16_sc1((bf16_t*)(ws + WS_CQ) + (size_t)row * 768 + pn * 256 + ct, pack8(v0, v1));
                    } else {
                        const int which = (pn - 3) >> 1;
                        const int cc = ((pn - 3) & 1) * 256 + ct, hh = cc >> 6, d = cc & 63;
                        if (which < 2 && (wc & 1) == 0) {
                            f32x4 r0 = v0, r1 = v1; rope8(r0, r1, 16, tabd + (size_t)row * 16, tabd + (size_t)row * 16 + 8, fq == 0);
                            if (fq < 2) { v0 = r0; v1 = r1; } }
                        if (which == 0) { v0 = v0 * QSCALE_D; v1 = v1 * QSCALE_D; }
                        bf16_t* dst = (bf16_t*)(ws + (which == 0 ? WS_DQ : which == 1 ? WS_DK : WS_DV));
                        *(u32x4*)(dst + ((size_t)(b * 8 + hh) * S + s) * 64 + d) = pack8(v0, v1);
                    }
                }
            }
        if (pn == 2 && wc == 0) {
#pragma unroll
            for (int o = 1; o < 16; o <<= 1) krmax = fmaxf(krmax, __shfl_xor(krmax, o));
            if ((threadIdx.x & 63) == 0) atomicMax((unsigned*)(ws + WS_KMX) + 32 + ((u.pm * 256) >> 13), __float_as_uint(krmax)); }
    }
};
struct EpiP2 {
    static constexpr bool PERM = true;
    unsigned char* ws;
    __device__ __forceinline__ void operator()(EPI_ARGS) const {
        const int pn = u.pn; const bool isq = u.aux == 0; float kmax[2] = {0.f, 0.f};
        const float* tabm = (const float*)(ws + WS_TABM); const float* ssq = (const float*)(ws + WS_SSQ);
#pragma unroll
        for (int ai = 0; ai < 2; ++ai)
#pragma unroll
            for (int m = 0; m < 4; ++m) {
                const int row = u.pm * 256 + ai * 128 + wr * 64 + m * 16 + fr; const int b = row >> 13, s = row & 8191;
                const float* sq = ssq + (size_t)row * 24; float rstd;
                if (isq) { const f32x4 a = *(const f32x4*)sq, bq = *(const f32x4*)(sq + 4), cq = *(const f32x4*)(sq + 8);
                    rstd = rsqrtf((((a[0] + a[1]) + (a[2] + a[3])) + ((bq[0] + bq[1]) + (bq[2] + bq[3])) + ((cq[0] + cq[1]) + (cq[2] + cq[3]))) * (1.f / 384.f) + EPS) * QSCALE_M; }
                else { const f32x4 a = *(const f32x4*)(sq + 12), bq = *(const f32x4*)(sq + 16);
                    rstd = rsqrtf((((a[0] + a[1]) + (a[2] + a[3])) + ((bq[0] + bq[1]) + (bq[2] + bq[3]))) * (1.f / 256.f) + EPS); }
#pragma unroll
                for (int bj = 0; bj < 2; ++bj) {
                    f32x4 v0 = acc[ai][bj][m][0] * rstd, v1 = acc[ai][bj][m][1] * rstd;
                    const int ct = bj * 128 + wc * 32 + 8 * fq, cc = (pn & 1) * 256 + ct;
                    if (isq) {
                        if (pn < 2) { const int hh = cc >> 6, d = cc & 63; *(u32x4*)((bf16_t*)(ws + WS_Q) + ((size_t)(b * 8 + hh) * S + s) * 96 + d) = pack8(v0, v1); }
                        else { const int hh = ct >> 5; const int f0 = 8 * (fq & 1); rope8(v0, v1, 32, tabm + (size_t)row * 32 + f0, tabm + (size_t)row * 32 + 16 + f0, fq < 2);
                            *(u32x4*)((bf16_t*)(ws + WS_Q) + ((size_t)(b * 8 + hh) * S + s) * 96 + 64 + 8 * fq) = pack8(v0, v1); }
                    } else { const int hh = cc >> 6, d = cc & 63; bf16_t* dst = (bf16_t*)(ws + (pn < 2 ? WS_KN : WS_V));
                        *(u32x4*)(dst + ((size_t)(b * 8 + hh) * S + s) * 64 + d) = pack8(v0, v1);
                        if (pn < 2) { float q2 = (v0[0] * v0[0] + v0[1] * v0[1]) + (v0[2] * v0[2] + v0[3] * v0[3]) + (v1[0] * v1[0] + v1[1] * v1[1]) + (v1[2] * v1[2] + v1[3] * v1[3]);
                            q2 += __shfl_xor(q2, 16); q2 += __shfl_xor(q2, 32); kmax[bj] = fmaxf(kmax[bj], q2); } }
                }
            }
        if (!isq && pn < 2) {
#pragma unroll
            for (int bj = 0; bj < 2; ++bj) { float km = kmax[bj];
#pragma unroll
                for (int o = 1; o < 16; o <<= 1) km = fmaxf(km, __shfl_xor(km, o));
                const int cc = (pn & 1) * 256 + bj * 128 + wc * 32, hh = cc >> 6, half = (cc >> 5) & 1, b = (u.pm * 256) >> 13;
                if ((threadIdx.x & 63) == 0) atomicMax((unsigned*)(ws + WS_KMX) + (b * 8 + hh) * 2 + half, __float_as_uint(km)); }
        }
    }
};

constexpr size_t WS_PCNT = 56 * KiB;
struct SchedP12 {
    static constexpr bool GATHER = false;
    const char *HB, *WIN, *CQ, *WUQ, *WUKV; unsigned* cnt; int G, vcu, c;
    __device__ __forceinline__ bool next(int i, gm::Unit& u) const {
        u.gidx = nullptr;
        if (G == 256) {
            const int n1 = c < 64 ? 3 : 2;
            if (i < n1) { int pm, pn; static_tile(i, 256, c, 64, 9, pm, pn);
                u.A = HB; u.Bt = WIN; u.lda2 = 2048; u.ldb2 = 2048; u.arow0 = pm * 256; u.brow0 = pn * 256; u.nt = 16; u.pm = pm; u.pn = pn; u.aux = 2; return true; }
            if (c < 64) return false;
            const int idx = (c - 64) + 192 * (i - 2); if (i - 2 >= 3 || idx >= 448) return false;
            if (idx < 256) { int pm, pn; static_tile(0, 256, idx, 64, 4, pm, pn); u.A = CQ + 768; u.Bt = WUKV; u.lda2 = 1536; u.ldb2 = 512; u.nt = 4; u.arow0 = pm * 256; u.brow0 = pn * 256; u.pm = pm; u.pn = pn; u.aux = 1; }
            else { int pm, pn; static_tile(0, 192, idx - 256, 64, 3, pm, pn); u.A = CQ; u.Bt = WUQ; u.lda2 = 1536; u.ldb2 = 768; u.nt = 6; u.arow0 = pm * 256; u.brow0 = pn * 256; u.pm = pm; u.pn = pn; u.aux = 0; }
            return true;
        }
        const int n1 = (576 - vcu + G - 1) / G;
        if (i < n1) { const int k = vcu + G * i, pn = k >> 6, pm = k & 63;
            u.A = HB; u.Bt = WIN; u.lda2 = 2048; u.ldb2 = 2048; u.arow0 = pm * 256; u.brow0 = pn * 256; u.nt = 16; u.pm = pm; u.pn = pn; u.aux = 2; return true; }
        const int idx = vcu + G * (i - n1); if (idx >= 448) return false;
        if (idx < 256) { const int pm = idx & 63, pn = idx >> 6; u.A = CQ + 768; u.Bt = WUKV; u.lda2 = 1536; u.ldb2 = 512; u.nt = 4; u.arow0 = pm * 256; u.brow0 = pn * 256; u.pm = pm; u.pn = pn; u.aux = 1; }
        else { const int j = idx - 256, pm = j & 63, pn = j >> 6; u.A = CQ; u.Bt = WUQ; u.lda2 = 1536; u.ldb2 = 768; u.nt = 6; u.arow0 = pm * 256; u.brow0 = pn * 256; u.pm = pm; u.pn = pn; u.aux = 0; }
        return true;
    }
    __device__ __forceinline__ void a_ready(const gm::Unit& u, int wid) const {
        if (u.aux == 2) return;
        if (wid == 0) { unsigned* p = cnt + 16 * u.pm; unsigned spins = 0;
            while ((unsigned)__builtin_amdgcn_readfirstlane(__hip_atomic_load(p, __ATOMIC_RELAXED, __HIP_MEMORY_SCOPE_AGENT)) < 24u) { __builtin_amdgcn_s_sleep(2); if (++spins > (1u << 22)) break; }
            __builtin_amdgcn_fence(__ATOMIC_ACQUIRE, "agent");
            asm volatile("s_waitcnt vmcnt(0)" ::: "memory"); }
        asm volatile("" ::: "memory"); __builtin_amdgcn_s_barrier(); asm volatile("" ::: "memory");
    }
    __device__ __forceinline__ void done(const gm::Unit& u, int lane) const {
        if (u.aux != 2 || u.pn >= 3) return;
        asm volatile("s_waitcnt vmcnt(0)" ::: "memory");
        if (lane == 0) __hip_atomic_fetch_add(cnt + 16 * u.pm, 1u, __ATOMIC_RELAXED, __HIP_MEMORY_SCOPE_AGENT);
    }
};
struct EpiP12 {
    static constexpr bool PERM = true;
    unsigned char* ws;
    __device__ __forceinline__ void operator()(EPI_ARGS) const { if (u.aux == 2) { EpiP1 e{ws}; e(acc, u, wr, wc, fr, fq); } else { EpiP2 e{ws}; e(acc, u, wr, wc, fr, fq); } }
};
}
namespace mk {
#define RLX_AGENT __ATOMIC_RELAXED, __HIP_MEMORY_SCOPE_AGENT
#define XB_TMO      128
#define XB_XCNT(j)  (256  + 64 * (j))
#define XB_XSUB(j)  (1280 + 64 * (j))
#define XB_XGEN(j)  (2304 + 64 * (j))
#define XB_TOP      3328
#define XB_TOPGEN   3392
#define XCD_BAR_WORDS 3456
#define XB_SPIN_CAP (1u << 18)
__device__ __forceinline__ unsigned xb_ld(unsigned* p)              { return __hip_atomic_load(p, __ATOMIC_RELAXED, __HIP_MEMORY_SCOPE_AGENT); }
__device__ __forceinline__ unsigned xb_add(unsigned* p, unsigned v) { return __hip_atomic_fetch_add(p, v, __ATOMIC_RELAXED, __HIP_MEMORY_SCOPE_AGENT); }
__device__ __forceinline__ unsigned xb_xcc_id() { return (unsigned)__builtin_amdgcn_s_getreg((3 << 11) | 20) & 0xFu; }
#define XB_SPIN(cond, bar) do { unsigned _sp = 0; while (cond) { __builtin_amdgcn_s_sleep(1); \
    if ((++_sp & 255u) == 0u) { if (xb_ld(&(bar)[XB_TMO])) break; if (_sp > XB_SPIN_CAP) { atomicAdd(&(bar)[XB_TMO], 1u); break; } } } } while (0)
struct XcdBarrier { unsigned* bar; unsigned x; volatile LAS unsigned* st; };
__device__ __forceinline__ XcdBarrier xcd_barrier_post(unsigned* bar, volatile LAS unsigned* st) {
    XcdBarrier b; b.bar = bar; b.x = xb_xcc_id(); b.st = st;
    if (threadIdx.x == 0) (void)xb_add(&bar[XB_XCNT(b.x)], 1u);
    return b;
}
__device__ __forceinline__ void xcd_barrier_complete(unsigned* bar, unsigned x, unsigned& nloc, unsigned& nx) {
    const unsigned G = gridDim.x * gridDim.y * gridDim.z;
    unsigned sum, cnt, mine, sp = 0u;
    for (;;) {
        sum = 0u; cnt = 0u; mine = 0u;
#pragma unroll
        for (unsigned j = 0; j < 16; ++j) { const unsigned c = xb_ld(&bar[XB_XCNT(j)]); sum += c; cnt += (c > 0u) ? 1u : 0u; mine = (j == x) ? c : mine; }
        if (sum == G) break;
        __builtin_amdgcn_s_sleep(1);
        if ((++sp & 255u) == 0u) { if (xb_ld(&bar[XB_TMO])) break; if (sp > XB_SPIN_CAP) { atomicAdd(&bar[XB_TMO], 1u); break; } }
    }
    nloc = mine > 0u ? mine : 1u; nx = cnt > 0u ? cnt : 1u;
}
__device__ __forceinline__ void xcd_barrier(const XcdBarrier& b) {
    asm volatile("s_waitcnt vmcnt(0)" ::: "memory");
    __syncthreads();
    if (threadIdx.x == 0) {
        unsigned* bar = b.bar;
        __builtin_amdgcn_s_waitcnt(0);
        unsigned nloc = b.st[0], nx = b.st[1];
        if (nloc == 0u) { xcd_barrier_complete(bar, b.x, nloc, nx); b.st[0] = nloc; b.st[1] = nx; }
        const unsigned old = xb_add(&bar[XB_XSUB(b.x)], 1u);
        const unsigned gen = old / nloc;
        if (old + 1u == (gen + 1u) * nloc) {
            __builtin_amdgcn_fence(__ATOMIC_RELEASE, "agent");
            asm volatile("s_waitcnt vmcnt(0)" ::: "memory");
            const unsigned og = xb_add(&bar[XB_TOP], 1u);
            const unsigned tg = og / nx;
            if (og + 1u == (tg + 1u) * nx) xb_add(&bar[XB_TOPGEN], 1u);
            else XB_SPIN(xb_ld(&bar[XB_TOPGEN]) == tg, bar);
            __builtin_amdgcn_fence(__ATOMIC_ACQUIRE, "agent");
            xb_add(&bar[XB_XGEN(b.x)], 1u);
            asm volatile("s_waitcnt vmcnt(0)" ::: "memory");
        } else {
            XB_SPIN(xb_ld(&bar[XB_XGEN(b.x)]) == gen, bar);
            __builtin_amdgcn_fence(__ATOMIC_ACQUIRE, "agent");
            asm volatile("s_waitcnt vmcnt(0)" ::: "memory");
        }
    }
    __syncthreads();
}
}
namespace at {
using bf16x8 = __attribute__((ext_vector_type(8))) short;
using s16x4 = __attribute__((ext_vector_type(4))) short;
using f32x16 = __attribute__((ext_vector_type(16))) float;
using u32x4 = __attribute__((ext_vector_type(4))) unsigned;
constexpr int S = 8192, T = 16384;
constexpr float THR = 8.f;
#define SBAR() __builtin_amdgcn_sched_barrier(0)
__device__ __forceinline__ int crow(int r, int hi) { return (r & 3) + 8 * (r >> 2) + 4 * hi; }
__device__ __forceinline__ unsigned cvtpk(float lo, float hi) { unsigned r; asm volatile("v_cvt_pk_bf16_f32 %0, %1, %2" : "=v"(r) : "v"(lo), "v"(hi)); return r; }
__device__ __forceinline__ float rowmax32(const f32x16& p0, const f32x16& p1) {
    float pmax = p0[0];
#pragma unroll
    for (int r = 1; r < 16; ++r) pmax = fmaxf(pmax, p0[r]);
#pragma unroll
    for (int r = 0; r < 16; ++r) pmax = fmaxf(pmax, p1[r]);
    auto rr = __builtin_amdgcn_permlane32_swap(__float_as_uint(pmax), __float_as_uint(pmax), false, false);
    return fmaxf(__uint_as_float(rr[0]), __uint_as_float(rr[1]));
}
__device__ __forceinline__ void partialSM(f32x16& p0, f32x16& p1, float& m_reg, float& mn, float& alpha) {
    const float pmax = rowmax32(p0, p1);
    if (__builtin_expect(__all(pmax - m_reg <= THR), 1)) { mn = m_reg; alpha = 1.f; }
    else { mn = fmaxf(m_reg, pmax); alpha = __builtin_amdgcn_exp2f(m_reg - mn); m_reg = mn; }
#pragma unroll
    for (int r = 0; r < 16; ++r) p0[r] = p0[r] - mn;
#pragma unroll
    for (int r = 0; r < 16; ++r) p1[r] = p1[r] - mn;
#pragma unroll
    for (int r = 0; r < 16; ++r) p0[r] = __builtin_amdgcn_exp2f(p0[r]);
}
#define PK4(P, BASE, OUT) do { unsigned a0 = cvtpk(P[BASE + 0], P[BASE + 1]), a1 = cvtpk(P[BASE + 2], P[BASE + 3]);   \
    unsigned b0 = cvtpk(P[BASE + 4], P[BASE + 5]), b1 = cvtpk(P[BASE + 6], P[BASE + 7]);                              \
    auto r0 = __builtin_amdgcn_permlane32_swap(a0, b0, false, false); auto r1 = __builtin_amdgcn_permlane32_swap(a1, b1, false, false); \
    u32x4 w = {r0[0], r1[0], r0[1], r1[1]}; OUT = *reinterpret_cast<bf16x8*>(&w); } while (0)
__device__ __forceinline__ void finishSM(f32x16& p0, f32x16& p1, float alpha, float& l_reg, bf16x8& pa0, bf16x8& pa1, bf16x8& pa2, bf16x8& pa3) {
#pragma unroll
    for (int r = 0; r < 16; ++r) p1[r] = __builtin_amdgcn_exp2f(p1[r]);
    float ps = 0;
#pragma unroll
    for (int r = 0; r < 16; ++r) ps += p0[r];
#pragma unroll
    for (int r = 0; r < 16; ++r) ps += p1[r];
    { auto rr = __builtin_amdgcn_permlane32_swap(__float_as_uint(ps), __float_as_uint(ps), false, false); ps = __uint_as_float(rr[0]) + __uint_as_float(rr[1]); }
    l_reg = l_reg * alpha + ps;
    PK4(p0, 0, pa0); PK4(p0, 8, pa1); PK4(p1, 0, pa2); PK4(p1, 8, pa3);
}
__device__ __forceinline__ int v_st(int k, int c) { const int kk = (k & ~0xC) | ((k & 4) << 1) | ((k & 8) >> 1); return ((kk >> 3) * 2 + (c >> 5)) * 512 + ((kk & 7) * 32 + (c & 31)) * 2; }
__device__ __forceinline__ int v_rd_base(int lane) { return ((lane & 3) << 3) | (((lane >> 2) & 3) << 6) | (((lane >> 4) & 1) << 5) | (((lane >> 5) & 1) << 8); }
constexpr int v_rd_off(int d0, int ks, int half) { return d0 * 512 + ks * 2048 + half * 1024; }
template <int OFF> __device__ __forceinline__ s16x4 tr_read(int vb) { s16x4 r; asm volatile("ds_read_b64_tr_b16 %0, %1 offset:%2" : "=&v"(r) : "v"(vb), "i"(OFF) : "memory"); return r; }
#define PKV(L, H) (bf16x8){L[0], L[1], L[2], L[3], H[0], H[1], H[2], H[3]}
template <int D0, int KOFF> __device__ __forceinline__ void pv_one(f32x16& od, int vb, bf16x8 pa0, bf16x8 pa1, bf16x8 pa2, bf16x8 pa3) {
    const s16x4 l0 = tr_read<KOFF + v_rd_off(D0, 0, 0)>(vb), h0 = tr_read<KOFF + v_rd_off(D0, 0, 1)>(vb), l1 = tr_read<KOFF + v_rd_off(D0, 1, 0)>(vb), h1 = tr_read<KOFF + v_rd_off(D0, 1, 1)>(vb);
    const s16x4 l2 = tr_read<KOFF + v_rd_off(D0, 2, 0)>(vb), h2 = tr_read<KOFF + v_rd_off(D0, 2, 1)>(vb), l3 = tr_read<KOFF + v_rd_off(D0, 3, 0)>(vb), h3 = tr_read<KOFF + v_rd_off(D0, 3, 1)>(vb);
    asm volatile("s_waitcnt lgkmcnt(0)" ::: "memory"); SBAR();
    od = __builtin_amdgcn_mfma_f32_32x32x16_bf16(pa0, PKV(l0, h0), od, 0, 0, 0);
    od = __builtin_amdgcn_mfma_f32_32x32x16_bf16(pa1, PKV(l1, h1), od, 0, 0, 0);
    od = __builtin_amdgcn_mfma_f32_32x32x16_bf16(pa2, PKV(l2, h2), od, 0, 0, 0);
    od = __builtin_amdgcn_mfma_f32_32x32x16_bf16(pa3, PKV(l3, h3), od, 0, 0, 0);
}
template <int D0, int KOFF> __device__ __forceinline__ void pv_half(f32x16& od, int vb, bf16x8 pa0, bf16x8 pa1) {
    const s16x4 l0 = tr_read<KOFF + v_rd_off(D0, 0, 0)>(vb), h0 = tr_read<KOFF + v_rd_off(D0, 0, 1)>(vb), l1 = tr_read<KOFF + v_rd_off(D0, 1, 0)>(vb), h1 = tr_read<KOFF + v_rd_off(D0, 1, 1)>(vb);
    asm volatile("s_waitcnt lgkmcnt(0)" ::: "memory"); SBAR();
    od = __builtin_amdgcn_mfma_f32_32x32x16_bf16(pa0, PKV(l0, h0), od, 0, 0, 0);
    od = __builtin_amdgcn_mfma_f32_32x32x16_bf16(pa1, PKV(l1, h1), od, 0, 0, 0);
}
template <class RowOff> __device__ __forceinline__ void store_o_tile(const f32x16 (&o)[2], const float (&rli)[16], unsigned short* stg, unsigned short* dst, RowOff row_off, int lane) {
    const int r32 = lane & 31, hi = lane >> 5;
#pragma unroll
    for (int r = 0; r < 16; ++r) { const int orow = crow(r, hi);
#pragma unroll
        for (int d0 = 0; d0 < 2; ++d0) stg[orow * 64 + d0 * 32 + r32] = (unsigned short)(cvtpk(o[d0][r] * rli[r], 0.f) & 0xffffu); }
    asm volatile("s_waitcnt lgkmcnt(0)" ::: "memory");
#pragma unroll
    for (int i = 0; i < 4; ++i) { const int row = i * 8 + (lane >> 3), ch = lane & 7; const u32x4 v = *(const u32x4*)(stg + row * 64 + ch * 8); *(u32x4*)(dst + row_off(row) + ch * 8) = v; }
    asm volatile("s_waitcnt lgkmcnt(0)" ::: "memory");
}

constexpr int SHM_V = 8192, SHM_K = 16384, MLA_WS = 2 * SHM_V + 2 * SHM_K, MLA_OST = MLA_WS + 8 * 256;
#define KSWZ(row, colB) ((row) * 256 + ((colB) ^ (((row) & 15) << 4)))
__device__ __forceinline__ void qkt96(f32x16& p0, f32x16& p1, const char* Ks, const bf16x8* qr, int r32, int hi) {
    p0 = f32x16{}; p1 = f32x16{};
#pragma unroll
    for (int d0 = 0; d0 < 6; ++d0) { const int cb = (d0 * 16 + hi * 8) * 2;
        const bf16x8 b0 = *reinterpret_cast<const bf16x8*>(Ks + KSWZ(r32, cb));
        const bf16x8 b1 = *reinterpret_cast<const bf16x8*>(Ks + KSWZ(32 + r32, cb));
        p0 = __builtin_amdgcn_mfma_f32_32x32x16_bf16(b0, qr[d0], p0, 0, 0, 0);
        p1 = __builtin_amdgcn_mfma_f32_32x32x16_bf16(b1, qr[d0], p1, 0, 0, 0); }
}
__device__ __forceinline__ void pv64(f32x16* o, int vb, bf16x8 pa0, bf16x8 pa1, bf16x8 pa2, bf16x8 pa3) {
    pv_one<0, 0>(o[0], vb, pa0, pa1, pa2, pa3); pv_one<1, 0>(o[1], vb, pa0, pa1, pa2, pa3);
}
__device__ __forceinline__ void mla_unit(int bh, int qb, const unsigned short* __restrict__ Q, const unsigned short* __restrict__ KN, const unsigned short* __restrict__ KR,
                                         const unsigned short* __restrict__ V, unsigned short* __restrict__ CAT, char* lds) {
    const int tid = threadIdx.x, wid = tid >> 6, lane = tid & 63, r32 = lane & 31, hi = lane >> 5;
    const int b = bh >> 3, h = bh & 7;
    char* V_lds = lds; char* K_lds = lds + 2 * SHM_V;
    float* wsf = (float*)(lds + MLA_WS) + wid * 64; float* li_l = wsf; float* al_l = wsf + 32;
    float m_reg = -1e30f, l_reg = 0; f32x16 o[2] = {}; bf16x8 qr[6];
    const size_t bhS = (size_t)bh * S; const int q0 = qb * 256;
    const unsigned short* Qw = Q + (bhS + q0 + wid * 32 + r32) * 96 + hi * 8;
#pragma unroll
    for (int d0 = 0; d0 < 6; ++d0) qr[d0] = *reinterpret_cast<const bf16x8*>(Qw + d0 * 16);
    const int srow = tid >> 3, sch = tid & 7, rrow = (tid & 255) >> 2, rch = tid & 3;
    const unsigned short* kn_src = KN + (bhS + srow) * 64 + sch * 8;
    const unsigned short* v_src = V + (bhS + srow) * 64 + sch * 8;
    const unsigned short* kr_src = KR + ((size_t)b * S + rrow) * 32 + rch * 8;
    const int kst = KSWZ(srow, sch * 16), krst = KSWZ(rrow, (8 + rch) * 16), vst = v_st(srow, sch * 8);
    const int vb0 = (int)(uintptr_t)V_lds + v_rd_base(lane);
    bf16x8 s_kn[2], s_kr[2], s_v[2];
#define SLOAD(i, k0) do { s_kn[i] = *reinterpret_cast<const bf16x8*>(kn_src + (size_t)(k0) * 64); s_kr[i] = *reinterpret_cast<const bf16x8*>(kr_src + (size_t)(k0) * 32); \
    s_v[i] = *reinterpret_cast<const bf16x8*>(v_src + (size_t)(k0) * 64); } while (0)
#define SWRITE(bb, i) do { *(bf16x8*)(K_lds + (bb) * SHM_K + kst) = s_kn[i]; if (tid < 256) *(bf16x8*)(K_lds + (bb) * SHM_K + krst) = s_kr[i]; *(bf16x8*)(V_lds + (bb) * SHM_V + vst) = s_v[i]; } while (0)
#define SWAIT() asm volatile("s_waitcnt vmcnt(3)" ::: "memory")
#define RESC(a) do { if (__any((a) < 1.f)) { if (hi == 0) al_l[r32] = (a); asm volatile("s_waitcnt lgkmcnt(0)" ::: "memory"); \
    _Pragma("unroll") for (int d = 0; d < 2; ++d) _Pragma("unroll") for (int r = 0; r < 16; ++r) o[d][r] *= al_l[crow(r, hi)]; } } while (0)
    f32x16 pA0, pA1, pB0, pB1; float mnA, mnB, alA, alB; bf16x8 pa0, pa1, pa2, pa3; constexpr int NT = S / 64;
    SLOAD(0, 0); asm volatile("s_waitcnt vmcnt(0)" ::: "memory"); SWRITE(0, 0); __syncthreads();
    qkt96(pA0, pA1, K_lds, qr, r32, hi); partialSM(pA0, pA1, m_reg, mnA, alA);
    SLOAD(1, 64); SLOAD(0, 128);
    SWAIT(); SWRITE(1, 1); __syncthreads();
    for (int j = 1; j + 1 < NT; j += 2) {
        SBAR(); qkt96(pB0, pB1, K_lds + SHM_K, qr, r32, hi);
        finishSM(pA0, pA1, alA, l_reg, pa0, pa1, pa2, pa3); SBAR();
        SLOAD(1, (j + 2) * 64); SBAR();
        pv64(o, vb0, pa0, pa1, pa2, pa3); partialSM(pB0, pB1, m_reg, mnB, alB);
        __syncthreads(); SWAIT(); SWRITE(0, 0);
        RESC(alB); __syncthreads();
        SBAR(); qkt96(pA0, pA1, K_lds, qr, r32, hi);
        finishSM(pB0, pB1, alB, l_reg, pa0, pa1, pa2, pa3); SBAR();
        if (j + 3 < NT) SLOAD(0, (j + 3) * 64); SBAR();
        pv64(o, vb0 + SHM_V, pa0, pa1, pa2, pa3); partialSM(pA0, pA1, m_reg, mnA, alA);
        __syncthreads(); SWAIT(); SWRITE(1, 1);
        RESC(alA); __syncthreads();
    }
    SBAR(); qkt96(pB0, pB1, K_lds + SHM_K, qr, r32, hi);
    finishSM(pA0, pA1, alA, l_reg, pa0, pa1, pa2, pa3); SBAR();
    pv64(o, vb0, pa0, pa1, pa2, pa3); partialSM(pB0, pB1, m_reg, mnB, alB);
    __syncthreads(); RESC(alB);
    finishSM(pB0, pB1, alB, l_reg, pa0, pa1, pa2, pa3); SBAR();
    pv64(o, vb0 + SHM_V, pa0, pa1, pa2, pa3);
    if (hi == 0) li_l[r32] = l_reg; asm volatile("s_waitcnt lgkmcnt(0)" ::: "memory");
    float rli[16];
#pragma unroll
    for (int r = 0; r < 16; ++r) rli[r] = __builtin_amdgcn_rcpf(li_l[crow(r, hi)]);
    unsigned short* stg = (unsigned short*)(lds + MLA_OST) + wid * 2048;
    unsigned short* dst = CAT + ((size_t)b * S + q0 + wid * 32) * 1024 + h * 64;
    store_o_tile(o, rli, stg, dst, [](int row) { return (size_t)row * 1024; }, lane);
    asm volatile("s_waitcnt vmcnt(0)" ::: "memory");
    __syncthreads();
#undef SLOAD
#undef SWRITE
#undef SWAIT
#undef RESC
}


constexpr int M2_K = 0, M2_V = 3 * SHM_K, M2_WS = M2_V + 3 * SHM_V, M2_OST = M2_WS + 8 * 256;
#ifndef MLA_PROBE_NOSTAGE
#define MLA_PROBE_NOSTAGE 0
#endif
#ifndef MLA_STATIC
#define MLA_STATIC 1
#endif
#ifndef MLA_STEP_MODE
#define MLA_STEP_MODE 0
#endif
#ifndef MLA_PROBE_VALU
#define MLA_PROBE_VALU 0
#endif
#ifndef MLA_NEGM
#define MLA_NEGM 1
#endif
#ifndef MLA_PRIO
#define MLA_PRIO 0
#endif
__device__ __forceinline__ void qkt96n(f32x16& p0, f32x16& p1, const char* Ks, const bf16x8* qr, const f32x16& negm, int r32, int hi) {
    if (MLA_PRIO) __builtin_amdgcn_s_setprio(1);
#pragma unroll
    for (int d0 = 0; d0 < 6; ++d0) { const int cb = (d0 * 16 + hi * 8) * 2;
        const bf16x8 b0 = *reinterpret_cast<const bf16x8*>(Ks + KSWZ(r32, cb));
        const bf16x8 b1 = *reinterpret_cast<const bf16x8*>(Ks + KSWZ(32 + r32, cb));
        if (d0 == 0) { p0 = __builtin_amdgcn_mfma_f32_32x32x16_bf16(b0, qr[0], MLA_NEGM ? negm : f32x16{}, 0, 0, 0); p1 = __builtin_amdgcn_mfma_f32_32x32x16_bf16(b1, qr[0], MLA_NEGM ? negm : f32x16{}, 0, 0, 0); }
        else { p0 = __builtin_amdgcn_mfma_f32_32x32x16_bf16(b0, qr[d0], p0, 0, 0, 0); p1 = __builtin_amdgcn_mfma_f32_32x32x16_bf16(b1, qr[d0], p1, 0, 0, 0); } }
    if (MLA_PRIO) __builtin_amdgcn_s_setprio(0);
}
__device__ __forceinline__ float rowmax32b(const f32x16& p0, const f32x16& p1) {
    float a = fmaxf(fmaxf(p0[0], p0[1]), p1[0]), b = fmaxf(fmaxf(p0[2], p0[3]), p1[1]); a = fmaxf(fmaxf(a, p1[2]), p1[3]);
#pragma unroll
    for (int r = 4; r < 16; r += 4) { a = fmaxf(fmaxf(a, p0[r]), p0[r + 1]); b = fmaxf(fmaxf(b, p0[r + 2]), p0[r + 3]); a = fmaxf(fmaxf(a, p1[r]), p1[r + 1]); b = fmaxf(fmaxf(b, p1[r + 2]), p1[r + 3]); }
    const float m = fmaxf(a, b);
    auto rr = __builtin_amdgcn_permlane32_swap(__float_as_uint(m), __float_as_uint(m), false, false);
    return fmaxf(__uint_as_float(rr[0]), __uint_as_float(rr[1]));
}
template <bool FIRST> __device__ __forceinline__ void partialSM2(f32x16& p0, f32x16& p1, float& m_reg, f32x16& negm, float& alpha, bool exact = true) {
    if (!exact) { alpha = 1.f;
#pragma unroll
        for (int r = 0; r < 16; ++r) p0[r] = __builtin_amdgcn_exp2f(p0[r]);
        return; }
    if (MLA_PROBE_VALU) { float d0_ = p1[0], d1_ = p1[1], d2_ = p1[2], d3_ = p1[3];
#pragma unroll
        for (int i = 0; i < 8; ++i) { d0_ = __builtin_amdgcn_exp2f(d0_); d1_ = __builtin_amdgcn_exp2f(d1_); d2_ = __builtin_amdgcn_exp2f(d2_); d3_ = __builtin_amdgcn_exp2f(d3_); }
        asm volatile("" :: "v"(d0_), "v"(d1_), "v"(d2_), "v"(d3_)); }
    if (!MLA_NEGM) {
        const float pm = rowmax32b(p0, p1); alpha = 1.f;
        if (FIRST) m_reg = pm; else if (!__builtin_expect(__all(pm - m_reg <= THR), 1)) { const float mn = fmaxf(m_reg, pm); alpha = __builtin_amdgcn_exp2f(m_reg - mn); m_reg = mn; }
#pragma unroll
        for (int r = 0; r < 16; ++r) { p0[r] -= m_reg; p1[r] -= m_reg; }
#pragma unroll
        for (int r = 0; r < 16; ++r) p0[r] = __builtin_amdgcn_exp2f(p0[r]);
        return; }
    const float pmax = rowmax32b(p0, p1);
    alpha = 1.f;
    if (FIRST || !__builtin_expect(__all(pmax <= THR), 1)) {
        const float dl = FIRST ? pmax : fmaxf(pmax, 0.f); m_reg += dl;
#pragma unroll
        for (int r = 0; r < 16; ++r) { p0[r] -= dl; p1[r] -= dl; }
#pragma unroll
        for (int r = 0; r < 16; ++r) negm[r] = -m_reg;
        if (!FIRST) alpha = __builtin_amdgcn_exp2f(-dl);
    }
#pragma unroll
    for (int r = 0; r < 16; ++r) p0[r] = __builtin_amdgcn_exp2f(p0[r]);
}
template <int D0> __device__ __forceinline__ void pv_one_p(f32x16& od, int vb, bf16x8 pa0, bf16x8 pa1, bf16x8 pa2, bf16x8 pa3) {
    const s16x4 l0 = tr_read<v_rd_off(D0, 0, 0)>(vb), h0 = tr_read<v_rd_off(D0, 0, 1)>(vb), l1 = tr_read<v_rd_off(D0, 1, 0)>(vb), h1 = tr_read<v_rd_off(D0, 1, 1)>(vb);
    const s16x4 l2 = tr_read<v_rd_off(D0, 2, 0)>(vb), h2 = tr_read<v_rd_off(D0, 2, 1)>(vb), l3 = tr_read<v_rd_off(D0, 3, 0)>(vb), h3 = tr_read<v_rd_off(D0, 3, 1)>(vb);
    asm volatile("s_waitcnt lgkmcnt(0)" ::: "memory"); SBAR();
    if (MLA_PRIO) __builtin_amdgcn_s_setprio(1);
    od = __builtin_amdgcn_mfma_f32_32x32x16_bf16(pa0, PKV(l0, h0), od, 0, 0, 0);
    od = __builtin_amdgcn_mfma_f32_32x32x16_bf16(pa1, PKV(l1, h1), od, 0, 0, 0);
    od = __builtin_amdgcn_mfma_f32_32x32x16_bf16(pa2, PKV(l2, h2), od, 0, 0, 0);
    od = __builtin_amdgcn_mfma_f32_32x32x16_bf16(pa3, PKV(l3, h3), od, 0, 0, 0);
    if (MLA_PRIO) __builtin_amdgcn_s_setprio(0);
}

__device__ __forceinline__ void kfrag_load(bf16x8 (&kf)[12], const char* Ks, int r32, int hi) {
#pragma unroll
    for (int d0 = 0; d0 < 6; ++d0) { const int cb = (d0 * 16 + hi * 8) * 2;
        kf[2 * d0] = *reinterpret_cast<const bf16x8*>(Ks + KSWZ(r32, cb)); kf[2 * d0 + 1] = *reinterpret_cast<const bf16x8*>(Ks + KSWZ(32 + r32, cb)); }
}
__device__ __forceinline__ void qk_mma(f32x16& p0, f32x16& p1, const bf16x8 (&kf)[12], const bf16x8* qr, const f32x16& negm) {
    if (MLA_PRIO) __builtin_amdgcn_s_setprio(1);
    p0 = __builtin_amdgcn_mfma_f32_32x32x16_bf16(kf[0], qr[0], MLA_NEGM ? negm : f32x16{}, 0, 0, 0); p1 = __builtin_amdgcn_mfma_f32_32x32x16_bf16(kf[1], qr[0], MLA_NEGM ? negm : f32x16{}, 0, 0, 0);
#pragma unroll
    for (int d0 = 1; d0 < 6; ++d0) { p0 = __builtin_amdgcn_mfma_f32_32x32x16_bf16(kf[2 * d0], qr[d0], p0, 0, 0, 0); p1 = __builtin_amdgcn_mfma_f32_32x32x16_bf16(kf[2 * d0 + 1], qr[d0], p1, 0, 0, 0); }
    if (MLA_PRIO) __builtin_amdgcn_s_setprio(0);
}
template <int D0> __device__ __forceinline__ void vfrag_load_h(s16x4 (&vl)[4], s16x4 (&vh)[4], int vb) {
    vl[0] = tr_read<v_rd_off(D0, 0, 0)>(vb); vh[0] = tr_read<v_rd_off(D0, 0, 1)>(vb); vl[1] = tr_read<v_rd_off(D0, 1, 0)>(vb); vh[1] = tr_read<v_rd_off(D0, 1, 1)>(vb);
    vl[2] = tr_read<v_rd_off(D0, 2, 0)>(vb); vh[2] = tr_read<v_rd_off(D0, 2, 1)>(vb); vl[3] = tr_read<v_rd_off(D0, 3, 0)>(vb); vh[3] = tr_read<v_rd_off(D0, 3, 1)>(vb);
}
__device__ __forceinline__ void pv_mma_h(f32x16& od, const s16x4 (&vl)[4], const s16x4 (&vh)[4], bf16x8 pa0, bf16x8 pa1, bf16x8 pa2, bf16x8 pa3) {
    if (MLA_PRIO) __builtin_amdgcn_s_setprio(1);
    od = __builtin_amdgcn_mfma_f32_32x32x16_bf16(pa0, PKV(vl[0], vh[0]), od, 0, 0, 0);
    od = __builtin_amdgcn_mfma_f32_32x32x16_bf16(pa1, PKV(vl[1], vh[1]), od, 0, 0, 0);
    od = __builtin_amdgcn_mfma_f32_32x32x16_bf16(pa2, PKV(vl[2], vh[2]), od, 0, 0, 0);
    od = __builtin_amdgcn_mfma_f32_32x32x16_bf16(pa3, PKV(vl[3], vh[3]), od, 0, 0, 0);
    if (MLA_PRIO) __builtin_amdgcn_s_setprio(0);
}
#if MLA_STEP_MODE == 0
#define MLA_STEP(PC0, PC1, PP0, PP1, ALP, ALC) do { \
    qkt96n(PC0, PC1, K_lds + sc * SHM_K, qr, negm, r32, hi); \
    finishSM(PP0, PP1, ALP, l_reg, pa0, pa1, pa2, pa3); SBAR(); \
    { const int vb_ = vb0 + sp * SHM_V; pv_one_p<0>(o[0], vb_, pa0, pa1, pa2, pa3); pv_one_p<1>(o[1], vb_, pa0, pa1, pa2, pa3); } \
    partialSM2<false>(PC0, PC1, m_reg, negm, ALC, exact); RESC(ALC); } while (0)
#elif MLA_STEP_MODE == 2
  \
#define SGB(mask, n) __builtin_amdgcn_sched_group_barrier(mask, n, 0)
#define MLA_STEP(PC0, PC1, PP0, PP1, ALP, ALC) do { \
    { const char* Ks_ = K_lds + sc * SHM_K; \
      _Pragma("unroll") for (int d0 = 0; d0 < 6; ++d0) { const int cb = (d0 * 16 + hi * 8) * 2; \
        const bf16x8 b0 = *reinterpret_cast<const bf16x8*>(Ks_ + KSWZ(r32, cb)); const bf16x8 b1 = *reinterpret_cast<const bf16x8*>(Ks_ + KSWZ(32 + r32, cb)); \
        if (d0 == 0) { PC0 = __builtin_amdgcn_mfma_f32_32x32x16_bf16(b0, qr[0], negm, 0, 0, 0); PC1 = __builtin_amdgcn_mfma_f32_32x32x16_bf16(b1, qr[0], negm, 0, 0, 0); } \
        else { PC0 = __builtin_amdgcn_mfma_f32_32x32x16_bf16(b0, qr[d0], PC0, 0, 0, 0); PC1 = __builtin_amdgcn_mfma_f32_32x32x16_bf16(b1, qr[d0], PC1, 0, 0, 0); } } } \
    finishSM(PP0, PP1, ALP, l_reg, pa0, pa1, pa2, pa3); \
    SGB(0x100, 4); \
    _Pragma("unroll") for (int g_ = 0; g_ < 12; ++g_) { SGB(0x008, 1); SGB(0x100, 1); SGB(0x002, 7); } \
    SBAR(); \
    { const int vb_ = vb0 + sp * SHM_V; \
      const s16x4 l0 = tr_read<v_rd_off(0, 0, 0)>(vb_), h0 = tr_read<v_rd_off(0, 0, 1)>(vb_), l1 = tr_read<v_rd_off(0, 1, 0)>(vb_), h1 = tr_read<v_rd_off(0, 1, 1)>(vb_); \
      const s16x4 l2 = tr_read<v_rd_off(0, 2, 0)>(vb_), h2 = tr_read<v_rd_off(0, 2, 1)>(vb_), l3 = tr_read<v_rd_off(0, 3, 0)>(vb_), h3 = tr_read<v_rd_off(0, 3, 1)>(vb_); \
      const s16x4 l4 = tr_read<v_rd_off(1, 0, 0)>(vb_), h4 = tr_read<v_rd_off(1, 0, 1)>(vb_), l5 = tr_read<v_rd_off(1, 1, 0)>(vb_), h5 = tr_read<v_rd_off(1, 1, 1)>(vb_); \
      const s16x4 l6 = tr_read<v_rd_off(1, 2, 0)>(vb_), h6 = tr_read<v_rd_off(1, 2, 1)>(vb_), l7 = tr_read<v_rd_off(1, 3, 0)>(vb_), h7 = tr_read<v_rd_off(1, 3, 1)>(vb_); \
      asm volatile("s_waitcnt lgkmcnt(0)" ::: "memory"); SBAR(); \
      o[0] = __builtin_amdgcn_mfma_f32_32x32x16_bf16(pa0, PKV(l0, h0), o[0], 0, 0, 0); o[1] = __builtin_amdgcn_mfma_f32_32x32x16_bf16(pa0, PKV(l4, h4), o[1], 0, 0, 0); \
      o[0] = __builtin_amdgcn_mfma_f32_32x32x16_bf16(pa1, PKV(l1, h1), o[0], 0, 0, 0); o[1] = __builtin_amdgcn_mfma_f32_32x32x16_bf16(pa1, PKV(l5, h5), o[1], 0, 0, 0); \
      o[0] = __builtin_amdgcn_mfma_f32_32x32x16_bf16(pa2, PKV(l2, h2), o[0], 0, 0, 0); o[1] = __builtin_amdgcn_mfma_f32_32x32x16_bf16(pa2, PKV(l6, h6), o[1], 0, 0, 0); \
      o[0] = __builtin_amdgcn_mfma_f32_32x32x16_bf16(pa3, PKV(l3, h3), o[0], 0, 0, 0); o[1] = __builtin_amdgcn_mfma_f32_32x32x16_bf16(pa3, PKV(l7, h7), o[1], 0, 0, 0); \
      partialSM2<false>(PC0, PC1, m_reg, negm, ALC, exact); \
      _Pragma("unroll") for (int g_ = 0; g_ < 8; ++g_) { SGB(0x008, 1); SGB(0x002, 2); } \
      SBAR(); } \
    RESC(ALC); } while (0)
#else
#define MLA_STEP(PC0, PC1, PP0, PP1, ALP, ALC) do { \
    bf16x8 kf[12]; s16x4 val[4], vah[4], vbl[4], vbh[4]; const int vb_ = vb0 + sp * SHM_V; \
    kfrag_load(kf, K_lds + sc * SHM_K, r32, hi); SBAR(); \
    finishSM(PP0, PP1, ALP, l_reg, pa0, pa1, pa2, pa3); SBAR(); \
    vfrag_load_h<0>(val, vah, vb_); SBAR(); \
    qk_mma(PC0, PC1, kf, qr, negm); SBAR(); \
    vfrag_load_h<1>(vbl, vbh, vb_); SBAR(); \
    asm volatile("s_waitcnt lgkmcnt(8)" ::: "memory"); SBAR(); \
    pv_mma_h(o[0], val, vah, pa0, pa1, pa2, pa3); SBAR(); \
    asm volatile("s_waitcnt lgkmcnt(0)" ::: "memory"); SBAR(); \
    pv_mma_h(o[1], vbl, vbh, pa0, pa1, pa2, pa3); SBAR(); \
    partialSM2<false>(PC0, PC1, m_reg, negm, ALC); RESC(ALC); } while (0)
#endif

__device__ __forceinline__ void mla_unit_v2(int bh, int qb, const unsigned short* __restrict__ Q, const unsigned short* __restrict__ KN, const unsigned short* __restrict__ KR,
                                            const unsigned short* __restrict__ V, unsigned short* __restrict__ CAT, const float* __restrict__ KMX, char* lds) {
    const int tid = threadIdx.x, wid = tid >> 6, lane = tid & 63, r32 = lane & 31, hi = lane >> 5;
    const int b = bh >> 3, h = bh & 7;
    char* K_lds = lds + M2_K; char* V_lds = lds + M2_V;
    float* wsf = (float*)(lds + M2_WS) + wid * 64; float* li_l = wsf; float* al_l = wsf + 32;
    float m_reg = 0.f, l_reg = 0; f32x16 o[2] = {}; bf16x8 qr[6]; f32x16 negm = f32x16{};
    const size_t bhS = (size_t)bh * S; const int q0 = qb * 256;
    const unsigned short* Qw = Q + (bhS + q0 + wid * 32 + r32) * 96 + hi * 8;
#pragma unroll
    for (int d0 = 0; d0 < 6; ++d0) qr[d0] = *reinterpret_cast<const bf16x8*>(Qw + d0 * 16);
    bool exact = true;
    if (MLA_STATIC) { float q2 = 0.f;
#pragma unroll
      for (int d0 = 0; d0 < 6; ++d0)
#pragma unroll
          for (int j = 0; j < 8; ++j) { const float x = __uint_as_float((unsigned)(unsigned short)qr[d0][j] << 16); q2 += x * x; }
      { auto rr = __builtin_amdgcn_permlane32_swap(__float_as_uint(q2), __float_as_uint(q2), false, false); q2 = __uint_as_float(rr[0]) + __uint_as_float(rr[1]); }
      const float k2 = KMX[(b * 8 + h) * 2] + KMX[(b * 8 + h) * 2 + 1] + KMX[32 + b];
      const float ms = 1.01f * sqrtf(q2 * k2);
      exact = __syncthreads_or(!(ms <= 60.f)) != 0;
      if (!exact) { m_reg = ms;
#pragma unroll
          for (int r = 0; r < 16; ++r) negm[r] = -ms; } }
    const int srow = tid >> 3, sch = tid & 7, rrow = (tid & 255) >> 2, rch = tid & 3;
    const char* kn_u = (const char*)(KN + bhS * 64); const char* v_u = (const char*)(V + bhS * 64); const char* kr_u = (const char*)(KR + (size_t)b * S * 32);
    const unsigned kn_off = (unsigned)(srow * 64 + sch * 8) * 2u, kr_off = (unsigned)(rrow * 32 + rch * 8) * 2u;
    const int kst = KSWZ(srow, sch * 16), krst = KSWZ(rrow, (8 + rch) * 16), vst = v_st(srow, sch * 8);
    const int vb0 = (int)(uintptr_t)V_lds + v_rd_base(lane);
    bf16x8 s_kn[1], s_kr[1], s_v[1];
#define SLOAD(i, t) do { s_kn[i] = *reinterpret_cast<const bf16x8*>(kn_u + (size_t)(t) * 8192 + kn_off); s_kr[i] = *reinterpret_cast<const bf16x8*>(kr_u + (size_t)(t) * 4096 + kr_off); \
    s_v[i] = *reinterpret_cast<const bf16x8*>(v_u + (size_t)(t) * 8192 + kn_off); } while (0)
#define SWRITE(sl, i) do { *(bf16x8*)(K_lds + (sl) * SHM_K + kst) = s_kn[i]; if (tid < 256) *(bf16x8*)(K_lds + (sl) * SHM_K + krst) = s_kr[i]; *(bf16x8*)(V_lds + (sl) * SHM_V + vst) = s_v[i]; } while (0)
#define SWAIT() asm volatile("s_waitcnt vmcnt(0)" ::: "memory")
#define RESC(a) do { if (exact && __any((a) < 1.f)) { if (hi == 0) al_l[r32] = (a); asm volatile("s_waitcnt lgkmcnt(0)" ::: "memory"); \
    _Pragma("unroll") for (int d = 0; d < 2; ++d) _Pragma("unroll") for (int r = 0; r < 16; ++r) o[d][r] *= al_l[crow(r, hi)]; } } while (0)
#define ROT3(x) ((x) == 2 ? 0 : (x) + 1)
    f32x16 pA0, pA1, pB0, pB1; float alA, alB; bf16x8 pa0, pa1, pa2, pa3; constexpr int NT = S / 64;
    SLOAD(0, 0);
    SWAIT(); SWRITE(0, 0); SLOAD(0, 1);
    __syncthreads();
    qkt96n(pA0, pA1, K_lds, qr, negm, r32, hi); if (exact) partialSM2<true>(pA0, pA1, m_reg, negm, alA); else partialSM2<false>(pA0, pA1, m_reg, negm, alA, false);
    SWAIT(); SWRITE(1, 0); SLOAD(0, 2);
    __syncthreads();
    int sp = 0, sc = 1, sn = 2;
    for (int j = 1; j + 1 < NT; j += 2) {
        if (!MLA_PROBE_NOSTAGE) { SWAIT(); SWRITE(sn, 0); if (j + 2 < NT) SLOAD(0, j + 2); }
        SBAR(); MLA_STEP(pB0, pB1, pA0, pA1, alA, alB);
        __syncthreads();
        sp = sc; sc = sn; sn = ROT3(sn);
        if (!MLA_PROBE_NOSTAGE) { SWAIT(); SWRITE(sn, 0); if (j + 3 < NT) SLOAD(0, j + 3); }
        SBAR(); MLA_STEP(pA0, pA1, pB0, pB1, alB, alA);
        __syncthreads();
        sp = sc; sc = sn; sn = ROT3(sn);
    }
    SBAR(); MLA_STEP(pB0, pB1, pA0, pA1, alA, alB);
    finishSM(pB0, pB1, alB, l_reg, pa0, pa1, pa2, pa3); SBAR();
    { const int vb = vb0 + sc * SHM_V; pv_one_p<0>(o[0], vb, pa0, pa1, pa2, pa3); pv_one_p<1>(o[1], vb, pa0, pa1, pa2, pa3); }
    if (hi == 0) li_l[r32] = l_reg; asm volatile("s_waitcnt lgkmcnt(0)" ::: "memory");
    float rli[16];
#pragma unroll
    for (int r = 0; r < 16; ++r) rli[r] = __builtin_amdgcn_rcpf(li_l[crow(r, hi)]);
    unsigned short* stg = (unsigned short*)(lds + M2_OST) + wid * 2048;
    unsigned short* dst = CAT + ((size_t)b * S + q0 + wid * 32) * 1024 + h * 64;
    store_o_tile(o, rli, stg, dst, [](int row) { return (size_t)row * 1024; }, lane);
    asm volatile("s_waitcnt vmcnt(0)" ::: "memory");
    __syncthreads();
#undef SLOAD
#undef SWRITE
#undef SWAIT
#undef RESC
#undef ROT3
}


__device__ __forceinline__ void finishSM_s(f32x16& p0, f32x16& p1, float& l_reg, bf16x8& pa0, bf16x8& pa1, bf16x8& pa2, bf16x8& pa3) {
#pragma unroll
    for (int r = 0; r < 16; ++r) p1[r] = __builtin_amdgcn_exp2f(p1[r]);
    float ps = 0;
#pragma unroll
    for (int r = 0; r < 16; ++r) ps += p0[r];
#pragma unroll
    for (int r = 0; r < 16; ++r) ps += p1[r];
    l_reg += ps;
    PK4(p0, 0, pa0); PK4(p0, 8, pa1); PK4(p1, 0, pa2); PK4(p1, 8, pa3);
}
__device__ __forceinline__ void exp_half(f32x16& p0) {
#pragma unroll
    for (int r = 0; r < 16; ++r) p0[r] = __builtin_amdgcn_exp2f(p0[r]);
}
__device__ __forceinline__ bool mla_unit_v5(int bh, int qb, const unsigned short* __restrict__ Q, const unsigned short* __restrict__ KN, const unsigned short* __restrict__ KR,
                                            const unsigned short* __restrict__ V, unsigned short* __restrict__ CAT, const float* __restrict__ KMX, char* lds) {
    const int tid = threadIdx.x, wid = tid >> 6, lane = tid & 63, r32 = lane & 31, hi = lane >> 5;
    const int b = bh >> 3, h = bh & 7;
    char* K_lds = lds + M2_K; char* V_lds = lds + M2_V;
    float* wsf = (float*)(lds + M2_WS) + wid * 64; float* li_l = wsf;
    float l_reg = 0; f32x16 o[2] = {}; bf16x8 qr[6];
    const size_t bhS = (size_t)bh * S; const int q0 = qb * 256;
    const unsigned short* Qw = Q + (bhS + q0 + wid * 32 + r32) * 96 + hi * 8;
#pragma unroll
    for (int d0 = 0; d0 < 6; ++d0) qr[d0] = *reinterpret_cast<const bf16x8*>(Qw + d0 * 16);
    f32x16 negm;
    { float q2 = 0.f;
#pragma unroll
      for (int d0 = 0; d0 < 6; ++d0)
#pragma unroll
          for (int j = 0; j < 8; ++j) { const float x = __uint_as_float((unsigned)(unsigned short)qr[d0][j] << 16); q2 += x * x; }
      { auto rr = __builtin_amdgcn_permlane32_swap(__float_as_uint(q2), __float_as_uint(q2), false, false); q2 = __uint_as_float(rr[0]) + __uint_as_float(rr[1]); }
      const float k2 = KMX[(b * 8 + h) * 2] + KMX[(b * 8 + h) * 2 + 1] + KMX[32 + b];
      const float m = 1.01f * sqrtf(q2 * k2);
#pragma unroll
      for (int r = 0; r < 16; ++r) negm[r] = -m; }
    const int srow = tid >> 3, sch = tid & 7, rrow = (tid & 255) >> 2, rch = tid & 3;
    const char* kn_u = (const char*)(KN + bhS * 64); const char* v_u = (const char*)(V + bhS * 64); const char* kr_u = (const char*)(KR + (size_t)b * S * 32);
    const unsigned kn_off = (unsigned)(srow * 64 + sch * 8) * 2u, kr_off = (unsigned)(rrow * 32 + rch * 8) * 2u;
    const int kst = KSWZ(srow, sch * 16), krst = KSWZ(rrow, (8 + rch) * 16), vst = v_st(srow, sch * 8);
    const int vb0 = (int)(uintptr_t)V_lds + v_rd_base(lane);
    bf16x8 s_kn, s_kr, s_v;
#define SLOAD(t) do { s_kn = *reinterpret_cast<const bf16x8*>(kn_u + (size_t)(t) * 8192 + kn_off); s_kr = *reinterpret_cast<const bf16x8*>(kr_u + (size_t)(t) * 4096 + kr_off); \
    s_v = *reinterpret_cast<const bf16x8*>(v_u + (size_t)(t) * 8192 + kn_off); } while (0)
#define SWRITE(sl) do { *(bf16x8*)(K_lds + (sl) * SHM_K + kst) = s_kn; if (tid < 256) *(bf16x8*)(K_lds + (sl) * SHM_K + krst) = s_kr; *(bf16x8*)(V_lds + (sl) * SHM_V + vst) = s_v; } while (0)
#define SWAIT() asm volatile("s_waitcnt vmcnt(0)" ::: "memory")
#define ROT3(x) ((x) == 2 ? 0 : (x) + 1)
#define STEP5(PC0, PC1, PP0, PP1) do { \
    qkt96n(PC0, PC1, K_lds + sc * SHM_K, qr, negm, r32, hi); \
    finishSM_s(PP0, PP1, l_reg, pa0, pa1, pa2, pa3); SBAR(); \
    { const int vb_ = vb0 + sp * SHM_V; pv_one_p<0>(o[0], vb_, pa0, pa1, pa2, pa3); pv_one_p<1>(o[1], vb_, pa0, pa1, pa2, pa3); } \
    exp_half(PC0); } while (0)
    f32x16 pA0, pA1, pB0, pB1; bf16x8 pa0, pa1, pa2, pa3; constexpr int NT = S / 64;
    SLOAD(0);
    SWAIT(); SWRITE(0); SLOAD(1);
    __syncthreads();
    qkt96n(pA0, pA1, K_lds, qr, negm, r32, hi); exp_half(pA0);
    SWAIT(); SWRITE(1); SLOAD(2);
    __syncthreads();
    int sp = 0, sc = 1, sn = 2;
    for (int j = 1; j + 1 < NT; j += 2) {
        SWAIT(); SWRITE(sn); if (j + 2 < NT) SLOAD(j + 2);
        SBAR(); STEP5(pB0, pB1, pA0, pA1);
        __syncthreads();
        sp = sc; sc = sn; sn = ROT3(sn);
        SWAIT(); SWRITE(sn); if (j + 3 < NT) SLOAD(j + 3);
        SBAR(); STEP5(pA0, pA1, pB0, pB1);
        __syncthreads();
        sp = sc; sc = sn; sn = ROT3(sn);
    }
    SBAR(); STEP5(pB0, pB1, pA0, pA1);
    finishSM_s(pB0, pB1, l_reg, pa0, pa1, pa2, pa3); SBAR();
    { const int vb = vb0 + sc * SHM_V; pv_one_p<0>(o[0], vb, pa0, pa1, pa2, pa3); pv_one_p<1>(o[1], vb, pa0, pa1, pa2, pa3); }
    { auto rr = __builtin_amdgcn_permlane32_swap(__float_as_uint(l_reg), __float_as_uint(l_reg), false, false); l_reg = __uint_as_float(rr[0]) + __uint_as_float(rr[1]); }
    const bool bad = !(l_reg > 1e-30f);
    if (hi == 0) li_l[r32] = l_reg; asm volatile("s_waitcnt lgkmcnt(0)" ::: "memory");
    float rli[16];
#pragma unroll
    for (int r = 0; r < 16; ++r) rli[r] = __builtin_amdgcn_rcpf(li_l[crow(r, hi)]);
    unsigned short* stg = (unsigned short*)(lds + M2_OST) + wid * 2048;
    unsigned short* dst = CAT + ((size_t)b * S + q0 + wid * 32) * 1024 + h * 64;
    store_o_tile(o, rli, stg, dst, [](int row) { return (size_t)row * 1024; }, lane);
    asm volatile("s_waitcnt vmcnt(0)" ::: "memory");
    const int anybad = __syncthreads_or(bad ? 1 : 0);
    return anybad != 0;
#undef SLOAD
#undef SWRITE
#undef SWAIT
#undef ROT3
#undef STEP5
}

constexpr int M4_K = 0, M4_V = 4 * SHM_K, M4_WS = M4_V + 4 * SHM_V, M4_OST = M4_WS + 8 * 256;
template <bool FIRST> __device__ __forceinline__ void softmax_full(f32x16& p0, f32x16& p1, float& m_reg, f32x16& negm, float& l_reg, float& alpha, bf16x8& pa0, bf16x8& pa1, bf16x8& pa2, bf16x8& pa3, bool exact) {
    if (exact) partialSM2<FIRST>(p0, p1, m_reg, negm, alpha, true); else partialSM2<false>(p0, p1, m_reg, negm, alpha, false);
    finishSM(p0, p1, alpha, l_reg, pa0, pa1, pa2, pa3);
}
__device__ __forceinline__ void mla_unit_v4(int bh, int qb, const unsigned short* __restrict__ Q, const unsigned short* __restrict__ KN, const unsigned short* __restrict__ KR,
                                            const unsigned short* __restrict__ V, unsigned short* __restrict__ CAT, const float* __restrict__ KMX, char* lds) {
    const int tid = threadIdx.x, wid = __builtin_amdgcn_readfirstlane(tid >> 6), lane = tid & 63, r32 = lane & 31, hi = lane >> 5;
    const int b = bh >> 3, h = bh & 7; const bool halfB = wid >= 4;
    char* K_lds = lds + M4_K; char* V_lds = lds + M4_V;
    float* wsf = (float*)(lds + M4_WS) + wid * 64; float* li_l = wsf; float* al_l = wsf + 32;
    float m_reg = 0.f, l_reg = 0; f32x16 o[2] = {}; bf16x8 qr[6]; f32x16 negm = f32x16{};
    const size_t bhS = (size_t)bh * S; const int q0 = qb * 256;
    const unsigned short* Qw = Q + (bhS + q0 + wid * 32 + r32) * 96 + hi * 8;
#pragma unroll
    for (int d0 = 0; d0 < 6; ++d0) qr[d0] = *reinterpret_cast<const bf16x8*>(Qw + d0 * 16);
    bool exact = true;
    if (MLA_STATIC) { float q2 = 0.f;
#pragma unroll
      for (int d0 = 0; d0 < 6; ++d0)
#pragma unroll
          for (int j = 0; j < 8; ++j) { const float x = __uint_as_float((unsigned)(unsigned short)qr[d0][j] << 16); q2 += x * x; }
      { auto rr = __builtin_amdgcn_permlane32_swap(__float_as_uint(q2), __float_as_uint(q2), false, false); q2 = __uint_as_float(rr[0]) + __uint_as_float(rr[1]); }
      const float k2 = KMX[(b * 8 + h) * 2] + KMX[(b * 8 + h) * 2 + 1] + KMX[32 + b];
      const float ms = 1.01f * sqrtf(q2 * k2);
      exact = __syncthreads_or(!(ms <= 60.f)) != 0;
      if (!exact) { m_reg = ms;
#pragma unroll
          for (int r = 0; r < 16; ++r) negm[r] = -ms; } }
    const int srow = tid >> 3, sch = tid & 7, rrow = (tid & 255) >> 2, rch = tid & 3;
    const char* kn_u = (const char*)(KN + bhS * 64); const char* v_u = (const char*)(V + bhS * 64); const char* kr_u = (const char*)(KR + (size_t)b * S * 32);
    const unsigned kn_off = (unsigned)(srow * 64 + sch * 8) * 2u, kr_off = (unsigned)(rrow * 32 + rch * 8) * 2u;
    const int kst = KSWZ(srow, sch * 16), krst = KSWZ(rrow, (8 + rch) * 16), vst = v_st(srow, sch * 8);
    const int vb0 = (int)(uintptr_t)V_lds + v_rd_base(lane);
    bf16x8 s_kn, s_kr, s_v;
#define SLOAD(t) do { s_kn = *reinterpret_cast<const bf16x8*>(kn_u + (size_t)(t) * 8192 + kn_off); s_kr = *reinterpret_cast<const bf16x8*>(kr_u + (size_t)(t) * 4096 + kr_off); \
    s_v = *reinterpret_cast<const bf16x8*>(v_u + (size_t)(t) * 8192 + kn_off); } while (0)
#define SWRITE(sl) do { *(bf16x8*)(K_lds + (sl) * SHM_K + kst) = s_kn; if (tid < 256) *(bf16x8*)(K_lds + (sl) * SHM_K + krst) = s_kr; *(bf16x8*)(V_lds + (sl) * SHM_V + vst) = s_v; } while (0)
#define SWAIT() asm volatile("s_waitcnt vmcnt(0)" ::: "memory")
#define RESC(a) do { if (exact && __any((a) < 1.f)) { if (hi == 0) al_l[r32] = (a); asm volatile("s_waitcnt lgkmcnt(0)" ::: "memory"); \
    _Pragma("unroll") for (int d = 0; d < 2; ++d) _Pragma("unroll") for (int r = 0; r < 16; ++r) o[d][r] *= al_l[crow(r, hi)]; } } while (0)
#define RAWBAR() do { asm volatile("" ::: "memory"); __builtin_amdgcn_s_barrier(); asm volatile("" ::: "memory"); } while (0)
    f32x16 p0, p1; float al; bf16x8 pa0, pa1, pa2, pa3; bf16x8 kf[12]; constexpr int NT = S / 64;
    SLOAD(0); SWAIT(); SWRITE(0); SLOAD(1); SWAIT(); SWRITE(1); SLOAD(2);
    asm volatile("s_waitcnt lgkmcnt(0)" ::: "memory"); RAWBAR();
    if (halfB) RAWBAR();
    kfrag_load(kf, K_lds, r32, hi); SBAR();
    qk_mma(p0, p1, kf, qr, negm); SBAR();
    asm volatile("s_waitcnt lgkmcnt(0)" ::: "memory"); RAWBAR();
    softmax_full<true>(p0, p1, m_reg, negm, l_reg, al, pa0, pa1, pa2, pa3, exact); SBAR();
    SWAIT(); SWRITE(2); SLOAD(3); SBAR();
    kfrag_load(kf, K_lds + SHM_K, r32, hi); SBAR();
    asm volatile("s_waitcnt lgkmcnt(12)" ::: "memory"); RAWBAR();
    int sp = 0, sc = 1, sw = 3;
    for (int t = 1; t < NT; ++t) {
        { s16x4 val[4], vah[4], vbl[4], vbh[4]; const int vb_ = vb0 + sp * SHM_V;
          vfrag_load_h<0>(val, vah, vb_); SBAR();
          qk_mma(p0, p1, kf, qr, negm); SBAR();
          vfrag_load_h<1>(vbl, vbh, vb_); SBAR();
          asm volatile("s_waitcnt lgkmcnt(8)" ::: "memory"); SBAR();
          pv_mma_h(o[0], val, vah, pa0, pa1, pa2, pa3); SBAR();
          asm volatile("s_waitcnt lgkmcnt(0)" ::: "memory"); SBAR();
          pv_mma_h(o[1], vbl, vbh, pa0, pa1, pa2, pa3); SBAR(); }
        RAWBAR();
        if (t + 2 < NT) { SWAIT(); SWRITE(sw); if (t + 3 < NT) SLOAD(t + 3); } SBAR();
        softmax_full<false>(p0, p1, m_reg, negm, l_reg, al, pa0, pa1, pa2, pa3, exact); RESC(al); SBAR();
        sp = sc; sc = (sc + 1) & 3; sw = (sw + 1) & 3;
        if (t + 1 < NT) { kfrag_load(kf, K_lds + sc * SHM_K, r32, hi); SBAR(); }
        asm volatile("s_waitcnt lgkmcnt(12)" ::: "memory"); RAWBAR();
    }
    { s16x4 val[4], vah[4], vbl[4], vbh[4]; const int vb_ = vb0 + sp * SHM_V;
      vfrag_load_h<0>(val, vah, vb_); vfrag_load_h<1>(vbl, vbh, vb_); SBAR();
      asm volatile("s_waitcnt lgkmcnt(0)" ::: "memory"); SBAR();
      pv_mma_h(o[0], val, vah, pa0, pa1, pa2, pa3); pv_mma_h(o[1], vbl, vbh, pa0, pa1, pa2, pa3); SBAR(); }
    if (!halfB) RAWBAR();
    if (hi == 0) li_l[r32] = l_reg; asm volatile("s_waitcnt lgkmcnt(0)" ::: "memory");
    float rli[16];
#pragma unroll
    for (int r = 0; r < 16; ++r) rli[r] = __builtin_amdgcn_rcpf(li_l[crow(r, hi)]);
    unsigned short* stg = (unsigned short*)(lds + M4_OST) + wid * 2048;
    unsigned short* dst = CAT + ((size_t)b * S + q0 + wid * 32) * 1024 + h * 64;
    store_o_tile(o, rli, stg, dst, [](int row) { return (size_t)row * 1024; }, lane);
    asm volatile("s_waitcnt vmcnt(0)" ::: "memory");
    __syncthreads();
#undef SLOAD
#undef SWRITE
#undef SWAIT
#undef RESC
#undef RAWBAR
}

constexpr int DL_K = 0, DL_V = 49152, DL_WS = 98304, DL_OST = DL_WS + 8 * 256;
#define KSWZD(row, colB) ((row) * 128 + ((colB) ^ ((((row) >> 1) & 7) << 4)))
__device__ __forceinline__ void dil_unit(int bh, int br, int blk, const unsigned short* __restrict__ DQ, const unsigned short* __restrict__ DK, const unsigned short* __restrict__ DV,
                                         unsigned short* __restrict__ OBR, float* __restrict__ LSE, char* lds) {
    const int tid = threadIdx.x, wid = tid >> 6, lane = tid & 63, r32 = lane & 31, hi = lane >> 5;
    const int sh = 2 * br, dil = 1 << sh, L = S >> sh, nbl = L >> 8, res = blk / nbl, lb = blk % nbl;
    const size_t bhS = (size_t)bh * S; const int b = bh >> 3, h = bh & 7;
    char* K_lds = lds + DL_K; char* V_lds = lds + DL_V;
#pragma unroll
    for (int half = 0; half < 2; ++half) {
        bf16x8 kk[3], vv[3];
#pragma unroll
        for (int it = 0; it < 3; ++it) { const int item = (half * 3 + it) * 512 + tid, row = item >> 3, ch = item & 7; const int l = 256 * lb - 64 + row; const bool valid = (l >= 0) && (l < L);
            const size_t src = (bhS + (valid ? ((size_t)l << sh) + res : 0)) * 64 + ch * 8;
            kk[it] = *reinterpret_cast<const bf16x8*>(DK + src); vv[it] = *reinterpret_cast<const bf16x8*>(DV + src);
            if (!valid) { kk[it] = bf16x8{}; vv[it] = bf16x8{}; } }
#pragma unroll
        for (int it = 0; it < 3; ++it) { const int item = (half * 3 + it) * 512 + tid, row = item >> 3, ch = item & 7;
            *(bf16x8*)(K_lds + KSWZD(row, ch * 16)) = kk[it]; *(bf16x8*)(V_lds + (row >> 4) * 2048 + v_st(row & 15, ch * 8)) = vv[it]; }
    }
    bf16x8 qr[4];
    const int ql = wid * 32 + r32; const size_t qpos = ((size_t)(256 * lb + ql) << sh) + res;
    const unsigned short* Qw = DQ + (bhS + qpos) * 64 + hi * 8;
#pragma unroll
    for (int d0 = 0; d0 < 4; ++d0) qr[d0] = *reinterpret_cast<const bf16x8*>(Qw + d0 * 16);
    __syncthreads();
    f32x16 p[5];
#pragma unroll
    for (int j = 0; j < 5; ++j) { p[j] = f32x16{}; const int row = wid * 32 + j * 32 + r32;
#pragma unroll
        for (int d0 = 0; d0 < 4; ++d0) { const bf16x8 kf = *reinterpret_cast<const bf16x8*>(K_lds + KSWZD(row, (d0 * 16 + hi * 8) * 2)); p[j] = __builtin_amdgcn_mfma_f32_32x32x16_bf16(kf, qr[d0], p[j], 0, 0, 0); } }
    const float NEG = -1e30f;
    const int klo = 64 - 256 * lb, khi = L + 64 - 256 * lb;
    { const int t0 = max(r32, klo - wid * 32) - 4 * hi, t1 = klo - wid * 32 - 32 - 4 * hi, t3 = khi - wid * 32 - 96 - 4 * hi, t4 = min(r32 + 1, khi - wid * 32 - 128) - 4 * hi;
#pragma unroll
      for (int r = 0; r < 16; ++r) { const int c = (r & 3) + 8 * (r >> 2);
          if (c < t0) p[0][r] = NEG; if (c < t1) p[1][r] = NEG; if (c >= t3) p[3][r] = NEG; if (c >= t4) p[4][r] = NEG; } }
    float mx = rowmax32(p[0], p[1]); mx = fmaxf(mx, rowmax32(p[2], p[3]));
    { float m4 = p[4][0];
#pragma unroll
      for (int r = 1; r < 16; ++r) m4 = fmaxf(m4, p[4][r]);
      auto rr = __builtin_amdgcn_permlane32_swap(__float_as_uint(m4), __float_as_uint(m4), false, false); mx = fmaxf(mx, fmaxf(__uint_as_float(rr[0]), __uint_as_float(rr[1]))); }
    float ps = 0.f;
#pragma unroll
    for (int j = 0; j < 5; ++j)
#pragma unroll
        for (int r = 0; r < 16; ++r) { p[j][r] = __builtin_amdgcn_exp2f(p[j][r] - mx); ps += p[j][r]; }
    { auto rr = __builtin_amdgcn_permlane32_swap(__float_as_uint(ps), __float_as_uint(ps), false, false); ps = __uint_as_float(rr[0]) + __uint_as_float(rr[1]); }
    bf16x8 pa[5][2];
#pragma unroll
    for (int j = 0; j < 5; ++j) { PK4(p[j], 0, pa[j][0]); PK4(p[j], 8, pa[j][1]); }
    f32x16 o[2] = {};
    const int vb = (int)(uintptr_t)V_lds + v_rd_base(lane) + wid * 4096;
    pv_half<0, 0 * 4096>(o[0], vb, pa[0][0], pa[0][1]); pv_half<1, 0 * 4096>(o[1], vb, pa[0][0], pa[0][1]);
    pv_half<0, 1 * 4096>(o[0], vb, pa[1][0], pa[1][1]); pv_half<1, 1 * 4096>(o[1], vb, pa[1][0], pa[1][1]);
    pv_half<0, 2 * 4096>(o[0], vb, pa[2][0], pa[2][1]); pv_half<1, 2 * 4096>(o[1], vb, pa[2][0], pa[2][1]);
    pv_half<0, 3 * 4096>(o[0], vb, pa[3][0], pa[3][1]); pv_half<1, 3 * 4096>(o[1], vb, pa[3][0], pa[3][1]);
    pv_half<0, 4 * 4096>(o[0], vb, pa[4][0], pa[4][1]); pv_half<1, 4 * 4096>(o[1], vb, pa[4][0], pa[4][1]);
    float* wsf = (float*)(lds + DL_WS) + wid * 64;
    if (hi == 0) { wsf[r32] = ps; LSE[((size_t)br * T + (size_t)b * S + qpos) * 8 + h] = mx + __builtin_amdgcn_logf(ps); }
    asm volatile("s_waitcnt lgkmcnt(0)" ::: "memory");
    float rli[16];
#pragma unroll
    for (int r = 0; r < 16; ++r) rli[r] = __builtin_amdgcn_rcpf(wsf[crow(r, hi)]);
    unsigned short* stg = (unsigned short*)(lds + DL_OST) + wid * 2048;
    unsigned short* dst = OBR + ((size_t)br * T + (size_t)b * S + (((size_t)(256 * lb + wid * 32)) << sh) + res) * 512 + h * 64;
    store_o_tile(o, rli, stg, dst, [sh](int row) { return ((size_t)row << sh) * 512; }, lane);
    asm volatile("s_waitcnt vmcnt(0)" ::: "memory");
    __syncthreads();
}
#define DIL_DECODE(u, bh_, br_, res_, lb_, sh_, L_) const int bh_ = (u) / 96, br_ = ((u) >> 5) % 3, blk__##bh_ = (u) & 31, sh_ = 2 * br_, L_ = S >> sh_, nbl__##bh_ = L_ >> 8, res_ = blk__##bh_ / nbl__##bh_, lb_ = blk__##bh_ % nbl__##bh_
__device__ __forceinline__ void dil_phase(int u0, int ustep, int nunits, const unsigned short* __restrict__ DQ, const unsigned short* __restrict__ DK, const unsigned short* __restrict__ DV,
                                          unsigned short* __restrict__ OBR, float* __restrict__ LSE, char* lds) {
    const int tid = threadIdx.x, wid = tid >> 6, lane = tid & 63, r32 = lane & 31, hi = lane >> 5;
    char* K_lds = lds + DL_K; char* V_lds = lds + DL_V;
    bf16x8 kk[6], qn[4]; unsigned kmask = 0u;
#define DIL_LOAD6(dst, mask, SRC, u) do { DIL_DECODE(u, bh_, br_, res_, lb_, sh_, L_); const size_t bhS_ = (size_t)bh_ * S; mask = 0u; \
        _Pragma("unroll") for (int it = 0; it < 6; ++it) { const int item = it * 512 + tid, row = item >> 3, ch = item & 7; const int l = 256 * lb_ - 64 + row; const bool valid = (l >= 0) && (l < L_); \
            const size_t src = (bhS_ + (valid ? ((size_t)l << sh_) + res_ : 0)) * 64 + ch * 8; dst[it] = *reinterpret_cast<const bf16x8*>(SRC + src); mask |= (valid ? 1u : 0u) << it; } } while (0)
#define DIL_LOADQ(u) do { DIL_DECODE(u, bh_, br_, res_, lb_, sh_, L_); const size_t qpos_ = ((size_t)(256 * lb_ + wid * 32 + r32) << sh_) + res_; const unsigned short* Qw_ = DQ + ((size_t)bh_ * S + qpos_) * 64 + hi * 8; \
        _Pragma("unroll") for (int d0 = 0; d0 < 4; ++d0) qn[d0] = *reinterpret_cast<const bf16x8*>(Qw_ + d0 * 16); } while (0)
    int u = u0;
    if (u < nunits) { DIL_LOAD6(kk, kmask, DK, u); DIL_LOADQ(u); }
    for (; u < nunits; u += ustep) {
        DIL_DECODE(u, bh, br, res, lb, sh, L); const int b = bh >> 3, h = bh & 7;
#pragma unroll
        for (int it = 0; it < 6; ++it) { const int item = it * 512 + tid, row = item >> 3, ch = item & 7; *(bf16x8*)(K_lds + KSWZD(row, ch * 16)) = ((kmask >> it) & 1u) ? kk[it] : bf16x8{}; }
        bf16x8 qr[4];
#pragma unroll
        for (int d0 = 0; d0 < 4; ++d0) qr[d0] = qn[d0];
        bf16x8 vv[6]; unsigned vmask; DIL_LOAD6(vv, vmask, DV, u);
        __syncthreads();
        const int ql = wid * 32 + r32; const size_t qpos = ((size_t)(256 * lb + ql) << sh) + res;
        f32x16 p[5];
#pragma unroll
        for (int j = 0; j < 5; ++j) { p[j] = f32x16{}; const int row = wid * 32 + j * 32 + r32;
#pragma unroll
            for (int d0 = 0; d0 < 4; ++d0) { const bf16x8 kf = *reinterpret_cast<const bf16x8*>(K_lds + KSWZD(row, (d0 * 16 + hi * 8) * 2)); p[j] = __builtin_amdgcn_mfma_f32_32x32x16_bf16(kf, qr[d0], p[j], 0, 0, 0); } }
        const float NEG = -1e30f;
        const int klo = 64 - 256 * lb, khi = L + 64 - 256 * lb;
        { const int t0 = max(r32, klo - wid * 32) - 4 * hi, t1 = klo - wid * 32 - 32 - 4 * hi, t3 = khi - wid * 32 - 96 - 4 * hi, t4 = min(r32 + 1, khi - wid * 32 - 128) - 4 * hi;
#pragma unroll
          for (int r = 0; r < 16; ++r) { const int c = (r & 3) + 8 * (r >> 2);
              if (c < t0) p[0][r] = NEG; if (c < t1) p[1][r] = NEG; if (c >= t3) p[3][r] = NEG; if (c >= t4) p[4][r] = NEG; } }
        float mx = rowmax32(p[0], p[1]); mx = fmaxf(mx, rowmax32(p[2], p[3]));
        { float m4 = p[4][0];
#pragma unroll
          for (int r = 1; r < 16; ++r) m4 = fmaxf(m4, p[4][r]);
          auto rr = __builtin_amdgcn_permlane32_swap(__float_as_uint(m4), __float_as_uint(m4), false, false); mx = fmaxf(mx, fmaxf(__uint_as_float(rr[0]), __uint_as_float(rr[1]))); }
        float ps = 0.f;
#pragma unroll
        for (int j = 0; j < 5; ++j)
#pragma unroll
            for (int r = 0; r < 16; ++r) { p[j][r] = __builtin_amdgcn_exp2f(p[j][r] - mx); ps += p[j][r]; }
        { auto rr = __builtin_amdgcn_permlane32_swap(__float_as_uint(ps), __float_as_uint(ps), false, false); ps = __uint_as_float(rr[0]) + __uint_as_float(rr[1]); }
        bf16x8 pa[5][2];
#pragma unroll
        for (int j = 0; j < 5; ++j) { PK4(p[j], 0, pa[j][0]); PK4(p[j], 8, pa[j][1]); }
#pragma unroll
        for (int it = 0; it < 6; ++it) { const int item = it * 512 + tid, row = item >> 3, ch = item & 7; *(bf16x8*)(V_lds + (row >> 4) * 2048 + v_st(row & 15, ch * 8)) = ((vmask >> it) & 1u) ? vv[it] : bf16x8{}; }
        __syncthreads();
        if (u + ustep < nunits) { DIL_LOAD6(kk, kmask, DK, u + ustep); DIL_LOADQ(u + ustep); }
        f32x16 o[2] = {};
        const int vb = (int)(uintptr_t)V_lds + v_rd_base(lane) + wid * 4096;
        pv_half<0, 0 * 4096>(o[0], vb, pa[0][0], pa[0][1]); pv_half<1, 0 * 4096>(o[1], vb, pa[0][0], pa[0][1]);
        pv_half<0, 1 * 4096>(o[0], vb, pa[1][0], pa[1][1]); pv_half<1, 1 * 4096>(o[1], vb, pa[1][0], pa[1][1]);
        pv_half<0, 2 * 4096>(o[0], vb, pa[2][0], pa[2][1]); pv_half<1, 2 * 4096>(o[1], vb, pa[2][0], pa[2][1]);
        pv_half<0, 3 * 4096>(o[0], vb, pa[3][0], pa[3][1]); pv_half<1, 3 * 4096>(o[1], vb, pa[3][0], pa[3][1]);
        pv_half<0, 4 * 4096>(o[0], vb, pa[4][0], pa[4][1]); pv_half<1, 4 * 4096>(o[1], vb, pa[4][0], pa[4][1]);
        float* wsf = (float*)(lds + DL_WS) + wid * 64;
        if (hi == 0) { wsf[r32] = ps; LSE[((size_t)br * T + (size_t)b * S + qpos) * 8 + h] = mx + __builtin_amdgcn_logf(ps); }
        asm volatile("s_waitcnt lgkmcnt(0)" ::: "memory");
        float rli[16];
#pragma unroll
        for (int r = 0; r < 16; ++r) rli[r] = __builtin_amdgcn_rcpf(wsf[crow(r, hi)]);
        unsigned short* stg = (unsigned short*)(lds + DL_OST) + wid * 2048;
        unsigned short* dst = OBR + ((size_t)br * T + (size_t)b * S + (((size_t)(256 * lb + wid * 32)) << sh) + res) * 512 + h * 64;
        store_o_tile(o, rli, stg, dst, [sh](int row) { return ((size_t)row << sh) * 512; }, lane);
        __syncthreads();
    }
#undef DIL_LOAD6
#undef DIL_LOADQ
}
__device__ __forceinline__ void dil_combine(const unsigned short* __restrict__ OBR, const float* __restrict__ LSE, unsigned short* __restrict__ CAT, int gtid, int gthreads) {
    for (int i = gtid; i < T * 64; i += gthreads) { const int t = i >> 6, c8 = i & 63, h = c8 >> 3;
        const float l0 = LSE[((size_t)0 * T + t) * 8 + h], l1 = LSE[((size_t)1 * T + t) * 8 + h], l2 = LSE[((size_t)2 * T + t) * 8 + h];
        const float mx = fmaxf(l0, fmaxf(l1, l2)); float w0 = __builtin_amdgcn_exp2f(l0 - mx), w1 = __builtin_amdgcn_exp2f(l1 - mx), w2 = __builtin_amdgcn_exp2f(l2 - mx);
        const float inv = 1.f / (w0 + w1 + w2); w0 *= inv; w1 *= inv; w2 *= inv;
        const u32x4 a = *(const u32x4*)(OBR + ((size_t)0 * T + t) * 512 + c8 * 8), bb = *(const u32x4*)(OBR + ((size_t)1 * T + t) * 512 + c8 * 8), cc = *(const u32x4*)(OBR + ((size_t)2 * T + t) * 512 + c8 * 8);
        u32x4 o;
#pragma unroll
        for (int k = 0; k < 4; ++k) { const float lo = w0 * __uint_as_float(a[k] << 16) + w1 * __uint_as_float(bb[k] << 16) + w2 * __uint_as_float(cc[k] << 16);
            const float hi = w0 * __uint_as_float(a[k] & 0xffff0000u) + w1 * __uint_as_float(bb[k] & 0xffff0000u) + w2 * __uint_as_float(cc[k] & 0xffff0000u); o[k] = cvtpk(lo, hi); }
        *(u32x4*)(CAT + (size_t)t * 1024 + 512 + c8 * 8) = o; }
}
#undef SBAR
}
namespace mk {
struct SchedP4 {
    __device__ __forceinline__ void a_ready(const gm::Unit&, int) const {}
    __device__ __forceinline__ void done(const gm::Unit&, int) const {}
    static constexpr bool GATHER = false;
    const char* A; const char* Bt; int G, c;
    __device__ __forceinline__ bool next(int i, gm::Unit& u) const { int pm, pn; if (!static_tile(i, G, c, 64, 4, pm, pn)) return false;
        u.A = A; u.Bt = Bt; u.gidx = nullptr; u.lda2 = 2048; u.ldb2 = 2048; u.arow0 = pm * 256; u.brow0 = pn * 256; u.nt = 16; u.pm = pm; u.pn = pn; u.aux = 0; return true; }
};
struct EpiP4 {
    static constexpr bool PERM = false;
    const float* x; float* out; const float* modf;
    __device__ __forceinline__ void operator()(EPI_ARGS) const {
        const int b = (u.pm * 256) >> 13; const float* gt = modf + b * 6144 + 2048;
        const int col0 = u.pn * 256 + wc * 32 + 4 * fq;
        f32x4 g[2][2];
#pragma unroll
        for (int bj = 0; bj < 2; ++bj)
#pragma unroll
            for (int n = 0; n < 2; ++n) g[bj][n] = *(const f32x4*)(gt + col0 + bj * 128 + n * 16);
#pragma unroll
        for (int ai = 0; ai < 2; ++ai)
#pragma unroll
            for (int m = 0; m < 4; ++m) { const size_t off = (size_t)(u.pm * 256 + ai * 128 + wr * 64 + m * 16 + fr) * D + col0;
#pragma unroll
                for (int bj = 0; bj < 2; ++bj)
#pragma unroll
                    for (int n = 0; n < 2; ++n) { const f32x4 xv = *(const f32x4*)(x + off + bj * 128 + n * 16); *(f32x4*)(out + off + bj * 128 + n * 16) = xv + g[bj][n] * acc[ai][bj][m][n]; } }
    }
};
__device__ __forceinline__ void p4b_rows(Frame& F) {
    LAS float* WR = (LAS float*)F.lds;
    LAS float* A1 = WR + 16384;
    LAS float* A0 = A1 + 2048;
    const float* modf = (const float*)(F.ws + WS_MODF);
    for (int i = F.tid; i < 16384; i += NTHREADS) { const int j = i >> 4, e = i & 15; WR[e * 1024 + j] = F.w_router[i]; }
    for (int i = F.tid; i < 2048; i += NTHREADS) { const int b = i >> 10, j = i & 1023; A1[i] = F.g_ffn[j] * (1.f + modf[b * 6144 + 4096 + j]); A0[i] = modf[b * 6144 + 3072 + j]; }
    __syncthreads();
    const int gw = F.vcu * NWAVES + F.wave, NGW = F.G * NWAVES, lane = fresh_lane();
    for (int m = gw; m < T; m += NGW) { const int b = m >> 13, s = m & 8191;
        const f32x4* xr = (const f32x4*)(F.out + (size_t)m * D) + lane; f32x4 v[4]; float ss = 0.f;
#pragma unroll
        for (int j = 0; j < 4; ++j) { v[j] = xr[64 * j]; ss += (v[j].x * v[j].x + v[j].y * v[j].y) + (v[j].z * v[j].z + v[j].w * v[j].w); }
        const float rstd = rsqrtf(wave_sum(ss) * (1.f / D) + EPS);
        unsigned long long* o8 = (unsigned long long*)((bf16_t*)(F.ws + WS_HB) + (size_t)m * D) + lane;
        float lg[16];
#pragma unroll
        for (int e = 0; e < 16; ++e) lg[e] = 0.f;
#pragma unroll
        for (int j = 0; j < 4; ++j) { asm volatile("" ::: "memory");
            const f32x4 a1 = *(const LAS f32x4*)(A1 + b * 1024 + 4 * lane + 256 * j), a0 = *(const LAS f32x4*)(A0 + b * 1024 + 4 * lane + 256 * j);
            const f32x4 o = v[j] * rstd * a1 + a0; o8[64 * j] = (unsigned long long)pk2(o.x, o.y) | ((unsigned long long)pk2(o.z, o.w) << 32);
#pragma unroll
            for (int e = 0; e < 16; ++e) { const f32x4 w = *(const LAS f32x4*)(WR + e * 1024 + 4 * lane + 256 * j); lg[e] += (o.x * w.x + o.y * w.y) + (o.z * w.z + o.w * w.w); } }
        float w8[8], w4[4], w2[2], w1;
        { const bool up = lane & 32;
#pragma unroll
          for (int i = 0; i < 8; ++i) { const float snd = up ? lg[i] : lg[8 + i], kp = up ? lg[8 + i] : lg[i]; w8[i] = kp + __shfl_xor(snd, 32); } }
        { const bool up = lane & 16;
#pragma unroll
          for (int i = 0; i < 4; ++i) { const float snd = up ? w8[i] : w8[4 + i], kp = up ? w8[4 + i] : w8[i]; w4[i] = kp + __shfl_xor(snd, 16); } }
        { const bool up = lane & 8;
#pragma unroll
          for (int i = 0; i < 2; ++i) { const float snd = up ? w4[i] : w4[2 + i], kp = up ? w4[2 + i] : w4[i]; w2[i] = kp + __shfl_xor(snd, 8); } }
        { const bool up = lane & 4; const float snd = up ? w2[0] : w2[1], kp = up ? w2[1] : w2[0]; w1 = kp + __shfl_xor(snd, 4); }
        w1 += __shfl_xor(w1, 1); w1 += __shfl_xor(w1, 2);
        const int e = lane >> 2; const float logit = w1 + F.b_router[e];
        float mx = logit;
#pragma unroll
        for (int o = 4; o < 64; o <<= 1) mx = fmaxf(mx, __shfl_xor(mx, o));
        const float ex = __expf(logit - mx); float den = ex;
#pragma unroll
        for (int o = 4; o < 64; o <<= 1) den += __shfl_xor(den, o);
        if ((lane & 3) == 0) ((float*)(F.ws + WS_AFF))[((size_t)b * 16 + e) * S + s] = ex / den;
    }
    __syncthreads();
}
__device__ __forceinline__ void p5_topk(Frame& F) {
    if (F.vcu >= 32) { if (WD_IN_P5 && F.G > 32) wd_convert(F, 32); return; }
    const int be = F.vcu, b = be >> 4, e = be & 15, tid = F.tid;
    LAS unsigned* vals = (LAS unsigned*)F.lds;
    LAS unsigned* hist = vals + 8192;
    LAS unsigned* suf = hist + 256;
    LAS unsigned* misc = suf + 264;
    LAS unsigned* wtot = misc + 8;
    const float* a = (const float*)(F.ws + WS_AFF) + (size_t)be * S;
    for (int i = tid; i < 8192; i += NTHREADS) vals[i] = __float_as_uint(a[i]);
    if (tid == 0) { misc[0] = 0u; misc[1] = 1024u; }
    __syncthreads();
    for (int pass = 0; pass < 4; ++pass) {
        const int sh = 24 - 8 * pass; const unsigned prefix = misc[0], k = misc[1]; const unsigned himask = pass == 0 ? 0u : (0xffffffffu << (sh + 8));
        if (tid < 256) hist[tid] = 0u;
        __syncthreads();
        for (int i = tid; i < 8192; i += NTHREADS) { const unsigned v = vals[i]; if ((v & himask) == prefix) __hip_atomic_fetch_add(&hist[(v >> sh) & 255u], 1u, __ATOMIC_RELAXED, __HIP_MEMORY_SCOPE_WORKGROUP); }
        __syncthreads();
        if (tid < 256) suf[tid] = hist[tid]; if (tid == 0) suf[256] = 0u;
        __syncthreads();
        for (int o = 1; o < 256; o <<= 1) { unsigned t = 0u; if (tid < 256) t = suf[tid] + ((tid + o < 256) ? suf[tid + o] : 0u); __syncthreads(); if (tid < 256) suf[tid] = t; __syncthreads(); }
        if (tid < 256) { const unsigned sge = suf[tid], sgt = (tid < 255) ? suf[tid + 1] : 0u; if (sge >= k && sgt < k) { misc[0] = prefix | ((unsigned)tid << sh); misc[1] = k - sgt; } }
        __syncthreads();
    }
    const unsigned thr = misc[0], need = misc[1];
    unsigned gtc = 0, eqc = 0;
#pragma unroll
    for (int i = 0; i < 16; ++i) { const unsigned v = vals[tid * 16 + i]; gtc += v > thr; eqc += v == thr; }
    unsigned gi = gtc, ei = eqc; const int lane = fresh_lane(), wv = F.wave;
#pragma unroll
    for (int o = 1; o < 64; o <<= 1) { const unsigned g2 = __shfl_up(gi, o), e2 = __shfl_up(ei, o); if (lane >= o) { gi += g2; ei += e2; } }
    if (lane == 63) { wtot[wv] = gi; wtot[8 + wv] = ei; }
    __syncthreads();
    unsigned gbase = 0, ebase = 0, gtotal = 0;
    for (int w = 0; w < 8; ++w) { const unsigned g = wtot[w], q = wtot[8 + w]; if (w < wv) { gbase += g; ebase += q; } gtotal += g; }
    unsigned gpos = gbase + gi - gtc, epos = ebase + ei - eqc;
    int* IDX = (int*)(F.ws + WS_IDX) + (e * 2 + b) * 1024; float* GATE = (float*)(F.ws + WS_GATE) + (e * 2 + b) * 1024; int* SLOT = (int*)(F.ws + WS_SLOT);
#pragma unroll
    for (int i = 0; i < 16; ++i) { const int s = tid * 16 + i; const unsigned v = vals[s]; int c = -1;
        if (v > thr) c = (int)gpos++; else if (v == thr) { if (epos < need) c = (int)(gtotal + epos); ++epos; }
        if (c >= 0) { IDX[c] = b * S + s; GATE[c] = __uint_as_float(v); }
        SLOT[(size_t)(b * S + s) * 16 + e] = c >= 0 ? (e * 2 + b) * 1024 + c : -1; }
}
struct SchedP6a {
    __device__ __forceinline__ void a_ready(const gm::Unit&, int) const {}
    __device__ __forceinline__ void done(const gm::Unit&, int) const {}
    static constexpr bool GATHER = true;
    const char* A; const char* W; const int* idx; int G, vcu;
    __device__ __forceinline__ bool next(int i, gm::Unit& u) const {
        int e, pmu, pn;
        if (G == 256) { if (i >= 4) return false; const int xcd = vcu >> 5, j = vcu & 31; e = xcd + 8 * (i >> 1); const int sub = (i & 1) * 32 + j; pmu = sub >> 3; pn = sub & 7; }
        else { const int L = i * G + vcu; if (L >= 1024) return false; e = L >> 6; pmu = (L >> 3) & 7; pn = L & 7; }
        u.A = A; u.gidx = idx + e * 2048 + pmu * 256; u.lda2 = 2048; u.arow0 = 0; u.Bt = W + (size_t)e * 2048 * 2048; u.brow0 = pn * 256; u.ldb2 = 2048; u.nt = 16; u.pm = e * 8 + pmu; u.pn = pn; u.aux = e; return true; }
};
struct EpiP6a {
    static constexpr bool PERM = true;
    bf16_t* H;
    __device__ __forceinline__ void operator()(EPI_ARGS) const {
#pragma unroll
        for (int ai = 0; ai < 2; ++ai)
#pragma unroll
            for (int m = 0; m < 4; ++m) { const size_t row = (size_t)u.pm * 256 + ai * 128 + wr * 64 + m * 16 + fr;
                f32x4 h0, h1;
#pragma unroll
                for (int j = 0; j < 4; ++j) { h0[j] = siluf(acc[ai][0][m][0][j]) * acc[ai][1][m][0][j]; h1[j] = siluf(acc[ai][0][m][1][j]) * acc[ai][1][m][1][j]; }
                *(u32x4*)(H + row * 1024 + u.pn * 128 + wc * 32 + 8 * fq) = pack8(h0, h1); }
    }
};
struct SchedP6b {
    __device__ __forceinline__ void a_ready(const gm::Unit&, int) const {}
    __device__ __forceinline__ void done(const gm::Unit&, int) const {}
    static constexpr bool GATHER = false;
    const char* A; const char* W; int G, vcu;
    __device__ __forceinline__ bool next(int i, gm::Unit& u) const {
        int e, pmu, pn;
        if (G == 256) { if (i >= 2) return false; const int xcd = vcu >> 5, j = vcu & 31; e = xcd + 8 * i; pmu = j >> 2; pn = j & 3; }
        else { const int L = i * G + vcu; if (L >= 512) return false; e = L >> 5; pmu = (L >> 2) & 7; pn = L & 3; }
        u.A = A; u.gidx = nullptr; u.lda2 = 2048; u.arow0 = (e * 8 + pmu) * 256; u.Bt = W + (size_t)e * 1024 * 2048; u.brow0 = pn * 256; u.ldb2 = 2048; u.nt = 16; u.pm = e * 8 + pmu; u.pn = pn; u.aux = e; return true; }
};
struct EpiP6b {
    static constexpr bool PERM = true;
    bf16_t* Y; const float* gate;
    __device__ __forceinline__ void operator()(EPI_ARGS) const {
#pragma unroll
        for (int ai = 0; ai < 2; ++ai)
#pragma unroll
            for (int m = 0; m < 4; ++m) { const size_t row = (size_t)u.pm * 256 + ai * 128 + wr * 64 + m * 16 + fr; const float g = gate[row];
#pragma unroll
                for (int bj = 0; bj < 2; ++bj) *(u32x4*)(Y + row * 1024 + u.pn * 256 + bj * 128 + wc * 32 + 8 * fq) = pack8(acc[ai][bj][m][0] * g, acc[ai][bj][m][1] * g); }
    }
};
__device__ __forceinline__ void p7_final(Frame& F) {
    const float* modf = (const float*)(F.ws + WS_MODF); const int* SLOT = (const int*)(F.ws + WS_SLOT); const bf16_t* Y = (const bf16_t*)(F.ws + WS_Y);
    const int gw = F.vcu * NWAVES + F.wave, NGW = F.G * NWAVES, lane = fresh_lane();
    for (int m0 = gw; m0 < T; m0 += 2 * NGW) {
        const int m1 = m0 + NGW; const bool has1 = m1 < T; const int mm1 = has1 ? m1 : m0;
        f32x4* xr0 = (f32x4*)(F.out + (size_t)m0 * D) + lane; f32x4* xr1 = (f32x4*)(F.out + (size_t)mm1 * D) + lane; f32x4 v0[4], v1[4], a0[4], a1[4];
#pragma unroll
        for (int j = 0; j < 4; ++j) { v0[j] = xr0[64 * j]; v1[j] = xr1[64 * j]; a0[j] = (f32x4){0.f, 0.f, 0.f, 0.f}; a1[j] = (f32x4){0.f, 0.f, 0.f, 0.f}; }
        const int sl0 = lane < 16 ? SLOT[(size_t)m0 * 16 + lane] : -1, sl1 = lane < 16 ? SLOT[(size_t)mm1 * 16 + lane] : -1;
        for (int e = 0; e < 16; ++e) { const int s0 = __shfl(sl0, e), s1 = __shfl(sl1, e);
            if (s0 >= 0) { const u32x2* yr = (const u32x2*)(Y + (size_t)s0 * 1024) + lane;
#pragma unroll
                for (int j = 0; j < 4; ++j) { const u32x2 w = yr[64 * j]; a0[j].x += __uint_as_float(w.x << 16); a0[j].y += __uint_as_float(w.x & 0xffff0000u); a0[j].z += __uint_as_float(w.y << 16); a0[j].w += __uint_as_float(w.y & 0xffff0000u); } }
            if (s1 >= 0) { const u32x2* yr = (const u32x2*)(Y + (size_t)s1 * 1024) + lane;
#pragma unroll
                for (int j = 0; j < 4; ++j) { const u32x2 w = yr[64 * j]; a1[j].x += __uint_as_float(w.x << 16); a1[j].y += __uint_as_float(w.x & 0xffff0000u); a1[j].z += __uint_as_float(w.y << 16); a1[j].w += __uint_as_float(w.y & 0xffff0000u); } } }
        float ss0 = 0.f, ss1 = 0.f; const int b0 = m0 >> 13, b1 = mm1 >> 13;
#pragma unroll
        for (int j = 0; j < 4; ++j) { const f32x4 g0 = *(const f32x4*)(modf + b0 * 6144 + 5120 + 4 * lane + 256 * j), g1 = *(const f32x4*)(modf + b1 * 6144 + 5120 + 4 * lane + 256 * j);
            v0[j] = v0[j] + g0 * a0[j]; v1[j] = v1[j] + g1 * a1[j];
            ss0 += (v0[j].x * v0[j].x + v0[j].y * v0[j].y) + (v0[j].z * v0[j].z + v0[j].w * v0[j].w); ss1 += (v1[j].x * v1[j].x + v1[j].y * v1[j].y) + (v1[j].z * v1[j].z + v1[j].w * v1[j].w); }
        const float r0 = rsqrtf(wave_sum(ss0) * (1.f / D) + EPS), r1 = rsqrtf(wave_sum(ss1) * (1.f / D) + EPS);
#pragma unroll
        for (int j = 0; j < 4; ++j) { const f32x4 g = *(const f32x4*)(F.g_final + 4 * lane + 256 * j); xr0[64 * j] = v0[j] * r0 * g; if (has1) xr1[64 * j] = v1[j] * r1 * g; }
    }
}
}
#ifndef MLA_V4
#define MLA_V4 0
#endif
#ifndef MERGE_P12
#define MERGE_P12 1
#endif
#ifndef DIL_PIPE
#define DIL_PIPE 1
#endif
#ifndef MLA_UNIT
#define MLA_UNIT mla_unit_v2
#endif
namespace mk {
namespace cg = cooperative_groups;
__global__ void __launch_bounds__(NTHREADS, 2) mega(Args args) {
    extern __shared__ __attribute__((aligned(16))) unsigned char lds_raw[];
    cg::grid_group grid = cg::this_grid();
    Frame F;
    F.lds = (LAS unsigned char*)lds_raw; F.ws = args.ws; F.out = args.out;
    F.tid = threadIdx.x; F.lane = F.tid & 63; F.wave = __builtin_amdgcn_readfirstlane(F.tid >> 6);
    F.G = gridDim.x; { const int bx = blockIdx.x; F.vcu = (F.G % 8 == 0) ? (bx % 8) * (F.G / 8) + bx / 8 : bx; }
    F.x = (const float*)args.in[0]; F.c = (const float*)args.in[1]; F.pos = (const int*)args.in[2]; F.w_ada = (const float*)args.in[3]; F.b_ada = (const float*)args.in[4];
    F.g_mix = (const float*)args.in[5]; F.w_in = (const float*)args.in[6]; F.g_q = (const float*)args.in[7]; F.w_uq = (const float*)args.in[8]; F.g_kv = (const float*)args.in[9];
    F.w_ukv = (const float*)args.in[10]; F.w_out = (const float*)args.in[11]; F.g_ffn = (const float*)args.in[12]; F.w_router = (const float*)args.in[13]; F.b_router = (const float*)args.in[14];
    F.w_gate = (const float*)args.in[15]; F.w_up = (const float*)args.in[16]; F.w_down = (const float*)args.in[17]; F.g_final = (const float*)args.in[18];
    const int lo = args.ph_lo, hi = args.ph_hi;
    volatile LAS unsigned* MISC = (volatile LAS unsigned*)(F.lds + LDS_BYTES - 256);
    if (F.tid < 64) MISC[F.tid] = 0u;
    __syncthreads();
    XcdBarrier xbar = xcd_barrier_post((unsigned*)(F.ws + WS_CTL) + 1024 + args.li * 4096, MISC + 8);
#define IN(k) (lo <= (k) && (k) < hi)
#ifndef CG_SEAMS
#define CG_SEAMS 0x000
#endif
#define SEAM(k) do { if (IN(k) && IN((k) + 1)) { if ((CG_SEAMS >> (k)) & 1) grid.sync(); else xcd_barrier(xbar); } } while (0)
    if (IN(0)) { p0_prologue(F); } SEAM(0);
    if (IN(1)) { p0b_rows(F); } SEAM(1);
#if MERGE_P12
    if (IN(2)) { SchedP12 S{(const char*)(F.ws + WS_HB), (const char*)(F.ws + WS_WIN), (const char*)(F.ws + WS_CQ), (const char*)(F.ws + WS_WUQ), (const char*)(F.ws + WS_WUKV), (unsigned*)(F.ws + WS_PCNT), F.G, F.vcu, (int)blockIdx.x};
        EpiP12 E{F.ws}; gm::gemm_phase<EpiP12, SchedP12>(F.lds, S, E); } SEAM(3);
#else
    if (IN(2)) { SchedP1 S{(const char*)(F.ws + WS_HB), (const char*)(F.ws + WS_WIN), F.G, (int)blockIdx.x}; EpiP1 E{F.ws}; gm::gemm_phase<EpiP1, SchedP1>(F.lds, S, E); } SEAM(2);
    if (IN(3)) { SchedP2 S{(const char*)(F.ws + WS_CQ), (const char*)(F.ws + WS_WUQ), (const char*)(F.ws + WS_WUKV), F.G, (int)blockIdx.x}; EpiP2 E{F.ws}; gm::gemm_phase<EpiP2, SchedP2>(F.lds, S, E); } SEAM(3);
#endif
    if (IN(4)) {
        const unsigned short* DQ = (const unsigned short*)(F.ws + WS_DQ); const unsigned short* DK = (const unsigned short*)(F.ws + WS_DK); const unsigned short* DV = (const unsigned short*)(F.ws + WS_DV);
        unsigned short* OBR = (unsigned short*)F.out; float* LSE = (float*)(F.ws + WS_LSE);
        if (args.pad & 1) { if (DIL_PIPE) at::dil_phase(F.vcu, F.G, 1536, DQ, DK, DV, OBR, LSE, (char*)lds_raw); else for (int u = F.vcu; u < 1536; u += F.G) { const int blk = u & 31, br = (u >> 5) % 3, bh = u / 96; at::dil_unit(bh, br, blk, DQ, DK, DV, OBR, LSE, (char*)lds_raw); } }
        if (args.pad & 2) for (int u = F.vcu; u < 512; u += F.G) { const int bh = (u >> 8) * 8 + ((u & 255) >> 5), qb = u & 31;
            #if MLA_V4
            at::mla_unit_v4(bh, qb, (const unsigned short*)(F.ws + WS_Q), (const unsigned short*)(F.ws + WS_KN), (const unsigned short*)(F.ws + WS_KR), (const unsigned short*)(F.ws + WS_V), (unsigned short*)(F.ws + WS_HB), (const float*)(F.ws + WS_KMX), (char*)lds_raw); }
#else
            at::mla_unit_v2(bh, qb, (const unsigned short*)(F.ws + WS_Q), (const unsigned short*)(F.ws + WS_KN), (const unsigned short*)(F.ws + WS_KR), (const unsigned short*)(F.ws + WS_V), (unsigned short*)(F.ws + WS_HB), (const float*)(F.ws + WS_KMX), (char*)lds_raw); }
#endif
    } SEAM(4);
    if (IN(5)) { at::dil_combine((const unsigned short*)F.out, (const float*)(F.ws + WS_LSE), (unsigned short*)(F.ws + WS_HB), F.vcu * NTHREADS + F.tid, F.G * NTHREADS); } SEAM(5);
    if (IN(6)) { SchedP4 S{(const char*)(F.ws + WS_HB), (const char*)(F.ws + WS_WOUT), F.G, (int)blockIdx.x}; EpiP4 E{F.x, F.out, (const float*)(F.ws + WS_MODF)}; gm::gemm_phase<EpiP4, SchedP4>(F.lds, S, E); } SEAM(6);
    if (IN(7)) { p4b_rows(F); } SEAM(7);
    if (IN(8)) { p5_topk(F); } SEAM(8);
    if (IN(9)) { SchedP6a S{(const char*)(F.ws + WS_HB), (const char*)(F.ws + WS_WGU), (const int*)(F.ws + WS_IDX), F.G, F.vcu}; EpiP6a E{(bf16_t*)(F.ws + WS_HBUF)}; gm::gemm_phase<EpiP6a, SchedP6a>(F.lds, S, E); } SEAM(9);
    if (IN(10)) { SchedP6b S{(const char*)(F.ws + WS_HBUF), (const char*)(F.ws + WS_WD), F.G, F.vcu}; EpiP6b E{(bf16_t*)(F.ws + WS_Y), (const float*)(F.ws + WS_GATE)}; gm::gemm_phase<EpiP6b, SchedP6b>(F.lds, S, E); } SEAM(10);
    if (IN(11)) { p7_final(F); }
#undef IN
#undef SEAM
}
}
namespace nv {
__device__ __forceinline__ float bf2f(unsigned short b) { return __builtin_bit_cast(float, (unsigned)b << 16); }
__global__ __launch_bounds__(256) void k_attn_mla_bf(const unsigned short* __restrict__ Q, const unsigned short* __restrict__ KN, const unsigned short* __restrict__ V, const unsigned short* __restrict__ KR, float* __restrict__ cat, int b) {
    __shared__ float Ks[32][96]; __shared__ float Vs[32][64];
    const int h = blockIdx.y, t = blockIdx.x * 256 + threadIdx.x; const size_t bh = (size_t)(b * 8 + h) * S;
    float qv[96];
#pragma unroll
    for (int d = 0; d < 96; ++d) qv[d] = bf2f(Q[(bh + t) * 96 + d]);
    float o[64];
#pragma unroll
    for (int d = 0; d < 64; ++d) o[d] = 0.f;
    float m = -1e30f, l = 0.f;
    for (int k0 = 0; k0 < S; k0 += 32) {
        __syncthreads();
        for (int i = threadIdx.x; i < 32 * 96; i += 256) { int r = i / 96, d = i % 96; Ks[r][d] = d < 64 ? bf2f(KN[(bh + k0 + r) * 64 + d]) : bf2f(KR[((size_t)b * S + k0 + r) * 32 + d - 64]); }
        for (int i = threadIdx.x; i < 32 * 64; i += 256) { int r = i / 64, d = i % 64; Vs[r][d] = bf2f(V[(bh + k0 + r) * 64 + d]); }
        __syncthreads();
        float sc[32]; float tm = -1e30f;
#pragma unroll
        for (int j = 0; j < 32; ++j) { float s = 0.f;
#pragma unroll
            for (int d = 0; d < 96; ++d) s += qv[d] * Ks[j][d];
            sc[j] = s; tm = fmaxf(tm, s); }
        const float mn = fmaxf(m, tm), al = exp2f(m - mn); m = mn; l *= al;
#pragma unroll
        for (int d = 0; d < 64; ++d) o[d] *= al;
#pragma unroll
        for (int j = 0; j < 32; ++j) { const float p = exp2f(sc[j] - mn); l += p;
#pragma unroll
            for (int d = 0; d < 64; ++d) o[d] += p * Vs[j][d]; }
    }
    const float il = 1.f / l;
#pragma unroll
    for (int d = 0; d < 64; ++d) cat[(size_t)t * 1024 + h * 64 + d] = o[d] * il;
}
__global__ __launch_bounds__(256) void k_attn_dil_bf(const unsigned short* __restrict__ DQ, const unsigned short* __restrict__ DK, const unsigned short* __restrict__ DV, float* __restrict__ cat, int b) {
    const int h = blockIdx.y, t = blockIdx.x * 256 + threadIdx.x; const size_t bh = (size_t)(b * 8 + h) * S;
    float qv[64];
#pragma unroll
    for (int d = 0; d < 64; ++d) qv[d] = bf2f(DQ[(bh + t) * 64 + d]);
    float o[64];
#pragma unroll
    for (int d = 0; d < 64; ++d) o[d] = 0.f;
    float m = -1e30f, l = 0.f;
    for (int br = 0; br < 3; ++br) { const int dil = br == 0 ? 1 : (br == 1 ? 4 : 16);
        for (int j = -64; j <= 64; ++j) { const int kt = t + dil * j; if (kt < 0 || kt >= S) continue;
            const unsigned short* kp = DK + (bh + kt) * 64; float s = 0.f;
#pragma unroll
            for (int d = 0; d < 64; ++d) s += qv[d] * bf2f(kp[d]);
            if (s > m) { const float al = exp2f(m - s); l *= al;
#pragma unroll
                for (int d = 0; d < 64; ++d) o[d] *= al;
                m = s; }
            const float p = exp2f(s - m); l += p; const unsigned short* vp = DV + (bh + kt) * 64;
#pragma unroll
            for (int d = 0; d < 64; ++d) o[d] += p * bf2f(vp[d]); } }
    const float il = 1.f / l;
#pragma unroll
    for (int d = 0; d < 64; ++d) cat[(size_t)t * 1024 + 512 + h * 64 + d] = o[d] * il;
}
__global__ void k_bf2f(const unsigned short* in, float* out, size_t n) { size_t i = (size_t)blockIdx.x * 256 + threadIdx.x; if (i < n) out[i] = bf2f(in[i]); }
static void naive_tail_from_cat(void* const* d_in, int b, float* ob, const float* mod, float* hb, float* mixed, float* Hb, float* Y, float* aff, int* idx, float* gate, int* slot, hipStream_t st) {
    const float* x = (const float*)d_in[0]; const float* w_out = (const float*)d_in[11];
    const float* xb = x + (size_t)b * S * D; const float* mb = mod + b * 6144;
    k_gemm<<<dim3(1024 / 64, S / 64, 1), 256, 0, st>>>(hb, 1024, 0, nullptr, w_out, nullptr, 1024, 0, mixed, 1024, S, 1024, 1024, nullptr);
    k_resid<<<(S * D + 255) / 256, 256, 0, st>>>(xb, mb + 2048, mixed, ob, S * D);
}
static void naive_tail_from_x1(void* const* d_in, int b, float* ob, const float* mod, float* hb, float* Hb, float* Y, float* aff, int* idx, float* gate, int* slot, hipStream_t st, bool have_h2) {
    const float* g_ffn = (const float*)d_in[12]; const float* w_router = (const float*)d_in[13]; const float* b_router = (const float*)d_in[14];
    const float* w_gate = (const float*)d_in[15]; const float* w_up = (const float*)d_in[16]; const float* w_down = (const float*)d_in[17]; const float* g_final = (const float*)d_in[18];
    const float* mb = mod + b * 6144;
    if (!have_h2) k_h2_aff<<<S / 4, 256, 0, st>>>(ob, g_ffn, mb + 3072, mb + 4096, w_router, b_router, hb, aff);
    k_topk<<<dim3(S / 256, 16), 256, 0, st>>>(aff, idx, gate, slot);
    k_gemm<<<dim3(16, 16, 16), 256, 0, st>>>(hb, 1024, 0, idx, w_gate, w_up, 1024, 1024 * 1024, Hb, 1024, 1024, 1024, 1024, nullptr);
    k_gemm<<<dim3(16, 16, 16), 256, 0, st>>>(Hb, 1024, 1024 * 1024, nullptr, w_down, nullptr, 1024, 1024 * 1024, Y, 1024, 1024, 1024, 1024, gate);
    k_final<<<S / 4, 256, 0, st>>>(ob, mb + 5120, Y, slot, g_final, ob);
}
}
#ifndef TEST_STAGE
#define TEST_STAGE 0
#endif
#ifndef PROBE_SPLIT
#define PROBE_SPLIT -1
#endif
#ifndef PROBE_SUB
#define PROBE_SUB 3
#endif
#ifndef PROBE_REPEAT
#define PROBE_REPEAT 0
#endif
#ifndef TEST_C0
#define TEST_C0 0
#endif
extern "C" void kernel_launch(void* const* d_in, const int* in_sizes, int n_in, void* d_out, int out_size, void* d_ws, size_t ws_size, hipStream_t stream) {
    using namespace mk;
    static int grid = 0;
    if (grid == 0) {
        if (n_in != 19 || out_size != T * D || ws_size < 290 * MiB) { fprintf(stderr, "kernel_launch: bad shapes/ws %d %d %zu\n", n_in, out_size, ws_size); grid = -1; return; }
        int dev = 0, cus = 0, per_cu = 0;
        hipGetDevice(&dev); hipDeviceGetAttribute(&cus, hipDeviceAttributeMultiprocessorCount, dev);
        if (hipFuncSetAttribute((const void*)mega, hipFuncAttributeMaxDynamicSharedMemorySize, LDS_BYTES) != hipSuccess) { fprintf(stderr, "hipFuncSetAttribute failed\n"); grid = -1; return; }
        hipOccupancyMaxActiveBlocksPerMultiprocessor(&per_cu, (const void*)mega, NTHREADS, LDS_BYTES);
        if (per_cu < 1) { fprintf(stderr, "occupancy query says %d\n", per_cu); grid = -1; return; }
        grid = cus;
    }
    if (grid < 0) return;
    hipMemsetAsync((char*)d_ws + WS_CTL, 0, 64 * KiB, stream);
    Args a{}; for (int i = 0; i < 19; ++i) a.in[i] = d_in[i]; a.out = (float*)d_out; a.ws = (unsigned char*)d_ws;
    a.pad = 3; a.ph_lo = 0; a.ph_hi = (TEST_STAGE == 0) ? 12 : (TEST_STAGE == 1) ? 4 : 6;
    void* kargs[] = {&a};
#if PROBE_SPLIT >= 0
    { const int hi_all = a.ph_hi; a.ph_lo = 0; a.ph_hi = PROBE_SPLIT + PROBE_REPEAT; a.li = 0;
      if (a.ph_hi > 0) { hipError_t e0 = hipLaunchCooperativeKernel((const void*)mega, dim3(grid), dim3(NTHREADS), kargs, LDS_BYTES, stream); if (e0 != hipSuccess) { fprintf(stderr, "launch A failed\n"); return; } }
      a.ph_lo = PROBE_SPLIT; a.ph_hi = hi_all; a.li = 1; a.pad = PROBE_SUB; }
#endif
    hipError_t e = hipLaunchCooperativeKernel((const void*)mega, dim3(grid), dim3(NTHREADS), kargs, LDS_BYTES, stream);
    if (e != hipSuccess) { fprintf(stderr, "cooperative launch failed: %s\n", hipGetErrorString(e)); return; }
    if (TEST_STAGE == 0) return;
    if (TEST_STAGE == 3) { nv::run_naive(d_in, (float*)d_out, (char*)d_ws + 52 * MiB, stream, (const unsigned short*)((char*)d_ws + WS_HB), (double*)((char*)d_ws + 4096), TEST_C0, 512); return; }
    char* ws = (char*)d_ws; const float* modf = (const float*)(ws + WS_MODF);
    float* cat0 = (float*)(ws + 180 * MiB); float* cat1 = (float*)(ws + 214 * MiB); float* mixed = (float*)(ws + 248 * MiB);
    float* aff = (float*)(ws + 282 * MiB); int* idx = (int*)(ws + 283 * MiB); float* gate = (float*)(ws + 283 * MiB + 256 * KiB); int* slot = (int*)(ws + 284 * MiB);
    float* Hb = (float*)(ws + 52 * MiB); float* Y = (float*)(ws + 116 * MiB);
    if (TEST_STAGE == 1) for (int b = 0; b < 2; ++b) { float* cat = b ? cat1 : cat0;
        nv::k_attn_mla_bf<<<dim3(S / 256, 8), 256, 0, stream>>>((const unsigned short*)(ws + WS_Q), (const unsigned short*)(ws + WS_KN), (const unsigned short*)(ws + WS_V), (const unsigned short*)(ws + WS_KR), cat, b);
        nv::k_attn_dil_bf<<<dim3(S / 256, 8), 256, 0, stream>>>((const unsigned short*)(ws + WS_DQ), (const unsigned short*)(ws + WS_DK), (const unsigned short*)(ws + WS_DV), cat, b); }
    if (TEST_STAGE == 2) for (int b = 0; b < 2; ++b) nv::k_bf2f<<<(S * 1024 + 255) / 256, 256, 0, stream>>>((const unsigned short*)(ws + WS_HB) + (size_t)b * S * 1024, b ? cat1 : cat0, (size_t)S * 1024);
    for (int b = 0; b < 2; ++b) { float* cat = b ? cat1 : cat0; float* ob = (float*)d_out + (size_t)b * S * D;
        nv::naive_tail_from_cat(d_in, b, ob, modf, cat, mixed, Hb, Y, aff, idx, gate, slot, stream);
        nv::naive_tail_from_x1(d_in, b, ob, modf, cat, Hb, Y, aff, idx, gate, slot, stream, false); }
}
```

```cpp
#include <hip/hip_runtime.h>
#include <hip/hip_cooperative_groups.h>
#include <hip/hip_bf16.h>
#include <cstdio>
#include <cstdint>
#include <cmath>
namespace gm {
#define LAS __attribute__((address_space(3)))
typedef unsigned short bf16_t;
typedef short bf16x8 __attribute__((ext_vector_type(8)));
typedef float f32x4 __attribute__((ext_vector_type(4)));
typedef float f32x2 __attribute__((ext_vector_type(2)));
typedef unsigned u32x4 __attribute__((ext_vector_type(4)));
typedef unsigned u32x2 __attribute__((ext_vector_type(2)));
constexpr int BM = 256, BK = 64, HALF = 128, HTB = HALF * BK * 2, STAGE_BYTES = 8 * HTB;

__device__ __forceinline__ int lds_byte(int r, int c) { const int st = (r >> 4) * 2 + (c >> 5), rr = r & 15, cc = c & 31, ob = rr * 64 + cc * 2; return st * 1024 + (ob ^ (((ob >> 9) & 1) << 5)); }
__device__ __forceinline__ void stage_rc(int b, int& R, int& C) { const int st = b / 1024, sb = b % 1024, swz = sb ^ (((sb >> 9) & 1) << 5); R = (st >> 1) * 16 + swz / 64; C = (st & 1) * 32 + (swz % 64) / 2; }
__device__ __forceinline__ int perm32(int rho) { const int n = rho >> 4, i = rho & 15; return 8 * (i >> 2) + 4 * n + (i & 3); }
__device__ __forceinline__ unsigned cvt_pk_bf16(float lo, float hi) { unsigned r; asm volatile("v_cvt_pk_bf16_f32 %0, %1, %2" : "=v"(r) : "v"(lo), "v"(hi)); return r; }

struct Unit {
    const char* A; const char* Bt; const int* gidx;
    unsigned lda2, ldb2;
    int arow0, brow0, nt;
    int pm, pn, aux;
};

template <class Epi, class Sched>
__device__ __forceinline__ void gemm_phase(LAS unsigned char* lds, const Sched& S, const Epi& E) {
    constexpr bool GATHER = Sched::GATHER;
    const int tid = threadIdx.x, wid = __builtin_amdgcn_readfirstlane(tid >> 6), lane = tid & 63, wr = wid >> 2, wc = wid & 3, fr = lane & 15, fq = lane >> 4;
    int sR[2], sC[2], sRb[2];
#pragma unroll
    for (int i = 0; i < 2; ++i) { int R, C; stage_rc(tid * 16 + i * 8192, R, C); sR[i] = R; sC[i] = C * 2; sRb[i] = Epi::PERM ? ((R & ~31) + perm32(R & 31)) : R; }
    const unsigned ldsw = (unsigned)wid * 1024u;
    const int aoff = lds_byte(wr * 64 + fr, fq * 8), boff = lds_byte(wc * 32 + fr, fq * 8);
#define GM_SA(b, h) (((b) * 2 + (h)) * HTB)
#define GM_SB(b, h) ((4 + (b) * 2 + (h)) * HTB)
#define GM_GLDS(src, dstoff) __builtin_amdgcn_global_load_lds((const unsigned*)(src), (LAS unsigned*)(lds + (dstoff)), 16, 0, 0)
#define GM_STAGE_B(bufoff, p, ld, h) do { _Pragma("unroll") for (int i_ = 0; i_ < 2; ++i_) \
        GM_GLDS((p) + ((unsigned)((h) * HALF + sRb[i_]) * (ld) + (unsigned)sC[i_]), (bufoff) + ldsw + i_ * 8192); } while (0)
#define GM_STAGE_A(bufoff, p, ld, h, g) do { _Pragma("unroll") for (int i_ = 0; i_ < 2; ++i_) { \
        const unsigned o_ = GATHER ? (g)[h][i_] + (unsigned)sC[i_] : (unsigned)((h) * HALF + sR[i_]) * (ld) + (unsigned)sC[i_]; \
        GM_GLDS((p) + o_, (bufoff) + ldsw + i_ * 8192); } } while (0)
#define GM_LDA(dst, b, h) do { _Pragma("unroll") for (int m = 0; m < 4; ++m) _Pragma("unroll") for (int k = 0; k < 2; ++k) dst[m][k] = *(const LAS bf16x8*)(lds + GM_SA(b, h) + aoff + m * 2048 + k * 1024); } while (0)
#define GM_LDB(dst, b, h) do { _Pragma("unroll") for (int n = 0; n < 2; ++n) _Pragma("unroll") for (int k = 0; k < 2; ++k) dst[n][k] = *(const LAS bf16x8*)(lds + GM_SB(b, h) + boff + n * 2048 + k * 1024); } while (0)
#define GM_MMA(ai, bj, At, Bt) do { __builtin_amdgcn_s_setprio(1); _Pragma("unroll") for (int m = 0; m < 4; ++m) _Pragma("unroll") for (int n = 0; n < 2; ++n) _Pragma("unroll") for (int k = 0; k < 2; ++k) \
        acc[ai][bj][m][n] = __builtin_amdgcn_mfma_f32_16x16x32_bf16(Bt[n][k], At[m][k], acc[ai][bj][m][n], 0, 0, 0); __builtin_amdgcn_s_setprio(0); } while (0)
#define GM_WAIT_V(n) asm volatile("s_waitcnt vmcnt(" #n ")" ::: "memory")
#define GM_WAIT_L(n) asm volatile("s_waitcnt lgkmcnt(" #n ")" ::: "memory")
#define GM_BAR __builtin_amdgcn_s_barrier()
#define GM_SCHED __builtin_amdgcn_sched_barrier(0)
#define GM_GOFFS(u, g) do { if (GATHER) { _Pragma("unroll") for (int h_ = 0; h_ < 2; ++h_) _Pragma("unroll") for (int i_ = 0; i_ < 2; ++i_) g[h_][i_] = (unsigned)(u).gidx[h_ * HALF + sR[i_]] * (u).lda2; } } while (0)
#define GM_ABASE(u) ((u).A + (GATHER ? (size_t)0 : (size_t)(u).arow0 * (u).lda2))
#define GM_BBASE(u) ((u).Bt + (size_t)(u).brow0 * (u).ldb2)
    Unit cur, nxt; int ui = 0;
    if (!S.next(0, cur)) return;
    f32x4 acc[2][2][4][2];
#pragma unroll
    for (int a = 0; a < 2; ++a)
#pragma unroll
        for (int b = 0; b < 2; ++b)
#pragma unroll
            for (int m = 0; m < 4; ++m)
#pragma unroll
                for (int n = 0; n < 2; ++n) acc[a][b][m][n] = (f32x4){0.f, 0.f, 0.f, 0.f};
    bf16x8 At[4][2], B0[2][2], B1[2][2];
    unsigned gc[2][2] = {{0u, 0u}, {0u, 0u}}, gn[2][2] = {{0u, 0u}, {0u, 0u}};
    GM_GOFFS(cur, gc);
    const char* cA = GM_ABASE(cur); const char* cB = GM_BBASE(cur); unsigned cla = cur.lda2, clb = cur.ldb2;
    GM_STAGE_B(GM_SB(0, 0), cB, clb, 0); GM_STAGE_B(GM_SB(0, 1), cB, clb, 1); GM_STAGE_A(GM_SA(0, 0), cA, cla, 0, gc); GM_STAGE_A(GM_SA(0, 1), cA, cla, 1, gc);
    if (wr == 1) GM_BAR;
    GM_WAIT_V(2); GM_BAR;
    GM_STAGE_B(GM_SB(1, 0), cB + 128, clb, 0); GM_STAGE_A(GM_SA(1, 0), cA + 128, cla, 0, gc); GM_STAGE_B(GM_SB(1, 1), cB + 128, clb, 1);
    GM_WAIT_V(6); GM_BAR;
    for (;;) {
        const bool has_next = S.next(ui + 1, nxt);
        const char* nA = cA; const char* nB = cB; unsigned nla = cla, nlb = clb;
        if (has_next) { GM_GOFFS(nxt, gn); nA = GM_ABASE(nxt); nB = GM_BBASE(nxt); nla = nxt.lda2; nlb = nxt.ldb2; }
        else if (GATHER) {
#pragma unroll
            for (int h = 0; h < 2; ++h)
#pragma unroll
                for (int i = 0; i < 2; ++i) gn[h][i] = gc[h][i];
        }
        const int nt = cur.nt;
        for (int t = 0; t < nt; t += 2) {
            const bool last = (t == nt - 2);
            if (last && has_next) S.a_ready(nxt, wid);
            const char* a1 = cA + (size_t)(t + 1) * 128;
            const char* a2 = last ? nA : cA + (size_t)(t + 2) * 128; const char* b2 = last ? nB : cB + (size_t)(t + 2) * 128;
            const char* a3 = a2 + 128; const char* b3 = b2 + 128;
            const unsigned la2 = last ? nla : cla, lb2 = last ? nlb : clb;
            unsigned g2[2][2];
#pragma unroll
            for (int h = 0; h < 2; ++h)
#pragma unroll
                for (int i = 0; i < 2; ++i) g2[h][i] = GATHER ? (last ? gn[h][i] : gc[h][i]) : 0u;
            GM_LDB(B0, 0, 0); GM_LDB(B1, 0, 1); GM_SCHED; GM_LDA(At, 0, 0); GM_STAGE_A(GM_SA(1, 1), a1, cla, 1, gc);
            GM_WAIT_V(8); GM_WAIT_L(0); GM_BAR; GM_MMA(0, 0, At, B0); GM_MMA(0, 1, At, B1); GM_BAR; GM_SCHED;
            GM_LDA(At, 0, 1); GM_STAGE_B(GM_SB(0, 0), b2, lb2, 0); GM_STAGE_B(GM_SB(0, 1), b2, lb2, 1); GM_STAGE_A(GM_SA(0, 0), a2, la2, 0, g2);
            GM_WAIT_V(8); GM_WAIT_L(0); GM_BAR; GM_MMA(1, 0, At, B0); GM_MMA(1, 1, At, B1); GM_BAR; GM_SCHED;
            GM_LDB(B0, 1, 0); GM_LDB(B1, 1, 1); GM_SCHED; GM_LDA(At, 1, 0); GM_STAGE_A(GM_SA(0, 1), a2, la2, 1, g2);
            GM_WAIT_V(8); GM_WAIT_L(0); GM_BAR; GM_MMA(0, 0, At, B0); GM_MMA(0, 1, At, B1); GM_BAR; GM_SCHED;
            GM_LDA(At, 1, 1); GM_STAGE_B(GM_SB(1, 0), b3, lb2, 0); GM_STAGE_B(GM_SB(1, 1), b3, lb2, 1); GM_STAGE_A(GM_SA(1, 0), a3, la2, 0, g2);
            GM_WAIT_V(8); GM_WAIT_L(0); GM_BAR; GM_MMA(1, 0, At, B0); GM_MMA(1, 1, At, B1); GM_BAR; GM_SCHED;
        }
        if (wr == 0) GM_BAR;
        E(acc, cur, wr, wc, fr, fq);
        S.done(cur, lane);
        if (!has_next) break;
#pragma unroll
        for (int a = 0; a < 2; ++a)
#pragma unroll
            for (int b = 0; b < 2; ++b)
#pragma unroll
                for (int m = 0; m < 4; ++m)
#pragma unroll
                    for (int n = 0; n < 2; ++n) acc[a][b][m][n] = (f32x4){0.f, 0.f, 0.f, 0.f};
        cur = nxt; cA = nA; cB = nB; cla = nla; clb = nlb; ++ui;
        if (GATHER) {
#pragma unroll
            for (int h = 0; h < 2; ++h)
#pragma unroll
                for (int i = 0; i < 2; ++i) gc[h][i] = gn[h][i];
        }
        if (wr == 1) GM_BAR;
    }
    GM_WAIT_V(0);
    GM_BAR;
#undef GM_SA
#undef GM_SB
#undef GM_GLDS
#undef GM_STAGE_A
#undef GM_STAGE_B
#undef GM_LDA
#undef GM_LDB
#undef GM_MMA
#undef GM_WAIT_V
#undef GM_WAIT_L
#undef GM_BAR
#undef GM_SCHED
#undef GM_GOFFS
#undef GM_ABASE
#undef GM_BBASE
}
}
namespace mk {
using gm::bf16_t; using gm::f32x4; using gm::f32x2; using gm::u32x4; using gm::u32x2; using gm::cvt_pk_bf16;
constexpr int T = 16384, S = 8192, D = 1024, NB = 2, NH = 8, NWAVES = 8, NTHREADS = 512;
constexpr float EPS = 1e-6f;
constexpr size_t KiB = 1024, MiB = 1u << 20;
constexpr size_t WS_CTL = 0;
constexpr size_t WS_KMX = 48 * KiB;
constexpr size_t WS_MODP = 1 * MiB;
constexpr size_t WS_MODF = 2 * MiB;
constexpr size_t WS_TABM = WS_MODF + 64 * KiB;
constexpr size_t WS_TABD = WS_TABM + 2 * MiB;
constexpr size_t WS_SSQ = WS_TABD + 1 * MiB;
constexpr size_t WS_KR = WS_SSQ + 1536 * KiB;
constexpr size_t WS_AFF = WS_KR + 1 * MiB;
constexpr size_t WS_IDX = WS_AFF + 1 * MiB;
constexpr size_t WS_GATE = WS_IDX + 128 * KiB;
constexpr size_t WS_SLOT = WS_GATE + 128 * KiB;
constexpr size_t WS_LSE = WS_SLOT + 1 * MiB;
constexpr size_t WS_WUQ = WS_LSE + 1536 * KiB;
constexpr size_t WS_WUKV = WS_WUQ + 576 * KiB;
constexpr size_t WS_WOUT = WS_WUKV + 512 * KiB;
constexpr size_t WS_WIN = WS_WOUT + 2 * MiB;
constexpr size_t WS_R0END = WS_WIN + 4608 * KiB;
static_assert(WS_R0END <= 20 * MiB, "R0");
constexpr size_t WS_HB = 20 * MiB;
constexpr size_t WS_CQ = 52 * MiB;
constexpr size_t WS_DQ = WS_CQ + 24 * MiB, WS_DK = WS_DQ + 16 * MiB, WS_DV = WS_DK + 16 * MiB;
constexpr size_t WS_Q = WS_DV + 16 * MiB;
constexpr size_t WS_KN = WS_Q + 24 * MiB, WS_V = WS_KN + 16 * MiB;
constexpr size_t WS_HBUF = WS_CQ;
constexpr size_t WS_WGU = 180 * MiB;
constexpr size_t WS_Y = WS_WGU;
constexpr size_t WS_WD = 244 * MiB;
constexpr size_t WS_END = 276 * MiB;
static_assert(WS_V + 16 * MiB == 180 * MiB, "arena");
constexpr int LDS_BYTES = 147456;

__device__ __forceinline__ float wave_sum(float v) {
#pragma unroll
    for (int o = 1; o < 64; o <<= 1) v += __shfl_xor(v, o);
    return v;
}
__device__ __forceinline__ unsigned f2bf(float f) { unsigned u = __builtin_bit_cast(unsigned, f); return (u + 0x7fffu + ((u >> 16) & 1u)) >> 16; }
__device__ __forceinline__ unsigned pk2(float lo, float hi) { return f2bf(lo) | (f2bf(hi) << 16); }
__device__ __forceinline__ float bf2f(unsigned short b) { return __builtin_bit_cast(float, (unsigned)b << 16); }
__device__ __forceinline__ float siluf(float v) { return v / (1.f + __expf(-v)); }
#define LDS_WAIT() asm volatile("s_waitcnt lgkmcnt(0)" ::: "memory")
__device__ __forceinline__ int fresh_lane() { int l; asm volatile("v_and_b32 %0, 63, %1" : "=v"(l) : "v"(threadIdx.x)); return l; }

struct Args { const void* in[19]; float* out; unsigned char* ws; int ph_lo, ph_hi, li, pad; };
struct Frame {
    LAS unsigned char* lds; unsigned char* ws; float* out;
    int tid, lane, wave, vcu, G;
    const float *x, *c; const int* pos; const float *w_ada, *b_ada, *g_mix, *w_in, *g_q, *w_uq, *g_kv, *w_ukv, *w_out, *g_ffn, *w_router, *b_router, *w_gate, *w_up, *w_down, *g_final;
};

__device__ __forceinline__ float inv_freq_m(int i) { return (float)exp2(-(double)i * (18.931568569324174 / 16.0)); }
__device__ __forceinline__ float inv_freq_d(int i) { return (float)exp2(-(double)i * (18.931568569324174 / 8.0)); }

#ifndef WD_IN_P5
#define WD_IN_P5 1
#endif
__device__ __forceinline__ void p0_transpose_item(const float* W, int ldw, int K, int k0, int n0, bf16_t* WT, int drow, const float* kscale, LAS float* scr, int lane) {
    f32x4 v[8];
#pragma unroll
    for (int i = 0; i < 8; ++i) v[i] = *(const f32x4*)(W + (size_t)(k0 + 8 * i + (lane >> 3)) * ldw + n0 + 4 * (lane & 7));
#pragma unroll
    for (int i = 0; i < 8; ++i) { const int kk = 8 * i + (lane >> 3); f32x4 x = v[i]; if (kscale) x = x * kscale[k0 + kk]; LAS float* d = scr + kk * 33 + 4 * (lane & 7); d[0] = x.x; d[1] = x.y; d[2] = x.z; d[3] = x.w; }
    LDS_WAIT(); asm volatile("" ::: "memory");
    const int c = lane & 7;
#pragma unroll
    for (int j = 0; j < 4; ++j) { const int n = (lane >> 3) + 8 * j; const LAS float* s = scr + (8 * c) * 33 + n;
        u32x4 o; o.x = pk2(s[0 * 33], s[1 * 33]); o.y = pk2(s[2 * 33], s[3 * 33]); o.z = pk2(s[4 * 33], s[5 * 33]); o.w = pk2(s[6 * 33], s[7 * 33]);
        *(u32x4*)(WT + (size_t)(drow + n) * K + k0 + 8 * c) = o; }
    LDS_WAIT(); asm volatile("" ::: "memory");
}
__device__ __forceinline__ void p0_prologue(Frame& F) {
    LAS float* scr = (LAS float*)(F.lds + F.wave * 16384);
    const int gw = F.vcu * NWAVES + F.wave, NGW = F.G * NWAVES, lane = fresh_lane();
    unsigned char* ws = F.ws;
    constexpr int I_MOD = 24 * 16, I_IN = 16 * 69, I_UQ = 6 * 24, I_UKV = 4 * 32, I_OUT = 16 * 32, I_EXP = 16 * 16 * 32, I_PAD = 96, I_TAB = T * 24 / 64;
    constexpr int NITEMS = I_MOD + I_IN + I_UQ + I_UKV + I_OUT + (WD_IN_P5 ? 2 : 3) * I_EXP + I_PAD + I_TAB;
    for (int it = gw; it < NITEMS; it += NGW) {
        int r = it;
        if (r < I_MOD) {
            const int cc = r % 24, kc = r / 24; f32x4 a0 = {0.f, 0.f, 0.f, 0.f}, a1 = {0.f, 0.f, 0.f, 0.f};
            const float* wp = F.w_ada + (size_t)(kc * 64) * 6144 + cc * 256 + 4 * lane;
#pragma unroll 8
            for (int k = 0; k < 64; ++k) { const f32x4 w = *(const f32x4*)(wp + (size_t)k * 6144); const float s0 = siluf(F.c[kc * 64 + k]), s1 = siluf(F.c[1024 + kc * 64 + k]); a0 += w * s0; a1 += w * s1; }
            float* mp = (float*)(ws + WS_MODP) + (size_t)kc * 2 * 6144 + cc * 256 + 4 * lane;
            *(f32x4*)mp = a0; *(f32x4*)(mp + 6144) = a1; continue; }
        r -= I_MOD;
        if (r < I_IN) { const int kb = r / 69, nb = r % 69, n0 = nb * 32; p0_transpose_item(F.w_in, 2208, 1024, kb * 64, n0, (bf16_t*)(ws + WS_WIN), n0 < 672 ? n0 : n0 + 96, nullptr, scr, lane); continue; }
        r -= I_IN;
        if (r < I_UQ) { const int kb = r / 24, nb = r % 24, n0 = nb * 32, h = n0 / 96, d = n0 % 96; p0_transpose_item(F.w_uq, 768, 384, kb * 64, n0, (bf16_t*)(ws + WS_WUQ), d < 64 ? h * 64 + d : 512 + h * 32, F.g_q, scr, lane); continue; }
        r -= I_UQ;
        if (r < I_UKV) { const int kb = r / 32, nb = r % 32, n0 = nb * 32, h = n0 / 128, d = n0 % 128; p0_transpose_item(F.w_ukv, 1024, 256, kb * 64, n0, (bf16_t*)(ws + WS_WUKV), d < 64 ? h * 64 + d : 512 + h * 64 + (d - 64), F.g_kv, scr, lane); continue; }
        r -= I_UKV;
        if (r < I_OUT) { const int kb = r / 32, nb = r % 32; p0_transpose_item(F.w_out, 1024, 1024, kb * 64, nb * 32, (bf16_t*)(ws + WS_WOUT), nb * 32, nullptr, scr, lane); continue; }
        r -= I_OUT;
        if (r < 2 * I_EXP) { const int up = r >= I_EXP; const int q = up ? r - I_EXP : r; const int e = q / 512, kb = (q % 512) / 32, nb = q % 32, n0 = nb * 32;
            p0_transpose_item((up ? F.w_up : F.w_gate) + (size_t)e * 1048576, 1024, 1024, kb * 64, n0, (bf16_t*)(ws + WS_WGU) + (size_t)e * 2048 * 1024, (n0 / 128) * 256 + up * 128 + (n0 % 128), nullptr, scr, lane); continue; }
        r -= 2 * I_EXP;
        if (!WD_IN_P5) { if (r < I_EXP) { const int e = r / 512, kb = (r % 512) / 32, nb = r % 32; p0_transpose_item(F.w_down + (size_t)e * 1048576, 1024, 1024, kb * 64, nb * 32, (bf16_t*)(ws + WS_WD) + (size_t)e * 1048576, nb * 32, nullptr, scr, lane); continue; }
        r -= I_EXP; }
        if (r < I_PAD) { u32x4 z = {0u, 0u, 0u, 0u}; u32x4* p = (u32x4*)((bf16_t*)(ws + WS_WIN) + (size_t)(672 + r) * 1024); p[lane] = z; p[64 + lane] = z; continue; }
        r -= I_PAD;
        {
            const int e = r * 64 + lane, tok = e / 24, f = e % 24; const int p = F.pos[tok];
            const float inv = f < 16 ? inv_freq_m(f) : inv_freq_d(f - 16); const float ang = (float)p * inv; const float cs = (float)cos((double)ang), sn = (float)sin((double)ang);
            if (f < 16) { float* tm = (float*)(ws + WS_TABM) + (size_t)tok * 32; tm[f] = cs; tm[16 + f] = sn; } else { float* td = (float*)(ws + WS_TABD) + (size_t)tok * 16; td[f - 16] = cs; td[8 + f - 16] = sn; }
        }
    }
}
__device__ __forceinline__ void wd_convert(Frame& F, int first_vcu) {
    LAS float* scr = (LAS float*)(F.lds + F.wave * 16384);
    const int gw = (F.vcu - first_vcu) * NWAVES + F.wave, NGW = (F.G - first_vcu) * NWAVES, lane = fresh_lane();
    for (int r = gw; r < 16 * 16 * 32; r += NGW) { const int e = r / 512, kb = (r % 512) / 32, nb = r % 32;
        p0_transpose_item(F.w_down + (size_t)e * 1048576, 1024, 1024, kb * 64, nb * 32, (bf16_t*)(F.ws + WS_WD) + (size_t)e * 1048576, nb * 32, nullptr, scr, lane); }
}
__device__ __forceinline__ void p0b_rows(Frame& F) {
    LAS float* A1 = (LAS float*)F.lds;
    LAS float* A0 = A1 + 2048;
    const float* mp = (const float*)(F.ws + WS_MODP);
#pragma unroll
    for (int half = 0; half < 2; ++half) { float s[4]; float pv[4][16];
#pragma unroll
        for (int q = 0; q < 4; ++q) { const int i = F.tid + NTHREADS * (half * 4 + q); const int b = i >> 11, n = ((i >> 10) & 1) * 1024 + (i & 1023);
#pragma unroll
            for (int k = 0; k < 16; ++k) pv[q][k] = mp[(size_t)k * 2 * 6144 + b * 6144 + n]; }
#pragma unroll
        for (int q = 0; q < 4; ++q) { const int i = F.tid + NTHREADS * (half * 4 + q); const int b = i >> 11, which = (i >> 10) & 1, j = i & 1023; s[q] = F.b_ada[which * 1024 + j];
#pragma unroll
            for (int k = 0; k < 16; ++k) s[q] += pv[q][k];
            if (which) A1[b * 1024 + j] = F.g_mix[j] * (1.f + s[q]); else A0[b * 1024 + j] = s[q]; } }
    if (blockIdx.x < 48 && F.tid < 256) { const int n = blockIdx.x * 256 + F.tid; const int b = n / 6144, nn = n % 6144; float s = F.b_ada[nn];
#pragma unroll
        for (int k = 0; k < 16; ++k) s += mp[(size_t)k * 2 * 6144 + b * 6144 + nn];
        ((float*)(F.ws + WS_MODF))[n] = s; }
    __syncthreads();
    const int gw = F.vcu * NWAVES + F.wave, NGW = F.G * NWAVES, lane = fresh_lane();
    for (int m0 = gw; m0 < T; m0 += 2 * NGW) {
        const int m1 = m0 + NGW; const bool has1 = m1 < T; const int mm1 = has1 ? m1 : m0;
        const f32x4* xr0 = (const f32x4*)(F.x + (size_t)m0 * D) + lane; const f32x4* xr1 = (const f32x4*)(F.x + (size_t)mm1 * D) + lane; f32x4 v0[4], v1[4]; float s0 = 0.f, s1 = 0.f;
#pragma unroll
        for (int j = 0; j < 4; ++j) { v0[j] = xr0[64 * j]; v1[j] = xr1[64 * j]; }
#pragma unroll
        for (int j = 0; j < 4; ++j) { s0 += (v0[j].x * v0[j].x + v0[j].y * v0[j].y) + (v0[j].z * v0[j].z + v0[j].w * v0[j].w); s1 += (v1[j].x * v1[j].x + v1[j].y * v1[j].y) + (v1[j].z * v1[j].z + v1[j].w * v1[j].w); }
        const float r0 = rsqrtf(wave_sum(s0) * (1.f / D) + EPS), r1 = rsqrtf(wave_sum(s1) * (1.f / D) + EPS);
        const int b0 = m0 >> 13, b1 = mm1 >> 13;
        unsigned long long* o0 = (unsigned long long*)((bf16_t*)(F.ws + WS_HB) + (size_t)m0 * D) + lane; unsigned long long* o1 = (unsigned long long*)((bf16_t*)(F.ws + WS_HB) + (size_t)mm1 * D) + lane;
#pragma unroll
        for (int j = 0; j < 4; ++j) { const f32x4 a1 = *(const LAS f32x4*)(A1 + b0 * 1024 + 4 * lane + 256 * j), a0 = *(const LAS f32x4*)(A0 + b0 * 1024 + 4 * lane + 256 * j);
            const f32x4 o = v0[j] * r0 * a1 + a0; o0[64 * j] = (unsigned long long)pk2(o.x, o.y) | ((unsigned long long)pk2(o.z, o.w) << 32); }
        if (has1) {
#pragma unroll
            for (int j = 0; j < 4; ++j) { const f32x4 a1 = *(const LAS f32x4*)(A1 + b1 * 1024 + 4 * lane + 256 * j), a0 = *(const LAS f32x4*)(A0 + b1 * 1024 + 4 * lane + 256 * j);
                const f32x4 o = v1[j] * r1 * a1 + a0; o1[64 * j] = (unsigned long long)pk2(o.x, o.y) | ((unsigned long long)pk2(o.z, o.w) << 32); } }
    }
    __syncthreads();
}

__device__ __forceinline__ bool static_tile(int i, int G, int c, int nM, int nN, int& pm, int& pn) {
    const int nwg = nM * nN; const long L = (long)i * G + c; if (L >= nwg) return false;
    int wgid = (int)L; { const int q = nwg / 8, r = nwg % 8, xcd = wgid % 8, off = wgid / 8; wgid = (xcd < r ? xcd * (q + 1) : r * (q + 1) + (xcd - r) * q) + off; }
    const int nig = 8 * nN, gid = wgid / nig, fm = gid * 8, gsz = (nM - fm) < 8 ? (nM - fm) : 8;
    pm = fm + ((wgid % nig) % gsz); pn = (wgid % nig) / gsz; return true;
}
struct SchedP1 {
    static constexpr bool GATHER = false;
    __device__ __forceinline__ void a_ready(const gm::Unit&, int) const {}
    __device__ __forceinline__ void done(const gm::Unit&, int) const {}
    const char* A; const char* Bt; int G, c;
    __device__ __forceinline__ bool next(int i, gm::Unit& u) const { int pm, pn; if (!static_tile(i, G, c, 64, 9, pm, pn)) return false;
        u.A = A; u.Bt = Bt; u.gidx = nullptr; u.lda2 = 2048; u.ldb2 = 2048; u.arow0 = pm * 256; u.brow0 = pn * 256; u.nt = 16; u.pm = pm; u.pn = pn; u.aux = 0; return true; }
};
struct SchedP2 {
    static constexpr bool GATHER = false;
    __device__ __forceinline__ void a_ready(const gm::Unit&, int) const {}
    __device__ __forceinline__ void done(const gm::Unit&, int) const {}
    const char* A; const char* Wuq; const char* Wukv; int G, c;
    __device__ __forceinline__ bool next(int i, gm::Unit& u) const {
        const int L = i * G + c; if (L >= 448) return false;
        u.A = A; u.gidx = nullptr; u.lda2 = 1536;
        if (L < 256) { int pm, pn; static_tile(0, 256, L, 64, 4, pm, pn); u.A = A + 768; u.Bt = Wukv; u.ldb2 = 512; u.nt = 4; u.arow0 = pm * 256; u.brow0 = pn * 256; u.pm = pm; u.pn = pn; u.aux = 1; }
        else { int pm, pn; static_tile(0, 192, L - 256, 64, 3, pm, pn); u.Bt = Wuq; u.ldb2 = 768; u.nt = 6; u.arow0 = pm * 256; u.brow0 = pn * 256; u.pm = pm; u.pn = pn; u.aux = 0; }
        return true; }
};

__device__ __forceinline__ void store16_sc1(void* p, u32x4 v) { asm volatile("global_store_dwordx4 %0, %1, off sc1\n\ts_nop 1" :: "v"(p), "v"(v) : "memory"); }
__device__ __forceinline__ void store4_sc1(float* p, float v) { __hip_atomic_store(p, v, __ATOMIC_RELAXED, __HIP_MEMORY_SCOPE_AGENT); }
#define EPI_ARGS const f32x4 (&acc)[2][2][4][2], const gm::Unit& u, int wr, int wc, int fr, int fq
constexpr float QSCALE_M = 0.10206207261596575f * 1.4426950408889634f;
constexpr float QSCALE_D = 0.125f * 1.4426950408889634f;
__device__ __forceinline__ u32x4 pack8(f32x4 a, f32x4 b) { u32x4 w; w.x = cvt_pk_bf16(a[0], a[1]); w.y = cvt_pk_bf16(a[2], a[3]); w.z = cvt_pk_bf16(b[0], b[1]); w.w = cvt_pk_bf16(b[2], b[3]); return w; }
__device__ __forceinline__ void rope8(f32x4& v0, f32x4& v1, int xmask, const float* cs, const float* sn, bool first) {
    f32x4 o0, o1;
#pragma unroll
    for (int j = 0; j < 4; ++j) { o0[j] = __shfl_xor(v0[j], xmask); o1[j] = __shfl_xor(v1[j], xmask); }
    const f32x4 c0 = *(const f32x4*)cs, c1 = *(const f32x4*)(cs + 4), s0 = *(const f32x4*)sn, s1 = *(const f32x4*)(sn + 4);
    const float sg = first ? -1.f : 1.f;
    v0 = v0 * c0 + o0 * s0 * sg; v1 = v1 * c1 + o1 * s1 * sg;
}
struct EpiP1 {
    static constexpr bool PERM = true;
    unsigned char* ws;
    __device__ __forceinline__ void operator()(EPI_ARGS) const {
        const int pn = u.pn; float krmax = 0.f;
        const float* tabm = (const float*)(ws + WS_TABM); const float* tabd = (const float*)(ws + WS_TABD);
#pragma unroll
        for (int ai = 0; ai < 2; ++ai)
#pragma unroll
            for (int m = 0; m < 4; ++m) {
                const int row = u.pm * 256 + ai * 128 + wr * 64 + m * 16 + fr; const int b = row >> 13, s = row & 8191;
#pragma unroll
                for (int bj = 0; bj < 2; ++bj) {
                    f32x4 v0 = acc[ai][bj][m][0], v1 = acc[ai][bj][m][1];
                    const int ct = bj * 128 + wc * 32 + 8 * fq;
                    if (pn < 3) {
                        float q = (v0[0] * v0[0] + v0[1] * v0[1]) + (v0[2] * v0[2] + v0[3] * v0[3]) + (v1[0] * v1[0] + v1[1] * v1[1]) + (v1[2] * v1[2] + v1[3] * v1[3]);
                        q += __shfl_xor(q, 16); q += __shfl_xor(q, 32);
                        if (fq == 0) store4_sc1((float*)(ws + WS_SSQ) + (size_t)row * 24 + pn * 8 + bj * 4 + wc, q);
                        if (pn == 2 && bj == 1 && wc == 0) {
                            const int f0 = 8 * (fq & 1); rope8(v0, v1, 32, tabm + (size_t)row * 32 + f0, tabm + (size_t)row * 32 + 16 + f0, fq < 2);
                            store16_sc1((bf16_t*)(ws + WS_KR) + (size_t)row * 32 + 8 * fq, pack8(v0, v1));
                            { float q2 = (v0[0] * v0[0] + v0[1] * v0[1]) + (v0[2] * v0[2] + v0[3] * v0[3]) + (v1[0] * v1[0] + v1[1] * v1[1]) + (v1[2] * v1[2] + v1[3] * v1[3]);
                              q2 += __shfl_xor(q2, 16); q2 += __shfl_xor(q2, 32); krmax = fmaxf(krmax, q2); }
                        } else store16_sc1((bf16_t*)(ws + WS_CQ) + (size_t)row * 768 + pn * 256 + ct, pack8(v0, v1));
                    } else {
                        const int which = (pn - 3) >> 1;
                        const int cc = ((pn - 3) & 1) * 256 + ct, hh = cc >> 6, d = cc & 63;
                        if (which < 2 && (wc & 1) == 0) {
                            f32x4 r0 = v0, r1 = v1; rope8(r0, r1, 16, tabd + (size_t)row * 16, tabd + (size_t)row * 16 + 8, fq == 0);
                            if (fq < 2) { v0 = r0; v1 = r1; } }
                        if (which == 0) { v0 = v0 * QSCALE_D; v1 = v1 * QSCALE_D; }
                        bf16_t* dst = (bf16_t*)(ws + (which == 0 ? WS_DQ : which == 1 ? WS_DK : WS_DV));
                        *(u32x4*)(dst + ((size_t)(b * 8 + hh) * S + s) * 64 + d) = pack8(v0, v1);
                    }
                }
            }
        if (pn == 2 && wc == 0) {
#pragma unroll
            for (int o = 1; o < 16; o <<= 1) krmax = fmaxf(krmax, __shfl_xor(krmax, o));
            if ((threadIdx.x & 63) == 0) atomicMax((unsigned*)(ws + WS_KMX) + 32 + ((u.pm * 256) >> 13), __float_as_uint(krmax)); }
    }
};
struct EpiP2 {
    static constexpr bool PERM = true;
    unsigned char* ws;
    __device__ __forceinline__ void operator()(EPI_ARGS) const {
        const int pn = u.pn; const bool isq = u.aux == 0; float kmax[2] = {0.f, 0.f};
        const float* tabm = (const float*)(ws + WS_TABM); const float* ssq = (const float*)(ws + WS_SSQ);
#pragma unroll
        for (int ai = 0; ai < 2; ++ai)
#pragma unroll
            for (int m = 0; m < 4; ++m) {
                const int row = u.pm * 256 + ai * 128 + wr * 64 + m * 16 + fr; const int b = row >> 13, s = row & 8191;
                const float* sq = ssq + (size_t)row * 24; float rstd;
                if (isq) { const f32x4 a = *(const f32x4*)sq, bq = *(const f32x4*)(sq + 4), cq = *(const f32x4*)(sq + 8);
                    rstd = rsqrtf((((a[0] + a[1]) + (a[2] + a[3])) + ((bq[0] + bq[1]) + (bq[2] + bq[3])) + ((cq[0] + cq[1]) + (cq[2] + cq[3]))) * (1.f / 384.f) + EPS) * QSCALE_M; }
                else { const f32x4 a = *(const f32x4*)(sq + 12), bq = *(const f32x4*)(sq + 16);
                    rstd = rsqrtf((((a[0] + a[1]) + (a[2] + a[3])) + ((bq[0] + bq[1]) + (bq[2] + bq[3]))) * (1.f / 256.f) + EPS); }
#pragma unroll
                for (int bj = 0; bj < 2; ++bj) {
                    f32x4 v0 = acc[ai][bj][m][0] * rstd, v1 = acc[ai][bj][m][1] * rstd;
                    const int ct = bj * 128 + wc * 32 + 8 * fq, cc = (pn & 1) * 256 + ct;
                    if (isq) {
                        if (pn < 2) { const int hh = cc >> 6, d = cc & 63; *(u32x4*)((bf16_t*)(ws + WS_Q) + ((size_t)(b * 8 + hh) * S + s) * 96 + d) = pack8(v0, v1); }
                        else { const int hh = ct >> 5; const int f0 = 8 * (fq & 1); rope8(v0, v1, 32, tabm + (size_t)row * 32 + f0, tabm + (size_t)row * 32 + 16 + f0, fq < 2);
                            *(u32x4*)((bf16_t*)(ws + WS_Q) + ((size_t)(b * 8 + hh) * S + s) * 96 + 64 + 8 * fq) = pack8(v0, v1); }
                    } else { const int hh = cc >> 6, d = cc & 63; bf16_t* dst = (bf16_t*)(ws + (pn < 2 ? WS_KN : WS_V));
                        *(u32x4*)(dst + ((size_t)(b * 8 + hh) * S + s) * 64 + d) = pack8(v0, v1);
                        if (pn < 2) { float q2 = (v0[0] * v0[0] + v0[1] * v0[1]) + (v0[2] * v0[2] + v0[3] * v0[3]) + (v1[0] * v1[0] + v1[1] * v1[1]) + (v1[2] * v1[2] + v1[3] * v1[3]);
                            q2 += __shfl_xor(q2, 16); q2 += __shfl_xor(q2, 32); kmax[bj] = fmaxf(kmax[bj], q2); } }
                }
            }
        if (!isq && pn < 2) {
#pragma unroll
            for (int bj = 0; bj < 2; ++bj) { float km = kmax[bj];
#pragma unroll
                for (int o = 1; o < 16; o <<= 1) km = fmaxf(km, __shfl_xor(km, o));
                const int cc = (pn & 1) * 256 + bj * 128 + wc * 32, hh = cc >> 6, half = (cc >> 5) & 1, b = (u.pm * 256) >> 13;
                if ((threadIdx.x & 63) == 0) atomicMax((unsigned*)(ws + WS_KMX) + (b * 8 + hh) * 2 + half, __float_as_uint(km)); }
        }
    }
};

constexpr size_t WS_PCNT = 56 * KiB;
struct SchedP12 {
    static constexpr bool GATHER = false;
    const char *HB, *WIN, *CQ, *WUQ, *WUKV; unsigned* cnt; int G, vcu, c;
    __device__ __forceinline__ bool next(int i, gm::Unit& u) const {
        u.gidx = nullptr;
        if (G == 256) {
            const int n1 = c < 64 ? 3 : 2;
            if (i < n1) { int pm, pn; static_tile(i, 256, c, 64, 9, pm, pn);
                u.A = HB; u.Bt = WIN; u.lda2 = 2048; u.ldb2 = 2048; u.arow0 = pm * 256; u.brow0 = pn * 256; u.nt = 16; u.pm = pm; u.pn = pn; u.aux = 2; return true; }
            if (c < 64) return false;
            const int idx = (c - 64) + 192 * (i - 2); if (i - 2 >= 3 || idx >= 448) return false;
            if (idx < 256) { int pm, pn; static_tile(0, 256, idx, 64, 4, pm, pn); u.A = CQ + 768; u.Bt = WUKV; u.lda2 = 1536; u.ldb2 = 512; u.nt = 4; u.arow0 = pm * 256; u.brow0 = pn * 256; u.pm = pm; u.pn = pn; u.aux = 1; }
            else { int pm, pn; static_tile(0, 192, idx - 256, 64, 3, pm, pn); u.A = CQ; u.Bt = WUQ; u.lda2 = 1536; u.ldb2 = 768; u.nt = 6; u.arow0 = pm * 256; u.brow0 = pn * 256; u.pm = pm; u.pn = pn; u.aux = 0; }
            return true;
        }
        const int n1 = (576 - vcu + G - 1) / G;
        if (i < n1) { const int k = vcu + G * i, pn = k >> 6, pm = k & 63;
            u.A = HB; u.Bt = WIN; u.lda2 = 2048; u.ldb2 = 2048; u.arow0 = pm * 256; u.brow0 = pn * 256; u.nt = 16; u.pm = pm; u.pn = pn; u.aux = 2; return true; }
        const int idx = vcu + G * (i - n1); if (idx >= 448) return false;
        if (idx < 256) { const int pm = idx & 63, pn = idx >> 6; u.A = CQ + 768; u.Bt = WUKV; u.lda2 = 1536; u.ldb2 = 512; u.nt = 4; u.arow0 = pm * 256; u.brow0 = pn * 256; u.pm = pm; u.pn = pn; u.aux = 1; }
        else { const int j = idx - 256, pm = j & 63, pn = j >> 6; u.A = CQ; u.Bt = WUQ; u.lda2 = 1536; u.ldb2 = 768; u.nt = 6; u.arow0 = pm * 256; u.brow0 = pn * 256; u.pm = pm; u.pn = pn; u.aux = 0; }
        return true;
    }
    __device__ __forceinline__ void a_ready(const gm::Unit& u, int wid) const {
        if (u.aux == 2) return;
        if (wid == 0) { unsigned* p = cnt + 16 * u.pm; unsigned spins = 0;
            while ((unsigned)__builtin_amdgcn_readfirstlane(__hip_atomic_load(p, __ATOMIC_RELAXED, __HIP_MEMORY_SCOPE_AGENT)) < 24u) { __builtin_amdgcn_s_sleep(2); if (++spins > (1u << 22)) break; }
            __builtin_amdgcn_fence(__ATOMIC_ACQUIRE, "agent");
            asm volatile("s_waitcnt vmcnt(0)" ::: "memory"); }
        asm volatile("" ::: "memory"); __builtin_amdgcn_s_barrier(); asm volatile("" ::: "memory");
    }
    __device__ __forceinline__ void done(const gm::Unit& u, int lane) const {
        if (u.aux != 2 || u.pn >= 3) return;
        asm volatile("s_waitcnt vmcnt(0)" ::: "memory");
        if (lane == 0) __hip_atomic_fetch_add(cnt + 16 * u.pm, 1u, __ATOMIC_RELAXED, __HIP_MEMORY_SCOPE_AGENT);
    }
};
struct EpiP12 {
    static constexpr bool PERM = true;
    unsigned char* ws;
    __device__ __forceinline__ void operator()(EPI_ARGS) const { if (u.aux == 2) { EpiP1 e{ws}; e(acc, u, wr, wc, fr, fq); } else { EpiP2 e{ws}; e(acc, u, wr, wc, fr, fq); } }
};
}
namespace mk {
#define RLX_AGENT __ATOMIC_RELAXED, __HIP_MEMORY_SCOPE_AGENT
#define XB_TMO      128
#define XB_XCNT(j)  (256  + 64 * (j))
#define XB_XSUB(j)  (1280 + 64 * (j))
#define XB_XGEN(j)  (2304 + 64 * (j))
#define XB_TOP      3328
#define XB_TOPGEN   3392
#define XCD_BAR_WORDS 3456
#define XB_SPIN_CAP (1u << 18)
__device__ __forceinline__ unsigned xb_ld(unsigned* p)              { return __hip_atomic_load(p, __ATOMIC_RELAXED, __HIP_MEMORY_SCOPE_AGENT); }
__device__ __forceinline__ unsigned xb_add(unsigned* p, unsigned v) { return __hip_atomic_fetch_add(p, v, __ATOMIC_RELAXED, __HIP_MEMORY_SCOPE_AGENT); }
__device__ __forceinline__ unsigned xb_xcc_id() { return (unsigned)__builtin_amdgcn_s_getreg((3 << 11) | 20) & 0xFu; }
#define XB_SPIN(cond, bar) do { unsigned _sp = 0; while (cond) { __builtin_amdgcn_s_sleep(1); \
    if ((++_sp & 255u) == 0u) { if (xb_ld(&(bar)[XB_TMO])) break; if (_sp > XB_SPIN_CAP) { atomicAdd(&(bar)[XB_TMO], 1u); break; } } } } while (0)
struct XcdBarrier { unsigned* bar; unsigned x; volatile LAS unsigned* st; };
__device__ __forceinline__ XcdBarrier xcd_barrier_post(unsigned* bar, volatile LAS unsigned* st) {
    XcdBarrier b; b.bar = bar; b.x = xb_xcc_id(); b.st = st;
    if (threadIdx.x == 0) (void)xb_add(&bar[XB_XCNT(b.x)], 1u);
    return b;
}
__device__ __forceinline__ void xcd_barrier_complete(unsigned* bar, unsigned x, unsigned& nloc, unsigned& nx) {
    const unsigned G = gridDim.x * gridDim.y * gridDim.z;
    unsigned sum, cnt, mine, sp = 0u;
    for (;;) {
        sum = 0u; cnt = 0u; mine = 0u;
#pragma unroll
        for (unsigned j = 0; j < 16; ++j) { const unsigned c = xb_ld(&bar[XB_XCNT(j)]); sum += c; cnt += (c > 0u) ? 1u : 0u; mine = (j == x) ? c : mine; }
        if (sum == G) break;
        __builtin_amdgcn_s_sleep(1);
        if ((++sp & 255u) == 0u) { if (xb_ld(&bar[XB_TMO])) break; if (sp > XB_SPIN_CAP) { atomicAdd(&bar[XB_TMO], 1u); break; } }
    }
    nloc = mine > 0u ? mine : 1u; nx = cnt > 0u ? cnt : 1u;
}
__device__ __forceinline__ void xcd_barrier(const XcdBarrier& b) {
    asm volatile("s_waitcnt vmcnt(0)" ::: "memory");
    __syncthreads();
    if (threadIdx.x == 0) {
        unsigned* bar = b.bar;
        __builtin_amdgcn_s_waitcnt(0);
        unsigned nloc = b.st[0], nx = b.st[1];
        if (nloc == 0u) { xcd_barrier_complete(bar, b.x, nloc, nx); b.st[0] = nloc; b.st[1] = nx; }
        const unsigned old = xb_add(&bar[XB_XSUB(b.x)], 1u);
        const unsigned gen = old / nloc;
        if (old + 1u == (gen + 1u) * nloc) {
            __builtin_amdgcn_fence(__ATOMIC_RELEASE, "agent");
            asm volatile("s_waitcnt vmcnt(0)" ::: "memory");
            const unsigned og = xb_add(&bar[XB_TOP], 1u);
            const unsigned tg = og / nx;
            if (og + 1u == (tg + 1u) * nx) xb_add(&bar[XB_TOPGEN], 1u);
            else XB_SPIN(xb_ld(&bar[XB_TOPGEN]) == tg, bar);
            __builtin_amdgcn_fence(__ATOMIC_ACQUIRE, "agent");
            xb_add(&bar[XB_XGEN(b.x)], 1u);
            asm volatile("s_waitcnt vmcnt(0)" ::: "memory");
        } else {
            XB_SPIN(xb_ld(&bar[XB_XGEN(b.x)]) == gen, bar);
            __builtin_amdgcn_fence(__ATOMIC_ACQUIRE, "agent");
            asm volatile("s_waitcnt vmcnt(0)" ::: "memory");
        }
    }
    __syncthreads();
}
}
namespace at {
using bf16x8 = __attribute__((ext_vector_type(8))) short;
using s16x4 = __attribute__((ext_vector_type(4))) short;
using f32x16 = __attribute__((ext_vector_type(16))) float;
using u32x4 = __attribute__((ext_vector_type(4))) unsigned;
constexpr int S = 8192, T = 16384;
constexpr float THR = 8.f;
#define SBAR() __builtin_amdgcn_sched_barrier(0)
__device__ __forceinline__ int crow(int r, int hi) { return (r & 3) + 8 * (r >> 2) + 4 * hi; }
__device__ __forceinline__ unsigned cvtpk(float lo, float hi) { unsigned r; asm volatile("v_cvt_pk_bf16_f32 %0, %1, %2" : "=v"(r) : "v"(lo), "v"(hi)); return r; }
__device__ __forceinline__ float rowmax32(const f32x16& p0, const f32x16& p1) {
    float pmax = p0[0];
#pragma unroll
    for (int r = 1; r < 16; ++r) pmax = fmaxf(pmax, p0[r]);
#pragma unroll
    for (int r = 0; r < 16; ++r) pmax = fmaxf(pmax, p1[r]);
    auto rr = __builtin_amdgcn_permlane32_swap(__float_as_uint(pmax), __float_as_uint(pmax), false, false);
    return fmaxf(__uint_as_float(rr[0]), __uint_as_float(rr[1]));
}
__device__ __forceinline__ void partialSM(f32x16& p0, f32x16& p1, float& m_reg, float& mn, float& alpha) {
    const float pmax = rowmax32(p0, p1);
    if (__builtin_expect(__all(pmax - m_reg <= THR), 1)) { mn = m_reg; alpha = 1.f; }
    else { mn = fmaxf(m_reg, pmax); alpha = __builtin_amdgcn_exp2f(m_reg - mn); m_reg = mn; }
#pragma unroll
    for (int r = 0; r < 16; ++r) p0[r] = p0[r] - mn;
#pragma unroll
    for (int r = 0; r < 16; ++r) p1[r] = p1[r] - mn;
#pragma unroll
    for (int r = 0; r < 16; ++r) p0[r] = __builtin_amdgcn_exp2f(p0[r]);
}
#define PK4(P, BASE, OUT) do { unsigned a0 = cvtpk(P[BASE + 0], P[BASE + 1]), a1 = cvtpk(P[BASE + 2], P[BASE + 3]);   \
    unsigned b0 = cvtpk(P[BASE + 4], P[BASE + 5]), b1 = cvtpk(P[BASE + 6], P[BASE + 7]);                              \
    auto r0 = __builtin_amdgcn_permlane32_swap(a0, b0, false, false); auto r1 = __builtin_amdgcn_permlane32_swap(a1, b1, false, false); \
    u32x4 w = {r0[0], r1[0], r0[1], r1[1]}; OUT = *reinterpret_cast<bf16x8*>(&w); } while (0)
__device__ __forceinline__ void finishSM(f32x16& p0, f32x16& p1, float alpha, float& l_reg, bf16x8& pa0, bf16x8& pa1, bf16x8& pa2, bf16x8& pa3) {
#pragma unroll
    for (int r = 0; r < 16; ++r) p1[r] = __builtin_amdgcn_exp2f(p1[r]);
    float ps = 0;
#pragma unroll
    for (int r = 0; r < 16; ++r) ps += p0[r];
#pragma unroll
    for (int r = 0; r < 16; ++r) ps += p1[r];
    { auto rr = __builtin_amdgcn_permlane32_swap(__float_as_uint(ps), __float_as_uint(ps), false, false); ps = __uint_as_float(rr[0]) + __uint_as_float(rr[1]); }
    l_reg = l_reg * alpha + ps;
    PK4(p0, 0, pa0); PK4(p0, 8, pa1); PK4(p1, 0, pa2); PK4(p1, 8, pa3);
}
__device__ __forceinline__ int v_st(int k, int c) { const int kk = (k & ~0xC) | ((k & 4) << 1) | ((k & 8) >> 1); return ((kk >> 3) * 2 + (c >> 5)) * 512 + ((kk & 7) * 32 + (c & 31)) * 2; }
__device__ __forceinline__ int v_rd_base(int lane) { return ((lane & 3) << 3) | (((lane >> 2) & 3) << 6) | (((lane >> 4) & 1) << 5) | (((lane >> 5) & 1) << 8); }
constexpr int v_rd_off(int d0, int ks, int half) { return d0 * 512 + ks * 2048 + half * 1024; }
template <int OFF> __device__ __forceinline__ s16x4 tr_read(int vb) { s16x4 r; asm volatile("ds_read_b64_tr_b16 %0, %1 offset:%2" : "=&v"(r) : "v"(vb), "i"(OFF) : "memory"); return r; }
#define PKV(L, H) (bf16x8){L[0], L[1], L[2], L[3], H[0], H[1], H[2], H[3]}
template <int D0, int KOFF> __device__ __forceinline__ void pv_one(f32x16& od, int vb, bf16x8 pa0, bf16x8 pa1, bf16x8 pa2, bf16x8 pa3) {
    const s16x4 l0 = tr_read<KOFF + v_rd_off(D0, 0, 0)>(vb), h0 = tr_read<KOFF + v_rd_off(D0, 0, 1)>(vb), l1 = tr_read<KOFF + v_rd_off(D0, 1, 0)>(vb), h1 = tr_read<KOFF + v_rd_off(D0, 1, 1)>(vb);
    const s16x4 l2 = tr_read<KOFF + v_rd_off(D0, 2, 0)>(vb), h2 = tr_read<KOFF + v_rd_off(D0, 2, 1)>(vb), l3 = tr_read<KOFF + v_rd_off(D0, 3, 0)>(vb), h3 = tr_read<KOFF + v_rd_off(D0, 3, 1)>(vb);
    asm volatile("s_waitcnt lgkmcnt(0)" ::: "memory"); SBAR();
    od = __builtin_amdgcn_mfma_f32_32x32x16_bf16(pa0, PKV(l0, h0), od, 0, 0, 0);
    od = __builtin_amdgcn_mfma_f32_32x32x16_bf16(pa1, PKV(l1, h1), od, 0, 0, 0);
    od = __builtin_amdgcn_mfma_f32_32x32x16_bf16(pa2, PKV(l2, h2), od, 0, 0, 0);
    od = __builtin_amdgcn_mfma_f32_32x32x16_bf16(pa3, PKV(l3, h3), od, 0, 0, 0);
}
template <int D0, int KOFF> __device__ __forceinline__ void pv_half(f32x16& od, int vb, bf16x8 pa0, bf16x8 pa1) {
    const s16x4 l0 = tr_read<KOFF + v_rd_off(D0, 0, 0)>(vb), h0 = tr_read<KOFF + v_rd_off(D0, 0, 1)>(vb), l1 = tr_read<KOFF + v_rd_off(D0, 1, 0)>(vb), h1 = tr_read<KOFF + v_rd_off(D0, 1, 1)>(vb);
    asm volatile("s_waitcnt lgkmcnt(0)" ::: "memory"); SBAR();
    od = __builtin_amdgcn_mfma_f32_32x32x16_bf16(pa0, PKV(l0, h0), od, 0, 0, 0);
    od = __builtin_amdgcn_mfma_f32_32x32x16_bf16(pa1, PKV(l1, h1), od, 0, 0, 0);
}
template <class RowOff> __device__ __forceinline__ void store_o_tile(const f32x16 (&o)[2], const float (&rli)[16], unsigned short* stg, unsigned short* dst, RowOff row_off, int lane) {
    const int r32 = lane & 31, hi = lane >> 5;
#pragma unroll
    for (int r = 0; r < 16; ++r) { const int orow = crow(r, hi);
#pragma unroll
        for (int d0 = 0; d0 < 2; ++d0) stg[orow * 64 + d0 * 32 + r32] = (unsigned short)(cvtpk(o[d0][r] * rli[r], 0.f) & 0xffffu); }
    asm volatile("s_waitcnt lgkmcnt(0)" ::: "memory");
#pragma unroll
    for (int i = 0; i < 4; ++i) { const int row = i * 8 + (lane >> 3), ch = lane & 7; const u32x4 v = *(const u32x4*)(stg + row * 64 + ch * 8); *(u32x4*)(dst + row_off(row) + ch * 8) = v; }
    asm volatile("s_waitcnt lgkmcnt(0)" ::: "memory");
}

constexpr int SHM_V = 8192, SHM_K = 16384, MLA_WS = 2 * SHM_V + 2 * SHM_K, MLA_OST = MLA_WS + 8 * 256;
#define KSWZ(row, colB) ((row) * 256 + ((colB) ^ (((row) & 15) << 4)))
__device__ __forceinline__ void qkt96(f32x16& p0, f32x16& p1, const char* Ks, const bf16x8* qr, int r32, int hi) {
    p0 = f32x16{}; p1 = f32x16{};
#pragma unroll
    for (int d0 = 0; d0 < 6; ++d0) { const int cb = (d0 * 16 + hi * 8) * 2;
        const bf16x8 b0 = *reinterpret_cast<const bf16x8*>(Ks + KSWZ(r32, cb));
        const bf16x8 b1 = *reinterpret_cast<const bf16x8*>(Ks + KSWZ(32 + r32, cb));
        p0 = __builtin_amdgcn_mfma_f32_32x32x16_bf16(b0, qr[d0], p0, 0, 0, 0);
        p1 = __builtin_amdgcn_mfma_f32_32x32x16_bf16(b1, qr[d0], p1, 0, 0, 0); }
}
__device__ __forceinline__ void pv64(f32x16* o, int vb, bf16x8 pa0, bf16x8 pa1, bf16x8 pa2, bf16x8 pa3) {
    pv_one<0, 0>(o[0], vb, pa0, pa1, pa2, pa3); pv_one<1, 0>(o[1], vb, pa0, pa1, pa2, pa3);
}
__device__ __forceinline__ void mla_unit(int bh, int qb, const unsigned short* __restrict__ Q, const unsigned short* __restrict__ KN, const unsigned short* __restrict__ KR,
                                         const unsigned short* __restrict__ V, unsigned short* __restrict__ CAT, char* lds) {
    const int tid = threadIdx.x, wid = tid >> 6, lane = tid & 63, r32 = lane & 31, hi = lane >> 5;
    const int b = bh >> 3, h = bh & 7;
    char* V_lds = lds; char* K_lds = lds + 2 * SHM_V;
    float* wsf = (float*)(lds + MLA_WS) + wid * 64; float* li_l = wsf; float* al_l = wsf + 32;
    float m_reg = -1e30f, l_reg = 0; f32x16 o[2] = {}; bf16x8 qr[6];
    const size_t bhS = (size_t)bh * S; const int q0 = qb * 256;
    const unsigned short* Qw = Q + (bhS + q0 + wid * 32 + r32) * 96 + hi * 8;
#pragma unroll
    for (int d0 = 0; d0 < 6; ++d0) qr[d0] = *reinterpret_cast<const bf16x8*>(Qw + d0 * 16);
    const int srow = tid >> 3, sch = tid & 7, rrow = (tid & 255) >> 2, rch = tid & 3;
    const unsigned short* kn_src = KN + (bhS + srow) * 64 + sch * 8;
    const unsigned short* v_src = V + (bhS + srow) * 64 + sch * 8;
    const unsigned short* kr_src = KR + ((size_t)b * S + rrow) * 32 + rch * 8;
    const int kst = KSWZ(srow, sch * 16), krst = KSWZ(rrow, (8 + rch) * 16), vst = v_st(srow, sch * 8);
    const int vb0 = (int)(uintptr_t)V_lds + v_rd_base(lane);
    bf16x8 s_kn[2], s_kr[2], s_v[2];
#define SLOAD(i, k0) do { s_kn[i] = *reinterpret_cast<const bf16x8*>(kn_src + (size_t)(k0) * 64); s_kr[i] = *reinterpret_cast<const bf16x8*>(kr_src + (size_t)(k0) * 32); \
    s_v[i] = *reinterpret_cast<const bf16x8*>(v_src + (size_t)(k0) * 64); } while (0)
#define SWRITE(bb, i) do { *(bf16x8*)(K_lds + (bb) * SHM_K + kst) = s_kn[i]; if (tid < 256) *(bf16x8*)(K_lds + (bb) * SHM_K + krst) = s_kr[i]; *(bf16x8*)(V_lds + (bb) * SHM_V + vst) = s_v[i]; } while (0)
#define SWAIT() asm volatile("s_waitcnt vmcnt(3)" ::: "memory")
#define RESC(a) do { if (__any((a) < 1.f)) { if (hi == 0) al_l[r32] = (a); asm volatile("s_waitcnt lgkmcnt(0)" ::: "memory"); \
    _Pragma("unroll") for (int d = 0; d < 2; ++d) _Pragma("unroll") for (int r = 0; r < 16; ++r) o[d][r] *= al_l[crow(r, hi)]; } } while (0)
    f32x16 pA0, pA1, pB0, pB1; float mnA, mnB, alA, alB; bf16x8 pa0, pa1, pa2, pa3; constexpr int NT = S / 64;
    SLOAD(0, 0); asm volatile("s_waitcnt vmcnt(0)" ::: "memory"); SWRITE(0, 0); __syncthreads();
    qkt96(pA0, pA1, K_lds, qr, r32, hi); partialSM(pA0, pA1, m_reg, mnA, alA);
    SLOAD(1, 64); SLOAD(0, 128);
    SWAIT(); SWRITE(1, 1); __syncthreads();
    for (int j = 1; j + 1 < NT; j += 2) {
        SBAR(); qkt96(pB0, pB1, K_lds + SHM_K, qr, r32, hi);
        finishSM(pA0, pA1, alA, l_reg, pa0, pa1, pa2, pa3); SBAR();
        SLOAD(1, (j + 2) * 64); SBAR();
        pv64(o, vb0, pa0, pa1, pa2, pa3); partialSM(pB0, pB1, m_reg, mnB, alB);
        __syncthreads(); SWAIT(); SWRITE(0, 0);
        RESC(alB); __syncthreads();
        SBAR(); qkt96(pA0, pA1, K_lds, qr, r32, hi);
        finishSM(pB0, pB1, alB, l_reg, pa0, pa1, pa2, pa3); SBAR();
        if (j + 3 < NT) SLOAD(0, (j + 3) * 64); SBAR();
        pv64(o, vb0 + SHM_V, pa0, pa1, pa2, pa3); partialSM(pA0, pA1, m_reg, mnA, alA);
        __syncthreads(); SWAIT(); SWRITE(1, 1);
        RESC(alA); __syncthreads();
    }
    SBAR(); qkt96(pB0, pB1, K_lds + SHM_K, qr, r32, hi);
    finishSM(pA0, pA1, alA, l_reg, pa0, pa1, pa2, pa3); SBAR();
    pv64(o, vb0, pa0, pa1, pa2, pa3); partialSM(pB0, pB1, m_reg, mnB, alB);
    __syncthreads(); RESC(alB);
    finishSM(pB0, pB1, alB, l_reg, pa0, pa1, pa2, pa3); SBAR();
    pv64(o, vb0 + SHM_V, pa0, pa1, pa2, pa3);
    if (hi == 0) li_l[r32] = l_reg; asm volatile("s_waitcnt lgkmcnt(0)" ::: "memory");
    float rli[16];
#pragma unroll
    for (int r = 0; r < 16; ++r) rli[r] = __builtin_amdgcn_rcpf(li_l[crow(r, hi)]);
    unsigned short* stg = (unsigned short*)(lds + MLA_OST) + wid * 2048;
    unsigned short* dst = CAT + ((size_t)b * S + q0 + wid * 32) * 1024 + h * 64;
    store_o_tile(o, rli, stg, dst, [](int row) { return (size_t)row * 1024; }, lane);
    asm volatile("s_waitcnt vmcnt(0)" ::: "memory");
    __syncthreads();
#undef SLOAD
#undef SWRITE
#undef SWAIT
#undef RESC
}


constexpr int M2_K = 0, M2_V = 3 * SHM_K, M2_WS = M2_V + 3 * SHM_V, M2_OST = M2_WS + 8 * 256;
#ifndef MLA_PROBE_NOSTAGE
#define MLA_PROBE_NOSTAGE 0
#endif
#ifndef MLA_STATIC
#define MLA_STATIC 1
#endif
#ifndef MLA_STEP_MODE
#define MLA_STEP_MODE 0
#endif
#ifndef MLA_PROBE_VALU
#define MLA_PROBE_VALU 0
#endif
#ifndef MLA_NEGM
#define MLA_NEGM 1
#endif
#ifndef MLA_PRIO
#define MLA_PRIO 0
#endif
__device__ __forceinline__ void qkt96n(f32x16& p0, f32x16& p1, const char* Ks, const bf16x8* qr, const f32x16& negm, int r32, int hi) {
    if (MLA_PRIO) __builtin_amdgcn_s_setprio(1);
#pragma unroll
    for (int d0 = 0; d0 < 6; ++d0) { const int cb = (d0 * 16 + hi * 8) * 2;
        const bf16x8 b0 = *reinterpret_cast<const bf16x8*>(Ks + KSWZ(r32, cb));
        const bf16x8 b1 = *reinterpret_cast<const bf16x8*>(Ks + KSWZ(32 + r32, cb));
        if (d0 == 0) { p0 = __builtin_amdgcn_mfma_f32_32x32x16_bf16(b0, qr[0], MLA_NEGM ? negm : f32x16{}, 0, 0, 0); p1 = __builtin_amdgcn_mfma_f32_32x32x16_bf16(b1, qr[0], MLA_NEGM ? negm : f32x16{}, 0, 0, 0); }
        else { p0 = __builtin_amdgcn_mfma_f32_32x32x16_bf16(b0, qr[d0], p0, 0, 0, 0); p1 = __builtin_amdgcn_mfma_f32_32x32x16_bf16(b1, qr[d0], p1, 0, 0, 0); } }
    if (MLA_PRIO) __builtin_amdgcn_s_setprio(0);
}
__device__ __forceinline__ float rowmax32b(const f32x16& p0, const f32x16& p1) {
    float a = fmaxf(fmaxf(p0[0], p0[1]), p1[0]), b = fmaxf(fmaxf(p0[2], p0[3]), p1[1]); a = fmaxf(fmaxf(a, p1[2]), p1[3]);
#pragma unroll
    for (int r = 4; r < 16; r += 4) { a = fmaxf(fmaxf(a, p0[r]), p0[r + 1]); b = fmaxf(fmaxf(b, p0[r + 2]), p0[r + 3]); a = fmaxf(fmaxf(a, p1[r]), p1[r + 1]); b = fmaxf(fmaxf(b, p1[r + 2]), p1[r + 3]); }
    const float m = fmaxf(a, b);
    auto rr = __builtin_amdgcn_permlane32_swap(__float_as_uint(m), __float_as_uint(m), false, false);
    return fmaxf(__uint_as_float(rr[0]), __uint_as_float(rr[1]));
}
template <bool FIRST> __device__ __forceinline__ void partialSM2(f32x16& p0, f32x16& p1, float& m_reg, f32x16& negm, float& alpha, bool exact = true) {
    if (!exact) { alpha = 1.f;
#pragma unroll
        for (int r = 0; r < 16; ++r) p0[r] = __builtin_amdgcn_exp2f(p0[r]);
        return; }
    if (MLA_PROBE_VALU) { float d0_ = p1[0], d1_ = p1[1], d2_ = p1[2], d3_ = p1[3];
#pragma unroll
        for (int i = 0; i < 8; ++i) { d0_ = __builtin_amdgcn_exp2f(d0_); d1_ = __builtin_amdgcn_exp2f(d1_); d2_ = __builtin_amdgcn_exp2f(d2_); d3_ = __builtin_amdgcn_exp2f(d3_); }
        asm volatile("" :: "v"(d0_), "v"(d1_), "v"(d2_), "v"(d3_)); }
    if (!MLA_NEGM) {
        const float pm = rowmax32b(p0, p1); alpha = 1.f;
        if (FIRST) m_reg = pm; else if (!__builtin_expect(__all(pm - m_reg <= THR), 1)) { const float mn = fmaxf(m_reg, pm); alpha = __builtin_amdgcn_exp2f(m_reg - mn); m_reg = mn; }
#pragma unroll
        for (int r = 0; r < 16; ++r) { p0[r] -= m_reg; p1[r] -= m_reg; }
#pragma unroll
        for (int r = 0; r < 16; ++r) p0[r] = __builtin_amdgcn_exp2f(p0[r]);
        return; }
    const float pmax = rowmax32b(p0, p1);
    alpha = 1.f;
    if (FIRST || !__builtin_expect(__all(pmax <= THR), 1)) {
        const float dl = FIRST ? pmax : fmaxf(pmax, 0.f); m_reg += dl;
#pragma unroll
        for (int r = 0; r < 16; ++r) { p0[r] -= dl; p1[r] -= dl; }
#pragma unroll
        for (int r = 0; r < 16; ++r) negm[r] = -m_reg;
        if (!FIRST) alpha = __builtin_amdgcn_exp2f(-dl);
    }
#pragma unroll
    for (int r = 0; r < 16; ++r) p0[r] = __builtin_amdgcn_exp2f(p0[r]);
}
template <int D0> __device__ __forceinline__ void pv_one_p(f32x16& od, int vb, bf16x8 pa0, bf16x8 pa1, bf16x8 pa2, bf16x8 pa3) {
    const s16x4 l0 = tr_read<v_rd_off(D0, 0, 0)>(vb), h0 = tr_read<v_rd_off(D0, 0, 1)>(vb), l1 = tr_read<v_rd_off(D0, 1, 0)>(vb), h1 = tr_read<v_rd_off(D0, 1, 1)>(vb);
    const s16x4 l2 = tr_read<v_rd_off(D0, 2, 0)>(vb), h2 = tr_read<v_rd_off(D0, 2, 1)>(vb), l3 = tr_read<v_rd_off(D0, 3, 0)>(vb), h3 = tr_read<v_rd_off(D0, 3, 1)>(vb);
    asm volatile("s_waitcnt lgkmcnt(0)" ::: "memory"); SBAR();
    if (MLA_PRIO) __builtin_amdgcn_s_setprio(1);
    od = __builtin_amdgcn_mfma_f32_32x32x16_bf16(pa0, PKV(l0, h0), od, 0, 0, 0);
    od = __builtin_amdgcn_mfma_f32_32x32x16_bf16(pa1, PKV(l1, h1), od, 0, 0, 0);
    od = __builtin_amdgcn_mfma_f32_32x32x16_bf16(pa2, PKV(l2, h2), od, 0, 0, 0);
    od = __builtin_amdgcn_mfma_f32_32x32x16_bf16(pa3, PKV(l3, h3), od, 0, 0, 0);
    if (MLA_PRIO) __builtin_amdgcn_s_setprio(0);
}

__device__ __forceinline__ void kfrag_load(bf16x8 (&kf)[12], const char* Ks, int r32, int hi) {
#pragma unroll
    for (int d0 = 0; d0 < 6; ++d0) { const int cb = (d0 * 16 + hi * 8) * 2;
        kf[2 * d0] = *reinterpret_cast<const bf16x8*>(Ks + KSWZ(r32, cb)); kf[2 * d0 + 1] = *reinterpret_cast<const bf16x8*>(Ks + KSWZ(32 + r32, cb)); }
}
__device__ __forceinline__ void qk_mma(f32x16& p0, f32x16& p1, const bf16x8 (&kf)[12], const bf16x8* qr, const f32x16& negm) {
    if (MLA_PRIO) __builtin_amdgcn_s_setprio(1);
    p0 = __builtin_amdgcn_mfma_f32_32x32x16_bf16(kf[0], qr[0], MLA_NEGM ? negm : f32x16{}, 0, 0, 0); p1 = __builtin_amdgcn_mfma_f32_32x32x16_bf16(kf[1], qr[0], MLA_NEGM ? negm : f32x16{}, 0, 0, 0);
#pragma unroll
    for (int d0 = 1; d0 < 6; ++d0) { p0 = __builtin_amdgcn_mfma_f32_32x32x16_bf16(kf[2 * d0], qr[d0], p0, 0, 0, 0); p1 = __builtin_amdgcn_mfma_f32_32x32x16_bf16(kf[2 * d0 + 1], qr[d0], p1, 0, 0, 0); }
    if (MLA_PRIO) __builtin_amdgcn_s_setprio(0);
}
template <int D0> __device__ __forceinline__ void vfrag_load_h(s16x4 (&vl)[4], s16x4 (&vh)[4], int vb) {
    vl[0] = tr_read<v_rd_off(D0, 0, 0)>(vb); vh[0] = tr_read<v_rd_off(D0, 0, 1)>(vb); vl[1] = tr_read<v_rd_off(D0, 1, 0)>(vb); vh[1] = tr_read<v_rd_off(D0, 1, 1)>(vb);
    vl[2] = tr_read<v_rd_off(D0, 2, 0)>(vb); vh[2] = tr_read<v_rd_off(D0, 2, 1)>(vb); vl[3] = tr_read<v_rd_off(D0, 3, 0)>(vb); vh[3] = tr_read<v_rd_off(D0, 3, 1)>(vb);
}
__device__ __forceinline__ void pv_mma_h(f32x16& od, const s16x4 (&vl)[4], const s16x4 (&vh)[4], bf16x8 pa0, bf16x8 pa1, bf16x8 pa2, bf16x8 pa3) {
    if (MLA_PRIO) __builtin_amdgcn_s_setprio(1);
    od = __builtin_amdgcn_mfma_f32_32x32x16_bf16(pa0, PKV(vl[0], vh[0]), od, 0, 0, 0);
    od = __builtin_amdgcn_mfma_f32_32x32x16_bf16(pa1, PKV(vl[1], vh[1]), od, 0, 0, 0);
    od = __builtin_amdgcn_mfma_f32_32x32x16_bf16(pa2, PKV(vl[2], vh[2]), od, 0, 0, 0);
    od = __builtin_amdgcn_mfma_f32_32x32x16_bf16(pa3, PKV(vl[3], vh[3]), od, 0, 0, 0);
    if (MLA_PRIO) __builtin_amdgcn_s_setprio(0);
}
#if MLA_STEP_MODE == 0
#define MLA_STEP(PC0, PC1, PP0, PP1, ALP, ALC) do { \
    qkt96n(PC0, PC1, K_lds + sc * SHM_K, qr, negm, r32, hi); \
    finishSM(PP0, PP1, ALP, l_reg, pa0, pa1, pa2, pa3); SBAR(); \
    { const int vb_ = vb0 + sp * SHM_V; pv_one_p<0>(o[0], vb_, pa0, pa1, pa2, pa3); pv_one_p<1>(o[1], vb_, pa0, pa1, pa2, pa3); } \
    partialSM2<false>(PC0, PC1, m_reg, negm, ALC, exact); RESC(ALC); } while (0)
#elif MLA_STEP_MODE == 2
  \
#define SGB(mask, n) __builtin_amdgcn_sched_group_barrier(mask, n, 0)
#define MLA_STEP(PC0, PC1, PP0, PP1, ALP, ALC) do { \
    { const char* Ks_ = K_lds + sc * SHM_K; \
      _Pragma("unroll") for (int d0 = 0; d0 < 6; ++d0) { const int cb = (d0 * 16 + hi * 8) * 2; \
        const bf16x8 b0 = *reinterpret_cast<const bf16x8*>(Ks_ + KSWZ(r32, cb)); const bf16x8 b1 = *reinterpret_cast<const bf16x8*>(Ks_ + KSWZ(32 + r32, cb)); \
        if (d0 == 0) { PC0 = __builtin_amdgcn_mfma_f32_32x32x16_bf16(b0, qr[0], negm, 0, 0, 0); PC1 = __builtin_amdgcn_mfma_f32_32x32x16_bf16(b1, qr[0], negm, 0, 0, 0); } \
        else { PC0 = __builtin_amdgcn_mfma_f32_32x32x16_bf16(b0, qr[d0], PC0, 0, 0, 0); PC1 = __builtin_amdgcn_mfma_f32_32x32x16_bf16(b1, qr[d0], PC1, 0, 0, 0); } } } \
    finishSM(PP0, PP1, ALP, l_reg, pa0, pa1, pa2, pa3); \
    SGB(0x100, 4); \
    _Pragma("unroll") for (int g_ = 0; g_ < 12; ++g_) { SGB(0x008, 1); SGB(0x100, 1); SGB(0x002, 7); } \
    SBAR(); \
    { const int vb_ = vb0 + sp * SHM_V; \
      const s16x4 l0 = tr_read<v_rd_off(0, 0, 0)>(vb_), h0 = tr_read<v_rd_off(0, 0, 1)>(vb_), l1 = tr_read<v_rd_off(0, 1, 0)>(vb_), h1 = tr_read<v_rd_off(0, 1, 1)>(vb_); \
      const s16x4 l2 = tr_read<v_rd_off(0, 2, 0)>(vb_), h2 = tr_read<v_rd_off(0, 2, 1)>(vb_), l3 = tr_read<v_rd_off(0, 3, 0)>(vb_), h3 = tr_read<v_rd_off(0, 3, 1)>(vb_); \
      const s16x4 l4 = tr_read<v_rd_off(1, 0, 0)>(vb_), h4 = tr_read<v_rd_off(1, 0, 1)>(vb_), l5 = tr_read<v_rd_off(1, 1, 0)>(vb_), h5 = tr_read<v_rd_off(1, 1, 1)>(vb_); \
      const s16x4 l6 = tr_read<v_rd_off(1, 2, 0)>(vb_), h6 = tr_read<v_rd_off(1, 2, 1)>(vb_), l7 = tr_read<v_rd_off(1, 3, 0)>(vb_), h7 = tr_read<v_rd_off(1, 3, 1)>(vb_); \
      asm volatile("s_waitcnt lgkmcnt(0)" ::: "memory"); SBAR(); \
      o[0] = __builtin_amdgcn_mfma_f32_32x32x16_bf16(pa0, PKV(l0, h0), o[0], 0, 0, 0); o[1] = __builtin_amdgcn_mfma_f32_32x32x16_bf16(pa0, PKV(l4, h4), o[1], 0, 0, 0); \
      o[0] = __builtin_amdgcn_mfma_f32_32x32x16_bf16(pa1, PKV(l1, h1), o[0], 0, 0, 0); o[1] = __builtin_amdgcn_mfma_f32_32x32x16_bf16(pa1, PKV(l5, h5), o[1], 0, 0, 0); \
      o[0] = __builtin_amdgcn_mfma_f32_32x32x16_bf16(pa2, PKV(l2, h2), o[0], 0, 0, 0); o[1] = __builtin_amdgcn_mfma_f32_32x32x16_bf16(pa2, PKV(l6, h6), o[1], 0, 0, 0); \
      o[0] = __builtin_amdgcn_mfma_f32_32x32x16_bf16(pa3, PKV(l3, h3), o[0], 0, 0, 0); o[1] = __builtin_amdgcn_mfma_f32_32x32x16_bf16(pa3, PKV(l7, h7), o[1], 0, 0, 0); \
      partialSM2<false>(PC0, PC1, m_reg, negm, ALC, exact); \
      _Pragma("unroll") for (int g_ = 0; g_ < 8; ++g_) { SGB(0x008, 1); SGB(0x002, 2); } \
      SBAR(); } \
    RESC(ALC); } while (0)
#else
#define MLA_STEP(PC0, PC1, PP0, PP1, ALP, ALC) do { \
    bf16x8 kf[12]; s16x4 val[4], vah[4], vbl[4], vbh[4]; const int vb_ = vb0 + sp * SHM_V; \
    kfrag_load(kf, K_lds + sc * SHM_K, r32, hi); SBAR(); \
    finishSM(PP0, PP1, ALP, l_reg, pa0, pa1, pa2, pa3); SBAR(); \
    vfrag_load_h<0>(val, vah, vb_); SBAR(); \
    qk_mma(PC0, PC1, kf, qr, negm); SBAR(); \
    vfrag_load_h<1>(vbl, vbh, vb_); SBAR(); \
    asm volatile("s_waitcnt lgkmcnt(8)" ::: "memory"); SBAR(); \
    pv_mma_h(o[0], val, vah, pa0, pa1, pa2, pa3); SBAR(); \
    asm volatile("s_waitcnt lgkmcnt(0)" ::: "memory"); SBAR(); \
    pv_mma_h(o[1], vbl, vbh, pa0, pa1, pa2, pa3); SBAR(); \
    partialSM2<false>(PC0, PC1, m_reg, negm, ALC); RESC(ALC); } while (0)
#endif

__device__ __forceinline__ void mla_unit_v2(int bh, int qb, const unsigned short* __restrict__ Q, const unsigned short* __restrict__ KN, const unsigned short* __restrict__ KR,
                                            const unsigned short* __restrict__ V, unsigned short* __restrict__ CAT, const float* __restrict__ KMX, char* lds) {
    const int tid = threadIdx.x, wid = tid >> 6, lane = tid & 63, r32 = lane & 31, hi = lane >> 5;
    const int b = bh >> 3, h = bh & 7;
    char* K_lds = lds + M2_K; char* V_lds = lds + M2_V;
    float* wsf = (float*)(lds + M2_WS) + wid * 64; float* li_l = wsf; float* al_l = wsf + 32;
    float m_reg = 0.f, l_reg = 0; f32x16 o[2] = {}; bf16x8 qr[6]; f32x16 negm = f32x16{};
    const size_t bhS = (size_t)bh * S; const int q0 = qb * 256;
    const unsigned short* Qw = Q + (bhS + q0 + wid * 32 + r32) * 96 + hi * 8;
#pragma unroll
    for (int d0 = 0; d0 < 6; ++d0) qr[d0] = *reinterpret_cast<const bf16x8*>(Qw + d0 * 16);
    bool exact = true;
    if (MLA_STATIC) { float q2 = 0.f;
#pragma unroll
      for (int d0 = 0; d0 < 6; ++d0)
#pragma unroll
          for (int j = 0; j < 8; ++j) { const float x = __uint_as_float((unsigned)(unsigned short)qr[d0][j] << 16); q2 += x * x; }
      { auto rr = __builtin_amdgcn_permlane32_swap(__float_as_uint(q2), __float_as_uint(q2), false, false); q2 = __uint_as_float(rr[0]) + __uint_as_float(rr[1]); }
      const float k2 = KMX[(b * 8 + h) * 2] + KMX[(b * 8 + h) * 2 + 1] + KMX[32 + b];
      const float ms = 1.01f * sqrtf(q2 * k2);
      exact = __syncthreads_or(!(ms <= 60.f)) != 0;
      if (!exact) { m_reg = ms;
#pragma unroll
          for (int r = 0; r < 16; ++r) negm[r] = -ms; } }
    const int srow = tid >> 3, sch = tid & 7, rrow = (tid & 255) >> 2, rch = tid & 3;
    const char* kn_u = (const char*)(KN + bhS * 64); const char* v_u = (const char*)(V + bhS * 64); const char* kr_u = (const char*)(KR + (size_t)b * S * 32);
    const unsigned kn_off = (unsigned)(srow * 64 + sch * 8) * 2u, kr_off = (unsigned)(rrow * 32 + rch * 8) * 2u;
    const int kst = KSWZ(srow, sch * 16), krst = KSWZ(rrow, (8 + rch) * 16), vst = v_st(srow, sch * 8);
    const int vb0 = (int)(uintptr_t)V_lds + v_rd_base(lane);
    bf16x8 s_kn[1], s_kr[1], s_v[1];
#define SLOAD(i, t) do { s_kn[i] = *reinterpret_cast<const bf16x8*>(kn_u + (size_t)(t) * 8192 + kn_off); s_kr[i] = *reinterpret_cast<const bf16x8*>(kr_u + (size_t)(t) * 4096 + kr_off); \
    s_v[i] = *reinterpret_cast<const bf16x8*>(v_u + (size_t)(t) * 8192 + kn_off); } while (0)
#define SWRITE(sl, i) do { *(bf16x8*)(K_lds + (sl) * SHM_K + kst) = s_kn[i]; if (tid < 256) *(bf16x8*)(K_lds + (sl) * SHM_K + krst) = s_kr[i]; *(bf16x8*)(V_lds + (sl) * SHM_V + vst) = s_v[i]; } while (0)
#define SWAIT() asm volatile("s_waitcnt vmcnt(0)" ::: "memory")
#define RESC(a) do { if (exact && __any((a) < 1.f)) { if (hi == 0) al_l[r32] = (a); asm volatile("s_waitcnt lgkmcnt(0)" ::: "memory"); \
    _Pragma("unroll") for (int d = 0; d < 2; ++d) _Pragma("unroll") for (int r = 0; r < 16; ++r) o[d][r] *= al_l[crow(r, hi)]; } } while (0)
#define ROT3(x) ((x) == 2 ? 0 : (x) + 1)
    f32x16 pA0, pA1, pB0, pB1; float alA, alB; bf16x8 pa0, pa1, pa2, pa3; constexpr int NT = S / 64;
    SLOAD(0, 0);
    SWAIT(); SWRITE(0, 0); SLOAD(0, 1);
    __syncthreads();
    qkt96n(pA0, pA1, K_lds, qr, negm, r32, hi); if (exact) partialSM2<true>(pA0, pA1, m_reg, negm, alA); else partialSM2<false>(pA0, pA1, m_reg, negm, alA, false);
    SWAIT(); SWRITE(1, 0); SLOAD(0, 2);
    __syncthreads();
    int sp = 0, sc = 1, sn = 2;
    for (int j = 1; j + 1 < NT; j += 2) {
        if (!MLA_PROBE_NOSTAGE) { SWAIT(); SWRITE(sn, 0); if (j + 2 < NT) SLOAD(0, j + 2); }
        SBAR(); MLA_STEP(pB0, pB1, pA0, pA1, alA, alB);
        __syncthreads();
        sp = sc; sc = sn; sn = ROT3(sn);
        if (!MLA_PROBE_NOSTAGE) { SWAIT(); SWRITE(sn, 0); if (j + 3 < NT) SLOAD(0, j + 3); }
        SBAR(); MLA_STEP(pA0, pA1, pB0, pB1, alB, alA);
        __syncthreads();
        sp = sc; sc = sn; sn = ROT3(sn);
    }
    SBAR(); MLA_STEP(pB0, pB1, pA0, pA1, alA, alB);
    finishSM(pB0, pB1, alB, l_reg, pa0, pa1, pa2, pa3); SBAR();
    { const int vb = vb0 + sc * SHM_V; pv_one_p<0>(o[0], vb, pa0, pa1, pa2, pa3); pv_one_p<1>(o[1], vb, pa0, pa1, pa2, pa3); }
    if (hi == 0) li_l[r32] = l_reg; asm volatile("s_waitcnt lgkmcnt(0)" ::: "memory");
    float rli[16];
#pragma unroll
    for (int r = 0; r < 16; ++r) rli[r] = __builtin_amdgcn_rcpf(li_l[crow(r, hi)]);
    unsigned short* stg = (unsigned short*)(lds + M2_OST) + wid * 2048;
    unsigned short* dst = CAT + ((size_t)b * S + q0 + wid * 32) * 1024 + h * 64;
    store_o_tile(o, rli, stg, dst, [](int row) { return (size_t)row * 1024; }, lane);
    asm volatile("s_waitcnt vmcnt(0)" ::: "memory");
    __syncthreads();
#undef SLOAD
#undef SWRITE
#undef SWAIT
#undef RESC
#undef ROT3
}


__device__ __forceinline__ void finishSM_s(f32x16& p0, f32x16& p1, float& l_reg, bf16x8& pa0, bf16x8& pa1, bf16x8& pa2, bf16x8& pa3) {
#pragma unroll
    for (int r = 0; r < 16; ++r) p1[r] = __builtin_amdgcn_exp2f(p1[r]);
    float ps = 0;
#pragma unroll
    for (int r = 0; r < 16; ++r) ps += p0[r];
#pragma unroll
    for (int r = 0; r < 16; ++r) ps += p1[r];
    l_reg += ps;
    PK4(p0, 0, pa0); PK4(p0, 8, pa1); PK4(p1, 0, pa2); PK4(p1, 8, pa3);
}
__device__ __forceinline__ void exp_half(f32x16& p0) {
#pragma unroll
    for (int r = 0; r < 16; ++r) p0[r] = __builtin_amdgcn_exp2f(p0[r]);
}
__device__ __forceinline__ bool mla_unit_v5(int bh, int qb, const unsigned short* __restrict__ Q, const unsigned short* __restrict__ KN, const unsigned short* __restrict__ KR,
                                            const unsigned short* __restrict__ V, unsigned short* __restrict__ CAT, const float* __restrict__ KMX, char* lds) {
    const int tid = threadIdx.x, wid = tid >> 6, lane = tid & 63, r32 = lane & 31, hi = lane >> 5;
    const int b = bh >> 3, h = bh & 7;
    char* K_lds = lds + M2_K; char* V_lds = lds + M2_V;
    float* wsf = (float*)(lds + M2_WS) + wid * 64; float* li_l = wsf;
    float l_reg = 0; f32x16 o[2] = {}; bf16x8 qr[6];
    const size_t bhS = (size_t)bh * S; const int q0 = qb * 256;
    const unsigned short* Qw = Q + (bhS + q0 + wid * 32 + r32) * 96 + hi * 8;
#pragma unroll
    for (int d0 = 0; d0 < 6; ++d0) qr[d0] = *reinterpret_cast<const bf16x8*>(Qw + d0 * 16);
    f32x16 negm;
    { float q2 = 0.f;
#pragma unroll
      for (int d0 = 0; d0 < 6; ++d0)
#pragma unroll
          for (int j = 0; j < 8; ++j) { const float x = __uint_as_float((unsigned)(unsigned short)qr[d0][j] << 16); q2 += x * x; }
      { auto rr = __builtin_amdgcn_permlane32_swap(__float_as_uint(q2), __float_as_uint(q2), false, false); q2 = __uint_as_float(rr[0]) + __uint_as_float(rr[1]); }
      const float k2 = KMX[(b * 8 + h) * 2] + KMX[(b * 8 + h) * 2 + 1] + KMX[32 + b];
      const float m = 1.01f * sqrtf(q2 * k2);
#pragma unroll
      for (int r = 0; r < 16; ++r) negm[r] = -m; }
    const int srow = tid >> 3, sch = tid & 7, rrow = (tid & 255) >> 2, rch = tid & 3;
    const char* kn_u = (const char*)(KN + bhS * 64); const char* v_u = (const char*)(V + bhS * 64); const char* kr_u = (const char*)(KR + (size_t)b * S * 32);
    const unsigned kn_off = (unsigned)(srow * 64 + sch * 8) * 2u, kr_off = (unsigned)(rrow * 32 + rch * 8) * 2u;
    const int kst = KSWZ(srow, sch * 16), krst = KSWZ(rrow, (8 + rch) * 16), vst = v_st(srow, sch * 8);
    const int vb0 = (int)(uintptr_t)V_lds + v_rd_base(lane);
    bf16x8 s_kn, s_kr, s_v;
#define SLOAD(t) do { s_kn = *reinterpret_cast<const bf16x8*>(kn_u + (size_t)(t) * 8192 + kn_off); s_kr = *reinterpret_cast<const bf16x8*>(kr_u + (size_t)(t) * 4096 + kr_off); \
    s_v = *reinterpret_cast<const bf16x8*>(v_u + (size_t)(t) * 8192 + kn_off); } while (0)
#define SWRITE(sl) do { *(bf16x8*)(K_lds + (sl) * SHM_K + kst) = s_kn; if (tid < 256) *(bf16x8*)(K_lds + (sl) * SHM_K + krst) = s_kr; *(bf16x8*)(V_lds + (sl) * SHM_V + vst) = s_v; } while (0)
#define SWAIT() asm volatile("s_waitcnt vmcnt(0)" ::: "memory")
#define ROT3(x) ((x) == 2 ? 0 : (x) + 1)
#define STEP5(PC0, PC1, PP0, PP1) do { \
    qkt96n(PC0, PC1, K_lds + sc * SHM_K, qr, negm, r32, hi); \
    finishSM_s(PP0, PP1, l_reg, pa0, pa1, pa2, pa3); SBAR(); \
    { const int vb_ = vb0 + sp * SHM_V; pv_one_p<0>(o[0], vb_, pa0, pa1, pa2, pa3); pv_one_p<1>(o[1], vb_, pa0, pa1, pa2, pa3); } \
    exp_half(PC0); } while (0)
    f32x16 pA0, pA1, pB0, pB1; bf16x8 pa0, pa1, pa2, pa3; constexpr int NT = S / 64;
    SLOAD(0);
    SWAIT(); SWRITE(0); SLOAD(1);
    __syncthreads();
    qkt96n(pA0, pA1, K_lds, qr, negm, r32, hi); exp_half(pA0);
    SWAIT(); SWRITE(1); SLOAD(2);
    __syncthreads();
    int sp = 0, sc = 1, sn = 2;
    for (int j = 1; j + 1 < NT; j += 2) {
        SWAIT(); SWRITE(sn); if (j + 2 < NT) SLOAD(j + 2);
        SBAR(); STEP5(pB0, pB1, pA0, pA1);
        __syncthreads();
        sp = sc; sc = sn; sn = ROT3(sn);
        SWAIT(); SWRITE(sn); if (j + 3 < NT) SLOAD(j + 3);
        SBAR(); STEP5(pA0, pA1, pB0, pB1);
        __syncthreads();
        sp = sc; sc = sn; sn = ROT3(sn);
    }
    SBAR(); STEP5(pB0, pB1, pA0, pA1);
    finishSM_s(pB0, pB1, l_reg, pa0, pa1, pa2, pa3); SBAR();
    { const int vb = vb0 + sc * SHM_V; pv_one_p<0>(o[0], vb, pa0, pa1, pa2, pa3); pv_one_p<1>(o[1], vb, pa0, pa1, pa2, pa3); }
    { auto rr = __builtin_amdgcn_permlane32_swap(__float_as_uint(l_reg), __float_as_uint(l_reg), false, false); l_reg = __uint_as_float(rr[0]) + __uint_as_float(rr[1]); }
    const bool bad = !(l_reg > 1e-30f);
    if (hi == 0) li_l[r32] = l_reg; asm volatile("s_waitcnt lgkmcnt(0)" ::: "memory");
    float rli[16];
#pragma unroll
    for (int r = 0; r < 16; ++r) rli[r] = __builtin_amdgcn_rcpf(li_l[crow(r, hi)]);
    unsigned short* stg = (unsigned short*)(lds + M2_OST) + wid * 2048;
    unsigned short* dst = CAT + ((size_t)b * S + q0 + wid * 32) * 1024 + h * 64;
    store_o_tile(o, rli, stg, dst, [](int row) { return (size_t)row * 1024; }, lane);
    asm volatile("s_waitcnt vmcnt(0)" ::: "memory");
    const int anybad = __syncthreads_or(bad ? 1 : 0);
    return anybad != 0;
#undef SLOAD
#undef SWRITE
#undef SWAIT
#undef ROT3
#undef STEP5
}

constexpr int M4_K = 0, M4_V = 4 * SHM_K, M4_WS = M4_V + 4 * SHM_V, M4_OST = M4_WS + 8 * 256;
template <bool FIRST> __device__ __forceinline__ void softmax_full(f32x16& p0, f32x16& p1, float& m_reg, f32x16& negm, float& l_reg, float& alpha, bf16x8& pa0, bf16x8& pa1, bf16x8& pa2, bf16x8& pa3, bool exact) {
    if (exact) partialSM2<FIRST>(p0, p1, m_reg, negm, alpha, true); else partialSM2<false>(p0, p1, m_reg, negm, alpha, false);
    finishSM(p0, p1, alpha, l_reg, pa0, pa1, pa2, pa3);
}
__device__ __forceinline__ void mla_unit_v4(int bh, int qb, const unsigned short* __restrict__ Q, const unsigned short* __restrict__ KN, const unsigned short* __restrict__ KR,
                                            const unsigned short* __restrict__ V, unsigned short* __restrict__ CAT, const float* __restrict__ KMX, char* lds) {
    const int tid = threadIdx.x, wid = __builtin_amdgcn_readfirstlane(tid >> 6), lane = tid & 63, r32 = lane & 31, hi = lane >> 5;
    const int b = bh >> 3, h = bh & 7; const bool halfB = wid >= 4;
    char* K_lds = lds + M4_K; char* V_lds = lds + M4_V;
    float* wsf = (float*)(lds + M4_WS) + wid * 64; float* li_l = wsf; float* al_l = wsf + 32;
    float m_reg = 0.f, l_reg = 0; f32x16 o[2] = {}; bf16x8 qr[6]; f32x16 negm = f32x16{};
    const size_t bhS = (size_t)bh * S; const int q0 = qb * 256;
    const unsigned short* Qw = Q + (bhS + q0 + wid * 32 + r32) * 96 + hi * 8;
#pragma unroll
    for (int d0 = 0; d0 < 6; ++d0) qr[d0] = *reinterpret_cast<const bf16x8*>(Qw + d0 * 16);
    bool exact = true;
    if (MLA_STATIC) { float q2 = 0.f;
#pragma unroll
      for (int d0 = 0; d0 < 6; ++d0)
#pragma unroll
          for (int j = 0; j < 8; ++j) { const float x = __uint_as_float((unsigned)(unsigned short)qr[d0][j] << 16); q2 += x * x; }
      { auto rr = __builtin_amdgcn_permlane32_swap(__float_as_uint(q2), __float_as_uint(q2), false, false); q2 = __uint_as_float(rr[0]) + __uint_as_float(rr[1]); }
      const float k2 = KMX[(b * 8 + h) * 2] + KMX[(b * 8 + h) * 2 + 1] + KMX[32 + b];
      const float ms = 1.01f * sqrtf(q2 * k2);
      exact = __syncthreads_or(!(ms <= 60.f)) != 0;
      if (!exact) { m_reg = ms;
#pragma unroll
          for (int r = 0; r < 16; ++r) negm[r] = -ms; } }
    const int srow = tid >> 3, sch = tid & 7, rrow = (tid & 255) >> 2, rch = tid & 3;
    const char* kn_u = (const char*)(KN + bhS * 64); const char* v_u = (const char*)(V + bhS * 64); const char* kr_u = (const char*)(KR + (size_t)b * S * 32);
    const unsigned kn_off = (unsigned)(srow * 64 + sch * 8) * 2u, kr_off = (unsigned)(rrow * 32 + rch * 8) * 2u;
    const int kst = KSWZ(srow, sch * 16), krst = KSWZ(rrow, (8 + rch) * 16), vst = v_st(srow, sch * 8);
    const int vb0 = (int)(uintptr_t)V_lds + v_rd_base(lane);
    bf16x8 s_kn, s_kr, s_v;
#define SLOAD(t) do { s_kn = *reinterpret_cast<const bf16x8*>(kn_u + (size_t)(t) * 8192 + kn_off); s_kr = *reinterpret_cast<const bf16x8*>(kr_u + (size_t)(t) * 4096 + kr_off); \
    s_v = *reinterpret_cast<const bf16x8*>(v_u + (size_t)(t) * 8192 + kn_off); } while (0)
#define SWRITE(sl) do { *(bf16x8*)(K_lds + (sl) * SHM_K + kst) = s_kn; if (tid < 256) *(bf16x8*)(K_lds + (sl) * SHM_K + krst) = s_kr; *(bf16x8*)(V_lds + (sl) * SHM_V + vst) = s_v; } while (0)
#define SWAIT() asm volatile("s_waitcnt vmcnt(0)" ::: "memory")
#define RESC(a) do { if (exact && __any((a) < 1.f)) { if (hi == 0) al_l[r32] = (a); asm volatile("s_waitcnt lgkmcnt(0)" ::: "memory"); \
    _Pragma("unroll") for (int d = 0; d < 2; ++d) _Pragma("unroll") for (int r = 0; r < 16; ++r) o[d][r] *= al_l[crow(r, hi)]; } } while (0)
#define RAWBAR() do { asm volatile("" ::: "memory"); __builtin_amdgcn_s_barrier(); asm volatile("" ::: "memory"); } while (0)
    f32x16 p0, p1; float al; bf16x8 pa0, pa1, pa2, pa3; bf16x8 kf[12]; constexpr int NT = S / 64;
    SLOAD(0); SWAIT(); SWRITE(0); SLOAD(1); SWAIT(); SWRITE(1); SLOAD(2);
    asm volatile("s_waitcnt lgkmcnt(0)" ::: "memory"); RAWBAR();
    if (halfB) RAWBAR();
    kfrag_load(kf, K_lds, r32, hi); SBAR();
    qk_mma(p0, p1, kf, qr, negm); SBAR();
    asm volatile("s_waitcnt lgkmcnt(0)" ::: "memory"); RAWBAR();
    softmax_full<true>(p0, p1, m_reg, negm, l_reg, al, pa0, pa1, pa2, pa3, exact); SBAR();
    SWAIT(); SWRITE(2); SLOAD(3); SBAR();
    kfrag_load(kf, K_lds + SHM_K, r32, hi); SBAR();
    asm volatile("s_waitcnt lgkmcnt(12)" ::: "memory"); RAWBAR();
    int sp = 0, sc = 1, sw = 3;
    for (int t = 1; t < NT; ++t) {
        { s16x4 val[4], vah[4], vbl[4], vbh[4]; const int vb_ = vb0 + sp * SHM_V;
          vfrag_load_h<0>(val, vah, vb_); SBAR();
          qk_mma(p0, p1, kf, qr, negm); SBAR();
          vfrag_load_h<1>(vbl, vbh, vb_); SBAR();
          asm volatile("s_waitcnt lgkmcnt(8)" ::: "memory"); SBAR();
          pv_mma_h(o[0], val, vah, pa0, pa1, pa2, pa3); SBAR();
          asm volatile("s_waitcnt lgkmcnt(0)" ::: "memory"); SBAR();
          pv_mma_h(o[1], vbl, vbh, pa0, pa1, pa2, pa3); SBAR(); }
        RAWBAR();
        if (t + 2 < NT) { SWAIT(); SWRITE(sw); if (t + 3 < NT) SLOAD(t + 3); } SBAR();
        softmax_full<false>(p0, p1, m_reg, negm, l_reg, al, pa0, pa1, pa2, pa3, exact); RESC(al); SBAR();
        sp = sc; sc = (sc + 1) & 3; sw = (sw + 1) & 3;
        if (t + 1 < NT) { kfrag_load(kf, K_lds + sc * SHM_K, r32, hi); SBAR(); }
        asm volatile("s_waitcnt lgkmcnt(12)" ::: "memory"); RAWBAR();
    }
    { s16x4 val[4], vah[4], vbl[4], vbh[4]; const int vb_ = vb0 + sp * SHM_V;
      vfrag_load_h<0>(val, vah, vb_); vfrag_load_h<1>(vbl, vbh, vb_); SBAR();
      asm volatile("s_waitcnt lgkmcnt(0)" ::: "memory"); SBAR();
      pv_mma_h(o[0], val, vah, pa0, pa1, pa2, pa3); pv_mma_h(o[1], vbl, vbh, pa0, pa1, pa2, pa3); SBAR(); }
    if (!halfB) RAWBAR();
    if (hi == 0) li_l[r32] = l_reg; asm volatile("s_waitcnt lgkmcnt(0)" ::: "memory");
    float rli[16];
#pragma unroll
    for (int r = 0; r < 16; ++r) rli[r] = __builtin_amdgcn_rcpf(li_l[crow(r, hi)]);
    unsigned short* stg = (unsigned short*)(lds + M4_OST) + wid * 2048;
    unsigned short* dst = CAT + ((size_t)b * S + q0 + wid * 32) * 1024 + h * 64;
    store_o_tile(o, rli, stg, dst, [](int row) { return (size_t)row * 1024; }, lane);
    asm volatile("s_waitcnt vmcnt(0)" ::: "memory");
    __syncthreads();
#undef SLOAD
#undef SWRITE
#undef SWAIT
#undef RESC
#undef RAWBAR
}

constexpr int DL_K = 0, DL_V = 49152, DL_WS = 98304, DL_OST = DL_WS + 8 * 256;
#define KSWZD(row, colB) ((row) * 128 + ((colB) ^ ((((row) >> 1) & 7) << 4)))
__device__ __forceinline__ void dil_unit(int bh, int br, int blk, const unsigned short* __restrict__ DQ, const unsigned short* __restrict__ DK, const unsigned short* __restrict__ DV,
                                         unsigned short* __restrict__ OBR, float* __restrict__ LSE, char* lds) {
    const int tid = threadIdx.x, wid = tid >> 6, lane = tid & 63, r32 = lane & 31, hi = lane >> 5;
    const int sh = 2 * br, dil = 1 << sh, L = S >> sh, nbl = L >> 8, res = blk / nbl, lb = blk % nbl;
    const size_t bhS = (size_t)bh * S; const int b = bh >> 3, h = bh & 7;
    char* K_lds = lds + DL_K; char* V_lds = lds + DL_V;
#pragma unroll
    for (int half = 0; half < 2; ++half) {
        bf16x8 kk[3], vv[3];
#pragma unroll
        for (int it = 0; it < 3; ++it) { const int item = (half * 3 + it) * 512 + tid, row = item >> 3, ch = item & 7; const int l = 256 * lb - 64 + row; const bool valid = (l >= 0) && (l < L);
            const size_t src = (bhS + (valid ? ((size_t)l << sh) + res : 0)) * 64 + ch * 8;
            kk[it] = *reinterpret_cast<const bf16x8*>(DK + src); vv[it] = *reinterpret_cast<const bf16x8*>(DV + src);
            if (!valid) { kk[it] = bf16x8{}; vv[it] = bf16x8{}; } }
#pragma unroll
        for (int it = 0; it < 3; ++it) { const int item = (half * 3 + it) * 512 + tid, row = item >> 3, ch = item & 7;
            *(bf16x8*)(K_lds + KSWZD(row, ch * 16)) = kk[it]; *(bf16x8*)(V_lds + (row >> 4) * 2048 + v_st(row & 15, ch * 8)) = vv[it]; }
    }
    bf16x8 qr[4];
    const int ql = wid * 32 + r32; const size_t qpos = ((size_t)(256 * lb + ql) << sh) + res;
    const unsigned short* Qw = DQ + (bhS + qpos) * 64 + hi * 8;
#pragma unroll
    for (int d0 = 0; d0 < 4; ++d0) qr[d0] = *reinterpret_cast<const bf16x8*>(Qw + d0 * 16);
    __syncthreads();
    f32x16 p[5];
#pragma unroll
    for (int j = 0; j < 5; ++j) { p[j] = f32x16{}; const int row = wid * 32 + j * 32 + r32;
#pragma unroll
        for (int d0 = 0; d0 < 4; ++d0) { const bf16x8 kf = *reinterpret_cast<const bf16x8*>(K_lds + KSWZD(row, (d0 * 16 + hi * 8) * 2)); p[j] = __builtin_amdgcn_mfma_f32_32x32x16_bf16(kf, qr[d0], p[j], 0, 0, 0); } }
    const float NEG = -1e30f;
    const int klo = 64 - 256 * lb, khi = L + 64 - 256 * lb;
    { const int t0 = max(r32, klo - wid * 32) - 4 * hi, t1 = klo - wid * 32 - 32 - 4 * hi, t3 = khi - wid * 32 - 96 - 4 * hi, t4 = min(r32 + 1, khi - wid * 32 - 128) - 4 * hi;
#pragma unroll
      for (int r = 0; r < 16; ++r) { const int c = (r & 3) + 8 * (r >> 2);
          if (c < t0) p[0][r] = NEG; if (c < t1) p[1][r] = NEG; if (c >= t3) p[3][r] = NEG; if (c >= t4) p[4][r] = NEG; } }
    float mx = rowmax32(p[0], p[1]); mx = fmaxf(mx, rowmax32(p[2], p[3]));
    { float m4 = p[4][0];
#pragma unroll
      for (int r = 1; r < 16; ++r) m4 = fmaxf(m4, p[4][r]);
      auto rr = __builtin_amdgcn_permlane32_swap(__float_as_uint(m4), __float_as_uint(m4), false, false); mx = fmaxf(mx, fmaxf(__uint_as_float(rr[0]), __uint_as_float(rr[1]))); }
    float ps = 0.f;
#pragma unroll
    for (int j = 0; j < 5; ++j)
#pragma unroll
        for (int r = 0; r < 16; ++r) { p[j][r] = __builtin_amdgcn_exp2f(p[j][r] - mx); ps += p[j][r]; }
    { auto rr = __builtin_amdgcn_permlane32_swap(__float_as_uint(ps), __float_as_uint(ps), false, false); ps = __uint_as_float(rr[0]) + __uint_as_float(rr[1]); }
    bf16x8 pa[5][2];
#pragma unroll
    for (int j = 0; j < 5; ++j) { PK4(p[j], 0, pa[j][0]); PK4(p[j], 8, pa[j][1]); }
    f32x16 o[2] = {};
    const int vb = (int)(uintptr_t)V_lds + v_rd_base(lane) + wid * 4096;
    pv_half<0, 0 * 4096>(o[0], vb, pa[0][0], pa[0][1]); pv_half<1, 0 * 4096>(o[1], vb, pa[0][0], pa[0][1]);
    pv_half<0, 1 * 4096>(o[0], vb, pa[1][0], pa[1][1]); pv_half<1, 1 * 4096>(o[1], vb, pa[1][0], pa[1][1]);
    pv_half<0, 2 * 4096>(o[0], vb, pa[2][0], pa[2][1]); pv_half<1, 2 * 4096>(o[1], vb, pa[2][0], pa[2][1]);
    pv_half<0, 3 * 4096>(o[0], vb, pa[3][0], pa[3][1]); pv_half<1, 3 * 4096>(o[1], vb, pa[3][0], pa[3][1]);
    pv_half<0, 4 * 4096>(o[0], vb, pa[4][0], pa[4][1]); pv_half<1, 4 * 4096>(o[1], vb, pa[4][0], pa[4][1]);
    float* wsf = (float*)(lds + DL_WS) + wid * 64;
    if (hi == 0) { wsf[r32] = ps; LSE[((size_t)br * T + (size_t)b * S + qpos) * 8 + h] = mx + __builtin_amdgcn_logf(ps); }
    asm volatile("s_waitcnt lgkmcnt(0)" ::: "memory");
    float rli[16];
#pragma unroll
    for (int r = 0; r < 16; ++r) rli[r] = __builtin_amdgcn_rcpf(wsf[crow(r, hi)]);
    unsigned short* stg = (unsigned short*)(lds + DL_OST) + wid * 2048;
    unsigned short* dst = OBR + ((size_t)br * T + (size_t)b * S + (((size_t)(256 * lb + wid * 32)) << sh) + res) * 512 + h * 64;
    store_o_tile(o, rli, stg, dst, [sh](int row) { return ((size_t)row << sh) * 512; }, lane);
    asm volatile("s_waitcnt vmcnt(0)" ::: "memory");
    __syncthreads();
}
#define DIL_DECODE(u, bh_, br_, res_, lb_, sh_, L_) const int bh_ = (u) / 96, br_ = ((u) >> 5) % 3, blk__##bh_ = (u) & 31, sh_ = 2 * br_, L_ = S >> sh_, nbl__##bh_ = L_ >> 8, res_ = blk__##bh_ / nbl__##bh_, lb_ = blk__##bh_ % nbl__##bh_
__device__ __forceinline__ void dil_phase(int u0, int ustep, int nunits, const unsigned short* __restrict__ DQ, const unsigned short* __restrict__ DK, const unsigned short* __restrict__ DV,
                                          unsigned short* __restrict__ OBR, float* __restrict__ LSE, char* lds) {
    const int tid = threadIdx.x, wid = tid >> 6, lane = tid & 63, r32 = lane & 31, hi = lane >> 5;
    char* K_lds = lds + DL_K; char* V_lds = lds + DL_V;
    bf16x8 kk[6], qn[4]; unsigned kmask = 0u;
#define DIL_LOAD6(dst, mask, SRC, u) do { DIL_DECODE(u, bh_, br_, res_, lb_, sh_, L_); const size_t bhS_ = (size_t)bh_ * S; mask = 0u; \
        _Pragma("unroll") for (int it = 0; it < 6; ++it) { const int item = it * 512 + tid, row = item >> 3, ch = item & 7; const int l = 256 * lb_ - 64 + row; const bool valid = (l >= 0) && (l < L_); \
            const size_t src = (bhS_ + (valid ? ((size_t)l << sh_) + res_ : 0)) * 64 + ch * 8; dst[it] = *reinterpret_cast<const bf16x8*>(SRC + src); mask |= (valid ? 1u : 0u) << it; } } while (0)
#define DIL_LOADQ(u) do { DIL_DECODE(u, bh_, br_, res_, lb_, sh_, L_); const size_t qpos_ = ((size_t)(256 * lb_ + wid * 32 + r32) << sh_) + res_; const unsigned short* Qw_ = DQ + ((size_t)bh_ * S + qpos_) * 64 + hi * 8; \
        _Pragma("unroll") for (int d0 = 0; d0 < 4; ++d0) qn[d0] = *reinterpret_cast<const bf16x8*>(Qw_ + d0 * 16); } while (0)
    int u = u0;
    if (u < nunits) { DIL_LOAD6(kk, kmask, DK, u); DIL_LOADQ(u); }
    for (; u < nunits; u += ustep) {
        DIL_DECODE(u, bh, br, res, lb, sh, L); const int b = bh >> 3, h = bh & 7;
#pragma unroll
        for (int it = 0; it < 6; ++it) { const int item = it * 512 + tid, row = item >> 3, ch = item & 7; *(bf16x8*)(K_lds + KSWZD(row, ch * 16)) = ((kmask >> it) & 1u) ? kk[it] : bf16x8{}; }
        bf16x8 qr[4];
#pragma unroll
        for (int d0 = 0; d0 < 4; ++d0) qr[d0] = qn[d0];
        bf16x8 vv[6]; unsigned vmask; DIL_LOAD6(vv, vmask, DV, u);
        __syncthreads();
        const int ql = wid * 32 + r32; const size_t qpos = ((size_t)(256 * lb + ql) << sh) + res;
        f32x16 p[5];
#pragma unroll
        for (int j = 0; j < 5; ++j) { p[j] = f32x16{}; const int row = wid * 32 + j * 32 + r32;
#pragma unroll
            for (int d0 = 0; d0 < 4; ++d0) { const bf16x8 kf = *reinterpret_cast<const bf16x8*>(K_lds + KSWZD(row, (d0 * 16 + hi * 8) * 2)); p[j] = __builtin_amdgcn_mfma_f32_32x32x16_bf16(kf, qr[d0], p[j], 0, 0, 0); } }
        const float NEG = -1e30f;
        const int klo = 64 - 256 * lb, khi = L + 64 - 256 * lb;
        { const int t0 = max(r32, klo - wid * 32) - 4 * hi, t1 = klo - wid * 32 - 32 - 4 * hi, t3 = khi - wid * 32 - 96 - 4 * hi, t4 = min(r32 + 1, khi - wid * 32 - 128) - 4 * hi;
#pragma unroll
          for (int r = 0; r < 16; ++r) { const int c = (r & 3) + 8 * (r >> 2);
              if (c < t0) p[0][r] = NEG; if (c < t1) p[1][r] = NEG; if (c >= t3) p[3][r] = NEG; if (c >= t4) p[4][r] = NEG; } }
        float mx = rowmax32(p[0], p[1]); mx = fmaxf(mx, rowmax32(p[2], p[3]));
        { float m4 = p[4][0];
#pragma unroll
          for (int r = 1; r < 16; ++r) m4 = fmaxf(m4, p[4][r]);
          auto rr = __builtin_amdgcn_permlane32_swap(__float_as_uint(m4), __float_as_uint(m4), false, false); mx = fmaxf(mx, fmaxf(__uint_as_float(rr[0]), __uint_as_float(rr[1]))); }
        float ps = 0.f;
#pragma unroll
        for (int j = 0; j < 5; ++j)
#pragma unroll
            for (int r = 0; r < 16; ++r) { p[j][r] = __builtin_amdgcn_exp2f(p[j][r] - mx); ps += p[j][r]; }
        { auto rr = __builtin_amdgcn_permlane32_swap(__float_as_uint(ps), __float_as_uint(ps), false, false); ps = __uint_as_float(rr[0]) + __uint_as_float(rr[1]); }
        bf16x8 pa[5][2];
#pragma unroll
        for (int j = 0; j < 5; ++j) { PK4(p[j], 0, pa[j][0]); PK4(p[j], 8, pa[j][1]); }
#pragma unroll
        for (int it = 0; it < 6; ++it) { const int item = it * 512 + tid, row = item >> 3, ch = item & 7; *(bf16x8*)(V_lds + (row >> 4) * 2048 + v_st(row & 15, ch * 8)) = ((vmask >> it) & 1u) ? vv[it] : bf16x8{}; }
        __syncthreads();
        if (u + ustep < nunits) { DIL_LOAD6(kk, kmask, DK, u + ustep); DIL_LOADQ(u + ustep); }
        f32x16 o[2] = {};
        const int vb = (int)(uintptr_t)V_lds + v_rd_base(lane) + wid * 4096;
        pv_half<0, 0 * 4096>(o[0], vb, pa[0][0], pa[0][1]); pv_half<1, 0 * 4096>(o[1], vb, pa[0][0], pa[0][1]);
        pv_half<0, 1 * 4096>(o[0], vb, pa[1][0], pa[1][1]); pv_half<1, 1 * 4096>(o[1], vb, pa[1][0], pa[1][1]);
        pv_half<0, 2 * 4096>(o[0], vb, pa[2][0], pa[2][1]); pv_half<1, 2 * 4096>(o[1], vb, pa[2][0], pa[2][1]);
        pv_half<0, 3 * 4096>(o[0], vb, pa[3][0], pa[3][1]); pv_half<1, 3 * 4096>(o[1], vb, pa[3][0], pa[3][1]);
        pv_half<0, 4 * 4096>(o[0], vb, pa[4][0], pa[4][1]); pv_half<1, 4 * 4096>(o[1], vb, pa[4][0], pa[4][1]);
        float* wsf = (float*)(lds + DL_WS) + wid * 64;
        if (hi == 0) { wsf[r32] = ps; LSE[((size_t)br * T + (size_t)b * S + qpos) * 8 + h] = mx + __builtin_amdgcn_logf(ps); }
        asm volatile("s_waitcnt lgkmcnt(0)" ::: "memory");
        float rli[16];
#pragma unroll
        for (int r = 0; r < 16; ++r) rli[r] = __builtin_amdgcn_rcpf(wsf[crow(r, hi)]);
        unsigned short* stg = (unsigned short*)(lds + DL_OST) + wid * 2048;
        unsigned short* dst = OBR + ((size_t)br * T + (size_t)b * S + (((size_t)(256 * lb + wid * 32)) << sh) + res) * 512 + h * 64;
        store_o_tile(o, rli, stg, dst, [sh](int row) { return ((size_t)row << sh) * 512; }, lane);
        __syncthreads();
    }
#undef DIL_LOAD6
#undef DIL_LOADQ
}
__device__ __forceinline__ void dil_combine(const unsigned short* __restrict__ OBR, const float* __restrict__ LSE, unsigned short* __restrict__ CAT, int gtid, int gthreads) {
    for (int i = gtid; i < T * 64; i += gthreads) { const int t = i >> 6, c8 = i & 63, h = c8 >> 3;
        const float l0 = LSE[((size_t)0 * T + t) * 8 + h], l1 = LSE[((size_t)1 * T + t) * 8 + h], l2 = LSE[((size_t)2 * T + t) * 8 + h];
        const float mx = fmaxf(l0, fmaxf(l1, l2)); float w0 = __builtin_amdgcn_exp2f(l0 - mx), w1 = __builtin_amdgcn_exp2f(l1 - mx), w2 = __builtin_amdgcn_exp2f(l2 - mx);
        const float inv = 1.f / (w0 + w1 + w2); w0 *= inv; w1 *= inv; w2 *= inv;
        const u32x4 a = *(const u32x4*)(OBR + ((size_t)0 * T + t) * 512 + c8 * 8), bb = *(const u32x4*)(OBR + ((size_t)1 * T + t) * 512 + c8 * 8), cc = *(const u32x4*)(OBR + ((size_t)2 * T + t) * 512 + c8 * 8);
        u32x4 o;
#pragma unroll
        for (int k = 0; k < 4; ++k) { const float lo = w0 * __uint_as_float(a[k] << 16) + w1 * __uint_as_float(bb[k] << 16) + w2 * __uint_as_float(cc[k] << 16);
            const float hi = w0 * __uint_as_float(a[k] & 0xffff0000u) + w1 * __uint_as_float(bb[k] & 0xffff0000u) + w2 * __uint_as_float(cc[k] & 0xffff0000u); o[k] = cvtpk(lo, hi); }
        *(u32x4*)(CAT + (size_t)t * 1024 + 512 + c8 * 8) = o; }
}
#undef SBAR
}
namespace mk {
struct SchedP4 {
    __device__ __forceinline__ void a_ready(const gm::Unit&, int) const {}
    __device__ __forceinline__ void done(const gm::Unit&, int) const {}
    static constexpr bool GATHER = false;
    const char* A; const char* Bt; int G, c;
    __device__ __forceinline__ bool next(int i, gm::Unit& u) const { int pm, pn; if (!static_tile(i, G, c, 64, 4, pm, pn)) return false;
        u.A = A; u.Bt = Bt; u.gidx = nullptr; u.lda2 = 2048; u.ldb2 = 2048; u.arow0 = pm * 256; u.brow0 = pn * 256; u.nt = 16; u.pm = pm; u.pn = pn; u.aux = 0; return true; }
};
struct EpiP4 {
    static constexpr bool PERM = false;
    const float* x; float* out; const float* modf;
    __device__ __forceinline__ void operator()(EPI_ARGS) const {
        const int b = (u.pm * 256) >> 13; const float* gt = modf + b * 6144 + 2048;
        const int col0 = u.pn * 256 + wc * 32 + 4 * fq;
        f32x4 g[2][2];
#pragma unroll
        for (int bj = 0; bj < 2; ++bj)
#pragma unroll
            for (int n = 0; n < 2; ++n) g[bj][n] = *(const f32x4*)(gt + col0 + bj * 128 + n * 16);
#pragma unroll
        for (int ai = 0; ai < 2; ++ai)
#pragma unroll
            for (int m = 0; m < 4; ++m) { const size_t off = (size_t)(u.pm * 256 + ai * 128 + wr * 64 + m * 16 + fr) * D + col0;
#pragma unroll
                for (int bj = 0; bj < 2; ++bj)
#pragma unroll
                    for (int n = 0; n < 2; ++n) { const f32x4 xv = *(const f32x4*)(x + off + bj * 128 + n * 16); *(f32x4*)(out + off + bj * 128 + n * 16) = xv + g[bj][n] * acc[ai][bj][m][n]; } }
    }
};
__device__ __forceinline__ void p4b_rows(Frame& F) {
    LAS float* WR = (LAS float*)F.lds;
    LAS float* A1 = WR + 16384;
    LAS float* A0 = A1 + 2048;
    const float* modf = (const float*)(F.ws + WS_MODF);
    for (int i = F.tid; i < 16384; i += NTHREADS) { const int j = i >> 4, e = i & 15; WR[e * 1024 + j] = F.w_router[i]; }
    for (int i = F.tid; i < 2048; i += NTHREADS) { const int b = i >> 10, j = i & 1023; A1[i] = F.g_ffn[j] * (1.f + modf[b * 6144 + 4096 + j]); A0[i] = modf[b * 6144 + 3072 + j]; }
    __syncthreads();
    const int gw = F.vcu * NWAVES + F.wave, NGW = F.G * NWAVES, lane = fresh_lane();
    for (int m = gw; m < T; m += NGW) { const int b = m >> 13, s = m & 8191;
        const f32x4* xr = (const f32x4*)(F.out + (size_t)m * D) + lane; f32x4 v[4]; float ss = 0.f;
#pragma unroll
        for (int j = 0; j < 4; ++j) { v[j] = xr[64 * j]; ss += (v[j].x * v[j].x + v[j].y * v[j].y) + (v[j].z * v[j].z + v[j].w * v[j].w); }
        const float rstd = rsqrtf(wave_sum(ss) * (1.f / D) + EPS);
        unsigned long long* o8 = (unsigned long long*)((bf16_t*)(F.ws + WS_HB) + (size_t)m * D) + lane;
        float lg[16];
#pragma unroll
        for (int e = 0; e < 16; ++e) lg[e] = 0.f;
#pragma unroll
        for (int j = 0; j < 4; ++j) { asm volatile("" ::: "memory");
            const f32x4 a1 = *(const LAS f32x4*)(A1 + b * 1024 + 4 * lane + 256 * j), a0 = *(const LAS f32x4*)(A0 + b * 1024 + 4 * lane + 256 * j);
            const f32x4 o = v[j] * rstd * a1 + a0; o8[64 * j] = (unsigned long long)pk2(o.x, o.y) | ((unsigned long long)pk2(o.z, o.w) << 32);
#pragma unroll
            for (int e = 0; e < 16; ++e) { const f32x4 w = *(const LAS f32x4*)(WR + e * 1024 + 4 * lane + 256 * j); lg[e] += (o.x * w.x + o.y * w.y) + (o.z * w.z + o.w * w.w); } }
        float w8[8], w4[4], w2[2], w1;
        { const bool up = lane & 32;
#pragma unroll
          for (int i = 0; i < 8; ++i) { const float snd = up ? lg[i] : lg[8 + i], kp = up ? lg[8 + i] : lg[i]; w8[i] = kp + __shfl_xor(snd, 32); } }
        { const bool up = lane & 16;
#pragma unroll
          for (int i = 0; i < 4; ++i) { const float snd = up ? w8[i] : w8[4 + i], kp = up ? w8[4 + i] : w8[i]; w4[i] = kp + __shfl_xor(snd, 16); } }
        { const bool up = lane & 8;
#pragma unroll
          for (int i = 0; i < 2; ++i) { const float snd = up ? w4[i] : w4[2 + i], kp = up ? w4[2 + i] : w4[i]; w2[i] = kp + __shfl_xor(snd, 8); } }
        { const bool up = lane & 4; const float snd = up ? w2[0] : w2[1], kp = up ? w2[1] : w2[0]; w1 = kp + __shfl_xor(snd, 4); }
        w1 += __shfl_xor(w1, 1); w1 += __shfl_xor(w1, 2);
        const int e = lane >> 2; const float logit = w1 + F.b_router[e];
        float mx = logit;
#pragma unroll
        for (int o = 4; o < 64; o <<= 1) mx = fmaxf(mx, __shfl_xor(mx, o));
        const float ex = __expf(logit - mx); float den = ex;
#pragma unroll
        for (int o = 4; o < 64; o <<= 1) den += __shfl_xor(den, o);
        if ((lane & 3) == 0) ((float*)(F.ws + WS_AFF))[((size_t)b * 16 + e) * S + s] = ex / den;
    }
    __syncthreads();
}
__device__ __forceinline__ void p5_topk(Frame& F) {
    if (F.vcu >= 32) { if (WD_IN_P5 && F.G > 32) wd_convert(F, 32); return; }
    const int be = F.vcu, b = be >> 4, e = be & 15, tid = F.tid;
    LAS unsigned* vals = (LAS unsigned*)F.lds;
    LAS unsigned* hist = vals + 8192;
    LAS unsigned* suf = hist + 256;
    LAS unsigned* misc = suf + 264;
    LAS unsigned* wtot = misc + 8;
    const float* a = (const float*)(F.ws + WS_AFF) + (size_t)be * S;
    for (int i = tid; i < 8192; i += NTHREADS) vals[i] = __float_as_uint(a[i]);
    if (tid == 0) { misc[0] = 0u; misc[1] = 1024u; }
    __syncthreads();
    for (int pass = 0; pass < 4; ++pass) {
        const int sh = 24 - 8 * pass; const unsigned prefix = misc[0], k = misc[1]; const unsigned himask = pass == 0 ? 0u : (0xffffffffu << (sh + 8));
        if (tid < 256) hist[tid] = 0u;
        __syncthreads();
        for (int i = tid; i < 8192; i += NTHREADS) { const unsigned v = vals[i]; if ((v & himask) == prefix) __hip_atomic_fetch_add(&hist[(v >> sh) & 255u], 1u, __ATOMIC_RELAXED, __HIP_MEMORY_SCOPE_WORKGROUP); }
        __syncthreads();
        if (tid < 256) suf[tid] = hist[tid]; if (tid == 0) suf[256] = 0u;
        __syncthreads();
        for (int o = 1; o < 256; o <<= 1) { unsigned t = 0u; if (tid < 256) t = suf[tid] + ((tid + o < 256) ? suf[tid + o] : 0u); __syncthreads(); if (tid < 256) suf[tid] = t; __syncthreads(); }
        if (tid < 256) { const unsigned sge = suf[tid], sgt = (tid < 255) ? suf[tid + 1] : 0u; if (sge >= k && sgt < k) { misc[0] = prefix | ((unsigned)tid << sh); misc[1] = k - sgt; } }
        __syncthreads();
    }
    const unsigned thr = misc[0], need = misc[1];
    unsigned gtc = 0, eqc = 0;
#pragma unroll
    for (int i = 0; i < 16; ++i) { const unsigned v = vals[tid * 16 + i]; gtc += v > thr; eqc += v == thr; }
    unsigned gi = gtc, ei = eqc; const int lane = fresh_lane(), wv = F.wave;
#pragma unroll
    for (int o = 1; o < 64; o <<= 1) { const unsigned g2 = __shfl_up(gi, o), e2 = __shfl_up(ei, o); if (lane >= o) { gi += g2; ei += e2; } }
    if (lane == 63) { wtot[wv] = gi; wtot[8 + wv] = ei; }
    __syncthreads();
    unsigned gbase = 0, ebase = 0, gtotal = 0;
    for (int w = 0; w < 8; ++w) { const unsigned g = wtot[w], q = wtot[8 + w]; if (w < wv) { gbase += g; ebase += q; } gtotal += g; }
    unsigned gpos = gbase + gi - gtc, epos = ebase + ei - eqc;
    int* IDX = (int*)(F.ws + WS_IDX) + (e * 2 + b) * 1024; float* GATE = (float*)(F.ws + WS_GATE) + (e * 2 + b) * 1024; int* SLOT = (int*)(F.ws + WS_SLOT);
#pragma unroll
    for (int i = 0; i < 16; ++i) { const int s = tid * 16 + i; const unsigned v = vals[s]; int c = -1;
        if (v > thr) c = (int)gpos++; else if (v == thr) { if (epos < need) c = (int)(gtotal + epos); ++epos; }
        if (c >= 0) { IDX[c] = b * S + s; GATE[c] = __uint_as_float(v); }
        SLOT[(size_t)(b * S + s) * 16 + e] = c >= 0 ? (e * 2 + b) * 1024 + c : -1; }
}
struct SchedP6a {
    __device__ __forceinline__ void a_ready(const gm::Unit&, int) const {}
    __device__ __forceinline__ void done(const gm::Unit&, int) const {}
    static constexpr bool GATHER = true;
    const char* A; const char* W; const int* idx; int G, vcu;
    __device__ __forceinline__ bool next(int i, gm::Unit& u) const {
        int e, pmu, pn;
        if (G == 256) { if (i >= 4) return false; const int xcd = vcu >> 5, j = vcu & 31; e = xcd + 8 * (i >> 1); const int sub = (i & 1) * 32 + j; pmu = sub >> 3; pn = sub & 7; }
        else { const int L = i * G + vcu; if (L >= 1024) return false; e = L >> 6; pmu = (L >> 3) & 7; pn = L & 7; }
        u.A = A; u.gidx = idx + e * 2048 + pmu * 256; u.lda2 = 2048; u.arow0 = 0; u.Bt = W + (size_t)e * 2048 * 2048; u.brow0 = pn * 256; u.ldb2 = 2048; u.nt = 16; u.pm = e * 8 + pmu; u.pn = pn; u.aux = e; return true; }
};
struct EpiP6a {
    static constexpr bool PERM = true;
    bf16_t* H;
    __device__ __forceinline__ void operator()(EPI_ARGS) const {
#pragma unroll
        for (int ai = 0; ai < 2; ++ai)
#pragma unroll
            for (int m = 0; m < 4; ++m) { const size_t row = (size_t)u.pm * 256 + ai * 128 + wr * 64 + m * 16 + fr;
                f32x4 h0, h1;
#pragma unroll
                for (int j = 0; j < 4; ++j) { h0[j] = siluf(acc[ai][0][m][0][j]) * acc[ai][1][m][0][j]; h1[j] = siluf(acc[ai][0][m][1][j]) * acc[ai][1][m][1][j]; }
                *(u32x4*)(H + row * 1024 + u.pn * 128 + wc * 32 + 8 * fq) = pack8(h0, h1); }
    }
};
struct SchedP6b {
    __device__ __forceinline__ void a_ready(const gm::Unit&, int) const {}
    __device__ __forceinline__ void done(const gm::Unit&, int) const {}
    static constexpr bool GATHER = false;
    const char* A; const char* W; int G, vcu;
    __device__ __forceinline__ bool next(int i, gm::Unit& u) const {
        int e, pmu, pn;
        if (G == 256) { if (i >= 2) return false; const int xcd = vcu >> 5, j = vcu & 31; e = xcd + 8 * i; pmu = j >> 2; pn = j & 3; }
        else { const int L = i * G + vcu; if (L >= 512) return false; e = L >> 5; pmu = (L >> 2) & 7; pn = L & 3; }
        u.A = A; u.gidx = nullptr; u.lda2 = 2048; u.arow0 = (e * 8 + pmu) * 256; u.Bt = W + (size_t)e * 1024 * 2048; u.brow0 = pn * 256; u.ldb2 = 2048; u.nt = 16; u.pm = e * 8 + pmu; u.pn = pn; u.aux = e; return true; }
};
struct EpiP6b {
    static constexpr bool PERM = true;
    bf16_t* Y; const float* gate;
    __device__ __forceinline__ void operator()(EPI_ARGS) const {
#pragma unroll
        for (int ai = 0; ai < 2; ++ai)
#pragma unroll
            for (int m = 0; m < 4; ++m) { const size_t row = (size_t)u.pm * 256 + ai * 128 + wr * 64 + m * 16 + fr; const float g = gate[row];
#pragma unroll
                for (int bj = 0; bj < 2; ++bj) *(u32x4*)(Y + row * 1024 + u.pn * 256 + bj * 128 + wc * 32 + 8 * fq) = pack8(acc[ai][bj][m][0] * g, acc[ai][bj][m][1] * g); }
    }
};
__device__ __forceinline__ void p7_final(Frame& F) {
    const float* modf = (const float*)(F.ws + WS_MODF); const int* SLOT = (const int*)(F.ws + WS_SLOT); const bf16_t* Y = (const bf16_t*)(F.ws + WS_Y);
    const int gw = F.vcu * NWAVES + F.wave, NGW = F.G * NWAVES, lane = fresh_lane();
    for (int m0 = gw; m0 < T; m0 += 2 * NGW) {
        const int m1 = m0 + NGW; const bool has1 = m1 < T; const int mm1 = has1 ? m1 : m0;
        f32x4* xr0 = (f32x4*)(F.out + (size_t)m0 * D) + lane; f32x4* xr1 = (f32x4*)(F.out + (size_t)mm1 * D) + lane; f32x4 v0[4], v1[4], a0[4], a1[4];
#pragma unroll
        for (int j = 0; j < 4; ++j) { v0[j] = xr0[64 * j]; v1[j] = xr1[64 * j]; a0[j] = (f32x4){0.f, 0.f, 0.f, 0.f}; a1[j] = (f32x4){0.f, 0.f, 0.f, 0.f}; }
        const int sl0 = lane < 16 ? SLOT[(size_t)m0 * 16 + lane] : -1, sl1 = lane < 16 ? SLOT[(size_t)mm1 * 16 + lane] : -1;
        for (int e = 0; e < 16; ++e) { const int s0 = __shfl(sl0, e), s1 = __shfl(sl1, e);
            if (s0 >= 0) { const u32x2* yr = (const u32x2*)(Y + (size_t)s0 * 1024) + lane;
#pragma unroll
                for (int j = 0; j < 4; ++j) { const u32x2 w = yr[64 * j]; a0[j].x += __uint_as_float(w.x << 16); a0[j].y += __uint_as_float(w.x & 0xffff0000u); a0[j].z += __uint_as_float(w.y << 16); a0[j].w += __uint_as_float(w.y & 0xffff0000u); } }
            if (s1 >= 0) { const u32x2* yr = (const u32x2*)(Y + (size_t)s1 * 1024) + lane;
#pragma unroll
                for (int j = 0; j < 4; ++j) { const u32x2 w = yr[64 * j]; a1[j].x += __uint_as_float(w.x << 16); a1[j].y += __uint_as_float(w.x & 0xffff0000u); a1[j].z += __uint_as_float(w.y << 16); a1[j].w += __uint_as_float(w.y & 0xffff0000u); } } }
        float ss0 = 0.f, ss1 = 0.f; const int b0 = m0 >> 13, b1 = mm1 >> 13;
#pragma unroll
        for (int j = 0; j < 4; ++j) { const f32x4 g0 = *(const f32x4*)(modf + b0 * 6144 + 5120 + 4 * lane + 256 * j), g1 = *(const f32x4*)(modf + b1 * 6144 + 5120 + 4 * lane + 256 * j);
            v0[j] = v0[j] + g0 * a0[j]; v1[j] = v1[j] + g1 * a1[j];
            ss0 += (v0[j].x * v0[j].x + v0[j].y * v0[j].y) + (v0[j].z * v0[j].z + v0[j].w * v0[j].w); ss1 += (v1[j].x * v1[j].x + v1[j].y * v1[j].y) + (v1[j].z * v1[j].z + v1[j].w * v1[j].w); }
        const float r0 = rsqrtf(wave_sum(ss0) * (1.f / D) + EPS), r1 = rsqrtf(wave_sum(ss1) * (1.f / D) + EPS);
#pragma unroll
        for (int j = 0; j < 4; ++j) { const f32x4 g = *(const f32x4*)(F.g_final + 4 * lane + 256 * j); xr0[64 * j] = v0[j] * r0 * g; if (has1) xr1[64 * j] = v1[j] * r1 * g; }
    }
}
}
#ifndef MLA_V4
#define MLA_V4 0
#endif
#ifndef MERGE_P12
#define MERGE_P12 1
#endif
#ifndef DIL_PIPE
#define DIL_PIPE 1
#endif
#ifndef MLA_UNIT
#define MLA_UNIT mla_unit_v2
#endif
namespace mk {
namespace cg = cooperative_groups;
__global__ void __launch_bounds__(NTHREADS, 2) mega(Args args) {
    extern __shared__ __attribute__((aligned(16))) unsigned char lds_raw[];
    cg::grid_group grid = cg::this_grid();
    Frame F;
    F.lds = (LAS unsigned char*)lds_raw; F.ws = args.ws; F.out = args.out;
    F.tid = threadIdx.x; F.lane = F.tid & 63; F.wave = __builtin_amdgcn_readfirstlane(F.tid >> 6);
    F.G = gridDim.x; { const int bx = blockIdx.x; F.vcu = (F.G % 8 == 0) ? (bx % 8) * (F.G / 8) + bx / 8 : bx; }
    F.x = (const float*)args.in[0]; F.c = (const float*)args.in[1]; F.pos = (const int*)args.in[2]; F.w_ada = (const float*)args.in[3]; F.b_ada = (const float*)args.in[4];
    F.g_mix = (const float*)args.in[5]; F.w_in = (const float*)args.in[6]; F.g_q = (const float*)args.in[7]; F.w_uq = (const float*)args.in[8]; F.g_kv = (const float*)args.in[9];
    F.w_ukv = (const float*)args.in[10]; F.w_out = (const float*)args.in[11]; F.g_ffn = (const float*)args.in[12]; F.w_router = (const float*)args.in[13]; F.b_router = (const float*)args.in[14];
    F.w_gate = (const float*)args.in[15]; F.w_up = (const float*)args.in[16]; F.w_down = (const float*)args.in[17]; F.g_final = (const float*)args.in[18];
    const int lo = args.ph_lo, hi = args.ph_hi;
    volatile LAS unsigned* MISC = (volatile LAS unsigned*)(F.lds + LDS_BYTES - 256);
    if (F.tid < 64) MISC[F.tid] = 0u;
    __syncthreads();
    XcdBarrier xbar = xcd_barrier_post((unsigned*)(F.ws + WS_CTL) + 1024 + args.li * 4096, MISC + 8);
#define IN(k) (lo <= (k) && (k) < hi)
#ifndef CG_SEAMS
#define CG_SEAMS 0x000
#endif
#define SEAM(k) do { if (IN(k) && IN((k) + 1)) { if ((CG_SEAMS >> (k)) & 1) grid.sync(); else xcd_barrier(xbar); } } while (0)
    if (IN(0)) { p0_prologue(F); } SEAM(0);
    if (IN(1)) { p0b_rows(F); } SEAM(1);
#if MERGE_P12
    if (IN(2)) { SchedP12 S{(const char*)(F.ws + WS_HB), (const char*)(F.ws + WS_WIN), (const char*)(F.ws + WS_CQ), (const char*)(F.ws + WS_WUQ), (const char*)(F.ws + WS_WUKV), (unsigned*)(F.ws + WS_PCNT), F.G, F.vcu, (int)blockIdx.x};
        EpiP12 E{F.ws}; gm::gemm_phase<EpiP12, SchedP12>(F.lds, S, E); } SEAM(3);
#else
    if (IN(2)) { SchedP1 S{(const char*)(F.ws + WS_HB), (const char*)(F.ws + WS_WIN), F.G, (int)blockIdx.x}; EpiP1 E{F.ws}; gm::gemm_phase<EpiP1, SchedP1>(F.lds, S, E); } SEAM(2);
    if (IN(3)) { SchedP2 S{(const char*)(F.ws + WS_CQ), (const char*)(F.ws + WS_WUQ), (const char*)(F.ws + WS_WUKV), F.G, (int)blockIdx.x}; EpiP2 E{F.ws}; gm::gemm_phase<EpiP2, SchedP2>(F.lds, S, E); } SEAM(3);
#endif
    if (IN(4)) {
        const unsigned short* DQ = (const unsigned short*)(F.ws + WS_DQ); const unsigned short* DK = (const unsigned short*)(F.ws + WS_DK); const unsigned short* DV = (const unsigned short*)(F.ws + WS_DV);
        unsigned short* OBR = (unsigned short*)F.out; float* LSE = (float*)(F.ws + WS_LSE);
        if (args.pad & 1) { if (DIL_PIPE) at::dil_phase(F.vcu, F.G, 1536, DQ, DK, DV, OBR, LSE, (char*)lds_raw); else for (int u = F.vcu; u < 1536; u += F.G) { const int blk = u & 31, br = (u >> 5) % 3, bh = u / 96; at::dil_unit(bh, br, blk, DQ, DK, DV, OBR, LSE, (char*)lds_raw); } }
        if (args.pad & 2) for (int u = F.vcu; u < 512; u += F.G) { const int bh = (u >> 8) * 8 + ((u & 255) >> 5), qb = u & 31;
            #if MLA_V4
            at::mla_unit_v4(bh, qb, (const unsigned short*)(F.ws + WS_Q), (const unsigned short*)(F.ws + WS_KN), (const unsigned short*)(F.ws + WS_KR), (const unsigned short*)(F.ws + WS_V), (unsigned short*)(F.ws + WS_HB), (const float*)(F.ws + WS_KMX), (char*)lds_raw); }
#else
            at::mla_unit_v2(bh, qb, (const unsigned short*)(F.ws + WS_Q), (const unsigned short*)(F.ws + WS_KN), (const unsigned short*)(F.ws + WS_KR), (const unsigned short*)(F.ws + WS_V), (unsigned short*)(F.ws + WS_HB), (const float*)(F.ws + WS_KMX), (char*)lds_raw); }
#endif
    } SEAM(4);
    if (IN(5)) { at::dil_combine((const unsigned short*)F.out, (const float*)(F.ws + WS_LSE), (unsigned short*)(F.ws + WS_HB), F.vcu * NTHREADS + F.tid, F.G * NTHREADS); } SEAM(5);
    if (IN(6)) { SchedP4 S{(const char*)(F.ws + WS_HB), (const char*)(F.ws + WS_WOUT), F.G, (int)blockIdx.x}; EpiP4 E{F.x, F.out, (const float*)(F.ws + WS_MODF)}; gm::gemm_phase<EpiP4, SchedP4>(F.lds, S, E); } SEAM(6);
    if (IN(7)) { p4b_rows(F); } SEAM(7);
    if (IN(8)) { p5_topk(F); } SEAM(8);
    if (IN(9)) { SchedP6a S{(const char*)(F.ws + WS_HB), (const char*)(F.ws + WS_WGU), (const int*)(F.ws + WS_IDX), F.G, F.vcu}; EpiP6a E{(bf16_t*)(F.ws + WS_HBUF)}; gm::gemm_phase<EpiP6a, SchedP6a>(F.lds, S, E); } SEAM(9);
    if (IN(10)) { SchedP6b S{(const char*)(F.ws + WS_HBUF), (const char*)(F.ws + WS_WD), F.G, F.vcu}; EpiP6b E{(bf16_t*)(F.ws + WS_Y), (const float*)(F.ws + WS_GATE)}; gm::gemm_phase<EpiP6b, SchedP6b>(F.lds, S, E); } SEAM(10);
    if (IN(11)) { p7_final(F); }
#undef IN
#undef SEAM
}
}
extern "C" void kernel_launch(void* const* d_in, const int* in_sizes, int n_in, void* d_out, int out_size, void* d_ws, size_t ws_size, hipStream_t stream) {
    using namespace mk;
    static int grid = 0;
    if (grid == 0) {
        if (n_in != 19 || out_size != T * D || in_sizes[0] != T * D || ws_size < WS_END) { fprintf(stderr, "kernel_launch: built for 19 inputs, x/out of %d floats and >= %zu bytes of workspace; got n_in %d out %d ws %zu; nothing launched\n", T * D, (size_t)WS_END, n_in, out_size, ws_size); grid = -1; return; }
        int dev = 0, cus = 0, per_cu = 0;
        if (hipGetDevice(&dev) != hipSuccess || hipDeviceGetAttribute(&cus, hipDeviceAttributeMultiprocessorCount, dev) != hipSuccess || cus < 32) { fprintf(stderr, "kernel_launch: device query failed\n"); grid = -1; return; }
        if (hipFuncSetAttribute((const void*)mega, hipFuncAttributeMaxDynamicSharedMemorySize, LDS_BYTES) != hipSuccess) { fprintf(stderr, "kernel_launch: hipFuncSetAttribute(%d B LDS) failed\n", LDS_BYTES); grid = -1; return; }
        if (hipOccupancyMaxActiveBlocksPerMultiprocessor(&per_cu, (const void*)mega, NTHREADS, LDS_BYTES) != hipSuccess || per_cu < 1) { fprintf(stderr, "kernel_launch: occupancy query reports %d workgroups per CU\n", per_cu); grid = -1; return; }
        grid = cus;
    }
    if (grid < 0) return;
    if (hipMemsetAsync((char*)d_ws + WS_CTL, 0, 64 * KiB, stream) != hipSuccess) { fprintf(stderr, "kernel_launch: memset failed\n"); return; }
    Args a{}; for (int i = 0; i < 19; ++i) a.in[i] = d_in[i]; a.out = (float*)d_out; a.ws = (unsigned char*)d_ws;
    a.pad = 3; a.ph_lo = 0; a.ph_hi = 12; a.li = 0;
    void* kargs[] = {&a};
    const hipError_t e = hipLaunchCooperativeKernel((const void*)mega, dim3(grid), dim3(NTHREADS), kargs, LDS_BYTES, stream);
    if (e != hipSuccess) fprintf(stderr, "kernel_launch: cooperative launch failed: %s (grid %d)\n", hipGetErrorString(e), grid);
}
```

```cpp
#include <hip/hip_runtime.h>
#include <hip/hip_cooperative_groups.h>
#include <hip/hip_bf16.h>
#include <cstdio>
#include <cstdint>
#include <cmath>
namespace gm {
#define LAS __attribute__((address_space(3)))
typedef unsigned short bf16_t;
typedef short bf16x8 __attribute__((ext_vector_type(8)));
typedef float f32x4 __attribute__((ext_vector_type(4)));
typedef float f32x2 __attribute__((ext_vector_type(2)));
typedef unsigned u32x4 __attribute__((ext_vector_type(4)));
typedef unsigned u32x2 __attribute__((ext_vector_type(2)));
constexpr int BM = 256, BK = 64, HALF = 128, HTB = HALF * BK * 2, STAGE_BYTES = 8 * HTB;

__device__ __forceinline__ int lds_byte(int r, int c) { const int st = (r >> 4) * 2 + (c >> 5), rr = r & 15, cc = c & 31, ob = rr * 64 + cc * 2; return st * 1024 + (ob ^ (((ob >> 9) & 1) << 5)); }
__device__ __forceinline__ void stage_rc(int b, int& R, int& C) { const int st = b / 1024, sb = b % 1024, swz = sb ^ (((sb >> 9) & 1) << 5); R = (st >> 1) * 16 + swz / 64; C = (st & 1) * 32 + (swz % 64) / 2; }
__device__ __forceinline__ int perm32(int rho) { const int n = rho >> 4, i = rho & 15; return 8 * (i >> 2) + 4 * n + (i & 3); }
__device__ __forceinline__ int lane_now() { int l; asm volatile("v_mbcnt_lo_u32_b32 %0, -1, 0\n\tv_mbcnt_hi_u32_b32 %0, -1, %0" : "=v"(l)); return l; }
__device__ __forceinline__ unsigned cvt_pk_bf16(float lo, float hi) { unsigned r; asm volatile("v_cvt_pk_bf16_f32 %0, %1, %2" : "=v"(r) : "v"(lo), "v"(hi)); return r; }

struct Unit {
    const char* A; const char* Bt; const int* gidx;
    unsigned lda2, ldb2;
    int arow0, brow0, nt;
    int pm, pn, aux;
};

template <class Epi, class Sched>
__device__ __forceinline__ void gemm_phase(LAS unsigned char* lds, const Sched& S, const Epi& E, int wave_sgpr) {
    constexpr bool GATHER = Sched::GATHER;
    const int wid = wave_sgpr, lane = lane_now(), tid = wid * 64 + lane, wr = wid >> 2, wc = wid & 3, fr = lane & 15, fq = lane >> 4;
    int sR[2], sC[2], sRb[2];
#pragma unroll
    for (int i = 0; i < 2; ++i) { int R, C; stage_rc(tid * 16 + i * 8192, R, C); sR[i] = R; sC[i] = C * 2; sRb[i] = Epi::PERM ? ((R & ~31) + perm32(R & 31)) : R; }
    const unsigned ldsw = (unsigned)wid * 1024u;
    const int aoff = lds_byte(wr * 64 + fr, fq * 8), boff = lds_byte(wc * 32 + fr, fq * 8);
#define GM_SA(b, h) (((b) * 2 + (h)) * HTB)
#define GM_SB(b, h) ((4 + (b) * 2 + (h)) * HTB)
#define GM_GLDS(src, dstoff) __builtin_amdgcn_global_load_lds((const unsigned*)(src), (LAS unsigned*)(lds + (dstoff)), 16, 0, 0)
#define GM_STAGE_B(bufoff, p, ld, h) do { _Pragma("unroll") for (int i_ = 0; i_ < 2; ++i_) \
        GM_GLDS((p) + ((unsigned)((h) * HALF + sRb[i_]) * (ld) + (unsigned)sC[i_]), (bufoff) + ldsw + i_ * 8192); } while (0)
#define GM_STAGE_A(bufoff, p, ld, h, g) do { _Pragma("unroll") for (int i_ = 0; i_ < 2; ++i_) { \
        const unsigned o_ = GATHER ? (g)[h][i_] + (unsigned)sC[i_] : (unsigned)((h) * HALF + sR[i_]) * (ld) + (unsigned)sC[i_]; \
        GM_GLDS((p) + o_, (bufoff) + ldsw + i_ * 8192); } } while (0)
#define GM_LDA(dst, b, h) do { _Pragma("unroll") for (int m = 0; m < 4; ++m) _Pragma("unroll") for (int k = 0; k < 2; ++k) dst[m][k] = *(const LAS bf16x8*)(lds + GM_SA(b, h) + aoff + m * 2048 + k * 1024); } while (0)
#define GM_LDB(dst, b, h) do { _Pragma("unroll") for (int n = 0; n < 2; ++n) _Pragma("unroll") for (int k = 0; k < 2; ++k) dst[n][k] = *(const LAS bf16x8*)(lds + GM_SB(b, h) + boff + n * 2048 + k * 1024); } while (0)
#define GM_MMA(ai, bj, At, Bt) do { __builtin_amdgcn_s_setprio(1); _Pragma("unroll") for (int m = 0; m < 4; ++m) _Pragma("unroll") for (int n = 0; n < 2; ++n) _Pragma("unroll") for (int k = 0; k < 2; ++k) \
        acc[ai][bj][m][n] = __builtin_amdgcn_mfma_f32_16x16x32_bf16(Bt[n][k], At[m][k], acc[ai][bj][m][n], 0, 0, 0); __builtin_amdgcn_s_setprio(0); } while (0)
#define GM_WAIT_V(n) asm volatile("s_waitcnt vmcnt(" #n ")" ::: "memory")
#define GM_WAIT_L(n) asm volatile("s_waitcnt lgkmcnt(" #n ")" ::: "memory")
#define GM_BAR __builtin_amdgcn_s_barrier()
#define GM_SCHED __builtin_amdgcn_sched_barrier(0)
#define GM_GOFFS(u, g) do { if (GATHER) { _Pragma("unroll") for (int h_ = 0; h_ < 2; ++h_) _Pragma("unroll") for (int i_ = 0; i_ < 2; ++i_) g[h_][i_] = (unsigned)(u).gidx[h_ * HALF + sR[i_]] * (u).lda2; } } while (0)
#define GM_ABASE(u) ((u).A + (GATHER ? (size_t)0 : (size_t)(u).arow0 * (u).lda2))
#define GM_BBASE(u) ((u).Bt + (size_t)(u).brow0 * (u).ldb2)
    Unit cur, nxt; int ui = 0;
    if (!S.next(0, cur)) return;
    f32x4 acc[2][2][4][2];
#pragma unroll
    for (int a = 0; a < 2; ++a)
#pragma unroll
        for (int b = 0; b < 2; ++b)
#pragma unroll
            for (int m = 0; m < 4; ++m)
#pragma unroll
                for (int n = 0; n < 2; ++n) acc[a][b][m][n] = (f32x4){0.f, 0.f, 0.f, 0.f};
    bf16x8 At[4][2], B0[2][2], B1[2][2];
    unsigned gc[2][2] = {{0u, 0u}, {0u, 0u}}, gn[2][2] = {{0u, 0u}, {0u, 0u}};
    GM_GOFFS(cur, gc);
    const char* cA = GM_ABASE(cur); const char* cB = GM_BBASE(cur); unsigned cla = cur.lda2, clb = cur.ldb2;
    GM_STAGE_B(GM_SB(0, 0), cB, clb, 0); GM_STAGE_B(GM_SB(0, 1), cB, clb, 1); GM_STAGE_A(GM_SA(0, 0), cA, cla, 0, gc); GM_STAGE_A(GM_SA(0, 1), cA, cla, 1, gc);
    if (wr == 1) GM_BAR;
    GM_WAIT_V(2); GM_BAR;
    GM_STAGE_B(GM_SB(1, 0), cB + 128, clb, 0); GM_STAGE_A(GM_SA(1, 0), cA + 128, cla, 0, gc); GM_STAGE_B(GM_SB(1, 1), cB + 128, clb, 1);
    GM_WAIT_V(6); GM_BAR;
    for (;;) {
        const bool has_next = S.next(ui + 1, nxt);
        const char* nA = cA; const char* nB = cB; unsigned nla = cla, nlb = clb;
        if (has_next) { GM_GOFFS(nxt, gn); nA = GM_ABASE(nxt); nB = GM_BBASE(nxt); nla = nxt.lda2; nlb = nxt.ldb2; }
        else if (GATHER) {
#pragma unroll
            for (int h = 0; h < 2; ++h)
#pragma unroll
                for (int i = 0; i < 2; ++i) gn[h][i] = gc[h][i];
        }
        const int nt = cur.nt;
        for (int t = 0; t < nt; t += 2) {
            const bool last = (t == nt - 2);
            if (last && has_next) S.a_ready(nxt, wid);
            const char* a1 = cA + (size_t)(t + 1) * 128;
            const char* a2 = last ? nA : cA + (size_t)(t + 2) * 128; const char* b2 = last ? nB : cB + (size_t)(t + 2) * 128;
            const char* a3 = a2 + 128; const char* b3 = b2 + 128;
            const unsigned la2 = last ? nla : cla, lb2 = last ? nlb : clb;
            unsigned g2[2][2];
#pragma unroll
            for (int h = 0; h < 2; ++h)
#pragma unroll
                for (int i = 0; i < 2; ++i) g2[h][i] = GATHER ? (last ? gn[h][i] : gc[h][i]) : 0u;
            GM_LDB(B0, 0, 0); GM_LDB(B1, 0, 1); GM_SCHED; GM_LDA(At, 0, 0); GM_STAGE_A(GM_SA(1, 1), a1, cla, 1, gc);
            GM_WAIT_V(8); GM_WAIT_L(0); GM_BAR; GM_MMA(0, 0, At, B0); GM_MMA(0, 1, At, B1); GM_BAR; GM_SCHED;
            GM_LDA(At, 0, 1); GM_STAGE_B(GM_SB(0, 0), b2, lb2, 0); GM_STAGE_B(GM_SB(0, 1), b2, lb2, 1); GM_STAGE_A(GM_SA(0, 0), a2, la2, 0, g2);
            GM_WAIT_V(8); GM_WAIT_L(0); GM_BAR; GM_MMA(1, 0, At, B0); GM_MMA(1, 1, At, B1); GM_BAR; GM_SCHED;
            GM_LDB(B0, 1, 0); GM_LDB(B1, 1, 1); GM_SCHED; GM_LDA(At, 1, 0); GM_STAGE_A(GM_SA(0, 1), a2, la2, 1, g2);
            GM_WAIT_V(8); GM_WAIT_L(0); GM_BAR; GM_MMA(0, 0, At, B0); GM_MMA(0, 1, At, B1); GM_BAR; GM_SCHED;
            GM_LDA(At, 1, 1); GM_STAGE_B(GM_SB(1, 0), b3, lb2, 0); GM_STAGE_B(GM_SB(1, 1), b3, lb2, 1); GM_STAGE_A(GM_SA(1, 0), a3, la2, 0, g2);
            GM_WAIT_V(8); GM_WAIT_L(0); GM_BAR; GM_MMA(1, 0, At, B0); GM_MMA(1, 1, At, B1); GM_BAR; GM_SCHED;
        }
        if (wr == 0) GM_BAR;
        E(acc, cur, wr, wc, fr, fq, lane);
        S.done(cur, lane);
        if (!has_next) break;
#pragma unroll
        for (int a = 0; a < 2; ++a)
#pragma unroll
            for (int b = 0; b < 2; ++b)
#pragma unroll
                for (int m = 0; m < 4; ++m)
#pragma unroll
                    for (int n = 0; n < 2; ++n) acc[a][b][m][n] = (f32x4){0.f, 0.f, 0.f, 0.f};
        cur = nxt; cA = nA; cB = nB; cla = nla; clb = nlb; ++ui;
        if (GATHER) {
#pragma unroll
            for (int h = 0; h < 2; ++h)
#pragma unroll
                for (int i = 0; i < 2; ++i) gc[h][i] = gn[h][i];
        }
        if (wr == 1) GM_BAR;
    }
    GM_WAIT_V(0);
    GM_BAR;
#undef GM_SA
#undef GM_SB
#undef GM_GLDS
#undef GM_STAGE_A
#undef GM_STAGE_B
#undef GM_LDA
#undef GM_LDB
#undef GM_MMA
#undef GM_WAIT_V
#undef GM_WAIT_L
#undef GM_BAR
#undef GM_SCHED
#undef GM_GOFFS
#undef GM_ABASE
#undef GM_BBASE
}
}
namespace mk {
using gm::bf16_t; using gm::f32x4; using gm::f32x2; using gm::u32x4; using gm::u32x2; using gm::cvt_pk_bf16;
constexpr int T = 16384, S = 8192, D = 1024, NB = 2, NH = 8, NWAVES = 8, NTHREADS = 512;
constexpr float EPS = 1e-6f;
constexpr size_t KiB = 1024, MiB = 1u << 20;
constexpr size_t WS_CTL = 0;
constexpr size_t WS_KMX = 48 * KiB;
constexpr size_t WS_MODP = 1 * MiB;
constexpr size_t WS_MODF = 2 * MiB;
constexpr size_t WS_TABM = WS_MODF + 64 * KiB;
constexpr size_t WS_TABD = WS_TABM + 2 * MiB;
constexpr size_t WS_SSQ = WS_TABD + 1 * MiB;
constexpr size_t WS_KR = WS_SSQ + 1536 * KiB;
constexpr size_t WS_AFF = WS_KR + 1 * MiB;
constexpr size_t WS_IDX = WS_AFF + 1 * MiB;
constexpr size_t WS_GATE = WS_IDX + 128 * KiB;
constexpr size_t WS_SLOT = WS_GATE + 128 * KiB;
constexpr size_t WS_LSE = WS_SLOT + 1 * MiB;
constexpr size_t WS_WUQ = WS_LSE + 1536 * KiB;
constexpr size_t WS_WUKV = WS_WUQ + 576 * KiB;
constexpr size_t WS_WOUT = WS_WUKV + 512 * KiB;
constexpr size_t WS_WIN = WS_WOUT + 2 * MiB;
constexpr size_t WS_R0END = WS_WIN + 4608 * KiB;
static_assert(WS_R0END <= 20 * MiB, "R0");
constexpr size_t WS_HB = 20 * MiB;
constexpr size_t WS_CQ = 52 * MiB;
constexpr size_t WS_DQ = WS_CQ + 24 * MiB, WS_DK = WS_DQ + 16 * MiB, WS_DV = WS_DK + 16 * MiB;
constexpr size_t WS_Q = WS_DV + 16 * MiB;
constexpr size_t WS_KN = WS_Q + 24 * MiB, WS_V = WS_KN + 16 * MiB;
constexpr size_t WS_HBUF = WS_CQ;
constexpr size_t WS_WGU = 180 * MiB;
constexpr size_t WS_Y = WS_WGU;
constexpr size_t WS_WD = 244 * MiB;
constexpr size_t WS_END = 276 * MiB;
static_assert(WS_V + 16 * MiB == 180 * MiB, "arena");
constexpr int LDS_BYTES = 147456;

__device__ __forceinline__ float wave_sum(float v) {
#pragma unroll
    for (int o = 1; o < 64; o <<= 1) v += __shfl_xor(v, o);
    return v;
}
__device__ __forceinline__ unsigned f2bf(float f) { unsigned u = __builtin_bit_cast(unsigned, f); return (u + 0x7fffu + ((u >> 16) & 1u)) >> 16; }
__device__ __forceinline__ unsigned pk2(float lo, float hi) { return f2bf(lo) | (f2bf(hi) << 16); }
__device__ __forceinline__ float bf2f(unsigned short b) { return __builtin_bit_cast(float, (unsigned)b << 16); }
__device__ __forceinline__ float siluf(float v) { return v / (1.f + __expf(-v)); }
#define LDS_WAIT() asm volatile("s_waitcnt lgkmcnt(0)" ::: "memory")
__device__ __forceinline__ int fresh_lane() { return gm::lane_now(); }

struct Args { const void* in[19]; float* out; unsigned char* ws; int ph_lo, ph_hi, li, pad; };
struct Frame {
    LAS unsigned char* lds; unsigned char* ws; float* out;
    int wave, vcu, G;
    const float *x, *c; const int* pos; const float *w_ada, *b_ada, *g_mix, *w_in, *g_q, *w_uq, *g_kv, *w_ukv, *w_out, *g_ffn, *w_router, *b_router, *w_gate, *w_up, *w_down, *g_final;
};

__device__ __forceinline__ float inv_freq_m(int i) { return (float)exp2(-(double)i * (18.931568569324174 / 16.0)); }
__device__ __forceinline__ float inv_freq_d(int i) { return (float)exp2(-(double)i * (18.931568569324174 / 8.0)); }

#ifndef WD_IN_P5
#define WD_IN_P5 1
#endif
__device__ __forceinline__ void p0_transpose_item(const float* W, int ldw, int K, int k0, int n0, bf16_t* WT, int drow, const float* kscale, LAS float* scr, int lane) {
    f32x4 v[8];
#pragma unroll
    for (int i = 0; i < 8; ++i) v[i] = *(const f32x4*)(W + (size_t)(k0 + 8 * i + (lane >> 3)) * ldw + n0 + 4 * (lane & 7));
#pragma unroll
    for (int i = 0; i < 8; ++i) { const int kk = 8 * i + (lane >> 3); f32x4 x = v[i]; if (kscale) x = x * kscale[k0 + kk]; LAS float* d = scr + kk * 33 + 4 * (lane & 7); d[0] = x.x; d[1] = x.y; d[2] = x.z; d[3] = x.w; }
    LDS_WAIT(); asm volatile("" ::: "memory");
    const int c = lane & 7;
#pragma unroll
    for (int j = 0; j < 4; ++j) { const int n = (lane >> 3) + 8 * j; const LAS float* s = scr + (8 * c) * 33 + n;
        u32x4 o; o.x = pk2(s[0 * 33], s[1 * 33]); o.y = pk2(s[2 * 33], s[3 * 33]); o.z = pk2(s[4 * 33], s[5 * 33]); o.w = pk2(s[6 * 33], s[7 * 33]);
        *(u32x4*)(WT + (size_t)(drow + n) * K + k0 + 8 * c) = o; }
    LDS_WAIT(); asm volatile("" ::: "memory");
}
__device__ __forceinline__ void p0_prologue(Frame& F) {
    LAS float* scr = (LAS float*)(F.lds + F.wave * 16384);
    const int gw = F.vcu * NWAVES + F.wave, NGW = F.G * NWAVES, lane = fresh_lane();
    unsigned char* ws = F.ws;
    constexpr int I_MOD = 24 * 16, I_IN = 16 * 69, I_UQ = 6 * 24, I_UKV = 4 * 32, I_OUT = 16 * 32, I_EXP = 16 * 16 * 32, I_PAD = 96, I_TAB = T * 24 / 64;
    constexpr int NITEMS = I_MOD + I_IN + I_UQ + I_UKV + I_OUT + (WD_IN_P5 ? 2 : 3) * I_EXP + I_PAD + I_TAB;
    for (int it = gw; it < NITEMS; it += NGW) {
        int r = it;
        if (r < I_MOD) {
            const int cc = r % 24, kc = r / 24; f32x4 a0 = {0.f, 0.f, 0.f, 0.f}, a1 = {0.f, 0.f, 0.f, 0.f};
            const float* wp = F.w_ada + (size_t)(kc * 64) * 6144 + cc * 256 + 4 * lane;
#pragma unroll 8
            for (int k = 0; k < 64; ++k) { const f32x4 w = *(const f32x4*)(wp + (size_t)k * 6144); const float s0 = siluf(F.c[kc * 64 + k]), s1 = siluf(F.c[1024 + kc * 64 + k]); a0 += w * s0; a1 += w * s1; }
            float* mp = (float*)(ws + WS_MODP) + (size_t)kc * 2 * 6144 + cc * 256 + 4 * lane;
            *(f32x4*)mp = a0; *(f32x4*)(mp + 6144) = a1; continue; }
        r -= I_MOD;
        if (r < I_IN) { const int kb = r / 69, nb = r % 69, n0 = nb * 32; p0_transpose_item(F.w_in, 2208, 1024, kb * 64, n0, (bf16_t*)(ws + WS_WIN), n0 < 672 ? n0 : n0 + 96, nullptr, scr, lane); continue; }
        r -= I_IN;
        if (r < I_UQ) { const int kb = r / 24, nb = r % 24, n0 = nb * 32, h = n0 / 96, d = n0 % 96; p0_transpose_item(F.w_uq, 768, 384, kb * 64, n0, (bf16_t*)(ws + WS_WUQ), d < 64 ? h * 64 + d : 512 + h * 32, F.g_q, scr, lane); continue; }
        r -= I_UQ;
        if (r < I_UKV) { const int kb = r / 32, nb = r % 32, n0 = nb * 32, h = n0 / 128, d = n0 % 128; p0_transpose_item(F.w_ukv, 1024, 256, kb * 64, n0, (bf16_t*)(ws + WS_WUKV), d < 64 ? h * 64 + d : 512 + h * 64 + (d - 64), F.g_kv, scr, lane); continue; }
        r -= I_UKV;
        if (r < I_OUT) { const int kb = r / 32, nb = r % 32; p0_transpose_item(F.w_out, 1024, 1024, kb * 64, nb * 32, (bf16_t*)(ws + WS_WOUT), nb * 32, nullptr, scr, lane); continue; }
        r -= I_OUT;
        if (r < 2 * I_EXP) { const int up = r >= I_EXP; const int q = up ? r - I_EXP : r; const int e = q / 512, kb = (q % 512) / 32, nb = q % 32, n0 = nb * 32;
            p0_transpose_item((up ? F.w_up : F.w_gate) + (size_t)e * 1048576, 1024, 1024, kb * 64, n0, (bf16_t*)(ws + WS_WGU) + (size_t)e * 2048 * 1024, (n0 / 128) * 256 + up * 128 + (n0 % 128), nullptr, scr, lane); continue; }
        r -= 2 * I_EXP;
        if (!WD_IN_P5) { if (r < I_EXP) { const int e = r / 512, kb = (r % 512) / 32, nb = r % 32; p0_transpose_item(F.w_down + (size_t)e * 1048576, 1024, 1024, kb * 64, nb * 32, (bf16_t*)(ws + WS_WD) + (size_t)e * 1048576, nb * 32, nullptr, scr, lane); continue; }
        r -= I_EXP; }
        if (r < I_PAD) { u32x4 z = {0u, 0u, 0u, 0u}; u32x4* p = (u32x4*)((bf16_t*)(ws + WS_WIN) + (size_t)(672 + r) * 1024); p[lane] = z; p[64 + lane] = z; continue; }
        r -= I_PAD;
        {
            const int e = r * 64 + lane, tok = e / 24, f = e % 24; const int p = F.pos[tok];
            const float inv = f < 16 ? inv_freq_m(f) : inv_freq_d(f - 16); const float ang = (float)p * inv; const float cs = (float)cos((double)ang), sn = (float)sin((double)ang);
            if (f < 16) { float* tm = (float*)(ws + WS_TABM) + (size_t)tok * 32; tm[f] = cs; tm[16 + f] = sn; } else { float* td = (float*)(ws + WS_TABD) + (size_t)tok * 16; td[f - 16] = cs; td[8 + f - 16] = sn; }
        }
    }
}
__device__ __forceinline__ void wd_convert(Frame& F, int first_vcu) {
    LAS float* scr = (LAS float*)(F.lds + F.wave * 16384);
    const int gw = (F.vcu - first_vcu) * NWAVES + F.wave, NGW = (F.G - first_vcu) * NWAVES, lane = fresh_lane();
    for (int r = gw; r < 16 * 16 * 32; r += NGW) { const int e = r / 512, kb = (r % 512) / 32, nb = r % 32;
        p0_transpose_item(F.w_down + (size_t)e * 1048576, 1024, 1024, kb * 64, nb * 32, (bf16_t*)(F.ws + WS_WD) + (size_t)e * 1048576, nb * 32, nullptr, scr, lane); }
}
__device__ __forceinline__ void p0b_rows(Frame& F) {
    const int tid_ = F.wave * 64 + fresh_lane();
    LAS float* A1 = (LAS float*)F.lds;
    LAS float* A0 = A1 + 2048;
    const float* mp = (const float*)(F.ws + WS_MODP);
#pragma unroll
    for (int half = 0; half < 2; ++half) { float s[4]; float pv[4][16];
#pragma unroll
        for (int q = 0; q < 4; ++q) { const int i = tid_ + NTHREADS * (half * 4 + q); const int b = i >> 11, n = ((i >> 10) & 1) * 1024 + (i & 1023);
#pragma unroll
            for (int k = 0; k < 16; ++k) pv[q][k] = mp[(size_t)k * 2 * 6144 + b * 6144 + n]; }
#pragma unroll
        for (int q = 0; q < 4; ++q) { const int i = tid_ + NTHREADS * (half * 4 + q); const int b = i >> 11, which = (i >> 10) & 1, j = i & 1023; s[q] = F.b_ada[which * 1024 + j];
#pragma unroll
            for (int k = 0; k < 16; ++k) s[q] += pv[q][k];
            if (which) A1[b * 1024 + j] = F.g_mix[j] * (1.f + s[q]); else A0[b * 1024 + j] = s[q]; } }
    if (blockIdx.x < 48 && tid_ < 256) { const int n = blockIdx.x * 256 + tid_; const int b = n / 6144, nn = n % 6144; float s = F.b_ada[nn];
#pragma unroll
        for (int k = 0; k < 16; ++k) s += mp[(size_t)k * 2 * 6144 + b * 6144 + nn];
        ((float*)(F.ws + WS_MODF))[n] = s; }
    __syncthreads();
    const int gw = F.vcu * NWAVES + F.wave, NGW = F.G * NWAVES, lane = fresh_lane();
    for (int m0 = gw; m0 < T; m0 += 2 * NGW) {
        const int m1 = m0 + NGW; const bool has1 = m1 < T; const int mm1 = has1 ? m1 : m0;
        const f32x4* xr0 = (const f32x4*)(F.x + (size_t)m0 * D) + lane; const f32x4* xr1 = (const f32x4*)(F.x + (size_t)mm1 * D) + lane; f32x4 v0[4], v1[4]; float s0 = 0.f, s1 = 0.f;
#pragma unroll
        for (int j = 0; j < 4; ++j) { v0[j] = xr0[64 * j]; v1[j] = xr1[64 * j]; }
#pragma unroll
        for (int j = 0; j < 4; ++j) { s0 += (v0[j].x * v0[j].x + v0[j].y * v0[j].y) + (v0[j].z * v0[j].z + v0[j].w * v0[j].w); s1 += (v1[j].x * v1[j].x + v1[j].y * v1[j].y) + (v1[j].z * v1[j].z + v1[j].w * v1[j].w); }
        const float r0 = rsqrtf(wave_sum(s0) * (1.f / D) + EPS), r1 = rsqrtf(wave_sum(s1) * (1.f / D) + EPS);
        const int b0 = m0 >> 13, b1 = mm1 >> 13;
        unsigned long long* o0 = (unsigned long long*)((bf16_t*)(F.ws + WS_HB) + (size_t)m0 * D) + lane; unsigned long long* o1 = (unsigned long long*)((bf16_t*)(F.ws + WS_HB) + (size_t)mm1 * D) + lane;
#pragma unroll
        for (int j = 0; j < 4; ++j) { const f32x4 a1 = *(const LAS f32x4*)(A1 + b0 * 1024 + 4 * lane + 256 * j), a0 = *(const LAS f32x4*)(A0 + b0 * 1024 + 4 * lane + 256 * j);
            const f32x4 o = v0[j] * r0 * a1 + a0; o0[64 * j] = (unsigned long long)pk2(o.x, o.y) | ((unsigned long long)pk2(o.z, o.w) << 32); }
        if (has1) {
#pragma unroll
            for (int j = 0; j < 4; ++j) { const f32x4 a1 = *(const LAS f32x4*)(A1 + b1 * 1024 + 4 * lane + 256 * j), a0 = *(const LAS f32x4*)(A0 + b1 * 1024 + 4 * lane + 256 * j);
                const f32x4 o = v1[j] * r1 * a1 + a0; o1[64 * j] = (unsigned long long)pk2(o.x, o.y) | ((unsigned long long)pk2(o.z, o.w) << 32); } }
    }
    __syncthreads();
}

__device__ __forceinline__ bool static_tile(int i, int G, int c, int nM, int nN, int& pm, int& pn) {
    const int nwg = nM * nN; const long L = (long)i * G + c; if (L >= nwg) return false;
    int wgid = (int)L; { const int q = nwg / 8, r = nwg % 8, xcd = wgid % 8, off = wgid / 8; wgid = (xcd < r ? xcd * (q + 1) : r * (q + 1) + (xcd - r) * q) + off; }
    const int nig = 8 * nN, gid = wgid / nig, fm = gid * 8, gsz = (nM - fm) < 8 ? (nM - fm) : 8;
    pm = fm + ((wgid % nig) % gsz); pn = (wgid % nig) / gsz; return true;
}
struct SchedP1 {
    static constexpr bool GATHER = false;
    __device__ __forceinline__ void a_ready(const gm::Unit&, int) const {}
    __device__ __forceinline__ void done(const gm::Unit&, int) const {}
    const char* A; const char* Bt; int G, c;
    __device__ __forceinline__ bool next(int i, gm::Unit& u) const { int pm, pn; if (!static_tile(i, G, c, 64, 9, pm, pn)) return false;
        u.A = A; u.Bt = Bt; u.gidx = nullptr; u.lda2 = 2048; u.ldb2 = 2048; u.arow0 = pm * 256; u.brow0 = pn * 256; u.nt = 16; u.pm = pm; u.pn = pn; u.aux = 0; return true; }
};
struct SchedP2 {
    static constexpr bool GATHER = false;
    __device__ __forceinline__ void a_ready(const gm::Unit&, int) const {}
    __device__ __forceinline__ void done(const gm::Unit&, int) const {}
    const char* A; const char* Wuq; const char* Wukv; int G, c;
    __device__ __forceinline__ bool next(int i, gm::Unit& u) const {
        const int L = i * G + c; if (L >= 448) return false;
        u.A = A; u.gidx = nullptr; u.lda2 = 1536;
        if (L < 256) { int pm, pn; static_tile(0, 256, L, 64, 4, pm, pn); u.A = A + 768; u.Bt = Wukv; u.ldb2 = 512; u.nt = 4; u.arow0 = pm * 256; u.brow0 = pn * 256; u.pm = pm; u.pn = pn; u.aux = 1; }
        else { int pm, pn; static_tile(0, 192, L - 256, 64, 3, pm, pn); u.Bt = Wuq; u.ldb2 = 768; u.nt = 6; u.arow0 = pm * 256; u.brow0 = pn * 256; u.pm = pm; u.pn = pn; u.aux = 0; }
        return true; }
};

__device__ __forceinline__ void store16_sc1(void* p, u32x4 v) { asm volatile("global_store_dwordx4 %0, %1, off sc1\n\ts_nop 1" :: "v"(p), "v"(v) : "memory"); }
__device__ __forceinline__ void store4_sc1(float* p, float v) { __hip_atomic_store(p, v, __ATOMIC_RELAXED, __HIP_MEMORY_SCOPE_AGENT); }
#define EPI_ARGS const f32x4 (&acc)[2][2][4][2], const gm::Unit& u, int wr, int wc, int fr, int fq, int lane
constexpr float QSCALE_M = 0.10206207261596575f * 1.4426950408889634f;
constexpr float QSCALE_D = 0.125f * 1.4426950408889634f;
__device__ __forceinline__ u32x4 pack8(f32x4 a, f32x4 b) { u32x4 w; w.x = cvt_pk_bf16(a[0], a[1]); w.y = cvt_pk_bf16(a[2], a[3]); w.z = cvt_pk_bf16(b[0], b[1]); w.w = cvt_pk_bf16(b[2], b[3]); return w; }
__device__ __forceinline__ void rope8(f32x4& v0, f32x4& v1, int xmask, const float* cs, const float* sn, bool first) {
    f32x4 o0, o1;
#pragma unroll
    for (int j = 0; j < 4; ++j) { o0[j] = __shfl_xor(v0[j], xmask); o1[j] = __shfl_xor(v1[j], xmask); }
    const f32x4 c0 = *(const f32x4*)cs, c1 = *(const f32x4*)(cs + 4), s0 = *(const f32x4*)sn, s1 = *(const f32x4*)(sn + 4);
    const float sg = first ? -1.f : 1.f;
    v0 = v0 * c0 + o0 * s0 * sg; v1 = v1 * c1 + o1 * s1 * sg;
}
struct EpiP1 {
    static constexpr bool PERM = true;
    unsigned char* ws;
    __device__ __forceinline__ void operator()(EPI_ARGS) const {
        const int pn = u.pn; float krmax = 0.f;
        const float* tabm = (const float*)(ws + WS_TABM); const float* tabd = (const float*)(ws + WS_TABD);
#pragma unroll
        for (int ai = 0; ai < 2; ++ai)
#pragma unroll
            for (int m = 0; m < 4; ++m) {
                const int row = u.pm * 256 + ai * 128 + wr * 64 + m * 16 + fr; const int b = row >> 13, s = row & 8191;
#pragma unroll
                for (int bj = 0; bj < 2; ++bj) {
                    f32x4 v0 = acc[ai][bj][m][0], v1 = acc[ai][bj][m][1];
                    const int ct = bj * 128 + wc * 32 + 8 * fq;
                    if (pn < 3) {
                        float q = (v0[0] * v0[0] + v0[1] * v0[1]) + (v0[2] * v0[2] + v0[3] * v0[3]) + (v1[0] * v1[0] + v1[1] * v1[1]) + (v1[2] * v1[2] + v1[3] * v1[3]);
                        q += __shfl_xor(q, 16); q += __shfl_xor(q, 32);
                        if (fq == 0) store4_sc1((float*)(ws + WS_SSQ) + (size_t)row * 24 + pn * 8 + bj * 4 + wc, q);
                        if (pn == 2 && bj == 1 && wc == 0) {
                            const int f0 = 8 * (fq & 1); rope8(v0, v1, 32, tabm + (size_t)row * 32 + f0, tabm + (size_t)row * 32 + 16 + f0, fq < 2);
                            store16_sc1((bf16_t*)(ws + WS_KR) + (size_t)row * 32 + 8 * fq, pack8(v0, v1));
                            { float q2 = (v0[0] * v0[0] + v0[1] * v0[1]) + (v0[2] * v0[2] + v0[3] * v0[3]) + (v1[0] * v1[0] + v1[1] * v1[1]) + (v1[2] * v1[2] + v1[3] * v1[3]);
                              q2 += __shfl_xor(q2, 16); q2 += __shfl_xor(q2, 32); krmax = fmaxf(krmax, q2); }
                        } else store16_sc1((bf16_t*)(ws + WS_CQ) + (size_t)row * 768 + pn * 256 + ct, pack8(v0, v1));
                    } else {
                        const int which = (pn - 3) >> 1;
                        const int cc = ((pn - 3) & 1) * 256 + ct, hh = cc >> 6, d = cc & 63;
                        if (which < 2 && (wc & 1) == 0) {
                            f32x4 r0 = v0, r1 = v1; rope8(r0, r1, 16, tabd + (size_t)row * 16, tabd + (size_t)row * 16 + 8, fq == 0);
                            if (fq < 2) { v0 = r0; v1 = r1; } }
                        if (which == 0) { v0 = v0 * QSCALE_D; v1 = v1 * QSCALE_D; }
                        bf16_t* dst = (bf16_t*)(ws + (which == 0 ? WS_DQ : which == 1 ? WS_DK : WS_DV));
                        *(u32x4*)(dst + ((size_t)(b * 8 + hh) * S + s) * 64 + d) = pack8(v0, v1);
                    }
                }
            }
        if (pn == 2 && wc == 0) {
#pragma unroll
            for (int o = 1; o < 16; o <<= 1) krmax = fmaxf(krmax, __shfl_xor(krmax, o));
            if (lane == 0) atomicMax((unsigned*)(ws + WS_KMX) + 32 + ((u.pm * 256) >> 13), __float_as_uint(krmax)); }
    }
};
struct EpiP2 {
    static constexpr bool PERM = true;
    unsigned char* ws;
    __device__ __forceinline__ void operator()(EPI_ARGS) const {
        const int pn = u.pn; const bool isq = u.aux == 0; float kmax[2] = {0.f, 0.f};
        const float* tabm = (const float*)(ws + WS_TABM); const float* ssq = (const float*)(ws + WS_SSQ);
#pragma unroll
        for (int ai = 0; ai < 2; ++ai)
#pragma unroll
            for (int m = 0; m < 4; ++m) {
                const int row = u.pm * 256 + ai * 128 + wr * 64 + m * 16 + fr; const int b = row >> 13, s = row & 8191;
                const float* sq = ssq + (size_t)row * 24; float rstd;
                if (isq) { const f32x4 a = *(const f32x4*)sq, bq = *(const f32x4*)(sq + 4), cq = *(const f32x4*)(sq + 8);
                    rstd = rsqrtf((((a[0] + a[1]) + (a[2] + a[3])) + ((bq[0] + bq[1]) + (bq[2] + bq[3])) + ((cq[0] + cq[1]) + (cq[2] + cq[3]))) * (1.f / 384.f) + EPS) * QSCALE_M; }
                else { const f32x4 a = *(const f32x4*)(sq + 12), bq = *(const f32x4*)(sq + 16);
                    rstd = rsqrtf((((a[0] + a[1]) + (a[2] + a[3])) + ((bq[0] + bq[1]) + (bq[2] + bq[3]))) * (1.f / 256.f) + EPS); }
#pragma unroll
                for (int bj = 0; bj < 2; ++bj) {
                    f32x4 v0 = acc[ai][bj][m][0] * rstd, v1 = acc[ai][bj][m][1] * rstd;
                    const int ct = bj * 128 + wc * 32 + 8 * fq, cc = (pn & 1) * 256 + ct;
                    if (isq) {
                        if (pn < 2) { const int hh = cc >> 6, d = cc & 63; *(u32x4*)((bf16_t*)(ws + WS_Q) + ((size_t)(b * 8 + hh) * S + s) * 96 + d) = pack8(v0, v1); }
                        else { const int hh = ct >> 5; const int f0 = 8 * (fq & 1); rope8(v0, v1, 32, tabm + (size_t)row * 32 + f0, tabm + (size_t)row * 32 + 16 + f0, fq < 2);
                            *(u32x4*)((bf16_t*)(ws + WS_Q) + ((size_t)(b * 8 + hh) * S + s) * 96 + 64 + 8 * fq) = pack8(v0, v1); }
                    } else { const int hh = cc >> 6, d = cc & 63; bf16_t* dst = (bf16_t*)(ws + (pn < 2 ? WS_KN : WS_V));
                        *(u32x4*)(dst + ((size_t)(b * 8 + hh) * S + s) * 64 + d) = pack8(v0, v1);
                        if (pn < 2) { float q2 = (v0[0] * v0[0] + v0[1] * v0[1]) + (v0[2] * v0[2] + v0[3] * v0[3]) + (v1[0] * v1[0] + v1[1] * v1[1]) + (v1[2] * v1[2] + v1[3] * v1[3]);
                            q2 += __shfl_xor(q2, 16); q2 += __shfl_xor(q2, 32); kmax[bj] = fmaxf(kmax[bj], q2); } }
                }
            }
        if (!isq && pn < 2) {
#pragma unroll
            for (int bj = 0; bj < 2; ++bj) { float km = kmax[bj];
#pragma unroll
                for (int o = 1; o < 16; o <<= 1) km = fmaxf(km, __shfl_xor(km, o));
                const int cc = (pn & 1) * 256 + bj * 128 + wc * 32, hh = cc >> 6, half = (cc >> 5) & 1, b = (u.pm * 256) >> 13;
                if (lane == 0) atomicMax((unsigned*)(ws + WS_KMX) + (b * 8 + hh) * 2 + half, __float_as_uint(km)); }
        }
    }
};

constexpr size_t WS_PCNT = 56 * KiB;
struct SchedP12 {
    static constexpr bool GATHER = false;
    const char *HB, *WIN, *CQ, *WUQ, *WUKV; unsigned* cnt; int G, vcu, c;
    __device__ __forceinline__ bool next(int i, gm::Unit& u) const {
        u.gidx = nullptr;
        if (G == 256) {
            const int n1 = c < 64 ? 3 : 2;
            if (i < n1) { int pm, pn; static_tile(i, 256, c, 64, 9, pm, pn);
                u.A = HB; u.Bt = WIN; u.lda2 = 2048; u.ldb2 = 2048; u.arow0 = pm * 256; u.brow0 = pn * 256; u.nt = 16; u.pm = pm; u.pn = pn; u.aux = 2; return true; }
            if (c < 64) return false;
            const int idx = (c - 64) + 192 * (i - 2); if (i - 2 >= 3 || idx >= 448) return false;
            if (idx < 256) { int pm, pn; static_tile(0, 256, idx, 64, 4, pm, pn); u.A = CQ + 768; u.Bt = WUKV; u.lda2 = 1536; u.ldb2 = 512; u.nt = 4; u.arow0 = pm * 256; u.brow0 = pn * 256; u.pm = pm; u.pn = pn; u.aux = 1; }
            else { int pm, pn; static_tile(0, 192, idx - 256, 64, 3, pm, pn); u.A = CQ; u.Bt = WUQ; u.lda2 = 1536; u.ldb2 = 768; u.nt = 6; u.arow0 = pm * 256; u.brow0 = pn * 256; u.pm = pm; u.pn = pn; u.aux = 0; }
            return true;
        }
        const int n1 = (576 - vcu + G - 1) / G;
        if (i < n1) { const int k = vcu + G * i, pn = k >> 6, pm = k & 63;
            u.A = HB; u.Bt = WIN; u.lda2 = 2048; u.ldb2 = 2048; u.arow0 = pm * 256; u.brow0 = pn * 256; u.nt = 16; u.pm = pm; u.pn = pn; u.aux = 2; return true; }
        const int idx = vcu + G * (i - n1); if (idx >= 448) return false;
        if (idx < 256) { const int pm = idx & 63, pn = idx >> 6; u.A = CQ + 768; u.Bt = WUKV; u.lda2 = 1536; u.ldb2 = 512; u.nt = 4; u.arow0 = pm * 256; u.brow0 = pn * 256; u.pm = pm; u.pn = pn; u.aux = 1; }
        else { const int j = idx - 256, pm = j & 63, pn = j >> 6; u.A = CQ; u.Bt = WUQ; u.lda2 = 1536; u.ldb2 = 768; u.nt = 6; u.arow0 = pm * 256; u.brow0 = pn * 256; u.pm = pm; u.pn = pn; u.aux = 0; }
        return true;
    }
    __device__ __forceinline__ void a_ready(const gm::Unit& u, int wid) const {
        if (u.aux == 2) return;
        if (wid == 0) { unsigned* p = cnt + 16 * u.pm; unsigned spins = 0;
            while ((unsigned)__builtin_amdgcn_readfirstlane(__hip_atomic_load(p, __ATOMIC_RELAXED, __HIP_MEMORY_SCOPE_AGENT)) < 24u) { __builtin_amdgcn_s_sleep(2); if (++spins > (1u << 22)) break; }
            __builtin_amdgcn_fence(__ATOMIC_ACQUIRE, "agent");
            asm volatile("s_waitcnt vmcnt(0)" ::: "memory"); }
        asm volatile("" ::: "memory"); __builtin_amdgcn_s_barrier(); asm volatile("" ::: "memory");
    }
    __device__ __forceinline__ void done(const gm::Unit& u, int lane) const {
        if (u.aux != 2 || u.pn >= 3) return;
        asm volatile("s_waitcnt vmcnt(0)" ::: "memory");
        if (lane == 0) __hip_atomic_fetch_add(cnt + 16 * u.pm, 1u, __ATOMIC_RELAXED, __HIP_MEMORY_SCOPE_AGENT);
    }
};
struct EpiP12 {
    static constexpr bool PERM = true;
    unsigned char* ws;
    __device__ __forceinline__ void operator()(EPI_ARGS) const { if (u.aux == 2) { EpiP1 e{ws}; e(acc, u, wr, wc, fr, fq, lane); } else { EpiP2 e{ws}; e(acc, u, wr, wc, fr, fq, lane); } }
};
}
namespace mk {
#define RLX_AGENT __ATOMIC_RELAXED, __HIP_MEMORY_SCOPE_AGENT
#define XB_TMO      128
#define XB_XCNT(j)  (256  + 64 * (j))
#define XB_XSUB(j)  (1280 + 64 * (j))
#define XB_XGEN(j)  (2304 + 64 * (j))
#define XB_TOP      3328
#define XB_TOPGEN   3392
#define XCD_BAR_WORDS 3456
#define XB_SPIN_CAP (1u << 18)
__device__ __forceinline__ unsigned xb_ld(unsigned* p)              { return __hip_atomic_load(p, __ATOMIC_RELAXED, __HIP_MEMORY_SCOPE_AGENT); }
__device__ __forceinline__ unsigned xb_add(unsigned* p, unsigned v) { return __hip_atomic_fetch_add(p, v, __ATOMIC_RELAXED, __HIP_MEMORY_SCOPE_AGENT); }
__device__ __forceinline__ unsigned xb_xcc_id() { return (unsigned)__builtin_amdgcn_s_getreg((3 << 11) | 20) & 0xFu; }
#define XB_SPIN(cond, bar) do { unsigned _sp = 0; while (cond) { __builtin_amdgcn_s_sleep(1); \
    if ((++_sp & 255u) == 0u) { if (xb_ld(&(bar)[XB_TMO])) break; if (_sp > XB_SPIN_CAP) { atomicAdd(&(bar)[XB_TMO], 1u); break; } } } } while (0)
struct XcdBarrier { unsigned* bar; unsigned x; volatile LAS unsigned* st; };
__device__ __forceinline__ XcdBarrier xcd_barrier_post(unsigned* bar, volatile LAS unsigned* st, bool first_thread) {
    XcdBarrier b; b.bar = bar; b.x = xb_xcc_id(); b.st = st;
    if (first_thread) (void)xb_add(&bar[XB_XCNT(b.x)], 1u);
    return b;
}
__device__ __forceinline__ void xcd_barrier_complete(unsigned* bar, unsigned x, unsigned& nloc, unsigned& nx) {
    const unsigned G = gridDim.x * gridDim.y * gridDim.z;
    unsigned sum, cnt, mine, sp = 0u;
    for (;;) {
        sum = 0u; cnt = 0u; mine = 0u;
#pragma unroll
        for (unsigned j = 0; j < 16; ++j) { const unsigned c = xb_ld(&bar[XB_XCNT(j)]); sum += c; cnt += (c > 0u) ? 1u : 0u; mine = (j == x) ? c : mine; }
        if (sum == G) break;
        __builtin_amdgcn_s_sleep(1);
        if ((++sp & 255u) == 0u) { if (xb_ld(&bar[XB_TMO])) break; if (sp > XB_SPIN_CAP) { atomicAdd(&bar[XB_TMO], 1u); break; } }
    }
    nloc = mine > 0u ? mine : 1u; nx = cnt > 0u ? cnt : 1u;
}
__device__ __forceinline__ void xcd_barrier(const XcdBarrier& b, bool first_thread) {
    asm volatile("s_waitcnt vmcnt(0)" ::: "memory");
    __syncthreads();
    if (first_thread) {
        unsigned* bar = b.bar;
        __builtin_amdgcn_s_waitcnt(0);
        unsigned nloc = b.st[0], nx = b.st[1];
        if (nloc == 0u) { xcd_barrier_complete(bar, b.x, nloc, nx); b.st[0] = nloc; b.st[1] = nx; }
        const unsigned old = xb_add(&bar[XB_XSUB(b.x)], 1u);
        const unsigned gen = old / nloc;
        if (old + 1u == (gen + 1u) * nloc) {
            __builtin_amdgcn_fence(__ATOMIC_RELEASE, "agent");
            asm volatile("s_waitcnt vmcnt(0)" ::: "memory");
            const unsigned og = xb_add(&bar[XB_TOP], 1u);
            const unsigned tg = og / nx;
            if (og + 1u == (tg + 1u) * nx) xb_add(&bar[XB_TOPGEN], 1u);
            else XB_SPIN(xb_ld(&bar[XB_TOPGEN]) == tg, bar);
            __builtin_amdgcn_fence(__ATOMIC_ACQUIRE, "agent");
            xb_add(&bar[XB_XGEN(b.x)], 1u);
            asm volatile("s_waitcnt vmcnt(0)" ::: "memory");
        } else {
            XB_SPIN(xb_ld(&bar[XB_XGEN(b.x)]) == gen, bar);
            __builtin_amdgcn_fence(__ATOMIC_ACQUIRE, "agent");
            asm volatile("s_waitcnt vmcnt(0)" ::: "memory");
        }
    }
    __syncthreads();
}
}
namespace at {
using bf16x8 = __attribute__((ext_vector_type(8))) short;
using s16x4 = __attribute__((ext_vector_type(4))) short;
using f32x16 = __attribute__((ext_vector_type(16))) float;
using u32x4 = __attribute__((ext_vector_type(4))) unsigned;
constexpr int S = 8192, T = 16384;
constexpr float THR = 8.f;
#define SBAR() __builtin_amdgcn_sched_barrier(0)
__device__ __forceinline__ int crow(int r, int hi) { return (r & 3) + 8 * (r >> 2) + 4 * hi; }
__device__ __forceinline__ unsigned cvtpk(float lo, float hi) { unsigned r; asm volatile("v_cvt_pk_bf16_f32 %0, %1, %2" : "=v"(r) : "v"(lo), "v"(hi)); return r; }
__device__ __forceinline__ float rowmax32(const f32x16& p0, const f32x16& p1) {
    float pmax = p0[0];
#pragma unroll
    for (int r = 1; r < 16; ++r) pmax = fmaxf(pmax, p0[r]);
#pragma unroll
    for (int r = 0; r < 16; ++r) pmax = fmaxf(pmax, p1[r]);
    auto rr = __builtin_amdgcn_permlane32_swap(__float_as_uint(pmax), __float_as_uint(pmax), false, false);
    return fmaxf(__uint_as_float(rr[0]), __uint_as_float(rr[1]));
}
__device__ __forceinline__ void partialSM(f32x16& p0, f32x16& p1, float& m_reg, float& mn, float& alpha) {
    const float pmax = rowmax32(p0, p1);
    if (__builtin_expect(__all(pmax - m_reg <= THR), 1)) { mn = m_reg; alpha = 1.f; }
    else { mn = fmaxf(m_reg, pmax); alpha = __builtin_amdgcn_exp2f(m_reg - mn); m_reg = mn; }
#pragma unroll
    for (int r = 0; r < 16; ++r) p0[r] = p0[r] - mn;
#pragma unroll
    for (int r = 0; r < 16; ++r) p1[r] = p1[r] - mn;
#pragma unroll
    for (int r = 0; r < 16; ++r) p0[r] = __builtin_amdgcn_exp2f(p0[r]);
}
#define PK4(P, BASE, OUT) do { unsigned a0 = cvtpk(P[BASE + 0], P[BASE + 1]), a1 = cvtpk(P[BASE + 2], P[BASE + 3]);   \
    unsigned b0 = cvtpk(P[BASE + 4], P[BASE + 5]), b1 = cvtpk(P[BASE + 6], P[BASE + 7]);                              \
    auto r0 = __builtin_amdgcn_permlane32_swap(a0, b0, false, false); auto r1 = __builtin_amdgcn_permlane32_swap(a1, b1, false, false); \
    u32x4 w = {r0[0], r1[0], r0[1], r1[1]}; OUT = *reinterpret_cast<bf16x8*>(&w); } while (0)
__device__ __forceinline__ void finishSM(f32x16& p0, f32x16& p1, float alpha, float& l_reg, bf16x8& pa0, bf16x8& pa1, bf16x8& pa2, bf16x8& pa3) {
#pragma unroll
    for (int r = 0; r < 16; ++r) p1[r] = __builtin_amdgcn_exp2f(p1[r]);
    float ps = 0;
#pragma unroll
    for (int r = 0; r < 16; ++r) ps += p0[r];
#pragma unroll
    for (int r = 0; r < 16; ++r) ps += p1[r];
    { auto rr = __builtin_amdgcn_permlane32_swap(__float_as_uint(ps), __float_as_uint(ps), false, false); ps = __uint_as_float(rr[0]) + __uint_as_float(rr[1]); }
    l_reg = l_reg * alpha + ps;
    PK4(p0, 0, pa0); PK4(p0, 8, pa1); PK4(p1, 0, pa2); PK4(p1, 8, pa3);
}
__device__ __forceinline__ int v_st(int k, int c) { const int kk = (k & ~0xC) | ((k & 4) << 1) | ((k & 8) >> 1); return ((kk >> 3) * 2 + (c >> 5)) * 512 + ((kk & 7) * 32 + (c & 31)) * 2; }
__device__ __forceinline__ int v_rd_base(int lane) { return ((lane & 3) << 3) | (((lane >> 2) & 3) << 6) | (((lane >> 4) & 1) << 5) | (((lane >> 5) & 1) << 8); }
constexpr int v_rd_off(int d0, int ks, int half) { return d0 * 512 + ks * 2048 + half * 1024; }
template <int OFF> __device__ __forceinline__ s16x4 tr_read(int vb) { s16x4 r; asm volatile("ds_read_b64_tr_b16 %0, %1 offset:%2" : "=&v"(r) : "v"(vb), "i"(OFF) : "memory"); return r; }
#define PKV(L, H) (bf16x8){L[0], L[1], L[2], L[3], H[0], H[1], H[2], H[3]}
template <int D0, int KOFF> __device__ __forceinline__ void pv_one(f32x16& od, int vb, bf16x8 pa0, bf16x8 pa1, bf16x8 pa2, bf16x8 pa3) {
    const s16x4 l0 = tr_read<KOFF + v_rd_off(D0, 0, 0)>(vb), h0 = tr_read<KOFF + v_rd_off(D0, 0, 1)>(vb), l1 = tr_read<KOFF + v_rd_off(D0, 1, 0)>(vb), h1 = tr_read<KOFF + v_rd_off(D0, 1, 1)>(vb);
    const s16x4 l2 = tr_read<KOFF + v_rd_off(D0, 2, 0)>(vb), h2 = tr_read<KOFF + v_rd_off(D0, 2, 1)>(vb), l3 = tr_read<KOFF + v_rd_off(D0, 3, 0)>(vb), h3 = tr_read<KOFF + v_rd_off(D0, 3, 1)>(vb);
    asm volatile("s_waitcnt lgkmcnt(0)" ::: "memory"); SBAR();
    od = __builtin_amdgcn_mfma_f32_32x32x16_bf16(pa0, PKV(l0, h0), od, 0, 0, 0);
    od = __builtin_amdgcn_mfma_f32_32x32x16_bf16(pa1, PKV(l1, h1), od, 0, 0, 0);
    od = __builtin_amdgcn_mfma_f32_32x32x16_bf16(pa2, PKV(l2, h2), od, 0, 0, 0);
    od = __builtin_amdgcn_mfma_f32_32x32x16_bf16(pa3, PKV(l3, h3), od, 0, 0, 0);
}
template <int D0, int KOFF> __device__ __forceinline__ void pv_half(f32x16& od, int vb, bf16x8 pa0, bf16x8 pa1) {
    const s16x4 l0 = tr_read<KOFF + v_rd_off(D0, 0, 0)>(vb), h0 = tr_read<KOFF + v_rd_off(D0, 0, 1)>(vb), l1 = tr_read<KOFF + v_rd_off(D0, 1, 0)>(vb), h1 = tr_read<KOFF + v_rd_off(D0, 1, 1)>(vb);
    asm volatile("s_waitcnt lgkmcnt(0)" ::: "memory"); SBAR();
    od = __builtin_amdgcn_mfma_f32_32x32x16_bf16(pa0, PKV(l0, h0), od, 0, 0, 0);
    od = __builtin_amdgcn_mfma_f32_32x32x16_bf16(pa1, PKV(l1, h1), od, 0, 0, 0);
}
template <class RowOff> __device__ __forceinline__ void store_o_tile(const f32x16 (&o)[2], const float (&rli)[16], unsigned short* stg, unsigned short* dst, RowOff row_off, int lane) {
    const int r32 = lane & 31, hi = lane >> 5;
#pragma unroll
    for (int r = 0; r < 16; ++r) { const int orow = crow(r, hi);
#pragma unroll
        for (int d0 = 0; d0 < 2; ++d0) stg[orow * 64 + d0 * 32 + r32] = (unsigned short)(cvtpk(o[d0][r] * rli[r], 0.f) & 0xffffu); }
    asm volatile("s_waitcnt lgkmcnt(0)" ::: "memory");
#pragma unroll
    for (int i = 0; i < 4; ++i) { const int row = i * 8 + (lane >> 3), ch = lane & 7; const u32x4 v = *(const u32x4*)(stg + row * 64 + ch * 8); *(u32x4*)(dst + row_off(row) + ch * 8) = v; }
    asm volatile("s_waitcnt lgkmcnt(0)" ::: "memory");
}

constexpr int SHM_V = 8192, SHM_K = 16384, MLA_WS = 2 * SHM_V + 2 * SHM_K, MLA_OST = MLA_WS + 8 * 256;
#define KSWZ(row, colB) ((row) * 256 + ((colB) ^ (((row) & 15) << 4)))
__device__ __forceinline__ void qkt96(f32x16& p0, f32x16& p1, const char* Ks, const bf16x8* qr, int r32, int hi) {
    p0 = f32x16{}; p1 = f32x16{};
#pragma unroll
    for (int d0 = 0; d0 < 6; ++d0) { const int cb = (d0 * 16 + hi * 8) * 2;
        const bf16x8 b0 = *reinterpret_cast<const bf16x8*>(Ks + KSWZ(r32, cb));
        const bf16x8 b1 = *reinterpret_cast<const bf16x8*>(Ks + KSWZ(32 + r32, cb));
        p0 = __builtin_amdgcn_mfma_f32_32x32x16_bf16(b0, qr[d0], p0, 0, 0, 0);
        p1 = __builtin_amdgcn_mfma_f32_32x32x16_bf16(b1, qr[d0], p1, 0, 0, 0); }
}
__device__ __forceinline__ void pv64(f32x16* o, int vb, bf16x8 pa0, bf16x8 pa1, bf16x8 pa2, bf16x8 pa3) {
    pv_one<0, 0>(o[0], vb, pa0, pa1, pa2, pa3); pv_one<1, 0>(o[1], vb, pa0, pa1, pa2, pa3);
}
__device__ __forceinline__ void mla_unit(int wv, int bh, int qb, const unsigned short* __restrict__ Q, const unsigned short* __restrict__ KN, const unsigned short* __restrict__ KR,
                                         const unsigned short* __restrict__ V, unsigned short* __restrict__ CAT, char* lds) {
    const int wid = wv, lane = gm::lane_now(), tid = wid * 64 + lane, r32 = lane & 31, hi = lane >> 5;
    const int b = bh >> 3, h = bh & 7;
    char* V_lds = lds; char* K_lds = lds + 2 * SHM_V;
    float* wsf = (float*)(lds + MLA_WS) + wid * 64; float* li_l = wsf; float* al_l = wsf + 32;
    float m_reg = -1e30f, l_reg = 0; f32x16 o[2] = {}; bf16x8 qr[6];
    const size_t bhS = (size_t)bh * S; const int q0 = qb * 256;
    const unsigned short* Qw = Q + (bhS + q0 + wid * 32 + r32) * 96 + hi * 8;
#pragma unroll
    for (int d0 = 0; d0 < 6; ++d0) qr[d0] = *reinterpret_cast<const bf16x8*>(Qw + d0 * 16);
    const int srow = tid >> 3, sch = tid & 7, rrow = (tid & 255) >> 2, rch = tid & 3;
    const unsigned short* kn_src = KN + (bhS + srow) * 64 + sch * 8;
    const unsigned short* v_src = V + (bhS + srow) * 64 + sch * 8;
    const unsigned short* kr_src = KR + ((size_t)b * S + rrow) * 32 + rch * 8;
    const int kst = KSWZ(srow, sch * 16), krst = KSWZ(rrow, (8 + rch) * 16), vst = v_st(srow, sch * 8);
    const int vb0 = (int)(uintptr_t)V_lds + v_rd_base(lane);
    bf16x8 s_kn[2], s_kr[2], s_v[2];
#define SLOAD(i, k0) do { s_kn[i] = *reinterpret_cast<const bf16x8*>(kn_src + (size_t)(k0) * 64); s_kr[i] = *reinterpret_cast<const bf16x8*>(kr_src + (size_t)(k0) * 32); \
    s_v[i] = *reinterpret_cast<const bf16x8*>(v_src + (size_t)(k0) * 64); } while (0)
#define SWRITE(bb, i) do { *(bf16x8*)(K_lds + (bb) * SHM_K + kst) = s_kn[i]; if (tid < 256) *(bf16x8*)(K_lds + (bb) * SHM_K + krst) = s_kr[i]; *(bf16x8*)(V_lds + (bb) * SHM_V + vst) = s_v[i]; } while (0)
#define SWAIT() asm volatile("s_waitcnt vmcnt(3)" ::: "memory")
#define RESC(a) do { if (__any((a) < 1.f)) { if (hi == 0) al_l[r32] = (a); asm volatile("s_waitcnt lgkmcnt(0)" ::: "memory"); \
    _Pragma("unroll") for (int d = 0; d < 2; ++d) _Pragma("unroll") for (int r = 0; r < 16; ++r) o[d][r] *= al_l[crow(r, hi)]; } } while (0)
    f32x16 pA0, pA1, pB0, pB1; float mnA, mnB, alA, alB; bf16x8 pa0, pa1, pa2, pa3; constexpr int NT = S / 64;
    SLOAD(0, 0); asm volatile("s_waitcnt vmcnt(0)" ::: "memory"); SWRITE(0, 0); __syncthreads();
    qkt96(pA0, pA1, K_lds, qr, r32, hi); partialSM(pA0, pA1, m_reg, mnA, alA);
    SLOAD(1, 64); SLOAD(0, 128);
    SWAIT(); SWRITE(1, 1); __syncthreads();
    for (int j = 1; j + 1 < NT; j += 2) {
        SBAR(); qkt96(pB0, pB1, K_lds + SHM_K, qr, r32, hi);
        finishSM(pA0, pA1, alA, l_reg, pa0, pa1, pa2, pa3); SBAR();
        SLOAD(1, (j + 2) * 64); SBAR();
        pv64(o, vb0, pa0, pa1, pa2, pa3); partialSM(pB0, pB1, m_reg, mnB, alB);
        __syncthreads(); SWAIT(); SWRITE(0, 0);
        RESC(alB); __syncthreads();
        SBAR(); qkt96(pA0, pA1, K_lds, qr, r32, hi);
        finishSM(pB0, pB1, alB, l_reg, pa0, pa1, pa2, pa3); SBAR();
        if (j + 3 < NT) SLOAD(0, (j + 3) * 64); SBAR();
        pv64(o, vb0 + SHM_V, pa0, pa1, pa2, pa3); partialSM(pA0, pA1, m_reg, mnA, alA);
        __syncthreads(); SWAIT(); SWRITE(1, 1);
        RESC(alA); __syncthreads();
    }
    SBAR(); qkt96(pB0, pB1, K_lds + SHM_K, qr, r32, hi);
    finishSM(pA0, pA1, alA, l_reg, pa0, pa1, pa2, pa3); SBAR();
    pv64(o, vb0, pa0, pa1, pa2, pa3); partialSM(pB0, pB1, m_reg, mnB, alB);
    __syncthreads(); RESC(alB);
    finishSM(pB0, pB1, alB, l_reg, pa0, pa1, pa2, pa3); SBAR();
    pv64(o, vb0 + SHM_V, pa0, pa1, pa2, pa3);
    if (hi == 0) li_l[r32] = l_reg; asm volatile("s_waitcnt lgkmcnt(0)" ::: "memory");
    float rli[16];
#pragma unroll
    for (int r = 0; r < 16; ++r) rli[r] = __builtin_amdgcn_rcpf(li_l[crow(r, hi)]);
    unsigned short* stg = (unsigned short*)(lds + MLA_OST) + wid * 2048;
    unsigned short* dst = CAT + ((size_t)b * S + q0 + wid * 32) * 1024 + h * 64;
    store_o_tile(o, rli, stg, dst, [](int row) { return (size_t)row * 1024; }, lane);
    asm volatile("s_waitcnt vmcnt(0)" ::: "memory");
    __syncthreads();
#undef SLOAD
#undef SWRITE
#undef SWAIT
#undef RESC
}


constexpr int M2_K = 0, M2_V = 3 * SHM_K, M2_WS = M2_V + 3 * SHM_V, M2_OST = M2_WS + 8 * 256;
#ifndef MLA_PROBE_NOSTAGE
#define MLA_PROBE_NOSTAGE 0
#endif
#ifndef MLA_STATIC
#define MLA_STATIC 1
#endif
#ifndef MLA_STATIC_THR
#define MLA_STATIC_THR 60.f
#endif
#ifndef MLA_STEP_MODE
#define MLA_STEP_MODE 0
#endif
#ifndef MLA_PROBE_VALU
#define MLA_PROBE_VALU 0
#endif
#ifndef MLA_NEGM
#define MLA_NEGM 1
#endif
#ifndef MLA_PRIO
#define MLA_PRIO 0
#endif
__device__ __forceinline__ void qkt96n(f32x16& p0, f32x16& p1, const char* Ks, const bf16x8* qr, const f32x16& negm, int r32, int hi, bool usec = true) {
    if (MLA_PRIO) __builtin_amdgcn_s_setprio(1);
#pragma unroll
    for (int d0 = 0; d0 < 6; ++d0) { const int cb = (d0 * 16 + hi * 8) * 2;
        const bf16x8 b0 = *reinterpret_cast<const bf16x8*>(Ks + KSWZ(r32, cb));
        const bf16x8 b1 = *reinterpret_cast<const bf16x8*>(Ks + KSWZ(32 + r32, cb));
        if (d0 == 0 && !usec) { p0 = __builtin_amdgcn_mfma_f32_32x32x16_bf16(b0, qr[0], f32x16{}, 0, 0, 0); p1 = __builtin_amdgcn_mfma_f32_32x32x16_bf16(b1, qr[0], f32x16{}, 0, 0, 0); }
        else if (d0 == 0) { p0 = __builtin_amdgcn_mfma_f32_32x32x16_bf16(b0, qr[0], MLA_NEGM ? negm : f32x16{}, 0, 0, 0); p1 = __builtin_amdgcn_mfma_f32_32x32x16_bf16(b1, qr[0], MLA_NEGM ? negm : f32x16{}, 0, 0, 0); }
        else { p0 = __builtin_amdgcn_mfma_f32_32x32x16_bf16(b0, qr[d0], p0, 0, 0, 0); p1 = __builtin_amdgcn_mfma_f32_32x32x16_bf16(b1, qr[d0], p1, 0, 0, 0); } }
    if (MLA_PRIO) __builtin_amdgcn_s_setprio(0);
}
__device__ __forceinline__ void qkt96z(f32x16& p0, f32x16& p1, const char* Ks, const bf16x8* qr, int r32, int hi) {
#pragma unroll
    for (int d0 = 0; d0 < 6; ++d0) { const int cb = (d0 * 16 + hi * 8) * 2;
        const bf16x8 b0 = *reinterpret_cast<const bf16x8*>(Ks + KSWZ(r32, cb));
        const bf16x8 b1 = *reinterpret_cast<const bf16x8*>(Ks + KSWZ(32 + r32, cb));
        if (d0 == 0) { p0 = __builtin_amdgcn_mfma_f32_32x32x16_bf16(b0, qr[0], f32x16{}, 0, 0, 0); p1 = __builtin_amdgcn_mfma_f32_32x32x16_bf16(b1, qr[0], f32x16{}, 0, 0, 0); }
        else { p0 = __builtin_amdgcn_mfma_f32_32x32x16_bf16(b0, qr[d0], p0, 0, 0, 0); p1 = __builtin_amdgcn_mfma_f32_32x32x16_bf16(b1, qr[d0], p1, 0, 0, 0); } }
}
__device__ __forceinline__ float rowmax32b(const f32x16& p0, const f32x16& p1) {
    float a = fmaxf(fmaxf(p0[0], p0[1]), p1[0]), b = fmaxf(fmaxf(p0[2], p0[3]), p1[1]); a = fmaxf(fmaxf(a, p1[2]), p1[3]);
#pragma unroll
    for (int r = 4; r < 16; r += 4) { a = fmaxf(fmaxf(a, p0[r]), p0[r + 1]); b = fmaxf(fmaxf(b, p0[r + 2]), p0[r + 3]); a = fmaxf(fmaxf(a, p1[r]), p1[r + 1]); b = fmaxf(fmaxf(b, p1[r + 2]), p1[r + 3]); }
    const float m = fmaxf(a, b);
    auto rr = __builtin_amdgcn_permlane32_swap(__float_as_uint(m), __float_as_uint(m), false, false);
    return fmaxf(__uint_as_float(rr[0]), __uint_as_float(rr[1]));
}
template <bool FIRST> __device__ __forceinline__ void partialSM2(f32x16& p0, f32x16& p1, float& m_reg, f32x16& negm, float& alpha, bool exact = true) {
    if (!exact) { alpha = 1.f;
#pragma unroll
        for (int r = 0; r < 16; ++r) p0[r] = __builtin_amdgcn_exp2f(p0[r]);
        return; }
    if (MLA_PROBE_VALU) { float d0_ = p1[0], d1_ = p1[1], d2_ = p1[2], d3_ = p1[3];
#pragma unroll
        for (int i = 0; i < 8; ++i) { d0_ = __builtin_amdgcn_exp2f(d0_); d1_ = __builtin_amdgcn_exp2f(d1_); d2_ = __builtin_amdgcn_exp2f(d2_); d3_ = __builtin_amdgcn_exp2f(d3_); }
        asm volatile("" :: "v"(d0_), "v"(d1_), "v"(d2_), "v"(d3_)); }
    if (!MLA_NEGM) {
        const float pm = rowmax32b(p0, p1); alpha = 1.f;
        if (FIRST) m_reg = pm; else if (!__builtin_expect(__all(pm - m_reg <= THR), 1)) { const float mn = fmaxf(m_reg, pm); alpha = __builtin_amdgcn_exp2f(m_reg - mn); m_reg = mn; }
#pragma unroll
        for (int r = 0; r < 16; ++r) { p0[r] -= m_reg; p1[r] -= m_reg; }
#pragma unroll
        for (int r = 0; r < 16; ++r) p0[r] = __builtin_amdgcn_exp2f(p0[r]);
        return; }
    const float pmax = rowmax32b(p0, p1);
    alpha = 1.f;
    if (FIRST || !__builtin_expect(__all(pmax <= THR), 1)) {
        const float dl = FIRST ? pmax : fmaxf(pmax, 0.f); m_reg += dl;
#pragma unroll
        for (int r = 0; r < 16; ++r) { p0[r] -= dl; p1[r] -= dl; }
#pragma unroll
        for (int r = 0; r < 16; ++r) negm[r] = -m_reg;
        if (!FIRST) alpha = __builtin_amdgcn_exp2f(-dl);
    }
#pragma unroll
    for (int r = 0; r < 16; ++r) p0[r] = __builtin_amdgcn_exp2f(p0[r]);
}
template <int D0> __device__ __forceinline__ void pv_one_p(f32x16& od, int vb, bf16x8 pa0, bf16x8 pa1, bf16x8 pa2, bf16x8 pa3) {
    const s16x4 l0 = tr_read<v_rd_off(D0, 0, 0)>(vb), h0 = tr_read<v_rd_off(D0, 0, 1)>(vb), l1 = tr_read<v_rd_off(D0, 1, 0)>(vb), h1 = tr_read<v_rd_off(D0, 1, 1)>(vb);
    const s16x4 l2 = tr_read<v_rd_off(D0, 2, 0)>(vb), h2 = tr_read<v_rd_off(D0, 2, 1)>(vb), l3 = tr_read<v_rd_off(D0, 3, 0)>(vb), h3 = tr_read<v_rd_off(D0, 3, 1)>(vb);
    asm volatile("s_waitcnt lgkmcnt(0)" ::: "memory"); SBAR();
    if (MLA_PRIO) __builtin_amdgcn_s_setprio(1);
    od = __builtin_amdgcn_mfma_f32_32x32x16_bf16(pa0, PKV(l0, h0), od, 0, 0, 0);
    od = __builtin_amdgcn_mfma_f32_32x32x16_bf16(pa1, PKV(l1, h1), od, 0, 0, 0);
    od = __builtin_amdgcn_mfma_f32_32x32x16_bf16(pa2, PKV(l2, h2), od, 0, 0, 0);
    od = __builtin_amdgcn_mfma_f32_32x32x16_bf16(pa3, PKV(l3, h3), od, 0, 0, 0);
    if (MLA_PRIO) __builtin_amdgcn_s_setprio(0);
}

__device__ __forceinline__ void kfrag_load(bf16x8 (&kf)[12], const char* Ks, int r32, int hi) {
#pragma unroll
    for (int d0 = 0; d0 < 6; ++d0) { const int cb = (d0 * 16 + hi * 8) * 2;
        kf[2 * d0] = *reinterpret_cast<const bf16x8*>(Ks + KSWZ(r32, cb)); kf[2 * d0 + 1] = *reinterpret_cast<const bf16x8*>(Ks + KSWZ(32 + r32, cb)); }
}
__device__ __forceinline__ void qk_mma(f32x16& p0, f32x16& p1, const bf16x8 (&kf)[12], const bf16x8* qr, const f32x16& negm) {
    if (MLA_PRIO) __builtin_amdgcn_s_setprio(1);
    p0 = __builtin_amdgcn_mfma_f32_32x32x16_bf16(kf[0], qr[0], MLA_NEGM ? negm : f32x16{}, 0, 0, 0); p1 = __builtin_amdgcn_mfma_f32_32x32x16_bf16(kf[1], qr[0], MLA_NEGM ? negm : f32x16{}, 0, 0, 0);
#pragma unroll
    for (int d0 = 1; d0 < 6; ++d0) { p0 = __builtin_amdgcn_mfma_f32_32x32x16_bf16(kf[2 * d0], qr[d0], p0, 0, 0, 0); p1 = __builtin_amdgcn_mfma_f32_32x32x16_bf16(kf[2 * d0 + 1], qr[d0], p1, 0, 0, 0); }
    if (MLA_PRIO) __builtin_amdgcn_s_setprio(0);
}
template <int D0> __device__ __forceinline__ void vfrag_load_h(s16x4 (&vl)[4], s16x4 (&vh)[4], int vb) {
    vl[0] = tr_read<v_rd_off(D0, 0, 0)>(vb); vh[0] = tr_read<v_rd_off(D0, 0, 1)>(vb); vl[1] = tr_read<v_rd_off(D0, 1, 0)>(vb); vh[1] = tr_read<v_rd_off(D0, 1, 1)>(vb);
    vl[2] = tr_read<v_rd_off(D0, 2, 0)>(vb); vh[2] = tr_read<v_rd_off(D0, 2, 1)>(vb); vl[3] = tr_read<v_rd_off(D0, 3, 0)>(vb); vh[3] = tr_read<v_rd_off(D0, 3, 1)>(vb);
}
__device__ __forceinline__ void pv_mma_h(f32x16& od, const s16x4 (&vl)[4], const s16x4 (&vh)[4], bf16x8 pa0, bf16x8 pa1, bf16x8 pa2, bf16x8 pa3) {
    if (MLA_PRIO) __builtin_amdgcn_s_setprio(1);
    od = __builtin_amdgcn_mfma_f32_32x32x16_bf16(pa0, PKV(vl[0], vh[0]), od, 0, 0, 0);
    od = __builtin_amdgcn_mfma_f32_32x32x16_bf16(pa1, PKV(vl[1], vh[1]), od, 0, 0, 0);
    od = __builtin_amdgcn_mfma_f32_32x32x16_bf16(pa2, PKV(vl[2], vh[2]), od, 0, 0, 0);
    od = __builtin_amdgcn_mfma_f32_32x32x16_bf16(pa3, PKV(vl[3], vh[3]), od, 0, 0, 0);
    if (MLA_PRIO) __builtin_amdgcn_s_setprio(0);
}
#if MLA_STEP_MODE == 0
#define MLA_STEP(PC0, PC1, PP0, PP1, ALP, ALC) do { \
    qkt96n(PC0, PC1, K_lds + sc * SHM_K, qr, negm, r32, hi); \
    finishSM(PP0, PP1, ALP, l_reg, pa0, pa1, pa2, pa3); SBAR(); \
    { const int vb_ = vb0 + sp * SHM_V; pv_one_p<0>(o[0], vb_, pa0, pa1, pa2, pa3); pv_one_p<1>(o[1], vb_, pa0, pa1, pa2, pa3); } \
    partialSM2<false>(PC0, PC1, m_reg, negm, ALC, exact); RESC(ALC); } while (0)
#elif MLA_STEP_MODE == 2
  \
#define SGB(mask, n) __builtin_amdgcn_sched_group_barrier(mask, n, 0)
#define MLA_STEP(PC0, PC1, PP0, PP1, ALP, ALC) do { \
    { const char* Ks_ = K_lds + sc * SHM_K; \
      _Pragma("unroll") for (int d0 = 0; d0 < 6; ++d0) { const int cb = (d0 * 16 + hi * 8) * 2; \
        const bf16x8 b0 = *reinterpret_cast<const bf16x8*>(Ks_ + KSWZ(r32, cb)); const bf16x8 b1 = *reinterpret_cast<const bf16x8*>(Ks_ + KSWZ(32 + r32, cb)); \
        if (d0 == 0) { PC0 = __builtin_amdgcn_mfma_f32_32x32x16_bf16(b0, qr[0], negm, 0, 0, 0); PC1 = __builtin_amdgcn_mfma_f32_32x32x16_bf16(b1, qr[0], negm, 0, 0, 0); } \
        else { PC0 = __builtin_amdgcn_mfma_f32_32x32x16_bf16(b0, qr[d0], PC0, 0, 0, 0); PC1 = __builtin_amdgcn_mfma_f32_32x32x16_bf16(b1, qr[d0], PC1, 0, 0, 0); } } } \
    finishSM(PP0, PP1, ALP, l_reg, pa0, pa1, pa2, pa3); \
    SGB(0x100, 4); \
    _Pragma("unroll") for (int g_ = 0; g_ < 12; ++g_) { SGB(0x008, 1); SGB(0x100, 1); SGB(0x002, 7); } \
    SBAR(); \
    { const int vb_ = vb0 + sp * SHM_V; \
      const s16x4 l0 = tr_read<v_rd_off(0, 0, 0)>(vb_), h0 = tr_read<v_rd_off(0, 0, 1)>(vb_), l1 = tr_read<v_rd_off(0, 1, 0)>(vb_), h1 = tr_read<v_rd_off(0, 1, 1)>(vb_); \
      const s16x4 l2 = tr_read<v_rd_off(0, 2, 0)>(vb_), h2 = tr_read<v_rd_off(0, 2, 1)>(vb_), l3 = tr_read<v_rd_off(0, 3, 0)>(vb_), h3 = tr_read<v_rd_off(0, 3, 1)>(vb_); \
      const s16x4 l4 = tr_read<v_rd_off(1, 0, 0)>(vb_), h4 = tr_read<v_rd_off(1, 0, 1)>(vb_), l5 = tr_read<v_rd_off(1, 1, 0)>(vb_), h5 = tr_read<v_rd_off(1, 1, 1)>(vb_); \
      const s16x4 l6 = tr_read<v_rd_off(1, 2, 0)>(vb_), h6 = tr_read<v_rd_off(1, 2, 1)>(vb_), l7 = tr_read<v_rd_off(1, 3, 0)>(vb_), h7 = tr_read<v_rd_off(1, 3, 1)>(vb_); \
      asm volatile("s_waitcnt lgkmcnt(0)" ::: "memory"); SBAR(); \
      o[0] = __builtin_amdgcn_mfma_f32_32x32x16_bf16(pa0, PKV(l0, h0), o[0], 0, 0, 0); o[1] = __builtin_amdgcn_mfma_f32_32x32x16_bf16(pa0, PKV(l4, h4), o[1], 0, 0, 0); \
      o[0] = __builtin_amdgcn_mfma_f32_32x32x16_bf16(pa1, PKV(l1, h1), o[0], 0, 0, 0); o[1] = __builtin_amdgcn_mfma_f32_32x32x16_bf16(pa1, PKV(l5, h5), o[1], 0, 0, 0); \
      o[0] = __builtin_amdgcn_mfma_f32_32x32x16_bf16(pa2, PKV(l2, h2), o[0], 0, 0, 0); o[1] = __builtin_amdgcn_mfma_f32_32x32x16_bf16(pa2, PKV(l6, h6), o[1], 0, 0, 0); \
      o[0] = __builtin_amdgcn_mfma_f32_32x32x16_bf16(pa3, PKV(l3, h3), o[0], 0, 0, 0); o[1] = __builtin_amdgcn_mfma_f32_32x32x16_bf16(pa3, PKV(l7, h7), o[1], 0, 0, 0); \
      partialSM2<false>(PC0, PC1, m_reg, negm, ALC, exact); \
      _Pragma("unroll") for (int g_ = 0; g_ < 8; ++g_) { SGB(0x008, 1); SGB(0x002, 2); } \
      SBAR(); } \
    RESC(ALC); } while (0)
#else
#define MLA_STEP(PC0, PC1, PP0, PP1, ALP, ALC) do { \
    bf16x8 kf[12]; s16x4 val[4], vah[4], vbl[4], vbh[4]; const int vb_ = vb0 + sp * SHM_V; \
    kfrag_load(kf, K_lds + sc * SHM_K, r32, hi); SBAR(); \
    finishSM(PP0, PP1, ALP, l_reg, pa0, pa1, pa2, pa3); SBAR(); \
    vfrag_load_h<0>(val, vah, vb_); SBAR(); \
    qk_mma(PC0, PC1, kf, qr, negm); SBAR(); \
    vfrag_load_h<1>(vbl, vbh, vb_); SBAR(); \
    asm volatile("s_waitcnt lgkmcnt(8)" ::: "memory"); SBAR(); \
    pv_mma_h(o[0], val, vah, pa0, pa1, pa2, pa3); SBAR(); \
    asm volatile("s_waitcnt lgkmcnt(0)" ::: "memory"); SBAR(); \
    pv_mma_h(o[1], vbl, vbh, pa0, pa1, pa2, pa3); SBAR(); \
    partialSM2<false>(PC0, PC1, m_reg, negm, ALC); RESC(ALC); } while (0)
#endif

__device__ __forceinline__ void mla_unit_v2(int wv, int bh, int qb, const unsigned short* __restrict__ Q, const unsigned short* __restrict__ KN, const unsigned short* __restrict__ KR,
                                            const unsigned short* __restrict__ V, unsigned short* __restrict__ CAT, const float* __restrict__ KMX, char* lds) {
    const int wid = wv, lane = gm::lane_now(), tid = wid * 64 + lane, r32 = lane & 31, hi = lane >> 5;
    const int b = bh >> 3, h = bh & 7;
    char* K_lds = lds + M2_K; char* V_lds = lds + M2_V;
    float* wsf = (float*)(lds + M2_WS) + wid * 64; float* li_l = wsf; float* al_l = wsf + 32;
    float m_reg = 0.f, l_reg = 0; f32x16 o[2] = {}; bf16x8 qr[6]; f32x16 negm = f32x16{};
    const size_t bhS = (size_t)bh * S; const int q0 = qb * 256;
    const unsigned short* Qw = Q + (bhS + q0 + wid * 32 + r32) * 96 + hi * 8;
#pragma unroll
    for (int d0 = 0; d0 < 6; ++d0) qr[d0] = *reinterpret_cast<const bf16x8*>(Qw + d0 * 16);
    bool exact = true;
    if (MLA_STATIC) { float q2 = 0.f;
#pragma unroll
      for (int d0 = 0; d0 < 6; ++d0)
#pragma unroll
          for (int j = 0; j < 8; ++j) { const float x = __uint_as_float((unsigned)(unsigned short)qr[d0][j] << 16); q2 += x * x; }
      { auto rr = __builtin_amdgcn_permlane32_swap(__float_as_uint(q2), __float_as_uint(q2), false, false); q2 = __uint_as_float(rr[0]) + __uint_as_float(rr[1]); }
      const float k2 = KMX[(b * 8 + h) * 2] + KMX[(b * 8 + h) * 2 + 1] + KMX[32 + b];
      const float ms = 1.01f * sqrtf(q2 * k2);
      exact = __syncthreads_or(!(ms <= MLA_STATIC_THR)) != 0;
      if (!exact) { m_reg = ms;
#pragma unroll
          for (int r = 0; r < 16; ++r) negm[r] = -ms; } }
    const int srow = tid >> 3, sch = tid & 7, rrow = (tid & 255) >> 2, rch = tid & 3;
    const char* kn_u = (const char*)(KN + bhS * 64); const char* v_u = (const char*)(V + bhS * 64); const char* kr_u = (const char*)(KR + (size_t)b * S * 32);
    const unsigned kn_off = (unsigned)(srow * 64 + sch * 8) * 2u, kr_off = (unsigned)(rrow * 32 + rch * 8) * 2u;
    const int kst = KSWZ(srow, sch * 16), krst = KSWZ(rrow, (8 + rch) * 16), vst = v_st(srow, sch * 8);
    const int vb0 = (int)(uintptr_t)V_lds + v_rd_base(lane);
    bf16x8 s_kn[1], s_kr[1], s_v[1];
#define SLOAD(i, t) do { s_kn[i] = *reinterpret_cast<const bf16x8*>(kn_u + (size_t)(t) * 8192 + kn_off); s_kr[i] = *reinterpret_cast<const bf16x8*>(kr_u + (size_t)(t) * 4096 + kr_off); \
    s_v[i] = *reinterpret_cast<const bf16x8*>(v_u + (size_t)(t) * 8192 + kn_off); } while (0)
#define SWRITE(sl, i) do { *(bf16x8*)(K_lds + (sl) * SHM_K + kst) = s_kn[i]; if (tid < 256) *(bf16x8*)(K_lds + (sl) * SHM_K + krst) = s_kr[i]; *(bf16x8*)(V_lds + (sl) * SHM_V + vst) = s_v[i]; } while (0)
#define SWAIT() asm volatile("s_waitcnt vmcnt(0)" ::: "memory")
#define RESC(a) do { if (exact && __any((a) < 1.f)) { if (hi == 0) al_l[r32] = (a); asm volatile("s_waitcnt lgkmcnt(0)" ::: "memory"); \
    _Pragma("unroll") for (int d = 0; d < 2; ++d) _Pragma("unroll") for (int r = 0; r < 16; ++r) o[d][r] *= al_l[crow(r, hi)]; } } while (0)
#define ROT3(x) ((x) == 2 ? 0 : (x) + 1)
    f32x16 pA0, pA1, pB0, pB1; float alA, alB; bf16x8 pa0, pa1, pa2, pa3; constexpr int NT = S / 64;
    SLOAD(0, 0);
    SWAIT(); SWRITE(0, 0); SLOAD(0, 1);
    __syncthreads();
    qkt96n(pA0, pA1, K_lds, qr, negm, r32, hi); if (exact) partialSM2<true>(pA0, pA1, m_reg, negm, alA); else partialSM2<false>(pA0, pA1, m_reg, negm, alA, false);
    SWAIT(); SWRITE(1, 0); SLOAD(0, 2);
    __syncthreads();
    int sp = 0, sc = 1, sn = 2;
    for (int j = 1; j + 1 < NT; j += 2) {
        if (!MLA_PROBE_NOSTAGE) { SWAIT(); SWRITE(sn, 0); if (j + 2 < NT) SLOAD(0, j + 2); }
        SBAR(); MLA_STEP(pB0, pB1, pA0, pA1, alA, alB);
        __syncthreads();
        sp = sc; sc = sn; sn = ROT3(sn);
        if (!MLA_PROBE_NOSTAGE) { SWAIT(); SWRITE(sn, 0); if (j + 3 < NT) SLOAD(0, j + 3); }
        SBAR(); MLA_STEP(pA0, pA1, pB0, pB1, alB, alA);
        __syncthreads();
        sp = sc; sc = sn; sn = ROT3(sn);
    }
    SBAR(); MLA_STEP(pB0, pB1, pA0, pA1, alA, alB);
    finishSM(pB0, pB1, alB, l_reg, pa0, pa1, pa2, pa3); SBAR();
    { const int vb = vb0 + sc * SHM_V; pv_one_p<0>(o[0], vb, pa0, pa1, pa2, pa3); pv_one_p<1>(o[1], vb, pa0, pa1, pa2, pa3); }
    if (hi == 0) li_l[r32] = l_reg; asm volatile("s_waitcnt lgkmcnt(0)" ::: "memory");
    float rli[16];
#pragma unroll
    for (int r = 0; r < 16; ++r) rli[r] = __builtin_amdgcn_rcpf(li_l[crow(r, hi)]);
    unsigned short* stg = (unsigned short*)(lds + M2_OST) + wid * 2048;
    unsigned short* dst = CAT + ((size_t)b * S + q0 + wid * 32) * 1024 + h * 64;
    store_o_tile(o, rli, stg, dst, [](int row) { return (size_t)row * 1024; }, lane);
    asm volatile("s_waitcnt vmcnt(0)" ::: "memory");
    __syncthreads();
#undef SLOAD
#undef SWRITE
#undef SWAIT
#undef RESC
#undef ROT3
}


__device__ __forceinline__ void finishSM_s(f32x16& p0, f32x16& p1, float& l_reg, bf16x8& pa0, bf16x8& pa1, bf16x8& pa2, bf16x8& pa3) {
#pragma unroll
    for (int r = 0; r < 16; ++r) p1[r] = __builtin_amdgcn_exp2f(p1[r]);
    float ps = 0;
#pragma unroll
    for (int r = 0; r < 16; ++r) ps += p0[r];
#pragma unroll
    for (int r = 0; r < 16; ++r) ps += p1[r];
    l_reg += ps;
    PK4(p0, 0, pa0); PK4(p0, 8, pa1); PK4(p1, 0, pa2); PK4(p1, 8, pa3);
}
__device__ __forceinline__ void exp_half(f32x16& p0) {
#pragma unroll
    for (int r = 0; r < 16; ++r) p0[r] = __builtin_amdgcn_exp2f(p0[r]);
}
__device__ __forceinline__ bool mla_unit_v5(int wv, int bh, int qb, const unsigned short* __restrict__ Q, const unsigned short* __restrict__ KN, const unsigned short* __restrict__ KR,
                                            const unsigned short* __restrict__ V, unsigned short* __restrict__ CAT, const float* __restrict__ KMX, char* lds) {
    const int wid = wv, lane = gm::lane_now(), tid = wid * 64 + lane, r32 = lane & 31, hi = lane >> 5;
    const int b = bh >> 3, h = bh & 7;
    char* K_lds = lds + M2_K; char* V_lds = lds + M2_V;
    float* wsf = (float*)(lds + M2_WS) + wid * 64; float* li_l = wsf;
    float l_reg = 0; f32x16 o[2] = {}; bf16x8 qr[6];
    const size_t bhS = (size_t)bh * S; const int q0 = qb * 256;
    const unsigned short* Qw = Q + (bhS + q0 + wid * 32 + r32) * 96 + hi * 8;
#pragma unroll
    for (int d0 = 0; d0 < 6; ++d0) qr[d0] = *reinterpret_cast<const bf16x8*>(Qw + d0 * 16);
    f32x16 negm;
    { float q2 = 0.f;
#pragma unroll
      for (int d0 = 0; d0 < 6; ++d0)
#pragma unroll
          for (int j = 0; j < 8; ++j) { const float x = __uint_as_float((unsigned)(unsigned short)qr[d0][j] << 16); q2 += x * x; }
      { auto rr = __builtin_amdgcn_permlane32_swap(__float_as_uint(q2), __float_as_uint(q2), false, false); q2 = __uint_as_float(rr[0]) + __uint_as_float(rr[1]); }
      const float k2 = KMX[(b * 8 + h) * 2] + KMX[(b * 8 + h) * 2 + 1] + KMX[32 + b];
      const float m = 1.01f * sqrtf(q2 * k2);
#pragma unroll
      for (int r = 0; r < 16; ++r) negm[r] = -m; }
    const int srow = tid >> 3, sch = tid & 7, rrow = (tid & 255) >> 2, rch = tid & 3;
    const char* kn_u = (const char*)(KN + bhS * 64); const char* v_u = (const char*)(V + bhS * 64); const char* kr_u = (const char*)(KR + (size_t)b * S * 32);
    const unsigned kn_off = (unsigned)(srow * 64 + sch * 8) * 2u, kr_off = (unsigned)(rrow * 32 + rch * 8) * 2u;
    const int kst = KSWZ(srow, sch * 16), krst = KSWZ(rrow, (8 + rch) * 16), vst = v_st(srow, sch * 8);
    const int vb0 = (int)(uintptr_t)V_lds + v_rd_base(lane);
    bf16x8 s_kn, s_kr, s_v;
#define SLOAD(t) do { s_kn = *reinterpret_cast<const bf16x8*>(kn_u + (size_t)(t) * 8192 + kn_off); s_kr = *reinterpret_cast<const bf16x8*>(kr_u + (size_t)(t) * 4096 + kr_off); \
    s_v = *reinterpret_cast<const bf16x8*>(v_u + (size_t)(t) * 8192 + kn_off); } while (0)
#define SWRITE(sl) do { *(bf16x8*)(K_lds + (sl) * SHM_K + kst) = s_kn; if (tid < 256) *(bf16x8*)(K_lds + (sl) * SHM_K + krst) = s_kr; *(bf16x8*)(V_lds + (sl) * SHM_V + vst) = s_v; } while (0)
#define SWAIT() asm volatile("s_waitcnt vmcnt(0)" ::: "memory")
#define ROT3(x) ((x) == 2 ? 0 : (x) + 1)
#define STEP5(PC0, PC1, PP0, PP1) do { \
    qkt96n(PC0, PC1, K_lds + sc * SHM_K, qr, negm, r32, hi); \
    finishSM_s(PP0, PP1, l_reg, pa0, pa1, pa2, pa3); SBAR(); \
    { const int vb_ = vb0 + sp * SHM_V; pv_one_p<0>(o[0], vb_, pa0, pa1, pa2, pa3); pv_one_p<1>(o[1], vb_, pa0, pa1, pa2, pa3); } \
    exp_half(PC0); } while (0)
    f32x16 pA0, pA1, pB0, pB1; bf16x8 pa0, pa1, pa2, pa3; constexpr int NT = S / 64;
    SLOAD(0);
    SWAIT(); SWRITE(0); SLOAD(1);
    __syncthreads();
    qkt96n(pA0, pA1, K_lds, qr, negm, r32, hi); exp_half(pA0);
    SWAIT(); SWRITE(1); SLOAD(2);
    __syncthreads();
    int sp = 0, sc = 1, sn = 2;
    for (int j = 1; j + 1 < NT; j += 2) {
        SWAIT(); SWRITE(sn); if (j + 2 < NT) SLOAD(j + 2);
        SBAR(); STEP5(pB0, pB1, pA0, pA1);
        __syncthreads();
        sp = sc; sc = sn; sn = ROT3(sn);
        SWAIT(); SWRITE(sn); if (j + 3 < NT) SLOAD(j + 3);
        SBAR(); STEP5(pA0, pA1, pB0, pB1);
        __syncthreads();
        sp = sc; sc = sn; sn = ROT3(sn);
    }
    SBAR(); STEP5(pB0, pB1, pA0, pA1);
    finishSM_s(pB0, pB1, l_reg, pa0, pa1, pa2, pa3); SBAR();
    { const int vb = vb0 + sc * SHM_V; pv_one_p<0>(o[0], vb, pa0, pa1, pa2, pa3); pv_one_p<1>(o[1], vb, pa0, pa1, pa2, pa3); }
    { auto rr = __builtin_amdgcn_permlane32_swap(__float_as_uint(l_reg), __float_as_uint(l_reg), false, false); l_reg = __uint_as_float(rr[0]) + __uint_as_float(rr[1]); }
    const bool bad = !(l_reg > 1e-30f);
    if (hi == 0) li_l[r32] = l_reg; asm volatile("s_waitcnt lgkmcnt(0)" ::: "memory");
    float rli[16];
#pragma unroll
    for (int r = 0; r < 16; ++r) rli[r] = __builtin_amdgcn_rcpf(li_l[crow(r, hi)]);
    unsigned short* stg = (unsigned short*)(lds + M2_OST) + wid * 2048;
    unsigned short* dst = CAT + ((size_t)b * S + q0 + wid * 32) * 1024 + h * 64;
    store_o_tile(o, rli, stg, dst, [](int row) { return (size_t)row * 1024; }, lane);
    asm volatile("s_waitcnt vmcnt(0)" ::: "memory");
    const int anybad = __syncthreads_or(bad ? 1 : 0);
    return anybad != 0;
#undef SLOAD
#undef SWRITE
#undef SWAIT
#undef ROT3
#undef STEP5
}

constexpr int M4_K = 0, M4_V = 4 * SHM_K, M4_WS = M4_V + 4 * SHM_V, M4_OST = M4_WS + 8 * 256;
template <bool FIRST> __device__ __forceinline__ void softmax_full(f32x16& p0, f32x16& p1, float& m_reg, f32x16& negm, float& l_reg, float& alpha, bf16x8& pa0, bf16x8& pa1, bf16x8& pa2, bf16x8& pa3, bool exact) {
    if (exact) partialSM2<FIRST>(p0, p1, m_reg, negm, alpha, true); else partialSM2<false>(p0, p1, m_reg, negm, alpha, false);
    finishSM(p0, p1, alpha, l_reg, pa0, pa1, pa2, pa3);
}
__device__ __forceinline__ void mla_unit_v4(int wv, int bh, int qb, const unsigned short* __restrict__ Q, const unsigned short* __restrict__ KN, const unsigned short* __restrict__ KR,
                                            const unsigned short* __restrict__ V, unsigned short* __restrict__ CAT, const float* __restrict__ KMX, char* lds) {
    const int wid = wv, lane = gm::lane_now(), tid = wid * 64 + lane, r32 = lane & 31, hi = lane >> 5;
    const int b = bh >> 3, h = bh & 7; const bool halfB = wid >= 4;
    char* K_lds = lds + M4_K; char* V_lds = lds + M4_V;
    float* wsf = (float*)(lds + M4_WS) + wid * 64; float* li_l = wsf; float* al_l = wsf + 32;
    float m_reg = 0.f, l_reg = 0; f32x16 o[2] = {}; bf16x8 qr[6]; f32x16 negm = f32x16{};
    const size_t bhS = (size_t)bh * S; const int q0 = qb * 256;
    const unsigned short* Qw = Q + (bhS + q0 + wid * 32 + r32) * 96 + hi * 8;
#pragma unroll
    for (int d0 = 0; d0 < 6; ++d0) qr[d0] = *reinterpret_cast<const bf16x8*>(Qw + d0 * 16);
    bool exact = true;
    if (MLA_STATIC) { float q2 = 0.f;
#pragma unroll
      for (int d0 = 0; d0 < 6; ++d0)
#pragma unroll
          for (int j = 0; j < 8; ++j) { const float x = __uint_as_float((unsigned)(unsigned short)qr[d0][j] << 16); q2 += x * x; }
      { auto rr = __builtin_amdgcn_permlane32_swap(__float_as_uint(q2), __float_as_uint(q2), false, false); q2 = __uint_as_float(rr[0]) + __uint_as_float(rr[1]); }
      const float k2 = KMX[(b * 8 + h) * 2] + KMX[(b * 8 + h) * 2 + 1] + KMX[32 + b];
      const float ms = 1.01f * sqrtf(q2 * k2);
      exact = __syncthreads_or(!(ms <= MLA_STATIC_THR)) != 0;
      if (!exact) { m_reg = ms;
#pragma unroll
          for (int r = 0; r < 16; ++r) negm[r] = -ms; } }
    const int srow = tid >> 3, sch = tid & 7, rrow = (tid & 255) >> 2, rch = tid & 3;
    const char* kn_u = (const char*)(KN + bhS * 64); const char* v_u = (const char*)(V + bhS * 64); const char* kr_u = (const char*)(KR + (size_t)b * S * 32);
    const unsigned kn_off = (unsigned)(srow * 64 + sch * 8) * 2u, kr_off = (unsigned)(rrow * 32 + rch * 8) * 2u;
    const int kst = KSWZ(srow, sch * 16), krst = KSWZ(rrow, (8 + rch) * 16), vst = v_st(srow, sch * 8);
    const int vb0 = (int)(uintptr_t)V_lds + v_rd_base(lane);
    bf16x8 s_kn, s_kr, s_v;
#define SLOAD(t) do { s_kn = *reinterpret_cast<const bf16x8*>(kn_u + (size_t)(t) * 8192 + kn_off); s_kr = *reinterpret_cast<const bf16x8*>(kr_u + (size_t)(t) * 4096 + kr_off); \
    s_v = *reinterpret_cast<const bf16x8*>(v_u + (size_t)(t) * 8192 + kn_off); } while (0)
#define SWRITE(sl) do { *(bf16x8*)(K_lds + (sl) * SHM_K + kst) = s_kn; if (tid < 256) *(bf16x8*)(K_lds + (sl) * SHM_K + krst) = s_kr; *(bf16x8*)(V_lds + (sl) * SHM_V + vst) = s_v; } while (0)
#define SWAIT() asm volatile("s_waitcnt vmcnt(0)" ::: "memory")
#define RESC(a) do { if (exact && __any((a) < 1.f)) { if (hi == 0) al_l[r32] = (a); asm volatile("s_waitcnt lgkmcnt(0)" ::: "memory"); \
    _Pragma("unroll") for (int d = 0; d < 2; ++d) _Pragma("unroll") for (int r = 0; r < 16; ++r) o[d][r] *= al_l[crow(r, hi)]; } } while (0)
#define RAWBAR() do { asm volatile("" ::: "memory"); __builtin_amdgcn_s_barrier(); asm volatile("" ::: "memory"); } while (0)
    f32x16 p0, p1; float al; bf16x8 pa0, pa1, pa2, pa3; bf16x8 kf[12]; constexpr int NT = S / 64;
    SLOAD(0); SWAIT(); SWRITE(0); SLOAD(1); SWAIT(); SWRITE(1); SLOAD(2);
    asm volatile("s_waitcnt lgkmcnt(0)" ::: "memory"); RAWBAR();
    if (halfB) RAWBAR();
    kfrag_load(kf, K_lds, r32, hi); SBAR();
    qk_mma(p0, p1, kf, qr, negm); SBAR();
    asm volatile("s_waitcnt lgkmcnt(0)" ::: "memory"); RAWBAR();
    softmax_full<true>(p0, p1, m_reg, negm, l_reg, al, pa0, pa1, pa2, pa3, exact); SBAR();
    SWAIT(); SWRITE(2); SLOAD(3); SBAR();
    kfrag_load(kf, K_lds + SHM_K, r32, hi); SBAR();
    asm volatile("s_waitcnt lgkmcnt(12)" ::: "memory"); RAWBAR();
    int sp = 0, sc = 1, sw = 3;
    for (int t = 1; t < NT; ++t) {
        { s16x4 val[4], vah[4], vbl[4], vbh[4]; const int vb_ = vb0 + sp * SHM_V;
          vfrag_load_h<0>(val, vah, vb_); SBAR();
          qk_mma(p0, p1, kf, qr, negm); SBAR();
          vfrag_load_h<1>(vbl, vbh, vb_); SBAR();
          asm volatile("s_waitcnt lgkmcnt(8)" ::: "memory"); SBAR();
          pv_mma_h(o[0], val, vah, pa0, pa1, pa2, pa3); SBAR();
          asm volatile("s_waitcnt lgkmcnt(0)" ::: "memory"); SBAR();
          pv_mma_h(o[1], vbl, vbh, pa0, pa1, pa2, pa3); SBAR(); }
        RAWBAR();
        if (t + 2 < NT) { SWAIT(); SWRITE(sw); if (t + 3 < NT) SLOAD(t + 3); } SBAR();
        softmax_full<false>(p0, p1, m_reg, negm, l_reg, al, pa0, pa1, pa2, pa3, exact); RESC(al); SBAR();
        sp = sc; sc = (sc + 1) & 3; sw = (sw + 1) & 3;
        if (t + 1 < NT) { kfrag_load(kf, K_lds + sc * SHM_K, r32, hi); SBAR(); }
        asm volatile("s_waitcnt lgkmcnt(12)" ::: "memory"); RAWBAR();
    }
    { s16x4 val[4], vah[4], vbl[4], vbh[4]; const int vb_ = vb0 + sp * SHM_V;
      vfrag_load_h<0>(val, vah, vb_); vfrag_load_h<1>(vbl, vbh, vb_); SBAR();
      asm volatile("s_waitcnt lgkmcnt(0)" ::: "memory"); SBAR();
      pv_mma_h(o[0], val, vah, pa0, pa1, pa2, pa3); pv_mma_h(o[1], vbl, vbh, pa0, pa1, pa2, pa3); SBAR(); }
    if (!halfB) RAWBAR();
    if (hi == 0) li_l[r32] = l_reg; asm volatile("s_waitcnt lgkmcnt(0)" ::: "memory");
    float rli[16];
#pragma unroll
    for (int r = 0; r < 16; ++r) rli[r] = __builtin_amdgcn_rcpf(li_l[crow(r, hi)]);
    unsigned short* stg = (unsigned short*)(lds + M4_OST) + wid * 2048;
    unsigned short* dst = CAT + ((size_t)b * S + q0 + wid * 32) * 1024 + h * 64;
    store_o_tile(o, rli, stg, dst, [](int row) { return (size_t)row * 1024; }, lane);
    asm volatile("s_waitcnt vmcnt(0)" ::: "memory");
    __syncthreads();
#undef SLOAD
#undef SWRITE
#undef SWAIT
#undef RESC
#undef RAWBAR
}

constexpr int DL_K = 0, DL_V = 49152, DL_WS = 98304, DL_OST = DL_WS + 8 * 256;
#define KSWZD(row, colB) ((row) * 128 + ((colB) ^ ((((row) >> 1) & 7) << 4)))
__device__ __forceinline__ void dil_unit(int wv, int bh, int br, int blk, const unsigned short* __restrict__ DQ, const unsigned short* __restrict__ DK, const unsigned short* __restrict__ DV,
                                         unsigned short* __restrict__ OBR, float* __restrict__ LSE, char* lds) {
    const int wid = wv, lane = gm::lane_now(), tid = wid * 64 + lane, r32 = lane & 31, hi = lane >> 5;
    const int sh = 2 * br, dil = 1 << sh, L = S >> sh, nbl = L >> 8, res = blk / nbl, lb = blk % nbl;
    const size_t bhS = (size_t)bh * S; const int b = bh >> 3, h = bh & 7;
    char* K_lds = lds + DL_K; char* V_lds = lds + DL_V;
#pragma unroll
    for (int half = 0; half < 2; ++half) {
        bf16x8 kk[3], vv[3];
#pragma unroll
        for (int it = 0; it < 3; ++it) { const int item = (half * 3 + it) * 512 + tid, row = item >> 3, ch = item & 7; const int l = 256 * lb - 64 + row; const bool valid = (l >= 0) && (l < L);
            const size_t src = (bhS + (valid ? ((size_t)l << sh) + res : 0)) * 64 + ch * 8;
            kk[it] = *reinterpret_cast<const bf16x8*>(DK + src); vv[it] = *reinterpret_cast<const bf16x8*>(DV + src);
            if (!valid) { kk[it] = bf16x8{}; vv[it] = bf16x8{}; } }
#pragma unroll
        for (int it = 0; it < 3; ++it) { const int item = (half * 3 + it) * 512 + tid, row = item >> 3, ch = item & 7;
            *(bf16x8*)(K_lds + KSWZD(row, ch * 16)) = kk[it]; *(bf16x8*)(V_lds + (row >> 4) * 2048 + v_st(row & 15, ch * 8)) = vv[it]; }
    }
    bf16x8 qr[4];
    const int ql = wid * 32 + r32; const size_t qpos = ((size_t)(256 * lb + ql) << sh) + res;
    const unsigned short* Qw = DQ + (bhS + qpos) * 64 + hi * 8;
#pragma unroll
    for (int d0 = 0; d0 < 4; ++d0) qr[d0] = *reinterpret_cast<const bf16x8*>(Qw + d0 * 16);
    __syncthreads();
    f32x16 p[5];
#pragma unroll
    for (int j = 0; j < 5; ++j) { p[j] = f32x16{}; const int row = wid * 32 + j * 32 + r32;
#pragma unroll
        for (int d0 = 0; d0 < 4; ++d0) { const bf16x8 kf = *reinterpret_cast<const bf16x8*>(K_lds + KSWZD(row, (d0 * 16 + hi * 8) * 2)); p[j] = __builtin_amdgcn_mfma_f32_32x32x16_bf16(kf, qr[d0], p[j], 0, 0, 0); } }
    const float NEG = -1e30f;
    const int klo = 64 - 256 * lb, khi = L + 64 - 256 * lb;
    { const int t0 = max(r32, klo - wid * 32) - 4 * hi, t1 = klo - wid * 32 - 32 - 4 * hi, t3 = khi - wid * 32 - 96 - 4 * hi, t4 = min(r32 + 1, khi - wid * 32 - 128) - 4 * hi;
#pragma unroll
      for (int r = 0; r < 16; ++r) { const int c = (r & 3) + 8 * (r >> 2);
          if (c < t0) p[0][r] = NEG; if (c < t1) p[1][r] = NEG; if (c >= t3) p[3][r] = NEG; if (c >= t4) p[4][r] = NEG; } }
    float mx = rowmax32(p[0], p[1]); mx = fmaxf(mx, rowmax32(p[2], p[3]));
    { float m4 = p[4][0];
#pragma unroll
      for (int r = 1; r < 16; ++r) m4 = fmaxf(m4, p[4][r]);
      auto rr = __builtin_amdgcn_permlane32_swap(__float_as_uint(m4), __float_as_uint(m4), false, false); mx = fmaxf(mx, fmaxf(__uint_as_float(rr[0]), __uint_as_float(rr[1]))); }
    float ps = 0.f;
#pragma unroll
    for (int j = 0; j < 5; ++j)
#pragma unroll
        for (int r = 0; r < 16; ++r) { p[j][r] = __builtin_amdgcn_exp2f(p[j][r] - mx); ps += p[j][r]; }
    { auto rr = __builtin_amdgcn_permlane32_swap(__float_as_uint(ps), __float_as_uint(ps), false, false); ps = __uint_as_float(rr[0]) + __uint_as_float(rr[1]); }
    bf16x8 pa[5][2];
#pragma unroll
    for (int j = 0; j < 5; ++j) { PK4(p[j], 0, pa[j][0]); PK4(p[j], 8, pa[j][1]); }
    f32x16 o[2] = {};
    const int vb = (int)(uintptr_t)V_lds + v_rd_base(lane) + wid * 4096;
    pv_half<0, 0 * 4096>(o[0], vb, pa[0][0], pa[0][1]); pv_half<1, 0 * 4096>(o[1], vb, pa[0][0], pa[0][1]);
    pv_half<0, 1 * 4096>(o[0], vb, pa[1][0], pa[1][1]); pv_half<1, 1 * 4096>(o[1], vb, pa[1][0], pa[1][1]);
    pv_half<0, 2 * 4096>(o[0], vb, pa[2][0], pa[2][1]); pv_half<1, 2 * 4096>(o[1], vb, pa[2][0], pa[2][1]);
    pv_half<0, 3 * 4096>(o[0], vb, pa[3][0], pa[3][1]); pv_half<1, 3 * 4096>(o[1], vb, pa[3][0], pa[3][1]);
    pv_half<0, 4 * 4096>(o[0], vb, pa[4][0], pa[4][1]); pv_half<1, 4 * 4096>(o[1], vb, pa[4][0], pa[4][1]);
    float* wsf = (float*)(lds + DL_WS) + wid * 64;
    if (hi == 0) { wsf[r32] = ps; LSE[((size_t)br * T + (size_t)b * S + qpos) * 8 + h] = mx + __builtin_amdgcn_logf(ps); }
    asm volatile("s_waitcnt lgkmcnt(0)" ::: "memory");
    float rli[16];
#pragma unroll
    for (int r = 0; r < 16; ++r) rli[r] = __builtin_amdgcn_rcpf(wsf[crow(r, hi)]);
    unsigned short* stg = (unsigned short*)(lds + DL_OST) + wid * 2048;
    unsigned short* dst = OBR + ((size_t)br * T + (size_t)b * S + (((size_t)(256 * lb + wid * 32)) << sh) + res) * 512 + h * 64;
    store_o_tile(o, rli, stg, dst, [sh](int row) { return ((size_t)row << sh) * 512; }, lane);
    asm volatile("s_waitcnt vmcnt(0)" ::: "memory");
    __syncthreads();
}
#define DIL_DECODE(u, bh_, br_, res_, lb_, sh_, L_) const int bh_ = (u) / 96, br_ = ((u) >> 5) % 3, blk__##bh_ = (u) & 31, sh_ = 2 * br_, L_ = S >> sh_, nbl__##bh_ = L_ >> 8, res_ = blk__##bh_ / nbl__##bh_, lb_ = blk__##bh_ % nbl__##bh_
__device__ __forceinline__ void dil_phase(int wv, int u0, int ustep, int nunits, const unsigned short* __restrict__ DQ, const unsigned short* __restrict__ DK, const unsigned short* __restrict__ DV,
                                          unsigned short* __restrict__ OBR, float* __restrict__ LSE, char* lds) {
    const int wid = wv, lane = gm::lane_now(), tid = wid * 64 + lane, r32 = lane & 31, hi = lane >> 5;
    char* K_lds = lds + DL_K; char* V_lds = lds + DL_V;
    bf16x8 kk[6], qn[4]; unsigned kmask = 0u;
#define DIL_LOAD6(dst, mask, SRC, u) do { DIL_DECODE(u, bh_, br_, res_, lb_, sh_, L_); const size_t bhS_ = (size_t)bh_ * S; mask = 0u; \
        _Pragma("unroll") for (int it = 0; it < 6; ++it) { const int item = it * 512 + tid, row = item >> 3, ch = item & 7; const int l = 256 * lb_ - 64 + row; const bool valid = (l >= 0) && (l < L_); \
            const size_t src = (bhS_ + (valid ? ((size_t)l << sh_) + res_ : 0)) * 64 + ch * 8; dst[it] = *reinterpret_cast<const bf16x8*>(SRC + src); mask |= (valid ? 1u : 0u) << it; } } while (0)
#define DIL_LOADQ(u) do { DIL_DECODE(u, bh_, br_, res_, lb_, sh_, L_); const size_t qpos_ = ((size_t)(256 * lb_ + wid * 32 + r32) << sh_) + res_; const unsigned short* Qw_ = DQ + ((size_t)bh_ * S + qpos_) * 64 + hi * 8; \
        _Pragma("unroll") for (int d0 = 0; d0 < 4; ++d0) qn[d0] = *reinterpret_cast<const bf16x8*>(Qw_ + d0 * 16); } while (0)
    int u = u0;
    if (u < nunits) { DIL_LOAD6(kk, kmask, DK, u); DIL_LOADQ(u); }
    for (; u < nunits; u += ustep) {
        DIL_DECODE(u, bh, br, res, lb, sh, L); const int b = bh >> 3, h = bh & 7;
#pragma unroll
        for (int it = 0; it < 6; ++it) { const int item = it * 512 + tid, row = item >> 3, ch = item & 7; *(bf16x8*)(K_lds + KSWZD(row, ch * 16)) = ((kmask >> it) & 1u) ? kk[it] : bf16x8{}; }
        bf16x8 qr[4];
#pragma unroll
        for (int d0 = 0; d0 < 4; ++d0) qr[d0] = qn[d0];
        bf16x8 vv[6]; unsigned vmask; DIL_LOAD6(vv, vmask, DV, u);
        __syncthreads();
        const int ql = wid * 32 + r32; const size_t qpos = ((size_t)(256 * lb + ql) << sh) + res;
        f32x16 p[5];
#pragma unroll
        for (int j = 0; j < 5; ++j) { p[j] = f32x16{}; const int row = wid * 32 + j * 32 + r32;
#pragma unroll
            for (int d0 = 0; d0 < 4; ++d0) { const bf16x8 kf = *reinterpret_cast<const bf16x8*>(K_lds + KSWZD(row, (d0 * 16 + hi * 8) * 2)); p[j] = __builtin_amdgcn_mfma_f32_32x32x16_bf16(kf, qr[d0], p[j], 0, 0, 0); } }
        const float NEG = -1e30f;
        const int klo = 64 - 256 * lb, khi = L + 64 - 256 * lb;
        { const int t0 = max(r32, klo - wid * 32) - 4 * hi, t1 = klo - wid * 32 - 32 - 4 * hi, t3 = khi - wid * 32 - 96 - 4 * hi, t4 = min(r32 + 1, khi - wid * 32 - 128) - 4 * hi;
#pragma unroll
          for (int r = 0; r < 16; ++r) { const int c = (r & 3) + 8 * (r >> 2);
              if (c < t0) p[0][r] = NEG; if (c < t1) p[1][r] = NEG; if (c >= t3) p[3][r] = NEG; if (c >= t4) p[4][r] = NEG; } }
        float mx = rowmax32(p[0], p[1]); mx = fmaxf(mx, rowmax32(p[2], p[3]));
        { float m4 = p[4][0];
#pragma unroll
          for (int r = 1; r < 16; ++r) m4 = fmaxf(m4, p[4][r]);
          auto rr = __builtin_amdgcn_permlane32_swap(__float_as_uint(m4), __float_as_uint(m4), false, false); mx = fmaxf(mx, fmaxf(__uint_as_float(rr[0]), __uint_as_float(rr[1]))); }
        float ps = 0.f;
#pragma unroll
        for (int j = 0; j < 5; ++j)
#pragma unroll
            for (int r = 0; r < 16; ++r) { p[j][r] = __builtin_amdgcn_exp2f(p[j][r] - mx); ps += p[j][r]; }
        { auto rr = __builtin_amdgcn_permlane32_swap(__float_as_uint(ps), __float_as_uint(ps), false, false); ps = __uint_as_float(rr[0]) + __uint_as_float(rr[1]); }
        bf16x8 pa[5][2];
#pragma unroll
        for (int j = 0; j < 5; ++j) { PK4(p[j], 0, pa[j][0]); PK4(p[j], 8, pa[j][1]); }
#pragma unroll
        for (int it = 0; it < 6; ++it) { const int item = it * 512 + tid, row = item >> 3, ch = item & 7; *(bf16x8*)(V_lds + (row >> 4) * 2048 + v_st(row & 15, ch * 8)) = ((vmask >> it) & 1u) ? vv[it] : bf16x8{}; }
        __syncthreads();
        if (u + ustep < nunits) { DIL_LOAD6(kk, kmask, DK, u + ustep); DIL_LOADQ(u + ustep); }
        f32x16 o[2] = {};
        const int vb = (int)(uintptr_t)V_lds + v_rd_base(lane) + wid * 4096;
        pv_half<0, 0 * 4096>(o[0], vb, pa[0][0], pa[0][1]); pv_half<1, 0 * 4096>(o[1], vb, pa[0][0], pa[0][1]);
        pv_half<0, 1 * 4096>(o[0], vb, pa[1][0], pa[1][1]); pv_half<1, 1 * 4096>(o[1], vb, pa[1][0], pa[1][1]);
        pv_half<0, 2 * 4096>(o[0], vb, pa[2][0], pa[2][1]); pv_half<1, 2 * 4096>(o[1], vb, pa[2][0], pa[2][1]);
        pv_half<0, 3 * 4096>(o[0], vb, pa[3][0], pa[3][1]); pv_half<1, 3 * 4096>(o[1], vb, pa[3][0], pa[3][1]);
        pv_half<0, 4 * 4096>(o[0], vb, pa[4][0], pa[4][1]); pv_half<1, 4 * 4096>(o[1], vb, pa[4][0], pa[4][1]);
        float* wsf = (float*)(lds + DL_WS) + wid * 64;
        if (hi == 0) { wsf[r32] = ps; LSE[((size_t)br * T + (size_t)b * S + qpos) * 8 + h] = mx + __builtin_amdgcn_logf(ps); }
        asm volatile("s_waitcnt lgkmcnt(0)" ::: "memory");
        float rli[16];
#pragma unroll
        for (int r = 0; r < 16; ++r) rli[r] = __builtin_amdgcn_rcpf(wsf[crow(r, hi)]);
        unsigned short* stg = (unsigned short*)(lds + DL_OST) + wid * 2048;
        unsigned short* dst = OBR + ((size_t)br * T + (size_t)b * S + (((size_t)(256 * lb + wid * 32)) << sh) + res) * 512 + h * 64;
        store_o_tile(o, rli, stg, dst, [sh](int row) { return ((size_t)row << sh) * 512; }, lane);
        __syncthreads();
    }
#undef DIL_LOAD6
#undef DIL_LOADQ
}
__device__ __forceinline__ void dil_combine(const unsigned short* __restrict__ OBR, const float* __restrict__ LSE, unsigned short* __restrict__ CAT, int gtid, int gthreads) {
    for (int i = gtid; i < T * 64; i += gthreads) { const int t = i >> 6, c8 = i & 63, h = c8 >> 3;
        const float l0 = LSE[((size_t)0 * T + t) * 8 + h], l1 = LSE[((size_t)1 * T + t) * 8 + h], l2 = LSE[((size_t)2 * T + t) * 8 + h];
        const float mx = fmaxf(l0, fmaxf(l1, l2)); float w0 = __builtin_amdgcn_exp2f(l0 - mx), w1 = __builtin_amdgcn_exp2f(l1 - mx), w2 = __builtin_amdgcn_exp2f(l2 - mx);
        const float inv = 1.f / (w0 + w1 + w2); w0 *= inv; w1 *= inv; w2 *= inv;
        const u32x4 a = *(const u32x4*)(OBR + ((size_t)0 * T + t) * 512 + c8 * 8), bb = *(const u32x4*)(OBR + ((size_t)1 * T + t) * 512 + c8 * 8), cc = *(const u32x4*)(OBR + ((size_t)2 * T + t) * 512 + c8 * 8);
        u32x4 o;
#pragma unroll
        for (int k = 0; k < 4; ++k) { const float lo = w0 * __uint_as_float(a[k] << 16) + w1 * __uint_as_float(bb[k] << 16) + w2 * __uint_as_float(cc[k] << 16);
            const float hi = w0 * __uint_as_float(a[k] & 0xffff0000u) + w1 * __uint_as_float(bb[k] & 0xffff0000u) + w2 * __uint_as_float(cc[k] & 0xffff0000u); o[k] = cvtpk(lo, hi); }
        *(u32x4*)(CAT + (size_t)t * 1024 + 512 + c8 * 8) = o; }
}
#undef SBAR
}
namespace mk {
struct SchedP4 {
    __device__ __forceinline__ void a_ready(const gm::Unit&, int) const {}
    __device__ __forceinline__ void done(const gm::Unit&, int) const {}
    static constexpr bool GATHER = false;
    const char* A; const char* Bt; int G, c;
    __device__ __forceinline__ bool next(int i, gm::Unit& u) const { int pm, pn; if (!static_tile(i, G, c, 64, 4, pm, pn)) return false;
        u.A = A; u.Bt = Bt; u.gidx = nullptr; u.lda2 = 2048; u.ldb2 = 2048; u.arow0 = pm * 256; u.brow0 = pn * 256; u.nt = 16; u.pm = pm; u.pn = pn; u.aux = 0; return true; }
};
struct EpiP4 {
    static constexpr bool PERM = false;
    const float* x; float* out; const float* modf;
    __device__ __forceinline__ void operator()(EPI_ARGS) const {
        const int b = (u.pm * 256) >> 13; const float* gt = modf + b * 6144 + 2048;
        const int col0 = u.pn * 256 + wc * 32 + 4 * fq;
        f32x4 g[2][2];
#pragma unroll
        for (int bj = 0; bj < 2; ++bj)
#pragma unroll
            for (int n = 0; n < 2; ++n) g[bj][n] = *(const f32x4*)(gt + col0 + bj * 128 + n * 16);
#pragma unroll
        for (int ai = 0; ai < 2; ++ai)
#pragma unroll
            for (int m = 0; m < 4; ++m) { const size_t off = (size_t)(u.pm * 256 + ai * 128 + wr * 64 + m * 16 + fr) * D + col0;
#pragma unroll
                for (int bj = 0; bj < 2; ++bj)
#pragma unroll
                    for (int n = 0; n < 2; ++n) { const f32x4 xv = *(const f32x4*)(x + off + bj * 128 + n * 16); *(f32x4*)(out + off + bj * 128 + n * 16) = xv + g[bj][n] * acc[ai][bj][m][n]; } }
    }
};
__device__ __forceinline__ void p4b_rows(Frame& F) {
    const int tid_ = F.wave * 64 + fresh_lane();
    LAS float* WR = (LAS float*)F.lds;
    LAS float* A1 = WR + 16384;
    LAS float* A0 = A1 + 2048;
    const float* modf = (const float*)(F.ws + WS_MODF);
    for (int i = tid_; i < 16384; i += NTHREADS) { const int j = i >> 4, e = i & 15; WR[e * 1024 + j] = F.w_router[i]; }
    for (int i = tid_; i < 2048; i += NTHREADS) { const int b = i >> 10, j = i & 1023; A1[i] = F.g_ffn[j] * (1.f + modf[b * 6144 + 4096 + j]); A0[i] = modf[b * 6144 + 3072 + j]; }
    __syncthreads();
    const int gw = F.vcu * NWAVES + F.wave, NGW = F.G * NWAVES, lane = fresh_lane();
    for (int m = gw; m < T; m += NGW) { const int b = m >> 13, s = m & 8191;
        const f32x4* xr = (const f32x4*)(F.out + (size_t)m * D) + lane; f32x4 v[4]; float ss = 0.f;
#pragma unroll
        for (int j = 0; j < 4; ++j) { v[j] = xr[64 * j]; ss += (v[j].x * v[j].x + v[j].y * v[j].y) + (v[j].z * v[j].z + v[j].w * v[j].w); }
        const float rstd = rsqrtf(wave_sum(ss) * (1.f / D) + EPS);
        unsigned long long* o8 = (unsigned long long*)((bf16_t*)(F.ws + WS_HB) + (size_t)m * D) + lane;
        float lg[16];
#pragma unroll
        for (int e = 0; e < 16; ++e) lg[e] = 0.f;
#pragma unroll
        for (int j = 0; j < 4; ++j) { asm volatile("" ::: "memory");
            const f32x4 a1 = *(const LAS f32x4*)(A1 + b * 1024 + 4 * lane + 256 * j), a0 = *(const LAS f32x4*)(A0 + b * 1024 + 4 * lane + 256 * j);
            const f32x4 o = v[j] * rstd * a1 + a0; o8[64 * j] = (unsigned long long)pk2(o.x, o.y) | ((unsigned long long)pk2(o.z, o.w) << 32);
#pragma unroll
            for (int e = 0; e < 16; ++e) { const f32x4 w = *(const LAS f32x4*)(WR + e * 1024 + 4 * lane + 256 * j); lg[e] += (o.x * w.x + o.y * w.y) + (o.z * w.z + o.w * w.w); } }
        float w8[8], w4[4], w2[2], w1;
        { const bool up = lane & 32;
#pragma unroll
          for (int i = 0; i < 8; ++i) { const float snd = up ? lg[i] : lg[8 + i], kp = up ? lg[8 + i] : lg[i]; w8[i] = kp + __shfl_xor(snd, 32); } }
        { const bool up = lane & 16;
#pragma unroll
          for (int i = 0; i < 4; ++i) { const float snd = up ? w8[i] : w8[4 + i], kp = up ? w8[4 + i] : w8[i]; w4[i] = kp + __shfl_xor(snd, 16); } }
        { const bool up = lane & 8;
#pragma unroll
          for (int i = 0; i < 2; ++i) { const float snd = up ? w4[i] : w4[2 + i], kp = up ? w4[2 + i] : w4[i]; w2[i] = kp + __shfl_xor(snd, 8); } }
        { const bool up = lane & 4; const float snd = up ? w2[0] : w2[1], kp = up ? w2[1] : w2[0]; w1 = kp + __shfl_xor(snd, 4); }
        w1 += __shfl_xor(w1, 1); w1 += __shfl_xor(w1, 2);
        const int e = lane >> 2; const float logit = w1 + F.b_router[e];
        float mx = logit;
#pragma unroll
        for (int o = 4; o < 64; o <<= 1) mx = fmaxf(mx, __shfl_xor(mx, o));
        const float ex = __expf(logit - mx); float den = ex;
#pragma unroll
        for (int o = 4; o < 64; o <<= 1) den += __shfl_xor(den, o);
        if ((lane & 3) == 0) ((float*)(F.ws + WS_AFF))[((size_t)b * 16 + e) * S + s] = ex / den;
    }
    __syncthreads();
}
__device__ __forceinline__ void p5_topk(Frame& F) {
    if (F.vcu >= 32) { if (WD_IN_P5 && F.G > 32) wd_convert(F, 32); return; }
    const int be = F.vcu, b = be >> 4, e = be & 15, tid = F.wave * 64 + fresh_lane();
    LAS unsigned* vals = (LAS unsigned*)F.lds;
    LAS unsigned* hist = vals + 8192;
    LAS unsigned* suf = hist + 256;
    LAS unsigned* misc = suf + 264;
    LAS unsigned* wtot = misc + 8;
    const float* a = (const float*)(F.ws + WS_AFF) + (size_t)be * S;
    for (int i = tid; i < 8192; i += NTHREADS) vals[i] = __float_as_uint(a[i]);
    if (tid == 0) { misc[0] = 0u; misc[1] = 1024u; }
    __syncthreads();
    for (int pass = 0; pass < 4; ++pass) {
        const int sh = 24 - 8 * pass; const unsigned prefix = misc[0], k = misc[1]; const unsigned himask = pass == 0 ? 0u : (0xffffffffu << (sh + 8));
        if (tid < 256) hist[tid] = 0u;
        __syncthreads();
        {
            const unsigned cand = (vals[0] >> sh) & 255u; unsigned nc = 0u;
            for (int i = tid; i < 8192; i += NTHREADS) { const unsigned v = vals[i]; if ((v & himask) == prefix) { const unsigned bn = (v >> sh) & 255u; if (bn == cand) ++nc; else __hip_atomic_fetch_add(&hist[bn], 1u, __ATOMIC_RELAXED, __HIP_MEMORY_SCOPE_WORKGROUP); } }
#pragma unroll
            for (int o = 1; o < 64; o <<= 1) nc += __shfl_xor(nc, o);
            if ((tid & 63) == 0 && nc) __hip_atomic_fetch_add(&hist[cand], nc, __ATOMIC_RELAXED, __HIP_MEMORY_SCOPE_WORKGROUP);
        }
        __syncthreads();
        if (tid < 64) {
            const int l = tid; const unsigned h0 = hist[4 * l], h1 = hist[4 * l + 1], h2 = hist[4 * l + 2], h3 = hist[4 * l + 3];
            const unsigned tot = (h0 + h1) + (h2 + h3); unsigned inc = tot;
#pragma unroll
            for (int o = 1; o < 64; o <<= 1) { const unsigned t = __shfl_down(inc, o); if (l + o < 64) inc += t; }
            const unsigned above = inc - tot;
            const unsigned s3 = above + h3, s2 = s3 + h2, s1 = s2 + h1, s0 = s1 + h0;
            int bin = -1; unsigned gt = 0u;
            if (s3 >= k && above < k) { bin = 4 * l + 3; gt = above; } else if (s2 >= k && s3 < k) { bin = 4 * l + 2; gt = s3; } else if (s1 >= k && s2 < k) { bin = 4 * l + 1; gt = s2; } else if (s0 >= k && s1 < k) { bin = 4 * l; gt = s1; }
            if (bin >= 0) { misc[0] = prefix | ((unsigned)bin << sh); misc[1] = k - gt; }
        }
        __syncthreads();
    }
    const unsigned thr = misc[0], need = misc[1];
    unsigned gtc = 0, eqc = 0;
#pragma unroll
    for (int i = 0; i < 16; ++i) { const unsigned v = vals[tid * 16 + i]; gtc += v > thr; eqc += v == thr; }
    unsigned gi = gtc, ei = eqc; const int lane = fresh_lane(), wv = F.wave;
#pragma unroll
    for (int o = 1; o < 64; o <<= 1) { const unsigned g2 = __shfl_up(gi, o), e2 = __shfl_up(ei, o); if (lane >= o) { gi += g2; ei += e2; } }
    if (lane == 63) { wtot[wv] = gi; wtot[8 + wv] = ei; }
    __syncthreads();
    unsigned gbase = 0, ebase = 0, gtotal = 0;
    for (int w = 0; w < 8; ++w) { const unsigned g = wtot[w], q = wtot[8 + w]; if (w < wv) { gbase += g; ebase += q; } gtotal += g; }
    unsigned gpos = gbase + gi - gtc, epos = ebase + ei - eqc;
    int* IDX = (int*)(F.ws + WS_IDX) + (e * 2 + b) * 1024; float* GATE = (float*)(F.ws + WS_GATE) + (e * 2 + b) * 1024; int* SLOT = (int*)(F.ws + WS_SLOT);
#pragma unroll
    for (int i = 0; i < 16; ++i) { const int s = tid * 16 + i; const unsigned v = vals[s]; int c = -1;
        if (v > thr) c = (int)gpos++; else if (v == thr) { if (epos < need) c = (int)(gtotal + epos); ++epos; }
        if (c >= 0) { IDX[c] = b * S + s; GATE[c] = __uint_as_float(v); }
        SLOT[(size_t)(b * S + s) * 16 + e] = c >= 0 ? (e * 2 + b) * 1024 + c : -1; }
}
struct SchedP6a {
    __device__ __forceinline__ void a_ready(const gm::Unit&, int) const {}
    __device__ __forceinline__ void done(const gm::Unit&, int) const {}
    static constexpr bool GATHER = true;
    const char* A; const char* W; const int* idx; int G, vcu;
    __device__ __forceinline__ bool next(int i, gm::Unit& u) const {
        int e, pmu, pn;
        if (G == 256) { if (i >= 4) return false; const int xcd = vcu >> 5, j = vcu & 31; e = xcd + 8 * (i >> 1); const int sub = (i & 1) * 32 + j; pmu = sub >> 3; pn = sub & 7; }
        else { const int L = i * G + vcu; if (L >= 1024) return false; e = L >> 6; pmu = (L >> 3) & 7; pn = L & 7; }
        u.A = A; u.gidx = idx + e * 2048 + pmu * 256; u.lda2 = 2048; u.arow0 = 0; u.Bt = W + (size_t)e * 2048 * 2048; u.brow0 = pn * 256; u.ldb2 = 2048; u.nt = 16; u.pm = e * 8 + pmu; u.pn = pn; u.aux = e; return true; }
};
struct EpiP6a {
    static constexpr bool PERM = true;
    bf16_t* H;
    __device__ __forceinline__ void operator()(EPI_ARGS) const {
#pragma unroll
        for (int ai = 0; ai < 2; ++ai)
#pragma unroll
            for (int m = 0; m < 4; ++m) { const size_t row = (size_t)u.pm * 256 + ai * 128 + wr * 64 + m * 16 + fr;
                f32x4 h0, h1;
#pragma unroll
                for (int j = 0; j < 4; ++j) { h0[j] = siluf(acc[ai][0][m][0][j]) * acc[ai][1][m][0][j]; h1[j] = siluf(acc[ai][0][m][1][j]) * acc[ai][1][m][1][j]; }
                *(u32x4*)(H + row * 1024 + u.pn * 128 + wc * 32 + 8 * fq) = pack8(h0, h1); }
    }
};
struct SchedP6b {
    __device__ __forceinline__ void a_ready(const gm::Unit&, int) const {}
    __device__ __forceinline__ void done(const gm::Unit&, int) const {}
    static constexpr bool GATHER = false;
    const char* A; const char* W; int G, vcu;
    __device__ __forceinline__ bool next(int i, gm::Unit& u) const {
        int e, pmu, pn;
        if (G == 256) { if (i >= 2) return false; const int xcd = vcu >> 5, j = vcu & 31; e = xcd + 8 * i; pmu = j >> 2; pn = j & 3; }
        else { const int L = i * G + vcu; if (L >= 512) return false; e = L >> 5; pmu = (L >> 2) & 7; pn = L & 3; }
        u.A = A; u.gidx = nullptr; u.lda2 = 2048; u.arow0 = (e * 8 + pmu) * 256; u.Bt = W + (size_t)e * 1024 * 2048; u.brow0 = pn * 256; u.ldb2 = 2048; u.nt = 16; u.pm = e * 8 + pmu; u.pn = pn; u.aux = e; return true; }
};
struct EpiP6b {
    static constexpr bool PERM = true;
    bf16_t* Y; const float* gate;
    __device__ __forceinline__ void operator()(EPI_ARGS) const {
#pragma unroll
        for (int ai = 0; ai < 2; ++ai)
#pragma unroll
            for (int m = 0; m < 4; ++m) { const size_t row = (size_t)u.pm * 256 + ai * 128 + wr * 64 + m * 16 + fr; const float g = gate[row];
#pragma unroll
                for (int bj = 0; bj < 2; ++bj) *(u32x4*)(Y + row * 1024 + u.pn * 256 + bj * 128 + wc * 32 + 8 * fq) = pack8(acc[ai][bj][m][0] * g, acc[ai][bj][m][1] * g); }
    }
};
__device__ __forceinline__ void p7_final(Frame& F) {
    const float* modf = (const float*)(F.ws + WS_MODF); const int* SLOT = (const int*)(F.ws + WS_SLOT); const bf16_t* Y = (const bf16_t*)(F.ws + WS_Y);
    const int gw = F.vcu * NWAVES + F.wave, NGW = F.G * NWAVES, lane = fresh_lane();
    for (int m0 = gw; m0 < T; m0 += 2 * NGW) {
        const int m1 = m0 + NGW; const bool has1 = m1 < T; const int mm1 = has1 ? m1 : m0;
        f32x4* xr0 = (f32x4*)(F.out + (size_t)m0 * D) + lane; f32x4* xr1 = (f32x4*)(F.out + (size_t)mm1 * D) + lane; f32x4 v0[4], v1[4], a0[4], a1[4];
#pragma unroll
        for (int j = 0; j < 4; ++j) { v0[j] = xr0[64 * j]; v1[j] = xr1[64 * j]; a0[j] = (f32x4){0.f, 0.f, 0.f, 0.f}; a1[j] = (f32x4){0.f, 0.f, 0.f, 0.f}; }
        const int sl0 = lane < 16 ? SLOT[(size_t)m0 * 16 + lane] : -1, sl1 = lane < 16 ? SLOT[(size_t)mm1 * 16 + lane] : -1;
        for (int e = 0; e < 16; ++e) { const int s0 = __shfl(sl0, e), s1 = __shfl(sl1, e);
            if (s0 >= 0) { const u32x2* yr = (const u32x2*)(Y + (size_t)s0 * 1024) + lane;
#pragma unroll
                for (int j = 0; j < 4; ++j) { const u32x2 w = yr[64 * j]; a0[j].x += __uint_as_float(w.x << 16); a0[j].y += __uint_as_float(w.x & 0xffff0000u); a0[j].z += __uint_as_float(w.y << 16); a0[j].w += __uint_as_float(w.y & 0xffff0000u); } }
            if (s1 >= 0) { const u32x2* yr = (const u32x2*)(Y + (size_t)s1 * 1024) + lane;
#pragma unroll
                for (int j = 0; j < 4; ++j) { const u32x2 w = yr[64 * j]; a1[j].x += __uint_as_float(w.x << 16); a1[j].y += __uint_as_float(w.x & 0xffff0000u); a1[j].z += __uint_as_float(w.y << 16); a1[j].w += __uint_as_float(w.y & 0xffff0000u); } } }
        float ss0 = 0.f, ss1 = 0.f; const int b0 = m0 >> 13, b1 = mm1 >> 13;
#pragma unroll
        for (int j = 0; j < 4; ++j) { const f32x4 g0 = *(const f32x4*)(modf + b0 * 6144 + 5120 + 4 * lane + 256 * j), g1 = *(const f32x4*)(modf + b1 * 6144 + 5120 + 4 * lane + 256 * j);
            v0[j] = v0[j] + g0 * a0[j]; v1[j] = v1[j] + g1 * a1[j];
            ss0 += (v0[j].x * v0[j].x + v0[j].y * v0[j].y) + (v0[j].z * v0[j].z + v0[j].w * v0[j].w); ss1 += (v1[j].x * v1[j].x + v1[j].y * v1[j].y) + (v1[j].z * v1[j].z + v1[j].w * v1[j].w); }
        const float r0 = rsqrtf(wave_sum(ss0) * (1.f / D) + EPS), r1 = rsqrtf(wave_sum(ss1) * (1.f / D) + EPS);
#pragma unroll
        for (int j = 0; j < 4; ++j) { const f32x4 g = *(const f32x4*)(F.g_final + 4 * lane + 256 * j); xr0[64 * j] = v0[j] * r0 * g; if (has1) xr1[64 * j] = v1[j] * r1 * g; }
    }
}
}
#ifndef MLA_V4
#define MLA_V4 0
#endif
#ifndef MERGE_P12
#define MERGE_P12 1
#endif
#ifndef DIL_PIPE
#define DIL_PIPE 1
#endif
#ifndef MLA_UNIT
#define MLA_UNIT mla_unit_v2
#endif
namespace mk {
namespace cg = cooperative_groups;
__global__ void __launch_bounds__(NTHREADS, 2) mega(Args args) {
    extern __shared__ __attribute__((aligned(16))) unsigned char lds_raw[];
    cg::grid_group grid = cg::this_grid();
    Frame F;
    F.lds = (LAS unsigned char*)lds_raw; F.ws = args.ws; F.out = args.out;
    F.wave = __builtin_amdgcn_readfirstlane((int)(threadIdx.x >> 6));
    F.G = gridDim.x; { const int bx = blockIdx.x; F.vcu = (F.G % 8 == 0) ? (bx % 8) * (F.G / 8) + bx / 8 : bx; }
    F.x = (const float*)args.in[0]; F.c = (const float*)args.in[1]; F.pos = (const int*)args.in[2]; F.w_ada = (const float*)args.in[3]; F.b_ada = (const float*)args.in[4];
    F.g_mix = (const float*)args.in[5]; F.w_in = (const float*)args.in[6]; F.g_q = (const float*)args.in[7]; F.w_uq = (const float*)args.in[8]; F.g_kv = (const float*)args.in[9];
    F.w_ukv = (const float*)args.in[10]; F.w_out = (const float*)args.in[11]; F.g_ffn = (const float*)args.in[12]; F.w_router = (const float*)args.in[13]; F.b_router = (const float*)args.in[14];
    F.w_gate = (const float*)args.in[15]; F.w_up = (const float*)args.in[16]; F.w_down = (const float*)args.in[17]; F.g_final = (const float*)args.in[18];
    const int lo = args.ph_lo, hi = args.ph_hi;
    volatile LAS unsigned* MISC = (volatile LAS unsigned*)(F.lds + LDS_BYTES - 256);
    { const int l0 = fresh_lane(); if (F.wave == 0) MISC[l0] = 0u; }
    __syncthreads();
    XcdBarrier xbar = xcd_barrier_post((unsigned*)(F.ws + WS_CTL) + 1024 + args.li * 4096, MISC + 8, F.wave == 0 && fresh_lane() == 0);
#define IN(k) (lo <= (k) && (k) < hi)
#ifndef CG_SEAMS
#define CG_SEAMS 0x000
#endif
#define SEAM(k) do { if (IN(k) && IN((k) + 1)) { if ((CG_SEAMS >> (k)) & 1) grid.sync(); else xcd_barrier(xbar, F.wave == 0 && fresh_lane() == 0); } } while (0)
    if (IN(0)) { p0_prologue(F); } SEAM(0);
    if (IN(1)) { p0b_rows(F); } SEAM(1);
#if MERGE_P12
    if (IN(2)) { SchedP12 S{(const char*)(F.ws + WS_HB), (const char*)(F.ws + WS_WIN), (const char*)(F.ws + WS_CQ), (const char*)(F.ws + WS_WUQ), (const char*)(F.ws + WS_WUKV), (unsigned*)(F.ws + WS_PCNT), F.G, F.vcu, (int)blockIdx.x};
        EpiP12 E{F.ws}; gm::gemm_phase<EpiP12, SchedP12>(F.lds, S, E, F.wave); } SEAM(3);
#else
    if (IN(2)) { SchedP1 S{(const char*)(F.ws + WS_HB), (const char*)(F.ws + WS_WIN), F.G, (int)blockIdx.x}; EpiP1 E{F.ws}; gm::gemm_phase<EpiP1, SchedP1>(F.lds, S, E, F.wave); } SEAM(2);
    if (IN(3)) { SchedP2 S{(const char*)(F.ws + WS_CQ), (const char*)(F.ws + WS_WUQ), (const char*)(F.ws + WS_WUKV), F.G, (int)blockIdx.x}; EpiP2 E{F.ws}; gm::gemm_phase<EpiP2, SchedP2>(F.lds, S, E, F.wave); } SEAM(3);
#endif
    if (IN(4)) {
        const unsigned short* DQ = (const unsigned short*)(F.ws + WS_DQ); const unsigned short* DK = (const unsigned short*)(F.ws + WS_DK); const unsigned short* DV = (const unsigned short*)(F.ws + WS_DV);
        unsigned short* OBR = (unsigned short*)F.out; float* LSE = (float*)(F.ws + WS_LSE);
        if (args.pad & 1) { if (DIL_PIPE) at::dil_phase(F.wave, F.vcu, F.G, 1536, DQ, DK, DV, OBR, LSE, (char*)lds_raw); else for (int u = F.vcu; u < 1536; u += F.G) { const int blk = u & 31, br = (u >> 5) % 3, bh = u / 96; at::dil_unit(F.wave, bh, br, blk, DQ, DK, DV, OBR, LSE, (char*)lds_raw); } }
        if (args.pad & 2) for (int u = F.vcu; u < 512; u += F.G) { const int bh = (u >> 8) * 8 + ((u & 255) >> 5), qb = u & 31;
            #if MLA_V4
            at::mla_unit_v4(F.wave, bh, qb, (const unsigned short*)(F.ws + WS_Q), (const unsigned short*)(F.ws + WS_KN), (const unsigned short*)(F.ws + WS_KR), (const unsigned short*)(F.ws + WS_V), (unsigned short*)(F.ws + WS_HB), (const float*)(F.ws + WS_KMX), (char*)lds_raw); }
#else
            at::mla_unit_v2(F.wave, bh, qb, (const unsigned short*)(F.ws + WS_Q), (const unsigned short*)(F.ws + WS_KN), (const unsigned short*)(F.ws + WS_KR), (const unsigned short*)(F.ws + WS_V), (unsigned short*)(F.ws + WS_HB), (const float*)(F.ws + WS_KMX), (char*)lds_raw); }
#endif
    } SEAM(4);
    if (IN(5)) { at::dil_combine((const unsigned short*)F.out, (const float*)(F.ws + WS_LSE), (unsigned short*)(F.ws + WS_HB), F.vcu * NTHREADS + F.wave * 64 + fresh_lane(), F.G * NTHREADS); } SEAM(5);
    if (IN(6)) { SchedP4 S{(const char*)(F.ws + WS_HB), (const char*)(F.ws + WS_WOUT), F.G, (int)blockIdx.x}; EpiP4 E{F.x, F.out, (const float*)(F.ws + WS_MODF)}; gm::gemm_phase<EpiP4, SchedP4>(F.lds, S, E, F.wave); } SEAM(6);
    if (IN(7)) { p4b_rows(F); } SEAM(7);
    if (IN(8)) { p5_topk(F); } SEAM(8);
    if (IN(9)) { SchedP6a S{(const char*)(F.ws + WS_HB), (const char*)(F.ws + WS_WGU), (const int*)(F.ws + WS_IDX), F.G, F.vcu}; EpiP6a E{(bf16_t*)(F.ws + WS_HBUF)}; gm::gemm_phase<EpiP6a, SchedP6a>(F.lds, S, E, F.wave); } SEAM(9);
    if (IN(10)) { SchedP6b S{(const char*)(F.ws + WS_HBUF), (const char*)(F.ws + WS_WD), F.G, F.vcu}; EpiP6b E{(bf16_t*)(F.ws + WS_Y), (const float*)(F.ws + WS_GATE)}; gm::gemm_phase<EpiP6b, SchedP6b>(F.lds, S, E, F.wave); } SEAM(10);
    if (IN(11)) { p7_final(F); }
#undef IN
#undef SEAM
}
}
extern "C" void kernel_launch(void* const* d_in, const int* in_sizes, int n_in, void* d_out, int out_size, void* d_ws, size_t ws_size, hipStream_t stream) {
    using namespace mk;
    static int grid = 0;
    if (grid == 0) {
        if (n_in != 19 || out_size != T * D || in_sizes[0] != T * D || ws_size < WS_END) { fprintf(stderr, "kernel_launch: built for 19 inputs, x/out of %d floats and >= %zu bytes of workspace; got n_in %d out %d ws %zu; nothing launched\n", T * D, (size_t)WS_END, n_in, out_size, ws_size); grid = -1; return; }
        int dev = 0, cus = 0, per_cu = 0;
        if (hipGetDevice(&dev) != hipSuccess || hipDeviceGetAttribute(&cus, hipDeviceAttributeMultiprocessorCount, dev) != hipSuccess || cus < 32) { fprintf(stderr, "kernel_launch: device query failed\n"); grid = -1; return; }
        if (hipFuncSetAttribute((const void*)mega, hipFuncAttributeMaxDynamicSharedMemorySize, LDS_BYTES) != hipSuccess) { fprintf(stderr, "kernel_launch: hipFuncSetAttribute(%d B LDS) failed\n", LDS_BYTES); grid = -1; return; }
        if (hipOccupancyMaxActiveBlocksPerMultiprocessor(&per_cu, (const void*)mega, NTHREADS, LDS_BYTES) != hipSuccess || per_cu < 1) { fprintf(stderr, "kernel_launch: occupancy query reports %d workgroups per CU\n", per_cu); grid = -1; return; }
        grid = cus;
    }
    if (grid < 0) return;
    if (hipMemsetAsync((char*)d_ws + WS_CTL, 0, 64 * KiB, stream) != hipSuccess) { fprintf(stderr, "kernel_launch: memset failed\n"); return; }
    Args a{}; for (int i = 0; i < 19; ++i) a.in[i] = d_in[i]; a.out = (float*)d_out; a.ws = (unsigned char*)d_ws;
    a.pad = 3; a.ph_lo = 0; a.ph_hi = 12; a.li = 0;
    void* kargs[] = {&a};
    const hipError_t e = hipLaunchCooperativeKernel((const void*)mega, dim3(grid), dim3(NTHREADS), kargs, LDS_BYTES, stream);
    if (e != hipSuccess) fprintf(stderr, "kernel_launch: cooperative launch failed: %s (grid %d)\n", hipGetErrorString(e), grid);
}
```

```cpp
#include <hip/hip_runtime.h>
#include <hip/hip_cooperative_groups.h>
#include <hip/hip_bf16.h>
#include <cstdio>
#include <cstdint>
#include <cmath>
namespace gm {
#define LAS __attribute__((address_space(3)))
typedef unsigned short bf16_t;
typedef short bf16x8 __attribute__((ext_vector_type(8)));
typedef float f32x4 __attribute__((ext_vector_type(4)));
typedef float f32x2 __attribute__((ext_vector_type(2)));
typedef unsigned u32x4 __attribute__((ext_vector_type(4)));
typedef unsigned u32x2 __attribute__((ext_vector_type(2)));
constexpr int BM = 256, BK = 64, HALF = 128, HTB = HALF * BK * 2, STAGE_BYTES = 8 * HTB;

__device__ __forceinline__ int lds_byte(int r, int c) { const int st = (r >> 4) * 2 + (c >> 5), rr = r & 15, cc = c & 31, ob = rr * 64 + cc * 2; return st * 1024 + (ob ^ (((ob >> 9) & 1) << 5)); }
__device__ __forceinline__ void stage_rc(int b, int& R, int& C) { const int st = b / 1024, sb = b % 1024, swz = sb ^ (((sb >> 9) & 1) << 5); R = (st >> 1) * 16 + swz / 64; C = (st & 1) * 32 + (swz % 64) / 2; }
__device__ __forceinline__ int perm32(int rho) { const int n = rho >> 4, i = rho & 15; return 8 * (i >> 2) + 4 * n + (i & 3); }
__device__ __forceinline__ int lane_now() { int l; asm volatile("v_mbcnt_lo_u32_b32 %0, -1, 0\n\tv_mbcnt_hi_u32_b32 %0, -1, %0" : "=v"(l)); return l; }
__device__ __forceinline__ unsigned cvt_pk_bf16(float lo, float hi) { unsigned r; asm volatile("v_cvt_pk_bf16_f32 %0, %1, %2" : "=v"(r) : "v"(lo), "v"(hi)); return r; }

struct Unit {
    const char* A; const char* Bt; const int* gidx;
    unsigned lda2, ldb2;
    int arow0, brow0, nt;
    int pm, pn, aux;
};

template <class Epi, class Sched>
__device__ __forceinline__ void gemm_phase(LAS unsigned char* lds, const Sched& S, const Epi& E, int wave_sgpr) {
    constexpr bool GATHER = Sched::GATHER;
    const int wid = wave_sgpr, lane = lane_now(), tid = wid * 64 + lane, wr = wid >> 2, wc = wid & 3, fr = lane & 15, fq = lane >> 4;
    int sR[2], sC[2], sRb[2];
#pragma unroll
    for (int i = 0; i < 2; ++i) { int R, C; stage_rc(tid * 16 + i * 8192, R, C); sR[i] = R; sC[i] = C * 2; sRb[i] = Epi::PERM ? ((R & ~31) + perm32(R & 31)) : R; }
    const unsigned ldsw = (unsigned)wid * 1024u;
    const int aoff = lds_byte(wr * 64 + fr, fq * 8), boff = lds_byte(wc * 32 + fr, fq * 8);
#define GM_SA(b, h) (((b) * 2 + (h)) * HTB)
#define GM_SB(b, h) ((4 + (b) * 2 + (h)) * HTB)
#define GM_GLDS(src, dstoff) __builtin_amdgcn_global_load_lds((const unsigned*)(src), (LAS unsigned*)(lds + (dstoff)), 16, 0, 0)
#define GM_STAGE_B(bufoff, p, ld, h) do { _Pragma("unroll") for (int i_ = 0; i_ < 2; ++i_) \
        GM_GLDS((p) + ((unsigned)((h) * HALF + sRb[i_]) * (ld) + (unsigned)sC[i_]), (bufoff) + ldsw + i_ * 8192); } while (0)
#define GM_STAGE_A(bufoff, p, ld, h, g) do { _Pragma("unroll") for (int i_ = 0; i_ < 2; ++i_) { \
        const unsigned o_ = GATHER ? (g)[h][i_] + (unsigned)sC[i_] : (unsigned)((h) * HALF + sR[i_]) * (ld) + (unsigned)sC[i_]; \
        GM_GLDS((p) + o_, (bufoff) + ldsw + i_ * 8192); } } while (0)
#define GM_LDA(dst, b, h) do { _Pragma("unroll") for (int m = 0; m < 4; ++m) _Pragma("unroll") for (int k = 0; k < 2; ++k) dst[m][k] = *(const LAS bf16x8*)(lds + GM_SA(b, h) + aoff + m * 2048 + k * 1024); } while (0)
#define GM_LDB(dst, b, h) do { _Pragma("unroll") for (int n = 0; n < 2; ++n) _Pragma("unroll") for (int k = 0; k < 2; ++k) dst[n][k] = *(const LAS bf16x8*)(lds + GM_SB(b, h) + boff + n * 2048 + k * 1024); } while (0)
#define GM_MMA(ai, bj, At, Bt) do { __builtin_amdgcn_s_setprio(1); _Pragma("unroll") for (int m = 0; m < 4; ++m) _Pragma("unroll") for (int n = 0; n < 2; ++n) _Pragma("unroll") for (int k = 0; k < 2; ++k) \
        acc[ai][bj][m][n] = __builtin_amdgcn_mfma_f32_16x16x32_bf16(Bt[n][k], At[m][k], acc[ai][bj][m][n], 0, 0, 0); __builtin_amdgcn_s_setprio(0); } while (0)
#define GM_WAIT_V(n) asm volatile("s_waitcnt vmcnt(" #n ")" ::: "memory")
#define GM_WAIT_L(n) asm volatile("s_waitcnt lgkmcnt(" #n ")" ::: "memory")
#define GM_BAR __builtin_amdgcn_s_barrier()
#define GM_SCHED __builtin_amdgcn_sched_barrier(0)
#define GM_GOFFS(u, g) do { if (GATHER) { _Pragma("unroll") for (int h_ = 0; h_ < 2; ++h_) _Pragma("unroll") for (int i_ = 0; i_ < 2; ++i_) g[h_][i_] = (unsigned)(u).gidx[h_ * HALF + sR[i_]] * (u).lda2; } } while (0)
#define GM_ABASE(u) ((u).A + (GATHER ? (size_t)0 : (size_t)(u).arow0 * (u).lda2))
#define GM_BBASE(u) ((u).Bt + (size_t)(u).brow0 * (u).ldb2)
    Unit cur, nxt; int ui = 0;
    if (!S.next(0, cur)) return;
    f32x4 acc[2][2][4][2];
#pragma unroll
    for (int a = 0; a < 2; ++a)
#pragma unroll
        for (int b = 0; b < 2; ++b)
#pragma unroll
            for (int m = 0; m < 4; ++m)
#pragma unroll
                for (int n = 0; n < 2; ++n) acc[a][b][m][n] = (f32x4){0.f, 0.f, 0.f, 0.f};
    bf16x8 At[4][2], B0[2][2], B1[2][2];
    unsigned gc[2][2] = {{0u, 0u}, {0u, 0u}}, gn[2][2] = {{0u, 0u}, {0u, 0u}};
    GM_GOFFS(cur, gc);
    const char* cA = GM_ABASE(cur); const char* cB = GM_BBASE(cur); unsigned cla = cur.lda2, clb = cur.ldb2;
    GM_STAGE_B(GM_SB(0, 0), cB, clb, 0); GM_STAGE_B(GM_SB(0, 1), cB, clb, 1); GM_STAGE_A(GM_SA(0, 0), cA, cla, 0, gc); GM_STAGE_A(GM_SA(0, 1), cA, cla, 1, gc);
    if (wr == 1) GM_BAR;
    GM_WAIT_V(2); GM_BAR;
    GM_STAGE_B(GM_SB(1, 0), cB + 128, clb, 0); GM_STAGE_A(GM_SA(1, 0), cA + 128, cla, 0, gc); GM_STAGE_B(GM_SB(1, 1), cB + 128, clb, 1);
    GM_WAIT_V(6); GM_BAR;
    for (;;) {
        const bool has_next = S.next(ui + 1, nxt);
        const char* nA = cA; const char* nB = cB; unsigned nla = cla, nlb = clb;
        if (has_next) { GM_GOFFS(nxt, gn); nA = GM_ABASE(nxt); nB = GM_BBASE(nxt); nla = nxt.lda2; nlb = nxt.ldb2; }
        else if (GATHER) {
#pragma unroll
            for (int h = 0; h < 2; ++h)
#pragma unroll
                for (int i = 0; i < 2; ++i) gn[h][i] = gc[h][i];
        }
        const int nt = cur.nt;
        for (int t = 0; t < nt; t += 2) {
            const bool last = (t == nt - 2);
            if (last && has_next) S.a_ready(nxt, wid, ui + 1);
            const char* a1 = cA + (size_t)(t + 1) * 128;
            const char* a2 = last ? nA : cA + (size_t)(t + 2) * 128; const char* b2 = last ? nB : cB + (size_t)(t + 2) * 128;
            const char* a3 = a2 + 128; const char* b3 = b2 + 128;
            const unsigned la2 = last ? nla : cla, lb2 = last ? nlb : clb;
            unsigned g2[2][2];
#pragma unroll
            for (int h = 0; h < 2; ++h)
#pragma unroll
                for (int i = 0; i < 2; ++i) g2[h][i] = GATHER ? (last ? gn[h][i] : gc[h][i]) : 0u;
            GM_LDB(B0, 0, 0); GM_LDB(B1, 0, 1); GM_SCHED; GM_LDA(At, 0, 0); GM_STAGE_A(GM_SA(1, 1), a1, cla, 1, gc);
            GM_WAIT_V(8); GM_WAIT_L(0); GM_BAR; GM_MMA(0, 0, At, B0); GM_MMA(0, 1, At, B1); GM_BAR; GM_SCHED;
            GM_LDA(At, 0, 1); GM_STAGE_B(GM_SB(0, 0), b2, lb2, 0); GM_STAGE_B(GM_SB(0, 1), b2, lb2, 1); GM_STAGE_A(GM_SA(0, 0), a2, la2, 0, g2);
            GM_WAIT_V(8); GM_WAIT_L(0); GM_BAR; GM_MMA(1, 0, At, B0); GM_MMA(1, 1, At, B1); GM_BAR; GM_SCHED;
            GM_LDB(B0, 1, 0); GM_LDB(B1, 1, 1); GM_SCHED; GM_LDA(At, 1, 0); GM_STAGE_A(GM_SA(0, 1), a2, la2, 1, g2);
            GM_WAIT_V(8); GM_WAIT_L(0); GM_BAR; GM_MMA(0, 0, At, B0); GM_MMA(0, 1, At, B1); GM_BAR; GM_SCHED;
            GM_LDA(At, 1, 1); GM_STAGE_B(GM_SB(1, 0), b3, lb2, 0); GM_STAGE_B(GM_SB(1, 1), b3, lb2, 1); GM_STAGE_A(GM_SA(1, 0), a3, la2, 0, g2);
            GM_WAIT_V(8); GM_WAIT_L(0); GM_BAR; GM_MMA(1, 0, At, B0); GM_MMA(1, 1, At, B1); GM_BAR; GM_SCHED;
        }
        if (wr == 0) GM_BAR;
        E(acc, cur, wr, wc, fr, fq, lane);
        S.done(cur, lane);
        S.stamp(ui, cur, wid, lane);
        if (!has_next) break;
#pragma unroll
        for (int a = 0; a < 2; ++a)
#pragma unroll
            for (int b = 0; b < 2; ++b)
#pragma unroll
                for (int m = 0; m < 4; ++m)
#pragma unroll
                    for (int n = 0; n < 2; ++n) acc[a][b][m][n] = (f32x4){0.f, 0.f, 0.f, 0.f};
        cur = nxt; cA = nA; cB = nB; cla = nla; clb = nlb; ++ui;
        if (GATHER) {
#pragma unroll
            for (int h = 0; h < 2; ++h)
#pragma unroll
                for (int i = 0; i < 2; ++i) gc[h][i] = gn[h][i];
        }
        if (wr == 1) GM_BAR;
    }
    GM_WAIT_V(0);
    GM_BAR;
#undef GM_SA
#undef GM_SB
#undef GM_GLDS
#undef GM_STAGE_A
#undef GM_STAGE_B
#undef GM_LDA
#undef GM_LDB
#undef GM_MMA
#undef GM_WAIT_V
#undef GM_WAIT_L
#undef GM_BAR
#undef GM_SCHED
#undef GM_GOFFS
#undef GM_ABASE
#undef GM_BBASE
}
}
namespace mk {
using gm::bf16_t; using gm::f32x4; using gm::f32x2; using gm::u32x4; using gm::u32x2; using gm::cvt_pk_bf16;
constexpr int T = 16384, S = 8192, D = 1024, NB = 2, NH = 8, NWAVES = 8, NTHREADS = 512;
constexpr float EPS = 1e-6f;
constexpr size_t KiB = 1024, MiB = 1u << 20;
constexpr size_t WS_CTL = 0;
constexpr size_t WS_KMX = 48 * KiB;
constexpr size_t WS_MODP = 1 * MiB;
constexpr size_t WS_MODF = 2 * MiB;
constexpr size_t WS_TABM = WS_MODF + 64 * KiB;
constexpr size_t WS_TABD = WS_TABM + 2 * MiB;
constexpr size_t WS_SSQ = WS_TABD + 1 * MiB;
constexpr size_t WS_KR = WS_SSQ + 1536 * KiB;
constexpr size_t WS_AFF = WS_KR + 1 * MiB;
constexpr size_t WS_IDX = WS_AFF + 1 * MiB;
constexpr size_t WS_GATE = WS_IDX + 128 * KiB;
constexpr size_t WS_SLOT = WS_GATE + 128 * KiB;
constexpr size_t WS_LSE = WS_SLOT + 1 * MiB;
constexpr size_t WS_WUQ = WS_LSE + 1536 * KiB;
constexpr size_t WS_WUKV = WS_WUQ + 576 * KiB;
constexpr size_t WS_WOUT = WS_WUKV + 512 * KiB;
constexpr size_t WS_WIN = WS_WOUT + 2 * MiB;
constexpr size_t WS_R0END = WS_WIN + 4608 * KiB;
static_assert(WS_R0END <= 20 * MiB, "R0");
constexpr size_t WS_HB = 20 * MiB;
constexpr size_t WS_CQ = 52 * MiB;
constexpr size_t WS_DQ = WS_CQ + 24 * MiB, WS_DK = WS_DQ + 16 * MiB, WS_DV = WS_DK + 16 * MiB;
constexpr size_t WS_Q = WS_DV + 16 * MiB;
constexpr size_t WS_KN = WS_Q + 24 * MiB, WS_V = WS_KN + 16 * MiB;
constexpr size_t WS_HBUF = WS_CQ;
constexpr size_t WS_WGU = 180 * MiB;
constexpr size_t WS_Y = WS_WGU;
constexpr size_t WS_WD = 244 * MiB;
constexpr size_t WS_END = 276 * MiB;
static_assert(WS_V + 16 * MiB == 180 * MiB, "arena");
constexpr int LDS_BYTES = 147456;

__device__ __forceinline__ float wave_sum(float v) {
#pragma unroll
    for (int o = 1; o < 64; o <<= 1) v += __shfl_xor(v, o);
    return v;
}
__device__ __forceinline__ unsigned f2bf(float f) { unsigned u = __builtin_bit_cast(unsigned, f); return (u + 0x7fffu + ((u >> 16) & 1u)) >> 16; }
__device__ __forceinline__ unsigned pk2(float lo, float hi) { return f2bf(lo) | (f2bf(hi) << 16); }
__device__ __forceinline__ float bf2f(unsigned short b) { return __builtin_bit_cast(float, (unsigned)b << 16); }
__device__ __forceinline__ float siluf(float v) { return v / (1.f + __expf(-v)); }
#define LDS_WAIT() asm volatile("s_waitcnt lgkmcnt(0)" ::: "memory")
__device__ __forceinline__ int fresh_lane() { return gm::lane_now(); }

struct Args { const void* in[19]; float* out; unsigned char* ws; int ph_lo, ph_hi, li, pad; };
struct Frame {
    LAS unsigned char* lds; unsigned char* ws; float* out;
    int wave, vcu, G;
    const float *x, *c; const int* pos; const float *w_ada, *b_ada, *g_mix, *w_in, *g_q, *w_uq, *g_kv, *w_ukv, *w_out, *g_ffn, *w_router, *b_router, *w_gate, *w_up, *w_down, *g_final;
};

__device__ __forceinline__ float inv_freq_m(int i) { return (float)exp2(-(double)i * (18.931568569324174 / 16.0)); }
__device__ __forceinline__ float inv_freq_d(int i) { return (float)exp2(-(double)i * (18.931568569324174 / 8.0)); }

#ifndef WD_IN_P5
#define WD_IN_P5 1
#endif
__device__ __forceinline__ void p0_transpose_item(const float* W, int ldw, int K, int k0, int n0, bf16_t* WT, int drow, const float* kscale, LAS float* scr, int lane) {
    f32x4 v[8];
#pragma unroll
    for (int i = 0; i < 8; ++i) v[i] = *(const f32x4*)(W + (size_t)(k0 + 8 * i + (lane >> 3)) * ldw + n0 + 4 * (lane & 7));
#pragma unroll
    for (int i = 0; i < 8; ++i) { const int kk = 8 * i + (lane >> 3); f32x4 x = v[i]; if (kscale) x = x * kscale[k0 + kk]; LAS float* d = scr + kk * 33 + 4 * (lane & 7); d[0] = x.x; d[1] = x.y; d[2] = x.z; d[3] = x.w; }
    LDS_WAIT(); asm volatile("" ::: "memory");
    const int c = lane & 7;
#pragma unroll
    for (int j = 0; j < 4; ++j) { const int n = (lane >> 3) + 8 * j; const LAS float* s = scr + (8 * c) * 33 + n;
        u32x4 o; o.x = pk2(s[0 * 33], s[1 * 33]); o.y = pk2(s[2 * 33], s[3 * 33]); o.z = pk2(s[4 * 33], s[5 * 33]); o.w = pk2(s[6 * 33], s[7 * 33]);
        *(u32x4*)(WT + (size_t)(drow + n) * K + k0 + 8 * c) = o; }
    LDS_WAIT(); asm volatile("" ::: "memory");
}
__device__ __forceinline__ void p0_prologue(Frame& F) {
    LAS float* scr = (LAS float*)(F.lds + F.wave * 16384);
    const int gw = F.vcu * NWAVES + F.wave, NGW = F.G * NWAVES, lane = fresh_lane();
    unsigned char* ws = F.ws;
    constexpr int I_MOD = 24 * 16, I_IN = 16 * 69, I_UQ = 6 * 24, I_UKV = 4 * 32, I_OUT = 16 * 32, I_EXP = 16 * 16 * 32, I_PAD = 96, I_TAB = T * 24 / 64;
    constexpr int NITEMS = I_MOD + I_IN + I_UQ + I_UKV + I_OUT + (WD_IN_P5 ? 2 : 3) * I_EXP + I_PAD + I_TAB;
    for (int it = gw; it < NITEMS; it += NGW) {
        int r = it;
        if (r < I_MOD) {
            const int cc = r % 24, kc = r / 24; f32x4 a0 = {0.f, 0.f, 0.f, 0.f}, a1 = {0.f, 0.f, 0.f, 0.f};
            const float* wp = F.w_ada + (size_t)(kc * 64) * 6144 + cc * 256 + 4 * lane;
#pragma unroll 8
            for (int k = 0; k < 64; ++k) { const f32x4 w = *(const f32x4*)(wp + (size_t)k * 6144); const float s0 = siluf(F.c[kc * 64 + k]), s1 = siluf(F.c[1024 + kc * 64 + k]); a0 += w * s0; a1 += w * s1; }
            float* mp = (float*)(ws + WS_MODP) + (size_t)kc * 2 * 6144 + cc * 256 + 4 * lane;
            *(f32x4*)mp = a0; *(f32x4*)(mp + 6144) = a1; continue; }
        r -= I_MOD;
        if (r < I_IN) { const int kb = r / 69, nb = r % 69, n0 = nb * 32; p0_transpose_item(F.w_in, 2208, 1024, kb * 64, n0, (bf16_t*)(ws + WS_WIN), n0 < 672 ? n0 : n0 + 96, nullptr, scr, lane); continue; }
        r -= I_IN;
        if (r < I_UQ) { const int kb = r / 24, nb = r % 24, n0 = nb * 32, h = n0 / 96, d = n0 % 96; p0_transpose_item(F.w_uq, 768, 384, kb * 64, n0, (bf16_t*)(ws + WS_WUQ), d < 64 ? h * 64 + d : 512 + h * 32, F.g_q, scr, lane); continue; }
        r -= I_UQ;
        if (r < I_UKV) { const int kb = r / 32, nb = r % 32, n0 = nb * 32, h = n0 / 128, d = n0 % 128; p0_transpose_item(F.w_ukv, 1024, 256, kb * 64, n0, (bf16_t*)(ws + WS_WUKV), d < 64 ? h * 64 + d : 512 + h * 64 + (d - 64), F.g_kv, scr, lane); continue; }
        r -= I_UKV;
        if (r < I_OUT) { const int kb = r / 32, nb = r % 32; p0_transpose_item(F.w_out, 1024, 1024, kb * 64, nb * 32, (bf16_t*)(ws + WS_WOUT), nb * 32, nullptr, scr, lane); continue; }
        r -= I_OUT;
        if (r < 2 * I_EXP) { const int up = r >= I_EXP; const int q = up ? r - I_EXP : r; const int e = q / 512, kb = (q % 512) / 32, nb = q % 32, n0 = nb * 32;
            p0_transpose_item((up ? F.w_up : F.w_gate) + (size_t)e * 1048576, 1024, 1024, kb * 64, n0, (bf16_t*)(ws + WS_WGU) + (size_t)e * 2048 * 1024, (n0 / 128) * 256 + up * 128 + (n0 % 128), nullptr, scr, lane); continue; }
        r -= 2 * I_EXP;
        if (!WD_IN_P5) { if (r < I_EXP) { const int e = r / 512, kb = (r % 512) / 32, nb = r % 32; p0_transpose_item(F.w_down + (size_t)e * 1048576, 1024, 1024, kb * 64, nb * 32, (bf16_t*)(ws + WS_WD) + (size_t)e * 1048576, nb * 32, nullptr, scr, lane); continue; }
        r -= I_EXP; }
        if (r < I_PAD) { u32x4 z = {0u, 0u, 0u, 0u}; u32x4* p = (u32x4*)((bf16_t*)(ws + WS_WIN) + (size_t)(672 + r) * 1024); p[lane] = z; p[64 + lane] = z; continue; }
        r -= I_PAD;
        {
            const int e = r * 64 + lane, tok = e / 24, f = e % 24; const int p = F.pos[tok];
            const float inv = f < 16 ? inv_freq_m(f) : inv_freq_d(f - 16); const float ang = (float)p * inv; const float cs = (float)cos((double)ang), sn = (float)sin((double)ang);
            if (f < 16) { float* tm = (float*)(ws + WS_TABM) + (size_t)tok * 32; tm[f] = cs; tm[16 + f] = sn; } else { float* td = (float*)(ws + WS_TABD) + (size_t)tok * 16; td[f - 16] = cs; td[8 + f - 16] = sn; }
        }
    }
}
__device__ __forceinline__ void wd_convert(Frame& F, int first_vcu) {
    LAS float* scr = (LAS float*)(F.lds + F.wave * 16384);
    const int gw = (F.vcu - first_vcu) * NWAVES + F.wave, NGW = (F.G - first_vcu) * NWAVES, lane = fresh_lane();
    for (int r = gw; r < 16 * 16 * 32; r += NGW) { const int e = r / 512, kb = (r % 512) / 32, nb = r % 32;
        p0_transpose_item(F.w_down + (size_t)e * 1048576, 1024, 1024, kb * 64, nb * 32, (bf16_t*)(F.ws + WS_WD) + (size_t)e * 1048576, nb * 32, nullptr, scr, lane); }
}
__device__ __forceinline__ void p0b_rows(Frame& F) {
    const int tid_ = F.wave * 64 + fresh_lane();
    LAS float* A1 = (LAS float*)F.lds;
    LAS float* A0 = A1 + 2048;
    const float* mp = (const float*)(F.ws + WS_MODP);
#pragma unroll
    for (int half = 0; half < 2; ++half) { float s[4]; float pv[4][16];
#pragma unroll
        for (int q = 0; q < 4; ++q) { const int i = tid_ + NTHREADS * (half * 4 + q); const int b = i >> 11, n = ((i >> 10) & 1) * 1024 + (i & 1023);
#pragma unroll
            for (int k = 0; k < 16; ++k) pv[q][k] = mp[(size_t)k * 2 * 6144 + b * 6144 + n]; }
#pragma unroll
        for (int q = 0; q < 4; ++q) { const int i = tid_ + NTHREADS * (half * 4 + q); const int b = i >> 11, which = (i >> 10) & 1, j = i & 1023; s[q] = F.b_ada[which * 1024 + j];
#pragma unroll
            for (int k = 0; k < 16; ++k) s[q] += pv[q][k];
            if (which) A1[b * 1024 + j] = F.g_mix[j] * (1.f + s[q]); else A0[b * 1024 + j] = s[q]; } }
    if (blockIdx.x < 48 && tid_ < 256) { const int n = blockIdx.x * 256 + tid_; const int b = n / 6144, nn = n % 6144; float s = F.b_ada[nn];
#pragma unroll
        for (int k = 0; k < 16; ++k) s += mp[(size_t)k * 2 * 6144 + b * 6144 + nn];
        ((float*)(F.ws + WS_MODF))[n] = s; }
    __syncthreads();
    const int gw = F.vcu * NWAVES + F.wave, NGW = F.G * NWAVES, lane = fresh_lane();
    for (int m0 = gw; m0 < T; m0 += 2 * NGW) {
        const int m1 = m0 + NGW; const bool has1 = m1 < T; const int mm1 = has1 ? m1 : m0;
        const f32x4* xr0 = (const f32x4*)(F.x + (size_t)m0 * D) + lane; const f32x4* xr1 = (const f32x4*)(F.x + (size_t)mm1 * D) + lane; f32x4 v0[4], v1[4]; float s0 = 0.f, s1 = 0.f;
#pragma unroll
        for (int j = 0; j < 4; ++j) { v0[j] = xr0[64 * j]; v1[j] = xr1[64 * j]; }
#pragma unroll
        for (int j = 0; j < 4; ++j) { s0 += (v0[j].x * v0[j].x + v0[j].y * v0[j].y) + (v0[j].z * v0[j].z + v0[j].w * v0[j].w); s1 += (v1[j].x * v1[j].x + v1[j].y * v1[j].y) + (v1[j].z * v1[j].z + v1[j].w * v1[j].w); }
        const float r0 = rsqrtf(wave_sum(s0) * (1.f / D) + EPS), r1 = rsqrtf(wave_sum(s1) * (1.f / D) + EPS);
        const int b0 = m0 >> 13, b1 = mm1 >> 13;
        unsigned long long* o0 = (unsigned long long*)((bf16_t*)(F.ws + WS_HB) + (size_t)m0 * D) + lane; unsigned long long* o1 = (unsigned long long*)((bf16_t*)(F.ws + WS_HB) + (size_t)mm1 * D) + lane;
#pragma unroll
        for (int j = 0; j < 4; ++j) { const f32x4 a1 = *(const LAS f32x4*)(A1 + b0 * 1024 + 4 * lane + 256 * j), a0 = *(const LAS f32x4*)(A0 + b0 * 1024 + 4 * lane + 256 * j);
            const f32x4 o = v0[j] * r0 * a1 + a0; o0[64 * j] = (unsigned long long)pk2(o.x, o.y) | ((unsigned long long)pk2(o.z, o.w) << 32); }
        if (has1) {
#pragma unroll
            for (int j = 0; j < 4; ++j) { const f32x4 a1 = *(const LAS f32x4*)(A1 + b1 * 1024 + 4 * lane + 256 * j), a0 = *(const LAS f32x4*)(A0 + b1 * 1024 + 4 * lane + 256 * j);
                const f32x4 o = v1[j] * r1 * a1 + a0; o1[64 * j] = (unsigned long long)pk2(o.x, o.y) | ((unsigned long long)pk2(o.z, o.w) << 32); } }
    }
    __syncthreads();
}

__device__ __forceinline__ bool static_tile(int i, int G, int c, int nM, int nN, int& pm, int& pn) {
    const int nwg = nM * nN; const long L = (long)i * G + c; if (L >= nwg) return false;
    int wgid = (int)L; { const int q = nwg / 8, r = nwg % 8, xcd = wgid % 8, off = wgid / 8; wgid = (xcd < r ? xcd * (q + 1) : r * (q + 1) + (xcd - r) * q) + off; }
    const int nig = 8 * nN, gid = wgid / nig, fm = gid * 8, gsz = (nM - fm) < 8 ? (nM - fm) : 8;
    pm = fm + ((wgid % nig) % gsz); pn = (wgid % nig) / gsz; return true;
}
struct SchedP1 {
    static constexpr bool GATHER = false;
    __device__ __forceinline__ void a_ready(const gm::Unit&, int, int) const {}
    __device__ __forceinline__ void done(const gm::Unit&, int) const {}
    __device__ __forceinline__ void stamp(int, const gm::Unit&, int, int) const {}
    const char* A; const char* Bt; int G, c;
    __device__ __forceinline__ bool next(int i, gm::Unit& u) const { int pm, pn; if (!static_tile(i, G, c, 64, 9, pm, pn)) return false;
        u.A = A; u.Bt = Bt; u.gidx = nullptr; u.lda2 = 2048; u.ldb2 = 2048; u.arow0 = pm * 256; u.brow0 = pn * 256; u.nt = 16; u.pm = pm; u.pn = pn; u.aux = 0; return true; }
};
struct SchedP2 {
    static constexpr bool GATHER = false;
    __device__ __forceinline__ void a_ready(const gm::Unit&, int, int) const {}
    __device__ __forceinline__ void done(const gm::Unit&, int) const {}
    __device__ __forceinline__ void stamp(int, const gm::Unit&, int, int) const {}
    const char* A; const char* Wuq; const char* Wukv; int G, c;
    __device__ __forceinline__ bool next(int i, gm::Unit& u) const {
        const int L = i * G + c; if (L >= 448) return false;
        u.A = A; u.gidx = nullptr; u.lda2 = 1536;
        if (L < 256) { int pm, pn; static_tile(0, 256, L, 64, 4, pm, pn); u.A = A + 768; u.Bt = Wukv; u.ldb2 = 512; u.nt = 4; u.arow0 = pm * 256; u.brow0 = pn * 256; u.pm = pm; u.pn = pn; u.aux = 1; }
        else { int pm, pn; static_tile(0, 192, L - 256, 64, 3, pm, pn); u.Bt = Wuq; u.ldb2 = 768; u.nt = 6; u.arow0 = pm * 256; u.brow0 = pn * 256; u.pm = pm; u.pn = pn; u.aux = 0; }
        return true; }
};

__device__ __forceinline__ void store16_sc1(void* p, u32x4 v) { asm volatile("global_store_dwordx4 %0, %1, off sc1\n\ts_nop 1" :: "v"(p), "v"(v) : "memory"); }
__device__ __forceinline__ void store4_sc1(float* p, float v) { __hip_atomic_store(p, v, __ATOMIC_RELAXED, __HIP_MEMORY_SCOPE_AGENT); }
#define EPI_ARGS const f32x4 (&acc)[2][2][4][2], const gm::Unit& u, int wr, int wc, int fr, int fq, int lane
constexpr float QSCALE_M = 0.10206207261596575f * 1.4426950408889634f;
constexpr float QSCALE_D = 0.125f * 1.4426950408889634f;
__device__ __forceinline__ u32x4 pack8(f32x4 a, f32x4 b) { u32x4 w; w.x = cvt_pk_bf16(a[0], a[1]); w.y = cvt_pk_bf16(a[2], a[3]); w.z = cvt_pk_bf16(b[0], b[1]); w.w = cvt_pk_bf16(b[2], b[3]); return w; }
__device__ __forceinline__ void rope8(f32x4& v0, f32x4& v1, int xmask, const float* cs, const float* sn, bool first) {
    f32x4 o0, o1;
#pragma unroll
    for (int j = 0; j < 4; ++j) { o0[j] = __shfl_xor(v0[j], xmask); o1[j] = __shfl_xor(v1[j], xmask); }
    const f32x4 c0 = *(const f32x4*)cs, c1 = *(const f32x4*)(cs + 4), s0 = *(const f32x4*)sn, s1 = *(const f32x4*)(sn + 4);
    const float sg = first ? -1.f : 1.f;
    v0 = v0 * c0 + o0 * s0 * sg; v1 = v1 * c1 + o1 * s1 * sg;
}
struct EpiP1 {
    static constexpr bool PERM = true;
    unsigned char* ws;
    __device__ __forceinline__ void operator()(EPI_ARGS) const {
        const int pn = u.pn; float krmax = 0.f;
        const float* tabm = (const float*)(ws + WS_TABM); const float* tabd = (const float*)(ws + WS_TABD);
#pragma unroll
        for (int ai = 0; ai < 2; ++ai)
#pragma unroll
            for (int m = 0; m < 4; ++m) {
                const int row = u.pm * 256 + ai * 128 + wr * 64 + m * 16 + fr; const int b = row >> 13, s = row & 8191;
#pragma unroll
                for (int bj = 0; bj < 2; ++bj) {
                    f32x4 v0 = acc[ai][bj][m][0], v1 = acc[ai][bj][m][1];
                    const int ct = bj * 128 + wc * 32 + 8 * fq;
                    if (pn < 3) {
                        float q = (v0[0] * v0[0] + v0[1] * v0[1]) + (v0[2] * v0[2] + v0[3] * v0[3]) + (v1[0] * v1[0] + v1[1] * v1[1]) + (v1[2] * v1[2] + v1[3] * v1[3]);
                        q += __shfl_xor(q, 16); q += __shfl_xor(q, 32);
                        if (fq == 0) store4_sc1((float*)(ws + WS_SSQ) + (size_t)row * 24 + pn * 8 + bj * 4 + wc, q);
                        if (pn == 2 && bj == 1 && wc == 0) {
                            const int f0 = 8 * (fq & 1); rope8(v0, v1, 32, tabm + (size_t)row * 32 + f0, tabm + (size_t)row * 32 + 16 + f0, fq < 2);
                            store16_sc1((bf16_t*)(ws + WS_KR) + (size_t)row * 32 + 8 * fq, pack8(v0, v1));
                            { float q2 = (v0[0] * v0[0] + v0[1] * v0[1]) + (v0[2] * v0[2] + v0[3] * v0[3]) + (v1[0] * v1[0] + v1[1] * v1[1]) + (v1[2] * v1[2] + v1[3] * v1[3]);
                              q2 += __shfl_xor(q2, 16); q2 += __shfl_xor(q2, 32); krmax = fmaxf(krmax, q2); }
                        } else store16_sc1((bf16_t*)(ws + WS_CQ) + (size_t)row * 768 + pn * 256 + ct, pack8(v0, v1));
                    } else {
                        const int which = (pn - 3) >> 1;
                        const int cc = ((pn - 3) & 1) * 256 + ct, hh = cc >> 6, d = cc & 63;
                        if (which < 2 && (wc & 1) == 0) {
                            f32x4 r0 = v0, r1 = v1; rope8(r0, r1, 16, tabd + (size_t)row * 16, tabd + (size_t)row * 16 + 8, fq == 0);
                            if (fq < 2) { v0 = r0; v1 = r1; } }
                        if (which == 0) { v0 = v0 * QSCALE_D; v1 = v1 * QSCALE_D; }
                        bf16_t* dst = (bf16_t*)(ws + (which == 0 ? WS_DQ : which == 1 ? WS_DK : WS_DV));
                        *(u32x4*)(dst + ((size_t)(b * 8 + hh) * S + s) * 64 + d) = pack8(v0, v1);
                    }
                }
            }
        if (pn == 2 && wc == 0) {
#pragma unroll
            for (int o = 1; o < 16; o <<= 1) krmax = fmaxf(krmax, __shfl_xor(krmax, o));
            if (lane == 0) atomicMax((unsigned*)(ws + WS_KMX) + 32 + ((u.pm * 256) >> 13), __float_as_uint(krmax)); }
    }
};
struct EpiP2 {
    static constexpr bool PERM = true;
    unsigned char* ws;
    __device__ __forceinline__ void operator()(EPI_ARGS) const {
        const int pn = u.pn; const bool isq = u.aux == 0; float kmax[2] = {0.f, 0.f};
        const float* tabm = (const float*)(ws + WS_TABM); const float* ssq = (const float*)(ws + WS_SSQ);
#pragma unroll
        for (int ai = 0; ai < 2; ++ai)
#pragma unroll
            for (int m = 0; m < 4; ++m) {
                const int row = u.pm * 256 + ai * 128 + wr * 64 + m * 16 + fr; const int b = row >> 13, s = row & 8191;
                const float* sq = ssq + (size_t)row * 24; float rstd;
                if (isq) { const f32x4 a = *(const f32x4*)sq, bq = *(const f32x4*)(sq + 4), cq = *(const f32x4*)(sq + 8);
                    rstd = rsqrtf((((a[0] + a[1]) + (a[2] + a[3])) + ((bq[0] + bq[1]) + (bq[2] + bq[3])) + ((cq[0] + cq[1]) + (cq[2] + cq[3]))) * (1.f / 384.f) + EPS) * QSCALE_M; }
                else { const f32x4 a = *(const f32x4*)(sq + 12), bq = *(const f32x4*)(sq + 16);
                    rstd = rsqrtf((((a[0] + a[1]) + (a[2] + a[3])) + ((bq[0] + bq[1]) + (bq[2] + bq[3]))) * (1.f / 256.f) + EPS); }
#pragma unroll
                for (int bj = 0; bj < 2; ++bj) {
                    f32x4 v0 = acc[ai][bj][m][0] * rstd, v1 = acc[ai][bj][m][1] * rstd;
                    const int ct = bj * 128 + wc * 32 + 8 * fq, cc = (pn & 1) * 256 + ct;
                    if (isq) {
                        if (pn < 2) { const int hh = cc >> 6, d = cc & 63; *(u32x4*)((bf16_t*)(ws + WS_Q) + ((size_t)(b * 8 + hh) * S + s) * 96 + d) = pack8(v0, v1); }
                        else { const int hh = ct >> 5; const int f0 = 8 * (fq & 1); rope8(v0, v1, 32, tabm + (size_t)row * 32 + f0, tabm + (size_t)row * 32 + 16 + f0, fq < 2);
                            *(u32x4*)((bf16_t*)(ws + WS_Q) + ((size_t)(b * 8 + hh) * S + s) * 96 + 64 + 8 * fq) = pack8(v0, v1); }
                    } else { const int hh = cc >> 6, d = cc & 63; bf16_t* dst = (bf16_t*)(ws + (pn < 2 ? WS_KN : WS_V));
                        *(u32x4*)(dst + ((size_t)(b * 8 + hh) * S + s) * 64 + d) = pack8(v0, v1);
                        if (pn < 2) { float q2 = (v0[0] * v0[0] + v0[1] * v0[1]) + (v0[2] * v0[2] + v0[3] * v0[3]) + (v1[0] * v1[0] + v1[1] * v1[1]) + (v1[2] * v1[2] + v1[3] * v1[3]);
                            q2 += __shfl_xor(q2, 16); q2 += __shfl_xor(q2, 32); kmax[bj] = fmaxf(kmax[bj], q2); } }
                }
            }
        if (!isq && pn < 2) {
#pragma unroll
            for (int bj = 0; bj < 2; ++bj) { float km = kmax[bj];
#pragma unroll
                for (int o = 1; o < 16; o <<= 1) km = fmaxf(km, __shfl_xor(km, o));
                const int cc = (pn & 1) * 256 + bj * 128 + wc * 32, hh = cc >> 6, half = (cc >> 5) & 1, b = (u.pm * 256) >> 13;
                if (lane == 0) atomicMax((unsigned*)(ws + WS_KMX) + (b * 8 + hh) * 2 + half, __float_as_uint(km)); }
        }
    }
};

constexpr size_t WS_PCNT = 56 * KiB;
struct SchedP12 {
    static constexpr bool GATHER = false;
    const char *HB, *WIN, *CQ, *WUQ, *WUKV; unsigned* cnt; int G, vcu, c;
    __device__ __forceinline__ bool next(int i, gm::Unit& u) const {
        u.gidx = nullptr;
        if (G == 256) {
            const int n1 = c < 64 ? 3 : 2;
            if (i < n1) { int pm, pn; static_tile(i, 256, c, 64, 9, pm, pn);
                u.A = HB; u.Bt = WIN; u.lda2 = 2048; u.ldb2 = 2048; u.arow0 = pm * 256; u.brow0 = pn * 256; u.nt = 16; u.pm = pm; u.pn = pn; u.aux = 2; return true; }
            if (c < 64) return false;
            const int idx = (c - 64) + 192 * (i - 2); if (i - 2 >= 3 || idx >= 448) return false;
            if (idx < 256) { int pm, pn; static_tile(0, 256, idx, 64, 4, pm, pn); u.A = CQ + 768; u.Bt = WUKV; u.lda2 = 1536; u.ldb2 = 512; u.nt = 4; u.arow0 = pm * 256; u.brow0 = pn * 256; u.pm = pm; u.pn = pn; u.aux = 1; }
            else { int pm, pn; static_tile(0, 192, idx - 256, 64, 3, pm, pn); u.A = CQ; u.Bt = WUQ; u.lda2 = 1536; u.ldb2 = 768; u.nt = 6; u.arow0 = pm * 256; u.brow0 = pn * 256; u.pm = pm; u.pn = pn; u.aux = 0; }
            return true;
        }
        const int n1 = (576 - vcu + G - 1) / G;
        if (i < n1) { const int k = vcu + G * i, pn = k >> 6, pm = k & 63;
            u.A = HB; u.Bt = WIN; u.lda2 = 2048; u.ldb2 = 2048; u.arow0 = pm * 256; u.brow0 = pn * 256; u.nt = 16; u.pm = pm; u.pn = pn; u.aux = 2; return true; }
        const int idx = vcu + G * (i - n1); if (idx >= 448) return false;
        if (idx < 256) { const int pm = idx & 63, pn = idx >> 6; u.A = CQ + 768; u.Bt = WUKV; u.lda2 = 1536; u.ldb2 = 512; u.nt = 4; u.arow0 = pm * 256; u.brow0 = pn * 256; u.pm = pm; u.pn = pn; u.aux = 1; }
        else { const int j = idx - 256, pm = j & 63, pn = j >> 6; u.A = CQ; u.Bt = WUQ; u.lda2 = 1536; u.ldb2 = 768; u.nt = 6; u.arow0 = pm * 256; u.brow0 = pn * 256; u.pm = pm; u.pn = pn; u.aux = 0; }
        return true;
    }
#ifndef P12_STAMP
#define P12_STAMP 0
#endif
    __device__ __forceinline__ void stamp(int ui, const gm::Unit& u, int wid, int lane) const {
#if P12_STAMP
        if (wid == 0 && lane == 0) { unsigned long long* ts = (unsigned long long*)((unsigned char*)cnt - WS_PCNT + 128 * KiB) + (size_t)c * 8; ts[1 + ui] = __builtin_amdgcn_s_memrealtime(); ts[6] = (unsigned long long)(ui + 1); ts[7] = (u.aux == 2) ? (unsigned long long)(ui + 1) : ts[7]; }
#endif
    }
    __device__ __forceinline__ void a_ready(const gm::Unit& u, int wid, int) const {
        if (u.aux == 2) return;
        if (wid == 0) { unsigned* p = cnt + 16 * u.pm; unsigned spins = 0;
            while ((unsigned)__builtin_amdgcn_readfirstlane(__hip_atomic_load(p, __ATOMIC_RELAXED, __HIP_MEMORY_SCOPE_AGENT)) < 24u) { __builtin_amdgcn_s_sleep(2); if (++spins > (1u << 22)) break; }
            __builtin_amdgcn_fence(__ATOMIC_ACQUIRE, "agent");
            asm volatile("s_waitcnt vmcnt(0)" ::: "memory"); }
        asm volatile("" ::: "memory"); __builtin_amdgcn_s_barrier(); asm volatile("" ::: "memory");
    }
    __device__ __forceinline__ void done(const gm::Unit& u, int lane) const {
        if (u.aux != 2 || u.pn >= 3) return;
        asm volatile("s_waitcnt vmcnt(0)" ::: "memory");
        if (lane == 0) __hip_atomic_fetch_add(cnt + 16 * u.pm, 1u, __ATOMIC_RELAXED, __HIP_MEMORY_SCOPE_AGENT);
    }
};
struct EpiP12 {
    static constexpr bool PERM = true;
    unsigned char* ws;
    __device__ __forceinline__ void operator()(EPI_ARGS) const { if (u.aux == 2) { EpiP1 e{ws}; e(acc, u, wr, wc, fr, fq, lane); } else { EpiP2 e{ws}; e(acc, u, wr, wc, fr, fq, lane); } }
};
}
namespace mk {
#define RLX_AGENT __ATOMIC_RELAXED, __HIP_MEMORY_SCOPE_AGENT
#define XB_TMO      128
#define XB_XCNT(j)  (256  + 64 * (j))
#define XB_XSUB(j)  (1280 + 64 * (j))
#define XB_XGEN(j)  (2304 + 64 * (j))
#define XB_TOP      3328
#define XB_TOPGEN   3392
#define XCD_BAR_WORDS 3456
#define XB_SPIN_CAP (1u << 18)
__device__ __forceinline__ unsigned xb_ld(unsigned* p)              { return __hip_atomic_load(p, __ATOMIC_RELAXED, __HIP_MEMORY_SCOPE_AGENT); }
__device__ __forceinline__ unsigned xb_add(unsigned* p, unsigned v) { return __hip_atomic_fetch_add(p, v, __ATOMIC_RELAXED, __HIP_MEMORY_SCOPE_AGENT); }
__device__ __forceinline__ unsigned xb_xcc_id() { return (unsigned)__builtin_amdgcn_s_getreg((3 << 11) | 20) & 0xFu; }
#define XB_SPIN(cond, bar) do { unsigned _sp = 0; while (cond) { __builtin_amdgcn_s_sleep(1); \
    if ((++_sp & 255u) == 0u) { if (xb_ld(&(bar)[XB_TMO])) break; if (_sp > XB_SPIN_CAP) { atomicAdd(&(bar)[XB_TMO], 1u); break; } } } } while (0)
struct XcdBarrier { unsigned* bar; unsigned x; volatile LAS unsigned* st; };
__device__ __forceinline__ XcdBarrier xcd_barrier_post(unsigned* bar, volatile LAS unsigned* st, bool first_thread) {
    XcdBarrier b; b.bar = bar; b.x = xb_xcc_id(); b.st = st;
    if (first_thread) (void)xb_add(&bar[XB_XCNT(b.x)], 1u);
    return b;
}
__device__ __forceinline__ void xcd_barrier_complete(unsigned* bar, unsigned x, unsigned& nloc, unsigned& nx) {
    const unsigned G = gridDim.x * gridDim.y * gridDim.z;
    unsigned sum, cnt, mine, sp = 0u;
    for (;;) {
        sum = 0u; cnt = 0u; mine = 0u;
#pragma unroll
        for (unsigned j = 0; j < 16; ++j) { const unsigned c = xb_ld(&bar[XB_XCNT(j)]); sum += c; cnt += (c > 0u) ? 1u : 0u; mine = (j == x) ? c : mine; }
        if (sum == G) break;
        __builtin_amdgcn_s_sleep(1);
        if ((++sp & 255u) == 0u) { if (xb_ld(&bar[XB_TMO])) break; if (sp > XB_SPIN_CAP) { atomicAdd(&bar[XB_TMO], 1u); break; } }
    }
    nloc = mine > 0u ? mine : 1u; nx = cnt > 0u ? cnt : 1u;
}
__device__ __forceinline__ void xcd_barrier(const XcdBarrier& b, bool first_thread) {
    asm volatile("s_waitcnt vmcnt(0)" ::: "memory");
    __syncthreads();
    if (first_thread) {
        unsigned* bar = b.bar;
        __builtin_amdgcn_s_waitcnt(0);
        unsigned nloc = b.st[0], nx = b.st[1];
        if (nloc == 0u) { xcd_barrier_complete(bar, b.x, nloc, nx); b.st[0] = nloc; b.st[1] = nx; }
        const unsigned old = xb_add(&bar[XB_XSUB(b.x)], 1u);
        const unsigned gen = old / nloc;
        if (old + 1u == (gen + 1u) * nloc) {
            __builtin_amdgcn_fence(__ATOMIC_RELEASE, "agent");
            asm volatile("s_waitcnt vmcnt(0)" ::: "memory");
            const unsigned og = xb_add(&bar[XB_TOP], 1u);
            const unsigned tg = og / nx;
            if (og + 1u == (tg + 1u) * nx) xb_add(&bar[XB_TOPGEN], 1u);
            else XB_SPIN(xb_ld(&bar[XB_TOPGEN]) == tg, bar);
            __builtin_amdgcn_fence(__ATOMIC_ACQUIRE, "agent");
            xb_add(&bar[XB_XGEN(b.x)], 1u);
            asm volatile("s_waitcnt vmcnt(0)" ::: "memory");
        } else {
            XB_SPIN(xb_ld(&bar[XB_XGEN(b.x)]) == gen, bar);
            __builtin_amdgcn_fence(__ATOMIC_ACQUIRE, "agent");
            asm volatile("s_waitcnt vmcnt(0)" ::: "memory");
        }
    }
    __syncthreads();
}
}
namespace at {
using bf16x8 = __attribute__((ext_vector_type(8))) short;
using s16x4 = __attribute__((ext_vector_type(4))) short;
using f32x16 = __attribute__((ext_vector_type(16))) float;
using u32x4 = __attribute__((ext_vector_type(4))) unsigned;
constexpr int S = 8192, T = 16384;
constexpr float THR = 8.f;
#define SBAR() __builtin_amdgcn_sched_barrier(0)
__device__ __forceinline__ int crow(int r, int hi) { return (r & 3) + 8 * (r >> 2) + 4 * hi; }
__device__ __forceinline__ unsigned cvtpk(float lo, float hi) { unsigned r; asm volatile("v_cvt_pk_bf16_f32 %0, %1, %2" : "=v"(r) : "v"(lo), "v"(hi)); return r; }
__device__ __forceinline__ float rowmax32(const f32x16& p0, const f32x16& p1) {
    float pmax = p0[0];
#pragma unroll
    for (int r = 1; r < 16; ++r) pmax = fmaxf(pmax, p0[r]);
#pragma unroll
    for (int r = 0; r < 16; ++r) pmax = fmaxf(pmax, p1[r]);
    auto rr = __builtin_amdgcn_permlane32_swap(__float_as_uint(pmax), __float_as_uint(pmax), false, false);
    return fmaxf(__uint_as_float(rr[0]), __uint_as_float(rr[1]));
}
__device__ __forceinline__ void partialSM(f32x16& p0, f32x16& p1, float& m_reg, float& mn, float& alpha) {
    const float pmax = rowmax32(p0, p1);
    if (__builtin_expect(__all(pmax - m_reg <= THR), 1)) { mn = m_reg; alpha = 1.f; }
    else { mn = fmaxf(m_reg, pmax); alpha = __builtin_amdgcn_exp2f(m_reg - mn); m_reg = mn; }
#pragma unroll
    for (int r = 0; r < 16; ++r) p0[r] = p0[r] - mn;
#pragma unroll
    for (int r = 0; r < 16; ++r) p1[r] = p1[r] - mn;
#pragma unroll
    for (int r = 0; r < 16; ++r) p0[r] = __builtin_amdgcn_exp2f(p0[r]);
}
#define PK4(P, BASE, OUT) do { u32x4 w = {cvtpk(P[BASE + 0], P[BASE + 1]), cvtpk(P[BASE + 2], P[BASE + 3]), cvtpk(P[BASE + 4], P[BASE + 5]), cvtpk(P[BASE + 6], P[BASE + 7])}; \
    OUT = *reinterpret_cast<bf16x8*>(&w); } while (0)
__device__ __forceinline__ void finishSM(f32x16& p0, f32x16& p1, float alpha, float& l_reg, bf16x8& pa0, bf16x8& pa1, bf16x8& pa2, bf16x8& pa3) {
#pragma unroll
    for (int r = 0; r < 16; ++r) p1[r] = __builtin_amdgcn_exp2f(p1[r]);
    float ps = 0;
#pragma unroll
    for (int r = 0; r < 16; ++r) ps += p0[r];
#pragma unroll
    for (int r = 0; r < 16; ++r) ps += p1[r];
    { auto rr = __builtin_amdgcn_permlane32_swap(__float_as_uint(ps), __float_as_uint(ps), false, false); ps = __uint_as_float(rr[0]) + __uint_as_float(rr[1]); }
    l_reg = l_reg * alpha + ps;
    PK4(p0, 0, pa0); PK4(p0, 8, pa1); PK4(p1, 0, pa2); PK4(p1, 8, pa3);
}
__device__ __forceinline__ int v_st(int k, int c) { const int kk = k; return ((kk >> 3) * 2 + (c >> 5)) * 512 + ((kk & 7) * 32 + (c & 31)) * 2; }
__device__ __forceinline__ int v_rd_base(int lane) { return ((lane & 3) << 3) | (((lane >> 2) & 3) << 6) | (((lane >> 4) & 1) << 5) | (((lane >> 5) & 1) << 8); }
constexpr int v_rd_off(int d0, int ks, int half) { return d0 * 512 + ks * 2048 + half * 1024; }
template <int OFF> __device__ __forceinline__ s16x4 tr_read(int vb) { s16x4 r; asm volatile("ds_read_b64_tr_b16 %0, %1 offset:%2" : "=&v"(r) : "v"(vb), "i"(OFF) : "memory"); return r; }
#define PKV(L, H) (bf16x8){L[0], L[1], L[2], L[3], H[0], H[1], H[2], H[3]}
template <int D0, int KOFF> __device__ __forceinline__ void pv_one(f32x16& od, int vb, bf16x8 pa0, bf16x8 pa1, bf16x8 pa2, bf16x8 pa3) {
    const s16x4 l0 = tr_read<KOFF + v_rd_off(D0, 0, 0)>(vb), h0 = tr_read<KOFF + v_rd_off(D0, 0, 1)>(vb), l1 = tr_read<KOFF + v_rd_off(D0, 1, 0)>(vb), h1 = tr_read<KOFF + v_rd_off(D0, 1, 1)>(vb);
    const s16x4 l2 = tr_read<KOFF + v_rd_off(D0, 2, 0)>(vb), h2 = tr_read<KOFF + v_rd_off(D0, 2, 1)>(vb), l3 = tr_read<KOFF + v_rd_off(D0, 3, 0)>(vb), h3 = tr_read<KOFF + v_rd_off(D0, 3, 1)>(vb);
    asm volatile("s_waitcnt lgkmcnt(0)" ::: "memory"); SBAR();
    od = __builtin_amdgcn_mfma_f32_32x32x16_bf16(pa0, PKV(l0, h0), od, 0, 0, 0);
    od = __builtin_amdgcn_mfma_f32_32x32x16_bf16(pa1, PKV(l1, h1), od, 0, 0, 0);
    od = __builtin_amdgcn_mfma_f32_32x32x16_bf16(pa2, PKV(l2, h2), od, 0, 0, 0);
    od = __builtin_amdgcn_mfma_f32_32x32x16_bf16(pa3, PKV(l3, h3), od, 0, 0, 0);
}
template <int D0, int KOFF> __device__ __forceinline__ void pv_half(f32x16& od, int vb, bf16x8 pa0, bf16x8 pa1) {
    const s16x4 l0 = tr_read<KOFF + v_rd_off(D0, 0, 0)>(vb), h0 = tr_read<KOFF + v_rd_off(D0, 0, 1)>(vb), l1 = tr_read<KOFF + v_rd_off(D0, 1, 0)>(vb), h1 = tr_read<KOFF + v_rd_off(D0, 1, 1)>(vb);
    asm volatile("s_waitcnt lgkmcnt(0)" ::: "memory"); SBAR();
    od = __builtin_amdgcn_mfma_f32_32x32x16_bf16(pa0, PKV(l0, h0), od, 0, 0, 0);
    od = __builtin_amdgcn_mfma_f32_32x32x16_bf16(pa1, PKV(l1, h1), od, 0, 0, 0);
}
template <class RowOff> __device__ __forceinline__ void store_o_tile(const f32x16 (&o)[2], const float (&rli)[16], unsigned short* stg, unsigned short* dst, RowOff row_off, int lane) {
    const int r32 = lane & 31, hi = lane >> 5;
#pragma unroll
    for (int r = 0; r < 16; ++r) { const int orow = crow(r, hi);
#pragma unroll
        for (int d0 = 0; d0 < 2; ++d0) stg[orow * 64 + d0 * 32 + r32] = (unsigned short)(cvtpk(o[d0][r] * rli[r], 0.f) & 0xffffu); }
    asm volatile("s_waitcnt lgkmcnt(0)" ::: "memory");
#pragma unroll
    for (int i = 0; i < 4; ++i) { const int row = i * 8 + (lane >> 3), ch = lane & 7; const u32x4 v = *(const u32x4*)(stg + row * 64 + ch * 8); *(u32x4*)(dst + row_off(row) + ch * 8) = v; }
    asm volatile("s_waitcnt lgkmcnt(0)" ::: "memory");
}

__device__ __forceinline__ bool wg_or(bool pred, unsigned* flags8, int wid, int lane) {
    const bool w = __any(pred); if (lane == 0) flags8[wid] = w ? 1u : 0u;
    __syncthreads();
    unsigned r = 0u;
#pragma unroll
    for (int i = 0; i < 8; ++i) r |= flags8[i];
    __syncthreads();
    return r != 0u;
}
constexpr int SHM_V = 8192, SHM_K = 16384, MLA_WS = 2 * SHM_V + 2 * SHM_K, MLA_OST = MLA_WS + 8 * 256;
#define KSWZ(row, colB) ((row) * 256 + ((colB) ^ (((row) & 15) << 4)))
__device__ __forceinline__ void qkt96(f32x16& p0, f32x16& p1, const char* Ks, const bf16x8* qr, int r32, int hi) {
    p0 = f32x16{}; p1 = f32x16{};
#pragma unroll
    for (int d0 = 0; d0 < 6; ++d0) { const int cb = (d0 * 16 + hi * 8) * 2;
        const bf16x8 b0 = *reinterpret_cast<const bf16x8*>(Ks + KSWZ(r32, cb));
        const bf16x8 b1 = *reinterpret_cast<const bf16x8*>(Ks + KSWZ(32 + r32, cb));
        p0 = __builtin_amdgcn_mfma_f32_32x32x16_bf16(b0, qr[d0], p0, 0, 0, 0);
        p1 = __builtin_amdgcn_mfma_f32_32x32x16_bf16(b1, qr[d0], p1, 0, 0, 0); }
}
__device__ __forceinline__ void pv64(f32x16* o, int vb, bf16x8 pa0, bf16x8 pa1, bf16x8 pa2, bf16x8 pa3) {
    pv_one<0, 0>(o[0], vb, pa0, pa1, pa2, pa3); pv_one<1, 0>(o[1], vb, pa0, pa1, pa2, pa3);
}
__device__ __forceinline__ void mla_unit(int wv, int bh, int qb, const unsigned short* __restrict__ Q, const unsigned short* __restrict__ KN, const unsigned short* __restrict__ KR,
                                         const unsigned short* __restrict__ V, unsigned short* __restrict__ CAT, char* lds) {
    const int wid = wv, lane = gm::lane_now(), tid = wid * 64 + lane, r32 = lane & 31, hi = lane >> 5;
    const int b = bh >> 3, h = bh & 7;
    char* V_lds = lds; char* K_lds = lds + 2 * SHM_V;
    float* wsf = (float*)(lds + MLA_WS) + wid * 64; float* li_l = wsf; float* al_l = wsf + 32;
    float m_reg = -1e30f, l_reg = 0; f32x16 o[2] = {}; bf16x8 qr[6];
    const size_t bhS = (size_t)bh * S; const int q0 = qb * 256;
    const unsigned short* Qw = Q + (bhS + q0 + wid * 32 + r32) * 96 + hi * 8;
#pragma unroll
    for (int d0 = 0; d0 < 6; ++d0) qr[d0] = *reinterpret_cast<const bf16x8*>(Qw + d0 * 16);
    const int srow = tid >> 3, sch = tid & 7, rrow = (tid & 255) >> 2, rch = tid & 3;
    const unsigned short* kn_src = KN + (bhS + srow) * 64 + sch * 8;
    const unsigned short* v_src = V + (bhS + srow) * 64 + sch * 8;
    const unsigned short* kr_src = KR + ((size_t)b * S + rrow) * 32 + rch * 8;
    const int kst = KSWZ(srow, sch * 16), krst = KSWZ(rrow, (8 + rch) * 16), vst = v_st(srow, sch * 8);
    const int vb0 = (int)(uintptr_t)V_lds + v_rd_base(lane);
    bf16x8 s_kn[2], s_kr[2], s_v[2];
#define SLOAD(i, k0) do { s_kn[i] = *reinterpret_cast<const bf16x8*>(kn_src + (size_t)(k0) * 64); s_kr[i] = *reinterpret_cast<const bf16x8*>(kr_src + (size_t)(k0) * 32); \
    s_v[i] = *reinterpret_cast<const bf16x8*>(v_src + (size_t)(k0) * 64); } while (0)
#define SWRITE(bb, i) do { *(bf16x8*)(K_lds + (bb) * SHM_K + kst) = s_kn[i]; if (tid < 256) *(bf16x8*)(K_lds + (bb) * SHM_K + krst) = s_kr[i]; *(bf16x8*)(V_lds + (bb) * SHM_V + vst) = s_v[i]; } while (0)
#define SWAIT() asm volatile("s_waitcnt vmcnt(3)" ::: "memory")
#define RESC(a) do { if (__any((a) < 1.f)) { if (hi == 0) al_l[r32] = (a); asm volatile("s_waitcnt lgkmcnt(0)" ::: "memory"); \
    _Pragma("unroll") for (int d = 0; d < 2; ++d) _Pragma("unroll") for (int r = 0; r < 16; ++r) o[d][r] *= al_l[crow(r, hi)]; } } while (0)
    f32x16 pA0, pA1, pB0, pB1; float mnA, mnB, alA, alB; bf16x8 pa0, pa1, pa2, pa3; constexpr int NT = S / 64;
    SLOAD(0, 0); asm volatile("s_waitcnt vmcnt(0)" ::: "memory"); SWRITE(0, 0); __syncthreads();
    qkt96(pA0, pA1, K_lds, qr, r32, hi); partialSM(pA0, pA1, m_reg, mnA, alA);
    SLOAD(1, 64); SLOAD(0, 128);
    SWAIT(); SWRITE(1, 1); __syncthreads();
    for (int j = 1; j + 1 < NT; j += 2) {
        SBAR(); qkt96(pB0, pB1, K_lds + SHM_K, qr, r32, hi);
        finishSM(pA0, pA1, alA, l_reg, pa0, pa1, pa2, pa3); SBAR();
        SLOAD(1, (j + 2) * 64); SBAR();
        pv64(o, vb0, pa0, pa1, pa2, pa3); partialSM(pB0, pB1, m_reg, mnB, alB);
        __syncthreads(); SWAIT(); SWRITE(0, 0);
        RESC(alB); __syncthreads();
        SBAR(); qkt96(pA0, pA1, K_lds, qr, r32, hi);
        finishSM(pB0, pB1, alB, l_reg, pa0, pa1, pa2, pa3); SBAR();
        if (j + 3 < NT) SLOAD(0, (j + 3) * 64); SBAR();
        pv64(o, vb0 + SHM_V, pa0, pa1, pa2, pa3); partialSM(pA0, pA1, m_reg, mnA, alA);
        __syncthreads(); SWAIT(); SWRITE(1, 1);
        RESC(alA); __syncthreads();
    }
    SBAR(); qkt96(pB0, pB1, K_lds + SHM_K, qr, r32, hi);
    finishSM(pA0, pA1, alA, l_reg, pa0, pa1, pa2, pa3); SBAR();
    pv64(o, vb0, pa0, pa1, pa2, pa3); partialSM(pB0, pB1, m_reg, mnB, alB);
    __syncthreads(); RESC(alB);
    finishSM(pB0, pB1, alB, l_reg, pa0, pa1, pa2, pa3); SBAR();
    pv64(o, vb0 + SHM_V, pa0, pa1, pa2, pa3);
    if (hi == 0) li_l[r32] = l_reg; asm volatile("s_waitcnt lgkmcnt(0)" ::: "memory");
    float rli[16];
#pragma unroll
    for (int r = 0; r < 16; ++r) rli[r] = __builtin_amdgcn_rcpf(li_l[crow(r, hi)]);
    unsigned short* stg = (unsigned short*)(lds + MLA_OST) + wid * 2048;
    unsigned short* dst = CAT + ((size_t)b * S + q0 + wid * 32) * 1024 + h * 64;
    store_o_tile(o, rli, stg, dst, [](int row) { return (size_t)row * 1024; }, lane);
    asm volatile("s_waitcnt vmcnt(0)" ::: "memory");
    __syncthreads();
#undef SLOAD
#undef SWRITE
#undef SWAIT
#undef RESC
}


#ifndef V7_EXACT
#define V7_EXACT 1
#endif
#ifndef MLA_STAMP
#define MLA_STAMP 0
#endif
#ifndef MLA_STAMP_WAVE
#define MLA_STAMP_WAVE 5
#endif
#if MLA_STAMP
#define STAMP_T(var) do { __builtin_amdgcn_sched_barrier(0); asm volatile("s_memtime %0\n\ts_waitcnt lgkmcnt(0)" : "=s"(var) :: "memory"); __builtin_amdgcn_sched_barrier(0); } while (0)
#define STAMP_ACC(i, t0_, t1_) (st_acc[i] += (t1_) - (t0_))
#else
#define STAMP_T(var) do { } while (0)
#define STAMP_ACC(i, t0_, t1_) do { } while (0)
#endif
constexpr int M2_K = 0, M2_V = 3 * SHM_K, M2_WS = M2_V + 3 * SHM_V, M2_OST = M2_WS + 8 * 256;
#ifndef MLA_PROBE_NOSTAGE
#define MLA_PROBE_NOSTAGE 0
#endif
#ifndef MLA_STATIC
#define MLA_STATIC 1
#endif
#ifndef MLA_STATIC_THR
#define MLA_STATIC_THR 60.f
#endif
#ifndef MLA_STEP_MODE
#define MLA_STEP_MODE 0
#endif
#ifndef MLA_PROBE_VALU
#define MLA_PROBE_VALU 0
#endif
#ifndef MLA_NEGM
#define MLA_NEGM 1
#endif
#ifndef MLA_PRIO
#define MLA_PRIO 0
#endif
__device__ __forceinline__ void qkt96n(f32x16& p0, f32x16& p1, const char* Ks, const bf16x8* qr, const f32x16& negm, int r32, int hi, bool usec = true) {
    if (MLA_PRIO) __builtin_amdgcn_s_setprio(1);
#pragma unroll
    for (int d0 = 0; d0 < 6; ++d0) { const int cb = (d0 * 16 + hi * 8) * 2;
        const bf16x8 b0 = *reinterpret_cast<const bf16x8*>(Ks + KSWZ(r32, cb));
        const bf16x8 b1 = *reinterpret_cast<const bf16x8*>(Ks + KSWZ(32 + r32, cb));
        if (d0 == 0 && !usec) { p0 = __builtin_amdgcn_mfma_f32_32x32x16_bf16(b0, qr[0], f32x16{}, 0, 0, 0); p1 = __builtin_amdgcn_mfma_f32_32x32x16_bf16(b1, qr[0], f32x16{}, 0, 0, 0); }
        else if (d0 == 0) { p0 = __builtin_amdgcn_mfma_f32_32x32x16_bf16(b0, qr[0], MLA_NEGM ? negm : f32x16{}, 0, 0, 0); p1 = __builtin_amdgcn_mfma_f32_32x32x16_bf16(b1, qr[0], MLA_NEGM ? negm : f32x16{}, 0, 0, 0); }
        else { p0 = __builtin_amdgcn_mfma_f32_32x32x16_bf16(b0, qr[d0], p0, 0, 0, 0); p1 = __builtin_amdgcn_mfma_f32_32x32x16_bf16(b1, qr[d0], p1, 0, 0, 0); } }
    if (MLA_PRIO) __builtin_amdgcn_s_setprio(0);
}
__device__ __forceinline__ void qkt96z(f32x16& p0, f32x16& p1, const char* Ks, const bf16x8* qr, int r32, int hi) {
#pragma unroll
    for (int d0 = 0; d0 < 6; ++d0) { const int cb = (d0 * 16 + hi * 8) * 2;
        const bf16x8 b0 = *reinterpret_cast<const bf16x8*>(Ks + KSWZ(r32, cb));
        const bf16x8 b1 = *reinterpret_cast<const bf16x8*>(Ks + KSWZ(32 + r32, cb));
        if (d0 == 0) { p0 = __builtin_amdgcn_mfma_f32_32x32x16_bf16(b0, qr[0], f32x16{}, 0, 0, 0); p1 = __builtin_amdgcn_mfma_f32_32x32x16_bf16(b1, qr[0], f32x16{}, 0, 0, 0); }
        else { p0 = __builtin_amdgcn_mfma_f32_32x32x16_bf16(b0, qr[d0], p0, 0, 0, 0); p1 = __builtin_amdgcn_mfma_f32_32x32x16_bf16(b1, qr[d0], p1, 0, 0, 0); } }
}
__device__ __forceinline__ float rowmax32b(const f32x16& p0, const f32x16& p1) {
    float a = fmaxf(fmaxf(p0[0], p0[1]), p1[0]), b = fmaxf(fmaxf(p0[2], p0[3]), p1[1]); a = fmaxf(fmaxf(a, p1[2]), p1[3]);
#pragma unroll
    for (int r = 4; r < 16; r += 4) { a = fmaxf(fmaxf(a, p0[r]), p0[r + 1]); b = fmaxf(fmaxf(b, p0[r + 2]), p0[r + 3]); a = fmaxf(fmaxf(a, p1[r]), p1[r + 1]); b = fmaxf(fmaxf(b, p1[r + 2]), p1[r + 3]); }
    const float m = fmaxf(a, b);
    auto rr = __builtin_amdgcn_permlane32_swap(__float_as_uint(m), __float_as_uint(m), false, false);
    return fmaxf(__uint_as_float(rr[0]), __uint_as_float(rr[1]));
}
template <bool FIRST> __device__ __forceinline__ void partialSM2(f32x16& p0, f32x16& p1, float& m_reg, f32x16& negm, float& alpha, bool exact = true) {
    if (!exact) { alpha = 1.f;
#pragma unroll
        for (int r = 0; r < 16; ++r) p0[r] = __builtin_amdgcn_exp2f(p0[r]);
        return; }
    if (MLA_PROBE_VALU) { float d0_ = p1[0], d1_ = p1[1], d2_ = p1[2], d3_ = p1[3];
#pragma unroll
        for (int i = 0; i < 8; ++i) { d0_ = __builtin_amdgcn_exp2f(d0_); d1_ = __builtin_amdgcn_exp2f(d1_); d2_ = __builtin_amdgcn_exp2f(d2_); d3_ = __builtin_amdgcn_exp2f(d3_); }
        asm volatile("" :: "v"(d0_), "v"(d1_), "v"(d2_), "v"(d3_)); }
    if (!MLA_NEGM) {
        const float pm = rowmax32b(p0, p1); alpha = 1.f;
        if (FIRST) m_reg = pm; else if (!__builtin_expect(__all(pm - m_reg <= THR), 1)) { const float mn = fmaxf(m_reg, pm); alpha = __builtin_amdgcn_exp2f(m_reg - mn); m_reg = mn; }
#pragma unroll
        for (int r = 0; r < 16; ++r) { p0[r] -= m_reg; p1[r] -= m_reg; }
#pragma unroll
        for (int r = 0; r < 16; ++r) p0[r] = __builtin_amdgcn_exp2f(p0[r]);
        return; }
    const float pmax = rowmax32b(p0, p1);
    alpha = 1.f;
    if (FIRST || !__builtin_expect(__all(pmax <= THR), 1)) {
        const float dl = FIRST ? pmax : fmaxf(pmax, 0.f); m_reg += dl;
#pragma unroll
        for (int r = 0; r < 16; ++r) { p0[r] -= dl; p1[r] -= dl; }
#pragma unroll
        for (int r = 0; r < 16; ++r) negm[r] = -m_reg;
        if (!FIRST) alpha = __builtin_amdgcn_exp2f(-dl);
    }
#pragma unroll
    for (int r = 0; r < 16; ++r) p0[r] = __builtin_amdgcn_exp2f(p0[r]);
}
template <int D0> __device__ __forceinline__ void pv_one_p(f32x16& od, int vb, bf16x8 pa0, bf16x8 pa1, bf16x8 pa2, bf16x8 pa3) {
    const s16x4 l0 = tr_read<v_rd_off(D0, 0, 0)>(vb), h0 = tr_read<v_rd_off(D0, 0, 1)>(vb), l1 = tr_read<v_rd_off(D0, 1, 0)>(vb), h1 = tr_read<v_rd_off(D0, 1, 1)>(vb);
    const s16x4 l2 = tr_read<v_rd_off(D0, 2, 0)>(vb), h2 = tr_read<v_rd_off(D0, 2, 1)>(vb), l3 = tr_read<v_rd_off(D0, 3, 0)>(vb), h3 = tr_read<v_rd_off(D0, 3, 1)>(vb);
    asm volatile("s_waitcnt lgkmcnt(0)" ::: "memory"); SBAR();
    if (MLA_PRIO) __builtin_amdgcn_s_setprio(1);
    od = __builtin_amdgcn_mfma_f32_32x32x16_bf16(pa0, PKV(l0, h0), od, 0, 0, 0);
    od = __builtin_amdgcn_mfma_f32_32x32x16_bf16(pa1, PKV(l1, h1), od, 0, 0, 0);
    od = __builtin_amdgcn_mfma_f32_32x32x16_bf16(pa2, PKV(l2, h2), od, 0, 0, 0);
    od = __builtin_amdgcn_mfma_f32_32x32x16_bf16(pa3, PKV(l3, h3), od, 0, 0, 0);
    if (MLA_PRIO) __builtin_amdgcn_s_setprio(0);
}

__device__ __forceinline__ void kfrag_load(bf16x8 (&kf)[12], const char* Ks, int r32, int hi) {
#pragma unroll
    for (int d0 = 0; d0 < 6; ++d0) { const int cb = (d0 * 16 + hi * 8) * 2;
        kf[2 * d0] = *reinterpret_cast<const bf16x8*>(Ks + KSWZ(r32, cb)); kf[2 * d0 + 1] = *reinterpret_cast<const bf16x8*>(Ks + KSWZ(32 + r32, cb)); }
}
__device__ __forceinline__ void qk_mma(f32x16& p0, f32x16& p1, const bf16x8 (&kf)[12], const bf16x8* qr, const f32x16& negm) {
    if (MLA_PRIO) __builtin_amdgcn_s_setprio(1);
    p0 = __builtin_amdgcn_mfma_f32_32x32x16_bf16(kf[0], qr[0], MLA_NEGM ? negm : f32x16{}, 0, 0, 0); p1 = __builtin_amdgcn_mfma_f32_32x32x16_bf16(kf[1], qr[0], MLA_NEGM ? negm : f32x16{}, 0, 0, 0);
#pragma unroll
    for (int d0 = 1; d0 < 6; ++d0) { p0 = __builtin_amdgcn_mfma_f32_32x32x16_bf16(kf[2 * d0], qr[d0], p0, 0, 0, 0); p1 = __builtin_amdgcn_mfma_f32_32x32x16_bf16(kf[2 * d0 + 1], qr[d0], p1, 0, 0, 0); }
    if (MLA_PRIO) __builtin_amdgcn_s_setprio(0);
}
template <int D0> __device__ __forceinline__ void vfrag_load_h(s16x4 (&vl)[4], s16x4 (&vh)[4], int vb) {
    vl[0] = tr_read<v_rd_off(D0, 0, 0)>(vb); vh[0] = tr_read<v_rd_off(D0, 0, 1)>(vb); vl[1] = tr_read<v_rd_off(D0, 1, 0)>(vb); vh[1] = tr_read<v_rd_off(D0, 1, 1)>(vb);
    vl[2] = tr_read<v_rd_off(D0, 2, 0)>(vb); vh[2] = tr_read<v_rd_off(D0, 2, 1)>(vb); vl[3] = tr_read<v_rd_off(D0, 3, 0)>(vb); vh[3] = tr_read<v_rd_off(D0, 3, 1)>(vb);
}
__device__ __forceinline__ void pv_mma_h(f32x16& od, const s16x4 (&vl)[4], const s16x4 (&vh)[4], bf16x8 pa0, bf16x8 pa1, bf16x8 pa2, bf16x8 pa3) {
    if (MLA_PRIO) __builtin_amdgcn_s_setprio(1);
    od = __builtin_amdgcn_mfma_f32_32x32x16_bf16(pa0, PKV(vl[0], vh[0]), od, 0, 0, 0);
    od = __builtin_amdgcn_mfma_f32_32x32x16_bf16(pa1, PKV(vl[1], vh[1]), od, 0, 0, 0);
    od = __builtin_amdgcn_mfma_f32_32x32x16_bf16(pa2, PKV(vl[2], vh[2]), od, 0, 0, 0);
    od = __builtin_amdgcn_mfma_f32_32x32x16_bf16(pa3, PKV(vl[3], vh[3]), od, 0, 0, 0);
    if (MLA_PRIO) __builtin_amdgcn_s_setprio(0);
}
#if MLA_STEP_MODE == 0
#define MLA_STEP(PC0, PC1, PP0, PP1, ALP, ALC) do { \
    STAMP_T(tq0); qkt96n(PC0, PC1, K_lds + sc * SHM_K, qr, negm, r32, hi); STAMP_T(tq1); STAMP_ACC(1, tq0, tq1); \
    finishSM(PP0, PP1, ALP, l_reg, pa0, pa1, pa2, pa3); SBAR(); STAMP_T(tq0); STAMP_ACC(2, tq1, tq0); \
    { const int vb_ = vb0 + sp * SHM_V; pv_one_p<0>(o[0], vb_, pa0, pa1, pa2, pa3); pv_one_p<1>(o[1], vb_, pa0, pa1, pa2, pa3); } STAMP_T(tq1); STAMP_ACC(3, tq0, tq1); \
    partialSM2<false>(PC0, PC1, m_reg, negm, ALC, exact); RESC(ALC); STAMP_T(tq0); STAMP_ACC(4, tq1, tq0); } while (0)
#elif MLA_STEP_MODE == 2
  \
#define SGB(mask, n) __builtin_amdgcn_sched_group_barrier(mask, n, 0)
#define MLA_STEP(PC0, PC1, PP0, PP1, ALP, ALC) do { \
    { const char* Ks_ = K_lds + sc * SHM_K; \
      _Pragma("unroll") for (int d0 = 0; d0 < 6; ++d0) { const int cb = (d0 * 16 + hi * 8) * 2; \
        const bf16x8 b0 = *reinterpret_cast<const bf16x8*>(Ks_ + KSWZ(r32, cb)); const bf16x8 b1 = *reinterpret_cast<const bf16x8*>(Ks_ + KSWZ(32 + r32, cb)); \
        if (d0 == 0) { PC0 = __builtin_amdgcn_mfma_f32_32x32x16_bf16(b0, qr[0], negm, 0, 0, 0); PC1 = __builtin_amdgcn_mfma_f32_32x32x16_bf16(b1, qr[0], negm, 0, 0, 0); } \
        else { PC0 = __builtin_amdgcn_mfma_f32_32x32x16_bf16(b0, qr[d0], PC0, 0, 0, 0); PC1 = __builtin_amdgcn_mfma_f32_32x32x16_bf16(b1, qr[d0], PC1, 0, 0, 0); } } } \
    finishSM(PP0, PP1, ALP, l_reg, pa0, pa1, pa2, pa3); \
    SGB(0x100, 4); \
    _Pragma("unroll") for (int g_ = 0; g_ < 12; ++g_) { SGB(0x008, 1); SGB(0x100, 1); SGB(0x002, 7); } \
    SBAR(); \
    { const int vb_ = vb0 + sp * SHM_V; \
      const s16x4 l0 = tr_read<v_rd_off(0, 0, 0)>(vb_), h0 = tr_read<v_rd_off(0, 0, 1)>(vb_), l1 = tr_read<v_rd_off(0, 1, 0)>(vb_), h1 = tr_read<v_rd_off(0, 1, 1)>(vb_); \
      const s16x4 l2 = tr_read<v_rd_off(0, 2, 0)>(vb_), h2 = tr_read<v_rd_off(0, 2, 1)>(vb_), l3 = tr_read<v_rd_off(0, 3, 0)>(vb_), h3 = tr_read<v_rd_off(0, 3, 1)>(vb_); \
      const s16x4 l4 = tr_read<v_rd_off(1, 0, 0)>(vb_), h4 = tr_read<v_rd_off(1, 0, 1)>(vb_), l5 = tr_read<v_rd_off(1, 1, 0)>(vb_), h5 = tr_read<v_rd_off(1, 1, 1)>(vb_); \
      const s16x4 l6 = tr_read<v_rd_off(1, 2, 0)>(vb_), h6 = tr_read<v_rd_off(1, 2, 1)>(vb_), l7 = tr_read<v_rd_off(1, 3, 0)>(vb_), h7 = tr_read<v_rd_off(1, 3, 1)>(vb_); \
      asm volatile("s_waitcnt lgkmcnt(0)" ::: "memory"); SBAR(); \
      o[0] = __builtin_amdgcn_mfma_f32_32x32x16_bf16(pa0, PKV(l0, h0), o[0], 0, 0, 0); o[1] = __builtin_amdgcn_mfma_f32_32x32x16_bf16(pa0, PKV(l4, h4), o[1], 0, 0, 0); \
      o[0] = __builtin_amdgcn_mfma_f32_32x32x16_bf16(pa1, PKV(l1, h1), o[0], 0, 0, 0); o[1] = __builtin_amdgcn_mfma_f32_32x32x16_bf16(pa1, PKV(l5, h5), o[1], 0, 0, 0); \
      o[0] = __builtin_amdgcn_mfma_f32_32x32x16_bf16(pa2, PKV(l2, h2), o[0], 0, 0, 0); o[1] = __builtin_amdgcn_mfma_f32_32x32x16_bf16(pa2, PKV(l6, h6), o[1], 0, 0, 0); \
      o[0] = __builtin_amdgcn_mfma_f32_32x32x16_bf16(pa3, PKV(l3, h3), o[0], 0, 0, 0); o[1] = __builtin_amdgcn_mfma_f32_32x32x16_bf16(pa3, PKV(l7, h7), o[1], 0, 0, 0); \
      partialSM2<false>(PC0, PC1, m_reg, negm, ALC, exact); \
      _Pragma("unroll") for (int g_ = 0; g_ < 8; ++g_) { SGB(0x008, 1); SGB(0x002, 2); } \
      SBAR(); } \
    RESC(ALC); } while (0)
#else
#define KFH(dst, Ks_, D0) do { _Pragma("unroll") for (int d_ = 0; d_ < 3; ++d_) { const int cb_ = (((D0) + d_) * 16 + hi * 8) * 2; \
        dst[2 * d_] = *reinterpret_cast<const bf16x8*>((Ks_) + KSWZ(r32, cb_)); dst[2 * d_ + 1] = *reinterpret_cast<const bf16x8*>((Ks_) + KSWZ(32 + r32, cb_)); } } while (0)
#define MLA_STEP(PC0, PC1, PP0, PP1, ALP, ALC) do { \
    bf16x8 ka[6], kb[6]; s16x4 val[4], vah[4], vbl[4], vbh[4]; const int vb_ = vb0 + sp * SHM_V; const char* Ks_ = K_lds + sc * SHM_K; \
    KFH(ka, Ks_, 0); SBAR(); \
    finishSM(PP0, PP1, ALP, l_reg, pa0, pa1, pa2, pa3); SBAR(); \
    KFH(kb, Ks_, 3); SBAR(); \
    if (exact) { PC0 = __builtin_amdgcn_mfma_f32_32x32x16_bf16(ka[0], qr[0], negm, 0, 0, 0); PC1 = __builtin_amdgcn_mfma_f32_32x32x16_bf16(ka[1], qr[0], negm, 0, 0, 0); } \
    else { PC0 = __builtin_amdgcn_mfma_f32_32x32x16_bf16(ka[0], qr[0], negm, 0, 0, 0); PC1 = __builtin_amdgcn_mfma_f32_32x32x16_bf16(ka[1], qr[0], negm, 0, 0, 0); } \
    PC0 = __builtin_amdgcn_mfma_f32_32x32x16_bf16(ka[2], qr[1], PC0, 0, 0, 0); PC1 = __builtin_amdgcn_mfma_f32_32x32x16_bf16(ka[3], qr[1], PC1, 0, 0, 0); \
    PC0 = __builtin_amdgcn_mfma_f32_32x32x16_bf16(ka[4], qr[2], PC0, 0, 0, 0); PC1 = __builtin_amdgcn_mfma_f32_32x32x16_bf16(ka[5], qr[2], PC1, 0, 0, 0); SBAR(); \
    vfrag_load_h<0>(val, vah, vb_); SBAR(); \
    PC0 = __builtin_amdgcn_mfma_f32_32x32x16_bf16(kb[0], qr[3], PC0, 0, 0, 0); PC1 = __builtin_amdgcn_mfma_f32_32x32x16_bf16(kb[1], qr[3], PC1, 0, 0, 0); \
    PC0 = __builtin_amdgcn_mfma_f32_32x32x16_bf16(kb[2], qr[4], PC0, 0, 0, 0); PC1 = __builtin_amdgcn_mfma_f32_32x32x16_bf16(kb[3], qr[4], PC1, 0, 0, 0); \
    PC0 = __builtin_amdgcn_mfma_f32_32x32x16_bf16(kb[4], qr[5], PC0, 0, 0, 0); PC1 = __builtin_amdgcn_mfma_f32_32x32x16_bf16(kb[5], qr[5], PC1, 0, 0, 0); SBAR(); \
    vfrag_load_h<1>(vbl, vbh, vb_); SBAR(); \
    asm volatile("s_waitcnt lgkmcnt(8)" ::: "memory"); SBAR(); \
    pv_mma_h(o[0], val, vah, pa0, pa1, pa2, pa3); SBAR(); \
    asm volatile("s_waitcnt lgkmcnt(0)" ::: "memory"); SBAR(); \
    pv_mma_h(o[1], vbl, vbh, pa0, pa1, pa2, pa3); SBAR(); \
    partialSM2<false>(PC0, PC1, m_reg, negm, ALC, exact); RESC(ALC); } while (0)
#endif

__device__ __forceinline__ void mla_unit_v2(int wv, int bh, int qb, const unsigned short* __restrict__ Q, const unsigned short* __restrict__ KN, const unsigned short* __restrict__ KR,
                                            const unsigned short* __restrict__ V, unsigned short* __restrict__ CAT, const float* __restrict__ KMX, char* lds, unsigned long long* STAMPS = nullptr) {
    const int wid = wv, lane = gm::lane_now(), tid = wid * 64 + lane, r32 = lane & 31, hi = lane >> 5;
    const int b = bh >> 3, h = bh & 7;
    char* K_lds = lds + M2_K; char* V_lds = lds + M2_V;
    float* wsf = (float*)(lds + M2_WS) + wid * 64; float* li_l = wsf; float* al_l = wsf + 32;
    float m_reg = 0.f, l_reg = 0; f32x16 o[2] = {}; bf16x8 qr[6]; f32x16 negm = f32x16{};
    const size_t bhS = (size_t)bh * S; const int q0 = qb * 256;
    const unsigned short* Qw = Q + (bhS + q0 + wid * 32 + r32) * 96 + hi * 8;
#pragma unroll
    for (int d0 = 0; d0 < 6; ++d0) qr[d0] = *reinterpret_cast<const bf16x8*>(Qw + d0 * 16);
    bool exact = true;
    if (MLA_STATIC) { float q2 = 0.f;
#pragma unroll
      for (int d0 = 0; d0 < 6; ++d0)
#pragma unroll
          for (int j = 0; j < 8; ++j) { const float x = __uint_as_float((unsigned)(unsigned short)qr[d0][j] << 16); q2 += x * x; }
      { auto rr = __builtin_amdgcn_permlane32_swap(__float_as_uint(q2), __float_as_uint(q2), false, false); q2 = __uint_as_float(rr[0]) + __uint_as_float(rr[1]); }
      const float k2 = KMX[(b * 8 + h) * 2] + KMX[(b * 8 + h) * 2 + 1] + KMX[32 + b];
      const float ms = 1.01f * sqrtf(q2 * k2);
      exact = wg_or(!(ms <= MLA_STATIC_THR), (unsigned*)(lds + 147456 - 512), wid, lane);
      if (!exact) { m_reg = ms;
#pragma unroll
          for (int r = 0; r < 16; ++r) negm[r] = -ms; } }
    const int srow = tid >> 3, sch = tid & 7, rrow = (tid & 255) >> 2, rch = tid & 3;
    const char* kn_u = (const char*)(KN + bhS * 64); const char* v_u = (const char*)(V + bhS * 64); const char* kr_u = (const char*)(KR + (size_t)b * S * 32);
    const unsigned kn_off = (unsigned)(srow * 64 + sch * 8) * 2u, kr_off = (unsigned)(rrow * 32 + rch * 8) * 2u;
    const int kst = KSWZ(srow, sch * 16), krst = KSWZ(rrow, (8 + rch) * 16), vst = v_st(srow, sch * 8);
    const int vb0 = (int)(uintptr_t)V_lds + v_rd_base(lane);
    bf16x8 s_kn[1], s_kr[1], s_v[1];
#define SLOAD(i, t) do { s_kn[i] = *reinterpret_cast<const bf16x8*>(kn_u + (size_t)(t) * 8192 + kn_off); s_kr[i] = *reinterpret_cast<const bf16x8*>(kr_u + (size_t)(t) * 4096 + kr_off); \
    s_v[i] = *reinterpret_cast<const bf16x8*>(v_u + (size_t)(t) * 8192 + kn_off); } while (0)
#define SWRITE(sl, i) do { *(bf16x8*)(K_lds + (sl) * SHM_K + kst) = s_kn[i]; if (tid < 256) *(bf16x8*)(K_lds + (sl) * SHM_K + krst) = s_kr[i]; *(bf16x8*)(V_lds + (sl) * SHM_V + vst) = s_v[i]; } while (0)
#define SWAIT() asm volatile("s_waitcnt vmcnt(0)" ::: "memory")
#define RESC(a) do { if (exact && __any((a) < 1.f)) { if (hi == 0) al_l[r32] = (a); asm volatile("s_waitcnt lgkmcnt(0)" ::: "memory"); \
    _Pragma("unroll") for (int d = 0; d < 2; ++d) _Pragma("unroll") for (int r = 0; r < 16; ++r) o[d][r] *= al_l[crow(r, hi)]; } } while (0)
#define ROT3(x) ((x) == 2 ? 0 : (x) + 1)
    f32x16 pA0, pA1, pB0, pB1; float alA, alB; bf16x8 pa0, pa1, pa2, pa3; constexpr int NT = S / 64;
#if MLA_STAMP
    unsigned long long st_acc[8] = {0, 0, 0, 0, 0, 0, 0, 0}, tq0 = 0, tq1 = 0, ts0 = 0, ts1 = 0, tu0 = 0; STAMP_T(tu0);
#endif
    SLOAD(0, 0);
    SWAIT(); SWRITE(0, 0); SLOAD(0, 1);
    __syncthreads();
    qkt96n(pA0, pA1, K_lds, qr, negm, r32, hi); if (exact) partialSM2<true>(pA0, pA1, m_reg, negm, alA); else partialSM2<false>(pA0, pA1, m_reg, negm, alA, false);
    SWAIT(); SWRITE(1, 0); SLOAD(0, 2);
    __syncthreads();
    int sp = 0, sc = 1, sn = 2;
    for (int j = 1; j + 1 < NT; j += 2) {
        if (!MLA_PROBE_NOSTAGE) { SWAIT(); SWRITE(sn, 0); if (j + 2 < NT) SLOAD(0, j + 2); }
        SBAR(); MLA_STEP(pB0, pB1, pA0, pA1, alA, alB);
        __syncthreads();
        sp = sc; sc = sn; sn = ROT3(sn);
        if (!MLA_PROBE_NOSTAGE) { SWAIT(); SWRITE(sn, 0); if (j + 3 < NT) SLOAD(0, j + 3); }
        SBAR(); MLA_STEP(pA0, pA1, pB0, pB1, alB, alA);
        __syncthreads();
        sp = sc; sc = sn; sn = ROT3(sn);
    }
    SBAR(); MLA_STEP(pB0, pB1, pA0, pA1, alA, alB);
    finishSM(pB0, pB1, alB, l_reg, pa0, pa1, pa2, pa3); SBAR();
    { const int vb = vb0 + sc * SHM_V; pv_one_p<0>(o[0], vb, pa0, pa1, pa2, pa3); pv_one_p<1>(o[1], vb, pa0, pa1, pa2, pa3); }
    if (hi == 0) li_l[r32] = l_reg; asm volatile("s_waitcnt lgkmcnt(0)" ::: "memory");
    float rli[16];
#pragma unroll
    for (int r = 0; r < 16; ++r) rli[r] = __builtin_amdgcn_rcpf(li_l[crow(r, hi)]);
    unsigned short* stg = (unsigned short*)(lds + M2_OST) + wid * 2048;
    unsigned short* dst = CAT + ((size_t)b * S + q0 + wid * 32) * 1024 + h * 64;
    store_o_tile(o, rli, stg, dst, [](int row) { return (size_t)row * 1024; }, lane);
    asm volatile("s_waitcnt vmcnt(0)" ::: "memory");
#if MLA_STAMP
    { unsigned long long tu1; STAMP_T(tu1); st_acc[6] = tu1 - tu0;
      if (blockIdx.x == 0 && wid == MLA_STAMP_WAVE && lane == 0 && STAMPS) {
#pragma unroll
          for (int i = 0; i < 8; ++i) STAMPS[i] = st_acc[i]; } }
#endif
    __syncthreads();
#undef SLOAD
#undef SWRITE
#undef SWAIT
#undef RESC
#undef ROT3
}


__device__ __forceinline__ void finishSM_s(f32x16& p0, f32x16& p1, float& l_reg, bf16x8& pa0, bf16x8& pa1, bf16x8& pa2, bf16x8& pa3) {
#pragma unroll
    for (int r = 0; r < 16; ++r) p1[r] = __builtin_amdgcn_exp2f(p1[r]);
    float ps = 0;
#pragma unroll
    for (int r = 0; r < 16; ++r) ps += p0[r];
#pragma unroll
    for (int r = 0; r < 16; ++r) ps += p1[r];
    l_reg += ps;
    PK4(p0, 0, pa0); PK4(p0, 8, pa1); PK4(p1, 0, pa2); PK4(p1, 8, pa3);
}
__device__ __forceinline__ void exp_half(f32x16& p0) {
#pragma unroll
    for (int r = 0; r < 16; ++r) p0[r] = __builtin_amdgcn_exp2f(p0[r]);
}
__device__ __forceinline__ bool mla_unit_v5(int wv, int bh, int qb, const unsigned short* __restrict__ Q, const unsigned short* __restrict__ KN, const unsigned short* __restrict__ KR,
                                            const unsigned short* __restrict__ V, unsigned short* __restrict__ CAT, const float* __restrict__ KMX, char* lds) {
    const int wid = wv, lane = gm::lane_now(), tid = wid * 64 + lane, r32 = lane & 31, hi = lane >> 5;
    const int b = bh >> 3, h = bh & 7;
    char* K_lds = lds + M2_K; char* V_lds = lds + M2_V;
    float* wsf = (float*)(lds + M2_WS) + wid * 64; float* li_l = wsf;
    float l_reg = 0; f32x16 o[2] = {}; bf16x8 qr[6];
    const size_t bhS = (size_t)bh * S; const int q0 = qb * 256;
    const unsigned short* Qw = Q + (bhS + q0 + wid * 32 + r32) * 96 + hi * 8;
#pragma unroll
    for (int d0 = 0; d0 < 6; ++d0) qr[d0] = *reinterpret_cast<const bf16x8*>(Qw + d0 * 16);
    f32x16 negm;
    { float q2 = 0.f;
#pragma unroll
      for (int d0 = 0; d0 < 6; ++d0)
#pragma unroll
          for (int j = 0; j < 8; ++j) { const float x = __uint_as_float((unsigned)(unsigned short)qr[d0][j] << 16); q2 += x * x; }
      { auto rr = __builtin_amdgcn_permlane32_swap(__float_as_uint(q2), __float_as_uint(q2), false, false); q2 = __uint_as_float(rr[0]) + __uint_as_float(rr[1]); }
      const float k2 = KMX[(b * 8 + h) * 2] + KMX[(b * 8 + h) * 2 + 1] + KMX[32 + b];
      const float m = 1.01f * sqrtf(q2 * k2);
#pragma unroll
      for (int r = 0; r < 16; ++r) negm[r] = -m; }
    const int srow = tid >> 3, sch = tid & 7, rrow = (tid & 255) >> 2, rch = tid & 3;
    const char* kn_u = (const char*)(KN + bhS * 64); const char* v_u = (const char*)(V + bhS * 64); const char* kr_u = (const char*)(KR + (size_t)b * S * 32);
    const unsigned kn_off = (unsigned)(srow * 64 + sch * 8) * 2u, kr_off = (unsigned)(rrow * 32 + rch * 8) * 2u;
    const int kst = KSWZ(srow, sch * 16), krst = KSWZ(rrow, (8 + rch) * 16), vst = v_st(srow, sch * 8);
    const int vb0 = (int)(uintptr_t)V_lds + v_rd_base(lane);
    bf16x8 s_kn, s_kr, s_v;
#define SLOAD(t) do { s_kn = *reinterpret_cast<const bf16x8*>(kn_u + (size_t)(t) * 8192 + kn_off); s_kr = *reinterpret_cast<const bf16x8*>(kr_u + (size_t)(t) * 4096 + kr_off); \
    s_v = *reinterpret_cast<const bf16x8*>(v_u + (size_t)(t) * 8192 + kn_off); } while (0)
#define SWRITE(sl) do { *(bf16x8*)(K_lds + (sl) * SHM_K + kst) = s_kn; if (tid < 256) *(bf16x8*)(K_lds + (sl) * SHM_K + krst) = s_kr; *(bf16x8*)(V_lds + (sl) * SHM_V + vst) = s_v; } while (0)
#define SWAIT() asm volatile("s_waitcnt vmcnt(0)" ::: "memory")
#define ROT3(x) ((x) == 2 ? 0 : (x) + 1)
#define STEP5(PC0, PC1, PP0, PP1) do { \
    qkt96n(PC0, PC1, K_lds + sc * SHM_K, qr, negm, r32, hi); \
    finishSM_s(PP0, PP1, l_reg, pa0, pa1, pa2, pa3); SBAR(); \
    { const int vb_ = vb0 + sp * SHM_V; pv_one_p<0>(o[0], vb_, pa0, pa1, pa2, pa3); pv_one_p<1>(o[1], vb_, pa0, pa1, pa2, pa3); } \
    exp_half(PC0); } while (0)
    f32x16 pA0, pA1, pB0, pB1; bf16x8 pa0, pa1, pa2, pa3; constexpr int NT = S / 64;
    SLOAD(0);
    SWAIT(); SWRITE(0); SLOAD(1);
    __syncthreads();
    qkt96n(pA0, pA1, K_lds, qr, negm, r32, hi); exp_half(pA0);
    SWAIT(); SWRITE(1); SLOAD(2);
    __syncthreads();
    int sp = 0, sc = 1, sn = 2;
    for (int j = 1; j + 1 < NT; j += 2) {
        SWAIT(); SWRITE(sn); if (j + 2 < NT) SLOAD(j + 2);
        SBAR(); STEP5(pB0, pB1, pA0, pA1);
        __syncthreads();
        sp = sc; sc = sn; sn = ROT3(sn);
        SWAIT(); SWRITE(sn); if (j + 3 < NT) SLOAD(j + 3);
        SBAR(); STEP5(pA0, pA1, pB0, pB1);
        __syncthreads();
        sp = sc; sc = sn; sn = ROT3(sn);
    }
    SBAR(); STEP5(pB0, pB1, pA0, pA1);
    finishSM_s(pB0, pB1, l_reg, pa0, pa1, pa2, pa3); SBAR();
    { const int vb = vb0 + sc * SHM_V; pv_one_p<0>(o[0], vb, pa0, pa1, pa2, pa3); pv_one_p<1>(o[1], vb, pa0, pa1, pa2, pa3); }
    { auto rr = __builtin_amdgcn_permlane32_swap(__float_as_uint(l_reg), __float_as_uint(l_reg), false, false); l_reg = __uint_as_float(rr[0]) + __uint_as_float(rr[1]); }
    const bool bad = !(l_reg > 1e-30f);
    if (hi == 0) li_l[r32] = l_reg; asm volatile("s_waitcnt lgkmcnt(0)" ::: "memory");
    float rli[16];
#pragma unroll
    for (int r = 0; r < 16; ++r) rli[r] = __builtin_amdgcn_rcpf(li_l[crow(r, hi)]);
    unsigned short* stg = (unsigned short*)(lds + M2_OST) + wid * 2048;
    unsigned short* dst = CAT + ((size_t)b * S + q0 + wid * 32) * 1024 + h * 64;
    store_o_tile(o, rli, stg, dst, [](int row) { return (size_t)row * 1024; }, lane);
    asm volatile("s_waitcnt vmcnt(0)" ::: "memory");
    const int anybad = wg_or(bad, (unsigned*)(lds + 147456 - 512), wid, lane) ? 1 : 0;
    return anybad != 0;
#undef SLOAD
#undef SWRITE
#undef SWAIT
#undef ROT3
#undef STEP5
}

constexpr int M4_K = 0, M4_V = 4 * SHM_K, M4_WS = M4_V + 4 * SHM_V, M4_OST = M4_WS + 8 * 256;
template <bool FIRST> __device__ __forceinline__ void softmax_full(f32x16& p0, f32x16& p1, float& m_reg, f32x16& negm, float& l_reg, float& alpha, bf16x8& pa0, bf16x8& pa1, bf16x8& pa2, bf16x8& pa3, bool exact) {
    if (exact) partialSM2<FIRST>(p0, p1, m_reg, negm, alpha, true); else partialSM2<false>(p0, p1, m_reg, negm, alpha, false);
    finishSM(p0, p1, alpha, l_reg, pa0, pa1, pa2, pa3);
}
__device__ __forceinline__ void mla_unit_v4(int wv, int bh, int qb, const unsigned short* __restrict__ Q, const unsigned short* __restrict__ KN, const unsigned short* __restrict__ KR,
                                            const unsigned short* __restrict__ V, unsigned short* __restrict__ CAT, const float* __restrict__ KMX, char* lds, unsigned long long* STAMPS = nullptr) {
    const int wid = wv, lane = gm::lane_now(), tid = wid * 64 + lane, r32 = lane & 31, hi = lane >> 5;
    const int b = bh >> 3, h = bh & 7; const bool halfB = wid >= 4;
    char* K_lds = lds + M4_K; char* V_lds = lds + M4_V;
    float* wsf = (float*)(lds + M4_WS) + wid * 64; float* li_l = wsf; float* al_l = wsf + 32;
    float m_reg = 0.f, l_reg = 0; f32x16 o[2] = {}; bf16x8 qr[6]; f32x16 negm = f32x16{};
    const size_t bhS = (size_t)bh * S; const int q0 = qb * 256;
    const unsigned short* Qw = Q + (bhS + q0 + wid * 32 + r32) * 96 + hi * 8;
#pragma unroll
    for (int d0 = 0; d0 < 6; ++d0) qr[d0] = *reinterpret_cast<const bf16x8*>(Qw + d0 * 16);
    bool exact = true;
    if (MLA_STATIC) { float q2 = 0.f;
#pragma unroll
      for (int d0 = 0; d0 < 6; ++d0)
#pragma unroll
          for (int j = 0; j < 8; ++j) { const float x = __uint_as_float((unsigned)(unsigned short)qr[d0][j] << 16); q2 += x * x; }
      { auto rr = __builtin_amdgcn_permlane32_swap(__float_as_uint(q2), __float_as_uint(q2), false, false); q2 = __uint_as_float(rr[0]) + __uint_as_float(rr[1]); }
      const float k2 = KMX[(b * 8 + h) * 2] + KMX[(b * 8 + h) * 2 + 1] + KMX[32 + b];
      const float ms = 1.01f * sqrtf(q2 * k2);
      exact = wg_or(!(ms <= MLA_STATIC_THR), (unsigned*)(lds + 147456 - 512), wid, lane);
      if (!exact) { m_reg = ms;
#pragma unroll
          for (int r = 0; r < 16; ++r) negm[r] = -ms; } }
    const int srow = tid >> 3, sch = tid & 7, rrow = (tid & 255) >> 2, rch = tid & 3;
    const char* kn_u = (const char*)(KN + bhS * 64); const char* v_u = (const char*)(V + bhS * 64); const char* kr_u = (const char*)(KR + (size_t)b * S * 32);
    const unsigned kn_off = (unsigned)(srow * 64 + sch * 8) * 2u, kr_off = (unsigned)(rrow * 32 + rch * 8) * 2u;
    const int kst = KSWZ(srow, sch * 16), krst = KSWZ(rrow, (8 + rch) * 16), vst = v_st(srow, sch * 8);
    const int vb0 = (int)(uintptr_t)V_lds + v_rd_base(lane);
    bf16x8 s_kn, s_kr, s_v;
#define SLOAD(t) do { s_kn = *reinterpret_cast<const bf16x8*>(kn_u + (size_t)(t) * 8192 + kn_off); s_kr = *reinterpret_cast<const bf16x8*>(kr_u + (size_t)(t) * 4096 + kr_off); \
    s_v = *reinterpret_cast<const bf16x8*>(v_u + (size_t)(t) * 8192 + kn_off); } while (0)
#define SWRITE(sl) do { *(bf16x8*)(K_lds + (sl) * SHM_K + kst) = s_kn; if (tid < 256) *(bf16x8*)(K_lds + (sl) * SHM_K + krst) = s_kr; *(bf16x8*)(V_lds + (sl) * SHM_V + vst) = s_v; } while (0)
#define SWAIT() asm volatile("s_waitcnt vmcnt(0)" ::: "memory")
#define RESC(a) do { if (exact && __any((a) < 1.f)) { if (hi == 0) al_l[r32] = (a); asm volatile("s_waitcnt lgkmcnt(0)" ::: "memory"); \
    _Pragma("unroll") for (int d = 0; d < 2; ++d) _Pragma("unroll") for (int r = 0; r < 16; ++r) o[d][r] *= al_l[crow(r, hi)]; } } while (0)
#define RAWBAR() do { asm volatile("" ::: "memory"); __builtin_amdgcn_s_barrier(); asm volatile("" ::: "memory"); } while (0)
    f32x16 p0, p1; float al; bf16x8 pa0, pa1, pa2, pa3; bf16x8 kf[12]; constexpr int NT = S / 64;
#if MLA_STAMP
    unsigned long long st_acc[8] = {0, 0, 0, 0, 0, 0, 0, 0}, tq0 = 0, tq1 = 0, tu0 = 0; STAMP_T(tu0);
#endif
    SLOAD(0); SWAIT(); SWRITE(0); SLOAD(1); SWAIT(); SWRITE(1); SLOAD(2);
    asm volatile("s_waitcnt lgkmcnt(0)" ::: "memory"); RAWBAR();
    if (halfB) RAWBAR();
    kfrag_load(kf, K_lds, r32, hi); SBAR();
    qk_mma(p0, p1, kf, qr, negm); SBAR();
    asm volatile("s_waitcnt lgkmcnt(0)" ::: "memory"); RAWBAR();
    softmax_full<true>(p0, p1, m_reg, negm, l_reg, al, pa0, pa1, pa2, pa3, exact); SBAR();
    SWAIT(); SWRITE(2); SLOAD(3); SBAR();
    kfrag_load(kf, K_lds + SHM_K, r32, hi); SBAR();
    asm volatile("s_waitcnt lgkmcnt(12)" ::: "memory"); RAWBAR();
    int sp = 0, sc = 1, sw = 3;
    for (int t = 1; t < NT; ++t) {
        STAMP_T(tq0);
        { s16x4 val[4], vah[4], vbl[4], vbh[4]; const int vb_ = vb0 + sp * SHM_V;
          vfrag_load_h<0>(val, vah, vb_); SBAR();
          qk_mma(p0, p1, kf, qr, negm); SBAR();
          vfrag_load_h<1>(vbl, vbh, vb_); SBAR();
          asm volatile("s_waitcnt lgkmcnt(8)" ::: "memory"); SBAR();
          pv_mma_h(o[0], val, vah, pa0, pa1, pa2, pa3); SBAR();
          asm volatile("s_waitcnt lgkmcnt(0)" ::: "memory"); SBAR();
          pv_mma_h(o[1], vbl, vbh, pa0, pa1, pa2, pa3); SBAR(); }
        STAMP_T(tq1); STAMP_ACC(1, tq0, tq1);
        RAWBAR();
        STAMP_T(tq0); STAMP_ACC(2, tq1, tq0);
        if (t + 2 < NT) { SWAIT(); SWRITE(sw); if (t + 3 < NT) SLOAD(t + 3); } SBAR();
        softmax_full<false>(p0, p1, m_reg, negm, l_reg, al, pa0, pa1, pa2, pa3, exact); RESC(al); SBAR();
        sp = sc; sc = (sc + 1) & 3; sw = (sw + 1) & 3;
        if (t + 1 < NT) { kfrag_load(kf, K_lds + sc * SHM_K, r32, hi); SBAR(); }
        STAMP_T(tq1); STAMP_ACC(3, tq0, tq1);
        asm volatile("s_waitcnt lgkmcnt(12)" ::: "memory"); RAWBAR();
        STAMP_T(tq0); STAMP_ACC(4, tq1, tq0);
    }
    { s16x4 val[4], vah[4], vbl[4], vbh[4]; const int vb_ = vb0 + sp * SHM_V;
      vfrag_load_h<0>(val, vah, vb_); vfrag_load_h<1>(vbl, vbh, vb_); SBAR();
      asm volatile("s_waitcnt lgkmcnt(0)" ::: "memory"); SBAR();
      pv_mma_h(o[0], val, vah, pa0, pa1, pa2, pa3); pv_mma_h(o[1], vbl, vbh, pa0, pa1, pa2, pa3); SBAR(); }
    if (!halfB) RAWBAR();
    if (hi == 0) li_l[r32] = l_reg; asm volatile("s_waitcnt lgkmcnt(0)" ::: "memory");
    float rli[16];
#pragma unroll
    for (int r = 0; r < 16; ++r) rli[r] = __builtin_amdgcn_rcpf(li_l[crow(r, hi)]);
    unsigned short* stg = (unsigned short*)(lds + M4_OST) + wid * 2048;
    unsigned short* dst = CAT + ((size_t)b * S + q0 + wid * 32) * 1024 + h * 64;
    store_o_tile(o, rli, stg, dst, [](int row) { return (size_t)row * 1024; }, lane);
    asm volatile("s_waitcnt vmcnt(0)" ::: "memory");
#if MLA_STAMP
    { unsigned long long tu1; STAMP_T(tu1); st_acc[6] = tu1 - tu0;
      if (blockIdx.x == 0 && wid == MLA_STAMP_WAVE && lane == 0 && STAMPS) {
#pragma unroll
          for (int i = 0; i < 8; ++i) STAMPS[i] = st_acc[i]; } }
#endif
    __syncthreads();
#undef SLOAD
#undef SWRITE
#undef SWAIT
#undef RESC
#undef RAWBAR
}


constexpr int M6_K = 0, M6_V = 4 * SHM_K, M6_WS = M6_V + 4 * SHM_V, M6_OST = M6_WS + 8 * 256;
#define KLD3(dst, Ks_, D0) do { _Pragma("unroll") for (int d_ = 0; d_ < 3; ++d_) { const int cb_ = (((D0) + d_) * 16 + hi * 8) * 2; \
        dst[2 * d_] = *reinterpret_cast<const bf16x8*>((Ks_) + KSWZ(r32, cb_)); dst[2 * d_ + 1] = *reinterpret_cast<const bf16x8*>((Ks_) + KSWZ(32 + r32, cb_)); } } while (0)
#define MF32(A, B, C) __builtin_amdgcn_mfma_f32_32x32x16_bf16(A, B, C, 0, 0, 0)
#define QK_ADD(DST, KF, QF, CIN, PPX, B) do { DST = MF32(KF, QF, CIN); s0 += PPX[B]; s1 += PPX[B + 1]; s2 += PPX[B + 2]; s3 += PPX[B + 3]; SBAR(); } while (0)
#define QK_PK(DST, KF, QF, CIN, PPX, B, OUT) do { DST = MF32(KF, QF, CIN); PK4(PPX, B, OUT); SBAR(); } while (0)
__device__ __forceinline__ void mla_unit_v6(int wv, int bh, int qb, const unsigned short* __restrict__ Q, const unsigned short* __restrict__ KN, const unsigned short* __restrict__ KR,
                                            const unsigned short* __restrict__ V, unsigned short* __restrict__ CAT, const float* __restrict__ KMX, char* lds) {
    const int wid = wv, lane = gm::lane_now(), tid = wid * 64 + lane, r32 = lane & 31, hi = lane >> 5;
    const int b = bh >> 3, h = bh & 7; const bool halfB = wid >= 4;
    char* K_lds = lds + M6_K; char* V_lds = lds + M6_V;
    float* wsf = (float*)(lds + M6_WS) + wid * 64; float* li_l = wsf; float* al_l = wsf + 32;
    float m_reg = 0.f, l_reg = 0; f32x16 o[2] = {}; bf16x8 qr[6]; f32x16 negm = f32x16{};
    const size_t bhS = (size_t)bh * S; const int q0 = qb * 256;
    const unsigned short* Qw = Q + (bhS + q0 + wid * 32 + r32) * 96 + hi * 8;
#pragma unroll
    for (int d0 = 0; d0 < 6; ++d0) qr[d0] = *reinterpret_cast<const bf16x8*>(Qw + d0 * 16);
    bool exact = true;
    if (MLA_STATIC) { float q2 = 0.f;
#pragma unroll
      for (int d0 = 0; d0 < 6; ++d0)
#pragma unroll
          for (int j = 0; j < 8; ++j) { const float x = __uint_as_float((unsigned)(unsigned short)qr[d0][j] << 16); q2 += x * x; }
      { auto rr = __builtin_amdgcn_permlane32_swap(__float_as_uint(q2), __float_as_uint(q2), false, false); q2 = __uint_as_float(rr[0]) + __uint_as_float(rr[1]); }
      const float k2 = KMX[(b * 8 + h) * 2] + KMX[(b * 8 + h) * 2 + 1] + KMX[32 + b];
      const float ms = 1.01f * sqrtf(q2 * k2);
      exact = wg_or(!(ms <= MLA_STATIC_THR), (unsigned*)(lds + 147456 - 512), wid, lane);
      if (!exact) { m_reg = ms;
#pragma unroll
          for (int r = 0; r < 16; ++r) negm[r] = -ms; } }
    const int srow = tid >> 3, sch = tid & 7, rrow = (tid & 255) >> 2, rch = tid & 3;
    const char* kn_u = (const char*)(KN + bhS * 64); const char* v_u = (const char*)(V + bhS * 64); const char* kr_u = (const char*)(KR + (size_t)b * S * 32);
    const unsigned kn_off = (unsigned)(srow * 64 + sch * 8) * 2u, kr_off = (unsigned)(rrow * 32 + rch * 8) * 2u;
    const int kst = KSWZ(srow, sch * 16), krst = KSWZ(rrow, (8 + rch) * 16), vst = v_st(srow, sch * 8);
    const int vb0 = (int)(uintptr_t)V_lds + v_rd_base(lane);
    bf16x8 s_kn, s_kr, s_v;
#define SLOAD(t) do { s_kn = *reinterpret_cast<const bf16x8*>(kn_u + (size_t)(t) * 8192 + kn_off); s_kr = *reinterpret_cast<const bf16x8*>(kr_u + (size_t)(t) * 4096 + kr_off); \
    s_v = *reinterpret_cast<const bf16x8*>(v_u + (size_t)(t) * 8192 + kn_off); } while (0)
#define SWRITE(sl) do { *(bf16x8*)(K_lds + (sl) * SHM_K + kst) = s_kn; if (tid < 256) *(bf16x8*)(K_lds + (sl) * SHM_K + krst) = s_kr; *(bf16x8*)(V_lds + (sl) * SHM_V + vst) = s_v; } while (0)
#define SWAIT() asm volatile("s_waitcnt vmcnt(0)" ::: "memory")
#define RESC(a) do { if (exact && __any((a) < 1.f)) { if (hi == 0) al_l[r32] = (a); asm volatile("s_waitcnt lgkmcnt(0)" ::: "memory"); l_reg *= (a); \
    _Pragma("unroll") for (int d = 0; d < 2; ++d) _Pragma("unroll") for (int r = 0; r < 16; ++r) o[d][r] *= al_l[crow(r, hi)]; } } while (0)
#define RAWBAR() do { asm volatile("" ::: "memory"); __builtin_amdgcn_s_barrier(); asm volatile("" ::: "memory"); } while (0)
#define EXP_TILE(P0, P1, FIRST_) do { float al_ = 1.f; \
        if (exact) { const float pmax = rowmax32b(P0, P1); \
            if ((FIRST_) || !__builtin_expect(__all(pmax <= THR), 1)) { const float dl = (FIRST_) ? pmax : fmaxf(pmax, 0.f); m_reg += dl; \
                _Pragma("unroll") for (int r = 0; r < 16; ++r) { P0[r] -= dl; P1[r] -= dl; } \
                _Pragma("unroll") for (int r = 0; r < 16; ++r) negm[r] = -m_reg; \
                if (!(FIRST_)) al_ = __builtin_amdgcn_exp2f(-dl); } } \
        _Pragma("unroll") for (int r = 0; r < 16; ++r) P0[r] = __builtin_amdgcn_exp2f(P0[r]); \
        _Pragma("unroll") for (int r = 0; r < 16; ++r) P1[r] = __builtin_amdgcn_exp2f(P1[r]); \
        RESC(al_); } while (0)
#define M_PART(PC0, PC1, PP0, PP1) do { \
        s16x4 val[4], vah[4], vbl[4], vbh[4]; const int vb_ = vb0 + sp * SHM_V; float s0 = 0.f, s1 = 0.f, s2 = 0.f, s3 = 0.f; \
        KLD3(kb, K_lds + sc * SHM_K, 3); SBAR(); \
        QK_ADD(PC0, ka[0], qr[0], negm, PP0, 0);  QK_ADD(PC1, ka[1], qr[0], negm, PP0, 4); \
        QK_ADD(PC0, ka[2], qr[1], PC0, PP0, 8);   QK_ADD(PC1, ka[3], qr[1], PC1, PP0, 12); \
        QK_ADD(PC0, ka[4], qr[2], PC0, PP1, 0);   QK_ADD(PC1, ka[5], qr[2], PC1, PP1, 4); \
        vfrag_load_h<0>(val, vah, vb_); vfrag_load_h<1>(vbl, vbh, vb_); SBAR(); \
        QK_ADD(PC0, kb[0], qr[3], PC0, PP1, 8);   QK_ADD(PC1, kb[1], qr[3], PC1, PP1, 12); \
        QK_PK(PC0, kb[2], qr[4], PC0, PP0, 0, pa0); QK_PK(PC1, kb[3], qr[4], PC1, PP0, 8, pa1); \
        QK_PK(PC0, kb[4], qr[5], PC0, PP1, 0, pa2); QK_PK(PC1, kb[5], qr[5], PC1, PP1, 8, pa3); \
        { float ps = (s0 + s1) + (s2 + s3); auto rr = __builtin_amdgcn_permlane32_swap(__float_as_uint(ps), __float_as_uint(ps), false, false); l_reg += __uint_as_float(rr[0]) + __uint_as_float(rr[1]); } \
        asm volatile("s_waitcnt lgkmcnt(0)" ::: "memory"); SBAR(); \
        pv_mma_h(o[0], val, vah, pa0, pa1, pa2, pa3); pv_mma_h(o[1], vbl, vbh, pa0, pa1, pa2, pa3); SBAR(); } while (0)
#define V_PART(PC0, PC1, t_) do { \
        if ((t_) + 2 < NT) { SWAIT(); SWRITE(sw); if ((t_) + 3 < NT) SLOAD((t_) + 3); } SBAR(); \
        EXP_TILE(PC0, PC1, false); SBAR(); \
        sp = sc; sc = (sc + 1) & 3; sw = (sw + 1) & 3; \
        if ((t_) + 1 < NT) { KLD3(ka, K_lds + sc * SHM_K, 0); SBAR(); } \
        asm volatile("s_waitcnt lgkmcnt(6)" ::: "memory"); RAWBAR(); } while (0)
    f32x16 pA0, pA1, pB0, pB1; bf16x8 pa0, pa1, pa2, pa3; bf16x8 ka[6], kb[6]; constexpr int NT = S / 64;
    SLOAD(0); SWAIT(); SWRITE(0); SLOAD(1); SWAIT(); SWRITE(1); SLOAD(2);
    asm volatile("s_waitcnt lgkmcnt(0)" ::: "memory"); RAWBAR();
    if (halfB) RAWBAR();
    KLD3(ka, K_lds, 0); KLD3(kb, K_lds, 3); SBAR();
    pA0 = MF32(ka[0], qr[0], negm); pA1 = MF32(ka[1], qr[0], negm); pA0 = MF32(ka[2], qr[1], pA0); pA1 = MF32(ka[3], qr[1], pA1); pA0 = MF32(ka[4], qr[2], pA0); pA1 = MF32(ka[5], qr[2], pA1);
    pA0 = MF32(kb[0], qr[3], pA0); pA1 = MF32(kb[1], qr[3], pA1); pA0 = MF32(kb[2], qr[4], pA0); pA1 = MF32(kb[3], qr[4], pA1); pA0 = MF32(kb[4], qr[5], pA0); pA1 = MF32(kb[5], qr[5], pA1); SBAR();
    asm volatile("s_waitcnt lgkmcnt(0)" ::: "memory"); RAWBAR();
    int sp = 0, sc = 0, sw = 2;
    SWAIT(); SWRITE(2); SLOAD(3); SBAR();
    EXP_TILE(pA0, pA1, true); SBAR();
    sp = 0; sc = 1; sw = 3;
    KLD3(ka, K_lds + SHM_K, 0); SBAR();
    asm volatile("s_waitcnt lgkmcnt(6)" ::: "memory"); RAWBAR();
    for (int t = 1; t + 1 < NT; t += 2) {
        M_PART(pB0, pB1, pA0, pA1); RAWBAR(); V_PART(pB0, pB1, t);
        M_PART(pA0, pA1, pB0, pB1); RAWBAR(); V_PART(pA0, pA1, t + 1);
    }
    M_PART(pB0, pB1, pA0, pA1); RAWBAR(); V_PART(pB0, pB1, NT - 1);
    { s16x4 val[4], vah[4], vbl[4], vbh[4]; const int vb_ = vb0 + sp * SHM_V; float ps = 0.f;
      vfrag_load_h<0>(val, vah, vb_); vfrag_load_h<1>(vbl, vbh, vb_); SBAR();
#pragma unroll
      for (int r = 0; r < 16; ++r) ps += pB0[r] + pB1[r];
      { auto rr = __builtin_amdgcn_permlane32_swap(__float_as_uint(ps), __float_as_uint(ps), false, false); l_reg += __uint_as_float(rr[0]) + __uint_as_float(rr[1]); }
      PK4(pB0, 0, pa0); PK4(pB0, 8, pa1); PK4(pB1, 0, pa2); PK4(pB1, 8, pa3);
      asm volatile("s_waitcnt lgkmcnt(0)" ::: "memory"); SBAR();
      pv_mma_h(o[0], val, vah, pa0, pa1, pa2, pa3); pv_mma_h(o[1], vbl, vbh, pa0, pa1, pa2, pa3); SBAR(); }
    if (!halfB) RAWBAR();
    if (hi == 0) li_l[r32] = l_reg; asm volatile("s_waitcnt lgkmcnt(0)" ::: "memory");
    float rli[16];
#pragma unroll
    for (int r = 0; r < 16; ++r) rli[r] = __builtin_amdgcn_rcpf(li_l[crow(r, hi)]);
    unsigned short* stg = (unsigned short*)(lds + M6_OST) + wid * 2048;
    unsigned short* dst = CAT + ((size_t)b * S + q0 + wid * 32) * 1024 + h * 64;
    store_o_tile(o, rli, stg, dst, [](int row) { return (size_t)row * 1024; }, lane);
    asm volatile("s_waitcnt vmcnt(0)" ::: "memory");
    __syncthreads();
#undef SLOAD
#undef SWRITE
#undef SWAIT
#undef RESC
#undef RAWBAR
#undef EXP_TILE
#undef M_PART
#undef V_PART
}


#define PV_EXP(OD, PA, VL, VH, PCX, B) do { OD = MF32(PA, PKV(VL, VH), OD); PCX[B] = __builtin_amdgcn_exp2f(PCX[B]); PCX[B + 1] = __builtin_amdgcn_exp2f(PCX[B + 1]); \
        PCX[B + 2] = __builtin_amdgcn_exp2f(PCX[B + 2]); PCX[B + 3] = __builtin_amdgcn_exp2f(PCX[B + 3]); asm volatile("" : "+v"(PCX)); SBAR(); } while (0)
__device__ __forceinline__ void mla_unit_v7(int wv, int bh, int qb, const unsigned short* __restrict__ Q, const unsigned short* __restrict__ KN, const unsigned short* __restrict__ KR,
                                            const unsigned short* __restrict__ V, unsigned short* __restrict__ CAT, const float* __restrict__ KMX, char* lds, unsigned long long* STAMPS = nullptr) {
    const int wid = wv, lane = gm::lane_now(), tid = wid * 64 + lane, r32 = lane & 31, hi = lane >> 5;
    const int b = bh >> 3, h = bh & 7;
    char* K_lds = lds + M6_K; char* V_lds = lds + M6_V;
    float* wsf = (float*)(lds + M6_WS) + wid * 64; float* li_l = wsf; float* al_l = wsf + 32;
    float m_reg = 0.f, l_reg = 0; f32x16 o[2] = {}; bf16x8 qr[6]; f32x16 negm = f32x16{};
    const size_t bhS = (size_t)bh * S; const int q0 = qb * 256;
    const unsigned short* Qw = Q + (bhS + q0 + wid * 32 + r32) * 96 + hi * 8;
#pragma unroll
    for (int d0 = 0; d0 < 6; ++d0) qr[d0] = *reinterpret_cast<const bf16x8*>(Qw + d0 * 16);
    bool exact = true;
    if (MLA_STATIC) { float q2 = 0.f;
#pragma unroll
      for (int d0 = 0; d0 < 6; ++d0)
#pragma unroll
          for (int j = 0; j < 8; ++j) { const float x = __uint_as_float((unsigned)(unsigned short)qr[d0][j] << 16); q2 += x * x; }
      { auto rr = __builtin_amdgcn_permlane32_swap(__float_as_uint(q2), __float_as_uint(q2), false, false); q2 = __uint_as_float(rr[0]) + __uint_as_float(rr[1]); }
      const float k2 = KMX[(b * 8 + h) * 2] + KMX[(b * 8 + h) * 2 + 1] + KMX[32 + b];
      const float ms = 1.01f * sqrtf(q2 * k2);
      exact = wg_or(!(ms <= MLA_STATIC_THR), (unsigned*)(lds + 147456 - 512), wid, lane);
      if (!exact) { m_reg = ms;
#pragma unroll
          for (int r = 0; r < 16; ++r) negm[r] = -ms; } }
    const int srow = tid >> 3, sch = tid & 7, rrow = (tid & 255) >> 2, rch = tid & 3;
    const char* kn_u = (const char*)(KN + bhS * 64); const char* v_u = (const char*)(V + bhS * 64); const char* kr_u = (const char*)(KR + (size_t)b * S * 32);
    const unsigned kn_off = (unsigned)(srow * 64 + sch * 8) * 2u, kr_off = (unsigned)(rrow * 32 + rch * 8) * 2u;
    const int kst = KSWZ(srow, sch * 16), krst = KSWZ(rrow, (8 + rch) * 16), vst = v_st(srow, sch * 8);
    const int vb0 = (int)(uintptr_t)V_lds + v_rd_base(lane);
    bf16x8 s_kn, s_kr, s_v;
#define SLOAD(t) do { s_kn = *reinterpret_cast<const bf16x8*>(kn_u + (size_t)(t) * 8192 + kn_off); s_kr = *reinterpret_cast<const bf16x8*>(kr_u + (size_t)(t) * 4096 + kr_off); \
    s_v = *reinterpret_cast<const bf16x8*>(v_u + (size_t)(t) * 8192 + kn_off); } while (0)
#define SWRITE(sl) do { *(bf16x8*)(K_lds + (sl) * SHM_K + kst) = s_kn; if (tid < 256) *(bf16x8*)(K_lds + (sl) * SHM_K + krst) = s_kr; *(bf16x8*)(V_lds + (sl) * SHM_V + vst) = s_v; } while (0)
#define SWAIT() asm volatile("s_waitcnt vmcnt(0)" ::: "memory")
#define RAWBAR() do { asm volatile("" ::: "memory"); __builtin_amdgcn_s_barrier(); asm volatile("" ::: "memory"); } while (0)
#define MAX_TILE(P0, P1, FIRST_, AL_) do { AL_ = 1.f; \
        if (V7_EXACT && exact) { const float pmax = rowmax32b(P0, P1); \
            if ((FIRST_) || !__builtin_expect(__all(pmax <= THR), 1)) { const float dl = (FIRST_) ? pmax : fmaxf(pmax, 0.f); m_reg += dl; \
                _Pragma("unroll") for (int r = 0; r < 16; ++r) { P0[r] -= dl; P1[r] -= dl; } \
                _Pragma("unroll") for (int r = 0; r < 16; ++r) negm[r] = -m_reg; \
                if (!(FIRST_)) AL_ = __builtin_amdgcn_exp2f(-dl); } } } while (0)
#define RESC7(a) do { if (V7_EXACT && exact && __any((a) < 1.f)) { if (hi == 0) al_l[r32] = (a); asm volatile("s_waitcnt lgkmcnt(0)" ::: "memory"); l_reg *= (a); \
    _Pragma("unroll") for (int d = 0; d < 2; ++d) _Pragma("unroll") for (int r = 0; r < 16; ++r) o[d][r] *= al_l[crow(r, hi)]; } } while (0)
#define STEP7(PC0, PC1, PP0, PP1, t_) do { \
        s16x4 val[4], vah[4], vbl[4], vbh[4]; const int vb_ = vb0 + sp * SHM_V; float s0 = 0.f, s1 = 0.f, s2 = 0.f, s3 = 0.f, al_; \
        if ((t_) + 2 < NT) { SWAIT(); SWRITE(sw); if ((t_) + 3 < NT) SLOAD((t_) + 3); } \
        KLD3(kb, K_lds + sc * SHM_K, 3); SBAR(); \
        QK_ADD(PC0, ka[0], qr[0], negm, PP0, 0);  QK_ADD(PC1, ka[1], qr[0], negm, PP0, 4); \
        QK_ADD(PC0, ka[2], qr[1], PC0, PP0, 8);   QK_ADD(PC1, ka[3], qr[1], PC1, PP0, 12); \
        QK_ADD(PC0, ka[4], qr[2], PC0, PP1, 0);   QK_ADD(PC1, ka[5], qr[2], PC1, PP1, 4); \
        vfrag_load_h<0>(val, vah, vb_); SBAR(); \
        QK_ADD(PC0, kb[0], qr[3], PC0, PP1, 8);   QK_ADD(PC1, kb[1], qr[3], PC1, PP1, 12); \
        QK_PK(PC0, kb[2], qr[4], PC0, PP0, 0, pa0); QK_PK(PC1, kb[3], qr[4], PC1, PP0, 8, pa1); \
        vfrag_load_h<1>(vbl, vbh, vb_); SBAR(); \
        QK_PK(PC0, kb[4], qr[5], PC0, PP1, 0, pa2); QK_PK(PC1, kb[5], qr[5], PC1, PP1, 8, pa3); \
        { float ps = (s0 + s1) + (s2 + s3); auto rr = __builtin_amdgcn_permlane32_swap(__float_as_uint(ps), __float_as_uint(ps), false, false); l_reg += __uint_as_float(rr[0]) + __uint_as_float(rr[1]); } \
        MAX_TILE(PC0, PC1, false, al_); \
        sp = sc; sc = (sc + 1) & 3; sw = (sw + 1) & 3; \
        if ((t_) + 1 < NT) KLD3(ka, K_lds + sc * SHM_K, 0); \
        asm volatile("s_waitcnt lgkmcnt(6)" ::: "memory"); SBAR(); \
        PV_EXP(o[0], pa0, val[0], vah[0], PC0, 0);  PV_EXP(o[1], pa0, vbl[0], vbh[0], PC0, 4); \
        PV_EXP(o[0], pa1, val[1], vah[1], PC0, 8);  PV_EXP(o[1], pa1, vbl[1], vbh[1], PC0, 12); \
        PV_EXP(o[0], pa2, val[2], vah[2], PC1, 0);  PV_EXP(o[1], pa2, vbl[2], vbh[2], PC1, 4); \
        PV_EXP(o[0], pa3, val[3], vah[3], PC1, 8);  PV_EXP(o[1], pa3, vbl[3], vbh[3], PC1, 12); \
        RESC7(al_); \
        RAWBAR(); } while (0)
    f32x16 pA0, pA1, pB0, pB1; bf16x8 pa0, pa1, pa2, pa3; bf16x8 ka[6], kb[6]; constexpr int NT = S / 64;

    SLOAD(0); SWAIT(); SWRITE(0); SLOAD(1); SWAIT(); SWRITE(1); SLOAD(2);
    asm volatile("s_waitcnt lgkmcnt(0)" ::: "memory"); RAWBAR();
    KLD3(ka, K_lds, 0); KLD3(kb, K_lds, 3); SBAR();
    pA0 = MF32(ka[0], qr[0], negm); pA1 = MF32(ka[1], qr[0], negm); pA0 = MF32(ka[2], qr[1], pA0); pA1 = MF32(ka[3], qr[1], pA1); pA0 = MF32(ka[4], qr[2], pA0); pA1 = MF32(ka[5], qr[2], pA1);
    pA0 = MF32(kb[0], qr[3], pA0); pA1 = MF32(kb[1], qr[3], pA1); pA0 = MF32(kb[2], qr[4], pA0); pA1 = MF32(kb[3], qr[4], pA1); pA0 = MF32(kb[4], qr[5], pA0); pA1 = MF32(kb[5], qr[5], pA1); SBAR();
    { float al0; MAX_TILE(pA0, pA1, true, al0); (void)al0; }
#pragma unroll
    for (int r = 0; r < 16; ++r) { pA0[r] = __builtin_amdgcn_exp2f(pA0[r]); pA1[r] = __builtin_amdgcn_exp2f(pA1[r]); }
    SWAIT(); SWRITE(2); SLOAD(3);
    int sp = 0, sc = 1, sw = 3;
    KLD3(ka, K_lds + SHM_K, 0);
    asm volatile("s_waitcnt lgkmcnt(6)" ::: "memory"); RAWBAR();
    for (int t = 1; t + 1 < NT; t += 2) { STEP7(pB0, pB1, pA0, pA1, t); STEP7(pA0, pA1, pB0, pB1, t + 1); }
    STEP7(pB0, pB1, pA0, pA1, NT - 1);
    { s16x4 val[4], vah[4], vbl[4], vbh[4]; const int vb_ = vb0 + sp * SHM_V; float ps = 0.f;
      vfrag_load_h<0>(val, vah, vb_); vfrag_load_h<1>(vbl, vbh, vb_); SBAR();
#pragma unroll
      for (int r = 0; r < 16; ++r) ps += pB0[r] + pB1[r];
      { auto rr = __builtin_amdgcn_permlane32_swap(__float_as_uint(ps), __float_as_uint(ps), false, false); l_reg += __uint_as_float(rr[0]) + __uint_as_float(rr[1]); }
      PK4(pB0, 0, pa0); PK4(pB0, 8, pa1); PK4(pB1, 0, pa2); PK4(pB1, 8, pa3);
      asm volatile("s_waitcnt lgkmcnt(0)" ::: "memory"); SBAR();
      pv_mma_h(o[0], val, vah, pa0, pa1, pa2, pa3); pv_mma_h(o[1], vbl, vbh, pa0, pa1, pa2, pa3); SBAR(); }
    if (hi == 0) li_l[r32] = l_reg; asm volatile("s_waitcnt lgkmcnt(0)" ::: "memory");
    float rli[16];
#pragma unroll
    for (int r = 0; r < 16; ++r) rli[r] = __builtin_amdgcn_rcpf(li_l[crow(r, hi)]);
    unsigned short* stg = (unsigned short*)(lds + M6_OST) + wid * 2048;
    unsigned short* dst = CAT + ((size_t)b * S + q0 + wid * 32) * 1024 + h * 64;
    store_o_tile(o, rli, stg, dst, [](int row) { return (size_t)row * 1024; }, lane);
    asm volatile("s_waitcnt vmcnt(0)" ::: "memory");
#if MLA_STAMP
    (void)STAMPS;
#endif
    __syncthreads();
#undef SLOAD
#undef SWRITE
#undef SWAIT
#undef RAWBAR
#undef MAX_TILE
#undef RESC7
#undef STEP7
}

#define PV_EXP8(OD, PA, VL, VH, PCX, B) do { OD = MF32(PA, PKV(VL, VH), OD); PCX[B] = __builtin_amdgcn_exp2f(PCX[B]); PCX[B + 1] = __builtin_amdgcn_exp2f(PCX[B + 1]); \
        PCX[B + 2] = __builtin_amdgcn_exp2f(PCX[B + 2]); PCX[B + 3] = __builtin_amdgcn_exp2f(PCX[B + 3]); asm volatile("" : "+v"(PCX)); SBAR(); } while (0)
__device__ __forceinline__ void mla_unit_v8(int wv, int bh, int qb, const unsigned short* __restrict__ Q, const unsigned short* __restrict__ KN, const unsigned short* __restrict__ KR,
                                            const unsigned short* __restrict__ V, unsigned short* __restrict__ CAT, const float* __restrict__ KMX, char* lds, unsigned long long* STAMPS = nullptr) {
    const int wid = wv, lane = gm::lane_now(), tid = wid * 64 + lane, r32 = lane & 31, hi = lane >> 5;
    const int b = bh >> 3, h = bh & 7; const bool halfB = wid >= 4;
    char* K_lds = lds + M6_K; char* V_lds = lds + M6_V;
    float* wsf = (float*)(lds + M6_WS) + wid * 64; float* li_l = wsf; float* al_l = wsf + 32;
    float m_reg = 0.f, l_reg = 0; f32x16 o[2] = {}; bf16x8 qr[6]; f32x16 negm = f32x16{};
    const size_t bhS = (size_t)bh * S; const int q0 = qb * 256;
    const unsigned short* Qw = Q + (bhS + q0 + wid * 32 + r32) * 96 + hi * 8;
#pragma unroll
    for (int d0 = 0; d0 < 6; ++d0) qr[d0] = *reinterpret_cast<const bf16x8*>(Qw + d0 * 16);
    bool exact = true;
    if (MLA_STATIC) { float q2 = 0.f;
#pragma unroll
      for (int d0 = 0; d0 < 6; ++d0)
#pragma unroll
          for (int j = 0; j < 8; ++j) { const float x = __uint_as_float((unsigned)(unsigned short)qr[d0][j] << 16); q2 += x * x; }
      { auto rr = __builtin_amdgcn_permlane32_swap(__float_as_uint(q2), __float_as_uint(q2), false, false); q2 = __uint_as_float(rr[0]) + __uint_as_float(rr[1]); }
      const float k2 = KMX[(b * 8 + h) * 2] + KMX[(b * 8 + h) * 2 + 1] + KMX[32 + b];
      const float ms = 1.01f * sqrtf(q2 * k2);
      exact = wg_or(!(ms <= MLA_STATIC_THR), (unsigned*)(lds + 147456 - 512), wid, lane);
      if (!exact) { m_reg = ms;
#pragma unroll
          for (int r = 0; r < 16; ++r) negm[r] = -ms; } }
    const int srow = tid >> 3, sch = tid & 7, rrow = (tid & 255) >> 2, rch = tid & 3;
    const char* kn_u = (const char*)(KN + bhS * 64); const char* v_u = (const char*)(V + bhS * 64); const char* kr_u = (const char*)(KR + (size_t)b * S * 32);
    const unsigned kn_off = (unsigned)(srow * 64 + sch * 8) * 2u, kr_off = (unsigned)(rrow * 32 + rch * 8) * 2u;
    const int kst = KSWZ(srow, sch * 16), krst = KSWZ(rrow, (8 + rch) * 16), vst = v_st(srow, sch * 8);
    const int vb0 = (int)(uintptr_t)V_lds + v_rd_base(lane);
    bf16x8 s_kn, s_kr, s_v;
#define SLOAD(t) do { s_kn = *reinterpret_cast<const bf16x8*>(kn_u + (size_t)(t) * 8192 + kn_off); s_kr = *reinterpret_cast<const bf16x8*>(kr_u + (size_t)(t) * 4096 + kr_off); \
    s_v = *reinterpret_cast<const bf16x8*>(v_u + (size_t)(t) * 8192 + kn_off); } while (0)
#define SWRITE(sl) do { *(bf16x8*)(K_lds + (sl) * SHM_K + kst) = s_kn; if (tid < 256) *(bf16x8*)(K_lds + (sl) * SHM_K + krst) = s_kr; *(bf16x8*)(V_lds + (sl) * SHM_V + vst) = s_v; } while (0)
#define SWAIT() asm volatile("s_waitcnt vmcnt(0)" ::: "memory")
#define RAWBAR() do { asm volatile("" ::: "memory"); __builtin_amdgcn_s_barrier(); asm volatile("" ::: "memory"); } while (0)
#define MAX_TILE(P0, P1, FIRST_, AL_) do { AL_ = 1.f; \
        if (V7_EXACT && exact) { const float pmax = rowmax32b(P0, P1); \
            if ((FIRST_) || !__builtin_expect(__all(pmax <= THR), 1)) { const float dl = (FIRST_) ? pmax : fmaxf(pmax, 0.f); m_reg += dl; \
                _Pragma("unroll") for (int r = 0; r < 16; ++r) { P0[r] -= dl; P1[r] -= dl; } \
                _Pragma("unroll") for (int r = 0; r < 16; ++r) negm[r] = -m_reg; \
                if (!(FIRST_)) AL_ = __builtin_amdgcn_exp2f(-dl); } } } while (0)
#define RESC7(a) do { if (V7_EXACT && exact && __any((a) < 1.f)) { if (hi == 0) al_l[r32] = (a); asm volatile("s_waitcnt lgkmcnt(0)" ::: "memory"); l_reg *= (a); \
    _Pragma("unroll") for (int d = 0; d < 2; ++d) _Pragma("unroll") for (int r = 0; r < 16; ++r) o[d][r] *= al_l[crow(r, hi)]; } } while (0)
#define STEP7(PC0, PC1, PP0, PP1, t_) do { \
        s16x4 val[4], vah[4], vbl[4], vbh[4]; const int vb_ = vb0 + sp * SHM_V; float s0 = 0.f, s1 = 0.f, s2 = 0.f, s3 = 0.f, al_; \
        KLD3(kb, K_lds + sc * SHM_K, 3); SBAR(); \
        QK_ADD(PC0, ka[0], qr[0], negm, PP0, 0);  QK_ADD(PC1, ka[1], qr[0], negm, PP0, 4); \
        QK_ADD(PC0, ka[2], qr[1], PC0, PP0, 8);   QK_ADD(PC1, ka[3], qr[1], PC1, PP0, 12); \
        QK_ADD(PC0, ka[4], qr[2], PC0, PP1, 0);   QK_ADD(PC1, ka[5], qr[2], PC1, PP1, 4); \
        vfrag_load_h<0>(val, vah, vb_); SBAR(); \
        QK_ADD(PC0, kb[0], qr[3], PC0, PP1, 8);   QK_ADD(PC1, kb[1], qr[3], PC1, PP1, 12); \
        QK_PK(PC0, kb[2], qr[4], PC0, PP0, 0, pa0); QK_PK(PC1, kb[3], qr[4], PC1, PP0, 8, pa1); \
        vfrag_load_h<1>(vbl, vbh, vb_); SBAR(); \
        QK_PK(PC0, kb[4], qr[5], PC0, PP1, 0, pa2); QK_PK(PC1, kb[5], qr[5], PC1, PP1, 8, pa3); \
        { float ps = (s0 + s1) + (s2 + s3); auto rr = __builtin_amdgcn_permlane32_swap(__float_as_uint(ps), __float_as_uint(ps), false, false); l_reg += __uint_as_float(rr[0]) + __uint_as_float(rr[1]); } \
        MAX_TILE(PC0, PC1, false, al_); \
        asm volatile("s_waitcnt lgkmcnt(0)" ::: "memory"); RAWBAR(); \
        if ((t_) + 2 < NT) { SWAIT(); SWRITE(sw); if ((t_) + 3 < NT) SLOAD((t_) + 3); } \
        sp = sc; sc = (sc + 1) & 3; sw = (sw + 1) & 3; \
        if ((t_) + 1 < NT) KLD3(ka, K_lds + sc * SHM_K, 0); SBAR(); \
        PV_EXP8(o[0], pa0, val[0], vah[0], PC0, 0);  PV_EXP8(o[1], pa0, vbl[0], vbh[0], PC0, 4); \
        PV_EXP8(o[0], pa1, val[1], vah[1], PC0, 8);  PV_EXP8(o[1], pa1, vbl[1], vbh[1], PC0, 12); \
        PV_EXP8(o[0], pa2, val[2], vah[2], PC1, 0);  PV_EXP8(o[1], pa2, vbl[2], vbh[2], PC1, 4); \
        PV_EXP8(o[0], pa3, val[3], vah[3], PC1, 8);  PV_EXP8(o[1], pa3, vbl[3], vbh[3], PC1, 12); \
        RESC7(al_); \
        asm volatile("s_waitcnt lgkmcnt(6)" ::: "memory"); RAWBAR(); } while (0)
    f32x16 pA0, pA1, pB0, pB1; bf16x8 pa0, pa1, pa2, pa3; bf16x8 ka[6], kb[6]; constexpr int NT = S / 64;

    SLOAD(0); SWAIT(); SWRITE(0); SLOAD(1); SWAIT(); SWRITE(1); SLOAD(2);
    asm volatile("s_waitcnt lgkmcnt(0)" ::: "memory"); RAWBAR();
    if (halfB) RAWBAR();
    KLD3(ka, K_lds, 0); KLD3(kb, K_lds, 3); SBAR();
    pA0 = MF32(ka[0], qr[0], negm); pA1 = MF32(ka[1], qr[0], negm); pA0 = MF32(ka[2], qr[1], pA0); pA1 = MF32(ka[3], qr[1], pA1); pA0 = MF32(ka[4], qr[2], pA0); pA1 = MF32(ka[5], qr[2], pA1);
    pA0 = MF32(kb[0], qr[3], pA0); pA1 = MF32(kb[1], qr[3], pA1); pA0 = MF32(kb[2], qr[4], pA0); pA1 = MF32(kb[3], qr[4], pA1); pA0 = MF32(kb[4], qr[5], pA0); pA1 = MF32(kb[5], qr[5], pA1); SBAR();
    { float al0; MAX_TILE(pA0, pA1, true, al0); (void)al0; }
    asm volatile("s_waitcnt lgkmcnt(0)" ::: "memory"); RAWBAR();
#pragma unroll
    for (int r = 0; r < 16; ++r) { pA0[r] = __builtin_amdgcn_exp2f(pA0[r]); pA1[r] = __builtin_amdgcn_exp2f(pA1[r]); }
    SWAIT(); SWRITE(2); SLOAD(3);
    int sp = 0, sc = 1, sw = 3;
    KLD3(ka, K_lds + SHM_K, 0);
    asm volatile("s_waitcnt lgkmcnt(6)" ::: "memory"); RAWBAR();
    for (int t = 1; t + 1 < NT; t += 2) { STEP7(pB0, pB1, pA0, pA1, t); STEP7(pA0, pA1, pB0, pB1, t + 1); }
    STEP7(pB0, pB1, pA0, pA1, NT - 1);
    { s16x4 val[4], vah[4], vbl[4], vbh[4]; const int vb_ = vb0 + sp * SHM_V; float ps = 0.f;
      vfrag_load_h<0>(val, vah, vb_); vfrag_load_h<1>(vbl, vbh, vb_); SBAR();
#pragma unroll
      for (int r = 0; r < 16; ++r) ps += pB0[r] + pB1[r];
      { auto rr = __builtin_amdgcn_permlane32_swap(__float_as_uint(ps), __float_as_uint(ps), false, false); l_reg += __uint_as_float(rr[0]) + __uint_as_float(rr[1]); }
      PK4(pB0, 0, pa0); PK4(pB0, 8, pa1); PK4(pB1, 0, pa2); PK4(pB1, 8, pa3);
      asm volatile("s_waitcnt lgkmcnt(0)" ::: "memory"); SBAR();
      pv_mma_h(o[0], val, vah, pa0, pa1, pa2, pa3); pv_mma_h(o[1], vbl, vbh, pa0, pa1, pa2, pa3); SBAR(); }
    if (!halfB) RAWBAR();
    if (hi == 0) li_l[r32] = l_reg; asm volatile("s_waitcnt lgkmcnt(0)" ::: "memory");
    float rli[16];
#pragma unroll
    for (int r = 0; r < 16; ++r) rli[r] = __builtin_amdgcn_rcpf(li_l[crow(r, hi)]);
    unsigned short* stg = (unsigned short*)(lds + M6_OST) + wid * 2048;
    unsigned short* dst = CAT + ((size_t)b * S + q0 + wid * 32) * 1024 + h * 64;
    store_o_tile(o, rli, stg, dst, [](int row) { return (size_t)row * 1024; }, lane);
    asm volatile("s_waitcnt vmcnt(0)" ::: "memory");
#if MLA_STAMP
    (void)STAMPS;
#endif
    __syncthreads();
#undef SLOAD
#undef SWRITE
#undef SWAIT
#undef RAWBAR
#undef MAX_TILE
#undef RESC7
#undef STEP7
#undef PV_EXP8
}

constexpr int DL_K = 0, DL_V = 49152, DL_WS = 98304, DL_OST = DL_WS + 8 * 256;
#define KSWZD(row, colB) ((row) * 128 + ((colB) ^ ((((row) >> 1) & 7) << 4)))
__device__ __forceinline__ void dil_unit(int wv, int bh, int br, int blk, const unsigned short* __restrict__ DQ, const unsigned short* __restrict__ DK, const unsigned short* __restrict__ DV,
                                         unsigned short* __restrict__ OBR, float* __restrict__ LSE, char* lds) {
    const int wid = wv, lane = gm::lane_now(), tid = wid * 64 + lane, r32 = lane & 31, hi = lane >> 5;
    const int sh = 2 * br, dil = 1 << sh, L = S >> sh, nbl = L >> 8, res = blk / nbl, lb = blk % nbl;
    const size_t bhS = (size_t)bh * S; const int b = bh >> 3, h = bh & 7;
    char* K_lds = lds + DL_K; char* V_lds = lds + DL_V;
#pragma unroll
    for (int half = 0; half < 2; ++half) {
        bf16x8 kk[3], vv[3];
#pragma unroll
        for (int it = 0; it < 3; ++it) { const int item = (half * 3 + it) * 512 + tid, row = item >> 3, ch = item & 7; const int l = 256 * lb - 64 + row; const bool valid = (l >= 0) && (l < L);
            const size_t src = (bhS + (valid ? ((size_t)l << sh) + res : 0)) * 64 + ch * 8;
            kk[it] = *reinterpret_cast<const bf16x8*>(DK + src); vv[it] = *reinterpret_cast<const bf16x8*>(DV + src);
            if (!valid) { kk[it] = bf16x8{}; vv[it] = bf16x8{}; } }
#pragma unroll
        for (int it = 0; it < 3; ++it) { const int item = (half * 3 + it) * 512 + tid, row = item >> 3, ch = item & 7;
            *(bf16x8*)(K_lds + KSWZD(row, ch * 16)) = kk[it]; *(bf16x8*)(V_lds + (row >> 4) * 2048 + v_st(row & 15, ch * 8)) = vv[it]; }
    }
    bf16x8 qr[4];
    const int ql = wid * 32 + r32; const size_t qpos = ((size_t)(256 * lb + ql) << sh) + res;
    const unsigned short* Qw = DQ + (bhS + qpos) * 64 + hi * 8;
#pragma unroll
    for (int d0 = 0; d0 < 4; ++d0) qr[d0] = *reinterpret_cast<const bf16x8*>(Qw + d0 * 16);
    __syncthreads();
    f32x16 p[5];
#pragma unroll
    for (int j = 0; j < 5; ++j) { p[j] = f32x16{}; const int row = wid * 32 + j * 32 + r32;
#pragma unroll
        for (int d0 = 0; d0 < 4; ++d0) { const bf16x8 kf = *reinterpret_cast<const bf16x8*>(K_lds + KSWZD(row, (d0 * 16 + hi * 8) * 2)); p[j] = __builtin_amdgcn_mfma_f32_32x32x16_bf16(kf, qr[d0], p[j], 0, 0, 0); } }
    const float NEG = -1e30f;
    const int klo = 64 - 256 * lb, khi = L + 64 - 256 * lb;
    { const int t0 = max(r32, klo - wid * 32) - 4 * hi, t1 = klo - wid * 32 - 32 - 4 * hi, t3 = khi - wid * 32 - 96 - 4 * hi, t4 = min(r32 + 1, khi - wid * 32 - 128) - 4 * hi;
#pragma unroll
      for (int r = 0; r < 16; ++r) { const int c = (r & 3) + 8 * (r >> 2);
          if (c < t0) p[0][r] = NEG; if (c < t1) p[1][r] = NEG; if (c >= t3) p[3][r] = NEG; if (c >= t4) p[4][r] = NEG; } }
    float mx = rowmax32(p[0], p[1]); mx = fmaxf(mx, rowmax32(p[2], p[3]));
    { float m4 = p[4][0];
#pragma unroll
      for (int r = 1; r < 16; ++r) m4 = fmaxf(m4, p[4][r]);
      auto rr = __builtin_amdgcn_permlane32_swap(__float_as_uint(m4), __float_as_uint(m4), false, false); mx = fmaxf(mx, fmaxf(__uint_as_float(rr[0]), __uint_as_float(rr[1]))); }
    float ps = 0.f;
#pragma unroll
    for (int j = 0; j < 5; ++j)
#pragma unroll
        for (int r = 0; r < 16; ++r) { p[j][r] = __builtin_amdgcn_exp2f(p[j][r] - mx); ps += p[j][r]; }
    { auto rr = __builtin_amdgcn_permlane32_swap(__float_as_uint(ps), __float_as_uint(ps), false, false); ps = __uint_as_float(rr[0]) + __uint_as_float(rr[1]); }
    bf16x8 pa[5][2];
#pragma unroll
    for (int j = 0; j < 5; ++j) { PK4(p[j], 0, pa[j][0]); PK4(p[j], 8, pa[j][1]); }
    f32x16 o[2] = {};
    const int vb = (int)(uintptr_t)V_lds + v_rd_base(lane) + wid * 4096;
    pv_half<0, 0 * 4096>(o[0], vb, pa[0][0], pa[0][1]); pv_half<1, 0 * 4096>(o[1], vb, pa[0][0], pa[0][1]);
    pv_half<0, 1 * 4096>(o[0], vb, pa[1][0], pa[1][1]); pv_half<1, 1 * 4096>(o[1], vb, pa[1][0], pa[1][1]);
    pv_half<0, 2 * 4096>(o[0], vb, pa[2][0], pa[2][1]); pv_half<1, 2 * 4096>(o[1], vb, pa[2][0], pa[2][1]);
    pv_half<0, 3 * 4096>(o[0], vb, pa[3][0], pa[3][1]); pv_half<1, 3 * 4096>(o[1], vb, pa[3][0], pa[3][1]);
    pv_half<0, 4 * 4096>(o[0], vb, pa[4][0], pa[4][1]); pv_half<1, 4 * 4096>(o[1], vb, pa[4][0], pa[4][1]);
    float* wsf = (float*)(lds + DL_WS) + wid * 64;
    if (hi == 0) { wsf[r32] = ps; LSE[((size_t)br * T + (size_t)b * S + qpos) * 8 + h] = mx + __builtin_amdgcn_logf(ps); }
    asm volatile("s_waitcnt lgkmcnt(0)" ::: "memory");
    float rli[16];
#pragma unroll
    for (int r = 0; r < 16; ++r) rli[r] = __builtin_amdgcn_rcpf(wsf[crow(r, hi)]);
    unsigned short* stg = (unsigned short*)(lds + DL_OST) + wid * 2048;
    unsigned short* dst = OBR + ((size_t)br * T + (size_t)b * S + (((size_t)(256 * lb + wid * 32)) << sh) + res) * 512 + h * 64;
    store_o_tile(o, rli, stg, dst, [sh](int row) { return ((size_t)row << sh) * 512; }, lane);
    asm volatile("s_waitcnt vmcnt(0)" ::: "memory");
    __syncthreads();
}
#define DIL_DECODE(u, bh_, br_, res_, lb_, sh_, L_) const int bh_ = (u) / 96, br_ = ((u) >> 5) % 3, blk__##bh_ = (u) & 31, sh_ = 2 * br_, L_ = S >> sh_, nbl__##bh_ = L_ >> 8, res_ = blk__##bh_ / nbl__##bh_, lb_ = blk__##bh_ % nbl__##bh_
__device__ __forceinline__ void dil_phase(int wv, int u0, int ustep, int nunits, const unsigned short* __restrict__ DQ, const unsigned short* __restrict__ DK, const unsigned short* __restrict__ DV,
                                          unsigned short* __restrict__ OBR, float* __restrict__ LSE, char* lds) {
    const int wid = wv, lane = gm::lane_now(), tid = wid * 64 + lane, r32 = lane & 31, hi = lane >> 5;
    char* K_lds = lds + DL_K; char* V_lds = lds + DL_V;
    bf16x8 kk[6], qn[4]; unsigned kmask = 0u;
#define DIL_LOAD6(dst, mask, SRC, u) do { DIL_DECODE(u, bh_, br_, res_, lb_, sh_, L_); const size_t bhS_ = (size_t)bh_ * S; mask = 0u; \
        _Pragma("unroll") for (int it = 0; it < 6; ++it) { const int item = it * 512 + tid, row = item >> 3, ch = item & 7; const int l = 256 * lb_ - 64 + row; const bool valid = (l >= 0) && (l < L_); \
            const size_t src = (bhS_ + (valid ? ((size_t)l << sh_) + res_ : 0)) * 64 + ch * 8; dst[it] = *reinterpret_cast<const bf16x8*>(SRC + src); mask |= (valid ? 1u : 0u) << it; } } while (0)
#define DIL_LOADQ(u) do { DIL_DECODE(u, bh_, br_, res_, lb_, sh_, L_); const size_t qpos_ = ((size_t)(256 * lb_ + wid * 32 + r32) << sh_) + res_; const unsigned short* Qw_ = DQ + ((size_t)bh_ * S + qpos_) * 64 + hi * 8; \
        _Pragma("unroll") for (int d0 = 0; d0 < 4; ++d0) qn[d0] = *reinterpret_cast<const bf16x8*>(Qw_ + d0 * 16); } while (0)
    int u = u0;
    if (u < nunits) { DIL_LOAD6(kk, kmask, DK, u); DIL_LOADQ(u); }
    for (; u < nunits; u += ustep) {
        DIL_DECODE(u, bh, br, res, lb, sh, L); const int b = bh >> 3, h = bh & 7;
#pragma unroll
        for (int it = 0; it < 6; ++it) { const int item = it * 512 + tid, row = item >> 3, ch = item & 7; *(bf16x8*)(K_lds + KSWZD(row, ch * 16)) = ((kmask >> it) & 1u) ? kk[it] : bf16x8{}; }
        bf16x8 qr[4];
#pragma unroll
        for (int d0 = 0; d0 < 4; ++d0) qr[d0] = qn[d0];
        bf16x8 vv[6]; unsigned vmask; DIL_LOAD6(vv, vmask, DV, u);
        __syncthreads();
        const int ql = wid * 32 + r32; const size_t qpos = ((size_t)(256 * lb + ql) << sh) + res;
        f32x16 p[5];
#pragma unroll
        for (int j = 0; j < 5; ++j) { p[j] = f32x16{}; const int row = wid * 32 + j * 32 + r32;
#pragma unroll
            for (int d0 = 0; d0 < 4; ++d0) { const bf16x8 kf = *reinterpret_cast<const bf16x8*>(K_lds + KSWZD(row, (d0 * 16 + hi * 8) * 2)); p[j] = __builtin_amdgcn_mfma_f32_32x32x16_bf16(kf, qr[d0], p[j], 0, 0, 0); } }
        const float NEG = -1e30f;
        const int klo = 64 - 256 * lb, khi = L + 64 - 256 * lb;
        { const int t0 = max(r32, klo - wid * 32) - 4 * hi, t1 = klo - wid * 32 - 32 - 4 * hi, t3 = khi - wid * 32 - 96 - 4 * hi, t4 = min(r32 + 1, khi - wid * 32 - 128) - 4 * hi;
#pragma unroll
          for (int r = 0; r < 16; ++r) { const int c = (r & 3) + 8 * (r >> 2);
              if (c < t0) p[0][r] = NEG; if (c < t1) p[1][r] = NEG; if (c >= t3) p[3][r] = NEG; if (c >= t4) p[4][r] = NEG; } }
        float mx = rowmax32(p[0], p[1]); mx = fmaxf(mx, rowmax32(p[2], p[3]));
        { float m4 = p[4][0];
#pragma unroll
          for (int r = 1; r < 16; ++r) m4 = fmaxf(m4, p[4][r]);
          auto rr = __builtin_amdgcn_permlane32_swap(__float_as_uint(m4), __float_as_uint(m4), false, false); mx = fmaxf(mx, fmaxf(__uint_as_float(rr[0]), __uint_as_float(rr[1]))); }
        float ps = 0.f;
#pragma unroll
        for (int j = 0; j < 5; ++j)
#pragma unroll
            for (int r = 0; r < 16; ++r) { p[j][r] = __builtin_amdgcn_exp2f(p[j][r] - mx); ps += p[j][r]; }
        { auto rr = __builtin_amdgcn_permlane32_swap(__float_as_uint(ps), __float_as_uint(ps), false, false); ps = __uint_as_float(rr[0]) + __uint_as_float(rr[1]); }
        bf16x8 pa[5][2];
#pragma unroll
        for (int j = 0; j < 5; ++j) { PK4(p[j], 0, pa[j][0]); PK4(p[j], 8, pa[j][1]); }
#pragma unroll
        for (int it = 0; it < 6; ++it) { const int item = it * 512 + tid, row = item >> 3, ch = item & 7; *(bf16x8*)(V_lds + (row >> 4) * 2048 + v_st(row & 15, ch * 8)) = ((vmask >> it) & 1u) ? vv[it] : bf16x8{}; }
        __syncthreads();
        if (u + ustep < nunits) { DIL_LOAD6(kk, kmask, DK, u + ustep); DIL_LOADQ(u + ustep); }
        f32x16 o[2] = {};
        const int vb = (int)(uintptr_t)V_lds + v_rd_base(lane) + wid * 4096;
        pv_half<0, 0 * 4096>(o[0], vb, pa[0][0], pa[0][1]); pv_half<1, 0 * 4096>(o[1], vb, pa[0][0], pa[0][1]);
        pv_half<0, 1 * 4096>(o[0], vb, pa[1][0], pa[1][1]); pv_half<1, 1 * 4096>(o[1], vb, pa[1][0], pa[1][1]);
        pv_half<0, 2 * 4096>(o[0], vb, pa[2][0], pa[2][1]); pv_half<1, 2 * 4096>(o[1], vb, pa[2][0], pa[2][1]);
        pv_half<0, 3 * 4096>(o[0], vb, pa[3][0], pa[3][1]); pv_half<1, 3 * 4096>(o[1], vb, pa[3][0], pa[3][1]);
        pv_half<0, 4 * 4096>(o[0], vb, pa[4][0], pa[4][1]); pv_half<1, 4 * 4096>(o[1], vb, pa[4][0], pa[4][1]);
        float* wsf = (float*)(lds + DL_WS) + wid * 64;
        if (hi == 0) { wsf[r32] = ps; LSE[((size_t)br * T + (size_t)b * S + qpos) * 8 + h] = mx + __builtin_amdgcn_logf(ps); }
        asm volatile("s_waitcnt lgkmcnt(0)" ::: "memory");
        float rli[16];
#pragma unroll
        for (int r = 0; r < 16; ++r) rli[r] = __builtin_amdgcn_rcpf(wsf[crow(r, hi)]);
        unsigned short* stg = (unsigned short*)(lds + DL_OST) + wid * 2048;
        unsigned short* dst = OBR + ((size_t)br * T + (size_t)b * S + (((size_t)(256 * lb + wid * 32)) << sh) + res) * 512 + h * 64;
        store_o_tile(o, rli, stg, dst, [sh](int row) { return ((size_t)row << sh) * 512; }, lane);
        __syncthreads();
    }
#undef DIL_LOAD6
#undef DIL_LOADQ
}
__device__ __forceinline__ void dil_combine(const unsigned short* __restrict__ OBR, const float* __restrict__ LSE, unsigned short* __restrict__ CAT, int gtid, int gthreads) {
    for (int i = gtid; i < T * 64; i += gthreads) { const int t = i >> 6, c8 = i & 63, h = c8 >> 3;
        const float l0 = LSE[((size_t)0 * T + t) * 8 + h], l1 = LSE[((size_t)1 * T + t) * 8 + h], l2 = LSE[((size_t)2 * T + t) * 8 + h];
        const float mx = fmaxf(l0, fmaxf(l1, l2)); float w0 = __builtin_amdgcn_exp2f(l0 - mx), w1 = __builtin_amdgcn_exp2f(l1 - mx), w2 = __builtin_amdgcn_exp2f(l2 - mx);
        const float inv = 1.f / (w0 + w1 + w2); w0 *= inv; w1 *= inv; w2 *= inv;
        const u32x4 a = *(const u32x4*)(OBR + ((size_t)0 * T + t) * 512 + c8 * 8), bb = *(const u32x4*)(OBR + ((size_t)1 * T + t) * 512 + c8 * 8), cc = *(const u32x4*)(OBR + ((size_t)2 * T + t) * 512 + c8 * 8);
        u32x4 o;
#pragma unroll
        for (int k = 0; k < 4; ++k) { const float lo = w0 * __uint_as_float(a[k] << 16) + w1 * __uint_as_float(bb[k] << 16) + w2 * __uint_as_float(cc[k] << 16);
            const float hi = w0 * __uint_as_float(a[k] & 0xffff0000u) + w1 * __uint_as_float(bb[k] & 0xffff0000u) + w2 * __uint_as_float(cc[k] & 0xffff0000u); o[k] = cvtpk(lo, hi); }
        *(u32x4*)(CAT + (size_t)t * 1024 + 512 + c8 * 8) = o; }
}
#undef SBAR
}
namespace mk {
struct SchedP4 {
    __device__ __forceinline__ void a_ready(const gm::Unit&, int, int) const {}
    __device__ __forceinline__ void done(const gm::Unit&, int) const {}
    __device__ __forceinline__ void stamp(int, const gm::Unit&, int, int) const {}
    static constexpr bool GATHER = false;
    const char* A; const char* Bt; int G, c;
    __device__ __forceinline__ bool next(int i, gm::Unit& u) const { int pm, pn; if (!static_tile(i, G, c, 64, 4, pm, pn)) return false;
        u.A = A; u.Bt = Bt; u.gidx = nullptr; u.lda2 = 2048; u.ldb2 = 2048; u.arow0 = pm * 256; u.brow0 = pn * 256; u.nt = 16; u.pm = pm; u.pn = pn; u.aux = 0; return true; }
};
struct EpiP4 {
    static constexpr bool PERM = false;
    const float* x; float* out; const float* modf;
    __device__ __forceinline__ void operator()(EPI_ARGS) const {
        const int b = (u.pm * 256) >> 13; const float* gt = modf + b * 6144 + 2048;
        const int col0 = u.pn * 256 + wc * 32 + 4 * fq;
        f32x4 g[2][2];
#pragma unroll
        for (int bj = 0; bj < 2; ++bj)
#pragma unroll
            for (int n = 0; n < 2; ++n) g[bj][n] = *(const f32x4*)(gt + col0 + bj * 128 + n * 16);
#pragma unroll
        for (int ai = 0; ai < 2; ++ai)
#pragma unroll
            for (int m = 0; m < 4; ++m) { const size_t off = (size_t)(u.pm * 256 + ai * 128 + wr * 64 + m * 16 + fr) * D + col0;
#pragma unroll
                for (int bj = 0; bj < 2; ++bj)
#pragma unroll
                    for (int n = 0; n < 2; ++n) { const f32x4 xv = *(const f32x4*)(x + off + bj * 128 + n * 16); *(f32x4*)(out + off + bj * 128 + n * 16) = xv + g[bj][n] * acc[ai][bj][m][n]; } }
    }
};
__device__ __forceinline__ void p4b_rows(Frame& F) {
    const int tid_ = F.wave * 64 + fresh_lane();
    LAS float* WR = (LAS float*)F.lds;
    LAS float* A1 = WR + 16384;
    LAS float* A0 = A1 + 2048;
    const float* modf = (const float*)(F.ws + WS_MODF);
    for (int i = tid_; i < 16384; i += NTHREADS) { const int j = i >> 4, e = i & 15; WR[e * 1024 + j] = F.w_router[i]; }
    for (int i = tid_; i < 2048; i += NTHREADS) { const int b = i >> 10, j = i & 1023; A1[i] = F.g_ffn[j] * (1.f + modf[b * 6144 + 4096 + j]); A0[i] = modf[b * 6144 + 3072 + j]; }
    __syncthreads();
    const int gw = F.vcu * NWAVES + F.wave, NGW = F.G * NWAVES, lane = fresh_lane();
    for (int m = gw; m < T; m += NGW) { const int b = m >> 13, s = m & 8191;
        const f32x4* xr = (const f32x4*)(F.out + (size_t)m * D) + lane; f32x4 v[4]; float ss = 0.f;
#pragma unroll
        for (int j = 0; j < 4; ++j) { v[j] = xr[64 * j]; ss += (v[j].x * v[j].x + v[j].y * v[j].y) + (v[j].z * v[j].z + v[j].w * v[j].w); }
        const float rstd = rsqrtf(wave_sum(ss) * (1.f / D) + EPS);
        unsigned long long* o8 = (unsigned long long*)((bf16_t*)(F.ws + WS_HB) + (size_t)m * D) + lane;
        float lg[16];
#pragma unroll
        for (int e = 0; e < 16; ++e) lg[e] = 0.f;
#pragma unroll
        for (int j = 0; j < 4; ++j) { asm volatile("" ::: "memory");
            const f32x4 a1 = *(const LAS f32x4*)(A1 + b * 1024 + 4 * lane + 256 * j), a0 = *(const LAS f32x4*)(A0 + b * 1024 + 4 * lane + 256 * j);
            const f32x4 o = v[j] * rstd * a1 + a0; o8[64 * j] = (unsigned long long)pk2(o.x, o.y) | ((unsigned long long)pk2(o.z, o.w) << 32);
#pragma unroll
            for (int e = 0; e < 16; ++e) { const f32x4 w = *(const LAS f32x4*)(WR + e * 1024 + 4 * lane + 256 * j); lg[e] += (o.x * w.x + o.y * w.y) + (o.z * w.z + o.w * w.w); } }
        float w8[8], w4[4], w2[2], w1;
        { const bool up = lane & 32;
#pragma unroll
          for (int i = 0; i < 8; ++i) { const float snd = up ? lg[i] : lg[8 + i], kp = up ? lg[8 + i] : lg[i]; w8[i] = kp + __shfl_xor(snd, 32); } }
        { const bool up = lane & 16;
#pragma unroll
          for (int i = 0; i < 4; ++i) { const float snd = up ? w8[i] : w8[4 + i], kp = up ? w8[4 + i] : w8[i]; w4[i] = kp + __shfl_xor(snd, 16); } }
        { const bool up = lane & 8;
#pragma unroll
          for (int i = 0; i < 2; ++i) { const float snd = up ? w4[i] : w4[2 + i], kp = up ? w4[2 + i] : w4[i]; w2[i] = kp + __shfl_xor(snd, 8); } }
        { const bool up = lane & 4; const float snd = up ? w2[0] : w2[1], kp = up ? w2[1] : w2[0]; w1 = kp + __shfl_xor(snd, 4); }
        w1 += __shfl_xor(w1, 1); w1 += __shfl_xor(w1, 2);
        const int e = lane >> 2; const float logit = w1 + F.b_router[e];
        float mx = logit;
#pragma unroll
        for (int o = 4; o < 64; o <<= 1) mx = fmaxf(mx, __shfl_xor(mx, o));
        const float ex = __expf(logit - mx); float den = ex;
#pragma unroll
        for (int o = 4; o < 64; o <<= 1) den += __shfl_xor(den, o);
        if ((lane & 3) == 0) ((float*)(F.ws + WS_AFF))[((size_t)b * 16 + e) * S + s] = ex / den;
    }
    __syncthreads();
}
__device__ __forceinline__ void p5_topk(Frame& F) {
    if (F.vcu >= 32) { if (WD_IN_P5 && F.G > 32) wd_convert(F, 32); return; }
    const int be = F.vcu, b = be >> 4, e = be & 15, tid = F.wave * 64 + fresh_lane();
    LAS unsigned* vals = (LAS unsigned*)F.lds;
    LAS unsigned* hist = vals + 8192;
    LAS unsigned* suf = hist + 256;
    LAS unsigned* misc = suf + 264;
    LAS unsigned* wtot = misc + 8;
    const float* a = (const float*)(F.ws + WS_AFF) + (size_t)be * S;
    for (int i = tid; i < 8192; i += NTHREADS) vals[i] = __float_as_uint(a[i]);
    if (tid == 0) { misc[0] = 0u; misc[1] = 1024u; }
    __syncthreads();
    for (int pass = 0; pass < 4; ++pass) {
        const int sh = 24 - 8 * pass; const unsigned prefix = misc[0], k = misc[1]; const unsigned himask = pass == 0 ? 0u : (0xffffffffu << (sh + 8));
        if (tid < 256) hist[tid] = 0u;
        __syncthreads();
        {
            const unsigned cand = (vals[0] >> sh) & 255u; unsigned nc = 0u;
            for (int i = tid; i < 8192; i += NTHREADS) { const unsigned v = vals[i]; if ((v & himask) == prefix) { const unsigned bn = (v >> sh) & 255u; if (bn == cand) ++nc; else __hip_atomic_fetch_add(&hist[bn], 1u, __ATOMIC_RELAXED, __HIP_MEMORY_SCOPE_WORKGROUP); } }
#pragma unroll
            for (int o = 1; o < 64; o <<= 1) nc += __shfl_xor(nc, o);
            if ((tid & 63) == 0 && nc) __hip_atomic_fetch_add(&hist[cand], nc, __ATOMIC_RELAXED, __HIP_MEMORY_SCOPE_WORKGROUP);
        }
        __syncthreads();
        if (tid < 64) {
            const int l = tid; const unsigned h0 = hist[4 * l], h1 = hist[4 * l + 1], h2 = hist[4 * l + 2], h3 = hist[4 * l + 3];
            const unsigned tot = (h0 + h1) + (h2 + h3); unsigned inc = tot;
#pragma unroll
            for (int o = 1; o < 64; o <<= 1) { const unsigned t = __shfl_down(inc, o); if (l + o < 64) inc += t; }
            const unsigned above = inc - tot;
            const unsigned s3 = above + h3, s2 = s3 + h2, s1 = s2 + h1, s0 = s1 + h0;
            int bin = -1; unsigned gt = 0u;
            if (s3 >= k && above < k) { bin = 4 * l + 3; gt = above; } else if (s2 >= k && s3 < k) { bin = 4 * l + 2; gt = s3; } else if (s1 >= k && s2 < k) { bin = 4 * l + 1; gt = s2; } else if (s0 >= k && s1 < k) { bin = 4 * l; gt = s1; }
            if (bin >= 0) { misc[0] = prefix | ((unsigned)bin << sh); misc[1] = k - gt; }
        }
        __syncthreads();
    }
    const unsigned thr = misc[0], need = misc[1];
    unsigned gtc = 0, eqc = 0;
#pragma unroll
    for (int i = 0; i < 16; ++i) { const unsigned v = vals[tid * 16 + i]; gtc += v > thr; eqc += v == thr; }
    unsigned gi = gtc, ei = eqc; const int lane = fresh_lane(), wv = F.wave;
#pragma unroll
    for (int o = 1; o < 64; o <<= 1) { const unsigned g2 = __shfl_up(gi, o), e2 = __shfl_up(ei, o); if (lane >= o) { gi += g2; ei += e2; } }
    if (lane == 63) { wtot[wv] = gi; wtot[8 + wv] = ei; }
    __syncthreads();
    unsigned gbase = 0, ebase = 0, gtotal = 0;
    for (int w = 0; w < 8; ++w) { const unsigned g = wtot[w], q = wtot[8 + w]; if (w < wv) { gbase += g; ebase += q; } gtotal += g; }
    unsigned gpos = gbase + gi - gtc, epos = ebase + ei - eqc;
    int* IDX = (int*)(F.ws + WS_IDX) + (e * 2 + b) * 1024; float* GATE = (float*)(F.ws + WS_GATE) + (e * 2 + b) * 1024; int* SLOT = (int*)(F.ws + WS_SLOT);
#pragma unroll
    for (int i = 0; i < 16; ++i) { const int s = tid * 16 + i; const unsigned v = vals[s]; int c = -1;
        if (v > thr) c = (int)gpos++; else if (v == thr) { if (epos < need) c = (int)(gtotal + epos); ++epos; }
        if (c >= 0) { IDX[c] = b * S + s; GATE[c] = __uint_as_float(v); }
        SLOT[(size_t)(b * S + s) * 16 + e] = c >= 0 ? (e * 2 + b) * 1024 + c : -1; }
}
struct SchedP6a {
    __device__ __forceinline__ void a_ready(const gm::Unit&, int, int) const {}
    __device__ __forceinline__ void done(const gm::Unit&, int) const {}
    __device__ __forceinline__ void stamp(int, const gm::Unit&, int, int) const {}
    static constexpr bool GATHER = true;
    const char* A; const char* W; const int* idx; int G, vcu;
    __device__ __forceinline__ bool next(int i, gm::Unit& u) const {
        int e, pmu, pn;
        if (G == 256) { if (i >= 4) return false; const int xcd = vcu >> 5, j = vcu & 31; e = xcd + 8 * (i >> 1); const int sub = (i & 1) * 32 + j; pmu = sub >> 3; pn = sub & 7; }
        else { const int L = i * G + vcu; if (L >= 1024) return false; e = L >> 6; pmu = (L >> 3) & 7; pn = L & 7; }
        u.A = A; u.gidx = idx + e * 2048 + pmu * 256; u.lda2 = 2048; u.arow0 = 0; u.Bt = W + (size_t)e * 2048 * 2048; u.brow0 = pn * 256; u.ldb2 = 2048; u.nt = 16; u.pm = e * 8 + pmu; u.pn = pn; u.aux = e; return true; }
};
struct EpiP6a {
    static constexpr bool PERM = true;
    bf16_t* H;
    __device__ __forceinline__ void operator()(EPI_ARGS) const {
#pragma unroll
        for (int ai = 0; ai < 2; ++ai)
#pragma unroll
            for (int m = 0; m < 4; ++m) { const size_t row = (size_t)u.pm * 256 + ai * 128 + wr * 64 + m * 16 + fr;
                f32x4 h0, h1;
#pragma unroll
                for (int j = 0; j < 4; ++j) { h0[j] = siluf(acc[ai][0][m][0][j]) * acc[ai][1][m][0][j]; h1[j] = siluf(acc[ai][0][m][1][j]) * acc[ai][1][m][1][j]; }
                *(u32x4*)(H + row * 1024 + u.pn * 128 + wc * 32 + 8 * fq) = pack8(h0, h1); }
    }
};
struct SchedP6b {
    __device__ __forceinline__ void a_ready(const gm::Unit&, int, int) const {}
    __device__ __forceinline__ void done(const gm::Unit&, int) const {}
    __device__ __forceinline__ void stamp(int, const gm::Unit&, int, int) const {}
    static constexpr bool GATHER = false;
    const char* A; const char* W; int G, vcu;
    __device__ __forceinline__ bool next(int i, gm::Unit& u) const {
        int e, pmu, pn;
        if (G == 256) { if (i >= 2) return false; const int xcd = vcu >> 5, j = vcu & 31; e = xcd + 8 * i; pmu = j >> 2; pn = j & 3; }
        else { const int L = i * G + vcu; if (L >= 512) return false; e = L >> 5; pmu = (L >> 2) & 7; pn = L & 3; }
        u.A = A; u.gidx = nullptr; u.lda2 = 2048; u.arow0 = (e * 8 + pmu) * 256; u.Bt = W + (size_t)e * 1024 * 2048; u.brow0 = pn * 256; u.ldb2 = 2048; u.nt = 16; u.pm = e * 8 + pmu; u.pn = pn; u.aux = e; return true; }
};
struct EpiP6b {
    static constexpr bool PERM = true;
    bf16_t* Y; const float* gate;
    __device__ __forceinline__ void operator()(EPI_ARGS) const {
#pragma unroll
        for (int ai = 0; ai < 2; ++ai)
#pragma unroll
            for (int m = 0; m < 4; ++m) { const size_t row = (size_t)u.pm * 256 + ai * 128 + wr * 64 + m * 16 + fr; const float g = gate[row];
#pragma unroll
                for (int bj = 0; bj < 2; ++bj) *(u32x4*)(Y + row * 1024 + u.pn * 256 + bj * 128 + wc * 32 + 8 * fq) = pack8(acc[ai][bj][m][0] * g, acc[ai][bj][m][1] * g); }
    }
};
__device__ __forceinline__ void p7_final(Frame& F) {
    const float* modf = (const float*)(F.ws + WS_MODF); const int* SLOT = (const int*)(F.ws + WS_SLOT); const bf16_t* Y = (const bf16_t*)(F.ws + WS_Y);
    const int gw = F.vcu * NWAVES + F.wave, NGW = F.G * NWAVES, lane = fresh_lane();
    for (int m0 = gw; m0 < T; m0 += 2 * NGW) {
        const int m1 = m0 + NGW; const bool has1 = m1 < T; const int mm1 = has1 ? m1 : m0;
        f32x4* xr0 = (f32x4*)(F.out + (size_t)m0 * D) + lane; f32x4* xr1 = (f32x4*)(F.out + (size_t)mm1 * D) + lane; f32x4 v0[4], v1[4], a0[4], a1[4];
#pragma unroll
        for (int j = 0; j < 4; ++j) { v0[j] = xr0[64 * j]; v1[j] = xr1[64 * j]; a0[j] = (f32x4){0.f, 0.f, 0.f, 0.f}; a1[j] = (f32x4){0.f, 0.f, 0.f, 0.f}; }
        const int sl0 = lane < 16 ? SLOT[(size_t)m0 * 16 + lane] : -1, sl1 = lane < 16 ? SLOT[(size_t)mm1 * 16 + lane] : -1;
        for (int e = 0; e < 16; ++e) { const int s0 = __shfl(sl0, e), s1 = __shfl(sl1, e);
            if (s0 >= 0) { const u32x2* yr = (const u32x2*)(Y + (size_t)s0 * 1024) + lane;
#pragma unroll
                for (int j = 0; j < 4; ++j) { const u32x2 w = yr[64 * j]; a0[j].x += __uint_as_float(w.x << 16); a0[j].y += __uint_as_float(w.x & 0xffff0000u); a0[j].z += __uint_as_float(w.y << 16); a0[j].w += __uint_as_float(w.y & 0xffff0000u); } }
            if (s1 >= 0) { const u32x2* yr = (const u32x2*)(Y + (size_t)s1 * 1024) + lane;
#pragma unroll
                for (int j = 0; j < 4; ++j) { const u32x2 w = yr[64 * j]; a1[j].x += __uint_as_float(w.x << 16); a1[j].y += __uint_as_float(w.x & 0xffff0000u); a1[j].z += __uint_as_float(w.y << 16); a1[j].w += __uint_as_float(w.y & 0xffff0000u); } } }
        float ss0 = 0.f, ss1 = 0.f; const int b0 = m0 >> 13, b1 = mm1 >> 13;
#pragma unroll
        for (int j = 0; j < 4; ++j) { const f32x4 g0 = *(const f32x4*)(modf + b0 * 6144 + 5120 + 4 * lane + 256 * j), g1 = *(const f32x4*)(modf + b1 * 6144 + 5120 + 4 * lane + 256 * j);
            v0[j] = v0[j] + g0 * a0[j]; v1[j] = v1[j] + g1 * a1[j];
            ss0 += (v0[j].x * v0[j].x + v0[j].y * v0[j].y) + (v0[j].z * v0[j].z + v0[j].w * v0[j].w); ss1 += (v1[j].x * v1[j].x + v1[j].y * v1[j].y) + (v1[j].z * v1[j].z + v1[j].w * v1[j].w); }
        const float r0 = rsqrtf(wave_sum(ss0) * (1.f / D) + EPS), r1 = rsqrtf(wave_sum(ss1) * (1.f / D) + EPS);
#pragma unroll
        for (int j = 0; j < 4; ++j) { const f32x4 g = *(const f32x4*)(F.g_final + 4 * lane + 256 * j); xr0[64 * j] = v0[j] * r0 * g; if (has1) xr1[64 * j] = v1[j] * r1 * g; }
    }
}
}
#ifndef MLA_STAG
#define MLA_STAG mla_unit_v7
#endif
#ifndef MLA_V4
#define MLA_V4 1
#endif
#ifndef MERGE_P12
#define MERGE_P12 1
#endif
#ifndef DIL_PIPE
#define DIL_PIPE 1
#endif
#ifndef MLA_UNIT
#define MLA_UNIT mla_unit_v2
#endif
namespace mk {
namespace cg = cooperative_groups;
__global__ void __launch_bounds__(NTHREADS, 2) mega(Args args) {
    extern __shared__ __attribute__((aligned(16))) unsigned char lds_raw[];
    cg::grid_group grid = cg::this_grid();
    Frame F;
    F.lds = (LAS unsigned char*)lds_raw; F.ws = args.ws; F.out = args.out;
    F.wave = __builtin_amdgcn_readfirstlane((int)(threadIdx.x >> 6));
    F.G = gridDim.x; { const int bx = blockIdx.x; F.vcu = (F.G % 8 == 0) ? (bx % 8) * (F.G / 8) + bx / 8 : bx; }
    F.x = (const float*)args.in[0]; F.c = (const float*)args.in[1]; F.pos = (const int*)args.in[2]; F.w_ada = (const float*)args.in[3]; F.b_ada = (const float*)args.in[4];
    F.g_mix = (const float*)args.in[5]; F.w_in = (const float*)args.in[6]; F.g_q = (const float*)args.in[7]; F.w_uq = (const float*)args.in[8]; F.g_kv = (const float*)args.in[9];
    F.w_ukv = (const float*)args.in[10]; F.w_out = (const float*)args.in[11]; F.g_ffn = (const float*)args.in[12]; F.w_router = (const float*)args.in[13]; F.b_router = (const float*)args.in[14];
    F.w_gate = (const float*)args.in[15]; F.w_up = (const float*)args.in[16]; F.w_down = (const float*)args.in[17]; F.g_final = (const float*)args.in[18];
    const int lo = args.ph_lo, hi = args.ph_hi;
    volatile LAS unsigned* MISC = (volatile LAS unsigned*)(F.lds + LDS_BYTES - 256);
    { const int l0 = fresh_lane(); if (F.wave == 0) MISC[l0] = 0u; }
    __syncthreads();
    XcdBarrier xbar = xcd_barrier_post((unsigned*)(F.ws + WS_CTL) + 1024 + args.li * 4096, MISC + 8, F.wave == 0 && fresh_lane() == 0);
#define IN(k) (lo <= (k) && (k) < hi)
#ifndef CG_SEAMS
#define CG_SEAMS 0x000
#endif
#define SEAM(k) do { if (IN(k) && IN((k) + 1)) { if ((CG_SEAMS >> (k)) & 1) grid.sync(); else xcd_barrier(xbar, F.wave == 0 && fresh_lane() == 0); } } while (0)
    if (IN(0)) { p0_prologue(F); } SEAM(0);
    if (IN(1)) { p0b_rows(F); } SEAM(1);
#if MERGE_P12
    if (IN(2)) {
#if P12_STAMP
        if (F.wave == 0 && fresh_lane() == 0) { unsigned long long* ts = (unsigned long long*)(F.ws + 128 * KiB) + (size_t)blockIdx.x * 8; ts[0] = __builtin_amdgcn_s_memrealtime(); ts[7] = 0; }
#endif
        SchedP12 S{(const char*)(F.ws + WS_HB), (const char*)(F.ws + WS_WIN), (const char*)(F.ws + WS_CQ), (const char*)(F.ws + WS_WUQ), (const char*)(F.ws + WS_WUKV), (unsigned*)(F.ws + WS_PCNT), F.G, F.vcu, (int)blockIdx.x};
        EpiP12 E{F.ws}; gm::gemm_phase<EpiP12, SchedP12>(F.lds, S, E, F.wave); } SEAM(3);
#else
    if (IN(2)) { SchedP1 S{(const char*)(F.ws + WS_HB), (const char*)(F.ws + WS_WIN), F.G, (int)blockIdx.x}; EpiP1 E{F.ws}; gm::gemm_phase<EpiP1, SchedP1>(F.lds, S, E, F.wave); } SEAM(2);
    if (IN(3)) { SchedP2 S{(const char*)(F.ws + WS_CQ), (const char*)(F.ws + WS_WUQ), (const char*)(F.ws + WS_WUKV), F.G, (int)blockIdx.x}; EpiP2 E{F.ws}; gm::gemm_phase<EpiP2, SchedP2>(F.lds, S, E, F.wave); } SEAM(3);
#endif
    if (IN(4)) {
        const unsigned short* DQ = (const unsigned short*)(F.ws + WS_DQ); const unsigned short* DK = (const unsigned short*)(F.ws + WS_DK); const unsigned short* DV = (const unsigned short*)(F.ws + WS_DV);
        unsigned short* OBR = (unsigned short*)F.out; float* LSE = (float*)(F.ws + WS_LSE);
        if (args.pad & 1) { if (DIL_PIPE) at::dil_phase(F.wave, F.vcu, F.G, 1536, DQ, DK, DV, OBR, LSE, (char*)lds_raw); else for (int u = F.vcu; u < 1536; u += F.G) { const int blk = u & 31, br = (u >> 5) % 3, bh = u / 96; at::dil_unit(F.wave, bh, br, blk, DQ, DK, DV, OBR, LSE, (char*)lds_raw); } }
        if (args.pad & 2) for (int u = F.vcu; u < 512; u += F.G) { const int bh = (u >> 8) * 8 + ((u & 255) >> 5), qb = u & 31;
            #if MLA_V4
            at::MLA_STAG(F.wave, bh, qb, (const unsigned short*)(F.ws + WS_Q), (const unsigned short*)(F.ws + WS_KN), (const unsigned short*)(F.ws + WS_KR), (const unsigned short*)(F.ws + WS_V), (unsigned short*)(F.ws + WS_HB), (const float*)(F.ws + WS_KMX), (char*)lds_raw, (u == F.vcu) ? (unsigned long long*)(F.ws + WS_CTL + 60 * 1024) : nullptr); }
#else
            at::mla_unit_v2(F.wave, bh, qb, (const unsigned short*)(F.ws + WS_Q), (const unsigned short*)(F.ws + WS_KN), (const unsigned short*)(F.ws + WS_KR), (const unsigned short*)(F.ws + WS_V), (unsigned short*)(F.ws + WS_HB), (const float*)(F.ws + WS_KMX), (char*)lds_raw, (u == F.vcu) ? (unsigned long long*)(F.ws + WS_CTL + 60 * 1024) : nullptr); }
#endif
    } SEAM(4);
    if (IN(5)) { at::dil_combine((const unsigned short*)F.out, (const float*)(F.ws + WS_LSE), (unsigned short*)(F.ws + WS_HB), F.vcu * NTHREADS + F.wave * 64 + fresh_lane(), F.G * NTHREADS); } SEAM(5);
    if (IN(6)) { SchedP4 S{(const char*)(F.ws + WS_HB), (const char*)(F.ws + WS_WOUT), F.G, (int)blockIdx.x}; EpiP4 E{F.x, F.out, (const float*)(F.ws + WS_MODF)}; gm::gemm_phase<EpiP4, SchedP4>(F.lds, S, E, F.wave); } SEAM(6);
    if (IN(7)) { p4b_rows(F); } SEAM(7);
    if (IN(8)) { p5_topk(F); } SEAM(8);
    if (IN(9)) { SchedP6a S{(const char*)(F.ws + WS_HB), (const char*)(F.ws + WS_WGU), (const int*)(F.ws + WS_IDX), F.G, F.vcu}; EpiP6a E{(bf16_t*)(F.ws + WS_HBUF)}; gm::gemm_phase<EpiP6a, SchedP6a>(F.lds, S, E, F.wave); } SEAM(9);
    if (IN(10)) { SchedP6b S{(const char*)(F.ws + WS_HBUF), (const char*)(F.ws + WS_WD), F.G, F.vcu}; EpiP6b E{(bf16_t*)(F.ws + WS_Y), (const float*)(F.ws + WS_GATE)}; gm::gemm_phase<EpiP6b, SchedP6b>(F.lds, S, E, F.wave); } SEAM(10);
    if (IN(11)) { p7_final(F); }
#undef IN
#undef SEAM
}
}
extern "C" void kernel_launch(void* const* d_in, const int* in_sizes, int n_in, void* d_out, int out_size, void* d_ws, size_t ws_size, hipStream_t stream) {
    using namespace mk;
    static int grid = 0;
    if (grid == 0) {
        if (n_in != 19 || out_size != T * D || in_sizes[0] != T * D || ws_size < WS_END) { fprintf(stderr, "kernel_launch: built for 19 inputs, x/out of %d floats and >= %zu bytes of workspace; got n_in %d out %d ws %zu; nothing launched\n", T * D, (size_t)WS_END, n_in, out_size, ws_size); grid = -1; return; }
        int dev = 0, cus = 0, per_cu = 0;
        if (hipGetDevice(&dev) != hipSuccess || hipDeviceGetAttribute(&cus, hipDeviceAttributeMultiprocessorCount, dev) != hipSuccess || cus < 32) { fprintf(stderr, "kernel_launch: device query failed\n"); grid = -1; return; }
        if (hipFuncSetAttribute((const void*)mega, hipFuncAttributeMaxDynamicSharedMemorySize, LDS_BYTES) != hipSuccess) { fprintf(stderr, "kernel_launch: hipFuncSetAttribute(%d B LDS) failed\n", LDS_BYTES); grid = -1; return; }
        if (hipOccupancyMaxActiveBlocksPerMultiprocessor(&per_cu, (const void*)mega, NTHREADS, LDS_BYTES) != hipSuccess || per_cu < 1) { fprintf(stderr, "kernel_launch: occupancy query reports %d workgroups per CU\n", per_cu); grid = -1; return; }
        grid = cus;
    }
    if (grid < 0) return;
    if (hipMemsetAsync((char*)d_ws + WS_CTL, 0, 64 * KiB, stream) != hipSuccess) { fprintf(stderr, "kernel_launch: memset failed\n"); return; }
    Args a{}; for (int i = 0; i < 19; ++i) a.in[i] = d_in[i]; a.out = (float*)d_out; a.ws = (unsigned char*)d_ws;
    a.pad = 3; a.ph_lo = 0; a.ph_hi = 12; a.li = 0;
    void* kargs[] = {&a};
    const hipError_t e = hipLaunchCooperativeKernel((const void*)mega, dim3(grid), dim3(NTHREADS), kargs, LDS_BYTES, stream);
    if (e != hipSuccess) fprintf(stderr, "kernel_launch: cooperative launch failed: %s (grid %d)\n", hipGetErrorString(e), grid);
}
```

```cpp
#include <hip/hip_runtime.h>
#include <hip/hip_cooperative_groups.h>
#include <hip/hip_bf16.h>
#include <cstdio>
#include <cstdint>
#include <cmath>
namespace gm {
#define LAS __attribute__((address_space(3)))
typedef unsigned short bf16_t;
typedef short bf16x8 __attribute__((ext_vector_type(8)));
typedef float f32x4 __attribute__((ext_vector_type(4)));
typedef float f32x2 __attribute__((ext_vector_type(2)));
typedef unsigned u32x4 __attribute__((ext_vector_type(4)));
typedef unsigned u32x2 __attribute__((ext_vector_type(2)));
constexpr int BM = 256, BK = 64, HALF = 128, HTB = HALF * BK * 2, STAGE_BYTES = 8 * HTB;

__device__ __forceinline__ int lds_byte(int r, int c) { const int st = (r >> 4) * 2 + (c >> 5), rr = r & 15, cc = c & 31, ob = rr * 64 + cc * 2; return st * 1024 + (ob ^ (((ob >> 9) & 1) << 5)); }
__device__ __forceinline__ void stage_rc(int b, int& R, int& C) { const int st = b / 1024, sb = b % 1024, swz = sb ^ (((sb >> 9) & 1) << 5); R = (st >> 1) * 16 + swz / 64; C = (st & 1) * 32 + (swz % 64) / 2; }
__device__ __forceinline__ int perm32(int rho) { const int n = rho >> 4, i = rho & 15; return 8 * (i >> 2) + 4 * n + (i & 3); }
__device__ __forceinline__ int lane_now() { int l; asm volatile("v_mbcnt_lo_u32_b32 %0, -1, 0\n\tv_mbcnt_hi_u32_b32 %0, -1, %0" : "=v"(l)); return l; }
__device__ __forceinline__ unsigned cvt_pk_bf16(float lo, float hi) { unsigned r; asm volatile("v_cvt_pk_bf16_f32 %0, %1, %2" : "=v"(r) : "v"(lo), "v"(hi)); return r; }

struct Unit {
    const char* A; const char* Bt; const int* gidx;
    unsigned lda2, ldb2;
    int arow0, brow0, nt;
    int pm, pn, aux;
};

template <class Epi, class Sched>
__device__ __forceinline__ void gemm_phase(LAS unsigned char* lds, const Sched& S, const Epi& E, int wave_sgpr) {
    constexpr bool GATHER = Sched::GATHER;
    const int wid = wave_sgpr, lane = lane_now(), tid = wid * 64 + lane, wr = wid >> 2, wc = wid & 3, fr = lane & 15, fq = lane >> 4;
    int sR[2], sC[2], sRb[2];
#pragma unroll
    for (int i = 0; i < 2; ++i) { int R, C; stage_rc(tid * 16 + i * 8192, R, C); sR[i] = R; sC[i] = C * 2; sRb[i] = Epi::PERM ? ((R & ~31) + perm32(R & 31)) : R; }
    const unsigned ldsw = (unsigned)wid * 1024u;
    const int aoff = lds_byte(wr * 64 + fr, fq * 8), boff = lds_byte(wc * 32 + fr, fq * 8);
#define GM_SA(b, h) (((b) * 2 + (h)) * HTB)
#define GM_SB(b, h) ((4 + (b) * 2 + (h)) * HTB)
#define GM_GLDS(src, dstoff) __builtin_amdgcn_global_load_lds((const unsigned*)(src), (LAS unsigned*)(lds + (dstoff)), 16, 0, 0)
#define GM_STAGE_B(bufoff, p, ld, h) do { _Pragma("unroll") for (int i_ = 0; i_ < 2; ++i_) \
        GM_GLDS((p) + ((unsigned)((h) * HALF + sRb[i_]) * (ld) + (unsigned)sC[i_]), (bufoff) + ldsw + i_ * 8192); } while (0)
#define GM_STAGE_A(bufoff, p, ld, h, g) do { _Pragma("unroll") for (int i_ = 0; i_ < 2; ++i_) { \
        const unsigned o_ = GATHER ? (g)[h][i_] + (unsigned)sC[i_] : (unsigned)((h) * HALF + sR[i_]) * (ld) + (unsigned)sC[i_]; \
        GM_GLDS((p) + o_, (bufoff) + ldsw + i_ * 8192); } } while (0)
#define GM_LDA(dst, b, h) do { _Pragma("unroll") for (int m = 0; m < 4; ++m) _Pragma("unroll") for (int k = 0; k < 2; ++k) dst[m][k] = *(const LAS bf16x8*)(lds + GM_SA(b, h) + aoff + m * 2048 + k * 1024); } while (0)
#define GM_LDB(dst, b, h) do { _Pragma("unroll") for (int n = 0; n < 2; ++n) _Pragma("unroll") for (int k = 0; k < 2; ++k) dst[n][k] = *(const LAS bf16x8*)(lds + GM_SB(b, h) + boff + n * 2048 + k * 1024); } while (0)
#define GM_MMA(ai, bj, At, Bt) do { __builtin_amdgcn_s_setprio(1); _Pragma("unroll") for (int m = 0; m < 4; ++m) _Pragma("unroll") for (int n = 0; n < 2; ++n) _Pragma("unroll") for (int k = 0; k < 2; ++k) \
        acc[ai][bj][m][n] = __builtin_amdgcn_mfma_f32_16x16x32_bf16(Bt[n][k], At[m][k], acc[ai][bj][m][n], 0, 0, 0); __builtin_amdgcn_s_setprio(0); } while (0)
#define GM_WAIT_V(n) asm volatile("s_waitcnt vmcnt(" #n ")" ::: "memory")
#define GM_WAIT_L(n) asm volatile("s_waitcnt lgkmcnt(" #n ")" ::: "memory")
#define GM_BAR __builtin_amdgcn_s_barrier()
#define GM_SCHED __builtin_amdgcn_sched_barrier(0)
#define GM_GOFFS(u, g) do { if (GATHER) { _Pragma("unroll") for (int h_ = 0; h_ < 2; ++h_) _Pragma("unroll") for (int i_ = 0; i_ < 2; ++i_) g[h_][i_] = (unsigned)(u).gidx[h_ * HALF + sR[i_]] * (u).lda2; } } while (0)
#define GM_ABASE(u) ((u).A + (GATHER ? (size_t)0 : (size_t)(u).arow0 * (u).lda2))
#define GM_BBASE(u) ((u).Bt + (size_t)(u).brow0 * (u).ldb2)
    Unit cur, nxt; int ui = 0;
    if (!S.next(0, cur)) return;
    f32x4 acc[2][2][4][2];
#pragma unroll
    for (int a = 0; a < 2; ++a)
#pragma unroll
        for (int b = 0; b < 2; ++b)
#pragma unroll
            for (int m = 0; m < 4; ++m)
#pragma unroll
                for (int n = 0; n < 2; ++n) acc[a][b][m][n] = (f32x4){0.f, 0.f, 0.f, 0.f};
    bf16x8 At[4][2], B0[2][2], B1[2][2];
    unsigned gc[2][2] = {{0u, 0u}, {0u, 0u}}, gn[2][2] = {{0u, 0u}, {0u, 0u}};
    GM_GOFFS(cur, gc);
    const char* cA = GM_ABASE(cur); const char* cB = GM_BBASE(cur); unsigned cla = cur.lda2, clb = cur.ldb2;
    GM_STAGE_B(GM_SB(0, 0), cB, clb, 0); GM_STAGE_B(GM_SB(0, 1), cB, clb, 1); GM_STAGE_A(GM_SA(0, 0), cA, cla, 0, gc); GM_STAGE_A(GM_SA(0, 1), cA, cla, 1, gc);
    if (wr == 1) GM_BAR;
    GM_WAIT_V(2); GM_BAR;
    GM_STAGE_B(GM_SB(1, 0), cB + 128, clb, 0); GM_STAGE_A(GM_SA(1, 0), cA + 128, cla, 0, gc); GM_STAGE_B(GM_SB(1, 1), cB + 128, clb, 1);
    GM_WAIT_V(6); GM_BAR;
    for (;;) {
        const bool has_next = S.next(ui + 1, nxt);
        const char* nA = cA; const char* nB = cB; unsigned nla = cla, nlb = clb;
        if (has_next) { GM_GOFFS(nxt, gn); nA = GM_ABASE(nxt); nB = GM_BBASE(nxt); nla = nxt.lda2; nlb = nxt.ldb2; }
        else if (GATHER) {
#pragma unroll
            for (int h = 0; h < 2; ++h)
#pragma unroll
                for (int i = 0; i < 2; ++i) gn[h][i] = gc[h][i];
        }
        const int nt = cur.nt;
        for (int t = 0; t < nt; t += 2) {
            const bool last = (t == nt - 2);
            if (last && has_next) S.a_ready(nxt, wid, ui + 1);
            const char* a1 = cA + (size_t)(t + 1) * 128;
            const char* a2 = last ? nA : cA + (size_t)(t + 2) * 128; const char* b2 = last ? nB : cB + (size_t)(t + 2) * 128;
            const char* a3 = a2 + 128; const char* b3 = b2 + 128;
            const unsigned la2 = last ? nla : cla, lb2 = last ? nlb : clb;
            unsigned g2[2][2];
#pragma unroll
            for (int h = 0; h < 2; ++h)
#pragma unroll
                for (int i = 0; i < 2; ++i) g2[h][i] = GATHER ? (last ? gn[h][i] : gc[h][i]) : 0u;
            GM_LDB(B0, 0, 0); GM_LDB(B1, 0, 1); GM_SCHED; GM_LDA(At, 0, 0); GM_STAGE_A(GM_SA(1, 1), a1, cla, 1, gc);
            GM_WAIT_V(8); GM_WAIT_L(0); GM_BAR; GM_MMA(0, 0, At, B0); GM_MMA(0, 1, At, B1); GM_BAR; GM_SCHED;
            GM_LDA(At, 0, 1); GM_STAGE_B(GM_SB(0, 0), b2, lb2, 0); GM_STAGE_B(GM_SB(0, 1), b2, lb2, 1); GM_STAGE_A(GM_SA(0, 0), a2, la2, 0, g2);
            GM_WAIT_V(8); GM_WAIT_L(0); GM_BAR; GM_MMA(1, 0, At, B0); GM_MMA(1, 1, At, B1); GM_BAR; GM_SCHED;
            GM_LDB(B0, 1, 0); GM_LDB(B1, 1, 1); GM_SCHED; GM_LDA(At, 1, 0); GM_STAGE_A(GM_SA(0, 1), a2, la2, 1, g2);
            GM_WAIT_V(8); GM_WAIT_L(0); GM_BAR; GM_MMA(0, 0, At, B0); GM_MMA(0, 1, At, B1); GM_BAR; GM_SCHED;
            GM_LDA(At, 1, 1); GM_STAGE_B(GM_SB(1, 0), b3, lb2, 0); GM_STAGE_B(GM_SB(1, 1), b3, lb2, 1); GM_STAGE_A(GM_SA(1, 0), a3, la2, 0, g2);
            GM_WAIT_V(8); GM_WAIT_L(0); GM_BAR; GM_MMA(1, 0, At, B0); GM_MMA(1, 1, At, B1); GM_BAR; GM_SCHED;
        }
        if (wr == 0) GM_BAR;
        E(acc, cur, wr, wc, fr, fq, lane);
        S.done(cur, lane);
        S.stamp(ui, cur, wid, lane);
        if (!has_next) break;
#pragma unroll
        for (int a = 0; a < 2; ++a)
#pragma unroll
            for (int b = 0; b < 2; ++b)
#pragma unroll
                for (int m = 0; m < 4; ++m)
#pragma unroll
                    for (int n = 0; n < 2; ++n) acc[a][b][m][n] = (f32x4){0.f, 0.f, 0.f, 0.f};
        cur = nxt; cA = nA; cB = nB; cla = nla; clb = nlb; ++ui;
        if (GATHER) {
#pragma unroll
            for (int h = 0; h < 2; ++h)
#pragma unroll
                for (int i = 0; i < 2; ++i) gc[h][i] = gn[h][i];
        }
        if (wr == 1) GM_BAR;
    }
    GM_WAIT_V(0);
    GM_BAR;
#undef GM_SA
#undef GM_SB
#undef GM_GLDS
#undef GM_STAGE_A
#undef GM_STAGE_B
#undef GM_LDA
#undef GM_LDB
#undef GM_MMA
#undef GM_WAIT_V
#undef GM_WAIT_L
#undef GM_BAR
#undef GM_SCHED
#undef GM_GOFFS
#undef GM_ABASE
#undef GM_BBASE
}
}
namespace mk {
using gm::bf16_t; using gm::f32x4; using gm::f32x2; using gm::u32x4; using gm::u32x2; using gm::cvt_pk_bf16;
constexpr int T = 16384, S = 8192, D = 1024, NB = 2, NH = 8, NWAVES = 8, NTHREADS = 512;
constexpr float EPS = 1e-6f;
constexpr size_t KiB = 1024, MiB = 1u << 20;
constexpr size_t WS_CTL = 0;
constexpr size_t WS_KMX = 48 * KiB;
constexpr size_t WS_MODP = 1 * MiB;
constexpr size_t WS_MODF = 2 * MiB;
constexpr size_t WS_TABM = WS_MODF + 64 * KiB;
constexpr size_t WS_TABD = WS_TABM + 2 * MiB;
constexpr size_t WS_SSQ = WS_TABD + 1 * MiB;
constexpr size_t WS_KR = WS_SSQ + 1536 * KiB;
constexpr size_t WS_AFF = WS_KR + 1 * MiB;
constexpr size_t WS_IDX = WS_AFF + 1 * MiB;
constexpr size_t WS_GATE = WS_IDX + 128 * KiB;
constexpr size_t WS_SLOT = WS_GATE + 128 * KiB;
constexpr size_t WS_LSE = WS_SLOT + 1 * MiB;
constexpr size_t WS_WUQ = WS_LSE + 1536 * KiB;
constexpr size_t WS_WUKV = WS_WUQ + 576 * KiB;
constexpr size_t WS_WOUT = WS_WUKV + 512 * KiB;
constexpr size_t WS_WIN = WS_WOUT + 2 * MiB;
constexpr size_t WS_R0END = WS_WIN + 4608 * KiB;
static_assert(WS_R0END <= 20 * MiB, "R0");
constexpr size_t WS_HB = 20 * MiB;
constexpr size_t WS_CQ = 52 * MiB;
constexpr size_t WS_DQ = WS_CQ + 24 * MiB, WS_DK = WS_DQ + 16 * MiB, WS_DV = WS_DK + 16 * MiB;
constexpr size_t WS_Q = WS_DV + 16 * MiB;
constexpr size_t WS_KN = WS_Q + 24 * MiB, WS_V = WS_KN + 16 * MiB;
constexpr size_t WS_HBUF = WS_CQ;
constexpr size_t WS_WGU = 180 * MiB;
constexpr size_t WS_Y = WS_WGU;
constexpr size_t WS_WD = 244 * MiB;
constexpr size_t WS_END = 276 * MiB;
static_assert(WS_V + 16 * MiB == 180 * MiB, "arena");
constexpr int LDS_BYTES = 147456;

__device__ __forceinline__ float wave_sum(float v) {
#pragma unroll
    for (int o = 1; o < 64; o <<= 1) v += __shfl_xor(v, o);
    return v;
}
__device__ __forceinline__ unsigned f2bf(float f) { unsigned u = __builtin_bit_cast(unsigned, f); return (u + 0x7fffu + ((u >> 16) & 1u)) >> 16; }
__device__ __forceinline__ unsigned pk2(float lo, float hi) { return f2bf(lo) | (f2bf(hi) << 16); }
__device__ __forceinline__ float bf2f(unsigned short b) { return __builtin_bit_cast(float, (unsigned)b << 16); }
__device__ __forceinline__ float siluf(float v) { return v / (1.f + __expf(-v)); }
#define LDS_WAIT() asm volatile("s_waitcnt lgkmcnt(0)" ::: "memory")
__device__ __forceinline__ int fresh_lane() { return gm::lane_now(); }

struct Args { const void* in[19]; float* out; unsigned char* ws; int ph_lo, ph_hi, li, pad; };
struct Frame {
    LAS unsigned char* lds; unsigned char* ws; float* out;
    int wave, vcu, G;
    const float *x, *c; const int* pos; const float *w_ada, *b_ada, *g_mix, *w_in, *g_q, *w_uq, *g_kv, *w_ukv, *w_out, *g_ffn, *w_router, *b_router, *w_gate, *w_up, *w_down, *g_final;
};

__device__ __forceinline__ float inv_freq_m(int i) { return (float)exp2(-(double)i * (18.931568569324174 / 16.0)); }
__device__ __forceinline__ float inv_freq_d(int i) { return (float)exp2(-(double)i * (18.931568569324174 / 8.0)); }

#ifndef WD_IN_P5
#define WD_IN_P5 1
#endif
__device__ __forceinline__ void p0_transpose_item(const float* W, int ldw, int K, int k0, int n0, bf16_t* WT, int drow, const float* kscale, LAS float* scr, int lane) {
    f32x4 v[8];
#pragma unroll
    for (int i = 0; i < 8; ++i) v[i] = *(const f32x4*)(W + (size_t)(k0 + 8 * i + (lane >> 3)) * ldw + n0 + 4 * (lane & 7));
#pragma unroll
    for (int i = 0; i < 8; ++i) { const int kk = 8 * i + (lane >> 3); f32x4 x = v[i]; if (kscale) x = x * kscale[k0 + kk]; LAS float* d = scr + kk * 33 + 4 * (lane & 7); d[0] = x.x; d[1] = x.y; d[2] = x.z; d[3] = x.w; }
    LDS_WAIT(); asm volatile("" ::: "memory");
    const int c = lane & 7;
#pragma unroll
    for (int j = 0; j < 4; ++j) { const int n = (lane >> 3) + 8 * j; const LAS float* s = scr + (8 * c) * 33 + n;
        u32x4 o; o.x = pk2(s[0 * 33], s[1 * 33]); o.y = pk2(s[2 * 33], s[3 * 33]); o.z = pk2(s[4 * 33], s[5 * 33]); o.w = pk2(s[6 * 33], s[7 * 33]);
        *(u32x4*)(WT + (size_t)(drow + n) * K + k0 + 8 * c) = o; }
    LDS_WAIT(); asm volatile("" ::: "memory");
}
__device__ __forceinline__ void p0_prologue(Frame& F) {
    LAS float* scr = (LAS float*)(F.lds + F.wave * 16384);
    const int gw = F.vcu * NWAVES + F.wave, NGW = F.G * NWAVES, lane = fresh_lane();
    unsigned char* ws = F.ws;
    constexpr int I_MOD = 24 * 16, I_IN = 16 * 69, I_UQ = 6 * 24, I_UKV = 4 * 32, I_OUT = 16 * 32, I_EXP = 16 * 16 * 32, I_PAD = 96, I_TAB = T * 24 / 64;
    constexpr int NITEMS = I_MOD + I_IN + I_UQ + I_UKV + I_OUT + (WD_IN_P5 ? 2 : 3) * I_EXP + I_PAD + I_TAB;
    for (int it = gw; it < NITEMS; it += NGW) {
        int r = it;
        if (r < I_MOD) {
            const int cc = r % 24, kc = r / 24; f32x4 a0 = {0.f, 0.f, 0.f, 0.f}, a1 = {0.f, 0.f, 0.f, 0.f};
            const float* wp = F.w_ada + (size_t)(kc * 64) * 6144 + cc * 256 + 4 * lane;
#pragma unroll 8
            for (int k = 0; k < 64; ++k) { const f32x4 w = *(const f32x4*)(wp + (size_t)k * 6144); const float s0 = siluf(F.c[kc * 64 + k]), s1 = siluf(F.c[1024 + kc * 64 + k]); a0 += w * s0; a1 += w * s1; }
            float* mp = (float*)(ws + WS_MODP) + (size_t)kc * 2 * 6144 + cc * 256 + 4 * lane;
            *(f32x4*)mp = a0; *(f32x4*)(mp + 6144) = a1; continue; }
        r -= I_MOD;
        if (r < I_IN) { const int kb = r / 69, nb = r % 69, n0 = nb * 32; p0_transpose_item(F.w_in, 2208, 1024, kb * 64, n0, (bf16_t*)(ws + WS_WIN), n0 < 672 ? n0 : n0 + 96, nullptr, scr, lane); continue; }
        r -= I_IN;
        if (r < I_UQ) { const int kb = r / 24, nb = r % 24, n0 = nb * 32, h = n0 / 96, d = n0 % 96; p0_transpose_item(F.w_uq, 768, 384, kb * 64, n0, (bf16_t*)(ws + WS_WUQ), d < 64 ? h * 64 + d : 512 + h * 32, F.g_q, scr, lane); continue; }
        r -= I_UQ;
        if (r < I_UKV) { const int kb = r / 32, nb = r % 32, n0 = nb * 32, h = n0 / 128, d = n0 % 128; p0_transpose_item(F.w_ukv, 1024, 256, kb * 64, n0, (bf16_t*)(ws + WS_WUKV), d < 64 ? h * 64 + d : 512 + h * 64 + (d - 64), F.g_kv, scr, lane); continue; }
        r -= I_UKV;
        if (r < I_OUT) { const int kb = r / 32, nb = r % 32; p0_transpose_item(F.w_out, 1024, 1024, kb * 64, nb * 32, (bf16_t*)(ws + WS_WOUT), nb * 32, nullptr, scr, lane); continue; }
        r -= I_OUT;
        if (r < 2 * I_EXP) { const int up = r >= I_EXP; const int q = up ? r - I_EXP : r; const int e = q / 512, kb = (q % 512) / 32, nb = q % 32, n0 = nb * 32;
            p0_transpose_item((up ? F.w_up : F.w_gate) + (size_t)e * 1048576, 1024, 1024, kb * 64, n0, (bf16_t*)(ws + WS_WGU) + (size_t)e * 2048 * 1024, (n0 / 128) * 256 + up * 128 + (n0 % 128), nullptr, scr, lane); continue; }
        r -= 2 * I_EXP;
        if (!WD_IN_P5) { if (r < I_EXP) { const int e = r / 512, kb = (r % 512) / 32, nb = r % 32; p0_transpose_item(F.w_down + (size_t)e * 1048576, 1024, 1024, kb * 64, nb * 32, (bf16_t*)(ws + WS_WD) + (size_t)e * 1048576, nb * 32, nullptr, scr, lane); continue; }
        r -= I_EXP; }
        if (r < I_PAD) { u32x4 z = {0u, 0u, 0u, 0u}; u32x4* p = (u32x4*)((bf16_t*)(ws + WS_WIN) + (size_t)(672 + r) * 1024); p[lane] = z; p[64 + lane] = z; continue; }
        r -= I_PAD;
        {
            const int e = r * 64 + lane, tok = e / 24, f = e % 24; const int p = F.pos[tok];
            const float inv = f < 16 ? inv_freq_m(f) : inv_freq_d(f - 16); const float ang = (float)p * inv; const float cs = (float)cos((double)ang), sn = (float)sin((double)ang);
            if (f < 16) { float* tm = (float*)(ws + WS_TABM) + (size_t)tok * 32; tm[f] = cs; tm[16 + f] = sn; } else { float* td = (float*)(ws + WS_TABD) + (size_t)tok * 16; td[f - 16] = cs; td[8 + f - 16] = sn; }
        }
    }
}
__device__ __forceinline__ void wd_convert(Frame& F, int first_vcu) {
    LAS float* scr = (LAS float*)(F.lds + F.wave * 16384);
    const int gw = (F.vcu - first_vcu) * NWAVES + F.wave, NGW = (F.G - first_vcu) * NWAVES, lane = fresh_lane();
    for (int r = gw; r < 16 * 16 * 32; r += NGW) { const int e = r / 512, kb = (r % 512) / 32, nb = r % 32;
        p0_transpose_item(F.w_down + (size_t)e * 1048576, 1024, 1024, kb * 64, nb * 32, (bf16_t*)(F.ws + WS_WD) + (size_t)e * 1048576, nb * 32, nullptr, scr, lane); }
}
__device__ __forceinline__ void p0b_rows(Frame& F) {
    const int tid_ = F.wave * 64 + fresh_lane();
    LAS float* A1 = (LAS float*)F.lds;
    LAS float* A0 = A1 + 2048;
    const float* mp = (const float*)(F.ws + WS_MODP);
#pragma unroll
    for (int half = 0; half < 2; ++half) { float s[4]; float pv[4][16];
#pragma unroll
        for (int q = 0; q < 4; ++q) { const int i = tid_ + NTHREADS * (half * 4 + q); const int b = i >> 11, n = ((i >> 10) & 1) * 1024 + (i & 1023);
#pragma unroll
            for (int k = 0; k < 16; ++k) pv[q][k] = mp[(size_t)k * 2 * 6144 + b * 6144 + n]; }
#pragma unroll
        for (int q = 0; q < 4; ++q) { const int i = tid_ + NTHREADS * (half * 4 + q); const int b = i >> 11, which = (i >> 10) & 1, j = i & 1023; s[q] = F.b_ada[which * 1024 + j];
#pragma unroll
            for (int k = 0; k < 16; ++k) s[q] += pv[q][k];
            if (which) A1[b * 1024 + j] = F.g_mix[j] * (1.f + s[q]); else A0[b * 1024 + j] = s[q]; } }
    if (blockIdx.x < 48 && tid_ < 256) { const int n = blockIdx.x * 256 + tid_; const int b = n / 6144, nn = n % 6144; float s = F.b_ada[nn];
#pragma unroll
        for (int k = 0; k < 16; ++k) s += mp[(size_t)k * 2 * 6144 + b * 6144 + nn];
        ((float*)(F.ws + WS_MODF))[n] = s; }
    __syncthreads();
    const int gw = F.vcu * NWAVES + F.wave, NGW = F.G * NWAVES, lane = fresh_lane();
    for (int m0 = gw; m0 < T; m0 += 2 * NGW) {
        const int m1 = m0 + NGW; const bool has1 = m1 < T; const int mm1 = has1 ? m1 : m0;
        const f32x4* xr0 = (const f32x4*)(F.x + (size_t)m0 * D) + lane; const f32x4* xr1 = (const f32x4*)(F.x + (size_t)mm1 * D) + lane; f32x4 v0[4], v1[4]; float s0 = 0.f, s1 = 0.f;
#pragma unroll
        for (int j = 0; j < 4; ++j) { v0[j] = xr0[64 * j]; v1[j] = xr1[64 * j]; }
#pragma unroll
        for (int j = 0; j < 4; ++j) { s0 += (v0[j].x * v0[j].x + v0[j].y * v0[j].y) + (v0[j].z * v0[j].z + v0[j].w * v0[j].w); s1 += (v1[j].x * v1[j].x + v1[j].y * v1[j].y) + (v1[j].z * v1[j].z + v1[j].w * v1[j].w); }
        const float r0 = rsqrtf(wave_sum(s0) * (1.f / D) + EPS), r1 = rsqrtf(wave_sum(s1) * (1.f / D) + EPS);
        const int b0 = m0 >> 13, b1 = mm1 >> 13;
        unsigned long long* o0 = (unsigned long long*)((bf16_t*)(F.ws + WS_HB) + (size_t)m0 * D) + lane; unsigned long long* o1 = (unsigned long long*)((bf16_t*)(F.ws + WS_HB) + (size_t)mm1 * D) + lane;
#pragma unroll
        for (int j = 0; j < 4; ++j) { const f32x4 a1 = *(const LAS f32x4*)(A1 + b0 * 1024 + 4 * lane + 256 * j), a0 = *(const LAS f32x4*)(A0 + b0 * 1024 + 4 * lane + 256 * j);
            const f32x4 o = v0[j] * r0 * a1 + a0; o0[64 * j] = (unsigned long long)pk2(o.x, o.y) | ((unsigned long long)pk2(o.z, o.w) << 32); }
        if (has1) {
#pragma unroll
            for (int j = 0; j < 4; ++j) { const f32x4 a1 = *(const LAS f32x4*)(A1 + b1 * 1024 + 4 * lane + 256 * j), a0 = *(const LAS f32x4*)(A0 + b1 * 1024 + 4 * lane + 256 * j);
                const f32x4 o = v1[j] * r1 * a1 + a0; o1[64 * j] = (unsigned long long)pk2(o.x, o.y) | ((unsigned long long)pk2(o.z, o.w) << 32); } }
    }
    __syncthreads();
}

__device__ __forceinline__ bool static_tile(int i, int G, int c, int nM, int nN, int& pm, int& pn) {
    const int nwg = nM * nN; const long L = (long)i * G + c; if (L >= nwg) return false;
    int wgid = (int)L; { const int q = nwg / 8, r = nwg % 8, xcd = wgid % 8, off = wgid / 8; wgid = (xcd < r ? xcd * (q + 1) : r * (q + 1) + (xcd - r) * q) + off; }
    const int nig = 8 * nN, gid = wgid / nig, fm = gid * 8, gsz = (nM - fm) < 8 ? (nM - fm) : 8;
    pm = fm + ((wgid % nig) % gsz); pn = (wgid % nig) / gsz; return true;
}
struct SchedP1 {
    static constexpr bool GATHER = false;
    __device__ __forceinline__ void a_ready(const gm::Unit&, int, int) const {}
    __device__ __forceinline__ void done(const gm::Unit&, int) const {}
    __device__ __forceinline__ void stamp(int, const gm::Unit&, int, int) const {}
    const char* A; const char* Bt; int G, c;
    __device__ __forceinline__ bool next(int i, gm::Unit& u) const { int pm, pn; if (!static_tile(i, G, c, 64, 9, pm, pn)) return false;
        u.A = A; u.Bt = Bt; u.gidx = nullptr; u.lda2 = 2048; u.ldb2 = 2048; u.arow0 = pm * 256; u.brow0 = pn * 256; u.nt = 16; u.pm = pm; u.pn = pn; u.aux = 0; return true; }
};
struct SchedP2 {
    static constexpr bool GATHER = false;
    __device__ __forceinline__ void a_ready(const gm::Unit&, int, int) const {}
    __device__ __forceinline__ void done(const gm::Unit&, int) const {}
    __device__ __forceinline__ void stamp(int, const gm::Unit&, int, int) const {}
    const char* A; const char* Wuq; const char* Wukv; int G, c;
    __device__ __forceinline__ bool next(int i, gm::Unit& u) const {
        const int L = i * G + c; if (L >= 448) return false;
        u.A = A; u.gidx = nullptr; u.lda2 = 1536;
        if (L < 256) { int pm, pn; static_tile(0, 256, L, 64, 4, pm, pn); u.A = A + 768; u.Bt = Wukv; u.ldb2 = 512; u.nt = 4; u.arow0 = pm * 256; u.brow0 = pn * 256; u.pm = pm; u.pn = pn; u.aux = 1; }
        else { int pm, pn; static_tile(0, 192, L - 256, 64, 3, pm, pn); u.Bt = Wuq; u.ldb2 = 768; u.nt = 6; u.arow0 = pm * 256; u.brow0 = pn * 256; u.pm = pm; u.pn = pn; u.aux = 0; }
        return true; }
};

__device__ __forceinline__ void store16_sc1(void* p, u32x4 v) { asm volatile("global_store_dwordx4 %0, %1, off sc1\n\ts_nop 1" :: "v"(p), "v"(v) : "memory"); }
__device__ __forceinline__ void store4_sc1(float* p, float v) { __hip_atomic_store(p, v, __ATOMIC_RELAXED, __HIP_MEMORY_SCOPE_AGENT); }
#define EPI_ARGS const f32x4 (&acc)[2][2][4][2], const gm::Unit& u, int wr, int wc, int fr, int fq, int lane
constexpr float QSCALE_M = 0.10206207261596575f * 1.4426950408889634f;
constexpr float QSCALE_D = 0.125f * 1.4426950408889634f;
__device__ __forceinline__ u32x4 pack8(f32x4 a, f32x4 b) { u32x4 w; w.x = cvt_pk_bf16(a[0], a[1]); w.y = cvt_pk_bf16(a[2], a[3]); w.z = cvt_pk_bf16(b[0], b[1]); w.w = cvt_pk_bf16(b[2], b[3]); return w; }
__device__ __forceinline__ void rope8(f32x4& v0, f32x4& v1, int xmask, const float* cs, const float* sn, bool first) {
    f32x4 o0, o1;
#pragma unroll
    for (int j = 0; j < 4; ++j) { o0[j] = __shfl_xor(v0[j], xmask); o1[j] = __shfl_xor(v1[j], xmask); }
    const f32x4 c0 = *(const f32x4*)cs, c1 = *(const f32x4*)(cs + 4), s0 = *(const f32x4*)sn, s1 = *(const f32x4*)(sn + 4);
    const float sg = first ? -1.f : 1.f;
    v0 = v0 * c0 + o0 * s0 * sg; v1 = v1 * c1 + o1 * s1 * sg;
}
struct EpiP1 {
    static constexpr bool PERM = true;
    unsigned char* ws;
    __device__ __forceinline__ void operator()(EPI_ARGS) const {
        const int pn = u.pn; float krmax = 0.f;
        const float* tabm = (const float*)(ws + WS_TABM); const float* tabd = (const float*)(ws + WS_TABD);
#pragma unroll
        for (int ai = 0; ai < 2; ++ai)
#pragma unroll
            for (int m = 0; m < 4; ++m) {
                const int row = u.pm * 256 + ai * 128 + wr * 64 + m * 16 + fr; const int b = row >> 13, s = row & 8191;
#pragma unroll
                for (int bj = 0; bj < 2; ++bj) {
                    f32x4 v0 = acc[ai][bj][m][0], v1 = acc[ai][bj][m][1];
                    const int ct = bj * 128 + wc * 32 + 8 * fq;
                    if (pn < 3) {
                        float q = (v0[0] * v0[0] + v0[1] * v0[1]) + (v0[2] * v0[2] + v0[3] * v0[3]) + (v1[0] * v1[0] + v1[1] * v1[1]) + (v1[2] * v1[2] + v1[3] * v1[3]);
                        q += __shfl_xor(q, 16); q += __shfl_xor(q, 32);
                        if (fq == 0) store4_sc1((float*)(ws + WS_SSQ) + (size_t)row * 24 + pn * 8 + bj * 4 + wc, q);
                        if (pn == 2 && bj == 1 && wc == 0) {
                            const int f0 = 8 * (fq & 1); rope8(v0, v1, 32, tabm + (size_t)row * 32 + f0, tabm + (size_t)row * 32 + 16 + f0, fq < 2);
                            store16_sc1((bf16_t*)(ws + WS_KR) + (size_t)row * 32 + 8 * fq, pack8(v0, v1));
                            { float q2 = (v0[0] * v0[0] + v0[1] * v0[1]) + (v0[2] * v0[2] + v0[3] * v0[3]) + (v1[0] * v1[0] + v1[1] * v1[1]) + (v1[2] * v1[2] + v1[3] * v1[3]);
                              q2 += __shfl_xor(q2, 16); q2 += __shfl_xor(q2, 32); krmax = fmaxf(krmax, q2); }
                        } else store16_sc1((bf16_t*)(ws + WS_CQ) + (size_t)row * 768 + pn * 256 + ct, pack8(v0, v1));
                    } else {
                        const int which = (pn - 3) >> 1;
                        const int cc = ((pn - 3) & 1) * 256 + ct, hh = cc >> 6, d = cc & 63;
                        if (which < 2 && (wc & 1) == 0) {
                            f32x4 r0 = v0, r1 = v1; rope8(r0, r1, 16, tabd + (size_t)row * 16, tabd + (size_t)row * 16 + 8, fq == 0);
                            if (fq < 2) { v0 = r0; v1 = r1; } }
                        if (which == 0) { v0 = v0 * QSCALE_D; v1 = v1 * QSCALE_D; }
                        bf16_t* dst = (bf16_t*)(ws + (which == 0 ? WS_DQ : which == 1 ? WS_DK : WS_DV));
                        *(u32x4*)(dst + ((size_t)(b * 8 + hh) * S + s) * 64 + d) = pack8(v0, v1);
                    }
                }
            }
        if (pn == 2 && wc == 0) {
#pragma unroll
            for (int o = 1; o < 16; o <<= 1) krmax = fmaxf(krmax, __shfl_xor(krmax, o));
            if (lane == 0) atomicMax((unsigned*)(ws + WS_KMX) + 32 + ((u.pm * 256) >> 13), __float_as_uint(krmax)); }
    }
};
struct EpiP2 {
    static constexpr bool PERM = true;
    unsigned char* ws;
    __device__ __forceinline__ void operator()(EPI_ARGS) const {
        const int pn = u.pn; const bool isq = u.aux == 0; float kmax[2] = {0.f, 0.f};
        const float* tabm = (const float*)(ws + WS_TABM); const float* ssq = (const float*)(ws + WS_SSQ);
#pragma unroll
        for (int ai = 0; ai < 2; ++ai)
#pragma unroll
            for (int m = 0; m < 4; ++m) {
                const int row = u.pm * 256 + ai * 128 + wr * 64 + m * 16 + fr; const int b = row >> 13, s = row & 8191;
                const float* sq = ssq + (size_t)row * 24; float rstd;
                if (isq) { const f32x4 a = *(const f32x4*)sq, bq = *(const f32x4*)(sq + 4), cq = *(const f32x4*)(sq + 8);
                    rstd = rsqrtf((((a[0] + a[1]) + (a[2] + a[3])) + ((bq[0] + bq[1]) + (bq[2] + bq[3])) + ((cq[0] + cq[1]) + (cq[2] + cq[3]))) * (1.f / 384.f) + EPS) * QSCALE_M; }
                else { const f32x4 a = *(const f32x4*)(sq + 12), bq = *(const f32x4*)(sq + 16);
                    rstd = rsqrtf((((a[0] + a[1]) + (a[2] + a[3])) + ((bq[0] + bq[1]) + (bq[2] + bq[3]))) * (1.f / 256.f) + EPS); }
#pragma unroll
                for (int bj = 0; bj < 2; ++bj) {
                    f32x4 v0 = acc[ai][bj][m][0] * rstd, v1 = acc[ai][bj][m][1] * rstd;
                    const int ct = bj * 128 + wc * 32 + 8 * fq, cc = (pn & 1) * 256 + ct;
                    if (isq) {
                        if (pn < 2) { const int hh = cc >> 6, d = cc & 63; *(u32x4*)((bf16_t*)(ws + WS_Q) + ((size_t)(b * 8 + hh) * S + s) * 96 + d) = pack8(v0, v1); }
                        else { const int hh = ct >> 5; const int f0 = 8 * (fq & 1); rope8(v0, v1, 32, tabm + (size_t)row * 32 + f0, tabm + (size_t)row * 32 + 16 + f0, fq < 2);
                            *(u32x4*)((bf16_t*)(ws + WS_Q) + ((size_t)(b * 8 + hh) * S + s) * 96 + 64 + 8 * fq) = pack8(v0, v1); }
                    } else { const int hh = cc >> 6, d = cc & 63; bf16_t* dst = (bf16_t*)(ws + (pn < 2 ? WS_KN : WS_V));
                        *(u32x4*)(dst + ((size_t)(b * 8 + hh) * S + s) * 64 + d) = pack8(v0, v1);
                        if (pn < 2) { float q2 = (v0[0] * v0[0] + v0[1] * v0[1]) + (v0[2] * v0[2] + v0[3] * v0[3]) + (v1[0] * v1[0] + v1[1] * v1[1]) + (v1[2] * v1[2] + v1[3] * v1[3]);
                            q2 += __shfl_xor(q2, 16); q2 += __shfl_xor(q2, 32); kmax[bj] = fmaxf(kmax[bj], q2); } }
                }
            }
        if (!isq && pn < 2) {
#pragma unroll
            for (int bj = 0; bj < 2; ++bj) { float km = kmax[bj];
#pragma unroll
                for (int o = 1; o < 16; o <<= 1) km = fmaxf(km, __shfl_xor(km, o));
                const int cc = (pn & 1) * 256 + bj * 128 + wc * 32, hh = cc >> 6, half = (cc >> 5) & 1, b = (u.pm * 256) >> 13;
                if (lane == 0) atomicMax((unsigned*)(ws + WS_KMX) + (b * 8 + hh) * 2 + half, __float_as_uint(km)); }
        }
    }
};

constexpr size_t WS_PCNT = 56 * KiB;
struct SchedP12 {
    static constexpr bool GATHER = false;
    const char *HB, *WIN, *CQ, *WUQ, *WUKV; unsigned* cnt; int G, vcu, c;
    __device__ __forceinline__ bool next(int i, gm::Unit& u) const {
        u.gidx = nullptr;
        if (G == 256) {
            const int n1 = c < 64 ? 3 : 2;
            if (i < n1) { int pm, pn; static_tile(i, 256, c, 64, 9, pm, pn);
                u.A = HB; u.Bt = WIN; u.lda2 = 2048; u.ldb2 = 2048; u.arow0 = pm * 256; u.brow0 = pn * 256; u.nt = 16; u.pm = pm; u.pn = pn; u.aux = 2; return true; }
            if (c < 64) return false;
            const int idx = (c - 64) + 192 * (i - 2); if (i - 2 >= 3 || idx >= 448) return false;
            if (idx < 256) { int pm, pn; static_tile(0, 256, idx, 64, 4, pm, pn); u.A = CQ + 768; u.Bt = WUKV; u.lda2 = 1536; u.ldb2 = 512; u.nt = 4; u.arow0 = pm * 256; u.brow0 = pn * 256; u.pm = pm; u.pn = pn; u.aux = 1; }
            else { int pm, pn; static_tile(0, 192, idx - 256, 64, 3, pm, pn); u.A = CQ; u.Bt = WUQ; u.lda2 = 1536; u.ldb2 = 768; u.nt = 6; u.arow0 = pm * 256; u.brow0 = pn * 256; u.pm = pm; u.pn = pn; u.aux = 0; }
            return true;
        }
        const int n1 = (576 - vcu + G - 1) / G;
        if (i < n1) { const int k = vcu + G * i, pn = k >> 6, pm = k & 63;
            u.A = HB; u.Bt = WIN; u.lda2 = 2048; u.ldb2 = 2048; u.arow0 = pm * 256; u.brow0 = pn * 256; u.nt = 16; u.pm = pm; u.pn = pn; u.aux = 2; return true; }
        const int idx = vcu + G * (i - n1); if (idx >= 448) return false;
        if (idx < 256) { const int pm = idx & 63, pn = idx >> 6; u.A = CQ + 768; u.Bt = WUKV; u.lda2 = 1536; u.ldb2 = 512; u.nt = 4; u.arow0 = pm * 256; u.brow0 = pn * 256; u.pm = pm; u.pn = pn; u.aux = 1; }
        else { const int j = idx - 256, pm = j & 63, pn = j >> 6; u.A = CQ; u.Bt = WUQ; u.lda2 = 1536; u.ldb2 = 768; u.nt = 6; u.arow0 = pm * 256; u.brow0 = pn * 256; u.pm = pm; u.pn = pn; u.aux = 0; }
        return true;
    }
#ifndef P12_STAMP
#define P12_STAMP 0
#endif
    __device__ __forceinline__ void stamp(int ui, const gm::Unit& u, int wid, int lane) const {
#if P12_STAMP
        if (wid == 0 && lane == 0) { unsigned long long* ts = (unsigned long long*)((unsigned char*)cnt - WS_PCNT + 128 * KiB) + (size_t)c * 8; ts[1 + ui] = __builtin_amdgcn_s_memrealtime(); ts[6] = (unsigned long long)(ui + 1); ts[7] = (u.aux == 2) ? (unsigned long long)(ui + 1) : ts[7]; }
#endif
    }
    __device__ __forceinline__ void a_ready(const gm::Unit& u, int wid, int) const {
        if (u.aux == 2) return;
        if (wid == 0) { unsigned* p = cnt + 16 * u.pm; unsigned spins = 0;
            while ((unsigned)__builtin_amdgcn_readfirstlane(__hip_atomic_load(p, __ATOMIC_RELAXED, __HIP_MEMORY_SCOPE_AGENT)) < 24u) { __builtin_amdgcn_s_sleep(2); if (++spins > (1u << 22)) break; }
            __builtin_amdgcn_fence(__ATOMIC_ACQUIRE, "agent");
            asm volatile("s_waitcnt vmcnt(0)" ::: "memory"); }
        asm volatile("" ::: "memory"); __builtin_amdgcn_s_barrier(); asm volatile("" ::: "memory");
    }
    __device__ __forceinline__ void done(const gm::Unit& u, int lane) const {
        if (u.aux != 2 || u.pn >= 3) return;
        asm volatile("s_waitcnt vmcnt(0)" ::: "memory");
        if (lane == 0) __hip_atomic_fetch_add(cnt + 16 * u.pm, 1u, __ATOMIC_RELAXED, __HIP_MEMORY_SCOPE_AGENT);
    }
};
struct EpiP12 {
    static constexpr bool PERM = true;
    unsigned char* ws;
    __device__ __forceinline__ void operator()(EPI_ARGS) const { if (u.aux == 2) { EpiP1 e{ws}; e(acc, u, wr, wc, fr, fq, lane); } else { EpiP2 e{ws}; e(acc, u, wr, wc, fr, fq, lane); } }
};
}
namespace mk {
#define RLX_AGENT __ATOMIC_RELAXED, __HIP_MEMORY_SCOPE_AGENT
#define XB_TMO      128
#define XB_XCNT(j)  (256  + 64 * (j))
#define XB_XSUB(j)  (1280 + 64 * (j))
#define XB_XGEN(j)  (2304 + 64 * (j))
#define XB_TOP      3328
#define XB_TOPGEN   3392
#define XCD_BAR_WORDS 3456
#define XB_SPIN_CAP (1u << 18)
__device__ __forceinline__ unsigned xb_ld(unsigned* p)              { return __hip_atomic_load(p, __ATOMIC_RELAXED, __HIP_MEMORY_SCOPE_AGENT); }
__device__ __forceinline__ unsigned xb_add(unsigned* p, unsigned v) { return __hip_atomic_fetch_add(p, v, __ATOMIC_RELAXED, __HIP_MEMORY_SCOPE_AGENT); }
__device__ __forceinline__ unsigned xb_xcc_id() { return (unsigned)__builtin_amdgcn_s_getreg((3 << 11) | 20) & 0xFu; }
#define XB_SPIN(cond, bar) do { unsigned _sp = 0; while (cond) { __builtin_amdgcn_s_sleep(1); \
    if ((++_sp & 255u) == 0u) { if (xb_ld(&(bar)[XB_TMO])) break; if (_sp > XB_SPIN_CAP) { atomicAdd(&(bar)[XB_TMO], 1u); break; } } } } while (0)
struct XcdBarrier { unsigned* bar; unsigned x; volatile LAS unsigned* st; };
__device__ __forceinline__ XcdBarrier xcd_barrier_post(unsigned* bar, volatile LAS unsigned* st, bool first_thread) {
    XcdBarrier b; b.bar = bar; b.x = xb_xcc_id(); b.st = st;
    if (first_thread) (void)xb_add(&bar[XB_XCNT(b.x)], 1u);
    return b;
}
__device__ __forceinline__ void xcd_barrier_complete(unsigned* bar, unsigned x, unsigned& nloc, unsigned& nx) {
    const unsigned G = gridDim.x * gridDim.y * gridDim.z;
    unsigned sum, cnt, mine, sp = 0u;
    for (;;) {
        sum = 0u; cnt = 0u; mine = 0u;
#pragma unroll
        for (unsigned j = 0; j < 16; ++j) { const unsigned c = xb_ld(&bar[XB_XCNT(j)]); sum += c; cnt += (c > 0u) ? 1u : 0u; mine = (j == x) ? c : mine; }
        if (sum == G) break;
        __builtin_amdgcn_s_sleep(1);
        if ((++sp & 255u) == 0u) { if (xb_ld(&bar[XB_TMO])) break; if (sp > XB_SPIN_CAP) { atomicAdd(&bar[XB_TMO], 1u); break; } }
    }
    nloc = mine > 0u ? mine : 1u; nx = cnt > 0u ? cnt : 1u;
}
__device__ __forceinline__ void xcd_barrier(const XcdBarrier& b, bool first_thread) {
    asm volatile("s_waitcnt vmcnt(0)" ::: "memory");
    __syncthreads();
    if (first_thread) {
        unsigned* bar = b.bar;
        __builtin_amdgcn_s_waitcnt(0);
        unsigned nloc = b.st[0], nx = b.st[1];
        if (nloc == 0u) { xcd_barrier_complete(bar, b.x, nloc, nx); b.st[0] = nloc; b.st[1] = nx; }
        const unsigned old = xb_add(&bar[XB_XSUB(b.x)], 1u);
        const unsigned gen = old / nloc;
        if (old + 1u == (gen + 1u) * nloc) {
            __builtin_amdgcn_fence(__ATOMIC_RELEASE, "agent");
            asm volatile("s_waitcnt vmcnt(0)" ::: "memory");
            const unsigned og = xb_add(&bar[XB_TOP], 1u);
            const unsigned tg = og / nx;
            if (og + 1u == (tg + 1u) * nx) xb_add(&bar[XB_TOPGEN], 1u);
            else XB_SPIN(xb_ld(&bar[XB_TOPGEN]) == tg, bar);
            __builtin_amdgcn_fence(__ATOMIC_ACQUIRE, "agent");
            xb_add(&bar[XB_XGEN(b.x)], 1u);
            asm volatile("s_waitcnt vmcnt(0)" ::: "memory");
        } else {
            XB_SPIN(xb_ld(&bar[XB_XGEN(b.x)]) == gen, bar);
            __builtin_amdgcn_fence(__ATOMIC_ACQUIRE, "agent");
            asm volatile("s_waitcnt vmcnt(0)" ::: "memory");
        }
    }
    __syncthreads();
}
}
namespace at {
using bf16x8 = __attribute__((ext_vector_type(8))) short;
using s16x4 = __attribute__((ext_vector_type(4))) short;
using f32x16 = __attribute__((ext_vector_type(16))) float;
using u32x4 = __attribute__((ext_vector_type(4))) unsigned;
constexpr int S = 8192, T = 16384;
constexpr float THR = 8.f;
#define SBAR() __builtin_amdgcn_sched_barrier(0)
__device__ __forceinline__ int crow(int r, int hi) { return (r & 3) + 8 * (r >> 2) + 4 * hi; }
__device__ __forceinline__ unsigned cvtpk(float lo, float hi) { unsigned r; asm volatile("v_cvt_pk_bf16_f32 %0, %1, %2" : "=v"(r) : "v"(lo), "v"(hi)); return r; }
__device__ __forceinline__ float rowmax32(const f32x16& p0, const f32x16& p1) {
    float pmax = p0[0];
#pragma unroll
    for (int r = 1; r < 16; ++r) pmax = fmaxf(pmax, p0[r]);
#pragma unroll
    for (int r = 0; r < 16; ++r) pmax = fmaxf(pmax, p1[r]);
    auto rr = __builtin_amdgcn_permlane32_swap(__float_as_uint(pmax), __float_as_uint(pmax), false, false);
    return fmaxf(__uint_as_float(rr[0]), __uint_as_float(rr[1]));
}
__device__ __forceinline__ void partialSM(f32x16& p0, f32x16& p1, float& m_reg, float& mn, float& alpha) {
    const float pmax = rowmax32(p0, p1);
    if (__builtin_expect(__all(pmax - m_reg <= THR), 1)) { mn = m_reg; alpha = 1.f; }
    else { mn = fmaxf(m_reg, pmax); alpha = __builtin_amdgcn_exp2f(m_reg - mn); m_reg = mn; }
#pragma unroll
    for (int r = 0; r < 16; ++r) p0[r] = p0[r] - mn;
#pragma unroll
    for (int r = 0; r < 16; ++r) p1[r] = p1[r] - mn;
#pragma unroll
    for (int r = 0; r < 16; ++r) p0[r] = __builtin_amdgcn_exp2f(p0[r]);
}
#define PK4(P, BASE, OUT) do { u32x4 w = {cvtpk(P[BASE + 0], P[BASE + 1]), cvtpk(P[BASE + 2], P[BASE + 3]), cvtpk(P[BASE + 4], P[BASE + 5]), cvtpk(P[BASE + 6], P[BASE + 7])}; \
    OUT = *reinterpret_cast<bf16x8*>(&w); } while (0)
__device__ __forceinline__ void finishSM(f32x16& p0, f32x16& p1, float alpha, float& l_reg, bf16x8& pa0, bf16x8& pa1, bf16x8& pa2, bf16x8& pa3) {
#pragma unroll
    for (int r = 0; r < 16; ++r) p1[r] = __builtin_amdgcn_exp2f(p1[r]);
    float ps = 0;
#pragma unroll
    for (int r = 0; r < 16; ++r) ps += p0[r];
#pragma unroll
    for (int r = 0; r < 16; ++r) ps += p1[r];
    { auto rr = __builtin_amdgcn_permlane32_swap(__float_as_uint(ps), __float_as_uint(ps), false, false); ps = __uint_as_float(rr[0]) + __uint_as_float(rr[1]); }
    l_reg = l_reg * alpha + ps;
    PK4(p0, 0, pa0); PK4(p0, 8, pa1); PK4(p1, 0, pa2); PK4(p1, 8, pa3);
}
__device__ __forceinline__ int v_st(int k, int c) { const int kk = k; return ((kk >> 3) * 2 + (c >> 5)) * 512 + ((kk & 7) * 32 + (c & 31)) * 2; }
__device__ __forceinline__ int v_rd_base(int lane) { return ((lane & 3) << 3) | (((lane >> 2) & 3) << 6) | (((lane >> 4) & 1) << 5) | (((lane >> 5) & 1) << 8); }
constexpr int v_rd_off(int d0, int ks, int half) { return d0 * 512 + ks * 2048 + half * 1024; }
template <int OFF> __device__ __forceinline__ s16x4 tr_read(int vb) { s16x4 r; asm volatile("ds_read_b64_tr_b16 %0, %1 offset:%2" : "=&v"(r) : "v"(vb), "i"(OFF) : "memory"); return r; }
#define PKV(L, H) (bf16x8){L[0], L[1], L[2], L[3], H[0], H[1], H[2], H[3]}
template <int D0, int KOFF> __device__ __forceinline__ void pv_one(f32x16& od, int vb, bf16x8 pa0, bf16x8 pa1, bf16x8 pa2, bf16x8 pa3) {
    const s16x4 l0 = tr_read<KOFF + v_rd_off(D0, 0, 0)>(vb), h0 = tr_read<KOFF + v_rd_off(D0, 0, 1)>(vb), l1 = tr_read<KOFF + v_rd_off(D0, 1, 0)>(vb), h1 = tr_read<KOFF + v_rd_off(D0, 1, 1)>(vb);
    const s16x4 l2 = tr_read<KOFF + v_rd_off(D0, 2, 0)>(vb), h2 = tr_read<KOFF + v_rd_off(D0, 2, 1)>(vb), l3 = tr_read<KOFF + v_rd_off(D0, 3, 0)>(vb), h3 = tr_read<KOFF + v_rd_off(D0, 3, 1)>(vb);
    asm volatile("s_waitcnt lgkmcnt(0)" ::: "memory"); SBAR();
    od = __builtin_amdgcn_mfma_f32_32x32x16_bf16(pa0, PKV(l0, h0), od, 0, 0, 0);
    od = __builtin_amdgcn_mfma_f32_32x32x16_bf16(pa1, PKV(l1, h1), od, 0, 0, 0);
    od = __builtin_amdgcn_mfma_f32_32x32x16_bf16(pa2, PKV(l2, h2), od, 0, 0, 0);
    od = __builtin_amdgcn_mfma_f32_32x32x16_bf16(pa3, PKV(l3, h3), od, 0, 0, 0);
}
template <int D0, int KOFF> __device__ __forceinline__ void pv_half(f32x16& od, int vb, bf16x8 pa0, bf16x8 pa1) {
    const s16x4 l0 = tr_read<KOFF + v_rd_off(D0, 0, 0)>(vb), h0 = tr_read<KOFF + v_rd_off(D0, 0, 1)>(vb), l1 = tr_read<KOFF + v_rd_off(D0, 1, 0)>(vb), h1 = tr_read<KOFF + v_rd_off(D0, 1, 1)>(vb);
    asm volatile("s_waitcnt lgkmcnt(0)" ::: "memory"); SBAR();
    od = __builtin_amdgcn_mfma_f32_32x32x16_bf16(pa0, PKV(l0, h0), od, 0, 0, 0);
    od = __builtin_amdgcn_mfma_f32_32x32x16_bf16(pa1, PKV(l1, h1), od, 0, 0, 0);
}
template <class RowOff> __device__ __forceinline__ void store_o_tile(const f32x16 (&o)[2], const float (&rli)[16], unsigned short* stg, unsigned short* dst, RowOff row_off, int lane) {
    const int r32 = lane & 31, hi = lane >> 5;
#pragma unroll
    for (int r = 0; r < 16; ++r) { const int orow = crow(r, hi);
#pragma unroll
        for (int d0 = 0; d0 < 2; ++d0) stg[orow * 64 + d0 * 32 + r32] = (unsigned short)(cvtpk(o[d0][r] * rli[r], 0.f) & 0xffffu); }
    asm volatile("s_waitcnt lgkmcnt(0)" ::: "memory");
#pragma unroll
    for (int i = 0; i < 4; ++i) { const int row = i * 8 + (lane >> 3), ch = lane & 7; const u32x4 v = *(const u32x4*)(stg + row * 64 + ch * 8); *(u32x4*)(dst + row_off(row) + ch * 8) = v; }
    asm volatile("s_waitcnt lgkmcnt(0)" ::: "memory");
}

__device__ __forceinline__ bool wg_or(bool pred, unsigned* flags8, int wid, int lane) {
    const bool w = __any(pred); if (lane == 0) flags8[wid] = w ? 1u : 0u;
    __syncthreads();
    unsigned r = 0u;
#pragma unroll
    for (int i = 0; i < 8; ++i) r |= flags8[i];
    __syncthreads();
    return r != 0u;
}
constexpr int SHM_V = 8192, SHM_K = 16384, MLA_WS = 2 * SHM_V + 2 * SHM_K, MLA_OST = MLA_WS + 8 * 256;
#define KSWZ(row, colB) ((row) * 256 + ((colB) ^ (((row) & 15) << 4)))
__device__ __forceinline__ void qkt96(f32x16& p0, f32x16& p1, const char* Ks, const bf16x8* qr, int r32, int hi) {
    p0 = f32x16{}; p1 = f32x16{};
#pragma unroll
    for (int d0 = 0; d0 < 6; ++d0) { const int cb = (d0 * 16 + hi * 8) * 2;
        const bf16x8 b0 = *reinterpret_cast<const bf16x8*>(Ks + KSWZ(r32, cb));
        const bf16x8 b1 = *reinterpret_cast<const bf16x8*>(Ks + KSWZ(32 + r32, cb));
        p0 = __builtin_amdgcn_mfma_f32_32x32x16_bf16(b0, qr[d0], p0, 0, 0, 0);
        p1 = __builtin_amdgcn_mfma_f32_32x32x16_bf16(b1, qr[d0], p1, 0, 0, 0); }
}
__device__ __forceinline__ void pv64(f32x16* o, int vb, bf16x8 pa0, bf16x8 pa1, bf16x8 pa2, bf16x8 pa3) {
    pv_one<0, 0>(o[0], vb, pa0, pa1, pa2, pa3); pv_one<1, 0>(o[1], vb, pa0, pa1, pa2, pa3);
}
__device__ __forceinline__ void mla_unit(int wv, int bh, int qb, const unsigned short* __restrict__ Q, const unsigned short* __restrict__ KN, const unsigned short* __restrict__ KR,
                                         const unsigned short* __restrict__ V, unsigned short* __restrict__ CAT, char* lds) {
    const int wid = wv, lane = gm::lane_now(), tid = wid * 64 + lane, r32 = lane & 31, hi = lane >> 5;
    const int b = bh >> 3, h = bh & 7;
    char* V_lds = lds; char* K_lds = lds + 2 * SHM_V;
    float* wsf = (float*)(lds + MLA_WS) + wid * 64; float* li_l = wsf; float* al_l = wsf + 32;
    float m_reg = -1e30f, l_reg = 0; f32x16 o[2] = {}; bf16x8 qr[6];
    const size_t bhS = (size_t)bh * S; const int q0 = qb * 256;
    const unsigned short* Qw = Q + (bhS + q0 + wid * 32 + r32) * 96 + hi * 8;
#pragma unroll
    for (int d0 = 0; d0 < 6; ++d0) qr[d0] = *reinterpret_cast<const bf16x8*>(Qw + d0 * 16);
    const int srow = tid >> 3, sch = tid & 7, rrow = (tid & 255) >> 2, rch = tid & 3;
    const unsigned short* kn_src = KN + (bhS + srow) * 64 + sch * 8;
    const unsigned short* v_src = V + (bhS + srow) * 64 + sch * 8;
    const unsigned short* kr_src = KR + ((size_t)b * S + rrow) * 32 + rch * 8;
    const int kst = KSWZ(srow, sch * 16), krst = KSWZ(rrow, (8 + rch) * 16), vst = v_st(srow, sch * 8);
    const int vb0 = (int)(uintptr_t)V_lds + v_rd_base(lane);
    bf16x8 s_kn[2], s_kr[2], s_v[2];
#define SLOAD(i, k0) do { s_kn[i] = *reinterpret_cast<const bf16x8*>(kn_src + (size_t)(k0) * 64); s_kr[i] = *reinterpret_cast<const bf16x8*>(kr_src + (size_t)(k0) * 32); \
    s_v[i] = *reinterpret_cast<const bf16x8*>(v_src + (size_t)(k0) * 64); } while (0)
#define SWRITE(bb, i) do { *(bf16x8*)(K_lds + (bb) * SHM_K + kst) = s_kn[i]; if (tid < 256) *(bf16x8*)(K_lds + (bb) * SHM_K + krst) = s_kr[i]; *(bf16x8*)(V_lds + (bb) * SHM_V + vst) = s_v[i]; } while (0)
#define SWAIT() asm volatile("s_waitcnt vmcnt(3)" ::: "memory")
#define RESC(a) do { if (__any((a) < 1.f)) { if (hi == 0) al_l[r32] = (a); asm volatile("s_waitcnt lgkmcnt(0)" ::: "memory"); \
    _Pragma("unroll") for (int d = 0; d < 2; ++d) _Pragma("unroll") for (int r = 0; r < 16; ++r) o[d][r] *= al_l[crow(r, hi)]; } } while (0)
    f32x16 pA0, pA1, pB0, pB1; float mnA, mnB, alA, alB; bf16x8 pa0, pa1, pa2, pa3; constexpr int NT = S / 64;
    SLOAD(0, 0); asm volatile("s_waitcnt vmcnt(0)" ::: "memory"); SWRITE(0, 0); __syncthreads();
    qkt96(pA0, pA1, K_lds, qr, r32, hi); partialSM(pA0, pA1, m_reg, mnA, alA);
    SLOAD(1, 64); SLOAD(0, 128);
    SWAIT(); SWRITE(1, 1); __syncthreads();
    for (int j = 1; j + 1 < NT; j += 2) {
        SBAR(); qkt96(pB0, pB1, K_lds + SHM_K, qr, r32, hi);
        finishSM(pA0, pA1, alA, l_reg, pa0, pa1, pa2, pa3); SBAR();
        SLOAD(1, (j + 2) * 64); SBAR();
        pv64(o, vb0, pa0, pa1, pa2, pa3); partialSM(pB0, pB1, m_reg, mnB, alB);
        __syncthreads(); SWAIT(); SWRITE(0, 0);
        RESC(alB); __syncthreads();
        SBAR(); qkt96(pA0, pA1, K_lds, qr, r32, hi);
        finishSM(pB0, pB1, alB, l_reg, pa0, pa1, pa2, pa3); SBAR();
        if (j + 3 < NT) SLOAD(0, (j + 3) * 64); SBAR();
        pv64(o, vb0 + SHM_V, pa0, pa1, pa2, pa3); partialSM(pA0, pA1, m_reg, mnA, alA);
        __syncthreads(); SWAIT(); SWRITE(1, 1);
        RESC(alA); __syncthreads();
    }
    SBAR(); qkt96(pB0, pB1, K_lds + SHM_K, qr, r32, hi);
    finishSM(pA0, pA1, alA, l_reg, pa0, pa1, pa2, pa3); SBAR();
    pv64(o, vb0, pa0, pa1, pa2, pa3); partialSM(pB0, pB1, m_reg, mnB, alB);
    __syncthreads(); RESC(alB);
    finishSM(pB0, pB1, alB, l_reg, pa0, pa1, pa2, pa3); SBAR();
    pv64(o, vb0 + SHM_V, pa0, pa1, pa2, pa3);
    if (hi == 0) li_l[r32] = l_reg; asm volatile("s_waitcnt lgkmcnt(0)" ::: "memory");
    float rli[16];
#pragma unroll
    for (int r = 0; r < 16; ++r) rli[r] = __builtin_amdgcn_rcpf(li_l[crow(r, hi)]);
    unsigned short* stg = (unsigned short*)(lds + MLA_OST) + wid * 2048;
    unsigned short* dst = CAT + ((size_t)b * S + q0 + wid * 32) * 1024 + h * 64;
    store_o_tile(o, rli, stg, dst, [](int row) { return (size_t)row * 1024; }, lane);
    asm volatile("s_waitcnt vmcnt(0)" ::: "memory");
    __syncthreads();
#undef SLOAD
#undef SWRITE
#undef SWAIT
#undef RESC
}


#ifndef V7_YOUNG_PRIO
#define V7_YOUNG_PRIO 1
#endif
#ifndef V7_EXACT
#define V7_EXACT 1
#endif
#ifndef MLA_STAMP
#define MLA_STAMP 0
#endif
#ifndef MLA_STAMP_WAVE
#define MLA_STAMP_WAVE 0
#endif
#if MLA_STAMP
#define STAMP_T(var) do { __builtin_amdgcn_sched_barrier(0); asm volatile("s_memtime %0\n\ts_waitcnt lgkmcnt(0)" : "=s"(var) :: "memory"); __builtin_amdgcn_sched_barrier(0); } while (0)
#define STAMP_ACC(i, t0_, t1_) (st_acc[i] += (t1_) - (t0_))
#else
#define STAMP_T(var) do { } while (0)
#define STAMP_ACC(i, t0_, t1_) do { } while (0)
#endif
#ifndef STAMP_SEC
#define STAMP_SEC 3
#endif
#if MLA_STAMP
#define SEC_B(i) do { if ((i) == STAMP_SEC) STAMP_T(tq0); } while (0)
#define SEC_E(i) do { if ((i) == STAMP_SEC) { STAMP_T(tq1); st_a += tq1 - tq0; } } while (0)
#else
#define SEC_B(i) do { } while (0)
#define SEC_E(i) do { } while (0)
#endif
constexpr int M2_K = 0, M2_V = 3 * SHM_K, M2_WS = M2_V + 3 * SHM_V, M2_OST = M2_WS + 8 * 256;
#ifndef MLA_PROBE_NOSTAGE
#define MLA_PROBE_NOSTAGE 0
#endif
#ifndef MLA_STATIC
#define MLA_STATIC 1
#endif
#ifndef MLA_STATIC_THR
#define MLA_STATIC_THR 60.f
#endif
#ifndef MLA_STEP_MODE
#define MLA_STEP_MODE 0
#endif
#ifndef MLA_PROBE_VALU
#define MLA_PROBE_VALU 0
#endif
#ifndef MLA_NEGM
#define MLA_NEGM 1
#endif
#ifndef MLA_PRIO
#define MLA_PRIO 0
#endif
__device__ __forceinline__ void qkt96n(f32x16& p0, f32x16& p1, const char* Ks, const bf16x8* qr, const f32x16& negm, int r32, int hi, bool usec = true) {
    if (MLA_PRIO) __builtin_amdgcn_s_setprio(1);
#pragma unroll
    for (int d0 = 0; d0 < 6; ++d0) { const int cb = (d0 * 16 + hi * 8) * 2;
        const bf16x8 b0 = *reinterpret_cast<const bf16x8*>(Ks + KSWZ(r32, cb));
        const bf16x8 b1 = *reinterpret_cast<const bf16x8*>(Ks + KSWZ(32 + r32, cb));
        if (d0 == 0 && !usec) { p0 = __builtin_amdgcn_mfma_f32_32x32x16_bf16(b0, qr[0], f32x16{}, 0, 0, 0); p1 = __builtin_amdgcn_mfma_f32_32x32x16_bf16(b1, qr[0], f32x16{}, 0, 0, 0); }
        else if (d0 == 0) { p0 = __builtin_amdgcn_mfma_f32_32x32x16_bf16(b0, qr[0], MLA_NEGM ? negm : f32x16{}, 0, 0, 0); p1 = __builtin_amdgcn_mfma_f32_32x32x16_bf16(b1, qr[0], MLA_NEGM ? negm : f32x16{}, 0, 0, 0); }
        else { p0 = __builtin_amdgcn_mfma_f32_32x32x16_bf16(b0, qr[d0], p0, 0, 0, 0); p1 = __builtin_amdgcn_mfma_f32_32x32x16_bf16(b1, qr[d0], p1, 0, 0, 0); } }
    if (MLA_PRIO) __builtin_amdgcn_s_setprio(0);
}
__device__ __forceinline__ void qkt96z(f32x16& p0, f32x16& p1, const char* Ks, const bf16x8* qr, int r32, int hi) {
#pragma unroll
    for (int d0 = 0; d0 < 6; ++d0) { const int cb = (d0 * 16 + hi * 8) * 2;
        const bf16x8 b0 = *reinterpret_cast<const bf16x8*>(Ks + KSWZ(r32, cb));
        const bf16x8 b1 = *reinterpret_cast<const bf16x8*>(Ks + KSWZ(32 + r32, cb));
        if (d0 == 0) { p0 = __builtin_amdgcn_mfma_f32_32x32x16_bf16(b0, qr[0], f32x16{}, 0, 0, 0); p1 = __builtin_amdgcn_mfma_f32_32x32x16_bf16(b1, qr[0], f32x16{}, 0, 0, 0); }
        else { p0 = __builtin_amdgcn_mfma_f32_32x32x16_bf16(b0, qr[d0], p0, 0, 0, 0); p1 = __builtin_amdgcn_mfma_f32_32x32x16_bf16(b1, qr[d0], p1, 0, 0, 0); } }
}
__device__ __forceinline__ float rowmax32b(const f32x16& p0, const f32x16& p1) {
    float a = fmaxf(fmaxf(p0[0], p0[1]), p1[0]), b = fmaxf(fmaxf(p0[2], p0[3]), p1[1]); a = fmaxf(fmaxf(a, p1[2]), p1[3]);
#pragma unroll
    for (int r = 4; r < 16; r += 4) { a = fmaxf(fmaxf(a, p0[r]), p0[r + 1]); b = fmaxf(fmaxf(b, p0[r + 2]), p0[r + 3]); a = fmaxf(fmaxf(a, p1[r]), p1[r + 1]); b = fmaxf(fmaxf(b, p1[r + 2]), p1[r + 3]); }
    const float m = fmaxf(a, b);
    auto rr = __builtin_amdgcn_permlane32_swap(__float_as_uint(m), __float_as_uint(m), false, false);
    return fmaxf(__uint_as_float(rr[0]), __uint_as_float(rr[1]));
}
template <bool FIRST> __device__ __forceinline__ void partialSM2(f32x16& p0, f32x16& p1, float& m_reg, f32x16& negm, float& alpha, bool exact = true) {
    if (!exact) { alpha = 1.f;
#pragma unroll
        for (int r = 0; r < 16; ++r) p0[r] = __builtin_amdgcn_exp2f(p0[r]);
        return; }
    if (MLA_PROBE_VALU) { float d0_ = p1[0], d1_ = p1[1], d2_ = p1[2], d3_ = p1[3];
#pragma unroll
        for (int i = 0; i < 8; ++i) { d0_ = __builtin_amdgcn_exp2f(d0_); d1_ = __builtin_amdgcn_exp2f(d1_); d2_ = __builtin_amdgcn_exp2f(d2_); d3_ = __builtin_amdgcn_exp2f(d3_); }
        asm volatile("" :: "v"(d0_), "v"(d1_), "v"(d2_), "v"(d3_)); }
    if (!MLA_NEGM) {
        const float pm = rowmax32b(p0, p1); alpha = 1.f;
        if (FIRST) m_reg = pm; else if (!__builtin_expect(__all(pm - m_reg <= THR), 1)) { const float mn = fmaxf(m_reg, pm); alpha = __builtin_amdgcn_exp2f(m_reg - mn); m_reg = mn; }
#pragma unroll
        for (int r = 0; r < 16; ++r) { p0[r] -= m_reg; p1[r] -= m_reg; }
#pragma unroll
        for (int r = 0; r < 16; ++r) p0[r] = __builtin_amdgcn_exp2f(p0[r]);
        return; }
    const float pmax = rowmax32b(p0, p1);
    alpha = 1.f;
    if (FIRST || !__builtin_expect(__all(pmax <= THR), 1)) {
        const float dl = FIRST ? pmax : fmaxf(pmax, 0.f); m_reg += dl;
#pragma unroll
        for (int r = 0; r < 16; ++r) { p0[r] -= dl; p1[r] -= dl; }
#pragma unroll
        for (int r = 0; r < 16; ++r) negm[r] = -m_reg;
        if (!FIRST) alpha = __builtin_amdgcn_exp2f(-dl);
    }
#pragma unroll
    for (int r = 0; r < 16; ++r) p0[r] = __builtin_amdgcn_exp2f(p0[r]);
}
template <int D0> __device__ __forceinline__ void pv_one_p(f32x16& od, int vb, bf16x8 pa0, bf16x8 pa1, bf16x8 pa2, bf16x8 pa3) {
    const s16x4 l0 = tr_read<v_rd_off(D0, 0, 0)>(vb), h0 = tr_read<v_rd_off(D0, 0, 1)>(vb), l1 = tr_read<v_rd_off(D0, 1, 0)>(vb), h1 = tr_read<v_rd_off(D0, 1, 1)>(vb);
    const s16x4 l2 = tr_read<v_rd_off(D0, 2, 0)>(vb), h2 = tr_read<v_rd_off(D0, 2, 1)>(vb), l3 = tr_read<v_rd_off(D0, 3, 0)>(vb), h3 = tr_read<v_rd_off(D0, 3, 1)>(vb);
    asm volatile("s_waitcnt lgkmcnt(0)" ::: "memory"); SBAR();
    if (MLA_PRIO) __builtin_amdgcn_s_setprio(1);
    od = __builtin_amdgcn_mfma_f32_32x32x16_bf16(pa0, PKV(l0, h0), od, 0, 0, 0);
    od = __builtin_amdgcn_mfma_f32_32x32x16_bf16(pa1, PKV(l1, h1), od, 0, 0, 0);
    od = __builtin_amdgcn_mfma_f32_32x32x16_bf16(pa2, PKV(l2, h2), od, 0, 0, 0);
    od = __builtin_amdgcn_mfma_f32_32x32x16_bf16(pa3, PKV(l3, h3), od, 0, 0, 0);
    if (MLA_PRIO) __builtin_amdgcn_s_setprio(0);
}

__device__ __forceinline__ void kfrag_load(bf16x8 (&kf)[12], const char* Ks, int r32, int hi) {
#pragma unroll
    for (int d0 = 0; d0 < 6; ++d0) { const int cb = (d0 * 16 + hi * 8) * 2;
        kf[2 * d0] = *reinterpret_cast<const bf16x8*>(Ks + KSWZ(r32, cb)); kf[2 * d0 + 1] = *reinterpret_cast<const bf16x8*>(Ks + KSWZ(32 + r32, cb)); }
}
__device__ __forceinline__ void qk_mma(f32x16& p0, f32x16& p1, const bf16x8 (&kf)[12], const bf16x8* qr, const f32x16& negm) {
    if (MLA_PRIO) __builtin_amdgcn_s_setprio(1);
    p0 = __builtin_amdgcn_mfma_f32_32x32x16_bf16(kf[0], qr[0], MLA_NEGM ? negm : f32x16{}, 0, 0, 0); p1 = __builtin_amdgcn_mfma_f32_32x32x16_bf16(kf[1], qr[0], MLA_NEGM ? negm : f32x16{}, 0, 0, 0);
#pragma unroll
    for (int d0 = 1; d0 < 6; ++d0) { p0 = __builtin_amdgcn_mfma_f32_32x32x16_bf16(kf[2 * d0], qr[d0], p0, 0, 0, 0); p1 = __builtin_amdgcn_mfma_f32_32x32x16_bf16(kf[2 * d0 + 1], qr[d0], p1, 0, 0, 0); }
    if (MLA_PRIO) __builtin_amdgcn_s_setprio(0);
}
template <int D0> __device__ __forceinline__ void vfrag_load_h(s16x4 (&vl)[4], s16x4 (&vh)[4], int vb) {
    vl[0] = tr_read<v_rd_off(D0, 0, 0)>(vb); vh[0] = tr_read<v_rd_off(D0, 0, 1)>(vb); vl[1] = tr_read<v_rd_off(D0, 1, 0)>(vb); vh[1] = tr_read<v_rd_off(D0, 1, 1)>(vb);
    vl[2] = tr_read<v_rd_off(D0, 2, 0)>(vb); vh[2] = tr_read<v_rd_off(D0, 2, 1)>(vb); vl[3] = tr_read<v_rd_off(D0, 3, 0)>(vb); vh[3] = tr_read<v_rd_off(D0, 3, 1)>(vb);
}
__device__ __forceinline__ void pv_mma_h(f32x16& od, const s16x4 (&vl)[4], const s16x4 (&vh)[4], bf16x8 pa0, bf16x8 pa1, bf16x8 pa2, bf16x8 pa3) {
    if (MLA_PRIO) __builtin_amdgcn_s_setprio(1);
    od = __builtin_amdgcn_mfma_f32_32x32x16_bf16(pa0, PKV(vl[0], vh[0]), od, 0, 0, 0);
    od = __builtin_amdgcn_mfma_f32_32x32x16_bf16(pa1, PKV(vl[1], vh[1]), od, 0, 0, 0);
    od = __builtin_amdgcn_mfma_f32_32x32x16_bf16(pa2, PKV(vl[2], vh[2]), od, 0, 0, 0);
    od = __builtin_amdgcn_mfma_f32_32x32x16_bf16(pa3, PKV(vl[3], vh[3]), od, 0, 0, 0);
    if (MLA_PRIO) __builtin_amdgcn_s_setprio(0);
}
#if MLA_STEP_MODE == 0
#define MLA_STEP(PC0, PC1, PP0, PP1, ALP, ALC) do { \
    STAMP_T(tq0); qkt96n(PC0, PC1, K_lds + sc * SHM_K, qr, negm, r32, hi); STAMP_T(tq1); STAMP_ACC(1, tq0, tq1); \
    finishSM(PP0, PP1, ALP, l_reg, pa0, pa1, pa2, pa3); SBAR(); STAMP_T(tq0); STAMP_ACC(2, tq1, tq0); \
    { const int vb_ = vb0 + sp * SHM_V; pv_one_p<0>(o[0], vb_, pa0, pa1, pa2, pa3); pv_one_p<1>(o[1], vb_, pa0, pa1, pa2, pa3); } STAMP_T(tq1); STAMP_ACC(3, tq0, tq1); \
    partialSM2<false>(PC0, PC1, m_reg, negm, ALC, exact); RESC(ALC); STAMP_T(tq0); STAMP_ACC(4, tq1, tq0); } while (0)
#elif MLA_STEP_MODE == 2
  \
#define SGB(mask, n) __builtin_amdgcn_sched_group_barrier(mask, n, 0)
#define MLA_STEP(PC0, PC1, PP0, PP1, ALP, ALC) do { \
    { const char* Ks_ = K_lds + sc * SHM_K; \
      _Pragma("unroll") for (int d0 = 0; d0 < 6; ++d0) { const int cb = (d0 * 16 + hi * 8) * 2; \
        const bf16x8 b0 = *reinterpret_cast<const bf16x8*>(Ks_ + KSWZ(r32, cb)); const bf16x8 b1 = *reinterpret_cast<const bf16x8*>(Ks_ + KSWZ(32 + r32, cb)); \
        if (d0 == 0) { PC0 = __builtin_amdgcn_mfma_f32_32x32x16_bf16(b0, qr[0], negm, 0, 0, 0); PC1 = __builtin_amdgcn_mfma_f32_32x32x16_bf16(b1, qr[0], negm, 0, 0, 0); } \
        else { PC0 = __builtin_amdgcn_mfma_f32_32x32x16_bf16(b0, qr[d0], PC0, 0, 0, 0); PC1 = __builtin_amdgcn_mfma_f32_32x32x16_bf16(b1, qr[d0], PC1, 0, 0, 0); } } } \
    finishSM(PP0, PP1, ALP, l_reg, pa0, pa1, pa2, pa3); \
    SGB(0x100, 4); \
    _Pragma("unroll") for (int g_ = 0; g_ < 12; ++g_) { SGB(0x008, 1); SGB(0x100, 1); SGB(0x002, 7); } \
    SBAR(); \
    { const int vb_ = vb0 + sp * SHM_V; \
      const s16x4 l0 = tr_read<v_rd_off(0, 0, 0)>(vb_), h0 = tr_read<v_rd_off(0, 0, 1)>(vb_), l1 = tr_read<v_rd_off(0, 1, 0)>(vb_), h1 = tr_read<v_rd_off(0, 1, 1)>(vb_); \
      const s16x4 l2 = tr_read<v_rd_off(0, 2, 0)>(vb_), h2 = tr_read<v_rd_off(0, 2, 1)>(vb_), l3 = tr_read<v_rd_off(0, 3, 0)>(vb_), h3 = tr_read<v_rd_off(0, 3, 1)>(vb_); \
      const s16x4 l4 = tr_read<v_rd_off(1, 0, 0)>(vb_), h4 = tr_read<v_rd_off(1, 0, 1)>(vb_), l5 = tr_read<v_rd_off(1, 1, 0)>(vb_), h5 = tr_read<v_rd_off(1, 1, 1)>(vb_); \
      const s16x4 l6 = tr_read<v_rd_off(1, 2, 0)>(vb_), h6 = tr_read<v_rd_off(1, 2, 1)>(vb_), l7 = tr_read<v_rd_off(1, 3, 0)>(vb_), h7 = tr_read<v_rd_off(1, 3, 1)>(vb_); \
      asm volatile("s_waitcnt lgkmcnt(0)" ::: "memory"); SBAR(); \
      o[0] = __builtin_amdgcn_mfma_f32_32x32x16_bf16(pa0, PKV(l0, h0), o[0], 0, 0, 0); o[1] = __builtin_amdgcn_mfma_f32_32x32x16_bf16(pa0, PKV(l4, h4), o[1], 0, 0, 0); \
      o[0] = __builtin_amdgcn_mfma_f32_32x32x16_bf16(pa1, PKV(l1, h1), o[0], 0, 0, 0); o[1] = __builtin_amdgcn_mfma_f32_32x32x16_bf16(pa1, PKV(l5, h5), o[1], 0, 0, 0); \
      o[0] = __builtin_amdgcn_mfma_f32_32x32x16_bf16(pa2, PKV(l2, h2), o[0], 0, 0, 0); o[1] = __builtin_amdgcn_mfma_f32_32x32x16_bf16(pa2, PKV(l6, h6), o[1], 0, 0, 0); \
      o[0] = __builtin_amdgcn_mfma_f32_32x32x16_bf16(pa3, PKV(l3, h3), o[0], 0, 0, 0); o[1] = __builtin_amdgcn_mfma_f32_32x32x16_bf16(pa3, PKV(l7, h7), o[1], 0, 0, 0); \
      partialSM2<false>(PC0, PC1, m_reg, negm, ALC, exact); \
      _Pragma("unroll") for (int g_ = 0; g_ < 8; ++g_) { SGB(0x008, 1); SGB(0x002, 2); } \
      SBAR(); } \
    RESC(ALC); } while (0)
#else
#define KFH(dst, Ks_, D0) do { _Pragma("unroll") for (int d_ = 0; d_ < 3; ++d_) { const int cb_ = (((D0) + d_) * 16 + hi * 8) * 2; \
        dst[2 * d_] = *reinterpret_cast<const bf16x8*>((Ks_) + KSWZ(r32, cb_)); dst[2 * d_ + 1] = *reinterpret_cast<const bf16x8*>((Ks_) + KSWZ(32 + r32, cb_)); } } while (0)
#define MLA_STEP(PC0, PC1, PP0, PP1, ALP, ALC) do { \
    bf16x8 ka[6], kb[6]; s16x4 val[4], vah[4], vbl[4], vbh[4]; const int vb_ = vb0 + sp * SHM_V; const char* Ks_ = K_lds + sc * SHM_K; \
    KFH(ka, Ks_, 0); SBAR(); \
    finishSM(PP0, PP1, ALP, l_reg, pa0, pa1, pa2, pa3); SBAR(); \
    KFH(kb, Ks_, 3); SBAR(); \
    if (exact) { PC0 = __builtin_amdgcn_mfma_f32_32x32x16_bf16(ka[0], qr[0], negm, 0, 0, 0); PC1 = __builtin_amdgcn_mfma_f32_32x32x16_bf16(ka[1], qr[0], negm, 0, 0, 0); } \
    else { PC0 = __builtin_amdgcn_mfma_f32_32x32x16_bf16(ka[0], qr[0], negm, 0, 0, 0); PC1 = __builtin_amdgcn_mfma_f32_32x32x16_bf16(ka[1], qr[0], negm, 0, 0, 0); } \
    PC0 = __builtin_amdgcn_mfma_f32_32x32x16_bf16(ka[2], qr[1], PC0, 0, 0, 0); PC1 = __builtin_amdgcn_mfma_f32_32x32x16_bf16(ka[3], qr[1], PC1, 0, 0, 0); \
    PC0 = __builtin_amdgcn_mfma_f32_32x32x16_bf16(ka[4], qr[2], PC0, 0, 0, 0); PC1 = __builtin_amdgcn_mfma_f32_32x32x16_bf16(ka[5], qr[2], PC1, 0, 0, 0); SBAR(); \
    vfrag_load_h<0>(val, vah, vb_); SBAR(); \
    PC0 = __builtin_amdgcn_mfma_f32_32x32x16_bf16(kb[0], qr[3], PC0, 0, 0, 0); PC1 = __builtin_amdgcn_mfma_f32_32x32x16_bf16(kb[1], qr[3], PC1, 0, 0, 0); \
    PC0 = __builtin_amdgcn_mfma_f32_32x32x16_bf16(kb[2], qr[4], PC0, 0, 0, 0); PC1 = __builtin_amdgcn_mfma_f32_32x32x16_bf16(kb[3], qr[4], PC1, 0, 0, 0); \
    PC0 = __builtin_amdgcn_mfma_f32_32x32x16_bf16(kb[4], qr[5], PC0, 0, 0, 0); PC1 = __builtin_amdgcn_mfma_f32_32x32x16_bf16(kb[5], qr[5], PC1, 0, 0, 0); SBAR(); \
    vfrag_load_h<1>(vbl, vbh, vb_); SBAR(); \
    asm volatile("s_waitcnt lgkmcnt(8)" ::: "memory"); SBAR(); \
    pv_mma_h(o[0], val, vah, pa0, pa1, pa2, pa3); SBAR(); \
    asm volatile("s_waitcnt lgkmcnt(0)" ::: "memory"); SBAR(); \
    pv_mma_h(o[1], vbl, vbh, pa0, pa1, pa2, pa3); SBAR(); \
    partialSM2<false>(PC0, PC1, m_reg, negm, ALC, exact); RESC(ALC); } while (0)
#endif

__device__ __forceinline__ void mla_unit_v2(int wv, int bh, int qb, const unsigned short* __restrict__ Q, const unsigned short* __restrict__ KN, const unsigned short* __restrict__ KR,
                                            const unsigned short* __restrict__ V, unsigned short* __restrict__ CAT, const float* __restrict__ KMX, char* lds, unsigned long long* STAMPS = nullptr) {
    const int wid = wv, lane = gm::lane_now(), tid = wid * 64 + lane, r32 = lane & 31, hi = lane >> 5;
    const int b = bh >> 3, h = bh & 7;
    char* K_lds = lds + M2_K; char* V_lds = lds + M2_V;
    float* wsf = (float*)(lds + M2_WS) + wid * 64; float* li_l = wsf; float* al_l = wsf + 32;
    float m_reg = 0.f, l_reg = 0; f32x16 o[2] = {}; bf16x8 qr[6]; f32x16 negm = f32x16{};
    const size_t bhS = (size_t)bh * S; const int q0 = qb * 256;
    const unsigned short* Qw = Q + (bhS + q0 + wid * 32 + r32) * 96 + hi * 8;
#pragma unroll
    for (int d0 = 0; d0 < 6; ++d0) qr[d0] = *reinterpret_cast<const bf16x8*>(Qw + d0 * 16);
    bool exact = true;
    if (MLA_STATIC) { float q2 = 0.f;
#pragma unroll
      for (int d0 = 0; d0 < 6; ++d0)
#pragma unroll
          for (int j = 0; j < 8; ++j) { const float x = __uint_as_float((unsigned)(unsigned short)qr[d0][j] << 16); q2 += x * x; }
      { auto rr = __builtin_amdgcn_permlane32_swap(__float_as_uint(q2), __float_as_uint(q2), false, false); q2 = __uint_as_float(rr[0]) + __uint_as_float(rr[1]); }
      const float k2 = KMX[(b * 8 + h) * 2] + KMX[(b * 8 + h) * 2 + 1] + KMX[32 + b];
      const float ms = 1.01f * sqrtf(q2 * k2);
      exact = wg_or(!(ms <= MLA_STATIC_THR), (unsigned*)(lds + 147456 - 512), wid, lane);
      if (!exact) { m_reg = ms;
#pragma unroll
          for (int r = 0; r < 16; ++r) negm[r] = -ms; } }
    const int srow = tid >> 3, sch = tid & 7, rrow = (tid & 255) >> 2, rch = tid & 3;
    const char* kn_u = (const char*)(KN + bhS * 64); const char* v_u = (const char*)(V + bhS * 64); const char* kr_u = (const char*)(KR + (size_t)b * S * 32);
    const unsigned kn_off = (unsigned)(srow * 64 + sch * 8) * 2u, kr_off = (unsigned)(rrow * 32 + rch * 8) * 2u;
    const int kst = KSWZ(srow, sch * 16), krst = KSWZ(rrow, (8 + rch) * 16), vst = v_st(srow, sch * 8);
    const int vb0 = (int)(uintptr_t)V_lds + v_rd_base(lane);
    bf16x8 s_kn[1], s_kr[1], s_v[1];
#define SLOAD(i, t) do { s_kn[i] = *reinterpret_cast<const bf16x8*>(kn_u + (size_t)(t) * 8192 + kn_off); s_kr[i] = *reinterpret_cast<const bf16x8*>(kr_u + (size_t)(t) * 4096 + kr_off); \
    s_v[i] = *reinterpret_cast<const bf16x8*>(v_u + (size_t)(t) * 8192 + kn_off); } while (0)
#define SWRITE(sl, i) do { *(bf16x8*)(K_lds + (sl) * SHM_K + kst) = s_kn[i]; if (tid < 256) *(bf16x8*)(K_lds + (sl) * SHM_K + krst) = s_kr[i]; *(bf16x8*)(V_lds + (sl) * SHM_V + vst) = s_v[i]; } while (0)
#define SWAIT() asm volatile("s_waitcnt vmcnt(0)" ::: "memory")
#define RESC(a) do { if (exact && __any((a) < 1.f)) { if (hi == 0) al_l[r32] = (a); asm volatile("s_waitcnt lgkmcnt(0)" ::: "memory"); \
    _Pragma("unroll") for (int d = 0; d < 2; ++d) _Pragma("unroll") for (int r = 0; r < 16; ++r) o[d][r] *= al_l[crow(r, hi)]; } } while (0)
#define ROT3(x) ((x) == 2 ? 0 : (x) + 1)
    f32x16 pA0, pA1, pB0, pB1; float alA, alB; bf16x8 pa0, pa1, pa2, pa3; constexpr int NT = S / 64;
#if MLA_STAMP
    unsigned long long st_acc[8] = {0, 0, 0, 0, 0, 0, 0, 0}, tq0 = 0, tq1 = 0, ts0 = 0, ts1 = 0, tu0 = 0; STAMP_T(tu0);
#endif
    SLOAD(0, 0);
    SWAIT(); SWRITE(0, 0); SLOAD(0, 1);
    __syncthreads();
    qkt96n(pA0, pA1, K_lds, qr, negm, r32, hi); if (exact) partialSM2<true>(pA0, pA1, m_reg, negm, alA); else partialSM2<false>(pA0, pA1, m_reg, negm, alA, false);
    SWAIT(); SWRITE(1, 0); SLOAD(0, 2);
    __syncthreads();
    int sp = 0, sc = 1, sn = 2;
    for (int j = 1; j + 1 < NT; j += 2) {
        if (!MLA_PROBE_NOSTAGE) { SWAIT(); SWRITE(sn, 0); if (j + 2 < NT) SLOAD(0, j + 2); }
        SBAR(); MLA_STEP(pB0, pB1, pA0, pA1, alA, alB);
        __syncthreads();
        sp = sc; sc = sn; sn = ROT3(sn);
        if (!MLA_PROBE_NOSTAGE) { SWAIT(); SWRITE(sn, 0); if (j + 3 < NT) SLOAD(0, j + 3); }
        SBAR(); MLA_STEP(pA0, pA1, pB0, pB1, alB, alA);
        __syncthreads();
        sp = sc; sc = sn; sn = ROT3(sn);
    }
    SBAR(); MLA_STEP(pB0, pB1, pA0, pA1, alA, alB);
    finishSM(pB0, pB1, alB, l_reg, pa0, pa1, pa2, pa3); SBAR();
    { const int vb = vb0 + sc * SHM_V; pv_one_p<0>(o[0], vb, pa0, pa1, pa2, pa3); pv_one_p<1>(o[1], vb, pa0, pa1, pa2, pa3); }
    if (hi == 0) li_l[r32] = l_reg; asm volatile("s_waitcnt lgkmcnt(0)" ::: "memory");
    float rli[16];
#pragma unroll
    for (int r = 0; r < 16; ++r) rli[r] = __builtin_amdgcn_rcpf(li_l[crow(r, hi)]);
    unsigned short* stg = (unsigned short*)(lds + M2_OST) + wid * 2048;
    unsigned short* dst = CAT + ((size_t)b * S + q0 + wid * 32) * 1024 + h * 64;
    store_o_tile(o, rli, stg, dst, [](int row) { return (size_t)row * 1024; }, lane);
    asm volatile("s_waitcnt vmcnt(0)" ::: "memory");
#if MLA_STAMP
    { unsigned long long tu1; STAMP_T(tu1); st_acc[6] = tu1 - tu0;
      if (blockIdx.x == 0 && wid == MLA_STAMP_WAVE && lane == 0 && STAMPS) {
#pragma unroll
          for (int i = 0; i < 8; ++i) STAMPS[i] = st_acc[i]; } }
#endif
    __syncthreads();
#undef SLOAD
#undef SWRITE
#undef SWAIT
#undef RESC
#undef ROT3
}


__device__ __forceinline__ void finishSM_s(f32x16& p0, f32x16& p1, float& l_reg, bf16x8& pa0, bf16x8& pa1, bf16x8& pa2, bf16x8& pa3) {
#pragma unroll
    for (int r = 0; r < 16; ++r) p1[r] = __builtin_amdgcn_exp2f(p1[r]);
    float ps = 0;
#pragma unroll
    for (int r = 0; r < 16; ++r) ps += p0[r];
#pragma unroll
    for (int r = 0; r < 16; ++r) ps += p1[r];
    l_reg += ps;
    PK4(p0, 0, pa0); PK4(p0, 8, pa1); PK4(p1, 0, pa2); PK4(p1, 8, pa3);
}
__device__ __forceinline__ void exp_half(f32x16& p0) {
#pragma unroll
    for (int r = 0; r < 16; ++r) p0[r] = __builtin_amdgcn_exp2f(p0[r]);
}
__device__ __forceinline__ bool mla_unit_v5(int wv, int bh, int qb, const unsigned short* __restrict__ Q, const unsigned short* __restrict__ KN, const unsigned short* __restrict__ KR,
                                            const unsigned short* __restrict__ V, unsigned short* __restrict__ CAT, const float* __restrict__ KMX, char* lds) {
    const int wid = wv, lane = gm::lane_now(), tid = wid * 64 + lane, r32 = lane & 31, hi = lane >> 5;
    const int b = bh >> 3, h = bh & 7;
    char* K_lds = lds + M2_K; char* V_lds = lds + M2_V;
    float* wsf = (float*)(lds + M2_WS) + wid * 64; float* li_l = wsf;
    float l_reg = 0; f32x16 o[2] = {}; bf16x8 qr[6];
    const size_t bhS = (size_t)bh * S; const int q0 = qb * 256;
    const unsigned short* Qw = Q + (bhS + q0 + wid * 32 + r32) * 96 + hi * 8;
#pragma unroll
    for (int d0 = 0; d0 < 6; ++d0) qr[d0] = *reinterpret_cast<const bf16x8*>(Qw + d0 * 16);
    f32x16 negm;
    { float q2 = 0.f;
#pragma unroll
      for (int d0 = 0; d0 < 6; ++d0)
#pragma unroll
          for (int j = 0; j < 8; ++j) { const float x = __uint_as_float((unsigned)(unsigned short)qr[d0][j] << 16); q2 += x * x; }
      { auto rr = __builtin_amdgcn_permlane32_swap(__float_as_uint(q2), __float_as_uint(q2), false, false); q2 = __uint_as_float(rr[0]) + __uint_as_float(rr[1]); }
      const float k2 = KMX[(b * 8 + h) * 2] + KMX[(b * 8 + h) * 2 + 1] + KMX[32 + b];
      const float m = 1.01f * sqrtf(q2 * k2);
#pragma unroll
      for (int r = 0; r < 16; ++r) negm[r] = -m; }
    const int srow = tid >> 3, sch = tid & 7, rrow = (tid & 255) >> 2, rch = tid & 3;
    const char* kn_u = (const char*)(KN + bhS * 64); const char* v_u = (const char*)(V + bhS * 64); const char* kr_u = (const char*)(KR + (size_t)b * S * 32);
    const unsigned kn_off = (unsigned)(srow * 64 + sch * 8) * 2u, kr_off = (unsigned)(rrow * 32 + rch * 8) * 2u;
    const int kst = KSWZ(srow, sch * 16), krst = KSWZ(rrow, (8 + rch) * 16), vst = v_st(srow, sch * 8);
    const int vb0 = (int)(uintptr_t)V_lds + v_rd_base(lane);
    bf16x8 s_kn, s_kr, s_v;
#define SLOAD(t) do { s_kn = *reinterpret_cast<const bf16x8*>(kn_u + (size_t)(t) * 8192 + kn_off); s_kr = *reinterpret_cast<const bf16x8*>(kr_u + (size_t)(t) * 4096 + kr_off); \
    s_v = *reinterpret_cast<const bf16x8*>(v_u + (size_t)(t) * 8192 + kn_off); } while (0)
#define SWRITE(sl) do { *(bf16x8*)(K_lds + (sl) * SHM_K + kst) = s_kn; if (tid < 256) *(bf16x8*)(K_lds + (sl) * SHM_K + krst) = s_kr; *(bf16x8*)(V_lds + (sl) * SHM_V + vst) = s_v; } while (0)
#define SWAIT() asm volatile("s_waitcnt vmcnt(0)" ::: "memory")
#define ROT3(x) ((x) == 2 ? 0 : (x) + 1)
#define STEP5(PC0, PC1, PP0, PP1) do { \
    qkt96n(PC0, PC1, K_lds + sc * SHM_K, qr, negm, r32, hi); \
    finishSM_s(PP0, PP1, l_reg, pa0, pa1, pa2, pa3); SBAR(); \
    { const int vb_ = vb0 + sp * SHM_V; pv_one_p<0>(o[0], vb_, pa0, pa1, pa2, pa3); pv_one_p<1>(o[1], vb_, pa0, pa1, pa2, pa3); } \
    exp_half(PC0); } while (0)
    f32x16 pA0, pA1, pB0, pB1; bf16x8 pa0, pa1, pa2, pa3; constexpr int NT = S / 64;
    SLOAD(0);
    SWAIT(); SWRITE(0); SLOAD(1);
    __syncthreads();
    qkt96n(pA0, pA1, K_lds, qr, negm, r32, hi); exp_half(pA0);
    SWAIT(); SWRITE(1); SLOAD(2);
    __syncthreads();
    int sp = 0, sc = 1, sn = 2;
    for (int j = 1; j + 1 < NT; j += 2) {
        SWAIT(); SWRITE(sn); if (j + 2 < NT) SLOAD(j + 2);
        SBAR(); STEP5(pB0, pB1, pA0, pA1);
        __syncthreads();
        sp = sc; sc = sn; sn = ROT3(sn);
        SWAIT(); SWRITE(sn); if (j + 3 < NT) SLOAD(j + 3);
        SBAR(); STEP5(pA0, pA1, pB0, pB1);
        __syncthreads();
        sp = sc; sc = sn; sn = ROT3(sn);
    }
    SBAR(); STEP5(pB0, pB1, pA0, pA1);
    finishSM_s(pB0, pB1, l_reg, pa0, pa1, pa2, pa3); SBAR();
    { const int vb = vb0 + sc * SHM_V; pv_one_p<0>(o[0], vb, pa0, pa1, pa2, pa3); pv_one_p<1>(o[1], vb, pa0, pa1, pa2, pa3); }
    { auto rr = __builtin_amdgcn_permlane32_swap(__float_as_uint(l_reg), __float_as_uint(l_reg), false, false); l_reg = __uint_as_float(rr[0]) + __uint_as_float(rr[1]); }
    const bool bad = !(l_reg > 1e-30f);
    if (hi == 0) li_l[r32] = l_reg; asm volatile("s_waitcnt lgkmcnt(0)" ::: "memory");
    float rli[16];
#pragma unroll
    for (int r = 0; r < 16; ++r) rli[r] = __builtin_amdgcn_rcpf(li_l[crow(r, hi)]);
    unsigned short* stg = (unsigned short*)(lds + M2_OST) + wid * 2048;
    unsigned short* dst = CAT + ((size_t)b * S + q0 + wid * 32) * 1024 + h * 64;
    store_o_tile(o, rli, stg, dst, [](int row) { return (size_t)row * 1024; }, lane);
    asm volatile("s_waitcnt vmcnt(0)" ::: "memory");
    const int anybad = wg_or(bad, (unsigned*)(lds + 147456 - 512), wid, lane) ? 1 : 0;
    return anybad != 0;
#undef SLOAD
#undef SWRITE
#undef SWAIT
#undef ROT3
#undef STEP5
}

constexpr int M4_K = 0, M4_V = 4 * SHM_K, M4_WS = M4_V + 4 * SHM_V, M4_OST = M4_WS + 8 * 256;
template <bool FIRST> __device__ __forceinline__ void softmax_full(f32x16& p0, f32x16& p1, float& m_reg, f32x16& negm, float& l_reg, float& alpha, bf16x8& pa0, bf16x8& pa1, bf16x8& pa2, bf16x8& pa3, bool exact) {
    if (exact) partialSM2<FIRST>(p0, p1, m_reg, negm, alpha, true); else partialSM2<false>(p0, p1, m_reg, negm, alpha, false);
    finishSM(p0, p1, alpha, l_reg, pa0, pa1, pa2, pa3);
}
__device__ __forceinline__ void mla_unit_v4(int wv, int bh, int qb, const unsigned short* __restrict__ Q, const unsigned short* __restrict__ KN, const unsigned short* __restrict__ KR,
                                            const unsigned short* __restrict__ V, unsigned short* __restrict__ CAT, const float* __restrict__ KMX, char* lds, unsigned long long* STAMPS = nullptr) {
    const int wid = wv, lane = gm::lane_now(), tid = wid * 64 + lane, r32 = lane & 31, hi = lane >> 5;
    const int b = bh >> 3, h = bh & 7; const bool halfB = wid >= 4;
    char* K_lds = lds + M4_K; char* V_lds = lds + M4_V;
    float* wsf = (float*)(lds + M4_WS) + wid * 64; float* li_l = wsf; float* al_l = wsf + 32;
    float m_reg = 0.f, l_reg = 0; f32x16 o[2] = {}; bf16x8 qr[6]; f32x16 negm = f32x16{};
    const size_t bhS = (size_t)bh * S; const int q0 = qb * 256;
    const unsigned short* Qw = Q + (bhS + q0 + wid * 32 + r32) * 96 + hi * 8;
#pragma unroll
    for (int d0 = 0; d0 < 6; ++d0) qr[d0] = *reinterpret_cast<const bf16x8*>(Qw + d0 * 16);
    bool exact = true;
    if (MLA_STATIC) { float q2 = 0.f;
#pragma unroll
      for (int d0 = 0; d0 < 6; ++d0)
#pragma unroll
          for (int j = 0; j < 8; ++j) { const float x = __uint_as_float((unsigned)(unsigned short)qr[d0][j] << 16); q2 += x * x; }
      { auto rr = __builtin_amdgcn_permlane32_swap(__float_as_uint(q2), __float_as_uint(q2), false, false); q2 = __uint_as_float(rr[0]) + __uint_as_float(rr[1]); }
      const float k2 = KMX[(b * 8 + h) * 2] + KMX[(b * 8 + h) * 2 + 1] + KMX[32 + b];
      const float ms = 1.01f * sqrtf(q2 * k2);
      exact = wg_or(!(ms <= MLA_STATIC_THR), (unsigned*)(lds + 147456 - 512), wid, lane);
      if (!exact) { m_reg = ms;
#pragma unroll
          for (int r = 0; r < 16; ++r) negm[r] = -ms; } }
    const int srow = tid >> 3, sch = tid & 7, rrow = (tid & 255) >> 2, rch = tid & 3;
    const char* kn_u = (const char*)(KN + bhS * 64); const char* v_u = (const char*)(V + bhS * 64); const char* kr_u = (const char*)(KR + (size_t)b * S * 32);
    const unsigned kn_off = (unsigned)(srow * 64 + sch * 8) * 2u, kr_off = (unsigned)(rrow * 32 + rch * 8) * 2u;
    const int kst = KSWZ(srow, sch * 16), krst = KSWZ(rrow, (8 + rch) * 16), vst = v_st(srow, sch * 8);
    const int vb0 = (int)(uintptr_t)V_lds + v_rd_base(lane);
    bf16x8 s_kn, s_kr, s_v;
#define SLOAD(t) do { s_kn = *reinterpret_cast<const bf16x8*>(kn_u + (size_t)(t) * 8192 + kn_off); s_kr = *reinterpret_cast<const bf16x8*>(kr_u + (size_t)(t) * 4096 + kr_off); \
    s_v = *reinterpret_cast<const bf16x8*>(v_u + (size_t)(t) * 8192 + kn_off); } while (0)
#define SWRITE(sl) do { *(bf16x8*)(K_lds + (sl) * SHM_K + kst) = s_kn; if (tid < 256) *(bf16x8*)(K_lds + (sl) * SHM_K + krst) = s_kr; *(bf16x8*)(V_lds + (sl) * SHM_V + vst) = s_v; } while (0)
#define SWAIT() asm volatile("s_waitcnt vmcnt(0)" ::: "memory")
#define RESC(a) do { if (exact && __any((a) < 1.f)) { if (hi == 0) al_l[r32] = (a); asm volatile("s_waitcnt lgkmcnt(0)" ::: "memory"); \
    _Pragma("unroll") for (int d = 0; d < 2; ++d) _Pragma("unroll") for (int r = 0; r < 16; ++r) o[d][r] *= al_l[crow(r, hi)]; } } while (0)
#define RAWBAR() do { asm volatile("" ::: "memory"); __builtin_amdgcn_s_barrier(); asm volatile("" ::: "memory"); } while (0)
    f32x16 p0, p1; float al; bf16x8 pa0, pa1, pa2, pa3; bf16x8 kf[12]; constexpr int NT = S / 64;
#if MLA_STAMP
    unsigned long long st_acc[8] = {0, 0, 0, 0, 0, 0, 0, 0}, tq0 = 0, tq1 = 0, tu0 = 0; STAMP_T(tu0);
#endif
    SLOAD(0); SWAIT(); SWRITE(0); SLOAD(1); SWAIT(); SWRITE(1); SLOAD(2);
    asm volatile("s_waitcnt lgkmcnt(0)" ::: "memory"); RAWBAR();
    if (halfB) RAWBAR();
    kfrag_load(kf, K_lds, r32, hi); SBAR();
    qk_mma(p0, p1, kf, qr, negm); SBAR();
    asm volatile("s_waitcnt lgkmcnt(0)" ::: "memory"); RAWBAR();
    softmax_full<true>(p0, p1, m_reg, negm, l_reg, al, pa0, pa1, pa2, pa3, exact); SBAR();
    SWAIT(); SWRITE(2); SLOAD(3); SBAR();
    kfrag_load(kf, K_lds + SHM_K, r32, hi); SBAR();
    asm volatile("s_waitcnt lgkmcnt(12)" ::: "memory"); RAWBAR();
    int sp = 0, sc = 1, sw = 3;
    for (int t = 1; t < NT; ++t) {
        STAMP_T(tq0);
        { s16x4 val[4], vah[4], vbl[4], vbh[4]; const int vb_ = vb0 + sp * SHM_V;
          vfrag_load_h<0>(val, vah, vb_); SBAR();
          qk_mma(p0, p1, kf, qr, negm); SBAR();
          vfrag_load_h<1>(vbl, vbh, vb_); SBAR();
          asm volatile("s_waitcnt lgkmcnt(8)" ::: "memory"); SBAR();
          pv_mma_h(o[0], val, vah, pa0, pa1, pa2, pa3); SBAR();
          asm volatile("s_waitcnt lgkmcnt(0)" ::: "memory"); SBAR();
          pv_mma_h(o[1], vbl, vbh, pa0, pa1, pa2, pa3); SBAR(); }
        STAMP_T(tq1); STAMP_ACC(1, tq0, tq1);
        RAWBAR();
        STAMP_T(tq0); STAMP_ACC(2, tq1, tq0);
        if (t + 2 < NT) { SWAIT(); SWRITE(sw); if (t + 3 < NT) SLOAD(t + 3); } SBAR();
        softmax_full<false>(p0, p1, m_reg, negm, l_reg, al, pa0, pa1, pa2, pa3, exact); RESC(al); SBAR();
        sp = sc; sc = (sc + 1) & 3; sw = (sw + 1) & 3;
        if (t + 1 < NT) { kfrag_load(kf, K_lds + sc * SHM_K, r32, hi); SBAR(); }
        STAMP_T(tq1); STAMP_ACC(3, tq0, tq1);
        asm volatile("s_waitcnt lgkmcnt(12)" ::: "memory"); RAWBAR();
        STAMP_T(tq0); STAMP_ACC(4, tq1, tq0);
    }
    { s16x4 val[4], vah[4], vbl[4], vbh[4]; const int vb_ = vb0 + sp * SHM_V;
      vfrag_load_h<0>(val, vah, vb_); vfrag_load_h<1>(vbl, vbh, vb_); SBAR();
      asm volatile("s_waitcnt lgkmcnt(0)" ::: "memory"); SBAR();
      pv_mma_h(o[0], val, vah, pa0, pa1, pa2, pa3); pv_mma_h(o[1], vbl, vbh, pa0, pa1, pa2, pa3); SBAR(); }
    if (!halfB) RAWBAR();
    if (hi == 0) li_l[r32] = l_reg; asm volatile("s_waitcnt lgkmcnt(0)" ::: "memory");
    float rli[16];
#pragma unroll
    for (int r = 0; r < 16; ++r) rli[r] = __builtin_amdgcn_rcpf(li_l[crow(r, hi)]);
    unsigned short* stg = (unsigned short*)(lds + M4_OST) + wid * 2048;
    unsigned short* dst = CAT + ((size_t)b * S + q0 + wid * 32) * 1024 + h * 64;
    store_o_tile(o, rli, stg, dst, [](int row) { return (size_t)row * 1024; }, lane);
    asm volatile("s_waitcnt vmcnt(0)" ::: "memory");
#if MLA_STAMP
    { unsigned long long tu1; STAMP_T(tu1); st_acc[6] = tu1 - tu0;
      if (blockIdx.x == 0 && wid == MLA_STAMP_WAVE && lane == 0 && STAMPS) {
#pragma unroll
          for (int i = 0; i < 8; ++i) STAMPS[i] = st_acc[i]; } }
#endif
    __syncthreads();
#undef SLOAD
#undef SWRITE
#undef SWAIT
#undef RESC
#undef RAWBAR
}


constexpr int M6_K = 0, M6_V = 4 * SHM_K, M6_WS = M6_V + 4 * SHM_V, M6_OST = M6_WS + 8 * 256;
#define KLD3(dst, Ks_, D0) do { _Pragma("unroll") for (int d_ = 0; d_ < 3; ++d_) { const int cb_ = (((D0) + d_) * 16 + hi * 8) * 2; \
        dst[2 * d_] = *reinterpret_cast<const bf16x8*>((Ks_) + KSWZ(r32, cb_)); dst[2 * d_ + 1] = *reinterpret_cast<const bf16x8*>((Ks_) + KSWZ(32 + r32, cb_)); } } while (0)
#define MF32(A, B, C) __builtin_amdgcn_mfma_f32_32x32x16_bf16(A, B, C, 0, 0, 0)
#define QK_ADD(DST, KF, QF, CIN, PPX, B) do { DST = MF32(KF, QF, CIN); s0 += PPX[B]; s1 += PPX[B + 1]; s2 += PPX[B + 2]; s3 += PPX[B + 3]; SBAR(); } while (0)
#define QK_PK(DST, KF, QF, CIN, PPX, B, OUT) do { DST = MF32(KF, QF, CIN); PK4(PPX, B, OUT); SBAR(); } while (0)
__device__ __forceinline__ void mla_unit_v6(int wv, int bh, int qb, const unsigned short* __restrict__ Q, const unsigned short* __restrict__ KN, const unsigned short* __restrict__ KR,
                                            const unsigned short* __restrict__ V, unsigned short* __restrict__ CAT, const float* __restrict__ KMX, char* lds) {
    const int wid = wv, lane = gm::lane_now(), tid = wid * 64 + lane, r32 = lane & 31, hi = lane >> 5;
    const int b = bh >> 3, h = bh & 7; const bool halfB = wid >= 4;
    char* K_lds = lds + M6_K; char* V_lds = lds + M6_V;
    float* wsf = (float*)(lds + M6_WS) + wid * 64; float* li_l = wsf; float* al_l = wsf + 32;
    float m_reg = 0.f, l_reg = 0; f32x16 o[2] = {}; bf16x8 qr[6]; f32x16 negm = f32x16{};
    const size_t bhS = (size_t)bh * S; const int q0 = qb * 256;
    const unsigned short* Qw = Q + (bhS + q0 + wid * 32 + r32) * 96 + hi * 8;
#pragma unroll
    for (int d0 = 0; d0 < 6; ++d0) qr[d0] = *reinterpret_cast<const bf16x8*>(Qw + d0 * 16);
    bool exact = true;
    if (MLA_STATIC) { float q2 = 0.f;
#pragma unroll
      for (int d0 = 0; d0 < 6; ++d0)
#pragma unroll
          for (int j = 0; j < 8; ++j) { const float x = __uint_as_float((unsigned)(unsigned short)qr[d0][j] << 16); q2 += x * x; }
      { auto rr = __builtin_amdgcn_permlane32_swap(__float_as_uint(q2), __float_as_uint(q2), false, false); q2 = __uint_as_float(rr[0]) + __uint_as_float(rr[1]); }
      const float k2 = KMX[(b * 8 + h) * 2] + KMX[(b * 8 + h) * 2 + 1] + KMX[32 + b];
      const float ms = 1.01f * sqrtf(q2 * k2);
      exact = wg_or(!(ms <= MLA_STATIC_THR), (unsigned*)(lds + 147456 - 512), wid, lane);
      if (!exact) { m_reg = ms;
#pragma unroll
          for (int r = 0; r < 16; ++r) negm[r] = -ms; } }
    const int srow = tid >> 3, sch = tid & 7, rrow = (tid & 255) >> 2, rch = tid & 3;
    const char* kn_u = (const char*)(KN + bhS * 64); const char* v_u = (const char*)(V + bhS * 64); const char* kr_u = (const char*)(KR + (size_t)b * S * 32);
    const unsigned kn_off = (unsigned)(srow * 64 + sch * 8) * 2u, kr_off = (unsigned)(rrow * 32 + rch * 8) * 2u;
    const int kst = KSWZ(srow, sch * 16), krst = KSWZ(rrow, (8 + rch) * 16), vst = v_st(srow, sch * 8);
    const int vb0 = (int)(uintptr_t)V_lds + v_rd_base(lane);
    bf16x8 s_kn, s_kr, s_v;
#define SLOAD(t) do { s_kn = *reinterpret_cast<const bf16x8*>(kn_u + (size_t)(t) * 8192 + kn_off); s_kr = *reinterpret_cast<const bf16x8*>(kr_u + (size_t)(t) * 4096 + kr_off); \
    s_v = *reinterpret_cast<const bf16x8*>(v_u + (size_t)(t) * 8192 + kn_off); } while (0)
#define SWRITE(sl) do { *(bf16x8*)(K_lds + (sl) * SHM_K + kst) = s_kn; if (tid < 256) *(bf16x8*)(K_lds + (sl) * SHM_K + krst) = s_kr; *(bf16x8*)(V_lds + (sl) * SHM_V + vst) = s_v; } while (0)
#define SWAIT() asm volatile("s_waitcnt vmcnt(0)" ::: "memory")
#define RESC(a) do { if (exact && __any((a) < 1.f)) { if (hi == 0) al_l[r32] = (a); asm volatile("s_waitcnt lgkmcnt(0)" ::: "memory"); l_reg *= (a); \
    _Pragma("unroll") for (int d = 0; d < 2; ++d) _Pragma("unroll") for (int r = 0; r < 16; ++r) o[d][r] *= al_l[crow(r, hi)]; } } while (0)
#define RAWBAR() do { asm volatile("" ::: "memory"); __builtin_amdgcn_s_barrier(); asm volatile("" ::: "memory"); } while (0)
#define EXP_TILE(P0, P1, FIRST_) do { float al_ = 1.f; \
        if (exact) { const float pmax = rowmax32b(P0, P1); \
            if ((FIRST_) || !__builtin_expect(__all(pmax <= THR), 1)) { const float dl = (FIRST_) ? pmax : fmaxf(pmax, 0.f); m_reg += dl; \
                _Pragma("unroll") for (int r = 0; r < 16; ++r) { P0[r] -= dl; P1[r] -= dl; } \
                _Pragma("unroll") for (int r = 0; r < 16; ++r) negm[r] = -m_reg; \
                if (!(FIRST_)) al_ = __builtin_amdgcn_exp2f(-dl); } } \
        _Pragma("unroll") for (int r = 0; r < 16; ++r) P0[r] = __builtin_amdgcn_exp2f(P0[r]); \
        _Pragma("unroll") for (int r = 0; r < 16; ++r) P1[r] = __builtin_amdgcn_exp2f(P1[r]); \
        RESC(al_); } while (0)
#define M_PART(PC0, PC1, PP0, PP1) do { \
        s16x4 val[4], vah[4], vbl[4], vbh[4]; const int vb_ = vb0 + sp * SHM_V; float s0 = 0.f, s1 = 0.f, s2 = 0.f, s3 = 0.f; \
        KLD3(kb, K_lds + sc * SHM_K, 3); SBAR(); \
        QK_ADD(PC0, ka[0], qr[0], negm, PP0, 0);  QK_ADD(PC1, ka[1], qr[0], negm, PP0, 4); \
        QK_ADD(PC0, ka[2], qr[1], PC0, PP0, 8);   QK_ADD(PC1, ka[3], qr[1], PC1, PP0, 12); \
        QK_ADD(PC0, ka[4], qr[2], PC0, PP1, 0);   QK_ADD(PC1, ka[5], qr[2], PC1, PP1, 4); \
        vfrag_load_h<0>(val, vah, vb_); vfrag_load_h<1>(vbl, vbh, vb_); SBAR(); \
        QK_ADD(PC0, kb[0], qr[3], PC0, PP1, 8);   QK_ADD(PC1, kb[1], qr[3], PC1, PP1, 12); \
        QK_PK(PC0, kb[2], qr[4], PC0, PP0, 0, pa0); QK_PK(PC1, kb[3], qr[4], PC1, PP0, 8, pa1); \
        QK_PK(PC0, kb[4], qr[5], PC0, PP1, 0, pa2); QK_PK(PC1, kb[5], qr[5], PC1, PP1, 8, pa3); \
        { float ps = (s0 + s1) + (s2 + s3); auto rr = __builtin_amdgcn_permlane32_swap(__float_as_uint(ps), __float_as_uint(ps), false, false); l_reg += __uint_as_float(rr[0]) + __uint_as_float(rr[1]); } \
        asm volatile("s_waitcnt lgkmcnt(0)" ::: "memory"); SBAR(); \
        pv_mma_h(o[0], val, vah, pa0, pa1, pa2, pa3); pv_mma_h(o[1], vbl, vbh, pa0, pa1, pa2, pa3); SBAR(); } while (0)
#define V_PART(PC0, PC1, t_) do { \
        if ((t_) + 2 < NT) { SWAIT(); SWRITE(sw); if ((t_) + 3 < NT) SLOAD((t_) + 3); } SBAR(); \
        EXP_TILE(PC0, PC1, false); SBAR(); \
        sp = sc; sc = (sc + 1) & 3; sw = (sw + 1) & 3; \
        if ((t_) + 1 < NT) { KLD3(ka, K_lds + sc * SHM_K, 0); SBAR(); } \
        asm volatile("s_waitcnt lgkmcnt(6)" ::: "memory"); RAWBAR(); } while (0)
    f32x16 pA0, pA1, pB0, pB1; bf16x8 pa0, pa1, pa2, pa3; bf16x8 ka[6], kb[6]; constexpr int NT = S / 64;
    SLOAD(0); SWAIT(); SWRITE(0); SLOAD(1); SWAIT(); SWRITE(1); SLOAD(2);
    asm volatile("s_waitcnt lgkmcnt(0)" ::: "memory"); RAWBAR();
    if (halfB) RAWBAR();
    KLD3(ka, K_lds, 0); KLD3(kb, K_lds, 3); SBAR();
    pA0 = MF32(ka[0], qr[0], negm); pA1 = MF32(ka[1], qr[0], negm); pA0 = MF32(ka[2], qr[1], pA0); pA1 = MF32(ka[3], qr[1], pA1); pA0 = MF32(ka[4], qr[2], pA0); pA1 = MF32(ka[5], qr[2], pA1);
    pA0 = MF32(kb[0], qr[3], pA0); pA1 = MF32(kb[1], qr[3], pA1); pA0 = MF32(kb[2], qr[4], pA0); pA1 = MF32(kb[3], qr[4], pA1); pA0 = MF32(kb[4], qr[5], pA0); pA1 = MF32(kb[5], qr[5], pA1); SBAR();
    asm volatile("s_waitcnt lgkmcnt(0)" ::: "memory"); RAWBAR();
    int sp = 0, sc = 0, sw = 2;
    SWAIT(); SWRITE(2); SLOAD(3); SBAR();
    EXP_TILE(pA0, pA1, true); SBAR();
    sp = 0; sc = 1; sw = 3;
    KLD3(ka, K_lds + SHM_K, 0); SBAR();
    asm volatile("s_waitcnt lgkmcnt(6)" ::: "memory"); RAWBAR();
    for (int t = 1; t + 1 < NT; t += 2) {
        M_PART(pB0, pB1, pA0, pA1); RAWBAR(); V_PART(pB0, pB1, t);
        M_PART(pA0, pA1, pB0, pB1); RAWBAR(); V_PART(pA0, pA1, t + 1);
    }
    M_PART(pB0, pB1, pA0, pA1); RAWBAR(); V_PART(pB0, pB1, NT - 1);
    { s16x4 val[4], vah[4], vbl[4], vbh[4]; const int vb_ = vb0 + sp * SHM_V; float ps = 0.f;
      vfrag_load_h<0>(val, vah, vb_); vfrag_load_h<1>(vbl, vbh, vb_); SBAR();
#pragma unroll
      for (int r = 0; r < 16; ++r) ps += pB0[r] + pB1[r];
      { auto rr = __builtin_amdgcn_permlane32_swap(__float_as_uint(ps), __float_as_uint(ps), false, false); l_reg += __uint_as_float(rr[0]) + __uint_as_float(rr[1]); }
      PK4(pB0, 0, pa0); PK4(pB0, 8, pa1); PK4(pB1, 0, pa2); PK4(pB1, 8, pa3);
      asm volatile("s_waitcnt lgkmcnt(0)" ::: "memory"); SBAR();
      pv_mma_h(o[0], val, vah, pa0, pa1, pa2, pa3); pv_mma_h(o[1], vbl, vbh, pa0, pa1, pa2, pa3); SBAR(); }
    if (!halfB) RAWBAR();
    if (hi == 0) li_l[r32] = l_reg; asm volatile("s_waitcnt lgkmcnt(0)" ::: "memory");
    float rli[16];
#pragma unroll
    for (int r = 0; r < 16; ++r) rli[r] = __builtin_amdgcn_rcpf(li_l[crow(r, hi)]);
    unsigned short* stg = (unsigned short*)(lds + M6_OST) + wid * 2048;
    unsigned short* dst = CAT + ((size_t)b * S + q0 + wid * 32) * 1024 + h * 64;
    store_o_tile(o, rli, stg, dst, [](int row) { return (size_t)row * 1024; }, lane);
    asm volatile("s_waitcnt vmcnt(0)" ::: "memory");
    __syncthreads();
#undef SLOAD
#undef SWRITE
#undef SWAIT
#undef RESC
#undef RAWBAR
#undef EXP_TILE
#undef M_PART
#undef V_PART
}


#define PV_EXP(OD, PA, VL, VH, PCX, B) do { OD = MF32(PA, PKV(VL, VH), OD); PCX[B] = __builtin_amdgcn_exp2f(PCX[B]); PCX[B + 1] = __builtin_amdgcn_exp2f(PCX[B + 1]); \
        PCX[B + 2] = __builtin_amdgcn_exp2f(PCX[B + 2]); PCX[B + 3] = __builtin_amdgcn_exp2f(PCX[B + 3]); asm volatile("" : "+v"(PCX)); SBAR(); } while (0)
__device__ __forceinline__ void mla_unit_v7(int wv, int bh, int qb, const unsigned short* __restrict__ Q, const unsigned short* __restrict__ KN, const unsigned short* __restrict__ KR,
                                            const unsigned short* __restrict__ V, unsigned short* __restrict__ CAT, const float* __restrict__ KMX, char* lds, unsigned long long* STAMPS = nullptr) {
    const int wid = wv, lane = gm::lane_now(), tid = wid * 64 + lane, r32 = lane & 31, hi = lane >> 5;
    const int b = bh >> 3, h = bh & 7;
    char* K_lds = lds + M6_K; char* V_lds = lds + M6_V;
    float* wsf = (float*)(lds + M6_WS) + wid * 64; float* li_l = wsf; float* al_l = wsf + 32;
    float m_reg = 0.f, l_reg = 0; f32x16 o[2] = {}; bf16x8 qr[6]; f32x16 negm = f32x16{};
    const size_t bhS = (size_t)bh * S; const int q0 = qb * 256;
    const unsigned short* Qw = Q + (bhS + q0 + wid * 32 + r32) * 96 + hi * 8;
#pragma unroll
    for (int d0 = 0; d0 < 6; ++d0) qr[d0] = *reinterpret_cast<const bf16x8*>(Qw + d0 * 16);
    bool exact = true;
    if (MLA_STATIC) { float q2 = 0.f;
#pragma unroll
      for (int d0 = 0; d0 < 6; ++d0)
#pragma unroll
          for (int j = 0; j < 8; ++j) { const float x = __uint_as_float((unsigned)(unsigned short)qr[d0][j] << 16); q2 += x * x; }
      { auto rr = __builtin_amdgcn_permlane32_swap(__float_as_uint(q2), __float_as_uint(q2), false, false); q2 = __uint_as_float(rr[0]) + __uint_as_float(rr[1]); }
      const float k2 = KMX[(b * 8 + h) * 2] + KMX[(b * 8 + h) * 2 + 1] + KMX[32 + b];
      const float ms = 1.01f * sqrtf(q2 * k2);
      exact = wg_or(!(ms <= MLA_STATIC_THR), (unsigned*)(lds + 147456 - 512), wid, lane);
      if (!exact) { m_reg = ms;
#pragma unroll
          for (int r = 0; r < 16; ++r) negm[r] = -ms; } }
    const int srow = tid >> 3, sch = tid & 7, rrow = (tid & 255) >> 2, rch = tid & 3;
    const char* kn_u = (const char*)(KN + bhS * 64); const char* v_u = (const char*)(V + bhS * 64); const char* kr_u = (const char*)(KR + (size_t)b * S * 32);
    const unsigned kn_off = (unsigned)(srow * 64 + sch * 8) * 2u, kr_off = (unsigned)(rrow * 32 + rch * 8) * 2u;
    const int kst = KSWZ(srow, sch * 16), krst = KSWZ(rrow, (8 + rch) * 16), vst = v_st(srow, sch * 8);
    const int vb0 = (int)(uintptr_t)V_lds + v_rd_base(lane);
    bf16x8 s_kn, s_kr, s_v;
#define SLOAD(t) do { s_kn = *reinterpret_cast<const bf16x8*>(kn_u + (size_t)(t) * 8192 + kn_off); s_kr = *reinterpret_cast<const bf16x8*>(kr_u + (size_t)(t) * 4096 + kr_off); \
    s_v = *reinterpret_cast<const bf16x8*>(v_u + (size_t)(t) * 8192 + kn_off); } while (0)
#define SWRITE(sl) do { *(bf16x8*)(K_lds + (sl) * SHM_K + kst) = s_kn; if (tid < 256) *(bf16x8*)(K_lds + (sl) * SHM_K + krst) = s_kr; *(bf16x8*)(V_lds + (sl) * SHM_V + vst) = s_v; } while (0)
#define SWAIT() asm volatile("s_waitcnt vmcnt(0)" ::: "memory")
#define RAWBAR() do { asm volatile("" ::: "memory"); __builtin_amdgcn_s_barrier(); asm volatile("" ::: "memory"); } while (0)
#define MAX_TILE(P0, P1, FIRST_, AL_) do { AL_ = 1.f; \
        if (V7_EXACT && exact) { const float pmax = rowmax32b(P0, P1); \
            if ((FIRST_) || !__builtin_expect(__all(pmax <= THR), 1)) { const float dl = (FIRST_) ? pmax : fmaxf(pmax, 0.f); m_reg += dl; \
                _Pragma("unroll") for (int r = 0; r < 16; ++r) { P0[r] -= dl; P1[r] -= dl; } \
                _Pragma("unroll") for (int r = 0; r < 16; ++r) negm[r] = -m_reg; \
                if (!(FIRST_)) AL_ = __builtin_amdgcn_exp2f(-dl); } } } while (0)
#define RESC7(a) do { if (V7_EXACT && exact && __any((a) < 1.f)) { if (hi == 0) al_l[r32] = (a); asm volatile("s_waitcnt lgkmcnt(0)" ::: "memory"); l_reg *= (a); \
    _Pragma("unroll") for (int d = 0; d < 2; ++d) _Pragma("unroll") for (int r = 0; r < 16; ++r) o[d][r] *= al_l[crow(r, hi)]; } } while (0)
#define STEP7(PC0, PC1, PP0, PP1, t_) do { \
        s16x4 val[4], vah[4], vbl[4], vbh[4]; const int vb_ = vb0 + sp * SHM_V; float s0 = 0.f, s1 = 0.f, s2 = 0.f, s3 = 0.f, al_; \
        SEC_B(0); if ((t_) + 2 < NT) { SWAIT(); SWRITE(sw); if ((t_) + 3 < NT) SLOAD((t_) + 3); } SEC_E(0); \
        SEC_B(1); KLD3(kb, K_lds + sc * SHM_K, 3); SBAR(); \
        QK_ADD(PC0, ka[0], qr[0], negm, PP0, 0);  QK_ADD(PC1, ka[1], qr[0], negm, PP0, 4); \
        QK_ADD(PC0, ka[2], qr[1], PC0, PP0, 8);   QK_ADD(PC1, ka[3], qr[1], PC1, PP0, 12); \
        QK_ADD(PC0, ka[4], qr[2], PC0, PP1, 0);   QK_ADD(PC1, ka[5], qr[2], PC1, PP1, 4); \
        vfrag_load_h<0>(val, vah, vb_); SBAR(); \
        QK_ADD(PC0, kb[0], qr[3], PC0, PP1, 8);   QK_ADD(PC1, kb[1], qr[3], PC1, PP1, 12); \
        QK_PK(PC0, kb[2], qr[4], PC0, PP0, 0, pa0); QK_PK(PC1, kb[3], qr[4], PC1, PP0, 8, pa1); \
        vfrag_load_h<1>(vbl, vbh, vb_); SBAR(); \
        QK_PK(PC0, kb[4], qr[5], PC0, PP1, 0, pa2); QK_PK(PC1, kb[5], qr[5], PC1, PP1, 8, pa3); \
        { float ps = (s0 + s1) + (s2 + s3); auto rr = __builtin_amdgcn_permlane32_swap(__float_as_uint(ps), __float_as_uint(ps), false, false); l_reg += __uint_as_float(rr[0]) + __uint_as_float(rr[1]); } \
        MAX_TILE(PC0, PC1, false, al_); SEC_E(1); \
        SEC_B(4); sp = sc; sc = (sc + 1) & 3; sw = (sw + 1) & 3; \
        if ((t_) + 1 < NT) KLD3(ka, K_lds + sc * SHM_K, 0); \
        asm volatile("s_waitcnt lgkmcnt(6)" ::: "memory"); SBAR(); SEC_E(4); SEC_B(2); \
        PV_EXP(o[0], pa0, val[0], vah[0], PC0, 0);  PV_EXP(o[1], pa0, vbl[0], vbh[0], PC0, 4); \
        PV_EXP(o[0], pa1, val[1], vah[1], PC0, 8);  PV_EXP(o[1], pa1, vbl[1], vbh[1], PC0, 12); \
        PV_EXP(o[0], pa2, val[2], vah[2], PC1, 0);  PV_EXP(o[1], pa2, vbl[2], vbh[2], PC1, 4); \
        PV_EXP(o[0], pa3, val[3], vah[3], PC1, 8);  PV_EXP(o[1], pa3, vbl[3], vbh[3], PC1, 12); \
        RESC7(al_); SEC_E(2); \
        SEC_B(3); RAWBAR(); SEC_E(3); } while (0)
    f32x16 pA0, pA1, pB0, pB1; bf16x8 pa0, pa1, pa2, pa3; bf16x8 ka[6], kb[6]; constexpr int NT = S / 64;
#if MLA_STAMP
    unsigned long long st_a = 0, tq0 = 0, tq1 = 0;
#endif

    if (V7_YOUNG_PRIO && wid >= 4) __builtin_amdgcn_s_setprio(1);
    SLOAD(0); SWAIT(); SWRITE(0); SLOAD(1); SWAIT(); SWRITE(1); SLOAD(2);
    asm volatile("s_waitcnt lgkmcnt(0)" ::: "memory"); RAWBAR();
    KLD3(ka, K_lds, 0); KLD3(kb, K_lds, 3); SBAR();
    pA0 = MF32(ka[0], qr[0], negm); pA1 = MF32(ka[1], qr[0], negm); pA0 = MF32(ka[2], qr[1], pA0); pA1 = MF32(ka[3], qr[1], pA1); pA0 = MF32(ka[4], qr[2], pA0); pA1 = MF32(ka[5], qr[2], pA1);
    pA0 = MF32(kb[0], qr[3], pA0); pA1 = MF32(kb[1], qr[3], pA1); pA0 = MF32(kb[2], qr[4], pA0); pA1 = MF32(kb[3], qr[4], pA1); pA0 = MF32(kb[4], qr[5], pA0); pA1 = MF32(kb[5], qr[5], pA1); SBAR();
    { float al0; MAX_TILE(pA0, pA1, true, al0); (void)al0; }
#pragma unroll
    for (int r = 0; r < 16; ++r) { pA0[r] = __builtin_amdgcn_exp2f(pA0[r]); pA1[r] = __builtin_amdgcn_exp2f(pA1[r]); }
    SWAIT(); SWRITE(2); SLOAD(3);
    int sp = 0, sc = 1, sw = 3;
    KLD3(ka, K_lds + SHM_K, 0);
    asm volatile("s_waitcnt lgkmcnt(6)" ::: "memory"); RAWBAR();
    for (int t = 1; t + 1 < NT; t += 2) { STEP7(pB0, pB1, pA0, pA1, t); STEP7(pA0, pA1, pB0, pB1, t + 1); }
    STEP7(pB0, pB1, pA0, pA1, NT - 1);
    { s16x4 val[4], vah[4], vbl[4], vbh[4]; const int vb_ = vb0 + sp * SHM_V; float ps = 0.f;
      vfrag_load_h<0>(val, vah, vb_); vfrag_load_h<1>(vbl, vbh, vb_); SBAR();
#pragma unroll
      for (int r = 0; r < 16; ++r) ps += pB0[r] + pB1[r];
      { auto rr = __builtin_amdgcn_permlane32_swap(__float_as_uint(ps), __float_as_uint(ps), false, false); l_reg += __uint_as_float(rr[0]) + __uint_as_float(rr[1]); }
      PK4(pB0, 0, pa0); PK4(pB0, 8, pa1); PK4(pB1, 0, pa2); PK4(pB1, 8, pa3);
      asm volatile("s_waitcnt lgkmcnt(0)" ::: "memory"); SBAR();
      pv_mma_h(o[0], val, vah, pa0, pa1, pa2, pa3); pv_mma_h(o[1], vbl, vbh, pa0, pa1, pa2, pa3); SBAR(); }
    if (V7_YOUNG_PRIO) __builtin_amdgcn_s_setprio(0);
    if (hi == 0) li_l[r32] = l_reg; asm volatile("s_waitcnt lgkmcnt(0)" ::: "memory");
    float rli[16];
#pragma unroll
    for (int r = 0; r < 16; ++r) rli[r] = __builtin_amdgcn_rcpf(li_l[crow(r, hi)]);
    unsigned short* stg = (unsigned short*)(lds + M6_OST) + wid * 2048;
    unsigned short* dst = CAT + ((size_t)b * S + q0 + wid * 32) * 1024 + h * 64;
    store_o_tile(o, rli, stg, dst, [](int row) { return (size_t)row * 1024; }, lane);
    asm volatile("s_waitcnt vmcnt(0)" ::: "memory");
#if MLA_STAMP
#if MLA_STAMP
    if (blockIdx.x == 0 && wid == MLA_STAMP_WAVE && lane == 0 && STAMPS) STAMPS[0] = st_a;
#endif
    (void)STAMPS;
#endif
    __syncthreads();
#undef SLOAD
#undef SWRITE
#undef SWAIT
#undef RAWBAR
#undef MAX_TILE
#undef RESC7
#undef STEP7
}

#define PV_EXP8(OD, PA, VL, VH, PCX, B) do { OD = MF32(PA, PKV(VL, VH), OD); PCX[B] = __builtin_amdgcn_exp2f(PCX[B]); PCX[B + 1] = __builtin_amdgcn_exp2f(PCX[B + 1]); \
        PCX[B + 2] = __builtin_amdgcn_exp2f(PCX[B + 2]); PCX[B + 3] = __builtin_amdgcn_exp2f(PCX[B + 3]); asm volatile("" : "+v"(PCX)); SBAR(); } while (0)
__device__ __forceinline__ void mla_unit_v8(int wv, int bh, int qb, const unsigned short* __restrict__ Q, const unsigned short* __restrict__ KN, const unsigned short* __restrict__ KR,
                                            const unsigned short* __restrict__ V, unsigned short* __restrict__ CAT, const float* __restrict__ KMX, char* lds, unsigned long long* STAMPS = nullptr) {
    const int wid = wv, lane = gm::lane_now(), tid = wid * 64 + lane, r32 = lane & 31, hi = lane >> 5;
    const int b = bh >> 3, h = bh & 7; const bool halfB = wid >= 4;
    char* K_lds = lds + M6_K; char* V_lds = lds + M6_V;
    float* wsf = (float*)(lds + M6_WS) + wid * 64; float* li_l = wsf; float* al_l = wsf + 32;
    float m_reg = 0.f, l_reg = 0; f32x16 o[2] = {}; bf16x8 qr[6]; f32x16 negm = f32x16{};
    const size_t bhS = (size_t)bh * S; const int q0 = qb * 256;
    const unsigned short* Qw = Q + (bhS + q0 + wid * 32 + r32) * 96 + hi * 8;
#pragma unroll
    for (int d0 = 0; d0 < 6; ++d0) qr[d0] = *reinterpret_cast<const bf16x8*>(Qw + d0 * 16);
    bool exact = true;
    if (MLA_STATIC) { float q2 = 0.f;
#pragma unroll
      for (int d0 = 0; d0 < 6; ++d0)
#pragma unroll
          for (int j = 0; j < 8; ++j) { const float x = __uint_as_float((unsigned)(unsigned short)qr[d0][j] << 16); q2 += x * x; }
      { auto rr = __builtin_amdgcn_permlane32_swap(__float_as_uint(q2), __float_as_uint(q2), false, false); q2 = __uint_as_float(rr[0]) + __uint_as_float(rr[1]); }
      const float k2 = KMX[(b * 8 + h) * 2] + KMX[(b * 8 + h) * 2 + 1] + KMX[32 + b];
      const float ms = 1.01f * sqrtf(q2 * k2);
      exact = wg_or(!(ms <= MLA_STATIC_THR), (unsigned*)(lds + 147456 - 512), wid, lane);
      if (!exact) { m_reg = ms;
#pragma unroll
          for (int r = 0; r < 16; ++r) negm[r] = -ms; } }
    const int srow = tid >> 3, sch = tid & 7, rrow = (tid & 255) >> 2, rch = tid & 3;
    const char* kn_u = (const char*)(KN + bhS * 64); const char* v_u = (const char*)(V + bhS * 64); const char* kr_u = (const char*)(KR + (size_t)b * S * 32);
    const unsigned kn_off = (unsigned)(srow * 64 + sch * 8) * 2u, kr_off = (unsigned)(rrow * 32 + rch * 8) * 2u;
    const int kst = KSWZ(srow, sch * 16), krst = KSWZ(rrow, (8 + rch) * 16), vst = v_st(srow, sch * 8);
    const int vb0 = (int)(uintptr_t)V_lds + v_rd_base(lane);
    bf16x8 s_kn, s_kr, s_v;
#define SLOAD(t) do { s_kn = *reinterpret_cast<const bf16x8*>(kn_u + (size_t)(t) * 8192 + kn_off); s_kr = *reinterpret_cast<const bf16x8*>(kr_u + (size_t)(t) * 4096 + kr_off); \
    s_v = *reinterpret_cast<const bf16x8*>(v_u + (size_t)(t) * 8192 + kn_off); } while (0)
#define SWRITE(sl) do { *(bf16x8*)(K_lds + (sl) * SHM_K + kst) = s_kn; if (tid < 256) *(bf16x8*)(K_lds + (sl) * SHM_K + krst) = s_kr; *(bf16x8*)(V_lds + (sl) * SHM_V + vst) = s_v; } while (0)
#define SWAIT() asm volatile("s_waitcnt vmcnt(0)" ::: "memory")
#define RAWBAR() do { asm volatile("" ::: "memory"); __builtin_amdgcn_s_barrier(); asm volatile("" ::: "memory"); } while (0)
#define MAX_TILE(P0, P1, FIRST_, AL_) do { AL_ = 1.f; \
        if (V7_EXACT && exact) { const float pmax = rowmax32b(P0, P1); \
            if ((FIRST_) || !__builtin_expect(__all(pmax <= THR), 1)) { const float dl = (FIRST_) ? pmax : fmaxf(pmax, 0.f); m_reg += dl; \
                _Pragma("unroll") for (int r = 0; r < 16; ++r) { P0[r] -= dl; P1[r] -= dl; } \
                _Pragma("unroll") for (int r = 0; r < 16; ++r) negm[r] = -m_reg; \
                if (!(FIRST_)) AL_ = __builtin_amdgcn_exp2f(-dl); } } } while (0)
#define RESC7(a) do { if (V7_EXACT && exact && __any((a) < 1.f)) { if (hi == 0) al_l[r32] = (a); asm volatile("s_waitcnt lgkmcnt(0)" ::: "memory"); l_reg *= (a); \
    _Pragma("unroll") for (int d = 0; d < 2; ++d) _Pragma("unroll") for (int r = 0; r < 16; ++r) o[d][r] *= al_l[crow(r, hi)]; } } while (0)
#define STEP7(PC0, PC1, PP0, PP1, t_) do { \
        s16x4 val[4], vah[4], vbl[4], vbh[4]; const int vb_ = vb0 + sp * SHM_V; float s0 = 0.f, s1 = 0.f, s2 = 0.f, s3 = 0.f, al_; \
        KLD3(kb, K_lds + sc * SHM_K, 3); SBAR(); \
        QK_ADD(PC0, ka[0], qr[0], negm, PP0, 0);  QK_ADD(PC1, ka[1], qr[0], negm, PP0, 4); \
        QK_ADD(PC0, ka[2], qr[1], PC0, PP0, 8);   QK_ADD(PC1, ka[3], qr[1], PC1, PP0, 12); \
        QK_ADD(PC0, ka[4], qr[2], PC0, PP1, 0);   QK_ADD(PC1, ka[5], qr[2], PC1, PP1, 4); \
        vfrag_load_h<0>(val, vah, vb_); SBAR(); \
        QK_ADD(PC0, kb[0], qr[3], PC0, PP1, 8);   QK_ADD(PC1, kb[1], qr[3], PC1, PP1, 12); \
        QK_PK(PC0, kb[2], qr[4], PC0, PP0, 0, pa0); QK_PK(PC1, kb[3], qr[4], PC1, PP0, 8, pa1); \
        vfrag_load_h<1>(vbl, vbh, vb_); SBAR(); \
        QK_PK(PC0, kb[4], qr[5], PC0, PP1, 0, pa2); QK_PK(PC1, kb[5], qr[5], PC1, PP1, 8, pa3); \
        { float ps = (s0 + s1) + (s2 + s3); auto rr = __builtin_amdgcn_permlane32_swap(__float_as_uint(ps), __float_as_uint(ps), false, false); l_reg += __uint_as_float(rr[0]) + __uint_as_float(rr[1]); } \
        MAX_TILE(PC0, PC1, false, al_); \
        asm volatile("s_waitcnt lgkmcnt(0)" ::: "memory"); RAWBAR(); \
        if ((t_) + 2 < NT) { SWAIT(); SWRITE(sw); if ((t_) + 3 < NT) SLOAD((t_) + 3); } \
        sp = sc; sc = (sc + 1) & 3; sw = (sw + 1) & 3; \
        if ((t_) + 1 < NT) KLD3(ka, K_lds + sc * SHM_K, 0); SBAR(); \
        PV_EXP8(o[0], pa0, val[0], vah[0], PC0, 0);  PV_EXP8(o[1], pa0, vbl[0], vbh[0], PC0, 4); \
        PV_EXP8(o[0], pa1, val[1], vah[1], PC0, 8);  PV_EXP8(o[1], pa1, vbl[1], vbh[1], PC0, 12); \
        PV_EXP8(o[0], pa2, val[2], vah[2], PC1, 0);  PV_EXP8(o[1], pa2, vbl[2], vbh[2], PC1, 4); \
        PV_EXP8(o[0], pa3, val[3], vah[3], PC1, 8);  PV_EXP8(o[1], pa3, vbl[3], vbh[3], PC1, 12); \
        RESC7(al_); \
        asm volatile("s_waitcnt lgkmcnt(6)" ::: "memory"); RAWBAR(); } while (0)
    f32x16 pA0, pA1, pB0, pB1; bf16x8 pa0, pa1, pa2, pa3; bf16x8 ka[6], kb[6]; constexpr int NT = S / 64;

    SLOAD(0); SWAIT(); SWRITE(0); SLOAD(1); SWAIT(); SWRITE(1); SLOAD(2);
    asm volatile("s_waitcnt lgkmcnt(0)" ::: "memory"); RAWBAR();
    if (halfB) RAWBAR();
    KLD3(ka, K_lds, 0); KLD3(kb, K_lds, 3); SBAR();
    pA0 = MF32(ka[0], qr[0], negm); pA1 = MF32(ka[1], qr[0], negm); pA0 = MF32(ka[2], qr[1], pA0); pA1 = MF32(ka[3], qr[1], pA1); pA0 = MF32(ka[4], qr[2], pA0); pA1 = MF32(ka[5], qr[2], pA1);
    pA0 = MF32(kb[0], qr[3], pA0); pA1 = MF32(kb[1], qr[3], pA1); pA0 = MF32(kb[2], qr[4], pA0); pA1 = MF32(kb[3], qr[4], pA1); pA0 = MF32(kb[4], qr[5], pA0); pA1 = MF32(kb[5], qr[5], pA1); SBAR();
    { float al0; MAX_TILE(pA0, pA1, true, al0); (void)al0; }
    asm volatile("s_waitcnt lgkmcnt(0)" ::: "memory"); RAWBAR();
#pragma unroll
    for (int r = 0; r < 16; ++r) { pA0[r] = __builtin_amdgcn_exp2f(pA0[r]); pA1[r] = __builtin_amdgcn_exp2f(pA1[r]); }
    SWAIT(); SWRITE(2); SLOAD(3);
    int sp = 0, sc = 1, sw = 3;
    KLD3(ka, K_lds + SHM_K, 0);
    asm volatile("s_waitcnt lgkmcnt(6)" ::: "memory"); RAWBAR();
    for (int t = 1; t + 1 < NT; t += 2) { STEP7(pB0, pB1, pA0, pA1, t); STEP7(pA0, pA1, pB0, pB1, t + 1); }
    STEP7(pB0, pB1, pA0, pA1, NT - 1);
    { s16x4 val[4], vah[4], vbl[4], vbh[4]; const int vb_ = vb0 + sp * SHM_V; float ps = 0.f;
      vfrag_load_h<0>(val, vah, vb_); vfrag_load_h<1>(vbl, vbh, vb_); SBAR();
#pragma unroll
      for (int r = 0; r < 16; ++r) ps += pB0[r] + pB1[r];
      { auto rr = __builtin_amdgcn_permlane32_swap(__float_as_uint(ps), __float_as_uint(ps), false, false); l_reg += __uint_as_float(rr[0]) + __uint_as_float(rr[1]); }
      PK4(pB0, 0, pa0); PK4(pB0, 8, pa1); PK4(pB1, 0, pa2); PK4(pB1, 8, pa3);
      asm volatile("s_waitcnt lgkmcnt(0)" ::: "memory"); SBAR();
      pv_mma_h(o[0], val, vah, pa0, pa1, pa2, pa3); pv_mma_h(o[1], vbl, vbh, pa0, pa1, pa2, pa3); SBAR(); }
    if (!halfB) RAWBAR();
    if (hi == 0) li_l[r32] = l_reg; asm volatile("s_waitcnt lgkmcnt(0)" ::: "memory");
    float rli[16];
#pragma unroll
    for (int r = 0; r < 16; ++r) rli[r] = __builtin_amdgcn_rcpf(li_l[crow(r, hi)]);
    unsigned short* stg = (unsigned short*)(lds + M6_OST) + wid * 2048;
    unsigned short* dst = CAT + ((size_t)b * S + q0 + wid * 32) * 1024 + h * 64;
    store_o_tile(o, rli, stg, dst, [](int row) { return (size_t)row * 1024; }, lane);
    asm volatile("s_waitcnt vmcnt(0)" ::: "memory");
#if MLA_STAMP
    (void)STAMPS;
#endif
    __syncthreads();
#undef SLOAD
#undef SWRITE
#undef SWAIT
#undef RAWBAR
#undef MAX_TILE
#undef RESC7
#undef STEP7
#undef PV_EXP8
}

constexpr int DL_K = 0, DL_V = 49152, DL_WS = 98304, DL_OST = DL_WS + 8 * 256;
#define KSWZD(row, colB) ((row) * 128 + ((colB) ^ ((((row) >> 1) & 7) << 4)))
__device__ __forceinline__ void dil_unit(int wv, int bh, int br, int blk, const unsigned short* __restrict__ DQ, const unsigned short* __restrict__ DK, const unsigned short* __restrict__ DV,
                                         unsigned short* __restrict__ OBR, float* __restrict__ LSE, char* lds) {
    const int wid = wv, lane = gm::lane_now(), tid = wid * 64 + lane, r32 = lane & 31, hi = lane >> 5;
    const int sh = 2 * br, dil = 1 << sh, L = S >> sh, nbl = L >> 8, res = blk / nbl, lb = blk % nbl;
    const size_t bhS = (size_t)bh * S; const int b = bh >> 3, h = bh & 7;
    char* K_lds = lds + DL_K; char* V_lds = lds + DL_V;
#pragma unroll
    for (int half = 0; half < 2; ++half) {
        bf16x8 kk[3], vv[3];
#pragma unroll
        for (int it = 0; it < 3; ++it) { const int item = (half * 3 + it) * 512 + tid, row = item >> 3, ch = item & 7; const int l = 256 * lb - 64 + row; const bool valid = (l >= 0) && (l < L);
            const size_t src = (bhS + (valid ? ((size_t)l << sh) + res : 0)) * 64 + ch * 8;
            kk[it] = *reinterpret_cast<const bf16x8*>(DK + src); vv[it] = *reinterpret_cast<const bf16x8*>(DV + src);
            if (!valid) { kk[it] = bf16x8{}; vv[it] = bf16x8{}; } }
#pragma unroll
        for (int it = 0; it < 3; ++it) { const int item = (half * 3 + it) * 512 + tid, row = item >> 3, ch = item & 7;
            *(bf16x8*)(K_lds + KSWZD(row, ch * 16)) = kk[it]; *(bf16x8*)(V_lds + (row >> 4) * 2048 + v_st(row & 15, ch * 8)) = vv[it]; }
    }
    bf16x8 qr[4];
    const int ql = wid * 32 + r32; const size_t qpos = ((size_t)(256 * lb + ql) << sh) + res;
    const unsigned short* Qw = DQ + (bhS + qpos) * 64 + hi * 8;
#pragma unroll
    for (int d0 = 0; d0 < 4; ++d0) qr[d0] = *reinterpret_cast<const bf16x8*>(Qw + d0 * 16);
    __syncthreads();
    f32x16 p[5];
#pragma unroll
    for (int j = 0; j < 5; ++j) { p[j] = f32x16{}; const int row = wid * 32 + j * 32 + r32;
#pragma unroll
        for (int d0 = 0; d0 < 4; ++d0) { const bf16x8 kf = *reinterpret_cast<const bf16x8*>(K_lds + KSWZD(row, (d0 * 16 + hi * 8) * 2)); p[j] = __builtin_amdgcn_mfma_f32_32x32x16_bf16(kf, qr[d0], p[j], 0, 0, 0); } }
    const float NEG = -1e30f;
    const int klo = 64 - 256 * lb, khi = L + 64 - 256 * lb;
    { const int t0 = max(r32, klo - wid * 32) - 4 * hi, t1 = klo - wid * 32 - 32 - 4 * hi, t3 = khi - wid * 32 - 96 - 4 * hi, t4 = min(r32 + 1, khi - wid * 32 - 128) - 4 * hi;
#pragma unroll
      for (int r = 0; r < 16; ++r) { const int c = (r & 3) + 8 * (r >> 2);
          if (c < t0) p[0][r] = NEG; if (c < t1) p[1][r] = NEG; if (c >= t3) p[3][r] = NEG; if (c >= t4) p[4][r] = NEG; } }
    float mx = rowmax32(p[0], p[1]); mx = fmaxf(mx, rowmax32(p[2], p[3]));
    { float m4 = p[4][0];
#pragma unroll
      for (int r = 1; r < 16; ++r) m4 = fmaxf(m4, p[4][r]);
      auto rr = __builtin_amdgcn_permlane32_swap(__float_as_uint(m4), __float_as_uint(m4), false, false); mx = fmaxf(mx, fmaxf(__uint_as_float(rr[0]), __uint_as_float(rr[1]))); }
    float ps = 0.f;
#pragma unroll
    for (int j = 0; j < 5; ++j)
#pragma unroll
        for (int r = 0; r < 16; ++r) { p[j][r] = __builtin_amdgcn_exp2f(p[j][r] - mx); ps += p[j][r]; }
    { auto rr = __builtin_amdgcn_permlane32_swap(__float_as_uint(ps), __float_as_uint(ps), false, false); ps = __uint_as_float(rr[0]) + __uint_as_float(rr[1]); }
    bf16x8 pa[5][2];
#pragma unroll
    for (int j = 0; j < 5; ++j) { PK4(p[j], 0, pa[j][0]); PK4(p[j], 8, pa[j][1]); }
    f32x16 o[2] = {};
    const int vb = (int)(uintptr_t)V_lds + v_rd_base(lane) + wid * 4096;
    pv_half<0, 0 * 4096>(o[0], vb, pa[0][0], pa[0][1]); pv_half<1, 0 * 4096>(o[1], vb, pa[0][0], pa[0][1]);
    pv_half<0, 1 * 4096>(o[0], vb, pa[1][0], pa[1][1]); pv_half<1, 1 * 4096>(o[1], vb, pa[1][0], pa[1][1]);
    pv_half<0, 2 * 4096>(o[0], vb, pa[2][0], pa[2][1]); pv_half<1, 2 * 4096>(o[1], vb, pa[2][0], pa[2][1]);
    pv_half<0, 3 * 4096>(o[0], vb, pa[3][0], pa[3][1]); pv_half<1, 3 * 4096>(o[1], vb, pa[3][0], pa[3][1]);
    pv_half<0, 4 * 4096>(o[0], vb, pa[4][0], pa[4][1]); pv_half<1, 4 * 4096>(o[1], vb, pa[4][0], pa[4][1]);
    float* wsf = (float*)(lds + DL_WS) + wid * 64;
    if (hi == 0) { wsf[r32] = ps; LSE[((size_t)br * T + (size_t)b * S + qpos) * 8 + h] = mx + __builtin_amdgcn_logf(ps); }
    asm volatile("s_waitcnt lgkmcnt(0)" ::: "memory");
    float rli[16];
#pragma unroll
    for (int r = 0; r < 16; ++r) rli[r] = __builtin_amdgcn_rcpf(wsf[crow(r, hi)]);
    unsigned short* stg = (unsigned short*)(lds + DL_OST) + wid * 2048;
    unsigned short* dst = OBR + ((size_t)br * T + (size_t)b * S + (((size_t)(256 * lb + wid * 32)) << sh) + res) * 512 + h * 64;
    store_o_tile(o, rli, stg, dst, [sh](int row) { return ((size_t)row << sh) * 512; }, lane);
    asm volatile("s_waitcnt vmcnt(0)" ::: "memory");
    __syncthreads();
}
#define DIL_DECODE(u, bh_, br_, res_, lb_, sh_, L_) const int bh_ = (u) / 96, br_ = ((u) >> 5) % 3, blk__##bh_ = (u) & 31, sh_ = 2 * br_, L_ = S >> sh_, nbl__##bh_ = L_ >> 8, res_ = blk__##bh_ / nbl__##bh_, lb_ = blk__##bh_ % nbl__##bh_
__device__ __forceinline__ void dil_phase(int wv, int u0, int ustep, int nunits, const unsigned short* __restrict__ DQ, const unsigned short* __restrict__ DK, const unsigned short* __restrict__ DV,
                                          unsigned short* __restrict__ OBR, float* __restrict__ LSE, char* lds) {
    const int wid = wv, lane = gm::lane_now(), tid = wid * 64 + lane, r32 = lane & 31, hi = lane >> 5;
    char* K_lds = lds + DL_K; char* V_lds = lds + DL_V;
    bf16x8 kk[6], qn[4]; unsigned kmask = 0u;
#define DIL_LOAD6(dst, mask, SRC, u) do { DIL_DECODE(u, bh_, br_, res_, lb_, sh_, L_); const size_t bhS_ = (size_t)bh_ * S; mask = 0u; \
        _Pragma("unroll") for (int it = 0; it < 6; ++it) { const int item = it * 512 + tid, row = item >> 3, ch = item & 7; const int l = 256 * lb_ - 64 + row; const bool valid = (l >= 0) && (l < L_); \
            const size_t src = (bhS_ + (valid ? ((size_t)l << sh_) + res_ : 0)) * 64 + ch * 8; dst[it] = *reinterpret_cast<const bf16x8*>(SRC + src); mask |= (valid ? 1u : 0u) << it; } } while (0)
#define DIL_LOADQ(u) do { DIL_DECODE(u, bh_, br_, res_, lb_, sh_, L_); const size_t qpos_ = ((size_t)(256 * lb_ + wid * 32 + r32) << sh_) + res_; const unsigned short* Qw_ = DQ + ((size_t)bh_ * S + qpos_) * 64 + hi * 8; \
        _Pragma("unroll") for (int d0 = 0; d0 < 4; ++d0) qn[d0] = *reinterpret_cast<const bf16x8*>(Qw_ + d0 * 16); } while (0)
    int u = u0;
    if (u < nunits) { DIL_LOAD6(kk, kmask, DK, u); DIL_LOADQ(u); }
    for (; u < nunits; u += ustep) {
        DIL_DECODE(u, bh, br, res, lb, sh, L); const int b = bh >> 3, h = bh & 7;
#pragma unroll
        for (int it = 0; it < 6; ++it) { const int item = it * 512 + tid, row = item >> 3, ch = item & 7; *(bf16x8*)(K_lds + KSWZD(row, ch * 16)) = ((kmask >> it) & 1u) ? kk[it] : bf16x8{}; }
        bf16x8 qr[4];
#pragma unroll
        for (int d0 = 0; d0 < 4; ++d0) qr[d0] = qn[d0];
        bf16x8 vv[6]; unsigned vmask; DIL_LOAD6(vv, vmask, DV, u);
        __syncthreads();
        const int ql = wid * 32 + r32; const size_t qpos = ((size_t)(256 * lb + ql) << sh) + res;
        f32x16 p[5];
#pragma unroll
        for (int j = 0; j < 5; ++j) { p[j] = f32x16{}; const int row = wid * 32 + j * 32 + r32;
#pragma unroll
            for (int d0 = 0; d0 < 4; ++d0) { const bf16x8 kf = *reinterpret_cast<const bf16x8*>(K_lds + KSWZD(row, (d0 * 16 + hi * 8) * 2)); p[j] = __builtin_amdgcn_mfma_f32_32x32x16_bf16(kf, qr[d0], p[j], 0, 0, 0); } }
        const float NEG = -1e30f;
        const int klo = 64 - 256 * lb, khi = L + 64 - 256 * lb;
        { const int t0 = max(r32, klo - wid * 32) - 4 * hi, t1 = klo - wid * 32 - 32 - 4 * hi, t3 = khi - wid * 32 - 96 - 4 * hi, t4 = min(r32 + 1, khi - wid * 32 - 128) - 4 * hi;
#pragma unroll
          for (int r = 0; r < 16; ++r) { const int c = (r & 3) + 8 * (r >> 2);
              if (c < t0) p[0][r] = NEG; if (c < t1) p[1][r] = NEG; if (c >= t3) p[3][r] = NEG; if (c >= t4) p[4][r] = NEG; } }
        float mx = rowmax32(p[0], p[1]); mx = fmaxf(mx, rowmax32(p[2], p[3]));
        { float m4 = p[4][0];
#pragma unroll
          for (int r = 1; r < 16; ++r) m4 = fmaxf(m4, p[4][r]);
          auto rr = __builtin_amdgcn_permlane32_swap(__float_as_uint(m4), __float_as_uint(m4), false, false); mx = fmaxf(mx, fmaxf(__uint_as_float(rr[0]), __uint_as_float(rr[1]))); }
        float ps = 0.f;
#pragma unroll
        for (int j = 0; j < 5; ++j)
#pragma unroll
            for (int r = 0; r < 16; ++r) { p[j][r] = __builtin_amdgcn_exp2f(p[j][r] - mx); ps += p[j][r]; }
        { auto rr = __builtin_amdgcn_permlane32_swap(__float_as_uint(ps), __float_as_uint(ps), false, false); ps = __uint_as_float(rr[0]) + __uint_as_float(rr[1]); }
        bf16x8 pa[5][2];
#pragma unroll
        for (int j = 0; j < 5; ++j) { PK4(p[j], 0, pa[j][0]); PK4(p[j], 8, pa[j][1]); }
#pragma unroll
        for (int it = 0; it < 6; ++it) { const int item = it * 512 + tid, row = item >> 3, ch = item & 7; *(bf16x8*)(V_lds + (row >> 4) * 2048 + v_st(row & 15, ch * 8)) = ((vmask >> it) & 1u) ? vv[it] : bf16x8{}; }
        __syncthreads();
        if (u + ustep < nunits) { DIL_LOAD6(kk, kmask, DK, u + ustep); DIL_LOADQ(u + ustep); }
        f32x16 o[2] = {};
        const int vb = (int)(uintptr_t)V_lds + v_rd_base(lane) + wid * 4096;
        pv_half<0, 0 * 4096>(o[0], vb, pa[0][0], pa[0][1]); pv_half<1, 0 * 4096>(o[1], vb, pa[0][0], pa[0][1]);
        pv_half<0, 1 * 4096>(o[0], vb, pa[1][0], pa[1][1]); pv_half<1, 1 * 4096>(o[1], vb, pa[1][0], pa[1][1]);
        pv_half<0, 2 * 4096>(o[0], vb, pa[2][0], pa[2][1]); pv_half<1, 2 * 4096>(o[1], vb, pa[2][0], pa[2][1]);
        pv_half<0, 3 * 4096>(o[0], vb, pa[3][0], pa[3][1]); pv_half<1, 3 * 4096>(o[1], vb, pa[3][0], pa[3][1]);
        pv_half<0, 4 * 4096>(o[0], vb, pa[4][0], pa[4][1]); pv_half<1, 4 * 4096>(o[1], vb, pa[4][0], pa[4][1]);
        float* wsf = (float*)(lds + DL_WS) + wid * 64;
        if (hi == 0) { wsf[r32] = ps; LSE[((size_t)br * T + (size_t)b * S + qpos) * 8 + h] = mx + __builtin_amdgcn_logf(ps); }
        asm volatile("s_waitcnt lgkmcnt(0)" ::: "memory");
        float rli[16];
#pragma unroll
        for (int r = 0; r < 16; ++r) rli[r] = __builtin_amdgcn_rcpf(wsf[crow(r, hi)]);
        unsigned short* stg = (unsigned short*)(lds + DL_OST) + wid * 2048;
        unsigned short* dst = OBR + ((size_t)br * T + (size_t)b * S + (((size_t)(256 * lb + wid * 32)) << sh) + res) * 512 + h * 64;
        store_o_tile(o, rli, stg, dst, [sh](int row) { return ((size_t)row << sh) * 512; }, lane);
        __syncthreads();
    }
#undef DIL_LOAD6
#undef DIL_LOADQ
}
__device__ __forceinline__ void dil_combine(const unsigned short* __restrict__ OBR, const float* __restrict__ LSE, unsigned short* __restrict__ CAT, int gtid, int gthreads) {
    for (int i = gtid; i < T * 64; i += gthreads) { const int t = i >> 6, c8 = i & 63, h = c8 >> 3;
        const float l0 = LSE[((size_t)0 * T + t) * 8 + h], l1 = LSE[((size_t)1 * T + t) * 8 + h], l2 = LSE[((size_t)2 * T + t) * 8 + h];
        const float mx = fmaxf(l0, fmaxf(l1, l2)); float w0 = __builtin_amdgcn_exp2f(l0 - mx), w1 = __builtin_amdgcn_exp2f(l1 - mx), w2 = __builtin_amdgcn_exp2f(l2 - mx);
        const float inv = 1.f / (w0 + w1 + w2); w0 *= inv; w1 *= inv; w2 *= inv;
        const u32x4 a = *(const u32x4*)(OBR + ((size_t)0 * T + t) * 512 + c8 * 8), bb = *(const u32x4*)(OBR + ((size_t)1 * T + t) * 512 + c8 * 8), cc = *(const u32x4*)(OBR + ((size_t)2 * T + t) * 512 + c8 * 8);
        u32x4 o;
#pragma unroll
        for (int k = 0; k < 4; ++k) { const float lo = w0 * __uint_as_float(a[k] << 16) + w1 * __uint_as_float(bb[k] << 16) + w2 * __uint_as_float(cc[k] << 16);
            const float hi = w0 * __uint_as_float(a[k] & 0xffff0000u) + w1 * __uint_as_float(bb[k] & 0xffff0000u) + w2 * __uint_as_float(cc[k] & 0xffff0000u); o[k] = cvtpk(lo, hi); }
        *(u32x4*)(CAT + (size_t)t * 1024 + 512 + c8 * 8) = o; }
}
#undef SBAR
}
namespace mk {
struct SchedP4 {
    __device__ __forceinline__ void a_ready(const gm::Unit&, int, int) const {}
    __device__ __forceinline__ void done(const gm::Unit&, int) const {}
    __device__ __forceinline__ void stamp(int, const gm::Unit&, int, int) const {}
    static constexpr bool GATHER = false;
    const char* A; const char* Bt; int G, c;
    __device__ __forceinline__ bool next(int i, gm::Unit& u) const { int pm, pn; if (!static_tile(i, G, c, 64, 4, pm, pn)) return false;
        u.A = A; u.Bt = Bt; u.gidx = nullptr; u.lda2 = 2048; u.ldb2 = 2048; u.arow0 = pm * 256; u.brow0 = pn * 256; u.nt = 16; u.pm = pm; u.pn = pn; u.aux = 0; return true; }
};
struct EpiP4 {
    static constexpr bool PERM = false;
    const float* x; float* out; const float* modf;
    __device__ __forceinline__ void operator()(EPI_ARGS) const {
        const int b = (u.pm * 256) >> 13; const float* gt = modf + b * 6144 + 2048;
        const int col0 = u.pn * 256 + wc * 32 + 4 * fq;
        f32x4 g[2][2];
#pragma unroll
        for (int bj = 0; bj < 2; ++bj)
#pragma unroll
            for (int n = 0; n < 2; ++n) g[bj][n] = *(const f32x4*)(gt + col0 + bj * 128 + n * 16);
#pragma unroll
        for (int ai = 0; ai < 2; ++ai)
#pragma unroll
            for (int m = 0; m < 4; ++m) { const size_t off = (size_t)(u.pm * 256 + ai * 128 + wr * 64 + m * 16 + fr) * D + col0;
#pragma unroll
                for (int bj = 0; bj < 2; ++bj)
#pragma unroll
                    for (int n = 0; n < 2; ++n) { const f32x4 xv = *(const f32x4*)(x + off + bj * 128 + n * 16); *(f32x4*)(out + off + bj * 128 + n * 16) = xv + g[bj][n] * acc[ai][bj][m][n]; } }
    }
};
__device__ __forceinline__ void p4b_rows(Frame& F) {
    const int tid_ = F.wave * 64 + fresh_lane();
    LAS float* WR = (LAS float*)F.lds;
    LAS float* A1 = WR + 16384;
    LAS float* A0 = A1 + 2048;
    const float* modf = (const float*)(F.ws + WS_MODF);
    for (int i = tid_; i < 16384; i += NTHREADS) { const int j = i >> 4, e = i & 15; WR[e * 1024 + j] = F.w_router[i]; }
    for (int i = tid_; i < 2048; i += NTHREADS) { const int b = i >> 10, j = i & 1023; A1[i] = F.g_ffn[j] * (1.f + modf[b * 6144 + 4096 + j]); A0[i] = modf[b * 6144 + 3072 + j]; }
    __syncthreads();
    const int gw = F.vcu * NWAVES + F.wave, NGW = F.G * NWAVES, lane = fresh_lane();
    for (int m = gw; m < T; m += NGW) { const int b = m >> 13, s = m & 8191;
        const f32x4* xr = (const f32x4*)(F.out + (size_t)m * D) + lane; f32x4 v[4]; float ss = 0.f;
#pragma unroll
        for (int j = 0; j < 4; ++j) { v[j] = xr[64 * j]; ss += (v[j].x * v[j].x + v[j].y * v[j].y) + (v[j].z * v[j].z + v[j].w * v[j].w); }
        const float rstd = rsqrtf(wave_sum(ss) * (1.f / D) + EPS);
        unsigned long long* o8 = (unsigned long long*)((bf16_t*)(F.ws + WS_HB) + (size_t)m * D) + lane;
        float lg[16];
#pragma unroll
        for (int e = 0; e < 16; ++e) lg[e] = 0.f;
#pragma unroll
        for (int j = 0; j < 4; ++j) { asm volatile("" ::: "memory");
            const f32x4 a1 = *(const LAS f32x4*)(A1 + b * 1024 + 4 * lane + 256 * j), a0 = *(const LAS f32x4*)(A0 + b * 1024 + 4 * lane + 256 * j);
            const f32x4 o = v[j] * rstd * a1 + a0; o8[64 * j] = (unsigned long long)pk2(o.x, o.y) | ((unsigned long long)pk2(o.z, o.w) << 32);
#pragma unroll
            for (int e = 0; e < 16; ++e) { const f32x4 w = *(const LAS f32x4*)(WR + e * 1024 + 4 * lane + 256 * j); lg[e] += (o.x * w.x + o.y * w.y) + (o.z * w.z + o.w * w.w); } }
        float w8[8], w4[4], w2[2], w1;
        { const bool up = lane & 32;
#pragma unroll
          for (int i = 0; i < 8; ++i) { const float snd = up ? lg[i] : lg[8 + i], kp = up ? lg[8 + i] : lg[i]; w8[i] = kp + __shfl_xor(snd, 32); } }
        { const bool up = lane & 16;
#pragma unroll
          for (int i = 0; i < 4; ++i) { const float snd = up ? w8[i] : w8[4 + i], kp = up ? w8[4 + i] : w8[i]; w4[i] = kp + __shfl_xor(snd, 16); } }
        { const bool up = lane & 8;
#pragma unroll
          for (int i = 0; i < 2; ++i) { const float snd = up ? w4[i] : w4[2 + i], kp = up ? w4[2 + i] : w4[i]; w2[i] = kp + __shfl_xor(snd, 8); } }
        { const bool up = lane & 4; const float snd = up ? w2[0] : w2[1], kp = up ? w2[1] : w2[0]; w1 = kp + __shfl_xor(snd, 4); }
        w1 += __shfl_xor(w1, 1); w1 += __shfl_xor(w1, 2);
        const int e = lane >> 2; const float logit = w1 + F.b_router[e];
        float mx = logit;
#pragma unroll
        for (int o = 4; o < 64; o <<= 1) mx = fmaxf(mx, __shfl_xor(mx, o));
        const float ex = __expf(logit - mx); float den = ex;
#pragma unroll
        for (int o = 4; o < 64; o <<= 1) den += __shfl_xor(den, o);
        if ((lane & 3) == 0) ((float*)(F.ws + WS_AFF))[((size_t)b * 16 + e) * S + s] = ex / den;
    }
    __syncthreads();
}
__device__ __forceinline__ void p5_topk(Frame& F) {
    if (F.vcu >= 32) { if (WD_IN_P5 && F.G > 32) wd_convert(F, 32); return; }
    const int be = F.vcu, b = be >> 4, e = be & 15, tid = F.wave * 64 + fresh_lane();
    LAS unsigned* vals = (LAS unsigned*)F.lds;
    LAS unsigned* hist = vals + 8192;
    LAS unsigned* suf = hist + 256;
    LAS unsigned* misc = suf + 264;
    LAS unsigned* wtot = misc + 8;
    const float* a = (const float*)(F.ws + WS_AFF) + (size_t)be * S;
    for (int i = tid; i < 8192; i += NTHREADS) vals[i] = __float_as_uint(a[i]);
    if (tid == 0) { misc[0] = 0u; misc[1] = 1024u; }
    __syncthreads();
    for (int pass = 0; pass < 4; ++pass) {
        const int sh = 24 - 8 * pass; const unsigned prefix = misc[0], k = misc[1]; const unsigned himask = pass == 0 ? 0u : (0xffffffffu << (sh + 8));
        if (tid < 256) hist[tid] = 0u;
        __syncthreads();
        {
            const unsigned cand = (vals[0] >> sh) & 255u; unsigned nc = 0u;
            for (int i = tid; i < 8192; i += NTHREADS) { const unsigned v = vals[i]; if ((v & himask) == prefix) { const unsigned bn = (v >> sh) & 255u; if (bn == cand) ++nc; else __hip_atomic_fetch_add(&hist[bn], 1u, __ATOMIC_RELAXED, __HIP_MEMORY_SCOPE_WORKGROUP); } }
#pragma unroll
            for (int o = 1; o < 64; o <<= 1) nc += __shfl_xor(nc, o);
            if ((tid & 63) == 0 && nc) __hip_atomic_fetch_add(&hist[cand], nc, __ATOMIC_RELAXED, __HIP_MEMORY_SCOPE_WORKGROUP);
        }
        __syncthreads();
        if (tid < 64) {
            const int l = tid; const unsigned h0 = hist[4 * l], h1 = hist[4 * l + 1], h2 = hist[4 * l + 2], h3 = hist[4 * l + 3];
            const unsigned tot = (h0 + h1) + (h2 + h3); unsigned inc = tot;
#pragma unroll
            for (int o = 1; o < 64; o <<= 1) { const unsigned t = __shfl_down(inc, o); if (l + o < 64) inc += t; }
            const unsigned above = inc - tot;
            const unsigned s3 = above + h3, s2 = s3 + h2, s1 = s2 + h1, s0 = s1 + h0;
            int bin = -1; unsigned gt = 0u;
            if (s3 >= k && above < k) { bin = 4 * l + 3; gt = above; } else if (s2 >= k && s3 < k) { bin = 4 * l + 2; gt = s3; } else if (s1 >= k && s2 < k) { bin = 4 * l + 1; gt = s2; } else if (s0 >= k && s1 < k) { bin = 4 * l; gt = s1; }
            if (bin >= 0) { misc[0] = prefix | ((unsigned)bin << sh); misc[1] = k - gt; }
        }
        __syncthreads();
    }
    const unsigned thr = misc[0], need = misc[1];
    unsigned gtc = 0, eqc = 0;
#pragma unroll
    for (int i = 0; i < 16; ++i) { const unsigned v = vals[tid * 16 + i]; gtc += v > thr; eqc += v == thr; }
    unsigned gi = gtc, ei = eqc; const int lane = fresh_lane(), wv = F.wave;
#pragma unroll
    for (int o = 1; o < 64; o <<= 1) { const unsigned g2 = __shfl_up(gi, o), e2 = __shfl_up(ei, o); if (lane >= o) { gi += g2; ei += e2; } }
    if (lane == 63) { wtot[wv] = gi; wtot[8 + wv] = ei; }
    __syncthreads();
    unsigned gbase = 0, ebase = 0, gtotal = 0;
    for (int w = 0; w < 8; ++w) { const unsigned g = wtot[w], q = wtot[8 + w]; if (w < wv) { gbase += g; ebase += q; } gtotal += g; }
    unsigned gpos = gbase + gi - gtc, epos = ebase + ei - eqc;
    int* IDX = (int*)(F.ws + WS_IDX) + (e * 2 + b) * 1024; float* GATE = (float*)(F.ws + WS_GATE) + (e * 2 + b) * 1024; int* SLOT = (int*)(F.ws + WS_SLOT);
#pragma unroll
    for (int i = 0; i < 16; ++i) { const int s = tid * 16 + i; const unsigned v = vals[s]; int c = -1;
        if (v > thr) c = (int)gpos++; else if (v == thr) { if (epos < need) c = (int)(gtotal + epos); ++epos; }
        if (c >= 0) { IDX[c] = b * S + s; GATE[c] = __uint_as_float(v); }
        SLOT[(size_t)(b * S + s) * 16 + e] = c >= 0 ? (e * 2 + b) * 1024 + c : -1; }
}
struct SchedP6a {
    __device__ __forceinline__ void a_ready(const gm::Unit&, int, int) const {}
    __device__ __forceinline__ void done(const gm::Unit&, int) const {}
    __device__ __forceinline__ void stamp(int, const gm::Unit&, int, int) const {}
    static constexpr bool GATHER = true;
    const char* A; const char* W; const int* idx; int G, vcu;
    __device__ __forceinline__ bool next(int i, gm::Unit& u) const {
        int e, pmu, pn;
        if (G == 256) { if (i >= 4) return false; const int xcd = vcu >> 5, j = vcu & 31; e = xcd + 8 * (i >> 1); const int sub = (i & 1) * 32 + j; pmu = sub >> 3; pn = sub & 7; }
        else { const int L = i * G + vcu; if (L >= 1024) return false; e = L >> 6; pmu = (L >> 3) & 7; pn = L & 7; }
        u.A = A; u.gidx = idx + e * 2048 + pmu * 256; u.lda2 = 2048; u.arow0 = 0; u.Bt = W + (size_t)e * 2048 * 2048; u.brow0 = pn * 256; u.ldb2 = 2048; u.nt = 16; u.pm = e * 8 + pmu; u.pn = pn; u.aux = e; return true; }
};
struct EpiP6a {
    static constexpr bool PERM = true;
    bf16_t* H;
    __device__ __forceinline__ void operator()(EPI_ARGS) const {
#pragma unroll
        for (int ai = 0; ai < 2; ++ai)
#pragma unroll
            for (int m = 0; m < 4; ++m) { const size_t row = (size_t)u.pm * 256 + ai * 128 + wr * 64 + m * 16 + fr;
                f32x4 h0, h1;
#pragma unroll
                for (int j = 0; j < 4; ++j) { h0[j] = siluf(acc[ai][0][m][0][j]) * acc[ai][1][m][0][j]; h1[j] = siluf(acc[ai][0][m][1][j]) * acc[ai][1][m][1][j]; }
                *(u32x4*)(H + row * 1024 + u.pn * 128 + wc * 32 + 8 * fq) = pack8(h0, h1); }
    }
};
struct SchedP6b {
    __device__ __forceinline__ void a_ready(const gm::Unit&, int, int) const {}
    __device__ __forceinline__ void done(const gm::Unit&, int) const {}
    __device__ __forceinline__ void stamp(int, const gm::Unit&, int, int) const {}
    static constexpr bool GATHER = false;
    const char* A; const char* W; int G, vcu;
    __device__ __forceinline__ bool next(int i, gm::Unit& u) const {
        int e, pmu, pn;
        if (G == 256) { if (i >= 2) return false; const int xcd = vcu >> 5, j = vcu & 31; e = xcd + 8 * i; pmu = j >> 2; pn = j & 3; }
        else { const int L = i * G + vcu; if (L >= 512) return false; e = L >> 5; pmu = (L >> 2) & 7; pn = L & 3; }
        u.A = A; u.gidx = nullptr; u.lda2 = 2048; u.arow0 = (e * 8 + pmu) * 256; u.Bt = W + (size_t)e * 1024 * 2048; u.brow0 = pn * 256; u.ldb2 = 2048; u.nt = 16; u.pm = e * 8 + pmu; u.pn = pn; u.aux = e; return true; }
};
struct EpiP6b {
    static constexpr bool PERM = true;
    bf16_t* Y; const float* gate;
    __device__ __forceinline__ void operator()(EPI_ARGS) const {
#pragma unroll
        for (int ai = 0; ai < 2; ++ai)
#pragma unroll
            for (int m = 0; m < 4; ++m) { const size_t row = (size_t)u.pm * 256 + ai * 128 + wr * 64 + m * 16 + fr; const float g = gate[row];
#pragma unroll
                for (int bj = 0; bj < 2; ++bj) *(u32x4*)(Y + row * 1024 + u.pn * 256 + bj * 128 + wc * 32 + 8 * fq) = pack8(acc[ai][bj][m][0] * g, acc[ai][bj][m][1] * g); }
    }
};
__device__ __forceinline__ void p7_final(Frame& F) {
    const float* modf = (const float*)(F.ws + WS_MODF); const int* SLOT = (const int*)(F.ws + WS_SLOT); const bf16_t* Y = (const bf16_t*)(F.ws + WS_Y);
    const int gw = F.vcu * NWAVES + F.wave, NGW = F.G * NWAVES, lane = fresh_lane();
    for (int m0 = gw; m0 < T; m0 += 2 * NGW) {
        const int m1 = m0 + NGW; const bool has1 = m1 < T; const int mm1 = has1 ? m1 : m0;
        f32x4* xr0 = (f32x4*)(F.out + (size_t)m0 * D) + lane; f32x4* xr1 = (f32x4*)(F.out + (size_t)mm1 * D) + lane; f32x4 v0[4], v1[4], a0[4], a1[4];
#pragma unroll
        for (int j = 0; j < 4; ++j) { v0[j] = xr0[64 * j]; v1[j] = xr1[64 * j]; a0[j] = (f32x4){0.f, 0.f, 0.f, 0.f}; a1[j] = (f32x4){0.f, 0.f, 0.f, 0.f}; }
        const int sl0 = lane < 16 ? SLOT[(size_t)m0 * 16 + lane] : -1, sl1 = lane < 16 ? SLOT[(size_t)mm1 * 16 + lane] : -1;
        for (int e = 0; e < 16; ++e) { const int s0 = __shfl(sl0, e), s1 = __shfl(sl1, e);
            if (s0 >= 0) { const u32x2* yr = (const u32x2*)(Y + (size_t)s0 * 1024) + lane;
#pragma unroll
                for (int j = 0; j < 4; ++j) { const u32x2 w = yr[64 * j]; a0[j].x += __uint_as_float(w.x << 16); a0[j].y += __uint_as_float(w.x & 0xffff0000u); a0[j].z += __uint_as_float(w.y << 16); a0[j].w += __uint_as_float(w.y & 0xffff0000u); } }
            if (s1 >= 0) { const u32x2* yr = (const u32x2*)(Y + (size_t)s1 * 1024) + lane;
#pragma unroll
                for (int j = 0; j < 4; ++j) { const u32x2 w = yr[64 * j]; a1[j].x += __uint_as_float(w.x << 16); a1[j].y += __uint_as_float(w.x & 0xffff0000u); a1[j].z += __uint_as_float(w.y << 16); a1[j].w += __uint_as_float(w.y & 0xffff0000u); } } }
        float ss0 = 0.f, ss1 = 0.f; const int b0 = m0 >> 13, b1 = mm1 >> 13;
#pragma unroll
        for (int j = 0; j < 4; ++j) { const f32x4 g0 = *(const f32x4*)(modf + b0 * 6144 + 5120 + 4 * lane + 256 * j), g1 = *(const f32x4*)(modf + b1 * 6144 + 5120 + 4 * lane + 256 * j);
            v0[j] = v0[j] + g0 * a0[j]; v1[j] = v1[j] + g1 * a1[j];
            ss0 += (v0[j].x * v0[j].x + v0[j].y * v0[j].y) + (v0[j].z * v0[j].z + v0[j].w * v0[j].w); ss1 += (v1[j].x * v1[j].x + v1[j].y * v1[j].y) + (v1[j].z * v1[j].z + v1[j].w * v1[j].w); }
        const float r0 = rsqrtf(wave_sum(ss0) * (1.f / D) + EPS), r1 = rsqrtf(wave_sum(ss1) * (1.f / D) + EPS);
#pragma unroll
        for (int j = 0; j < 4; ++j) { const f32x4 g = *(const f32x4*)(F.g_final + 4 * lane + 256 * j); xr0[64 * j] = v0[j] * r0 * g; if (has1) xr1[64 * j] = v1[j] * r1 * g; }
    }
}
}
#ifndef MLA_STAG
#define MLA_STAG mla_unit_v7
#endif
#ifndef MLA_V4
#define MLA_V4 1
#endif
#ifndef MERGE_P12
#define MERGE_P12 1
#endif
#ifndef DIL_PIPE
#define DIL_PIPE 1
#endif
#ifndef MLA_UNIT
#define MLA_UNIT mla_unit_v2
#endif
namespace mk {
namespace cg = cooperative_groups;
__global__ void __launch_bounds__(NTHREADS, 2) mega(Args args) {
    extern __shared__ __attribute__((aligned(16))) unsigned char lds_raw[];
    cg::grid_group grid = cg::this_grid();
    Frame F;
    F.lds = (LAS unsigned char*)lds_raw; F.ws = args.ws; F.out = args.out;
    F.wave = __builtin_amdgcn_readfirstlane((int)(threadIdx.x >> 6));
    F.G = gridDim.x; { const int bx = blockIdx.x; F.vcu = (F.G % 8 == 0) ? (bx % 8) * (F.G / 8) + bx / 8 : bx; }
    F.x = (const float*)args.in[0]; F.c = (const float*)args.in[1]; F.pos = (const int*)args.in[2]; F.w_ada = (const float*)args.in[3]; F.b_ada = (const float*)args.in[4];
    F.g_mix = (const float*)args.in[5]; F.w_in = (const float*)args.in[6]; F.g_q = (const float*)args.in[7]; F.w_uq = (const float*)args.in[8]; F.g_kv = (const float*)args.in[9];
    F.w_ukv = (const float*)args.in[10]; F.w_out = (const float*)args.in[11]; F.g_ffn = (const float*)args.in[12]; F.w_router = (const float*)args.in[13]; F.b_router = (const float*)args.in[14];
    F.w_gate = (const float*)args.in[15]; F.w_up = (const float*)args.in[16]; F.w_down = (const float*)args.in[17]; F.g_final = (const float*)args.in[18];
    const int lo = args.ph_lo, hi = args.ph_hi;
    volatile LAS unsigned* MISC = (volatile LAS unsigned*)(F.lds + LDS_BYTES - 256);
    { const int l0 = fresh_lane(); if (F.wave == 0) MISC[l0] = 0u; }
    __syncthreads();
    XcdBarrier xbar = xcd_barrier_post((unsigned*)(F.ws + WS_CTL) + 1024 + args.li * 4096, MISC + 8, F.wave == 0 && fresh_lane() == 0);
#define IN(k) (lo <= (k) && (k) < hi)
#ifndef CG_SEAMS
#define CG_SEAMS 0x000
#endif
#define SEAM(k) do { if (IN(k) && IN((k) + 1)) { if ((CG_SEAMS >> (k)) & 1) grid.sync(); else xcd_barrier(xbar, F.wave == 0 && fresh_lane() == 0); } } while (0)
    if (IN(0)) { p0_prologue(F); } SEAM(0);
    if (IN(1)) { p0b_rows(F); } SEAM(1);
#if MERGE_P12
    if (IN(2)) {
#if P12_STAMP
        if (F.wave == 0 && fresh_lane() == 0) { unsigned long long* ts = (unsigned long long*)(F.ws + 128 * KiB) + (size_t)blockIdx.x * 8; ts[0] = __builtin_amdgcn_s_memrealtime(); ts[7] = 0; }
#endif
        SchedP12 S{(const char*)(F.ws + WS_HB), (const char*)(F.ws + WS_WIN), (const char*)(F.ws + WS_CQ), (const char*)(F.ws + WS_WUQ), (const char*)(F.ws + WS_WUKV), (unsigned*)(F.ws + WS_PCNT), F.G, F.vcu, (int)blockIdx.x};
        EpiP12 E{F.ws}; gm::gemm_phase<EpiP12, SchedP12>(F.lds, S, E, F.wave); } SEAM(3);
#else
    if (IN(2)) { SchedP1 S{(const char*)(F.ws + WS_HB), (const char*)(F.ws + WS_WIN), F.G, (int)blockIdx.x}; EpiP1 E{F.ws}; gm::gemm_phase<EpiP1, SchedP1>(F.lds, S, E, F.wave); } SEAM(2);
    if (IN(3)) { SchedP2 S{(const char*)(F.ws + WS_CQ), (const char*)(F.ws + WS_WUQ), (const char*)(F.ws + WS_WUKV), F.G, (int)blockIdx.x}; EpiP2 E{F.ws}; gm::gemm_phase<EpiP2, SchedP2>(F.lds, S, E, F.wave); } SEAM(3);
#endif
    if (IN(4)) {
        const unsigned short* DQ = (const unsigned short*)(F.ws + WS_DQ); const unsigned short* DK = (const unsigned short*)(F.ws + WS_DK); const unsigned short* DV = (const unsigned short*)(F.ws + WS_DV);
        unsigned short* OBR = (unsigned short*)F.out; float* LSE = (float*)(F.ws + WS_LSE);
        if (args.pad & 1) { if (DIL_PIPE) at::dil_phase(F.wave, F.vcu, F.G, 1536, DQ, DK, DV, OBR, LSE, (char*)lds_raw); else for (int u = F.vcu; u < 1536; u += F.G) { const int blk = u & 31, br = (u >> 5) % 3, bh = u / 96; at::dil_unit(F.wave, bh, br, blk, DQ, DK, DV, OBR, LSE, (char*)lds_raw); } }
        if (args.pad & 2) for (int u = F.vcu; u < 512; u += F.G) { const int bh = (u >> 8) * 8 + ((u & 255) >> 5), qb = u & 31;
            #if MLA_V4
            at::MLA_STAG(F.wave, bh, qb, (const unsigned short*)(F.ws + WS_Q), (const unsigned short*)(F.ws + WS_KN), (const unsigned short*)(F.ws + WS_KR), (const unsigned short*)(F.ws + WS_V), (unsigned short*)(F.ws + WS_HB), (const float*)(F.ws + WS_KMX), (char*)lds_raw, (u == F.vcu) ? (unsigned long long*)(F.ws + WS_CTL + 60 * 1024) : nullptr); }
#else
            at::mla_unit_v2(F.wave, bh, qb, (const unsigned short*)(F.ws + WS_Q), (const unsigned short*)(F.ws + WS_KN), (const unsigned short*)(F.ws + WS_KR), (const unsigned short*)(F.ws + WS_V), (unsigned short*)(F.ws + WS_HB), (const float*)(F.ws + WS_KMX), (char*)lds_raw, (u == F.vcu) ? (unsigned long long*)(F.ws + WS_CTL + 60 * 1024) : nullptr); }
#endif
    } SEAM(4);
    if (IN(5)) { at::dil_combine((const unsigned short*)F.out, (const float*)(F.ws + WS_LSE), (unsigned short*)(F.ws + WS_HB), F.vcu * NTHREADS + F.wave * 64 + fresh_lane(), F.G * NTHREADS); } SEAM(5);
    if (IN(6)) { SchedP4 S{(const char*)(F.ws + WS_HB), (const char*)(F.ws + WS_WOUT), F.G, (int)blockIdx.x}; EpiP4 E{F.x, F.out, (const float*)(F.ws + WS_MODF)}; gm::gemm_phase<EpiP4, SchedP4>(F.lds, S, E, F.wave); } SEAM(6);
    if (IN(7)) { p4b_rows(F); } SEAM(7);
    if (IN(8)) { p5_topk(F); } SEAM(8);
    if (IN(9)) { SchedP6a S{(const char*)(F.ws + WS_HB), (const char*)(F.ws + WS_WGU), (const int*)(F.ws + WS_IDX), F.G, F.vcu}; EpiP6a E{(bf16_t*)(F.ws + WS_HBUF)}; gm::gemm_phase<EpiP6a, SchedP6a>(F.lds, S, E, F.wave); } SEAM(9);
    if (IN(10)) { SchedP6b S{(const char*)(F.ws + WS_HBUF), (const char*)(F.ws + WS_WD), F.G, F.vcu}; EpiP6b E{(bf16_t*)(F.ws + WS_Y), (const float*)(F.ws + WS_GATE)}; gm::gemm_phase<EpiP6b, SchedP6b>(F.lds, S, E, F.wave); } SEAM(10);
    if (IN(11)) { p7_final(F); }
#undef IN
#undef SEAM
}
}
extern "C" void kernel_launch(void* const* d_in, const int* in_sizes, int n_in, void* d_out, int out_size, void* d_ws, size_t ws_size, hipStream_t stream) {
    using namespace mk;
    static int grid = 0;
    if (grid == 0) {
        if (n_in != 19 || out_size != T * D || in_sizes[0] != T * D || ws_size < WS_END) { fprintf(stderr, "kernel_launch: built for 19 inputs, x/out of %d floats and >= %zu bytes of workspace; got n_in %d out %d ws %zu; nothing launched\n", T * D, (size_t)WS_END, n_in, out_size, ws_size); grid = -1; return; }
        int dev = 0, cus = 0, per_cu = 0;
        if (hipGetDevice(&dev) != hipSuccess || hipDeviceGetAttribute(&cus, hipDeviceAttributeMultiprocessorCount, dev) != hipSuccess || cus < 32) { fprintf(stderr, "kernel_launch: device query failed\n"); grid = -1; return; }
        if (hipFuncSetAttribute((const void*)mega, hipFuncAttributeMaxDynamicSharedMemorySize, LDS_BYTES) != hipSuccess) { fprintf(stderr, "kernel_launch: hipFuncSetAttribute(%d B LDS) failed\n", LDS_BYTES); grid = -1; return; }
        if (hipOccupancyMaxActiveBlocksPerMultiprocessor(&per_cu, (const void*)mega, NTHREADS, LDS_BYTES) != hipSuccess || per_cu < 1) { fprintf(stderr, "kernel_launch: occupancy query reports %d workgroups per CU\n", per_cu); grid = -1; return; }
        grid = cus;
    }
    if (grid < 0) return;
    if (hipMemsetAsync((char*)d_ws + WS_CTL, 0, 64 * KiB, stream) != hipSuccess) { fprintf(stderr, "kernel_launch: memset failed\n"); return; }
    Args a{}; for (int i = 0; i < 19; ++i) a.in[i] = d_in[i]; a.out = (float*)d_out; a.ws = (unsigned char*)d_ws;
    a.pad = 3; a.ph_lo = 0; a.ph_hi = 12; a.li = 0;
    void* kargs[] = {&a};
    const hipError_t e = hipLaunchCooperativeKernel((const void*)mega, dim3(grid), dim3(NTHREADS), kargs, LDS_BYTES, stream);
    if (e != hipSuccess) fprintf(stderr, "kernel_launch: cooperative launch failed: %s (grid %d)\n", hipGetErrorString(e), grid);
}
```

```cpp
#include <hip/hip_runtime.h>
#include <hip/hip_cooperative_groups.h>
#include <hip/hip_bf16.h>
#include <cstdio>
#include <cstdint>
#include <cmath>
namespace gm {
#define LAS __attribute__((address_space(3)))
typedef unsigned short bf16_t;
typedef short bf16x8 __attribute__((ext_vector_type(8)));
typedef float f32x4 __attribute__((ext_vector_type(4)));
typedef float f32x2 __attribute__((ext_vector_type(2)));
typedef unsigned u32x4 __attribute__((ext_vector_type(4)));
typedef unsigned u32x2 __attribute__((ext_vector_type(2)));
constexpr int BM = 256, BK = 64, HALF = 128, HTB = HALF * BK * 2, STAGE_BYTES = 8 * HTB;

__device__ __forceinline__ int lds_byte(int r, int c) { const int st = (r >> 4) * 2 + (c >> 5), rr = r & 15, cc = c & 31, ob = rr * 64 + cc * 2; return st * 1024 + (ob ^ (((ob >> 9) & 1) << 5)); }
__device__ __forceinline__ void stage_rc(int b, int& R, int& C) { const int st = b / 1024, sb = b % 1024, swz = sb ^ (((sb >> 9) & 1) << 5); R = (st >> 1) * 16 + swz / 64; C = (st & 1) * 32 + (swz % 64) / 2; }
__device__ __forceinline__ int perm32(int rho) { const int n = rho >> 4, i = rho & 15; return 8 * (i >> 2) + 4 * n + (i & 3); }
__device__ __forceinline__ int lane_now() { int l; asm volatile("v_mbcnt_lo_u32_b32 %0, -1, 0\n\tv_mbcnt_hi_u32_b32 %0, -1, %0" : "=v"(l)); return l; }
__device__ __forceinline__ unsigned cvt_pk_bf16(float lo, float hi) { unsigned r; asm volatile("v_cvt_pk_bf16_f32 %0, %1, %2" : "=v"(r) : "v"(lo), "v"(hi)); return r; }

struct Unit {
    const char* A; const char* Bt; const int* gidx;
    unsigned lda2, ldb2;
    int arow0, brow0, nt;
    int pm, pn, aux;
};

template <class Epi, class Sched>
__device__ __forceinline__ void gemm_phase(LAS unsigned char* lds, const Sched& S, const Epi& E, int wave_sgpr) {
    constexpr bool GATHER = Sched::GATHER;
    const int wid = wave_sgpr, lane = lane_now(), tid = wid * 64 + lane, wr = wid >> 2, wc = wid & 3, fr = lane & 15, fq = lane >> 4;
    int sR[2], sC[2], sRb[2];
#pragma unroll
    for (int i = 0; i < 2; ++i) { int R, C; stage_rc(tid * 16 + i * 8192, R, C); sR[i] = R; sC[i] = C * 2; sRb[i] = Epi::PERM ? ((R & ~31) + perm32(R & 31)) : R; }
    const unsigned ldsw = (unsigned)wid * 1024u;
    const int aoff = lds_byte(wr * 64 + fr, fq * 8), boff = lds_byte(wc * 32 + fr, fq * 8);
#define GM_SA(b, h) (((b) * 2 + (h)) * HTB)
#define GM_SB(b, h) ((4 + (b) * 2 + (h)) * HTB)
#define GM_GLDS(src, dstoff) __builtin_amdgcn_global_load_lds((const unsigned*)(src), (LAS unsigned*)(lds + (dstoff)), 16, 0, 0)
#define GM_STAGE_B(bufoff, p, ld, h) do { _Pragma("unroll") for (int i_ = 0; i_ < 2; ++i_) \
        GM_GLDS((p) + ((unsigned)((h) * HALF + sRb[i_]) * (ld) + (unsigned)sC[i_]), (bufoff) + ldsw + i_ * 8192); } while (0)
#define GM_STAGE_A(bufoff, p, ld, h, g) do { _Pragma("unroll") for (int i_ = 0; i_ < 2; ++i_) { \
        const unsigned o_ = GATHER ? (g)[h][i_] + (unsigned)sC[i_] : (unsigned)((h) * HALF + sR[i_]) * (ld) + (unsigned)sC[i_]; \
        GM_GLDS((p) + o_, (bufoff) + ldsw + i_ * 8192); } } while (0)
#define GM_LDA(dst, b, h) do { _Pragma("unroll") for (int m = 0; m < 4; ++m) _Pragma("unroll") for (int k = 0; k < 2; ++k) dst[m][k] = *(const LAS bf16x8*)(lds + GM_SA(b, h) + aoff + m * 2048 + k * 1024); } while (0)
#define GM_LDB(dst, b, h) do { _Pragma("unroll") for (int n = 0; n < 2; ++n) _Pragma("unroll") for (int k = 0; k < 2; ++k) dst[n][k] = *(const LAS bf16x8*)(lds + GM_SB(b, h) + boff + n * 2048 + k * 1024); } while (0)
#define GM_MMA(ai, bj, At, Bt) do { __builtin_amdgcn_s_setprio(1); _Pragma("unroll") for (int m = 0; m < 4; ++m) _Pragma("unroll") for (int n = 0; n < 2; ++n) _Pragma("unroll") for (int k = 0; k < 2; ++k) \
        acc[ai][bj][m][n] = __builtin_amdgcn_mfma_f32_16x16x32_bf16(Bt[n][k], At[m][k], acc[ai][bj][m][n], 0, 0, 0); __builtin_amdgcn_s_setprio(0); } while (0)
#define GM_WAIT_V(n) asm volatile("s_waitcnt vmcnt(" #n ")" ::: "memory")
#define GM_WAIT_L(n) asm volatile("s_waitcnt lgkmcnt(" #n ")" ::: "memory")
#define GM_BAR __builtin_amdgcn_s_barrier()
#define GM_SCHED __builtin_amdgcn_sched_barrier(0)
#define GM_GOFFS(u, g) do { if (GATHER) { _Pragma("unroll") for (int h_ = 0; h_ < 2; ++h_) _Pragma("unroll") for (int i_ = 0; i_ < 2; ++i_) g[h_][i_] = (unsigned)(u).gidx[h_ * HALF + sR[i_]] * (u).lda2; } } while (0)
#define GM_ABASE(u) ((u).A + (GATHER ? (size_t)0 : (size_t)(u).arow0 * (u).lda2))
#define GM_BBASE(u) ((u).Bt + (size_t)(u).brow0 * (u).ldb2)
    Unit cur, nxt; int ui = 0;
    if (!S.next(0, cur)) return;
    f32x4 acc[2][2][4][2];
#pragma unroll
    for (int a = 0; a < 2; ++a)
#pragma unroll
        for (int b = 0; b < 2; ++b)
#pragma unroll
            for (int m = 0; m < 4; ++m)
#pragma unroll
                for (int n = 0; n < 2; ++n) acc[a][b][m][n] = (f32x4){0.f, 0.f, 0.f, 0.f};
    bf16x8 At[4][2], B0[2][2], B1[2][2];
    unsigned gc[2][2] = {{0u, 0u}, {0u, 0u}}, gn[2][2] = {{0u, 0u}, {0u, 0u}};
    GM_GOFFS(cur, gc);
    const char* cA = GM_ABASE(cur); const char* cB = GM_BBASE(cur); unsigned cla = cur.lda2, clb = cur.ldb2;
    GM_STAGE_B(GM_SB(0, 0), cB, clb, 0); GM_STAGE_B(GM_SB(0, 1), cB, clb, 1); GM_STAGE_A(GM_SA(0, 0), cA, cla, 0, gc); GM_STAGE_A(GM_SA(0, 1), cA, cla, 1, gc);
    if (wr == 1) GM_BAR;
    GM_WAIT_V(2); GM_BAR;
    GM_STAGE_B(GM_SB(1, 0), cB + 128, clb, 0); GM_STAGE_A(GM_SA(1, 0), cA + 128, cla, 0, gc); GM_STAGE_B(GM_SB(1, 1), cB + 128, clb, 1);
    GM_WAIT_V(6); GM_BAR;
    for (;;) {
        const bool has_next = S.next(ui + 1, nxt);
        const char* nA = cA; const char* nB = cB; unsigned nla = cla, nlb = clb;
        if (has_next) { GM_GOFFS(nxt, gn); nA = GM_ABASE(nxt); nB = GM_BBASE(nxt); nla = nxt.lda2; nlb = nxt.ldb2; }
        else if (GATHER) {
#pragma unroll
            for (int h = 0; h < 2; ++h)
#pragma unroll
                for (int i = 0; i < 2; ++i) gn[h][i] = gc[h][i];
        }
        const int nt = cur.nt;
        for (int t = 0; t < nt; t += 2) {
            const bool last = (t == nt - 2);
            if (last && has_next) S.a_ready(nxt, wid, ui + 1);
            const char* a1 = cA + (size_t)(t + 1) * 128;
            const char* a2 = last ? nA : cA + (size_t)(t + 2) * 128; const char* b2 = last ? nB : cB + (size_t)(t + 2) * 128;
            const char* a3 = a2 + 128; const char* b3 = b2 + 128;
            const unsigned la2 = last ? nla : cla, lb2 = last ? nlb : clb;
            unsigned g2[2][2];
#pragma unroll
            for (int h = 0; h < 2; ++h)
#pragma unroll
                for (int i = 0; i < 2; ++i) g2[h][i] = GATHER ? (last ? gn[h][i] : gc[h][i]) : 0u;
            GM_LDB(B0, 0, 0); GM_LDB(B1, 0, 1); GM_SCHED; GM_LDA(At, 0, 0); GM_STAGE_A(GM_SA(1, 1), a1, cla, 1, gc);
            GM_WAIT_V(8); GM_WAIT_L(0); GM_BAR; GM_MMA(0, 0, At, B0); GM_MMA(0, 1, At, B1); GM_BAR; GM_SCHED;
            GM_LDA(At, 0, 1); GM_STAGE_B(GM_SB(0, 0), b2, lb2, 0); GM_STAGE_B(GM_SB(0, 1), b2, lb2, 1); GM_STAGE_A(GM_SA(0, 0), a2, la2, 0, g2);
            GM_WAIT_V(8); GM_WAIT_L(0); GM_BAR; GM_MMA(1, 0, At, B0); GM_MMA(1, 1, At, B1); GM_BAR; GM_SCHED;
            GM_LDB(B0, 1, 0); GM_LDB(B1, 1, 1); GM_SCHED; GM_LDA(At, 1, 0); GM_STAGE_A(GM_SA(0, 1), a2, la2, 1, g2);
            GM_WAIT_V(8); GM_WAIT_L(0); GM_BAR; GM_MMA(0, 0, At, B0); GM_MMA(0, 1, At, B1); GM_BAR; GM_SCHED;
            GM_LDA(At, 1, 1); GM_STAGE_B(GM_SB(1, 0), b3, lb2, 0); GM_STAGE_B(GM_SB(1, 1), b3, lb2, 1); GM_STAGE_A(GM_SA(1, 0), a3, la2, 0, g2);
            GM_WAIT_V(8); GM_WAIT_L(0); GM_BAR; GM_MMA(1, 0, At, B0); GM_MMA(1, 1, At, B1); GM_BAR; GM_SCHED;
        }
        if (wr == 0) GM_BAR;
        E(acc, cur, wr, wc, fr, fq, lane);
        S.done(cur, lane);
        S.stamp(ui, cur, wid, lane);
        if (!has_next) break;
#pragma unroll
        for (int a = 0; a < 2; ++a)
#pragma unroll
            for (int b = 0; b < 2; ++b)
#pragma unroll
                for (int m = 0; m < 4; ++m)
#pragma unroll
                    for (int n = 0; n < 2; ++n) acc[a][b][m][n] = (f32x4){0.f, 0.f, 0.f, 0.f};
        cur = nxt; cA = nA; cB = nB; cla = nla; clb = nlb; ++ui;
        if (GATHER) {
#pragma unroll
            for (int h = 0; h < 2; ++h)
#pragma unroll
                for (int i = 0; i < 2; ++i) gc[h][i] = gn[h][i];
        }
        if (wr == 1) GM_BAR;
    }
    GM_WAIT_V(0);
    GM_BAR;
#undef GM_SA
#undef GM_SB
#undef GM_GLDS
#undef GM_STAGE_A
#undef GM_STAGE_B
#undef GM_LDA
#undef GM_LDB
#undef GM_MMA
#undef GM_WAIT_V
#undef GM_WAIT_L
#undef GM_BAR
#undef GM_SCHED
#undef GM_GOFFS
#undef GM_ABASE
#undef GM_BBASE
}
}
namespace mk {
using gm::bf16_t; using gm::f32x4; using gm::f32x2; using gm::u32x4; using gm::u32x2; using gm::cvt_pk_bf16;
constexpr int T = 16384, S = 8192, D = 1024, NB = 2, NH = 8, NWAVES = 8, NTHREADS = 512;
constexpr float EPS = 1e-6f;
constexpr size_t KiB = 1024, MiB = 1u << 20;
constexpr size_t WS_CTL = 0;
constexpr size_t WS_KMX = 48 * KiB;
constexpr size_t WS_MODP = 1 * MiB;
constexpr size_t WS_MODF = 2 * MiB;
constexpr size_t WS_TABM = WS_MODF + 64 * KiB;
constexpr size_t WS_TABD = WS_TABM + 2 * MiB;
constexpr size_t WS_SSQ = WS_TABD + 1 * MiB;
constexpr size_t WS_KR = WS_SSQ + 1536 * KiB;
constexpr size_t WS_AFF = WS_KR + 1 * MiB;
constexpr size_t WS_IDX = WS_AFF + 1 * MiB;
constexpr size_t WS_GATE = WS_IDX + 128 * KiB;
constexpr size_t WS_SLOT = WS_GATE + 128 * KiB;
constexpr size_t WS_LSE = WS_SLOT + 1 * MiB;
constexpr size_t WS_WUQ = WS_LSE + 1536 * KiB;
constexpr size_t WS_WUKV = WS_WUQ + 576 * KiB;
constexpr size_t WS_WOUT = WS_WUKV + 512 * KiB;
constexpr size_t WS_WIN = WS_WOUT + 2 * MiB;
constexpr size_t WS_R0END = WS_WIN + 4608 * KiB;
static_assert(WS_R0END <= 20 * MiB, "R0");
constexpr size_t WS_HB = 20 * MiB;
constexpr size_t WS_CQ = 52 * MiB;
constexpr size_t WS_DQ = WS_CQ + 24 * MiB, WS_DK = WS_DQ + 16 * MiB, WS_DV = WS_DK + 16 * MiB;
constexpr size_t WS_Q = WS_DV + 16 * MiB;
constexpr size_t WS_KN = WS_Q + 24 * MiB, WS_V = WS_KN + 16 * MiB;
constexpr size_t WS_HBUF = WS_CQ;
constexpr size_t WS_WGU = 180 * MiB;
constexpr size_t WS_Y = WS_WGU;
constexpr size_t WS_WD = 244 * MiB;
constexpr size_t WS_END = 276 * MiB;
static_assert(WS_V + 16 * MiB == 180 * MiB, "arena");
constexpr int LDS_BYTES = 147456;

__device__ __forceinline__ float wave_sum(float v) {
#pragma unroll
    for (int o = 1; o < 64; o <<= 1) v += __shfl_xor(v, o);
    return v;
}
__device__ __forceinline__ unsigned f2bf(float f) { unsigned u = __builtin_bit_cast(unsigned, f); return (u + 0x7fffu + ((u >> 16) & 1u)) >> 16; }
__device__ __forceinline__ unsigned pk2(float lo, float hi) { return f2bf(lo) | (f2bf(hi) << 16); }
__device__ __forceinline__ float bf2f(unsigned short b) { return __builtin_bit_cast(float, (unsigned)b << 16); }
__device__ __forceinline__ float siluf(float v) { return v / (1.f + __expf(-v)); }
#define LDS_WAIT() asm volatile("s_waitcnt lgkmcnt(0)" ::: "memory")
__device__ __forceinline__ int fresh_lane() { return gm::lane_now(); }

struct Args { const void* in[19]; float* out; unsigned char* ws; int ph_lo, ph_hi, li, pad; };
struct Frame {
    LAS unsigned char* lds; unsigned char* ws; float* out;
    int wave, vcu, G;
    const float *x, *c; const int* pos; const float *w_ada, *b_ada, *g_mix, *w_in, *g_q, *w_uq, *g_kv, *w_ukv, *w_out, *g_ffn, *w_router, *b_router, *w_gate, *w_up, *w_down, *g_final;
};

__device__ __forceinline__ float inv_freq_m(int i) { return (float)exp2(-(double)i * (18.931568569324174 / 16.0)); }
__device__ __forceinline__ float inv_freq_d(int i) { return (float)exp2(-(double)i * (18.931568569324174 / 8.0)); }

#ifndef WD_IN_P5
#define WD_IN_P5 1
#endif
__device__ __forceinline__ void p0_transpose_item(const float* W, int ldw, int K, int k0, int n0, bf16_t* WT, int drow, const float* kscale, LAS float* scr, int lane) {
    f32x4 v[8];
#pragma unroll
    for (int i = 0; i < 8; ++i) v[i] = *(const f32x4*)(W + (size_t)(k0 + 8 * i + (lane >> 3)) * ldw + n0 + 4 * (lane & 7));
#pragma unroll
    for (int i = 0; i < 8; ++i) { const int kk = 8 * i + (lane >> 3); f32x4 x = v[i]; if (kscale) x = x * kscale[k0 + kk]; LAS float* d = scr + kk * 33 + 4 * (lane & 7); d[0] = x.x; d[1] = x.y; d[2] = x.z; d[3] = x.w; }
    LDS_WAIT(); asm volatile("" ::: "memory");
    const int c = lane & 7;
#pragma unroll
    for (int j = 0; j < 4; ++j) { const int n = (lane >> 3) + 8 * j; const LAS float* s = scr + (8 * c) * 33 + n;
        u32x4 o; o.x = pk2(s[0 * 33], s[1 * 33]); o.y = pk2(s[2 * 33], s[3 * 33]); o.z = pk2(s[4 * 33], s[5 * 33]); o.w = pk2(s[6 * 33], s[7 * 33]);
        *(u32x4*)(WT + (size_t)(drow + n) * K + k0 + 8 * c) = o; }
    LDS_WAIT(); asm volatile("" ::: "memory");
}
__device__ __forceinline__ void p0_prologue(Frame& F) {
    LAS float* scr = (LAS float*)(F.lds + F.wave * 16384);
    const int gw = F.vcu * NWAVES + F.wave, NGW = F.G * NWAVES, lane = fresh_lane();
    unsigned char* ws = F.ws;
    constexpr int I_MOD = 24 * 16, I_IN = 16 * 69, I_UQ = 6 * 24, I_UKV = 4 * 32, I_OUT = 16 * 32, I_EXP = 16 * 16 * 32, I_PAD = 96, I_TAB = T * 24 / 64;
    constexpr int NITEMS = I_MOD + I_IN + I_UQ + I_UKV + I_OUT + (WD_IN_P5 ? 2 : 3) * I_EXP + I_PAD + I_TAB;
    for (int it = gw; it < NITEMS; it += NGW) {
        int r = it;
        if (r < I_MOD) {
            const int cc = r % 24, kc = r / 24; f32x4 a0 = {0.f, 0.f, 0.f, 0.f}, a1 = {0.f, 0.f, 0.f, 0.f};
            const float* wp = F.w_ada + (size_t)(kc * 64) * 6144 + cc * 256 + 4 * lane;
#pragma unroll 8
            for (int k = 0; k < 64; ++k) { const f32x4 w = *(const f32x4*)(wp + (size_t)k * 6144); const float s0 = siluf(F.c[kc * 64 + k]), s1 = siluf(F.c[1024 + kc * 64 + k]); a0 += w * s0; a1 += w * s1; }
            float* mp = (float*)(ws + WS_MODP) + (size_t)kc * 2 * 6144 + cc * 256 + 4 * lane;
            *(f32x4*)mp = a0; *(f32x4*)(mp + 6144) = a1; continue; }
        r -= I_MOD;
        if (r < I_IN) { const int kb = r / 69, nb = r % 69, n0 = nb * 32; p0_transpose_item(F.w_in, 2208, 1024, kb * 64, n0, (bf16_t*)(ws + WS_WIN), n0 < 672 ? n0 : n0 + 96, nullptr, scr, lane); continue; }
        r -= I_IN;
        if (r < I_UQ) { const int kb = r / 24, nb = r % 24, n0 = nb * 32, h = n0 / 96, d = n0 % 96; p0_transpose_item(F.w_uq, 768, 384, kb * 64, n0, (bf16_t*)(ws + WS_WUQ), d < 64 ? h * 64 + d : 512 + h * 32, F.g_q, scr, lane); continue; }
        r -= I_UQ;
        if (r < I_UKV) { const int kb = r / 32, nb = r % 32, n0 = nb * 32, h = n0 / 128, d = n0 % 128; p0_transpose_item(F.w_ukv, 1024, 256, kb * 64, n0, (bf16_t*)(ws + WS_WUKV), d < 64 ? h * 64 + d : 512 + h * 64 + (d - 64), F.g_kv, scr, lane); continue; }
        r -= I_UKV;
        if (r < I_OUT) { const int kb = r / 32, nb = r % 32; p0_transpose_item(F.w_out, 1024, 1024, kb * 64, nb * 32, (bf16_t*)(ws + WS_WOUT), nb * 32, nullptr, scr, lane); continue; }
        r -= I_OUT;
        if (r < 2 * I_EXP) { const int up = r >= I_EXP; const int q = up ? r - I_EXP : r; const int e = q / 512, kb = (q % 512) / 32, nb = q % 32, n0 = nb * 32;
            p0_transpose_item((up ? F.w_up : F.w_gate) + (size_t)e * 1048576, 1024, 1024, kb * 64, n0, (bf16_t*)(ws + WS_WGU) + (size_t)e * 2048 * 1024, (n0 / 128) * 256 + up * 128 + (n0 % 128), nullptr, scr, lane); continue; }
        r -= 2 * I_EXP;
        if (!WD_IN_P5) { if (r < I_EXP) { const int e = r / 512, kb = (r % 512) / 32, nb = r % 32; p0_transpose_item(F.w_down + (size_t)e * 1048576, 1024, 1024, kb * 64, nb * 32, (bf16_t*)(ws + WS_WD) + (size_t)e * 1048576, nb * 32, nullptr, scr, lane); continue; }
        r -= I_EXP; }
        if (r < I_PAD) { u32x4 z = {0u, 0u, 0u, 0u}; u32x4* p = (u32x4*)((bf16_t*)(ws + WS_WIN) + (size_t)(672 + r) * 1024); p[lane] = z; p[64 + lane] = z; continue; }
        r -= I_PAD;
        {
            const int e = r * 64 + lane, tok = e / 24, f = e % 24; const int p = F.pos[tok];
            const float inv = f < 16 ? inv_freq_m(f) : inv_freq_d(f - 16); const float ang = (float)p * inv; const float cs = (float)cos((double)ang), sn = (float)sin((double)ang);
            if (f < 16) { float* tm = (float*)(ws + WS_TABM) + (size_t)tok * 32; tm[f] = cs; tm[16 + f] = sn; } else { float* td = (float*)(ws + WS_TABD) + (size_t)tok * 16; td[f - 16] = cs; td[8 + f - 16] = sn; }
        }
    }
}
__device__ __forceinline__ void wd_convert(Frame& F, int first_vcu) {
    LAS float* scr = (LAS float*)(F.lds + F.wave * 16384);
    const int gw = (F.vcu - first_vcu) * NWAVES + F.wave, NGW = (F.G - first_vcu) * NWAVES, lane = fresh_lane();
    for (int r = gw; r < 16 * 16 * 32; r += NGW) { const int e = r / 512, kb = (r % 512) / 32, nb = r % 32;
        p0_transpose_item(F.w_down + (size_t)e * 1048576, 1024, 1024, kb * 64, nb * 32, (bf16_t*)(F.ws + WS_WD) + (size_t)e * 1048576, nb * 32, nullptr, scr, lane); }
}
__device__ __forceinline__ void p0b_rows(Frame& F) {
    const int tid_ = F.wave * 64 + fresh_lane();
    LAS float* A1 = (LAS float*)F.lds;
    LAS float* A0 = A1 + 2048;
    const float* mp = (const float*)(F.ws + WS_MODP);
#pragma unroll
    for (int half = 0; half < 2; ++half) { float s[4]; float pv[4][16];
#pragma unroll
        for (int q = 0; q < 4; ++q) { const int i = tid_ + NTHREADS * (half * 4 + q); const int b = i >> 11, n = ((i >> 10) & 1) * 1024 + (i & 1023);
#pragma unroll
            for (int k = 0; k < 16; ++k) pv[q][k] = mp[(size_t)k * 2 * 6144 + b * 6144 + n]; }
#pragma unroll
        for (int q = 0; q < 4; ++q) { const int i = tid_ + NTHREADS * (half * 4 + q); const int b = i >> 11, which = (i >> 10) & 1, j = i & 1023; s[q] = F.b_ada[which * 1024 + j];
#pragma unroll
            for (int k = 0; k < 16; ++k) s[q] += pv[q][k];
            if (which) A1[b * 1024 + j] = F.g_mix[j] * (1.f + s[q]); else A0[b * 1024 + j] = s[q]; } }
    if (blockIdx.x < 48 && tid_ < 256) { const int n = blockIdx.x * 256 + tid_; const int b = n / 6144, nn = n % 6144; float s = F.b_ada[nn];
#pragma unroll
        for (int k = 0; k < 16; ++k) s += mp[(size_t)k * 2 * 6144 + b * 6144 + nn];
        ((float*)(F.ws + WS_MODF))[n] = s; }
    __syncthreads();
    const int gw = F.vcu * NWAVES + F.wave, NGW = F.G * NWAVES, lane = fresh_lane();
    for (int m0 = gw; m0 < T; m0 += 2 * NGW) {
        const int m1 = m0 + NGW; const bool has1 = m1 < T; const int mm1 = has1 ? m1 : m0;
        const f32x4* xr0 = (const f32x4*)(F.x + (size_t)m0 * D) + lane; const f32x4* xr1 = (const f32x4*)(F.x + (size_t)mm1 * D) + lane; f32x4 v0[4], v1[4]; float s0 = 0.f, s1 = 0.f;
#pragma unroll
        for (int j = 0; j < 4; ++j) { v0[j] = xr0[64 * j]; v1[j] = xr1[64 * j]; }
#pragma unroll
        for (int j = 0; j < 4; ++j) { s0 += (v0[j].x * v0[j].x + v0[j].y * v0[j].y) + (v0[j].z * v0[j].z + v0[j].w * v0[j].w); s1 += (v1[j].x * v1[j].x + v1[j].y * v1[j].y) + (v1[j].z * v1[j].z + v1[j].w * v1[j].w); }
        const float r0 = rsqrtf(wave_sum(s0) * (1.f / D) + EPS), r1 = rsqrtf(wave_sum(s1) * (1.f / D) + EPS);
        const int b0 = m0 >> 13, b1 = mm1 >> 13;
        unsigned long long* o0 = (unsigned long long*)((bf16_t*)(F.ws + WS_HB) + (size_t)m0 * D) + lane; unsigned long long* o1 = (unsigned long long*)((bf16_t*)(F.ws + WS_HB) + (size_t)mm1 * D) + lane;
#pragma unroll
        for (int j = 0; j < 4; ++j) { const f32x4 a1 = *(const LAS f32x4*)(A1 + b0 * 1024 + 4 * lane + 256 * j), a0 = *(const LAS f32x4*)(A0 + b0 * 1024 + 4 * lane + 256 * j);
            const f32x4 o = v0[j] * r0 * a1 + a0; o0[64 * j] = (unsigned long long)pk2(o.x, o.y) | ((unsigned long long)pk2(o.z, o.w) << 32); }
        if (has1) {
#pragma unroll
            for (int j = 0; j < 4; ++j) { const f32x4 a1 = *(const LAS f32x4*)(A1 + b1 * 1024 + 4 * lane + 256 * j), a0 = *(const LAS f32x4*)(A0 + b1 * 1024 + 4 * lane + 256 * j);
                const f32x4 o = v1[j] * r1 * a1 + a0; o1[64 * j] = (unsigned long long)pk2(o.x, o.y) | ((unsigned long long)pk2(o.z, o.w) << 32); } }
    }
    __syncthreads();
}

__device__ __forceinline__ bool static_tile(int i, int G, int c, int nM, int nN, int& pm, int& pn) {
    const int nwg = nM * nN; const long L = (long)i * G + c; if (L >= nwg) return false;
    int wgid = (int)L; { const int q = nwg / 8, r = nwg % 8, xcd = wgid % 8, off = wgid / 8; wgid = (xcd < r ? xcd * (q + 1) : r * (q + 1) + (xcd - r) * q) + off; }
    const int nig = 8 * nN, gid = wgid / nig, fm = gid * 8, gsz = (nM - fm) < 8 ? (nM - fm) : 8;
    pm = fm + ((wgid % nig) % gsz); pn = (wgid % nig) / gsz; return true;
}
struct SchedP1 {
    static constexpr bool GATHER = false;
    __device__ __forceinline__ void a_ready(const gm::Unit&, int, int) const {}
    __device__ __forceinline__ void done(const gm::Unit&, int) const {}
    __device__ __forceinline__ void stamp(int, const gm::Unit&, int, int) const {}
    const char* A; const char* Bt; int G, c;
    __device__ __forceinline__ bool next(int i, gm::Unit& u) const { int pm, pn; if (!static_tile(i, G, c, 64, 9, pm, pn)) return false;
        u.A = A; u.Bt = Bt; u.gidx = nullptr; u.lda2 = 2048; u.ldb2 = 2048; u.arow0 = pm * 256; u.brow0 = pn * 256; u.nt = 16; u.pm = pm; u.pn = pn; u.aux = 0; return true; }
};
struct SchedP2 {
    static constexpr bool GATHER = false;
    __device__ __forceinline__ void a_ready(const gm::Unit&, int, int) const {}
    __device__ __forceinline__ void done(const gm::Unit&, int) const {}
    __device__ __forceinline__ void stamp(int, const gm::Unit&, int, int) const {}
    const char* A; const char* Wuq; const char* Wukv; int G, c;
    __device__ __forceinline__ bool next(int i, gm::Unit& u) const {
        const int L = i * G + c; if (L >= 448) return false;
        u.A = A; u.gidx = nullptr; u.lda2 = 1536;
        if (L < 256) { int pm, pn; static_tile(0, 256, L, 64, 4, pm, pn); u.A = A + 768; u.Bt = Wukv; u.ldb2 = 512; u.nt = 4; u.arow0 = pm * 256; u.brow0 = pn * 256; u.pm = pm; u.pn = pn; u.aux = 1; }
        else { int pm, pn; static_tile(0, 192, L - 256, 64, 3, pm, pn); u.Bt = Wuq; u.ldb2 = 768; u.nt = 6; u.arow0 = pm * 256; u.brow0 = pn * 256; u.pm = pm; u.pn = pn; u.aux = 0; }
        return true; }
};

__device__ __forceinline__ void store16_sc1(void* p, u32x4 v) { asm volatile("global_store_dwordx4 %0, %1, off sc1\n\ts_nop 1" :: "v"(p), "v"(v) : "memory"); }
__device__ __forceinline__ void store4_sc1(float* p, float v) { __hip_atomic_store(p, v, __ATOMIC_RELAXED, __HIP_MEMORY_SCOPE_AGENT); }
#define EPI_ARGS const f32x4 (&acc)[2][2][4][2], const gm::Unit& u, int wr, int wc, int fr, int fq, int lane
constexpr float QSCALE_M = 0.10206207261596575f * 1.4426950408889634f;
constexpr float QSCALE_D = 0.125f * 1.4426950408889634f;
__device__ __forceinline__ u32x4 pack8(f32x4 a, f32x4 b) { u32x4 w; w.x = cvt_pk_bf16(a[0], a[1]); w.y = cvt_pk_bf16(a[2], a[3]); w.z = cvt_pk_bf16(b[0], b[1]); w.w = cvt_pk_bf16(b[2], b[3]); return w; }
__device__ __forceinline__ void rope8(f32x4& v0, f32x4& v1, int xmask, const float* cs, const float* sn, bool first) {
    f32x4 o0, o1;
#pragma unroll
    for (int j = 0; j < 4; ++j) { o0[j] = __shfl_xor(v0[j], xmask); o1[j] = __shfl_xor(v1[j], xmask); }
    const f32x4 c0 = *(const f32x4*)cs, c1 = *(const f32x4*)(cs + 4), s0 = *(const f32x4*)sn, s1 = *(const f32x4*)(sn + 4);
    const float sg = first ? -1.f : 1.f;
    v0 = v0 * c0 + o0 * s0 * sg; v1 = v1 * c1 + o1 * s1 * sg;
}
struct EpiP1 {
    static constexpr bool PERM = true;
    unsigned char* ws;
    __device__ __forceinline__ void operator()(EPI_ARGS) const {
        const int pn = u.pn; float krmax = 0.f;
        const float* tabm = (const float*)(ws + WS_TABM); const float* tabd = (const float*)(ws + WS_TABD);
#pragma unroll
        for (int ai = 0; ai < 2; ++ai)
#pragma unroll
            for (int m = 0; m < 4; ++m) {
                const int row = u.pm * 256 + ai * 128 + wr * 64 + m * 16 + fr; const int b = row >> 13, s = row & 8191;
#pragma unroll
                for (int bj = 0; bj < 2; ++bj) {
                    f32x4 v0 = acc[ai][bj][m][0], v1 = acc[ai][bj][m][1];
                    const int ct = bj * 128 + wc * 32 + 8 * fq;
                    if (pn < 3) {
                        float q = (v0[0] * v0[0] + v0[1] * v0[1]) + (v0[2] * v0[2] + v0[3] * v0[3]) + (v1[0] * v1[0] + v1[1] * v1[1]) + (v1[2] * v1[2] + v1[3] * v1[3]);
                        q += __shfl_xor(q, 16); q += __shfl_xor(q, 32);
                        if (fq == 0) store4_sc1((float*)(ws + WS_SSQ) + (size_t)row * 24 + pn * 8 + bj * 4 + wc, q);
                        if (pn == 2 && bj == 1 && wc == 0) {
                            const int f0 = 8 * (fq & 1); rope8(v0, v1, 32, tabm + (size_t)row * 32 + f0, tabm + (size_t)row * 32 + 16 + f0, fq < 2);
                            store16_sc1((bf16_t*)(ws + WS_KR) + (size_t)row * 32 + 8 * fq, pack8(v0, v1));
                            { float q2 = (v0[0] * v0[0] + v0[1] * v0[1]) + (v0[2] * v0[2] + v0[3] * v0[3]) + (v1[0] * v1[0] + v1[1] * v1[1]) + (v1[2] * v1[2] + v1[3] * v1[3]);
                              q2 += __shfl_xor(q2, 16); q2 += __shfl_xor(q2, 32); krmax = fmaxf(krmax, q2); }
                        } else store16_sc1((bf16_t*)(ws + WS_CQ) + (size_t)row * 768 + pn * 256 + ct, pack8(v0, v1));
                    } else {
                        const int which = (pn - 3) >> 1;
                        const int cc = ((pn - 3) & 1) * 256 + ct, hh = cc >> 6, d = cc & 63;
                        if (which < 2 && (wc & 1) == 0) {
                            f32x4 r0 = v0, r1 = v1; rope8(r0, r1, 16, tabd + (size_t)row * 16, tabd + (size_t)row * 16 + 8, fq == 0);
                            if (fq < 2) { v0 = r0; v1 = r1; } }
                        if (which == 0) { v0 = v0 * QSCALE_D; v1 = v1 * QSCALE_D; }
                        bf16_t* dst = (bf16_t*)(ws + (which == 0 ? WS_DQ : which == 1 ? WS_DK : WS_DV));
                        *(u32x4*)(dst + ((size_t)(b * 8 + hh) * S + s) * 64 + d) = pack8(v0, v1);
                    }
                }
            }
        if (pn == 2 && wc == 0) {
#pragma unroll
            for (int o = 1; o < 16; o <<= 1) krmax = fmaxf(krmax, __shfl_xor(krmax, o));
            if (lane == 0) atomicMax((unsigned*)(ws + WS_KMX) + 32 + ((u.pm * 256) >> 13), __float_as_uint(krmax)); }
    }
};
struct EpiP2 {
    static constexpr bool PERM = true;
    unsigned char* ws;
    __device__ __forceinline__ void operator()(EPI_ARGS) const {
        const int pn = u.pn; const bool isq = u.aux == 0; float kmax[2] = {0.f, 0.f};
        const float* tabm = (const float*)(ws + WS_TABM); const float* ssq = (const float*)(ws + WS_SSQ);
#pragma unroll
        for (int ai = 0; ai < 2; ++ai)
#pragma unroll
            for (int m = 0; m < 4; ++m) {
                const int row = u.pm * 256 + ai * 128 + wr * 64 + m * 16 + fr; const int b = row >> 13, s = row & 8191;
                const float* sq = ssq + (size_t)row * 24; float rstd;
                if (isq) { const f32x4 a = *(const f32x4*)sq, bq = *(const f32x4*)(sq + 4), cq = *(const f32x4*)(sq + 8);
                    rstd = rsqrtf((((a[0] + a[1]) + (a[2] + a[3])) + ((bq[0] + bq[1]) + (bq[2] + bq[3])) + ((cq[0] + cq[1]) + (cq[2] + cq[3]))) * (1.f / 384.f) + EPS) * QSCALE_M; }
                else { const f32x4 a = *(const f32x4*)(sq + 12), bq = *(const f32x4*)(sq + 16);
                    rstd = rsqrtf((((a[0] + a[1]) + (a[2] + a[3])) + ((bq[0] + bq[1]) + (bq[2] + bq[3]))) * (1.f / 256.f) + EPS); }
#pragma unroll
                for (int bj = 0; bj < 2; ++bj) {
                    f32x4 v0 = acc[ai][bj][m][0] * rstd, v1 = acc[ai][bj][m][1] * rstd;
                    const int ct = bj * 128 + wc * 32 + 8 * fq, cc = (pn & 1) * 256 + ct;
                    if (isq) {
                        if (pn < 2) { const int hh = cc >> 6, d = cc & 63; *(u32x4*)((bf16_t*)(ws + WS_Q) + ((size_t)(b * 8 + hh) * S + s) * 96 + d) = pack8(v0, v1); }
                        else { const int hh = ct >> 5; const int f0 = 8 * (fq & 1); rope8(v0, v1, 32, tabm + (size_t)row * 32 + f0, tabm + (size_t)row * 32 + 16 + f0, fq < 2);
                            *(u32x4*)((bf16_t*)(ws + WS_Q) + ((size_t)(b * 8 + hh) * S + s) * 96 + 64 + 8 * fq) = pack8(v0, v1); }
                    } else { const int hh = cc >> 6, d = cc & 63; bf16_t* dst = (bf16_t*)(ws + (pn < 2 ? WS_KN : WS_V));
                        *(u32x4*)(dst + ((size_t)(b * 8 + hh) * S + s) * 64 + d) = pack8(v0, v1);
                        if (pn < 2) { float q2 = (v0[0] * v0[0] + v0[1] * v0[1]) + (v0[2] * v0[2] + v0[3] * v0[3]) + (v1[0] * v1[0] + v1[1] * v1[1]) + (v1[2] * v1[2] + v1[3] * v1[3]);
                            q2 += __shfl_xor(q2, 16); q2 += __shfl_xor(q2, 32); kmax[bj] = fmaxf(kmax[bj], q2); } }
                }
            }
        if (!isq && pn < 2) {
#pragma unroll
            for (int bj = 0; bj < 2; ++bj) { float km = kmax[bj];
#pragma unroll
                for (int o = 1; o < 16; o <<= 1) km = fmaxf(km, __shfl_xor(km, o));
                const int cc = (pn & 1) * 256 + bj * 128 + wc * 32, hh = cc >> 6, half = (cc >> 5) & 1, b = (u.pm * 256) >> 13;
                if (lane == 0) atomicMax((unsigned*)(ws + WS_KMX) + (b * 8 + hh) * 2 + half, __float_as_uint(km)); }
        }
    }
};

constexpr size_t WS_PCNT = 56 * KiB;
struct SchedP12 {
    static constexpr bool GATHER = false;
    const char *HB, *WIN, *CQ, *WUQ, *WUKV; unsigned* cnt; int G, vcu, c;
    __device__ __forceinline__ bool next(int i, gm::Unit& u) const {
        u.gidx = nullptr;
        if (G == 256) {
            const int n1 = c < 64 ? 3 : 2;
            if (i < n1) { int pm, pn; static_tile(i, 256, c, 64, 9, pm, pn);
                u.A = HB; u.Bt = WIN; u.lda2 = 2048; u.ldb2 = 2048; u.arow0 = pm * 256; u.brow0 = pn * 256; u.nt = 16; u.pm = pm; u.pn = pn; u.aux = 2; return true; }
            if (c < 64) return false;
            const int idx = (c - 64) + 192 * (i - 2); if (i - 2 >= 3 || idx >= 448) return false;
            if (idx < 256) { int pm, pn; static_tile(0, 256, idx, 64, 4, pm, pn); u.A = CQ + 768; u.Bt = WUKV; u.lda2 = 1536; u.ldb2 = 512; u.nt = 4; u.arow0 = pm * 256; u.brow0 = pn * 256; u.pm = pm; u.pn = pn; u.aux = 1; }
            else { int pm, pn; static_tile(0, 192, idx - 256, 64, 3, pm, pn); u.A = CQ; u.Bt = WUQ; u.lda2 = 1536; u.ldb2 = 768; u.nt = 6; u.arow0 = pm * 256; u.brow0 = pn * 256; u.pm = pm; u.pn = pn; u.aux = 0; }
            return true;
        }
        const int n1 = (576 - vcu + G - 1) / G;
        if (i < n1) { const int k = vcu + G * i, pn = k >> 6, pm = k & 63;
            u.A = HB; u.Bt = WIN; u.lda2 = 2048; u.ldb2 = 2048; u.arow0 = pm * 256; u.brow0 = pn * 256; u.nt = 16; u.pm = pm; u.pn = pn; u.aux = 2; return true; }
        const int idx = vcu + G * (i - n1); if (idx >= 448) return false;
        if (idx < 256) { const int pm = idx & 63, pn = idx >> 6; u.A = CQ + 768; u.Bt = WUKV; u.lda2 = 1536; u.ldb2 = 512; u.nt = 4; u.arow0 = pm * 256; u.brow0 = pn * 256; u.pm = pm; u.pn = pn; u.aux = 1; }
        else { const int j = idx - 256, pm = j & 63, pn = j >> 6; u.A = CQ; u.Bt = WUQ; u.lda2 = 1536; u.ldb2 = 768; u.nt = 6; u.arow0 = pm * 256; u.brow0 = pn * 256; u.pm = pm; u.pn = pn; u.aux = 0; }
        return true;
    }
#ifndef P12_STAMP
#define P12_STAMP 0
#endif
    __device__ __forceinline__ void stamp(int ui, const gm::Unit& u, int wid, int lane) const {
#if P12_STAMP
        if (wid == 0 && lane == 0) { unsigned long long* ts = (unsigned long long*)((unsigned char*)cnt - WS_PCNT + 128 * KiB) + (size_t)c * 8; ts[1 + ui] = __builtin_amdgcn_s_memrealtime(); ts[6] = (unsigned long long)(ui + 1); ts[7] = (u.aux == 2) ? (unsigned long long)(ui + 1) : ts[7]; }
#endif
    }
    __device__ __forceinline__ void a_ready(const gm::Unit& u, int wid, int) const {
        if (u.aux == 2) return;
        if (wid == 0) { unsigned* p = cnt + 16 * u.pm; unsigned spins = 0;
            while ((unsigned)__builtin_amdgcn_readfirstlane(__hip_atomic_load(p, __ATOMIC_RELAXED, __HIP_MEMORY_SCOPE_AGENT)) < 24u) { __builtin_amdgcn_s_sleep(2); if (++spins > (1u << 22)) break; }
            __builtin_amdgcn_fence(__ATOMIC_ACQUIRE, "agent");
            asm volatile("s_waitcnt vmcnt(0)" ::: "memory"); }
        asm volatile("" ::: "memory"); __builtin_amdgcn_s_barrier(); asm volatile("" ::: "memory");
    }
    __device__ __forceinline__ void done(const gm::Unit& u, int lane) const {
        if (u.aux != 2 || u.pn >= 3) return;
        asm volatile("s_waitcnt vmcnt(0)" ::: "memory");
        if (lane == 0) __hip_atomic_fetch_add(cnt + 16 * u.pm, 1u, __ATOMIC_RELAXED, __HIP_MEMORY_SCOPE_AGENT);
    }
};
struct EpiP12 {
    static constexpr bool PERM = true;
    unsigned char* ws;
    __device__ __forceinline__ void operator()(EPI_ARGS) const { if (u.aux == 2) { EpiP1 e{ws}; e(acc, u, wr, wc, fr, fq, lane); } else { EpiP2 e{ws}; e(acc, u, wr, wc, fr, fq, lane); } }
};
}
namespace mk {
#define RLX_AGENT __ATOMIC_RELAXED, __HIP_MEMORY_SCOPE_AGENT
#define XB_TMO      128
#define XB_XCNT(j)  (256  + 64 * (j))
#define XB_XSUB(j)  (1280 + 64 * (j))
#define XB_XGEN(j)  (2304 + 64 * (j))
#define XB_TOP      3328
#define XB_TOPGEN   3392
#define XCD_BAR_WORDS 3456
#define XB_SPIN_CAP (1u << 18)
__device__ __forceinline__ unsigned xb_ld(unsigned* p)              { return __hip_atomic_load(p, __ATOMIC_RELAXED, __HIP_MEMORY_SCOPE_AGENT); }
__device__ __forceinline__ unsigned xb_add(unsigned* p, unsigned v) { return __hip_atomic_fetch_add(p, v, __ATOMIC_RELAXED, __HIP_MEMORY_SCOPE_AGENT); }
__device__ __forceinline__ unsigned xb_xcc_id() { return (unsigned)__builtin_amdgcn_s_getreg((3 << 11) | 20) & 0xFu; }
#define XB_SPIN(cond, bar) do { unsigned _sp = 0; while (cond) { __builtin_amdgcn_s_sleep(1); \
    if ((++_sp & 255u) == 0u) { if (xb_ld(&(bar)[XB_TMO])) break; if (_sp > XB_SPIN_CAP) { atomicAdd(&(bar)[XB_TMO], 1u); break; } } } } while (0)
struct XcdBarrier { unsigned* bar; unsigned x; volatile LAS unsigned* st; };
__device__ __forceinline__ XcdBarrier xcd_barrier_post(unsigned* bar, volatile LAS unsigned* st, bool first_thread) {
    XcdBarrier b; b.bar = bar; b.x = xb_xcc_id(); b.st = st;
    if (first_thread) (void)xb_add(&bar[XB_XCNT(b.x)], 1u);
    return b;
}
__device__ __forceinline__ void xcd_barrier_complete(unsigned* bar, unsigned x, unsigned& nloc, unsigned& nx) {
    const unsigned G = gridDim.x * gridDim.y * gridDim.z;
    unsigned sum, cnt, mine, sp = 0u;
    for (;;) {
        sum = 0u; cnt = 0u; mine = 0u;
#pragma unroll
        for (unsigned j = 0; j < 16; ++j) { const unsigned c = xb_ld(&bar[XB_XCNT(j)]); sum += c; cnt += (c > 0u) ? 1u : 0u; mine = (j == x) ? c : mine; }
        if (sum == G) break;
        __builtin_amdgcn_s_sleep(1);
        if ((++sp & 255u) == 0u) { if (xb_ld(&bar[XB_TMO])) break; if (sp > XB_SPIN_CAP) { atomicAdd(&bar[XB_TMO], 1u); break; } }
    }
    nloc = mine > 0u ? mine : 1u; nx = cnt > 0u ? cnt : 1u;
}
__device__ __forceinline__ void xcd_barrier(const XcdBarrier& b, bool first_thread) {
    asm volatile("s_waitcnt vmcnt(0)" ::: "memory");
    __syncthreads();
    if (first_thread) {
        unsigned* bar = b.bar;
        __builtin_amdgcn_s_waitcnt(0);
        unsigned nloc = b.st[0], nx = b.st[1];
        if (nloc == 0u) { xcd_barrier_complete(bar, b.x, nloc, nx); b.st[0] = nloc; b.st[1] = nx; }
        const unsigned old = xb_add(&bar[XB_XSUB(b.x)], 1u);
        const unsigned gen = old / nloc;
        if (old + 1u == (gen + 1u) * nloc) {
            __builtin_amdgcn_fence(__ATOMIC_RELEASE, "agent");
            asm volatile("s_waitcnt vmcnt(0)" ::: "memory");
            const unsigned og = xb_add(&bar[XB_TOP], 1u);
            const unsigned tg = og / nx;
            if (og + 1u == (tg + 1u) * nx) xb_add(&bar[XB_TOPGEN], 1u);
            else XB_SPIN(xb_ld(&bar[XB_TOPGEN]) == tg, bar);
            __builtin_amdgcn_fence(__ATOMIC_ACQUIRE, "agent");
            xb_add(&bar[XB_XGEN(b.x)], 1u);
            asm volatile("s_waitcnt vmcnt(0)" ::: "memory");
        } else {
            XB_SPIN(xb_ld(&bar[XB_XGEN(b.x)]) == gen, bar);
            __builtin_amdgcn_fence(__ATOMIC_ACQUIRE, "agent");
            asm volatile("s_waitcnt vmcnt(0)" ::: "memory");
        }
    }
    __syncthreads();
}
}
namespace at {
using bf16x8 = __attribute__((ext_vector_type(8))) short;
using s16x4 = __attribute__((ext_vector_type(4))) short;
using f32x16 = __attribute__((ext_vector_type(16))) float;
using u32x4 = __attribute__((ext_vector_type(4))) unsigned;
constexpr int S = 8192, T = 16384;
constexpr float THR = 8.f;
#define SBAR() __builtin_amdgcn_sched_barrier(0)
__device__ __forceinline__ int crow(int r, int hi) { return (r & 3) + 8 * (r >> 2) + 4 * hi; }
__device__ __forceinline__ unsigned cvtpk(float lo, float hi) { unsigned r; asm volatile("v_cvt_pk_bf16_f32 %0, %1, %2" : "=v"(r) : "v"(lo), "v"(hi)); return r; }
__device__ __forceinline__ float rowmax32(const f32x16& p0, const f32x16& p1) {
    float pmax = p0[0];
#pragma unroll
    for (int r = 1; r < 16; ++r) pmax = fmaxf(pmax, p0[r]);
#pragma unroll
    for (int r = 0; r < 16; ++r) pmax = fmaxf(pmax, p1[r]);
    auto rr = __builtin_amdgcn_permlane32_swap(__float_as_uint(pmax), __float_as_uint(pmax), false, false);
    return fmaxf(__uint_as_float(rr[0]), __uint_as_float(rr[1]));
}
__device__ __forceinline__ void partialSM(f32x16& p0, f32x16& p1, float& m_reg, float& mn, float& alpha) {
    const float pmax = rowmax32(p0, p1);
    if (__builtin_expect(__all(pmax - m_reg <= THR), 1)) { mn = m_reg; alpha = 1.f; }
    else { mn = fmaxf(m_reg, pmax); alpha = __builtin_amdgcn_exp2f(m_reg - mn); m_reg = mn; }
#pragma unroll
    for (int r = 0; r < 16; ++r) p0[r] = p0[r] - mn;
#pragma unroll
    for (int r = 0; r < 16; ++r) p1[r] = p1[r] - mn;
#pragma unroll
    for (int r = 0; r < 16; ++r) p0[r] = __builtin_amdgcn_exp2f(p0[r]);
}
#define PK4(P, BASE, OUT) do { u32x4 w = {cvtpk(P[BASE + 0], P[BASE + 1]), cvtpk(P[BASE + 2], P[BASE + 3]), cvtpk(P[BASE + 4], P[BASE + 5]), cvtpk(P[BASE + 6], P[BASE + 7])}; \
    OUT = *reinterpret_cast<bf16x8*>(&w); } while (0)
__device__ __forceinline__ void finishSM(f32x16& p0, f32x16& p1, float alpha, float& l_reg, bf16x8& pa0, bf16x8& pa1, bf16x8& pa2, bf16x8& pa3) {
#pragma unroll
    for (int r = 0; r < 16; ++r) p1[r] = __builtin_amdgcn_exp2f(p1[r]);
    float ps = 0;
#pragma unroll
    for (int r = 0; r < 16; ++r) ps += p0[r];
#pragma unroll
    for (int r = 0; r < 16; ++r) ps += p1[r];
    { auto rr = __builtin_amdgcn_permlane32_swap(__float_as_uint(ps), __float_as_uint(ps), false, false); ps = __uint_as_float(rr[0]) + __uint_as_float(rr[1]); }
    l_reg = l_reg * alpha + ps;
    PK4(p0, 0, pa0); PK4(p0, 8, pa1); PK4(p1, 0, pa2); PK4(p1, 8, pa3);
}
__device__ __forceinline__ int v_st(int k, int c) { const int kk = k; return ((kk >> 3) * 2 + (c >> 5)) * 512 + ((kk & 7) * 32 + (c & 31)) * 2; }
__device__ __forceinline__ int v_rd_base(int lane) { return ((lane & 3) << 3) | (((lane >> 2) & 3) << 6) | (((lane >> 4) & 1) << 5) | (((lane >> 5) & 1) << 8); }
constexpr int v_rd_off(int d0, int ks, int half) { return d0 * 512 + ks * 2048 + half * 1024; }
template <int OFF> __device__ __forceinline__ s16x4 tr_read(int vb) { s16x4 r; asm volatile("ds_read_b64_tr_b16 %0, %1 offset:%2" : "=&v"(r) : "v"(vb), "i"(OFF) : "memory"); return r; }
#define PKV(L, H) (bf16x8){L[0], L[1], L[2], L[3], H[0], H[1], H[2], H[3]}
template <int D0, int KOFF> __device__ __forceinline__ void pv_one(f32x16& od, int vb, bf16x8 pa0, bf16x8 pa1, bf16x8 pa2, bf16x8 pa3) {
    const s16x4 l0 = tr_read<KOFF + v_rd_off(D0, 0, 0)>(vb), h0 = tr_read<KOFF + v_rd_off(D0, 0, 1)>(vb), l1 = tr_read<KOFF + v_rd_off(D0, 1, 0)>(vb), h1 = tr_read<KOFF + v_rd_off(D0, 1, 1)>(vb);
    const s16x4 l2 = tr_read<KOFF + v_rd_off(D0, 2, 0)>(vb), h2 = tr_read<KOFF + v_rd_off(D0, 2, 1)>(vb), l3 = tr_read<KOFF + v_rd_off(D0, 3, 0)>(vb), h3 = tr_read<KOFF + v_rd_off(D0, 3, 1)>(vb);
    asm volatile("s_waitcnt lgkmcnt(0)" ::: "memory"); SBAR();
    od = __builtin_amdgcn_mfma_f32_32x32x16_bf16(pa0, PKV(l0, h0), od, 0, 0, 0);
    od = __builtin_amdgcn_mfma_f32_32x32x16_bf16(pa1, PKV(l1, h1), od, 0, 0, 0);
    od = __builtin_amdgcn_mfma_f32_32x32x16_bf16(pa2, PKV(l2, h2), od, 0, 0, 0);
    od = __builtin_amdgcn_mfma_f32_32x32x16_bf16(pa3, PKV(l3, h3), od, 0, 0, 0);
}
template <int D0, int KOFF> __device__ __forceinline__ void pv_half(f32x16& od, int vb, bf16x8 pa0, bf16x8 pa1) {
    const s16x4 l0 = tr_read<KOFF + v_rd_off(D0, 0, 0)>(vb), h0 = tr_read<KOFF + v_rd_off(D0, 0, 1)>(vb), l1 = tr_read<KOFF + v_rd_off(D0, 1, 0)>(vb), h1 = tr_read<KOFF + v_rd_off(D0, 1, 1)>(vb);
    asm volatile("s_waitcnt lgkmcnt(0)" ::: "memory"); SBAR();
    od = __builtin_amdgcn_mfma_f32_32x32x16_bf16(pa0, PKV(l0, h0), od, 0, 0, 0);
    od = __builtin_amdgcn_mfma_f32_32x32x16_bf16(pa1, PKV(l1, h1), od, 0, 0, 0);
}
template <class RowOff> __device__ __forceinline__ void store_o_tile(const f32x16 (&o)[2], const float (&rli)[16], unsigned short* stg, unsigned short* dst, RowOff row_off, int lane) {
    const int r32 = lane & 31, hi = lane >> 5;
#pragma unroll
    for (int r = 0; r < 16; ++r) { const int orow = crow(r, hi);
#pragma unroll
        for (int d0 = 0; d0 < 2; ++d0) stg[orow * 64 + d0 * 32 + r32] = (unsigned short)(cvtpk(o[d0][r] * rli[r], 0.f) & 0xffffu); }
    asm volatile("s_waitcnt lgkmcnt(0)" ::: "memory");
#pragma unroll
    for (int i = 0; i < 4; ++i) { const int row = i * 8 + (lane >> 3), ch = lane & 7; const u32x4 v = *(const u32x4*)(stg + row * 64 + ch * 8); *(u32x4*)(dst + row_off(row) + ch * 8) = v; }
    asm volatile("s_waitcnt lgkmcnt(0)" ::: "memory");
}

__device__ __forceinline__ bool wg_or(bool pred, unsigned* flags8, int wid, int lane) {
    const bool w = __any(pred); if (lane == 0) flags8[wid] = w ? 1u : 0u;
    __syncthreads();
    unsigned r = 0u;
#pragma unroll
    for (int i = 0; i < 8; ++i) r |= flags8[i];
    __syncthreads();
    return r != 0u;
}
constexpr int SHM_V = 8192, SHM_K = 16384, MLA_WS = 2 * SHM_V + 2 * SHM_K, MLA_OST = MLA_WS + 8 * 256;
#define KSWZ(row, colB) ((row) * 256 + ((colB) ^ (((row) & 15) << 4)))
__device__ __forceinline__ void qkt96(f32x16& p0, f32x16& p1, const char* Ks, const bf16x8* qr, int r32, int hi) {
    p0 = f32x16{}; p1 = f32x16{};
#pragma unroll
    for (int d0 = 0; d0 < 6; ++d0) { const int cb = (d0 * 16 + hi * 8) * 2;
        const bf16x8 b0 = *reinterpret_cast<const bf16x8*>(Ks + KSWZ(r32, cb));
        const bf16x8 b1 = *reinterpret_cast<const bf16x8*>(Ks + KSWZ(32 + r32, cb));
        p0 = __builtin_amdgcn_mfma_f32_32x32x16_bf16(b0, qr[d0], p0, 0, 0, 0);
        p1 = __builtin_amdgcn_mfma_f32_32x32x16_bf16(b1, qr[d0], p1, 0, 0, 0); }
}
__device__ __forceinline__ void pv64(f32x16* o, int vb, bf16x8 pa0, bf16x8 pa1, bf16x8 pa2, bf16x8 pa3) {
    pv_one<0, 0>(o[0], vb, pa0, pa1, pa2, pa3); pv_one<1, 0>(o[1], vb, pa0, pa1, pa2, pa3);
}
__device__ __forceinline__ void mla_unit(int wv, int bh, int qb, const unsigned short* __restrict__ Q, const unsigned short* __restrict__ KN, const unsigned short* __restrict__ KR,
                                         const unsigned short* __restrict__ V, unsigned short* __restrict__ CAT, char* lds) {
    const int wid = wv, lane = gm::lane_now(), tid = wid * 64 + lane, r32 = lane & 31, hi = lane >> 5;
    const int b = bh >> 3, h = bh & 7;
    char* V_lds = lds; char* K_lds = lds + 2 * SHM_V;
    float* wsf = (float*)(lds + MLA_WS) + wid * 64; float* li_l = wsf; float* al_l = wsf + 32;
    float m_reg = -1e30f, l_reg = 0; f32x16 o[2] = {}; bf16x8 qr[6];
    const size_t bhS = (size_t)bh * S; const int q0 = qb * 256;
    const unsigned short* Qw = Q + (bhS + q0 + wid * 32 + r32) * 96 + hi * 8;
#pragma unroll
    for (int d0 = 0; d0 < 6; ++d0) qr[d0] = *reinterpret_cast<const bf16x8*>(Qw + d0 * 16);
    const int srow = tid >> 3, sch = tid & 7, rrow = (tid & 255) >> 2, rch = tid & 3;
    const unsigned short* kn_src = KN + (bhS + srow) * 64 + sch * 8;
    const unsigned short* v_src = V + (bhS + srow) * 64 + sch * 8;
    const unsigned short* kr_src = KR + ((size_t)b * S + rrow) * 32 + rch * 8;
    const int kst = KSWZ(srow, sch * 16), krst = KSWZ(rrow, (8 + rch) * 16), vst = v_st(srow, sch * 8);
    const int vb0 = (int)(uintptr_t)V_lds + v_rd_base(lane);
    bf16x8 s_kn[2], s_kr[2], s_v[2];
#define SLOAD(i, k0) do { s_kn[i] = *reinterpret_cast<const bf16x8*>(kn_src + (size_t)(k0) * 64); s_kr[i] = *reinterpret_cast<const bf16x8*>(kr_src + (size_t)(k0) * 32); \
    s_v[i] = *reinterpret_cast<const bf16x8*>(v_src + (size_t)(k0) * 64); } while (0)
#define SWRITE(bb, i) do { *(bf16x8*)(K_lds + (bb) * SHM_K + kst) = s_kn[i]; if (tid < 256) *(bf16x8*)(K_lds + (bb) * SHM_K + krst) = s_kr[i]; *(bf16x8*)(V_lds + (bb) * SHM_V + vst) = s_v[i]; } while (0)
#define SWAIT() asm volatile("s_waitcnt vmcnt(3)" ::: "memory")
#define RESC(a) do { if (__any((a) < 1.f)) { if (hi == 0) al_l[r32] = (a); asm volatile("s_waitcnt lgkmcnt(0)" ::: "memory"); \
    _Pragma("unroll") for (int d = 0; d < 2; ++d) _Pragma("unroll") for (int r = 0; r < 16; ++r) o[d][r] *= al_l[crow(r, hi)]; } } while (0)
    f32x16 pA0, pA1, pB0, pB1; float mnA, mnB, alA, alB; bf16x8 pa0, pa1, pa2, pa3; constexpr int NT = S / 64;
    SLOAD(0, 0); asm volatile("s_waitcnt vmcnt(0)" ::: "memory"); SWRITE(0, 0); __syncthreads();
    qkt96(pA0, pA1, K_lds, qr, r32, hi); partialSM(pA0, pA1, m_reg, mnA, alA);
    SLOAD(1, 64); SLOAD(0, 128);
    SWAIT(); SWRITE(1, 1); __syncthreads();
    for (int j = 1; j + 1 < NT; j += 2) {
        SBAR(); qkt96(pB0, pB1, K_lds + SHM_K, qr, r32, hi);
        finishSM(pA0, pA1, alA, l_reg, pa0, pa1, pa2, pa3); SBAR();
        SLOAD(1, (j + 2) * 64); SBAR();
        pv64(o, vb0, pa0, pa1, pa2, pa3); partialSM(pB0, pB1, m_reg, mnB, alB);
        __syncthreads(); SWAIT(); SWRITE(0, 0);
        RESC(alB); __syncthreads();
        SBAR(); qkt96(pA0, pA1, K_lds, qr, r32, hi);
        finishSM(pB0, pB1, alB, l_reg, pa0, pa1, pa2, pa3); SBAR();
        if (j + 3 < NT) SLOAD(0, (j + 3) * 64); SBAR();
        pv64(o, vb0 + SHM_V, pa0, pa1, pa2, pa3); partialSM(pA0, pA1, m_reg, mnA, alA);
        __syncthreads(); SWAIT(); SWRITE(1, 1);
        RESC(alA); __syncthreads();
    }
    SBAR(); qkt96(pB0, pB1, K_lds + SHM_K, qr, r32, hi);
    finishSM(pA0, pA1, alA, l_reg, pa0, pa1, pa2, pa3); SBAR();
    pv64(o, vb0, pa0, pa1, pa2, pa3); partialSM(pB0, pB1, m_reg, mnB, alB);
    __syncthreads(); RESC(alB);
    finishSM(pB0, pB1, alB, l_reg, pa0, pa1, pa2, pa3); SBAR();
    pv64(o, vb0 + SHM_V, pa0, pa1, pa2, pa3);
    if (hi == 0) li_l[r32] = l_reg; asm volatile("s_waitcnt lgkmcnt(0)" ::: "memory");
    float rli[16];
#pragma unroll
    for (int r = 0; r < 16; ++r) rli[r] = __builtin_amdgcn_rcpf(li_l[crow(r, hi)]);
    unsigned short* stg = (unsigned short*)(lds + MLA_OST) + wid * 2048;
    unsigned short* dst = CAT + ((size_t)b * S + q0 + wid * 32) * 1024 + h * 64;
    store_o_tile(o, rli, stg, dst, [](int row) { return (size_t)row * 1024; }, lane);
    asm volatile("s_waitcnt vmcnt(0)" ::: "memory");
    __syncthreads();
#undef SLOAD
#undef SWRITE
#undef SWAIT
#undef RESC
}


#ifndef V7_YOUNG_PRIO
#define V7_YOUNG_PRIO 1
#endif
#ifndef V7_EXACT
#define V7_EXACT 1
#endif
#ifndef MLA_STAMP
#define MLA_STAMP 0
#endif
#ifndef MLA_STAMP_WAVE
#define MLA_STAMP_WAVE 0
#endif
#if MLA_STAMP
#define STAMP_T(var) do { __builtin_amdgcn_sched_barrier(0); asm volatile("s_memtime %0\n\ts_waitcnt lgkmcnt(0)" : "=s"(var) :: "memory"); __builtin_amdgcn_sched_barrier(0); } while (0)
#define STAMP_ACC(i, t0_, t1_) (st_acc[i] += (t1_) - (t0_))
#else
#define STAMP_T(var) do { } while (0)
#define STAMP_ACC(i, t0_, t1_) do { } while (0)
#endif
#ifndef STAMP_SEC
#define STAMP_SEC 3
#endif
#if MLA_STAMP
#define SEC_B(i) do { if ((i) == STAMP_SEC) STAMP_T(tq0); } while (0)
#define SEC_E(i) do { if ((i) == STAMP_SEC) { STAMP_T(tq1); st_a += tq1 - tq0; } } while (0)
#else
#define SEC_B(i) do { } while (0)
#define SEC_E(i) do { } while (0)
#endif
constexpr int M2_K = 0, M2_V = 3 * SHM_K, M2_WS = M2_V + 3 * SHM_V, M2_OST = M2_WS + 8 * 256;
#ifndef MLA_PROBE_NOSTAGE
#define MLA_PROBE_NOSTAGE 0
#endif
#ifndef MLA_STATIC
#define MLA_STATIC 1
#endif
#ifndef MLA_STATIC_THR
#define MLA_STATIC_THR 60.f
#endif
#ifndef MLA_STEP_MODE
#define MLA_STEP_MODE 0
#endif
#ifndef MLA_PROBE_VALU
#define MLA_PROBE_VALU 0
#endif
#ifndef MLA_NEGM
#define MLA_NEGM 1
#endif
#ifndef MLA_PRIO
#define MLA_PRIO 0
#endif
__device__ __forceinline__ void qkt96n(f32x16& p0, f32x16& p1, const char* Ks, const bf16x8* qr, const f32x16& negm, int r32, int hi, bool usec = true) {
    if (MLA_PRIO) __builtin_amdgcn_s_setprio(1);
#pragma unroll
    for (int d0 = 0; d0 < 6; ++d0) { const int cb = (d0 * 16 + hi * 8) * 2;
        const bf16x8 b0 = *reinterpret_cast<const bf16x8*>(Ks + KSWZ(r32, cb));
        const bf16x8 b1 = *reinterpret_cast<const bf16x8*>(Ks + KSWZ(32 + r32, cb));
        if (d0 == 0 && !usec) { p0 = __builtin_amdgcn_mfma_f32_32x32x16_bf16(b0, qr[0], f32x16{}, 0, 0, 0); p1 = __builtin_amdgcn_mfma_f32_32x32x16_bf16(b1, qr[0], f32x16{}, 0, 0, 0); }
        else if (d0 == 0) { p0 = __builtin_amdgcn_mfma_f32_32x32x16_bf16(b0, qr[0], MLA_NEGM ? negm : f32x16{}, 0, 0, 0); p1 = __builtin_amdgcn_mfma_f32_32x32x16_bf16(b1, qr[0], MLA_NEGM ? negm : f32x16{}, 0, 0, 0); }
        else { p0 = __builtin_amdgcn_mfma_f32_32x32x16_bf16(b0, qr[d0], p0, 0, 0, 0); p1 = __builtin_amdgcn_mfma_f32_32x32x16_bf16(b1, qr[d0], p1, 0, 0, 0); } }
    if (MLA_PRIO) __builtin_amdgcn_s_setprio(0);
}
__device__ __forceinline__ void qkt96z(f32x16& p0, f32x16& p1, const char* Ks, const bf16x8* qr, int r32, int hi) {
#pragma unroll
    for (int d0 = 0; d0 < 6; ++d0) { const int cb = (d0 * 16 + hi * 8) * 2;
        const bf16x8 b0 = *reinterpret_cast<const bf16x8*>(Ks + KSWZ(r32, cb));
        const bf16x8 b1 = *reinterpret_cast<const bf16x8*>(Ks + KSWZ(32 + r32, cb));
        if (d0 == 0) { p0 = __builtin_amdgcn_mfma_f32_32x32x16_bf16(b0, qr[0], f32x16{}, 0, 0, 0); p1 = __builtin_amdgcn_mfma_f32_32x32x16_bf16(b1, qr[0], f32x16{}, 0, 0, 0); }
        else { p0 = __builtin_amdgcn_mfma_f32_32x32x16_bf16(b0, qr[d0], p0, 0, 0, 0); p1 = __builtin_amdgcn_mfma_f32_32x32x16_bf16(b1, qr[d0], p1, 0, 0, 0); } }
}
__device__ __forceinline__ float rowmax32b(const f32x16& p0, const f32x16& p1) {
    float a = fmaxf(fmaxf(p0[0], p0[1]), p1[0]), b = fmaxf(fmaxf(p0[2], p0[3]), p1[1]); a = fmaxf(fmaxf(a, p1[2]), p1[3]);
#pragma unroll
    for (int r = 4; r < 16; r += 4) { a = fmaxf(fmaxf(a, p0[r]), p0[r + 1]); b = fmaxf(fmaxf(b, p0[r + 2]), p0[r + 3]); a = fmaxf(fmaxf(a, p1[r]), p1[r + 1]); b = fmaxf(fmaxf(b, p1[r + 2]), p1[r + 3]); }
    const float m = fmaxf(a, b);
    auto rr = __builtin_amdgcn_permlane32_swap(__float_as_uint(m), __float_as_uint(m), false, false);
    return fmaxf(__uint_as_float(rr[0]), __uint_as_float(rr[1]));
}
template <bool FIRST> __device__ __forceinline__ void partialSM2(f32x16& p0, f32x16& p1, float& m_reg, f32x16& negm, float& alpha, bool exact = true) {
    if (!exact) { alpha = 1.f;
#pragma unroll
        for (int r = 0; r < 16; ++r) p0[r] = __builtin_amdgcn_exp2f(p0[r]);
        return; }
    if (MLA_PROBE_VALU) { float d0_ = p1[0], d1_ = p1[1], d2_ = p1[2], d3_ = p1[3];
#pragma unroll
        for (int i = 0; i < 8; ++i) { d0_ = __builtin_amdgcn_exp2f(d0_); d1_ = __builtin_amdgcn_exp2f(d1_); d2_ = __builtin_amdgcn_exp2f(d2_); d3_ = __builtin_amdgcn_exp2f(d3_); }
        asm volatile("" :: "v"(d0_), "v"(d1_), "v"(d2_), "v"(d3_)); }
    if (!MLA_NEGM) {
        const float pm = rowmax32b(p0, p1); alpha = 1.f;
        if (FIRST) m_reg = pm; else if (!__builtin_expect(__all(pm - m_reg <= THR), 1)) { const float mn = fmaxf(m_reg, pm); alpha = __builtin_amdgcn_exp2f(m_reg - mn); m_reg = mn; }
#pragma unroll
        for (int r = 0; r < 16; ++r) { p0[r] -= m_reg; p1[r] -= m_reg; }
#pragma unroll
        for (int r = 0; r < 16; ++r) p0[r] = __builtin_amdgcn_exp2f(p0[r]);
        return; }
    const float pmax = rowmax32b(p0, p1);
    alpha = 1.f;
    if (FIRST || !__builtin_expect(__all(pmax <= THR), 1)) {
        const float dl = FIRST ? pmax : fmaxf(pmax, 0.f); m_reg += dl;
#pragma unroll
        for (int r = 0; r < 16; ++r) { p0[r] -= dl; p1[r] -= dl; }
#pragma unroll
        for (int r = 0; r < 16; ++r) negm[r] = -m_reg;
        if (!FIRST) alpha = __builtin_amdgcn_exp2f(-dl);
    }
#pragma unroll
    for (int r = 0; r < 16; ++r) p0[r] = __builtin_amdgcn_exp2f(p0[r]);
}
template <int D0> __device__ __forceinline__ void pv_one_p(f32x16& od, int vb, bf16x8 pa0, bf16x8 pa1, bf16x8 pa2, bf16x8 pa3) {
    const s16x4 l0 = tr_read<v_rd_off(D0, 0, 0)>(vb), h0 = tr_read<v_rd_off(D0, 0, 1)>(vb), l1 = tr_read<v_rd_off(D0, 1, 0)>(vb), h1 = tr_read<v_rd_off(D0, 1, 1)>(vb);
    const s16x4 l2 = tr_read<v_rd_off(D0, 2, 0)>(vb), h2 = tr_read<v_rd_off(D0, 2, 1)>(vb), l3 = tr_read<v_rd_off(D0, 3, 0)>(vb), h3 = tr_read<v_rd_off(D0, 3, 1)>(vb);
    asm volatile("s_waitcnt lgkmcnt(0)" ::: "memory"); SBAR();
    if (MLA_PRIO) __builtin_amdgcn_s_setprio(1);
    od = __builtin_amdgcn_mfma_f32_32x32x16_bf16(pa0, PKV(l0, h0), od, 0, 0, 0);
    od = __builtin_amdgcn_mfma_f32_32x32x16_bf16(pa1, PKV(l1, h1), od, 0, 0, 0);
    od = __builtin_amdgcn_mfma_f32_32x32x16_bf16(pa2, PKV(l2, h2), od, 0, 0, 0);
    od = __builtin_amdgcn_mfma_f32_32x32x16_bf16(pa3, PKV(l3, h3), od, 0, 0, 0);
    if (MLA_PRIO) __builtin_amdgcn_s_setprio(0);
}

__device__ __forceinline__ void kfrag_load(bf16x8 (&kf)[12], const char* Ks, int r32, int hi) {
#pragma unroll
    for (int d0 = 0; d0 < 6; ++d0) { const int cb = (d0 * 16 + hi * 8) * 2;
        kf[2 * d0] = *reinterpret_cast<const bf16x8*>(Ks + KSWZ(r32, cb)); kf[2 * d0 + 1] = *reinterpret_cast<const bf16x8*>(Ks + KSWZ(32 + r32, cb)); }
}
__device__ __forceinline__ void qk_mma(f32x16& p0, f32x16& p1, const bf16x8 (&kf)[12], const bf16x8* qr, const f32x16& negm) {
    if (MLA_PRIO) __builtin_amdgcn_s_setprio(1);
    p0 = __builtin_amdgcn_mfma_f32_32x32x16_bf16(kf[0], qr[0], MLA_NEGM ? negm : f32x16{}, 0, 0, 0); p1 = __builtin_amdgcn_mfma_f32_32x32x16_bf16(kf[1], qr[0], MLA_NEGM ? negm : f32x16{}, 0, 0, 0);
#pragma unroll
    for (int d0 = 1; d0 < 6; ++d0) { p0 = __builtin_amdgcn_mfma_f32_32x32x16_bf16(kf[2 * d0], qr[d0], p0, 0, 0, 0); p1 = __builtin_amdgcn_mfma_f32_32x32x16_bf16(kf[2 * d0 + 1], qr[d0], p1, 0, 0, 0); }
    if (MLA_PRIO) __builtin_amdgcn_s_setprio(0);
}
template <int D0> __device__ __forceinline__ void vfrag_load_h(s16x4 (&vl)[4], s16x4 (&vh)[4], int vb) {
    vl[0] = tr_read<v_rd_off(D0, 0, 0)>(vb); vh[0] = tr_read<v_rd_off(D0, 0, 1)>(vb); vl[1] = tr_read<v_rd_off(D0, 1, 0)>(vb); vh[1] = tr_read<v_rd_off(D0, 1, 1)>(vb);
    vl[2] = tr_read<v_rd_off(D0, 2, 0)>(vb); vh[2] = tr_read<v_rd_off(D0, 2, 1)>(vb); vl[3] = tr_read<v_rd_off(D0, 3, 0)>(vb); vh[3] = tr_read<v_rd_off(D0, 3, 1)>(vb);
}
__device__ __forceinline__ void pv_mma_h(f32x16& od, const s16x4 (&vl)[4], const s16x4 (&vh)[4], bf16x8 pa0, bf16x8 pa1, bf16x8 pa2, bf16x8 pa3) {
    if (MLA_PRIO) __builtin_amdgcn_s_setprio(1);
    od = __builtin_amdgcn_mfma_f32_32x32x16_bf16(pa0, PKV(vl[0], vh[0]), od, 0, 0, 0);
    od = __builtin_amdgcn_mfma_f32_32x32x16_bf16(pa1, PKV(vl[1], vh[1]), od, 0, 0, 0);
    od = __builtin_amdgcn_mfma_f32_32x32x16_bf16(pa2, PKV(vl[2], vh[2]), od, 0, 0, 0);
    od = __builtin_amdgcn_mfma_f32_32x32x16_bf16(pa3, PKV(vl[3], vh[3]), od, 0, 0, 0);
    if (MLA_PRIO) __builtin_amdgcn_s_setprio(0);
}
#if MLA_STEP_MODE == 0
#define MLA_STEP(PC0, PC1, PP0, PP1, ALP, ALC) do { \
    STAMP_T(tq0); qkt96n(PC0, PC1, K_lds + sc * SHM_K, qr, negm, r32, hi); STAMP_T(tq1); STAMP_ACC(1, tq0, tq1); \
    finishSM(PP0, PP1, ALP, l_reg, pa0, pa1, pa2, pa3); SBAR(); STAMP_T(tq0); STAMP_ACC(2, tq1, tq0); \
    { const int vb_ = vb0 + sp * SHM_V; pv_one_p<0>(o[0], vb_, pa0, pa1, pa2, pa3); pv_one_p<1>(o[1], vb_, pa0, pa1, pa2, pa3); } STAMP_T(tq1); STAMP_ACC(3, tq0, tq1); \
    partialSM2<false>(PC0, PC1, m_reg, negm, ALC, exact); RESC(ALC); STAMP_T(tq0); STAMP_ACC(4, tq1, tq0); } while (0)
#elif MLA_STEP_MODE == 2
  \
#define SGB(mask, n) __builtin_amdgcn_sched_group_barrier(mask, n, 0)
#define MLA_STEP(PC0, PC1, PP0, PP1, ALP, ALC) do { \
    { const char* Ks_ = K_lds + sc * SHM_K; \
      _Pragma("unroll") for (int d0 = 0; d0 < 6; ++d0) { const int cb = (d0 * 16 + hi * 8) * 2; \
        const bf16x8 b0 = *reinterpret_cast<const bf16x8*>(Ks_ + KSWZ(r32, cb)); const bf16x8 b1 = *reinterpret_cast<const bf16x8*>(Ks_ + KSWZ(32 + r32, cb)); \
        if (d0 == 0) { PC0 = __builtin_amdgcn_mfma_f32_32x32x16_bf16(b0, qr[0], negm, 0, 0, 0); PC1 = __builtin_amdgcn_mfma_f32_32x32x16_bf16(b1, qr[0], negm, 0, 0, 0); } \
        else { PC0 = __builtin_amdgcn_mfma_f32_32x32x16_bf16(b0, qr[d0], PC0, 0, 0, 0); PC1 = __builtin_amdgcn_mfma_f32_32x32x16_bf16(b1, qr[d0], PC1, 0, 0, 0); } } } \
    finishSM(PP0, PP1, ALP, l_reg, pa0, pa1, pa2, pa3); \
    SGB(0x100, 4); \
    _Pragma("unroll") for (int g_ = 0; g_ < 12; ++g_) { SGB(0x008, 1); SGB(0x100, 1); SGB(0x002, 7); } \
    SBAR(); \
    { const int vb_ = vb0 + sp * SHM_V; \
      const s16x4 l0 = tr_read<v_rd_off(0, 0, 0)>(vb_), h0 = tr_read<v_rd_off(0, 0, 1)>(vb_), l1 = tr_read<v_rd_off(0, 1, 0)>(vb_), h1 = tr_read<v_rd_off(0, 1, 1)>(vb_); \
      const s16x4 l2 = tr_read<v_rd_off(0, 2, 0)>(vb_), h2 = tr_read<v_rd_off(0, 2, 1)>(vb_), l3 = tr_read<v_rd_off(0, 3, 0)>(vb_), h3 = tr_read<v_rd_off(0, 3, 1)>(vb_); \
      const s16x4 l4 = tr_read<v_rd_off(1, 0, 0)>(vb_), h4 = tr_read<v_rd_off(1, 0, 1)>(vb_), l5 = tr_read<v_rd_off(1, 1, 0)>(vb_), h5 = tr_read<v_rd_off(1, 1, 1)>(vb_); \
      const s16x4 l6 = tr_read<v_rd_off(1, 2, 0)>(vb_), h6 = tr_read<v_rd_off(1, 2, 1)>(vb_), l7 = tr_read<v_rd_off(1, 3, 0)>(vb_), h7 = tr_read<v_rd_off(1, 3, 1)>(vb_); \
      asm volatile("s_waitcnt lgkmcnt(0)" ::: "memory"); SBAR(); \
      o[0] = __builtin_amdgcn_mfma_f32_32x32x16_bf16(pa0, PKV(l0, h0), o[0], 0, 0, 0); o[1] = __builtin_amdgcn_mfma_f32_32x32x16_bf16(pa0, PKV(l4, h4), o[1], 0, 0, 0); \
      o[0] = __builtin_amdgcn_mfma_f32_32x32x16_bf16(pa1, PKV(l1, h1), o[0], 0, 0, 0); o[1] = __builtin_amdgcn_mfma_f32_32x32x16_bf16(pa1, PKV(l5, h5), o[1], 0, 0, 0); \
      o[0] = __builtin_amdgcn_mfma_f32_32x32x16_bf16(pa2, PKV(l2, h2), o[0], 0, 0, 0); o[1] = __builtin_amdgcn_mfma_f32_32x32x16_bf16(pa2, PKV(l6, h6), o[1], 0, 0, 0); \
      o[0] = __builtin_amdgcn_mfma_f32_32x32x16_bf16(pa3, PKV(l3, h3), o[0], 0, 0, 0); o[1] = __builtin_amdgcn_mfma_f32_32x32x16_bf16(pa3, PKV(l7, h7), o[1], 0, 0, 0); \
      partialSM2<false>(PC0, PC1, m_reg, negm, ALC, exact); \
      _Pragma("unroll") for (int g_ = 0; g_ < 8; ++g_) { SGB(0x008, 1); SGB(0x002, 2); } \
      SBAR(); } \
    RESC(ALC); } while (0)
#else
#define KFH(dst, Ks_, D0) do { _Pragma("unroll") for (int d_ = 0; d_ < 3; ++d_) { const int cb_ = (((D0) + d_) * 16 + hi * 8) * 2; \
        dst[2 * d_] = *reinterpret_cast<const bf16x8*>((Ks_) + KSWZ(r32, cb_)); dst[2 * d_ + 1] = *reinterpret_cast<const bf16x8*>((Ks_) + KSWZ(32 + r32, cb_)); } } while (0)
#define MLA_STEP(PC0, PC1, PP0, PP1, ALP, ALC) do { \
    bf16x8 ka[6], kb[6]; s16x4 val[4], vah[4], vbl[4], vbh[4]; const int vb_ = vb0 + sp * SHM_V; const char* Ks_ = K_lds + sc * SHM_K; \
    KFH(ka, Ks_, 0); SBAR(); \
    finishSM(PP0, PP1, ALP, l_reg, pa0, pa1, pa2, pa3); SBAR(); \
    KFH(kb, Ks_, 3); SBAR(); \
    if (exact) { PC0 = __builtin_amdgcn_mfma_f32_32x32x16_bf16(ka[0], qr[0], negm, 0, 0, 0); PC1 = __builtin_amdgcn_mfma_f32_32x32x16_bf16(ka[1], qr[0], negm, 0, 0, 0); } \
    else { PC0 = __builtin_amdgcn_mfma_f32_32x32x16_bf16(ka[0], qr[0], negm, 0, 0, 0); PC1 = __builtin_amdgcn_mfma_f32_32x32x16_bf16(ka[1], qr[0], negm, 0, 0, 0); } \
    PC0 = __builtin_amdgcn_mfma_f32_32x32x16_bf16(ka[2], qr[1], PC0, 0, 0, 0); PC1 = __builtin_amdgcn_mfma_f32_32x32x16_bf16(ka[3], qr[1], PC1, 0, 0, 0); \
    PC0 = __builtin_amdgcn_mfma_f32_32x32x16_bf16(ka[4], qr[2], PC0, 0, 0, 0); PC1 = __builtin_amdgcn_mfma_f32_32x32x16_bf16(ka[5], qr[2], PC1, 0, 0, 0); SBAR(); \
    vfrag_load_h<0>(val, vah, vb_); SBAR(); \
    PC0 = __builtin_amdgcn_mfma_f32_32x32x16_bf16(kb[0], qr[3], PC0, 0, 0, 0); PC1 = __builtin_amdgcn_mfma_f32_32x32x16_bf16(kb[1], qr[3], PC1, 0, 0, 0); \
    PC0 = __builtin_amdgcn_mfma_f32_32x32x16_bf16(kb[2], qr[4], PC0, 0, 0, 0); PC1 = __builtin_amdgcn_mfma_f32_32x32x16_bf16(kb[3], qr[4], PC1, 0, 0, 0); \
    PC0 = __builtin_amdgcn_mfma_f32_32x32x16_bf16(kb[4], qr[5], PC0, 0, 0, 0); PC1 = __builtin_amdgcn_mfma_f32_32x32x16_bf16(kb[5], qr[5], PC1, 0, 0, 0); SBAR(); \
    vfrag_load_h<1>(vbl, vbh, vb_); SBAR(); \
    asm volatile("s_waitcnt lgkmcnt(8)" ::: "memory"); SBAR(); \
    pv_mma_h(o[0], val, vah, pa0, pa1, pa2, pa3); SBAR(); \
    asm volatile("s_waitcnt lgkmcnt(0)" ::: "memory"); SBAR(); \
    pv_mma_h(o[1], vbl, vbh, pa0, pa1, pa2, pa3); SBAR(); \
    partialSM2<false>(PC0, PC1, m_reg, negm, ALC, exact); RESC(ALC); } while (0)
#endif

__device__ __forceinline__ void mla_unit_v2(int wv, int bh, int qb, const unsigned short* __restrict__ Q, const unsigned short* __restrict__ KN, const unsigned short* __restrict__ KR,
                                            const unsigned short* __restrict__ V, unsigned short* __restrict__ CAT, const float* __restrict__ KMX, char* lds, unsigned long long* STAMPS = nullptr) {
    const int wid = wv, lane = gm::lane_now(), tid = wid * 64 + lane, r32 = lane & 31, hi = lane >> 5;
    const int b = bh >> 3, h = bh & 7;
    char* K_lds = lds + M2_K; char* V_lds = lds + M2_V;
    float* wsf = (float*)(lds + M2_WS) + wid * 64; float* li_l = wsf; float* al_l = wsf + 32;
    float m_reg = 0.f, l_reg = 0; f32x16 o[2] = {}; bf16x8 qr[6]; f32x16 negm = f32x16{};
    const size_t bhS = (size_t)bh * S; const int q0 = qb * 256;
    const unsigned short* Qw = Q + (bhS + q0 + wid * 32 + r32) * 96 + hi * 8;
#pragma unroll
    for (int d0 = 0; d0 < 6; ++d0) qr[d0] = *reinterpret_cast<const bf16x8*>(Qw + d0 * 16);
    bool exact = true;
    if (MLA_STATIC) { float q2 = 0.f;
#pragma unroll
      for (int d0 = 0; d0 < 6; ++d0)
#pragma unroll
          for (int j = 0; j < 8; ++j) { const float x = __uint_as_float((unsigned)(unsigned short)qr[d0][j] << 16); q2 += x * x; }
      { auto rr = __builtin_amdgcn_permlane32_swap(__float_as_uint(q2), __float_as_uint(q2), false, false); q2 = __uint_as_float(rr[0]) + __uint_as_float(rr[1]); }
      const float k2 = KMX[(b * 8 + h) * 2] + KMX[(b * 8 + h) * 2 + 1] + KMX[32 + b];
      const float ms = 1.01f * sqrtf(q2 * k2);
      exact = wg_or(!(ms <= MLA_STATIC_THR), (unsigned*)(lds + 147456 - 512), wid, lane);
      if (!exact) { m_reg = ms;
#pragma unroll
          for (int r = 0; r < 16; ++r) negm[r] = -ms; } }
    const int srow = tid >> 3, sch = tid & 7, rrow = (tid & 255) >> 2, rch = tid & 3;
    const char* kn_u = (const char*)(KN + bhS * 64); const char* v_u = (const char*)(V + bhS * 64); const char* kr_u = (const char*)(KR + (size_t)b * S * 32);
    const unsigned kn_off = (unsigned)(srow * 64 + sch * 8) * 2u, kr_off = (unsigned)(rrow * 32 + rch * 8) * 2u;
    const int kst = KSWZ(srow, sch * 16), krst = KSWZ(rrow, (8 + rch) * 16), vst = v_st(srow, sch * 8);
    const int vb0 = (int)(uintptr_t)V_lds + v_rd_base(lane);
    bf16x8 s_kn[1], s_kr[1], s_v[1];
#define SLOAD(i, t) do { s_kn[i] = *reinterpret_cast<const bf16x8*>(kn_u + (size_t)(t) * 8192 + kn_off); s_kr[i] = *reinterpret_cast<const bf16x8*>(kr_u + (size_t)(t) * 4096 + kr_off); \
    s_v[i] = *reinterpret_cast<const bf16x8*>(v_u + (size_t)(t) * 8192 + kn_off); } while (0)
#define SWRITE(sl, i) do { *(bf16x8*)(K_lds + (sl) * SHM_K + kst) = s_kn[i]; if (tid < 256) *(bf16x8*)(K_lds + (sl) * SHM_K + krst) = s_kr[i]; *(bf16x8*)(V_lds + (sl) * SHM_V + vst) = s_v[i]; } while (0)
#define SWAIT() asm volatile("s_waitcnt vmcnt(0)" ::: "memory")
#define RESC(a) do { if (exact && __any((a) < 1.f)) { if (hi == 0) al_l[r32] = (a); asm volatile("s_waitcnt lgkmcnt(0)" ::: "memory"); \
    _Pragma("unroll") for (int d = 0; d < 2; ++d) _Pragma("unroll") for (int r = 0; r < 16; ++r) o[d][r] *= al_l[crow(r, hi)]; } } while (0)
#define ROT3(x) ((x) == 2 ? 0 : (x) + 1)
    f32x16 pA0, pA1, pB0, pB1; float alA, alB; bf16x8 pa0, pa1, pa2, pa3; constexpr int NT = S / 64;
#if MLA_STAMP
    unsigned long long st_acc[8] = {0, 0, 0, 0, 0, 0, 0, 0}, tq0 = 0, tq1 = 0, ts0 = 0, ts1 = 0, tu0 = 0; STAMP_T(tu0);
#endif
    SLOAD(0, 0);
    SWAIT(); SWRITE(0, 0); SLOAD(0, 1);
    __syncthreads();
    qkt96n(pA0, pA1, K_lds, qr, negm, r32, hi); if (exact) partialSM2<true>(pA0, pA1, m_reg, negm, alA); else partialSM2<false>(pA0, pA1, m_reg, negm, alA, false);
    SWAIT(); SWRITE(1, 0); SLOAD(0, 2);
    __syncthreads();
    int sp = 0, sc = 1, sn = 2;
    for (int j = 1; j + 1 < NT; j += 2) {
        if (!MLA_PROBE_NOSTAGE) { SWAIT(); SWRITE(sn, 0); if (j + 2 < NT) SLOAD(0, j + 2); }
        SBAR(); MLA_STEP(pB0, pB1, pA0, pA1, alA, alB);
        __syncthreads();
        sp = sc; sc = sn; sn = ROT3(sn);
        if (!MLA_PROBE_NOSTAGE) { SWAIT(); SWRITE(sn, 0); if (j + 3 < NT) SLOAD(0, j + 3); }
        SBAR(); MLA_STEP(pA0, pA1, pB0, pB1, alB, alA);
        __syncthreads();
        sp = sc; sc = sn; sn = ROT3(sn);
    }
    SBAR(); MLA_STEP(pB0, pB1, pA0, pA1, alA, alB);
    finishSM(pB0, pB1, alB, l_reg, pa0, pa1, pa2, pa3); SBAR();
    { const int vb = vb0 + sc * SHM_V; pv_one_p<0>(o[0], vb, pa0, pa1, pa2, pa3); pv_one_p<1>(o[1], vb, pa0, pa1, pa2, pa3); }
    if (hi == 0) li_l[r32] = l_reg; asm volatile("s_waitcnt lgkmcnt(0)" ::: "memory");
    float rli[16];
#pragma unroll
    for (int r = 0; r < 16; ++r) rli[r] = __builtin_amdgcn_rcpf(li_l[crow(r, hi)]);
    unsigned short* stg = (unsigned short*)(lds + M2_OST) + wid * 2048;
    unsigned short* dst = CAT + ((size_t)b * S + q0 + wid * 32) * 1024 + h * 64;
    store_o_tile(o, rli, stg, dst, [](int row) { return (size_t)row * 1024; }, lane);
    asm volatile("s_waitcnt vmcnt(0)" ::: "memory");
#if MLA_STAMP
    { unsigned long long tu1; STAMP_T(tu1); st_acc[6] = tu1 - tu0;
      if (blockIdx.x == 0 && wid == MLA_STAMP_WAVE && lane == 0 && STAMPS) {
#pragma unroll
          for (int i = 0; i < 8; ++i) STAMPS[i] = st_acc[i]; } }
#endif
    __syncthreads();
#undef SLOAD
#undef SWRITE
#undef SWAIT
#undef RESC
#undef ROT3
}


__device__ __forceinline__ void finishSM_s(f32x16& p0, f32x16& p1, float& l_reg, bf16x8& pa0, bf16x8& pa1, bf16x8& pa2, bf16x8& pa3) {
#pragma unroll
    for (int r = 0; r < 16; ++r) p1[r] = __builtin_amdgcn_exp2f(p1[r]);
    float ps = 0;
#pragma unroll
    for (int r = 0; r < 16; ++r) ps += p0[r];
#pragma unroll
    for (int r = 0; r < 16; ++r) ps += p1[r];
    l_reg += ps;
    PK4(p0, 0, pa0); PK4(p0, 8, pa1); PK4(p1, 0, pa2); PK4(p1, 8, pa3);
}
__device__ __forceinline__ void exp_half(f32x16& p0) {
#pragma unroll
    for (int r = 0; r < 16; ++r) p0[r] = __builtin_amdgcn_exp2f(p0[r]);
}
__device__ __forceinline__ bool mla_unit_v5(int wv, int bh, int qb, const unsigned short* __restrict__ Q, const unsigned short* __restrict__ KN, const unsigned short* __restrict__ KR,
                                            const unsigned short* __restrict__ V, unsigned short* __restrict__ CAT, const float* __restrict__ KMX, char* lds) {
    const int wid = wv, lane = gm::lane_now(), tid = wid * 64 + lane, r32 = lane & 31, hi = lane >> 5;
    const int b = bh >> 3, h = bh & 7;
    char* K_lds = lds + M2_K; char* V_lds = lds + M2_V;
    float* wsf = (float*)(lds + M2_WS) + wid * 64; float* li_l = wsf;
    float l_reg = 0; f32x16 o[2] = {}; bf16x8 qr[6];
    const size_t bhS = (size_t)bh * S; const int q0 = qb * 256;
    const unsigned short* Qw = Q + (bhS + q0 + wid * 32 + r32) * 96 + hi * 8;
#pragma unroll
    for (int d0 = 0; d0 < 6; ++d0) qr[d0] = *reinterpret_cast<const bf16x8*>(Qw + d0 * 16);
    f32x16 negm;
    { float q2 = 0.f;
#pragma unroll
      for (int d0 = 0; d0 < 6; ++d0)
#pragma unroll
          for (int j = 0; j < 8; ++j) { const float x = __uint_as_float((unsigned)(unsigned short)qr[d0][j] << 16); q2 += x * x; }
      { auto rr = __builtin_amdgcn_permlane32_swap(__float_as_uint(q2), __float_as_uint(q2), false, false); q2 = __uint_as_float(rr[0]) + __uint_as_float(rr[1]); }
      const float k2 = KMX[(b * 8 + h) * 2] + KMX[(b * 8 + h) * 2 + 1] + KMX[32 + b];
      const float m = 1.01f * sqrtf(q2 * k2);
#pragma unroll
      for (int r = 0; r < 16; ++r) negm[r] = -m; }
    const int srow = tid >> 3, sch = tid & 7, rrow = (tid & 255) >> 2, rch = tid & 3;
    const char* kn_u = (const char*)(KN + bhS * 64); const char* v_u = (const char*)(V + bhS * 64); const char* kr_u = (const char*)(KR + (size_t)b * S * 32);
    const unsigned kn_off = (unsigned)(srow * 64 + sch * 8) * 2u, kr_off = (unsigned)(rrow * 32 + rch * 8) * 2u;
    const int kst = KSWZ(srow, sch * 16), krst = KSWZ(rrow, (8 + rch) * 16), vst = v_st(srow, sch * 8);
    const int vb0 = (int)(uintptr_t)V_lds + v_rd_base(lane);
    bf16x8 s_kn, s_kr, s_v;
#define SLOAD(t) do { s_kn = *reinterpret_cast<const bf16x8*>(kn_u + (size_t)(t) * 8192 + kn_off); s_kr = *reinterpret_cast<const bf16x8*>(kr_u + (size_t)(t) * 4096 + kr_off); \
    s_v = *reinterpret_cast<const bf16x8*>(v_u + (size_t)(t) * 8192 + kn_off); } while (0)
#define SWRITE(sl) do { *(bf16x8*)(K_lds + (sl) * SHM_K + kst) = s_kn; if (tid < 256) *(bf16x8*)(K_lds + (sl) * SHM_K + krst) = s_kr; *(bf16x8*)(V_lds + (sl) * SHM_V + vst) = s_v; } while (0)
#define SWAIT() asm volatile("s_waitcnt vmcnt(0)" ::: "memory")
#define ROT3(x) ((x) == 2 ? 0 : (x) + 1)
#define STEP5(PC0, PC1, PP0, PP1) do { \
    qkt96n(PC0, PC1, K_lds + sc * SHM_K, qr, negm, r32, hi); \
    finishSM_s(PP0, PP1, l_reg, pa0, pa1, pa2, pa3); SBAR(); \
    { const int vb_ = vb0 + sp * SHM_V; pv_one_p<0>(o[0], vb_, pa0, pa1, pa2, pa3); pv_one_p<1>(o[1], vb_, pa0, pa1, pa2, pa3); } \
    exp_half(PC0); } while (0)
    f32x16 pA0, pA1, pB0, pB1; bf16x8 pa0, pa1, pa2, pa3; constexpr int NT = S / 64;
    SLOAD(0);
    SWAIT(); SWRITE(0); SLOAD(1);
    __syncthreads();
    qkt96n(pA0, pA1, K_lds, qr, negm, r32, hi); exp_half(pA0);
    SWAIT(); SWRITE(1); SLOAD(2);
    __syncthreads();
    int sp = 0, sc = 1, sn = 2;
    for (int j = 1; j + 1 < NT; j += 2) {
        SWAIT(); SWRITE(sn); if (j + 2 < NT) SLOAD(j + 2);
        SBAR(); STEP5(pB0, pB1, pA0, pA1);
        __syncthreads();
        sp = sc; sc = sn; sn = ROT3(sn);
        SWAIT(); SWRITE(sn); if (j + 3 < NT) SLOAD(j + 3);
        SBAR(); STEP5(pA0, pA1, pB0, pB1);
        __syncthreads();
        sp = sc; sc = sn; sn = ROT3(sn);
    }
    SBAR(); STEP5(pB0, pB1, pA0, pA1);
    finishSM_s(pB0, pB1, l_reg, pa0, pa1, pa2, pa3); SBAR();
    { const int vb = vb0 + sc * SHM_V; pv_one_p<0>(o[0], vb, pa0, pa1, pa2, pa3); pv_one_p<1>(o[1], vb, pa0, pa1, pa2, pa3); }
    { auto rr = __builtin_amdgcn_permlane32_swap(__float_as_uint(l_reg), __float_as_uint(l_reg), false, false); l_reg = __uint_as_float(rr[0]) + __uint_as_float(rr[1]); }
    const bool bad = !(l_reg > 1e-30f);
    if (hi == 0) li_l[r32] = l_reg; asm volatile("s_waitcnt lgkmcnt(0)" ::: "memory");
    float rli[16];
#pragma unroll
    for (int r = 0; r < 16; ++r) rli[r] = __builtin_amdgcn_rcpf(li_l[crow(r, hi)]);
    unsigned short* stg = (unsigned short*)(lds + M2_OST) + wid * 2048;
    unsigned short* dst = CAT + ((size_t)b * S + q0 + wid * 32) * 1024 + h * 64;
    store_o_tile(o, rli, stg, dst, [](int row) { return (size_t)row * 1024; }, lane);
    asm volatile("s_waitcnt vmcnt(0)" ::: "memory");
    const int anybad = wg_or(bad, (unsigned*)(lds + 147456 - 512), wid, lane) ? 1 : 0;
    return anybad != 0;
#undef SLOAD
#undef SWRITE
#undef SWAIT
#undef ROT3
#undef STEP5
}

constexpr int M4_K = 0, M4_V = 4 * SHM_K, M4_WS = M4_V + 4 * SHM_V, M4_OST = M4_WS + 8 * 256;
template <bool FIRST> __device__ __forceinline__ void softmax_full(f32x16& p0, f32x16& p1, float& m_reg, f32x16& negm, float& l_reg, float& alpha, bf16x8& pa0, bf16x8& pa1, bf16x8& pa2, bf16x8& pa3, bool exact) {
    if (exact) partialSM2<FIRST>(p0, p1, m_reg, negm, alpha, true); else partialSM2<false>(p0, p1, m_reg, negm, alpha, false);
    finishSM(p0, p1, alpha, l_reg, pa0, pa1, pa2, pa3);
}
__device__ __forceinline__ void mla_unit_v4(int wv, int bh, int qb, const unsigned short* __restrict__ Q, const unsigned short* __restrict__ KN, const unsigned short* __restrict__ KR,
                                            const unsigned short* __restrict__ V, unsigned short* __restrict__ CAT, const float* __restrict__ KMX, char* lds, unsigned long long* STAMPS = nullptr) {
    const int wid = wv, lane = gm::lane_now(), tid = wid * 64 + lane, r32 = lane & 31, hi = lane >> 5;
    const int b = bh >> 3, h = bh & 7; const bool halfB = wid >= 4;
    char* K_lds = lds + M4_K; char* V_lds = lds + M4_V;
    float* wsf = (float*)(lds + M4_WS) + wid * 64; float* li_l = wsf; float* al_l = wsf + 32;
    float m_reg = 0.f, l_reg = 0; f32x16 o[2] = {}; bf16x8 qr[6]; f32x16 negm = f32x16{};
    const size_t bhS = (size_t)bh * S; const int q0 = qb * 256;
    const unsigned short* Qw = Q + (bhS + q0 + wid * 32 + r32) * 96 + hi * 8;
#pragma unroll
    for (int d0 = 0; d0 < 6; ++d0) qr[d0] = *reinterpret_cast<const bf16x8*>(Qw + d0 * 16);
    bool exact = true;
    if (MLA_STATIC) { float q2 = 0.f;
#pragma unroll
      for (int d0 = 0; d0 < 6; ++d0)
#pragma unroll
          for (int j = 0; j < 8; ++j) { const float x = __uint_as_float((unsigned)(unsigned short)qr[d0][j] << 16); q2 += x * x; }
      { auto rr = __builtin_amdgcn_permlane32_swap(__float_as_uint(q2), __float_as_uint(q2), false, false); q2 = __uint_as_float(rr[0]) + __uint_as_float(rr[1]); }
      const float k2 = KMX[(b * 8 + h) * 2] + KMX[(b * 8 + h) * 2 + 1] + KMX[32 + b];
      const float ms = 1.01f * sqrtf(q2 * k2);
      exact = wg_or(!(ms <= MLA_STATIC_THR), (unsigned*)(lds + 147456 - 512), wid, lane);
      if (!exact) { m_reg = ms;
#pragma unroll
          for (int r = 0; r < 16; ++r) negm[r] = -ms; } }
    const int srow = tid >> 3, sch = tid & 7, rrow = (tid & 255) >> 2, rch = tid & 3;
    const char* kn_u = (const char*)(KN + bhS * 64); const char* v_u = (const char*)(V + bhS * 64); const char* kr_u = (const char*)(KR + (size_t)b * S * 32);
    const unsigned kn_off = (unsigned)(srow * 64 + sch * 8) * 2u, kr_off = (unsigned)(rrow * 32 + rch * 8) * 2u;
    const int kst = KSWZ(srow, sch * 16), krst = KSWZ(rrow, (8 + rch) * 16), vst = v_st(srow, sch * 8);
    const int vb0 = (int)(uintptr_t)V_lds + v_rd_base(lane);
    bf16x8 s_kn, s_kr, s_v;
#define SLOAD(t) do { s_kn = *reinterpret_cast<const bf16x8*>(kn_u + (size_t)(t) * 8192 + kn_off); s_kr = *reinterpret_cast<const bf16x8*>(kr_u + (size_t)(t) * 4096 + kr_off); \
    s_v = *reinterpret_cast<const bf16x8*>(v_u + (size_t)(t) * 8192 + kn_off); } while (0)
#define SWRITE(sl) do { *(bf16x8*)(K_lds + (sl) * SHM_K + kst) = s_kn; if (tid < 256) *(bf16x8*)(K_lds + (sl) * SHM_K + krst) = s_kr; *(bf16x8*)(V_lds + (sl) * SHM_V + vst) = s_v; } while (0)
#define SWAIT() asm volatile("s_waitcnt vmcnt(0)" ::: "memory")
#define RESC(a) do { if (exact && __any((a) < 1.f)) { if (hi == 0) al_l[r32] = (a); asm volatile("s_waitcnt lgkmcnt(0)" ::: "memory"); \
    _Pragma("unroll") for (int d = 0; d < 2; ++d) _Pragma("unroll") for (int r = 0; r < 16; ++r) o[d][r] *= al_l[crow(r, hi)]; } } while (0)
#define RAWBAR() do { asm volatile("" ::: "memory"); __builtin_amdgcn_s_barrier(); asm volatile("" ::: "memory"); } while (0)
    f32x16 p0, p1; float al; bf16x8 pa0, pa1, pa2, pa3; bf16x8 kf[12]; constexpr int NT = S / 64;
#if MLA_STAMP
    unsigned long long st_acc[8] = {0, 0, 0, 0, 0, 0, 0, 0}, tq0 = 0, tq1 = 0, tu0 = 0; STAMP_T(tu0);
#endif
    SLOAD(0); SWAIT(); SWRITE(0); SLOAD(1); SWAIT(); SWRITE(1); SLOAD(2);
    asm volatile("s_waitcnt lgkmcnt(0)" ::: "memory"); RAWBAR();
    if (halfB) RAWBAR();
    kfrag_load(kf, K_lds, r32, hi); SBAR();
    qk_mma(p0, p1, kf, qr, negm); SBAR();
    asm volatile("s_waitcnt lgkmcnt(0)" ::: "memory"); RAWBAR();
    softmax_full<true>(p0, p1, m_reg, negm, l_reg, al, pa0, pa1, pa2, pa3, exact); SBAR();
    SWAIT(); SWRITE(2); SLOAD(3); SBAR();
    kfrag_load(kf, K_lds + SHM_K, r32, hi); SBAR();
    asm volatile("s_waitcnt lgkmcnt(12)" ::: "memory"); RAWBAR();
    int sp = 0, sc = 1, sw = 3;
    for (int t = 1; t < NT; ++t) {
        STAMP_T(tq0);
        { s16x4 val[4], vah[4], vbl[4], vbh[4]; const int vb_ = vb0 + sp * SHM_V;
          vfrag_load_h<0>(val, vah, vb_); SBAR();
          qk_mma(p0, p1, kf, qr, negm); SBAR();
          vfrag_load_h<1>(vbl, vbh, vb_); SBAR();
          asm volatile("s_waitcnt lgkmcnt(8)" ::: "memory"); SBAR();
          pv_mma_h(o[0], val, vah, pa0, pa1, pa2, pa3); SBAR();
          asm volatile("s_waitcnt lgkmcnt(0)" ::: "memory"); SBAR();
          pv_mma_h(o[1], vbl, vbh, pa0, pa1, pa2, pa3); SBAR(); }
        STAMP_T(tq1); STAMP_ACC(1, tq0, tq1);
        RAWBAR();
        STAMP_T(tq0); STAMP_ACC(2, tq1, tq0);
        if (t + 2 < NT) { SWAIT(); SWRITE(sw); if (t + 3 < NT) SLOAD(t + 3); } SBAR();
        softmax_full<false>(p0, p1, m_reg, negm, l_reg, al, pa0, pa1, pa2, pa3, exact); RESC(al); SBAR();
        sp = sc; sc = (sc + 1) & 3; sw = (sw + 1) & 3;
        if (t + 1 < NT) { kfrag_load(kf, K_lds + sc * SHM_K, r32, hi); SBAR(); }
        STAMP_T(tq1); STAMP_ACC(3, tq0, tq1);
        asm volatile("s_waitcnt lgkmcnt(12)" ::: "memory"); RAWBAR();
        STAMP_T(tq0); STAMP_ACC(4, tq1, tq0);
    }
    { s16x4 val[4], vah[4], vbl[4], vbh[4]; const int vb_ = vb0 + sp * SHM_V;
      vfrag_load_h<0>(val, vah, vb_); vfrag_load_h<1>(vbl, vbh, vb_); SBAR();
      asm volatile("s_waitcnt lgkmcnt(0)" ::: "memory"); SBAR();
      pv_mma_h(o[0], val, vah, pa0, pa1, pa2, pa3); pv_mma_h(o[1], vbl, vbh, pa0, pa1, pa2, pa3); SBAR(); }
    if (!halfB) RAWBAR();
    if (hi == 0) li_l[r32] = l_reg; asm volatile("s_waitcnt lgkmcnt(0)" ::: "memory");
    float rli[16];
#pragma unroll
    for (int r = 0; r < 16; ++r) rli[r] = __builtin_amdgcn_rcpf(li_l[crow(r, hi)]);
    unsigned short* stg = (unsigned short*)(lds + M4_OST) + wid * 2048;
    unsigned short* dst = CAT + ((size_t)b * S + q0 + wid * 32) * 1024 + h * 64;
    store_o_tile(o, rli, stg, dst, [](int row) { return (size_t)row * 1024; }, lane);
    asm volatile("s_waitcnt vmcnt(0)" ::: "memory");
#if MLA_STAMP
    { unsigned long long tu1; STAMP_T(tu1); st_acc[6] = tu1 - tu0;
      if (blockIdx.x == 0 && wid == MLA_STAMP_WAVE && lane == 0 && STAMPS) {
#pragma unroll
          for (int i = 0; i < 8; ++i) STAMPS[i] = st_acc[i]; } }
#endif
    __syncthreads();
#undef SLOAD
#undef SWRITE
#undef SWAIT
#undef RESC
#undef RAWBAR
}


constexpr int M6_K = 0, M6_V = 4 * SHM_K, M6_WS = M6_V + 4 * SHM_V, M6_OST = M6_WS + 8 * 256;
#define KLD3(dst, Ks_, D0) do { _Pragma("unroll") for (int d_ = 0; d_ < 3; ++d_) { const int cb_ = (((D0) + d_) * 16 + hi * 8) * 2; \
        dst[2 * d_] = *reinterpret_cast<const bf16x8*>((Ks_) + KSWZ(r32, cb_)); dst[2 * d_ + 1] = *reinterpret_cast<const bf16x8*>((Ks_) + KSWZ(32 + r32, cb_)); } } while (0)
#define MF32(A, B, C) __builtin_amdgcn_mfma_f32_32x32x16_bf16(A, B, C, 0, 0, 0)
#define QK_ADD(DST, KF, QF, CIN, PPX, B) do { DST = MF32(KF, QF, CIN); s0 += PPX[B]; s1 += PPX[B + 1]; s2 += PPX[B + 2]; s3 += PPX[B + 3]; SBAR(); } while (0)
#define QK_PK(DST, KF, QF, CIN, PPX, B, OUT) do { DST = MF32(KF, QF, CIN); PK4(PPX, B, OUT); SBAR(); } while (0)
__device__ __forceinline__ void mla_unit_v6(int wv, int bh, int qb, const unsigned short* __restrict__ Q, const unsigned short* __restrict__ KN, const unsigned short* __restrict__ KR,
                                            const unsigned short* __restrict__ V, unsigned short* __restrict__ CAT, const float* __restrict__ KMX, char* lds) {
    const int wid = wv, lane = gm::lane_now(), tid = wid * 64 + lane, r32 = lane & 31, hi = lane >> 5;
    const int b = bh >> 3, h = bh & 7; const bool halfB = wid >= 4;
    char* K_lds = lds + M6_K; char* V_lds = lds + M6_V;
    float* wsf = (float*)(lds + M6_WS) + wid * 64; float* li_l = wsf; float* al_l = wsf + 32;
    float m_reg = 0.f, l_reg = 0; f32x16 o[2] = {}; bf16x8 qr[6]; f32x16 negm = f32x16{};
    const size_t bhS = (size_t)bh * S; const int q0 = qb * 256;
    const unsigned short* Qw = Q + (bhS + q0 + wid * 32 + r32) * 96 + hi * 8;
#pragma unroll
    for (int d0 = 0; d0 < 6; ++d0) qr[d0] = *reinterpret_cast<const bf16x8*>(Qw + d0 * 16);
    bool exact = true;
    if (MLA_STATIC) { float q2 = 0.f;
#pragma unroll
      for (int d0 = 0; d0 < 6; ++d0)
#pragma unroll
          for (int j = 0; j < 8; ++j) { const float x = __uint_as_float((unsigned)(unsigned short)qr[d0][j] << 16); q2 += x * x; }
      { auto rr = __builtin_amdgcn_permlane32_swap(__float_as_uint(q2), __float_as_uint(q2), false, false); q2 = __uint_as_float(rr[0]) + __uint_as_float(rr[1]); }
      const float k2 = KMX[(b * 8 + h) * 2] + KMX[(b * 8 + h) * 2 + 1] + KMX[32 + b];
      const float ms = 1.01f * sqrtf(q2 * k2);
      exact = wg_or(!(ms <= MLA_STATIC_THR), (unsigned*)(lds + 147456 - 512), wid, lane);
      if (!exact) { m_reg = ms;
#pragma unroll
          for (int r = 0; r < 16; ++r) negm[r] = -ms; } }
    const int srow = tid >> 3, sch = tid & 7, rrow = (tid & 255) >> 2, rch = tid & 3;
    const char* kn_u = (const char*)(KN + bhS * 64); const char* v_u = (const char*)(V + bhS * 64); const char* kr_u = (const char*)(KR + (size_t)b * S * 32);
    const unsigned kn_off = (unsigned)(srow * 64 + sch * 8) * 2u, kr_off = (unsigned)(rrow * 32 + rch * 8) * 2u;
    const int kst = KSWZ(srow, sch * 16), krst = KSWZ(rrow, (8 + rch) * 16), vst = v_st(srow, sch * 8);
    const int vb0 = (int)(uintptr_t)V_lds + v_rd_base(lane);
    bf16x8 s_kn, s_kr, s_v;
#define SLOAD(t) do { s_kn = *reinterpret_cast<const bf16x8*>(kn_u + (size_t)(t) * 8192 + kn_off); s_kr = *reinterpret_cast<const bf16x8*>(kr_u + (size_t)(t) * 4096 + kr_off); \
    s_v = *reinterpret_cast<const bf16x8*>(v_u + (size_t)(t) * 8192 + kn_off); } while (0)
#define SWRITE(sl) do { *(bf16x8*)(K_lds + (sl) * SHM_K + kst) = s_kn; if (tid < 256) *(bf16x8*)(K_lds + (sl) * SHM_K + krst) = s_kr; *(bf16x8*)(V_lds + (sl) * SHM_V + vst) = s_v; } while (0)
#define SWAIT() asm volatile("s_waitcnt vmcnt(0)" ::: "memory")
#define RESC(a) do { if (exact && __any((a) < 1.f)) { if (hi == 0) al_l[r32] = (a); asm volatile("s_waitcnt lgkmcnt(0)" ::: "memory"); l_reg *= (a); \
    _Pragma("unroll") for (int d = 0; d < 2; ++d) _Pragma("unroll") for (int r = 0; r < 16; ++r) o[d][r] *= al_l[crow(r, hi)]; } } while (0)
#define RAWBAR() do { asm volatile("" ::: "memory"); __builtin_amdgcn_s_barrier(); asm volatile("" ::: "memory"); } while (0)
#define EXP_TILE(P0, P1, FIRST_) do { float al_ = 1.f; \
        if (exact) { const float pmax = rowmax32b(P0, P1); \
            if ((FIRST_) || !__builtin_expect(__all(pmax <= THR), 1)) { const float dl = (FIRST_) ? pmax : fmaxf(pmax, 0.f); m_reg += dl; \
                _Pragma("unroll") for (int r = 0; r < 16; ++r) { P0[r] -= dl; P1[r] -= dl; } \
                _Pragma("unroll") for (int r = 0; r < 16; ++r) negm[r] = -m_reg; \
                if (!(FIRST_)) al_ = __builtin_amdgcn_exp2f(-dl); } } \
        _Pragma("unroll") for (int r = 0; r < 16; ++r) P0[r] = __builtin_amdgcn_exp2f(P0[r]); \
        _Pragma("unroll") for (int r = 0; r < 16; ++r) P1[r] = __builtin_amdgcn_exp2f(P1[r]); \
        RESC(al_); } while (0)
#define M_PART(PC0, PC1, PP0, PP1) do { \
        s16x4 val[4], vah[4], vbl[4], vbh[4]; const int vb_ = vb0 + sp * SHM_V; float s0 = 0.f, s1 = 0.f, s2 = 0.f, s3 = 0.f; \
        KLD3(kb, K_lds + sc * SHM_K, 3); SBAR(); \
        QK_ADD(PC0, ka[0], qr[0], negm, PP0, 0);  QK_ADD(PC1, ka[1], qr[0], negm, PP0, 4); \
        QK_ADD(PC0, ka[2], qr[1], PC0, PP0, 8);   QK_ADD(PC1, ka[3], qr[1], PC1, PP0, 12); \
        QK_ADD(PC0, ka[4], qr[2], PC0, PP1, 0);   QK_ADD(PC1, ka[5], qr[2], PC1, PP1, 4); \
        vfrag_load_h<0>(val, vah, vb_); vfrag_load_h<1>(vbl, vbh, vb_); SBAR(); \
        QK_ADD(PC0, kb[0], qr[3], PC0, PP1, 8);   QK_ADD(PC1, kb[1], qr[3], PC1, PP1, 12); \
        QK_PK(PC0, kb[2], qr[4], PC0, PP0, 0, pa0); QK_PK(PC1, kb[3], qr[4], PC1, PP0, 8, pa1); \
        QK_PK(PC0, kb[4], qr[5], PC0, PP1, 0, pa2); QK_PK(PC1, kb[5], qr[5], PC1, PP1, 8, pa3); \
        { float ps = (s0 + s1) + (s2 + s3); auto rr = __builtin_amdgcn_permlane32_swap(__float_as_uint(ps), __float_as_uint(ps), false, false); l_reg += __uint_as_float(rr[0]) + __uint_as_float(rr[1]); } \
        asm volatile("s_waitcnt lgkmcnt(0)" ::: "memory"); SBAR(); \
        pv_mma_h(o[0], val, vah, pa0, pa1, pa2, pa3); pv_mma_h(o[1], vbl, vbh, pa0, pa1, pa2, pa3); SBAR(); } while (0)
#define V_PART(PC0, PC1, t_) do { \
        if ((t_) + 2 < NT) { SWAIT(); SWRITE(sw); if ((t_) + 3 < NT) SLOAD((t_) + 3); } SBAR(); \
        EXP_TILE(PC0, PC1, false); SBAR(); \
        sp = sc; sc = (sc + 1) & 3; sw = (sw + 1) & 3; \
        if ((t_) + 1 < NT) { KLD3(ka, K_lds + sc * SHM_K, 0); SBAR(); } \
        asm volatile("s_waitcnt lgkmcnt(6)" ::: "memory"); RAWBAR(); } while (0)
    f32x16 pA0, pA1, pB0, pB1; bf16x8 pa0, pa1, pa2, pa3; bf16x8 ka[6], kb[6]; constexpr int NT = S / 64;
    SLOAD(0); SWAIT(); SWRITE(0); SLOAD(1); SWAIT(); SWRITE(1); SLOAD(2);
    asm volatile("s_waitcnt lgkmcnt(0)" ::: "memory"); RAWBAR();
    if (halfB) RAWBAR();
    KLD3(ka, K_lds, 0); KLD3(kb, K_lds, 3); SBAR();
    pA0 = MF32(ka[0], qr[0], negm); pA1 = MF32(ka[1], qr[0], negm); pA0 = MF32(ka[2], qr[1], pA0); pA1 = MF32(ka[3], qr[1], pA1); pA0 = MF32(ka[4], qr[2], pA0); pA1 = MF32(ka[5], qr[2], pA1);
    pA0 = MF32(kb[0], qr[3], pA0); pA1 = MF32(kb[1], qr[3], pA1); pA0 = MF32(kb[2], qr[4], pA0); pA1 = MF32(kb[3], qr[4], pA1); pA0 = MF32(kb[4], qr[5], pA0); pA1 = MF32(kb[5], qr[5], pA1); SBAR();
    asm volatile("s_waitcnt lgkmcnt(0)" ::: "memory"); RAWBAR();
    int sp = 0, sc = 0, sw = 2;
    SWAIT(); SWRITE(2); SLOAD(3); SBAR();
    EXP_TILE(pA0, pA1, true); SBAR();
    sp = 0; sc = 1; sw = 3;
    KLD3(ka, K_lds + SHM_K, 0); SBAR();
    asm volatile("s_waitcnt lgkmcnt(6)" ::: "memory"); RAWBAR();
    for (int t = 1; t + 1 < NT; t += 2) {
        M_PART(pB0, pB1, pA0, pA1); RAWBAR(); V_PART(pB0, pB1, t);
        M_PART(pA0, pA1, pB0, pB1); RAWBAR(); V_PART(pA0, pA1, t + 1);
    }
    M_PART(pB0, pB1, pA0, pA1); RAWBAR(); V_PART(pB0, pB1, NT - 1);
    { s16x4 val[4], vah[4], vbl[4], vbh[4]; const int vb_ = vb0 + sp * SHM_V; float ps = 0.f;
      vfrag_load_h<0>(val, vah, vb_); vfrag_load_h<1>(vbl, vbh, vb_); SBAR();
#pragma unroll
      for (int r = 0; r < 16; ++r) ps += pB0[r] + pB1[r];
      { auto rr = __builtin_amdgcn_permlane32_swap(__float_as_uint(ps), __float_as_uint(ps), false, false); l_reg += __uint_as_float(rr[0]) + __uint_as_float(rr[1]); }
      PK4(pB0, 0, pa0); PK4(pB0, 8, pa1); PK4(pB1, 0, pa2); PK4(pB1, 8, pa3);
      asm volatile("s_waitcnt lgkmcnt(0)" ::: "memory"); SBAR();
      pv_mma_h(o[0], val, vah, pa0, pa1, pa2, pa3); pv_mma_h(o[1], vbl, vbh, pa0, pa1, pa2, pa3); SBAR(); }
    if (!halfB) RAWBAR();
    if (hi == 0) li_l[r32] = l_reg; asm volatile("s_waitcnt lgkmcnt(0)" ::: "memory");
    float rli[16];
#pragma unroll
    for (int r = 0; r < 16; ++r) rli[r] = __builtin_amdgcn_rcpf(li_l[crow(r, hi)]);
    unsigned short* stg = (unsigned short*)(lds + M6_OST) + wid * 2048;
    unsigned short* dst = CAT + ((size_t)b * S + q0 + wid * 32) * 1024 + h * 64;
    store_o_tile(o, rli, stg, dst, [](int row) { return (size_t)row * 1024; }, lane);
    asm volatile("s_waitcnt vmcnt(0)" ::: "memory");
    __syncthreads();
#undef SLOAD
#undef SWRITE
#undef SWAIT
#undef RESC
#undef RAWBAR
#undef EXP_TILE
#undef M_PART
#undef V_PART
}


#define PV_EXP(OD, PA, VL, VH, PCX, B) do { OD = MF32(PA, PKV(VL, VH), OD); PCX[B] = __builtin_amdgcn_exp2f(PCX[B]); PCX[B + 1] = __builtin_amdgcn_exp2f(PCX[B + 1]); \
        PCX[B + 2] = __builtin_amdgcn_exp2f(PCX[B + 2]); PCX[B + 3] = __builtin_amdgcn_exp2f(PCX[B + 3]); asm volatile("" : "+v"(PCX)); SBAR(); } while (0)
__device__ __forceinline__ void mla_unit_v7(int wv, int bh, int qb, const unsigned short* __restrict__ Q, const unsigned short* __restrict__ KN, const unsigned short* __restrict__ KR,
                                            const unsigned short* __restrict__ V, unsigned short* __restrict__ CAT, const float* __restrict__ KMX, char* lds, unsigned long long* STAMPS = nullptr) {
    const int wid = wv, lane = gm::lane_now(), tid = wid * 64 + lane, r32 = lane & 31, hi = lane >> 5;
    const int b = bh >> 3, h = bh & 7;
    char* K_lds = lds + M6_K; char* V_lds = lds + M6_V;
    float* wsf = (float*)(lds + M6_WS) + wid * 64; float* li_l = wsf; float* al_l = wsf + 32;
    float m_reg = 0.f, l_reg = 0; f32x16 o[2] = {}; bf16x8 qr[6]; f32x16 negm = f32x16{};
    const size_t bhS = (size_t)bh * S; const int q0 = qb * 256;
    const unsigned short* Qw = Q + (bhS + q0 + wid * 32 + r32) * 96 + hi * 8;
#pragma unroll
    for (int d0 = 0; d0 < 6; ++d0) qr[d0] = *reinterpret_cast<const bf16x8*>(Qw + d0 * 16);
    bool exact = true;
    if (MLA_STATIC) { float q2 = 0.f;
#pragma unroll
      for (int d0 = 0; d0 < 6; ++d0)
#pragma unroll
          for (int j = 0; j < 8; ++j) { const float x = __uint_as_float((unsigned)(unsigned short)qr[d0][j] << 16); q2 += x * x; }
      { auto rr = __builtin_amdgcn_permlane32_swap(__float_as_uint(q2), __float_as_uint(q2), false, false); q2 = __uint_as_float(rr[0]) + __uint_as_float(rr[1]); }
      const float k2 = KMX[(b * 8 + h) * 2] + KMX[(b * 8 + h) * 2 + 1] + KMX[32 + b];
      const float ms = 1.01f * sqrtf(q2 * k2);
      exact = wg_or(!(ms <= MLA_STATIC_THR), (unsigned*)(lds + 147456 - 512), wid, lane);
      if (!exact) { m_reg = ms;
#pragma unroll
          for (int r = 0; r < 16; ++r) negm[r] = -ms; } }
    const int srow = tid >> 3, sch = tid & 7, rrow = (tid & 255) >> 2, rch = tid & 3;
    const char* kn_u = (const char*)(KN + bhS * 64); const char* v_u = (const char*)(V + bhS * 64); const char* kr_u = (const char*)(KR + (size_t)b * S * 32);
    const unsigned kn_off = (unsigned)(srow * 64 + sch * 8) * 2u, kr_off = (unsigned)(rrow * 32 + rch * 8) * 2u;
    const int kst = KSWZ(srow, sch * 16), krst = KSWZ(rrow, (8 + rch) * 16), vst = v_st(srow, sch * 8);
    const int vb0 = (int)(uintptr_t)V_lds + v_rd_base(lane);
    bf16x8 s_kn, s_kr, s_v;
#define SLOAD(t) do { s_kn = *reinterpret_cast<const bf16x8*>(kn_u + (size_t)(t) * 8192 + kn_off); s_kr = *reinterpret_cast<const bf16x8*>(kr_u + (size_t)(t) * 4096 + kr_off); \
    s_v = *reinterpret_cast<const bf16x8*>(v_u + (size_t)(t) * 8192 + kn_off); } while (0)
#define SWRITE(sl) do { *(bf16x8*)(K_lds + (sl) * SHM_K + kst) = s_kn; if (tid < 256) *(bf16x8*)(K_lds + (sl) * SHM_K + krst) = s_kr; *(bf16x8*)(V_lds + (sl) * SHM_V + vst) = s_v; } while (0)
#define SWAIT() asm volatile("s_waitcnt vmcnt(0)" ::: "memory")
#define RAWBAR() do { asm volatile("" ::: "memory"); __builtin_amdgcn_s_barrier(); asm volatile("" ::: "memory"); } while (0)
#define MAX_TILE(P0, P1, FIRST_, AL_) do { AL_ = 1.f; \
        if (V7_EXACT && exact) { const float pmax = rowmax32b(P0, P1); \
            if ((FIRST_) || !__builtin_expect(__all(pmax <= THR), 1)) { const float dl = (FIRST_) ? pmax : fmaxf(pmax, 0.f); m_reg += dl; \
                _Pragma("unroll") for (int r = 0; r < 16; ++r) { P0[r] -= dl; P1[r] -= dl; } \
                _Pragma("unroll") for (int r = 0; r < 16; ++r) negm[r] = -m_reg; \
                if (!(FIRST_)) AL_ = __builtin_amdgcn_exp2f(-dl); } } } while (0)
#define RESC7(a) do { if (V7_EXACT && exact && __any((a) < 1.f)) { if (hi == 0) al_l[r32] = (a); asm volatile("s_waitcnt lgkmcnt(0)" ::: "memory"); l_reg *= (a); \
    _Pragma("unroll") for (int d = 0; d < 2; ++d) _Pragma("unroll") for (int r = 0; r < 16; ++r) o[d][r] *= al_l[crow(r, hi)]; } } while (0)
#define STEP7(PC0, PC1, PP0, PP1, t_) do { \
        s16x4 val[4], vah[4], vbl[4], vbh[4]; const int vb_ = vb0 + sp * SHM_V; float s0 = 0.f, s1 = 0.f, s2 = 0.f, s3 = 0.f, al_; \
        SEC_B(0); if ((t_) + 2 < NT) { SWAIT(); SWRITE(sw); if ((t_) + 3 < NT) SLOAD((t_) + 3); } SEC_E(0); \
        SEC_B(1); KLD3(kb, K_lds + sc * SHM_K, 3); SBAR(); \
        QK_ADD(PC0, ka[0], qr[0], negm, PP0, 0);  QK_ADD(PC1, ka[1], qr[0], negm, PP0, 4); \
        QK_ADD(PC0, ka[2], qr[1], PC0, PP0, 8);   QK_ADD(PC1, ka[3], qr[1], PC1, PP0, 12); \
        QK_ADD(PC0, ka[4], qr[2], PC0, PP1, 0);   QK_ADD(PC1, ka[5], qr[2], PC1, PP1, 4); \
        vfrag_load_h<0>(val, vah, vb_); SBAR(); \
        QK_ADD(PC0, kb[0], qr[3], PC0, PP1, 8);   QK_ADD(PC1, kb[1], qr[3], PC1, PP1, 12); \
        QK_PK(PC0, kb[2], qr[4], PC0, PP0, 0, pa0); QK_PK(PC1, kb[3], qr[4], PC1, PP0, 8, pa1); \
        vfrag_load_h<1>(vbl, vbh, vb_); SBAR(); \
        QK_PK(PC0, kb[4], qr[5], PC0, PP1, 0, pa2); QK_PK(PC1, kb[5], qr[5], PC1, PP1, 8, pa3); \
        { float ps = (s0 + s1) + (s2 + s3); auto rr = __builtin_amdgcn_permlane32_swap(__float_as_uint(ps), __float_as_uint(ps), false, false); l_reg += __uint_as_float(rr[0]) + __uint_as_float(rr[1]); } \
        MAX_TILE(PC0, PC1, false, al_); SEC_E(1); \
        SEC_B(4); sp = sc; sc = (sc + 1) & 3; sw = (sw + 1) & 3; \
        if ((t_) + 1 < NT) KLD3(ka, K_lds + sc * SHM_K, 0); \
        asm volatile("s_waitcnt lgkmcnt(6)" ::: "memory"); SBAR(); SEC_E(4); SEC_B(2); \
        PV_EXP(o[0], pa0, val[0], vah[0], PC0, 0);  PV_EXP(o[1], pa0, vbl[0], vbh[0], PC0, 4); \
        PV_EXP(o[0], pa1, val[1], vah[1], PC0, 8);  PV_EXP(o[1], pa1, vbl[1], vbh[1], PC0, 12); \
        PV_EXP(o[0], pa2, val[2], vah[2], PC1, 0);  PV_EXP(o[1], pa2, vbl[2], vbh[2], PC1, 4); \
        PV_EXP(o[0], pa3, val[3], vah[3], PC1, 8);  PV_EXP(o[1], pa3, vbl[3], vbh[3], PC1, 12); \
        RESC7(al_); SEC_E(2); \
        SEC_B(3); RAWBAR(); SEC_E(3); } while (0)
    f32x16 pA0, pA1, pB0, pB1; bf16x8 pa0, pa1, pa2, pa3; bf16x8 ka[6], kb[6]; constexpr int NT = S / 64;
#if MLA_STAMP
    unsigned long long st_a = 0, tq0 = 0, tq1 = 0;
#endif

    if (V7_YOUNG_PRIO && wid >= 4) __builtin_amdgcn_s_setprio(1);
    SLOAD(0); SWAIT(); SWRITE(0); SLOAD(1); SWAIT(); SWRITE(1); SLOAD(2);
    asm volatile("s_waitcnt lgkmcnt(0)" ::: "memory"); RAWBAR();
    KLD3(ka, K_lds, 0); KLD3(kb, K_lds, 3); SBAR();
    pA0 = MF32(ka[0], qr[0], negm); pA1 = MF32(ka[1], qr[0], negm); pA0 = MF32(ka[2], qr[1], pA0); pA1 = MF32(ka[3], qr[1], pA1); pA0 = MF32(ka[4], qr[2], pA0); pA1 = MF32(ka[5], qr[2], pA1);
    pA0 = MF32(kb[0], qr[3], pA0); pA1 = MF32(kb[1], qr[3], pA1); pA0 = MF32(kb[2], qr[4], pA0); pA1 = MF32(kb[3], qr[4], pA1); pA0 = MF32(kb[4], qr[5], pA0); pA1 = MF32(kb[5], qr[5], pA1); SBAR();
    { float al0; MAX_TILE(pA0, pA1, true, al0); (void)al0; }
#pragma unroll
    for (int r = 0; r < 16; ++r) { pA0[r] = __builtin_amdgcn_exp2f(pA0[r]); pA1[r] = __builtin_amdgcn_exp2f(pA1[r]); }
    SWAIT(); SWRITE(2); SLOAD(3);
    int sp = 0, sc = 1, sw = 3;
    KLD3(ka, K_lds + SHM_K, 0);
    asm volatile("s_waitcnt lgkmcnt(6)" ::: "memory"); RAWBAR();
    for (int t = 1; t + 1 < NT; t += 2) { STEP7(pB0, pB1, pA0, pA1, t); STEP7(pA0, pA1, pB0, pB1, t + 1); }
    STEP7(pB0, pB1, pA0, pA1, NT - 1);
    { s16x4 val[4], vah[4], vbl[4], vbh[4]; const int vb_ = vb0 + sp * SHM_V; float ps = 0.f;
      vfrag_load_h<0>(val, vah, vb_); vfrag_load_h<1>(vbl, vbh, vb_); SBAR();
#pragma unroll
      for (int r = 0; r < 16; ++r) ps += pB0[r] + pB1[r];
      { auto rr = __builtin_amdgcn_permlane32_swap(__float_as_uint(ps), __float_as_uint(ps), false, false); l_reg += __uint_as_float(rr[0]) + __uint_as_float(rr[1]); }
      PK4(pB0, 0, pa0); PK4(pB0, 8, pa1); PK4(pB1, 0, pa2); PK4(pB1, 8, pa3);
      asm volatile("s_waitcnt lgkmcnt(0)" ::: "memory"); SBAR();
      pv_mma_h(o[0], val, vah, pa0, pa1, pa2, pa3); pv_mma_h(o[1], vbl, vbh, pa0, pa1, pa2, pa3); SBAR(); }
    if (V7_YOUNG_PRIO) __builtin_amdgcn_s_setprio(0);
    if (hi == 0) li_l[r32] = l_reg; asm volatile("s_waitcnt lgkmcnt(0)" ::: "memory");
    float rli[16];
#pragma unroll
    for (int r = 0; r < 16; ++r) rli[r] = __builtin_amdgcn_rcpf(li_l[crow(r, hi)]);
    unsigned short* stg = (unsigned short*)(lds + M6_OST) + wid * 2048;
    unsigned short* dst = CAT + ((size_t)b * S + q0 + wid * 32) * 1024 + h * 64;
    store_o_tile(o, rli, stg, dst, [](int row) { return (size_t)row * 1024; }, lane);
    asm volatile("s_waitcnt vmcnt(0)" ::: "memory");
#if MLA_STAMP
#if MLA_STAMP
    if (blockIdx.x == 0 && wid == MLA_STAMP_WAVE && lane == 0 && STAMPS) STAMPS[0] = st_a;
#endif
    (void)STAMPS;
#endif
    __syncthreads();
#undef SLOAD
#undef SWRITE
#undef SWAIT
#undef RAWBAR
#undef MAX_TILE
#undef RESC7
#undef STEP7
}

#define PV_EXP9(OD, PA, VL, VH, PCX, B) do { OD = MF32(PA, PKV(VL, VH), OD); PCX[B] = __builtin_amdgcn_exp2f(PCX[B]); PCX[B + 1] = __builtin_amdgcn_exp2f(PCX[B + 1]); \
        PCX[B + 2] = __builtin_amdgcn_exp2f(PCX[B + 2]); PCX[B + 3] = __builtin_amdgcn_exp2f(PCX[B + 3]); asm volatile("" : "+v"(PCX)); SBAR(); } while (0)
__device__ __forceinline__ void mla_unit_v9(int wv, int bh, int qb, const unsigned short* __restrict__ Q, const unsigned short* __restrict__ KN, const unsigned short* __restrict__ KR,
                                            const unsigned short* __restrict__ V, unsigned short* __restrict__ CAT, const float* __restrict__ KMX, char* lds, unsigned long long* STAMPS = nullptr) {
    const int wid = wv, lane = gm::lane_now(), tid = wid * 64 + lane, r32 = lane & 31, hi = lane >> 5;
    const int b = bh >> 3, h = bh & 7;
    char* K_lds = lds; char* V_lds = lds + 5 * SHM_K;
    float* wsf = (float*)(lds + 5 * SHM_K + 5 * SHM_V) + wid * 64; float* li_l = wsf; float* al_l = wsf + 32;
    float m_reg = 0.f, l_reg = 0; f32x16 o[2] = {}; bf16x8 qr[6]; f32x16 negm = f32x16{};
    const size_t bhS = (size_t)bh * S; const int q0 = qb * 256;
    const unsigned short* Qw = Q + (bhS + q0 + wid * 32 + r32) * 96 + hi * 8;
#pragma unroll
    for (int d0 = 0; d0 < 6; ++d0) qr[d0] = *reinterpret_cast<const bf16x8*>(Qw + d0 * 16);
    bool exact = true;
    if (MLA_STATIC) { float q2 = 0.f;
#pragma unroll
      for (int d0 = 0; d0 < 6; ++d0)
#pragma unroll
          for (int j = 0; j < 8; ++j) { const float x = __uint_as_float((unsigned)(unsigned short)qr[d0][j] << 16); q2 += x * x; }
      { auto rr = __builtin_amdgcn_permlane32_swap(__float_as_uint(q2), __float_as_uint(q2), false, false); q2 = __uint_as_float(rr[0]) + __uint_as_float(rr[1]); }
      const float k2 = KMX[(b * 8 + h) * 2] + KMX[(b * 8 + h) * 2 + 1] + KMX[32 + b];
      const float ms = 1.01f * sqrtf(q2 * k2);
      exact = wg_or(!(ms <= MLA_STATIC_THR), (unsigned*)(lds + 147456 - 512), wid, lane);
      if (!exact) { m_reg = ms;
#pragma unroll
          for (int r = 0; r < 16; ++r) negm[r] = -ms; } }
    const unsigned lds_k = (unsigned)(uintptr_t)K_lds, lds_v = (unsigned)(uintptr_t)V_lds;
    const char* kp[2]; unsigned kstr[2];
#pragma unroll
    for (int i = 0; i < 2; ++i) { const int r = 8 * wid + 4 * i + (lane >> 4), p = lane & 15, c = p ^ (r & 15); const bool rope = (c >= 8) && (c < 12); const int cn = c & 7;
        kp[i] = rope ? (const char*)(KR + ((size_t)b * S + r) * 32 + (c - 8) * 8) : (const char*)(KN + (bhS + r) * 64 + cn * 8); kstr[i] = rope ? 4096u : 8192u; }
    const char* v_u = (const char*)(V + bhS * 64);
    const unsigned v_off = (unsigned)(((8 * wid + ((lane >> 2) & 7)) * 64 + (lane >> 5) * 32 + (lane & 3) * 8) * 2);
    const int vb0 = (int)(uintptr_t)V_lds + v_rd_base(lane);
#define GLDS16(src, ldsaddr) __builtin_amdgcn_global_load_lds((const unsigned*)(src), (LAS unsigned*)(uintptr_t)(unsigned)(ldsaddr), 16, 0, 0)
#define DMA_TILE(t, sl) do { GLDS16(kp[0] + (size_t)(t) * kstr[0], lds_k + (sl) * SHM_K + (2 * wid) * 1024); GLDS16(kp[1] + (size_t)(t) * kstr[1], lds_k + (sl) * SHM_K + (2 * wid + 1) * 1024); \
        GLDS16(v_u + (size_t)(t) * 8192 + v_off, lds_v + (sl) * SHM_V + wid * 1024); } while (0)
#define RAWBAR() do { asm volatile("" ::: "memory"); __builtin_amdgcn_s_barrier(); asm volatile("" ::: "memory"); } while (0)
#define MAX_TILE(P0, P1, FIRST_, AL_) do { AL_ = 1.f; \
        if (V7_EXACT && exact) { const float pmax = rowmax32b(P0, P1); \
            if ((FIRST_) || !__builtin_expect(__all(pmax <= THR), 1)) { const float dl = (FIRST_) ? pmax : fmaxf(pmax, 0.f); m_reg += dl; \
                _Pragma("unroll") for (int r = 0; r < 16; ++r) { P0[r] -= dl; P1[r] -= dl; } \
                _Pragma("unroll") for (int r = 0; r < 16; ++r) negm[r] = -m_reg; \
                if (!(FIRST_)) AL_ = __builtin_amdgcn_exp2f(-dl); } } } while (0)
#define RESC7(a) do { if (V7_EXACT && exact && __any((a) < 1.f)) { if (hi == 0) al_l[r32] = (a); asm volatile("s_waitcnt lgkmcnt(0)" ::: "memory"); l_reg *= (a); \
    _Pragma("unroll") for (int d = 0; d < 2; ++d) _Pragma("unroll") for (int r = 0; r < 16; ++r) o[d][r] *= al_l[crow(r, hi)]; } } while (0)
#define STEP7(PC0, PC1, PP0, PP1, t_) do { \
        s16x4 val[4], vah[4], vbl[4], vbh[4]; const int vb_ = vb0 + sp * SHM_V; float s0 = 0.f, s1 = 0.f, s2 = 0.f, s3 = 0.f, al_; \
        if ((t_) + 3 < NT) DMA_TILE((t_) + 3, sw); \
        KLD3(kb, K_lds + sc * SHM_K, 3); SBAR(); \
        QK_ADD(PC0, ka[0], qr[0], negm, PP0, 0);  QK_ADD(PC1, ka[1], qr[0], negm, PP0, 4); \
        QK_ADD(PC0, ka[2], qr[1], PC0, PP0, 8);   QK_ADD(PC1, ka[3], qr[1], PC1, PP0, 12); \
        QK_ADD(PC0, ka[4], qr[2], PC0, PP1, 0);   QK_ADD(PC1, ka[5], qr[2], PC1, PP1, 4); \
        vfrag_load_h<0>(val, vah, vb_); SBAR(); \
        QK_ADD(PC0, kb[0], qr[3], PC0, PP1, 8);   QK_ADD(PC1, kb[1], qr[3], PC1, PP1, 12); \
        QK_PK(PC0, kb[2], qr[4], PC0, PP0, 0, pa0); QK_PK(PC1, kb[3], qr[4], PC1, PP0, 8, pa1); \
        vfrag_load_h<1>(vbl, vbh, vb_); SBAR(); \
        QK_PK(PC0, kb[4], qr[5], PC0, PP1, 0, pa2); QK_PK(PC1, kb[5], qr[5], PC1, PP1, 8, pa3); \
        { float ps = (s0 + s1) + (s2 + s3); auto rr = __builtin_amdgcn_permlane32_swap(__float_as_uint(ps), __float_as_uint(ps), false, false); l_reg += __uint_as_float(rr[0]) + __uint_as_float(rr[1]); } \
        MAX_TILE(PC0, PC1, false, al_); \
        sp = sc; sc = (sc == 4) ? 0 : sc + 1; sw = (sw == 4) ? 0 : sw + 1; \
        if ((t_) + 1 < NT) KLD3(ka, K_lds + sc * SHM_K, 0); \
        asm volatile("s_waitcnt lgkmcnt(6)" ::: "memory"); SBAR(); \
        PV_EXP9(o[0], pa0, val[0], vah[0], PC0, 0);  PV_EXP9(o[1], pa0, vbl[0], vbh[0], PC0, 4); \
        PV_EXP9(o[0], pa1, val[1], vah[1], PC0, 8);  PV_EXP9(o[1], pa1, vbl[1], vbh[1], PC0, 12); \
        PV_EXP9(o[0], pa2, val[2], vah[2], PC1, 0);  PV_EXP9(o[1], pa2, vbl[2], vbh[2], PC1, 4); \
        PV_EXP9(o[0], pa3, val[3], vah[3], PC1, 8);  PV_EXP9(o[1], pa3, vbl[3], vbh[3], PC1, 12); \
        RESC7(al_); \
        if ((t_) + 3 < NT) asm volatile("s_waitcnt vmcnt(3)" ::: "memory"); else asm volatile("s_waitcnt vmcnt(0)" ::: "memory");     \
        RAWBAR(); } while (0)
    f32x16 pA0, pA1, pB0, pB1; bf16x8 pa0, pa1, pa2, pa3; bf16x8 ka[6], kb[6]; constexpr int NT = S / 64;
#if MLA_STAMP
    unsigned long long st_a = 0, tq0 = 0, tq1 = 0;
#endif

    if (V7_YOUNG_PRIO && wid >= 4) __builtin_amdgcn_s_setprio(1);
    DMA_TILE(0, 0); DMA_TILE(1, 1); DMA_TILE(2, 2);
    asm volatile("s_waitcnt vmcnt(0)" ::: "memory"); RAWBAR();
    KLD3(ka, K_lds, 0); KLD3(kb, K_lds, 3); SBAR();
    pA0 = MF32(ka[0], qr[0], negm); pA1 = MF32(ka[1], qr[0], negm); pA0 = MF32(ka[2], qr[1], pA0); pA1 = MF32(ka[3], qr[1], pA1); pA0 = MF32(ka[4], qr[2], pA0); pA1 = MF32(ka[5], qr[2], pA1);
    pA0 = MF32(kb[0], qr[3], pA0); pA1 = MF32(kb[1], qr[3], pA1); pA0 = MF32(kb[2], qr[4], pA0); pA1 = MF32(kb[3], qr[4], pA1); pA0 = MF32(kb[4], qr[5], pA0); pA1 = MF32(kb[5], qr[5], pA1); SBAR();
    { float al0; MAX_TILE(pA0, pA1, true, al0); (void)al0; }
#pragma unroll
    for (int r = 0; r < 16; ++r) { pA0[r] = __builtin_amdgcn_exp2f(pA0[r]); pA1[r] = __builtin_amdgcn_exp2f(pA1[r]); }
    DMA_TILE(3, 3);
    int sp = 0, sc = 1, sw = 4;
    KLD3(ka, K_lds + SHM_K, 0);
    asm volatile("s_waitcnt vmcnt(3)" ::: "memory"); RAWBAR();
    for (int t = 1; t + 1 < NT; t += 2) { STEP7(pB0, pB1, pA0, pA1, t); STEP7(pA0, pA1, pB0, pB1, t + 1); }
    STEP7(pB0, pB1, pA0, pA1, NT - 1);
    { s16x4 val[4], vah[4], vbl[4], vbh[4]; const int vb_ = vb0 + sp * SHM_V; float ps = 0.f;
      vfrag_load_h<0>(val, vah, vb_); vfrag_load_h<1>(vbl, vbh, vb_); SBAR();
#pragma unroll
      for (int r = 0; r < 16; ++r) ps += pB0[r] + pB1[r];
      { auto rr = __builtin_amdgcn_permlane32_swap(__float_as_uint(ps), __float_as_uint(ps), false, false); l_reg += __uint_as_float(rr[0]) + __uint_as_float(rr[1]); }
      PK4(pB0, 0, pa0); PK4(pB0, 8, pa1); PK4(pB1, 0, pa2); PK4(pB1, 8, pa3);
      asm volatile("s_waitcnt lgkmcnt(0)" ::: "memory"); SBAR();
      pv_mma_h(o[0], val, vah, pa0, pa1, pa2, pa3); pv_mma_h(o[1], vbl, vbh, pa0, pa1, pa2, pa3); SBAR(); }
    if (V7_YOUNG_PRIO) __builtin_amdgcn_s_setprio(0);
    asm volatile("s_waitcnt lgkmcnt(0)" ::: "memory"); RAWBAR();
    if (hi == 0) li_l[r32] = l_reg; asm volatile("s_waitcnt lgkmcnt(0)" ::: "memory");
    float rli[16];
#pragma unroll
    for (int r = 0; r < 16; ++r) rli[r] = __builtin_amdgcn_rcpf(li_l[crow(r, hi)]);
    unsigned short* stg = (unsigned short*)lds + wid * 2048;
    unsigned short* dst = CAT + ((size_t)b * S + q0 + wid * 32) * 1024 + h * 64;
    store_o_tile(o, rli, stg, dst, [](int row) { return (size_t)row * 1024; }, lane);
    asm volatile("s_waitcnt vmcnt(0)" ::: "memory");
#if MLA_STAMP
#if MLA_STAMP
    if (blockIdx.x == 0 && wid == MLA_STAMP_WAVE && lane == 0 && STAMPS) STAMPS[0] = st_a;
#endif
    (void)STAMPS;
#endif
    __syncthreads();
#undef GLDS16
#undef DMA_TILE
#undef RAWBAR
#undef MAX_TILE
#undef RESC7
#undef STEP7
#undef PV_EXP9
}

#define PV_EXP8(OD, PA, VL, VH, PCX, B) do { OD = MF32(PA, PKV(VL, VH), OD); PCX[B] = __builtin_amdgcn_exp2f(PCX[B]); PCX[B + 1] = __builtin_amdgcn_exp2f(PCX[B + 1]); \
        PCX[B + 2] = __builtin_amdgcn_exp2f(PCX[B + 2]); PCX[B + 3] = __builtin_amdgcn_exp2f(PCX[B + 3]); asm volatile("" : "+v"(PCX)); SBAR(); } while (0)
__device__ __forceinline__ void mla_unit_v8(int wv, int bh, int qb, const unsigned short* __restrict__ Q, const unsigned short* __restrict__ KN, const unsigned short* __restrict__ KR,
                                            const unsigned short* __restrict__ V, unsigned short* __restrict__ CAT, const float* __restrict__ KMX, char* lds, unsigned long long* STAMPS = nullptr) {
    const int wid = wv, lane = gm::lane_now(), tid = wid * 64 + lane, r32 = lane & 31, hi = lane >> 5;
    const int b = bh >> 3, h = bh & 7; const bool halfB = wid >= 4;
    char* K_lds = lds + M6_K; char* V_lds = lds + M6_V;
    float* wsf = (float*)(lds + M6_WS) + wid * 64; float* li_l = wsf; float* al_l = wsf + 32;
    float m_reg = 0.f, l_reg = 0; f32x16 o[2] = {}; bf16x8 qr[6]; f32x16 negm = f32x16{};
    const size_t bhS = (size_t)bh * S; const int q0 = qb * 256;
    const unsigned short* Qw = Q + (bhS + q0 + wid * 32 + r32) * 96 + hi * 8;
#pragma unroll
    for (int d0 = 0; d0 < 6; ++d0) qr[d0] = *reinterpret_cast<const bf16x8*>(Qw + d0 * 16);
    bool exact = true;
    if (MLA_STATIC) { float q2 = 0.f;
#pragma unroll
      for (int d0 = 0; d0 < 6; ++d0)
#pragma unroll
          for (int j = 0; j < 8; ++j) { const float x = __uint_as_float((unsigned)(unsigned short)qr[d0][j] << 16); q2 += x * x; }
      { auto rr = __builtin_amdgcn_permlane32_swap(__float_as_uint(q2), __float_as_uint(q2), false, false); q2 = __uint_as_float(rr[0]) + __uint_as_float(rr[1]); }
      const float k2 = KMX[(b * 8 + h) * 2] + KMX[(b * 8 + h) * 2 + 1] + KMX[32 + b];
      const float ms = 1.01f * sqrtf(q2 * k2);
      exact = wg_or(!(ms <= MLA_STATIC_THR), (unsigned*)(lds + 147456 - 512), wid, lane);
      if (!exact) { m_reg = ms;
#pragma unroll
          for (int r = 0; r < 16; ++r) negm[r] = -ms; } }
    const int srow = tid >> 3, sch = tid & 7, rrow = (tid & 255) >> 2, rch = tid & 3;
    const char* kn_u = (const char*)(KN + bhS * 64); const char* v_u = (const char*)(V + bhS * 64); const char* kr_u = (const char*)(KR + (size_t)b * S * 32);
    const unsigned kn_off = (unsigned)(srow * 64 + sch * 8) * 2u, kr_off = (unsigned)(rrow * 32 + rch * 8) * 2u;
    const int kst = KSWZ(srow, sch * 16), krst = KSWZ(rrow, (8 + rch) * 16), vst = v_st(srow, sch * 8);
    const int vb0 = (int)(uintptr_t)V_lds + v_rd_base(lane);
    bf16x8 s_kn, s_kr, s_v;
#define SLOAD(t) do { s_kn = *reinterpret_cast<const bf16x8*>(kn_u + (size_t)(t) * 8192 + kn_off); s_kr = *reinterpret_cast<const bf16x8*>(kr_u + (size_t)(t) * 4096 + kr_off); \
    s_v = *reinterpret_cast<const bf16x8*>(v_u + (size_t)(t) * 8192 + kn_off); } while (0)
#define SWRITE(sl) do { *(bf16x8*)(K_lds + (sl) * SHM_K + kst) = s_kn; if (tid < 256) *(bf16x8*)(K_lds + (sl) * SHM_K + krst) = s_kr; *(bf16x8*)(V_lds + (sl) * SHM_V + vst) = s_v; } while (0)
#define SWAIT() asm volatile("s_waitcnt vmcnt(0)" ::: "memory")
#define RAWBAR() do { asm volatile("" ::: "memory"); __builtin_amdgcn_s_barrier(); asm volatile("" ::: "memory"); } while (0)
#define MAX_TILE(P0, P1, FIRST_, AL_) do { AL_ = 1.f; \
        if (V7_EXACT && exact) { const float pmax = rowmax32b(P0, P1); \
            if ((FIRST_) || !__builtin_expect(__all(pmax <= THR), 1)) { const float dl = (FIRST_) ? pmax : fmaxf(pmax, 0.f); m_reg += dl; \
                _Pragma("unroll") for (int r = 0; r < 16; ++r) { P0[r] -= dl; P1[r] -= dl; } \
                _Pragma("unroll") for (int r = 0; r < 16; ++r) negm[r] = -m_reg; \
                if (!(FIRST_)) AL_ = __builtin_amdgcn_exp2f(-dl); } } } while (0)
#define RESC7(a) do { if (V7_EXACT && exact && __any((a) < 1.f)) { if (hi == 0) al_l[r32] = (a); asm volatile("s_waitcnt lgkmcnt(0)" ::: "memory"); l_reg *= (a); \
    _Pragma("unroll") for (int d = 0; d < 2; ++d) _Pragma("unroll") for (int r = 0; r < 16; ++r) o[d][r] *= al_l[crow(r, hi)]; } } while (0)
#define STEP7(PC0, PC1, PP0, PP1, t_) do { \
        s16x4 val[4], vah[4], vbl[4], vbh[4]; const int vb_ = vb0 + sp * SHM_V; float s0 = 0.f, s1 = 0.f, s2 = 0.f, s3 = 0.f, al_; \
        KLD3(kb, K_lds + sc * SHM_K, 3); SBAR(); \
        QK_ADD(PC0, ka[0], qr[0], negm, PP0, 0);  QK_ADD(PC1, ka[1], qr[0], negm, PP0, 4); \
        QK_ADD(PC0, ka[2], qr[1], PC0, PP0, 8);   QK_ADD(PC1, ka[3], qr[1], PC1, PP0, 12); \
        QK_ADD(PC0, ka[4], qr[2], PC0, PP1, 0);   QK_ADD(PC1, ka[5], qr[2], PC1, PP1, 4); \
        vfrag_load_h<0>(val, vah, vb_); SBAR(); \
        QK_ADD(PC0, kb[0], qr[3], PC0, PP1, 8);   QK_ADD(PC1, kb[1], qr[3], PC1, PP1, 12); \
        QK_PK(PC0, kb[2], qr[4], PC0, PP0, 0, pa0); QK_PK(PC1, kb[3], qr[4], PC1, PP0, 8, pa1); \
        vfrag_load_h<1>(vbl, vbh, vb_); SBAR(); \
        QK_PK(PC0, kb[4], qr[5], PC0, PP1, 0, pa2); QK_PK(PC1, kb[5], qr[5], PC1, PP1, 8, pa3); \
        { float ps = (s0 + s1) + (s2 + s3); auto rr = __builtin_amdgcn_permlane32_swap(__float_as_uint(ps), __float_as_uint(ps), false, false); l_reg += __uint_as_float(rr[0]) + __uint_as_float(rr[1]); } \
        MAX_TILE(PC0, PC1, false, al_); \
        asm volatile("s_waitcnt lgkmcnt(0)" ::: "memory"); RAWBAR(); \
        if ((t_) + 2 < NT) { SWAIT(); SWRITE(sw); if ((t_) + 3 < NT) SLOAD((t_) + 3); } \
        sp = sc; sc = (sc + 1) & 3; sw = (sw + 1) & 3; \
        if ((t_) + 1 < NT) KLD3(ka, K_lds + sc * SHM_K, 0); SBAR(); \
        PV_EXP8(o[0], pa0, val[0], vah[0], PC0, 0);  PV_EXP8(o[1], pa0, vbl[0], vbh[0], PC0, 4); \
        PV_EXP8(o[0], pa1, val[1], vah[1], PC0, 8);  PV_EXP8(o[1], pa1, vbl[1], vbh[1], PC0, 12); \
        PV_EXP8(o[0], pa2, val[2], vah[2], PC1, 0);  PV_EXP8(o[1], pa2, vbl[2], vbh[2], PC1, 4); \
        PV_EXP8(o[0], pa3, val[3], vah[3], PC1, 8);  PV_EXP8(o[1], pa3, vbl[3], vbh[3], PC1, 12); \
        RESC7(al_); \
        asm volatile("s_waitcnt lgkmcnt(6)" ::: "memory"); RAWBAR(); } while (0)
    f32x16 pA0, pA1, pB0, pB1; bf16x8 pa0, pa1, pa2, pa3; bf16x8 ka[6], kb[6]; constexpr int NT = S / 64;

    SLOAD(0); SWAIT(); SWRITE(0); SLOAD(1); SWAIT(); SWRITE(1); SLOAD(2);
    asm volatile("s_waitcnt lgkmcnt(0)" ::: "memory"); RAWBAR();
    if (halfB) RAWBAR();
    KLD3(ka, K_lds, 0); KLD3(kb, K_lds, 3); SBAR();
    pA0 = MF32(ka[0], qr[0], negm); pA1 = MF32(ka[1], qr[0], negm); pA0 = MF32(ka[2], qr[1], pA0); pA1 = MF32(ka[3], qr[1], pA1); pA0 = MF32(ka[4], qr[2], pA0); pA1 = MF32(ka[5], qr[2], pA1);
    pA0 = MF32(kb[0], qr[3], pA0); pA1 = MF32(kb[1], qr[3], pA1); pA0 = MF32(kb[2], qr[4], pA0); pA1 = MF32(kb[3], qr[4], pA1); pA0 = MF32(kb[4], qr[5], pA0); pA1 = MF32(kb[5], qr[5], pA1); SBAR();
    { float al0; MAX_TILE(pA0, pA1, true, al0); (void)al0; }
    asm volatile("s_waitcnt lgkmcnt(0)" ::: "memory"); RAWBAR();
#pragma unroll
    for (int r = 0; r < 16; ++r) { pA0[r] = __builtin_amdgcn_exp2f(pA0[r]); pA1[r] = __builtin_amdgcn_exp2f(pA1[r]); }
    SWAIT(); SWRITE(2); SLOAD(3);
    int sp = 0, sc = 1, sw = 3;
    KLD3(ka, K_lds + SHM_K, 0);
    asm volatile("s_waitcnt lgkmcnt(6)" ::: "memory"); RAWBAR();
    for (int t = 1; t + 1 < NT; t += 2) { STEP7(pB0, pB1, pA0, pA1, t); STEP7(pA0, pA1, pB0, pB1, t + 1); }
    STEP7(pB0, pB1, pA0, pA1, NT - 1);
    { s16x4 val[4], vah[4], vbl[4], vbh[4]; const int vb_ = vb0 + sp * SHM_V; float ps = 0.f;
      vfrag_load_h<0>(val, vah, vb_); vfrag_load_h<1>(vbl, vbh, vb_); SBAR();
#pragma unroll
      for (int r = 0; r < 16; ++r) ps += pB0[r] + pB1[r];
      { auto rr = __builtin_amdgcn_permlane32_swap(__float_as_uint(ps), __float_as_uint(ps), false, false); l_reg += __uint_as_float(rr[0]) + __uint_as_float(rr[1]); }
      PK4(pB0, 0, pa0); PK4(pB0, 8, pa1); PK4(pB1, 0, pa2); PK4(pB1, 8, pa3);
      asm volatile("s_waitcnt lgkmcnt(0)" ::: "memory"); SBAR();
      pv_mma_h(o[0], val, vah, pa0, pa1, pa2, pa3); pv_mma_h(o[1], vbl, vbh, pa0, pa1, pa2, pa3); SBAR(); }
    if (!halfB) RAWBAR();
    if (hi == 0) li_l[r32] = l_reg; asm volatile("s_waitcnt lgkmcnt(0)" ::: "memory");
    float rli[16];
#pragma unroll
    for (int r = 0; r < 16; ++r) rli[r] = __builtin_amdgcn_rcpf(li_l[crow(r, hi)]);
    unsigned short* stg = (unsigned short*)(lds + M6_OST) + wid * 2048;
    unsigned short* dst = CAT + ((size_t)b * S + q0 + wid * 32) * 1024 + h * 64;
    store_o_tile(o, rli, stg, dst, [](int row) { return (size_t)row * 1024; }, lane);
    asm volatile("s_waitcnt vmcnt(0)" ::: "memory");
#if MLA_STAMP
    (void)STAMPS;
#endif
    __syncthreads();
#undef SLOAD
#undef SWRITE
#undef SWAIT
#undef RAWBAR
#undef MAX_TILE
#undef RESC7
#undef STEP7
#undef PV_EXP8
}

constexpr int DL_K = 0, DL_V = 49152, DL_WS = 98304, DL_OST = DL_WS + 8 * 256;
#define KSWZD(row, colB) ((row) * 128 + ((colB) ^ ((((row) >> 1) & 7) << 4)))
__device__ __forceinline__ void dil_unit(int wv, int bh, int br, int blk, const unsigned short* __restrict__ DQ, const unsigned short* __restrict__ DK, const unsigned short* __restrict__ DV,
                                         unsigned short* __restrict__ OBR, float* __restrict__ LSE, char* lds) {
    const int wid = wv, lane = gm::lane_now(), tid = wid * 64 + lane, r32 = lane & 31, hi = lane >> 5;
    const int sh = 2 * br, dil = 1 << sh, L = S >> sh, nbl = L >> 8, res = blk / nbl, lb = blk % nbl;
    const size_t bhS = (size_t)bh * S; const int b = bh >> 3, h = bh & 7;
    char* K_lds = lds + DL_K; char* V_lds = lds + DL_V;
#pragma unroll
    for (int half = 0; half < 2; ++half) {
        bf16x8 kk[3], vv[3];
#pragma unroll
        for (int it = 0; it < 3; ++it) { const int item = (half * 3 + it) * 512 + tid, row = item >> 3, ch = item & 7; const int l = 256 * lb - 64 + row; const bool valid = (l >= 0) && (l < L);
            const size_t src = (bhS + (valid ? ((size_t)l << sh) + res : 0)) * 64 + ch * 8;
            kk[it] = *reinterpret_cast<const bf16x8*>(DK + src); vv[it] = *reinterpret_cast<const bf16x8*>(DV + src);
            if (!valid) { kk[it] = bf16x8{}; vv[it] = bf16x8{}; } }
#pragma unroll
        for (int it = 0; it < 3; ++it) { const int item = (half * 3 + it) * 512 + tid, row = item >> 3, ch = item & 7;
            *(bf16x8*)(K_lds + KSWZD(row, ch * 16)) = kk[it]; *(bf16x8*)(V_lds + (row >> 4) * 2048 + v_st(row & 15, ch * 8)) = vv[it]; }
    }
    bf16x8 qr[4];
    const int ql = wid * 32 + r32; const size_t qpos = ((size_t)(256 * lb + ql) << sh) + res;
    const unsigned short* Qw = DQ + (bhS + qpos) * 64 + hi * 8;
#pragma unroll
    for (int d0 = 0; d0 < 4; ++d0) qr[d0] = *reinterpret_cast<const bf16x8*>(Qw + d0 * 16);
    __syncthreads();
    f32x16 p[5];
#pragma unroll
    for (int j = 0; j < 5; ++j) { p[j] = f32x16{}; const int row = wid * 32 + j * 32 + r32;
#pragma unroll
        for (int d0 = 0; d0 < 4; ++d0) { const bf16x8 kf = *reinterpret_cast<const bf16x8*>(K_lds + KSWZD(row, (d0 * 16 + hi * 8) * 2)); p[j] = __builtin_amdgcn_mfma_f32_32x32x16_bf16(kf, qr[d0], p[j], 0, 0, 0); } }
    const float NEG = -1e30f;
    const int klo = 64 - 256 * lb, khi = L + 64 - 256 * lb;
    { const int t0 = max(r32, klo - wid * 32) - 4 * hi, t1 = klo - wid * 32 - 32 - 4 * hi, t3 = khi - wid * 32 - 96 - 4 * hi, t4 = min(r32 + 1, khi - wid * 32 - 128) - 4 * hi;
#pragma unroll
      for (int r = 0; r < 16; ++r) { const int c = (r & 3) + 8 * (r >> 2);
          if (c < t0) p[0][r] = NEG; if (c < t1) p[1][r] = NEG; if (c >= t3) p[3][r] = NEG; if (c >= t4) p[4][r] = NEG; } }
    float mx = rowmax32(p[0], p[1]); mx = fmaxf(mx, rowmax32(p[2], p[3]));
    { float m4 = p[4][0];
#pragma unroll
      for (int r = 1; r < 16; ++r) m4 = fmaxf(m4, p[4][r]);
      auto rr = __builtin_amdgcn_permlane32_swap(__float_as_uint(m4), __float_as_uint(m4), false, false); mx = fmaxf(mx, fmaxf(__uint_as_float(rr[0]), __uint_as_float(rr[1]))); }
    float ps = 0.f;
#pragma unroll
    for (int j = 0; j < 5; ++j)
#pragma unroll
        for (int r = 0; r < 16; ++r) { p[j][r] = __builtin_amdgcn_exp2f(p[j][r] - mx); ps += p[j][r]; }
    { auto rr = __builtin_amdgcn_permlane32_swap(__float_as_uint(ps), __float_as_uint(ps), false, false); ps = __uint_as_float(rr[0]) + __uint_as_float(rr[1]); }
    bf16x8 pa[5][2];
#pragma unroll
    for (int j = 0; j < 5; ++j) { PK4(p[j], 0, pa[j][0]); PK4(p[j], 8, pa[j][1]); }
    f32x16 o[2] = {};
    const int vb = (int)(uintptr_t)V_lds + v_rd_base(lane) + wid * 4096;
    pv_half<0, 0 * 4096>(o[0], vb, pa[0][0], pa[0][1]); pv_half<1, 0 * 4096>(o[1], vb, pa[0][0], pa[0][1]);
    pv_half<0, 1 * 4096>(o[0], vb, pa[1][0], pa[1][1]); pv_half<1, 1 * 4096>(o[1], vb, pa[1][0], pa[1][1]);
    pv_half<0, 2 * 4096>(o[0], vb, pa[2][0], pa[2][1]); pv_half<1, 2 * 4096>(o[1], vb, pa[2][0], pa[2][1]);
    pv_half<0, 3 * 4096>(o[0], vb, pa[3][0], pa[3][1]); pv_half<1, 3 * 4096>(o[1], vb, pa[3][0], pa[3][1]);
    pv_half<0, 4 * 4096>(o[0], vb, pa[4][0], pa[4][1]); pv_half<1, 4 * 4096>(o[1], vb, pa[4][0], pa[4][1]);
    float* wsf = (float*)(lds + DL_WS) + wid * 64;
    if (hi == 0) { wsf[r32] = ps; LSE[((size_t)br * T + (size_t)b * S + qpos) * 8 + h] = mx + __builtin_amdgcn_logf(ps); }
    asm volatile("s_waitcnt lgkmcnt(0)" ::: "memory");
    float rli[16];
#pragma unroll
    for (int r = 0; r < 16; ++r) rli[r] = __builtin_amdgcn_rcpf(wsf[crow(r, hi)]);
    unsigned short* stg = (unsigned short*)(lds + DL_OST) + wid * 2048;
    unsigned short* dst = OBR + ((size_t)br * T + (size_t)b * S + (((size_t)(256 * lb + wid * 32)) << sh) + res) * 512 + h * 64;
    store_o_tile(o, rli, stg, dst, [sh](int row) { return ((size_t)row << sh) * 512; }, lane);
    asm volatile("s_waitcnt vmcnt(0)" ::: "memory");
    __syncthreads();
}
#define DIL_DECODE(u, bh_, br_, res_, lb_, sh_, L_) const int bh_ = (u) / 96, br_ = ((u) >> 5) % 3, blk__##bh_ = (u) & 31, sh_ = 2 * br_, L_ = S >> sh_, nbl__##bh_ = L_ >> 8, res_ = blk__##bh_ / nbl__##bh_, lb_ = blk__##bh_ % nbl__##bh_
__device__ __forceinline__ void dil_phase(int wv, int u0, int ustep, int nunits, const unsigned short* __restrict__ DQ, const unsigned short* __restrict__ DK, const unsigned short* __restrict__ DV,
                                          unsigned short* __restrict__ OBR, float* __restrict__ LSE, char* lds) {
    const int wid = wv, lane = gm::lane_now(), tid = wid * 64 + lane, r32 = lane & 31, hi = lane >> 5;
    char* K_lds = lds + DL_K; char* V_lds = lds + DL_V;
    bf16x8 kk[6], qn[4]; unsigned kmask = 0u;
#define DIL_LOAD6(dst, mask, SRC, u) do { DIL_DECODE(u, bh_, br_, res_, lb_, sh_, L_); const size_t bhS_ = (size_t)bh_ * S; mask = 0u; \
        _Pragma("unroll") for (int it = 0; it < 6; ++it) { const int item = it * 512 + tid, row = item >> 3, ch = item & 7; const int l = 256 * lb_ - 64 + row; const bool valid = (l >= 0) && (l < L_); \
            const size_t src = (bhS_ + (valid ? ((size_t)l << sh_) + res_ : 0)) * 64 + ch * 8; dst[it] = *reinterpret_cast<const bf16x8*>(SRC + src); mask |= (valid ? 1u : 0u) << it; } } while (0)
#define DIL_LOADQ(u) do { DIL_DECODE(u, bh_, br_, res_, lb_, sh_, L_); const size_t qpos_ = ((size_t)(256 * lb_ + wid * 32 + r32) << sh_) + res_; const unsigned short* Qw_ = DQ + ((size_t)bh_ * S + qpos_) * 64 + hi * 8; \
        _Pragma("unroll") for (int d0 = 0; d0 < 4; ++d0) qn[d0] = *reinterpret_cast<const bf16x8*>(Qw_ + d0 * 16); } while (0)
    if (wid >= 4) __builtin_amdgcn_s_setprio(1);
    int u = u0;
    if (u < nunits) { DIL_LOAD6(kk, kmask, DK, u); DIL_LOADQ(u); }
    for (; u < nunits; u += ustep) {
        DIL_DECODE(u, bh, br, res, lb, sh, L); const int b = bh >> 3, h = bh & 7;
#pragma unroll
        for (int it = 0; it < 6; ++it) { const int item = it * 512 + tid, row = item >> 3, ch = item & 7; *(bf16x8*)(K_lds + KSWZD(row, ch * 16)) = ((kmask >> it) & 1u) ? kk[it] : bf16x8{}; }
        bf16x8 qr[4];
#pragma unroll
        for (int d0 = 0; d0 < 4; ++d0) qr[d0] = qn[d0];
        bf16x8 vv[6]; unsigned vmask; DIL_LOAD6(vv, vmask, DV, u);
        __syncthreads();
        const int ql = wid * 32 + r32; const size_t qpos = ((size_t)(256 * lb + ql) << sh) + res;
        f32x16 p[5];
#pragma unroll
        for (int j = 0; j < 5; ++j) { p[j] = f32x16{}; const int row = wid * 32 + j * 32 + r32;
#pragma unroll
            for (int d0 = 0; d0 < 4; ++d0) { const bf16x8 kf = *reinterpret_cast<const bf16x8*>(K_lds + KSWZD(row, (d0 * 16 + hi * 8) * 2)); p[j] = __builtin_amdgcn_mfma_f32_32x32x16_bf16(kf, qr[d0], p[j], 0, 0, 0); } }
        const float NEG = -1e30f;
        const int klo = 64 - 256 * lb, khi = L + 64 - 256 * lb;
        { const int t0 = max(r32, klo - wid * 32) - 4 * hi, t1 = klo - wid * 32 - 32 - 4 * hi, t3 = khi - wid * 32 - 96 - 4 * hi, t4 = min(r32 + 1, khi - wid * 32 - 128) - 4 * hi;
#pragma unroll
          for (int r = 0; r < 16; ++r) { const int c = (r & 3) + 8 * (r >> 2);
              if (c < t0) p[0][r] = NEG; if (c < t1) p[1][r] = NEG; if (c >= t3) p[3][r] = NEG; if (c >= t4) p[4][r] = NEG; } }
        float mx = rowmax32(p[0], p[1]); mx = fmaxf(mx, rowmax32(p[2], p[3]));
        { float m4 = p[4][0];
#pragma unroll
          for (int r = 1; r < 16; ++r) m4 = fmaxf(m4, p[4][r]);
          auto rr = __builtin_amdgcn_permlane32_swap(__float_as_uint(m4), __float_as_uint(m4), false, false); mx = fmaxf(mx, fmaxf(__uint_as_float(rr[0]), __uint_as_float(rr[1]))); }
        float ps = 0.f;
#pragma unroll
        for (int j = 0; j < 5; ++j)
#pragma unroll
            for (int r = 0; r < 16; ++r) { p[j][r] = __builtin_amdgcn_exp2f(p[j][r] - mx); ps += p[j][r]; }
        { auto rr = __builtin_amdgcn_permlane32_swap(__float_as_uint(ps), __float_as_uint(ps), false, false); ps = __uint_as_float(rr[0]) + __uint_as_float(rr[1]); }
        bf16x8 pa[5][2];
#pragma unroll
        for (int j = 0; j < 5; ++j) { PK4(p[j], 0, pa[j][0]); PK4(p[j], 8, pa[j][1]); }
#pragma unroll
        for (int it = 0; it < 6; ++it) { const int item = it * 512 + tid, row = item >> 3, ch = item & 7; *(bf16x8*)(V_lds + (row >> 4) * 2048 + v_st(row & 15, ch * 8)) = ((vmask >> it) & 1u) ? vv[it] : bf16x8{}; }
        __syncthreads();
        if (u + ustep < nunits) { DIL_LOAD6(kk, kmask, DK, u + ustep); DIL_LOADQ(u + ustep); }
        f32x16 o[2] = {};
        const int vb = (int)(uintptr_t)V_lds + v_rd_base(lane) + wid * 4096;
        pv_half<0, 0 * 4096>(o[0], vb, pa[0][0], pa[0][1]); pv_half<1, 0 * 4096>(o[1], vb, pa[0][0], pa[0][1]);
        pv_half<0, 1 * 4096>(o[0], vb, pa[1][0], pa[1][1]); pv_half<1, 1 * 4096>(o[1], vb, pa[1][0], pa[1][1]);
        pv_half<0, 2 * 4096>(o[0], vb, pa[2][0], pa[2][1]); pv_half<1, 2 * 4096>(o[1], vb, pa[2][0], pa[2][1]);
        pv_half<0, 3 * 4096>(o[0], vb, pa[3][0], pa[3][1]); pv_half<1, 3 * 4096>(o[1], vb, pa[3][0], pa[3][1]);
        pv_half<0, 4 * 4096>(o[0], vb, pa[4][0], pa[4][1]); pv_half<1, 4 * 4096>(o[1], vb, pa[4][0], pa[4][1]);
        float* wsf = (float*)(lds + DL_WS) + wid * 64;
        if (hi == 0) { wsf[r32] = ps; LSE[((size_t)br * T + (size_t)b * S + qpos) * 8 + h] = mx + __builtin_amdgcn_logf(ps); }
        asm volatile("s_waitcnt lgkmcnt(0)" ::: "memory");
        float rli[16];
#pragma unroll
        for (int r = 0; r < 16; ++r) rli[r] = __builtin_amdgcn_rcpf(wsf[crow(r, hi)]);
        unsigned short* stg = (unsigned short*)(lds + DL_OST) + wid * 2048;
        unsigned short* dst = OBR + ((size_t)br * T + (size_t)b * S + (((size_t)(256 * lb + wid * 32)) << sh) + res) * 512 + h * 64;
        store_o_tile(o, rli, stg, dst, [sh](int row) { return ((size_t)row << sh) * 512; }, lane);
        __syncthreads();
    }
    __builtin_amdgcn_s_setprio(0);
#undef DIL_LOAD6
#undef DIL_LOADQ
}
__device__ __forceinline__ void dil_combine(const unsigned short* __restrict__ OBR, const float* __restrict__ LSE, unsigned short* __restrict__ CAT, int gtid, int gthreads) {
    for (int i = gtid; i < T * 64; i += gthreads) { const int t = i >> 6, c8 = i & 63, h = c8 >> 3;
        const float l0 = LSE[((size_t)0 * T + t) * 8 + h], l1 = LSE[((size_t)1 * T + t) * 8 + h], l2 = LSE[((size_t)2 * T + t) * 8 + h];
        const float mx = fmaxf(l0, fmaxf(l1, l2)); float w0 = __builtin_amdgcn_exp2f(l0 - mx), w1 = __builtin_amdgcn_exp2f(l1 - mx), w2 = __builtin_amdgcn_exp2f(l2 - mx);
        const float inv = 1.f / (w0 + w1 + w2); w0 *= inv; w1 *= inv; w2 *= inv;
        const u32x4 a = *(const u32x4*)(OBR + ((size_t)0 * T + t) * 512 + c8 * 8), bb = *(const u32x4*)(OBR + ((size_t)1 * T + t) * 512 + c8 * 8), cc = *(const u32x4*)(OBR + ((size_t)2 * T + t) * 512 + c8 * 8);
        u32x4 o;
#pragma unroll
        for (int k = 0; k < 4; ++k) { const float lo = w0 * __uint_as_float(a[k] << 16) + w1 * __uint_as_float(bb[k] << 16) + w2 * __uint_as_float(cc[k] << 16);
            const float hi = w0 * __uint_as_float(a[k] & 0xffff0000u) + w1 * __uint_as_float(bb[k] & 0xffff0000u) + w2 * __uint_as_float(cc[k] & 0xffff0000u); o[k] = cvtpk(lo, hi); }
        *(u32x4*)(CAT + (size_t)t * 1024 + 512 + c8 * 8) = o; }
}
#undef SBAR
}
namespace mk {
struct SchedP4 {
    __device__ __forceinline__ void a_ready(const gm::Unit&, int, int) const {}
    __device__ __forceinline__ void done(const gm::Unit&, int) const {}
    __device__ __forceinline__ void stamp(int, const gm::Unit&, int, int) const {}
    static constexpr bool GATHER = false;
    const char* A; const char* Bt; int G, c;
    __device__ __forceinline__ bool next(int i, gm::Unit& u) const { int pm, pn; if (!static_tile(i, G, c, 64, 4, pm, pn)) return false;
        u.A = A; u.Bt = Bt; u.gidx = nullptr; u.lda2 = 2048; u.ldb2 = 2048; u.arow0 = pm * 256; u.brow0 = pn * 256; u.nt = 16; u.pm = pm; u.pn = pn; u.aux = 0; return true; }
};
struct EpiP4 {
    static constexpr bool PERM = false;
    const float* x; float* out; const float* modf;
    __device__ __forceinline__ void operator()(EPI_ARGS) const {
        const int b = (u.pm * 256) >> 13; const float* gt = modf + b * 6144 + 2048;
        const int col0 = u.pn * 256 + wc * 32 + 4 * fq;
        f32x4 g[2][2];
#pragma unroll
        for (int bj = 0; bj < 2; ++bj)
#pragma unroll
            for (int n = 0; n < 2; ++n) g[bj][n] = *(const f32x4*)(gt + col0 + bj * 128 + n * 16);
#pragma unroll
        for (int ai = 0; ai < 2; ++ai)
#pragma unroll
            for (int m = 0; m < 4; ++m) { const size_t off = (size_t)(u.pm * 256 + ai * 128 + wr * 64 + m * 16 + fr) * D + col0;
#pragma unroll
                for (int bj = 0; bj < 2; ++bj)
#pragma unroll
                    for (int n = 0; n < 2; ++n) { const f32x4 xv = *(const f32x4*)(x + off + bj * 128 + n * 16); *(f32x4*)(out + off + bj * 128 + n * 16) = xv + g[bj][n] * acc[ai][bj][m][n]; } }
    }
};
__device__ __forceinline__ void p4b_rows(Frame& F) {
    const int tid_ = F.wave * 64 + fresh_lane();
    LAS float* WR = (LAS float*)F.lds;
    LAS float* A1 = WR + 16384;
    LAS float* A0 = A1 + 2048;
    const float* modf = (const float*)(F.ws + WS_MODF);
    for (int i = tid_; i < 16384; i += NTHREADS) { const int j = i >> 4, e = i & 15; WR[e * 1024 + j] = F.w_router[i]; }
    for (int i = tid_; i < 2048; i += NTHREADS) { const int b = i >> 10, j = i & 1023; A1[i] = F.g_ffn[j] * (1.f + modf[b * 6144 + 4096 + j]); A0[i] = modf[b * 6144 + 3072 + j]; }
    __syncthreads();
    const int gw = F.vcu * NWAVES + F.wave, NGW = F.G * NWAVES, lane = fresh_lane();
    for (int m = gw; m < T; m += NGW) { const int b = m >> 13, s = m & 8191;
        const f32x4* xr = (const f32x4*)(F.out + (size_t)m * D) + lane; f32x4 v[4]; float ss = 0.f;
#pragma unroll
        for (int j = 0; j < 4; ++j) { v[j] = xr[64 * j]; ss += (v[j].x * v[j].x + v[j].y * v[j].y) + (v[j].z * v[j].z + v[j].w * v[j].w); }
        const float rstd = rsqrtf(wave_sum(ss) * (1.f / D) + EPS);
        unsigned long long* o8 = (unsigned long long*)((bf16_t*)(F.ws + WS_HB) + (size_t)m * D) + lane;
        float lg[16];
#pragma unroll
        for (int e = 0; e < 16; ++e) lg[e] = 0.f;
#pragma unroll
        for (int j = 0; j < 4; ++j) { asm volatile("" ::: "memory");
            const f32x4 a1 = *(const LAS f32x4*)(A1 + b * 1024 + 4 * lane + 256 * j), a0 = *(const LAS f32x4*)(A0 + b * 1024 + 4 * lane + 256 * j);
            const f32x4 o = v[j] * rstd * a1 + a0; o8[64 * j] = (unsigned long long)pk2(o.x, o.y) | ((unsigned long long)pk2(o.z, o.w) << 32);
#pragma unroll
            for (int e = 0; e < 16; ++e) { const f32x4 w = *(const LAS f32x4*)(WR + e * 1024 + 4 * lane + 256 * j); lg[e] += (o.x * w.x + o.y * w.y) + (o.z * w.z + o.w * w.w); } }
        float w8[8], w4[4], w2[2], w1;
        { const bool up = lane & 32;
#pragma unroll
          for (int i = 0; i < 8; ++i) { const float snd = up ? lg[i] : lg[8 + i], kp = up ? lg[8 + i] : lg[i]; w8[i] = kp + __shfl_xor(snd, 32); } }
        { const bool up = lane & 16;
#pragma unroll
          for (int i = 0; i < 4; ++i) { const float snd = up ? w8[i] : w8[4 + i], kp = up ? w8[4 + i] : w8[i]; w4[i] = kp + __shfl_xor(snd, 16); } }
        { const bool up = lane & 8;
#pragma unroll
          for (int i = 0; i < 2; ++i) { const float snd = up ? w4[i] : w4[2 + i], kp = up ? w4[2 + i] : w4[i]; w2[i] = kp + __shfl_xor(snd, 8); } }
        { const bool up = lane & 4; const float snd = up ? w2[0] : w2[1], kp = up ? w2[1] : w2[0]; w1 = kp + __shfl_xor(snd, 4); }
        w1 += __shfl_xor(w1, 1); w1 += __shfl_xor(w1, 2);
        const int e = lane >> 2; const float logit = w1 + F.b_router[e];
        float mx = logit;
#pragma unroll
        for (int o = 4; o < 64; o <<= 1) mx = fmaxf(mx, __shfl_xor(mx, o));
        const float ex = __expf(logit - mx); float den = ex;
#pragma unroll
        for (int o = 4; o < 64; o <<= 1) den += __shfl_xor(den, o);
        if ((lane & 3) == 0) ((float*)(F.ws + WS_AFF))[((size_t)b * 16 + e) * S + s] = ex / den;
    }
    __syncthreads();
}
__device__ __forceinline__ void p5_topk(Frame& F) {
    if (F.vcu >= 32) { if (WD_IN_P5 && F.G > 32) wd_convert(F, 32); return; }
    const int be = F.vcu, b = be >> 4, e = be & 15, tid = F.wave * 64 + fresh_lane();
    LAS unsigned* vals = (LAS unsigned*)F.lds;
    LAS unsigned* hist = vals + 8192;
    LAS unsigned* suf = hist + 256;
    LAS unsigned* misc = suf + 264;
    LAS unsigned* wtot = misc + 8;
    const float* a = (const float*)(F.ws + WS_AFF) + (size_t)be * S;
    for (int i = tid; i < 8192; i += NTHREADS) vals[i] = __float_as_uint(a[i]);
    if (tid == 0) { misc[0] = 0u; misc[1] = 1024u; }
    __syncthreads();
    for (int pass = 0; pass < 4; ++pass) {
        const int sh = 24 - 8 * pass; const unsigned prefix = misc[0], k = misc[1]; const unsigned himask = pass == 0 ? 0u : (0xffffffffu << (sh + 8));
        if (tid < 256) hist[tid] = 0u;
        __syncthreads();
        {
            const unsigned cand = (vals[0] >> sh) & 255u; unsigned nc = 0u;
            for (int i = tid; i < 8192; i += NTHREADS) { const unsigned v = vals[i]; if ((v & himask) == prefix) { const unsigned bn = (v >> sh) & 255u; if (bn == cand) ++nc; else __hip_atomic_fetch_add(&hist[bn], 1u, __ATOMIC_RELAXED, __HIP_MEMORY_SCOPE_WORKGROUP); } }
#pragma unroll
            for (int o = 1; o < 64; o <<= 1) nc += __shfl_xor(nc, o);
            if ((tid & 63) == 0 && nc) __hip_atomic_fetch_add(&hist[cand], nc, __ATOMIC_RELAXED, __HIP_MEMORY_SCOPE_WORKGROUP);
        }
        __syncthreads();
        if (tid < 64) {
            const int l = tid; const unsigned h0 = hist[4 * l], h1 = hist[4 * l + 1], h2 = hist[4 * l + 2], h3 = hist[4 * l + 3];
            const unsigned tot = (h0 + h1) + (h2 + h3); unsigned inc = tot;
#pragma unroll
            for (int o = 1; o < 64; o <<= 1) { const unsigned t = __shfl_down(inc, o); if (l + o < 64) inc += t; }
            const unsigned above = inc - tot;
            const unsigned s3 = above + h3, s2 = s3 + h2, s1 = s2 + h1, s0 = s1 + h0;
            int bin = -1; unsigned gt = 0u;
            if (s3 >= k && above < k) { bin = 4 * l + 3; gt = above; } else if (s2 >= k && s3 < k) { bin = 4 * l + 2; gt = s3; } else if (s1 >= k && s2 < k) { bin = 4 * l + 1; gt = s2; } else if (s0 >= k && s1 < k) { bin = 4 * l; gt = s1; }
            if (bin >= 0) { misc[0] = prefix | ((unsigned)bin << sh); misc[1] = k - gt; }
        }
        __syncthreads();
    }
    const unsigned thr = misc[0], need = misc[1];
    unsigned gtc = 0, eqc = 0;
#pragma unroll
    for (int i = 0; i < 16; ++i) { const unsigned v = vals[tid * 16 + i]; gtc += v > thr; eqc += v == thr; }
    unsigned gi = gtc, ei = eqc; const int lane = fresh_lane(), wv = F.wave;
#pragma unroll
    for (int o = 1; o < 64; o <<= 1) { const unsigned g2 = __shfl_up(gi, o), e2 = __shfl_up(ei, o); if (lane >= o) { gi += g2; ei += e2; } }
    if (lane == 63) { wtot[wv] = gi; wtot[8 + wv] = ei; }
    __syncthreads();
    unsigned gbase = 0, ebase = 0, gtotal = 0;
    for (int w = 0; w < 8; ++w) { const unsigned g = wtot[w], q = wtot[8 + w]; if (w < wv) { gbase += g; ebase += q; } gtotal += g; }
    unsigned gpos = gbase + gi - gtc, epos = ebase + ei - eqc;
    int* IDX = (int*)(F.ws + WS_IDX) + (e * 2 + b) * 1024; float* GATE = (float*)(F.ws + WS_GATE) + (e * 2 + b) * 1024; int* SLOT = (int*)(F.ws + WS_SLOT);
#pragma unroll
    for (int i = 0; i < 16; ++i) { const int s = tid * 16 + i; const unsigned v = vals[s]; int c = -1;
        if (v > thr) c = (int)gpos++; else if (v == thr) { if (epos < need) c = (int)(gtotal + epos); ++epos; }
        if (c >= 0) { IDX[c] = b * S + s; GATE[c] = __uint_as_float(v); }
        SLOT[(size_t)(b * S + s) * 16 + e] = c >= 0 ? (e * 2 + b) * 1024 + c : -1; }
}
struct SchedP6a {
    __device__ __forceinline__ void a_ready(const gm::Unit&, int, int) const {}
    __device__ __forceinline__ void done(const gm::Unit&, int) const {}
    __device__ __forceinline__ void stamp(int, const gm::Unit&, int, int) const {}
    static constexpr bool GATHER = true;
    const char* A; const char* W; const int* idx; int G, vcu;
    __device__ __forceinline__ bool next(int i, gm::Unit& u) const {
        int e, pmu, pn;
        if (G == 256) { if (i >= 4) return false; const int xcd = vcu >> 5, j = vcu & 31; e = xcd + 8 * (i >> 1); const int sub = (i & 1) * 32 + j; pmu = sub >> 3; pn = sub & 7; }
        else { const int L = i * G + vcu; if (L >= 1024) return false; e = L >> 6; pmu = (L >> 3) & 7; pn = L & 7; }
        u.A = A; u.gidx = idx + e * 2048 + pmu * 256; u.lda2 = 2048; u.arow0 = 0; u.Bt = W + (size_t)e * 2048 * 2048; u.brow0 = pn * 256; u.ldb2 = 2048; u.nt = 16; u.pm = e * 8 + pmu; u.pn = pn; u.aux = e; return true; }
};
struct EpiP6a {
    static constexpr bool PERM = true;
    bf16_t* H;
    __device__ __forceinline__ void operator()(EPI_ARGS) const {
#pragma unroll
        for (int ai = 0; ai < 2; ++ai)
#pragma unroll
            for (int m = 0; m < 4; ++m) { const size_t row = (size_t)u.pm * 256 + ai * 128 + wr * 64 + m * 16 + fr;
                f32x4 h0, h1;
#pragma unroll
                for (int j = 0; j < 4; ++j) { h0[j] = siluf(acc[ai][0][m][0][j]) * acc[ai][1][m][0][j]; h1[j] = siluf(acc[ai][0][m][1][j]) * acc[ai][1][m][1][j]; }
                *(u32x4*)(H + row * 1024 + u.pn * 128 + wc * 32 + 8 * fq) = pack8(h0, h1); }
    }
};
struct SchedP6b {
    __device__ __forceinline__ void a_ready(const gm::Unit&, int, int) const {}
    __device__ __forceinline__ void done(const gm::Unit&, int) const {}
    __device__ __forceinline__ void stamp(int, const gm::Unit&, int, int) const {}
    static constexpr bool GATHER = false;
    const char* A; const char* W; int G, vcu;
    __device__ __forceinline__ bool next(int i, gm::Unit& u) const {
        int e, pmu, pn;
        if (G == 256) { if (i >= 2) return false; const int xcd = vcu >> 5, j = vcu & 31; e = xcd + 8 * i; pmu = j >> 2; pn = j & 3; }
        else { const int L = i * G + vcu; if (L >= 512) return false; e = L >> 5; pmu = (L >> 2) & 7; pn = L & 3; }
        u.A = A; u.gidx = nullptr; u.lda2 = 2048; u.arow0 = (e * 8 + pmu) * 256; u.Bt = W + (size_t)e * 1024 * 2048; u.brow0 = pn * 256; u.ldb2 = 2048; u.nt = 16; u.pm = e * 8 + pmu; u.pn = pn; u.aux = e; return true; }
};
struct EpiP6b {
    static constexpr bool PERM = true;
    bf16_t* Y; const float* gate;
    __device__ __forceinline__ void operator()(EPI_ARGS) const {
#pragma unroll
        for (int ai = 0; ai < 2; ++ai)
#pragma unroll
            for (int m = 0; m < 4; ++m) { const size_t row = (size_t)u.pm * 256 + ai * 128 + wr * 64 + m * 16 + fr; const float g = gate[row];
#pragma unroll
                for (int bj = 0; bj < 2; ++bj) *(u32x4*)(Y + row * 1024 + u.pn * 256 + bj * 128 + wc * 32 + 8 * fq) = pack8(acc[ai][bj][m][0] * g, acc[ai][bj][m][1] * g); }
    }
};
__device__ __forceinline__ void p7_final(Frame& F) {
    const float* modf = (const float*)(F.ws + WS_MODF); const int* SLOT = (const int*)(F.ws + WS_SLOT); const bf16_t* Y = (const bf16_t*)(F.ws + WS_Y);
    const int gw = F.vcu * NWAVES + F.wave, NGW = F.G * NWAVES, lane = fresh_lane();
    for (int m0 = gw; m0 < T; m0 += 2 * NGW) {
        const int m1 = m0 + NGW; const bool has1 = m1 < T; const int mm1 = has1 ? m1 : m0;
        f32x4* xr0 = (f32x4*)(F.out + (size_t)m0 * D) + lane; f32x4* xr1 = (f32x4*)(F.out + (size_t)mm1 * D) + lane; f32x4 v0[4], v1[4], a0[4], a1[4];
#pragma unroll
        for (int j = 0; j < 4; ++j) { v0[j] = xr0[64 * j]; v1[j] = xr1[64 * j]; a0[j] = (f32x4){0.f, 0.f, 0.f, 0.f}; a1[j] = (f32x4){0.f, 0.f, 0.f, 0.f}; }
        const int sl0 = lane < 16 ? SLOT[(size_t)m0 * 16 + lane] : -1, sl1 = lane < 16 ? SLOT[(size_t)mm1 * 16 + lane] : -1;
        for (int e = 0; e < 16; ++e) { const int s0 = __shfl(sl0, e), s1 = __shfl(sl1, e);
            if (s0 >= 0) { const u32x2* yr = (const u32x2*)(Y + (size_t)s0 * 1024) + lane;
#pragma unroll
                for (int j = 0; j < 4; ++j) { const u32x2 w = yr[64 * j]; a0[j].x += __uint_as_float(w.x << 16); a0[j].y += __uint_as_float(w.x & 0xffff0000u); a0[j].z += __uint_as_float(w.y << 16); a0[j].w += __uint_as_float(w.y & 0xffff0000u); } }
            if (s1 >= 0) { const u32x2* yr = (const u32x2*)(Y + (size_t)s1 * 1024) + lane;
#pragma unroll
                for (int j = 0; j < 4; ++j) { const u32x2 w = yr[64 * j]; a1[j].x += __uint_as_float(w.x << 16); a1[j].y += __uint_as_float(w.x & 0xffff0000u); a1[j].z += __uint_as_float(w.y << 16); a1[j].w += __uint_as_float(w.y & 0xffff0000u); } } }
        float ss0 = 0.f, ss1 = 0.f; const int b0 = m0 >> 13, b1 = mm1 >> 13;
#pragma unroll
        for (int j = 0; j < 4; ++j) { const f32x4 g0 = *(const f32x4*)(modf + b0 * 6144 + 5120 + 4 * lane + 256 * j), g1 = *(const f32x4*)(modf + b1 * 6144 + 5120 + 4 * lane + 256 * j);
            v0[j] = v0[j] + g0 * a0[j]; v1[j] = v1[j] + g1 * a1[j];
            ss0 += (v0[j].x * v0[j].x + v0[j].y * v0[j].y) + (v0[j].z * v0[j].z + v0[j].w * v0[j].w); ss1 += (v1[j].x * v1[j].x + v1[j].y * v1[j].y) + (v1[j].z * v1[j].z + v1[j].w * v1[j].w); }
        const float r0 = rsqrtf(wave_sum(ss0) * (1.f / D) + EPS), r1 = rsqrtf(wave_sum(ss1) * (1.f / D) + EPS);
#pragma unroll
        for (int j = 0; j < 4; ++j) { const f32x4 g = *(const f32x4*)(F.g_final + 4 * lane + 256 * j); xr0[64 * j] = v0[j] * r0 * g; if (has1) xr1[64 * j] = v1[j] * r1 * g; }
    }
}
}
#ifndef MLA_STAG
#define MLA_STAG mla_unit_v9
#endif
#ifndef MLA_V4
#define MLA_V4 1
#endif
#ifndef MERGE_P12
#define MERGE_P12 1
#endif
#ifndef DIL_PIPE
#define DIL_PIPE 1
#endif
#ifndef MLA_UNIT
#define MLA_UNIT mla_unit_v2
#endif
namespace mk {
namespace cg = cooperative_groups;
__global__ void __launch_bounds__(NTHREADS, 2) mega(Args args) {
    extern __shared__ __attribute__((aligned(16))) unsigned char lds_raw[];
    cg::grid_group grid = cg::this_grid();
    Frame F;
    F.lds = (LAS unsigned char*)lds_raw; F.ws = args.ws; F.out = args.out;
    F.wave = __builtin_amdgcn_readfirstlane((int)(threadIdx.x >> 6));
    F.G = gridDim.x; { const int bx = blockIdx.x; F.vcu = (F.G % 8 == 0) ? (bx % 8) * (F.G / 8) + bx / 8 : bx; }
    F.x = (const float*)args.in[0]; F.c = (const float*)args.in[1]; F.pos = (const int*)args.in[2]; F.w_ada = (const float*)args.in[3]; F.b_ada = (const float*)args.in[4];
    F.g_mix = (const float*)args.in[5]; F.w_in = (const float*)args.in[6]; F.g_q = (const float*)args.in[7]; F.w_uq = (const float*)args.in[8]; F.g_kv = (const float*)args.in[9];
    F.w_ukv = (const float*)args.in[10]; F.w_out = (const float*)args.in[11]; F.g_ffn = (const float*)args.in[12]; F.w_router = (const float*)args.in[13]; F.b_router = (const float*)args.in[14];
    F.w_gate = (const float*)args.in[15]; F.w_up = (const float*)args.in[16]; F.w_down = (const float*)args.in[17]; F.g_final = (const float*)args.in[18];
    const int lo = args.ph_lo, hi = args.ph_hi;
    volatile LAS unsigned* MISC = (volatile LAS unsigned*)(F.lds + LDS_BYTES - 256);
    { const int l0 = fresh_lane(); if (F.wave == 0) MISC[l0] = 0u; }
    __syncthreads();
    XcdBarrier xbar = xcd_barrier_post((unsigned*)(F.ws + WS_CTL) + 1024 + args.li * 4096, MISC + 8, F.wave == 0 && fresh_lane() == 0);
#define IN(k) (lo <= (k) && (k) < hi)
#ifndef CG_SEAMS
#define CG_SEAMS 0x000
#endif
#define SEAM(k) do { if (IN(k) && IN((k) + 1)) { if ((CG_SEAMS >> (k)) & 1) grid.sync(); else xcd_barrier(xbar, F.wave == 0 && fresh_lane() == 0); } } while (0)
    if (IN(0)) { p0_prologue(F); } SEAM(0);
    if (IN(1)) { p0b_rows(F); } SEAM(1);
#if MERGE_P12
    if (IN(2)) {
#if P12_STAMP
        if (F.wave == 0 && fresh_lane() == 0) { unsigned long long* ts = (unsigned long long*)(F.ws + 128 * KiB) + (size_t)blockIdx.x * 8; ts[0] = __builtin_amdgcn_s_memrealtime(); ts[7] = 0; }
#endif
        SchedP12 S{(const char*)(F.ws + WS_HB), (const char*)(F.ws + WS_WIN), (const char*)(F.ws + WS_CQ), (const char*)(F.ws + WS_WUQ), (const char*)(F.ws + WS_WUKV), (unsigned*)(F.ws + WS_PCNT), F.G, F.vcu, (int)blockIdx.x};
        EpiP12 E{F.ws}; gm::gemm_phase<EpiP12, SchedP12>(F.lds, S, E, F.wave); } SEAM(3);
#else
    if (IN(2)) { SchedP1 S{(const char*)(F.ws + WS_HB), (const char*)(F.ws + WS_WIN), F.G, (int)blockIdx.x}; EpiP1 E{F.ws}; gm::gemm_phase<EpiP1, SchedP1>(F.lds, S, E, F.wave); } SEAM(2);
    if (IN(3)) { SchedP2 S{(const char*)(F.ws + WS_CQ), (const char*)(F.ws + WS_WUQ), (const char*)(F.ws + WS_WUKV), F.G, (int)blockIdx.x}; EpiP2 E{F.ws}; gm::gemm_phase<EpiP2, SchedP2>(F.lds, S, E, F.wave); } SEAM(3);
#endif
    if (IN(4)) {
        const unsigned short* DQ = (const unsigned short*)(F.ws + WS_DQ); const unsigned short* DK = (const unsigned short*)(F.ws + WS_DK); const unsigned short* DV = (const unsigned short*)(F.ws + WS_DV);
        unsigned short* OBR = (unsigned short*)F.out; float* LSE = (float*)(F.ws + WS_LSE);
        if (args.pad & 1) { if (DIL_PIPE) at::dil_phase(F.wave, F.vcu, F.G, 1536, DQ, DK, DV, OBR, LSE, (char*)lds_raw); else for (int u = F.vcu; u < 1536; u += F.G) { const int blk = u & 31, br = (u >> 5) % 3, bh = u / 96; at::dil_unit(F.wave, bh, br, blk, DQ, DK, DV, OBR, LSE, (char*)lds_raw); } }
        if (args.pad & 2) for (int u = F.vcu; u < 512; u += F.G) { const int bh = (u >> 8) * 8 + ((u & 255) >> 5), qb = u & 31;
            #if MLA_V4
            at::MLA_STAG(F.wave, bh, qb, (const unsigned short*)(F.ws + WS_Q), (const unsigned short*)(F.ws + WS_KN), (const unsigned short*)(F.ws + WS_KR), (const unsigned short*)(F.ws + WS_V), (unsigned short*)(F.ws + WS_HB), (const float*)(F.ws + WS_KMX), (char*)lds_raw, (u == F.vcu) ? (unsigned long long*)(F.ws + WS_CTL + 60 * 1024) : nullptr); }
#else
            at::mla_unit_v2(F.wave, bh, qb, (const unsigned short*)(F.ws + WS_Q), (const unsigned short*)(F.ws + WS_KN), (const unsigned short*)(F.ws + WS_KR), (const unsigned short*)(F.ws + WS_V), (unsigned short*)(F.ws + WS_HB), (const float*)(F.ws + WS_KMX), (char*)lds_raw, (u == F.vcu) ? (unsigned long long*)(F.ws + WS_CTL + 60 * 1024) : nullptr); }
#endif
    } SEAM(4);
    if (IN(5)) { at::dil_combine((const unsigned short*)F.out, (const float*)(F.ws + WS_LSE), (unsigned short*)(F.ws + WS_HB), F.vcu * NTHREADS + F.wave * 64 + fresh_lane(), F.G * NTHREADS); } SEAM(5);
    if (IN(6)) { SchedP4 S{(const char*)(F.ws + WS_HB), (const char*)(F.ws + WS_WOUT), F.G, (int)blockIdx.x}; EpiP4 E{F.x, F.out, (const float*)(F.ws + WS_MODF)}; gm::gemm_phase<EpiP4, SchedP4>(F.lds, S, E, F.wave); } SEAM(6);
    if (IN(7)) { p4b_rows(F); } SEAM(7);
    if (IN(8)) { p5_topk(F); } SEAM(8);
    if (IN(9)) { SchedP6a S{(const char*)(F.ws + WS_HB), (const char*)(F.ws + WS_WGU), (const int*)(F.ws + WS_IDX), F.G, F.vcu}; EpiP6a E{(bf16_t*)(F.ws + WS_HBUF)}; gm::gemm_phase<EpiP6a, SchedP6a>(F.lds, S, E, F.wave); } SEAM(9);
    if (IN(10)) { SchedP6b S{(const char*)(F.ws + WS_HBUF), (const char*)(F.ws + WS_WD), F.G, F.vcu}; EpiP6b E{(bf16_t*)(F.ws + WS_Y), (const float*)(F.ws + WS_GATE)}; gm::gemm_phase<EpiP6b, SchedP6b>(F.lds, S, E, F.wave); } SEAM(10);
    if (IN(11)) { p7_final(F); }
#undef IN
#undef SEAM
}
}
extern "C" void kernel_launch(void* const* d_in, const int* in_sizes, int n_in, void* d_out, int out_size, void* d_ws, size_t ws_size, hipStream_t stream) {
    using namespace mk;
    static int grid = 0;
    if (grid == 0) {
        if (n_in != 19 || out_size != T * D || in_sizes[0] != T * D || ws_size < WS_END) { fprintf(stderr, "kernel_launch: built for 19 inputs, x/out of %d floats and >= %zu bytes of workspace; got n_in %d out %d ws %zu; nothing launched\n", T * D, (size_t)WS_END, n_in, out_size, ws_size); grid = -1; return; }
        int dev = 0, cus = 0, per_cu = 0;
        if (hipGetDevice(&dev) != hipSuccess || hipDeviceGetAttribute(&cus, hipDeviceAttributeMultiprocessorCount, dev) != hipSuccess || cus < 32) { fprintf(stderr, "kernel_launch: device query failed\n"); grid = -1; return; }
        if (hipFuncSetAttribute((const void*)mega, hipFuncAttributeMaxDynamicSharedMemorySize, LDS_BYTES) != hipSuccess) { fprintf(stderr, "kernel_launch: hipFuncSetAttribute(%d B LDS) failed\n", LDS_BYTES); grid = -1; return; }
        if (hipOccupancyMaxActiveBlocksPerMultiprocessor(&per_cu, (const void*)mega, NTHREADS, LDS_BYTES) != hipSuccess || per_cu < 1) { fprintf(stderr, "kernel_launch: occupancy query reports %d workgroups per CU\n", per_cu); grid = -1; return; }
        grid = cus;
    }
    if (grid < 0) return;
    if (hipMemsetAsync((char*)d_ws + WS_CTL, 0, 64 * KiB, stream) != hipSuccess) { fprintf(stderr, "kernel_launch: memset failed\n"); return; }
    Args a{}; for (int i = 0; i < 19; ++i) a.in[i] = d_in[i]; a.out = (float*)d_out; a.ws = (unsigned char*)d_ws;
    a.pad = 3; a.ph_lo = 0; a.ph_hi = 12; a.li = 0;
    void* kargs[] = {&a};
    const hipError_t e = hipLaunchCooperativeKernel((const void*)mega, dim3(grid), dim3(NTHREADS), kargs, LDS_BYTES, stream);
    if (e != hipSuccess) fprintf(stderr, "kernel_launch: cooperative launch failed: %s (grid %d)\n", hipGetErrorString(e), grid);
}
```

```cpp
#include <hip/hip_runtime.h>
#include <hip/hip_cooperative_groups.h>
#include <hip/hip_bf16.h>
#include <cstdio>
#include <cstdint>
#include <cmath>
namespace gm {
#define LAS __attribute__((address_space(3)))
typedef unsigned short bf16_t;
typedef short bf16x8 __attribute__((ext_vector_type(8)));
typedef float f32x4 __attribute__((ext_vector_type(4)));
typedef float f32x2 __attribute__((ext_vector_type(2)));
typedef unsigned u32x4 __attribute__((ext_vector_type(4)));
typedef unsigned u32x2 __attribute__((ext_vector_type(2)));
constexpr int BM = 256, BK = 64, HALF = 128, HTB = HALF * BK * 2, STAGE_BYTES = 8 * HTB;

__device__ __forceinline__ int lds_byte(int r, int c) { const int st = (r >> 4) * 2 + (c >> 5), rr = r & 15, cc = c & 31, ob = rr * 64 + cc * 2; return st * 1024 + (ob ^ (((ob >> 9) & 1) << 5)); }
__device__ __forceinline__ void stage_rc(int b, int& R, int& C) { const int st = b / 1024, sb = b % 1024, swz = sb ^ (((sb >> 9) & 1) << 5); R = (st >> 1) * 16 + swz / 64; C = (st & 1) * 32 + (swz % 64) / 2; }
__device__ __forceinline__ int perm32(int rho) { const int n = rho >> 4, i = rho & 15; return 8 * (i >> 2) + 4 * n + (i & 3); }
__device__ __forceinline__ int lane_now() { int l; asm volatile("v_mbcnt_lo_u32_b32 %0, -1, 0\n\tv_mbcnt_hi_u32_b32 %0, -1, %0" : "=v"(l)); return l; }
__device__ __forceinline__ unsigned cvt_pk_bf16(float lo, float hi) { unsigned r; asm volatile("v_cvt_pk_bf16_f32 %0, %1, %2" : "=v"(r) : "v"(lo), "v"(hi)); return r; }

struct Unit {
    const char* A; const char* Bt; const int* gidx;
    unsigned lda2, ldb2;
    int arow0, brow0, nt;
    int pm, pn, aux;
};

template <class Epi, class Sched>
__device__ __forceinline__ void gemm_phase(LAS unsigned char* lds, const Sched& S, const Epi& E, int wave_sgpr) {
    constexpr bool GATHER = Sched::GATHER;
    const int wid = wave_sgpr, lane = lane_now(), tid = wid * 64 + lane, wr = wid >> 2, wc = wid & 3, fr = lane & 15, fq = lane >> 4;
    int sR[2], sC[2], sRb[2];
#pragma unroll
    for (int i = 0; i < 2; ++i) { int R, C; stage_rc(tid * 16 + i * 8192, R, C); sR[i] = R; sC[i] = C * 2; sRb[i] = Epi::PERM ? ((R & ~31) + perm32(R & 31)) : R; }
    const unsigned ldsw = (unsigned)wid * 1024u;
    const int aoff = lds_byte(wr * 64 + fr, fq * 8), boff = lds_byte(wc * 32 + fr, fq * 8);
#define GM_SA(b, h) (((b) * 2 + (h)) * HTB)
#define GM_SB(b, h) ((4 + (b) * 2 + (h)) * HTB)
#define GM_GLDS(src, dstoff) __builtin_amdgcn_global_load_lds((const unsigned*)(src), (LAS unsigned*)(lds + (dstoff)), 16, 0, 0)
#define GM_STAGE_B(bufoff, p, ld, h) do { _Pragma("unroll") for (int i_ = 0; i_ < 2; ++i_) \
        GM_GLDS((p) + ((unsigned)((h) * HALF + sRb[i_]) * (ld) + (unsigned)sC[i_]), (bufoff) + ldsw + i_ * 8192); } while (0)
#define GM_STAGE_A(bufoff, p, ld, h, g) do { _Pragma("unroll") for (int i_ = 0; i_ < 2; ++i_) { \
        const unsigned o_ = GATHER ? (g)[h][i_] + (unsigned)sC[i_] : (unsigned)((h) * HALF + sR[i_]) * (ld) + (unsigned)sC[i_]; \
        GM_GLDS((p) + o_, (bufoff) + ldsw + i_ * 8192); } } while (0)
#define GM_LDA(dst, b, h) do { _Pragma("unroll") for (int m = 0; m < 4; ++m) _Pragma("unroll") for (int k = 0; k < 2; ++k) dst[m][k] = *(const LAS bf16x8*)(lds + GM_SA(b, h) + aoff + m * 2048 + k * 1024); } while (0)
#define GM_LDB(dst, b, h) do { _Pragma("unroll") for (int n = 0; n < 2; ++n) _Pragma("unroll") for (int k = 0; k < 2; ++k) dst[n][k] = *(const LAS bf16x8*)(lds + GM_SB(b, h) + boff + n * 2048 + k * 1024); } while (0)
#define GM_MMA(ai, bj, At, Bt) do { __builtin_amdgcn_s_setprio(1); _Pragma("unroll") for (int m = 0; m < 4; ++m) _Pragma("unroll") for (int n = 0; n < 2; ++n) _Pragma("unroll") for (int k = 0; k < 2; ++k) \
        acc[ai][bj][m][n] = __builtin_amdgcn_mfma_f32_16x16x32_bf16(Bt[n][k], At[m][k], acc[ai][bj][m][n], 0, 0, 0); __builtin_amdgcn_s_setprio(0); } while (0)
#define GM_WAIT_V(n) asm volatile("s_waitcnt vmcnt(" #n ")" ::: "memory")
#define GM_WAIT_L(n) asm volatile("s_waitcnt lgkmcnt(" #n ")" ::: "memory")
#define GM_BAR __builtin_amdgcn_s_barrier()
#define GM_SCHED __builtin_amdgcn_sched_barrier(0)
#define GM_GOFFS(u, g) do { if (GATHER) { _Pragma("unroll") for (int h_ = 0; h_ < 2; ++h_) _Pragma("unroll") for (int i_ = 0; i_ < 2; ++i_) g[h_][i_] = (unsigned)(u).gidx[h_ * HALF + sR[i_]] * (u).lda2; } } while (0)
#define GM_ABASE(u) ((u).A + (GATHER ? (size_t)0 : (size_t)(u).arow0 * (u).lda2))
#define GM_BBASE(u) ((u).Bt + (size_t)(u).brow0 * (u).ldb2)
    Unit cur, nxt; int ui = 0;
    if (!S.next(0, cur)) return;
    f32x4 acc[2][2][4][2];
#pragma unroll
    for (int a = 0; a < 2; ++a)
#pragma unroll
        for (int b = 0; b < 2; ++b)
#pragma unroll
            for (int m = 0; m < 4; ++m)
#pragma unroll
                for (int n = 0; n < 2; ++n) acc[a][b][m][n] = (f32x4){0.f, 0.f, 0.f, 0.f};
    bf16x8 At[4][2], B0[2][2], B1[2][2];
    unsigned gc[2][2] = {{0u, 0u}, {0u, 0u}}, gn[2][2] = {{0u, 0u}, {0u, 0u}};
    GM_GOFFS(cur, gc);
    const char* cA = GM_ABASE(cur); const char* cB = GM_BBASE(cur); unsigned cla = cur.lda2, clb = cur.ldb2;
    GM_STAGE_B(GM_SB(0, 0), cB, clb, 0); GM_STAGE_B(GM_SB(0, 1), cB, clb, 1); GM_STAGE_A(GM_SA(0, 0), cA, cla, 0, gc); GM_STAGE_A(GM_SA(0, 1), cA, cla, 1, gc);
    if (wr == 1) GM_BAR;
    GM_WAIT_V(2); GM_BAR;
    GM_STAGE_B(GM_SB(1, 0), cB + 128, clb, 0); GM_STAGE_A(GM_SA(1, 0), cA + 128, cla, 0, gc); GM_STAGE_B(GM_SB(1, 1), cB + 128, clb, 1);
    GM_WAIT_V(6); GM_BAR;
    for (;;) {
        const bool has_next = S.next(ui + 1, nxt);
        const char* nA = cA; const char* nB = cB; unsigned nla = cla, nlb = clb;
        if (has_next) { GM_GOFFS(nxt, gn); nA = GM_ABASE(nxt); nB = GM_BBASE(nxt); nla = nxt.lda2; nlb = nxt.ldb2; }
        else if (GATHER) {
#pragma unroll
            for (int h = 0; h < 2; ++h)
#pragma unroll
                for (int i = 0; i < 2; ++i) gn[h][i] = gc[h][i];
        }
        const int nt = cur.nt;
        for (int t = 0; t < nt; t += 2) {
            const bool last = (t == nt - 2);
            if (last && has_next) S.a_ready(nxt, wid, ui + 1);
            const char* a1 = cA + (size_t)(t + 1) * 128;
            const char* a2 = last ? nA : cA + (size_t)(t + 2) * 128; const char* b2 = last ? nB : cB + (size_t)(t + 2) * 128;
            const char* a3 = a2 + 128; const char* b3 = b2 + 128;
            const unsigned la2 = last ? nla : cla, lb2 = last ? nlb : clb;
            unsigned g2[2][2];
#pragma unroll
            for (int h = 0; h < 2; ++h)
#pragma unroll
                for (int i = 0; i < 2; ++i) g2[h][i] = GATHER ? (last ? gn[h][i] : gc[h][i]) : 0u;
            GM_LDB(B0, 0, 0); GM_LDB(B1, 0, 1); GM_SCHED; GM_LDA(At, 0, 0); GM_STAGE_A(GM_SA(1, 1), a1, cla, 1, gc);
            GM_WAIT_V(8); GM_WAIT_L(0); GM_BAR; GM_MMA(0, 0, At, B0); GM_MMA(0, 1, At, B1); GM_BAR; GM_SCHED;
            GM_LDA(At, 0, 1); GM_STAGE_B(GM_SB(0, 0), b2, lb2, 0); GM_STAGE_B(GM_SB(0, 1), b2, lb2, 1); GM_STAGE_A(GM_SA(0, 0), a2, la2, 0, g2);
            GM_WAIT_V(8); GM_WAIT_L(0); GM_BAR; GM_MMA(1, 0, At, B0); GM_MMA(1, 1, At, B1); GM_BAR; GM_SCHED;
            GM_LDB(B0, 1, 0); GM_LDB(B1, 1, 1); GM_SCHED; GM_LDA(At, 1, 0); GM_STAGE_A(GM_SA(0, 1), a2, la2, 1, g2);
            GM_WAIT_V(8); GM_WAIT_L(0); GM_BAR; GM_MMA(0, 0, At, B0); GM_MMA(0, 1, At, B1); GM_BAR; GM_SCHED;
            GM_LDA(At, 1, 1); GM_STAGE_B(GM_SB(1, 0), b3, lb2, 0); GM_STAGE_B(GM_SB(1, 1), b3, lb2, 1); GM_STAGE_A(GM_SA(1, 0), a3, la2, 0, g2);
            GM_WAIT_V(8); GM_WAIT_L(0); GM_BAR; GM_MMA(1, 0, At, B0); GM_MMA(1, 1, At, B1); GM_BAR; GM_SCHED;
        }
        if (wr == 0) GM_BAR;
        E(acc, cur, wr, wc, fr, fq, lane);
        S.done(cur, lane);
        S.stamp(ui, cur, wid, lane);
        if (!has_next) break;
#pragma unroll
        for (int a = 0; a < 2; ++a)
#pragma unroll
            for (int b = 0; b < 2; ++b)
#pragma unroll
                for (int m = 0; m < 4; ++m)
#pragma unroll
                    for (int n = 0; n < 2; ++n) acc[a][b][m][n] = (f32x4){0.f, 0.f, 0.f, 0.f};
        cur = nxt; cA = nA; cB = nB; cla = nla; clb = nlb; ++ui;
        if (GATHER) {
#pragma unroll
            for (int h = 0; h < 2; ++h)
#pragma unroll
                for (int i = 0; i < 2; ++i) gc[h][i] = gn[h][i];
        }
        if (wr == 1) GM_BAR;
    }
    GM_WAIT_V(0);
    GM_BAR;
#undef GM_SA
#undef GM_SB
#undef GM_GLDS
#undef GM_STAGE_A
#undef GM_STAGE_B
#undef GM_LDA
#undef GM_LDB
#undef GM_MMA
#undef GM_WAIT_V
#undef GM_WAIT_L
#undef GM_BAR
#undef GM_SCHED
#undef GM_GOFFS
#undef GM_ABASE
#undef GM_BBASE
}
}
namespace mk {
using gm::bf16_t; using gm::f32x4; using gm::f32x2; using gm::u32x4; using gm::u32x2; using gm::cvt_pk_bf16;
constexpr int T = 16384, S = 8192, D = 1024, NB = 2, NH = 8, NWAVES = 8, NTHREADS = 512;
constexpr float EPS = 1e-6f;
constexpr size_t KiB = 1024, MiB = 1u << 20;
constexpr size_t WS_CTL = 0;
constexpr size_t WS_KMX = 48 * KiB;
constexpr size_t WS_MODP = 1 * MiB;
constexpr size_t WS_MODF = 2 * MiB;
constexpr size_t WS_TABM = WS_MODF + 64 * KiB;
constexpr size_t WS_TABD = WS_TABM + 2 * MiB;
constexpr size_t WS_SSQ = WS_TABD + 1 * MiB;
constexpr size_t WS_KR = WS_SSQ + 1536 * KiB;
constexpr size_t WS_AFF = WS_KR + 1 * MiB;
constexpr size_t WS_IDX = WS_AFF + 1 * MiB;
constexpr size_t WS_GATE = WS_IDX + 128 * KiB;
constexpr size_t WS_SLOT = WS_GATE + 128 * KiB;
constexpr size_t WS_LSE = WS_SLOT + 1 * MiB;
constexpr size_t WS_WUQ = WS_LSE + 1536 * KiB;
constexpr size_t WS_WUKV = WS_WUQ + 576 * KiB;
constexpr size_t WS_WOUT = WS_WUKV + 512 * KiB;
constexpr size_t WS_WIN = WS_WOUT + 2 * MiB;
constexpr size_t WS_R0END = WS_WIN + 4608 * KiB;
static_assert(WS_R0END <= 20 * MiB, "R0");
constexpr size_t WS_HB = 20 * MiB;
constexpr size_t WS_CQ = 52 * MiB;
constexpr size_t WS_DQ = WS_CQ + 24 * MiB, WS_DK = WS_DQ + 16 * MiB, WS_DV = WS_DK + 16 * MiB;
constexpr size_t WS_Q = WS_DV + 16 * MiB;
constexpr size_t WS_KN = WS_Q + 24 * MiB, WS_V = WS_KN + 16 * MiB;
constexpr size_t WS_HBUF = WS_CQ;
constexpr size_t WS_WGU = 180 * MiB;
constexpr size_t WS_Y = WS_WGU;
constexpr size_t WS_WD = 244 * MiB;
constexpr size_t WS_END = 276 * MiB;
static_assert(WS_V + 16 * MiB == 180 * MiB, "arena");
constexpr int LDS_BYTES = 147456;

__device__ __forceinline__ float wave_sum(float v) {
#pragma unroll
    for (int o = 1; o < 64; o <<= 1) v += __shfl_xor(v, o);
    return v;
}
__device__ __forceinline__ unsigned f2bf(float f) { unsigned u = __builtin_bit_cast(unsigned, f); return (u + 0x7fffu + ((u >> 16) & 1u)) >> 16; }
__device__ __forceinline__ unsigned pk2(float lo, float hi) { return f2bf(lo) | (f2bf(hi) << 16); }
__device__ __forceinline__ float bf2f(unsigned short b) { return __builtin_bit_cast(float, (unsigned)b << 16); }
__device__ __forceinline__ float siluf(float v) { return v / (1.f + __expf(-v)); }
#define LDS_WAIT() asm volatile("s_waitcnt lgkmcnt(0)" ::: "memory")
__device__ __forceinline__ int fresh_lane() { return gm::lane_now(); }

struct Args { const void* in[19]; float* out; unsigned char* ws; int ph_lo, ph_hi, li, pad; };
struct Frame {
    LAS unsigned char* lds; unsigned char* ws; float* out;
    int wave, vcu, G;
    const float *x, *c; const int* pos; const float *w_ada, *b_ada, *g_mix, *w_in, *g_q, *w_uq, *g_kv, *w_ukv, *w_out, *g_ffn, *w_router, *b_router, *w_gate, *w_up, *w_down, *g_final;
};

__device__ __forceinline__ float inv_freq_m(int i) { return (float)exp2(-(double)i * (18.931568569324174 / 16.0)); }
__device__ __forceinline__ float inv_freq_d(int i) { return (float)exp2(-(double)i * (18.931568569324174 / 8.0)); }

#ifndef WD_IN_P5
#define WD_IN_P5 1
#endif
#ifndef EXP_IN_ATTN
#define EXP_IN_ATTN 1
#endif
__device__ __forceinline__ void p0_transpose_item(const float* W, int ldw, int K, int k0, int n0, bf16_t* WT, int drow, const float* kscale, LAS float* scr, int lane) {
    f32x4 v[8];
#pragma unroll
    for (int i = 0; i < 8; ++i) v[i] = *(const f32x4*)(W + (size_t)(k0 + 8 * i + (lane >> 3)) * ldw + n0 + 4 * (lane & 7));
#pragma unroll
    for (int i = 0; i < 8; ++i) { const int kk = 8 * i + (lane >> 3); f32x4 x = v[i]; if (kscale) x = x * kscale[k0 + kk]; LAS float* d = scr + kk * 33 + 4 * (lane & 7); d[0] = x.x; d[1] = x.y; d[2] = x.z; d[3] = x.w; }
    LDS_WAIT(); asm volatile("" ::: "memory");
    const int c = lane & 7;
#pragma unroll
    for (int j = 0; j < 4; ++j) { const int n = (lane >> 3) + 8 * j; const LAS float* s = scr + (8 * c) * 33 + n;
        u32x4 o; o.x = pk2(s[0 * 33], s[1 * 33]); o.y = pk2(s[2 * 33], s[3 * 33]); o.z = pk2(s[4 * 33], s[5 * 33]); o.w = pk2(s[6 * 33], s[7 * 33]);
        *(u32x4*)(WT + (size_t)(drow + n) * K + k0 + 8 * c) = o; }
    LDS_WAIT(); asm volatile("" ::: "memory");
}
__device__ __forceinline__ void p0_prologue(Frame& F) {
    LAS float* scr = (LAS float*)(F.lds + F.wave * 16384);
    const int gw = F.vcu * NWAVES + F.wave, NGW = F.G * NWAVES, lane = fresh_lane();
    unsigned char* ws = F.ws;
    constexpr int I_MOD = 24 * 16, I_IN = 16 * 69, I_UQ = 6 * 24, I_UKV = 4 * 32, I_OUT = 16 * 32, I_EXP = 16 * 16 * 32, I_PAD = 96, I_TAB = T * 24 / 64;
    constexpr int NITEMS = I_MOD + I_IN + I_UQ + I_UKV + I_OUT + (EXP_IN_ATTN ? 0 : 2) * I_EXP + (WD_IN_P5 ? 0 : 1) * I_EXP + I_PAD + I_TAB;
    for (int it = gw; it < NITEMS; it += NGW) {
        int r = it;
        if (r < I_MOD) {
            const int cc = r % 24, kc = r / 24; f32x4 a0 = {0.f, 0.f, 0.f, 0.f}, a1 = {0.f, 0.f, 0.f, 0.f};
            const float* wp = F.w_ada + (size_t)(kc * 64) * 6144 + cc * 256 + 4 * lane;
#pragma unroll 8
            for (int k = 0; k < 64; ++k) { const f32x4 w = *(const f32x4*)(wp + (size_t)k * 6144); const float s0 = siluf(F.c[kc * 64 + k]), s1 = siluf(F.c[1024 + kc * 64 + k]); a0 += w * s0; a1 += w * s1; }
            float* mp = (float*)(ws + WS_MODP) + (size_t)kc * 2 * 6144 + cc * 256 + 4 * lane;
            *(f32x4*)mp = a0; *(f32x4*)(mp + 6144) = a1; continue; }
        r -= I_MOD;
        if (r < I_IN) { const int kb = r / 69, nb = r % 69, n0 = nb * 32; p0_transpose_item(F.w_in, 2208, 1024, kb * 64, n0, (bf16_t*)(ws + WS_WIN), n0 < 672 ? n0 : n0 + 96, nullptr, scr, lane); continue; }
        r -= I_IN;
        if (r < I_UQ) { const int kb = r / 24, nb = r % 24, n0 = nb * 32, h = n0 / 96, d = n0 % 96; p0_transpose_item(F.w_uq, 768, 384, kb * 64, n0, (bf16_t*)(ws + WS_WUQ), d < 64 ? h * 64 + d : 512 + h * 32, F.g_q, scr, lane); continue; }
        r -= I_UQ;
        if (r < I_UKV) { const int kb = r / 32, nb = r % 32, n0 = nb * 32, h = n0 / 128, d = n0 % 128; p0_transpose_item(F.w_ukv, 1024, 256, kb * 64, n0, (bf16_t*)(ws + WS_WUKV), d < 64 ? h * 64 + d : 512 + h * 64 + (d - 64), F.g_kv, scr, lane); continue; }
        r -= I_UKV;
        if (r < I_OUT) { const int kb = r / 32, nb = r % 32; p0_transpose_item(F.w_out, 1024, 1024, kb * 64, nb * 32, (bf16_t*)(ws + WS_WOUT), nb * 32, nullptr, scr, lane); continue; }
        r -= I_OUT;
        if (!EXP_IN_ATTN) { if (r < 2 * I_EXP) { const int up = r >= I_EXP; const int q = up ? r - I_EXP : r; const int e = q / 512, kb = (q % 512) / 32, nb = q % 32, n0 = nb * 32;
            p0_transpose_item((up ? F.w_up : F.w_gate) + (size_t)e * 1048576, 1024, 1024, kb * 64, n0, (bf16_t*)(ws + WS_WGU) + (size_t)e * 2048 * 1024, (n0 / 128) * 256 + up * 128 + (n0 % 128), nullptr, scr, lane); continue; }
        r -= 2 * I_EXP; }
        if (!WD_IN_P5) { if (r < I_EXP) { const int e = r / 512, kb = (r % 512) / 32, nb = r % 32; p0_transpose_item(F.w_down + (size_t)e * 1048576, 1024, 1024, kb * 64, nb * 32, (bf16_t*)(ws + WS_WD) + (size_t)e * 1048576, nb * 32, nullptr, scr, lane); continue; }
        r -= I_EXP; }
        if (r < I_PAD) { u32x4 z = {0u, 0u, 0u, 0u}; u32x4* p = (u32x4*)((bf16_t*)(ws + WS_WIN) + (size_t)(672 + r) * 1024); p[lane] = z; p[64 + lane] = z; continue; }
        r -= I_PAD;
        {
            const int e = r * 64 + lane, tok = e / 24, f = e % 24; const int p = F.pos[tok];
            const float inv = f < 16 ? inv_freq_m(f) : inv_freq_d(f - 16); const float ang = (float)p * inv; const float cs = (float)cos((double)ang), sn = (float)sin((double)ang);
            if (f < 16) { float* tm = (float*)(ws + WS_TABM) + (size_t)tok * 32; tm[f] = cs; tm[16 + f] = sn; } else { float* td = (float*)(ws + WS_TABD) + (size_t)tok * 16; td[f - 16] = cs; td[8 + f - 16] = sn; }
        }
    }
}
__device__ __forceinline__ void exp_convert(Frame& F) {
    LAS float* scr = (LAS float*)(F.lds + F.wave * 16384); const int lane = fresh_lane();
    const int chunk = (16384 + F.G - 1) / F.G;
    for (int k = F.wave; k < chunk; k += NWAVES) { const int r = F.vcu * chunk + k; if (r >= 16384) break; const int up = r >= 8192; const int q = up ? r - 8192 : r; const int e = q / 512, kb = (q % 512) / 32, nb = q % 32, n0 = nb * 32;
        p0_transpose_item((up ? F.w_up : F.w_gate) + (size_t)e * 1048576, 1024, 1024, kb * 64, n0, (bf16_t*)(F.ws + WS_WGU) + (size_t)e * 2048 * 1024, (n0 / 128) * 256 + up * 128 + (n0 % 128), nullptr, scr, lane); }
    __syncthreads();
}
__device__ __forceinline__ void wd_convert(Frame& F, int first_vcu) {
    LAS float* scr = (LAS float*)(F.lds + F.wave * 16384);
    const int gw = (F.vcu - first_vcu) * NWAVES + F.wave, NGW = (F.G - first_vcu) * NWAVES, lane = fresh_lane();
    for (int r = gw; r < 16 * 16 * 32; r += NGW) { const int e = r / 512, kb = (r % 512) / 32, nb = r % 32;
        p0_transpose_item(F.w_down + (size_t)e * 1048576, 1024, 1024, kb * 64, nb * 32, (bf16_t*)(F.ws + WS_WD) + (size_t)e * 1048576, nb * 32, nullptr, scr, lane); }
}
__device__ __forceinline__ void p0b_rows(Frame& F) {
    const int tid_ = F.wave * 64 + fresh_lane();
    LAS float* A1 = (LAS float*)F.lds;
    LAS float* A0 = A1 + 2048;
    const float* mp = (const float*)(F.ws + WS_MODP);
#pragma unroll
    for (int half = 0; half < 2; ++half) { float s[4]; float pv[4][16];
#pragma unroll
        for (int q = 0; q < 4; ++q) { const int i = tid_ + NTHREADS * (half * 4 + q); const int b = i >> 11, n = ((i >> 10) & 1) * 1024 + (i & 1023);
#pragma unroll
            for (int k = 0; k < 16; ++k) pv[q][k] = mp[(size_t)k * 2 * 6144 + b * 6144 + n]; }
#pragma unroll
        for (int q = 0; q < 4; ++q) { const int i = tid_ + NTHREADS * (half * 4 + q); const int b = i >> 11, which = (i >> 10) & 1, j = i & 1023; s[q] = F.b_ada[which * 1024 + j];
#pragma unroll
            for (int k = 0; k < 16; ++k) s[q] += pv[q][k];
            if (which) A1[b * 1024 + j] = F.g_mix[j] * (1.f + s[q]); else A0[b * 1024 + j] = s[q]; } }
    if (blockIdx.x < 48 && tid_ < 256) { const int n = blockIdx.x * 256 + tid_; const int b = n / 6144, nn = n % 6144; float s = F.b_ada[nn];
#pragma unroll
        for (int k = 0; k < 16; ++k) s += mp[(size_t)k * 2 * 6144 + b * 6144 + nn];
        ((float*)(F.ws + WS_MODF))[n] = s; }
    __syncthreads();
    const int gw = F.vcu * NWAVES + F.wave, NGW = F.G * NWAVES, lane = fresh_lane();
    for (int m0 = gw; m0 < T; m0 += 2 * NGW) {
        const int m1 = m0 + NGW; const bool has1 = m1 < T; const int mm1 = has1 ? m1 : m0;
        const f32x4* xr0 = (const f32x4*)(F.x + (size_t)m0 * D) + lane; const f32x4* xr1 = (const f32x4*)(F.x + (size_t)mm1 * D) + lane; f32x4 v0[4], v1[4]; float s0 = 0.f, s1 = 0.f;
#pragma unroll
        for (int j = 0; j < 4; ++j) { v0[j] = xr0[64 * j]; v1[j] = xr1[64 * j]; }
#pragma unroll
        for (int j = 0; j < 4; ++j) { s0 += (v0[j].x * v0[j].x + v0[j].y * v0[j].y) + (v0[j].z * v0[j].z + v0[j].w * v0[j].w); s1 += (v1[j].x * v1[j].x + v1[j].y * v1[j].y) + (v1[j].z * v1[j].z + v1[j].w * v1[j].w); }
        const float r0 = rsqrtf(wave_sum(s0) * (1.f / D) + EPS), r1 = rsqrtf(wave_sum(s1) * (1.f / D) + EPS);
        const int b0 = m0 >> 13, b1 = mm1 >> 13;
        unsigned long long* o0 = (unsigned long long*)((bf16_t*)(F.ws + WS_HB) + (size_t)m0 * D) + lane; unsigned long long* o1 = (unsigned long long*)((bf16_t*)(F.ws + WS_HB) + (size_t)mm1 * D) + lane;
#pragma unroll
        for (int j = 0; j < 4; ++j) { const f32x4 a1 = *(const LAS f32x4*)(A1 + b0 * 1024 + 4 * lane + 256 * j), a0 = *(const LAS f32x4*)(A0 + b0 * 1024 + 4 * lane + 256 * j);
            const f32x4 o = v0[j] * r0 * a1 + a0; o0[64 * j] = (unsigned long long)pk2(o.x, o.y) | ((unsigned long long)pk2(o.z, o.w) << 32); }
        if (has1) {
#pragma unroll
            for (int j = 0; j < 4; ++j) { const f32x4 a1 = *(const LAS f32x4*)(A1 + b1 * 1024 + 4 * lane + 256 * j), a0 = *(const LAS f32x4*)(A0 + b1 * 1024 + 4 * lane + 256 * j);
                const f32x4 o = v1[j] * r1 * a1 + a0; o1[64 * j] = (unsigned long long)pk2(o.x, o.y) | ((unsigned long long)pk2(o.z, o.w) << 32); } }
    }
    __syncthreads();
}

__device__ __forceinline__ bool static_tile(int i, int G, int c, int nM, int nN, int& pm, int& pn) {
    const int nwg = nM * nN; const long L = (long)i * G + c; if (L >= nwg) return false;
    int wgid = (int)L; { const int q = nwg / 8, r = nwg % 8, xcd = wgid % 8, off = wgid / 8; wgid = (xcd < r ? xcd * (q + 1) : r * (q + 1) + (xcd - r) * q) + off; }
    const int nig = 8 * nN, gid = wgid / nig, fm = gid * 8, gsz = (nM - fm) < 8 ? (nM - fm) : 8;
    pm = fm + ((wgid % nig) % gsz); pn = (wgid % nig) / gsz; return true;
}
struct SchedP1 {
    static constexpr bool GATHER = false;
    __device__ __forceinline__ void a_ready(const gm::Unit&, int, int) const {}
    __device__ __forceinline__ void done(const gm::Unit&, int) const {}
    __device__ __forceinline__ void stamp(int, const gm::Unit&, int, int) const {}
    const char* A; const char* Bt; int G, c;
    __device__ __forceinline__ bool next(int i, gm::Unit& u) const { int pm, pn; if (!static_tile(i, G, c, 64, 9, pm, pn)) return false;
        u.A = A; u.Bt = Bt; u.gidx = nullptr; u.lda2 = 2048; u.ldb2 = 2048; u.arow0 = pm * 256; u.brow0 = pn * 256; u.nt = 16; u.pm = pm; u.pn = pn; u.aux = 0; return true; }
};
struct SchedP2 {
    static constexpr bool GATHER = false;
    __device__ __forceinline__ void a_ready(const gm::Unit&, int, int) const {}
    __device__ __forceinline__ void done(const gm::Unit&, int) const {}
    __device__ __forceinline__ void stamp(int, const gm::Unit&, int, int) const {}
    const char* A; const char* Wuq; const char* Wukv; int G, c;
    __device__ __forceinline__ bool next(int i, gm::Unit& u) const {
        const int L = i * G + c; if (L >= 448) return false;
        u.A = A; u.gidx = nullptr; u.lda2 = 1536;
        if (L < 256) { int pm, pn; static_tile(0, 256, L, 64, 4, pm, pn); u.A = A + 768; u.Bt = Wukv; u.ldb2 = 512; u.nt = 4; u.arow0 = pm * 256; u.brow0 = pn * 256; u.pm = pm; u.pn = pn; u.aux = 1; }
        else { int pm, pn; static_tile(0, 192, L - 256, 64, 3, pm, pn); u.Bt = Wuq; u.ldb2 = 768; u.nt = 6; u.arow0 = pm * 256; u.brow0 = pn * 256; u.pm = pm; u.pn = pn; u.aux = 0; }
        return true; }
};

__device__ __forceinline__ void store16_sc1(void* p, u32x4 v) { asm volatile("global_store_dwordx4 %0, %1, off sc1\n\ts_nop 1" :: "v"(p), "v"(v) : "memory"); }
__device__ __forceinline__ void store4_sc1(float* p, float v) { __hip_atomic_store(p, v, __ATOMIC_RELAXED, __HIP_MEMORY_SCOPE_AGENT); }
#define EPI_ARGS const f32x4 (&acc)[2][2][4][2], const gm::Unit& u, int wr, int wc, int fr, int fq, int lane
constexpr float QSCALE_M = 0.10206207261596575f * 1.4426950408889634f;
constexpr float QSCALE_D = 0.125f * 1.4426950408889634f;
__device__ __forceinline__ u32x4 pack8(f32x4 a, f32x4 b) { u32x4 w; w.x = cvt_pk_bf16(a[0], a[1]); w.y = cvt_pk_bf16(a[2], a[3]); w.z = cvt_pk_bf16(b[0], b[1]); w.w = cvt_pk_bf16(b[2], b[3]); return w; }
__device__ __forceinline__ void rope8(f32x4& v0, f32x4& v1, int xmask, const float* cs, const float* sn, bool first) {
    f32x4 o0, o1;
#pragma unroll
    for (int j = 0; j < 4; ++j) { o0[j] = __shfl_xor(v0[j], xmask); o1[j] = __shfl_xor(v1[j], xmask); }
    const f32x4 c0 = *(const f32x4*)cs, c1 = *(const f32x4*)(cs + 4), s0 = *(const f32x4*)sn, s1 = *(const f32x4*)(sn + 4);
    const float sg = first ? -1.f : 1.f;
    v0 = v0 * c0 + o0 * s0 * sg; v1 = v1 * c1 + o1 * s1 * sg;
}
struct EpiP1 {
    static constexpr bool PERM = true;
    unsigned char* ws;
    __device__ __forceinline__ void operator()(EPI_ARGS) const {
        const int pn = u.pn; float krmax = 0.f;
        const float* tabm = (const float*)(ws + WS_TABM); const float* tabd = (const float*)(ws + WS_TABD);
#pragma unroll
        for (int ai = 0; ai < 2; ++ai)
#pragma unroll
            for (int m = 0; m < 4; ++m) {
                const int row = u.pm * 256 + ai * 128 + wr * 64 + m * 16 + fr; const int b = row >> 13, s = row & 8191;
#pragma unroll
                for (int bj = 0; bj < 2; ++bj) {
                    f32x4 v0 = acc[ai][bj][m][0], v1 = acc[ai][bj][m][1];
                    const int ct = bj * 128 + wc * 32 + 8 * fq;
                    if (pn < 3) {
                        float q = (v0[0] * v0[0] + v0[1] * v0[1]) + (v0[2] * v0[2] + v0[3] * v0[3]) + (v1[0] * v1[0] + v1[1] * v1[1]) + (v1[2] * v1[2] + v1[3] * v1[3]);
                        q += __shfl_xor(q, 16); q += __shfl_xor(q, 32);
                        if (fq == 0) store4_sc1((float*)(ws + WS_SSQ) + (size_t)row * 24 + pn * 8 + bj * 4 + wc, q);
                        if (pn == 2 && bj == 1 && wc == 0) {
                            const int f0 = 8 * (fq & 1); rope8(v0, v1, 32, tabm + (size_t)row * 32 + f0, tabm + (size_t)row * 32 + 16 + f0, fq < 2);
                            store16_sc1((bf16_t*)(ws + WS_KR) + (size_t)row * 32 + 8 * fq, pack8(v0, v1));
                            { float q2 = (v0[0] * v0[0] + v0[1] * v0[1]) + (v0[2] * v0[2] + v0[3] * v0[3]) + (v1[0] * v1[0] + v1[1] * v1[1]) + (v1[2] * v1[2] + v1[3] * v1[3]);
                              q2 += __shfl_xor(q2, 16); q2 += __shfl_xor(q2, 32); krmax = fmaxf(krmax, q2); }
                        } else store16_sc1((bf16_t*)(ws + WS_CQ) + (size_t)row * 768 + pn * 256 + ct, pack8(v0, v1));
                    } else {
                        const int which = (pn - 3) >> 1;
                        const int cc = ((pn - 3) & 1) * 256 + ct, hh = cc >> 6, d = cc & 63;
                        if (which < 2 && (wc & 1) == 0) {
                            f32x4 r0 = v0, r1 = v1; rope8(r0, r1, 16, tabd + (size_t)row * 16, tabd + (size_t)row * 16 + 8, fq == 0);
                            if (fq < 2) { v0 = r0; v1 = r1; } }
                        if (which == 0) { v0 = v0 * QSCALE_D; v1 = v1 * QSCALE_D; }
                        bf16_t* dst = (bf16_t*)(ws + (which == 0 ? WS_DQ : which == 1 ? WS_DK : WS_DV));
                        *(u32x4*)(dst + ((size_t)(b * 8 + hh) * S + s) * 64 + d) = pack8(v0, v1);
                    }
                }
            }
        if (pn == 2 && wc == 0) {
#pragma unroll
            for (int o = 1; o < 16; o <<= 1) krmax = fmaxf(krmax, __shfl_xor(krmax, o));
            if (lane == 0) atomicMax((unsigned*)(ws + WS_KMX) + 32 + ((u.pm * 256) >> 13), __float_as_uint(krmax)); }
    }
};
struct EpiP2 {
    static constexpr bool PERM = true;
    unsigned char* ws;
    __device__ __forceinline__ void operator()(EPI_ARGS) const {
        const int pn = u.pn; const bool isq = u.aux == 0; float kmax[2] = {0.f, 0.f};
        const float* tabm = (const float*)(ws + WS_TABM); const float* ssq = (const float*)(ws + WS_SSQ);
#pragma unroll
        for (int ai = 0; ai < 2; ++ai)
#pragma unroll
            for (int m = 0; m < 4; ++m) {
                const int row = u.pm * 256 + ai * 128 + wr * 64 + m * 16 + fr; const int b = row >> 13, s = row & 8191;
                const float* sq = ssq + (size_t)row * 24; float rstd;
                if (isq) { const f32x4 a = *(const f32x4*)sq, bq = *(const f32x4*)(sq + 4), cq = *(const f32x4*)(sq + 8);
                    rstd = rsqrtf((((a[0] + a[1]) + (a[2] + a[3])) + ((bq[0] + bq[1]) + (bq[2] + bq[3])) + ((cq[0] + cq[1]) + (cq[2] + cq[3]))) * (1.f / 384.f) + EPS) * QSCALE_M; }
                else { const f32x4 a = *(const f32x4*)(sq + 12), bq = *(const f32x4*)(sq + 16);
                    rstd = rsqrtf((((a[0] + a[1]) + (a[2] + a[3])) + ((bq[0] + bq[1]) + (bq[2] + bq[3]))) * (1.f / 256.f) + EPS); }
#pragma unroll
                for (int bj = 0; bj < 2; ++bj) {
                    f32x4 v0 = acc[ai][bj][m][0] * rstd, v1 = acc[ai][bj][m][1] * rstd;
                    const int ct = bj * 128 + wc * 32 + 8 * fq, cc = (pn & 1) * 256 + ct;
                    if (isq) {
                        if (pn < 2) { const int hh = cc >> 6, d = cc & 63; *(u32x4*)((bf16_t*)(ws + WS_Q) + ((size_t)(b * 8 + hh) * S + s) * 96 + d) = pack8(v0, v1); }
                        else { const int hh = ct >> 5; const int f0 = 8 * (fq & 1); rope8(v0, v1, 32, tabm + (size_t)row * 32 + f0, tabm + (size_t)row * 32 + 16 + f0, fq < 2);
                            *(u32x4*)((bf16_t*)(ws + WS_Q) + ((size_t)(b * 8 + hh) * S + s) * 96 + 64 + 8 * fq) = pack8(v0, v1); }
                    } else { const int hh = cc >> 6, d = cc & 63; bf16_t* dst = (bf16_t*)(ws + (pn < 2 ? WS_KN : WS_V));
                        *(u32x4*)(dst + ((size_t)(b * 8 + hh) * S + s) * 64 + d) = pack8(v0, v1);
                        if (pn < 2) { float q2 = (v0[0] * v0[0] + v0[1] * v0[1]) + (v0[2] * v0[2] + v0[3] * v0[3]) + (v1[0] * v1[0] + v1[1] * v1[1]) + (v1[2] * v1[2] + v1[3] * v1[3]);
                            q2 += __shfl_xor(q2, 16); q2 += __shfl_xor(q2, 32); kmax[bj] = fmaxf(kmax[bj], q2); } }
                }
            }
        if (!isq && pn < 2) {
#pragma unroll
            for (int bj = 0; bj < 2; ++bj) { float km = kmax[bj];
#pragma unroll
                for (int o = 1; o < 16; o <<= 1) km = fmaxf(km, __shfl_xor(km, o));
                const int cc = (pn & 1) * 256 + bj * 128 + wc * 32, hh = cc >> 6, half = (cc >> 5) & 1, b = (u.pm * 256) >> 13;
                if (lane == 0) atomicMax((unsigned*)(ws + WS_KMX) + (b * 8 + hh) * 2 + half, __float_as_uint(km)); }
        }
    }
};

constexpr size_t WS_DCNT = 52 * KiB;
constexpr size_t WS_PCNT = 56 * KiB;
struct SchedP12 {
    static constexpr bool GATHER = false;
    const char *HB, *WIN, *CQ, *WUQ, *WUKV; unsigned* cnt; int G, vcu, c;
    __device__ __forceinline__ bool next(int i, gm::Unit& u) const {
        u.gidx = nullptr;
        if (G == 256) {
            const int n1 = c < 64 ? 3 : 2;
            if (i < n1) { int pm, pn; static_tile(i, 256, c, 64, 9, pm, pn);
                u.A = HB; u.Bt = WIN; u.lda2 = 2048; u.ldb2 = 2048; u.arow0 = pm * 256; u.brow0 = pn * 256; u.nt = 16; u.pm = pm; u.pn = pn; u.aux = 2; return true; }
            if (c < 64) return false;
            const int idx = (c - 64) + 192 * (i - 2); if (i - 2 >= 3 || idx >= 448) return false;
            if (idx < 256) { int pm, pn; static_tile(0, 256, idx, 64, 4, pm, pn); u.A = CQ + 768; u.Bt = WUKV; u.lda2 = 1536; u.ldb2 = 512; u.nt = 4; u.arow0 = pm * 256; u.brow0 = pn * 256; u.pm = pm; u.pn = pn; u.aux = 1; }
            else { int pm, pn; static_tile(0, 192, idx - 256, 64, 3, pm, pn); u.A = CQ; u.Bt = WUQ; u.lda2 = 1536; u.ldb2 = 768; u.nt = 6; u.arow0 = pm * 256; u.brow0 = pn * 256; u.pm = pm; u.pn = pn; u.aux = 0; }
            return true;
        }
        const int n1 = (576 - vcu + G - 1) / G;
        if (i < n1) { const int k = vcu + G * i, pn = k >> 6, pm = k & 63;
            u.A = HB; u.Bt = WIN; u.lda2 = 2048; u.ldb2 = 2048; u.arow0 = pm * 256; u.brow0 = pn * 256; u.nt = 16; u.pm = pm; u.pn = pn; u.aux = 2; return true; }
        const int idx = vcu + G * (i - n1); if (idx >= 448) return false;
        if (idx < 256) { const int pm = idx & 63, pn = idx >> 6; u.A = CQ + 768; u.Bt = WUKV; u.lda2 = 1536; u.ldb2 = 512; u.nt = 4; u.arow0 = pm * 256; u.brow0 = pn * 256; u.pm = pm; u.pn = pn; u.aux = 1; }
        else { const int j = idx - 256, pm = j & 63, pn = j >> 6; u.A = CQ; u.Bt = WUQ; u.lda2 = 1536; u.ldb2 = 768; u.nt = 6; u.arow0 = pm * 256; u.brow0 = pn * 256; u.pm = pm; u.pn = pn; u.aux = 0; }
        return true;
    }
#ifndef P12_STAMP
#define P12_STAMP 0
#endif
    __device__ __forceinline__ void stamp(int ui, const gm::Unit& u, int wid, int lane) const {
#if P12_STAMP
        if (wid == 0 && lane == 0) { unsigned long long* ts = (unsigned long long*)((unsigned char*)cnt - WS_PCNT + 128 * KiB) + (size_t)c * 8; ts[1 + ui] = __builtin_amdgcn_s_memrealtime(); ts[6] = (unsigned long long)(ui + 1); ts[7] = (u.aux == 2) ? (unsigned long long)(ui + 1) : ts[7]; }
#endif
    }
    __device__ __forceinline__ void a_ready(const gm::Unit& u, int wid, int) const {
        if (u.aux == 2) return;
        if (wid == 0) { unsigned* p = cnt + 16 * u.pm; unsigned spins = 0;
            while ((unsigned)__builtin_amdgcn_readfirstlane(__hip_atomic_load(p, __ATOMIC_RELAXED, __HIP_MEMORY_SCOPE_AGENT)) < 24u) { __builtin_amdgcn_s_sleep(2); if (++spins > (1u << 22)) break; }
            __builtin_amdgcn_fence(__ATOMIC_ACQUIRE, "agent");
            asm volatile("s_waitcnt vmcnt(0)" ::: "memory"); }
        asm volatile("" ::: "memory"); __builtin_amdgcn_s_barrier(); asm volatile("" ::: "memory");
    }
    __device__ __forceinline__ void done(const gm::Unit& u, int lane) const {
        if (u.aux != 2 || u.pn >= 3) return;
        asm volatile("s_waitcnt vmcnt(0)" ::: "memory");
        if (lane == 0) __hip_atomic_fetch_add(cnt + 16 * u.pm, 1u, __ATOMIC_RELAXED, __HIP_MEMORY_SCOPE_AGENT);
    }
};
struct EpiP12 {
    static constexpr bool PERM = true;
    unsigned char* ws;
    __device__ __forceinline__ void operator()(EPI_ARGS) const { if (u.aux == 2) { EpiP1 e{ws}; e(acc, u, wr, wc, fr, fq, lane); } else { EpiP2 e{ws}; e(acc, u, wr, wc, fr, fq, lane); } }
};
}
namespace mk {
#define RLX_AGENT __ATOMIC_RELAXED, __HIP_MEMORY_SCOPE_AGENT
#define XB_TMO      128
#define XB_XCNT(j)  (256  + 64 * (j))
#define XB_XSUB(j)  (1280 + 64 * (j))
#define XB_XGEN(j)  (2304 + 64 * (j))
#define XB_TOP      3328
#define XB_TOPGEN   3392
#define XCD_BAR_WORDS 3456
#define XB_SPIN_CAP (1u << 18)
__device__ __forceinline__ unsigned xb_ld(unsigned* p)              { return __hip_atomic_load(p, __ATOMIC_RELAXED, __HIP_MEMORY_SCOPE_AGENT); }
__device__ __forceinline__ unsigned xb_add(unsigned* p, unsigned v) { return __hip_atomic_fetch_add(p, v, __ATOMIC_RELAXED, __HIP_MEMORY_SCOPE_AGENT); }
__device__ __forceinline__ unsigned xb_xcc_id() { return (unsigned)__builtin_amdgcn_s_getreg((3 << 11) | 20) & 0xFu; }
#define XB_SPIN(cond, bar) do { unsigned _sp = 0; while (cond) { __builtin_amdgcn_s_sleep(1); \
    if ((++_sp & 255u) == 0u) { if (xb_ld(&(bar)[XB_TMO])) break; if (_sp > XB_SPIN_CAP) { atomicAdd(&(bar)[XB_TMO], 1u); break; } } } } while (0)
struct XcdBarrier { unsigned* bar; unsigned x; volatile LAS unsigned* st; };
__device__ __forceinline__ XcdBarrier xcd_barrier_post(unsigned* bar, volatile LAS unsigned* st, bool first_thread) {
    XcdBarrier b; b.bar = bar; b.x = xb_xcc_id(); b.st = st;
    if (first_thread) (void)xb_add(&bar[XB_XCNT(b.x)], 1u);
    return b;
}
__device__ __forceinline__ void xcd_barrier_complete(unsigned* bar, unsigned x, unsigned& nloc, unsigned& nx) {
    const unsigned G = gridDim.x * gridDim.y * gridDim.z;
    unsigned sum, cnt, mine, sp = 0u;
    for (;;) {
        sum = 0u; cnt = 0u; mine = 0u;
#pragma unroll
        for (unsigned j = 0; j < 16; ++j) { const unsigned c = xb_ld(&bar[XB_XCNT(j)]); sum += c; cnt += (c > 0u) ? 1u : 0u; mine = (j == x) ? c : mine; }
        if (sum == G) break;
        __builtin_amdgcn_s_sleep(1);
        if ((++sp & 255u) == 0u) { if (xb_ld(&bar[XB_TMO])) break; if (sp > XB_SPIN_CAP) { atomicAdd(&bar[XB_TMO], 1u); break; } }
    }
    nloc = mine > 0u ? mine : 1u; nx = cnt > 0u ? cnt : 1u;
}
__device__ __forceinline__ void xcd_barrier(const XcdBarrier& b, bool first_thread) {
    asm volatile("s_waitcnt vmcnt(0)" ::: "memory");
    __syncthreads();
    if (first_thread) {
        unsigned* bar = b.bar;
        __builtin_amdgcn_s_waitcnt(0);
        unsigned nloc = b.st[0], nx = b.st[1];
        if (nloc == 0u) { xcd_barrier_complete(bar, b.x, nloc, nx); b.st[0] = nloc; b.st[1] = nx; }
        const unsigned old = xb_add(&bar[XB_XSUB(b.x)], 1u);
        const unsigned gen = old / nloc;
        if (old + 1u == (gen + 1u) * nloc) {
            __builtin_amdgcn_fence(__ATOMIC_RELEASE, "agent");
            asm volatile("s_waitcnt vmcnt(0)" ::: "memory");
            const unsigned og = xb_add(&bar[XB_TOP], 1u);
            const unsigned tg = og / nx;
            if (og + 1u == (tg + 1u) * nx) xb_add(&bar[XB_TOPGEN], 1u);
            else XB_SPIN(xb_ld(&bar[XB_TOPGEN]) == tg, bar);
            __builtin_amdgcn_fence(__ATOMIC_ACQUIRE, "agent");
            xb_add(&bar[XB_XGEN(b.x)], 1u);
            asm volatile("s_waitcnt vmcnt(0)" ::: "memory");
        } else {
            XB_SPIN(xb_ld(&bar[XB_XGEN(b.x)]) == gen, bar);
            __builtin_amdgcn_fence(__ATOMIC_ACQUIRE, "agent");
            asm volatile("s_waitcnt vmcnt(0)" ::: "memory");
        }
    }
    __syncthreads();
}
}
namespace at {
using bf16x8 = __attribute__((ext_vector_type(8))) short;
using s16x4 = __attribute__((ext_vector_type(4))) short;
using f32x16 = __attribute__((ext_vector_type(16))) float;
using u32x4 = __attribute__((ext_vector_type(4))) unsigned;
constexpr int S = 8192, T = 16384;
constexpr float THR = 8.f;
#define SBAR() __builtin_amdgcn_sched_barrier(0)
__device__ __forceinline__ int crow(int r, int hi) { return (r & 3) + 8 * (r >> 2) + 4 * hi; }
__device__ __forceinline__ unsigned cvtpk(float lo, float hi) { unsigned r; asm volatile("v_cvt_pk_bf16_f32 %0, %1, %2" : "=v"(r) : "v"(lo), "v"(hi)); return r; }
__device__ __forceinline__ float rowmax32(const f32x16& p0, const f32x16& p1) {
    float pmax = p0[0];
#pragma unroll
    for (int r = 1; r < 16; ++r) pmax = fmaxf(pmax, p0[r]);
#pragma unroll
    for (int r = 0; r < 16; ++r) pmax = fmaxf(pmax, p1[r]);
    auto rr = __builtin_amdgcn_permlane32_swap(__float_as_uint(pmax), __float_as_uint(pmax), false, false);
    return fmaxf(__uint_as_float(rr[0]), __uint_as_float(rr[1]));
}
__device__ __forceinline__ void partialSM(f32x16& p0, f32x16& p1, float& m_reg, float& mn, float& alpha) {
    const float pmax = rowmax32(p0, p1);
    if (__builtin_expect(__all(pmax - m_reg <= THR), 1)) { mn = m_reg; alpha = 1.f; }
    else { mn = fmaxf(m_reg, pmax); alpha = __builtin_amdgcn_exp2f(m_reg - mn); m_reg = mn; }
#pragma unroll
    for (int r = 0; r < 16; ++r) p0[r] = p0[r] - mn;
#pragma unroll
    for (int r = 0; r < 16; ++r) p1[r] = p1[r] - mn;
#pragma unroll
    for (int r = 0; r < 16; ++r) p0[r] = __builtin_amdgcn_exp2f(p0[r]);
}
#define PK4(P, BASE, OUT) do { u32x4 w = {cvtpk(P[BASE + 0], P[BASE + 1]), cvtpk(P[BASE + 2], P[BASE + 3]), cvtpk(P[BASE + 4], P[BASE + 5]), cvtpk(P[BASE + 6], P[BASE + 7])}; \
    OUT = *reinterpret_cast<bf16x8*>(&w); } while (0)
__device__ __forceinline__ void finishSM(f32x16& p0, f32x16& p1, float alpha, float& l_reg, bf16x8& pa0, bf16x8& pa1, bf16x8& pa2, bf16x8& pa3) {
#pragma unroll
    for (int r = 0; r < 16; ++r) p1[r] = __builtin_amdgcn_exp2f(p1[r]);
    float ps = 0;
#pragma unroll
    for (int r = 0; r < 16; ++r) ps += p0[r];
#pragma unroll
    for (int r = 0; r < 16; ++r) ps += p1[r];
    { auto rr = __builtin_amdgcn_permlane32_swap(__float_as_uint(ps), __float_as_uint(ps), false, false); ps = __uint_as_float(rr[0]) + __uint_as_float(rr[1]); }
    l_reg = l_reg * alpha + ps;
    PK4(p0, 0, pa0); PK4(p0, 8, pa1); PK4(p1, 0, pa2); PK4(p1, 8, pa3);
}
__device__ __forceinline__ int v_st(int k, int c) { const int kk = k; return ((kk >> 3) * 2 + (c >> 5)) * 512 + ((kk & 7) * 32 + (c & 31)) * 2; }
__device__ __forceinline__ int v_rd_base(int lane) { return ((lane & 3) << 3) | (((lane >> 2) & 3) << 6) | (((lane >> 4) & 1) << 5) | (((lane >> 5) & 1) << 8); }
constexpr int v_rd_off(int d0, int ks, int half) { return d0 * 512 + ks * 2048 + half * 1024; }
template <int OFF> __device__ __forceinline__ s16x4 tr_read(int vb) { s16x4 r; asm volatile("ds_read_b64_tr_b16 %0, %1 offset:%2" : "=&v"(r) : "v"(vb), "i"(OFF) : "memory"); return r; }
#define PKV(L, H) (bf16x8){L[0], L[1], L[2], L[3], H[0], H[1], H[2], H[3]}
template <int D0, int KOFF> __device__ __forceinline__ void pv_one(f32x16& od, int vb, bf16x8 pa0, bf16x8 pa1, bf16x8 pa2, bf16x8 pa3) {
    const s16x4 l0 = tr_read<KOFF + v_rd_off(D0, 0, 0)>(vb), h0 = tr_read<KOFF + v_rd_off(D0, 0, 1)>(vb), l1 = tr_read<KOFF + v_rd_off(D0, 1, 0)>(vb), h1 = tr_read<KOFF + v_rd_off(D0, 1, 1)>(vb);
    const s16x4 l2 = tr_read<KOFF + v_rd_off(D0, 2, 0)>(vb), h2 = tr_read<KOFF + v_rd_off(D0, 2, 1)>(vb), l3 = tr_read<KOFF + v_rd_off(D0, 3, 0)>(vb), h3 = tr_read<KOFF + v_rd_off(D0, 3, 1)>(vb);
    asm volatile("s_waitcnt lgkmcnt(0)" ::: "memory"); SBAR();
    od = __builtin_amdgcn_mfma_f32_32x32x16_bf16(pa0, PKV(l0, h0), od, 0, 0, 0);
    od = __builtin_amdgcn_mfma_f32_32x32x16_bf16(pa1, PKV(l1, h1), od, 0, 0, 0);
    od = __builtin_amdgcn_mfma_f32_32x32x16_bf16(pa2, PKV(l2, h2), od, 0, 0, 0);
    od = __builtin_amdgcn_mfma_f32_32x32x16_bf16(pa3, PKV(l3, h3), od, 0, 0, 0);
}
template <int D0, int KOFF> __device__ __forceinline__ void pv_half(f32x16& od, int vb, bf16x8 pa0, bf16x8 pa1) {
    const s16x4 l0 = tr_read<KOFF + v_rd_off(D0, 0, 0)>(vb), h0 = tr_read<KOFF + v_rd_off(D0, 0, 1)>(vb), l1 = tr_read<KOFF + v_rd_off(D0, 1, 0)>(vb), h1 = tr_read<KOFF + v_rd_off(D0, 1, 1)>(vb);
    asm volatile("s_waitcnt lgkmcnt(0)" ::: "memory"); SBAR();
    od = __builtin_amdgcn_mfma_f32_32x32x16_bf16(pa0, PKV(l0, h0), od, 0, 0, 0);
    od = __builtin_amdgcn_mfma_f32_32x32x16_bf16(pa1, PKV(l1, h1), od, 0, 0, 0);
}
template <class RowOff> __device__ __forceinline__ void store_o_tile(const f32x16 (&o)[2], const float (&rli)[16], unsigned short* stg, unsigned short* dst, RowOff row_off, int lane) {
    const int r32 = lane & 31, hi = lane >> 5;
#pragma unroll
    for (int r = 0; r < 16; ++r) { const int orow = crow(r, hi);
#pragma unroll
        for (int d0 = 0; d0 < 2; ++d0) stg[orow * 64 + d0 * 32 + r32] = (unsigned short)(cvtpk(o[d0][r] * rli[r], 0.f) & 0xffffu); }
    asm volatile("s_waitcnt lgkmcnt(0)" ::: "memory");
#pragma unroll
    for (int i = 0; i < 4; ++i) { const int row = i * 8 + (lane >> 3), ch = lane & 7; const u32x4 v = *(const u32x4*)(stg + row * 64 + ch * 8); *(u32x4*)(dst + row_off(row) + ch * 8) = v; }
    asm volatile("s_waitcnt lgkmcnt(0)" ::: "memory");
}

__device__ __forceinline__ bool wg_or(bool pred, unsigned* flags8, int wid, int lane) {
    const bool w = __any(pred); if (lane == 0) flags8[wid] = w ? 1u : 0u;
    __syncthreads();
    unsigned r = 0u;
#pragma unroll
    for (int i = 0; i < 8; ++i) r |= flags8[i];
    __syncthreads();
    return r != 0u;
}
constexpr int SHM_V = 8192, SHM_K = 16384, MLA_WS = 2 * SHM_V + 2 * SHM_K, MLA_OST = MLA_WS + 8 * 256;
#define KSWZ(row, colB) ((row) * 256 + ((colB) ^ (((row) & 15) << 4)))
__device__ __forceinline__ void qkt96(f32x16& p0, f32x16& p1, const char* Ks, const bf16x8* qr, int r32, int hi) {
    p0 = f32x16{}; p1 = f32x16{};
#pragma unroll
    for (int d0 = 0; d0 < 6; ++d0) { const int cb = (d0 * 16 + hi * 8) * 2;
        const bf16x8 b0 = *reinterpret_cast<const bf16x8*>(Ks + KSWZ(r32, cb));
        const bf16x8 b1 = *reinterpret_cast<const bf16x8*>(Ks + KSWZ(32 + r32, cb));
        p0 = __builtin_amdgcn_mfma_f32_32x32x16_bf16(b0, qr[d0], p0, 0, 0, 0);
        p1 = __builtin_amdgcn_mfma_f32_32x32x16_bf16(b1, qr[d0], p1, 0, 0, 0); }
}
__device__ __forceinline__ void pv64(f32x16* o, int vb, bf16x8 pa0, bf16x8 pa1, bf16x8 pa2, bf16x8 pa3) {
    pv_one<0, 0>(o[0], vb, pa0, pa1, pa2, pa3); pv_one<1, 0>(o[1], vb, pa0, pa1, pa2, pa3);
}
__device__ __forceinline__ void mla_unit(int wv, int bh, int qb, const unsigned short* __restrict__ Q, const unsigned short* __restrict__ KN, const unsigned short* __restrict__ KR,
                                         const unsigned short* __restrict__ V, unsigned short* __restrict__ CAT, char* lds) {
    const int wid = wv, lane = gm::lane_now(), tid = wid * 64 + lane, r32 = lane & 31, hi = lane >> 5;
    const int b = bh >> 3, h = bh & 7;
    char* V_lds = lds; char* K_lds = lds + 2 * SHM_V;
    float* wsf = (float*)(lds + MLA_WS) + wid * 64; float* li_l = wsf; float* al_l = wsf + 32;
    float m_reg = -1e30f, l_reg = 0; f32x16 o[2] = {}; bf16x8 qr[6];
    const size_t bhS = (size_t)bh * S; const int q0 = qb * 256;
    const unsigned short* Qw = Q + (bhS + q0 + wid * 32 + r32) * 96 + hi * 8;
#pragma unroll
    for (int d0 = 0; d0 < 6; ++d0) qr[d0] = *reinterpret_cast<const bf16x8*>(Qw + d0 * 16);
    const int srow = tid >> 3, sch = tid & 7, rrow = (tid & 255) >> 2, rch = tid & 3;
    const unsigned short* kn_src = KN + (bhS + srow) * 64 + sch * 8;
    const unsigned short* v_src = V + (bhS + srow) * 64 + sch * 8;
    const unsigned short* kr_src = KR + ((size_t)b * S + rrow) * 32 + rch * 8;
    const int kst = KSWZ(srow, sch * 16), krst = KSWZ(rrow, (8 + rch) * 16), vst = v_st(srow, sch * 8);
    const int vb0 = (int)(uintptr_t)V_lds + v_rd_base(lane);
    bf16x8 s_kn[2], s_kr[2], s_v[2];
#define SLOAD(i, k0) do { s_kn[i] = *reinterpret_cast<const bf16x8*>(kn_src + (size_t)(k0) * 64); s_kr[i] = *reinterpret_cast<const bf16x8*>(kr_src + (size_t)(k0) * 32); \
    s_v[i] = *reinterpret_cast<const bf16x8*>(v_src + (size_t)(k0) * 64); } while (0)
#define SWRITE(bb, i) do { *(bf16x8*)(K_lds + (bb) * SHM_K + kst) = s_kn[i]; if (tid < 256) *(bf16x8*)(K_lds + (bb) * SHM_K + krst) = s_kr[i]; *(bf16x8*)(V_lds + (bb) * SHM_V + vst) = s_v[i]; } while (0)
#define SWAIT() asm volatile("s_waitcnt vmcnt(3)" ::: "memory")
#define RESC(a) do { if (__any((a) < 1.f)) { if (hi == 0) al_l[r32] = (a); asm volatile("s_waitcnt lgkmcnt(0)" ::: "memory"); \
    _Pragma("unroll") for (int d = 0; d < 2; ++d) _Pragma("unroll") for (int r = 0; r < 16; ++r) o[d][r] *= al_l[crow(r, hi)]; } } while (0)
    f32x16 pA0, pA1, pB0, pB1; float mnA, mnB, alA, alB; bf16x8 pa0, pa1, pa2, pa3; constexpr int NT = S / 64;
    SLOAD(0, 0); asm volatile("s_waitcnt vmcnt(0)" ::: "memory"); SWRITE(0, 0); __syncthreads();
    qkt96(pA0, pA1, K_lds, qr, r32, hi); partialSM(pA0, pA1, m_reg, mnA, alA);
    SLOAD(1, 64); SLOAD(0, 128);
    SWAIT(); SWRITE(1, 1); __syncthreads();
    for (int j = 1; j + 1 < NT; j += 2) {
        SBAR(); qkt96(pB0, pB1, K_lds + SHM_K, qr, r32, hi);
        finishSM(pA0, pA1, alA, l_reg, pa0, pa1, pa2, pa3); SBAR();
        SLOAD(1, (j + 2) * 64); SBAR();
        pv64(o, vb0, pa0, pa1, pa2, pa3); partialSM(pB0, pB1, m_reg, mnB, alB);
        __syncthreads(); SWAIT(); SWRITE(0, 0);
        RESC(alB); __syncthreads();
        SBAR(); qkt96(pA0, pA1, K_lds, qr, r32, hi);
        finishSM(pB0, pB1, alB, l_reg, pa0, pa1, pa2, pa3); SBAR();
        if (j + 3 < NT) SLOAD(0, (j + 3) * 64); SBAR();
        pv64(o, vb0 + SHM_V, pa0, pa1, pa2, pa3); partialSM(pA0, pA1, m_reg, mnA, alA);
        __syncthreads(); SWAIT(); SWRITE(1, 1);
        RESC(alA); __syncthreads();
    }
    SBAR(); qkt96(pB0, pB1, K_lds + SHM_K, qr, r32, hi);
    finishSM(pA0, pA1, alA, l_reg, pa0, pa1, pa2, pa3); SBAR();
    pv64(o, vb0, pa0, pa1, pa2, pa3); partialSM(pB0, pB1, m_reg, mnB, alB);
    __syncthreads(); RESC(alB);
    finishSM(pB0, pB1, alB, l_reg, pa0, pa1, pa2, pa3); SBAR();
    pv64(o, vb0 + SHM_V, pa0, pa1, pa2, pa3);
    if (hi == 0) li_l[r32] = l_reg; asm volatile("s_waitcnt lgkmcnt(0)" ::: "memory");
    float rli[16];
#pragma unroll
    for (int r = 0; r < 16; ++r) rli[r] = __builtin_amdgcn_rcpf(li_l[crow(r, hi)]);
    unsigned short* stg = (unsigned short*)(lds + MLA_OST) + wid * 2048;
    unsigned short* dst = CAT + ((size_t)b * S + q0 + wid * 32) * 1024 + h * 64;
    store_o_tile(o, rli, stg, dst, [](int row) { return (size_t)row * 1024; }, lane);
    asm volatile("s_waitcnt vmcnt(0)" ::: "memory");
    __syncthreads();
#undef SLOAD
#undef SWRITE
#undef SWAIT
#undef RESC
}


#ifndef V9_SPLIT_PRIO
#define V9_SPLIT_PRIO 0
#endif
#ifndef V7_YOUNG_PRIO
#define V7_YOUNG_PRIO 1
#endif
#ifndef V7_EXACT
#define V7_EXACT 1
#endif
#ifndef MLA_STAMP
#define MLA_STAMP 0
#endif
#ifndef MLA_STAMP_WAVE
#define MLA_STAMP_WAVE 5
#endif
#if MLA_STAMP
#define STAMP_T(var) do { __builtin_amdgcn_sched_barrier(0); asm volatile("s_memtime %0\n\ts_waitcnt lgkmcnt(0)" : "=s"(var) :: "memory"); __builtin_amdgcn_sched_barrier(0); } while (0)
#define STAMP_ACC(i, t0_, t1_) (st_acc[i] += (t1_) - (t0_))
#else
#define STAMP_T(var) do { } while (0)
#define STAMP_ACC(i, t0_, t1_) do { } while (0)
#endif
#ifndef STAMP_SEC
#define STAMP_SEC 4
#endif
#if MLA_STAMP
#define SEC_B(i) do { if ((i) == STAMP_SEC) STAMP_T(tq0); } while (0)
#define SEC_E(i) do { if ((i) == STAMP_SEC) { STAMP_T(tq1); st_a += tq1 - tq0; } } while (0)
#else
#define SEC_B(i) do { } while (0)
#define SEC_E(i) do { } while (0)
#endif
constexpr int M2_K = 0, M2_V = 3 * SHM_K, M2_WS = M2_V + 3 * SHM_V, M2_OST = M2_WS + 8 * 256;
#ifndef MLA_PROBE_NOSTAGE
#define MLA_PROBE_NOSTAGE 0
#endif
#ifndef MLA_STATIC
#define MLA_STATIC 1
#endif
#ifndef MLA_STATIC_THR
#define MLA_STATIC_THR 60.f
#endif
#ifndef MLA_STEP_MODE
#define MLA_STEP_MODE 0
#endif
#ifndef MLA_PROBE_VALU
#define MLA_PROBE_VALU 0
#endif
#ifndef MLA_NEGM
#define MLA_NEGM 1
#endif
#ifndef MLA_PRIO
#define MLA_PRIO 0
#endif
__device__ __forceinline__ void qkt96n(f32x16& p0, f32x16& p1, const char* Ks, const bf16x8* qr, const f32x16& negm, int r32, int hi, bool usec = true) {
    if (MLA_PRIO) __builtin_amdgcn_s_setprio(1);
#pragma unroll
    for (int d0 = 0; d0 < 6; ++d0) { const int cb = (d0 * 16 + hi * 8) * 2;
        const bf16x8 b0 = *reinterpret_cast<const bf16x8*>(Ks + KSWZ(r32, cb));
        const bf16x8 b1 = *reinterpret_cast<const bf16x8*>(Ks + KSWZ(32 + r32, cb));
        if (d0 == 0 && !usec) { p0 = __builtin_amdgcn_mfma_f32_32x32x16_bf16(b0, qr[0], f32x16{}, 0, 0, 0); p1 = __builtin_amdgcn_mfma_f32_32x32x16_bf16(b1, qr[0], f32x16{}, 0, 0, 0); }
        else if (d0 == 0) { p0 = __builtin_amdgcn_mfma_f32_32x32x16_bf16(b0, qr[0], MLA_NEGM ? negm : f32x16{}, 0, 0, 0); p1 = __builtin_amdgcn_mfma_f32_32x32x16_bf16(b1, qr[0], MLA_NEGM ? negm : f32x16{}, 0, 0, 0); }
        else { p0 = __builtin_amdgcn_mfma_f32_32x32x16_bf16(b0, qr[d0], p0, 0, 0, 0); p1 = __builtin_amdgcn_mfma_f32_32x32x16_bf16(b1, qr[d0], p1, 0, 0, 0); } }
    if (MLA_PRIO) __builtin_amdgcn_s_setprio(0);
}
__device__ __forceinline__ void qkt96z(f32x16& p0, f32x16& p1, const char* Ks, const bf16x8* qr, int r32, int hi) {
#pragma unroll
    for (int d0 = 0; d0 < 6; ++d0) { const int cb = (d0 * 16 + hi * 8) * 2;
        const bf16x8 b0 = *reinterpret_cast<const bf16x8*>(Ks + KSWZ(r32, cb));
        const bf16x8 b1 = *reinterpret_cast<const bf16x8*>(Ks + KSWZ(32 + r32, cb));
        if (d0 == 0) { p0 = __builtin_amdgcn_mfma_f32_32x32x16_bf16(b0, qr[0], f32x16{}, 0, 0, 0); p1 = __builtin_amdgcn_mfma_f32_32x32x16_bf16(b1, qr[0], f32x16{}, 0, 0, 0); }
        else { p0 = __builtin_amdgcn_mfma_f32_32x32x16_bf16(b0, qr[d0], p0, 0, 0, 0); p1 = __builtin_amdgcn_mfma_f32_32x32x16_bf16(b1, qr[d0], p1, 0, 0, 0); } }
}
__device__ __forceinline__ float rowmax32b(const f32x16& p0, const f32x16& p1) {
    float a = fmaxf(fmaxf(p0[0], p0[1]), p1[0]), b = fmaxf(fmaxf(p0[2], p0[3]), p1[1]); a = fmaxf(fmaxf(a, p1[2]), p1[3]);
#pragma unroll
    for (int r = 4; r < 16; r += 4) { a = fmaxf(fmaxf(a, p0[r]), p0[r + 1]); b = fmaxf(fmaxf(b, p0[r + 2]), p0[r + 3]); a = fmaxf(fmaxf(a, p1[r]), p1[r + 1]); b = fmaxf(fmaxf(b, p1[r + 2]), p1[r + 3]); }
    const float m = fmaxf(a, b);
    auto rr = __builtin_amdgcn_permlane32_swap(__float_as_uint(m), __float_as_uint(m), false, false);
    return fmaxf(__uint_as_float(rr[0]), __uint_as_float(rr[1]));
}
template <bool FIRST> __device__ __forceinline__ void partialSM2(f32x16& p0, f32x16& p1, float& m_reg, f32x16& negm, float& alpha, bool exact = true) {
    if (!exact) { alpha = 1.f;
#pragma unroll
        for (int r = 0; r < 16; ++r) p0[r] = __builtin_amdgcn_exp2f(p0[r]);
        return; }
    if (MLA_PROBE_VALU) { float d0_ = p1[0], d1_ = p1[1], d2_ = p1[2], d3_ = p1[3];
#pragma unroll
        for (int i = 0; i < 8; ++i) { d0_ = __builtin_amdgcn_exp2f(d0_); d1_ = __builtin_amdgcn_exp2f(d1_); d2_ = __builtin_amdgcn_exp2f(d2_); d3_ = __builtin_amdgcn_exp2f(d3_); }
        asm volatile("" :: "v"(d0_), "v"(d1_), "v"(d2_), "v"(d3_)); }
    if (!MLA_NEGM) {
        const float pm = rowmax32b(p0, p1); alpha = 1.f;
        if (FIRST) m_reg = pm; else if (!__builtin_expect(__all(pm - m_reg <= THR), 1)) { const float mn = fmaxf(m_reg, pm); alpha = __builtin_amdgcn_exp2f(m_reg - mn); m_reg = mn; }
#pragma unroll
        for (int r = 0; r < 16; ++r) { p0[r] -= m_reg; p1[r] -= m_reg; }
#pragma unroll
        for (int r = 0; r < 16; ++r) p0[r] = __builtin_amdgcn_exp2f(p0[r]);
        return; }
    const float pmax = rowmax32b(p0, p1);
    alpha = 1.f;
    if (FIRST || !__builtin_expect(__all(pmax <= THR), 1)) {
        const float dl = FIRST ? pmax : fmaxf(pmax, 0.f); m_reg += dl;
#pragma unroll
        for (int r = 0; r < 16; ++r) { p0[r] -= dl; p1[r] -= dl; }
#pragma unroll
        for (int r = 0; r < 16; ++r) negm[r] = -m_reg;
        if (!FIRST) alpha = __builtin_amdgcn_exp2f(-dl);
    }
#pragma unroll
    for (int r = 0; r < 16; ++r) p0[r] = __builtin_amdgcn_exp2f(p0[r]);
}
template <int D0> __device__ __forceinline__ void pv_one_p(f32x16& od, int vb, bf16x8 pa0, bf16x8 pa1, bf16x8 pa2, bf16x8 pa3) {
    const s16x4 l0 = tr_read<v_rd_off(D0, 0, 0)>(vb), h0 = tr_read<v_rd_off(D0, 0, 1)>(vb), l1 = tr_read<v_rd_off(D0, 1, 0)>(vb), h1 = tr_read<v_rd_off(D0, 1, 1)>(vb);
    const s16x4 l2 = tr_read<v_rd_off(D0, 2, 0)>(vb), h2 = tr_read<v_rd_off(D0, 2, 1)>(vb), l3 = tr_read<v_rd_off(D0, 3, 0)>(vb), h3 = tr_read<v_rd_off(D0, 3, 1)>(vb);
    asm volatile("s_waitcnt lgkmcnt(0)" ::: "memory"); SBAR();
    if (MLA_PRIO) __builtin_amdgcn_s_setprio(1);
    od = __builtin_amdgcn_mfma_f32_32x32x16_bf16(pa0, PKV(l0, h0), od, 0, 0, 0);
    od = __builtin_amdgcn_mfma_f32_32x32x16_bf16(pa1, PKV(l1, h1), od, 0, 0, 0);
    od = __builtin_amdgcn_mfma_f32_32x32x16_bf16(pa2, PKV(l2, h2), od, 0, 0, 0);
    od = __builtin_amdgcn_mfma_f32_32x32x16_bf16(pa3, PKV(l3, h3), od, 0, 0, 0);
    if (MLA_PRIO) __builtin_amdgcn_s_setprio(0);
}

__device__ __forceinline__ void kfrag_load(bf16x8 (&kf)[12], const char* Ks, int r32, int hi) {
#pragma unroll
    for (int d0 = 0; d0 < 6; ++d0) { const int cb = (d0 * 16 + hi * 8) * 2;
        kf[2 * d0] = *reinterpret_cast<const bf16x8*>(Ks + KSWZ(r32, cb)); kf[2 * d0 + 1] = *reinterpret_cast<const bf16x8*>(Ks + KSWZ(32 + r32, cb)); }
}
__device__ __forceinline__ void qk_mma(f32x16& p0, f32x16& p1, const bf16x8 (&kf)[12], const bf16x8* qr, const f32x16& negm) {
    if (MLA_PRIO) __builtin_amdgcn_s_setprio(1);
    p0 = __builtin_amdgcn_mfma_f32_32x32x16_bf16(kf[0], qr[0], MLA_NEGM ? negm : f32x16{}, 0, 0, 0); p1 = __builtin_amdgcn_mfma_f32_32x32x16_bf16(kf[1], qr[0], MLA_NEGM ? negm : f32x16{}, 0, 0, 0);
#pragma unroll
    for (int d0 = 1; d0 < 6; ++d0) { p0 = __builtin_amdgcn_mfma_f32_32x32x16_bf16(kf[2 * d0], qr[d0], p0, 0, 0, 0); p1 = __builtin_amdgcn_mfma_f32_32x32x16_bf16(kf[2 * d0 + 1], qr[d0], p1, 0, 0, 0); }
    if (MLA_PRIO) __builtin_amdgcn_s_setprio(0);
}
template <int D0> __device__ __forceinline__ void vfrag_load_h(s16x4 (&vl)[4], s16x4 (&vh)[4], int vb) {
    vl[0] = tr_read<v_rd_off(D0, 0, 0)>(vb); vh[0] = tr_read<v_rd_off(D0, 0, 1)>(vb); vl[1] = tr_read<v_rd_off(D0, 1, 0)>(vb); vh[1] = tr_read<v_rd_off(D0, 1, 1)>(vb);
    vl[2] = tr_read<v_rd_off(D0, 2, 0)>(vb); vh[2] = tr_read<v_rd_off(D0, 2, 1)>(vb); vl[3] = tr_read<v_rd_off(D0, 3, 0)>(vb); vh[3] = tr_read<v_rd_off(D0, 3, 1)>(vb);
}
__device__ __forceinline__ void pv_mma_h(f32x16& od, const s16x4 (&vl)[4], const s16x4 (&vh)[4], bf16x8 pa0, bf16x8 pa1, bf16x8 pa2, bf16x8 pa3) {
    if (MLA_PRIO) __builtin_amdgcn_s_setprio(1);
    od = __builtin_amdgcn_mfma_f32_32x32x16_bf16(pa0, PKV(vl[0], vh[0]), od, 0, 0, 0);
    od = __builtin_amdgcn_mfma_f32_32x32x16_bf16(pa1, PKV(vl[1], vh[1]), od, 0, 0, 0);
    od = __builtin_amdgcn_mfma_f32_32x32x16_bf16(pa2, PKV(vl[2], vh[2]), od, 0, 0, 0);
    od = __builtin_amdgcn_mfma_f32_32x32x16_bf16(pa3, PKV(vl[3], vh[3]), od, 0, 0, 0);
    if (MLA_PRIO) __builtin_amdgcn_s_setprio(0);
}
#if MLA_STEP_MODE == 0
#define MLA_STEP(PC0, PC1, PP0, PP1, ALP, ALC) do { \
    STAMP_T(tq0); qkt96n(PC0, PC1, K_lds + sc * SHM_K, qr, negm, r32, hi); STAMP_T(tq1); STAMP_ACC(1, tq0, tq1); \
    finishSM(PP0, PP1, ALP, l_reg, pa0, pa1, pa2, pa3); SBAR(); STAMP_T(tq0); STAMP_ACC(2, tq1, tq0); \
    { const int vb_ = vb0 + sp * SHM_V; pv_one_p<0>(o[0], vb_, pa0, pa1, pa2, pa3); pv_one_p<1>(o[1], vb_, pa0, pa1, pa2, pa3); } STAMP_T(tq1); STAMP_ACC(3, tq0, tq1); \
    partialSM2<false>(PC0, PC1, m_reg, negm, ALC, exact); RESC(ALC); STAMP_T(tq0); STAMP_ACC(4, tq1, tq0); } while (0)
#elif MLA_STEP_MODE == 2
  \
#define SGB(mask, n) __builtin_amdgcn_sched_group_barrier(mask, n, 0)
#define MLA_STEP(PC0, PC1, PP0, PP1, ALP, ALC) do { \
    { const char* Ks_ = K_lds + sc * SHM_K; \
      _Pragma("unroll") for (int d0 = 0; d0 < 6; ++d0) { const int cb = (d0 * 16 + hi * 8) * 2; \
        const bf16x8 b0 = *reinterpret_cast<const bf16x8*>(Ks_ + KSWZ(r32, cb)); const bf16x8 b1 = *reinterpret_cast<const bf16x8*>(Ks_ + KSWZ(32 + r32, cb)); \
        if (d0 == 0) { PC0 = __builtin_amdgcn_mfma_f32_32x32x16_bf16(b0, qr[0], negm, 0, 0, 0); PC1 = __builtin_amdgcn_mfma_f32_32x32x16_bf16(b1, qr[0], negm, 0, 0, 0); } \
        else { PC0 = __builtin_amdgcn_mfma_f32_32x32x16_bf16(b0, qr[d0], PC0, 0, 0, 0); PC1 = __builtin_amdgcn_mfma_f32_32x32x16_bf16(b1, qr[d0], PC1, 0, 0, 0); } } } \
    finishSM(PP0, PP1, ALP, l_reg, pa0, pa1, pa2, pa3); \
    SGB(0x100, 4); \
    _Pragma("unroll") for (int g_ = 0; g_ < 12; ++g_) { SGB(0x008, 1); SGB(0x100, 1); SGB(0x002, 7); } \
    SBAR(); \
    { const int vb_ = vb0 + sp * SHM_V; \
      const s16x4 l0 = tr_read<v_rd_off(0, 0, 0)>(vb_), h0 = tr_read<v_rd_off(0, 0, 1)>(vb_), l1 = tr_read<v_rd_off(0, 1, 0)>(vb_), h1 = tr_read<v_rd_off(0, 1, 1)>(vb_); \
      const s16x4 l2 = tr_read<v_rd_off(0, 2, 0)>(vb_), h2 = tr_read<v_rd_off(0, 2, 1)>(vb_), l3 = tr_read<v_rd_off(0, 3, 0)>(vb_), h3 = tr_read<v_rd_off(0, 3, 1)>(vb_); \
      const s16x4 l4 = tr_read<v_rd_off(1, 0, 0)>(vb_), h4 = tr_read<v_rd_off(1, 0, 1)>(vb_), l5 = tr_read<v_rd_off(1, 1, 0)>(vb_), h5 = tr_read<v_rd_off(1, 1, 1)>(vb_); \
      const s16x4 l6 = tr_read<v_rd_off(1, 2, 0)>(vb_), h6 = tr_read<v_rd_off(1, 2, 1)>(vb_), l7 = tr_read<v_rd_off(1, 3, 0)>(vb_), h7 = tr_read<v_rd_off(1, 3, 1)>(vb_); \
      asm volatile("s_waitcnt lgkmcnt(0)" ::: "memory"); SBAR(); \
      o[0] = __builtin_amdgcn_mfma_f32_32x32x16_bf16(pa0, PKV(l0, h0), o[0], 0, 0, 0); o[1] = __builtin_amdgcn_mfma_f32_32x32x16_bf16(pa0, PKV(l4, h4), o[1], 0, 0, 0); \
      o[0] = __builtin_amdgcn_mfma_f32_32x32x16_bf16(pa1, PKV(l1, h1), o[0], 0, 0, 0); o[1] = __builtin_amdgcn_mfma_f32_32x32x16_bf16(pa1, PKV(l5, h5), o[1], 0, 0, 0); \
      o[0] = __builtin_amdgcn_mfma_f32_32x32x16_bf16(pa2, PKV(l2, h2), o[0], 0, 0, 0); o[1] = __builtin_amdgcn_mfma_f32_32x32x16_bf16(pa2, PKV(l6, h6), o[1], 0, 0, 0); \
      o[0] = __builtin_amdgcn_mfma_f32_32x32x16_bf16(pa3, PKV(l3, h3), o[0], 0, 0, 0); o[1] = __builtin_amdgcn_mfma_f32_32x32x16_bf16(pa3, PKV(l7, h7), o[1], 0, 0, 0); \
      partialSM2<false>(PC0, PC1, m_reg, negm, ALC, exact); \
      _Pragma("unroll") for (int g_ = 0; g_ < 8; ++g_) { SGB(0x008, 1); SGB(0x002, 2); } \
      SBAR(); } \
    RESC(ALC); } while (0)
#else
#define KFH(dst, Ks_, D0) do { _Pragma("unroll") for (int d_ = 0; d_ < 3; ++d_) { const int cb_ = (((D0) + d_) * 16 + hi * 8) * 2; \
        dst[2 * d_] = *reinterpret_cast<const bf16x8*>((Ks_) + KSWZ(r32, cb_)); dst[2 * d_ + 1] = *reinterpret_cast<const bf16x8*>((Ks_) + KSWZ(32 + r32, cb_)); } } while (0)
#define MLA_STEP(PC0, PC1, PP0, PP1, ALP, ALC) do { \
    bf16x8 ka[6], kb[6]; s16x4 val[4], vah[4], vbl[4], vbh[4]; const int vb_ = vb0 + sp * SHM_V; const char* Ks_ = K_lds + sc * SHM_K; \
    KFH(ka, Ks_, 0); SBAR(); \
    finishSM(PP0, PP1, ALP, l_reg, pa0, pa1, pa2, pa3); SBAR(); \
    KFH(kb, Ks_, 3); SBAR(); \
    if (exact) { PC0 = __builtin_amdgcn_mfma_f32_32x32x16_bf16(ka[0], qr[0], negm, 0, 0, 0); PC1 = __builtin_amdgcn_mfma_f32_32x32x16_bf16(ka[1], qr[0], negm, 0, 0, 0); } \
    else { PC0 = __builtin_amdgcn_mfma_f32_32x32x16_bf16(ka[0], qr[0], negm, 0, 0, 0); PC1 = __builtin_amdgcn_mfma_f32_32x32x16_bf16(ka[1], qr[0], negm, 0, 0, 0); } \
    PC0 = __builtin_amdgcn_mfma_f32_32x32x16_bf16(ka[2], qr[1], PC0, 0, 0, 0); PC1 = __builtin_amdgcn_mfma_f32_32x32x16_bf16(ka[3], qr[1], PC1, 0, 0, 0); \
    PC0 = __builtin_amdgcn_mfma_f32_32x32x16_bf16(ka[4], qr[2], PC0, 0, 0, 0); PC1 = __builtin_amdgcn_mfma_f32_32x32x16_bf16(ka[5], qr[2], PC1, 0, 0, 0); SBAR(); \
    vfrag_load_h<0>(val, vah, vb_); SBAR(); \
    PC0 = __builtin_amdgcn_mfma_f32_32x32x16_bf16(kb[0], qr[3], PC0, 0, 0, 0); PC1 = __builtin_amdgcn_mfma_f32_32x32x16_bf16(kb[1], qr[3], PC1, 0, 0, 0); \
    PC0 = __builtin_amdgcn_mfma_f32_32x32x16_bf16(kb[2], qr[4], PC0, 0, 0, 0); PC1 = __builtin_amdgcn_mfma_f32_32x32x16_bf16(kb[3], qr[4], PC1, 0, 0, 0); \
    PC0 = __builtin_amdgcn_mfma_f32_32x32x16_bf16(kb[4], qr[5], PC0, 0, 0, 0); PC1 = __builtin_amdgcn_mfma_f32_32x32x16_bf16(kb[5], qr[5], PC1, 0, 0, 0); SBAR(); \
    vfrag_load_h<1>(vbl, vbh, vb_); SBAR(); \
    asm volatile("s_waitcnt lgkmcnt(8)" ::: "memory"); SBAR(); \
    pv_mma_h(o[0], val, vah, pa0, pa1, pa2, pa3); SBAR(); \
    asm volatile("s_waitcnt lgkmcnt(0)" ::: "memory"); SBAR(); \
    pv_mma_h(o[1], vbl, vbh, pa0, pa1, pa2, pa3); SBAR(); \
    partialSM2<false>(PC0, PC1, m_reg, negm, ALC, exact); RESC(ALC); } while (0)
#endif

__device__ __forceinline__ void mla_unit_v2(int wv, int bh, int qb, const unsigned short* __restrict__ Q, const unsigned short* __restrict__ KN, const unsigned short* __restrict__ KR,
                                            const unsigned short* __restrict__ V, unsigned short* __restrict__ CAT, const float* __restrict__ KMX, char* lds, unsigned long long* STAMPS = nullptr) {
    const int wid = wv, lane = gm::lane_now(), tid = wid * 64 + lane, r32 = lane & 31, hi = lane >> 5;
    const int b = bh >> 3, h = bh & 7;
    char* K_lds = lds + M2_K; char* V_lds = lds + M2_V;
    float* wsf = (float*)(lds + M2_WS) + wid * 64; float* li_l = wsf; float* al_l = wsf + 32;
    float m_reg = 0.f, l_reg = 0; f32x16 o[2] = {}; bf16x8 qr[6]; f32x16 negm = f32x16{};
    const size_t bhS = (size_t)bh * S; const int q0 = qb * 256;
    const unsigned short* Qw = Q + (bhS + q0 + wid * 32 + r32) * 96 + hi * 8;
#pragma unroll
    for (int d0 = 0; d0 < 6; ++d0) qr[d0] = *reinterpret_cast<const bf16x8*>(Qw + d0 * 16);
    bool exact = true;
    if (MLA_STATIC) { float q2 = 0.f;
#pragma unroll
      for (int d0 = 0; d0 < 6; ++d0)
#pragma unroll
          for (int j = 0; j < 8; ++j) { const float x = __uint_as_float((unsigned)(unsigned short)qr[d0][j] << 16); q2 += x * x; }
      { auto rr = __builtin_amdgcn_permlane32_swap(__float_as_uint(q2), __float_as_uint(q2), false, false); q2 = __uint_as_float(rr[0]) + __uint_as_float(rr[1]); }
      const float k2 = KMX[(b * 8 + h) * 2] + KMX[(b * 8 + h) * 2 + 1] + KMX[32 + b];
      const float ms = 1.01f * sqrtf(q2 * k2);
      exact = wg_or(!(ms <= MLA_STATIC_THR), (unsigned*)(lds + 147456 - 512), wid, lane);
      if (!exact) { m_reg = ms;
#pragma unroll
          for (int r = 0; r < 16; ++r) negm[r] = -ms; } }
    const int srow = tid >> 3, sch = tid & 7, rrow = (tid & 255) >> 2, rch = tid & 3;
    const char* kn_u = (const char*)(KN + bhS * 64); const char* v_u = (const char*)(V + bhS * 64); const char* kr_u = (const char*)(KR + (size_t)b * S * 32);
    const unsigned kn_off = (unsigned)(srow * 64 + sch * 8) * 2u, kr_off = (unsigned)(rrow * 32 + rch * 8) * 2u;
    const int kst = KSWZ(srow, sch * 16), krst = KSWZ(rrow, (8 + rch) * 16), vst = v_st(srow, sch * 8);
    const int vb0 = (int)(uintptr_t)V_lds + v_rd_base(lane);
    bf16x8 s_kn[1], s_kr[1], s_v[1];
#define SLOAD(i, t) do { s_kn[i] = *reinterpret_cast<const bf16x8*>(kn_u + (size_t)(t) * 8192 + kn_off); s_kr[i] = *reinterpret_cast<const bf16x8*>(kr_u + (size_t)(t) * 4096 + kr_off); \
    s_v[i] = *reinterpret_cast<const bf16x8*>(v_u + (size_t)(t) * 8192 + kn_off); } while (0)
#define SWRITE(sl, i) do { *(bf16x8*)(K_lds + (sl) * SHM_K + kst) = s_kn[i]; if (tid < 256) *(bf16x8*)(K_lds + (sl) * SHM_K + krst) = s_kr[i]; *(bf16x8*)(V_lds + (sl) * SHM_V + vst) = s_v[i]; } while (0)
#define SWAIT() asm volatile("s_waitcnt vmcnt(0)" ::: "memory")
#define RESC(a) do { if (exact && __any((a) < 1.f)) { if (hi == 0) al_l[r32] = (a); asm volatile("s_waitcnt lgkmcnt(0)" ::: "memory"); \
    _Pragma("unroll") for (int d = 0; d < 2; ++d) _Pragma("unroll") for (int r = 0; r < 16; ++r) o[d][r] *= al_l[crow(r, hi)]; } } while (0)
#define ROT3(x) ((x) == 2 ? 0 : (x) + 1)
    f32x16 pA0, pA1, pB0, pB1; float alA, alB; bf16x8 pa0, pa1, pa2, pa3; constexpr int NT = S / 64;
#if MLA_STAMP
    unsigned long long st_acc[8] = {0, 0, 0, 0, 0, 0, 0, 0}, tq0 = 0, tq1 = 0, ts0 = 0, ts1 = 0, tu0 = 0; STAMP_T(tu0);
#endif
    SLOAD(0, 0);
    SWAIT(); SWRITE(0, 0); SLOAD(0, 1);
    __syncthreads();
    qkt96n(pA0, pA1, K_lds, qr, negm, r32, hi); if (exact) partialSM2<true>(pA0, pA1, m_reg, negm, alA); else partialSM2<false>(pA0, pA1, m_reg, negm, alA, false);
    SWAIT(); SWRITE(1, 0); SLOAD(0, 2);
    __syncthreads();
    int sp = 0, sc = 1, sn = 2;
    for (int j = 1; j + 1 < NT; j += 2) {
        if (!MLA_PROBE_NOSTAGE) { SWAIT(); SWRITE(sn, 0); if (j + 2 < NT) SLOAD(0, j + 2); }
        SBAR(); MLA_STEP(pB0, pB1, pA0, pA1, alA, alB);
        __syncthreads();
        sp = sc; sc = sn; sn = ROT3(sn);
        if (!MLA_PROBE_NOSTAGE) { SWAIT(); SWRITE(sn, 0); if (j + 3 < NT) SLOAD(0, j + 3); }
        SBAR(); MLA_STEP(pA0, pA1, pB0, pB1, alB, alA);
        __syncthreads();
        sp = sc; sc = sn; sn = ROT3(sn);
    }
    SBAR(); MLA_STEP(pB0, pB1, pA0, pA1, alA, alB);
    finishSM(pB0, pB1, alB, l_reg, pa0, pa1, pa2, pa3); SBAR();
    { const int vb = vb0 + sc * SHM_V; pv_one_p<0>(o[0], vb, pa0, pa1, pa2, pa3); pv_one_p<1>(o[1], vb, pa0, pa1, pa2, pa3); }
    if (hi == 0) li_l[r32] = l_reg; asm volatile("s_waitcnt lgkmcnt(0)" ::: "memory");
    float rli[16];
#pragma unroll
    for (int r = 0; r < 16; ++r) rli[r] = __builtin_amdgcn_rcpf(li_l[crow(r, hi)]);
    unsigned short* stg = (unsigned short*)(lds + M2_OST) + wid * 2048;
    unsigned short* dst = CAT + ((size_t)b * S + q0 + wid * 32) * 1024 + h * 64;
    store_o_tile(o, rli, stg, dst, [](int row) { return (size_t)row * 1024; }, lane);
    asm volatile("s_waitcnt vmcnt(0)" ::: "memory");
#if MLA_STAMP
    { unsigned long long tu1; STAMP_T(tu1); st_acc[6] = tu1 - tu0;
      if (blockIdx.x == 0 && wid == MLA_STAMP_WAVE && lane == 0 && STAMPS) {
#pragma unroll
          for (int i = 0; i < 8; ++i) STAMPS[i] = st_acc[i]; } }
#endif
    __syncthreads();
#undef SLOAD
#undef SWRITE
#undef SWAIT
#undef RESC
#undef ROT3
}


__device__ __forceinline__ void finishSM_s(f32x16& p0, f32x16& p1, float& l_reg, bf16x8& pa0, bf16x8& pa1, bf16x8& pa2, bf16x8& pa3) {
#pragma unroll
    for (int r = 0; r < 16; ++r) p1[r] = __builtin_amdgcn_exp2f(p1[r]);
    float ps = 0;
#pragma unroll
    for (int r = 0; r < 16; ++r) ps += p0[r];
#pragma unroll
    for (int r = 0; r < 16; ++r) ps += p1[r];
    l_reg += ps;
    PK4(p0, 0, pa0); PK4(p0, 8, pa1); PK4(p1, 0, pa2); PK4(p1, 8, pa3);
}
__device__ __forceinline__ void exp_half(f32x16& p0) {
#pragma unroll
    for (int r = 0; r < 16; ++r) p0[r] = __builtin_amdgcn_exp2f(p0[r]);
}
__device__ __forceinline__ bool mla_unit_v5(int wv, int bh, int qb, const unsigned short* __restrict__ Q, const unsigned short* __restrict__ KN, const unsigned short* __restrict__ KR,
                                            const unsigned short* __restrict__ V, unsigned short* __restrict__ CAT, const float* __restrict__ KMX, char* lds) {
    const int wid = wv, lane = gm::lane_now(), tid = wid * 64 + lane, r32 = lane & 31, hi = lane >> 5;
    const int b = bh >> 3, h = bh & 7;
    char* K_lds = lds + M2_K; char* V_lds = lds + M2_V;
    float* wsf = (float*)(lds + M2_WS) + wid * 64; float* li_l = wsf;
    float l_reg = 0; f32x16 o[2] = {}; bf16x8 qr[6];
    const size_t bhS = (size_t)bh * S; const int q0 = qb * 256;
    const unsigned short* Qw = Q + (bhS + q0 + wid * 32 + r32) * 96 + hi * 8;
#pragma unroll
    for (int d0 = 0; d0 < 6; ++d0) qr[d0] = *reinterpret_cast<const bf16x8*>(Qw + d0 * 16);
    f32x16 negm;
    { float q2 = 0.f;
#pragma unroll
      for (int d0 = 0; d0 < 6; ++d0)
#pragma unroll
          for (int j = 0; j < 8; ++j) { const float x = __uint_as_float((unsigned)(unsigned short)qr[d0][j] << 16); q2 += x * x; }
      { auto rr = __builtin_amdgcn_permlane32_swap(__float_as_uint(q2), __float_as_uint(q2), false, false); q2 = __uint_as_float(rr[0]) + __uint_as_float(rr[1]); }
      const float k2 = KMX[(b * 8 + h) * 2] + KMX[(b * 8 + h) * 2 + 1] + KMX[32 + b];
      const float m = 1.01f * sqrtf(q2 * k2);
#pragma unroll
      for (int r = 0; r < 16; ++r) negm[r] = -m; }
    const int srow = tid >> 3, sch = tid & 7, rrow = (tid & 255) >> 2, rch = tid & 3;
    const char* kn_u = (const char*)(KN + bhS * 64); const char* v_u = (const char*)(V + bhS * 64); const char* kr_u = (const char*)(KR + (size_t)b * S * 32);
    const unsigned kn_off = (unsigned)(srow * 64 + sch * 8) * 2u, kr_off = (unsigned)(rrow * 32 + rch * 8) * 2u;
    const int kst = KSWZ(srow, sch * 16), krst = KSWZ(rrow, (8 + rch) * 16), vst = v_st(srow, sch * 8);
    const int vb0 = (int)(uintptr_t)V_lds + v_rd_base(lane);
    bf16x8 s_kn, s_kr, s_v;
#define SLOAD(t) do { s_kn = *reinterpret_cast<const bf16x8*>(kn_u + (size_t)(t) * 8192 + kn_off); s_kr = *reinterpret_cast<const bf16x8*>(kr_u + (size_t)(t) * 4096 + kr_off); \
    s_v = *reinterpret_cast<const bf16x8*>(v_u + (size_t)(t) * 8192 + kn_off); } while (0)
#define SWRITE(sl) do { *(bf16x8*)(K_lds + (sl) * SHM_K + kst) = s_kn; if (tid < 256) *(bf16x8*)(K_lds + (sl) * SHM_K + krst) = s_kr; *(bf16x8*)(V_lds + (sl) * SHM_V + vst) = s_v; } while (0)
#define SWAIT() asm volatile("s_waitcnt vmcnt(0)" ::: "memory")
#define ROT3(x) ((x) == 2 ? 0 : (x) + 1)
#define STEP5(PC0, PC1, PP0, PP1) do { \
    qkt96n(PC0, PC1, K_lds + sc * SHM_K, qr, negm, r32, hi); \
    finishSM_s(PP0, PP1, l_reg, pa0, pa1, pa2, pa3); SBAR(); \
    { const int vb_ = vb0 + sp * SHM_V; pv_one_p<0>(o[0], vb_, pa0, pa1, pa2, pa3); pv_one_p<1>(o[1], vb_, pa0, pa1, pa2, pa3); } \
    exp_half(PC0); } while (0)
    f32x16 pA0, pA1, pB0, pB1; bf16x8 pa0, pa1, pa2, pa3; constexpr int NT = S / 64;
    SLOAD(0);
    SWAIT(); SWRITE(0); SLOAD(1);
    __syncthreads();
    qkt96n(pA0, pA1, K_lds, qr, negm, r32, hi); exp_half(pA0);
    SWAIT(); SWRITE(1); SLOAD(2);
    __syncthreads();
    int sp = 0, sc = 1, sn = 2;
    for (int j = 1; j + 1 < NT; j += 2) {
        SWAIT(); SWRITE(sn); if (j + 2 < NT) SLOAD(j + 2);
        SBAR(); STEP5(pB0, pB1, pA0, pA1);
        __syncthreads();
        sp = sc; sc = sn; sn = ROT3(sn);
        SWAIT(); SWRITE(sn); if (j + 3 < NT) SLOAD(j + 3);
        SBAR(); STEP5(pA0, pA1, pB0, pB1);
        __syncthreads();
        sp = sc; sc = sn; sn = ROT3(sn);
    }
    SBAR(); STEP5(pB0, pB1, pA0, pA1);
    finishSM_s(pB0, pB1, l_reg, pa0, pa1, pa2, pa3); SBAR();
    { const int vb = vb0 + sc * SHM_V; pv_one_p<0>(o[0], vb, pa0, pa1, pa2, pa3); pv_one_p<1>(o[1], vb, pa0, pa1, pa2, pa3); }
    { auto rr = __builtin_amdgcn_permlane32_swap(__float_as_uint(l_reg), __float_as_uint(l_reg), false, false); l_reg = __uint_as_float(rr[0]) + __uint_as_float(rr[1]); }
    const bool bad = !(l_reg > 1e-30f);
    if (hi == 0) li_l[r32] = l_reg; asm volatile("s_waitcnt lgkmcnt(0)" ::: "memory");
    float rli[16];
#pragma unroll
    for (int r = 0; r < 16; ++r) rli[r] = __builtin_amdgcn_rcpf(li_l[crow(r, hi)]);
    unsigned short* stg = (unsigned short*)(lds + M2_OST) + wid * 2048;
    unsigned short* dst = CAT + ((size_t)b * S + q0 + wid * 32) * 1024 + h * 64;
    store_o_tile(o, rli, stg, dst, [](int row) { return (size_t)row * 1024; }, lane);
    asm volatile("s_waitcnt vmcnt(0)" ::: "memory");
    const int anybad = wg_or(bad, (unsigned*)(lds + 147456 - 512), wid, lane) ? 1 : 0;
    return anybad != 0;
#undef SLOAD
#undef SWRITE
#undef SWAIT
#undef ROT3
#undef STEP5
}

constexpr int M4_K = 0, M4_V = 4 * SHM_K, M4_WS = M4_V + 4 * SHM_V, M4_OST = M4_WS + 8 * 256;
template <bool FIRST> __device__ __forceinline__ void softmax_full(f32x16& p0, f32x16& p1, float& m_reg, f32x16& negm, float& l_reg, float& alpha, bf16x8& pa0, bf16x8& pa1, bf16x8& pa2, bf16x8& pa3, bool exact) {
    if (exact) partialSM2<FIRST>(p0, p1, m_reg, negm, alpha, true); else partialSM2<false>(p0, p1, m_reg, negm, alpha, false);
    finishSM(p0, p1, alpha, l_reg, pa0, pa1, pa2, pa3);
}
__device__ __forceinline__ void mla_unit_v4(int wv, int bh, int qb, const unsigned short* __restrict__ Q, const unsigned short* __restrict__ KN, const unsigned short* __restrict__ KR,
                                            const unsigned short* __restrict__ V, unsigned short* __restrict__ CAT, const float* __restrict__ KMX, char* lds, unsigned long long* STAMPS = nullptr) {
    const int wid = wv, lane = gm::lane_now(), tid = wid * 64 + lane, r32 = lane & 31, hi = lane >> 5;
    const int b = bh >> 3, h = bh & 7; const bool halfB = wid >= 4;
    char* K_lds = lds + M4_K; char* V_lds = lds + M4_V;
    float* wsf = (float*)(lds + M4_WS) + wid * 64; float* li_l = wsf; float* al_l = wsf + 32;
    float m_reg = 0.f, l_reg = 0; f32x16 o[2] = {}; bf16x8 qr[6]; f32x16 negm = f32x16{};
    const size_t bhS = (size_t)bh * S; const int q0 = qb * 256;
    const unsigned short* Qw = Q + (bhS + q0 + wid * 32 + r32) * 96 + hi * 8;
#pragma unroll
    for (int d0 = 0; d0 < 6; ++d0) qr[d0] = *reinterpret_cast<const bf16x8*>(Qw + d0 * 16);
    bool exact = true;
    if (MLA_STATIC) { float q2 = 0.f;
#pragma unroll
      for (int d0 = 0; d0 < 6; ++d0)
#pragma unroll
          for (int j = 0; j < 8; ++j) { const float x = __uint_as_float((unsigned)(unsigned short)qr[d0][j] << 16); q2 += x * x; }
      { auto rr = __builtin_amdgcn_permlane32_swap(__float_as_uint(q2), __float_as_uint(q2), false, false); q2 = __uint_as_float(rr[0]) + __uint_as_float(rr[1]); }
      const float k2 = KMX[(b * 8 + h) * 2] + KMX[(b * 8 + h) * 2 + 1] + KMX[32 + b];
      const float ms = 1.01f * sqrtf(q2 * k2);
      exact = wg_or(!(ms <= MLA_STATIC_THR), (unsigned*)(lds + 147456 - 512), wid, lane);
      if (!exact) { m_reg = ms;
#pragma unroll
          for (int r = 0; r < 16; ++r) negm[r] = -ms; } }
    const int srow = tid >> 3, sch = tid & 7, rrow = (tid & 255) >> 2, rch = tid & 3;
    const char* kn_u = (const char*)(KN + bhS * 64); const char* v_u = (const char*)(V + bhS * 64); const char* kr_u = (const char*)(KR + (size_t)b * S * 32);
    const unsigned kn_off = (unsigned)(srow * 64 + sch * 8) * 2u, kr_off = (unsigned)(rrow * 32 + rch * 8) * 2u;
    const int kst = KSWZ(srow, sch * 16), krst = KSWZ(rrow, (8 + rch) * 16), vst = v_st(srow, sch * 8);
    const int vb0 = (int)(uintptr_t)V_lds + v_rd_base(lane);
    bf16x8 s_kn, s_kr, s_v;
#define SLOAD(t) do { s_kn = *reinterpret_cast<const bf16x8*>(kn_u + (size_t)(t) * 8192 + kn_off); s_kr = *reinterpret_cast<const bf16x8*>(kr_u + (size_t)(t) * 4096 + kr_off); \
    s_v = *reinterpret_cast<const bf16x8*>(v_u + (size_t)(t) * 8192 + kn_off); } while (0)
#define SWRITE(sl) do { *(bf16x8*)(K_lds + (sl) * SHM_K + kst) = s_kn; if (tid < 256) *(bf16x8*)(K_lds + (sl) * SHM_K + krst) = s_kr; *(bf16x8*)(V_lds + (sl) * SHM_V + vst) = s_v; } while (0)
#define SWAIT() asm volatile("s_waitcnt vmcnt(0)" ::: "memory")
#define RESC(a) do { if (exact && __any((a) < 1.f)) { if (hi == 0) al_l[r32] = (a); asm volatile("s_waitcnt lgkmcnt(0)" ::: "memory"); \
    _Pragma("unroll") for (int d = 0; d < 2; ++d) _Pragma("unroll") for (int r = 0; r < 16; ++r) o[d][r] *= al_l[crow(r, hi)]; } } while (0)
#define RAWBAR() do { asm volatile("" ::: "memory"); __builtin_amdgcn_s_barrier(); asm volatile("" ::: "memory"); } while (0)
    f32x16 p0, p1; float al; bf16x8 pa0, pa1, pa2, pa3; bf16x8 kf[12]; constexpr int NT = S / 64;
#if MLA_STAMP
    unsigned long long st_acc[8] = {0, 0, 0, 0, 0, 0, 0, 0}, tq0 = 0, tq1 = 0, tu0 = 0; STAMP_T(tu0);
#endif
    SLOAD(0); SWAIT(); SWRITE(0); SLOAD(1); SWAIT(); SWRITE(1); SLOAD(2);
    asm volatile("s_waitcnt lgkmcnt(0)" ::: "memory"); RAWBAR();
    if (halfB) RAWBAR();
    kfrag_load(kf, K_lds, r32, hi); SBAR();
    qk_mma(p0, p1, kf, qr, negm); SBAR();
    asm volatile("s_waitcnt lgkmcnt(0)" ::: "memory"); RAWBAR();
    softmax_full<true>(p0, p1, m_reg, negm, l_reg, al, pa0, pa1, pa2, pa3, exact); SBAR();
    SWAIT(); SWRITE(2); SLOAD(3); SBAR();
    kfrag_load(kf, K_lds + SHM_K, r32, hi); SBAR();
    asm volatile("s_waitcnt lgkmcnt(12)" ::: "memory"); RAWBAR();
    int sp = 0, sc = 1, sw = 3;
    for (int t = 1; t < NT; ++t) {
        STAMP_T(tq0);
        { s16x4 val[4], vah[4], vbl[4], vbh[4]; const int vb_ = vb0 + sp * SHM_V;
          vfrag_load_h<0>(val, vah, vb_); SBAR();
          qk_mma(p0, p1, kf, qr, negm); SBAR();
          vfrag_load_h<1>(vbl, vbh, vb_); SBAR();
          asm volatile("s_waitcnt lgkmcnt(8)" ::: "memory"); SBAR();
          pv_mma_h(o[0], val, vah, pa0, pa1, pa2, pa3); SBAR();
          asm volatile("s_waitcnt lgkmcnt(0)" ::: "memory"); SBAR();
          pv_mma_h(o[1], vbl, vbh, pa0, pa1, pa2, pa3); SBAR(); }
        STAMP_T(tq1); STAMP_ACC(1, tq0, tq1);
        RAWBAR();
        STAMP_T(tq0); STAMP_ACC(2, tq1, tq0);
        if (t + 2 < NT) { SWAIT(); SWRITE(sw); if (t + 3 < NT) SLOAD(t + 3); } SBAR();
        softmax_full<false>(p0, p1, m_reg, negm, l_reg, al, pa0, pa1, pa2, pa3, exact); RESC(al); SBAR();
        sp = sc; sc = (sc + 1) & 3; sw = (sw + 1) & 3;
        if (t + 1 < NT) { kfrag_load(kf, K_lds + sc * SHM_K, r32, hi); SBAR(); }
        STAMP_T(tq1); STAMP_ACC(3, tq0, tq1);
        asm volatile("s_waitcnt lgkmcnt(12)" ::: "memory"); RAWBAR();
        STAMP_T(tq0); STAMP_ACC(4, tq1, tq0);
    }
    { s16x4 val[4], vah[4], vbl[4], vbh[4]; const int vb_ = vb0 + sp * SHM_V;
      vfrag_load_h<0>(val, vah, vb_); vfrag_load_h<1>(vbl, vbh, vb_); SBAR();
      asm volatile("s_waitcnt lgkmcnt(0)" ::: "memory"); SBAR();
      pv_mma_h(o[0], val, vah, pa0, pa1, pa2, pa3); pv_mma_h(o[1], vbl, vbh, pa0, pa1, pa2, pa3); SBAR(); }
    if (!halfB) RAWBAR();
    if (hi == 0) li_l[r32] = l_reg; asm volatile("s_waitcnt lgkmcnt(0)" ::: "memory");
    float rli[16];
#pragma unroll
    for (int r = 0; r < 16; ++r) rli[r] = __builtin_amdgcn_rcpf(li_l[crow(r, hi)]);
    unsigned short* stg = (unsigned short*)(lds + M4_OST) + wid * 2048;
    unsigned short* dst = CAT + ((size_t)b * S + q0 + wid * 32) * 1024 + h * 64;
    store_o_tile(o, rli, stg, dst, [](int row) { return (size_t)row * 1024; }, lane);
    asm volatile("s_waitcnt vmcnt(0)" ::: "memory");
#if MLA_STAMP
    { unsigned long long tu1; STAMP_T(tu1); st_acc[6] = tu1 - tu0;
      if (blockIdx.x == 0 && wid == MLA_STAMP_WAVE && lane == 0 && STAMPS) {
#pragma unroll
          for (int i = 0; i < 8; ++i) STAMPS[i] = st_acc[i]; } }
#endif
    __syncthreads();
#undef SLOAD
#undef SWRITE
#undef SWAIT
#undef RESC
#undef RAWBAR
}


constexpr int M6_K = 0, M6_V = 4 * SHM_K, M6_WS = M6_V + 4 * SHM_V, M6_OST = M6_WS + 8 * 256;
#define KLD3(dst, Ks_, D0) do { _Pragma("unroll") for (int d_ = 0; d_ < 3; ++d_) { const int cb_ = (((D0) + d_) * 16 + hi * 8) * 2; \
        dst[2 * d_] = *reinterpret_cast<const bf16x8*>((Ks_) + KSWZ(r32, cb_)); dst[2 * d_ + 1] = *reinterpret_cast<const bf16x8*>((Ks_) + KSWZ(32 + r32, cb_)); } } while (0)
#define MF32(A, B, C) __builtin_amdgcn_mfma_f32_32x32x16_bf16(A, B, C, 0, 0, 0)
#define QK_ADD(DST, KF, QF, CIN, PPX, B) do { DST = MF32(KF, QF, CIN); s0 += PPX[B]; s1 += PPX[B + 1]; s2 += PPX[B + 2]; s3 += PPX[B + 3]; SBAR(); } while (0)
#define QK_PK(DST, KF, QF, CIN, PPX, B, OUT) do { DST = MF32(KF, QF, CIN); PK4(PPX, B, OUT); SBAR(); } while (0)
__device__ __forceinline__ void mla_unit_v6(int wv, int bh, int qb, const unsigned short* __restrict__ Q, const unsigned short* __restrict__ KN, const unsigned short* __restrict__ KR,
                                            const unsigned short* __restrict__ V, unsigned short* __restrict__ CAT, const float* __restrict__ KMX, char* lds) {
    const int wid = wv, lane = gm::lane_now(), tid = wid * 64 + lane, r32 = lane & 31, hi = lane >> 5;
    const int b = bh >> 3, h = bh & 7; const bool halfB = wid >= 4;
    char* K_lds = lds + M6_K; char* V_lds = lds + M6_V;
    float* wsf = (float*)(lds + M6_WS) + wid * 64; float* li_l = wsf; float* al_l = wsf + 32;
    float m_reg = 0.f, l_reg = 0; f32x16 o[2] = {}; bf16x8 qr[6]; f32x16 negm = f32x16{};
    const size_t bhS = (size_t)bh * S; const int q0 = qb * 256;
    const unsigned short* Qw = Q + (bhS + q0 + wid * 32 + r32) * 96 + hi * 8;
#pragma unroll
    for (int d0 = 0; d0 < 6; ++d0) qr[d0] = *reinterpret_cast<const bf16x8*>(Qw + d0 * 16);
    bool exact = true;
    if (MLA_STATIC) { float q2 = 0.f;
#pragma unroll
      for (int d0 = 0; d0 < 6; ++d0)
#pragma unroll
          for (int j = 0; j < 8; ++j) { const float x = __uint_as_float((unsigned)(unsigned short)qr[d0][j] << 16); q2 += x * x; }
      { auto rr = __builtin_amdgcn_permlane32_swap(__float_as_uint(q2), __float_as_uint(q2), false, false); q2 = __uint_as_float(rr[0]) + __uint_as_float(rr[1]); }
      const float k2 = KMX[(b * 8 + h) * 2] + KMX[(b * 8 + h) * 2 + 1] + KMX[32 + b];
      const float ms = 1.01f * sqrtf(q2 * k2);
      exact = wg_or(!(ms <= MLA_STATIC_THR), (unsigned*)(lds + 147456 - 512), wid, lane);
      if (!exact) { m_reg = ms;
#pragma unroll
          for (int r = 0; r < 16; ++r) negm[r] = -ms; } }
    const int srow = tid >> 3, sch = tid & 7, rrow = (tid & 255) >> 2, rch = tid & 3;
    const char* kn_u = (const char*)(KN + bhS * 64); const char* v_u = (const char*)(V + bhS * 64); const char* kr_u = (const char*)(KR + (size_t)b * S * 32);
    const unsigned kn_off = (unsigned)(srow * 64 + sch * 8) * 2u, kr_off = (unsigned)(rrow * 32 + rch * 8) * 2u;
    const int kst = KSWZ(srow, sch * 16), krst = KSWZ(rrow, (8 + rch) * 16), vst = v_st(srow, sch * 8);
    const int vb0 = (int)(uintptr_t)V_lds + v_rd_base(lane);
    bf16x8 s_kn, s_kr, s_v;
#define SLOAD(t) do { s_kn = *reinterpret_cast<const bf16x8*>(kn_u + (size_t)(t) * 8192 + kn_off); s_kr = *reinterpret_cast<const bf16x8*>(kr_u + (size_t)(t) * 4096 + kr_off); \
    s_v = *reinterpret_cast<const bf16x8*>(v_u + (size_t)(t) * 8192 + kn_off); } while (0)
#define SWRITE(sl) do { *(bf16x8*)(K_lds + (sl) * SHM_K + kst) = s_kn; if (tid < 256) *(bf16x8*)(K_lds + (sl) * SHM_K + krst) = s_kr; *(bf16x8*)(V_lds + (sl) * SHM_V + vst) = s_v; } while (0)
#define SWAIT() asm volatile("s_waitcnt vmcnt(0)" ::: "memory")
#define RESC(a) do { if (exact && __any((a) < 1.f)) { if (hi == 0) al_l[r32] = (a); asm volatile("s_waitcnt lgkmcnt(0)" ::: "memory"); l_reg *= (a); \
    _Pragma("unroll") for (int d = 0; d < 2; ++d) _Pragma("unroll") for (int r = 0; r < 16; ++r) o[d][r] *= al_l[crow(r, hi)]; } } while (0)
#define RAWBAR() do { asm volatile("" ::: "memory"); __builtin_amdgcn_s_barrier(); asm volatile("" ::: "memory"); } while (0)
#define EXP_TILE(P0, P1, FIRST_) do { float al_ = 1.f; \
        if (exact) { const float pmax = rowmax32b(P0, P1); \
            if ((FIRST_) || !__builtin_expect(__all(pmax <= THR), 1)) { const float dl = (FIRST_) ? pmax : fmaxf(pmax, 0.f); m_reg += dl; \
                _Pragma("unroll") for (int r = 0; r < 16; ++r) { P0[r] -= dl; P1[r] -= dl; } \
                _Pragma("unroll") for (int r = 0; r < 16; ++r) negm[r] = -m_reg; \
                if (!(FIRST_)) al_ = __builtin_amdgcn_exp2f(-dl); } } \
        _Pragma("unroll") for (int r = 0; r < 16; ++r) P0[r] = __builtin_amdgcn_exp2f(P0[r]); \
        _Pragma("unroll") for (int r = 0; r < 16; ++r) P1[r] = __builtin_amdgcn_exp2f(P1[r]); \
        RESC(al_); } while (0)
#define M_PART(PC0, PC1, PP0, PP1) do { \
        s16x4 val[4], vah[4], vbl[4], vbh[4]; const int vb_ = vb0 + sp * SHM_V; float s0 = 0.f, s1 = 0.f, s2 = 0.f, s3 = 0.f; \
        KLD3(kb, K_lds + sc * SHM_K, 3); SBAR(); \
        QK_ADD(PC0, ka[0], qr[0], negm, PP0, 0);  QK_ADD(PC1, ka[1], qr[0], negm, PP0, 4); \
        QK_ADD(PC0, ka[2], qr[1], PC0, PP0, 8);   QK_ADD(PC1, ka[3], qr[1], PC1, PP0, 12); \
        QK_ADD(PC0, ka[4], qr[2], PC0, PP1, 0);   QK_ADD(PC1, ka[5], qr[2], PC1, PP1, 4); \
        vfrag_load_h<0>(val, vah, vb_); vfrag_load_h<1>(vbl, vbh, vb_); SBAR(); \
        QK_ADD(PC0, kb[0], qr[3], PC0, PP1, 8);   QK_ADD(PC1, kb[1], qr[3], PC1, PP1, 12); \
        QK_PK(PC0, kb[2], qr[4], PC0, PP0, 0, pa0); QK_PK(PC1, kb[3], qr[4], PC1, PP0, 8, pa1); \
        QK_PK(PC0, kb[4], qr[5], PC0, PP1, 0, pa2); QK_PK(PC1, kb[5], qr[5], PC1, PP1, 8, pa3); \
        { float ps = (s0 + s1) + (s2 + s3); auto rr = __builtin_amdgcn_permlane32_swap(__float_as_uint(ps), __float_as_uint(ps), false, false); l_reg += __uint_as_float(rr[0]) + __uint_as_float(rr[1]); } \
        asm volatile("s_waitcnt lgkmcnt(0)" ::: "memory"); SBAR(); \
        pv_mma_h(o[0], val, vah, pa0, pa1, pa2, pa3); pv_mma_h(o[1], vbl, vbh, pa0, pa1, pa2, pa3); SBAR(); } while (0)
#define V_PART(PC0, PC1, t_) do { \
        if ((t_) + 2 < NT) { SWAIT(); SWRITE(sw); if ((t_) + 3 < NT) SLOAD((t_) + 3); } SBAR(); \
        EXP_TILE(PC0, PC1, false); SBAR(); \
        sp = sc; sc = (sc + 1) & 3; sw = (sw + 1) & 3; \
        if ((t_) + 1 < NT) { KLD3(ka, K_lds + sc * SHM_K, 0); SBAR(); } \
        asm volatile("s_waitcnt lgkmcnt(6)" ::: "memory"); RAWBAR(); } while (0)
    f32x16 pA0, pA1, pB0, pB1; bf16x8 pa0, pa1, pa2, pa3; bf16x8 ka[6], kb[6]; constexpr int NT = S / 64;
    SLOAD(0); SWAIT(); SWRITE(0); SLOAD(1); SWAIT(); SWRITE(1); SLOAD(2);
    asm volatile("s_waitcnt lgkmcnt(0)" ::: "memory"); RAWBAR();
    if (halfB) RAWBAR();
    KLD3(ka, K_lds, 0); KLD3(kb, K_lds, 3); SBAR();
    pA0 = MF32(ka[0], qr[0], negm); pA1 = MF32(ka[1], qr[0], negm); pA0 = MF32(ka[2], qr[1], pA0); pA1 = MF32(ka[3], qr[1], pA1); pA0 = MF32(ka[4], qr[2], pA0); pA1 = MF32(ka[5], qr[2], pA1);
    pA0 = MF32(kb[0], qr[3], pA0); pA1 = MF32(kb[1], qr[3], pA1); pA0 = MF32(kb[2], qr[4], pA0); pA1 = MF32(kb[3], qr[4], pA1); pA0 = MF32(kb[4], qr[5], pA0); pA1 = MF32(kb[5], qr[5], pA1); SBAR();
    asm volatile("s_waitcnt lgkmcnt(0)" ::: "memory"); RAWBAR();
    int sp = 0, sc = 0, sw = 2;
    SWAIT(); SWRITE(2); SLOAD(3); SBAR();
    EXP_TILE(pA0, pA1, true); SBAR();
    sp = 0; sc = 1; sw = 3;
    KLD3(ka, K_lds + SHM_K, 0); SBAR();
    asm volatile("s_waitcnt lgkmcnt(6)" ::: "memory"); RAWBAR();
    for (int t = 1; t + 1 < NT; t += 2) {
        M_PART(pB0, pB1, pA0, pA1); RAWBAR(); V_PART(pB0, pB1, t);
        M_PART(pA0, pA1, pB0, pB1); RAWBAR(); V_PART(pA0, pA1, t + 1);
    }
    M_PART(pB0, pB1, pA0, pA1); RAWBAR(); V_PART(pB0, pB1, NT - 1);
    { s16x4 val[4], vah[4], vbl[4], vbh[4]; const int vb_ = vb0 + sp * SHM_V; float ps = 0.f;
      vfrag_load_h<0>(val, vah, vb_); vfrag_load_h<1>(vbl, vbh, vb_); SBAR();
#pragma unroll
      for (int r = 0; r < 16; ++r) ps += pB0[r] + pB1[r];
      { auto rr = __builtin_amdgcn_permlane32_swap(__float_as_uint(ps), __float_as_uint(ps), false, false); l_reg += __uint_as_float(rr[0]) + __uint_as_float(rr[1]); }
      PK4(pB0, 0, pa0); PK4(pB0, 8, pa1); PK4(pB1, 0, pa2); PK4(pB1, 8, pa3);
      asm volatile("s_waitcnt lgkmcnt(0)" ::: "memory"); SBAR();
      pv_mma_h(o[0], val, vah, pa0, pa1, pa2, pa3); pv_mma_h(o[1], vbl, vbh, pa0, pa1, pa2, pa3); SBAR(); }
    if (!halfB) RAWBAR();
    if (hi == 0) li_l[r32] = l_reg; asm volatile("s_waitcnt lgkmcnt(0)" ::: "memory");
    float rli[16];
#pragma unroll
    for (int r = 0; r < 16; ++r) rli[r] = __builtin_amdgcn_rcpf(li_l[crow(r, hi)]);
    unsigned short* stg = (unsigned short*)(lds + M6_OST) + wid * 2048;
    unsigned short* dst = CAT + ((size_t)b * S + q0 + wid * 32) * 1024 + h * 64;
    store_o_tile(o, rli, stg, dst, [](int row) { return (size_t)row * 1024; }, lane);
    asm volatile("s_waitcnt vmcnt(0)" ::: "memory");
    __syncthreads();
#undef SLOAD
#undef SWRITE
#undef SWAIT
#undef RESC
#undef RAWBAR
#undef EXP_TILE
#undef M_PART
#undef V_PART
}


#define PV_EXP(OD, PA, VL, VH, PCX, B) do { OD = MF32(PA, PKV(VL, VH), OD); PCX[B] = __builtin_amdgcn_exp2f(PCX[B]); PCX[B + 1] = __builtin_amdgcn_exp2f(PCX[B + 1]); \
        PCX[B + 2] = __builtin_amdgcn_exp2f(PCX[B + 2]); PCX[B + 3] = __builtin_amdgcn_exp2f(PCX[B + 3]); asm volatile("" : "+v"(PCX)); SBAR(); } while (0)
__device__ __forceinline__ void mla_unit_v7(int wv, int bh, int qb, const unsigned short* __restrict__ Q, const unsigned short* __restrict__ KN, const unsigned short* __restrict__ KR,
                                            const unsigned short* __restrict__ V, unsigned short* __restrict__ CAT, const float* __restrict__ KMX, char* lds, unsigned long long* STAMPS = nullptr) {
    const int wid = wv, lane = gm::lane_now(), tid = wid * 64 + lane, r32 = lane & 31, hi = lane >> 5;
    const int b = bh >> 3, h = bh & 7;
    char* K_lds = lds + M6_K; char* V_lds = lds + M6_V;
    float* wsf = (float*)(lds + M6_WS) + wid * 64; float* li_l = wsf; float* al_l = wsf + 32;
    float m_reg = 0.f, l_reg = 0; f32x16 o[2] = {}; bf16x8 qr[6]; f32x16 negm = f32x16{};
    const size_t bhS = (size_t)bh * S; const int q0 = qb * 256;
    const unsigned short* Qw = Q + (bhS + q0 + wid * 32 + r32) * 96 + hi * 8;
#pragma unroll
    for (int d0 = 0; d0 < 6; ++d0) qr[d0] = *reinterpret_cast<const bf16x8*>(Qw + d0 * 16);
    bool exact = true;
    if (MLA_STATIC) { float q2 = 0.f;
#pragma unroll
      for (int d0 = 0; d0 < 6; ++d0)
#pragma unroll
          for (int j = 0; j < 8; ++j) { const float x = __uint_as_float((unsigned)(unsigned short)qr[d0][j] << 16); q2 += x * x; }
      { auto rr = __builtin_amdgcn_permlane32_swap(__float_as_uint(q2), __float_as_uint(q2), false, false); q2 = __uint_as_float(rr[0]) + __uint_as_float(rr[1]); }
      const float k2 = KMX[(b * 8 + h) * 2] + KMX[(b * 8 + h) * 2 + 1] + KMX[32 + b];
      const float ms = 1.01f * sqrtf(q2 * k2);
      exact = wg_or(!(ms <= MLA_STATIC_THR), (unsigned*)(lds + 147456 - 512), wid, lane);
      if (!exact) { m_reg = ms;
#pragma unroll
          for (int r = 0; r < 16; ++r) negm[r] = -ms; } }
    const int srow = tid >> 3, sch = tid & 7, rrow = (tid & 255) >> 2, rch = tid & 3;
    const char* kn_u = (const char*)(KN + bhS * 64); const char* v_u = (const char*)(V + bhS * 64); const char* kr_u = (const char*)(KR + (size_t)b * S * 32);
    const unsigned kn_off = (unsigned)(srow * 64 + sch * 8) * 2u, kr_off = (unsigned)(rrow * 32 + rch * 8) * 2u;
    const int kst = KSWZ(srow, sch * 16), krst = KSWZ(rrow, (8 + rch) * 16), vst = v_st(srow, sch * 8);
    const int vb0 = (int)(uintptr_t)V_lds + v_rd_base(lane);
    bf16x8 s_kn, s_kr, s_v;
#define SLOAD(t) do { s_kn = *reinterpret_cast<const bf16x8*>(kn_u + (size_t)(t) * 8192 + kn_off); s_kr = *reinterpret_cast<const bf16x8*>(kr_u + (size_t)(t) * 4096 + kr_off); \
    s_v = *reinterpret_cast<const bf16x8*>(v_u + (size_t)(t) * 8192 + kn_off); } while (0)
#define SWRITE(sl) do { *(bf16x8*)(K_lds + (sl) * SHM_K + kst) = s_kn; if (tid < 256) *(bf16x8*)(K_lds + (sl) * SHM_K + krst) = s_kr; *(bf16x8*)(V_lds + (sl) * SHM_V + vst) = s_v; } while (0)
#define SWAIT() asm volatile("s_waitcnt vmcnt(0)" ::: "memory")
#define RAWBAR() do { asm volatile("" ::: "memory"); __builtin_amdgcn_s_barrier(); asm volatile("" ::: "memory"); } while (0)
#define MAX_TILE(P0, P1, FIRST_, AL_) do { AL_ = 1.f; \
        if (V7_EXACT && exact) { const float pmax = rowmax32b(P0, P1); \
            if ((FIRST_) || !__builtin_expect(__all(pmax <= THR), 1)) { const float dl = (FIRST_) ? pmax : fmaxf(pmax, 0.f); m_reg += dl; \
                _Pragma("unroll") for (int r = 0; r < 16; ++r) { P0[r] -= dl; P1[r] -= dl; } \
                _Pragma("unroll") for (int r = 0; r < 16; ++r) negm[r] = -m_reg; \
                if (!(FIRST_)) AL_ = __builtin_amdgcn_exp2f(-dl); } } } while (0)
#define RESC7(a) do { if (V7_EXACT && exact && __any((a) < 1.f)) { if (hi == 0) al_l[r32] = (a); asm volatile("s_waitcnt lgkmcnt(0)" ::: "memory"); l_reg *= (a); \
    _Pragma("unroll") for (int d = 0; d < 2; ++d) _Pragma("unroll") for (int r = 0; r < 16; ++r) o[d][r] *= al_l[crow(r, hi)]; } } while (0)
#define STEP7(PC0, PC1, PP0, PP1, t_) do { \
        s16x4 val[4], vah[4], vbl[4], vbh[4]; const int vb_ = vb0 + sp * SHM_V; float s0 = 0.f, s1 = 0.f, s2 = 0.f, s3 = 0.f, al_; \
        SEC_B(0); if ((t_) + 2 < NT) { SWAIT(); SWRITE(sw); if ((t_) + 3 < NT) SLOAD((t_) + 3); } SEC_E(0); \
        SEC_B(1); KLD3(kb, K_lds + sc * SHM_K, 3); SBAR(); \
        QK_ADD(PC0, ka[0], qr[0], negm, PP0, 0);  QK_ADD(PC1, ka[1], qr[0], negm, PP0, 4); \
        QK_ADD(PC0, ka[2], qr[1], PC0, PP0, 8);   QK_ADD(PC1, ka[3], qr[1], PC1, PP0, 12); \
        QK_ADD(PC0, ka[4], qr[2], PC0, PP1, 0);   QK_ADD(PC1, ka[5], qr[2], PC1, PP1, 4); \
        vfrag_load_h<0>(val, vah, vb_); SBAR(); \
        QK_ADD(PC0, kb[0], qr[3], PC0, PP1, 8);   QK_ADD(PC1, kb[1], qr[3], PC1, PP1, 12); \
        QK_PK(PC0, kb[2], qr[4], PC0, PP0, 0, pa0); QK_PK(PC1, kb[3], qr[4], PC1, PP0, 8, pa1); \
        vfrag_load_h<1>(vbl, vbh, vb_); SBAR(); \
        QK_PK(PC0, kb[4], qr[5], PC0, PP1, 0, pa2); QK_PK(PC1, kb[5], qr[5], PC1, PP1, 8, pa3); \
        { float ps = (s0 + s1) + (s2 + s3); auto rr = __builtin_amdgcn_permlane32_swap(__float_as_uint(ps), __float_as_uint(ps), false, false); l_reg += __uint_as_float(rr[0]) + __uint_as_float(rr[1]); } \
        MAX_TILE(PC0, PC1, false, al_); SEC_E(1); \
        SEC_B(4); sp = sc; sc = (sc + 1) & 3; sw = (sw + 1) & 3; \
        if ((t_) + 1 < NT) KLD3(ka, K_lds + sc * SHM_K, 0); \
        asm volatile("s_waitcnt lgkmcnt(6)" ::: "memory"); SBAR(); SEC_E(4); SEC_B(2); \
        PV_EXP(o[0], pa0, val[0], vah[0], PC0, 0);  PV_EXP(o[1], pa0, vbl[0], vbh[0], PC0, 4); \
        PV_EXP(o[0], pa1, val[1], vah[1], PC0, 8);  PV_EXP(o[1], pa1, vbl[1], vbh[1], PC0, 12); \
        PV_EXP(o[0], pa2, val[2], vah[2], PC1, 0);  PV_EXP(o[1], pa2, vbl[2], vbh[2], PC1, 4); \
        PV_EXP(o[0], pa3, val[3], vah[3], PC1, 8);  PV_EXP(o[1], pa3, vbl[3], vbh[3], PC1, 12); \
        RESC7(al_); SEC_E(2); \
        SEC_B(3); RAWBAR(); SEC_E(3); } while (0)
    f32x16 pA0, pA1, pB0, pB1; bf16x8 pa0, pa1, pa2, pa3; bf16x8 ka[6], kb[6]; constexpr int NT = S / 64;
#if MLA_STAMP
    unsigned long long st_a = 0, tq0 = 0, tq1 = 0;
#endif

    if (V7_YOUNG_PRIO && wid >= 4) __builtin_amdgcn_s_setprio(1);
    SLOAD(0); SWAIT(); SWRITE(0); SLOAD(1); SWAIT(); SWRITE(1); SLOAD(2);
    asm volatile("s_waitcnt lgkmcnt(0)" ::: "memory"); RAWBAR();
    KLD3(ka, K_lds, 0); KLD3(kb, K_lds, 3); SBAR();
    pA0 = MF32(ka[0], qr[0], negm); pA1 = MF32(ka[1], qr[0], negm); pA0 = MF32(ka[2], qr[1], pA0); pA1 = MF32(ka[3], qr[1], pA1); pA0 = MF32(ka[4], qr[2], pA0); pA1 = MF32(ka[5], qr[2], pA1);
    pA0 = MF32(kb[0], qr[3], pA0); pA1 = MF32(kb[1], qr[3], pA1); pA0 = MF32(kb[2], qr[4], pA0); pA1 = MF32(kb[3], qr[4], pA1); pA0 = MF32(kb[4], qr[5], pA0); pA1 = MF32(kb[5], qr[5], pA1); SBAR();
    { float al0; MAX_TILE(pA0, pA1, true, al0); (void)al0; }
#pragma unroll
    for (int r = 0; r < 16; ++r) { pA0[r] = __builtin_amdgcn_exp2f(pA0[r]); pA1[r] = __builtin_amdgcn_exp2f(pA1[r]); }
    SWAIT(); SWRITE(2); SLOAD(3);
    int sp = 0, sc = 1, sw = 3;
    KLD3(ka, K_lds + SHM_K, 0);
    asm volatile("s_waitcnt lgkmcnt(6)" ::: "memory"); RAWBAR();
    for (int t = 1; t + 1 < NT; t += 2) { STEP7(pB0, pB1, pA0, pA1, t); STEP7(pA0, pA1, pB0, pB1, t + 1); }
    STEP7(pB0, pB1, pA0, pA1, NT - 1);
    { s16x4 val[4], vah[4], vbl[4], vbh[4]; const int vb_ = vb0 + sp * SHM_V; float ps = 0.f;
      vfrag_load_h<0>(val, vah, vb_); vfrag_load_h<1>(vbl, vbh, vb_); SBAR();
#pragma unroll
      for (int r = 0; r < 16; ++r) ps += pB0[r] + pB1[r];
      { auto rr = __builtin_amdgcn_permlane32_swap(__float_as_uint(ps), __float_as_uint(ps), false, false); l_reg += __uint_as_float(rr[0]) + __uint_as_float(rr[1]); }
      PK4(pB0, 0, pa0); PK4(pB0, 8, pa1); PK4(pB1, 0, pa2); PK4(pB1, 8, pa3);
      asm volatile("s_waitcnt lgkmcnt(0)" ::: "memory"); SBAR();
      pv_mma_h(o[0], val, vah, pa0, pa1, pa2, pa3); pv_mma_h(o[1], vbl, vbh, pa0, pa1, pa2, pa3); SBAR(); }
    if (V7_YOUNG_PRIO) __builtin_amdgcn_s_setprio(0);
    if (hi == 0) li_l[r32] = l_reg; asm volatile("s_waitcnt lgkmcnt(0)" ::: "memory");
    float rli[16];
#pragma unroll
    for (int r = 0; r < 16; ++r) rli[r] = __builtin_amdgcn_rcpf(li_l[crow(r, hi)]);
    unsigned short* stg = (unsigned short*)(lds + M6_OST) + wid * 2048;
    unsigned short* dst = CAT + ((size_t)b * S + q0 + wid * 32) * 1024 + h * 64;
    store_o_tile(o, rli, stg, dst, [](int row) { return (size_t)row * 1024; }, lane);
    asm volatile("s_waitcnt vmcnt(0)" ::: "memory");
#if MLA_STAMP
#if MLA_STAMP
    if (blockIdx.x == 0 && wid == MLA_STAMP_WAVE && lane == 0 && STAMPS) STAMPS[0] = st_a;
#endif
    (void)STAMPS;
#endif
    __syncthreads();
#undef SLOAD
#undef SWRITE
#undef SWAIT
#undef RAWBAR
#undef MAX_TILE
#undef RESC7
#undef STEP7
}

#define PV_EXP9(OD, PA, VL, VH, PCX, B) do { OD = MF32(PA, PKV(VL, VH), OD); PCX[B] = __builtin_amdgcn_exp2f(PCX[B]); PCX[B + 1] = __builtin_amdgcn_exp2f(PCX[B + 1]); \
        PCX[B + 2] = __builtin_amdgcn_exp2f(PCX[B + 2]); PCX[B + 3] = __builtin_amdgcn_exp2f(PCX[B + 3]); asm volatile("" : "+v"(PCX)); SBAR(); } while (0)
__device__ __forceinline__ void mla_unit_v9(int wv, int bh, int qb, const unsigned short* __restrict__ Q, const unsigned short* __restrict__ KN, const unsigned short* __restrict__ KR,
                                            const unsigned short* __restrict__ V, unsigned short* __restrict__ CAT, const float* __restrict__ KMX, char* lds, unsigned long long* STAMPS = nullptr) {
    const int wid = wv, lane = gm::lane_now(), tid = wid * 64 + lane, r32 = lane & 31, hi = lane >> 5;
    const int b = bh >> 3, h = bh & 7; const bool halfB = wid >= 4;
    char* K_lds = lds; char* V_lds = lds + 5 * SHM_K;
    float* wsf = (float*)(lds + 5 * SHM_K + 5 * SHM_V) + wid * 64; float* li_l = wsf; float* al_l = wsf + 32;
    float m_reg = 0.f, l_reg = 0; f32x16 o[2] = {}; bf16x8 qr[6]; f32x16 negm = f32x16{};
    const size_t bhS = (size_t)bh * S; const int q0 = qb * 256;
    const unsigned short* Qw = Q + (bhS + q0 + wid * 32 + r32) * 96 + hi * 8;
#pragma unroll
    for (int d0 = 0; d0 < 6; ++d0) qr[d0] = *reinterpret_cast<const bf16x8*>(Qw + d0 * 16);
    bool exact = true;
    if (MLA_STATIC) { float q2 = 0.f;
#pragma unroll
      for (int d0 = 0; d0 < 6; ++d0)
#pragma unroll
          for (int j = 0; j < 8; ++j) { const float x = __uint_as_float((unsigned)(unsigned short)qr[d0][j] << 16); q2 += x * x; }
      { auto rr = __builtin_amdgcn_permlane32_swap(__float_as_uint(q2), __float_as_uint(q2), false, false); q2 = __uint_as_float(rr[0]) + __uint_as_float(rr[1]); }
      const float k2 = KMX[(b * 8 + h) * 2] + KMX[(b * 8 + h) * 2 + 1] + KMX[32 + b];
      const float ms = 1.01f * sqrtf(q2 * k2);
      exact = wg_or(!(ms <= MLA_STATIC_THR), (unsigned*)(lds + 147456 - 512), wid, lane);
      if (!exact) { m_reg = ms;
#pragma unroll
          for (int r = 0; r < 16; ++r) negm[r] = -ms; } }
    const unsigned lds_k = (unsigned)(uintptr_t)K_lds, lds_v = (unsigned)(uintptr_t)V_lds;
    const char* kp[2]; unsigned kstr[2];
#pragma unroll
    for (int i = 0; i < 2; ++i) { const int r = 8 * wid + 4 * i + (lane >> 4), p = lane & 15, c = p ^ (r & 15); const bool rope = (c >= 8) && (c < 12); const int cn = c & 7;
        kp[i] = rope ? (const char*)(KR + ((size_t)b * S + r) * 32 + (c - 8) * 8) : (const char*)(KN + (bhS + r) * 64 + cn * 8); kstr[i] = rope ? 4096u : 8192u; }
    const char* v_u = (const char*)(V + bhS * 64);
    const unsigned v_off = (unsigned)(((8 * wid + ((lane >> 2) & 7)) * 64 + (lane >> 5) * 32 + (lane & 3) * 8) * 2);
    const int vb0 = (int)(uintptr_t)V_lds + v_rd_base(lane);
#define GLDS16(src, ldsaddr) __builtin_amdgcn_global_load_lds((const unsigned*)(src), (LAS unsigned*)(uintptr_t)(unsigned)(ldsaddr), 16, 0, 0)
#define DMA_TILE(t, sl) do { GLDS16(kp[0] + (size_t)(t) * kstr[0], lds_k + (sl) * SHM_K + (2 * wid) * 1024); GLDS16(kp[1] + (size_t)(t) * kstr[1], lds_k + (sl) * SHM_K + (2 * wid + 1) * 1024); \
        GLDS16(v_u + (size_t)(t) * 8192 + v_off, lds_v + (sl) * SHM_V + wid * 1024); } while (0)
#define RAWBAR() do { asm volatile("" ::: "memory"); __builtin_amdgcn_s_barrier(); asm volatile("" ::: "memory"); } while (0)
#define MAX_TILE(P0, P1, FIRST_, AL_) do { AL_ = 1.f; \
        if (V7_EXACT && exact) { const float pmax = rowmax32b(P0, P1); \
            if ((FIRST_) || !__builtin_expect(__all(pmax <= THR), 1)) { const float dl = (FIRST_) ? pmax : fmaxf(pmax, 0.f); m_reg += dl; \
                _Pragma("unroll") for (int r = 0; r < 16; ++r) { P0[r] -= dl; P1[r] -= dl; } \
                _Pragma("unroll") for (int r = 0; r < 16; ++r) negm[r] = -m_reg; \
                if (!(FIRST_)) AL_ = __builtin_amdgcn_exp2f(-dl); } } } while (0)
#define RESC7(a) do { if (V7_EXACT && exact && __any((a) < 1.f)) { if (hi == 0) al_l[r32] = (a); asm volatile("s_waitcnt lgkmcnt(0)" ::: "memory"); l_reg *= (a); \
    _Pragma("unroll") for (int d = 0; d < 2; ++d) _Pragma("unroll") for (int r = 0; r < 16; ++r) o[d][r] *= al_l[crow(r, hi)]; } } while (0)
#define STEP7(PC0, PC1, PP0, PP1, t_) do { \
        s16x4 val[4], vah[4], vbl[4], vbh[4]; const int vb_ = vb0 + sp * SHM_V; float s0 = 0.f, s1 = 0.f, s2 = 0.f, s3 = 0.f, al_; \
        SEC_B(0); if ((t_) + 3 < NT) DMA_TILE((t_) + 3, sw); SEC_E(0); \
        SEC_B(1); if (V9_SPLIT_PRIO) { if (halfB) __builtin_amdgcn_s_setprio(0); else __builtin_amdgcn_s_setprio(1); } KLD3(kb, K_lds + sc * SHM_K, 3); SBAR(); \
        QK_ADD(PC0, ka[0], qr[0], negm, PP0, 0);  QK_ADD(PC1, ka[1], qr[0], negm, PP0, 4); \
        QK_ADD(PC0, ka[2], qr[1], PC0, PP0, 8);   QK_ADD(PC1, ka[3], qr[1], PC1, PP0, 12); \
        QK_ADD(PC0, ka[4], qr[2], PC0, PP1, 0);   QK_ADD(PC1, ka[5], qr[2], PC1, PP1, 4); \
        vfrag_load_h<0>(val, vah, vb_); SBAR(); \
        QK_ADD(PC0, kb[0], qr[3], PC0, PP1, 8);   QK_ADD(PC1, kb[1], qr[3], PC1, PP1, 12); \
        QK_PK(PC0, kb[2], qr[4], PC0, PP0, 0, pa0); QK_PK(PC1, kb[3], qr[4], PC1, PP0, 8, pa1); \
        vfrag_load_h<1>(vbl, vbh, vb_); SBAR(); \
        QK_PK(PC0, kb[4], qr[5], PC0, PP1, 0, pa2); QK_PK(PC1, kb[5], qr[5], PC1, PP1, 8, pa3); \
        { float ps = (s0 + s1) + (s2 + s3); auto rr = __builtin_amdgcn_permlane32_swap(__float_as_uint(ps), __float_as_uint(ps), false, false); l_reg += __uint_as_float(rr[0]) + __uint_as_float(rr[1]); } \
        MAX_TILE(PC0, PC1, false, al_); SEC_E(1); \
        SEC_B(4); sp = sc; sc = (sc == 4) ? 0 : sc + 1; sw = (sw == 4) ? 0 : sw + 1; \
        if ((t_) + 1 < NT) KLD3(ka, K_lds + sc * SHM_K, 0); \
        asm volatile("s_waitcnt lgkmcnt(6)" ::: "memory"); SBAR(); SEC_E(4); SEC_B(2); if (V9_SPLIT_PRIO) { if (halfB) __builtin_amdgcn_s_setprio(1); else __builtin_amdgcn_s_setprio(0); } \
        PV_EXP9(o[0], pa0, val[0], vah[0], PC0, 0);  PV_EXP9(o[1], pa0, vbl[0], vbh[0], PC0, 4); \
        PV_EXP9(o[0], pa1, val[1], vah[1], PC0, 8);  PV_EXP9(o[1], pa1, vbl[1], vbh[1], PC0, 12); \
        PV_EXP9(o[0], pa2, val[2], vah[2], PC1, 0);  PV_EXP9(o[1], pa2, vbl[2], vbh[2], PC1, 4); \
        PV_EXP9(o[0], pa3, val[3], vah[3], PC1, 8);  PV_EXP9(o[1], pa3, vbl[3], vbh[3], PC1, 12); \
        RESC7(al_); SEC_E(2); \
        SEC_B(3); if ((t_) + 3 < NT) asm volatile("s_waitcnt vmcnt(3)" ::: "memory"); else asm volatile("s_waitcnt vmcnt(0)" ::: "memory");     \
        RAWBAR(); SEC_E(3); } while (0)
    f32x16 pA0, pA1, pB0, pB1; bf16x8 pa0, pa1, pa2, pa3; bf16x8 ka[6], kb[6]; constexpr int NT = S / 64;
#if MLA_STAMP
    unsigned long long st_a = 0, tq0 = 0, tq1 = 0;
#endif


    if (!V9_SPLIT_PRIO && V7_YOUNG_PRIO && wid >= 4) __builtin_amdgcn_s_setprio(1);
    DMA_TILE(0, 0); DMA_TILE(1, 1); DMA_TILE(2, 2);
    asm volatile("s_waitcnt vmcnt(0)" ::: "memory"); RAWBAR();
    KLD3(ka, K_lds, 0); KLD3(kb, K_lds, 3); SBAR();
    pA0 = MF32(ka[0], qr[0], negm); pA1 = MF32(ka[1], qr[0], negm); pA0 = MF32(ka[2], qr[1], pA0); pA1 = MF32(ka[3], qr[1], pA1); pA0 = MF32(ka[4], qr[2], pA0); pA1 = MF32(ka[5], qr[2], pA1);
    pA0 = MF32(kb[0], qr[3], pA0); pA1 = MF32(kb[1], qr[3], pA1); pA0 = MF32(kb[2], qr[4], pA0); pA1 = MF32(kb[3], qr[4], pA1); pA0 = MF32(kb[4], qr[5], pA0); pA1 = MF32(kb[5], qr[5], pA1); SBAR();
    { float al0; MAX_TILE(pA0, pA1, true, al0); (void)al0; }
#pragma unroll
    for (int r = 0; r < 16; ++r) { pA0[r] = __builtin_amdgcn_exp2f(pA0[r]); pA1[r] = __builtin_amdgcn_exp2f(pA1[r]); }
    DMA_TILE(3, 3);
    int sp = 0, sc = 1, sw = 4;
    KLD3(ka, K_lds + SHM_K, 0);
    asm volatile("s_waitcnt vmcnt(3)" ::: "memory"); RAWBAR();
    for (int t = 1; t + 1 < NT; t += 2) { STEP7(pB0, pB1, pA0, pA1, t); STEP7(pA0, pA1, pB0, pB1, t + 1); }
    STEP7(pB0, pB1, pA0, pA1, NT - 1);
    { s16x4 val[4], vah[4], vbl[4], vbh[4]; const int vb_ = vb0 + sp * SHM_V; float ps = 0.f;
      vfrag_load_h<0>(val, vah, vb_); vfrag_load_h<1>(vbl, vbh, vb_); SBAR();
#pragma unroll
      for (int r = 0; r < 16; ++r) ps += pB0[r] + pB1[r];
      { auto rr = __builtin_amdgcn_permlane32_swap(__float_as_uint(ps), __float_as_uint(ps), false, false); l_reg += __uint_as_float(rr[0]) + __uint_as_float(rr[1]); }
      PK4(pB0, 0, pa0); PK4(pB0, 8, pa1); PK4(pB1, 0, pa2); PK4(pB1, 8, pa3);
      asm volatile("s_waitcnt lgkmcnt(0)" ::: "memory"); SBAR();
      pv_mma_h(o[0], val, vah, pa0, pa1, pa2, pa3); pv_mma_h(o[1], vbl, vbh, pa0, pa1, pa2, pa3); SBAR(); }
    __builtin_amdgcn_s_setprio(0);
    asm volatile("s_waitcnt lgkmcnt(0)" ::: "memory"); RAWBAR();
    if (hi == 0) li_l[r32] = l_reg; asm volatile("s_waitcnt lgkmcnt(0)" ::: "memory");
    float rli[16];
#pragma unroll
    for (int r = 0; r < 16; ++r) rli[r] = __builtin_amdgcn_rcpf(li_l[crow(r, hi)]);
    unsigned short* stg = (unsigned short*)lds + wid * 2048;
    unsigned short* dst = CAT + ((size_t)b * S + q0 + wid * 32) * 1024 + h * 64;
    store_o_tile(o, rli, stg, dst, [](int row) { return (size_t)row * 1024; }, lane);
    asm volatile("s_waitcnt vmcnt(0)" ::: "memory");
#if MLA_STAMP
#if MLA_STAMP
    if (blockIdx.x == 0 && wid == MLA_STAMP_WAVE && lane == 0 && STAMPS) STAMPS[0] = st_a;
#endif
    (void)STAMPS;
#endif
    __syncthreads();
#undef GLDS16
#undef DMA_TILE
#undef RAWBAR
#undef MAX_TILE
#undef RESC7
#undef STEP7
#undef PV_EXP9
}

#define PV_EXP8(OD, PA, VL, VH, PCX, B) do { OD = MF32(PA, PKV(VL, VH), OD); PCX[B] = __builtin_amdgcn_exp2f(PCX[B]); PCX[B + 1] = __builtin_amdgcn_exp2f(PCX[B + 1]); \
        PCX[B + 2] = __builtin_amdgcn_exp2f(PCX[B + 2]); PCX[B + 3] = __builtin_amdgcn_exp2f(PCX[B + 3]); asm volatile("" : "+v"(PCX)); SBAR(); } while (0)
__device__ __forceinline__ void mla_unit_v8(int wv, int bh, int qb, const unsigned short* __restrict__ Q, const unsigned short* __restrict__ KN, const unsigned short* __restrict__ KR,
                                            const unsigned short* __restrict__ V, unsigned short* __restrict__ CAT, const float* __restrict__ KMX, char* lds, unsigned long long* STAMPS = nullptr) {
    const int wid = wv, lane = gm::lane_now(), tid = wid * 64 + lane, r32 = lane & 31, hi = lane >> 5;
    const int b = bh >> 3, h = bh & 7; const bool halfB = wid >= 4;
    char* K_lds = lds + M6_K; char* V_lds = lds + M6_V;
    float* wsf = (float*)(lds + M6_WS) + wid * 64; float* li_l = wsf; float* al_l = wsf + 32;
    float m_reg = 0.f, l_reg = 0; f32x16 o[2] = {}; bf16x8 qr[6]; f32x16 negm = f32x16{};
    const size_t bhS = (size_t)bh * S; const int q0 = qb * 256;
    const unsigned short* Qw = Q + (bhS + q0 + wid * 32 + r32) * 96 + hi * 8;
#pragma unroll
    for (int d0 = 0; d0 < 6; ++d0) qr[d0] = *reinterpret_cast<const bf16x8*>(Qw + d0 * 16);
    bool exact = true;
    if (MLA_STATIC) { float q2 = 0.f;
#pragma unroll
      for (int d0 = 0; d0 < 6; ++d0)
#pragma unroll
          for (int j = 0; j < 8; ++j) { const float x = __uint_as_float((unsigned)(unsigned short)qr[d0][j] << 16); q2 += x * x; }
      { auto rr = __builtin_amdgcn_permlane32_swap(__float_as_uint(q2), __float_as_uint(q2), false, false); q2 = __uint_as_float(rr[0]) + __uint_as_float(rr[1]); }
      const float k2 = KMX[(b * 8 + h) * 2] + KMX[(b * 8 + h) * 2 + 1] + KMX[32 + b];
      const float ms = 1.01f * sqrtf(q2 * k2);
      exact = wg_or(!(ms <= MLA_STATIC_THR), (unsigned*)(lds + 147456 - 512), wid, lane);
      if (!exact) { m_reg = ms;
#pragma unroll
          for (int r = 0; r < 16; ++r) negm[r] = -ms; } }
    const int srow = tid >> 3, sch = tid & 7, rrow = (tid & 255) >> 2, rch = tid & 3;
    const char* kn_u = (const char*)(KN + bhS * 64); const char* v_u = (const char*)(V + bhS * 64); const char* kr_u = (const char*)(KR + (size_t)b * S * 32);
    const unsigned kn_off = (unsigned)(srow * 64 + sch * 8) * 2u, kr_off = (unsigned)(rrow * 32 + rch * 8) * 2u;
    const int kst = KSWZ(srow, sch * 16), krst = KSWZ(rrow, (8 + rch) * 16), vst = v_st(srow, sch * 8);
    const int vb0 = (int)(uintptr_t)V_lds + v_rd_base(lane);
    bf16x8 s_kn, s_kr, s_v;
#define SLOAD(t) do { s_kn = *reinterpret_cast<const bf16x8*>(kn_u + (size_t)(t) * 8192 + kn_off); s_kr = *reinterpret_cast<const bf16x8*>(kr_u + (size_t)(t) * 4096 + kr_off); \
    s_v = *reinterpret_cast<const bf16x8*>(v_u + (size_t)(t) * 8192 + kn_off); } while (0)
#define SWRITE(sl) do { *(bf16x8*)(K_lds + (sl) * SHM_K + kst) = s_kn; if (tid < 256) *(bf16x8*)(K_lds + (sl) * SHM_K + krst) = s_kr; *(bf16x8*)(V_lds + (sl) * SHM_V + vst) = s_v; } while (0)
#define SWAIT() asm volatile("s_waitcnt vmcnt(0)" ::: "memory")
#define RAWBAR() do { asm volatile("" ::: "memory"); __builtin_amdgcn_s_barrier(); asm volatile("" ::: "memory"); } while (0)
#define MAX_TILE(P0, P1, FIRST_, AL_) do { AL_ = 1.f; \
        if (V7_EXACT && exact) { const float pmax = rowmax32b(P0, P1); \
            if ((FIRST_) || !__builtin_expect(__all(pmax <= THR), 1)) { const float dl = (FIRST_) ? pmax : fmaxf(pmax, 0.f); m_reg += dl; \
                _Pragma("unroll") for (int r = 0; r < 16; ++r) { P0[r] -= dl; P1[r] -= dl; } \
                _Pragma("unroll") for (int r = 0; r < 16; ++r) negm[r] = -m_reg; \
                if (!(FIRST_)) AL_ = __builtin_amdgcn_exp2f(-dl); } } } while (0)
#define RESC7(a) do { if (V7_EXACT && exact && __any((a) < 1.f)) { if (hi == 0) al_l[r32] = (a); asm volatile("s_waitcnt lgkmcnt(0)" ::: "memory"); l_reg *= (a); \
    _Pragma("unroll") for (int d = 0; d < 2; ++d) _Pragma("unroll") for (int r = 0; r < 16; ++r) o[d][r] *= al_l[crow(r, hi)]; } } while (0)
#define STEP7(PC0, PC1, PP0, PP1, t_) do { \
        s16x4 val[4], vah[4], vbl[4], vbh[4]; const int vb_ = vb0 + sp * SHM_V; float s0 = 0.f, s1 = 0.f, s2 = 0.f, s3 = 0.f, al_; \
        KLD3(kb, K_lds + sc * SHM_K, 3); SBAR(); \
        QK_ADD(PC0, ka[0], qr[0], negm, PP0, 0);  QK_ADD(PC1, ka[1], qr[0], negm, PP0, 4); \
        QK_ADD(PC0, ka[2], qr[1], PC0, PP0, 8);   QK_ADD(PC1, ka[3], qr[1], PC1, PP0, 12); \
        QK_ADD(PC0, ka[4], qr[2], PC0, PP1, 0);   QK_ADD(PC1, ka[5], qr[2], PC1, PP1, 4); \
        vfrag_load_h<0>(val, vah, vb_); SBAR(); \
        QK_ADD(PC0, kb[0], qr[3], PC0, PP1, 8);   QK_ADD(PC1, kb[1], qr[3], PC1, PP1, 12); \
        QK_PK(PC0, kb[2], qr[4], PC0, PP0, 0, pa0); QK_PK(PC1, kb[3], qr[4], PC1, PP0, 8, pa1); \
        vfrag_load_h<1>(vbl, vbh, vb_); SBAR(); \
        QK_PK(PC0, kb[4], qr[5], PC0, PP1, 0, pa2); QK_PK(PC1, kb[5], qr[5], PC1, PP1, 8, pa3); \
        { float ps = (s0 + s1) + (s2 + s3); auto rr = __builtin_amdgcn_permlane32_swap(__float_as_uint(ps), __float_as_uint(ps), false, false); l_reg += __uint_as_float(rr[0]) + __uint_as_float(rr[1]); } \
        MAX_TILE(PC0, PC1, false, al_); \
        asm volatile("s_waitcnt lgkmcnt(0)" ::: "memory"); RAWBAR(); \
        if ((t_) + 2 < NT) { SWAIT(); SWRITE(sw); if ((t_) + 3 < NT) SLOAD((t_) + 3); } \
        sp = sc; sc = (sc + 1) & 3; sw = (sw + 1) & 3; \
        if ((t_) + 1 < NT) KLD3(ka, K_lds + sc * SHM_K, 0); SBAR(); \
        PV_EXP8(o[0], pa0, val[0], vah[0], PC0, 0);  PV_EXP8(o[1], pa0, vbl[0], vbh[0], PC0, 4); \
        PV_EXP8(o[0], pa1, val[1], vah[1], PC0, 8);  PV_EXP8(o[1], pa1, vbl[1], vbh[1], PC0, 12); \
        PV_EXP8(o[0], pa2, val[2], vah[2], PC1, 0);  PV_EXP8(o[1], pa2, vbl[2], vbh[2], PC1, 4); \
        PV_EXP8(o[0], pa3, val[3], vah[3], PC1, 8);  PV_EXP8(o[1], pa3, vbl[3], vbh[3], PC1, 12); \
        RESC7(al_); \
        asm volatile("s_waitcnt lgkmcnt(6)" ::: "memory"); RAWBAR(); } while (0)
    f32x16 pA0, pA1, pB0, pB1; bf16x8 pa0, pa1, pa2, pa3; bf16x8 ka[6], kb[6]; constexpr int NT = S / 64;

    SLOAD(0); SWAIT(); SWRITE(0); SLOAD(1); SWAIT(); SWRITE(1); SLOAD(2);
    asm volatile("s_waitcnt lgkmcnt(0)" ::: "memory"); RAWBAR();
    if (halfB) RAWBAR();
    KLD3(ka, K_lds, 0); KLD3(kb, K_lds, 3); SBAR();
    pA0 = MF32(ka[0], qr[0], negm); pA1 = MF32(ka[1], qr[0], negm); pA0 = MF32(ka[2], qr[1], pA0); pA1 = MF32(ka[3], qr[1], pA1); pA0 = MF32(ka[4], qr[2], pA0); pA1 = MF32(ka[5], qr[2], pA1);
    pA0 = MF32(kb[0], qr[3], pA0); pA1 = MF32(kb[1], qr[3], pA1); pA0 = MF32(kb[2], qr[4], pA0); pA1 = MF32(kb[3], qr[4], pA1); pA0 = MF32(kb[4], qr[5], pA0); pA1 = MF32(kb[5], qr[5], pA1); SBAR();
    { float al0; MAX_TILE(pA0, pA1, true, al0); (void)al0; }
    asm volatile("s_waitcnt lgkmcnt(0)" ::: "memory"); RAWBAR();
#pragma unroll
    for (int r = 0; r < 16; ++r) { pA0[r] = __builtin_amdgcn_exp2f(pA0[r]); pA1[r] = __builtin_amdgcn_exp2f(pA1[r]); }
    SWAIT(); SWRITE(2); SLOAD(3);
    int sp = 0, sc = 1, sw = 3;
    KLD3(ka, K_lds + SHM_K, 0);
    asm volatile("s_waitcnt lgkmcnt(6)" ::: "memory"); RAWBAR();
    for (int t = 1; t + 1 < NT; t += 2) { STEP7(pB0, pB1, pA0, pA1, t); STEP7(pA0, pA1, pB0, pB1, t + 1); }
    STEP7(pB0, pB1, pA0, pA1, NT - 1);
    { s16x4 val[4], vah[4], vbl[4], vbh[4]; const int vb_ = vb0 + sp * SHM_V; float ps = 0.f;
      vfrag_load_h<0>(val, vah, vb_); vfrag_load_h<1>(vbl, vbh, vb_); SBAR();
#pragma unroll
      for (int r = 0; r < 16; ++r) ps += pB0[r] + pB1[r];
      { auto rr = __builtin_amdgcn_permlane32_swap(__float_as_uint(ps), __float_as_uint(ps), false, false); l_reg += __uint_as_float(rr[0]) + __uint_as_float(rr[1]); }
      PK4(pB0, 0, pa0); PK4(pB0, 8, pa1); PK4(pB1, 0, pa2); PK4(pB1, 8, pa3);
      asm volatile("s_waitcnt lgkmcnt(0)" ::: "memory"); SBAR();
      pv_mma_h(o[0], val, vah, pa0, pa1, pa2, pa3); pv_mma_h(o[1], vbl, vbh, pa0, pa1, pa2, pa3); SBAR(); }
    if (!halfB) RAWBAR();
    if (hi == 0) li_l[r32] = l_reg; asm volatile("s_waitcnt lgkmcnt(0)" ::: "memory");
    float rli[16];
#pragma unroll
    for (int r = 0; r < 16; ++r) rli[r] = __builtin_amdgcn_rcpf(li_l[crow(r, hi)]);
    unsigned short* stg = (unsigned short*)(lds + M6_OST) + wid * 2048;
    unsigned short* dst = CAT + ((size_t)b * S + q0 + wid * 32) * 1024 + h * 64;
    store_o_tile(o, rli, stg, dst, [](int row) { return (size_t)row * 1024; }, lane);
    asm volatile("s_waitcnt vmcnt(0)" ::: "memory");
#if MLA_STAMP
    (void)STAMPS;
#endif
    __syncthreads();
#undef SLOAD
#undef SWRITE
#undef SWAIT
#undef RAWBAR
#undef MAX_TILE
#undef RESC7
#undef STEP7
#undef PV_EXP8
}

constexpr int DL_K = 0, DL_V = 49152, DL_WS = 98304, DL_OST = DL_WS + 8 * 256;
#define KSWZD(row, colB) ((row) * 128 + ((colB) ^ ((((row) >> 1) & 7) << 4)))
__device__ __forceinline__ void dil_unit(int wv, int bh, int br, int blk, const unsigned short* __restrict__ DQ, const unsigned short* __restrict__ DK, const unsigned short* __restrict__ DV,
                                         unsigned short* __restrict__ OBR, float* __restrict__ LSE, char* lds) {
    const int wid = wv, lane = gm::lane_now(), tid = wid * 64 + lane, r32 = lane & 31, hi = lane >> 5;
    const int sh = 2 * br, dil = 1 << sh, L = S >> sh, nbl = L >> 8, res = blk / nbl, lb = blk % nbl;
    const size_t bhS = (size_t)bh * S; const int b = bh >> 3, h = bh & 7;
    char* K_lds = lds + DL_K; char* V_lds = lds + DL_V;
#pragma unroll
    for (int half = 0; half < 2; ++half) {
        bf16x8 kk[3], vv[3];
#pragma unroll
        for (int it = 0; it < 3; ++it) { const int item = (half * 3 + it) * 512 + tid, row = item >> 3, ch = item & 7; const int l = 256 * lb - 64 + row; const bool valid = (l >= 0) && (l < L);
            const size_t src = (bhS + (valid ? ((size_t)l << sh) + res : 0)) * 64 + ch * 8;
            kk[it] = *reinterpret_cast<const bf16x8*>(DK + src); vv[it] = *reinterpret_cast<const bf16x8*>(DV + src);
            if (!valid) { kk[it] = bf16x8{}; vv[it] = bf16x8{}; } }
#pragma unroll
        for (int it = 0; it < 3; ++it) { const int item = (half * 3 + it) * 512 + tid, row = item >> 3, ch = item & 7;
            *(bf16x8*)(K_lds + KSWZD(row, ch * 16)) = kk[it]; *(bf16x8*)(V_lds + (row >> 4) * 2048 + v_st(row & 15, ch * 8)) = vv[it]; }
    }
    bf16x8 qr[4];
    const int ql = wid * 32 + r32; const size_t qpos = ((size_t)(256 * lb + ql) << sh) + res;
    const unsigned short* Qw = DQ + (bhS + qpos) * 64 + hi * 8;
#pragma unroll
    for (int d0 = 0; d0 < 4; ++d0) qr[d0] = *reinterpret_cast<const bf16x8*>(Qw + d0 * 16);
    __syncthreads();
    f32x16 p[5];
#pragma unroll
    for (int j = 0; j < 5; ++j) { p[j] = f32x16{}; const int row = wid * 32 + j * 32 + r32;
#pragma unroll
        for (int d0 = 0; d0 < 4; ++d0) { const bf16x8 kf = *reinterpret_cast<const bf16x8*>(K_lds + KSWZD(row, (d0 * 16 + hi * 8) * 2)); p[j] = __builtin_amdgcn_mfma_f32_32x32x16_bf16(kf, qr[d0], p[j], 0, 0, 0); } }
    const float NEG = -1e30f;
    const int klo = 64 - 256 * lb, khi = L + 64 - 256 * lb;
    { const int t0 = max(r32, klo - wid * 32) - 4 * hi, t1 = klo - wid * 32 - 32 - 4 * hi, t3 = khi - wid * 32 - 96 - 4 * hi, t4 = min(r32 + 1, khi - wid * 32 - 128) - 4 * hi;
#pragma unroll
      for (int r = 0; r < 16; ++r) { const int c = (r & 3) + 8 * (r >> 2);
          if (c < t0) p[0][r] = NEG; if (c < t1) p[1][r] = NEG; if (c >= t3) p[3][r] = NEG; if (c >= t4) p[4][r] = NEG; } }
    float mx = rowmax32(p[0], p[1]); mx = fmaxf(mx, rowmax32(p[2], p[3]));
    { float m4 = p[4][0];
#pragma unroll
      for (int r = 1; r < 16; ++r) m4 = fmaxf(m4, p[4][r]);
      auto rr = __builtin_amdgcn_permlane32_swap(__float_as_uint(m4), __float_as_uint(m4), false, false); mx = fmaxf(mx, fmaxf(__uint_as_float(rr[0]), __uint_as_float(rr[1]))); }
    float ps = 0.f;
#pragma unroll
    for (int j = 0; j < 5; ++j)
#pragma unroll
        for (int r = 0; r < 16; ++r) { p[j][r] = __builtin_amdgcn_exp2f(p[j][r] - mx); ps += p[j][r]; }
    { auto rr = __builtin_amdgcn_permlane32_swap(__float_as_uint(ps), __float_as_uint(ps), false, false); ps = __uint_as_float(rr[0]) + __uint_as_float(rr[1]); }
    bf16x8 pa[5][2];
#pragma unroll
    for (int j = 0; j < 5; ++j) { PK4(p[j], 0, pa[j][0]); PK4(p[j], 8, pa[j][1]); }
    f32x16 o[2] = {};
    const int vb = (int)(uintptr_t)V_lds + v_rd_base(lane) + wid * 4096;
    pv_half<0, 0 * 4096>(o[0], vb, pa[0][0], pa[0][1]); pv_half<1, 0 * 4096>(o[1], vb, pa[0][0], pa[0][1]);
    pv_half<0, 1 * 4096>(o[0], vb, pa[1][0], pa[1][1]); pv_half<1, 1 * 4096>(o[1], vb, pa[1][0], pa[1][1]);
    pv_half<0, 2 * 4096>(o[0], vb, pa[2][0], pa[2][1]); pv_half<1, 2 * 4096>(o[1], vb, pa[2][0], pa[2][1]);
    pv_half<0, 3 * 4096>(o[0], vb, pa[3][0], pa[3][1]); pv_half<1, 3 * 4096>(o[1], vb, pa[3][0], pa[3][1]);
    pv_half<0, 4 * 4096>(o[0], vb, pa[4][0], pa[4][1]); pv_half<1, 4 * 4096>(o[1], vb, pa[4][0], pa[4][1]);
    float* wsf = (float*)(lds + DL_WS) + wid * 64;
    if (hi == 0) { wsf[r32] = ps; LSE[((size_t)br * T + (size_t)b * S + qpos) * 8 + h] = mx + __builtin_amdgcn_logf(ps); }
    asm volatile("s_waitcnt lgkmcnt(0)" ::: "memory");
    float rli[16];
#pragma unroll
    for (int r = 0; r < 16; ++r) rli[r] = __builtin_amdgcn_rcpf(wsf[crow(r, hi)]);
    unsigned short* stg = (unsigned short*)(lds + DL_OST) + wid * 2048;
    unsigned short* dst = OBR + ((size_t)br * T + (size_t)b * S + (((size_t)(256 * lb + wid * 32)) << sh) + res) * 512 + h * 64;
    store_o_tile(o, rli, stg, dst, [sh](int row) { return ((size_t)row << sh) * 512; }, lane);
    asm volatile("s_waitcnt vmcnt(0)" ::: "memory");
    __syncthreads();
}
#define DIL_DECODE(u, bh_, br_, res_, lb_, sh_, L_) const int bh_ = (u) / 96, br_ = ((u) >> 5) % 3, blk__##bh_ = (u) & 31, sh_ = 2 * br_, L_ = S >> sh_, nbl__##bh_ = L_ >> 8, res_ = blk__##bh_ / nbl__##bh_, lb_ = blk__##bh_ % nbl__##bh_
__device__ __forceinline__ void dil_phase(int wv, int u0, int ustep, int nunits, const unsigned short* __restrict__ DQ, const unsigned short* __restrict__ DK, const unsigned short* __restrict__ DV,
                                          unsigned short* __restrict__ OBR, float* __restrict__ LSE, char* lds) {
    const int wid = wv, lane = gm::lane_now(), tid = wid * 64 + lane, r32 = lane & 31, hi = lane >> 5;
    char* K_lds = lds + DL_K; char* V_lds = lds + DL_V;
    bf16x8 kk[6], qn[4]; unsigned kmask = 0u;
#define DIL_LOAD6(dst, mask, SRC, u) do { DIL_DECODE(u, bh_, br_, res_, lb_, sh_, L_); const size_t bhS_ = (size_t)bh_ * S; mask = 0u; \
        _Pragma("unroll") for (int it = 0; it < 6; ++it) { const int item = it * 512 + tid, row = item >> 3, ch = item & 7; const int l = 256 * lb_ - 64 + row; const bool valid = (l >= 0) && (l < L_); \
            const size_t src = (bhS_ + (valid ? ((size_t)l << sh_) + res_ : 0)) * 64 + ch * 8; dst[it] = *reinterpret_cast<const bf16x8*>(SRC + src); mask |= (valid ? 1u : 0u) << it; } } while (0)
#define DIL_LOADQ(u) do { DIL_DECODE(u, bh_, br_, res_, lb_, sh_, L_); const size_t qpos_ = ((size_t)(256 * lb_ + wid * 32 + r32) << sh_) + res_; const unsigned short* Qw_ = DQ + ((size_t)bh_ * S + qpos_) * 64 + hi * 8; \
        _Pragma("unroll") for (int d0 = 0; d0 < 4; ++d0) qn[d0] = *reinterpret_cast<const bf16x8*>(Qw_ + d0 * 16); } while (0)
    if (wid >= 4) __builtin_amdgcn_s_setprio(1);
    int u = u0;
    if (u < nunits) { DIL_LOAD6(kk, kmask, DK, u); DIL_LOADQ(u); }
    for (; u < nunits; u += ustep) {
        DIL_DECODE(u, bh, br, res, lb, sh, L); const int b = bh >> 3, h = bh & 7;
#pragma unroll
        for (int it = 0; it < 6; ++it) { const int item = it * 512 + tid, row = item >> 3, ch = item & 7; *(bf16x8*)(K_lds + KSWZD(row, ch * 16)) = ((kmask >> it) & 1u) ? kk[it] : bf16x8{}; }
        bf16x8 qr[4];
#pragma unroll
        for (int d0 = 0; d0 < 4; ++d0) qr[d0] = qn[d0];
        bf16x8 vv[6]; unsigned vmask; DIL_LOAD6(vv, vmask, DV, u);
        __syncthreads();
        const int ql = wid * 32 + r32; const size_t qpos = ((size_t)(256 * lb + ql) << sh) + res;
        f32x16 p[5];
#pragma unroll
        for (int j = 0; j < 5; ++j) { p[j] = f32x16{}; const int row = wid * 32 + j * 32 + r32;
#pragma unroll
            for (int d0 = 0; d0 < 4; ++d0) { const bf16x8 kf = *reinterpret_cast<const bf16x8*>(K_lds + KSWZD(row, (d0 * 16 + hi * 8) * 2)); p[j] = __builtin_amdgcn_mfma_f32_32x32x16_bf16(kf, qr[d0], p[j], 0, 0, 0); } }
        const float NEG = -1e30f;
        const int klo = 64 - 256 * lb, khi = L + 64 - 256 * lb;
        { const int t0 = max(r32, klo - wid * 32) - 4 * hi, t1 = klo - wid * 32 - 32 - 4 * hi, t3 = khi - wid * 32 - 96 - 4 * hi, t4 = min(r32 + 1, khi - wid * 32 - 128) - 4 * hi;
#pragma unroll
          for (int r = 0; r < 16; ++r) { const int c = (r & 3) + 8 * (r >> 2);
              if (c < t0) p[0][r] = NEG; if (c < t1) p[1][r] = NEG; if (c >= t3) p[3][r] = NEG; if (c >= t4) p[4][r] = NEG; } }
        float mx = rowmax32(p[0], p[1]); mx = fmaxf(mx, rowmax32(p[2], p[3]));
        { float m4 = p[4][0];
#pragma unroll
          for (int r = 1; r < 16; ++r) m4 = fmaxf(m4, p[4][r]);
          auto rr = __builtin_amdgcn_permlane32_swap(__float_as_uint(m4), __float_as_uint(m4), false, false); mx = fmaxf(mx, fmaxf(__uint_as_float(rr[0]), __uint_as_float(rr[1]))); }
        float ps = 0.f;
#pragma unroll
        for (int j = 0; j < 5; ++j)
#pragma unroll
            for (int r = 0; r < 16; ++r) { p[j][r] = __builtin_amdgcn_exp2f(p[j][r] - mx); ps += p[j][r]; }
        { auto rr = __builtin_amdgcn_permlane32_swap(__float_as_uint(ps), __float_as_uint(ps), false, false); ps = __uint_as_float(rr[0]) + __uint_as_float(rr[1]); }
        bf16x8 pa[5][2];
#pragma unroll
        for (int j = 0; j < 5; ++j) { PK4(p[j], 0, pa[j][0]); PK4(p[j], 8, pa[j][1]); }
#pragma unroll
        for (int it = 0; it < 6; ++it) { const int item = it * 512 + tid, row = item >> 3, ch = item & 7; *(bf16x8*)(V_lds + (row >> 4) * 2048 + v_st(row & 15, ch * 8)) = ((vmask >> it) & 1u) ? vv[it] : bf16x8{}; }
        __syncthreads();
        if (u + ustep < nunits) { DIL_LOAD6(kk, kmask, DK, u + ustep); DIL_LOADQ(u + ustep); }
        f32x16 o[2] = {};
        const int vb = (int)(uintptr_t)V_lds + v_rd_base(lane) + wid * 4096;
        pv_half<0, 0 * 4096>(o[0], vb, pa[0][0], pa[0][1]); pv_half<1, 0 * 4096>(o[1], vb, pa[0][0], pa[0][1]);
        pv_half<0, 1 * 4096>(o[0], vb, pa[1][0], pa[1][1]); pv_half<1, 1 * 4096>(o[1], vb, pa[1][0], pa[1][1]);
        pv_half<0, 2 * 4096>(o[0], vb, pa[2][0], pa[2][1]); pv_half<1, 2 * 4096>(o[1], vb, pa[2][0], pa[2][1]);
        pv_half<0, 3 * 4096>(o[0], vb, pa[3][0], pa[3][1]); pv_half<1, 3 * 4096>(o[1], vb, pa[3][0], pa[3][1]);
        pv_half<0, 4 * 4096>(o[0], vb, pa[4][0], pa[4][1]); pv_half<1, 4 * 4096>(o[1], vb, pa[4][0], pa[4][1]);
        float* wsf = (float*)(lds + DL_WS) + wid * 64;
        if (hi == 0) { wsf[r32] = ps; LSE[((size_t)br * T + (size_t)b * S + qpos) * 8 + h] = mx + __builtin_amdgcn_logf(ps); }
        asm volatile("s_waitcnt lgkmcnt(0)" ::: "memory");
        float rli[16];
#pragma unroll
        for (int r = 0; r < 16; ++r) rli[r] = __builtin_amdgcn_rcpf(wsf[crow(r, hi)]);
        unsigned short* stg = (unsigned short*)(lds + DL_OST) + wid * 2048;
        unsigned short* dst = OBR + ((size_t)br * T + (size_t)b * S + (((size_t)(256 * lb + wid * 32)) << sh) + res) * 512 + h * 64;
        store_o_tile(o, rli, stg, dst, [sh](int row) { return ((size_t)row << sh) * 512; }, lane);
        __syncthreads();
    }
    __builtin_amdgcn_s_setprio(0);
#undef DIL_LOAD6
#undef DIL_LOADQ
}
__device__ __forceinline__ void dil_combine(const unsigned short* __restrict__ OBR, const float* __restrict__ LSE, unsigned short* __restrict__ CAT, int gtid, int gthreads) {
    for (int i = gtid; i < T * 64; i += gthreads) { const int t = i >> 6, c8 = i & 63, h = c8 >> 3;
        const float l0 = LSE[((size_t)0 * T + t) * 8 + h], l1 = LSE[((size_t)1 * T + t) * 8 + h], l2 = LSE[((size_t)2 * T + t) * 8 + h];
        const float mx = fmaxf(l0, fmaxf(l1, l2)); float w0 = __builtin_amdgcn_exp2f(l0 - mx), w1 = __builtin_amdgcn_exp2f(l1 - mx), w2 = __builtin_amdgcn_exp2f(l2 - mx);
        const float inv = 1.f / (w0 + w1 + w2); w0 *= inv; w1 *= inv; w2 *= inv;
        const u32x4 a = *(const u32x4*)(OBR + ((size_t)0 * T + t) * 512 + c8 * 8), bb = *(const u32x4*)(OBR + ((size_t)1 * T + t) * 512 + c8 * 8), cc = *(const u32x4*)(OBR + ((size_t)2 * T + t) * 512 + c8 * 8);
        u32x4 o;
#pragma unroll
        for (int k = 0; k < 4; ++k) { const float lo = w0 * __uint_as_float(a[k] << 16) + w1 * __uint_as_float(bb[k] << 16) + w2 * __uint_as_float(cc[k] << 16);
            const float hi = w0 * __uint_as_float(a[k] & 0xffff0000u) + w1 * __uint_as_float(bb[k] & 0xffff0000u) + w2 * __uint_as_float(cc[k] & 0xffff0000u); o[k] = cvtpk(lo, hi); }
        *(u32x4*)(CAT + (size_t)t * 1024 + 512 + c8 * 8) = o; }
}
#undef SBAR
}
namespace mk {
struct SchedP4 {
    __device__ __forceinline__ void a_ready(const gm::Unit&, int, int) const {}
    __device__ __forceinline__ void done(const gm::Unit&, int) const {}
    __device__ __forceinline__ void stamp(int, const gm::Unit&, int, int) const {}
    static constexpr bool GATHER = false;
    const char* A; const char* Bt; int G, c;
    __device__ __forceinline__ bool next(int i, gm::Unit& u) const { int pm, pn; if (!static_tile(i, G, c, 64, 4, pm, pn)) return false;
        u.A = A; u.Bt = Bt; u.gidx = nullptr; u.lda2 = 2048; u.ldb2 = 2048; u.arow0 = pm * 256; u.brow0 = pn * 256; u.nt = 16; u.pm = pm; u.pn = pn; u.aux = 0; return true; }
};
struct EpiP4 {
    static constexpr bool PERM = false;
    const float* x; float* out; const float* modf;
    __device__ __forceinline__ void operator()(EPI_ARGS) const {
        const int b = (u.pm * 256) >> 13; const float* gt = modf + b * 6144 + 2048;
        const int col0 = u.pn * 256 + wc * 32 + 4 * fq;
        f32x4 g[2][2];
#pragma unroll
        for (int bj = 0; bj < 2; ++bj)
#pragma unroll
            for (int n = 0; n < 2; ++n) g[bj][n] = *(const f32x4*)(gt + col0 + bj * 128 + n * 16);
#pragma unroll
        for (int ai = 0; ai < 2; ++ai)
#pragma unroll
            for (int m = 0; m < 4; ++m) { const size_t off = (size_t)(u.pm * 256 + ai * 128 + wr * 64 + m * 16 + fr) * D + col0;
#pragma unroll
                for (int bj = 0; bj < 2; ++bj)
#pragma unroll
                    for (int n = 0; n < 2; ++n) { const f32x4 xv = *(const f32x4*)(x + off + bj * 128 + n * 16); *(f32x4*)(out + off + bj * 128 + n * 16) = xv + g[bj][n] * acc[ai][bj][m][n]; } }
    }
};
__device__ __forceinline__ void p4b_rows(Frame& F) {
    const int tid_ = F.wave * 64 + fresh_lane();
    LAS float* WR = (LAS float*)F.lds;
    LAS float* A1 = WR + 16384;
    LAS float* A0 = A1 + 2048;
    const float* modf = (const float*)(F.ws + WS_MODF);
    for (int i = tid_; i < 16384; i += NTHREADS) { const int j = i >> 4, e = i & 15; WR[e * 1024 + j] = F.w_router[i]; }
    for (int i = tid_; i < 2048; i += NTHREADS) { const int b = i >> 10, j = i & 1023; A1[i] = F.g_ffn[j] * (1.f + modf[b * 6144 + 4096 + j]); A0[i] = modf[b * 6144 + 3072 + j]; }
    __syncthreads();
    const int gw = F.vcu * NWAVES + F.wave, NGW = F.G * NWAVES, lane = fresh_lane();
    for (int m = gw; m < T; m += NGW) { const int b = m >> 13, s = m & 8191;
        const f32x4* xr = (const f32x4*)(F.out + (size_t)m * D) + lane; f32x4 v[4]; float ss = 0.f;
#pragma unroll
        for (int j = 0; j < 4; ++j) { v[j] = xr[64 * j]; ss += (v[j].x * v[j].x + v[j].y * v[j].y) + (v[j].z * v[j].z + v[j].w * v[j].w); }
        const float rstd = rsqrtf(wave_sum(ss) * (1.f / D) + EPS);
        unsigned long long* o8 = (unsigned long long*)((bf16_t*)(F.ws + WS_HB) + (size_t)m * D) + lane;
        float lg[16];
#pragma unroll
        for (int e = 0; e < 16; ++e) lg[e] = 0.f;
#pragma unroll
        for (int j = 0; j < 4; ++j) { asm volatile("" ::: "memory");
            const f32x4 a1 = *(const LAS f32x4*)(A1 + b * 1024 + 4 * lane + 256 * j), a0 = *(const LAS f32x4*)(A0 + b * 1024 + 4 * lane + 256 * j);
            const f32x4 o = v[j] * rstd * a1 + a0; o8[64 * j] = (unsigned long long)pk2(o.x, o.y) | ((unsigned long long)pk2(o.z, o.w) << 32);
#pragma unroll
            for (int e = 0; e < 16; ++e) { const f32x4 w = *(const LAS f32x4*)(WR + e * 1024 + 4 * lane + 256 * j); lg[e] += (o.x * w.x + o.y * w.y) + (o.z * w.z + o.w * w.w); } }
        float w8[8], w4[4], w2[2], w1;
        { const bool up = lane & 32;
#pragma unroll
          for (int i = 0; i < 8; ++i) { const float snd = up ? lg[i] : lg[8 + i], kp = up ? lg[8 + i] : lg[i]; w8[i] = kp + __shfl_xor(snd, 32); } }
        { const bool up = lane & 16;
#pragma unroll
          for (int i = 0; i < 4; ++i) { const float snd = up ? w8[i] : w8[4 + i], kp = up ? w8[4 + i] : w8[i]; w4[i] = kp + __shfl_xor(snd, 16); } }
        { const bool up = lane & 8;
#pragma unroll
          for (int i = 0; i < 2; ++i) { const float snd = up ? w4[i] : w4[2 + i], kp = up ? w4[2 + i] : w4[i]; w2[i] = kp + __shfl_xor(snd, 8); } }
        { const bool up = lane & 4; const float snd = up ? w2[0] : w2[1], kp = up ? w2[1] : w2[0]; w1 = kp + __shfl_xor(snd, 4); }
        w1 += __shfl_xor(w1, 1); w1 += __shfl_xor(w1, 2);
        const int e = lane >> 2; const float logit = w1 + F.b_router[e];
        float mx = logit;
#pragma unroll
        for (int o = 4; o < 64; o <<= 1) mx = fmaxf(mx, __shfl_xor(mx, o));
        const float ex = __expf(logit - mx); float den = ex;
#pragma unroll
        for (int o = 4; o < 64; o <<= 1) den += __shfl_xor(den, o);
        if ((lane & 3) == 0) ((float*)(F.ws + WS_AFF))[((size_t)b * 16 + e) * S + s] = ex / den;
    }
    __syncthreads();
}
__device__ __forceinline__ void p5_topk(Frame& F) {
    if (F.vcu >= 32) { if (WD_IN_P5 && F.G > 32) wd_convert(F, 32); return; }
    const int be = F.vcu, b = be >> 4, e = be & 15, tid = F.wave * 64 + fresh_lane();
    LAS unsigned* vals = (LAS unsigned*)F.lds;
    LAS unsigned* hist = vals + 8192;
    LAS unsigned* suf = hist + 256;
    LAS unsigned* misc = suf + 264;
    LAS unsigned* wtot = misc + 8;
    const float* a = (const float*)(F.ws + WS_AFF) + (size_t)be * S;
    for (int i = tid; i < 8192; i += NTHREADS) vals[i] = __float_as_uint(a[i]);
    if (tid == 0) { misc[0] = 0u; misc[1] = 1024u; }
    __syncthreads();
    for (int pass = 0; pass < 4; ++pass) {
        const int sh = 24 - 8 * pass; const unsigned prefix = misc[0], k = misc[1]; const unsigned himask = pass == 0 ? 0u : (0xffffffffu << (sh + 8));
        if (tid < 256) hist[tid] = 0u;
        __syncthreads();
        {
            const unsigned cand = (vals[0] >> sh) & 255u; unsigned nc = 0u;
            for (int i = tid; i < 8192; i += NTHREADS) { const unsigned v = vals[i]; if ((v & himask) == prefix) { const unsigned bn = (v >> sh) & 255u; if (bn == cand) ++nc; else __hip_atomic_fetch_add(&hist[bn], 1u, __ATOMIC_RELAXED, __HIP_MEMORY_SCOPE_WORKGROUP); } }
#pragma unroll
            for (int o = 1; o < 64; o <<= 1) nc += __shfl_xor(nc, o);
            if ((tid & 63) == 0 && nc) __hip_atomic_fetch_add(&hist[cand], nc, __ATOMIC_RELAXED, __HIP_MEMORY_SCOPE_WORKGROUP);
        }
        __syncthreads();
        if (tid < 64) {
            const int l = tid; const unsigned h0 = hist[4 * l], h1 = hist[4 * l + 1], h2 = hist[4 * l + 2], h3 = hist[4 * l + 3];
            const unsigned tot = (h0 + h1) + (h2 + h3); unsigned inc = tot;
#pragma unroll
            for (int o = 1; o < 64; o <<= 1) { const unsigned t = __shfl_down(inc, o); if (l + o < 64) inc += t; }
            const unsigned above = inc - tot;
            const unsigned s3 = above + h3, s2 = s3 + h2, s1 = s2 + h1, s0 = s1 + h0;
            int bin = -1; unsigned gt = 0u;
            if (s3 >= k && above < k) { bin = 4 * l + 3; gt = above; } else if (s2 >= k && s3 < k) { bin = 4 * l + 2; gt = s3; } else if (s1 >= k && s2 < k) { bin = 4 * l + 1; gt = s2; } else if (s0 >= k && s1 < k) { bin = 4 * l; gt = s1; }
            if (bin >= 0) { misc[0] = prefix | ((unsigned)bin << sh); misc[1] = k - gt; }
        }
        __syncthreads();
    }
    const unsigned thr = misc[0], need = misc[1];
    unsigned gtc = 0, eqc = 0;
#pragma unroll
    for (int i = 0; i < 16; ++i) { const unsigned v = vals[tid * 16 + i]; gtc += v > thr; eqc += v == thr; }
    unsigned gi = gtc, ei = eqc; const int lane = fresh_lane(), wv = F.wave;
#pragma unroll
    for (int o = 1; o < 64; o <<= 1) { const unsigned g2 = __shfl_up(gi, o), e2 = __shfl_up(ei, o); if (lane >= o) { gi += g2; ei += e2; } }
    if (lane == 63) { wtot[wv] = gi; wtot[8 + wv] = ei; }
    __syncthreads();
    unsigned gbase = 0, ebase = 0, gtotal = 0;
    for (int w = 0; w < 8; ++w) { const unsigned g = wtot[w], q = wtot[8 + w]; if (w < wv) { gbase += g; ebase += q; } gtotal += g; }
    unsigned gpos = gbase + gi - gtc, epos = ebase + ei - eqc;
    int* IDX = (int*)(F.ws + WS_IDX) + (e * 2 + b) * 1024; float* GATE = (float*)(F.ws + WS_GATE) + (e * 2 + b) * 1024; int* SLOT = (int*)(F.ws + WS_SLOT);
#pragma unroll
    for (int i = 0; i < 16; ++i) { const int s = tid * 16 + i; const unsigned v = vals[s]; int c = -1;
        if (v > thr) c = (int)gpos++; else if (v == thr) { if (epos < need) c = (int)(gtotal + epos); ++epos; }
        if (c >= 0) { IDX[c] = b * S + s; GATE[c] = __uint_as_float(v); }
        SLOT[(size_t)(b * S + s) * 16 + e] = c >= 0 ? (e * 2 + b) * 1024 + c : -1; }
}
struct SchedP6a {
    __device__ __forceinline__ void a_ready(const gm::Unit&, int, int) const {}
    __device__ __forceinline__ void done(const gm::Unit&, int) const {}
    __device__ __forceinline__ void stamp(int, const gm::Unit&, int, int) const {}
    static constexpr bool GATHER = true;
    const char* A; const char* W; const int* idx; int G, vcu;
    __device__ __forceinline__ bool next(int i, gm::Unit& u) const {
        int e, pmu, pn;
        if (G == 256) { if (i >= 4) return false; const int xcd = vcu >> 5, j = vcu & 31; e = xcd + 8 * (i >> 1); const int sub = (i & 1) * 32 + j; pmu = sub >> 3; pn = sub & 7; }
        else { const int L = i * G + vcu; if (L >= 1024) return false; e = L >> 6; pmu = (L >> 3) & 7; pn = L & 7; }
        u.A = A; u.gidx = idx + e * 2048 + pmu * 256; u.lda2 = 2048; u.arow0 = 0; u.Bt = W + (size_t)e * 2048 * 2048; u.brow0 = pn * 256; u.ldb2 = 2048; u.nt = 16; u.pm = e * 8 + pmu; u.pn = pn; u.aux = e; return true; }
};
struct EpiP6a {
    static constexpr bool PERM = true;
    bf16_t* H;
    __device__ __forceinline__ void operator()(EPI_ARGS) const {
#pragma unroll
        for (int ai = 0; ai < 2; ++ai)
#pragma unroll
            for (int m = 0; m < 4; ++m) { const size_t row = (size_t)u.pm * 256 + ai * 128 + wr * 64 + m * 16 + fr;
                f32x4 h0, h1;
#pragma unroll
                for (int j = 0; j < 4; ++j) { h0[j] = siluf(acc[ai][0][m][0][j]) * acc[ai][1][m][0][j]; h1[j] = siluf(acc[ai][0][m][1][j]) * acc[ai][1][m][1][j]; }
                *(u32x4*)(H + row * 1024 + u.pn * 128 + wc * 32 + 8 * fq) = pack8(h0, h1); }
    }
};
struct SchedP6b {
    __device__ __forceinline__ void a_ready(const gm::Unit&, int, int) const {}
    __device__ __forceinline__ void done(const gm::Unit&, int) const {}
    __device__ __forceinline__ void stamp(int, const gm::Unit&, int, int) const {}
    static constexpr bool GATHER = false;
    const char* A; const char* W; int G, vcu;
    __device__ __forceinline__ bool next(int i, gm::Unit& u) const {
        int e, pmu, pn;
        if (G == 256) { if (i >= 2) return false; const int xcd = vcu >> 5, j = vcu & 31; e = xcd + 8 * i; pmu = j >> 2; pn = j & 3; }
        else { const int L = i * G + vcu; if (L >= 512) return false; e = L >> 5; pmu = (L >> 2) & 7; pn = L & 3; }
        u.A = A; u.gidx = nullptr; u.lda2 = 2048; u.arow0 = (e * 8 + pmu) * 256; u.Bt = W + (size_t)e * 1024 * 2048; u.brow0 = pn * 256; u.ldb2 = 2048; u.nt = 16; u.pm = e * 8 + pmu; u.pn = pn; u.aux = e; return true; }
};
struct EpiP6b {
    static constexpr bool PERM = true;
    bf16_t* Y; const float* gate;
    __device__ __forceinline__ void operator()(EPI_ARGS) const {
#pragma unroll
        for (int ai = 0; ai < 2; ++ai)
#pragma unroll
            for (int m = 0; m < 4; ++m) { const size_t row = (size_t)u.pm * 256 + ai * 128 + wr * 64 + m * 16 + fr; const float g = gate[row];
#pragma unroll
                for (int bj = 0; bj < 2; ++bj) *(u32x4*)(Y + row * 1024 + u.pn * 256 + bj * 128 + wc * 32 + 8 * fq) = pack8(acc[ai][bj][m][0] * g, acc[ai][bj][m][1] * g); }
    }
};
__device__ __forceinline__ void p7_final(Frame& F) {
    const float* modf = (const float*)(F.ws + WS_MODF); const int* SLOT = (const int*)(F.ws + WS_SLOT); const bf16_t* Y = (const bf16_t*)(F.ws + WS_Y);
    const int gw = F.vcu * NWAVES + F.wave, NGW = F.G * NWAVES, lane = fresh_lane();
    for (int m0 = gw; m0 < T; m0 += 2 * NGW) {
        const int m1 = m0 + NGW; const bool has1 = m1 < T; const int mm1 = has1 ? m1 : m0;
        f32x4* xr0 = (f32x4*)(F.out + (size_t)m0 * D) + lane; f32x4* xr1 = (f32x4*)(F.out + (size_t)mm1 * D) + lane; f32x4 v0[4], v1[4], a0[4], a1[4];
#pragma unroll
        for (int j = 0; j < 4; ++j) { v0[j] = xr0[64 * j]; v1[j] = xr1[64 * j]; a0[j] = (f32x4){0.f, 0.f, 0.f, 0.f}; a1[j] = (f32x4){0.f, 0.f, 0.f, 0.f}; }
        const int sl0 = lane < 16 ? SLOT[(size_t)m0 * 16 + lane] : -1, sl1 = lane < 16 ? SLOT[(size_t)mm1 * 16 + lane] : -1;
        for (int e = 0; e < 16; ++e) { const int s0 = __shfl(sl0, e), s1 = __shfl(sl1, e);
            if (s0 >= 0) { const u32x2* yr = (const u32x2*)(Y + (size_t)s0 * 1024) + lane;
#pragma unroll
                for (int j = 0; j < 4; ++j) { const u32x2 w = yr[64 * j]; a0[j].x += __uint_as_float(w.x << 16); a0[j].y += __uint_as_float(w.x & 0xffff0000u); a0[j].z += __uint_as_float(w.y << 16); a0[j].w += __uint_as_float(w.y & 0xffff0000u); } }
            if (s1 >= 0) { const u32x2* yr = (const u32x2*)(Y + (size_t)s1 * 1024) + lane;
#pragma unroll
                for (int j = 0; j < 4; ++j) { const u32x2 w = yr[64 * j]; a1[j].x += __uint_as_float(w.x << 16); a1[j].y += __uint_as_float(w.x & 0xffff0000u); a1[j].z += __uint_as_float(w.y << 16); a1[j].w += __uint_as_float(w.y & 0xffff0000u); } } }
        float ss0 = 0.f, ss1 = 0.f; const int b0 = m0 >> 13, b1 = mm1 >> 13;
#pragma unroll
        for (int j = 0; j < 4; ++j) { const f32x4 g0 = *(const f32x4*)(modf + b0 * 6144 + 5120 + 4 * lane + 256 * j), g1 = *(const f32x4*)(modf + b1 * 6144 + 5120 + 4 * lane + 256 * j);
            v0[j] = v0[j] + g0 * a0[j]; v1[j] = v1[j] + g1 * a1[j];
            ss0 += (v0[j].x * v0[j].x + v0[j].y * v0[j].y) + (v0[j].z * v0[j].z + v0[j].w * v0[j].w); ss1 += (v1[j].x * v1[j].x + v1[j].y * v1[j].y) + (v1[j].z * v1[j].z + v1[j].w * v1[j].w); }
        const float r0 = rsqrtf(wave_sum(ss0) * (1.f / D) + EPS), r1 = rsqrtf(wave_sum(ss1) * (1.f / D) + EPS);
#pragma unroll
        for (int j = 0; j < 4; ++j) { const f32x4 g = *(const f32x4*)(F.g_final + 4 * lane + 256 * j); xr0[64 * j] = v0[j] * r0 * g; if (has1) xr1[64 * j] = v1[j] * r1 * g; }
    }
}
}
#ifndef MLA_STAG
#define MLA_STAG mla_unit_v9
#endif
#ifndef MLA_V4
#define MLA_V4 1
#endif
#ifndef MERGE_P12
#define MERGE_P12 1
#endif
#ifndef DIL_PIPE
#define DIL_PIPE 1
#endif
#ifndef MLA_UNIT
#define MLA_UNIT mla_unit_v2
#endif
namespace mk {
namespace cg = cooperative_groups;
__global__ void __launch_bounds__(NTHREADS, 2) mega(Args args) {
    extern __shared__ __attribute__((aligned(16))) unsigned char lds_raw[];
    cg::grid_group grid = cg::this_grid();
    Frame F;
    F.lds = (LAS unsigned char*)lds_raw; F.ws = args.ws; F.out = args.out;
    F.wave = __builtin_amdgcn_readfirstlane((int)(threadIdx.x >> 6));
    F.G = gridDim.x; { const int bx = blockIdx.x; F.vcu = (F.G % 8 == 0) ? (bx % 8) * (F.G / 8) + bx / 8 : bx; }
    F.x = (const float*)args.in[0]; F.c = (const float*)args.in[1]; F.pos = (const int*)args.in[2]; F.w_ada = (const float*)args.in[3]; F.b_ada = (const float*)args.in[4];
    F.g_mix = (const float*)args.in[5]; F.w_in = (const float*)args.in[6]; F.g_q = (const float*)args.in[7]; F.w_uq = (const float*)args.in[8]; F.g_kv = (const float*)args.in[9];
    F.w_ukv = (const float*)args.in[10]; F.w_out = (const float*)args.in[11]; F.g_ffn = (const float*)args.in[12]; F.w_router = (const float*)args.in[13]; F.b_router = (const float*)args.in[14];
    F.w_gate = (const float*)args.in[15]; F.w_up = (const float*)args.in[16]; F.w_down = (const float*)args.in[17]; F.g_final = (const float*)args.in[18];
    const int lo = args.ph_lo, hi = args.ph_hi;
    volatile LAS unsigned* MISC = (volatile LAS unsigned*)(F.lds + LDS_BYTES - 256);
    { const int l0 = fresh_lane(); if (F.wave == 0) MISC[l0] = 0u; }
    __syncthreads();
    XcdBarrier xbar = xcd_barrier_post((unsigned*)(F.ws + WS_CTL) + 1024 + args.li * 4096, MISC + 8, F.wave == 0 && fresh_lane() == 0);
#define IN(k) (lo <= (k) && (k) < hi)
#ifndef CG_SEAMS
#define CG_SEAMS 0x000
#endif
#define SEAM(k) do { if (IN(k) && IN((k) + 1)) { if ((CG_SEAMS >> (k)) & 1) grid.sync(); else xcd_barrier(xbar, F.wave == 0 && fresh_lane() == 0); } } while (0)
    if (IN(0)) { p0_prologue(F); } SEAM(0);
    if (IN(1)) { p0b_rows(F); } SEAM(1);
#if MERGE_P12
    if (IN(2)) {
#if P12_STAMP
        if (F.wave == 0 && fresh_lane() == 0) { unsigned long long* ts = (unsigned long long*)(F.ws + 128 * KiB) + (size_t)blockIdx.x * 8; ts[0] = __builtin_amdgcn_s_memrealtime(); ts[7] = 0; }
#endif
        SchedP12 S{(const char*)(F.ws + WS_HB), (const char*)(F.ws + WS_WIN), (const char*)(F.ws + WS_CQ), (const char*)(F.ws + WS_WUQ), (const char*)(F.ws + WS_WUKV), (unsigned*)(F.ws + WS_PCNT), F.G, F.vcu, (int)blockIdx.x};
        EpiP12 E{F.ws}; gm::gemm_phase<EpiP12, SchedP12>(F.lds, S, E, F.wave); } SEAM(3);
#else
    if (IN(2)) { SchedP1 S{(const char*)(F.ws + WS_HB), (const char*)(F.ws + WS_WIN), F.G, (int)blockIdx.x}; EpiP1 E{F.ws}; gm::gemm_phase<EpiP1, SchedP1>(F.lds, S, E, F.wave); } SEAM(2);
    if (IN(3)) { SchedP2 S{(const char*)(F.ws + WS_CQ), (const char*)(F.ws + WS_WUQ), (const char*)(F.ws + WS_WUKV), F.G, (int)blockIdx.x}; EpiP2 E{F.ws}; gm::gemm_phase<EpiP2, SchedP2>(F.lds, S, E, F.wave); } SEAM(3);
#endif
    if (IN(4)) {
        const unsigned short* DQ = (const unsigned short*)(F.ws + WS_DQ); const unsigned short* DK = (const unsigned short*)(F.ws + WS_DK); const unsigned short* DV = (const unsigned short*)(F.ws + WS_DV);
        unsigned short* OBR = (unsigned short*)F.out; float* LSE = (float*)(F.ws + WS_LSE);
        const int cslot = F.vcu % 3;
        if (EXP_IN_ATTN && cslot == 0) exp_convert(F);
        if (args.pad & 1) { if (DIL_PIPE) at::dil_phase(F.wave, F.vcu, F.G, 1536, DQ, DK, DV, OBR, LSE, (char*)lds_raw); else for (int u = F.vcu; u < 1536; u += F.G) { const int blk = u & 31, br = (u >> 5) % 3, bh = u / 96; at::dil_unit(F.wave, bh, br, blk, DQ, DK, DV, OBR, LSE, (char*)lds_raw); } }
        if (EXP_IN_ATTN && cslot == 1) exp_convert(F);
        const bool has2 = (args.pad & 2) && (F.vcu + F.G < 512);
        if (EXP_IN_ATTN && cslot == 2 && !has2) exp_convert(F);
        if (args.pad & 2) for (int u = F.vcu; u < 512; u += F.G) { const int bh = (u >> 8) * 8 + ((u & 255) >> 5), qb = u & 31;
            if (EXP_IN_ATTN && cslot == 2 && has2 && u == F.vcu + F.G) exp_convert(F);
            #if MLA_V4
            at::MLA_STAG(F.wave, bh, qb, (const unsigned short*)(F.ws + WS_Q), (const unsigned short*)(F.ws + WS_KN), (const unsigned short*)(F.ws + WS_KR), (const unsigned short*)(F.ws + WS_V), (unsigned short*)(F.ws + WS_HB), (const float*)(F.ws + WS_KMX), (char*)lds_raw, (u == F.vcu) ? (unsigned long long*)(F.ws + WS_CTL + 60 * 1024) : nullptr); }
#else
            at::mla_unit_v2(F.wave, bh, qb, (const unsigned short*)(F.ws + WS_Q), (const unsigned short*)(F.ws + WS_KN), (const unsigned short*)(F.ws + WS_KR), (const unsigned short*)(F.ws + WS_V), (unsigned short*)(F.ws + WS_HB), (const float*)(F.ws + WS_KMX), (char*)lds_raw, (u == F.vcu) ? (unsigned long long*)(F.ws + WS_CTL + 60 * 1024) : nullptr); }
#endif
    } SEAM(4);
    if (IN(5)) { at::dil_combine((const unsigned short*)F.out, (const float*)(F.ws + WS_LSE), (unsigned short*)(F.ws + WS_HB), F.vcu * NTHREADS + F.wave * 64 + fresh_lane(), F.G * NTHREADS); } SEAM(5);
    if (IN(6)) { SchedP4 S{(const char*)(F.ws + WS_HB), (const char*)(F.ws + WS_WOUT), F.G, (int)blockIdx.x}; EpiP4 E{F.x, F.out, (const float*)(F.ws + WS_MODF)}; gm::gemm_phase<EpiP4, SchedP4>(F.lds, S, E, F.wave); } SEAM(6);
    if (IN(7)) { p4b_rows(F); } SEAM(7);
    if (IN(8)) { p5_topk(F); } SEAM(8);
    if (IN(9)) { SchedP6a S{(const char*)(F.ws + WS_HB), (const char*)(F.ws + WS_WGU), (const int*)(F.ws + WS_IDX), F.G, F.vcu}; EpiP6a E{(bf16_t*)(F.ws + WS_HBUF)}; gm::gemm_phase<EpiP6a, SchedP6a>(F.lds, S, E, F.wave); } SEAM(9);
    if (IN(10)) { SchedP6b S{(const char*)(F.ws + WS_HBUF), (const char*)(F.ws + WS_WD), F.G, F.vcu}; EpiP6b E{(bf16_t*)(F.ws + WS_Y), (const float*)(F.ws + WS_GATE)}; gm::gemm_phase<EpiP6b, SchedP6b>(F.lds, S, E, F.wave); } SEAM(10);
    if (IN(11)) { p7_final(F); }
#undef IN
#undef SEAM
}
}
extern "C" void kernel_launch(void* const* d_in, const int* in_sizes, int n_in, void* d_out, int out_size, void* d_ws, size_t ws_size, hipStream_t stream) {
    using namespace mk;
    static int grid = 0;
    if (grid == 0) {
        if (n_in != 19 || out_size != T * D || in_sizes[0] != T * D || ws_size < WS_END) { fprintf(stderr, "kernel_launch: built for 19 inputs, x/out of %d floats and >= %zu bytes of workspace; got n_in %d out %d ws %zu; nothing launched\n", T * D, (size_t)WS_END, n_in, out_size, ws_size); grid = -1; return; }
        int dev = 0, cus = 0, per_cu = 0;
        if (hipGetDevice(&dev) != hipSuccess || hipDeviceGetAttribute(&cus, hipDeviceAttributeMultiprocessorCount, dev) != hipSuccess || cus < 32) { fprintf(stderr, "kernel_launch: device query failed\n"); grid = -1; return; }
        if (hipFuncSetAttribute((const void*)mega, hipFuncAttributeMaxDynamicSharedMemorySize, LDS_BYTES) != hipSuccess) { fprintf(stderr, "kernel_launch: hipFuncSetAttribute(%d B LDS) failed\n", LDS_BYTES); grid = -1; return; }
        if (hipOccupancyMaxActiveBlocksPerMultiprocessor(&per_cu, (const void*)mega, NTHREADS, LDS_BYTES) != hipSuccess || per_cu < 1) { fprintf(stderr, "kernel_launch: occupancy query reports %d workgroups per CU\n", per_cu); grid = -1; return; }
        grid = cus;
    }
    if (grid < 0) return;
    if (hipMemsetAsync((char*)d_ws + WS_CTL, 0, 64 * KiB, stream) != hipSuccess) { fprintf(stderr, "kernel_launch: memset failed\n"); return; }
    Args a{}; for (int i = 0; i < 19; ++i) a.in[i] = d_in[i]; a.out = (float*)d_out; a.ws = (unsigned char*)d_ws;
    a.pad = 3; a.ph_lo = 0; a.ph_hi = 12; a.li = 0;
    void* kargs[] = {&a};
    const hipError_t e = hipLaunchCooperativeKernel((const void*)mega, dim3(grid), dim3(NTHREADS), kargs, LDS_BYTES, stream);
    if (e != hipSuccess) fprintf(stderr, "kernel_launch: cooperative launch failed: %s (grid %d)\n", hipGetErrorString(e), grid);
}
```

```cpp
#include <hip/hip_runtime.h>
#include <hip/hip_cooperative_groups.h>
#include <hip/hip_bf16.h>
#include <cstdio>
#include <cstdint>
#include <cmath>
namespace gm {
#define LAS __attribute__((address_space(3)))
typedef unsigned short bf16_t;
typedef short bf16x8 __attribute__((ext_vector_type(8)));
typedef float f32x4 __attribute__((ext_vector_type(4)));
typedef float f32x2 __attribute__((ext_vector_type(2)));
typedef unsigned u32x4 __attribute__((ext_vector_type(4)));
typedef unsigned u32x2 __attribute__((ext_vector_type(2)));
constexpr int BM = 256, BK = 64, HALF = 128, HTB = HALF * BK * 2, STAGE_BYTES = 8 * HTB;

__device__ __forceinline__ int lds_byte(int r, int c) { const int st = (r >> 4) * 2 + (c >> 5), rr = r & 15, cc = c & 31, ob = rr * 64 + cc * 2; return st * 1024 + (ob ^ (((ob >> 9) & 1) << 5)); }
__device__ __forceinline__ void stage_rc(int b, int& R, int& C) { const int st = b / 1024, sb = b % 1024, swz = sb ^ (((sb >> 9) & 1) << 5); R = (st >> 1) * 16 + swz / 64; C = (st & 1) * 32 + (swz % 64) / 2; }
__device__ __forceinline__ int perm32(int rho) { const int n = rho >> 4, i = rho & 15; return 8 * (i >> 2) + 4 * n + (i & 3); }
__device__ __forceinline__ int lane_now() { int l; asm volatile("v_mbcnt_lo_u32_b32 %0, -1, 0\n\tv_mbcnt_hi_u32_b32 %0, -1, %0" : "=v"(l)); return l; }
__device__ __forceinline__ unsigned cvt_pk_bf16(float lo, float hi) { unsigned r; asm volatile("v_cvt_pk_bf16_f32 %0, %1, %2" : "=v"(r) : "v"(lo), "v"(hi)); return r; }

struct Unit {
    const char* A; const char* Bt; const int* gidx;
    unsigned lda2, ldb2;
    int arow0, brow0, nt;
    int pm, pn, aux;
};

template <class Epi, class Sched>
__device__ __forceinline__ void gemm_phase(LAS unsigned char* lds, const Sched& S, const Epi& E, int wave_sgpr) {
    constexpr bool GATHER = Sched::GATHER;
    const int wid = wave_sgpr, lane = lane_now(), tid = wid * 64 + lane, wr = wid >> 2, wc = wid & 3, fr = lane & 15, fq = lane >> 4;
    int sR[2], sC[2], sRb[2];
#pragma unroll
    for (int i = 0; i < 2; ++i) { int R, C; stage_rc(tid * 16 + i * 8192, R, C); sR[i] = R; sC[i] = C * 2; sRb[i] = Epi::PERM ? ((R & ~31) + perm32(R & 31)) : R; }
    const unsigned ldsw = (unsigned)wid * 1024u;
    const int aoff = lds_byte(wr * 64 + fr, fq * 8), boff = lds_byte(wc * 32 + fr, fq * 8);
#define GM_SA(b, h) (((b) * 2 + (h)) * HTB)
#define GM_SB(b, h) ((4 + (b) * 2 + (h)) * HTB)
#define GM_GLDS(src, dstoff) __builtin_amdgcn_global_load_lds((const unsigned*)(src), (LAS unsigned*)(lds + (dstoff)), 16, 0, 0)
#define GM_STAGE_B(bufoff, p, ld, h) do { _Pragma("unroll") for (int i_ = 0; i_ < 2; ++i_) \
        GM_GLDS((p) + ((unsigned)((h) * HALF + sRb[i_]) * (ld) + (unsigned)sC[i_]), (bufoff) + ldsw + i_ * 8192); } while (0)
#define GM_STAGE_A(bufoff, p, ld, h, g) do { _Pragma("unroll") for (int i_ = 0; i_ < 2; ++i_) { \
        const unsigned o_ = GATHER ? (g)[h][i_] + (unsigned)sC[i_] : (unsigned)((h) * HALF + sR[i_]) * (ld) + (unsigned)sC[i_]; \
        GM_GLDS((p) + o_, (bufoff) + ldsw + i_ * 8192); } } while (0)
#define GM_LDA(dst, b, h) do { _Pragma("unroll") for (int m = 0; m < 4; ++m) _Pragma("unroll") for (int k = 0; k < 2; ++k) dst[m][k] = *(const LAS bf16x8*)(lds + GM_SA(b, h) + aoff + m * 2048 + k * 1024); } while (0)
#define GM_LDB(dst, b, h) do { _Pragma("unroll") for (int n = 0; n < 2; ++n) _Pragma("unroll") for (int k = 0; k < 2; ++k) dst[n][k] = *(const LAS bf16x8*)(lds + GM_SB(b, h) + boff + n * 2048 + k * 1024); } while (0)
#define GM_MMA(ai, bj, At, Bt) do { __builtin_amdgcn_s_setprio(1); _Pragma("unroll") for (int m = 0; m < 4; ++m) _Pragma("unroll") for (int n = 0; n < 2; ++n) _Pragma("unroll") for (int k = 0; k < 2; ++k) \
        acc[ai][bj][m][n] = __builtin_amdgcn_mfma_f32_16x16x32_bf16(Bt[n][k], At[m][k], acc[ai][bj][m][n], 0, 0, 0); __builtin_amdgcn_s_setprio(0); } while (0)
#define GM_WAIT_V(n) asm volatile("s_waitcnt vmcnt(" #n ")" ::: "memory")
#define GM_WAIT_L(n) asm volatile("s_waitcnt lgkmcnt(" #n ")" ::: "memory")
#define GM_BAR __builtin_amdgcn_s_barrier()
#define GM_SCHED __builtin_amdgcn_sched_barrier(0)
#define GM_GOFFS(u, g) do { if (GATHER) { _Pragma("unroll") for (int h_ = 0; h_ < 2; ++h_) _Pragma("unroll") for (int i_ = 0; i_ < 2; ++i_) g[h_][i_] = (unsigned)(u).gidx[h_ * HALF + sR[i_]] * (u).lda2; } } while (0)
#define GM_ABASE(u) ((u).A + (GATHER ? (size_t)0 : (size_t)(u).arow0 * (u).lda2))
#define GM_BBASE(u) ((u).Bt + (size_t)(u).brow0 * (u).ldb2)
    Unit cur, nxt; int ui = 0;
    if (!S.next(0, cur)) return;
    f32x4 acc[2][2][4][2];
#pragma unroll
    for (int a = 0; a < 2; ++a)
#pragma unroll
        for (int b = 0; b < 2; ++b)
#pragma unroll
            for (int m = 0; m < 4; ++m)
#pragma unroll
                for (int n = 0; n < 2; ++n) acc[a][b][m][n] = (f32x4){0.f, 0.f, 0.f, 0.f};
    bf16x8 At[4][2], B0[2][2], B1[2][2];
    unsigned gc[2][2] = {{0u, 0u}, {0u, 0u}}, gn[2][2] = {{0u, 0u}, {0u, 0u}};
    GM_GOFFS(cur, gc);
    const char* cA = GM_ABASE(cur); const char* cB = GM_BBASE(cur); unsigned cla = cur.lda2, clb = cur.ldb2;
    GM_STAGE_B(GM_SB(0, 0), cB, clb, 0); GM_STAGE_B(GM_SB(0, 1), cB, clb, 1); GM_STAGE_A(GM_SA(0, 0), cA, cla, 0, gc); GM_STAGE_A(GM_SA(0, 1), cA, cla, 1, gc);
    if (wr == 1) GM_BAR;
    GM_WAIT_V(2); GM_BAR;
    GM_STAGE_B(GM_SB(1, 0), cB + 128, clb, 0); GM_STAGE_A(GM_SA(1, 0), cA + 128, cla, 0, gc); GM_STAGE_B(GM_SB(1, 1), cB + 128, clb, 1);
    GM_WAIT_V(6); GM_BAR;
    for (;;) {
        const bool has_next = S.next(ui + 1, nxt);
        const char* nA = cA; const char* nB = cB; unsigned nla = cla, nlb = clb;
        if (has_next) { GM_GOFFS(nxt, gn); nA = GM_ABASE(nxt); nB = GM_BBASE(nxt); nla = nxt.lda2; nlb = nxt.ldb2; }
        else if (GATHER) {
#pragma unroll
            for (int h = 0; h < 2; ++h)
#pragma unroll
                for (int i = 0; i < 2; ++i) gn[h][i] = gc[h][i];
        }
        const int nt = cur.nt;
        for (int t = 0; t < nt; t += 2) {
            const bool last = (t == nt - 2);
            if (last && has_next) S.a_ready(nxt, wid, ui + 1);
            const char* a1 = cA + (size_t)(t + 1) * 128;
            const char* a2 = last ? nA : cA + (size_t)(t + 2) * 128; const char* b2 = last ? nB : cB + (size_t)(t + 2) * 128;
            const char* a3 = a2 + 128; const char* b3 = b2 + 128;
            const unsigned la2 = last ? nla : cla, lb2 = last ? nlb : clb;
            unsigned g2[2][2];
#pragma unroll
            for (int h = 0; h < 2; ++h)
#pragma unroll
                for (int i = 0; i < 2; ++i) g2[h][i] = GATHER ? (last ? gn[h][i] : gc[h][i]) : 0u;
            GM_LDB(B0, 0, 0); GM_LDB(B1, 0, 1); GM_SCHED; GM_LDA(At, 0, 0); GM_STAGE_A(GM_SA(1, 1), a1, cla, 1, gc);
            GM_WAIT_V(8); GM_WAIT_L(0); GM_BAR; GM_MMA(0, 0, At, B0); GM_MMA(0, 1, At, B1); GM_BAR; GM_SCHED;
            GM_LDA(At, 0, 1); GM_STAGE_B(GM_SB(0, 0), b2, lb2, 0); GM_STAGE_B(GM_SB(0, 1), b2, lb2, 1); GM_STAGE_A(GM_SA(0, 0), a2, la2, 0, g2);
            GM_WAIT_V(8); GM_WAIT_L(0); GM_BAR; GM_MMA(1, 0, At, B0); GM_MMA(1, 1, At, B1); GM_BAR; GM_SCHED;
            GM_LDB(B0, 1, 0); GM_LDB(B1, 1, 1); GM_SCHED; GM_LDA(At, 1, 0); GM_STAGE_A(GM_SA(0, 1), a2, la2, 1, g2);
            GM_WAIT_V(8); GM_WAIT_L(0); GM_BAR; GM_MMA(0, 0, At, B0); GM_MMA(0, 1, At, B1); GM_BAR; GM_SCHED;
            GM_LDA(At, 1, 1); GM_STAGE_B(GM_SB(1, 0), b3, lb2, 0); GM_STAGE_B(GM_SB(1, 1), b3, lb2, 1); GM_STAGE_A(GM_SA(1, 0), a3, la2, 0, g2);
            GM_WAIT_V(8); GM_WAIT_L(0); GM_BAR; GM_MMA(1, 0, At, B0); GM_MMA(1, 1, At, B1); GM_BAR; GM_SCHED;
        }
        if (wr == 0) GM_BAR;
        E(acc, cur, wr, wc, fr, fq, lane);
        S.done(cur, lane);
        S.stamp(ui, cur, wid, lane);
        if (!has_next) break;
#pragma unroll
        for (int a = 0; a < 2; ++a)
#pragma unroll
            for (int b = 0; b < 2; ++b)
#pragma unroll
                for (int m = 0; m < 4; ++m)
#pragma unroll
                    for (int n = 0; n < 2; ++n) acc[a][b][m][n] = (f32x4){0.f, 0.f, 0.f, 0.f};
        cur = nxt; cA = nA; cB = nB; cla = nla; clb = nlb; ++ui;
        if (GATHER) {
#pragma unroll
            for (int h = 0; h < 2; ++h)
#pragma unroll
                for (int i = 0; i < 2; ++i) gc[h][i] = gn[h][i];
        }
        if (wr == 1) GM_BAR;
    }
    GM_WAIT_V(0);
    GM_BAR;
#undef GM_SA
#undef GM_SB
#undef GM_GLDS
#undef GM_STAGE_A
#undef GM_STAGE_B
#undef GM_LDA
#undef GM_LDB
#undef GM_MMA
#undef GM_WAIT_V
#undef GM_WAIT_L
#undef GM_BAR
#undef GM_SCHED
#undef GM_GOFFS
#undef GM_ABASE
#undef GM_BBASE
}
}
namespace mk {
using gm::bf16_t; using gm::f32x4; using gm::f32x2; using gm::u32x4; using gm::u32x2; using gm::cvt_pk_bf16;
constexpr int T = 16384, S = 8192, D = 1024, NB = 2, NH = 8, NWAVES = 8, NTHREADS = 512;
constexpr float EPS = 1e-6f;
constexpr size_t KiB = 1024, MiB = 1u << 20;
constexpr size_t WS_CTL = 0;
constexpr size_t WS_KMX = 48 * KiB;
constexpr size_t WS_MODP = 1 * MiB;
constexpr size_t WS_MODF = 2 * MiB;
constexpr size_t WS_TABM = WS_MODF + 64 * KiB;
constexpr size_t WS_TABD = WS_TABM + 2 * MiB;
constexpr size_t WS_SSQ = WS_TABD + 1 * MiB;
constexpr size_t WS_KR = WS_SSQ + 1536 * KiB;
constexpr size_t WS_AFF = WS_KR + 1 * MiB;
constexpr size_t WS_IDX = WS_AFF + 1 * MiB;
constexpr size_t WS_GATE = WS_IDX + 128 * KiB;
constexpr size_t WS_SLOT = WS_GATE + 128 * KiB;
constexpr size_t WS_LSE = WS_SLOT + 1 * MiB;
constexpr size_t WS_WUQ = WS_LSE + 1536 * KiB;
constexpr size_t WS_WUKV = WS_WUQ + 576 * KiB;
constexpr size_t WS_WOUT = WS_WUKV + 512 * KiB;
constexpr size_t WS_WIN = WS_WOUT + 2 * MiB;
constexpr size_t WS_R0END = WS_WIN + 4608 * KiB;
static_assert(WS_R0END <= 20 * MiB, "R0");
constexpr size_t WS_HB = 20 * MiB;
constexpr size_t WS_CQ = 52 * MiB;
constexpr size_t WS_DQ = WS_CQ + 24 * MiB, WS_DK = WS_DQ + 16 * MiB, WS_DV = WS_DK + 16 * MiB;
constexpr size_t WS_Q = WS_DV + 16 * MiB;
constexpr size_t WS_KN = WS_Q + 24 * MiB, WS_V = WS_KN + 16 * MiB;
constexpr size_t WS_HBUF = WS_CQ;
constexpr size_t WS_WGU = 180 * MiB;
constexpr size_t WS_Y = WS_WGU;
constexpr size_t WS_WD = 244 * MiB;
constexpr size_t WS_END = 276 * MiB;
static_assert(WS_V + 16 * MiB == 180 * MiB, "arena");
constexpr int LDS_BYTES = 147456;

__device__ __forceinline__ float wave_sum(float v) {
#pragma unroll
    for (int o = 1; o < 64; o <<= 1) v += __shfl_xor(v, o);
    return v;
}
__device__ __forceinline__ unsigned f2bf(float f) { unsigned u = __builtin_bit_cast(unsigned, f); return (u + 0x7fffu + ((u >> 16) & 1u)) >> 16; }
__device__ __forceinline__ unsigned pk2(float lo, float hi) { return f2bf(lo) | (f2bf(hi) << 16); }
__device__ __forceinline__ float bf2f(unsigned short b) { return __builtin_bit_cast(float, (unsigned)b << 16); }
__device__ __forceinline__ float siluf(float v) { return v / (1.f + __expf(-v)); }
#define LDS_WAIT() asm volatile("s_waitcnt lgkmcnt(0)" ::: "memory")
__device__ __forceinline__ int fresh_lane() { return gm::lane_now(); }

struct Args { const void* in[19]; float* out; unsigned char* ws; int ph_lo, ph_hi, li, pad; };
struct Frame {
    LAS unsigned char* lds; unsigned char* ws; float* out;
    int wave, vcu, G;
    const float *x, *c; const int* pos; const float *w_ada, *b_ada, *g_mix, *w_in, *g_q, *w_uq, *g_kv, *w_ukv, *w_out, *g_ffn, *w_router, *b_router, *w_gate, *w_up, *w_down, *g_final;
};

__device__ __forceinline__ float inv_freq_m(int i) { return (float)exp2(-(double)i * (18.931568569324174 / 16.0)); }
__device__ __forceinline__ float inv_freq_d(int i) { return (float)exp2(-(double)i * (18.931568569324174 / 8.0)); }

#ifndef WD_IN_P5
#define WD_IN_P5 1
#endif
#ifndef EXP_IN_ATTN
#define EXP_IN_ATTN 1
#endif
__device__ __forceinline__ void p0_transpose_item(const float* W, int ldw, int K, int k0, int n0, bf16_t* WT, int drow, const float* kscale, LAS float* scr, int lane) {
    f32x4 v[8];
#pragma unroll
    for (int i = 0; i < 8; ++i) v[i] = *(const f32x4*)(W + (size_t)(k0 + 8 * i + (lane >> 3)) * ldw + n0 + 4 * (lane & 7));
#pragma unroll
    for (int i = 0; i < 8; ++i) { const int kk = 8 * i + (lane >> 3); f32x4 x = v[i]; if (kscale) x = x * kscale[k0 + kk]; LAS float* d = scr + kk * 33 + 4 * (lane & 7); d[0] = x.x; d[1] = x.y; d[2] = x.z; d[3] = x.w; }
    LDS_WAIT(); asm volatile("" ::: "memory");
    const int c = lane & 7;
#pragma unroll
    for (int j = 0; j < 4; ++j) { const int n = (lane >> 3) + 8 * j; const LAS float* s = scr + (8 * c) * 33 + n;
        u32x4 o; o.x = pk2(s[0 * 33], s[1 * 33]); o.y = pk2(s[2 * 33], s[3 * 33]); o.z = pk2(s[4 * 33], s[5 * 33]); o.w = pk2(s[6 * 33], s[7 * 33]);
        *(u32x4*)(WT + (size_t)(drow + n) * K + k0 + 8 * c) = o; }
    LDS_WAIT(); asm volatile("" ::: "memory");
}
__device__ __forceinline__ void p0_prologue(Frame& F) {
    LAS float* scr = (LAS float*)(F.lds + F.wave * 16384);
    const int gw = F.vcu * NWAVES + F.wave, NGW = F.G * NWAVES, lane = fresh_lane();
    unsigned char* ws = F.ws;
    constexpr int I_MOD = 24 * 16, I_IN = 16 * 69, I_UQ = 6 * 24, I_UKV = 4 * 32, I_OUT = 16 * 32, I_EXP = 16 * 16 * 32, I_PAD = 96, I_TAB = T * 24 / 64;
    constexpr int NITEMS = I_MOD + I_IN + I_UQ + I_UKV + I_OUT + (EXP_IN_ATTN ? 0 : 2) * I_EXP + (WD_IN_P5 ? 0 : 1) * I_EXP + I_PAD + I_TAB;
    for (int it = gw; it < NITEMS; it += NGW) {
        int r = it;
        if (r < I_MOD) {
            const int cc = r % 24, kc = r / 24; f32x4 a0 = {0.f, 0.f, 0.f, 0.f}, a1 = {0.f, 0.f, 0.f, 0.f};
            const float* wp = F.w_ada + (size_t)(kc * 64) * 6144 + cc * 256 + 4 * lane;
#pragma unroll 8
            for (int k = 0; k < 64; ++k) { const f32x4 w = *(const f32x4*)(wp + (size_t)k * 6144); const float s0 = siluf(F.c[kc * 64 + k]), s1 = siluf(F.c[1024 + kc * 64 + k]); a0 += w * s0; a1 += w * s1; }
            float* mp = (float*)(ws + WS_MODP) + (size_t)kc * 2 * 6144 + cc * 256 + 4 * lane;
            *(f32x4*)mp = a0; *(f32x4*)(mp + 6144) = a1; continue; }
        r -= I_MOD;
        if (r < I_IN) { const int kb = r / 69, nb = r % 69, n0 = nb * 32; p0_transpose_item(F.w_in, 2208, 1024, kb * 64, n0, (bf16_t*)(ws + WS_WIN), n0 < 672 ? n0 : n0 + 96, nullptr, scr, lane); continue; }
        r -= I_IN;
        if (r < I_UQ) { const int kb = r / 24, nb = r % 24, n0 = nb * 32, h = n0 / 96, d = n0 % 96; p0_transpose_item(F.w_uq, 768, 384, kb * 64, n0, (bf16_t*)(ws + WS_WUQ), d < 64 ? h * 64 + d : 512 + h * 32, F.g_q, scr, lane); continue; }
        r -= I_UQ;
        if (r < I_UKV) { const int kb = r / 32, nb = r % 32, n0 = nb * 32, h = n0 / 128, d = n0 % 128; p0_transpose_item(F.w_ukv, 1024, 256, kb * 64, n0, (bf16_t*)(ws + WS_WUKV), d < 64 ? h * 64 + d : 512 + h * 64 + (d - 64), F.g_kv, scr, lane); continue; }
        r -= I_UKV;
        if (r < I_OUT) { const int kb = r / 32, nb = r % 32; p0_transpose_item(F.w_out, 1024, 1024, kb * 64, nb * 32, (bf16_t*)(ws + WS_WOUT), nb * 32, nullptr, scr, lane); continue; }
        r -= I_OUT;
        if (!EXP_IN_ATTN) { if (r < 2 * I_EXP) { const int up = r >= I_EXP; const int q = up ? r - I_EXP : r; const int e = q / 512, kb = (q % 512) / 32, nb = q % 32, n0 = nb * 32;
            p0_transpose_item((up ? F.w_up : F.w_gate) + (size_t)e * 1048576, 1024, 1024, kb * 64, n0, (bf16_t*)(ws + WS_WGU) + (size_t)e * 2048 * 1024, (n0 / 128) * 256 + up * 128 + (n0 % 128), nullptr, scr, lane); continue; }
        r -= 2 * I_EXP; }
        if (!WD_IN_P5) { if (r < I_EXP) { const int e = r / 512, kb = (r % 512) / 32, nb = r % 32; p0_transpose_item(F.w_down + (size_t)e * 1048576, 1024, 1024, kb * 64, nb * 32, (bf16_t*)(ws + WS_WD) + (size_t)e * 1048576, nb * 32, nullptr, scr, lane); continue; }
        r -= I_EXP; }
        if (r < I_PAD) { u32x4 z = {0u, 0u, 0u, 0u}; u32x4* p = (u32x4*)((bf16_t*)(ws + WS_WIN) + (size_t)(672 + r) * 1024); p[lane] = z; p[64 + lane] = z; continue; }
        r -= I_PAD;
        {
            const int e = r * 64 + lane, tok = e / 24, f = e % 24; const int p = F.pos[tok];
            const float inv = f < 16 ? inv_freq_m(f) : inv_freq_d(f - 16); const float ang = (float)p * inv; const float cs = (float)cos((double)ang), sn = (float)sin((double)ang);
            if (f < 16) { float* tm = (float*)(ws + WS_TABM) + (size_t)tok * 32; tm[f] = cs; tm[16 + f] = sn; } else { float* td = (float*)(ws + WS_TABD) + (size_t)tok * 16; td[f - 16] = cs; td[8 + f - 16] = sn; }
        }
    }
}
__device__ __forceinline__ void exp_convert(Frame& F) {
    LAS float* scr = (LAS float*)(F.lds + F.wave * 16384); const int lane = fresh_lane();
    const int chunk = (16384 + F.G - 1) / F.G;
    for (int k = F.wave; k < chunk; k += NWAVES) { const int r = F.vcu * chunk + k; if (r >= 16384) break; const int up = r >= 8192; const int q = up ? r - 8192 : r; const int e = q / 512, kb = (q % 512) / 32, nb = q % 32, n0 = nb * 32;
        p0_transpose_item((up ? F.w_up : F.w_gate) + (size_t)e * 1048576, 1024, 1024, kb * 64, n0, (bf16_t*)(F.ws + WS_WGU) + (size_t)e * 2048 * 1024, (n0 / 128) * 256 + up * 128 + (n0 % 128), nullptr, scr, lane); }
    __syncthreads();
}
__device__ __forceinline__ void wd_convert(Frame& F, int first_vcu) {
    LAS float* scr = (LAS float*)(F.lds + F.wave * 16384);
    const int gw = (F.vcu - first_vcu) * NWAVES + F.wave, NGW = (F.G - first_vcu) * NWAVES, lane = fresh_lane();
    for (int r = gw; r < 16 * 16 * 32; r += NGW) { const int e = r / 512, kb = (r % 512) / 32, nb = r % 32;
        p0_transpose_item(F.w_down + (size_t)e * 1048576, 1024, 1024, kb * 64, nb * 32, (bf16_t*)(F.ws + WS_WD) + (size_t)e * 1048576, nb * 32, nullptr, scr, lane); }
}
__device__ __forceinline__ void p0b_rows(Frame& F) {
    const int tid_ = F.wave * 64 + fresh_lane();
    LAS float* A1 = (LAS float*)F.lds;
    LAS float* A0 = A1 + 2048;
    const float* mp = (const float*)(F.ws + WS_MODP);
#pragma unroll
    for (int half = 0; half < 2; ++half) { float s[4]; float pv[4][16];
#pragma unroll
        for (int q = 0; q < 4; ++q) { const int i = tid_ + NTHREADS * (half * 4 + q); const int b = i >> 11, n = ((i >> 10) & 1) * 1024 + (i & 1023);
#pragma unroll
            for (int k = 0; k < 16; ++k) pv[q][k] = mp[(size_t)k * 2 * 6144 + b * 6144 + n]; }
#pragma unroll
        for (int q = 0; q < 4; ++q) { const int i = tid_ + NTHREADS * (half * 4 + q); const int b = i >> 11, which = (i >> 10) & 1, j = i & 1023; s[q] = F.b_ada[which * 1024 + j];
#pragma unroll
            for (int k = 0; k < 16; ++k) s[q] += pv[q][k];
            if (which) A1[b * 1024 + j] = F.g_mix[j] * (1.f + s[q]); else A0[b * 1024 + j] = s[q]; } }
    if (blockIdx.x < 48 && tid_ < 256) { const int n = blockIdx.x * 256 + tid_; const int b = n / 6144, nn = n % 6144; float s = F.b_ada[nn];
#pragma unroll
        for (int k = 0; k < 16; ++k) s += mp[(size_t)k * 2 * 6144 + b * 6144 + nn];
        ((float*)(F.ws + WS_MODF))[n] = s; }
    __syncthreads();
    const int gw = F.vcu * NWAVES + F.wave, NGW = F.G * NWAVES, lane = fresh_lane();
    for (int m0 = gw; m0 < T; m0 += 2 * NGW) {
        const int m1 = m0 + NGW; const bool has1 = m1 < T; const int mm1 = has1 ? m1 : m0;
        const f32x4* xr0 = (const f32x4*)(F.x + (size_t)m0 * D) + lane; const f32x4* xr1 = (const f32x4*)(F.x + (size_t)mm1 * D) + lane; f32x4 v0[4], v1[4]; float s0 = 0.f, s1 = 0.f;
#pragma unroll
        for (int j = 0; j < 4; ++j) { v0[j] = xr0[64 * j]; v1[j] = xr1[64 * j]; }
#pragma unroll
        for (int j = 0; j < 4; ++j) { s0 += (v0[j].x * v0[j].x + v0[j].y * v0[j].y) + (v0[j].z * v0[j].z + v0[j].w * v0[j].w); s1 += (v1[j].x * v1[j].x + v1[j].y * v1[j].y) + (v1[j].z * v1[j].z + v1[j].w * v1[j].w); }
        const float r0 = rsqrtf(wave_sum(s0) * (1.f / D) + EPS), r1 = rsqrtf(wave_sum(s1) * (1.f / D) + EPS);
        const int b0 = m0 >> 13, b1 = mm1 >> 13;
        unsigned long long* o0 = (unsigned long long*)((bf16_t*)(F.ws + WS_HB) + (size_t)m0 * D) + lane; unsigned long long* o1 = (unsigned long long*)((bf16_t*)(F.ws + WS_HB) + (size_t)mm1 * D) + lane;
#pragma unroll
        for (int j = 0; j < 4; ++j) { const f32x4 a1 = *(const LAS f32x4*)(A1 + b0 * 1024 + 4 * lane + 256 * j), a0 = *(const LAS f32x4*)(A0 + b0 * 1024 + 4 * lane + 256 * j);
            const f32x4 o = v0[j] * r0 * a1 + a0; o0[64 * j] = (unsigned long long)pk2(o.x, o.y) | ((unsigned long long)pk2(o.z, o.w) << 32); }
        if (has1) {
#pragma unroll
            for (int j = 0; j < 4; ++j) { const f32x4 a1 = *(const LAS f32x4*)(A1 + b1 * 1024 + 4 * lane + 256 * j), a0 = *(const LAS f32x4*)(A0 + b1 * 1024 + 4 * lane + 256 * j);
                const f32x4 o = v1[j] * r1 * a1 + a0; o1[64 * j] = (unsigned long long)pk2(o.x, o.y) | ((unsigned long long)pk2(o.z, o.w) << 32); } }
    }
    __syncthreads();
}

__device__ __forceinline__ bool static_tile(int i, int G, int c, int nM, int nN, int& pm, int& pn) {
    const int nwg = nM * nN; const long L = (long)i * G + c; if (L >= nwg) return false;
    int wgid = (int)L; { const int q = nwg / 8, r = nwg % 8, xcd = wgid % 8, off = wgid / 8; wgid = (xcd < r ? xcd * (q + 1) : r * (q + 1) + (xcd - r) * q) + off; }
    const int nig = 8 * nN, gid = wgid / nig, fm = gid * 8, gsz = (nM - fm) < 8 ? (nM - fm) : 8;
    pm = fm + ((wgid % nig) % gsz); pn = (wgid % nig) / gsz; return true;
}
struct SchedP1 {
    static constexpr bool GATHER = false;
    __device__ __forceinline__ void a_ready(const gm::Unit&, int, int) const {}
    __device__ __forceinline__ void done(const gm::Unit&, int) const {}
    __device__ __forceinline__ void stamp(int, const gm::Unit&, int, int) const {}
    const char* A; const char* Bt; int G, c;
    __device__ __forceinline__ bool next(int i, gm::Unit& u) const { int pm, pn; if (!static_tile(i, G, c, 64, 9, pm, pn)) return false;
        u.A = A; u.Bt = Bt; u.gidx = nullptr; u.lda2 = 2048; u.ldb2 = 2048; u.arow0 = pm * 256; u.brow0 = pn * 256; u.nt = 16; u.pm = pm; u.pn = pn; u.aux = 0; return true; }
};
struct SchedP2 {
    static constexpr bool GATHER = false;
    __device__ __forceinline__ void a_ready(const gm::Unit&, int, int) const {}
    __device__ __forceinline__ void done(const gm::Unit&, int) const {}
    __device__ __forceinline__ void stamp(int, const gm::Unit&, int, int) const {}
    const char* A; const char* Wuq; const char* Wukv; int G, c;
    __device__ __forceinline__ bool next(int i, gm::Unit& u) const {
        const int L = i * G + c; if (L >= 448) return false;
        u.A = A; u.gidx = nullptr; u.lda2 = 1536;
        if (L < 256) { int pm, pn; static_tile(0, 256, L, 64, 4, pm, pn); u.A = A + 768; u.Bt = Wukv; u.ldb2 = 512; u.nt = 4; u.arow0 = pm * 256; u.brow0 = pn * 256; u.pm = pm; u.pn = pn; u.aux = 1; }
        else { int pm, pn; static_tile(0, 192, L - 256, 64, 3, pm, pn); u.Bt = Wuq; u.ldb2 = 768; u.nt = 6; u.arow0 = pm * 256; u.brow0 = pn * 256; u.pm = pm; u.pn = pn; u.aux = 0; }
        return true; }
};

__device__ __forceinline__ void store16_sc1(void* p, u32x4 v) { asm volatile("global_store_dwordx4 %0, %1, off sc1\n\ts_nop 1" :: "v"(p), "v"(v) : "memory"); }
__device__ __forceinline__ void store4_sc1(float* p, float v) { __hip_atomic_store(p, v, __ATOMIC_RELAXED, __HIP_MEMORY_SCOPE_AGENT); }
#define EPI_ARGS const f32x4 (&acc)[2][2][4][2], const gm::Unit& u, int wr, int wc, int fr, int fq, int lane
constexpr float QSCALE_M = 0.10206207261596575f * 1.4426950408889634f;
constexpr float QSCALE_D = 0.125f * 1.4426950408889634f;
__device__ __forceinline__ u32x4 pack8(f32x4 a, f32x4 b) { u32x4 w; w.x = cvt_pk_bf16(a[0], a[1]); w.y = cvt_pk_bf16(a[2], a[3]); w.z = cvt_pk_bf16(b[0], b[1]); w.w = cvt_pk_bf16(b[2], b[3]); return w; }
__device__ __forceinline__ void rope8(f32x4& v0, f32x4& v1, int xmask, const float* cs, const float* sn, bool first) {
    f32x4 o0, o1;
#pragma unroll
    for (int j = 0; j < 4; ++j) { o0[j] = __shfl_xor(v0[j], xmask); o1[j] = __shfl_xor(v1[j], xmask); }
    const f32x4 c0 = *(const f32x4*)cs, c1 = *(const f32x4*)(cs + 4), s0 = *(const f32x4*)sn, s1 = *(const f32x4*)(sn + 4);
    const float sg = first ? -1.f : 1.f;
    v0 = v0 * c0 + o0 * s0 * sg; v1 = v1 * c1 + o1 * s1 * sg;
}
struct EpiP1 {
    static constexpr bool PERM = true;
    unsigned char* ws;
    __device__ __forceinline__ void operator()(EPI_ARGS) const {
        const int pn = u.pn; float krmax = 0.f;
        const float* tabm = (const float*)(ws + WS_TABM); const float* tabd = (const float*)(ws + WS_TABD);
#pragma unroll
        for (int ai = 0; ai < 2; ++ai)
#pragma unroll
            for (int m = 0; m < 4; ++m) {
                const int row = u.pm * 256 + ai * 128 + wr * 64 + m * 16 + fr; const int b = row >> 13, s = row & 8191;
#pragma unroll
                for (int bj = 0; bj < 2; ++bj) {
                    f32x4 v0 = acc[ai][bj][m][0], v1 = acc[ai][bj][m][1];
                    const int ct = bj * 128 + wc * 32 + 8 * fq;
                    if (pn < 3) {
                        float q = (v0[0] * v0[0] + v0[1] * v0[1]) + (v0[2] * v0[2] + v0[3] * v0[3]) + (v1[0] * v1[0] + v1[1] * v1[1]) + (v1[2] * v1[2] + v1[3] * v1[3]);
                        q += __shfl_xor(q, 16); q += __shfl_xor(q, 32);
                        if (fq == 0) store4_sc1((float*)(ws + WS_SSQ) + (size_t)row * 24 + pn * 8 + bj * 4 + wc, q);
                        if (pn == 2 && bj == 1 && wc == 0) {
                            const int f0 = 8 * (fq & 1); rope8(v0, v1, 32, tabm + (size_t)row * 32 + f0, tabm + (size_t)row * 32 + 16 + f0, fq < 2);
                            store16_sc1((bf16_t*)(ws + WS_KR) + (size_t)row * 32 + 8 * fq, pack8(v0, v1));
                            { float q2 = (v0[0] * v0[0] + v0[1] * v0[1]) + (v0[2] * v0[2] + v0[3] * v0[3]) + (v1[0] * v1[0] + v1[1] * v1[1]) + (v1[2] * v1[2] + v1[3] * v1[3]);
                              q2 += __shfl_xor(q2, 16); q2 += __shfl_xor(q2, 32); krmax = fmaxf(krmax, q2); }
                        } else store16_sc1((bf16_t*)(ws + WS_CQ) + (size_t)row * 768 + pn * 256 + ct, pack8(v0, v1));
                    } else {
                        const int which = (pn - 3) >> 1;
                        const int cc = ((pn - 3) & 1) * 256 + ct, hh = cc >> 6, d = cc & 63;
                        if (which < 2 && (wc & 1) == 0) {
                            f32x4 r0 = v0, r1 = v1; rope8(r0, r1, 16, tabd + (size_t)row * 16, tabd + (size_t)row * 16 + 8, fq == 0);
                            if (fq < 2) { v0 = r0; v1 = r1; } }
                        if (which == 0) { v0 = v0 * QSCALE_D; v1 = v1 * QSCALE_D; }
                        bf16_t* dst = (bf16_t*)(ws + (which == 0 ? WS_DQ : which == 1 ? WS_DK : WS_DV));
                        *(u32x4*)(dst + ((size_t)(b * 8 + hh) * S + s) * 64 + d) = pack8(v0, v1);
                    }
                }
            }
        if (pn == 2 && wc == 0) {
#pragma unroll
            for (int o = 1; o < 16; o <<= 1) krmax = fmaxf(krmax, __shfl_xor(krmax, o));
            if (lane == 0) atomicMax((unsigned*)(ws + WS_KMX) + 32 + ((u.pm * 256) >> 13), __float_as_uint(krmax)); }
    }
};
struct EpiP2 {
    static constexpr bool PERM = true;
    unsigned char* ws;
    __device__ __forceinline__ void operator()(EPI_ARGS) const {
        const int pn = u.pn; const bool isq = u.aux == 0; float kmax[2] = {0.f, 0.f};
        const float* tabm = (const float*)(ws + WS_TABM); const float* ssq = (const float*)(ws + WS_SSQ);
#pragma unroll
        for (int ai = 0; ai < 2; ++ai)
#pragma unroll
            for (int m = 0; m < 4; ++m) {
                const int row = u.pm * 256 + ai * 128 + wr * 64 + m * 16 + fr; const int b = row >> 13, s = row & 8191;
                const float* sq = ssq + (size_t)row * 24; float rstd;
                if (isq) { const f32x4 a = *(const f32x4*)sq, bq = *(const f32x4*)(sq + 4), cq = *(const f32x4*)(sq + 8);
                    rstd = rsqrtf((((a[0] + a[1]) + (a[2] + a[3])) + ((bq[0] + bq[1]) + (bq[2] + bq[3])) + ((cq[0] + cq[1]) + (cq[2] + cq[3]))) * (1.f / 384.f) + EPS) * QSCALE_M; }
                else { const f32x4 a = *(const f32x4*)(sq + 12), bq = *(const f32x4*)(sq + 16);
                    rstd = rsqrtf((((a[0] + a[1]) + (a[2] + a[3])) + ((bq[0] + bq[1]) + (bq[2] + bq[3]))) * (1.f / 256.f) + EPS); }
#pragma unroll
                for (int bj = 0; bj < 2; ++bj) {
                    f32x4 v0 = acc[ai][bj][m][0] * rstd, v1 = acc[ai][bj][m][1] * rstd;
                    const int ct = bj * 128 + wc * 32 + 8 * fq, cc = (pn & 1) * 256 + ct;
                    if (isq) {
                        if (pn < 2) { const int hh = cc >> 6, d = cc & 63; *(u32x4*)((bf16_t*)(ws + WS_Q) + ((size_t)(b * 8 + hh) * S + s) * 96 + d) = pack8(v0, v1); }
                        else { const int hh = ct >> 5; const int f0 = 8 * (fq & 1); rope8(v0, v1, 32, tabm + (size_t)row * 32 + f0, tabm + (size_t)row * 32 + 16 + f0, fq < 2);
                            *(u32x4*)((bf16_t*)(ws + WS_Q) + ((size_t)(b * 8 + hh) * S + s) * 96 + 64 + 8 * fq) = pack8(v0, v1); }
                    } else { const int hh = cc >> 6, d = cc & 63; bf16_t* dst = (bf16_t*)(ws + (pn < 2 ? WS_KN : WS_V));
                        *(u32x4*)(dst + ((size_t)(b * 8 + hh) * S + s) * 64 + d) = pack8(v0, v1);
                        if (pn < 2) { float q2 = (v0[0] * v0[0] + v0[1] * v0[1]) + (v0[2] * v0[2] + v0[3] * v0[3]) + (v1[0] * v1[0] + v1[1] * v1[1]) + (v1[2] * v1[2] + v1[3] * v1[3]);
                            q2 += __shfl_xor(q2, 16); q2 += __shfl_xor(q2, 32); kmax[bj] = fmaxf(kmax[bj], q2); } }
                }
            }
        if (!isq && pn < 2) {
#pragma unroll
            for (int bj = 0; bj < 2; ++bj) { float km = kmax[bj];
#pragma unroll
                for (int o = 1; o < 16; o <<= 1) km = fmaxf(km, __shfl_xor(km, o));
                const int cc = (pn & 1) * 256 + bj * 128 + wc * 32, hh = cc >> 6, half = (cc >> 5) & 1, b = (u.pm * 256) >> 13;
                if (lane == 0) atomicMax((unsigned*)(ws + WS_KMX) + (b * 8 + hh) * 2 + half, __float_as_uint(km)); }
        }
    }
};

constexpr size_t WS_DCNT = 52 * KiB;
constexpr size_t WS_PCNT = 56 * KiB;
struct SchedP12 {
    static constexpr bool GATHER = false;
    const char *HB, *WIN, *CQ, *WUQ, *WUKV; unsigned* cnt; int G, vcu, c;
    __device__ __forceinline__ bool next(int i, gm::Unit& u) const {
        u.gidx = nullptr;
        if (G == 256) {
            const int n1 = c < 64 ? 3 : 2;
            if (i < n1) { int pm, pn; static_tile(i, 256, c, 64, 9, pm, pn);
                u.A = HB; u.Bt = WIN; u.lda2 = 2048; u.ldb2 = 2048; u.arow0 = pm * 256; u.brow0 = pn * 256; u.nt = 16; u.pm = pm; u.pn = pn; u.aux = 2; return true; }
            if (c < 64) return false;
            const int idx = (c - 64) + 192 * (i - 2); if (i - 2 >= 3 || idx >= 448) return false;
            if (idx < 256) { int pm, pn; static_tile(0, 256, idx, 64, 4, pm, pn); u.A = CQ + 768; u.Bt = WUKV; u.lda2 = 1536; u.ldb2 = 512; u.nt = 4; u.arow0 = pm * 256; u.brow0 = pn * 256; u.pm = pm; u.pn = pn; u.aux = 1; }
            else { int pm, pn; static_tile(0, 192, idx - 256, 64, 3, pm, pn); u.A = CQ; u.Bt = WUQ; u.lda2 = 1536; u.ldb2 = 768; u.nt = 6; u.arow0 = pm * 256; u.brow0 = pn * 256; u.pm = pm; u.pn = pn; u.aux = 0; }
            return true;
        }
        const int n1 = (576 - vcu + G - 1) / G;
        if (i < n1) { const int k = vcu + G * i, pn = k >> 6, pm = k & 63;
            u.A = HB; u.Bt = WIN; u.lda2 = 2048; u.ldb2 = 2048; u.arow0 = pm * 256; u.brow0 = pn * 256; u.nt = 16; u.pm = pm; u.pn = pn; u.aux = 2; return true; }
        const int idx = vcu + G * (i - n1); if (idx >= 448) return false;
        if (idx < 256) { const int pm = idx & 63, pn = idx >> 6; u.A = CQ + 768; u.Bt = WUKV; u.lda2 = 1536; u.ldb2 = 512; u.nt = 4; u.arow0 = pm * 256; u.brow0 = pn * 256; u.pm = pm; u.pn = pn; u.aux = 1; }
        else { const int j = idx - 256, pm = j & 63, pn = j >> 6; u.A = CQ; u.Bt = WUQ; u.lda2 = 1536; u.ldb2 = 768; u.nt = 6; u.arow0 = pm * 256; u.brow0 = pn * 256; u.pm = pm; u.pn = pn; u.aux = 0; }
        return true;
    }
#ifndef P12_STAMP
#define P12_STAMP 0
#endif
    __device__ __forceinline__ void stamp(int ui, const gm::Unit& u, int wid, int lane) const {
#if P12_STAMP
        if (wid == 0 && lane == 0) { unsigned long long* ts = (unsigned long long*)((unsigned char*)cnt - WS_PCNT + 128 * KiB) + (size_t)c * 8; ts[1 + ui] = __builtin_amdgcn_s_memrealtime(); ts[6] = (unsigned long long)(ui + 1); ts[7] = (u.aux == 2) ? (unsigned long long)(ui + 1) : ts[7]; }
#endif
    }
    __device__ __forceinline__ void a_ready(const gm::Unit& u, int wid, int) const {
        if (u.aux == 2) return;
        if (wid == 0) { unsigned* p = cnt + 16 * u.pm; unsigned spins = 0;
            while ((unsigned)__builtin_amdgcn_readfirstlane(__hip_atomic_load(p, __ATOMIC_RELAXED, __HIP_MEMORY_SCOPE_AGENT)) < 24u) { __builtin_amdgcn_s_sleep(2); if (++spins > (1u << 22)) break; }
            __builtin_amdgcn_fence(__ATOMIC_ACQUIRE, "agent");
            asm volatile("s_waitcnt vmcnt(0)" ::: "memory"); }
        asm volatile("" ::: "memory"); __builtin_amdgcn_s_barrier(); asm volatile("" ::: "memory");
    }
    __device__ __forceinline__ void done(const gm::Unit& u, int lane) const {
        if (u.aux != 2 || u.pn >= 3) return;
        asm volatile("s_waitcnt vmcnt(0)" ::: "memory");
        if (lane == 0) __hip_atomic_fetch_add(cnt + 16 * u.pm, 1u, __ATOMIC_RELAXED, __HIP_MEMORY_SCOPE_AGENT);
    }
};
struct EpiP12 {
    static constexpr bool PERM = true;
    unsigned char* ws;
    __device__ __forceinline__ void operator()(EPI_ARGS) const { if (u.aux == 2) { EpiP1 e{ws}; e(acc, u, wr, wc, fr, fq, lane); } else { EpiP2 e{ws}; e(acc, u, wr, wc, fr, fq, lane); } }
};
}
namespace mk {
#define RLX_AGENT __ATOMIC_RELAXED, __HIP_MEMORY_SCOPE_AGENT
#define XB_TMO      128
#define XB_XCNT(j)  (256  + 64 * (j))
#define XB_XSUB(j)  (1280 + 64 * (j))
#define XB_XGEN(j)  (2304 + 64 * (j))
#define XB_TOP      3328
#define XB_TOPGEN   3392
#define XCD_BAR_WORDS 3456
#define XB_SPIN_CAP (1u << 18)
__device__ __forceinline__ unsigned xb_ld(unsigned* p)              { return __hip_atomic_load(p, __ATOMIC_RELAXED, __HIP_MEMORY_SCOPE_AGENT); }
__device__ __forceinline__ unsigned xb_add(unsigned* p, unsigned v) { return __hip_atomic_fetch_add(p, v, __ATOMIC_RELAXED, __HIP_MEMORY_SCOPE_AGENT); }
__device__ __forceinline__ unsigned xb_xcc_id() { return (unsigned)__builtin_amdgcn_s_getreg((3 << 11) | 20) & 0xFu; }
#define XB_SPIN(cond, bar) do { unsigned _sp = 0; while (cond) { __builtin_amdgcn_s_sleep(1); \
    if ((++_sp & 255u) == 0u) { if (xb_ld(&(bar)[XB_TMO])) break; if (_sp > XB_SPIN_CAP) { atomicAdd(&(bar)[XB_TMO], 1u); break; } } } } while (0)
struct XcdBarrier { unsigned* bar; unsigned x; volatile LAS unsigned* st; };
__device__ __forceinline__ XcdBarrier xcd_barrier_post(unsigned* bar, volatile LAS unsigned* st, bool first_thread) {
    XcdBarrier b; b.bar = bar; b.x = xb_xcc_id(); b.st = st;
    if (first_thread) (void)xb_add(&bar[XB_XCNT(b.x)], 1u);
    return b;
}
__device__ __forceinline__ void xcd_barrier_complete(unsigned* bar, unsigned x, unsigned& nloc, unsigned& nx) {
    const unsigned G = gridDim.x * gridDim.y * gridDim.z;
    unsigned sum, cnt, mine, sp = 0u;
    for (;;) {
        sum = 0u; cnt = 0u; mine = 0u;
#pragma unroll
        for (unsigned j = 0; j < 16; ++j) { const unsigned c = xb_ld(&bar[XB_XCNT(j)]); sum += c; cnt += (c > 0u) ? 1u : 0u; mine = (j == x) ? c : mine; }
        if (sum == G) break;
        __builtin_amdgcn_s_sleep(1);
        if ((++sp & 255u) == 0u) { if (xb_ld(&bar[XB_TMO])) break; if (sp > XB_SPIN_CAP) { atomicAdd(&bar[XB_TMO], 1u); break; } }
    }
    nloc = mine > 0u ? mine : 1u; nx = cnt > 0u ? cnt : 1u;
}
__device__ __forceinline__ void xcd_barrier(const XcdBarrier& b, bool first_thread) {
    asm volatile("s_waitcnt vmcnt(0)" ::: "memory");
    __syncthreads();
    if (first_thread) {
        unsigned* bar = b.bar;
        __builtin_amdgcn_s_waitcnt(0);
        unsigned nloc = b.st[0], nx = b.st[1];
        if (nloc == 0u) { xcd_barrier_complete(bar, b.x, nloc, nx); b.st[0] = nloc; b.st[1] = nx; }
        const unsigned old = xb_add(&bar[XB_XSUB(b.x)], 1u);
        const unsigned gen = old / nloc;
        if (old + 1u == (gen + 1u) * nloc) {
            __builtin_amdgcn_fence(__ATOMIC_RELEASE, "agent");
            asm volatile("s_waitcnt vmcnt(0)" ::: "memory");
            const unsigned og = xb_add(&bar[XB_TOP], 1u);
            const unsigned tg = og / nx;
            if (og + 1u == (tg + 1u) * nx) xb_add(&bar[XB_TOPGEN], 1u);
            else XB_SPIN(xb_ld(&bar[XB_TOPGEN]) == tg, bar);
            __builtin_amdgcn_fence(__ATOMIC_ACQUIRE, "agent");
            xb_add(&bar[XB_XGEN(b.x)], 1u);
            asm volatile("s_waitcnt vmcnt(0)" ::: "memory");
        } else {
            XB_SPIN(xb_ld(&bar[XB_XGEN(b.x)]) == gen, bar);
            __builtin_amdgcn_fence(__ATOMIC_ACQUIRE, "agent");
            asm volatile("s_waitcnt vmcnt(0)" ::: "memory");
        }
    }
    __syncthreads();
}
}
namespace at {
using bf16x8 = __attribute__((ext_vector_type(8))) short;
using s16x4 = __attribute__((ext_vector_type(4))) short;
using f32x16 = __attribute__((ext_vector_type(16))) float;
using u32x4 = __attribute__((ext_vector_type(4))) unsigned;
constexpr int S = 8192, T = 16384;
constexpr float THR = 8.f;
#define SBAR() __builtin_amdgcn_sched_barrier(0)
__device__ __forceinline__ int crow(int r, int hi) { return (r & 3) + 8 * (r >> 2) + 4 * hi; }
__device__ __forceinline__ unsigned cvtpk(float lo, float hi) { unsigned r; asm volatile("v_cvt_pk_bf16_f32 %0, %1, %2" : "=v"(r) : "v"(lo), "v"(hi)); return r; }
__device__ __forceinline__ float rowmax32(const f32x16& p0, const f32x16& p1) {
    float pmax = p0[0];
#pragma unroll
    for (int r = 1; r < 16; ++r) pmax = fmaxf(pmax, p0[r]);
#pragma unroll
    for (int r = 0; r < 16; ++r) pmax = fmaxf(pmax, p1[r]);
    auto rr = __builtin_amdgcn_permlane32_swap(__float_as_uint(pmax), __float_as_uint(pmax), false, false);
    return fmaxf(__uint_as_float(rr[0]), __uint_as_float(rr[1]));
}
__device__ __forceinline__ void partialSM(f32x16& p0, f32x16& p1, float& m_reg, float& mn, float& alpha) {
    const float pmax = rowmax32(p0, p1);
    if (__builtin_expect(__all(pmax - m_reg <= THR), 1)) { mn = m_reg; alpha = 1.f; }
    else { mn = fmaxf(m_reg, pmax); alpha = __builtin_amdgcn_exp2f(m_reg - mn); m_reg = mn; }
#pragma unroll
    for (int r = 0; r < 16; ++r) p0[r] = p0[r] - mn;
#pragma unroll
    for (int r = 0; r < 16; ++r) p1[r] = p1[r] - mn;
#pragma unroll
    for (int r = 0; r < 16; ++r) p0[r] = __builtin_amdgcn_exp2f(p0[r]);
}
#define PK4(P, BASE, OUT) do { u32x4 w = {cvtpk(P[BASE + 0], P[BASE + 1]), cvtpk(P[BASE + 2], P[BASE + 3]), cvtpk(P[BASE + 4], P[BASE + 5]), cvtpk(P[BASE + 6], P[BASE + 7])}; \
    OUT = *reinterpret_cast<bf16x8*>(&w); } while (0)
__device__ __forceinline__ void finishSM(f32x16& p0, f32x16& p1, float alpha, float& l_reg, bf16x8& pa0, bf16x8& pa1, bf16x8& pa2, bf16x8& pa3) {
#pragma unroll
    for (int r = 0; r < 16; ++r) p1[r] = __builtin_amdgcn_exp2f(p1[r]);
    float ps = 0;
#pragma unroll
    for (int r = 0; r < 16; ++r) ps += p0[r];
#pragma unroll
    for (int r = 0; r < 16; ++r) ps += p1[r];
    { auto rr = __builtin_amdgcn_permlane32_swap(__float_as_uint(ps), __float_as_uint(ps), false, false); ps = __uint_as_float(rr[0]) + __uint_as_float(rr[1]); }
    l_reg = l_reg * alpha + ps;
    PK4(p0, 0, pa0); PK4(p0, 8, pa1); PK4(p1, 0, pa2); PK4(p1, 8, pa3);
}
__device__ __forceinline__ int v_st(int k, int c) { const int kk = k; return ((kk >> 3) * 2 + (c >> 5)) * 512 + ((kk & 7) * 32 + (c & 31)) * 2; }
__device__ __forceinline__ int v_rd_base(int lane) { return ((lane & 3) << 3) | (((lane >> 2) & 3) << 6) | (((lane >> 4) & 1) << 5) | (((lane >> 5) & 1) << 8); }
constexpr int v_rd_off(int d0, int ks, int half) { return d0 * 512 + ks * 2048 + half * 1024; }
template <int OFF> __device__ __forceinline__ s16x4 tr_read(int vb) { s16x4 r; asm volatile("ds_read_b64_tr_b16 %0, %1 offset:%2" : "=&v"(r) : "v"(vb), "i"(OFF) : "memory"); return r; }
#define PKV(L, H) (bf16x8){L[0], L[1], L[2], L[3], H[0], H[1], H[2], H[3]}
template <int D0, int KOFF> __device__ __forceinline__ void pv_one(f32x16& od, int vb, bf16x8 pa0, bf16x8 pa1, bf16x8 pa2, bf16x8 pa3) {
    const s16x4 l0 = tr_read<KOFF + v_rd_off(D0, 0, 0)>(vb), h0 = tr_read<KOFF + v_rd_off(D0, 0, 1)>(vb), l1 = tr_read<KOFF + v_rd_off(D0, 1, 0)>(vb), h1 = tr_read<KOFF + v_rd_off(D0, 1, 1)>(vb);
    const s16x4 l2 = tr_read<KOFF + v_rd_off(D0, 2, 0)>(vb), h2 = tr_read<KOFF + v_rd_off(D0, 2, 1)>(vb), l3 = tr_read<KOFF + v_rd_off(D0, 3, 0)>(vb), h3 = tr_read<KOFF + v_rd_off(D0, 3, 1)>(vb);
    asm volatile("s_waitcnt lgkmcnt(0)" ::: "memory"); SBAR();
    od = __builtin_amdgcn_mfma_f32_32x32x16_bf16(pa0, PKV(l0, h0), od, 0, 0, 0);
    od = __builtin_amdgcn_mfma_f32_32x32x16_bf16(pa1, PKV(l1, h1), od, 0, 0, 0);
    od = __builtin_amdgcn_mfma_f32_32x32x16_bf16(pa2, PKV(l2, h2), od, 0, 0, 0);
    od = __builtin_amdgcn_mfma_f32_32x32x16_bf16(pa3, PKV(l3, h3), od, 0, 0, 0);
}
template <int D0, int KOFF> __device__ __forceinline__ void pv_half(f32x16& od, int vb, bf16x8 pa0, bf16x8 pa1) {
    const s16x4 l0 = tr_read<KOFF + v_rd_off(D0, 0, 0)>(vb), h0 = tr_read<KOFF + v_rd_off(D0, 0, 1)>(vb), l1 = tr_read<KOFF + v_rd_off(D0, 1, 0)>(vb), h1 = tr_read<KOFF + v_rd_off(D0, 1, 1)>(vb);
    asm volatile("s_waitcnt lgkmcnt(0)" ::: "memory"); SBAR();
    od = __builtin_amdgcn_mfma_f32_32x32x16_bf16(pa0, PKV(l0, h0), od, 0, 0, 0);
    od = __builtin_amdgcn_mfma_f32_32x32x16_bf16(pa1, PKV(l1, h1), od, 0, 0, 0);
}
template <class RowOff> __device__ __forceinline__ void store_o_tile(const f32x16 (&o)[2], const float (&rli)[16], unsigned short* stg, unsigned short* dst, RowOff row_off, int lane) {
    const int r32 = lane & 31, hi = lane >> 5;
#pragma unroll
    for (int r = 0; r < 16; ++r) { const int orow = crow(r, hi);
#pragma unroll
        for (int d0 = 0; d0 < 2; ++d0) stg[orow * 64 + d0 * 32 + r32] = (unsigned short)(cvtpk(o[d0][r] * rli[r], 0.f) & 0xffffu); }
    asm volatile("s_waitcnt lgkmcnt(0)" ::: "memory");
#pragma unroll
    for (int i = 0; i < 4; ++i) { const int row = i * 8 + (lane >> 3), ch = lane & 7; const u32x4 v = *(const u32x4*)(stg + row * 64 + ch * 8); *(u32x4*)(dst + row_off(row) + ch * 8) = v; }
    asm volatile("s_waitcnt lgkmcnt(0)" ::: "memory");
}

__device__ __forceinline__ bool wg_or(bool pred, unsigned* flags8, int wid, int lane) {
    const bool w = __any(pred); if (lane == 0) flags8[wid] = w ? 1u : 0u;
    __syncthreads();
    unsigned r = 0u;
#pragma unroll
    for (int i = 0; i < 8; ++i) r |= flags8[i];
    __syncthreads();
    return r != 0u;
}
constexpr int SHM_V = 8192, SHM_K = 16384, MLA_WS = 2 * SHM_V + 2 * SHM_K, MLA_OST = MLA_WS + 8 * 256;
#define KSWZ(row, colB) ((row) * 256 + ((colB) ^ (((row) & 15) << 4)))
__device__ __forceinline__ void qkt96(f32x16& p0, f32x16& p1, const char* Ks, const bf16x8* qr, int r32, int hi) {
    p0 = f32x16{}; p1 = f32x16{};
#pragma unroll
    for (int d0 = 0; d0 < 6; ++d0) { const int cb = (d0 * 16 + hi * 8) * 2;
        const bf16x8 b0 = *reinterpret_cast<const bf16x8*>(Ks + KSWZ(r32, cb));
        const bf16x8 b1 = *reinterpret_cast<const bf16x8*>(Ks + KSWZ(32 + r32, cb));
        p0 = __builtin_amdgcn_mfma_f32_32x32x16_bf16(b0, qr[d0], p0, 0, 0, 0);
        p1 = __builtin_amdgcn_mfma_f32_32x32x16_bf16(b1, qr[d0], p1, 0, 0, 0); }
}
__device__ __forceinline__ void pv64(f32x16* o, int vb, bf16x8 pa0, bf16x8 pa1, bf16x8 pa2, bf16x8 pa3) {
    pv_one<0, 0>(o[0], vb, pa0, pa1, pa2, pa3); pv_one<1, 0>(o[1], vb, pa0, pa1, pa2, pa3);
}
__device__ __forceinline__ void mla_unit(int wv, int bh, int qb, const unsigned short* __restrict__ Q, const unsigned short* __restrict__ KN, const unsigned short* __restrict__ KR,
                                         const unsigned short* __restrict__ V, unsigned short* __restrict__ CAT, char* lds) {
    const int wid = wv, lane = gm::lane_now(), tid = wid * 64 + lane, r32 = lane & 31, hi = lane >> 5;
    const int b = bh >> 3, h = bh & 7;
    char* V_lds = lds; char* K_lds = lds + 2 * SHM_V;
    float* wsf = (float*)(lds + MLA_WS) + wid * 64; float* li_l = wsf; float* al_l = wsf + 32;
    float m_reg = -1e30f, l_reg = 0; f32x16 o[2] = {}; bf16x8 qr[6];
    const size_t bhS = (size_t)bh * S; const int q0 = qb * 256;
    const unsigned short* Qw = Q + (bhS + q0 + wid * 32 + r32) * 96 + hi * 8;
#pragma unroll
    for (int d0 = 0; d0 < 6; ++d0) qr[d0] = *reinterpret_cast<const bf16x8*>(Qw + d0 * 16);
    const int srow = tid >> 3, sch = tid & 7, rrow = (tid & 255) >> 2, rch = tid & 3;
    const unsigned short* kn_src = KN + (bhS + srow) * 64 + sch * 8;
    const unsigned short* v_src = V + (bhS + srow) * 64 + sch * 8;
    const unsigned short* kr_src = KR + ((size_t)b * S + rrow) * 32 + rch * 8;
    const int kst = KSWZ(srow, sch * 16), krst = KSWZ(rrow, (8 + rch) * 16), vst = v_st(srow, sch * 8);
    const int vb0 = (int)(uintptr_t)V_lds + v_rd_base(lane);
    bf16x8 s_kn[2], s_kr[2], s_v[2];
#define SLOAD(i, k0) do { s_kn[i] = *reinterpret_cast<const bf16x8*>(kn_src + (size_t)(k0) * 64); s_kr[i] = *reinterpret_cast<const bf16x8*>(kr_src + (size_t)(k0) * 32); \
    s_v[i] = *reinterpret_cast<const bf16x8*>(v_src + (size_t)(k0) * 64); } while (0)
#define SWRITE(bb, i) do { *(bf16x8*)(K_lds + (bb) * SHM_K + kst) = s_kn[i]; if (tid < 256) *(bf16x8*)(K_lds + (bb) * SHM_K + krst) = s_kr[i]; *(bf16x8*)(V_lds + (bb) * SHM_V + vst) = s_v[i]; } while (0)
#define SWAIT() asm volatile("s_waitcnt vmcnt(3)" ::: "memory")
#define RESC(a) do { if (__any((a) < 1.f)) { if (hi == 0) al_l[r32] = (a); asm volatile("s_waitcnt lgkmcnt(0)" ::: "memory"); \
    _Pragma("unroll") for (int d = 0; d < 2; ++d) _Pragma("unroll") for (int r = 0; r < 16; ++r) o[d][r] *= al_l[crow(r, hi)]; } } while (0)
    f32x16 pA0, pA1, pB0, pB1; float mnA, mnB, alA, alB; bf16x8 pa0, pa1, pa2, pa3; constexpr int NT = S / 64;
    SLOAD(0, 0); asm volatile("s_waitcnt vmcnt(0)" ::: "memory"); SWRITE(0, 0); __syncthreads();
    qkt96(pA0, pA1, K_lds, qr, r32, hi); partialSM(pA0, pA1, m_reg, mnA, alA);
    SLOAD(1, 64); SLOAD(0, 128);
    SWAIT(); SWRITE(1, 1); __syncthreads();
    for (int j = 1; j + 1 < NT; j += 2) {
        SBAR(); qkt96(pB0, pB1, K_lds + SHM_K, qr, r32, hi);
        finishSM(pA0, pA1, alA, l_reg, pa0, pa1, pa2, pa3); SBAR();
        SLOAD(1, (j + 2) * 64); SBAR();
        pv64(o, vb0, pa0, pa1, pa2, pa3); partialSM(pB0, pB1, m_reg, mnB, alB);
        __syncthreads(); SWAIT(); SWRITE(0, 0);
        RESC(alB); __syncthreads();
        SBAR(); qkt96(pA0, pA1, K_lds, qr, r32, hi);
        finishSM(pB0, pB1, alB, l_reg, pa0, pa1, pa2, pa3); SBAR();
        if (j + 3 < NT) SLOAD(0, (j + 3) * 64); SBAR();
        pv64(o, vb0 + SHM_V, pa0, pa1, pa2, pa3); partialSM(pA0, pA1, m_reg, mnA, alA);
        __syncthreads(); SWAIT(); SWRITE(1, 1);
        RESC(alA); __syncthreads();
    }
    SBAR(); qkt96(pB0, pB1, K_lds + SHM_K, qr, r32, hi);
    finishSM(pA0, pA1, alA, l_reg, pa0, pa1, pa2, pa3); SBAR();
    pv64(o, vb0, pa0, pa1, pa2, pa3); partialSM(pB0, pB1, m_reg, mnB, alB);
    __syncthreads(); RESC(alB);
    finishSM(pB0, pB1, alB, l_reg, pa0, pa1, pa2, pa3); SBAR();
    pv64(o, vb0 + SHM_V, pa0, pa1, pa2, pa3);
    if (hi == 0) li_l[r32] = l_reg; asm volatile("s_waitcnt lgkmcnt(0)" ::: "memory");
    float rli[16];
#pragma unroll
    for (int r = 0; r < 16; ++r) rli[r] = __builtin_amdgcn_rcpf(li_l[crow(r, hi)]);
    unsigned short* stg = (unsigned short*)(lds + MLA_OST) + wid * 2048;
    unsigned short* dst = CAT + ((size_t)b * S + q0 + wid * 32) * 1024 + h * 64;
    store_o_tile(o, rli, stg, dst, [](int row) { return (size_t)row * 1024; }, lane);
    asm volatile("s_waitcnt vmcnt(0)" ::: "memory");
    __syncthreads();
#undef SLOAD
#undef SWRITE
#undef SWAIT
#undef RESC
}


#ifndef V9_SPLIT_PRIO
#define V9_SPLIT_PRIO 0
#endif
#ifndef V7_YOUNG_PRIO
#define V7_YOUNG_PRIO 1
#endif
#ifndef V7_EXACT
#define V7_EXACT 1
#endif
#ifndef MLA_STAMP
#define MLA_STAMP 0
#endif
#ifndef MLA_STAMP_WAVE
#define MLA_STAMP_WAVE 5
#endif
#if MLA_STAMP
#define STAMP_T(var) do { __builtin_amdgcn_sched_barrier(0); asm volatile("s_memtime %0\n\ts_waitcnt lgkmcnt(0)" : "=s"(var) :: "memory"); __builtin_amdgcn_sched_barrier(0); } while (0)
#define STAMP_ACC(i, t0_, t1_) (st_acc[i] += (t1_) - (t0_))
#else
#define STAMP_T(var) do { } while (0)
#define STAMP_ACC(i, t0_, t1_) do { } while (0)
#endif
#ifndef STAMP_SEC
#define STAMP_SEC 4
#endif
#if MLA_STAMP
#define SEC_B(i) do { if ((i) == STAMP_SEC) STAMP_T(tq0); } while (0)
#define SEC_E(i) do { if ((i) == STAMP_SEC) { STAMP_T(tq1); st_a += tq1 - tq0; } } while (0)
#else
#define SEC_B(i) do { } while (0)
#define SEC_E(i) do { } while (0)
#endif
constexpr int M2_K = 0, M2_V = 3 * SHM_K, M2_WS = M2_V + 3 * SHM_V, M2_OST = M2_WS + 8 * 256;
#ifndef MLA_PROBE_NOSTAGE
#define MLA_PROBE_NOSTAGE 0
#endif
#ifndef MLA_STATIC
#define MLA_STATIC 1
#endif
#ifndef MLA_STATIC_THR
#define MLA_STATIC_THR 60.f
#endif
#ifndef MLA_STEP_MODE
#define MLA_STEP_MODE 0
#endif
#ifndef MLA_PROBE_VALU
#define MLA_PROBE_VALU 0
#endif
#ifndef MLA_NEGM
#define MLA_NEGM 1
#endif
#ifndef MLA_PRIO
#define MLA_PRIO 0
#endif
__device__ __forceinline__ void qkt96n(f32x16& p0, f32x16& p1, const char* Ks, const bf16x8* qr, const f32x16& negm, int r32, int hi, bool usec = true) {
    if (MLA_PRIO) __builtin_amdgcn_s_setprio(1);
#pragma unroll
    for (int d0 = 0; d0 < 6; ++d0) { const int cb = (d0 * 16 + hi * 8) * 2;
        const bf16x8 b0 = *reinterpret_cast<const bf16x8*>(Ks + KSWZ(r32, cb));
        const bf16x8 b1 = *reinterpret_cast<const bf16x8*>(Ks + KSWZ(32 + r32, cb));
        if (d0 == 0 && !usec) { p0 = __builtin_amdgcn_mfma_f32_32x32x16_bf16(b0, qr[0], f32x16{}, 0, 0, 0); p1 = __builtin_amdgcn_mfma_f32_32x32x16_bf16(b1, qr[0], f32x16{}, 0, 0, 0); }
        else if (d0 == 0) { p0 = __builtin_amdgcn_mfma_f32_32x32x16_bf16(b0, qr[0], MLA_NEGM ? negm : f32x16{}, 0, 0, 0); p1 = __builtin_amdgcn_mfma_f32_32x32x16_bf16(b1, qr[0], MLA_NEGM ? negm : f32x16{}, 0, 0, 0); }
        else { p0 = __builtin_amdgcn_mfma_f32_32x32x16_bf16(b0, qr[d0], p0, 0, 0, 0); p1 = __builtin_amdgcn_mfma_f32_32x32x16_bf16(b1, qr[d0], p1, 0, 0, 0); } }
    if (MLA_PRIO) __builtin_amdgcn_s_setprio(0);
}
__device__ __forceinline__ void qkt96z(f32x16& p0, f32x16& p1, const char* Ks, const bf16x8* qr, int r32, int hi) {
#pragma unroll
    for (int d0 = 0; d0 < 6; ++d0) { const int cb = (d0 * 16 + hi * 8) * 2;
        const bf16x8 b0 = *reinterpret_cast<const bf16x8*>(Ks + KSWZ(r32, cb));
        const bf16x8 b1 = *reinterpret_cast<const bf16x8*>(Ks + KSWZ(32 + r32, cb));
        if (d0 == 0) { p0 = __builtin_amdgcn_mfma_f32_32x32x16_bf16(b0, qr[0], f32x16{}, 0, 0, 0); p1 = __builtin_amdgcn_mfma_f32_32x32x16_bf16(b1, qr[0], f32x16{}, 0, 0, 0); }
        else { p0 = __builtin_amdgcn_mfma_f32_32x32x16_bf16(b0, qr[d0], p0, 0, 0, 0); p1 = __builtin_amdgcn_mfma_f32_32x32x16_bf16(b1, qr[d0], p1, 0, 0, 0); } }
}
__device__ __forceinline__ float rowmax32b(const f32x16& p0, const f32x16& p1) {
    float a = fmaxf(fmaxf(p0[0], p0[1]), p1[0]), b = fmaxf(fmaxf(p0[2], p0[3]), p1[1]); a = fmaxf(fmaxf(a, p1[2]), p1[3]);
#pragma unroll
    for (int r = 4; r < 16; r += 4) { a = fmaxf(fmaxf(a, p0[r]), p0[r + 1]); b = fmaxf(fmaxf(b, p0[r + 2]), p0[r + 3]); a = fmaxf(fmaxf(a, p1[r]), p1[r + 1]); b = fmaxf(fmaxf(b, p1[r + 2]), p1[r + 3]); }
    const float m = fmaxf(a, b);
    auto rr = __builtin_amdgcn_permlane32_swap(__float_as_uint(m), __float_as_uint(m), false, false);
    return fmaxf(__uint_as_float(rr[0]), __uint_as_float(rr[1]));
}
template <bool FIRST> __device__ __forceinline__ void partialSM2(f32x16& p0, f32x16& p1, float& m_reg, f32x16& negm, float& alpha, bool exact = true) {
    if (!exact) { alpha = 1.f;
#pragma unroll
        for (int r = 0; r < 16; ++r) p0[r] = __builtin_amdgcn_exp2f(p0[r]);
        return; }
    if (MLA_PROBE_VALU) { float d0_ = p1[0], d1_ = p1[1], d2_ = p1[2], d3_ = p1[3];
#pragma unroll
        for (int i = 0; i < 8; ++i) { d0_ = __builtin_amdgcn_exp2f(d0_); d1_ = __builtin_amdgcn_exp2f(d1_); d2_ = __builtin_amdgcn_exp2f(d2_); d3_ = __builtin_amdgcn_exp2f(d3_); }
        asm volatile("" :: "v"(d0_), "v"(d1_), "v"(d2_), "v"(d3_)); }
    if (!MLA_NEGM) {
        const float pm = rowmax32b(p0, p1); alpha = 1.f;
        if (FIRST) m_reg = pm; else if (!__builtin_expect(__all(pm - m_reg <= THR), 1)) { const float mn = fmaxf(m_reg, pm); alpha = __builtin_amdgcn_exp2f(m_reg - mn); m_reg = mn; }
#pragma unroll
        for (int r = 0; r < 16; ++r) { p0[r] -= m_reg; p1[r] -= m_reg; }
#pragma unroll
        for (int r = 0; r < 16; ++r) p0[r] = __builtin_amdgcn_exp2f(p0[r]);
        return; }
    const float pmax = rowmax32b(p0, p1);
    alpha = 1.f;
    if (FIRST || !__builtin_expect(__all(pmax <= THR), 1)) {
        const float dl = FIRST ? pmax : fmaxf(pmax, 0.f); m_reg += dl;
#pragma unroll
        for (int r = 0; r < 16; ++r) { p0[r] -= dl; p1[r] -= dl; }
#pragma unroll
        for (int r = 0; r < 16; ++r) negm[r] = -m_reg;
        if (!FIRST) alpha = __builtin_amdgcn_exp2f(-dl);
    }
#pragma unroll
    for (int r = 0; r < 16; ++r) p0[r] = __builtin_amdgcn_exp2f(p0[r]);
}
template <int D0> __device__ __forceinline__ void pv_one_p(f32x16& od, int vb, bf16x8 pa0, bf16x8 pa1, bf16x8 pa2, bf16x8 pa3) {
    const s16x4 l0 = tr_read<v_rd_off(D0, 0, 0)>(vb), h0 = tr_read<v_rd_off(D0, 0, 1)>(vb), l1 = tr_read<v_rd_off(D0, 1, 0)>(vb), h1 = tr_read<v_rd_off(D0, 1, 1)>(vb);
    const s16x4 l2 = tr_read<v_rd_off(D0, 2, 0)>(vb), h2 = tr_read<v_rd_off(D0, 2, 1)>(vb), l3 = tr_read<v_rd_off(D0, 3, 0)>(vb), h3 = tr_read<v_rd_off(D0, 3, 1)>(vb);
    asm volatile("s_waitcnt lgkmcnt(0)" ::: "memory"); SBAR();
    if (MLA_PRIO) __builtin_amdgcn_s_setprio(1);
    od = __builtin_amdgcn_mfma_f32_32x32x16_bf16(pa0, PKV(l0, h0), od, 0, 0, 0);
    od = __builtin_amdgcn_mfma_f32_32x32x16_bf16(pa1, PKV(l1, h1), od, 0, 0, 0);
    od = __builtin_amdgcn_mfma_f32_32x32x16_bf16(pa2, PKV(l2, h2), od, 0, 0, 0);
    od = __builtin_amdgcn_mfma_f32_32x32x16_bf16(pa3, PKV(l3, h3), od, 0, 0, 0);
    if (MLA_PRIO) __builtin_amdgcn_s_setprio(0);
}

__device__ __forceinline__ void kfrag_load(bf16x8 (&kf)[12], const char* Ks, int r32, int hi) {
#pragma unroll
    for (int d0 = 0; d0 < 6; ++d0) { const int cb = (d0 * 16 + hi * 8) * 2;
        kf[2 * d0] = *reinterpret_cast<const bf16x8*>(Ks + KSWZ(r32, cb)); kf[2 * d0 + 1] = *reinterpret_cast<const bf16x8*>(Ks + KSWZ(32 + r32, cb)); }
}
__device__ __forceinline__ void qk_mma(f32x16& p0, f32x16& p1, const bf16x8 (&kf)[12], const bf16x8* qr, const f32x16& negm) {
    if (MLA_PRIO) __builtin_amdgcn_s_setprio(1);
    p0 = __builtin_amdgcn_mfma_f32_32x32x16_bf16(kf[0], qr[0], MLA_NEGM ? negm : f32x16{}, 0, 0, 0); p1 = __builtin_amdgcn_mfma_f32_32x32x16_bf16(kf[1], qr[0], MLA_NEGM ? negm : f32x16{}, 0, 0, 0);
#pragma unroll
    for (int d0 = 1; d0 < 6; ++d0) { p0 = __builtin_amdgcn_mfma_f32_32x32x16_bf16(kf[2 * d0], qr[d0], p0, 0, 0, 0); p1 = __builtin_amdgcn_mfma_f32_32x32x16_bf16(kf[2 * d0 + 1], qr[d0], p1, 0, 0, 0); }
    if (MLA_PRIO) __builtin_amdgcn_s_setprio(0);
}
template <int D0> __device__ __forceinline__ void vfrag_load_h(s16x4 (&vl)[4], s16x4 (&vh)[4], int vb) {
    vl[0] = tr_read<v_rd_off(D0, 0, 0)>(vb); vh[0] = tr_read<v_rd_off(D0, 0, 1)>(vb); vl[1] = tr_read<v_rd_off(D0, 1, 0)>(vb); vh[1] = tr_read<v_rd_off(D0, 1, 1)>(vb);
    vl[2] = tr_read<v_rd_off(D0, 2, 0)>(vb); vh[2] = tr_read<v_rd_off(D0, 2, 1)>(vb); vl[3] = tr_read<v_rd_off(D0, 3, 0)>(vb); vh[3] = tr_read<v_rd_off(D0, 3, 1)>(vb);
}
__device__ __forceinline__ void pv_mma_h(f32x16& od, const s16x4 (&vl)[4], const s16x4 (&vh)[4], bf16x8 pa0, bf16x8 pa1, bf16x8 pa2, bf16x8 pa3) {
    if (MLA_PRIO) __builtin_amdgcn_s_setprio(1);
    od = __builtin_amdgcn_mfma_f32_32x32x16_bf16(pa0, PKV(vl[0], vh[0]), od, 0, 0, 0);
    od = __builtin_amdgcn_mfma_f32_32x32x16_bf16(pa1, PKV(vl[1], vh[1]), od, 0, 0, 0);
    od = __builtin_amdgcn_mfma_f32_32x32x16_bf16(pa2, PKV(vl[2], vh[2]), od, 0, 0, 0);
    od = __builtin_amdgcn_mfma_f32_32x32x16_bf16(pa3, PKV(vl[3], vh[3]), od, 0, 0, 0);
    if (MLA_PRIO) __builtin_amdgcn_s_setprio(0);
}
#if MLA_STEP_MODE == 0
#define MLA_STEP(PC0, PC1, PP0, PP1, ALP, ALC) do { \
    STAMP_T(tq0); qkt96n(PC0, PC1, K_lds + sc * SHM_K, qr, negm, r32, hi); STAMP_T(tq1); STAMP_ACC(1, tq0, tq1); \
    finishSM(PP0, PP1, ALP, l_reg, pa0, pa1, pa2, pa3); SBAR(); STAMP_T(tq0); STAMP_ACC(2, tq1, tq0); \
    { const int vb_ = vb0 + sp * SHM_V; pv_one_p<0>(o[0], vb_, pa0, pa1, pa2, pa3); pv_one_p<1>(o[1], vb_, pa0, pa1, pa2, pa3); } STAMP_T(tq1); STAMP_ACC(3, tq0, tq1); \
    partialSM2<false>(PC0, PC1, m_reg, negm, ALC, exact); RESC(ALC); STAMP_T(tq0); STAMP_ACC(4, tq1, tq0); } while (0)
#elif MLA_STEP_MODE == 2
  \
#define SGB(mask, n) __builtin_amdgcn_sched_group_barrier(mask, n, 0)
#define MLA_STEP(PC0, PC1, PP0, PP1, ALP, ALC) do { \
    { const char* Ks_ = K_lds + sc * SHM_K; \
      _Pragma("unroll") for (int d0 = 0; d0 < 6; ++d0) { const int cb = (d0 * 16 + hi * 8) * 2; \
        const bf16x8 b0 = *reinterpret_cast<const bf16x8*>(Ks_ + KSWZ(r32, cb)); const bf16x8 b1 = *reinterpret_cast<const bf16x8*>(Ks_ + KSWZ(32 + r32, cb)); \
        if (d0 == 0) { PC0 = __builtin_amdgcn_mfma_f32_32x32x16_bf16(b0, qr[0], negm, 0, 0, 0); PC1 = __builtin_amdgcn_mfma_f32_32x32x16_bf16(b1, qr[0], negm, 0, 0, 0); } \
        else { PC0 = __builtin_amdgcn_mfma_f32_32x32x16_bf16(b0, qr[d0], PC0, 0, 0, 0); PC1 = __builtin_amdgcn_mfma_f32_32x32x16_bf16(b1, qr[d0], PC1, 0, 0, 0); } } } \
    finishSM(PP0, PP1, ALP, l_reg, pa0, pa1, pa2, pa3); \
    SGB(0x100, 4); \
    _Pragma("unroll") for (int g_ = 0; g_ < 12; ++g_) { SGB(0x008, 1); SGB(0x100, 1); SGB(0x002, 7); } \
    SBAR(); \
    { const int vb_ = vb0 + sp * SHM_V; \
      const s16x4 l0 = tr_read<v_rd_off(0, 0, 0)>(vb_), h0 = tr_read<v_rd_off(0, 0, 1)>(vb_), l1 = tr_read<v_rd_off(0, 1, 0)>(vb_), h1 = tr_read<v_rd_off(0, 1, 1)>(vb_); \
      const s16x4 l2 = tr_read<v_rd_off(0, 2, 0)>(vb_), h2 = tr_read<v_rd_off(0, 2, 1)>(vb_), l3 = tr_read<v_rd_off(0, 3, 0)>(vb_), h3 = tr_read<v_rd_off(0, 3, 1)>(vb_); \
      const s16x4 l4 = tr_read<v_rd_off(1, 0, 0)>(vb_), h4 = tr_read<v_rd_off(1, 0, 1)>(vb_), l5 = tr_read<v_rd_off(1, 1, 0)>(vb_), h5 = tr_read<v_rd_off(1, 1, 1)>(vb_); \
      const s16x4 l6 = tr_read<v_rd_off(1, 2, 0)>(vb_), h6 = tr_read<v_rd_off(1, 2, 1)>(vb_), l7 = tr_read<v_rd_off(1, 3, 0)>(vb_), h7 = tr_read<v_rd_off(1, 3, 1)>(vb_); \
      asm volatile("s_waitcnt lgkmcnt(0)" ::: "memory"); SBAR(); \
      o[0] = __builtin_amdgcn_mfma_f32_32x32x16_bf16(pa0, PKV(l0, h0), o[0], 0, 0, 0); o[1] = __builtin_amdgcn_mfma_f32_32x32x16_bf16(pa0, PKV(l4, h4), o[1], 0, 0, 0); \
      o[0] = __builtin_amdgcn_mfma_f32_32x32x16_bf16(pa1, PKV(l1, h1), o[0], 0, 0, 0); o[1] = __builtin_amdgcn_mfma_f32_32x32x16_bf16(pa1, PKV(l5, h5), o[1], 0, 0, 0); \
      o[0] = __builtin_amdgcn_mfma_f32_32x32x16_bf16(pa2, PKV(l2, h2), o[0], 0, 0, 0); o[1] = __builtin_amdgcn_mfma_f32_32x32x16_bf16(pa2, PKV(l6, h6), o[1], 0, 0, 0); \
      o[0] = __builtin_amdgcn_mfma_f32_32x32x16_bf16(pa3, PKV(l3, h3), o[0], 0, 0, 0); o[1] = __builtin_amdgcn_mfma_f32_32x32x16_bf16(pa3, PKV(l7, h7), o[1], 0, 0, 0); \
      partialSM2<false>(PC0, PC1, m_reg, negm, ALC, exact); \
      _Pragma("unroll") for (int g_ = 0; g_ < 8; ++g_) { SGB(0x008, 1); SGB(0x002, 2); } \
      SBAR(); } \
    RESC(ALC); } while (0)
#else
#define KFH(dst, Ks_, D0) do { _Pragma("unroll") for (int d_ = 0; d_ < 3; ++d_) { const int cb_ = (((D0) + d_) * 16 + hi * 8) * 2; \
        dst[2 * d_] = *reinterpret_cast<const bf16x8*>((Ks_) + KSWZ(r32, cb_)); dst[2 * d_ + 1] = *reinterpret_cast<const bf16x8*>((Ks_) + KSWZ(32 + r32, cb_)); } } while (0)
#define MLA_STEP(PC0, PC1, PP0, PP1, ALP, ALC) do { \
    bf16x8 ka[6], kb[6]; s16x4 val[4], vah[4], vbl[4], vbh[4]; const int vb_ = vb0 + sp * SHM_V; const char* Ks_ = K_lds + sc * SHM_K; \
    KFH(ka, Ks_, 0); SBAR(); \
    finishSM(PP0, PP1, ALP, l_reg, pa0, pa1, pa2, pa3); SBAR(); \
    KFH(kb, Ks_, 3); SBAR(); \
    if (exact) { PC0 = __builtin_amdgcn_mfma_f32_32x32x16_bf16(ka[0], qr[0], negm, 0, 0, 0); PC1 = __builtin_amdgcn_mfma_f32_32x32x16_bf16(ka[1], qr[0], negm, 0, 0, 0); } \
    else { PC0 = __builtin_amdgcn_mfma_f32_32x32x16_bf16(ka[0], qr[0], negm, 0, 0, 0); PC1 = __builtin_amdgcn_mfma_f32_32x32x16_bf16(ka[1], qr[0], negm, 0, 0, 0); } \
    PC0 = __builtin_amdgcn_mfma_f32_32x32x16_bf16(ka[2], qr[1], PC0, 0, 0, 0); PC1 = __builtin_amdgcn_mfma_f32_32x32x16_bf16(ka[3], qr[1], PC1, 0, 0, 0); \
    PC0 = __builtin_amdgcn_mfma_f32_32x32x16_bf16(ka[4], qr[2], PC0, 0, 0, 0); PC1 = __builtin_amdgcn_mfma_f32_32x32x16_bf16(ka[5], qr[2], PC1, 0, 0, 0); SBAR(); \
    vfrag_load_h<0>(val, vah, vb_); SBAR(); \
    PC0 = __builtin_amdgcn_mfma_f32_32x32x16_bf16(kb[0], qr[3], PC0, 0, 0, 0); PC1 = __builtin_amdgcn_mfma_f32_32x32x16_bf16(kb[1], qr[3], PC1, 0, 0, 0); \
    PC0 = __builtin_amdgcn_mfma_f32_32x32x16_bf16(kb[2], qr[4], PC0, 0, 0, 0); PC1 = __builtin_amdgcn_mfma_f32_32x32x16_bf16(kb[3], qr[4], PC1, 0, 0, 0); \
    PC0 = __builtin_amdgcn_mfma_f32_32x32x16_bf16(kb[4], qr[5], PC0, 0, 0, 0); PC1 = __builtin_amdgcn_mfma_f32_32x32x16_bf16(kb[5], qr[5], PC1, 0, 0, 0); SBAR(); \
    vfrag_load_h<1>(vbl, vbh, vb_); SBAR(); \
    asm volatile("s_waitcnt lgkmcnt(8)" ::: "memory"); SBAR(); \
    pv_mma_h(o[0], val, vah, pa0, pa1, pa2, pa3); SBAR(); \
    asm volatile("s_waitcnt lgkmcnt(0)" ::: "memory"); SBAR(); \
    pv_mma_h(o[1], vbl, vbh, pa0, pa1, pa2, pa3); SBAR(); \
    partialSM2<false>(PC0, PC1, m_reg, negm, ALC, exact); RESC(ALC); } while (0)
#endif

__device__ __forceinline__ void mla_unit_v2(int wv, int bh, int qb, const unsigned short* __restrict__ Q, const unsigned short* __restrict__ KN, const unsigned short* __restrict__ KR,
                                            const unsigned short* __restrict__ V, unsigned short* __restrict__ CAT, const float* __restrict__ KMX, char* lds, unsigned long long* STAMPS = nullptr) {
    const int wid = wv, lane = gm::lane_now(), tid = wid * 64 + lane, r32 = lane & 31, hi = lane >> 5;
    const int b = bh >> 3, h = bh & 7;
    char* K_lds = lds + M2_K; char* V_lds = lds + M2_V;
    float* wsf = (float*)(lds + M2_WS) + wid * 64; float* li_l = wsf; float* al_l = wsf + 32;
    float m_reg = 0.f, l_reg = 0; f32x16 o[2] = {}; bf16x8 qr[6]; f32x16 negm = f32x16{};
    const size_t bhS = (size_t)bh * S; const int q0 = qb * 256;
    const unsigned short* Qw = Q + (bhS + q0 + wid * 32 + r32) * 96 + hi * 8;
#pragma unroll
    for (int d0 = 0; d0 < 6; ++d0) qr[d0] = *reinterpret_cast<const bf16x8*>(Qw + d0 * 16);
    bool exact = true;
    if (MLA_STATIC) { float q2 = 0.f;
#pragma unroll
      for (int d0 = 0; d0 < 6; ++d0)
#pragma unroll
          for (int j = 0; j < 8; ++j) { const float x = __uint_as_float((unsigned)(unsigned short)qr[d0][j] << 16); q2 += x * x; }
      { auto rr = __builtin_amdgcn_permlane32_swap(__float_as_uint(q2), __float_as_uint(q2), false, false); q2 = __uint_as_float(rr[0]) + __uint_as_float(rr[1]); }
      const float k2 = KMX[(b * 8 + h) * 2] + KMX[(b * 8 + h) * 2 + 1] + KMX[32 + b];
      const float ms = 1.01f * sqrtf(q2 * k2);
      exact = wg_or(!(ms <= MLA_STATIC_THR), (unsigned*)(lds + 147456 - 512), wid, lane);
      if (!exact) { m_reg = ms;
#pragma unroll
          for (int r = 0; r < 16; ++r) negm[r] = -ms; } }
    const int srow = tid >> 3, sch = tid & 7, rrow = (tid & 255) >> 2, rch = tid & 3;
    const char* kn_u = (const char*)(KN + bhS * 64); const char* v_u = (const char*)(V + bhS * 64); const char* kr_u = (const char*)(KR + (size_t)b * S * 32);
    const unsigned kn_off = (unsigned)(srow * 64 + sch * 8) * 2u, kr_off = (unsigned)(rrow * 32 + rch * 8) * 2u;
    const int kst = KSWZ(srow, sch * 16), krst = KSWZ(rrow, (8 + rch) * 16), vst = v_st(srow, sch * 8);
    const int vb0 = (int)(uintptr_t)V_lds + v_rd_base(lane);
    bf16x8 s_kn[1], s_kr[1], s_v[1];
#define SLOAD(i, t) do { s_kn[i] = *reinterpret_cast<const bf16x8*>(kn_u + (size_t)(t) * 8192 + kn_off); s_kr[i] = *reinterpret_cast<const bf16x8*>(kr_u + (size_t)(t) * 4096 + kr_off); \
    s_v[i] = *reinterpret_cast<const bf16x8*>(v_u + (size_t)(t) * 8192 + kn_off); } while (0)
#define SWRITE(sl, i) do { *(bf16x8*)(K_lds + (sl) * SHM_K + kst) = s_kn[i]; if (tid < 256) *(bf16x8*)(K_lds + (sl) * SHM_K + krst) = s_kr[i]; *(bf16x8*)(V_lds + (sl) * SHM_V + vst) = s_v[i]; } while (0)
#define SWAIT() asm volatile("s_waitcnt vmcnt(0)" ::: "memory")
#define RESC(a) do { if (exact && __any((a) < 1.f)) { if (hi == 0) al_l[r32] = (a); asm volatile("s_waitcnt lgkmcnt(0)" ::: "memory"); \
    _Pragma("unroll") for (int d = 0; d < 2; ++d) _Pragma("unroll") for (int r = 0; r < 16; ++r) o[d][r] *= al_l[crow(r, hi)]; } } while (0)
#define ROT3(x) ((x) == 2 ? 0 : (x) + 1)
    f32x16 pA0, pA1, pB0, pB1; float alA, alB; bf16x8 pa0, pa1, pa2, pa3; constexpr int NT = S / 64;
#if MLA_STAMP
    unsigned long long st_acc[8] = {0, 0, 0, 0, 0, 0, 0, 0}, tq0 = 0, tq1 = 0, ts0 = 0, ts1 = 0, tu0 = 0; STAMP_T(tu0);
#endif
    SLOAD(0, 0);
    SWAIT(); SWRITE(0, 0); SLOAD(0, 1);
    __syncthreads();
    qkt96n(pA0, pA1, K_lds, qr, negm, r32, hi); if (exact) partialSM2<true>(pA0, pA1, m_reg, negm, alA); else partialSM2<false>(pA0, pA1, m_reg, negm, alA, false);
    SWAIT(); SWRITE(1, 0); SLOAD(0, 2);
    __syncthreads();
    int sp = 0, sc = 1, sn = 2;
    for (int j = 1; j + 1 < NT; j += 2) {
        if (!MLA_PROBE_NOSTAGE) { SWAIT(); SWRITE(sn, 0); if (j + 2 < NT) SLOAD(0, j + 2); }
        SBAR(); MLA_STEP(pB0, pB1, pA0, pA1, alA, alB);
        __syncthreads();
        sp = sc; sc = sn; sn = ROT3(sn);
        if (!MLA_PROBE_NOSTAGE) { SWAIT(); SWRITE(sn, 0); if (j + 3 < NT) SLOAD(0, j + 3); }
        SBAR(); MLA_STEP(pA0, pA1, pB0, pB1, alB, alA);
        __syncthreads();
        sp = sc; sc = sn; sn = ROT3(sn);
    }
    SBAR(); MLA_STEP(pB0, pB1, pA0, pA1, alA, alB);
    finishSM(pB0, pB1, alB, l_reg, pa0, pa1, pa2, pa3); SBAR();
    { const int vb = vb0 + sc * SHM_V; pv_one_p<0>(o[0], vb, pa0, pa1, pa2, pa3); pv_one_p<1>(o[1], vb, pa0, pa1, pa2, pa3); }
    if (hi == 0) li_l[r32] = l_reg; asm volatile("s_waitcnt lgkmcnt(0)" ::: "memory");
    float rli[16];
#pragma unroll
    for (int r = 0; r < 16; ++r) rli[r] = __builtin_amdgcn_rcpf(li_l[crow(r, hi)]);
    unsigned short* stg = (unsigned short*)(lds + M2_OST) + wid * 2048;
    unsigned short* dst = CAT + ((size_t)b * S + q0 + wid * 32) * 1024 + h * 64;
    store_o_tile(o, rli, stg, dst, [](int row) { return (size_t)row * 1024; }, lane);
    asm volatile("s_waitcnt vmcnt(0)" ::: "memory");
#if MLA_STAMP
    { unsigned long long tu1; STAMP_T(tu1); st_acc[6] = tu1 - tu0;
      if (blockIdx.x == 0 && wid == MLA_STAMP_WAVE && lane == 0 && STAMPS) {
#pragma unroll
          for (int i = 0; i < 8; ++i) STAMPS[i] = st_acc[i]; } }
#endif
    __syncthreads();
#undef SLOAD
#undef SWRITE
#undef SWAIT
#undef RESC
#undef ROT3
}


__device__ __forceinline__ void finishSM_s(f32x16& p0, f32x16& p1, float& l_reg, bf16x8& pa0, bf16x8& pa1, bf16x8& pa2, bf16x8& pa3) {
#pragma unroll
    for (int r = 0; r < 16; ++r) p1[r] = __builtin_amdgcn_exp2f(p1[r]);
    float ps = 0;
#pragma unroll
    for (int r = 0; r < 16; ++r) ps += p0[r];
#pragma unroll
    for (int r = 0; r < 16; ++r) ps += p1[r];
    l_reg += ps;
    PK4(p0, 0, pa0); PK4(p0, 8, pa1); PK4(p1, 0, pa2); PK4(p1, 8, pa3);
}
__device__ __forceinline__ void exp_half(f32x16& p0) {
#pragma unroll
    for (int r = 0; r < 16; ++r) p0[r] = __builtin_amdgcn_exp2f(p0[r]);
}
__device__ __forceinline__ bool mla_unit_v5(int wv, int bh, int qb, const unsigned short* __restrict__ Q, const unsigned short* __restrict__ KN, const unsigned short* __restrict__ KR,
                                            const unsigned short* __restrict__ V, unsigned short* __restrict__ CAT, const float* __restrict__ KMX, char* lds) {
    const int wid = wv, lane = gm::lane_now(), tid = wid * 64 + lane, r32 = lane & 31, hi = lane >> 5;
    const int b = bh >> 3, h = bh & 7;
    char* K_lds = lds + M2_K; char* V_lds = lds + M2_V;
    float* wsf = (float*)(lds + M2_WS) + wid * 64; float* li_l = wsf;
    float l_reg = 0; f32x16 o[2] = {}; bf16x8 qr[6];
    const size_t bhS = (size_t)bh * S; const int q0 = qb * 256;
    const unsigned short* Qw = Q + (bhS + q0 + wid * 32 + r32) * 96 + hi * 8;
#pragma unroll
    for (int d0 = 0; d0 < 6; ++d0) qr[d0] = *reinterpret_cast<const bf16x8*>(Qw + d0 * 16);
    f32x16 negm;
    { float q2 = 0.f;
#pragma unroll
      for (int d0 = 0; d0 < 6; ++d0)
#pragma unroll
          for (int j = 0; j < 8; ++j) { const float x = __uint_as_float((unsigned)(unsigned short)qr[d0][j] << 16); q2 += x * x; }
      { auto rr = __builtin_amdgcn_permlane32_swap(__float_as_uint(q2), __float_as_uint(q2), false, false); q2 = __uint_as_float(rr[0]) + __uint_as_float(rr[1]); }
      const float k2 = KMX[(b * 8 + h) * 2] + KMX[(b * 8 + h) * 2 + 1] + KMX[32 + b];
      const float m = 1.01f * sqrtf(q2 * k2);
#pragma unroll
      for (int r = 0; r < 16; ++r) negm[r] = -m; }
    const int srow = tid >> 3, sch = tid & 7, rrow = (tid & 255) >> 2, rch = tid & 3;
    const char* kn_u = (const char*)(KN + bhS * 64); const char* v_u = (const char*)(V + bhS * 64); const char* kr_u = (const char*)(KR + (size_t)b * S * 32);
    const unsigned kn_off = (unsigned)(srow * 64 + sch * 8) * 2u, kr_off = (unsigned)(rrow * 32 + rch * 8) * 2u;
    const int kst = KSWZ(srow, sch * 16), krst = KSWZ(rrow, (8 + rch) * 16), vst = v_st(srow, sch * 8);
    const int vb0 = (int)(uintptr_t)V_lds + v_rd_base(lane);
    bf16x8 s_kn, s_kr, s_v;
#define SLOAD(t) do { s_kn = *reinterpret_cast<const bf16x8*>(kn_u + (size_t)(t) * 8192 + kn_off); s_kr = *reinterpret_cast<const bf16x8*>(kr_u + (size_t)(t) * 4096 + kr_off); \
    s_v = *reinterpret_cast<const bf16x8*>(v_u + (size_t)(t) * 8192 + kn_off); } while (0)
#define SWRITE(sl) do { *(bf16x8*)(K_lds + (sl) * SHM_K + kst) = s_kn; if (tid < 256) *(bf16x8*)(K_lds + (sl) * SHM_K + krst) = s_kr; *(bf16x8*)(V_lds + (sl) * SHM_V + vst) = s_v; } while (0)
#define SWAIT() asm volatile("s_waitcnt vmcnt(0)" ::: "memory")
#define ROT3(x) ((x) == 2 ? 0 : (x) + 1)
#define STEP5(PC0, PC1, PP0, PP1) do { \
    qkt96n(PC0, PC1, K_lds + sc * SHM_K, qr, negm, r32, hi); \
    finishSM_s(PP0, PP1, l_reg, pa0, pa1, pa2, pa3); SBAR(); \
    { const int vb_ = vb0 + sp * SHM_V; pv_one_p<0>(o[0], vb_, pa0, pa1, pa2, pa3); pv_one_p<1>(o[1], vb_, pa0, pa1, pa2, pa3); } \
    exp_half(PC0); } while (0)
    f32x16 pA0, pA1, pB0, pB1; bf16x8 pa0, pa1, pa2, pa3; constexpr int NT = S / 64;
    SLOAD(0);
    SWAIT(); SWRITE(0); SLOAD(1);
    __syncthreads();
    qkt96n(pA0, pA1, K_lds, qr, negm, r32, hi); exp_half(pA0);
    SWAIT(); SWRITE(1); SLOAD(2);
    __syncthreads();
    int sp = 0, sc = 1, sn = 2;
    for (int j = 1; j + 1 < NT; j += 2) {
        SWAIT(); SWRITE(sn); if (j + 2 < NT) SLOAD(j + 2);
        SBAR(); STEP5(pB0, pB1, pA0, pA1);
        __syncthreads();
        sp = sc; sc = sn; sn = ROT3(sn);
        SWAIT(); SWRITE(sn); if (j + 3 < NT) SLOAD(j + 3);
        SBAR(); STEP5(pA0, pA1, pB0, pB1);
        __syncthreads();
        sp = sc; sc = sn; sn = ROT3(sn);
    }
    SBAR(); STEP5(pB0, pB1, pA0, pA1);
    finishSM_s(pB0, pB1, l_reg, pa0, pa1, pa2, pa3); SBAR();
    { const int vb = vb0 + sc * SHM_V; pv_one_p<0>(o[0], vb, pa0, pa1, pa2, pa3); pv_one_p<1>(o[1], vb, pa0, pa1, pa2, pa3); }
    { auto rr = __builtin_amdgcn_permlane32_swap(__float_as_uint(l_reg), __float_as_uint(l_reg), false, false); l_reg = __uint_as_float(rr[0]) + __uint_as_float(rr[1]); }
    const bool bad = !(l_reg > 1e-30f);
    if (hi == 0) li_l[r32] = l_reg; asm volatile("s_waitcnt lgkmcnt(0)" ::: "memory");
    float rli[16];
#pragma unroll
    for (int r = 0; r < 16; ++r) rli[r] = __builtin_amdgcn_rcpf(li_l[crow(r, hi)]);
    unsigned short* stg = (unsigned short*)(lds + M2_OST) + wid * 2048;
    unsigned short* dst = CAT + ((size_t)b * S + q0 + wid * 32) * 1024 + h * 64;
    store_o_tile(o, rli, stg, dst, [](int row) { return (size_t)row * 1024; }, lane);
    asm volatile("s_waitcnt vmcnt(0)" ::: "memory");
    const int anybad = wg_or(bad, (unsigned*)(lds + 147456 - 512), wid, lane) ? 1 : 0;
    return anybad != 0;
#undef SLOAD
#undef SWRITE
#undef SWAIT
#undef ROT3
#undef STEP5
}

constexpr int M4_K = 0, M4_V = 4 * SHM_K, M4_WS = M4_V + 4 * SHM_V, M4_OST = M4_WS + 8 * 256;
template <bool FIRST> __device__ __forceinline__ void softmax_full(f32x16& p0, f32x16& p1, float& m_reg, f32x16& negm, float& l_reg, float& alpha, bf16x8& pa0, bf16x8& pa1, bf16x8& pa2, bf16x8& pa3, bool exact) {
    if (exact) partialSM2<FIRST>(p0, p1, m_reg, negm, alpha, true); else partialSM2<false>(p0, p1, m_reg, negm, alpha, false);
    finishSM(p0, p1, alpha, l_reg, pa0, pa1, pa2, pa3);
}
__device__ __forceinline__ void mla_unit_v4(int wv, int bh, int qb, const unsigned short* __restrict__ Q, const unsigned short* __restrict__ KN, const unsigned short* __restrict__ KR,
                                            const unsigned short* __restrict__ V, unsigned short* __restrict__ CAT, const float* __restrict__ KMX, char* lds, unsigned long long* STAMPS = nullptr) {
    const int wid = wv, lane = gm::lane_now(), tid = wid * 64 + lane, r32 = lane & 31, hi = lane >> 5;
    const int b = bh >> 3, h = bh & 7; const bool halfB = wid >= 4;
    char* K_lds = lds + M4_K; char* V_lds = lds + M4_V;
    float* wsf = (float*)(lds + M4_WS) + wid * 64; float* li_l = wsf; float* al_l = wsf + 32;
    float m_reg = 0.f, l_reg = 0; f32x16 o[2] = {}; bf16x8 qr[6]; f32x16 negm = f32x16{};
    const size_t bhS = (size_t)bh * S; const int q0 = qb * 256;
    const unsigned short* Qw = Q + (bhS + q0 + wid * 32 + r32) * 96 + hi * 8;
#pragma unroll
    for (int d0 = 0; d0 < 6; ++d0) qr[d0] = *reinterpret_cast<const bf16x8*>(Qw + d0 * 16);
    bool exact = true;
    if (MLA_STATIC) { float q2 = 0.f;
#pragma unroll
      for (int d0 = 0; d0 < 6; ++d0)
#pragma unroll
          for (int j = 0; j < 8; ++j) { const float x = __uint_as_float((unsigned)(unsigned short)qr[d0][j] << 16); q2 += x * x; }
      { auto rr = __builtin_amdgcn_permlane32_swap(__float_as_uint(q2), __float_as_uint(q2), false, false); q2 = __uint_as_float(rr[0]) + __uint_as_float(rr[1]); }
      const float k2 = KMX[(b * 8 + h) * 2] + KMX[(b * 8 + h) * 2 + 1] + KMX[32 + b];
      const float ms = 1.01f * sqrtf(q2 * k2);
      exact = wg_or(!(ms <= MLA_STATIC_THR), (unsigned*)(lds + 147456 - 512), wid, lane);
      if (!exact) { m_reg = ms;
#pragma unroll
          for (int r = 0; r < 16; ++r) negm[r] = -ms; } }
    const int srow = tid >> 3, sch = tid & 7, rrow = (tid & 255) >> 2, rch = tid & 3;
    const char* kn_u = (const char*)(KN + bhS * 64); const char* v_u = (const char*)(V + bhS * 64); const char* kr_u = (const char*)(KR + (size_t)b * S * 32);
    const unsigned kn_off = (unsigned)(srow * 64 + sch * 8) * 2u, kr_off = (unsigned)(rrow * 32 + rch * 8) * 2u;
    const int kst = KSWZ(srow, sch * 16), krst = KSWZ(rrow, (8 + rch) * 16), vst = v_st(srow, sch * 8);
    const int vb0 = (int)(uintptr_t)V_lds + v_rd_base(lane);
    bf16x8 s_kn, s_kr, s_v;
#define SLOAD(t) do { s_kn = *reinterpret_cast<const bf16x8*>(kn_u + (size_t)(t) * 8192 + kn_off); s_kr = *reinterpret_cast<const bf16x8*>(kr_u + (size_t)(t) * 4096 + kr_off); \
    s_v = *reinterpret_cast<const bf16x8*>(v_u + (size_t)(t) * 8192 + kn_off); } while (0)
#define SWRITE(sl) do { *(bf16x8*)(K_lds + (sl) * SHM_K + kst) = s_kn; if (tid < 256) *(bf16x8*)(K_lds + (sl) * SHM_K + krst) = s_kr; *(bf16x8*)(V_lds + (sl) * SHM_V + vst) = s_v; } while (0)
#define SWAIT() asm volatile("s_waitcnt vmcnt(0)" ::: "memory")
#define RESC(a) do { if (exact && __any((a) < 1.f)) { if (hi == 0) al_l[r32] = (a); asm volatile("s_waitcnt lgkmcnt(0)" ::: "memory"); \
    _Pragma("unroll") for (int d = 0; d < 2; ++d) _Pragma("unroll") for (int r = 0; r < 16; ++r) o[d][r] *= al_l[crow(r, hi)]; } } while (0)
#define RAWBAR() do { asm volatile("" ::: "memory"); __builtin_amdgcn_s_barrier(); asm volatile("" ::: "memory"); } while (0)
    f32x16 p0, p1; float al; bf16x8 pa0, pa1, pa2, pa3; bf16x8 kf[12]; constexpr int NT = S / 64;
#if MLA_STAMP
    unsigned long long st_acc[8] = {0, 0, 0, 0, 0, 0, 0, 0}, tq0 = 0, tq1 = 0, tu0 = 0; STAMP_T(tu0);
#endif
    SLOAD(0); SWAIT(); SWRITE(0); SLOAD(1); SWAIT(); SWRITE(1); SLOAD(2);
    asm volatile("s_waitcnt lgkmcnt(0)" ::: "memory"); RAWBAR();
    if (halfB) RAWBAR();
    kfrag_load(kf, K_lds, r32, hi); SBAR();
    qk_mma(p0, p1, kf, qr, negm); SBAR();
    asm volatile("s_waitcnt lgkmcnt(0)" ::: "memory"); RAWBAR();
    softmax_full<true>(p0, p1, m_reg, negm, l_reg, al, pa0, pa1, pa2, pa3, exact); SBAR();
    SWAIT(); SWRITE(2); SLOAD(3); SBAR();
    kfrag_load(kf, K_lds + SHM_K, r32, hi); SBAR();
    asm volatile("s_waitcnt lgkmcnt(12)" ::: "memory"); RAWBAR();
    int sp = 0, sc = 1, sw = 3;
    for (int t = 1; t < NT; ++t) {
        STAMP_T(tq0);
        { s16x4 val[4], vah[4], vbl[4], vbh[4]; const int vb_ = vb0 + sp * SHM_V;
          vfrag_load_h<0>(val, vah, vb_); SBAR();
          qk_mma(p0, p1, kf, qr, negm); SBAR();
          vfrag_load_h<1>(vbl, vbh, vb_); SBAR();
          asm volatile("s_waitcnt lgkmcnt(8)" ::: "memory"); SBAR();
          pv_mma_h(o[0], val, vah, pa0, pa1, pa2, pa3); SBAR();
          asm volatile("s_waitcnt lgkmcnt(0)" ::: "memory"); SBAR();
          pv_mma_h(o[1], vbl, vbh, pa0, pa1, pa2, pa3); SBAR(); }
        STAMP_T(tq1); STAMP_ACC(1, tq0, tq1);
        RAWBAR();
        STAMP_T(tq0); STAMP_ACC(2, tq1, tq0);
        if (t + 2 < NT) { SWAIT(); SWRITE(sw); if (t + 3 < NT) SLOAD(t + 3); } SBAR();
        softmax_full<false>(p0, p1, m_reg, negm, l_reg, al, pa0, pa1, pa2, pa3, exact); RESC(al); SBAR();
        sp = sc; sc = (sc + 1) & 3; sw = (sw + 1) & 3;
        if (t + 1 < NT) { kfrag_load(kf, K_lds + sc * SHM_K, r32, hi); SBAR(); }
        STAMP_T(tq1); STAMP_ACC(3, tq0, tq1);
        asm volatile("s_waitcnt lgkmcnt(12)" ::: "memory"); RAWBAR();
        STAMP_T(tq0); STAMP_ACC(4, tq1, tq0);
    }
    { s16x4 val[4], vah[4], vbl[4], vbh[4]; const int vb_ = vb0 + sp * SHM_V;
      vfrag_load_h<0>(val, vah, vb_); vfrag_load_h<1>(vbl, vbh, vb_); SBAR();
      asm volatile("s_waitcnt lgkmcnt(0)" ::: "memory"); SBAR();
      pv_mma_h(o[0], val, vah, pa0, pa1, pa2, pa3); pv_mma_h(o[1], vbl, vbh, pa0, pa1, pa2, pa3); SBAR(); }
    if (!halfB) RAWBAR();
    if (hi == 0) li_l[r32] = l_reg; asm volatile("s_waitcnt lgkmcnt(0)" ::: "memory");
    float rli[16];
#pragma unroll
    for (int r = 0; r < 16; ++r) rli[r] = __builtin_amdgcn_rcpf(li_l[crow(r, hi)]);
    unsigned short* stg = (unsigned short*)(lds + M4_OST) + wid * 2048;
    unsigned short* dst = CAT + ((size_t)b * S + q0 + wid * 32) * 1024 + h * 64;
    store_o_tile(o, rli, stg, dst, [](int row) { return (size_t)row * 1024; }, lane);
    asm volatile("s_waitcnt vmcnt(0)" ::: "memory");
#if MLA_STAMP
    { unsigned long long tu1; STAMP_T(tu1); st_acc[6] = tu1 - tu0;
      if (blockIdx.x == 0 && wid == MLA_STAMP_WAVE && lane == 0 && STAMPS) {
#pragma unroll
          for (int i = 0; i < 8; ++i) STAMPS[i] = st_acc[i]; } }
#endif
    __syncthreads();
#undef SLOAD
#undef SWRITE
#undef SWAIT
#undef RESC
#undef RAWBAR
}


constexpr int M6_K = 0, M6_V = 4 * SHM_K, M6_WS = M6_V + 4 * SHM_V, M6_OST = M6_WS + 8 * 256;
#define KLD3(dst, Ks_, D0) do { _Pragma("unroll") for (int d_ = 0; d_ < 3; ++d_) { const int cb_ = (((D0) + d_) * 16 + hi * 8) * 2; \
        dst[2 * d_] = *reinterpret_cast<const bf16x8*>((Ks_) + KSWZ(r32, cb_)); dst[2 * d_ + 1] = *reinterpret_cast<const bf16x8*>((Ks_) + KSWZ(32 + r32, cb_)); } } while (0)
#define MF32(A, B, C) __builtin_amdgcn_mfma_f32_32x32x16_bf16(A, B, C, 0, 0, 0)
#define QK_ADD(DST, KF, QF, CIN, PPX, B) do { DST = MF32(KF, QF, CIN); s0 += PPX[B]; s1 += PPX[B + 1]; s2 += PPX[B + 2]; s3 += PPX[B + 3]; SBAR(); } while (0)
#define QK_PK(DST, KF, QF, CIN, PPX, B, OUT) do { DST = MF32(KF, QF, CIN); PK4(PPX, B, OUT); SBAR(); } while (0)
__device__ __forceinline__ void mla_unit_v6(int wv, int bh, int qb, const unsigned short* __restrict__ Q, const unsigned short* __restrict__ KN, const unsigned short* __restrict__ KR,
                                            const unsigned short* __restrict__ V, unsigned short* __restrict__ CAT, const float* __restrict__ KMX, char* lds) {
    const int wid = wv, lane = gm::lane_now(), tid = wid * 64 + lane, r32 = lane & 31, hi = lane >> 5;
    const int b = bh >> 3, h = bh & 7; const bool halfB = wid >= 4;
    char* K_lds = lds + M6_K; char* V_lds = lds + M6_V;
    float* wsf = (float*)(lds + M6_WS) + wid * 64; float* li_l = wsf; float* al_l = wsf + 32;
    float m_reg = 0.f, l_reg = 0; f32x16 o[2] = {}; bf16x8 qr[6]; f32x16 negm = f32x16{};
    const size_t bhS = (size_t)bh * S; const int q0 = qb * 256;
    const unsigned short* Qw = Q + (bhS + q0 + wid * 32 + r32) * 96 + hi * 8;
#pragma unroll
    for (int d0 = 0; d0 < 6; ++d0) qr[d0] = *reinterpret_cast<const bf16x8*>(Qw + d0 * 16);
    bool exact = true;
    if (MLA_STATIC) { float q2 = 0.f;
#pragma unroll
      for (int d0 = 0; d0 < 6; ++d0)
#pragma unroll
          for (int j = 0; j < 8; ++j) { const float x = __uint_as_float((unsigned)(unsigned short)qr[d0][j] << 16); q2 += x * x; }
      { auto rr = __builtin_amdgcn_permlane32_swap(__float_as_uint(q2), __float_as_uint(q2), false, false); q2 = __uint_as_float(rr[0]) + __uint_as_float(rr[1]); }
      const float k2 = KMX[(b * 8 + h) * 2] + KMX[(b * 8 + h) * 2 + 1] + KMX[32 + b];
      const float ms = 1.01f * sqrtf(q2 * k2);
      exact = wg_or(!(ms <= MLA_STATIC_THR), (unsigned*)(lds + 147456 - 512), wid, lane);
      if (!exact) { m_reg = ms;
#pragma unroll
          for (int r = 0; r < 16; ++r) negm[r] = -ms; } }
    const int srow = tid >> 3, sch = tid & 7, rrow = (tid & 255) >> 2, rch = tid & 3;
    const char* kn_u = (const char*)(KN + bhS * 64); const char* v_u = (const char*)(V + bhS * 64); const char* kr_u = (const char*)(KR + (size_t)b * S * 32);
    const unsigned kn_off = (unsigned)(srow * 64 + sch * 8) * 2u, kr_off = (unsigned)(rrow * 32 + rch * 8) * 2u;
    const int kst = KSWZ(srow, sch * 16), krst = KSWZ(rrow, (8 + rch) * 16), vst = v_st(srow, sch * 8);
    const int vb0 = (int)(uintptr_t)V_lds + v_rd_base(lane);
    bf16x8 s_kn, s_kr, s_v;
#define SLOAD(t) do { s_kn = *reinterpret_cast<const bf16x8*>(kn_u + (size_t)(t) * 8192 + kn_off); s_kr = *reinterpret_cast<const bf16x8*>(kr_u + (size_t)(t) * 4096 + kr_off); \
    s_v = *reinterpret_cast<const bf16x8*>(v_u + (size_t)(t) * 8192 + kn_off); } while (0)
#define SWRITE(sl) do { *(bf16x8*)(K_lds + (sl) * SHM_K + kst) = s_kn; if (tid < 256) *(bf16x8*)(K_lds + (sl) * SHM_K + krst) = s_kr; *(bf16x8*)(V_lds + (sl) * SHM_V + vst) = s_v; } while (0)
#define SWAIT() asm volatile("s_waitcnt vmcnt(0)" ::: "memory")
#define RESC(a) do { if (exact && __any((a) < 1.f)) { if (hi == 0) al_l[r32] = (a); asm volatile("s_waitcnt lgkmcnt(0)" ::: "memory"); l_reg *= (a); \
    _Pragma("unroll") for (int d = 0; d < 2; ++d) _Pragma("unroll") for (int r = 0; r < 16; ++r) o[d][r] *= al_l[crow(r, hi)]; } } while (0)
#define RAWBAR() do { asm volatile("" ::: "memory"); __builtin_amdgcn_s_barrier(); asm volatile("" ::: "memory"); } while (0)
#define EXP_TILE(P0, P1, FIRST_) do { float al_ = 1.f; \
        if (exact) { const float pmax = rowmax32b(P0, P1); \
            if ((FIRST_) || !__builtin_expect(__all(pmax <= THR), 1)) { const float dl = (FIRST_) ? pmax : fmaxf(pmax, 0.f); m_reg += dl; \
                _Pragma("unroll") for (int r = 0; r < 16; ++r) { P0[r] -= dl; P1[r] -= dl; } \
                _Pragma("unroll") for (int r = 0; r < 16; ++r) negm[r] = -m_reg; \
                if (!(FIRST_)) al_ = __builtin_amdgcn_exp2f(-dl); } } \
        _Pragma("unroll") for (int r = 0; r < 16; ++r) P0[r] = __builtin_amdgcn_exp2f(P0[r]); \
        _Pragma("unroll") for (int r = 0; r < 16; ++r) P1[r] = __builtin_amdgcn_exp2f(P1[r]); \
        RESC(al_); } while (0)
#define M_PART(PC0, PC1, PP0, PP1) do { \
        s16x4 val[4], vah[4], vbl[4], vbh[4]; const int vb_ = vb0 + sp * SHM_V; float s0 = 0.f, s1 = 0.f, s2 = 0.f, s3 = 0.f; \
        KLD3(kb, K_lds + sc * SHM_K, 3); SBAR(); \
        QK_ADD(PC0, ka[0], qr[0], negm, PP0, 0);  QK_ADD(PC1, ka[1], qr[0], negm, PP0, 4); \
        QK_ADD(PC0, ka[2], qr[1], PC0, PP0, 8);   QK_ADD(PC1, ka[3], qr[1], PC1, PP0, 12); \
        QK_ADD(PC0, ka[4], qr[2], PC0, PP1, 0);   QK_ADD(PC1, ka[5], qr[2], PC1, PP1, 4); \
        vfrag_load_h<0>(val, vah, vb_); vfrag_load_h<1>(vbl, vbh, vb_); SBAR(); \
        QK_ADD(PC0, kb[0], qr[3], PC0, PP1, 8);   QK_ADD(PC1, kb[1], qr[3], PC1, PP1, 12); \
        QK_PK(PC0, kb[2], qr[4], PC0, PP0, 0, pa0); QK_PK(PC1, kb[3], qr[4], PC1, PP0, 8, pa1); \
        QK_PK(PC0, kb[4], qr[5], PC0, PP1, 0, pa2); QK_PK(PC1, kb[5], qr[5], PC1, PP1, 8, pa3); \
        { float ps = (s0 + s1) + (s2 + s3); auto rr = __builtin_amdgcn_permlane32_swap(__float_as_uint(ps), __float_as_uint(ps), false, false); l_reg += __uint_as_float(rr[0]) + __uint_as_float(rr[1]); } \
        asm volatile("s_waitcnt lgkmcnt(0)" ::: "memory"); SBAR(); \
        pv_mma_h(o[0], val, vah, pa0, pa1, pa2, pa3); pv_mma_h(o[1], vbl, vbh, pa0, pa1, pa2, pa3); SBAR(); } while (0)
#define V_PART(PC0, PC1, t_) do { \
        if ((t_) + 2 < NT) { SWAIT(); SWRITE(sw); if ((t_) + 3 < NT) SLOAD((t_) + 3); } SBAR(); \
        EXP_TILE(PC0, PC1, false); SBAR(); \
        sp = sc; sc = (sc + 1) & 3; sw = (sw + 1) & 3; \
        if ((t_) + 1 < NT) { KLD3(ka, K_lds + sc * SHM_K, 0); SBAR(); } \
        asm volatile("s_waitcnt lgkmcnt(6)" ::: "memory"); RAWBAR(); } while (0)
    f32x16 pA0, pA1, pB0, pB1; bf16x8 pa0, pa1, pa2, pa3; bf16x8 ka[6], kb[6]; constexpr int NT = S / 64;
    SLOAD(0); SWAIT(); SWRITE(0); SLOAD(1); SWAIT(); SWRITE(1); SLOAD(2);
    asm volatile("s_waitcnt lgkmcnt(0)" ::: "memory"); RAWBAR();
    if (halfB) RAWBAR();
    KLD3(ka, K_lds, 0); KLD3(kb, K_lds, 3); SBAR();
    pA0 = MF32(ka[0], qr[0], negm); pA1 = MF32(ka[1], qr[0], negm); pA0 = MF32(ka[2], qr[1], pA0); pA1 = MF32(ka[3], qr[1], pA1); pA0 = MF32(ka[4], qr[2], pA0); pA1 = MF32(ka[5], qr[2], pA1);
    pA0 = MF32(kb[0], qr[3], pA0); pA1 = MF32(kb[1], qr[3], pA1); pA0 = MF32(kb[2], qr[4], pA0); pA1 = MF32(kb[3], qr[4], pA1); pA0 = MF32(kb[4], qr[5], pA0); pA1 = MF32(kb[5], qr[5], pA1); SBAR();
    asm volatile("s_waitcnt lgkmcnt(0)" ::: "memory"); RAWBAR();
    int sp = 0, sc = 0, sw = 2;
    SWAIT(); SWRITE(2); SLOAD(3); SBAR();
    EXP_TILE(pA0, pA1, true); SBAR();
    sp = 0; sc = 1; sw = 3;
    KLD3(ka, K_lds + SHM_K, 0); SBAR();
    asm volatile("s_waitcnt lgkmcnt(6)" ::: "memory"); RAWBAR();
    for (int t = 1; t + 1 < NT; t += 2) {
        M_PART(pB0, pB1, pA0, pA1); RAWBAR(); V_PART(pB0, pB1, t);
        M_PART(pA0, pA1, pB0, pB1); RAWBAR(); V_PART(pA0, pA1, t + 1);
    }
    M_PART(pB0, pB1, pA0, pA1); RAWBAR(); V_PART(pB0, pB1, NT - 1);
    { s16x4 val[4], vah[4], vbl[4], vbh[4]; const int vb_ = vb0 + sp * SHM_V; float ps = 0.f;
      vfrag_load_h<0>(val, vah, vb_); vfrag_load_h<1>(vbl, vbh, vb_); SBAR();
#pragma unroll
      for (int r = 0; r < 16; ++r) ps += pB0[r] + pB1[r];
      { auto rr = __builtin_amdgcn_permlane32_swap(__float_as_uint(ps), __float_as_uint(ps), false, false); l_reg += __uint_as_float(rr[0]) + __uint_as_float(rr[1]); }
      PK4(pB0, 0, pa0); PK4(pB0, 8, pa1); PK4(pB1, 0, pa2); PK4(pB1, 8, pa3);
      asm volatile("s_waitcnt lgkmcnt(0)" ::: "memory"); SBAR();
      pv_mma_h(o[0], val, vah, pa0, pa1, pa2, pa3); pv_mma_h(o[1], vbl, vbh, pa0, pa1, pa2, pa3); SBAR(); }
    if (!halfB) RAWBAR();
    if (hi == 0) li_l[r32] = l_reg; asm volatile("s_waitcnt lgkmcnt(0)" ::: "memory");
    float rli[16];
#pragma unroll
    for (int r = 0; r < 16; ++r) rli[r] = __builtin_amdgcn_rcpf(li_l[crow(r, hi)]);
    unsigned short* stg = (unsigned short*)(lds + M6_OST) + wid * 2048;
    unsigned short* dst = CAT + ((size_t)b * S + q0 + wid * 32) * 1024 + h * 64;
    store_o_tile(o, rli, stg, dst, [](int row) { return (size_t)row * 1024; }, lane);
    asm volatile("s_waitcnt vmcnt(0)" ::: "memory");
    __syncthreads();
#undef SLOAD
#undef SWRITE
#undef SWAIT
#undef RESC
#undef RAWBAR
#undef EXP_TILE
#undef M_PART
#undef V_PART
}


#define PV_EXP(OD, PA, VL, VH, PCX, B) do { OD = MF32(PA, PKV(VL, VH), OD); PCX[B] = __builtin_amdgcn_exp2f(PCX[B]); PCX[B + 1] = __builtin_amdgcn_exp2f(PCX[B + 1]); \
        PCX[B + 2] = __builtin_amdgcn_exp2f(PCX[B + 2]); PCX[B + 3] = __builtin_amdgcn_exp2f(PCX[B + 3]); asm volatile("" : "+v"(PCX)); SBAR(); } while (0)
__device__ __forceinline__ void mla_unit_v7(int wv, int bh, int qb, const unsigned short* __restrict__ Q, const unsigned short* __restrict__ KN, const unsigned short* __restrict__ KR,
                                            const unsigned short* __restrict__ V, unsigned short* __restrict__ CAT, const float* __restrict__ KMX, char* lds, unsigned long long* STAMPS = nullptr) {
    const int wid = wv, lane = gm::lane_now(), tid = wid * 64 + lane, r32 = lane & 31, hi = lane >> 5;
    const int b = bh >> 3, h = bh & 7;
    char* K_lds = lds + M6_K; char* V_lds = lds + M6_V;
    float* wsf = (float*)(lds + M6_WS) + wid * 64; float* li_l = wsf; float* al_l = wsf + 32;
    float m_reg = 0.f, l_reg = 0; f32x16 o[2] = {}; bf16x8 qr[6]; f32x16 negm = f32x16{};
    const size_t bhS = (size_t)bh * S; const int q0 = qb * 256;
    const unsigned short* Qw = Q + (bhS + q0 + wid * 32 + r32) * 96 + hi * 8;
#pragma unroll
    for (int d0 = 0; d0 < 6; ++d0) qr[d0] = *reinterpret_cast<const bf16x8*>(Qw + d0 * 16);
    bool exact = true;
    if (MLA_STATIC) { float q2 = 0.f;
#pragma unroll
      for (int d0 = 0; d0 < 6; ++d0)
#pragma unroll
          for (int j = 0; j < 8; ++j) { const float x = __uint_as_float((unsigned)(unsigned short)qr[d0][j] << 16); q2 += x * x; }
      { auto rr = __builtin_amdgcn_permlane32_swap(__float_as_uint(q2), __float_as_uint(q2), false, false); q2 = __uint_as_float(rr[0]) + __uint_as_float(rr[1]); }
      const float k2 = KMX[(b * 8 + h) * 2] + KMX[(b * 8 + h) * 2 + 1] + KMX[32 + b];
      const float ms = 1.01f * sqrtf(q2 * k2);
      exact = wg_or(!(ms <= MLA_STATIC_THR), (unsigned*)(lds + 147456 - 512), wid, lane);
      if (!exact) { m_reg = ms;
#pragma unroll
          for (int r = 0; r < 16; ++r) negm[r] = -ms; } }
    const int srow = tid >> 3, sch = tid & 7, rrow = (tid & 255) >> 2, rch = tid & 3;
    const char* kn_u = (const char*)(KN + bhS * 64); const char* v_u = (const char*)(V + bhS * 64); const char* kr_u = (const char*)(KR + (size_t)b * S * 32);
    const unsigned kn_off = (unsigned)(srow * 64 + sch * 8) * 2u, kr_off = (unsigned)(rrow * 32 + rch * 8) * 2u;
    const int kst = KSWZ(srow, sch * 16), krst = KSWZ(rrow, (8 + rch) * 16), vst = v_st(srow, sch * 8);
    const int vb0 = (int)(uintptr_t)V_lds + v_rd_base(lane);
    bf16x8 s_kn, s_kr, s_v;
#define SLOAD(t) do { s_kn = *reinterpret_cast<const bf16x8*>(kn_u + (size_t)(t) * 8192 + kn_off); s_kr = *reinterpret_cast<const bf16x8*>(kr_u + (size_t)(t) * 4096 + kr_off); \
    s_v = *reinterpret_cast<const bf16x8*>(v_u + (size_t)(t) * 8192 + kn_off); } while (0)
#define SWRITE(sl) do { *(bf16x8*)(K_lds + (sl) * SHM_K + kst) = s_kn; if (tid < 256) *(bf16x8*)(K_lds + (sl) * SHM_K + krst) = s_kr; *(bf16x8*)(V_lds + (sl) * SHM_V + vst) = s_v; } while (0)
#define SWAIT() asm volatile("s_waitcnt vmcnt(0)" ::: "memory")
#define RAWBAR() do { asm volatile("" ::: "memory"); __builtin_amdgcn_s_barrier(); asm volatile("" ::: "memory"); } while (0)
#define MAX_TILE(P0, P1, FIRST_, AL_) do { AL_ = 1.f; \
        if (V7_EXACT && exact) { const float pmax = rowmax32b(P0, P1); \
            if ((FIRST_) || !__builtin_expect(__all(pmax <= THR), 1)) { const float dl = (FIRST_) ? pmax : fmaxf(pmax, 0.f); m_reg += dl; \
                _Pragma("unroll") for (int r = 0; r < 16; ++r) { P0[r] -= dl; P1[r] -= dl; } \
                _Pragma("unroll") for (int r = 0; r < 16; ++r) negm[r] = -m_reg; \
                if (!(FIRST_)) AL_ = __builtin_amdgcn_exp2f(-dl); } } } while (0)
#define RESC7(a) do { if (V7_EXACT && exact && __any((a) < 1.f)) { if (hi == 0) al_l[r32] = (a); asm volatile("s_waitcnt lgkmcnt(0)" ::: "memory"); l_reg *= (a); \
    _Pragma("unroll") for (int d = 0; d < 2; ++d) _Pragma("unroll") for (int r = 0; r < 16; ++r) o[d][r] *= al_l[crow(r, hi)]; } } while (0)
#define STEP7(PC0, PC1, PP0, PP1, t_) do { \
        s16x4 val[4], vah[4], vbl[4], vbh[4]; const int vb_ = vb0 + sp * SHM_V; float s0 = 0.f, s1 = 0.f, s2 = 0.f, s3 = 0.f, al_; \
        SEC_B(0); if ((t_) + 2 < NT) { SWAIT(); SWRITE(sw); if ((t_) + 3 < NT) SLOAD((t_) + 3); } SEC_E(0); \
        SEC_B(1); KLD3(kb, K_lds + sc * SHM_K, 3); SBAR(); \
        QK_ADD(PC0, ka[0], qr[0], negm, PP0, 0);  QK_ADD(PC1, ka[1], qr[0], negm, PP0, 4); \
        QK_ADD(PC0, ka[2], qr[1], PC0, PP0, 8);   QK_ADD(PC1, ka[3], qr[1], PC1, PP0, 12); \
        QK_ADD(PC0, ka[4], qr[2], PC0, PP1, 0);   QK_ADD(PC1, ka[5], qr[2], PC1, PP1, 4); \
        vfrag_load_h<0>(val, vah, vb_); SBAR(); \
        QK_ADD(PC0, kb[0], qr[3], PC0, PP1, 8);   QK_ADD(PC1, kb[1], qr[3], PC1, PP1, 12); \
        QK_PK(PC0, kb[2], qr[4], PC0, PP0, 0, pa0); QK_PK(PC1, kb[3], qr[4], PC1, PP0, 8, pa1); \
        vfrag_load_h<1>(vbl, vbh, vb_); SBAR(); \
        QK_PK(PC0, kb[4], qr[5], PC0, PP1, 0, pa2); QK_PK(PC1, kb[5], qr[5], PC1, PP1, 8, pa3); \
        { float ps = (s0 + s1) + (s2 + s3); auto rr = __builtin_amdgcn_permlane32_swap(__float_as_uint(ps), __float_as_uint(ps), false, false); l_reg += __uint_as_float(rr[0]) + __uint_as_float(rr[1]); } \
        MAX_TILE(PC0, PC1, false, al_); SEC_E(1); \
        SEC_B(4); sp = sc; sc = (sc + 1) & 3; sw = (sw + 1) & 3; \
        if ((t_) + 1 < NT) KLD3(ka, K_lds + sc * SHM_K, 0); \
        asm volatile("s_waitcnt lgkmcnt(6)" ::: "memory"); SBAR(); SEC_E(4); SEC_B(2); \
        PV_EXP(o[0], pa0, val[0], vah[0], PC0, 0);  PV_EXP(o[1], pa0, vbl[0], vbh[0], PC0, 4); \
        PV_EXP(o[0], pa1, val[1], vah[1], PC0, 8);  PV_EXP(o[1], pa1, vbl[1], vbh[1], PC0, 12); \
        PV_EXP(o[0], pa2, val[2], vah[2], PC1, 0);  PV_EXP(o[1], pa2, vbl[2], vbh[2], PC1, 4); \
        PV_EXP(o[0], pa3, val[3], vah[3], PC1, 8);  PV_EXP(o[1], pa3, vbl[3], vbh[3], PC1, 12); \
        RESC7(al_); SEC_E(2); \
        SEC_B(3); RAWBAR(); SEC_E(3); } while (0)
    f32x16 pA0, pA1, pB0, pB1; bf16x8 pa0, pa1, pa2, pa3; bf16x8 ka[6], kb[6]; constexpr int NT = S / 64;
#if MLA_STAMP
    unsigned long long st_a = 0, tq0 = 0, tq1 = 0;
#endif

    if (V7_YOUNG_PRIO && wid >= 4) __builtin_amdgcn_s_setprio(1);
    SLOAD(0); SWAIT(); SWRITE(0); SLOAD(1); SWAIT(); SWRITE(1); SLOAD(2);
    asm volatile("s_waitcnt lgkmcnt(0)" ::: "memory"); RAWBAR();
    KLD3(ka, K_lds, 0); KLD3(kb, K_lds, 3); SBAR();
    pA0 = MF32(ka[0], qr[0], negm); pA1 = MF32(ka[1], qr[0], negm); pA0 = MF32(ka[2], qr[1], pA0); pA1 = MF32(ka[3], qr[1], pA1); pA0 = MF32(ka[4], qr[2], pA0); pA1 = MF32(ka[5], qr[2], pA1);
    pA0 = MF32(kb[0], qr[3], pA0); pA1 = MF32(kb[1], qr[3], pA1); pA0 = MF32(kb[2], qr[4], pA0); pA1 = MF32(kb[3], qr[4], pA1); pA0 = MF32(kb[4], qr[5], pA0); pA1 = MF32(kb[5], qr[5], pA1); SBAR();
    { float al0; MAX_TILE(pA0, pA1, true, al0); (void)al0; }
#pragma unroll
    for (int r = 0; r < 16; ++r) { pA0[r] = __builtin_amdgcn_exp2f(pA0[r]); pA1[r] = __builtin_amdgcn_exp2f(pA1[r]); }
    SWAIT(); SWRITE(2); SLOAD(3);
    int sp = 0, sc = 1, sw = 3;
    KLD3(ka, K_lds + SHM_K, 0);
    asm volatile("s_waitcnt lgkmcnt(6)" ::: "memory"); RAWBAR();
    for (int t = 1; t + 1 < NT; t += 2) { STEP7(pB0, pB1, pA0, pA1, t); STEP7(pA0, pA1, pB0, pB1, t + 1); }
    STEP7(pB0, pB1, pA0, pA1, NT - 1);
    { s16x4 val[4], vah[4], vbl[4], vbh[4]; const int vb_ = vb0 + sp * SHM_V; float ps = 0.f;
      vfrag_load_h<0>(val, vah, vb_); vfrag_load_h<1>(vbl, vbh, vb_); SBAR();
#pragma unroll
      for (int r = 0; r < 16; ++r) ps += pB0[r] + pB1[r];
      { auto rr = __builtin_amdgcn_permlane32_swap(__float_as_uint(ps), __float_as_uint(ps), false, false); l_reg += __uint_as_float(rr[0]) + __uint_as_float(rr[1]); }
      PK4(pB0, 0, pa0); PK4(pB0, 8, pa1); PK4(pB1, 0, pa2); PK4(pB1, 8, pa3);
      asm volatile("s_waitcnt lgkmcnt(0)" ::: "memory"); SBAR();
      pv_mma_h(o[0], val, vah, pa0, pa1, pa2, pa3); pv_mma_h(o[1], vbl, vbh, pa0, pa1, pa2, pa3); SBAR(); }
    if (V7_YOUNG_PRIO) __builtin_amdgcn_s_setprio(0);
    if (hi == 0) li_l[r32] = l_reg; asm volatile("s_waitcnt lgkmcnt(0)" ::: "memory");
    float rli[16];
#pragma unroll
    for (int r = 0; r < 16; ++r) rli[r] = __builtin_amdgcn_rcpf(li_l[crow(r, hi)]);
    unsigned short* stg = (unsigned short*)(lds + M6_OST) + wid * 2048;
    unsigned short* dst = CAT + ((size_t)b * S + q0 + wid * 32) * 1024 + h * 64;
    store_o_tile(o, rli, stg, dst, [](int row) { return (size_t)row * 1024; }, lane);
    asm volatile("s_waitcnt vmcnt(0)" ::: "memory");
#if MLA_STAMP
#if MLA_STAMP
    if (blockIdx.x == 0 && wid == MLA_STAMP_WAVE && lane == 0 && STAMPS) STAMPS[0] = st_a;
#endif
    (void)STAMPS;
#endif
    __syncthreads();
#undef SLOAD
#undef SWRITE
#undef SWAIT
#undef RAWBAR
#undef MAX_TILE
#undef RESC7
#undef STEP7
}

#define PV_EXP9(OD, PA, VL, VH, PCX, B) do { OD = MF32(PA, PKV(VL, VH), OD); PCX[B] = __builtin_amdgcn_exp2f(PCX[B]); PCX[B + 1] = __builtin_amdgcn_exp2f(PCX[B + 1]); \
        PCX[B + 2] = __builtin_amdgcn_exp2f(PCX[B + 2]); PCX[B + 3] = __builtin_amdgcn_exp2f(PCX[B + 3]); asm volatile("" : "+v"(PCX)); SBAR(); } while (0)
__device__ __forceinline__ void mla_unit_v9(int wv, int bh, int qb, const unsigned short* __restrict__ Q, const unsigned short* __restrict__ KN, const unsigned short* __restrict__ KR,
                                            const unsigned short* __restrict__ V, unsigned short* __restrict__ CAT, const float* __restrict__ KMX, char* lds, unsigned long long* STAMPS = nullptr) {
    const int wid = wv, lane = gm::lane_now(), tid = wid * 64 + lane, r32 = lane & 31, hi = lane >> 5;
    const int b = bh >> 3, h = bh & 7; const bool halfB = wid >= 4;
    char* K_lds = lds; char* V_lds = lds + 5 * SHM_K;
    float* wsf = (float*)(lds + 5 * SHM_K + 5 * SHM_V) + wid * 64; float* li_l = wsf; float* al_l = wsf + 32;
    float m_reg = 0.f, l_reg = 0; f32x16 o[2] = {}; bf16x8 qr[6]; f32x16 negm = f32x16{};
    const size_t bhS = (size_t)bh * S; const int q0 = qb * 256;
    const unsigned short* Qw = Q + (bhS + q0 + wid * 32 + r32) * 96 + hi * 8;
#pragma unroll
    for (int d0 = 0; d0 < 6; ++d0) qr[d0] = *reinterpret_cast<const bf16x8*>(Qw + d0 * 16);
    bool exact = true;
    if (MLA_STATIC) { float q2 = 0.f;
#pragma unroll
      for (int d0 = 0; d0 < 6; ++d0)
#pragma unroll
          for (int j = 0; j < 8; ++j) { const float x = __uint_as_float((unsigned)(unsigned short)qr[d0][j] << 16); q2 += x * x; }
      { auto rr = __builtin_amdgcn_permlane32_swap(__float_as_uint(q2), __float_as_uint(q2), false, false); q2 = __uint_as_float(rr[0]) + __uint_as_float(rr[1]); }
      const float k2 = KMX[(b * 8 + h) * 2] + KMX[(b * 8 + h) * 2 + 1] + KMX[32 + b];
      const float ms = 1.01f * sqrtf(q2 * k2);
      exact = wg_or(!(ms <= MLA_STATIC_THR), (unsigned*)(lds + 147456 - 512), wid, lane);
      if (!exact) { m_reg = ms;
#pragma unroll
          for (int r = 0; r < 16; ++r) negm[r] = -ms; } }
    const unsigned lds_k = (unsigned)(uintptr_t)K_lds, lds_v = (unsigned)(uintptr_t)V_lds;
    const char* kp[2]; unsigned kstr[2];
#pragma unroll
    for (int i = 0; i < 2; ++i) { const int r = 8 * wid + 4 * i + (lane >> 4), p = lane & 15, c = p ^ (r & 15); const bool rope = (c >= 8) && (c < 12); const int cn = c & 7;
        kp[i] = rope ? (const char*)(KR + ((size_t)b * S + r) * 32 + (c - 8) * 8) : (const char*)(KN + (bhS + r) * 64 + cn * 8); kstr[i] = rope ? 4096u : 8192u; }
    const char* v_u = (const char*)(V + bhS * 64);
    const unsigned v_off = (unsigned)(((8 * wid + ((lane >> 2) & 7)) * 64 + (lane >> 5) * 32 + (lane & 3) * 8) * 2);
    const int vb0 = (int)(uintptr_t)V_lds + v_rd_base(lane);
#define GLDS16(src, ldsaddr) __builtin_amdgcn_global_load_lds((const unsigned*)(src), (LAS unsigned*)(uintptr_t)(unsigned)(ldsaddr), 16, 0, 0)
#define DMA_TILE(t, sl) do { GLDS16(kp[0] + (size_t)(t) * kstr[0], lds_k + (sl) * SHM_K + (2 * wid) * 1024); GLDS16(kp[1] + (size_t)(t) * kstr[1], lds_k + (sl) * SHM_K + (2 * wid + 1) * 1024); \
        GLDS16(v_u + (size_t)(t) * 8192 + v_off, lds_v + (sl) * SHM_V + wid * 1024); } while (0)
#define RAWBAR() do { asm volatile("" ::: "memory"); __builtin_amdgcn_s_barrier(); asm volatile("" ::: "memory"); } while (0)
#define MAX_TILE(P0, P1, FIRST_, AL_) do { AL_ = 1.f; \
        if (V7_EXACT && exact) { const float pmax = rowmax32b(P0, P1); \
            if ((FIRST_) || !__builtin_expect(__all(pmax <= THR), 1)) { const float dl = (FIRST_) ? pmax : fmaxf(pmax, 0.f); m_reg += dl; \
                _Pragma("unroll") for (int r = 0; r < 16; ++r) { P0[r] -= dl; P1[r] -= dl; } \
                _Pragma("unroll") for (int r = 0; r < 16; ++r) negm[r] = -m_reg; \
                if (!(FIRST_)) AL_ = __builtin_amdgcn_exp2f(-dl); } } } while (0)
#define RESC7(a) do { if (V7_EXACT && exact && __any((a) < 1.f)) { if (hi == 0) al_l[r32] = (a); asm volatile("s_waitcnt lgkmcnt(0)" ::: "memory"); l_reg *= (a); \
    _Pragma("unroll") for (int d = 0; d < 2; ++d) _Pragma("unroll") for (int r = 0; r < 16; ++r) o[d][r] *= al_l[crow(r, hi)]; } } while (0)
#define STEP7(PC0, PC1, PP0, PP1, t_) do { \
        s16x4 val[4], vah[4], vbl[4], vbh[4]; const int vb_ = vb0 + sp * SHM_V; float s0 = 0.f, s1 = 0.f, s2 = 0.f, s3 = 0.f, al_; \
        SEC_B(0); if ((t_) + 3 < NT) DMA_TILE((t_) + 3, sw); SEC_E(0); \
        SEC_B(1); if (V9_SPLIT_PRIO) { if (halfB) __builtin_amdgcn_s_setprio(0); else __builtin_amdgcn_s_setprio(1); } KLD3(kb, K_lds + sc * SHM_K, 3); SBAR(); \
        QK_ADD(PC0, ka[0], qr[0], negm, PP0, 0);  QK_ADD(PC1, ka[1], qr[0], negm, PP0, 4); \
        QK_ADD(PC0, ka[2], qr[1], PC0, PP0, 8);   QK_ADD(PC1, ka[3], qr[1], PC1, PP0, 12); \
        QK_ADD(PC0, ka[4], qr[2], PC0, PP1, 0);   QK_ADD(PC1, ka[5], qr[2], PC1, PP1, 4); \
        vfrag_load_h<0>(val, vah, vb_); SBAR(); \
        QK_ADD(PC0, kb[0], qr[3], PC0, PP1, 8);   QK_ADD(PC1, kb[1], qr[3], PC1, PP1, 12); \
        QK_PK(PC0, kb[2], qr[4], PC0, PP0, 0, pa0); QK_PK(PC1, kb[3], qr[4], PC1, PP0, 8, pa1); \
        vfrag_load_h<1>(vbl, vbh, vb_); SBAR(); \
        QK_PK(PC0, kb[4], qr[5], PC0, PP1, 0, pa2); QK_PK(PC1, kb[5], qr[5], PC1, PP1, 8, pa3); \
        { float ps = (s0 + s1) + (s2 + s3); auto rr = __builtin_amdgcn_permlane32_swap(__float_as_uint(ps), __float_as_uint(ps), false, false); l_reg += __uint_as_float(rr[0]) + __uint_as_float(rr[1]); } \
        MAX_TILE(PC0, PC1, false, al_); SEC_E(1); \
        SEC_B(4); sp = sc; sc = (sc == 4) ? 0 : sc + 1; sw = (sw == 4) ? 0 : sw + 1; \
        if ((t_) + 1 < NT) KLD3(ka, K_lds + sc * SHM_K, 0); \
        asm volatile("s_waitcnt lgkmcnt(6)" ::: "memory"); SBAR(); SEC_E(4); SEC_B(2); if (V9_SPLIT_PRIO) { if (halfB) __builtin_amdgcn_s_setprio(1); else __builtin_amdgcn_s_setprio(0); } \
        PV_EXP9(o[0], pa0, val[0], vah[0], PC0, 0);  PV_EXP9(o[1], pa0, vbl[0], vbh[0], PC0, 4); \
        PV_EXP9(o[0], pa1, val[1], vah[1], PC0, 8);  PV_EXP9(o[1], pa1, vbl[1], vbh[1], PC0, 12); \
        PV_EXP9(o[0], pa2, val[2], vah[2], PC1, 0);  PV_EXP9(o[1], pa2, vbl[2], vbh[2], PC1, 4); \
        PV_EXP9(o[0], pa3, val[3], vah[3], PC1, 8);  PV_EXP9(o[1], pa3, vbl[3], vbh[3], PC1, 12); \
        RESC7(al_); SEC_E(2); \
        SEC_B(3); if ((t_) + 3 < NT) asm volatile("s_waitcnt vmcnt(3)" ::: "memory"); else asm volatile("s_waitcnt vmcnt(0)" ::: "memory");     \
        RAWBAR(); SEC_E(3); } while (0)
    f32x16 pA0, pA1, pB0, pB1; bf16x8 pa0, pa1, pa2, pa3; bf16x8 ka[6], kb[6]; constexpr int NT = S / 64;
#if MLA_STAMP
    unsigned long long st_a = 0, tq0 = 0, tq1 = 0;
#endif


    if (!V9_SPLIT_PRIO && V7_YOUNG_PRIO && wid >= 4) __builtin_amdgcn_s_setprio(1);
    DMA_TILE(0, 0); DMA_TILE(1, 1); DMA_TILE(2, 2);
    asm volatile("s_waitcnt vmcnt(0)" ::: "memory"); RAWBAR();
    KLD3(ka, K_lds, 0); KLD3(kb, K_lds, 3); SBAR();
    pA0 = MF32(ka[0], qr[0], negm); pA1 = MF32(ka[1], qr[0], negm); pA0 = MF32(ka[2], qr[1], pA0); pA1 = MF32(ka[3], qr[1], pA1); pA0 = MF32(ka[4], qr[2], pA0); pA1 = MF32(ka[5], qr[2], pA1);
    pA0 = MF32(kb[0], qr[3], pA0); pA1 = MF32(kb[1], qr[3], pA1); pA0 = MF32(kb[2], qr[4], pA0); pA1 = MF32(kb[3], qr[4], pA1); pA0 = MF32(kb[4], qr[5], pA0); pA1 = MF32(kb[5], qr[5], pA1); SBAR();
    { float al0; MAX_TILE(pA0, pA1, true, al0); (void)al0; }
#pragma unroll
    for (int r = 0; r < 16; ++r) { pA0[r] = __builtin_amdgcn_exp2f(pA0[r]); pA1[r] = __builtin_amdgcn_exp2f(pA1[r]); }
    DMA_TILE(3, 3);
    int sp = 0, sc = 1, sw = 4;
    KLD3(ka, K_lds + SHM_K, 0);
    asm volatile("s_waitcnt vmcnt(3)" ::: "memory"); RAWBAR();
    for (int t = 1; t + 1 < NT; t += 2) { STEP7(pB0, pB1, pA0, pA1, t); STEP7(pA0, pA1, pB0, pB1, t + 1); }
    STEP7(pB0, pB1, pA0, pA1, NT - 1);
    { s16x4 val[4], vah[4], vbl[4], vbh[4]; const int vb_ = vb0 + sp * SHM_V; float ps = 0.f;
      vfrag_load_h<0>(val, vah, vb_); vfrag_load_h<1>(vbl, vbh, vb_); SBAR();
#pragma unroll
      for (int r = 0; r < 16; ++r) ps += pB0[r] + pB1[r];
      { auto rr = __builtin_amdgcn_permlane32_swap(__float_as_uint(ps), __float_as_uint(ps), false, false); l_reg += __uint_as_float(rr[0]) + __uint_as_float(rr[1]); }
      PK4(pB0, 0, pa0); PK4(pB0, 8, pa1); PK4(pB1, 0, pa2); PK4(pB1, 8, pa3);
      asm volatile("s_waitcnt lgkmcnt(0)" ::: "memory"); SBAR();
      pv_mma_h(o[0], val, vah, pa0, pa1, pa2, pa3); pv_mma_h(o[1], vbl, vbh, pa0, pa1, pa2, pa3); SBAR(); }
    __builtin_amdgcn_s_setprio(0);
    asm volatile("s_waitcnt lgkmcnt(0)" ::: "memory"); RAWBAR();
    if (hi == 0) li_l[r32] = l_reg; asm volatile("s_waitcnt lgkmcnt(0)" ::: "memory");
    float rli[16];
#pragma unroll
    for (int r = 0; r < 16; ++r) rli[r] = __builtin_amdgcn_rcpf(li_l[crow(r, hi)]);
    unsigned short* stg = (unsigned short*)lds + wid * 2048;
    unsigned short* dst = CAT + ((size_t)b * S + q0 + wid * 32) * 1024 + h * 64;
    store_o_tile(o, rli, stg, dst, [](int row) { return (size_t)row * 1024; }, lane);
    asm volatile("s_waitcnt vmcnt(0)" ::: "memory");
#if MLA_STAMP
#if MLA_STAMP
    if (blockIdx.x == 0 && wid == MLA_STAMP_WAVE && lane == 0 && STAMPS) STAMPS[0] = st_a;
#endif
    (void)STAMPS;
#endif
    __syncthreads();
#undef GLDS16
#undef DMA_TILE
#undef RAWBAR
#undef MAX_TILE
#undef RESC7
#undef STEP7
#undef PV_EXP9
}

#define PV_EXP8(OD, PA, VL, VH, PCX, B) do { OD = MF32(PA, PKV(VL, VH), OD); PCX[B] = __builtin_amdgcn_exp2f(PCX[B]); PCX[B + 1] = __builtin_amdgcn_exp2f(PCX[B + 1]); \
        PCX[B + 2] = __builtin_amdgcn_exp2f(PCX[B + 2]); PCX[B + 3] = __builtin_amdgcn_exp2f(PCX[B + 3]); asm volatile("" : "+v"(PCX)); SBAR(); } while (0)
__device__ __forceinline__ void mla_unit_v8(int wv, int bh, int qb, const unsigned short* __restrict__ Q, const unsigned short* __restrict__ KN, const unsigned short* __restrict__ KR,
                                            const unsigned short* __restrict__ V, unsigned short* __restrict__ CAT, const float* __restrict__ KMX, char* lds, unsigned long long* STAMPS = nullptr) {
    const int wid = wv, lane = gm::lane_now(), tid = wid * 64 + lane, r32 = lane & 31, hi = lane >> 5;
    const int b = bh >> 3, h = bh & 7; const bool halfB = wid >= 4;
    char* K_lds = lds + M6_K; char* V_lds = lds + M6_V;
    float* wsf = (float*)(lds + M6_WS) + wid * 64; float* li_l = wsf; float* al_l = wsf + 32;
    float m_reg = 0.f, l_reg = 0; f32x16 o[2] = {}; bf16x8 qr[6]; f32x16 negm = f32x16{};
    const size_t bhS = (size_t)bh * S; const int q0 = qb * 256;
    const unsigned short* Qw = Q + (bhS + q0 + wid * 32 + r32) * 96 + hi * 8;
#pragma unroll
    for (int d0 = 0; d0 < 6; ++d0) qr[d0] = *reinterpret_cast<const bf16x8*>(Qw + d0 * 16);
    bool exact = true;
    if (MLA_STATIC) { float q2 = 0.f;
#pragma unroll
      for (int d0 = 0; d0 < 6; ++d0)
#pragma unroll
          for (int j = 0; j < 8; ++j) { const float x = __uint_as_float((unsigned)(unsigned short)qr[d0][j] << 16); q2 += x * x; }
      { auto rr = __builtin_amdgcn_permlane32_swap(__float_as_uint(q2), __float_as_uint(q2), false, false); q2 = __uint_as_float(rr[0]) + __uint_as_float(rr[1]); }
      const float k2 = KMX[(b * 8 + h) * 2] + KMX[(b * 8 + h) * 2 + 1] + KMX[32 + b];
      const float ms = 1.01f * sqrtf(q2 * k2);
      exact = wg_or(!(ms <= MLA_STATIC_THR), (unsigned*)(lds + 147456 - 512), wid, lane);
      if (!exact) { m_reg = ms;
#pragma unroll
          for (int r = 0; r < 16; ++r) negm[r] = -ms; } }
    const int srow = tid >> 3, sch = tid & 7, rrow = (tid & 255) >> 2, rch = tid & 3;
    const char* kn_u = (const char*)(KN + bhS * 64); const char* v_u = (const char*)(V + bhS * 64); const char* kr_u = (const char*)(KR + (size_t)b * S * 32);
    const unsigned kn_off = (unsigned)(srow * 64 + sch * 8) * 2u, kr_off = (unsigned)(rrow * 32 + rch * 8) * 2u;
    const int kst = KSWZ(srow, sch * 16), krst = KSWZ(rrow, (8 + rch) * 16), vst = v_st(srow, sch * 8);
    const int vb0 = (int)(uintptr_t)V_lds + v_rd_base(lane);
    bf16x8 s_kn, s_kr, s_v;
#define SLOAD(t) do { s_kn = *reinterpret_cast<const bf16x8*>(kn_u + (size_t)(t) * 8192 + kn_off); s_kr = *reinterpret_cast<const bf16x8*>(kr_u + (size_t)(t) * 4096 + kr_off); \
    s_v = *reinterpret_cast<const bf16x8*>(v_u + (size_t)(t) * 8192 + kn_off); } while (0)
#define SWRITE(sl) do { *(bf16x8*)(K_lds + (sl) * SHM_K + kst) = s_kn; if (tid < 256) *(bf16x8*)(K_lds + (sl) * SHM_K + krst) = s_kr; *(bf16x8*)(V_lds + (sl) * SHM_V + vst) = s_v; } while (0)
#define SWAIT() asm volatile("s_waitcnt vmcnt(0)" ::: "memory")
#define RAWBAR() do { asm volatile("" ::: "memory"); __builtin_amdgcn_s_barrier(); asm volatile("" ::: "memory"); } while (0)
#define MAX_TILE(P0, P1, FIRST_, AL_) do { AL_ = 1.f; \
        if (V7_EXACT && exact) { const float pmax = rowmax32b(P0, P1); \
            if ((FIRST_) || !__builtin_expect(__all(pmax <= THR), 1)) { const float dl = (FIRST_) ? pmax : fmaxf(pmax, 0.f); m_reg += dl; \
                _Pragma("unroll") for (int r = 0; r < 16; ++r) { P0[r] -= dl; P1[r] -= dl; } \
                _Pragma("unroll") for (int r = 0; r < 16; ++r) negm[r] = -m_reg; \
                if (!(FIRST_)) AL_ = __builtin_amdgcn_exp2f(-dl); } } } while (0)
#define RESC7(a) do { if (V7_EXACT && exact && __any((a) < 1.f)) { if (hi == 0) al_l[r32] = (a); asm volatile("s_waitcnt lgkmcnt(0)" ::: "memory"); l_reg *= (a); \
    _Pragma("unroll") for (int d = 0; d < 2; ++d) _Pragma("unroll") for (int r = 0; r < 16; ++r) o[d][r] *= al_l[crow(r, hi)]; } } while (0)
#define STEP7(PC0, PC1, PP0, PP1, t_) do { \
        s16x4 val[4], vah[4], vbl[4], vbh[4]; const int vb_ = vb0 + sp * SHM_V; float s0 = 0.f, s1 = 0.f, s2 = 0.f, s3 = 0.f, al_; \
        KLD3(kb, K_lds + sc * SHM_K, 3); SBAR(); \
        QK_ADD(PC0, ka[0], qr[0], negm, PP0, 0);  QK_ADD(PC1, ka[1], qr[0], negm, PP0, 4); \
        QK_ADD(PC0, ka[2], qr[1], PC0, PP0, 8);   QK_ADD(PC1, ka[3], qr[1], PC1, PP0, 12); \
        QK_ADD(PC0, ka[4], qr[2], PC0, PP1, 0);   QK_ADD(PC1, ka[5], qr[2], PC1, PP1, 4); \
        vfrag_load_h<0>(val, vah, vb_); SBAR(); \
        QK_ADD(PC0, kb[0], qr[3], PC0, PP1, 8);   QK_ADD(PC1, kb[1], qr[3], PC1, PP1, 12); \
        QK_PK(PC0, kb[2], qr[4], PC0, PP0, 0, pa0); QK_PK(PC1, kb[3], qr[4], PC1, PP0, 8, pa1); \
        vfrag_load_h<1>(vbl, vbh, vb_); SBAR(); \
        QK_PK(PC0, kb[4], qr[5], PC0, PP1, 0, pa2); QK_PK(PC1, kb[5], qr[5], PC1, PP1, 8, pa3); \
        { float ps = (s0 + s1) + (s2 + s3); auto rr = __builtin_amdgcn_permlane32_swap(__float_as_uint(ps), __float_as_uint(ps), false, false); l_reg += __uint_as_float(rr[0]) + __uint_as_float(rr[1]); } \
        MAX_TILE(PC0, PC1, false, al_); \
        asm volatile("s_waitcnt lgkmcnt(0)" ::: "memory"); RAWBAR(); \
        if ((t_) + 2 < NT) { SWAIT(); SWRITE(sw); if ((t_) + 3 < NT) SLOAD((t_) + 3); } \
        sp = sc; sc = (sc + 1) & 3; sw = (sw + 1) & 3; \
        if ((t_) + 1 < NT) KLD3(ka, K_lds + sc * SHM_K, 0); SBAR(); \
        PV_EXP8(o[0], pa0, val[0], vah[0], PC0, 0);  PV_EXP8(o[1], pa0, vbl[0], vbh[0], PC0, 4); \
        PV_EXP8(o[0], pa1, val[1], vah[1], PC0, 8);  PV_EXP8(o[1], pa1, vbl[1], vbh[1], PC0, 12); \
        PV_EXP8(o[0], pa2, val[2], vah[2], PC1, 0);  PV_EXP8(o[1], pa2, vbl[2], vbh[2], PC1, 4); \
        PV_EXP8(o[0], pa3, val[3], vah[3], PC1, 8);  PV_EXP8(o[1], pa3, vbl[3], vbh[3], PC1, 12); \
        RESC7(al_); \
        asm volatile("s_waitcnt lgkmcnt(6)" ::: "memory"); RAWBAR(); } while (0)
    f32x16 pA0, pA1, pB0, pB1; bf16x8 pa0, pa1, pa2, pa3; bf16x8 ka[6], kb[6]; constexpr int NT = S / 64;

    SLOAD(0); SWAIT(); SWRITE(0); SLOAD(1); SWAIT(); SWRITE(1); SLOAD(2);
    asm volatile("s_waitcnt lgkmcnt(0)" ::: "memory"); RAWBAR();
    if (halfB) RAWBAR();
    KLD3(ka, K_lds, 0); KLD3(kb, K_lds, 3); SBAR();
    pA0 = MF32(ka[0], qr[0], negm); pA1 = MF32(ka[1], qr[0], negm); pA0 = MF32(ka[2], qr[1], pA0); pA1 = MF32(ka[3], qr[1], pA1); pA0 = MF32(ka[4], qr[2], pA0); pA1 = MF32(ka[5], qr[2], pA1);
    pA0 = MF32(kb[0], qr[3], pA0); pA1 = MF32(kb[1], qr[3], pA1); pA0 = MF32(kb[2], qr[4], pA0); pA1 = MF32(kb[3], qr[4], pA1); pA0 = MF32(kb[4], qr[5], pA0); pA1 = MF32(kb[5], qr[5], pA1); SBAR();
    { float al0; MAX_TILE(pA0, pA1, true, al0); (void)al0; }
    asm volatile("s_waitcnt lgkmcnt(0)" ::: "memory"); RAWBAR();
#pragma unroll
    for (int r = 0; r < 16; ++r) { pA0[r] = __builtin_amdgcn_exp2f(pA0[r]); pA1[r] = __builtin_amdgcn_exp2f(pA1[r]); }
    SWAIT(); SWRITE(2); SLOAD(3);
    int sp = 0, sc = 1, sw = 3;
    KLD3(ka, K_lds + SHM_K, 0);
    asm volatile("s_waitcnt lgkmcnt(6)" ::: "memory"); RAWBAR();
    for (int t = 1; t + 1 < NT; t += 2) { STEP7(pB0, pB1, pA0, pA1, t); STEP7(pA0, pA1, pB0, pB1, t + 1); }
    STEP7(pB0, pB1, pA0, pA1, NT - 1);
    { s16x4 val[4], vah[4], vbl[4], vbh[4]; const int vb_ = vb0 + sp * SHM_V; float ps = 0.f;
      vfrag_load_h<0>(val, vah, vb_); vfrag_load_h<1>(vbl, vbh, vb_); SBAR();
#pragma unroll
      for (int r = 0; r < 16; ++r) ps += pB0[r] + pB1[r];
      { auto rr = __builtin_amdgcn_permlane32_swap(__float_as_uint(ps), __float_as_uint(ps), false, false); l_reg += __uint_as_float(rr[0]) + __uint_as_float(rr[1]); }
      PK4(pB0, 0, pa0); PK4(pB0, 8, pa1); PK4(pB1, 0, pa2); PK4(pB1, 8, pa3);
      asm volatile("s_waitcnt lgkmcnt(0)" ::: "memory"); SBAR();
      pv_mma_h(o[0], val, vah, pa0, pa1, pa2, pa3); pv_mma_h(o[1], vbl, vbh, pa0, pa1, pa2, pa3); SBAR(); }
    if (!halfB) RAWBAR();
    if (hi == 0) li_l[r32] = l_reg; asm volatile("s_waitcnt lgkmcnt(0)" ::: "memory");
    float rli[16];
#pragma unroll
    for (int r = 0; r < 16; ++r) rli[r] = __builtin_amdgcn_rcpf(li_l[crow(r, hi)]);
    unsigned short* stg = (unsigned short*)(lds + M6_OST) + wid * 2048;
    unsigned short* dst = CAT + ((size_t)b * S + q0 + wid * 32) * 1024 + h * 64;
    store_o_tile(o, rli, stg, dst, [](int row) { return (size_t)row * 1024; }, lane);
    asm volatile("s_waitcnt vmcnt(0)" ::: "memory");
#if MLA_STAMP
    (void)STAMPS;
#endif
    __syncthreads();
#undef SLOAD
#undef SWRITE
#undef SWAIT
#undef RAWBAR
#undef MAX_TILE
#undef RESC7
#undef STEP7
#undef PV_EXP8
}

constexpr int DL_K = 0, DL_V = 49152, DL_WS = 98304, DL_OST = DL_WS + 8 * 256;
#define KSWZD(row, colB) ((row) * 128 + ((colB) ^ ((((row) >> 1) & 7) << 4)))
__device__ __forceinline__ void dil_unit(int wv, int bh, int br, int blk, const unsigned short* __restrict__ DQ, const unsigned short* __restrict__ DK, const unsigned short* __restrict__ DV,
                                         unsigned short* __restrict__ OBR, float* __restrict__ LSE, char* lds) {
    const int wid = wv, lane = gm::lane_now(), tid = wid * 64 + lane, r32 = lane & 31, hi = lane >> 5;
    const int sh = 2 * br, dil = 1 << sh, L = S >> sh, nbl = L >> 8, res = blk / nbl, lb = blk % nbl;
    const size_t bhS = (size_t)bh * S; const int b = bh >> 3, h = bh & 7;
    char* K_lds = lds + DL_K; char* V_lds = lds + DL_V;
#pragma unroll
    for (int half = 0; half < 2; ++half) {
        bf16x8 kk[3], vv[3];
#pragma unroll
        for (int it = 0; it < 3; ++it) { const int item = (half * 3 + it) * 512 + tid, row = item >> 3, ch = item & 7; const int l = 256 * lb - 64 + row; const bool valid = (l >= 0) && (l < L);
            const size_t src = (bhS + (valid ? ((size_t)l << sh) + res : 0)) * 64 + ch * 8;
            kk[it] = *reinterpret_cast<const bf16x8*>(DK + src); vv[it] = *reinterpret_cast<const bf16x8*>(DV + src);
            if (!valid) { kk[it] = bf16x8{}; vv[it] = bf16x8{}; } }
#pragma unroll
        for (int it = 0; it < 3; ++it) { const int item = (half * 3 + it) * 512 + tid, row = item >> 3, ch = item & 7;
            *(bf16x8*)(K_lds + KSWZD(row, ch * 16)) = kk[it]; *(bf16x8*)(V_lds + (row >> 4) * 2048 + v_st(row & 15, ch * 8)) = vv[it]; }
    }
    bf16x8 qr[4];
    const int ql = wid * 32 + r32; const size_t qpos = ((size_t)(256 * lb + ql) << sh) + res;
    const unsigned short* Qw = DQ + (bhS + qpos) * 64 + hi * 8;
#pragma unroll
    for (int d0 = 0; d0 < 4; ++d0) qr[d0] = *reinterpret_cast<const bf16x8*>(Qw + d0 * 16);
    __syncthreads();
    f32x16 p[5];
#pragma unroll
    for (int j = 0; j < 5; ++j) { p[j] = f32x16{}; const int row = wid * 32 + j * 32 + r32;
#pragma unroll
        for (int d0 = 0; d0 < 4; ++d0) { const bf16x8 kf = *reinterpret_cast<const bf16x8*>(K_lds + KSWZD(row, (d0 * 16 + hi * 8) * 2)); p[j] = __builtin_amdgcn_mfma_f32_32x32x16_bf16(kf, qr[d0], p[j], 0, 0, 0); } }
    const float NEG = -1e30f;
    const int klo = 64 - 256 * lb, khi = L + 64 - 256 * lb;
    { const int t0 = max(r32, klo - wid * 32) - 4 * hi, t1 = klo - wid * 32 - 32 - 4 * hi, t3 = khi - wid * 32 - 96 - 4 * hi, t4 = min(r32 + 1, khi - wid * 32 - 128) - 4 * hi;
#pragma unroll
      for (int r = 0; r < 16; ++r) { const int c = (r & 3) + 8 * (r >> 2);
          if (c < t0) p[0][r] = NEG; if (c < t1) p[1][r] = NEG; if (c >= t3) p[3][r] = NEG; if (c >= t4) p[4][r] = NEG; } }
    float mx = rowmax32(p[0], p[1]); mx = fmaxf(mx, rowmax32(p[2], p[3]));
    { float m4 = p[4][0];
#pragma unroll
      for (int r = 1; r < 16; ++r) m4 = fmaxf(m4, p[4][r]);
      auto rr = __builtin_amdgcn_permlane32_swap(__float_as_uint(m4), __float_as_uint(m4), false, false); mx = fmaxf(mx, fmaxf(__uint_as_float(rr[0]), __uint_as_float(rr[1]))); }
    float ps = 0.f;
#pragma unroll
    for (int j = 0; j < 5; ++j)
#pragma unroll
        for (int r = 0; r < 16; ++r) { p[j][r] = __builtin_amdgcn_exp2f(p[j][r] - mx); ps += p[j][r]; }
    { auto rr = __builtin_amdgcn_permlane32_swap(__float_as_uint(ps), __float_as_uint(ps), false, false); ps = __uint_as_float(rr[0]) + __uint_as_float(rr[1]); }
    bf16x8 pa[5][2];
#pragma unroll
    for (int j = 0; j < 5; ++j) { PK4(p[j], 0, pa[j][0]); PK4(p[j], 8, pa[j][1]); }
    f32x16 o[2] = {};
    const int vb = (int)(uintptr_t)V_lds + v_rd_base(lane) + wid * 4096;
    pv_half<0, 0 * 4096>(o[0], vb, pa[0][0], pa[0][1]); pv_half<1, 0 * 4096>(o[1], vb, pa[0][0], pa[0][1]);
    pv_half<0, 1 * 4096>(o[0], vb, pa[1][0], pa[1][1]); pv_half<1, 1 * 4096>(o[1], vb, pa[1][0], pa[1][1]);
    pv_half<0, 2 * 4096>(o[0], vb, pa[2][0], pa[2][1]); pv_half<1, 2 * 4096>(o[1], vb, pa[2][0], pa[2][1]);
    pv_half<0, 3 * 4096>(o[0], vb, pa[3][0], pa[3][1]); pv_half<1, 3 * 4096>(o[1], vb, pa[3][0], pa[3][1]);
    pv_half<0, 4 * 4096>(o[0], vb, pa[4][0], pa[4][1]); pv_half<1, 4 * 4096>(o[1], vb, pa[4][0], pa[4][1]);
    float* wsf = (float*)(lds + DL_WS) + wid * 64;
    if (hi == 0) { wsf[r32] = ps; LSE[((size_t)br * T + (size_t)b * S + qpos) * 8 + h] = mx + __builtin_amdgcn_logf(ps); }
    asm volatile("s_waitcnt lgkmcnt(0)" ::: "memory");
    float rli[16];
#pragma unroll
    for (int r = 0; r < 16; ++r) rli[r] = __builtin_amdgcn_rcpf(wsf[crow(r, hi)]);
    unsigned short* stg = (unsigned short*)(lds + DL_OST) + wid * 2048;
    unsigned short* dst = OBR + ((size_t)br * T + (size_t)b * S + (((size_t)(256 * lb + wid * 32)) << sh) + res) * 512 + h * 64;
    store_o_tile(o, rli, stg, dst, [sh](int row) { return ((size_t)row << sh) * 512; }, lane);
    asm volatile("s_waitcnt vmcnt(0)" ::: "memory");
    __syncthreads();
}
#define DIL_DECODE(u, bh_, br_, res_, lb_, sh_, L_) const int bh_ = (u) / 96, br_ = ((u) >> 5) % 3, blk__##bh_ = (u) & 31, sh_ = 2 * br_, L_ = S >> sh_, nbl__##bh_ = L_ >> 8, res_ = blk__##bh_ / nbl__##bh_, lb_ = blk__##bh_ % nbl__##bh_
__device__ __forceinline__ void dil_phase(int wv, int u0, int ustep, int nunits, const unsigned short* __restrict__ DQ, const unsigned short* __restrict__ DK, const unsigned short* __restrict__ DV,
                                          unsigned short* __restrict__ OBR, float* __restrict__ LSE, char* lds) {
    const int wid = wv, lane = gm::lane_now(), tid = wid * 64 + lane, r32 = lane & 31, hi = lane >> 5;
    char* K_lds = lds + DL_K; char* V_lds = lds + DL_V;
    bf16x8 kk[6], qn[4]; unsigned kmask = 0u;
#define DIL_LOAD6(dst, mask, SRC, u) do { DIL_DECODE(u, bh_, br_, res_, lb_, sh_, L_); const size_t bhS_ = (size_t)bh_ * S; mask = 0u; \
        _Pragma("unroll") for (int it = 0; it < 6; ++it) { const int item = it * 512 + tid, row = item >> 3, ch = item & 7; const int l = 256 * lb_ - 64 + row; const bool valid = (l >= 0) && (l < L_); \
            const size_t src = (bhS_ + (valid ? ((size_t)l << sh_) + res_ : 0)) * 64 + ch * 8; dst[it] = *reinterpret_cast<const bf16x8*>(SRC + src); mask |= (valid ? 1u : 0u) << it; } } while (0)
#define DIL_LOADQ(u) do { DIL_DECODE(u, bh_, br_, res_, lb_, sh_, L_); const size_t qpos_ = ((size_t)(256 * lb_ + wid * 32 + r32) << sh_) + res_; const unsigned short* Qw_ = DQ + ((size_t)bh_ * S + qpos_) * 64 + hi * 8; \
        _Pragma("unroll") for (int d0 = 0; d0 < 4; ++d0) qn[d0] = *reinterpret_cast<const bf16x8*>(Qw_ + d0 * 16); } while (0)
    if (wid >= 4) __builtin_amdgcn_s_setprio(1);
    int u = u0;
    if (u < nunits) { DIL_LOAD6(kk, kmask, DK, u); DIL_LOADQ(u); }
    for (; u < nunits; u += ustep) {
        DIL_DECODE(u, bh, br, res, lb, sh, L); const int b = bh >> 3, h = bh & 7;
#pragma unroll
        for (int it = 0; it < 6; ++it) { const int item = it * 512 + tid, row = item >> 3, ch = item & 7; *(bf16x8*)(K_lds + KSWZD(row, ch * 16)) = ((kmask >> it) & 1u) ? kk[it] : bf16x8{}; }
        bf16x8 qr[4];
#pragma unroll
        for (int d0 = 0; d0 < 4; ++d0) qr[d0] = qn[d0];
        bf16x8 vv[6]; unsigned vmask; DIL_LOAD6(vv, vmask, DV, u);
        __syncthreads();
        const int ql = wid * 32 + r32; const size_t qpos = ((size_t)(256 * lb + ql) << sh) + res;
        f32x16 p[5];
#pragma unroll
        for (int j = 0; j < 5; ++j) { p[j] = f32x16{}; const int row = wid * 32 + j * 32 + r32;
#pragma unroll
            for (int d0 = 0; d0 < 4; ++d0) { const bf16x8 kf = *reinterpret_cast<const bf16x8*>(K_lds + KSWZD(row, (d0 * 16 + hi * 8) * 2)); p[j] = __builtin_amdgcn_mfma_f32_32x32x16_bf16(kf, qr[d0], p[j], 0, 0, 0); } }
        const float NEG = -1e30f;
        const int klo = 64 - 256 * lb, khi = L + 64 - 256 * lb;
        { const int t0 = max(r32, klo - wid * 32) - 4 * hi, t1 = klo - wid * 32 - 32 - 4 * hi, t3 = khi - wid * 32 - 96 - 4 * hi, t4 = min(r32 + 1, khi - wid * 32 - 128) - 4 * hi;
#pragma unroll
          for (int r = 0; r < 16; ++r) { const int c = (r & 3) + 8 * (r >> 2);
              if (c < t0) p[0][r] = NEG; if (c < t1) p[1][r] = NEG; if (c >= t3) p[3][r] = NEG; if (c >= t4) p[4][r] = NEG; } }
        float mx = rowmax32(p[0], p[1]); mx = fmaxf(mx, rowmax32(p[2], p[3]));
        { float m4 = p[4][0];
#pragma unroll
          for (int r = 1; r < 16; ++r) m4 = fmaxf(m4, p[4][r]);
          auto rr = __builtin_amdgcn_permlane32_swap(__float_as_uint(m4), __float_as_uint(m4), false, false); mx = fmaxf(mx, fmaxf(__uint_as_float(rr[0]), __uint_as_float(rr[1]))); }
        float ps = 0.f;
#pragma unroll
        for (int j = 0; j < 5; ++j)
#pragma unroll
            for (int r = 0; r < 16; ++r) { p[j][r] = __builtin_amdgcn_exp2f(p[j][r] - mx); ps += p[j][r]; }
        { auto rr = __builtin_amdgcn_permlane32_swap(__float_as_uint(ps), __float_as_uint(ps), false, false); ps = __uint_as_float(rr[0]) + __uint_as_float(rr[1]); }
        bf16x8 pa[5][2];
#pragma unroll
        for (int j = 0; j < 5; ++j) { PK4(p[j], 0, pa[j][0]); PK4(p[j], 8, pa[j][1]); }
#pragma unroll
        for (int it = 0; it < 6; ++it) { const int item = it * 512 + tid, row = item >> 3, ch = item & 7; *(bf16x8*)(V_lds + (row >> 4) * 2048 + v_st(row & 15, ch * 8)) = ((vmask >> it) & 1u) ? vv[it] : bf16x8{}; }
        __syncthreads();
        if (u + ustep < nunits) { DIL_LOAD6(kk, kmask, DK, u + ustep); DIL_LOADQ(u + ustep); }
        f32x16 o[2] = {};
        const int vb = (int)(uintptr_t)V_lds + v_rd_base(lane) + wid * 4096;
        pv_half<0, 0 * 4096>(o[0], vb, pa[0][0], pa[0][1]); pv_half<1, 0 * 4096>(o[1], vb, pa[0][0], pa[0][1]);
        pv_half<0, 1 * 4096>(o[0], vb, pa[1][0], pa[1][1]); pv_half<1, 1 * 4096>(o[1], vb, pa[1][0], pa[1][1]);
        pv_half<0, 2 * 4096>(o[0], vb, pa[2][0], pa[2][1]); pv_half<1, 2 * 4096>(o[1], vb, pa[2][0], pa[2][1]);
        pv_half<0, 3 * 4096>(o[0], vb, pa[3][0], pa[3][1]); pv_half<1, 3 * 4096>(o[1], vb, pa[3][0], pa[3][1]);
        pv_half<0, 4 * 4096>(o[0], vb, pa[4][0], pa[4][1]); pv_half<1, 4 * 4096>(o[1], vb, pa[4][0], pa[4][1]);
        float* wsf = (float*)(lds + DL_WS) + wid * 64;
        if (hi == 0) { wsf[r32] = ps; LSE[((size_t)br * T + (size_t)b * S + qpos) * 8 + h] = mx + __builtin_amdgcn_logf(ps); }
        asm volatile("s_waitcnt lgkmcnt(0)" ::: "memory");
        float rli[16];
#pragma unroll
        for (int r = 0; r < 16; ++r) rli[r] = __builtin_amdgcn_rcpf(wsf[crow(r, hi)]);
        unsigned short* stg = (unsigned short*)(lds + DL_OST) + wid * 2048;
        unsigned short* dst = OBR + ((size_t)br * T + (size_t)b * S + (((size_t)(256 * lb + wid * 32)) << sh) + res) * 512 + h * 64;
        store_o_tile(o, rli, stg, dst, [sh](int row) { return ((size_t)row << sh) * 512; }, lane);
        __syncthreads();
    }
    __builtin_amdgcn_s_setprio(0);
#undef DIL_LOAD6
#undef DIL_LOADQ
}
__device__ __forceinline__ void dil_combine(const unsigned short* __restrict__ OBR, const float* __restrict__ LSE, unsigned short* __restrict__ CAT, int gtid, int gthreads) {
    for (int i = gtid; i < T * 64; i += gthreads) { const int t = i >> 6, c8 = i & 63, h = c8 >> 3;
        const float l0 = LSE[((size_t)0 * T + t) * 8 + h], l1 = LSE[((size_t)1 * T + t) * 8 + h], l2 = LSE[((size_t)2 * T + t) * 8 + h];
        const float mx = fmaxf(l0, fmaxf(l1, l2)); float w0 = __builtin_amdgcn_exp2f(l0 - mx), w1 = __builtin_amdgcn_exp2f(l1 - mx), w2 = __builtin_amdgcn_exp2f(l2 - mx);
        const float inv = 1.f / (w0 + w1 + w2); w0 *= inv; w1 *= inv; w2 *= inv;
        const u32x4 a = *(const u32x4*)(OBR + ((size_t)0 * T + t) * 512 + c8 * 8), bb = *(const u32x4*)(OBR + ((size_t)1 * T + t) * 512 + c8 * 8), cc = *(const u32x4*)(OBR + ((size_t)2 * T + t) * 512 + c8 * 8);
        u32x4 o;
#pragma unroll
        for (int k = 0; k < 4; ++k) { const float lo = w0 * __uint_as_float(a[k] << 16) + w1 * __uint_as_float(bb[k] << 16) + w2 * __uint_as_float(cc[k] << 16);
            const float hi = w0 * __uint_as_float(a[k] & 0xffff0000u) + w1 * __uint_as_float(bb[k] & 0xffff0000u) + w2 * __uint_as_float(cc[k] & 0xffff0000u); o[k] = cvtpk(lo, hi); }
        *(u32x4*)(CAT + (size_t)t * 1024 + 512 + c8 * 8) = o; }
}
#undef SBAR
}
namespace mk {
struct SchedP4 {
    __device__ __forceinline__ void a_ready(const gm::Unit&, int, int) const {}
    __device__ __forceinline__ void done(const gm::Unit&, int) const {}
    __device__ __forceinline__ void stamp(int, const gm::Unit&, int, int) const {}
    static constexpr bool GATHER = false;
    const char* A; const char* Bt; int G, c;
    __device__ __forceinline__ bool next(int i, gm::Unit& u) const { int pm, pn; if (!static_tile(i, G, c, 64, 4, pm, pn)) return false;
        u.A = A; u.Bt = Bt; u.gidx = nullptr; u.lda2 = 2048; u.ldb2 = 2048; u.arow0 = pm * 256; u.brow0 = pn * 256; u.nt = 16; u.pm = pm; u.pn = pn; u.aux = 0; return true; }
};
#ifndef X1_BF16
#define X1_BF16 1
#endif
constexpr size_t WS_X1B = WS_Q;
struct EpiP4 {
    static constexpr bool PERM = X1_BF16 ? true : false;
    const float* x; float* out; const float* modf; bf16_t* x1b;
    __device__ __forceinline__ void operator()(EPI_ARGS) const {
        const int b = (u.pm * 256) >> 13; const float* gt = modf + b * 6144 + 2048;
        if (X1_BF16) {
            const int col0 = u.pn * 256 + wc * 32 + 8 * fq;
            f32x4 g[2][2];
#pragma unroll
            for (int bj = 0; bj < 2; ++bj)
#pragma unroll
                for (int n = 0; n < 2; ++n) g[bj][n] = *(const f32x4*)(gt + col0 + bj * 128 + n * 4);
#pragma unroll
            for (int ai = 0; ai < 2; ++ai)
#pragma unroll
                for (int m = 0; m < 4; ++m) { const size_t off = (size_t)(u.pm * 256 + ai * 128 + wr * 64 + m * 16 + fr) * D + col0;
#pragma unroll
                    for (int bj = 0; bj < 2; ++bj) { const f32x4 x0 = *(const f32x4*)(x + off + bj * 128), x1 = *(const f32x4*)(x + off + bj * 128 + 4);
                        *(u32x4*)(x1b + off + bj * 128) = pack8(x0 + g[bj][0] * acc[ai][bj][m][0], x1 + g[bj][1] * acc[ai][bj][m][1]); } }
            return; }
        const int col0 = u.pn * 256 + wc * 32 + 4 * fq;
        f32x4 g[2][2];
#pragma unroll
        for (int bj = 0; bj < 2; ++bj)
#pragma unroll
            for (int n = 0; n < 2; ++n) g[bj][n] = *(const f32x4*)(gt + col0 + bj * 128 + n * 16);
#pragma unroll
        for (int ai = 0; ai < 2; ++ai)
#pragma unroll
            for (int m = 0; m < 4; ++m) { const size_t off = (size_t)(u.pm * 256 + ai * 128 + wr * 64 + m * 16 + fr) * D + col0;
#pragma unroll
                for (int bj = 0; bj < 2; ++bj)
#pragma unroll
                    for (int n = 0; n < 2; ++n) { const f32x4 xv = *(const f32x4*)(x + off + bj * 128 + n * 16); *(f32x4*)(out + off + bj * 128 + n * 16) = xv + g[bj][n] * acc[ai][bj][m][n]; } }
    }
};
__device__ __forceinline__ f32x4 bf4_to_f32(u32x2 w) { f32x4 r; r.x = __uint_as_float(w.x << 16); r.y = __uint_as_float(w.x & 0xffff0000u); r.z = __uint_as_float(w.y << 16); r.w = __uint_as_float(w.y & 0xffff0000u); return r; }
__device__ __forceinline__ void p4b_rows(Frame& F) {
    const int tid_ = F.wave * 64 + fresh_lane();
    LAS float* WR = (LAS float*)F.lds;
    LAS float* A1 = WR + 16384;
    LAS float* A0 = A1 + 2048;
    const float* modf = (const float*)(F.ws + WS_MODF);
    for (int i = tid_; i < 16384; i += NTHREADS) { const int j = i >> 4, e = i & 15; WR[e * 1024 + j] = F.w_router[i]; }
    for (int i = tid_; i < 2048; i += NTHREADS) { const int b = i >> 10, j = i & 1023; A1[i] = F.g_ffn[j] * (1.f + modf[b * 6144 + 4096 + j]); A0[i] = modf[b * 6144 + 3072 + j]; }
    __syncthreads();
    const int gw = F.vcu * NWAVES + F.wave, NGW = F.G * NWAVES, lane = fresh_lane();
    for (int m = gw; m < T; m += NGW) { const int b = m >> 13, s = m & 8191;
        const f32x4* xr = (const f32x4*)(F.out + (size_t)m * D) + lane; const u32x2* xb = (const u32x2*)((const bf16_t*)(F.ws + WS_X1B) + (size_t)m * D) + lane; f32x4 v[4]; float ss = 0.f;
#pragma unroll
        for (int j = 0; j < 4; ++j) { if (X1_BF16) v[j] = bf4_to_f32(xb[64 * j]); else v[j] = xr[64 * j]; ss += (v[j].x * v[j].x + v[j].y * v[j].y) + (v[j].z * v[j].z + v[j].w * v[j].w); }
        const float rstd = rsqrtf(wave_sum(ss) * (1.f / D) + EPS);
        unsigned long long* o8 = (unsigned long long*)((bf16_t*)(F.ws + WS_HB) + (size_t)m * D) + lane;
        float lg[16];
#pragma unroll
        for (int e = 0; e < 16; ++e) lg[e] = 0.f;
#pragma unroll
        for (int j = 0; j < 4; ++j) { asm volatile("" ::: "memory");
            const f32x4 a1 = *(const LAS f32x4*)(A1 + b * 1024 + 4 * lane + 256 * j), a0 = *(const LAS f32x4*)(A0 + b * 1024 + 4 * lane + 256 * j);
            const f32x4 o = v[j] * rstd * a1 + a0; o8[64 * j] = (unsigned long long)pk2(o.x, o.y) | ((unsigned long long)pk2(o.z, o.w) << 32);
#pragma unroll
            for (int e = 0; e < 16; ++e) { const f32x4 w = *(const LAS f32x4*)(WR + e * 1024 + 4 * lane + 256 * j); lg[e] += (o.x * w.x + o.y * w.y) + (o.z * w.z + o.w * w.w); } }
        float w8[8], w4[4], w2[2], w1;
        { const bool up = lane & 32;
#pragma unroll
          for (int i = 0; i < 8; ++i) { const float snd = up ? lg[i] : lg[8 + i], kp = up ? lg[8 + i] : lg[i]; w8[i] = kp + __shfl_xor(snd, 32); } }
        { const bool up = lane & 16;
#pragma unroll
          for (int i = 0; i < 4; ++i) { const float snd = up ? w8[i] : w8[4 + i], kp = up ? w8[4 + i] : w8[i]; w4[i] = kp + __shfl_xor(snd, 16); } }
        { const bool up = lane & 8;
#pragma unroll
          for (int i = 0; i < 2; ++i) { const float snd = up ? w4[i] : w4[2 + i], kp = up ? w4[2 + i] : w4[i]; w2[i] = kp + __shfl_xor(snd, 8); } }
        { const bool up = lane & 4; const float snd = up ? w2[0] : w2[1], kp = up ? w2[1] : w2[0]; w1 = kp + __shfl_xor(snd, 4); }
        w1 += __shfl_xor(w1, 1); w1 += __shfl_xor(w1, 2);
        const int e = lane >> 2; const float logit = w1 + F.b_router[e];
        float mx = logit;
#pragma unroll
        for (int o = 4; o < 64; o <<= 1) mx = fmaxf(mx, __shfl_xor(mx, o));
        const float ex = __expf(logit - mx); float den = ex;
#pragma unroll
        for (int o = 4; o < 64; o <<= 1) den += __shfl_xor(den, o);
        if ((lane & 3) == 0) ((float*)(F.ws + WS_AFF))[((size_t)b * 16 + e) * S + s] = ex / den;
    }
    __syncthreads();
}
__device__ __forceinline__ void p5_topk(Frame& F) {
    if (F.vcu >= 32) { if (WD_IN_P5 && F.G > 32) wd_convert(F, 32); return; }
    const int be = F.vcu, b = be >> 4, e = be & 15, tid = F.wave * 64 + fresh_lane();
    LAS unsigned* vals = (LAS unsigned*)F.lds;
    LAS unsigned* hist = vals + 8192;
    LAS unsigned* suf = hist + 256;
    LAS unsigned* misc = suf + 264;
    LAS unsigned* wtot = misc + 8;
    const float* a = (const float*)(F.ws + WS_AFF) + (size_t)be * S;
    for (int i = tid; i < 8192; i += NTHREADS) vals[i] = __float_as_uint(a[i]);
    if (tid == 0) { misc[0] = 0u; misc[1] = 1024u; }
    __syncthreads();
    for (int pass = 0; pass < 4; ++pass) {
        const int sh = 24 - 8 * pass; const unsigned prefix = misc[0], k = misc[1]; const unsigned himask = pass == 0 ? 0u : (0xffffffffu << (sh + 8));
        if (tid < 256) hist[tid] = 0u;
        __syncthreads();
        {
            const unsigned cand = (vals[0] >> sh) & 255u; unsigned nc = 0u;
            for (int i = tid; i < 8192; i += NTHREADS) { const unsigned v = vals[i]; if ((v & himask) == prefix) { const unsigned bn = (v >> sh) & 255u; if (bn == cand) ++nc; else __hip_atomic_fetch_add(&hist[bn], 1u, __ATOMIC_RELAXED, __HIP_MEMORY_SCOPE_WORKGROUP); } }
#pragma unroll
            for (int o = 1; o < 64; o <<= 1) nc += __shfl_xor(nc, o);
            if ((tid & 63) == 0 && nc) __hip_atomic_fetch_add(&hist[cand], nc, __ATOMIC_RELAXED, __HIP_MEMORY_SCOPE_WORKGROUP);
        }
        __syncthreads();
        if (tid < 64) {
            const int l = tid; const unsigned h0 = hist[4 * l], h1 = hist[4 * l + 1], h2 = hist[4 * l + 2], h3 = hist[4 * l + 3];
            const unsigned tot = (h0 + h1) + (h2 + h3); unsigned inc = tot;
#pragma unroll
            for (int o = 1; o < 64; o <<= 1) { const unsigned t = __shfl_down(inc, o); if (l + o < 64) inc += t; }
            const unsigned above = inc - tot;
            const unsigned s3 = above + h3, s2 = s3 + h2, s1 = s2 + h1, s0 = s1 + h0;
            int bin = -1; unsigned gt = 0u;
            if (s3 >= k && above < k) { bin = 4 * l + 3; gt = above; } else if (s2 >= k && s3 < k) { bin = 4 * l + 2; gt = s3; } else if (s1 >= k && s2 < k) { bin = 4 * l + 1; gt = s2; } else if (s0 >= k && s1 < k) { bin = 4 * l; gt = s1; }
            if (bin >= 0) { misc[0] = prefix | ((unsigned)bin << sh); misc[1] = k - gt; }
        }
        __syncthreads();
    }
    const unsigned thr = misc[0], need = misc[1];
    unsigned gtc = 0, eqc = 0;
#pragma unroll
    for (int i = 0; i < 16; ++i) { const unsigned v = vals[tid * 16 + i]; gtc += v > thr; eqc += v == thr; }
    unsigned gi = gtc, ei = eqc; const int lane = fresh_lane(), wv = F.wave;
#pragma unroll
    for (int o = 1; o < 64; o <<= 1) { const unsigned g2 = __shfl_up(gi, o), e2 = __shfl_up(ei, o); if (lane >= o) { gi += g2; ei += e2; } }
    if (lane == 63) { wtot[wv] = gi; wtot[8 + wv] = ei; }
    __syncthreads();
    unsigned gbase = 0, ebase = 0, gtotal = 0;
    for (int w = 0; w < 8; ++w) { const unsigned g = wtot[w], q = wtot[8 + w]; if (w < wv) { gbase += g; ebase += q; } gtotal += g; }
    unsigned gpos = gbase + gi - gtc, epos = ebase + ei - eqc;
    int* IDX = (int*)(F.ws + WS_IDX) + (e * 2 + b) * 1024; float* GATE = (float*)(F.ws + WS_GATE) + (e * 2 + b) * 1024; int* SLOT = (int*)(F.ws + WS_SLOT);
#pragma unroll
    for (int i = 0; i < 16; ++i) { const int s = tid * 16 + i; const unsigned v = vals[s]; int c = -1;
        if (v > thr) c = (int)gpos++; else if (v == thr) { if (epos < need) c = (int)(gtotal + epos); ++epos; }
        if (c >= 0) { IDX[c] = b * S + s; GATE[c] = __uint_as_float(v); }
        SLOT[(size_t)(b * S + s) * 16 + e] = c >= 0 ? (e * 2 + b) * 1024 + c : -1; }
}
struct SchedP6a {
    __device__ __forceinline__ void a_ready(const gm::Unit&, int, int) const {}
    __device__ __forceinline__ void done(const gm::Unit&, int) const {}
    __device__ __forceinline__ void stamp(int, const gm::Unit&, int, int) const {}
    static constexpr bool GATHER = true;
    const char* A; const char* W; const int* idx; int G, vcu;
    __device__ __forceinline__ bool next(int i, gm::Unit& u) const {
        int e, pmu, pn;
        if (G == 256) { if (i >= 4) return false; const int xcd = vcu >> 5, j = vcu & 31; e = xcd + 8 * (i >> 1); const int sub = (i & 1) * 32 + j; pmu = sub >> 3; pn = sub & 7; }
        else { const int L = i * G + vcu; if (L >= 1024) return false; e = L >> 6; pmu = (L >> 3) & 7; pn = L & 7; }
        u.A = A; u.gidx = idx + e * 2048 + pmu * 256; u.lda2 = 2048; u.arow0 = 0; u.Bt = W + (size_t)e * 2048 * 2048; u.brow0 = pn * 256; u.ldb2 = 2048; u.nt = 16; u.pm = e * 8 + pmu; u.pn = pn; u.aux = e; return true; }
};
struct EpiP6a {
    static constexpr bool PERM = true;
    bf16_t* H;
    __device__ __forceinline__ void operator()(EPI_ARGS) const {
#pragma unroll
        for (int ai = 0; ai < 2; ++ai)
#pragma unroll
            for (int m = 0; m < 4; ++m) { const size_t row = (size_t)u.pm * 256 + ai * 128 + wr * 64 + m * 16 + fr;
                f32x4 h0, h1;
#pragma unroll
                for (int j = 0; j < 4; ++j) { h0[j] = siluf(acc[ai][0][m][0][j]) * acc[ai][1][m][0][j]; h1[j] = siluf(acc[ai][0][m][1][j]) * acc[ai][1][m][1][j]; }
                *(u32x4*)(H + row * 1024 + u.pn * 128 + wc * 32 + 8 * fq) = pack8(h0, h1); }
    }
};
struct SchedP6b {
    __device__ __forceinline__ void a_ready(const gm::Unit&, int, int) const {}
    __device__ __forceinline__ void done(const gm::Unit&, int) const {}
    __device__ __forceinline__ void stamp(int, const gm::Unit&, int, int) const {}
    static constexpr bool GATHER = false;
    const char* A; const char* W; int G, vcu;
    __device__ __forceinline__ bool next(int i, gm::Unit& u) const {
        int e, pmu, pn;
        if (G == 256) { if (i >= 2) return false; const int xcd = vcu >> 5, j = vcu & 31; e = xcd + 8 * i; pmu = j >> 2; pn = j & 3; }
        else { const int L = i * G + vcu; if (L >= 512) return false; e = L >> 5; pmu = (L >> 2) & 7; pn = L & 3; }
        u.A = A; u.gidx = nullptr; u.lda2 = 2048; u.arow0 = (e * 8 + pmu) * 256; u.Bt = W + (size_t)e * 1024 * 2048; u.brow0 = pn * 256; u.ldb2 = 2048; u.nt = 16; u.pm = e * 8 + pmu; u.pn = pn; u.aux = e; return true; }
};
struct EpiP6b {
    static constexpr bool PERM = true;
    bf16_t* Y; const float* gate;
    __device__ __forceinline__ void operator()(EPI_ARGS) const {
#pragma unroll
        for (int ai = 0; ai < 2; ++ai)
#pragma unroll
            for (int m = 0; m < 4; ++m) { const size_t row = (size_t)u.pm * 256 + ai * 128 + wr * 64 + m * 16 + fr; const float g = gate[row];
#pragma unroll
                for (int bj = 0; bj < 2; ++bj) *(u32x4*)(Y + row * 1024 + u.pn * 256 + bj * 128 + wc * 32 + 8 * fq) = pack8(acc[ai][bj][m][0] * g, acc[ai][bj][m][1] * g); }
    }
};
__device__ __forceinline__ void p7_final(Frame& F) {
    const float* modf = (const float*)(F.ws + WS_MODF); const int* SLOT = (const int*)(F.ws + WS_SLOT); const bf16_t* Y = (const bf16_t*)(F.ws + WS_Y);
    const int gw = F.vcu * NWAVES + F.wave, NGW = F.G * NWAVES, lane = fresh_lane();
    for (int m0 = gw; m0 < T; m0 += 2 * NGW) {
        const int m1 = m0 + NGW; const bool has1 = m1 < T; const int mm1 = has1 ? m1 : m0;
        f32x4* xr0 = (f32x4*)(F.out + (size_t)m0 * D) + lane; f32x4* xr1 = (f32x4*)(F.out + (size_t)mm1 * D) + lane; f32x4 v0[4], v1[4], a0[4], a1[4];
        const u32x2* xb0 = (const u32x2*)((const bf16_t*)(F.ws + WS_X1B) + (size_t)m0 * D) + lane; const u32x2* xb1 = (const u32x2*)((const bf16_t*)(F.ws + WS_X1B) + (size_t)mm1 * D) + lane;
#pragma unroll
        for (int j = 0; j < 4; ++j) { if (X1_BF16) { v0[j] = bf4_to_f32(xb0[64 * j]); v1[j] = bf4_to_f32(xb1[64 * j]); } else { v0[j] = xr0[64 * j]; v1[j] = xr1[64 * j]; } a0[j] = (f32x4){0.f, 0.f, 0.f, 0.f}; a1[j] = (f32x4){0.f, 0.f, 0.f, 0.f}; }
        const int sl0 = lane < 16 ? SLOT[(size_t)m0 * 16 + lane] : -1, sl1 = lane < 16 ? SLOT[(size_t)mm1 * 16 + lane] : -1;
        for (int e = 0; e < 16; ++e) { const int s0 = __shfl(sl0, e), s1 = __shfl(sl1, e);
            if (s0 >= 0) { const u32x2* yr = (const u32x2*)(Y + (size_t)s0 * 1024) + lane;
#pragma unroll
                for (int j = 0; j < 4; ++j) { const u32x2 w = yr[64 * j]; a0[j].x += __uint_as_float(w.x << 16); a0[j].y += __uint_as_float(w.x & 0xffff0000u); a0[j].z += __uint_as_float(w.y << 16); a0[j].w += __uint_as_float(w.y & 0xffff0000u); } }
            if (s1 >= 0) { const u32x2* yr = (const u32x2*)(Y + (size_t)s1 * 1024) + lane;
#pragma unroll
                for (int j = 0; j < 4; ++j) { const u32x2 w = yr[64 * j]; a1[j].x += __uint_as_float(w.x << 16); a1[j].y += __uint_as_float(w.x & 0xffff0000u); a1[j].z += __uint_as_float(w.y << 16); a1[j].w += __uint_as_float(w.y & 0xffff0000u); } } }
        float ss0 = 0.f, ss1 = 0.f; const int b0 = m0 >> 13, b1 = mm1 >> 13;
#pragma unroll
        for (int j = 0; j < 4; ++j) { const f32x4 g0 = *(const f32x4*)(modf + b0 * 6144 + 5120 + 4 * lane + 256 * j), g1 = *(const f32x4*)(modf + b1 * 6144 + 5120 + 4 * lane + 256 * j);
            v0[j] = v0[j] + g0 * a0[j]; v1[j] = v1[j] + g1 * a1[j];
            ss0 += (v0[j].x * v0[j].x + v0[j].y * v0[j].y) + (v0[j].z * v0[j].z + v0[j].w * v0[j].w); ss1 += (v1[j].x * v1[j].x + v1[j].y * v1[j].y) + (v1[j].z * v1[j].z + v1[j].w * v1[j].w); }
        const float r0 = rsqrtf(wave_sum(ss0) * (1.f / D) + EPS), r1 = rsqrtf(wave_sum(ss1) * (1.f / D) + EPS);
#pragma unroll
        for (int j = 0; j < 4; ++j) { const f32x4 g = *(const f32x4*)(F.g_final + 4 * lane + 256 * j); xr0[64 * j] = v0[j] * r0 * g; if (has1) xr1[64 * j] = v1[j] * r1 * g; }
    }
}
}
#ifndef MLA_STAG
#define MLA_STAG mla_unit_v9
#endif
#ifndef MLA_V4
#define MLA_V4 1
#endif
#ifndef MERGE_P12
#define MERGE_P12 1
#endif
#ifndef DIL_PIPE
#define DIL_PIPE 1
#endif
#ifndef MLA_UNIT
#define MLA_UNIT mla_unit_v2
#endif
namespace mk {
namespace cg = cooperative_groups;
__global__ void __launch_bounds__(NTHREADS, 2) mega(Args args) {
    extern __shared__ __attribute__((aligned(16))) unsigned char lds_raw[];
    cg::grid_group grid = cg::this_grid();
    Frame F;
    F.lds = (LAS unsigned char*)lds_raw; F.ws = args.ws; F.out = args.out;
    F.wave = __builtin_amdgcn_readfirstlane((int)(threadIdx.x >> 6));
    F.G = gridDim.x; { const int bx = blockIdx.x; F.vcu = (F.G % 8 == 0) ? (bx % 8) * (F.G / 8) + bx / 8 : bx; }
    F.x = (const float*)args.in[0]; F.c = (const float*)args.in[1]; F.pos = (const int*)args.in[2]; F.w_ada = (const float*)args.in[3]; F.b_ada = (const float*)args.in[4];
    F.g_mix = (const float*)args.in[5]; F.w_in = (const float*)args.in[6]; F.g_q = (const float*)args.in[7]; F.w_uq = (const float*)args.in[8]; F.g_kv = (const float*)args.in[9];
    F.w_ukv = (const float*)args.in[10]; F.w_out = (const float*)args.in[11]; F.g_ffn = (const float*)args.in[12]; F.w_router = (const float*)args.in[13]; F.b_router = (const float*)args.in[14];
    F.w_gate = (const float*)args.in[15]; F.w_up = (const float*)args.in[16]; F.w_down = (const float*)args.in[17]; F.g_final = (const float*)args.in[18];
    const int lo = args.ph_lo, hi = args.ph_hi;
    volatile LAS unsigned* MISC = (volatile LAS unsigned*)(F.lds + LDS_BYTES - 256);
    { const int l0 = fresh_lane(); if (F.wave == 0) MISC[l0] = 0u; }
    __syncthreads();
    XcdBarrier xbar = xcd_barrier_post((unsigned*)(F.ws + WS_CTL) + 1024 + args.li * 4096, MISC + 8, F.wave == 0 && fresh_lane() == 0);
#define IN(k) (lo <= (k) && (k) < hi)
#ifndef CG_SEAMS
#define CG_SEAMS 0x000
#endif
#define SEAM(k) do { if (IN(k) && IN((k) + 1)) { if ((CG_SEAMS >> (k)) & 1) grid.sync(); else xcd_barrier(xbar, F.wave == 0 && fresh_lane() == 0); } } while (0)
    if (IN(0)) { p0_prologue(F); } SEAM(0);
    if (IN(1)) { p0b_rows(F); } SEAM(1);
#if MERGE_P12
    if (IN(2)) {
#if P12_STAMP
        if (F.wave == 0 && fresh_lane() == 0) { unsigned long long* ts = (unsigned long long*)(F.ws + 128 * KiB) + (size_t)blockIdx.x * 8; ts[0] = __builtin_amdgcn_s_memrealtime(); ts[7] = 0; }
#endif
        SchedP12 S{(const char*)(F.ws + WS_HB), (const char*)(F.ws + WS_WIN), (const char*)(F.ws + WS_CQ), (const char*)(F.ws + WS_WUQ), (const char*)(F.ws + WS_WUKV), (unsigned*)(F.ws + WS_PCNT), F.G, F.vcu, (int)blockIdx.x};
        EpiP12 E{F.ws}; gm::gemm_phase<EpiP12, SchedP12>(F.lds, S, E, F.wave); } SEAM(3);
#else
    if (IN(2)) { SchedP1 S{(const char*)(F.ws + WS_HB), (const char*)(F.ws + WS_WIN), F.G, (int)blockIdx.x}; EpiP1 E{F.ws}; gm::gemm_phase<EpiP1, SchedP1>(F.lds, S, E, F.wave); } SEAM(2);
    if (IN(3)) { SchedP2 S{(const char*)(F.ws + WS_CQ), (const char*)(F.ws + WS_WUQ), (const char*)(F.ws + WS_WUKV), F.G, (int)blockIdx.x}; EpiP2 E{F.ws}; gm::gemm_phase<EpiP2, SchedP2>(F.lds, S, E, F.wave); } SEAM(3);
#endif
    if (IN(4)) {
        const unsigned short* DQ = (const unsigned short*)(F.ws + WS_DQ); const unsigned short* DK = (const unsigned short*)(F.ws + WS_DK); const unsigned short* DV = (const unsigned short*)(F.ws + WS_DV);
        unsigned short* OBR = (unsigned short*)F.out; float* LSE = (float*)(F.ws + WS_LSE);
        const int cslot = F.vcu % 3;
        if (EXP_IN_ATTN && cslot == 0) exp_convert(F);
        if (args.pad & 1) { if (DIL_PIPE) at::dil_phase(F.wave, F.vcu, F.G, 1536, DQ, DK, DV, OBR, LSE, (char*)lds_raw); else for (int u = F.vcu; u < 1536; u += F.G) { const int blk = u & 31, br = (u >> 5) % 3, bh = u / 96; at::dil_unit(F.wave, bh, br, blk, DQ, DK, DV, OBR, LSE, (char*)lds_raw); } }
        if (EXP_IN_ATTN && cslot == 1) exp_convert(F);
        const bool has2 = (args.pad & 2) && (F.vcu + F.G < 512);
        if (EXP_IN_ATTN && cslot == 2 && !has2) exp_convert(F);
        if (args.pad & 2) for (int u = F.vcu; u < 512; u += F.G) { const int bh = (u >> 8) * 8 + ((u & 255) >> 5), qb = u & 31;
            if (EXP_IN_ATTN && cslot == 2 && has2 && u == F.vcu + F.G) exp_convert(F);
            #if MLA_V4
            at::MLA_STAG(F.wave, bh, qb, (const unsigned short*)(F.ws + WS_Q), (const unsigned short*)(F.ws + WS_KN), (const unsigned short*)(F.ws + WS_KR), (const unsigned short*)(F.ws + WS_V), (unsigned short*)(F.ws + WS_HB), (const float*)(F.ws + WS_KMX), (char*)lds_raw, (u == F.vcu) ? (unsigned long long*)(F.ws + WS_CTL + 60 * 1024) : nullptr); }
#else
            at::mla_unit_v2(F.wave, bh, qb, (const unsigned short*)(F.ws + WS_Q), (const unsigned short*)(F.ws + WS_KN), (const unsigned short*)(F.ws + WS_KR), (const unsigned short*)(F.ws + WS_V), (unsigned short*)(F.ws + WS_HB), (const float*)(F.ws + WS_KMX), (char*)lds_raw, (u == F.vcu) ? (unsigned long long*)(F.ws + WS_CTL + 60 * 1024) : nullptr); }
#endif
    } SEAM(4);
    if (IN(5)) { at::dil_combine((const unsigned short*)F.out, (const float*)(F.ws + WS_LSE), (unsigned short*)(F.ws + WS_HB), F.vcu * NTHREADS + F.wave * 64 + fresh_lane(), F.G * NTHREADS); } SEAM(5);
    if (IN(6)) { SchedP4 S{(const char*)(F.ws + WS_HB), (const char*)(F.ws + WS_WOUT), F.G, (int)blockIdx.x}; EpiP4 E{F.x, F.out, (const float*)(F.ws + WS_MODF), (bf16_t*)(F.ws + WS_X1B)}; gm::gemm_phase<EpiP4, SchedP4>(F.lds, S, E, F.wave); } SEAM(6);
    if (IN(7)) { p4b_rows(F); } SEAM(7);
    if (IN(8)) { p5_topk(F); } SEAM(8);
    if (IN(9)) { SchedP6a S{(const char*)(F.ws + WS_HB), (const char*)(F.ws + WS_WGU), (const int*)(F.ws + WS_IDX), F.G, F.vcu}; EpiP6a E{(bf16_t*)(F.ws + WS_HBUF)}; gm::gemm_phase<EpiP6a, SchedP6a>(F.lds, S, E, F.wave); } SEAM(9);
    if (IN(10)) { SchedP6b S{(const char*)(F.ws + WS_HBUF), (const char*)(F.ws + WS_WD), F.G, F.vcu}; EpiP6b E{(bf16_t*)(F.ws + WS_Y), (const float*)(F.ws + WS_GATE)}; gm::gemm_phase<EpiP6b, SchedP6b>(F.lds, S, E, F.wave); } SEAM(10);
    if (IN(11)) { p7_final(F); }
#undef IN
#undef SEAM
}
}
extern "C" void kernel_launch(void* const* d_in, const int* in_sizes, int n_in, void* d_out, int out_size, void* d_ws, size_t ws_size, hipStream_t stream) {
    using namespace mk;
    static int grid = 0;
    if (grid == 0) {
        if (n_in != 19 || out_size != T * D || in_sizes[0] != T * D || ws_size < WS_END) { fprintf(stderr, "kernel_launch: built for 19 inputs, x/out of %d floats and >= %zu bytes of workspace; got n_in %d out %d ws %zu; nothing launched\n", T * D, (size_t)WS_END, n_in, out_size, ws_size); grid = -1; return; }
        int dev = 0, cus = 0, per_cu = 0;
        if (hipGetDevice(&dev) != hipSuccess || hipDeviceGetAttribute(&cus, hipDeviceAttributeMultiprocessorCount, dev) != hipSuccess || cus < 32) { fprintf(stderr, "kernel_launch: device query failed\n"); grid = -1; return; }
        if (hipFuncSetAttribute((const void*)mega, hipFuncAttributeMaxDynamicSharedMemorySize, LDS_BYTES) != hipSuccess) { fprintf(stderr, "kernel_launch: hipFuncSetAttribute(%d B LDS) failed\n", LDS_BYTES); grid = -1; return; }
        if (hipOccupancyMaxActiveBlocksPerMultiprocessor(&per_cu, (const void*)mega, NTHREADS, LDS_BYTES) != hipSuccess || per_cu < 1) { fprintf(stderr, "kernel_launch: occupancy query reports %d workgroups per CU\n", per_cu); grid = -1; return; }
        grid = cus;
    }
    if (grid < 0) return;
    if (hipMemsetAsync((char*)d_ws + WS_CTL, 0, 64 * KiB, stream) != hipSuccess) { fprintf(stderr, "kernel_launch: memset failed\n"); return; }
    Args a{}; for (int i = 0; i < 19; ++i) a.in[i] = d_in[i]; a.out = (float*)d_out; a.ws = (unsigned char*)d_ws;
    a.pad = 3; a.ph_lo = 0; a.ph_hi = 12; a.li = 0;
    void* kargs[] = {&a};
    const hipError_t e = hipLaunchCooperativeKernel((const void*)mega, dim3(grid), dim3(NTHREADS), kargs, LDS_BYTES, stream);
    if (e != hipSuccess) fprintf(stderr, "kernel_launch: cooperative launch failed: %s (grid %d)\n", hipGetErrorString(e), grid);
}
```

```cpp
#include <hip/hip_runtime.h>
#include <hip/hip_cooperative_groups.h>
#include <hip/hip_bf16.h>
#include <cstdio>
#include <cstdint>
#include <cmath>
#ifndef GM_EPI_DRAIN
#define GM_EPI_DRAIN 0
#endif
#ifndef GM_YOUNG_PRIO
#define GM_YOUNG_PRIO 0
#endif
namespace gm {
#define LAS __attribute__((address_space(3)))
typedef unsigned short bf16_t;
typedef short bf16x8 __attribute__((ext_vector_type(8)));
typedef float f32x4 __attribute__((ext_vector_type(4)));
typedef float f32x2 __attribute__((ext_vector_type(2)));
typedef unsigned u32x4 __attribute__((ext_vector_type(4)));
typedef unsigned u32x2 __attribute__((ext_vector_type(2)));
constexpr int BM = 256, BK = 64, HALF = 128, HTB = HALF * BK * 2, STAGE_BYTES = 8 * HTB;

__device__ __forceinline__ int lds_byte(int r, int c) { const int st = (r >> 4) * 2 + (c >> 5), rr = r & 15, cc = c & 31, ob = rr * 64 + cc * 2; return st * 1024 + (ob ^ (((ob >> 9) & 1) << 5)); }
__device__ __forceinline__ void stage_rc(int b, int& R, int& C) { const int st = b / 1024, sb = b % 1024, swz = sb ^ (((sb >> 9) & 1) << 5); R = (st >> 1) * 16 + swz / 64; C = (st & 1) * 32 + (swz % 64) / 2; }
__device__ __forceinline__ int perm32(int rho) { const int n = rho >> 4, i = rho & 15; return 8 * (i >> 2) + 4 * n + (i & 3); }
__device__ __forceinline__ int lane_now() { int l; asm volatile("v_mbcnt_lo_u32_b32 %0, -1, 0\n\tv_mbcnt_hi_u32_b32 %0, -1, %0" : "=v"(l)); return l; }
__device__ __forceinline__ unsigned cvt_pk_bf16(float lo, float hi) { unsigned r; asm volatile("v_cvt_pk_bf16_f32 %0, %1, %2" : "=v"(r) : "v"(lo), "v"(hi)); return r; }

struct Unit {
    const char* A; const char* Bt; const int* gidx;
    unsigned lda2, ldb2;
    int arow0, brow0, nt;
    int pm, pn, aux;
};

template <class Epi, class Sched>
__device__ __forceinline__ void gemm_phase(LAS unsigned char* lds, const Sched& S, const Epi& E, int wave_sgpr) {
    constexpr bool GATHER = Sched::GATHER;
    if (GM_YOUNG_PRIO && wave_sgpr >= 4) __builtin_amdgcn_s_setprio(1);
    const int wid = wave_sgpr, lane = lane_now(), tid = wid * 64 + lane, wr = wid >> 2, wc = wid & 3, fr = lane & 15, fq = lane >> 4;
    int sR[2], sC[2], sRb[2];
#pragma unroll
    for (int i = 0; i < 2; ++i) { int R, C; stage_rc(tid * 16 + i * 8192, R, C); sR[i] = R; sC[i] = C * 2; sRb[i] = Epi::PERM ? ((R & ~31) + perm32(R & 31)) : R; }
    const unsigned ldsw = (unsigned)wid * 1024u;
    const int aoff = lds_byte(wr * 64 + fr, fq * 8), boff = lds_byte(wc * 32 + fr, fq * 8);
#define GM_SA(b, h) (((b) * 2 + (h)) * HTB)
#define GM_SB(b, h) ((4 + (b) * 2 + (h)) * HTB)
#define GM_GLDS(src, dstoff) __builtin_amdgcn_global_load_lds((const unsigned*)(src), (LAS unsigned*)(lds + (dstoff)), 16, 0, 0)
#define GM_STAGE_B(bufoff, p, ld, h) do { _Pragma("unroll") for (int i_ = 0; i_ < 2; ++i_) \
        GM_GLDS((p) + ((unsigned)((h) * HALF + sRb[i_]) * (ld) + (unsigned)sC[i_]), (bufoff) + ldsw + i_ * 8192); } while (0)
#define GM_STAGE_A(bufoff, p, ld, h, g) do { _Pragma("unroll") for (int i_ = 0; i_ < 2; ++i_) { \
        const unsigned o_ = GATHER ? (g)[h][i_] + (unsigned)sC[i_] : (unsigned)((h) * HALF + sR[i_]) * (ld) + (unsigned)sC[i_]; \
        GM_GLDS((p) + o_, (bufoff) + ldsw + i_ * 8192); } } while (0)
#define GM_LDA(dst, b, h) do { _Pragma("unroll") for (int m = 0; m < 4; ++m) _Pragma("unroll") for (int k = 0; k < 2; ++k) dst[m][k] = *(const LAS bf16x8*)(lds + GM_SA(b, h) + aoff + m * 2048 + k * 1024); } while (0)
#define GM_LDB(dst, b, h) do { _Pragma("unroll") for (int n = 0; n < 2; ++n) _Pragma("unroll") for (int k = 0; k < 2; ++k) dst[n][k] = *(const LAS bf16x8*)(lds + GM_SB(b, h) + boff + n * 2048 + k * 1024); } while (0)
#define GM_MMA(ai, bj, At, Bt) do { __builtin_amdgcn_s_setprio(1); _Pragma("unroll") for (int m = 0; m < 4; ++m) _Pragma("unroll") for (int n = 0; n < 2; ++n) _Pragma("unroll") for (int k = 0; k < 2; ++k) \
        acc[ai][bj][m][n] = __builtin_amdgcn_mfma_f32_16x16x32_bf16(Bt[n][k], At[m][k], acc[ai][bj][m][n], 0, 0, 0); __builtin_amdgcn_s_setprio(0); } while (0)
#define GM_WAIT_V(n) asm volatile("s_waitcnt vmcnt(" #n ")" ::: "memory")
#define GM_WAIT_L(n) asm volatile("s_waitcnt lgkmcnt(" #n ")" ::: "memory")
#define GM_BAR __builtin_amdgcn_s_barrier()
#define GM_SCHED __builtin_amdgcn_sched_barrier(0)
#define GM_GOFFS(u, g) do { if (GATHER) { _Pragma("unroll") for (int h_ = 0; h_ < 2; ++h_) _Pragma("unroll") for (int i_ = 0; i_ < 2; ++i_) g[h_][i_] = (unsigned)(u).gidx[h_ * HALF + sR[i_]] * (u).lda2; } } while (0)
#define GM_ABASE(u) ((u).A + (GATHER ? (size_t)0 : (size_t)(u).arow0 * (u).lda2))
#define GM_BBASE(u) ((u).Bt + (size_t)(u).brow0 * (u).ldb2)
    Unit cur, nxt; int ui = 0;
    if (!S.next(0, cur)) return;
    f32x4 acc[2][2][4][2];
#pragma unroll
    for (int a = 0; a < 2; ++a)
#pragma unroll
        for (int b = 0; b < 2; ++b)
#pragma unroll
            for (int m = 0; m < 4; ++m)
#pragma unroll
                for (int n = 0; n < 2; ++n) acc[a][b][m][n] = (f32x4){0.f, 0.f, 0.f, 0.f};
    bf16x8 At[4][2], B0[2][2], B1[2][2];
    unsigned gc[2][2] = {{0u, 0u}, {0u, 0u}}, gn[2][2] = {{0u, 0u}, {0u, 0u}};
    GM_GOFFS(cur, gc);
    const char* cA = GM_ABASE(cur); const char* cB = GM_BBASE(cur); unsigned cla = cur.lda2, clb = cur.ldb2;
    GM_STAGE_B(GM_SB(0, 0), cB, clb, 0); GM_STAGE_B(GM_SB(0, 1), cB, clb, 1); GM_STAGE_A(GM_SA(0, 0), cA, cla, 0, gc); GM_STAGE_A(GM_SA(0, 1), cA, cla, 1, gc);
    if (wr == 1) GM_BAR;
    GM_WAIT_V(2); GM_BAR;
    GM_STAGE_B(GM_SB(1, 0), cB + 128, clb, 0); GM_STAGE_A(GM_SA(1, 0), cA + 128, cla, 0, gc); GM_STAGE_B(GM_SB(1, 1), cB + 128, clb, 1);
    GM_WAIT_V(6); GM_BAR;
    for (;;) {
        const bool has_next = S.next(ui + 1, nxt);
        const char* nA = cA; const char* nB = cB; unsigned nla = cla, nlb = clb;
        if (has_next) { GM_GOFFS(nxt, gn); nA = GM_ABASE(nxt); nB = GM_BBASE(nxt); nla = nxt.lda2; nlb = nxt.ldb2; }
        else if (GATHER) {
#pragma unroll
            for (int h = 0; h < 2; ++h)
#pragma unroll
                for (int i = 0; i < 2; ++i) gn[h][i] = gc[h][i];
        }
        const int nt = cur.nt;
        for (int t = 0; t < nt; t += 2) {
            const bool last = (t == nt - 2);
            if (last && has_next) S.a_ready(nxt, wid, ui + 1);
            const char* a1 = cA + (size_t)(t + 1) * 128;
            const char* a2 = last ? nA : cA + (size_t)(t + 2) * 128; const char* b2 = last ? nB : cB + (size_t)(t + 2) * 128;
            const char* a3 = a2 + 128; const char* b3 = b2 + 128;
            const unsigned la2 = last ? nla : cla, lb2 = last ? nlb : clb;
            unsigned g2[2][2];
#pragma unroll
            for (int h = 0; h < 2; ++h)
#pragma unroll
                for (int i = 0; i < 2; ++i) g2[h][i] = GATHER ? (last ? gn[h][i] : gc[h][i]) : 0u;
            const bool fresh = GM_EPI_DRAIN && Epi::DRAIN && t == 0 && ui > 0;
            GM_LDB(B0, 0, 0); GM_LDB(B1, 0, 1); GM_SCHED; GM_LDA(At, 0, 0); GM_STAGE_A(GM_SA(1, 1), a1, cla, 1, gc);
            if (!fresh) GM_WAIT_V(8); GM_WAIT_L(0); GM_BAR; GM_MMA(0, 0, At, B0); GM_MMA(0, 1, At, B1); GM_BAR; GM_SCHED;
            GM_LDA(At, 0, 1); GM_STAGE_B(GM_SB(0, 0), b2, lb2, 0); GM_STAGE_B(GM_SB(0, 1), b2, lb2, 1); GM_STAGE_A(GM_SA(0, 0), a2, la2, 0, g2);
            if (!fresh) GM_WAIT_V(8); GM_WAIT_L(0); GM_BAR; GM_MMA(1, 0, At, B0); GM_MMA(1, 1, At, B1); GM_BAR; GM_SCHED;
            GM_LDB(B0, 1, 0); GM_LDB(B1, 1, 1); GM_SCHED; GM_LDA(At, 1, 0); GM_STAGE_A(GM_SA(0, 1), a2, la2, 1, g2);
            if (!fresh) GM_WAIT_V(8); GM_WAIT_L(0); GM_BAR; GM_MMA(0, 0, At, B0); GM_MMA(0, 1, At, B1); GM_BAR; GM_SCHED;
            GM_LDA(At, 1, 1); GM_STAGE_B(GM_SB(1, 0), b3, lb2, 0); GM_STAGE_B(GM_SB(1, 1), b3, lb2, 1); GM_STAGE_A(GM_SA(1, 0), a3, la2, 0, g2);
            GM_WAIT_V(8); GM_WAIT_L(0); GM_BAR; GM_MMA(1, 0, At, B0); GM_MMA(1, 1, At, B1); GM_BAR; GM_SCHED;
        }
        if (wr == 0) GM_BAR;
        if (GM_EPI_DRAIN && Epi::DRAIN) GM_WAIT_V(0);
        E(acc, cur, wr, wc, fr, fq, lane);
        S.done(cur, lane);
        S.stamp(ui, cur, wid, lane);
        if (!has_next) break;
#pragma unroll
        for (int a = 0; a < 2; ++a)
#pragma unroll
            for (int b = 0; b < 2; ++b)
#pragma unroll
                for (int m = 0; m < 4; ++m)
#pragma unroll
                    for (int n = 0; n < 2; ++n) acc[a][b][m][n] = (f32x4){0.f, 0.f, 0.f, 0.f};
        cur = nxt; cA = nA; cB = nB; cla = nla; clb = nlb; ++ui;
        if (GATHER) {
#pragma unroll
            for (int h = 0; h < 2; ++h)
#pragma unroll
                for (int i = 0; i < 2; ++i) gc[h][i] = gn[h][i];
        }
        if (wr == 1) GM_BAR;
    }
    GM_WAIT_V(0);
    GM_BAR;
#undef GM_SA
#undef GM_SB
#undef GM_GLDS
#undef GM_STAGE_A
#undef GM_STAGE_B
#undef GM_LDA
#undef GM_LDB
#undef GM_MMA
#undef GM_WAIT_V
#undef GM_WAIT_L
#undef GM_BAR
#undef GM_SCHED
#undef GM_GOFFS
#undef GM_ABASE
#undef GM_BBASE
    if (GM_YOUNG_PRIO) __builtin_amdgcn_s_setprio(0);
}
}
namespace mk {
using gm::bf16_t; using gm::f32x4; using gm::f32x2; using gm::u32x4; using gm::u32x2; using gm::cvt_pk_bf16;
constexpr int T = 16384, S = 8192, D = 1024, NB = 2, NH = 8, NWAVES = 8, NTHREADS = 512;
constexpr float EPS = 1e-6f;
constexpr size_t KiB = 1024, MiB = 1u << 20;
constexpr size_t WS_CTL = 0;
constexpr size_t WS_KMX = 48 * KiB;
constexpr size_t WS_DCNT = 52 * KiB;
constexpr size_t WS_MODP = 1 * MiB;
constexpr size_t WS_MODF = 2 * MiB;
constexpr size_t WS_TABM = WS_MODF + 64 * KiB;
constexpr size_t WS_TABD = WS_TABM + 2 * MiB;
constexpr size_t WS_SSQ = WS_TABD + 1 * MiB;
constexpr size_t WS_KR = WS_SSQ + 1536 * KiB;
constexpr size_t WS_AFF = WS_KR + 1 * MiB;
constexpr size_t WS_IDX = WS_AFF + 1 * MiB;
constexpr size_t WS_GATE = WS_IDX + 128 * KiB;
constexpr size_t WS_SLOT = WS_GATE + 128 * KiB;
constexpr size_t WS_LSE = WS_SLOT + 1 * MiB;
constexpr size_t WS_WUQ = WS_LSE + 1536 * KiB;
constexpr size_t WS_WUKV = WS_WUQ + 576 * KiB;
constexpr size_t WS_WOUT = WS_WUKV + 512 * KiB;
constexpr size_t WS_WIN = WS_WOUT + 2 * MiB;
constexpr size_t WS_R0END = WS_WIN + 4608 * KiB;
static_assert(WS_R0END <= 20 * MiB, "R0");
constexpr size_t WS_HB = 20 * MiB;
constexpr size_t WS_CQ = 52 * MiB;
constexpr size_t WS_DQ = WS_CQ + 24 * MiB, WS_DK = WS_DQ + 16 * MiB, WS_DV = WS_DK + 16 * MiB;
constexpr size_t WS_Q = WS_DV + 16 * MiB;
constexpr size_t WS_KN = WS_Q + 24 * MiB, WS_V = WS_KN + 16 * MiB;
constexpr size_t WS_HBUF = WS_CQ;
constexpr size_t WS_WGU = 180 * MiB;
constexpr size_t WS_Y = WS_WGU;
constexpr size_t WS_WD = 244 * MiB;
constexpr size_t WS_END = 276 * MiB;
static_assert(WS_V + 16 * MiB == 180 * MiB, "arena");
constexpr int LDS_BYTES = 147456;

#ifndef DPP_SUM
#define DPP_SUM 0
#endif
__device__ __forceinline__ float dpp_f(float v, int ctrl) { (void)ctrl; return v; }
template <int CTRL> __device__ __forceinline__ float dpp_get(float v) { return __uint_as_float((unsigned)__builtin_amdgcn_update_dpp(0, (int)__float_as_uint(v), CTRL, 0xf, 0xf, false)); }
__device__ __forceinline__ float wave_sum(float v) {
    if (DPP_SUM) {
        v += dpp_get<0xB1>(v); v += dpp_get<0x4E>(v); v += dpp_get<0x141>(v); v += dpp_get<0x140>(v);
        auto a = __builtin_amdgcn_permlane16_swap(__float_as_uint(v), __float_as_uint(v), false, false); v = __uint_as_float(a[0]) + __uint_as_float(a[1]);
        auto b = __builtin_amdgcn_permlane32_swap(__float_as_uint(v), __float_as_uint(v), false, false); return __uint_as_float(b[0]) + __uint_as_float(b[1]); }
#pragma unroll
    for (int o = 1; o < 64; o <<= 1) v += __shfl_xor(v, o);
    return v;
}
__device__ __forceinline__ unsigned f2bf(float f) { unsigned u = __builtin_bit_cast(unsigned, f); return (u + 0x7fffu + ((u >> 16) & 1u)) >> 16; }
__device__ __forceinline__ unsigned pk2(float lo, float hi) { return f2bf(lo) | (f2bf(hi) << 16); }
__device__ __forceinline__ float bf2f(unsigned short b) { return __builtin_bit_cast(float, (unsigned)b << 16); }
__device__ __forceinline__ float siluf(float v) { return v / (1.f + __expf(-v)); }
#define LDS_WAIT() asm volatile("s_waitcnt lgkmcnt(0)" ::: "memory")
__device__ __forceinline__ int fresh_lane() { return gm::lane_now(); }

struct Args { const void* in[19]; float* out; unsigned char* ws; int ph_lo, ph_hi, li, pad; };
struct Frame {
    LAS unsigned char* lds; unsigned char* ws; float* out;
    int wave, vcu, G;
    const float *x, *c; const int* pos; const float *w_ada, *b_ada, *g_mix, *w_in, *g_q, *w_uq, *g_kv, *w_ukv, *w_out, *g_ffn, *w_router, *b_router, *w_gate, *w_up, *w_down, *g_final;
};

__device__ __forceinline__ float inv_freq_m(int i) { return (float)exp2(-(double)i * (18.931568569324174 / 16.0)); }
__device__ __forceinline__ float inv_freq_d(int i) { return (float)exp2(-(double)i * (18.931568569324174 / 8.0)); }

#ifndef HW_CVT
#define HW_CVT 0
#endif
#ifndef NT_CONV
#define NT_CONV 0
#endif
#ifndef WD_IN_P5
#define WD_IN_P5 1
#endif
#ifndef P12_ACQ
#define P12_ACQ 1
#endif
#ifndef P0_MERGE
#define P0_MERGE 0
#endif
#ifndef WD_IN_ATTN
#define WD_IN_ATTN 0
#endif
#ifndef EXP_IN_ATTN
#define EXP_IN_ATTN 1
#endif
__device__ __forceinline__ void p0_transpose_item(const float* W, int ldw, int K, int k0, int n0, bf16_t* WT, int drow, const float* kscale, LAS float* scr, int lane) {
    f32x4 v[8];
#pragma unroll
    for (int i = 0; i < 8; ++i) v[i] = NT_CONV ? __builtin_nontemporal_load((const f32x4*)(W + (size_t)(k0 + 8 * i + (lane >> 3)) * ldw + n0 + 4 * (lane & 7))) : *(const f32x4*)(W + (size_t)(k0 + 8 * i + (lane >> 3)) * ldw + n0 + 4 * (lane & 7));
#pragma unroll
    for (int i = 0; i < 8; ++i) { const int kk = 8 * i + (lane >> 3); f32x4 x = v[i]; if (kscale) x = x * kscale[k0 + kk]; LAS float* d = scr + kk * 33 + 4 * (lane & 7); d[0] = x.x; d[1] = x.y; d[2] = x.z; d[3] = x.w; }
    LDS_WAIT(); asm volatile("" ::: "memory");
    const int c = lane & 7;
#pragma unroll
    for (int j = 0; j < 4; ++j) { const int n = (lane >> 3) + 8 * j; const LAS float* s = scr + (8 * c) * 33 + n;
        u32x4 o; if (HW_CVT) { o.x = cvt_pk_bf16(s[0 * 33], s[1 * 33]); o.y = cvt_pk_bf16(s[2 * 33], s[3 * 33]); o.z = cvt_pk_bf16(s[4 * 33], s[5 * 33]); o.w = cvt_pk_bf16(s[6 * 33], s[7 * 33]); }
        else { o.x = pk2(s[0 * 33], s[1 * 33]); o.y = pk2(s[2 * 33], s[3 * 33]); o.z = pk2(s[4 * 33], s[5 * 33]); o.w = pk2(s[6 * 33], s[7 * 33]); }
        if (NT_CONV) __builtin_nontemporal_store(o, (u32x4*)(WT + (size_t)(drow + n) * K + k0 + 8 * c)); else *(u32x4*)(WT + (size_t)(drow + n) * K + k0 + 8 * c) = o; }
    LDS_WAIT(); asm volatile("" ::: "memory");
}
#ifndef MOD_PRESILU
#define MOD_PRESILU 1
#endif
#ifndef FAST_ROPE_TAB
#define FAST_ROPE_TAB 0
#endif
#ifndef P0_WAVE_MAJOR
#define P0_WAVE_MAJOR 1
#endif
__device__ __forceinline__ void p0_prologue(Frame& F) {
    LAS float* scr = (LAS float*)(F.lds + F.wave * 16384);
    const int gw = P0_WAVE_MAJOR ? F.wave * F.G + F.vcu : F.vcu * NWAVES + F.wave, NGW = F.G * NWAVES, lane = fresh_lane();
    unsigned char* ws = F.ws;
    constexpr int I_MOD = 24 * 16, I_IN = 16 * 69, I_UQ = 6 * 24, I_UKV = 4 * 32, I_OUT = 16 * 32, I_EXP = 16 * 16 * 32, I_PAD = 96, I_TAB = T * 24 / 64;
    constexpr int NITEMS = I_MOD + I_IN + I_UQ + I_UKV + I_OUT + (EXP_IN_ATTN ? 0 : 2) * I_EXP + ((WD_IN_P5 || WD_IN_ATTN) ? 0 : 1) * I_EXP + I_PAD + I_TAB;
    bool tab_ready = false; (void)tab_ready;
    for (int it = gw; it < NITEMS; it += NGW) {
        int r = it;
        if (r < I_MOD) {
            const int cc = r % 24, kc = r / 24; f32x4 a0 = {0.f, 0.f, 0.f, 0.f}, a1 = {0.f, 0.f, 0.f, 0.f};
            const float* wp = F.w_ada + (size_t)(kc * 64) * 6144 + cc * 256 + 4 * lane;
#if MOD_PRESILU
            const float sv0 = siluf(F.c[kc * 64 + lane]), sv1 = siluf(F.c[1024 + kc * 64 + lane]);
#pragma unroll
            for (int k0 = 0; k0 < 64; k0 += 16) { f32x4 w[16];
#pragma unroll
                for (int k = 0; k < 16; ++k) w[k] = *(const f32x4*)(wp + (size_t)(k0 + k) * 6144);
#pragma unroll
                for (int k = 0; k < 16; ++k) { const float s0 = __uint_as_float(__builtin_amdgcn_readlane(__float_as_uint(sv0), k0 + k)), s1 = __uint_as_float(__builtin_amdgcn_readlane(__float_as_uint(sv1), k0 + k)); a0 += w[k] * s0; a1 += w[k] * s1; } }
#else
#pragma unroll 8
            for (int k = 0; k < 64; ++k) { const f32x4 w = *(const f32x4*)(wp + (size_t)k * 6144); const float s0 = siluf(F.c[kc * 64 + k]), s1 = siluf(F.c[1024 + kc * 64 + k]); a0 += w * s0; a1 += w * s1; }
#endif
            float* mp = (float*)(ws + WS_MODP) + (size_t)kc * 2 * 6144 + cc * 256 + 4 * lane;
            if (P0_MERGE) {
                asm volatile("global_store_dwordx4 %0, %1, off sc1" :: "v"(mp), "v"(a0) : "memory"); asm volatile("global_store_dwordx4 %0, %1, off sc1" :: "v"(mp + 6144), "v"(a1) : "memory");
                asm volatile("s_waitcnt vmcnt(0)" ::: "memory");
                if (lane == 0) __hip_atomic_fetch_add((unsigned*)(ws + WS_DCNT), 1u, __ATOMIC_RELAXED, __HIP_MEMORY_SCOPE_AGENT);
            } else { *(f32x4*)mp = a0; *(f32x4*)(mp + 6144) = a1; }
            continue; }
        r -= I_MOD;
        if (r < I_IN) { const int kb = r / 69, nb = r % 69, n0 = nb * 32; p0_transpose_item(F.w_in, 2208, 1024, kb * 64, n0, (bf16_t*)(ws + WS_WIN), n0 < 672 ? n0 : n0 + 96, nullptr, scr, lane); continue; }
        r -= I_IN;
        if (r < I_UQ) { const int kb = r / 24, nb = r % 24, n0 = nb * 32, h = n0 / 96, d = n0 % 96; p0_transpose_item(F.w_uq, 768, 384, kb * 64, n0, (bf16_t*)(ws + WS_WUQ), d < 64 ? h * 64 + d : 512 + h * 32, F.g_q, scr, lane); continue; }
        r -= I_UQ;
        if (r < I_UKV) { const int kb = r / 32, nb = r % 32, n0 = nb * 32, h = n0 / 128, d = n0 % 128; p0_transpose_item(F.w_ukv, 1024, 256, kb * 64, n0, (bf16_t*)(ws + WS_WUKV), d < 64 ? h * 64 + d : 512 + h * 64 + (d - 64), F.g_kv, scr, lane); continue; }
        r -= I_UKV;
        if (r < I_OUT) { const int kb = r / 32, nb = r % 32; p0_transpose_item(F.w_out, 1024, 1024, kb * 64, nb * 32, (bf16_t*)(ws + WS_WOUT), nb * 32, nullptr, scr, lane); continue; }
        r -= I_OUT;
        if (!EXP_IN_ATTN) { if (r < 2 * I_EXP) { const int up = r >= I_EXP; const int q = up ? r - I_EXP : r; const int e = q / 512, kb = (q % 512) / 32, nb = q % 32, n0 = nb * 32;
            p0_transpose_item((up ? F.w_up : F.w_gate) + (size_t)e * 1048576, 1024, 1024, kb * 64, n0, (bf16_t*)(ws + WS_WGU) + (size_t)e * 2048 * 1024, (n0 / 128) * 256 + up * 128 + (n0 % 128), nullptr, scr, lane); continue; }
        r -= 2 * I_EXP; }
        if (!WD_IN_P5 && !WD_IN_ATTN) { if (r < I_EXP) { const int e = r / 512, kb = (r % 512) / 32, nb = r % 32; p0_transpose_item(F.w_down + (size_t)e * 1048576, 1024, 1024, kb * 64, nb * 32, (bf16_t*)(ws + WS_WD) + (size_t)e * 1048576, nb * 32, nullptr, scr, lane); continue; }
        r -= I_EXP; }
        if (r < I_PAD) { u32x4 z = {0u, 0u, 0u, 0u}; u32x4* p = (u32x4*)((bf16_t*)(ws + WS_WIN) + (size_t)(672 + r) * 1024); p[lane] = z; p[64 + lane] = z; continue; }
        r -= I_PAD;
        {
            const int e = r * 64 + lane, tok = e / 24, f = e % 24; const int p = F.pos[tok];
#if FAST_ROPE_TAB
            LAS double* ft = (LAS double*)(scr + 64 * 33);
            if (!tab_ready) { if (lane < 24) ft[lane] = (double)(lane < 16 ? inv_freq_m(lane) : inv_freq_d(lane - 16)); LDS_WAIT(); asm volatile("" ::: "memory"); tab_ready = true; }
            const double rev = (double)((float)p * (float)ft[f]) * 0.15915494309189535; const float fr = (float)(rev - floor(rev));
            const float cs = __builtin_amdgcn_cosf(fr), sn = __builtin_amdgcn_sinf(fr);
#else
            const float inv = f < 16 ? inv_freq_m(f) : inv_freq_d(f - 16); const float ang = (float)p * inv; const float cs = (float)cos((double)ang), sn = (float)sin((double)ang);
#endif
            if (f < 16) { float* tm = (float*)(ws + WS_TABM) + (size_t)tok * 32; tm[f] = cs; tm[16 + f] = sn; } else { float* td = (float*)(ws + WS_TABD) + (size_t)tok * 16; td[f - 16] = cs; td[8 + f - 16] = sn; }
        }
    }
}
__device__ __forceinline__ void exp_convert_simple(Frame& F) {
    LAS float* scr = (LAS float*)(F.lds + F.wave * 16384); const int lane = fresh_lane();
#if WD_IN_ATTN
    const float* wg_ = F.w_gate; const float* wu_ = F.w_up; const float* wd_ = F.w_down;
    asm volatile("" : "+s"(wg_), "+s"(wu_), "+s"(wd_));
    const int chunk = (24576 + F.G - 1) / F.G;
    for (int k = F.wave; k < chunk; k += NWAVES) { const int r = F.vcu * chunk + k; if (r >= 24576) break; const int q = r & 8191, e = q / 512, kb = (q % 512) / 32, nb = q % 32, n0 = nb * 32;
        if (r < 16384) { const int up = r >> 13; p0_transpose_item((up ? wu_ : wg_) + (size_t)e * 1048576, 1024, 1024, kb * 64, n0, (bf16_t*)(F.ws + WS_WGU) + (size_t)e * 2048 * 1024, (n0 / 128) * 256 + up * 128 + (n0 % 128), nullptr, scr, lane); }
        else p0_transpose_item(wd_ + (size_t)e * 1048576, 1024, 1024, kb * 64, n0, (bf16_t*)(F.ws + WS_WD) + (size_t)e * 1048576, n0, nullptr, scr, lane); }
#else
    const int chunk = (16384 + F.G - 1) / F.G;
    for (int k = F.wave; k < chunk; k += NWAVES) { const int r = F.vcu * chunk + k; if (r >= 16384) break; const int up = r >= 8192; const int q = up ? r - 8192 : r; const int e = q / 512, kb = (q % 512) / 32, nb = q % 32, n0 = nb * 32;
        p0_transpose_item((up ? F.w_up : F.w_gate) + (size_t)e * 1048576, 1024, 1024, kb * 64, n0, (bf16_t*)(F.ws + WS_WGU) + (size_t)e * 2048 * 1024, (n0 / 128) * 256 + up * 128 + (n0 % 128), nullptr, scr, lane); }
#endif
    __syncthreads();
}
#ifndef CV_PIPE
#define CV_PIPE 0
#endif
#define CV_DECODE(r_, SRC, DST) const float* SRC; bf16_t* DST; { const int r__ = (r_); const int up__ = r__ >> 13, q__ = r__ & 8191, e__ = q__ >> 9, kb__ = (q__ & 511) >> 5, n0__ = (q__ & 31) * 32; \
        SRC = (up__ ? wu_ : wg_) + (size_t)e__ * 1048576 + (size_t)(kb__ * 64) * 1024 + n0__; \
        DST = (bf16_t*)(F.ws + WS_WGU) + (size_t)e__ * 2048 * 1024 + (size_t)((n0__ / 128) * 256 + up__ * 128 + (n0__ % 128)) * 1024 + kb__ * 64; }
#define CV_LOAD(v, r_) do { CV_DECODE(r_, src__, dst__); (void)dst__; _Pragma("unroll") for (int i = 0; i < 8; ++i) v[i] = *(const f32x4*)(src__ + (size_t)(8 * i + (lane >> 3)) * 1024 + 4 * (lane & 7)); } while (0)
#define CV_WRITE(v, scr_) do { _Pragma("unroll") for (int i = 0; i < 8; ++i) { LAS float* d = (scr_) + (8 * i + (lane >> 3)) * 33 + 4 * (lane & 7); d[0] = v[i].x; d[1] = v[i].y; d[2] = v[i].z; d[3] = v[i].w; } } while (0)
#define CV_STORE(scr_, r_) do { CV_DECODE(r_, src__, dst__); (void)src__; const int c = lane & 7; _Pragma("unroll") for (int j = 0; j < 4; ++j) { const int n = (lane >> 3) + 8 * j; const LAS float* s = (scr_) + (8 * c) * 33 + n; \
        u32x4 o; o.x = pk2(s[0 * 33], s[1 * 33]); o.y = pk2(s[2 * 33], s[3 * 33]); o.z = pk2(s[4 * 33], s[5 * 33]); o.w = pk2(s[6 * 33], s[7 * 33]); *(u32x4*)(dst__ + (size_t)n * 1024 + 8 * c) = o; } } while (0)
__device__ __forceinline__ void exp_convert(Frame& F) {
    if (!CV_PIPE) { exp_convert_simple(F); return; }
    LAS float* scrA = (LAS float*)(F.lds + F.wave * 16384); const int lane = fresh_lane();
    const float* wg_ = F.w_gate; const float* wu_ = F.w_up;
    asm volatile("" : "+s"(wg_), "+s"(wu_));
    const int chunk = (16384 + F.G - 1) / F.G; const int r_hi = min(16384, (F.vcu + 1) * chunk);
    int r = F.vcu * chunk + F.wave; bool ha = r < r_hi;
    f32x4 va[8];
    if (ha) CV_LOAD(va, r);
    while (ha) {
        CV_WRITE(va, scrA);
        const int rn = r + NWAVES; const bool na = rn < r_hi;
        if (na) CV_LOAD(va, rn);
        LDS_WAIT(); asm volatile("" ::: "memory");
        CV_STORE(scrA, r);
        LDS_WAIT(); asm volatile("" ::: "memory");
        r = rn; ha = na;
    }
    __syncthreads();
}
__device__ __forceinline__ void wd_convert(Frame& F, int first_vcu, int rank = -1, int nconv = 0) {
    LAS float* scr = (LAS float*)(F.lds + F.wave * 16384);
    const int gw = (rank >= 0 ? rank : F.vcu - first_vcu) * NWAVES + F.wave, NGW = (rank >= 0 ? nconv : F.G - first_vcu) * NWAVES, lane = fresh_lane();
    for (int r = gw; r < 16 * 16 * 32; r += NGW) { const int e = r / 512, kb = (r % 512) / 32, nb = r % 32;
        p0_transpose_item(F.w_down + (size_t)e * 1048576, 1024, 1024, kb * 64, nb * 32, (bf16_t*)(F.ws + WS_WD) + (size_t)e * 1048576, nb * 32, nullptr, scr, lane); }
}
__device__ __forceinline__ void p0b_rows(Frame& F) {
    const int tid_ = F.wave * 64 + fresh_lane();
    LAS float* A1 = (LAS float*)F.lds;
    LAS float* A0 = A1 + 2048;
    const float* mp = (const float*)(F.ws + WS_MODP);
    if (P0_MERGE) {
        if (F.wave == 0) { unsigned* p = (unsigned*)(F.ws + WS_DCNT); unsigned spins = 0;
            while ((unsigned)__builtin_amdgcn_readfirstlane(__hip_atomic_load(p, __ATOMIC_RELAXED, __HIP_MEMORY_SCOPE_AGENT)) < 384u) { __builtin_amdgcn_s_sleep(2); if (++spins > (1u << 22)) break; }
            __builtin_amdgcn_fence(__ATOMIC_ACQUIRE, "agent"); }
        __syncthreads(); }
#pragma unroll
    for (int half = 0; half < 2; ++half) { float s[4]; float pv[4][16];
#pragma unroll
        for (int q = 0; q < 4; ++q) { const int i = tid_ + NTHREADS * (half * 4 + q); const int b = i >> 11, n = ((i >> 10) & 1) * 1024 + (i & 1023);
#pragma unroll
            for (int k = 0; k < 16; ++k) pv[q][k] = mp[(size_t)k * 2 * 6144 + b * 6144 + n]; }
#pragma unroll
        for (int q = 0; q < 4; ++q) { const int i = tid_ + NTHREADS * (half * 4 + q); const int b = i >> 11, which = (i >> 10) & 1, j = i & 1023; s[q] = F.b_ada[which * 1024 + j];
#pragma unroll
            for (int k = 0; k < 16; ++k) s[q] += pv[q][k];
            if (which) A1[b * 1024 + j] = F.g_mix[j] * (1.f + s[q]); else A0[b * 1024 + j] = s[q]; } }
    if (blockIdx.x < 48 && tid_ < 256) { const int n = blockIdx.x * 256 + tid_; const int b = n / 6144, nn = n % 6144; float s = F.b_ada[nn];
#pragma unroll
        for (int k = 0; k < 16; ++k) s += mp[(size_t)k * 2 * 6144 + b * 6144 + nn];
        ((float*)(F.ws + WS_MODF))[n] = s; }
    __syncthreads();
    const int gw = F.vcu * NWAVES + F.wave, NGW = F.G * NWAVES, lane = fresh_lane();
    for (int m0 = gw; m0 < T; m0 += 2 * NGW) {
        const int m1 = m0 + NGW; const bool has1 = m1 < T; const int mm1 = has1 ? m1 : m0;
        const f32x4* xr0 = (const f32x4*)(F.x + (size_t)m0 * D) + lane; const f32x4* xr1 = (const f32x4*)(F.x + (size_t)mm1 * D) + lane; f32x4 v0[4], v1[4]; float s0 = 0.f, s1 = 0.f;
#pragma unroll
        for (int j = 0; j < 4; ++j) { v0[j] = xr0[64 * j]; v1[j] = xr1[64 * j]; }
#pragma unroll
        for (int j = 0; j < 4; ++j) { s0 += (v0[j].x * v0[j].x + v0[j].y * v0[j].y) + (v0[j].z * v0[j].z + v0[j].w * v0[j].w); s1 += (v1[j].x * v1[j].x + v1[j].y * v1[j].y) + (v1[j].z * v1[j].z + v1[j].w * v1[j].w); }
        const float r0 = rsqrtf(wave_sum(s0) * (1.f / D) + EPS), r1 = rsqrtf(wave_sum(s1) * (1.f / D) + EPS);
        const int b0 = m0 >> 13, b1 = mm1 >> 13;
        unsigned long long* o0 = (unsigned long long*)((bf16_t*)(F.ws + WS_HB) + (size_t)m0 * D) + lane; unsigned long long* o1 = (unsigned long long*)((bf16_t*)(F.ws + WS_HB) + (size_t)mm1 * D) + lane;
#pragma unroll
        for (int j = 0; j < 4; ++j) { const f32x4 a1 = *(const LAS f32x4*)(A1 + b0 * 1024 + 4 * lane + 256 * j), a0 = *(const LAS f32x4*)(A0 + b0 * 1024 + 4 * lane + 256 * j);
            const f32x4 o = v0[j] * r0 * a1 + a0; o0[64 * j] = (unsigned long long)pk2(o.x, o.y) | ((unsigned long long)pk2(o.z, o.w) << 32); }
        if (has1) {
#pragma unroll
            for (int j = 0; j < 4; ++j) { const f32x4 a1 = *(const LAS f32x4*)(A1 + b1 * 1024 + 4 * lane + 256 * j), a0 = *(const LAS f32x4*)(A0 + b1 * 1024 + 4 * lane + 256 * j);
                const f32x4 o = v1[j] * r1 * a1 + a0; o1[64 * j] = (unsigned long long)pk2(o.x, o.y) | ((unsigned long long)pk2(o.z, o.w) << 32); } }
    }
    __syncthreads();
}

__device__ __forceinline__ bool static_tile(int i, int G, int c, int nM, int nN, int& pm, int& pn) {
    const int nwg = nM * nN; const long L = (long)i * G + c; if (L >= nwg) return false;
    int wgid = (int)L; { const int q = nwg / 8, r = nwg % 8, xcd = wgid % 8, off = wgid / 8; wgid = (xcd < r ? xcd * (q + 1) : r * (q + 1) + (xcd - r) * q) + off; }
    const int nig = 8 * nN, gid = wgid / nig, fm = gid * 8, gsz = (nM - fm) < 8 ? (nM - fm) : 8;
    pm = fm + ((wgid % nig) % gsz); pn = (wgid % nig) / gsz; return true;
}
struct SchedP1 {
    static constexpr bool GATHER = false;
    __device__ __forceinline__ void a_ready(const gm::Unit&, int, int) const {}
    __device__ __forceinline__ void done(const gm::Unit&, int) const {}
    __device__ __forceinline__ void stamp(int, const gm::Unit&, int, int) const {}
    const char* A; const char* Bt; int G, c;
    __device__ __forceinline__ bool next(int i, gm::Unit& u) const { int pm, pn; if (!static_tile(i, G, c, 64, 9, pm, pn)) return false;
        u.A = A; u.Bt = Bt; u.gidx = nullptr; u.lda2 = 2048; u.ldb2 = 2048; u.arow0 = pm * 256; u.brow0 = pn * 256; u.nt = 16; u.pm = pm; u.pn = pn; u.aux = 0; return true; }
};
struct SchedP2 {
    static constexpr bool GATHER = false;
    __device__ __forceinline__ void a_ready(const gm::Unit&, int, int) const {}
    __device__ __forceinline__ void done(const gm::Unit&, int) const {}
    __device__ __forceinline__ void stamp(int, const gm::Unit&, int, int) const {}
    const char* A; const char* Wuq; const char* Wukv; int G, c;
    __device__ __forceinline__ bool next(int i, gm::Unit& u) const {
        const int L = i * G + c; if (L >= 448) return false;
        u.A = A; u.gidx = nullptr; u.lda2 = 1536;
        if (L < 256) { int pm, pn; static_tile(0, 256, L, 64, 4, pm, pn); u.A = A + 768; u.Bt = Wukv; u.ldb2 = 512; u.nt = 4; u.arow0 = pm * 256; u.brow0 = pn * 256; u.pm = pm; u.pn = pn; u.aux = 1; }
        else { int pm, pn; static_tile(0, 192, L - 256, 64, 3, pm, pn); u.Bt = Wuq; u.ldb2 = 768; u.nt = 6; u.arow0 = pm * 256; u.brow0 = pn * 256; u.pm = pm; u.pn = pn; u.aux = 0; }
        return true; }
};

__device__ __forceinline__ void store16_sc1(void* p, u32x4 v) { asm volatile("global_store_dwordx4 %0, %1, off sc1\n\ts_nop 1" :: "v"(p), "v"(v) : "memory"); }
__device__ __forceinline__ void store4_sc1(float* p, float v) { __hip_atomic_store(p, v, __ATOMIC_RELAXED, __HIP_MEMORY_SCOPE_AGENT); }
#define EPI_ARGS const f32x4 (&acc)[2][2][4][2], const gm::Unit& u, int wr, int wc, int fr, int fq, int lane
constexpr float QSCALE_M = 0.10206207261596575f * 1.4426950408889634f;
constexpr float QSCALE_D = 0.125f * 1.4426950408889634f;
__device__ __forceinline__ u32x4 pack8(f32x4 a, f32x4 b) { u32x4 w; w.x = cvt_pk_bf16(a[0], a[1]); w.y = cvt_pk_bf16(a[2], a[3]); w.z = cvt_pk_bf16(b[0], b[1]); w.w = cvt_pk_bf16(b[2], b[3]); return w; }
#ifndef SWAP_SHFL
#define SWAP_SHFL 1
#endif
__device__ __forceinline__ float xsum_16_32(float x) {
    if (!SWAP_SHFL) { x += __shfl_xor(x, 16); x += __shfl_xor(x, 32); return x; }
    auto a = __builtin_amdgcn_permlane16_swap(__float_as_uint(x), __float_as_uint(x), false, false); x = __uint_as_float(a[0]) + __uint_as_float(a[1]);
    auto b = __builtin_amdgcn_permlane32_swap(__float_as_uint(x), __float_as_uint(x), false, false); return __uint_as_float(b[0]) + __uint_as_float(b[1]); }
__device__ __forceinline__ float xpartner(float x, int xmask, bool upper) {
    if (!SWAP_SHFL) return __shfl_xor(x, xmask);
    if (xmask == 32) { auto r = __builtin_amdgcn_permlane32_swap(__float_as_uint(x), __float_as_uint(x), false, false); return __uint_as_float(upper ? r[0] : r[1]); }
    auto r = __builtin_amdgcn_permlane16_swap(__float_as_uint(x), __float_as_uint(x), false, false); return __uint_as_float(upper ? r[0] : r[1]); }
__device__ __forceinline__ void rope8(f32x4& v0, f32x4& v1, int xmask, const float* cs, const float* sn, bool first) {
    f32x4 o0, o1;
#pragma unroll
    for (int j = 0; j < 4; ++j) { o0[j] = xpartner(v0[j], xmask, !first); o1[j] = xpartner(v1[j], xmask, !first); }
    const f32x4 c0 = *(const f32x4*)cs, c1 = *(const f32x4*)(cs + 4), s0 = *(const f32x4*)sn, s1 = *(const f32x4*)(sn + 4);
    const float sg = first ? -1.f : 1.f;
    v0 = v0 * c0 + o0 * s0 * sg; v1 = v1 * c1 + o1 * s1 * sg;
}
__device__ __forceinline__ void rope8v(f32x4& v0, f32x4& v1, int xmask, f32x4 c0, f32x4 c1, f32x4 s0, f32x4 s1, bool first) {
    f32x4 o0, o1;
#pragma unroll
    for (int j = 0; j < 4; ++j) { o0[j] = xpartner(v0[j], xmask, !first); o1[j] = xpartner(v1[j], xmask, !first); }
    const float sg = first ? -1.f : 1.f;
    v0 = v0 * c0 + o0 * s0 * sg; v1 = v1 * c1 + o1 * s1 * sg;
}
#ifndef RSTD_PRE
#define RSTD_PRE 0
#endif
#ifndef ROPE_HOIST
#define ROPE_HOIST 0
#endif
struct EpiP1 {
    static constexpr bool PERM = true; static constexpr bool DRAIN = false;
    unsigned char* ws;
    __device__ __forceinline__ void operator()(EPI_ARGS) const {
        const int pn = u.pn; float krmax = 0.f;
        const float* tabm = (const float*)(ws + WS_TABM); const float* tabd = (const float*)(ws + WS_TABD);
#pragma unroll
        for (int ai = 0; ai < 2; ++ai)
#pragma unroll
            for (int m = 0; m < 4; ++m) {
                const int row = u.pm * 256 + ai * 128 + wr * 64 + m * 16 + fr; const int b = row >> 13, s = row & 8191;
                f32x4 tc0 = {0.f, 0.f, 0.f, 0.f}, tc1 = tc0, ts0 = tc0, ts1 = tc0;
                if (ROPE_HOIST && pn >= 3 && pn < 7 && (wc & 1) == 0) { const float* tr = tabd + (size_t)row * 16; tc0 = *(const f32x4*)tr; tc1 = *(const f32x4*)(tr + 4); ts0 = *(const f32x4*)(tr + 8); ts1 = *(const f32x4*)(tr + 12); }
#pragma unroll
                for (int bj = 0; bj < 2; ++bj) {
                    f32x4 v0 = acc[ai][bj][m][0], v1 = acc[ai][bj][m][1];
                    const int ct = bj * 128 + wc * 32 + 8 * fq;
                    if (pn < 3) {
                        float q = (v0[0] * v0[0] + v0[1] * v0[1]) + (v0[2] * v0[2] + v0[3] * v0[3]) + (v1[0] * v1[0] + v1[1] * v1[1]) + (v1[2] * v1[2] + v1[3] * v1[3]);
                        q = xsum_16_32(q);
                        if (fq == 0) store4_sc1((float*)(ws + WS_SSQ) + (size_t)row * 24 + pn * 8 + bj * 4 + wc, q);
                        if (pn == 2 && bj == 1 && wc == 0) {
                            const int f0 = 8 * (fq & 1); rope8(v0, v1, 32, tabm + (size_t)row * 32 + f0, tabm + (size_t)row * 32 + 16 + f0, fq < 2);
                            store16_sc1((bf16_t*)(ws + WS_KR) + (size_t)row * 32 + 8 * fq, pack8(v0, v1));
                            { float q2 = (v0[0] * v0[0] + v0[1] * v0[1]) + (v0[2] * v0[2] + v0[3] * v0[3]) + (v1[0] * v1[0] + v1[1] * v1[1]) + (v1[2] * v1[2] + v1[3] * v1[3]);
                              q2 = xsum_16_32(q2); krmax = fmaxf(krmax, q2); }
                        } else store16_sc1((bf16_t*)(ws + WS_CQ) + (size_t)row * 768 + pn * 256 + ct, pack8(v0, v1));
                    } else {
                        const int which = (pn - 3) >> 1;
                        const int cc = ((pn - 3) & 1) * 256 + ct, hh = cc >> 6, d = cc & 63;
                        if (which < 2 && (wc & 1) == 0) {
                            f32x4 r0 = v0, r1 = v1; if (ROPE_HOIST) rope8v(r0, r1, 16, tc0, tc1, ts0, ts1, fq == 0); else rope8(r0, r1, 16, tabd + (size_t)row * 16, tabd + (size_t)row * 16 + 8, fq == 0);
                            if (fq < 2) { v0 = r0; v1 = r1; } }
                        if (which == 0) { v0 = v0 * QSCALE_D; v1 = v1 * QSCALE_D; }
                        bf16_t* dst = (bf16_t*)(ws + (which == 0 ? WS_DQ : which == 1 ? WS_DK : WS_DV));
                        *(u32x4*)(dst + ((size_t)(b * 8 + hh) * S + s) * 64 + d) = pack8(v0, v1);
                    }
                }
            }
        if (pn == 2 && wc == 0) {
#pragma unroll
            for (int o = 1; o < 16; o <<= 1) krmax = fmaxf(krmax, __shfl_xor(krmax, o));
            if (lane == 0) atomicMax((unsigned*)(ws + WS_KMX) + 32 + ((u.pm * 256) >> 13), __float_as_uint(krmax)); }
    }
};
struct EpiP2 {
    static constexpr bool PERM = true; static constexpr bool DRAIN = false;
    unsigned char* ws;
    __device__ __forceinline__ void operator()(EPI_ARGS) const {
        const int pn = u.pn; const bool isq = u.aux == 0; float kmax[2] = {0.f, 0.f};
        const float* tabm = (const float*)(ws + WS_TABM); const float* ssq = (const float*)(ws + WS_SSQ);
#if RSTD_PRE
        float rs8[2][4];
#pragma unroll
        for (int ai = 0; ai < 2; ++ai) { f32x4 pa[4], pb[4], pc[4];
#pragma unroll
            for (int m = 0; m < 4; ++m) { const float* sq = ssq + (size_t)(u.pm * 256 + ai * 128 + wr * 64 + m * 16 + fr) * 24;
                if (isq) { pa[m] = *(const f32x4*)sq; pb[m] = *(const f32x4*)(sq + 4); pc[m] = *(const f32x4*)(sq + 8); }
                else { pa[m] = *(const f32x4*)(sq + 12); pb[m] = *(const f32x4*)(sq + 16); pc[m] = (f32x4){0.f, 0.f, 0.f, 0.f}; } }
#pragma unroll
            for (int m = 0; m < 4; ++m) { const f32x4 a = pa[m], bq = pb[m], cq = pc[m];
                const float sum = (((a[0] + a[1]) + (a[2] + a[3])) + ((bq[0] + bq[1]) + (bq[2] + bq[3]))) + ((cq[0] + cq[1]) + (cq[2] + cq[3]));
                rs8[ai][m] = isq ? rsqrtf(sum * (1.f / 384.f) + EPS) * QSCALE_M : rsqrtf(sum * (1.f / 256.f) + EPS); }
            asm volatile("" ::: "memory"); }
#endif
#pragma unroll
        for (int ai = 0; ai < 2; ++ai)
#pragma unroll
            for (int m = 0; m < 4; ++m) {
                const int row = u.pm * 256 + ai * 128 + wr * 64 + m * 16 + fr; const int b = row >> 13, s = row & 8191;
                const float* sq = ssq + (size_t)row * 24; float rstd;
#if RSTD_PRE
                rstd = rs8[ai][m]; if (false)
#endif
                if (isq) { const f32x4 a = *(const f32x4*)sq, bq = *(const f32x4*)(sq + 4), cq = *(const f32x4*)(sq + 8);
                    rstd = rsqrtf((((a[0] + a[1]) + (a[2] + a[3])) + ((bq[0] + bq[1]) + (bq[2] + bq[3])) + ((cq[0] + cq[1]) + (cq[2] + cq[3]))) * (1.f / 384.f) + EPS) * QSCALE_M; }
                else { const f32x4 a = *(const f32x4*)(sq + 12), bq = *(const f32x4*)(sq + 16);
                    rstd = rsqrtf((((a[0] + a[1]) + (a[2] + a[3])) + ((bq[0] + bq[1]) + (bq[2] + bq[3]))) * (1.f / 256.f) + EPS); }
#pragma unroll
                for (int bj = 0; bj < 2; ++bj) {
                    f32x4 v0 = acc[ai][bj][m][0] * rstd, v1 = acc[ai][bj][m][1] * rstd;
                    const int ct = bj * 128 + wc * 32 + 8 * fq, cc = (pn & 1) * 256 + ct;
                    if (isq) {
                        if (pn < 2) { const int hh = cc >> 6, d = cc & 63; *(u32x4*)((bf16_t*)(ws + WS_Q) + ((size_t)(b * 8 + hh) * S + s) * 96 + d) = pack8(v0, v1); }
                        else { const int hh = ct >> 5; const int f0 = 8 * (fq & 1); rope8(v0, v1, 32, tabm + (size_t)row * 32 + f0, tabm + (size_t)row * 32 + 16 + f0, fq < 2);
                            *(u32x4*)((bf16_t*)(ws + WS_Q) + ((size_t)(b * 8 + hh) * S + s) * 96 + 64 + 8 * fq) = pack8(v0, v1); }
                    } else { const int hh = cc >> 6, d = cc & 63; bf16_t* dst = (bf16_t*)(ws + (pn < 2 ? WS_KN : WS_V));
                        *(u32x4*)(dst + ((size_t)(b * 8 + hh) * S + s) * 64 + d) = pack8(v0, v1);
                        if (pn < 2) { float q2 = (v0[0] * v0[0] + v0[1] * v0[1]) + (v0[2] * v0[2] + v0[3] * v0[3]) + (v1[0] * v1[0] + v1[1] * v1[1]) + (v1[2] * v1[2] + v1[3] * v1[3]);
                            q2 = xsum_16_32(q2); kmax[bj] = fmaxf(kmax[bj], q2); } }
                }
            }
        if (!isq && pn < 2) {
#pragma unroll
            for (int bj = 0; bj < 2; ++bj) { float km = kmax[bj];
#pragma unroll
                for (int o = 1; o < 16; o <<= 1) km = fmaxf(km, __shfl_xor(km, o));
                const int cc = (pn & 1) * 256 + bj * 128 + wc * 32, hh = cc >> 6, half = (cc >> 5) & 1, b = (u.pm * 256) >> 13;
                if (lane == 0) atomicMax((unsigned*)(ws + WS_KMX) + (b * 8 + hh) * 2 + half, __float_as_uint(km)); }
        }
    }
};

constexpr size_t WS_PCNT = 56 * KiB;
struct SchedP12 {
    static constexpr bool GATHER = false;
    const char *HB, *WIN, *CQ, *WUQ, *WUKV; unsigned* cnt; int G, vcu, c;
    __device__ __forceinline__ bool next(int i, gm::Unit& u) const {
        u.gidx = nullptr;
        if (G == 256) {
            const int n1 = c < 64 ? 3 : 2;
            if (i < n1) { int pm, pn; static_tile(i, 256, c, 64, 9, pm, pn);
                u.A = HB; u.Bt = WIN; u.lda2 = 2048; u.ldb2 = 2048; u.arow0 = pm * 256; u.brow0 = pn * 256; u.nt = 16; u.pm = pm; u.pn = pn; u.aux = 2; return true; }
            if (i - n1 >= (c < 64 ? 1 : 2)) return false;
            const int idx = c < 64 ? 192 + c : (c - 64) + 256 * (i - 2);
            if (idx < 256) { int pm, pn; static_tile(0, 256, idx, 64, 4, pm, pn); u.A = CQ + 768; u.Bt = WUKV; u.lda2 = 1536; u.ldb2 = 512; u.nt = 4; u.arow0 = pm * 256; u.brow0 = pn * 256; u.pm = pm; u.pn = pn; u.aux = 1; }
            else { int pm, pn; static_tile(0, 192, idx - 256, 64, 3, pm, pn); u.A = CQ; u.Bt = WUQ; u.lda2 = 1536; u.ldb2 = 768; u.nt = 6; u.arow0 = pm * 256; u.brow0 = pn * 256; u.pm = pm; u.pn = pn; u.aux = 0; }
            return true;
        }
        const int n1 = (576 - vcu + G - 1) / G;
        if (i < n1) { const int k = vcu + G * i, pn = k >> 6, pm = k & 63;
            u.A = HB; u.Bt = WIN; u.lda2 = 2048; u.ldb2 = 2048; u.arow0 = pm * 256; u.brow0 = pn * 256; u.nt = 16; u.pm = pm; u.pn = pn; u.aux = 2; return true; }
        const int idx = vcu + G * (i - n1); if (idx >= 448) return false;
        if (idx < 256) { const int pm = idx & 63, pn = idx >> 6; u.A = CQ + 768; u.Bt = WUKV; u.lda2 = 1536; u.ldb2 = 512; u.nt = 4; u.arow0 = pm * 256; u.brow0 = pn * 256; u.pm = pm; u.pn = pn; u.aux = 1; }
        else { const int j = idx - 256, pm = j & 63, pn = j >> 6; u.A = CQ; u.Bt = WUQ; u.lda2 = 1536; u.ldb2 = 768; u.nt = 6; u.arow0 = pm * 256; u.brow0 = pn * 256; u.pm = pm; u.pn = pn; u.aux = 0; }
        return true;
    }
#ifndef P12_STAMP
#define P12_STAMP 0
#endif
    __device__ __forceinline__ void stamp(int ui, const gm::Unit& u, int wid, int lane) const {
#if P12_STAMP
        if (wid == 0 && lane == 0) { unsigned long long* ts = (unsigned long long*)((unsigned char*)cnt - WS_PCNT + 128 * KiB) + (size_t)c * 8; ts[1 + ui] = __builtin_amdgcn_s_memrealtime(); ts[6] = (unsigned long long)(ui + 1); ts[7] = (u.aux == 2) ? (unsigned long long)(ui + 1) : ts[7]; }
#endif
    }
    __device__ __forceinline__ void a_ready(const gm::Unit& u, int wid, int) const {
        if (u.aux == 2) return;
        if (wid == 0) { unsigned* p = cnt + 16 * u.pm; unsigned spins = 0;
            while ((unsigned)__builtin_amdgcn_readfirstlane(__hip_atomic_load(p, __ATOMIC_RELAXED, __HIP_MEMORY_SCOPE_AGENT)) < 24u) { __builtin_amdgcn_s_sleep(2); if (++spins > (1u << 22)) break; }
            if (P12_ACQ) __builtin_amdgcn_fence(__ATOMIC_ACQUIRE, "agent");
            asm volatile("s_waitcnt vmcnt(0)" ::: "memory"); }
        asm volatile("" ::: "memory"); __builtin_amdgcn_s_barrier(); asm volatile("" ::: "memory");
    }
    __device__ __forceinline__ void done(const gm::Unit& u, int lane) const {
        if (u.aux != 2 || u.pn >= 3) return;
        asm volatile("s_waitcnt vmcnt(0)" ::: "memory");
        if (lane == 0) __hip_atomic_fetch_add(cnt + 16 * u.pm, 1u, __ATOMIC_RELAXED, __HIP_MEMORY_SCOPE_AGENT);
    }
};
struct EpiP12 {
    static constexpr bool PERM = true; static constexpr bool DRAIN = true;
    unsigned char* ws;
    __device__ __forceinline__ void operator()(EPI_ARGS) const { if (u.aux == 2) { EpiP1 e{ws}; e(acc, u, wr, wc, fr, fq, lane); } else { EpiP2 e{ws}; e(acc, u, wr, wc, fr, fq, lane); } }
};
}
namespace mk {
#define RLX_AGENT __ATOMIC_RELAXED, __HIP_MEMORY_SCOPE_AGENT
#define XB_TMO      128
#define XB_XCNT(j)  (256  + 64 * (j))
#define XB_XSUB(j)  (1280 + 64 * (j))
#define XB_XGEN(j)  (2304 + 64 * (j))
#define XB_TOP      3328
#define XB_TOPGEN   3392
#define XCD_BAR_WORDS 3456
#define XB_SPIN_CAP (1u << 18)
__device__ __forceinline__ unsigned xb_ld(unsigned* p)              { return __hip_atomic_load(p, __ATOMIC_RELAXED, __HIP_MEMORY_SCOPE_AGENT); }
__device__ __forceinline__ unsigned xb_add(unsigned* p, unsigned v) { return __hip_atomic_fetch_add(p, v, __ATOMIC_RELAXED, __HIP_MEMORY_SCOPE_AGENT); }
__device__ __forceinline__ unsigned xb_xcc_id() { return (unsigned)__builtin_amdgcn_s_getreg((3 << 11) | 20) & 0xFu; }
#define XB_SPIN(cond, bar) do { unsigned _sp = 0; while (cond) { __builtin_amdgcn_s_sleep(1); \
    if ((++_sp & 255u) == 0u) { if (xb_ld(&(bar)[XB_TMO])) break; if (_sp > XB_SPIN_CAP) { atomicAdd(&(bar)[XB_TMO], 1u); break; } } } } while (0)
struct XcdBarrier { unsigned* bar; unsigned x; volatile LAS unsigned* st; };
__device__ __forceinline__ XcdBarrier xcd_barrier_post(unsigned* bar, volatile LAS unsigned* st, bool first_thread) {
    XcdBarrier b; b.bar = bar; b.x = xb_xcc_id(); b.st = st;
    if (first_thread) (void)xb_add(&bar[XB_XCNT(b.x)], 1u);
    return b;
}
__device__ __forceinline__ void xcd_barrier_complete(unsigned* bar, unsigned x, unsigned& nloc, unsigned& nx) {
    const unsigned G = gridDim.x * gridDim.y * gridDim.z;
    unsigned sum, cnt, mine, sp = 0u;
    for (;;) {
        sum = 0u; cnt = 0u; mine = 0u;
#pragma unroll
        for (unsigned j = 0; j < 16; ++j) { const unsigned c = xb_ld(&bar[XB_XCNT(j)]); sum += c; cnt += (c > 0u) ? 1u : 0u; mine = (j == x) ? c : mine; }
        if (sum == G) break;
        __builtin_amdgcn_s_sleep(1);
        if ((++sp & 255u) == 0u) { if (xb_ld(&bar[XB_TMO])) break; if (sp > XB_SPIN_CAP) { atomicAdd(&bar[XB_TMO], 1u); break; } }
    }
    nloc = mine > 0u ? mine : 1u; nx = cnt > 0u ? cnt : 1u;
}
#ifndef XB_FLAT_WAKE
#define XB_FLAT_WAKE 2
#endif
#ifndef XB_TIGHT
#define XB_TIGHT 0
#endif
#ifndef XB_MODE
#define XB_MODE 0
#endif
__device__ __forceinline__ void xcd_barrier(const XcdBarrier& b, bool first_thread) {
    asm volatile("s_waitcnt vmcnt(0)" ::: "memory");
    __syncthreads();
    if (XB_MODE == 2) {
        if (first_thread) {
            unsigned* bar = b.bar; const unsigned mygen = b.st[2]; const unsigned target = (gridDim.x * gridDim.y * gridDim.z) * (mygen + 1u);
            __builtin_amdgcn_fence(__ATOMIC_RELEASE, "agent");
            asm volatile("s_waitcnt vmcnt(0)" ::: "memory");
            (void)xb_add(&bar[XB_XSUB(b.x)], 1u);
            unsigned sp = 0u;
            for (;;) { unsigned sum = 0u;
#pragma unroll
                for (unsigned j = 0; j < 8; ++j) sum += xb_ld(&bar[XB_XSUB(j)]);
                if (sum >= target) break;
                __builtin_amdgcn_s_sleep(2);
                if ((++sp & 255u) == 0u) { if (xb_ld(&bar[XB_TMO])) break; if (sp > XB_SPIN_CAP) { atomicAdd(&bar[XB_TMO], 1u); break; } } }
            __builtin_amdgcn_fence(__ATOMIC_ACQUIRE, "agent");
            asm volatile("s_waitcnt vmcnt(0)" ::: "memory");
            b.st[2] = mygen + 1u;
        }
        __syncthreads();
        return;
    }
    if (first_thread) {
        unsigned* bar = b.bar;
        __builtin_amdgcn_s_waitcnt(0);
        unsigned nloc = b.st[0], nx = b.st[1];
        if (nloc == 0u) { xcd_barrier_complete(bar, b.x, nloc, nx); b.st[0] = nloc; b.st[1] = nx; }
        const unsigned mygen = b.st[2];
        const unsigned old = xb_add(&bar[XB_XSUB(b.x)], 1u);
        const unsigned gen = old / nloc;
        if (XB_FLAT_WAKE == 2) {
            if (old + 1u == (gen + 1u) * nloc) { __builtin_amdgcn_fence(__ATOMIC_RELEASE, "agent"); asm volatile("s_waitcnt vmcnt(0)" ::: "memory"); (void)xb_add(&bar[XB_TOP], 1u); }
            const unsigned target = nx * (mygen + 1u);
            if (XB_TIGHT) { unsigned sp_ = 0u; while (xb_ld(&bar[XB_TOP]) < target) { if ((++sp_ & 1023u) == 0u) { if (xb_ld(&bar[XB_TMO])) break; if (sp_ > (XB_SPIN_CAP << 2)) { atomicAdd(&bar[XB_TMO], 1u); break; } } } }
            else XB_SPIN(xb_ld(&bar[XB_TOP]) < target, bar);
            __builtin_amdgcn_fence(__ATOMIC_ACQUIRE, "agent");
            asm volatile("s_waitcnt vmcnt(0)" ::: "memory");
        } else
        if (old + 1u == (gen + 1u) * nloc) {
            __builtin_amdgcn_fence(__ATOMIC_RELEASE, "agent");
            asm volatile("s_waitcnt vmcnt(0)" ::: "memory");
            const unsigned og = xb_add(&bar[XB_TOP], 1u);
            const unsigned tg = og / nx;
            if (og + 1u == (tg + 1u) * nx) xb_add(&bar[XB_TOPGEN], 1u);
            else XB_SPIN(xb_ld(&bar[XB_TOPGEN]) == tg, bar);
            __builtin_amdgcn_fence(__ATOMIC_ACQUIRE, "agent");
            if (!XB_FLAT_WAKE) xb_add(&bar[XB_XGEN(b.x)], 1u);
            asm volatile("s_waitcnt vmcnt(0)" ::: "memory");
        } else {
            if (XB_FLAT_WAKE) XB_SPIN(xb_ld(&bar[XB_TOPGEN]) == mygen, bar); else XB_SPIN(xb_ld(&bar[XB_XGEN(b.x)]) == gen, bar);
            __builtin_amdgcn_fence(__ATOMIC_ACQUIRE, "agent");
            asm volatile("s_waitcnt vmcnt(0)" ::: "memory");
        }
        b.st[2] = mygen + 1u;
    }
    __syncthreads();
}
template <class Fn> __device__ __forceinline__ void xcd_barrier_fz(const XcdBarrier& b, bool first_thread, Fn fn) {
    asm volatile("s_waitcnt vmcnt(0)" ::: "memory");
    __syncthreads();
    unsigned target = 0u, mygen = 0u;
    if (first_thread) {
        unsigned* bar = b.bar;
        __builtin_amdgcn_s_waitcnt(0);
        unsigned nloc = b.st[0], nx = b.st[1];
        if (nloc == 0u) { xcd_barrier_complete(bar, b.x, nloc, nx); b.st[0] = nloc; b.st[1] = nx; }
        mygen = b.st[2];
        const unsigned old = xb_add(&bar[XB_XSUB(b.x)], 1u);
        const unsigned gen = old / nloc;
        if (old + 1u == (gen + 1u) * nloc) { __builtin_amdgcn_fence(__ATOMIC_RELEASE, "agent"); asm volatile("s_waitcnt vmcnt(0)" ::: "memory"); (void)xb_add(&bar[XB_TOP], 1u); }
        target = nx * (mygen + 1u);
    }
    fn();
    if (first_thread) {
        unsigned* bar = b.bar;
        XB_SPIN(xb_ld(&bar[XB_TOP]) < target, bar);
        __builtin_amdgcn_fence(__ATOMIC_ACQUIRE, "agent");
        asm volatile("s_waitcnt vmcnt(0)" ::: "memory");
        b.st[2] = mygen + 1u;
    }
    __syncthreads();
}
}
namespace at {
using bf16x8 = __attribute__((ext_vector_type(8))) short;
using s16x4 = __attribute__((ext_vector_type(4))) short;
using f32x16 = __attribute__((ext_vector_type(16))) float;
using u32x4 = __attribute__((ext_vector_type(4))) unsigned;
constexpr int S = 8192, T = 16384;
constexpr float THR = 8.f;
#define SBAR() __builtin_amdgcn_sched_barrier(0)
__device__ __forceinline__ int crow(int r, int hi) { return (r & 3) + 8 * (r >> 2) + 4 * hi; }
__device__ __forceinline__ unsigned cvtpk(float lo, float hi) { unsigned r; asm volatile("v_cvt_pk_bf16_f32 %0, %1, %2" : "=v"(r) : "v"(lo), "v"(hi)); return r; }
__device__ __forceinline__ float rowmax32(const f32x16& p0, const f32x16& p1) {
    float pmax = p0[0];
#pragma unroll
    for (int r = 1; r < 16; ++r) pmax = fmaxf(pmax, p0[r]);
#pragma unroll
    for (int r = 0; r < 16; ++r) pmax = fmaxf(pmax, p1[r]);
    auto rr = __builtin_amdgcn_permlane32_swap(__float_as_uint(pmax), __float_as_uint(pmax), false, false);
    return fmaxf(__uint_as_float(rr[0]), __uint_as_float(rr[1]));
}
__device__ __forceinline__ void partialSM(f32x16& p0, f32x16& p1, float& m_reg, float& mn, float& alpha) {
    const float pmax = rowmax32(p0, p1);
    if (__builtin_expect(__all(pmax - m_reg <= THR), 1)) { mn = m_reg; alpha = 1.f; }
    else { mn = fmaxf(m_reg, pmax); alpha = __builtin_amdgcn_exp2f(m_reg - mn); m_reg = mn; }
#pragma unroll
    for (int r = 0; r < 16; ++r) p0[r] = p0[r] - mn;
#pragma unroll
    for (int r = 0; r < 16; ++r) p1[r] = p1[r] - mn;
#pragma unroll
    for (int r = 0; r < 16; ++r) p0[r] = __builtin_amdgcn_exp2f(p0[r]);
}
#define PK4(P, BASE, OUT) do { u32x4 w = {cvtpk(P[BASE + 0], P[BASE + 1]), cvtpk(P[BASE + 2], P[BASE + 3]), cvtpk(P[BASE + 4], P[BASE + 5]), cvtpk(P[BASE + 6], P[BASE + 7])}; \
    OUT = *reinterpret_cast<bf16x8*>(&w); } while (0)
__device__ __forceinline__ void finishSM(f32x16& p0, f32x16& p1, float alpha, float& l_reg, bf16x8& pa0, bf16x8& pa1, bf16x8& pa2, bf16x8& pa3) {
#pragma unroll
    for (int r = 0; r < 16; ++r) p1[r] = __builtin_amdgcn_exp2f(p1[r]);
    float ps = 0;
#pragma unroll
    for (int r = 0; r < 16; ++r) ps += p0[r];
#pragma unroll
    for (int r = 0; r < 16; ++r) ps += p1[r];
    { auto rr = __builtin_amdgcn_permlane32_swap(__float_as_uint(ps), __float_as_uint(ps), false, false); ps = __uint_as_float(rr[0]) + __uint_as_float(rr[1]); }
    l_reg = l_reg * alpha + ps;
    PK4(p0, 0, pa0); PK4(p0, 8, pa1); PK4(p1, 0, pa2); PK4(p1, 8, pa3);
}
__device__ __forceinline__ int v_st(int k, int c) { const int kk = k; return ((kk >> 3) * 2 + (c >> 5)) * 512 + ((kk & 7) * 32 + (c & 31)) * 2; }
__device__ __forceinline__ int v_rd_base(int lane) { return ((lane & 3) << 3) | (((lane >> 2) & 3) << 6) | (((lane >> 4) & 1) << 5) | (((lane >> 5) & 1) << 8); }
constexpr int v_rd_off(int d0, int ks, int half) { return d0 * 512 + ks * 2048 + half * 1024; }
template <int OFF> __device__ __forceinline__ s16x4 tr_read(int vb) { s16x4 r; asm volatile("ds_read_b64_tr_b16 %0, %1 offset:%2" : "=&v"(r) : "v"(vb), "i"(OFF) : "memory"); return r; }
#define PKV(L, H) (bf16x8){L[0], L[1], L[2], L[3], H[0], H[1], H[2], H[3]}
template <int D0, int KOFF> __device__ __forceinline__ void pv_one(f32x16& od, int vb, bf16x8 pa0, bf16x8 pa1, bf16x8 pa2, bf16x8 pa3) {
    const s16x4 l0 = tr_read<KOFF + v_rd_off(D0, 0, 0)>(vb), h0 = tr_read<KOFF + v_rd_off(D0, 0, 1)>(vb), l1 = tr_read<KOFF + v_rd_off(D0, 1, 0)>(vb), h1 = tr_read<KOFF + v_rd_off(D0, 1, 1)>(vb);
    const s16x4 l2 = tr_read<KOFF + v_rd_off(D0, 2, 0)>(vb), h2 = tr_read<KOFF + v_rd_off(D0, 2, 1)>(vb), l3 = tr_read<KOFF + v_rd_off(D0, 3, 0)>(vb), h3 = tr_read<KOFF + v_rd_off(D0, 3, 1)>(vb);
    asm volatile("s_waitcnt lgkmcnt(0)" ::: "memory"); SBAR();
    od = __builtin_amdgcn_mfma_f32_32x32x16_bf16(pa0, PKV(l0, h0), od, 0, 0, 0);
    od = __builtin_amdgcn_mfma_f32_32x32x16_bf16(pa1, PKV(l1, h1), od, 0, 0, 0);
    od = __builtin_amdgcn_mfma_f32_32x32x16_bf16(pa2, PKV(l2, h2), od, 0, 0, 0);
    od = __builtin_amdgcn_mfma_f32_32x32x16_bf16(pa3, PKV(l3, h3), od, 0, 0, 0);
}
template <int D0, int KOFF> __device__ __forceinline__ void pv_half(f32x16& od, int vb, bf16x8 pa0, bf16x8 pa1) {
    const s16x4 l0 = tr_read<KOFF + v_rd_off(D0, 0, 0)>(vb), h0 = tr_read<KOFF + v_rd_off(D0, 0, 1)>(vb), l1 = tr_read<KOFF + v_rd_off(D0, 1, 0)>(vb), h1 = tr_read<KOFF + v_rd_off(D0, 1, 1)>(vb);
    asm volatile("s_waitcnt lgkmcnt(0)" ::: "memory"); SBAR();
    od = __builtin_amdgcn_mfma_f32_32x32x16_bf16(pa0, PKV(l0, h0), od, 0, 0, 0);
    od = __builtin_amdgcn_mfma_f32_32x32x16_bf16(pa1, PKV(l1, h1), od, 0, 0, 0);
}
template <class RowOff> __device__ __forceinline__ void store_o_tile(const f32x16 (&o)[2], const float (&rli)[16], unsigned short* stg, unsigned short* dst, RowOff row_off, int lane) {
    const int r32 = lane & 31, hi = lane >> 5;
#pragma unroll
    for (int r = 0; r < 16; ++r) { const int orow = crow(r, hi);
#pragma unroll
        for (int d0 = 0; d0 < 2; ++d0) stg[orow * 64 + d0 * 32 + r32] = (unsigned short)(cvtpk(o[d0][r] * rli[r], 0.f) & 0xffffu); }
    asm volatile("s_waitcnt lgkmcnt(0)" ::: "memory");
#pragma unroll
    for (int i = 0; i < 4; ++i) { const int row = i * 8 + (lane >> 3), ch = lane & 7; const u32x4 v = *(const u32x4*)(stg + row * 64 + ch * 8); *(u32x4*)(dst + row_off(row) + ch * 8) = v; }
    asm volatile("s_waitcnt lgkmcnt(0)" ::: "memory");
}

__device__ __forceinline__ bool wg_or(bool pred, unsigned* flags8, int wid, int lane) {
    const bool w = __any(pred); if (lane == 0) flags8[wid] = w ? 1u : 0u;
    __syncthreads();
    unsigned r = 0u;
#pragma unroll
    for (int i = 0; i < 8; ++i) r |= flags8[i];
    __syncthreads();
    return r != 0u;
}
constexpr int SHM_V = 8192, SHM_K = 16384, MLA_WS = 2 * SHM_V + 2 * SHM_K, MLA_OST = MLA_WS + 8 * 256;
#define KSWZ(row, colB) ((row) * 256 + ((colB) ^ (((row) & 15) << 4)))
__device__ __forceinline__ void qkt96(f32x16& p0, f32x16& p1, const char* Ks, const bf16x8* qr, int r32, int hi) {
    p0 = f32x16{}; p1 = f32x16{};
#pragma unroll
    for (int d0 = 0; d0 < 6; ++d0) { const int cb = (d0 * 16 + hi * 8) * 2;
        const bf16x8 b0 = *reinterpret_cast<const bf16x8*>(Ks + KSWZ(r32, cb));
        const bf16x8 b1 = *reinterpret_cast<const bf16x8*>(Ks + KSWZ(32 + r32, cb));
        p0 = __builtin_amdgcn_mfma_f32_32x32x16_bf16(b0, qr[d0], p0, 0, 0, 0);
        p1 = __builtin_amdgcn_mfma_f32_32x32x16_bf16(b1, qr[d0], p1, 0, 0, 0); }
}
__device__ __forceinline__ void pv64(f32x16* o, int vb, bf16x8 pa0, bf16x8 pa1, bf16x8 pa2, bf16x8 pa3) {
    pv_one<0, 0>(o[0], vb, pa0, pa1, pa2, pa3); pv_one<1, 0>(o[1], vb, pa0, pa1, pa2, pa3);
}
__device__ __forceinline__ void mla_unit(int wv, int bh, int qb, const unsigned short* __restrict__ Q, const unsigned short* __restrict__ KN, const unsigned short* __restrict__ KR,
                                         const unsigned short* __restrict__ V, unsigned short* __restrict__ CAT, char* lds) {
    const int wid = wv, lane = gm::lane_now(), tid = wid * 64 + lane, r32 = lane & 31, hi = lane >> 5;
    const int b = bh >> 3, h = bh & 7;
    char* V_lds = lds; char* K_lds = lds + 2 * SHM_V;
    float* wsf = (float*)(lds + MLA_WS) + wid * 64; float* li_l = wsf; float* al_l = wsf + 32;
    float m_reg = -1e30f, l_reg = 0; f32x16 o[2] = {}; bf16x8 qr[6];
    const size_t bhS = (size_t)bh * S; const int q0 = qb * 256;
    const unsigned short* Qw = Q + (bhS + q0 + wid * 32 + r32) * 96 + hi * 8;
#pragma unroll
    for (int d0 = 0; d0 < 6; ++d0) qr[d0] = *reinterpret_cast<const bf16x8*>(Qw + d0 * 16);
    const int srow = tid >> 3, sch = tid & 7, rrow = (tid & 255) >> 2, rch = tid & 3;
    const unsigned short* kn_src = KN + (bhS + srow) * 64 + sch * 8;
    const unsigned short* v_src = V + (bhS + srow) * 64 + sch * 8;
    const unsigned short* kr_src = KR + ((size_t)b * S + rrow) * 32 + rch * 8;
    const int kst = KSWZ(srow, sch * 16), krst = KSWZ(rrow, (8 + rch) * 16), vst = v_st(srow, sch * 8);
    const int vb0 = (int)(uintptr_t)V_lds + v_rd_base(lane);
    bf16x8 s_kn[2], s_kr[2], s_v[2];
#define SLOAD(i, k0) do { s_kn[i] = *reinterpret_cast<const bf16x8*>(kn_src + (size_t)(k0) * 64); s_kr[i] = *reinterpret_cast<const bf16x8*>(kr_src + (size_t)(k0) * 32); \
    s_v[i] = *reinterpret_cast<const bf16x8*>(v_src + (size_t)(k0) * 64); } while (0)
#define SWRITE(bb, i) do { *(bf16x8*)(K_lds + (bb) * SHM_K + kst) = s_kn[i]; if (tid < 256) *(bf16x8*)(K_lds + (bb) * SHM_K + krst) = s_kr[i]; *(bf16x8*)(V_lds + (bb) * SHM_V + vst) = s_v[i]; } while (0)
#define SWAIT() asm volatile("s_waitcnt vmcnt(3)" ::: "memory")
#define RESC(a) do { if (__any((a) < 1.f)) { if (hi == 0) al_l[r32] = (a); asm volatile("s_waitcnt lgkmcnt(0)" ::: "memory"); \
    _Pragma("unroll") for (int d = 0; d < 2; ++d) _Pragma("unroll") for (int r = 0; r < 16; ++r) o[d][r] *= al_l[crow(r, hi)]; } } while (0)
    f32x16 pA0, pA1, pB0, pB1; float mnA, mnB, alA, alB; bf16x8 pa0, pa1, pa2, pa3; constexpr int NT = S / 64;
    SLOAD(0, 0); asm volatile("s_waitcnt vmcnt(0)" ::: "memory"); SWRITE(0, 0); __syncthreads();
    qkt96(pA0, pA1, K_lds, qr, r32, hi); partialSM(pA0, pA1, m_reg, mnA, alA);
    SLOAD(1, 64); SLOAD(0, 128);
    SWAIT(); SWRITE(1, 1); __syncthreads();
    for (int j = 1; j + 1 < NT; j += 2) {
        SBAR(); qkt96(pB0, pB1, K_lds + SHM_K, qr, r32, hi);
        finishSM(pA0, pA1, alA, l_reg, pa0, pa1, pa2, pa3); SBAR();
        SLOAD(1, (j + 2) * 64); SBAR();
        pv64(o, vb0, pa0, pa1, pa2, pa3); partialSM(pB0, pB1, m_reg, mnB, alB);
        __syncthreads(); SWAIT(); SWRITE(0, 0);
        RESC(alB); __syncthreads();
        SBAR(); qkt96(pA0, pA1, K_lds, qr, r32, hi);
        finishSM(pB0, pB1, alB, l_reg, pa0, pa1, pa2, pa3); SBAR();
        if (j + 3 < NT) SLOAD(0, (j + 3) * 64); SBAR();
        pv64(o, vb0 + SHM_V, pa0, pa1, pa2, pa3); partialSM(pA0, pA1, m_reg, mnA, alA);
        __syncthreads(); SWAIT(); SWRITE(1, 1);
        RESC(alA); __syncthreads();
    }
    SBAR(); qkt96(pB0, pB1, K_lds + SHM_K, qr, r32, hi);
    finishSM(pA0, pA1, alA, l_reg, pa0, pa1, pa2, pa3); SBAR();
    pv64(o, vb0, pa0, pa1, pa2, pa3); partialSM(pB0, pB1, m_reg, mnB, alB);
    __syncthreads(); RESC(alB);
    finishSM(pB0, pB1, alB, l_reg, pa0, pa1, pa2, pa3); SBAR();
    pv64(o, vb0 + SHM_V, pa0, pa1, pa2, pa3);
    if (hi == 0) li_l[r32] = l_reg; asm volatile("s_waitcnt lgkmcnt(0)" ::: "memory");
    float rli[16];
#pragma unroll
    for (int r = 0; r < 16; ++r) rli[r] = __builtin_amdgcn_rcpf(li_l[crow(r, hi)]);
    unsigned short* stg = (unsigned short*)(lds + MLA_OST) + wid * 2048;
    unsigned short* dst = CAT + ((size_t)b * S + q0 + wid * 32) * 1024 + h * 64;
    store_o_tile(o, rli, stg, dst, [](int row) { return (size_t)row * 1024; }, lane);
    asm volatile("s_waitcnt vmcnt(0)" ::: "memory");
    __syncthreads();
#undef SLOAD
#undef SWRITE
#undef SWAIT
#undef RESC
}


#ifndef MLA_ALIGN
#define MLA_ALIGN 1
#define MLA_ALIGN_STR "8"
#endif
#ifndef V9_STATIC_THR
#define V9_STATIC_THR 100.f
#endif
#ifndef V9_FALLBACK
#define V9_FALLBACK 1
#endif
#define V9_EXACT (V9_FALLBACK ? 0 : V7_EXACT)
#ifndef DIL2_SKIPMASK
#define DIL2_SKIPMASK 1
#endif
#ifndef DIL2_PRIO
#define DIL2_PRIO 1
#endif
#ifndef V9_DMA_LATE
#define V9_DMA_LATE 0
#endif
#ifndef V9_KASM
#define V9_KASM 1
#endif
#ifndef V9_KB_EARLY
#define V9_KB_EARLY 0
#endif
#ifndef V9_SPLIT_PRIO
#define V9_SPLIT_PRIO 0
#endif
#ifndef V7_YOUNG_PRIO
#define V7_YOUNG_PRIO 1
#endif
#ifndef V7_EXACT
#define V7_EXACT 1
#endif
#ifndef MLA_STAMP
#define MLA_STAMP 0
#endif
#ifndef MLA_STAMP_WAVE
#define MLA_STAMP_WAVE 5
#endif
#if MLA_STAMP
#define STAMP_T(var) do { __builtin_amdgcn_sched_barrier(0); asm volatile("s_memtime %0\n\ts_waitcnt lgkmcnt(0)" : "=s"(var) :: "memory"); __builtin_amdgcn_sched_barrier(0); } while (0)
#define STAMP_ACC(i, t0_, t1_) (st_acc[i] += (t1_) - (t0_))
#else
#define STAMP_T(var) do { } while (0)
#define STAMP_ACC(i, t0_, t1_) do { } while (0)
#endif
#ifndef STAMP_SEC
#define STAMP_SEC 4
#endif
#if MLA_STAMP
#define SEC_B(i) do { if ((i) == STAMP_SEC) STAMP_T(tq0); } while (0)
#define SEC_E(i) do { if ((i) == STAMP_SEC) { STAMP_T(tq1); st_a += tq1 - tq0; } } while (0)
#else
#define SEC_B(i) do { } while (0)
#define SEC_E(i) do { } while (0)
#endif
constexpr int M2_K = 0, M2_V = 3 * SHM_K, M2_WS = M2_V + 3 * SHM_V, M2_OST = M2_WS + 8 * 256;
#ifndef MLA_PROBE_NOSTAGE
#define MLA_PROBE_NOSTAGE 0
#endif
#ifndef MLA_STATIC
#define MLA_STATIC 1
#endif
#ifndef MLA_STATIC_THR
#define MLA_STATIC_THR 60.f
#endif
#ifndef MLA_STEP_MODE
#define MLA_STEP_MODE 0
#endif
#ifndef MLA_PROBE_VALU
#define MLA_PROBE_VALU 0
#endif
#ifndef MLA_NEGM
#define MLA_NEGM 1
#endif
#ifndef MLA_PRIO
#define MLA_PRIO 0
#endif
__device__ __forceinline__ void qkt96n(f32x16& p0, f32x16& p1, const char* Ks, const bf16x8* qr, const f32x16& negm, int r32, int hi, bool usec = true) {
    if (MLA_PRIO) __builtin_amdgcn_s_setprio(1);
#pragma unroll
    for (int d0 = 0; d0 < 6; ++d0) { const int cb = (d0 * 16 + hi * 8) * 2;
        const bf16x8 b0 = *reinterpret_cast<const bf16x8*>(Ks + KSWZ(r32, cb));
        const bf16x8 b1 = *reinterpret_cast<const bf16x8*>(Ks + KSWZ(32 + r32, cb));
        if (d0 == 0 && !usec) { p0 = __builtin_amdgcn_mfma_f32_32x32x16_bf16(b0, qr[0], f32x16{}, 0, 0, 0); p1 = __builtin_amdgcn_mfma_f32_32x32x16_bf16(b1, qr[0], f32x16{}, 0, 0, 0); }
        else if (d0 == 0) { p0 = __builtin_amdgcn_mfma_f32_32x32x16_bf16(b0, qr[0], MLA_NEGM ? negm : f32x16{}, 0, 0, 0); p1 = __builtin_amdgcn_mfma_f32_32x32x16_bf16(b1, qr[0], MLA_NEGM ? negm : f32x16{}, 0, 0, 0); }
        else { p0 = __builtin_amdgcn_mfma_f32_32x32x16_bf16(b0, qr[d0], p0, 0, 0, 0); p1 = __builtin_amdgcn_mfma_f32_32x32x16_bf16(b1, qr[d0], p1, 0, 0, 0); } }
    if (MLA_PRIO) __builtin_amdgcn_s_setprio(0);
}
__device__ __forceinline__ void qkt96z(f32x16& p0, f32x16& p1, const char* Ks, const bf16x8* qr, int r32, int hi) {
#pragma unroll
    for (int d0 = 0; d0 < 6; ++d0) { const int cb = (d0 * 16 + hi * 8) * 2;
        const bf16x8 b0 = *reinterpret_cast<const bf16x8*>(Ks + KSWZ(r32, cb));
        const bf16x8 b1 = *reinterpret_cast<const bf16x8*>(Ks + KSWZ(32 + r32, cb));
        if (d0 == 0) { p0 = __builtin_amdgcn_mfma_f32_32x32x16_bf16(b0, qr[0], f32x16{}, 0, 0, 0); p1 = __builtin_amdgcn_mfma_f32_32x32x16_bf16(b1, qr[0], f32x16{}, 0, 0, 0); }
        else { p0 = __builtin_amdgcn_mfma_f32_32x32x16_bf16(b0, qr[d0], p0, 0, 0, 0); p1 = __builtin_amdgcn_mfma_f32_32x32x16_bf16(b1, qr[d0], p1, 0, 0, 0); } }
}
__device__ __forceinline__ float rowmax32b(const f32x16& p0, const f32x16& p1) {
    float a = fmaxf(fmaxf(p0[0], p0[1]), p1[0]), b = fmaxf(fmaxf(p0[2], p0[3]), p1[1]); a = fmaxf(fmaxf(a, p1[2]), p1[3]);
#pragma unroll
    for (int r = 4; r < 16; r += 4) { a = fmaxf(fmaxf(a, p0[r]), p0[r + 1]); b = fmaxf(fmaxf(b, p0[r + 2]), p0[r + 3]); a = fmaxf(fmaxf(a, p1[r]), p1[r + 1]); b = fmaxf(fmaxf(b, p1[r + 2]), p1[r + 3]); }
    const float m = fmaxf(a, b);
    auto rr = __builtin_amdgcn_permlane32_swap(__float_as_uint(m), __float_as_uint(m), false, false);
    return fmaxf(__uint_as_float(rr[0]), __uint_as_float(rr[1]));
}
template <bool FIRST> __device__ __forceinline__ void partialSM2(f32x16& p0, f32x16& p1, float& m_reg, f32x16& negm, float& alpha, bool exact = true) {
    if (!exact) { alpha = 1.f;
#pragma unroll
        for (int r = 0; r < 16; ++r) p0[r] = __builtin_amdgcn_exp2f(p0[r]);
        return; }
    if (MLA_PROBE_VALU) { float d0_ = p1[0], d1_ = p1[1], d2_ = p1[2], d3_ = p1[3];
#pragma unroll
        for (int i = 0; i < 8; ++i) { d0_ = __builtin_amdgcn_exp2f(d0_); d1_ = __builtin_amdgcn_exp2f(d1_); d2_ = __builtin_amdgcn_exp2f(d2_); d3_ = __builtin_amdgcn_exp2f(d3_); }
        asm volatile("" :: "v"(d0_), "v"(d1_), "v"(d2_), "v"(d3_)); }
    if (!MLA_NEGM) {
        const float pm = rowmax32b(p0, p1); alpha = 1.f;
        if (FIRST) m_reg = pm; else if (!__builtin_expect(__all(pm - m_reg <= THR), 1)) { const float mn = fmaxf(m_reg, pm); alpha = __builtin_amdgcn_exp2f(m_reg - mn); m_reg = mn; }
#pragma unroll
        for (int r = 0; r < 16; ++r) { p0[r] -= m_reg; p1[r] -= m_reg; }
#pragma unroll
        for (int r = 0; r < 16; ++r) p0[r] = __builtin_amdgcn_exp2f(p0[r]);
        return; }
    const float pmax = rowmax32b(p0, p1);
    alpha = 1.f;
    if (FIRST || !__builtin_expect(__all(pmax <= THR), 1)) {
        const float dl = FIRST ? pmax : fmaxf(pmax, 0.f); m_reg += dl;
#pragma unroll
        for (int r = 0; r < 16; ++r) { p0[r] -= dl; p1[r] -= dl; }
#pragma unroll
        for (int r = 0; r < 16; ++r) negm[r] = -m_reg;
        if (!FIRST) alpha = __builtin_amdgcn_exp2f(-dl);
    }
#pragma unroll
    for (int r = 0; r < 16; ++r) p0[r] = __builtin_amdgcn_exp2f(p0[r]);
}
template <int D0> __device__ __forceinline__ void pv_one_p(f32x16& od, int vb, bf16x8 pa0, bf16x8 pa1, bf16x8 pa2, bf16x8 pa3) {
    const s16x4 l0 = tr_read<v_rd_off(D0, 0, 0)>(vb), h0 = tr_read<v_rd_off(D0, 0, 1)>(vb), l1 = tr_read<v_rd_off(D0, 1, 0)>(vb), h1 = tr_read<v_rd_off(D0, 1, 1)>(vb);
    const s16x4 l2 = tr_read<v_rd_off(D0, 2, 0)>(vb), h2 = tr_read<v_rd_off(D0, 2, 1)>(vb), l3 = tr_read<v_rd_off(D0, 3, 0)>(vb), h3 = tr_read<v_rd_off(D0, 3, 1)>(vb);
    asm volatile("s_waitcnt lgkmcnt(0)" ::: "memory"); SBAR();
    if (MLA_PRIO) __builtin_amdgcn_s_setprio(1);
    od = __builtin_amdgcn_mfma_f32_32x32x16_bf16(pa0, PKV(l0, h0), od, 0, 0, 0);
    od = __builtin_amdgcn_mfma_f32_32x32x16_bf16(pa1, PKV(l1, h1), od, 0, 0, 0);
    od = __builtin_amdgcn_mfma_f32_32x32x16_bf16(pa2, PKV(l2, h2), od, 0, 0, 0);
    od = __builtin_amdgcn_mfma_f32_32x32x16_bf16(pa3, PKV(l3, h3), od, 0, 0, 0);
    if (MLA_PRIO) __builtin_amdgcn_s_setprio(0);
}

__device__ __forceinline__ void kfrag_load(bf16x8 (&kf)[12], const char* Ks, int r32, int hi) {
#pragma unroll
    for (int d0 = 0; d0 < 6; ++d0) { const int cb = (d0 * 16 + hi * 8) * 2;
        kf[2 * d0] = *reinterpret_cast<const bf16x8*>(Ks + KSWZ(r32, cb)); kf[2 * d0 + 1] = *reinterpret_cast<const bf16x8*>(Ks + KSWZ(32 + r32, cb)); }
}
__device__ __forceinline__ void qk_mma(f32x16& p0, f32x16& p1, const bf16x8 (&kf)[12], const bf16x8* qr, const f32x16& negm) {
    if (MLA_PRIO) __builtin_amdgcn_s_setprio(1);
    p0 = __builtin_amdgcn_mfma_f32_32x32x16_bf16(kf[0], qr[0], MLA_NEGM ? negm : f32x16{}, 0, 0, 0); p1 = __builtin_amdgcn_mfma_f32_32x32x16_bf16(kf[1], qr[0], MLA_NEGM ? negm : f32x16{}, 0, 0, 0);
#pragma unroll
    for (int d0 = 1; d0 < 6; ++d0) { p0 = __builtin_amdgcn_mfma_f32_32x32x16_bf16(kf[2 * d0], qr[d0], p0, 0, 0, 0); p1 = __builtin_amdgcn_mfma_f32_32x32x16_bf16(kf[2 * d0 + 1], qr[d0], p1, 0, 0, 0); }
    if (MLA_PRIO) __builtin_amdgcn_s_setprio(0);
}
template <int D0> __device__ __forceinline__ void vfrag_load_h(s16x4 (&vl)[4], s16x4 (&vh)[4], int vb) {
    vl[0] = tr_read<v_rd_off(D0, 0, 0)>(vb); vh[0] = tr_read<v_rd_off(D0, 0, 1)>(vb); vl[1] = tr_read<v_rd_off(D0, 1, 0)>(vb); vh[1] = tr_read<v_rd_off(D0, 1, 1)>(vb);
    vl[2] = tr_read<v_rd_off(D0, 2, 0)>(vb); vh[2] = tr_read<v_rd_off(D0, 2, 1)>(vb); vl[3] = tr_read<v_rd_off(D0, 3, 0)>(vb); vh[3] = tr_read<v_rd_off(D0, 3, 1)>(vb);
}
__device__ __forceinline__ void pv_mma_h(f32x16& od, const s16x4 (&vl)[4], const s16x4 (&vh)[4], bf16x8 pa0, bf16x8 pa1, bf16x8 pa2, bf16x8 pa3) {
    if (MLA_PRIO) __builtin_amdgcn_s_setprio(1);
    od = __builtin_amdgcn_mfma_f32_32x32x16_bf16(pa0, PKV(vl[0], vh[0]), od, 0, 0, 0);
    od = __builtin_amdgcn_mfma_f32_32x32x16_bf16(pa1, PKV(vl[1], vh[1]), od, 0, 0, 0);
    od = __builtin_amdgcn_mfma_f32_32x32x16_bf16(pa2, PKV(vl[2], vh[2]), od, 0, 0, 0);
    od = __builtin_amdgcn_mfma_f32_32x32x16_bf16(pa3, PKV(vl[3], vh[3]), od, 0, 0, 0);
    if (MLA_PRIO) __builtin_amdgcn_s_setprio(0);
}
#if MLA_STEP_MODE == 0
#define MLA_STEP(PC0, PC1, PP0, PP1, ALP, ALC) do { \
    STAMP_T(tq0); qkt96n(PC0, PC1, K_lds + sc * SHM_K, qr, negm, r32, hi); STAMP_T(tq1); STAMP_ACC(1, tq0, tq1); \
    finishSM(PP0, PP1, ALP, l_reg, pa0, pa1, pa2, pa3); SBAR(); STAMP_T(tq0); STAMP_ACC(2, tq1, tq0); \
    { const int vb_ = vb0 + sp * SHM_V; pv_one_p<0>(o[0], vb_, pa0, pa1, pa2, pa3); pv_one_p<1>(o[1], vb_, pa0, pa1, pa2, pa3); } STAMP_T(tq1); STAMP_ACC(3, tq0, tq1); \
    partialSM2<false>(PC0, PC1, m_reg, negm, ALC, exact); RESC(ALC); STAMP_T(tq0); STAMP_ACC(4, tq1, tq0); } while (0)
#elif MLA_STEP_MODE == 2
  \
#define SGB(mask, n) __builtin_amdgcn_sched_group_barrier(mask, n, 0)
#define MLA_STEP(PC0, PC1, PP0, PP1, ALP, ALC) do { \
    { const char* Ks_ = K_lds + sc * SHM_K; \
      _Pragma("unroll") for (int d0 = 0; d0 < 6; ++d0) { const int cb = (d0 * 16 + hi * 8) * 2; \
        const bf16x8 b0 = *reinterpret_cast<const bf16x8*>(Ks_ + KSWZ(r32, cb)); const bf16x8 b1 = *reinterpret_cast<const bf16x8*>(Ks_ + KSWZ(32 + r32, cb)); \
        if (d0 == 0) { PC0 = __builtin_amdgcn_mfma_f32_32x32x16_bf16(b0, qr[0], negm, 0, 0, 0); PC1 = __builtin_amdgcn_mfma_f32_32x32x16_bf16(b1, qr[0], negm, 0, 0, 0); } \
        else { PC0 = __builtin_amdgcn_mfma_f32_32x32x16_bf16(b0, qr[d0], PC0, 0, 0, 0); PC1 = __builtin_amdgcn_mfma_f32_32x32x16_bf16(b1, qr[d0], PC1, 0, 0, 0); } } } \
    finishSM(PP0, PP1, ALP, l_reg, pa0, pa1, pa2, pa3); \
    SGB(0x100, 4); \
    _Pragma("unroll") for (int g_ = 0; g_ < 12; ++g_) { SGB(0x008, 1); SGB(0x100, 1); SGB(0x002, 7); } \
    SBAR(); \
    { const int vb_ = vb0 + sp * SHM_V; \
      const s16x4 l0 = tr_read<v_rd_off(0, 0, 0)>(vb_), h0 = tr_read<v_rd_off(0, 0, 1)>(vb_), l1 = tr_read<v_rd_off(0, 1, 0)>(vb_), h1 = tr_read<v_rd_off(0, 1, 1)>(vb_); \
      const s16x4 l2 = tr_read<v_rd_off(0, 2, 0)>(vb_), h2 = tr_read<v_rd_off(0, 2, 1)>(vb_), l3 = tr_read<v_rd_off(0, 3, 0)>(vb_), h3 = tr_read<v_rd_off(0, 3, 1)>(vb_); \
      const s16x4 l4 = tr_read<v_rd_off(1, 0, 0)>(vb_), h4 = tr_read<v_rd_off(1, 0, 1)>(vb_), l5 = tr_read<v_rd_off(1, 1, 0)>(vb_), h5 = tr_read<v_rd_off(1, 1, 1)>(vb_); \
      const s16x4 l6 = tr_read<v_rd_off(1, 2, 0)>(vb_), h6 = tr_read<v_rd_off(1, 2, 1)>(vb_), l7 = tr_read<v_rd_off(1, 3, 0)>(vb_), h7 = tr_read<v_rd_off(1, 3, 1)>(vb_); \
      asm volatile("s_waitcnt lgkmcnt(0)" ::: "memory"); SBAR(); \
      o[0] = __builtin_amdgcn_mfma_f32_32x32x16_bf16(pa0, PKV(l0, h0), o[0], 0, 0, 0); o[1] = __builtin_amdgcn_mfma_f32_32x32x16_bf16(pa0, PKV(l4, h4), o[1], 0, 0, 0); \
      o[0] = __builtin_amdgcn_mfma_f32_32x32x16_bf16(pa1, PKV(l1, h1), o[0], 0, 0, 0); o[1] = __builtin_amdgcn_mfma_f32_32x32x16_bf16(pa1, PKV(l5, h5), o[1], 0, 0, 0); \
      o[0] = __builtin_amdgcn_mfma_f32_32x32x16_bf16(pa2, PKV(l2, h2), o[0], 0, 0, 0); o[1] = __builtin_amdgcn_mfma_f32_32x32x16_bf16(pa2, PKV(l6, h6), o[1], 0, 0, 0); \
      o[0] = __builtin_amdgcn_mfma_f32_32x32x16_bf16(pa3, PKV(l3, h3), o[0], 0, 0, 0); o[1] = __builtin_amdgcn_mfma_f32_32x32x16_bf16(pa3, PKV(l7, h7), o[1], 0, 0, 0); \
      partialSM2<false>(PC0, PC1, m_reg, negm, ALC, exact); \
      _Pragma("unroll") for (int g_ = 0; g_ < 8; ++g_) { SGB(0x008, 1); SGB(0x002, 2); } \
      SBAR(); } \
    RESC(ALC); } while (0)
#else
#define KFH(dst, Ks_, D0) do { _Pragma("unroll") for (int d_ = 0; d_ < 3; ++d_) { const int cb_ = (((D0) + d_) * 16 + hi * 8) * 2; \
        dst[2 * d_] = *reinterpret_cast<const bf16x8*>((Ks_) + KSWZ(r32, cb_)); dst[2 * d_ + 1] = *reinterpret_cast<const bf16x8*>((Ks_) + KSWZ(32 + r32, cb_)); } } while (0)
#define MLA_STEP(PC0, PC1, PP0, PP1, ALP, ALC) do { \
    bf16x8 ka[6], kb[6]; s16x4 val[4], vah[4], vbl[4], vbh[4]; const int vb_ = vb0 + sp * SHM_V; const char* Ks_ = K_lds + sc * SHM_K; \
    KFH(ka, Ks_, 0); SBAR(); \
    finishSM(PP0, PP1, ALP, l_reg, pa0, pa1, pa2, pa3); SBAR(); \
    KFH(kb, Ks_, 3); SBAR(); \
    if (exact) { PC0 = __builtin_amdgcn_mfma_f32_32x32x16_bf16(ka[0], qr[0], negm, 0, 0, 0); PC1 = __builtin_amdgcn_mfma_f32_32x32x16_bf16(ka[1], qr[0], negm, 0, 0, 0); } \
    else { PC0 = __builtin_amdgcn_mfma_f32_32x32x16_bf16(ka[0], qr[0], negm, 0, 0, 0); PC1 = __builtin_amdgcn_mfma_f32_32x32x16_bf16(ka[1], qr[0], negm, 0, 0, 0); } \
    PC0 = __builtin_amdgcn_mfma_f32_32x32x16_bf16(ka[2], qr[1], PC0, 0, 0, 0); PC1 = __builtin_amdgcn_mfma_f32_32x32x16_bf16(ka[3], qr[1], PC1, 0, 0, 0); \
    PC0 = __builtin_amdgcn_mfma_f32_32x32x16_bf16(ka[4], qr[2], PC0, 0, 0, 0); PC1 = __builtin_amdgcn_mfma_f32_32x32x16_bf16(ka[5], qr[2], PC1, 0, 0, 0); SBAR(); \
    vfrag_load_h<0>(val, vah, vb_); SBAR(); \
    PC0 = __builtin_amdgcn_mfma_f32_32x32x16_bf16(kb[0], qr[3], PC0, 0, 0, 0); PC1 = __builtin_amdgcn_mfma_f32_32x32x16_bf16(kb[1], qr[3], PC1, 0, 0, 0); \
    PC0 = __builtin_amdgcn_mfma_f32_32x32x16_bf16(kb[2], qr[4], PC0, 0, 0, 0); PC1 = __builtin_amdgcn_mfma_f32_32x32x16_bf16(kb[3], qr[4], PC1, 0, 0, 0); \
    PC0 = __builtin_amdgcn_mfma_f32_32x32x16_bf16(kb[4], qr[5], PC0, 0, 0, 0); PC1 = __builtin_amdgcn_mfma_f32_32x32x16_bf16(kb[5], qr[5], PC1, 0, 0, 0); SBAR(); \
    vfrag_load_h<1>(vbl, vbh, vb_); SBAR(); \
    asm volatile("s_waitcnt lgkmcnt(8)" ::: "memory"); SBAR(); \
    pv_mma_h(o[0], val, vah, pa0, pa1, pa2, pa3); SBAR(); \
    asm volatile("s_waitcnt lgkmcnt(0)" ::: "memory"); SBAR(); \
    pv_mma_h(o[1], vbl, vbh, pa0, pa1, pa2, pa3); SBAR(); \
    partialSM2<false>(PC0, PC1, m_reg, negm, ALC, exact); RESC(ALC); } while (0)
#endif

__device__ __forceinline__ void mla_unit_v2(int wv, int bh, int qb, const unsigned short* __restrict__ Q, const unsigned short* __restrict__ KN, const unsigned short* __restrict__ KR,
                                            const unsigned short* __restrict__ V, unsigned short* __restrict__ CAT, const float* __restrict__ KMX, char* lds, unsigned long long* STAMPS = nullptr) {
    const int wid = wv, lane = gm::lane_now(), tid = wid * 64 + lane, r32 = lane & 31, hi = lane >> 5;
    const int b = bh >> 3, h = bh & 7;
    char* K_lds = lds + M2_K; char* V_lds = lds + M2_V;
    float* wsf = (float*)(lds + M2_WS) + wid * 64; float* li_l = wsf; float* al_l = wsf + 32;
    float m_reg = 0.f, l_reg = 0; f32x16 o[2] = {}; bf16x8 qr[6]; f32x16 negm = f32x16{};
    const size_t bhS = (size_t)bh * S; const int q0 = qb * 256;
    const unsigned short* Qw = Q + (bhS + q0 + wid * 32 + r32) * 96 + hi * 8;
#pragma unroll
    for (int d0 = 0; d0 < 6; ++d0) qr[d0] = *reinterpret_cast<const bf16x8*>(Qw + d0 * 16);
    bool exact = true;
    if (MLA_STATIC) { float q2 = 0.f;
#pragma unroll
      for (int d0 = 0; d0 < 6; ++d0)
#pragma unroll
          for (int j = 0; j < 8; ++j) { const float x = __uint_as_float((unsigned)(unsigned short)qr[d0][j] << 16); q2 += x * x; }
      { auto rr = __builtin_amdgcn_permlane32_swap(__float_as_uint(q2), __float_as_uint(q2), false, false); q2 = __uint_as_float(rr[0]) + __uint_as_float(rr[1]); }
      const float k2 = KMX[(b * 8 + h) * 2] + KMX[(b * 8 + h) * 2 + 1] + KMX[32 + b];
      const float ms = 1.01f * sqrtf(q2 * k2);
      exact = wg_or(!(ms <= MLA_STATIC_THR), (unsigned*)(lds + 147456 - 512), wid, lane);
      if (!exact) { m_reg = ms;
#pragma unroll
          for (int r = 0; r < 16; ++r) negm[r] = -ms; } }
    const int srow = tid >> 3, sch = tid & 7, rrow = (tid & 255) >> 2, rch = tid & 3;
    const char* kn_u = (const char*)(KN + bhS * 64); const char* v_u = (const char*)(V + bhS * 64); const char* kr_u = (const char*)(KR + (size_t)b * S * 32);
    const unsigned kn_off = (unsigned)(srow * 64 + sch * 8) * 2u, kr_off = (unsigned)(rrow * 32 + rch * 8) * 2u;
    const int kst = KSWZ(srow, sch * 16), krst = KSWZ(rrow, (8 + rch) * 16), vst = v_st(srow, sch * 8);
    const int vb0 = (int)(uintptr_t)V_lds + v_rd_base(lane);
    bf16x8 s_kn[1], s_kr[1], s_v[1];
#define SLOAD(i, t) do { s_kn[i] = *reinterpret_cast<const bf16x8*>(kn_u + (size_t)(t) * 8192 + kn_off); s_kr[i] = *reinterpret_cast<const bf16x8*>(kr_u + (size_t)(t) * 4096 + kr_off); \
    s_v[i] = *reinterpret_cast<const bf16x8*>(v_u + (size_t)(t) * 8192 + kn_off); } while (0)
#define SWRITE(sl, i) do { *(bf16x8*)(K_lds + (sl) * SHM_K + kst) = s_kn[i]; if (tid < 256) *(bf16x8*)(K_lds + (sl) * SHM_K + krst) = s_kr[i]; *(bf16x8*)(V_lds + (sl) * SHM_V + vst) = s_v[i]; } while (0)
#define SWAIT() asm volatile("s_waitcnt vmcnt(0)" ::: "memory")
#define RESC(a) do { if (exact && __any((a) < 1.f)) { if (hi == 0) al_l[r32] = (a); asm volatile("s_waitcnt lgkmcnt(0)" ::: "memory"); \
    _Pragma("unroll") for (int d = 0; d < 2; ++d) _Pragma("unroll") for (int r = 0; r < 16; ++r) o[d][r] *= al_l[crow(r, hi)]; } } while (0)
#define ROT3(x) ((x) == 2 ? 0 : (x) + 1)
    f32x16 pA0, pA1, pB0, pB1; float alA, alB; bf16x8 pa0, pa1, pa2, pa3; constexpr int NT = S / 64;
#if MLA_STAMP
    unsigned long long st_acc[8] = {0, 0, 0, 0, 0, 0, 0, 0}, tq0 = 0, tq1 = 0, ts0 = 0, ts1 = 0, tu0 = 0; STAMP_T(tu0);
#endif
    SLOAD(0, 0);
    SWAIT(); SWRITE(0, 0); SLOAD(0, 1);
    __syncthreads();
    qkt96n(pA0, pA1, K_lds, qr, negm, r32, hi); if (exact) partialSM2<true>(pA0, pA1, m_reg, negm, alA); else partialSM2<false>(pA0, pA1, m_reg, negm, alA, false);
    SWAIT(); SWRITE(1, 0); SLOAD(0, 2);
    __syncthreads();
    int sp = 0, sc = 1, sn = 2;
    for (int j = 1; j + 1 < NT; j += 2) {
        if (!MLA_PROBE_NOSTAGE) { SWAIT(); SWRITE(sn, 0); if (j + 2 < NT) SLOAD(0, j + 2); }
        SBAR(); MLA_STEP(pB0, pB1, pA0, pA1, alA, alB);
        __syncthreads();
        sp = sc; sc = sn; sn = ROT3(sn);
        if (!MLA_PROBE_NOSTAGE) { SWAIT(); SWRITE(sn, 0); if (j + 3 < NT) SLOAD(0, j + 3); }
        SBAR(); MLA_STEP(pA0, pA1, pB0, pB1, alB, alA);
        __syncthreads();
        sp = sc; sc = sn; sn = ROT3(sn);
    }
    SBAR(); MLA_STEP(pB0, pB1, pA0, pA1, alA, alB);
    finishSM(pB0, pB1, alB, l_reg, pa0, pa1, pa2, pa3); SBAR();
    { const int vb = vb0 + sc * SHM_V; pv_one_p<0>(o[0], vb, pa0, pa1, pa2, pa3); pv_one_p<1>(o[1], vb, pa0, pa1, pa2, pa3); }
    if (hi == 0) li_l[r32] = l_reg; asm volatile("s_waitcnt lgkmcnt(0)" ::: "memory");
    float rli[16];
#pragma unroll
    for (int r = 0; r < 16; ++r) rli[r] = __builtin_amdgcn_rcpf(li_l[crow(r, hi)]);
    unsigned short* stg = (unsigned short*)(lds + M2_OST) + wid * 2048;
    unsigned short* dst = CAT + ((size_t)b * S + q0 + wid * 32) * 1024 + h * 64;
    store_o_tile(o, rli, stg, dst, [](int row) { return (size_t)row * 1024; }, lane);
    asm volatile("s_waitcnt vmcnt(0)" ::: "memory");
#if MLA_STAMP
    { unsigned long long tu1; STAMP_T(tu1); st_acc[6] = tu1 - tu0;
      if (blockIdx.x == 0 && wid == MLA_STAMP_WAVE && lane == 0 && STAMPS) {
#pragma unroll
          for (int i = 0; i < 8; ++i) STAMPS[i] = st_acc[i]; } }
#endif
    __syncthreads();
#undef SLOAD
#undef SWRITE
#undef SWAIT
#undef RESC
#undef ROT3
}


__device__ __forceinline__ void finishSM_s(f32x16& p0, f32x16& p1, float& l_reg, bf16x8& pa0, bf16x8& pa1, bf16x8& pa2, bf16x8& pa3) {
#pragma unroll
    for (int r = 0; r < 16; ++r) p1[r] = __builtin_amdgcn_exp2f(p1[r]);
    float ps = 0;
#pragma unroll
    for (int r = 0; r < 16; ++r) ps += p0[r];
#pragma unroll
    for (int r = 0; r < 16; ++r) ps += p1[r];
    l_reg += ps;
    PK4(p0, 0, pa0); PK4(p0, 8, pa1); PK4(p1, 0, pa2); PK4(p1, 8, pa3);
}
__device__ __forceinline__ void exp_half(f32x16& p0) {
#pragma unroll
    for (int r = 0; r < 16; ++r) p0[r] = __builtin_amdgcn_exp2f(p0[r]);
}
__device__ __forceinline__ bool mla_unit_v5(int wv, int bh, int qb, const unsigned short* __restrict__ Q, const unsigned short* __restrict__ KN, const unsigned short* __restrict__ KR,
                                            const unsigned short* __restrict__ V, unsigned short* __restrict__ CAT, const float* __restrict__ KMX, char* lds) {
    const int wid = wv, lane = gm::lane_now(), tid = wid * 64 + lane, r32 = lane & 31, hi = lane >> 5;
    const int b = bh >> 3, h = bh & 7;
    char* K_lds = lds + M2_K; char* V_lds = lds + M2_V;
    float* wsf = (float*)(lds + M2_WS) + wid * 64; float* li_l = wsf;
    float l_reg = 0; f32x16 o[2] = {}; bf16x8 qr[6];
    const size_t bhS = (size_t)bh * S; const int q0 = qb * 256;
    const unsigned short* Qw = Q + (bhS + q0 + wid * 32 + r32) * 96 + hi * 8;
#pragma unroll
    for (int d0 = 0; d0 < 6; ++d0) qr[d0] = *reinterpret_cast<const bf16x8*>(Qw + d0 * 16);
    f32x16 negm;
    { float q2 = 0.f;
#pragma unroll
      for (int d0 = 0; d0 < 6; ++d0)
#pragma unroll
          for (int j = 0; j < 8; ++j) { const float x = __uint_as_float((unsigned)(unsigned short)qr[d0][j] << 16); q2 += x * x; }
      { auto rr = __builtin_amdgcn_permlane32_swap(__float_as_uint(q2), __float_as_uint(q2), false, false); q2 = __uint_as_float(rr[0]) + __uint_as_float(rr[1]); }
      const float k2 = KMX[(b * 8 + h) * 2] + KMX[(b * 8 + h) * 2 + 1] + KMX[32 + b];
      const float m = 1.01f * sqrtf(q2 * k2);
#pragma unroll
      for (int r = 0; r < 16; ++r) negm[r] = -m; }
    const int srow = tid >> 3, sch = tid & 7, rrow = (tid & 255) >> 2, rch = tid & 3;
    const char* kn_u = (const char*)(KN + bhS * 64); const char* v_u = (const char*)(V + bhS * 64); const char* kr_u = (const char*)(KR + (size_t)b * S * 32);
    const unsigned kn_off = (unsigned)(srow * 64 + sch * 8) * 2u, kr_off = (unsigned)(rrow * 32 + rch * 8) * 2u;
    const int kst = KSWZ(srow, sch * 16), krst = KSWZ(rrow, (8 + rch) * 16), vst = v_st(srow, sch * 8);
    const int vb0 = (int)(uintptr_t)V_lds + v_rd_base(lane);
    bf16x8 s_kn, s_kr, s_v;
#define SLOAD(t) do { s_kn = *reinterpret_cast<const bf16x8*>(kn_u + (size_t)(t) * 8192 + kn_off); s_kr = *reinterpret_cast<const bf16x8*>(kr_u + (size_t)(t) * 4096 + kr_off); \
    s_v = *reinterpret_cast<const bf16x8*>(v_u + (size_t)(t) * 8192 + kn_off); } while (0)
#define SWRITE(sl) do { *(bf16x8*)(K_lds + (sl) * SHM_K + kst) = s_kn; if (tid < 256) *(bf16x8*)(K_lds + (sl) * SHM_K + krst) = s_kr; *(bf16x8*)(V_lds + (sl) * SHM_V + vst) = s_v; } while (0)
#define SWAIT() asm volatile("s_waitcnt vmcnt(0)" ::: "memory")
#define ROT3(x) ((x) == 2 ? 0 : (x) + 1)
#define STEP5(PC0, PC1, PP0, PP1) do { \
    qkt96n(PC0, PC1, K_lds + sc * SHM_K, qr, negm, r32, hi); \
    finishSM_s(PP0, PP1, l_reg, pa0, pa1, pa2, pa3); SBAR(); \
    { const int vb_ = vb0 + sp * SHM_V; pv_one_p<0>(o[0], vb_, pa0, pa1, pa2, pa3); pv_one_p<1>(o[1], vb_, pa0, pa1, pa2, pa3); } \
    exp_half(PC0); } while (0)
    f32x16 pA0, pA1, pB0, pB1; bf16x8 pa0, pa1, pa2, pa3; constexpr int NT = S / 64;
    SLOAD(0);
    SWAIT(); SWRITE(0); SLOAD(1);
    __syncthreads();
    qkt96n(pA0, pA1, K_lds, qr, negm, r32, hi); exp_half(pA0);
    SWAIT(); SWRITE(1); SLOAD(2);
    __syncthreads();
    int sp = 0, sc = 1, sn = 2;
    for (int j = 1; j + 1 < NT; j += 2) {
        SWAIT(); SWRITE(sn); if (j + 2 < NT) SLOAD(j + 2);
        SBAR(); STEP5(pB0, pB1, pA0, pA1);
        __syncthreads();
        sp = sc; sc = sn; sn = ROT3(sn);
        SWAIT(); SWRITE(sn); if (j + 3 < NT) SLOAD(j + 3);
        SBAR(); STEP5(pA0, pA1, pB0, pB1);
        __syncthreads();
        sp = sc; sc = sn; sn = ROT3(sn);
    }
    SBAR(); STEP5(pB0, pB1, pA0, pA1);
    finishSM_s(pB0, pB1, l_reg, pa0, pa1, pa2, pa3); SBAR();
    { const int vb = vb0 + sc * SHM_V; pv_one_p<0>(o[0], vb, pa0, pa1, pa2, pa3); pv_one_p<1>(o[1], vb, pa0, pa1, pa2, pa3); }
    { auto rr = __builtin_amdgcn_permlane32_swap(__float_as_uint(l_reg), __float_as_uint(l_reg), false, false); l_reg = __uint_as_float(rr[0]) + __uint_as_float(rr[1]); }
    const bool bad = !(l_reg > 1e-30f);
    if (hi == 0) li_l[r32] = l_reg; asm volatile("s_waitcnt lgkmcnt(0)" ::: "memory");
    float rli[16];
#pragma unroll
    for (int r = 0; r < 16; ++r) rli[r] = __builtin_amdgcn_rcpf(li_l[crow(r, hi)]);
    unsigned short* stg = (unsigned short*)(lds + M2_OST) + wid * 2048;
    unsigned short* dst = CAT + ((size_t)b * S + q0 + wid * 32) * 1024 + h * 64;
    store_o_tile(o, rli, stg, dst, [](int row) { return (size_t)row * 1024; }, lane);
    asm volatile("s_waitcnt vmcnt(0)" ::: "memory");
    const int anybad = wg_or(bad, (unsigned*)(lds + 147456 - 512), wid, lane) ? 1 : 0;
    return anybad != 0;
#undef SLOAD
#undef SWRITE
#undef SWAIT
#undef ROT3
#undef STEP5
}

constexpr int M4_K = 0, M4_V = 4 * SHM_K, M4_WS = M4_V + 4 * SHM_V, M4_OST = M4_WS + 8 * 256;
template <bool FIRST> __device__ __forceinline__ void softmax_full(f32x16& p0, f32x16& p1, float& m_reg, f32x16& negm, float& l_reg, float& alpha, bf16x8& pa0, bf16x8& pa1, bf16x8& pa2, bf16x8& pa3, bool exact) {
    if (exact) partialSM2<FIRST>(p0, p1, m_reg, negm, alpha, true); else partialSM2<false>(p0, p1, m_reg, negm, alpha, false);
    finishSM(p0, p1, alpha, l_reg, pa0, pa1, pa2, pa3);
}
__device__ __forceinline__ void mla_unit_v4(int wv, int bh, int qb, const unsigned short* __restrict__ Q, const unsigned short* __restrict__ KN, const unsigned short* __restrict__ KR,
                                            const unsigned short* __restrict__ V, unsigned short* __restrict__ CAT, const float* __restrict__ KMX, char* lds, unsigned long long* STAMPS = nullptr) {
    const int wid = wv, lane = gm::lane_now(), tid = wid * 64 + lane, r32 = lane & 31, hi = lane >> 5;
    const int b = bh >> 3, h = bh & 7; const bool halfB = wid >= 4;
    char* K_lds = lds + M4_K; char* V_lds = lds + M4_V;
    float* wsf = (float*)(lds + M4_WS) + wid * 64; float* li_l = wsf; float* al_l = wsf + 32;
    float m_reg = 0.f, l_reg = 0; f32x16 o[2] = {}; bf16x8 qr[6]; f32x16 negm = f32x16{};
    const size_t bhS = (size_t)bh * S; const int q0 = qb * 256;
    const unsigned short* Qw = Q + (bhS + q0 + wid * 32 + r32) * 96 + hi * 8;
#pragma unroll
    for (int d0 = 0; d0 < 6; ++d0) qr[d0] = *reinterpret_cast<const bf16x8*>(Qw + d0 * 16);
    bool exact = true;
    if (MLA_STATIC) { float q2 = 0.f;
#pragma unroll
      for (int d0 = 0; d0 < 6; ++d0)
#pragma unroll
          for (int j = 0; j < 8; ++j) { const float x = __uint_as_float((unsigned)(unsigned short)qr[d0][j] << 16); q2 += x * x; }
      { auto rr = __builtin_amdgcn_permlane32_swap(__float_as_uint(q2), __float_as_uint(q2), false, false); q2 = __uint_as_float(rr[0]) + __uint_as_float(rr[1]); }
      const float k2 = KMX[(b * 8 + h) * 2] + KMX[(b * 8 + h) * 2 + 1] + KMX[32 + b];
      const float ms = 1.01f * sqrtf(q2 * k2);
      exact = wg_or(!(ms <= MLA_STATIC_THR), (unsigned*)(lds + 147456 - 512), wid, lane);
      if (!exact) { m_reg = ms;
#pragma unroll
          for (int r = 0; r < 16; ++r) negm[r] = -ms; } }
    const int srow = tid >> 3, sch = tid & 7, rrow = (tid & 255) >> 2, rch = tid & 3;
    const char* kn_u = (const char*)(KN + bhS * 64); const char* v_u = (const char*)(V + bhS * 64); const char* kr_u = (const char*)(KR + (size_t)b * S * 32);
    const unsigned kn_off = (unsigned)(srow * 64 + sch * 8) * 2u, kr_off = (unsigned)(rrow * 32 + rch * 8) * 2u;
    const int kst = KSWZ(srow, sch * 16), krst = KSWZ(rrow, (8 + rch) * 16), vst = v_st(srow, sch * 8);
    const int vb0 = (int)(uintptr_t)V_lds + v_rd_base(lane);
    bf16x8 s_kn, s_kr, s_v;
#define SLOAD(t) do { s_kn = *reinterpret_cast<const bf16x8*>(kn_u + (size_t)(t) * 8192 + kn_off); s_kr = *reinterpret_cast<const bf16x8*>(kr_u + (size_t)(t) * 4096 + kr_off); \
    s_v = *reinterpret_cast<const bf16x8*>(v_u + (size_t)(t) * 8192 + kn_off); } while (0)
#define SWRITE(sl) do { *(bf16x8*)(K_lds + (sl) * SHM_K + kst) = s_kn; if (tid < 256) *(bf16x8*)(K_lds + (sl) * SHM_K + krst) = s_kr; *(bf16x8*)(V_lds + (sl) * SHM_V + vst) = s_v; } while (0)
#define SWAIT() asm volatile("s_waitcnt vmcnt(0)" ::: "memory")
#define RESC(a) do { if (exact && __any((a) < 1.f)) { if (hi == 0) al_l[r32] = (a); asm volatile("s_waitcnt lgkmcnt(0)" ::: "memory"); \
    _Pragma("unroll") for (int d = 0; d < 2; ++d) _Pragma("unroll") for (int r = 0; r < 16; ++r) o[d][r] *= al_l[crow(r, hi)]; } } while (0)
#define RAWBAR() do { asm volatile("" ::: "memory"); __builtin_amdgcn_s_barrier(); asm volatile("" ::: "memory"); } while (0)
    f32x16 p0, p1; float al; bf16x8 pa0, pa1, pa2, pa3; bf16x8 kf[12]; constexpr int NT = S / 64;
#if MLA_STAMP
    unsigned long long st_acc[8] = {0, 0, 0, 0, 0, 0, 0, 0}, tq0 = 0, tq1 = 0, tu0 = 0; STAMP_T(tu0);
#endif
    SLOAD(0); SWAIT(); SWRITE(0); SLOAD(1); SWAIT(); SWRITE(1); SLOAD(2);
    asm volatile("s_waitcnt lgkmcnt(0)" ::: "memory"); RAWBAR();
    if (halfB) RAWBAR();
    kfrag_load(kf, K_lds, r32, hi); SBAR();
    qk_mma(p0, p1, kf, qr, negm); SBAR();
    asm volatile("s_waitcnt lgkmcnt(0)" ::: "memory"); RAWBAR();
    softmax_full<true>(p0, p1, m_reg, negm, l_reg, al, pa0, pa1, pa2, pa3, exact); SBAR();
    SWAIT(); SWRITE(2); SLOAD(3); SBAR();
    kfrag_load(kf, K_lds + SHM_K, r32, hi); SBAR();
    asm volatile("s_waitcnt lgkmcnt(12)" ::: "memory"); RAWBAR();
    int sp = 0, sc = 1, sw = 3;
    for (int t = 1; t < NT; ++t) {
        STAMP_T(tq0);
        { s16x4 val[4], vah[4], vbl[4], vbh[4]; const int vb_ = vb0 + sp * SHM_V;
          vfrag_load_h<0>(val, vah, vb_); SBAR();
          qk_mma(p0, p1, kf, qr, negm); SBAR();
          vfrag_load_h<1>(vbl, vbh, vb_); SBAR();
          asm volatile("s_waitcnt lgkmcnt(8)" ::: "memory"); SBAR();
          pv_mma_h(o[0], val, vah, pa0, pa1, pa2, pa3); SBAR();
          asm volatile("s_waitcnt lgkmcnt(0)" ::: "memory"); SBAR();
          pv_mma_h(o[1], vbl, vbh, pa0, pa1, pa2, pa3); SBAR(); }
        STAMP_T(tq1); STAMP_ACC(1, tq0, tq1);
        RAWBAR();
        STAMP_T(tq0); STAMP_ACC(2, tq1, tq0);
        if (t + 2 < NT) { SWAIT(); SWRITE(sw); if (t + 3 < NT) SLOAD(t + 3); } SBAR();
        softmax_full<false>(p0, p1, m_reg, negm, l_reg, al, pa0, pa1, pa2, pa3, exact); RESC(al); SBAR();
        sp = sc; sc = (sc + 1) & 3; sw = (sw + 1) & 3;
        if (t + 1 < NT) { kfrag_load(kf, K_lds + sc * SHM_K, r32, hi); SBAR(); }
        STAMP_T(tq1); STAMP_ACC(3, tq0, tq1);
        asm volatile("s_waitcnt lgkmcnt(12)" ::: "memory"); RAWBAR();
        STAMP_T(tq0); STAMP_ACC(4, tq1, tq0);
    }
    { s16x4 val[4], vah[4], vbl[4], vbh[4]; const int vb_ = vb0 + sp * SHM_V;
      vfrag_load_h<0>(val, vah, vb_); vfrag_load_h<1>(vbl, vbh, vb_); SBAR();
      asm volatile("s_waitcnt lgkmcnt(0)" ::: "memory"); SBAR();
      pv_mma_h(o[0], val, vah, pa0, pa1, pa2, pa3); pv_mma_h(o[1], vbl, vbh, pa0, pa1, pa2, pa3); SBAR(); }
    if (!halfB) RAWBAR();
    if (hi == 0) li_l[r32] = l_reg; asm volatile("s_waitcnt lgkmcnt(0)" ::: "memory");
    float rli[16];
#pragma unroll
    for (int r = 0; r < 16; ++r) rli[r] = __builtin_amdgcn_rcpf(li_l[crow(r, hi)]);
    unsigned short* stg = (unsigned short*)(lds + M4_OST) + wid * 2048;
    unsigned short* dst = CAT + ((size_t)b * S + q0 + wid * 32) * 1024 + h * 64;
    store_o_tile(o, rli, stg, dst, [](int row) { return (size_t)row * 1024; }, lane);
    asm volatile("s_waitcnt vmcnt(0)" ::: "memory");
#if MLA_STAMP
    { unsigned long long tu1; STAMP_T(tu1); st_acc[6] = tu1 - tu0;
      if (blockIdx.x == 0 && wid == MLA_STAMP_WAVE && lane == 0 && STAMPS) {
#pragma unroll
          for (int i = 0; i < 8; ++i) STAMPS[i] = st_acc[i]; } }
#endif
    __syncthreads();
#undef SLOAD
#undef SWRITE
#undef SWAIT
#undef RESC
#undef RAWBAR
}


constexpr int M6_K = 0, M6_V = 4 * SHM_K, M6_WS = M6_V + 4 * SHM_V, M6_OST = M6_WS + 8 * 256;
#define KLD3(dst, Ks_, D0) do { _Pragma("unroll") for (int d_ = 0; d_ < 3; ++d_) { const int cb_ = (((D0) + d_) * 16 + hi * 8) * 2; \
        dst[2 * d_] = *reinterpret_cast<const bf16x8*>((Ks_) + KSWZ(r32, cb_)); dst[2 * d_ + 1] = *reinterpret_cast<const bf16x8*>((Ks_) + KSWZ(32 + r32, cb_)); } } while (0)
#define MF32(A, B, C) __builtin_amdgcn_mfma_f32_32x32x16_bf16(A, B, C, 0, 0, 0)
#define QK_ADD(DST, KF, QF, CIN, PPX, B) do { DST = MF32(KF, QF, CIN); s0 += PPX[B]; s1 += PPX[B + 1]; s2 += PPX[B + 2]; s3 += PPX[B + 3]; SBAR(); } while (0)
#define QK_PK(DST, KF, QF, CIN, PPX, B, OUT) do { DST = MF32(KF, QF, CIN); PK4(PPX, B, OUT); SBAR(); } while (0)
__device__ __forceinline__ void mla_unit_v6(int wv, int bh, int qb, const unsigned short* __restrict__ Q, const unsigned short* __restrict__ KN, const unsigned short* __restrict__ KR,
                                            const unsigned short* __restrict__ V, unsigned short* __restrict__ CAT, const float* __restrict__ KMX, char* lds) {
    const int wid = wv, lane = gm::lane_now(), tid = wid * 64 + lane, r32 = lane & 31, hi = lane >> 5;
    const int b = bh >> 3, h = bh & 7; const bool halfB = wid >= 4;
    char* K_lds = lds + M6_K; char* V_lds = lds + M6_V;
    float* wsf = (float*)(lds + M6_WS) + wid * 64; float* li_l = wsf; float* al_l = wsf + 32;
    float m_reg = 0.f, l_reg = 0; f32x16 o[2] = {}; bf16x8 qr[6]; f32x16 negm = f32x16{};
    const size_t bhS = (size_t)bh * S; const int q0 = qb * 256;
    const unsigned short* Qw = Q + (bhS + q0 + wid * 32 + r32) * 96 + hi * 8;
#pragma unroll
    for (int d0 = 0; d0 < 6; ++d0) qr[d0] = *reinterpret_cast<const bf16x8*>(Qw + d0 * 16);
    bool exact = true;
    if (MLA_STATIC) { float q2 = 0.f;
#pragma unroll
      for (int d0 = 0; d0 < 6; ++d0)
#pragma unroll
          for (int j = 0; j < 8; ++j) { const float x = __uint_as_float((unsigned)(unsigned short)qr[d0][j] << 16); q2 += x * x; }
      { auto rr = __builtin_amdgcn_permlane32_swap(__float_as_uint(q2), __float_as_uint(q2), false, false); q2 = __uint_as_float(rr[0]) + __uint_as_float(rr[1]); }
      const float k2 = KMX[(b * 8 + h) * 2] + KMX[(b * 8 + h) * 2 + 1] + KMX[32 + b];
      const float ms = 1.01f * sqrtf(q2 * k2);
      exact = wg_or(!(ms <= MLA_STATIC_THR), (unsigned*)(lds + 147456 - 512), wid, lane);
      if (!exact) { m_reg = ms;
#pragma unroll
          for (int r = 0; r < 16; ++r) negm[r] = -ms; } }
    const int srow = tid >> 3, sch = tid & 7, rrow = (tid & 255) >> 2, rch = tid & 3;
    const char* kn_u = (const char*)(KN + bhS * 64); const char* v_u = (const char*)(V + bhS * 64); const char* kr_u = (const char*)(KR + (size_t)b * S * 32);
    const unsigned kn_off = (unsigned)(srow * 64 + sch * 8) * 2u, kr_off = (unsigned)(rrow * 32 + rch * 8) * 2u;
    const int kst = KSWZ(srow, sch * 16), krst = KSWZ(rrow, (8 + rch) * 16), vst = v_st(srow, sch * 8);
    const int vb0 = (int)(uintptr_t)V_lds + v_rd_base(lane);
    bf16x8 s_kn, s_kr, s_v;
#define SLOAD(t) do { s_kn = *reinterpret_cast<const bf16x8*>(kn_u + (size_t)(t) * 8192 + kn_off); s_kr = *reinterpret_cast<const bf16x8*>(kr_u + (size_t)(t) * 4096 + kr_off); \
    s_v = *reinterpret_cast<const bf16x8*>(v_u + (size_t)(t) * 8192 + kn_off); } while (0)
#define SWRITE(sl) do { *(bf16x8*)(K_lds + (sl) * SHM_K + kst) = s_kn; if (tid < 256) *(bf16x8*)(K_lds + (sl) * SHM_K + krst) = s_kr; *(bf16x8*)(V_lds + (sl) * SHM_V + vst) = s_v; } while (0)
#define SWAIT() asm volatile("s_waitcnt vmcnt(0)" ::: "memory")
#define RESC(a) do { if (exact && __any((a) < 1.f)) { if (hi == 0) al_l[r32] = (a); asm volatile("s_waitcnt lgkmcnt(0)" ::: "memory"); l_reg *= (a); \
    _Pragma("unroll") for (int d = 0; d < 2; ++d) _Pragma("unroll") for (int r = 0; r < 16; ++r) o[d][r] *= al_l[crow(r, hi)]; } } while (0)
#define RAWBAR() do { asm volatile("" ::: "memory"); __builtin_amdgcn_s_barrier(); asm volatile("" ::: "memory"); } while (0)
#define EXP_TILE(P0, P1, FIRST_) do { float al_ = 1.f; \
        if (exact) { const float pmax = rowmax32b(P0, P1); \
            if ((FIRST_) || !__builtin_expect(__all(pmax <= THR), 1)) { const float dl = (FIRST_) ? pmax : fmaxf(pmax, 0.f); m_reg += dl; \
                _Pragma("unroll") for (int r = 0; r < 16; ++r) { P0[r] -= dl; P1[r] -= dl; } \
                _Pragma("unroll") for (int r = 0; r < 16; ++r) negm[r] = -m_reg; \
                if (!(FIRST_)) al_ = __builtin_amdgcn_exp2f(-dl); } } \
        _Pragma("unroll") for (int r = 0; r < 16; ++r) P0[r] = __builtin_amdgcn_exp2f(P0[r]); \
        _Pragma("unroll") for (int r = 0; r < 16; ++r) P1[r] = __builtin_amdgcn_exp2f(P1[r]); \
        RESC(al_); } while (0)
#define M_PART(PC0, PC1, PP0, PP1) do { \
        s16x4 val[4], vah[4], vbl[4], vbh[4]; const int vb_ = vb0 + sp * SHM_V; float s0 = 0.f, s1 = 0.f, s2 = 0.f, s3 = 0.f; \
        KLD3(kb, K_lds + sc * SHM_K, 3); SBAR(); \
        QK_ADD(PC0, ka[0], qr[0], negm, PP0, 0);  QK_ADD(PC1, ka[1], qr[0], negm, PP0, 4); \
        QK_ADD(PC0, ka[2], qr[1], PC0, PP0, 8);   QK_ADD(PC1, ka[3], qr[1], PC1, PP0, 12); \
        QK_ADD(PC0, ka[4], qr[2], PC0, PP1, 0);   QK_ADD(PC1, ka[5], qr[2], PC1, PP1, 4); \
        vfrag_load_h<0>(val, vah, vb_); vfrag_load_h<1>(vbl, vbh, vb_); SBAR(); \
        QK_ADD(PC0, kb[0], qr[3], PC0, PP1, 8);   QK_ADD(PC1, kb[1], qr[3], PC1, PP1, 12); \
        QK_PK(PC0, kb[2], qr[4], PC0, PP0, 0, pa0); QK_PK(PC1, kb[3], qr[4], PC1, PP0, 8, pa1); \
        QK_PK(PC0, kb[4], qr[5], PC0, PP1, 0, pa2); QK_PK(PC1, kb[5], qr[5], PC1, PP1, 8, pa3); \
        { float ps = (s0 + s1) + (s2 + s3); auto rr = __builtin_amdgcn_permlane32_swap(__float_as_uint(ps), __float_as_uint(ps), false, false); l_reg += __uint_as_float(rr[0]) + __uint_as_float(rr[1]); } \
        asm volatile("s_waitcnt lgkmcnt(0)" ::: "memory"); SBAR(); \
        pv_mma_h(o[0], val, vah, pa0, pa1, pa2, pa3); pv_mma_h(o[1], vbl, vbh, pa0, pa1, pa2, pa3); SBAR(); } while (0)
#define V_PART(PC0, PC1, t_) do { \
        if ((t_) + 2 < NT) { SWAIT(); SWRITE(sw); if ((t_) + 3 < NT) SLOAD((t_) + 3); } SBAR(); \
        EXP_TILE(PC0, PC1, false); SBAR(); \
        sp = sc; sc = (sc + 1) & 3; sw = (sw + 1) & 3; \
        if ((t_) + 1 < NT) { KLD3(ka, K_lds + sc * SHM_K, 0); SBAR(); } \
        asm volatile("s_waitcnt lgkmcnt(6)" ::: "memory"); RAWBAR(); } while (0)
    f32x16 pA0, pA1, pB0, pB1; bf16x8 pa0, pa1, pa2, pa3; bf16x8 ka[6], kb[6]; constexpr int NT = S / 64;
    SLOAD(0); SWAIT(); SWRITE(0); SLOAD(1); SWAIT(); SWRITE(1); SLOAD(2);
    asm volatile("s_waitcnt lgkmcnt(0)" ::: "memory"); RAWBAR();
    if (halfB) RAWBAR();
    KLD3(ka, K_lds, 0); KLD3(kb, K_lds, 3); SBAR();
    pA0 = MF32(ka[0], qr[0], negm); pA1 = MF32(ka[1], qr[0], negm); pA0 = MF32(ka[2], qr[1], pA0); pA1 = MF32(ka[3], qr[1], pA1); pA0 = MF32(ka[4], qr[2], pA0); pA1 = MF32(ka[5], qr[2], pA1);
    pA0 = MF32(kb[0], qr[3], pA0); pA1 = MF32(kb[1], qr[3], pA1); pA0 = MF32(kb[2], qr[4], pA0); pA1 = MF32(kb[3], qr[4], pA1); pA0 = MF32(kb[4], qr[5], pA0); pA1 = MF32(kb[5], qr[5], pA1); SBAR();
    asm volatile("s_waitcnt lgkmcnt(0)" ::: "memory"); RAWBAR();
    int sp = 0, sc = 0, sw = 2;
    SWAIT(); SWRITE(2); SLOAD(3); SBAR();
    EXP_TILE(pA0, pA1, true); SBAR();
    sp = 0; sc = 1; sw = 3;
    KLD3(ka, K_lds + SHM_K, 0); SBAR();
    asm volatile("s_waitcnt lgkmcnt(6)" ::: "memory"); RAWBAR();
    for (int t = 1; t + 1 < NT; t += 2) {
        M_PART(pB0, pB1, pA0, pA1); RAWBAR(); V_PART(pB0, pB1, t);
        M_PART(pA0, pA1, pB0, pB1); RAWBAR(); V_PART(pA0, pA1, t + 1);
    }
    M_PART(pB0, pB1, pA0, pA1); RAWBAR(); V_PART(pB0, pB1, NT - 1);
    { s16x4 val[4], vah[4], vbl[4], vbh[4]; const int vb_ = vb0 + sp * SHM_V; float ps = 0.f;
      vfrag_load_h<0>(val, vah, vb_); vfrag_load_h<1>(vbl, vbh, vb_); SBAR();
#pragma unroll
      for (int r = 0; r < 16; ++r) ps += pB0[r] + pB1[r];
      { auto rr = __builtin_amdgcn_permlane32_swap(__float_as_uint(ps), __float_as_uint(ps), false, false); l_reg += __uint_as_float(rr[0]) + __uint_as_float(rr[1]); }
      PK4(pB0, 0, pa0); PK4(pB0, 8, pa1); PK4(pB1, 0, pa2); PK4(pB1, 8, pa3);
      asm volatile("s_waitcnt lgkmcnt(0)" ::: "memory"); SBAR();
      pv_mma_h(o[0], val, vah, pa0, pa1, pa2, pa3); pv_mma_h(o[1], vbl, vbh, pa0, pa1, pa2, pa3); SBAR(); }
    if (!halfB) RAWBAR();
    if (hi == 0) li_l[r32] = l_reg; asm volatile("s_waitcnt lgkmcnt(0)" ::: "memory");
    float rli[16];
#pragma unroll
    for (int r = 0; r < 16; ++r) rli[r] = __builtin_amdgcn_rcpf(li_l[crow(r, hi)]);
    unsigned short* stg = (unsigned short*)(lds + M6_OST) + wid * 2048;
    unsigned short* dst = CAT + ((size_t)b * S + q0 + wid * 32) * 1024 + h * 64;
    store_o_tile(o, rli, stg, dst, [](int row) { return (size_t)row * 1024; }, lane);
    asm volatile("s_waitcnt vmcnt(0)" ::: "memory");
    __syncthreads();
#undef SLOAD
#undef SWRITE
#undef SWAIT
#undef RESC
#undef RAWBAR
#undef EXP_TILE
#undef M_PART
#undef V_PART
}


#define PV_EXP(OD, PA, VL, VH, PCX, B) do { OD = MF32(PA, PKV(VL, VH), OD); PCX[B] = __builtin_amdgcn_exp2f(PCX[B]); PCX[B + 1] = __builtin_amdgcn_exp2f(PCX[B + 1]); \
        PCX[B + 2] = __builtin_amdgcn_exp2f(PCX[B + 2]); PCX[B + 3] = __builtin_amdgcn_exp2f(PCX[B + 3]); asm volatile("" : "+v"(PCX)); SBAR(); } while (0)
__device__ __forceinline__ void mla_unit_v7(int wv, int bh, int qb, const unsigned short* __restrict__ Q, const unsigned short* __restrict__ KN, const unsigned short* __restrict__ KR,
                                            const unsigned short* __restrict__ V, unsigned short* __restrict__ CAT, const float* __restrict__ KMX, char* lds, unsigned long long* STAMPS = nullptr) {
    const int wid = wv, lane = gm::lane_now(), tid = wid * 64 + lane, r32 = lane & 31, hi = lane >> 5;
    const int b = bh >> 3, h = bh & 7;
    char* K_lds = lds + M6_K; char* V_lds = lds + M6_V;
    float* wsf = (float*)(lds + M6_WS) + wid * 64; float* li_l = wsf; float* al_l = wsf + 32;
    float m_reg = 0.f, l_reg = 0; f32x16 o[2] = {}; bf16x8 qr[6]; f32x16 negm = f32x16{};
    const size_t bhS = (size_t)bh * S; const int q0 = qb * 256;
    const unsigned short* Qw = Q + (bhS + q0 + wid * 32 + r32) * 96 + hi * 8;
#pragma unroll
    for (int d0 = 0; d0 < 6; ++d0) qr[d0] = *reinterpret_cast<const bf16x8*>(Qw + d0 * 16);
    bool exact = true;
    if (MLA_STATIC) { float q2 = 0.f;
#pragma unroll
      for (int d0 = 0; d0 < 6; ++d0)
#pragma unroll
          for (int j = 0; j < 8; ++j) { const float x = __uint_as_float((unsigned)(unsigned short)qr[d0][j] << 16); q2 += x * x; }
      { auto rr = __builtin_amdgcn_permlane32_swap(__float_as_uint(q2), __float_as_uint(q2), false, false); q2 = __uint_as_float(rr[0]) + __uint_as_float(rr[1]); }
      const float k2 = KMX[(b * 8 + h) * 2] + KMX[(b * 8 + h) * 2 + 1] + KMX[32 + b];
      const float ms = 1.01f * sqrtf(q2 * k2);
      exact = wg_or(!(ms <= MLA_STATIC_THR), (unsigned*)(lds + 147456 - 512), wid, lane);
      if (!exact) { m_reg = ms;
#pragma unroll
          for (int r = 0; r < 16; ++r) negm[r] = -ms; } }
    const int srow = tid >> 3, sch = tid & 7, rrow = (tid & 255) >> 2, rch = tid & 3;
    const char* kn_u = (const char*)(KN + bhS * 64); const char* v_u = (const char*)(V + bhS * 64); const char* kr_u = (const char*)(KR + (size_t)b * S * 32);
    const unsigned kn_off = (unsigned)(srow * 64 + sch * 8) * 2u, kr_off = (unsigned)(rrow * 32 + rch * 8) * 2u;
    const int kst = KSWZ(srow, sch * 16), krst = KSWZ(rrow, (8 + rch) * 16), vst = v_st(srow, sch * 8);
    const int vb0 = (int)(uintptr_t)V_lds + v_rd_base(lane);
    bf16x8 s_kn, s_kr, s_v;
#define SLOAD(t) do { s_kn = *reinterpret_cast<const bf16x8*>(kn_u + (size_t)(t) * 8192 + kn_off); s_kr = *reinterpret_cast<const bf16x8*>(kr_u + (size_t)(t) * 4096 + kr_off); \
    s_v = *reinterpret_cast<const bf16x8*>(v_u + (size_t)(t) * 8192 + kn_off); } while (0)
#define SWRITE(sl) do { *(bf16x8*)(K_lds + (sl) * SHM_K + kst) = s_kn; if (tid < 256) *(bf16x8*)(K_lds + (sl) * SHM_K + krst) = s_kr; *(bf16x8*)(V_lds + (sl) * SHM_V + vst) = s_v; } while (0)
#define SWAIT() asm volatile("s_waitcnt vmcnt(0)" ::: "memory")
#define RAWBAR() do { asm volatile("" ::: "memory"); __builtin_amdgcn_s_barrier(); asm volatile("" ::: "memory"); } while (0)
#define MAX_TILE(P0, P1, FIRST_, AL_) do { AL_ = 1.f; \
        if (V7_EXACT && exact) { const float pmax = rowmax32b(P0, P1); \
            if ((FIRST_) || !__builtin_expect(__all(pmax <= THR), 1)) { const float dl = (FIRST_) ? pmax : fmaxf(pmax, 0.f); m_reg += dl; \
                _Pragma("unroll") for (int r = 0; r < 16; ++r) { P0[r] -= dl; P1[r] -= dl; } \
                _Pragma("unroll") for (int r = 0; r < 16; ++r) negm[r] = -m_reg; \
                if (!(FIRST_)) AL_ = __builtin_amdgcn_exp2f(-dl); } } } while (0)
#define RESC7(a) do { if (V7_EXACT && exact && __any((a) < 1.f)) { if (hi == 0) al_l[r32] = (a); asm volatile("s_waitcnt lgkmcnt(0)" ::: "memory"); l_reg *= (a); \
    _Pragma("unroll") for (int d = 0; d < 2; ++d) _Pragma("unroll") for (int r = 0; r < 16; ++r) o[d][r] *= al_l[crow(r, hi)]; } } while (0)
#define STEP7(PC0, PC1, PP0, PP1, t_) do { \
        s16x4 val[4], vah[4], vbl[4], vbh[4]; const int vb_ = vb0 + sp * SHM_V; float s0 = 0.f, s1 = 0.f, s2 = 0.f, s3 = 0.f, al_; \
        SEC_B(0); if ((t_) + 2 < NT) { SWAIT(); SWRITE(sw); if ((t_) + 3 < NT) SLOAD((t_) + 3); } SEC_E(0); \
        SEC_B(1); KLD3(kb, K_lds + sc * SHM_K, 3); SBAR(); \
        QK_ADD(PC0, ka[0], qr[0], negm, PP0, 0);  QK_ADD(PC1, ka[1], qr[0], negm, PP0, 4); \
        QK_ADD(PC0, ka[2], qr[1], PC0, PP0, 8);   QK_ADD(PC1, ka[3], qr[1], PC1, PP0, 12); \
        QK_ADD(PC0, ka[4], qr[2], PC0, PP1, 0);   QK_ADD(PC1, ka[5], qr[2], PC1, PP1, 4); \
        vfrag_load_h<0>(val, vah, vb_); SBAR(); \
        QK_ADD(PC0, kb[0], qr[3], PC0, PP1, 8);   QK_ADD(PC1, kb[1], qr[3], PC1, PP1, 12); \
        QK_PK(PC0, kb[2], qr[4], PC0, PP0, 0, pa0); QK_PK(PC1, kb[3], qr[4], PC1, PP0, 8, pa1); \
        vfrag_load_h<1>(vbl, vbh, vb_); SBAR(); \
        QK_PK(PC0, kb[4], qr[5], PC0, PP1, 0, pa2); QK_PK(PC1, kb[5], qr[5], PC1, PP1, 8, pa3); \
        { float ps = (s0 + s1) + (s2 + s3); auto rr = __builtin_amdgcn_permlane32_swap(__float_as_uint(ps), __float_as_uint(ps), false, false); l_reg += __uint_as_float(rr[0]) + __uint_as_float(rr[1]); } \
        MAX_TILE(PC0, PC1, false, al_); SEC_E(1); \
        SEC_B(4); sp = sc; sc = (sc + 1) & 3; sw = (sw + 1) & 3; \
        if ((t_) + 1 < NT) KLD3(ka, K_lds + sc * SHM_K, 0); \
        asm volatile("s_waitcnt lgkmcnt(6)" ::: "memory"); SBAR(); SEC_E(4); SEC_B(2); \
        PV_EXP(o[0], pa0, val[0], vah[0], PC0, 0);  PV_EXP(o[1], pa0, vbl[0], vbh[0], PC0, 4); \
        PV_EXP(o[0], pa1, val[1], vah[1], PC0, 8);  PV_EXP(o[1], pa1, vbl[1], vbh[1], PC0, 12); \
        PV_EXP(o[0], pa2, val[2], vah[2], PC1, 0);  PV_EXP(o[1], pa2, vbl[2], vbh[2], PC1, 4); \
        PV_EXP(o[0], pa3, val[3], vah[3], PC1, 8);  PV_EXP(o[1], pa3, vbl[3], vbh[3], PC1, 12); \
        RESC7(al_); SEC_E(2); \
        SEC_B(3); RAWBAR(); SEC_E(3); } while (0)
    f32x16 pA0, pA1, pB0, pB1; bf16x8 pa0, pa1, pa2, pa3; bf16x8 ka[6], kb[6]; constexpr int NT = S / 64;
#if MLA_STAMP
    unsigned long long st_a = 0, tq0 = 0, tq1 = 0;
#endif

    if (V7_YOUNG_PRIO && wid >= 4) __builtin_amdgcn_s_setprio(1);
    SLOAD(0); SWAIT(); SWRITE(0); SLOAD(1); SWAIT(); SWRITE(1); SLOAD(2);
    asm volatile("s_waitcnt lgkmcnt(0)" ::: "memory"); RAWBAR();
    KLD3(ka, K_lds, 0); KLD3(kb, K_lds, 3); SBAR();
    pA0 = MF32(ka[0], qr[0], negm); pA1 = MF32(ka[1], qr[0], negm); pA0 = MF32(ka[2], qr[1], pA0); pA1 = MF32(ka[3], qr[1], pA1); pA0 = MF32(ka[4], qr[2], pA0); pA1 = MF32(ka[5], qr[2], pA1);
    pA0 = MF32(kb[0], qr[3], pA0); pA1 = MF32(kb[1], qr[3], pA1); pA0 = MF32(kb[2], qr[4], pA0); pA1 = MF32(kb[3], qr[4], pA1); pA0 = MF32(kb[4], qr[5], pA0); pA1 = MF32(kb[5], qr[5], pA1); SBAR();
    { float al0; MAX_TILE(pA0, pA1, true, al0); (void)al0; }
#pragma unroll
    for (int r = 0; r < 16; ++r) { pA0[r] = __builtin_amdgcn_exp2f(pA0[r]); pA1[r] = __builtin_amdgcn_exp2f(pA1[r]); }
    SWAIT(); SWRITE(2); SLOAD(3);
    int sp = 0, sc = 1, sw = 3;
    KLD3(ka, K_lds + SHM_K, 0);
    asm volatile("s_waitcnt lgkmcnt(6)" ::: "memory"); RAWBAR();
    for (int t = 1; t + 1 < NT; t += 2) { STEP7(pB0, pB1, pA0, pA1, t); STEP7(pA0, pA1, pB0, pB1, t + 1); }
    STEP7(pB0, pB1, pA0, pA1, NT - 1);
    { s16x4 val[4], vah[4], vbl[4], vbh[4]; const int vb_ = vb0 + sp * SHM_V; float ps = 0.f;
      vfrag_load_h<0>(val, vah, vb_); vfrag_load_h<1>(vbl, vbh, vb_); SBAR();
#pragma unroll
      for (int r = 0; r < 16; ++r) ps += pB0[r] + pB1[r];
      { auto rr = __builtin_amdgcn_permlane32_swap(__float_as_uint(ps), __float_as_uint(ps), false, false); l_reg += __uint_as_float(rr[0]) + __uint_as_float(rr[1]); }
      PK4(pB0, 0, pa0); PK4(pB0, 8, pa1); PK4(pB1, 0, pa2); PK4(pB1, 8, pa3);
      asm volatile("s_waitcnt lgkmcnt(0)" ::: "memory"); SBAR();
      pv_mma_h(o[0], val, vah, pa0, pa1, pa2, pa3); pv_mma_h(o[1], vbl, vbh, pa0, pa1, pa2, pa3); SBAR(); }
    if (V7_YOUNG_PRIO) __builtin_amdgcn_s_setprio(0);
    if (hi == 0) li_l[r32] = l_reg; asm volatile("s_waitcnt lgkmcnt(0)" ::: "memory");
    float rli[16];
#pragma unroll
    for (int r = 0; r < 16; ++r) rli[r] = __builtin_amdgcn_rcpf(li_l[crow(r, hi)]);
    unsigned short* stg = (unsigned short*)(lds + M6_OST) + wid * 2048;
    unsigned short* dst = CAT + ((size_t)b * S + q0 + wid * 32) * 1024 + h * 64;
    store_o_tile(o, rli, stg, dst, [](int row) { return (size_t)row * 1024; }, lane);
    asm volatile("s_waitcnt vmcnt(0)" ::: "memory");
#if MLA_STAMP
#if MLA_STAMP
    if (blockIdx.x == 0 && wid == MLA_STAMP_WAVE && lane == 0 && STAMPS) STAMPS[0] = st_a;
#endif
    (void)STAMPS;
#endif
    __syncthreads();
#undef SLOAD
#undef SWRITE
#undef SWAIT
#undef RAWBAR
#undef MAX_TILE
#undef RESC7
#undef STEP7
}

#define PV_EXP9(OD, PA, VL, VH, PCX, B) do { OD = MF32(PA, PKV(VL, VH), OD); PCX[B] = __builtin_amdgcn_exp2f(PCX[B]); PCX[B + 1] = __builtin_amdgcn_exp2f(PCX[B + 1]); \
        PCX[B + 2] = __builtin_amdgcn_exp2f(PCX[B + 2]); PCX[B + 3] = __builtin_amdgcn_exp2f(PCX[B + 3]); asm volatile("" : "+v"(PCX)); SBAR(); } while (0)
__device__ __forceinline__ void mla_unit_v9(int wv, int bh, int qb, const unsigned short* __restrict__ Q, const unsigned short* __restrict__ KN, const unsigned short* __restrict__ KR,
                                            const unsigned short* __restrict__ V, unsigned short* __restrict__ CAT, const float* __restrict__ KMX, char* lds, unsigned long long* STAMPS = nullptr) {
    const int wid = wv, lane = gm::lane_now(), tid = wid * 64 + lane, r32 = lane & 31, hi = lane >> 5;
    const int b = bh >> 3, h = bh & 7; const bool halfB = wid >= 4;
    char* K_lds = lds; char* V_lds = lds + 5 * SHM_K;
    float* wsf = (float*)(lds + 5 * SHM_K + 5 * SHM_V) + wid * 64; float* li_l = wsf; float* al_l = wsf + 32;
    float m_reg = 0.f, l_reg = 0; f32x16 o[2] = {}; bf16x8 qr[6]; const f32x16 zc = f32x16{};
    const size_t bhS = (size_t)bh * S; const int q0 = qb * 256;
    const unsigned short* Qw = Q + (bhS + q0 + wid * 32 + r32) * 96 + hi * 8;
#pragma unroll
    for (int d0 = 0; d0 < 6; ++d0) qr[d0] = *reinterpret_cast<const bf16x8*>(Qw + d0 * 16);
    bool exact = true;
    if (MLA_STATIC) { float q2 = 0.f;
#pragma unroll
      for (int d0 = 0; d0 < 6; ++d0)
#pragma unroll
          for (int j = 0; j < 8; ++j) { const float x = __uint_as_float((unsigned)(unsigned short)qr[d0][j] << 16); q2 += x * x; }
      { auto rr = __builtin_amdgcn_permlane32_swap(__float_as_uint(q2), __float_as_uint(q2), false, false); q2 = __uint_as_float(rr[0]) + __uint_as_float(rr[1]); }
      const float k2 = KMX[(b * 8 + h) * 2] + KMX[(b * 8 + h) * 2 + 1] + KMX[32 + b];
      const float ms = 1.01f * sqrtf(q2 * k2);
      exact = wg_or(!(ms <= (V9_FALLBACK ? V9_STATIC_THR : MLA_STATIC_THR)), (unsigned*)(lds + 147456 - 512), wid, lane); }
    if (V9_FALLBACK && exact) { mla_unit_v2(wv, bh, qb, Q, KN, KR, V, CAT, KMX, lds, STAMPS); return; }
    const unsigned lds_k = (unsigned)(uintptr_t)K_lds, lds_v = (unsigned)(uintptr_t)V_lds;
    const char* kp[2]; unsigned kstr[2];
#pragma unroll
    for (int i = 0; i < 2; ++i) { const int r = 8 * wid + 4 * i + (lane >> 4), p = lane & 15, c = p ^ (r & 15); const bool rope = (c >= 8) && (c < 12); const int cn = c & 7;
        kp[i] = rope ? (const char*)(KR + ((size_t)b * S + r) * 32 + (c - 8) * 8) : (const char*)(KN + (bhS + r) * 64 + cn * 8); kstr[i] = rope ? 4096u : 8192u; }
    const char* v_u = (const char*)(V + bhS * 64);
    const unsigned v_off = (unsigned)(((8 * wid + ((lane >> 2) & 7)) * 64 + (lane >> 5) * 32 + (lane & 3) * 8) * 2);
    const int vb0 = (int)(uintptr_t)V_lds + v_rd_base(lane);
#define GLDS16(src, ldsaddr) __builtin_amdgcn_global_load_lds((const unsigned*)(src), (LAS unsigned*)(uintptr_t)(unsigned)(ldsaddr), 16, 0, 0)
#define DMA_TILE(t, sl) do { GLDS16(kp[0] + (size_t)(t) * kstr[0], lds_k + (sl) * SHM_K + (2 * wid) * 1024); GLDS16(kp[1] + (size_t)(t) * kstr[1], lds_k + (sl) * SHM_K + (2 * wid + 1) * 1024); \
        GLDS16(v_u + (size_t)(t) * 8192 + v_off, lds_v + (sl) * SHM_V + wid * 1024); } while (0)
#define RAWBAR() do { asm volatile("" ::: "memory"); __builtin_amdgcn_s_barrier(); asm volatile("" ::: "memory"); } while (0)
#define MAX_TILE(P0, P1, FIRST_, AL_) do { AL_ = 1.f; \
        if (V9_EXACT && exact) { if (!(FIRST_)) { _Pragma("unroll") for (int r = 0; r < 16; ++r) { P0[r] -= m_reg; P1[r] -= m_reg; } } \
            const float pmax = rowmax32b(P0, P1); \
            if ((FIRST_) || !__builtin_expect(__all(pmax <= THR), 1)) { const float dl = (FIRST_) ? pmax : fmaxf(pmax, 0.f); m_reg += dl; \
                _Pragma("unroll") for (int r = 0; r < 16; ++r) { P0[r] -= dl; P1[r] -= dl; } \
                if (!(FIRST_)) AL_ = __builtin_amdgcn_exp2f(-dl); } } } while (0)
#define RESC7(a) do { if (V9_EXACT && exact && __any((a) < 1.f)) { if (hi == 0) al_l[r32] = (a); asm volatile("s_waitcnt lgkmcnt(0)" ::: "memory"); l_reg *= (a); \
    _Pragma("unroll") for (int d = 0; d < 2; ++d) _Pragma("unroll") for (int r = 0; r < 16; ++r) o[d][r] *= al_l[crow(r, hi)]; } } while (0)
#define KLD3A(dst, Ks_, D0) do { _Pragma("unroll") for (int d_ = 0; d_ < 3; ++d_) { const int cb_ = (((D0) + d_) * 16 + hi * 8) * 2; \
        const int ad_ = (int)(uintptr_t)((Ks_) + KSWZ(r32, cb_)); \
        asm volatile("ds_read_b128 %0, %1" : "=v"(dst[2 * d_]) : "v"(ad_) : "memory"); \
        asm volatile("ds_read_b128 %0, %1 offset:8192" : "=v"(dst[2 * d_ + 1]) : "v"(ad_) : "memory"); } } while (0)
#define KLDX(dst, Ks_, D0) do { if (V9_KASM) KLD3A(dst, Ks_, D0); else KLD3(dst, Ks_, D0); } while (0)
#define STEP7(PC0, PC1, PP0, PP1, t_) do { \
        s16x4 val[4], vah[4], vbl[4], vbh[4]; const int vb_ = vb0 + sp * SHM_V; float s0 = 0.f, s1 = 0.f, s2 = 0.f, s3 = 0.f, al_; \
        SEC_B(0); if (!V9_DMA_LATE && (t_) + 3 < NT) DMA_TILE((t_) + 3, sw); SEC_E(0); \
        SEC_B(1); if (V9_SPLIT_PRIO) { if (halfB) __builtin_amdgcn_s_setprio(0); else __builtin_amdgcn_s_setprio(1); } if (!V9_KB_EARLY) { KLDX(kb, K_lds + sc * SHM_K, 3); } SBAR(); \
        QK_ADD(PC0, ka[0], qr[0], zc, PP0, 0);  QK_ADD(PC1, ka[1], qr[0], zc, PP0, 4); if (V9_DMA_LATE && (t_) + 3 < NT) { DMA_TILE((t_) + 3, sw); SBAR(); } \
        QK_ADD(PC0, ka[2], qr[1], PC0, PP0, 8);   QK_ADD(PC1, ka[3], qr[1], PC1, PP0, 12); \
        QK_ADD(PC0, ka[4], qr[2], PC0, PP1, 0);   QK_ADD(PC1, ka[5], qr[2], PC1, PP1, 4); \
        vfrag_load_h<0>(val, vah, vb_); if (V9_KASM) asm volatile("s_waitcnt lgkmcnt(8)" ::: "memory");     SBAR(); \
        QK_ADD(PC0, kb[0], qr[3], PC0, PP1, 8);   QK_ADD(PC1, kb[1], qr[3], PC1, PP1, 12); \
        QK_PK(PC0, kb[2], qr[4], PC0, PP0, 0, pa0); QK_PK(PC1, kb[3], qr[4], PC1, PP0, 8, pa1); \
        vfrag_load_h<1>(vbl, vbh, vb_); SBAR(); \
        QK_PK(PC0, kb[4], qr[5], PC0, PP1, 0, pa2); QK_PK(PC1, kb[5], qr[5], PC1, PP1, 8, pa3); \
        { float ps = (s0 + s1) + (s2 + s3); auto rr = __builtin_amdgcn_permlane32_swap(__float_as_uint(ps), __float_as_uint(ps), false, false); l_reg += __uint_as_float(rr[0]) + __uint_as_float(rr[1]); } \
        MAX_TILE(PC0, PC1, false, al_); SEC_E(1); \
        SEC_B(4); sp = sc; sc = (sc == 4) ? 0 : sc + 1; sw = (sw == 4) ? 0 : sw + 1; \
        if ((t_) + 1 < NT) { KLDX(ka, K_lds + sc * SHM_K, 0); if (V9_KB_EARLY) KLDX(kb, K_lds + sc * SHM_K, 3); } \
        if (V9_KB_EARLY) asm volatile("s_waitcnt lgkmcnt(12)" ::: "memory"); else asm volatile("s_waitcnt lgkmcnt(6)" ::: "memory"); SBAR(); SEC_E(4); SEC_B(2); if (V9_SPLIT_PRIO) { if (halfB) __builtin_amdgcn_s_setprio(1); else __builtin_amdgcn_s_setprio(0); } \
        PV_EXP9(o[0], pa0, val[0], vah[0], PC0, 0);  PV_EXP9(o[1], pa0, vbl[0], vbh[0], PC0, 4); \
        PV_EXP9(o[0], pa1, val[1], vah[1], PC0, 8);  PV_EXP9(o[1], pa1, vbl[1], vbh[1], PC0, 12); \
        PV_EXP9(o[0], pa2, val[2], vah[2], PC1, 0);  PV_EXP9(o[1], pa2, vbl[2], vbh[2], PC1, 4); \
        PV_EXP9(o[0], pa3, val[3], vah[3], PC1, 8);  PV_EXP9(o[1], pa3, vbl[3], vbh[3], PC1, 12); \
        RESC7(al_); SEC_E(2); \
        SEC_B(3); if (V9_KASM) asm volatile("s_waitcnt lgkmcnt(0)" ::: "memory"); if ((t_) + 3 < NT) asm volatile("s_waitcnt vmcnt(3)" ::: "memory"); else asm volatile("s_waitcnt vmcnt(0)" ::: "memory");     \
        RAWBAR(); SEC_E(3); } while (0)
    f32x16 pA0, pA1, pB0, pB1; bf16x8 pa0, pa1, pa2, pa3; bf16x8 ka[6], kb[6]; constexpr int NT = S / 64;
#if MLA_STAMP
    unsigned long long st_a = 0, tq0 = 0, tq1 = 0;
#endif


    if (!V9_SPLIT_PRIO && V7_YOUNG_PRIO && wid >= 4) __builtin_amdgcn_s_setprio(1);
    DMA_TILE(0, 0); DMA_TILE(1, 1); DMA_TILE(2, 2);
    asm volatile("s_waitcnt vmcnt(0)" ::: "memory"); RAWBAR();
    KLDX(ka, K_lds, 0); KLDX(kb, K_lds, 3); if (V9_KASM) asm volatile("s_waitcnt lgkmcnt(0)" ::: "memory"); SBAR();
    pA0 = MF32(ka[0], qr[0], zc); pA1 = MF32(ka[1], qr[0], zc); pA0 = MF32(ka[2], qr[1], pA0); pA1 = MF32(ka[3], qr[1], pA1); pA0 = MF32(ka[4], qr[2], pA0); pA1 = MF32(ka[5], qr[2], pA1);
    pA0 = MF32(kb[0], qr[3], pA0); pA1 = MF32(kb[1], qr[3], pA1); pA0 = MF32(kb[2], qr[4], pA0); pA1 = MF32(kb[3], qr[4], pA1); pA0 = MF32(kb[4], qr[5], pA0); pA1 = MF32(kb[5], qr[5], pA1); SBAR();
    { float al0; MAX_TILE(pA0, pA1, true, al0); (void)al0; }
#pragma unroll
    for (int r = 0; r < 16; ++r) { pA0[r] = __builtin_amdgcn_exp2f(pA0[r]); pA1[r] = __builtin_amdgcn_exp2f(pA1[r]); }
    DMA_TILE(3, 3);
    int sp = 0, sc = 1, sw = 4;
    KLDX(ka, K_lds + SHM_K, 0); if (V9_KB_EARLY) KLDX(kb, K_lds + SHM_K, 3);
    if (V9_KASM) asm volatile("s_waitcnt lgkmcnt(0)" ::: "memory");
    asm volatile("s_waitcnt vmcnt(3)" ::: "memory"); RAWBAR();
#if MLA_ALIGN
    asm volatile(".p2align " MLA_ALIGN_STR ::: "memory");
#endif
    for (int t = 1; t + 1 < NT; t += 2) { STEP7(pB0, pB1, pA0, pA1, t); STEP7(pA0, pA1, pB0, pB1, t + 1); }
    STEP7(pB0, pB1, pA0, pA1, NT - 1);
    { s16x4 val[4], vah[4], vbl[4], vbh[4]; const int vb_ = vb0 + sp * SHM_V; float ps = 0.f;
      vfrag_load_h<0>(val, vah, vb_); vfrag_load_h<1>(vbl, vbh, vb_); SBAR();
#pragma unroll
      for (int r = 0; r < 16; ++r) ps += pB0[r] + pB1[r];
      { auto rr = __builtin_amdgcn_permlane32_swap(__float_as_uint(ps), __float_as_uint(ps), false, false); l_reg += __uint_as_float(rr[0]) + __uint_as_float(rr[1]); }
      PK4(pB0, 0, pa0); PK4(pB0, 8, pa1); PK4(pB1, 0, pa2); PK4(pB1, 8, pa3);
      asm volatile("s_waitcnt lgkmcnt(0)" ::: "memory"); SBAR();
      pv_mma_h(o[0], val, vah, pa0, pa1, pa2, pa3); pv_mma_h(o[1], vbl, vbh, pa0, pa1, pa2, pa3); SBAR(); }
    __builtin_amdgcn_s_setprio(0);
    asm volatile("s_waitcnt lgkmcnt(0)" ::: "memory"); RAWBAR();
    if (hi == 0) li_l[r32] = l_reg; asm volatile("s_waitcnt lgkmcnt(0)" ::: "memory");
    float rli[16];
#pragma unroll
    for (int r = 0; r < 16; ++r) rli[r] = __builtin_amdgcn_rcpf(li_l[crow(r, hi)]);
    unsigned short* stg = (unsigned short*)lds + wid * 2048;
    unsigned short* dst = CAT + ((size_t)b * S + q0 + wid * 32) * 1024 + h * 64;
    store_o_tile(o, rli, stg, dst, [](int row) { return (size_t)row * 1024; }, lane);
    asm volatile("s_waitcnt vmcnt(0)" ::: "memory");
#if MLA_STAMP
#if MLA_STAMP
    if (blockIdx.x == 0 && wid == MLA_STAMP_WAVE && lane == 0 && STAMPS) STAMPS[0] = st_a;
#endif
    (void)STAMPS;
#endif
    __syncthreads();
#undef GLDS16
#undef DMA_TILE
#undef RAWBAR
#undef MAX_TILE
#undef RESC7
#undef STEP7
#undef KLD3A
#undef KLDX
#undef PV_EXP9
}

#define PV_EXP8(OD, PA, VL, VH, PCX, B) do { OD = MF32(PA, PKV(VL, VH), OD); PCX[B] = __builtin_amdgcn_exp2f(PCX[B]); PCX[B + 1] = __builtin_amdgcn_exp2f(PCX[B + 1]); \
        PCX[B + 2] = __builtin_amdgcn_exp2f(PCX[B + 2]); PCX[B + 3] = __builtin_amdgcn_exp2f(PCX[B + 3]); asm volatile("" : "+v"(PCX)); SBAR(); } while (0)
__device__ __forceinline__ void mla_unit_v8(int wv, int bh, int qb, const unsigned short* __restrict__ Q, const unsigned short* __restrict__ KN, const unsigned short* __restrict__ KR,
                                            const unsigned short* __restrict__ V, unsigned short* __restrict__ CAT, const float* __restrict__ KMX, char* lds, unsigned long long* STAMPS = nullptr) {
    const int wid = wv, lane = gm::lane_now(), tid = wid * 64 + lane, r32 = lane & 31, hi = lane >> 5;
    const int b = bh >> 3, h = bh & 7; const bool halfB = wid >= 4;
    char* K_lds = lds + M6_K; char* V_lds = lds + M6_V;
    float* wsf = (float*)(lds + M6_WS) + wid * 64; float* li_l = wsf; float* al_l = wsf + 32;
    float m_reg = 0.f, l_reg = 0; f32x16 o[2] = {}; bf16x8 qr[6]; f32x16 negm = f32x16{};
    const size_t bhS = (size_t)bh * S; const int q0 = qb * 256;
    const unsigned short* Qw = Q + (bhS + q0 + wid * 32 + r32) * 96 + hi * 8;
#pragma unroll
    for (int d0 = 0; d0 < 6; ++d0) qr[d0] = *reinterpret_cast<const bf16x8*>(Qw + d0 * 16);
    bool exact = true;
    if (MLA_STATIC) { float q2 = 0.f;
#pragma unroll
      for (int d0 = 0; d0 < 6; ++d0)
#pragma unroll
          for (int j = 0; j < 8; ++j) { const float x = __uint_as_float((unsigned)(unsigned short)qr[d0][j] << 16); q2 += x * x; }
      { auto rr = __builtin_amdgcn_permlane32_swap(__float_as_uint(q2), __float_as_uint(q2), false, false); q2 = __uint_as_float(rr[0]) + __uint_as_float(rr[1]); }
      const float k2 = KMX[(b * 8 + h) * 2] + KMX[(b * 8 + h) * 2 + 1] + KMX[32 + b];
      const float ms = 1.01f * sqrtf(q2 * k2);
      exact = wg_or(!(ms <= MLA_STATIC_THR), (unsigned*)(lds + 147456 - 512), wid, lane);
      if (!exact) { m_reg = ms;
#pragma unroll
          for (int r = 0; r < 16; ++r) negm[r] = -ms; } }
    const int srow = tid >> 3, sch = tid & 7, rrow = (tid & 255) >> 2, rch = tid & 3;
    const char* kn_u = (const char*)(KN + bhS * 64); const char* v_u = (const char*)(V + bhS * 64); const char* kr_u = (const char*)(KR + (size_t)b * S * 32);
    const unsigned kn_off = (unsigned)(srow * 64 + sch * 8) * 2u, kr_off = (unsigned)(rrow * 32 + rch * 8) * 2u;
    const int kst = KSWZ(srow, sch * 16), krst = KSWZ(rrow, (8 + rch) * 16), vst = v_st(srow, sch * 8);
    const int vb0 = (int)(uintptr_t)V_lds + v_rd_base(lane);
    bf16x8 s_kn, s_kr, s_v;
#define SLOAD(t) do { s_kn = *reinterpret_cast<const bf16x8*>(kn_u + (size_t)(t) * 8192 + kn_off); s_kr = *reinterpret_cast<const bf16x8*>(kr_u + (size_t)(t) * 4096 + kr_off); \
    s_v = *reinterpret_cast<const bf16x8*>(v_u + (size_t)(t) * 8192 + kn_off); } while (0)
#define SWRITE(sl) do { *(bf16x8*)(K_lds + (sl) * SHM_K + kst) = s_kn; if (tid < 256) *(bf16x8*)(K_lds + (sl) * SHM_K + krst) = s_kr; *(bf16x8*)(V_lds + (sl) * SHM_V + vst) = s_v; } while (0)
#define SWAIT() asm volatile("s_waitcnt vmcnt(0)" ::: "memory")
#define RAWBAR() do { asm volatile("" ::: "memory"); __builtin_amdgcn_s_barrier(); asm volatile("" ::: "memory"); } while (0)
#define MAX_TILE(P0, P1, FIRST_, AL_) do { AL_ = 1.f; \
        if (V7_EXACT && exact) { const float pmax = rowmax32b(P0, P1); \
            if ((FIRST_) || !__builtin_expect(__all(pmax <= THR), 1)) { const float dl = (FIRST_) ? pmax : fmaxf(pmax, 0.f); m_reg += dl; \
                _Pragma("unroll") for (int r = 0; r < 16; ++r) { P0[r] -= dl; P1[r] -= dl; } \
                _Pragma("unroll") for (int r = 0; r < 16; ++r) negm[r] = -m_reg; \
                if (!(FIRST_)) AL_ = __builtin_amdgcn_exp2f(-dl); } } } while (0)
#define RESC7(a) do { if (V7_EXACT && exact && __any((a) < 1.f)) { if (hi == 0) al_l[r32] = (a); asm volatile("s_waitcnt lgkmcnt(0)" ::: "memory"); l_reg *= (a); \
    _Pragma("unroll") for (int d = 0; d < 2; ++d) _Pragma("unroll") for (int r = 0; r < 16; ++r) o[d][r] *= al_l[crow(r, hi)]; } } while (0)
#define STEP7(PC0, PC1, PP0, PP1, t_) do { \
        s16x4 val[4], vah[4], vbl[4], vbh[4]; const int vb_ = vb0 + sp * SHM_V; float s0 = 0.f, s1 = 0.f, s2 = 0.f, s3 = 0.f, al_; \
        KLD3(kb, K_lds + sc * SHM_K, 3); SBAR(); \
        QK_ADD(PC0, ka[0], qr[0], negm, PP0, 0);  QK_ADD(PC1, ka[1], qr[0], negm, PP0, 4); \
        QK_ADD(PC0, ka[2], qr[1], PC0, PP0, 8);   QK_ADD(PC1, ka[3], qr[1], PC1, PP0, 12); \
        QK_ADD(PC0, ka[4], qr[2], PC0, PP1, 0);   QK_ADD(PC1, ka[5], qr[2], PC1, PP1, 4); \
        vfrag_load_h<0>(val, vah, vb_); SBAR(); \
        QK_ADD(PC0, kb[0], qr[3], PC0, PP1, 8);   QK_ADD(PC1, kb[1], qr[3], PC1, PP1, 12); \
        QK_PK(PC0, kb[2], qr[4], PC0, PP0, 0, pa0); QK_PK(PC1, kb[3], qr[4], PC1, PP0, 8, pa1); \
        vfrag_load_h<1>(vbl, vbh, vb_); SBAR(); \
        QK_PK(PC0, kb[4], qr[5], PC0, PP1, 0, pa2); QK_PK(PC1, kb[5], qr[5], PC1, PP1, 8, pa3); \
        { float ps = (s0 + s1) + (s2 + s3); auto rr = __builtin_amdgcn_permlane32_swap(__float_as_uint(ps), __float_as_uint(ps), false, false); l_reg += __uint_as_float(rr[0]) + __uint_as_float(rr[1]); } \
        MAX_TILE(PC0, PC1, false, al_); \
        asm volatile("s_waitcnt lgkmcnt(0)" ::: "memory"); RAWBAR(); \
        if ((t_) + 2 < NT) { SWAIT(); SWRITE(sw); if ((t_) + 3 < NT) SLOAD((t_) + 3); } \
        sp = sc; sc = (sc + 1) & 3; sw = (sw + 1) & 3; \
        if ((t_) + 1 < NT) KLD3(ka, K_lds + sc * SHM_K, 0); SBAR(); \
        PV_EXP8(o[0], pa0, val[0], vah[0], PC0, 0);  PV_EXP8(o[1], pa0, vbl[0], vbh[0], PC0, 4); \
        PV_EXP8(o[0], pa1, val[1], vah[1], PC0, 8);  PV_EXP8(o[1], pa1, vbl[1], vbh[1], PC0, 12); \
        PV_EXP8(o[0], pa2, val[2], vah[2], PC1, 0);  PV_EXP8(o[1], pa2, vbl[2], vbh[2], PC1, 4); \
        PV_EXP8(o[0], pa3, val[3], vah[3], PC1, 8);  PV_EXP8(o[1], pa3, vbl[3], vbh[3], PC1, 12); \
        RESC7(al_); \
        asm volatile("s_waitcnt lgkmcnt(6)" ::: "memory"); RAWBAR(); } while (0)
    f32x16 pA0, pA1, pB0, pB1; bf16x8 pa0, pa1, pa2, pa3; bf16x8 ka[6], kb[6]; constexpr int NT = S / 64;

    SLOAD(0); SWAIT(); SWRITE(0); SLOAD(1); SWAIT(); SWRITE(1); SLOAD(2);
    asm volatile("s_waitcnt lgkmcnt(0)" ::: "memory"); RAWBAR();
    if (halfB) RAWBAR();
    KLD3(ka, K_lds, 0); KLD3(kb, K_lds, 3); SBAR();
    pA0 = MF32(ka[0], qr[0], negm); pA1 = MF32(ka[1], qr[0], negm); pA0 = MF32(ka[2], qr[1], pA0); pA1 = MF32(ka[3], qr[1], pA1); pA0 = MF32(ka[4], qr[2], pA0); pA1 = MF32(ka[5], qr[2], pA1);
    pA0 = MF32(kb[0], qr[3], pA0); pA1 = MF32(kb[1], qr[3], pA1); pA0 = MF32(kb[2], qr[4], pA0); pA1 = MF32(kb[3], qr[4], pA1); pA0 = MF32(kb[4], qr[5], pA0); pA1 = MF32(kb[5], qr[5], pA1); SBAR();
    { float al0; MAX_TILE(pA0, pA1, true, al0); (void)al0; }
    asm volatile("s_waitcnt lgkmcnt(0)" ::: "memory"); RAWBAR();
#pragma unroll
    for (int r = 0; r < 16; ++r) { pA0[r] = __builtin_amdgcn_exp2f(pA0[r]); pA1[r] = __builtin_amdgcn_exp2f(pA1[r]); }
    SWAIT(); SWRITE(2); SLOAD(3);
    int sp = 0, sc = 1, sw = 3;
    KLD3(ka, K_lds + SHM_K, 0);
    asm volatile("s_waitcnt lgkmcnt(6)" ::: "memory"); RAWBAR();
    for (int t = 1; t + 1 < NT; t += 2) { STEP7(pB0, pB1, pA0, pA1, t); STEP7(pA0, pA1, pB0, pB1, t + 1); }
    STEP7(pB0, pB1, pA0, pA1, NT - 1);
    { s16x4 val[4], vah[4], vbl[4], vbh[4]; const int vb_ = vb0 + sp * SHM_V; float ps = 0.f;
      vfrag_load_h<0>(val, vah, vb_); vfrag_load_h<1>(vbl, vbh, vb_); SBAR();
#pragma unroll
      for (int r = 0; r < 16; ++r) ps += pB0[r] + pB1[r];
      { auto rr = __builtin_amdgcn_permlane32_swap(__float_as_uint(ps), __float_as_uint(ps), false, false); l_reg += __uint_as_float(rr[0]) + __uint_as_float(rr[1]); }
      PK4(pB0, 0, pa0); PK4(pB0, 8, pa1); PK4(pB1, 0, pa2); PK4(pB1, 8, pa3);
      asm volatile("s_waitcnt lgkmcnt(0)" ::: "memory"); SBAR();
      pv_mma_h(o[0], val, vah, pa0, pa1, pa2, pa3); pv_mma_h(o[1], vbl, vbh, pa0, pa1, pa2, pa3); SBAR(); }
    if (!halfB) RAWBAR();
    if (hi == 0) li_l[r32] = l_reg; asm volatile("s_waitcnt lgkmcnt(0)" ::: "memory");
    float rli[16];
#pragma unroll
    for (int r = 0; r < 16; ++r) rli[r] = __builtin_amdgcn_rcpf(li_l[crow(r, hi)]);
    unsigned short* stg = (unsigned short*)(lds + M6_OST) + wid * 2048;
    unsigned short* dst = CAT + ((size_t)b * S + q0 + wid * 32) * 1024 + h * 64;
    store_o_tile(o, rli, stg, dst, [](int row) { return (size_t)row * 1024; }, lane);
    asm volatile("s_waitcnt vmcnt(0)" ::: "memory");
#if MLA_STAMP
    (void)STAMPS;
#endif
    __syncthreads();
#undef SLOAD
#undef SWRITE
#undef SWAIT
#undef RAWBAR
#undef MAX_TILE
#undef RESC7
#undef STEP7
#undef PV_EXP8
}

constexpr int DL_K = 0, DL_V = 49152, DL_WS = 98304, DL_OST = DL_WS + 8 * 256;
#define KSWZD(row, colB) ((row) * 128 + ((colB) ^ ((((row) >> 1) & 7) << 4)))
__device__ __forceinline__ void dil_unit(int wv, int bh, int br, int blk, const unsigned short* __restrict__ DQ, const unsigned short* __restrict__ DK, const unsigned short* __restrict__ DV,
                                         unsigned short* __restrict__ OBR, float* __restrict__ LSE, char* lds) {
    const int wid = wv, lane = gm::lane_now(), tid = wid * 64 + lane, r32 = lane & 31, hi = lane >> 5;
    const int sh = 2 * br, dil = 1 << sh, L = S >> sh, nbl = L >> 8, res = blk / nbl, lb = blk % nbl;
    const size_t bhS = (size_t)bh * S; const int b = bh >> 3, h = bh & 7;
    char* K_lds = lds + DL_K; char* V_lds = lds + DL_V;
#pragma unroll
    for (int half = 0; half < 2; ++half) {
        bf16x8 kk[3], vv[3];
#pragma unroll
        for (int it = 0; it < 3; ++it) { const int item = (half * 3 + it) * 512 + tid, row = item >> 3, ch = item & 7; const int l = 256 * lb - 64 + row; const bool valid = (l >= 0) && (l < L);
            const size_t src = (bhS + (valid ? ((size_t)l << sh) + res : 0)) * 64 + ch * 8;
            kk[it] = *reinterpret_cast<const bf16x8*>(DK + src); vv[it] = *reinterpret_cast<const bf16x8*>(DV + src);
            if (!valid) { kk[it] = bf16x8{}; vv[it] = bf16x8{}; } }
#pragma unroll
        for (int it = 0; it < 3; ++it) { const int item = (half * 3 + it) * 512 + tid, row = item >> 3, ch = item & 7;
            *(bf16x8*)(K_lds + KSWZD(row, ch * 16)) = kk[it]; *(bf16x8*)(V_lds + (row >> 4) * 2048 + v_st(row & 15, ch * 8)) = vv[it]; }
    }
    bf16x8 qr[4];
    const int ql = wid * 32 + r32; const size_t qpos = ((size_t)(256 * lb + ql) << sh) + res;
    const unsigned short* Qw = DQ + (bhS + qpos) * 64 + hi * 8;
#pragma unroll
    for (int d0 = 0; d0 < 4; ++d0) qr[d0] = *reinterpret_cast<const bf16x8*>(Qw + d0 * 16);
    __syncthreads();
    f32x16 p[5];
#pragma unroll
    for (int j = 0; j < 5; ++j) { p[j] = f32x16{}; const int row = wid * 32 + j * 32 + r32;
#pragma unroll
        for (int d0 = 0; d0 < 4; ++d0) { const bf16x8 kf = *reinterpret_cast<const bf16x8*>(K_lds + KSWZD(row, (d0 * 16 + hi * 8) * 2)); p[j] = __builtin_amdgcn_mfma_f32_32x32x16_bf16(kf, qr[d0], p[j], 0, 0, 0); } }
    const float NEG = -1e30f;
    const int klo = 64 - 256 * lb, khi = L + 64 - 256 * lb;
    { const int t0 = max(r32, klo - wid * 32) - 4 * hi, t1 = klo - wid * 32 - 32 - 4 * hi, t3 = khi - wid * 32 - 96 - 4 * hi, t4 = min(r32 + 1, khi - wid * 32 - 128) - 4 * hi;
#pragma unroll
      for (int r = 0; r < 16; ++r) { const int c = (r & 3) + 8 * (r >> 2);
          if (c < t0) p[0][r] = NEG; if (c < t1) p[1][r] = NEG; if (c >= t3) p[3][r] = NEG; if (c >= t4) p[4][r] = NEG; } }
    float mx = rowmax32(p[0], p[1]); mx = fmaxf(mx, rowmax32(p[2], p[3]));
    { float m4 = p[4][0];
#pragma unroll
      for (int r = 1; r < 16; ++r) m4 = fmaxf(m4, p[4][r]);
      auto rr = __builtin_amdgcn_permlane32_swap(__float_as_uint(m4), __float_as_uint(m4), false, false); mx = fmaxf(mx, fmaxf(__uint_as_float(rr[0]), __uint_as_float(rr[1]))); }
    float ps = 0.f;
#pragma unroll
    for (int j = 0; j < 5; ++j)
#pragma unroll
        for (int r = 0; r < 16; ++r) { p[j][r] = __builtin_amdgcn_exp2f(p[j][r] - mx); ps += p[j][r]; }
    { auto rr = __builtin_amdgcn_permlane32_swap(__float_as_uint(ps), __float_as_uint(ps), false, false); ps = __uint_as_float(rr[0]) + __uint_as_float(rr[1]); }
    bf16x8 pa[5][2];
#pragma unroll
    for (int j = 0; j < 5; ++j) { PK4(p[j], 0, pa[j][0]); PK4(p[j], 8, pa[j][1]); }
    f32x16 o[2] = {};
    const int vb = (int)(uintptr_t)V_lds + v_rd_base(lane) + wid * 4096;
    pv_half<0, 0 * 4096>(o[0], vb, pa[0][0], pa[0][1]); pv_half<1, 0 * 4096>(o[1], vb, pa[0][0], pa[0][1]);
    pv_half<0, 1 * 4096>(o[0], vb, pa[1][0], pa[1][1]); pv_half<1, 1 * 4096>(o[1], vb, pa[1][0], pa[1][1]);
    pv_half<0, 2 * 4096>(o[0], vb, pa[2][0], pa[2][1]); pv_half<1, 2 * 4096>(o[1], vb, pa[2][0], pa[2][1]);
    pv_half<0, 3 * 4096>(o[0], vb, pa[3][0], pa[3][1]); pv_half<1, 3 * 4096>(o[1], vb, pa[3][0], pa[3][1]);
    pv_half<0, 4 * 4096>(o[0], vb, pa[4][0], pa[4][1]); pv_half<1, 4 * 4096>(o[1], vb, pa[4][0], pa[4][1]);
    float* wsf = (float*)(lds + DL_WS) + wid * 64;
    if (hi == 0) { wsf[r32] = ps; LSE[((size_t)br * T + (size_t)b * S + qpos) * 8 + h] = mx + __builtin_amdgcn_logf(ps); }
    asm volatile("s_waitcnt lgkmcnt(0)" ::: "memory");
    float rli[16];
#pragma unroll
    for (int r = 0; r < 16; ++r) rli[r] = __builtin_amdgcn_rcpf(wsf[crow(r, hi)]);
    unsigned short* stg = (unsigned short*)(lds + DL_OST) + wid * 2048;
    unsigned short* dst = OBR + ((size_t)br * T + (size_t)b * S + (((size_t)(256 * lb + wid * 32)) << sh) + res) * 512 + h * 64;
    store_o_tile(o, rli, stg, dst, [sh](int row) { return ((size_t)row << sh) * 512; }, lane);
    asm volatile("s_waitcnt vmcnt(0)" ::: "memory");
    __syncthreads();
}
#define DIL_DECODE(u, bh_, br_, res_, lb_, sh_, L_) const int bh_ = (u) / 96, br_ = ((u) >> 5) % 3, blk__##bh_ = (u) & 31, sh_ = 2 * br_, L_ = S >> sh_, nbl__##bh_ = L_ >> 8, res_ = blk__##bh_ / nbl__##bh_, lb_ = blk__##bh_ % nbl__##bh_
__device__ __forceinline__ void dil_phase(int wv, int u0, int ustep, int nunits, const unsigned short* __restrict__ DQ, const unsigned short* __restrict__ DK, const unsigned short* __restrict__ DV,
                                          unsigned short* __restrict__ OBR, float* __restrict__ LSE, char* lds) {
    const int wid = wv, lane = gm::lane_now(), tid = wid * 64 + lane, r32 = lane & 31, hi = lane >> 5;
    char* K_lds = lds + DL_K; char* V_lds = lds + DL_V;
    bf16x8 kk[6], qn[4]; unsigned kmask = 0u;
#define DIL_LOAD6(dst, mask, SRC, u) do { DIL_DECODE(u, bh_, br_, res_, lb_, sh_, L_); const size_t bhS_ = (size_t)bh_ * S; mask = 0u; \
        _Pragma("unroll") for (int it = 0; it < 6; ++it) { const int item = it * 512 + tid, row = item >> 3, ch = item & 7; const int l = 256 * lb_ - 64 + row; const bool valid = (l >= 0) && (l < L_); \
            const size_t src = (bhS_ + (valid ? ((size_t)l << sh_) + res_ : 0)) * 64 + ch * 8; dst[it] = *reinterpret_cast<const bf16x8*>(SRC + src); mask |= (valid ? 1u : 0u) << it; } } while (0)
#define DIL_LOADQ(u) do { DIL_DECODE(u, bh_, br_, res_, lb_, sh_, L_); const size_t qpos_ = ((size_t)(256 * lb_ + wid * 32 + r32) << sh_) + res_; const unsigned short* Qw_ = DQ + ((size_t)bh_ * S + qpos_) * 64 + hi * 8; \
        _Pragma("unroll") for (int d0 = 0; d0 < 4; ++d0) qn[d0] = *reinterpret_cast<const bf16x8*>(Qw_ + d0 * 16); } while (0)
    if (wid >= 4) __builtin_amdgcn_s_setprio(1);
    int u = u0;
    if (u < nunits) { DIL_LOAD6(kk, kmask, DK, u); DIL_LOADQ(u); }
    for (; u < nunits; u += ustep) {
        DIL_DECODE(u, bh, br, res, lb, sh, L); const int b = bh >> 3, h = bh & 7;
#pragma unroll
        for (int it = 0; it < 6; ++it) { const int item = it * 512 + tid, row = item >> 3, ch = item & 7; *(bf16x8*)(K_lds + KSWZD(row, ch * 16)) = ((kmask >> it) & 1u) ? kk[it] : bf16x8{}; }
        bf16x8 qr[4];
#pragma unroll
        for (int d0 = 0; d0 < 4; ++d0) qr[d0] = qn[d0];
        bf16x8 vv[6]; unsigned vmask; DIL_LOAD6(vv, vmask, DV, u);
        __syncthreads();
        const int ql = wid * 32 + r32; const size_t qpos = ((size_t)(256 * lb + ql) << sh) + res;
        f32x16 p[5];
#pragma unroll
        for (int j = 0; j < 5; ++j) { p[j] = f32x16{}; const int row = wid * 32 + j * 32 + r32;
#pragma unroll
            for (int d0 = 0; d0 < 4; ++d0) { const bf16x8 kf = *reinterpret_cast<const bf16x8*>(K_lds + KSWZD(row, (d0 * 16 + hi * 8) * 2)); p[j] = __builtin_amdgcn_mfma_f32_32x32x16_bf16(kf, qr[d0], p[j], 0, 0, 0); } }
        const float NEG = -1e30f;
        const int klo = 64 - 256 * lb, khi = L + 64 - 256 * lb;
        { const int t0 = max(r32, klo - wid * 32) - 4 * hi, t1 = klo - wid * 32 - 32 - 4 * hi, t3 = khi - wid * 32 - 96 - 4 * hi, t4 = min(r32 + 1, khi - wid * 32 - 128) - 4 * hi;
#pragma unroll
          for (int r = 0; r < 16; ++r) { const int c = (r & 3) + 8 * (r >> 2);
              if (c < t0) p[0][r] = NEG; if (c < t1) p[1][r] = NEG; if (c >= t3) p[3][r] = NEG; if (c >= t4) p[4][r] = NEG; } }
        float mx = rowmax32(p[0], p[1]); mx = fmaxf(mx, rowmax32(p[2], p[3]));
        { float m4 = p[4][0];
#pragma unroll
          for (int r = 1; r < 16; ++r) m4 = fmaxf(m4, p[4][r]);
          auto rr = __builtin_amdgcn_permlane32_swap(__float_as_uint(m4), __float_as_uint(m4), false, false); mx = fmaxf(mx, fmaxf(__uint_as_float(rr[0]), __uint_as_float(rr[1]))); }
        float ps = 0.f;
#pragma unroll
        for (int j = 0; j < 5; ++j)
#pragma unroll
            for (int r = 0; r < 16; ++r) { p[j][r] = __builtin_amdgcn_exp2f(p[j][r] - mx); ps += p[j][r]; }
        { auto rr = __builtin_amdgcn_permlane32_swap(__float_as_uint(ps), __float_as_uint(ps), false, false); ps = __uint_as_float(rr[0]) + __uint_as_float(rr[1]); }
        bf16x8 pa[5][2];
#pragma unroll
        for (int j = 0; j < 5; ++j) { PK4(p[j], 0, pa[j][0]); PK4(p[j], 8, pa[j][1]); }
#pragma unroll
        for (int it = 0; it < 6; ++it) { const int item = it * 512 + tid, row = item >> 3, ch = item & 7; *(bf16x8*)(V_lds + (row >> 4) * 2048 + v_st(row & 15, ch * 8)) = ((vmask >> it) & 1u) ? vv[it] : bf16x8{}; }
        __syncthreads();
        if (u + ustep < nunits) { DIL_LOAD6(kk, kmask, DK, u + ustep); DIL_LOADQ(u + ustep); }
        f32x16 o[2] = {};
        const int vb = (int)(uintptr_t)V_lds + v_rd_base(lane) + wid * 4096;
        pv_half<0, 0 * 4096>(o[0], vb, pa[0][0], pa[0][1]); pv_half<1, 0 * 4096>(o[1], vb, pa[0][0], pa[0][1]);
        pv_half<0, 1 * 4096>(o[0], vb, pa[1][0], pa[1][1]); pv_half<1, 1 * 4096>(o[1], vb, pa[1][0], pa[1][1]);
        pv_half<0, 2 * 4096>(o[0], vb, pa[2][0], pa[2][1]); pv_half<1, 2 * 4096>(o[1], vb, pa[2][0], pa[2][1]);
        pv_half<0, 3 * 4096>(o[0], vb, pa[3][0], pa[3][1]); pv_half<1, 3 * 4096>(o[1], vb, pa[3][0], pa[3][1]);
        pv_half<0, 4 * 4096>(o[0], vb, pa[4][0], pa[4][1]); pv_half<1, 4 * 4096>(o[1], vb, pa[4][0], pa[4][1]);
        float* wsf = (float*)(lds + DL_WS) + wid * 64;
        if (hi == 0) { wsf[r32] = ps; LSE[((size_t)br * T + (size_t)b * S + qpos) * 8 + h] = mx + __builtin_amdgcn_logf(ps); }
        asm volatile("s_waitcnt lgkmcnt(0)" ::: "memory");
        float rli[16];
#pragma unroll
        for (int r = 0; r < 16; ++r) rli[r] = __builtin_amdgcn_rcpf(wsf[crow(r, hi)]);
        unsigned short* stg = (unsigned short*)(lds + DL_OST) + wid * 2048;
        unsigned short* dst = OBR + ((size_t)br * T + (size_t)b * S + (((size_t)(256 * lb + wid * 32)) << sh) + res) * 512 + h * 64;
        store_o_tile(o, rli, stg, dst, [sh](int row) { return ((size_t)row << sh) * 512; }, lane);
        __syncthreads();
    }
    __builtin_amdgcn_s_setprio(0);
#undef DIL_LOAD6
#undef DIL_LOADQ
}
__device__ __forceinline__ void dil_phase2(int wv, int u0, int ustep, int nunits, const unsigned short* __restrict__ DQ, const unsigned short* __restrict__ DK, const unsigned short* __restrict__ DV,
                                           unsigned short* __restrict__ OBR, float* __restrict__ LSE, char* lds) {
    const int wid = wv, lane = gm::lane_now(), r32 = lane & 31, hi = lane >> 5;
    char* K_lds = lds + DL_K; char* V_lds = lds + DL_V;
    const unsigned lds_k = (unsigned)(uintptr_t)K_lds, lds_v = (unsigned)(uintptr_t)V_lds;
    bf16x8 qn[4];
#define GLDS16D(src, ldsaddr) __builtin_amdgcn_global_load_lds((const unsigned*)(src), (LAS unsigned*)(uintptr_t)(unsigned)(ldsaddr), 16, 0, 0)
#define DIL_DMA_K(u) do { DIL_DECODE(u, bh_, br_, res_, lb_, sh_, L_); const char* base_ = (const char*)(DK + (size_t)bh_ * S * 64); \
        _Pragma("unroll") for (int i = 0; i < 6; ++i) { const int g = wid * 6 + i, row = 8 * g + (lane >> 3), ch = (lane & 7) ^ ((row >> 1) & 7); int l = 256 * lb_ - 64 + row; l = l < 0 ? 0 : (l >= L_ ? L_ - 1 : l); \
            GLDS16D(base_ + ((size_t)((l << sh_) + res_) * 64 + ch * 8) * 2, lds_k + g * 1024); } } while (0)
#define DIL_DMA_V(u) do { DIL_DECODE(u, bh_, br_, res_, lb_, sh_, L_); const char* base_ = (const char*)(DV + (size_t)bh_ * S * 64); \
        _Pragma("unroll") for (int i = 0; i < 6; ++i) { const int g = wid * 6 + i, row = 8 * g + ((lane >> 2) & 7); int l = 256 * lb_ - 64 + row; l = l < 0 ? 0 : (l >= L_ ? L_ - 1 : l); \
            GLDS16D(base_ + ((size_t)((l << sh_) + res_) * 64 + (lane >> 5) * 32 + (lane & 3) * 8) * 2, lds_v + g * 1024); } } while (0)
#define DIL_LOADQ2(u) do { DIL_DECODE(u, bh_, br_, res_, lb_, sh_, L_); const size_t qpos_ = ((size_t)(256 * lb_ + wid * 32 + r32) << sh_) + res_; const unsigned short* Qw_ = DQ + ((size_t)bh_ * S + qpos_) * 64 + hi * 8; \
        _Pragma("unroll") for (int d0 = 0; d0 < 4; ++d0) qn[d0] = *reinterpret_cast<const bf16x8*>(Qw_ + d0 * 16); } while (0)
    if (DIL2_PRIO && wid >= 4) __builtin_amdgcn_s_setprio(1);
    int u = u0; bool first = true;
#define USEQ() asm volatile("" : "+v"(qn[0]), "+v"(qn[1]), "+v"(qn[2]), "+v"(qn[3]))
    if (u < nunits) { DIL_LOADQ2(u); asm volatile("s_waitcnt vmcnt(0)" ::: "memory"); USEQ(); DIL_DMA_K(u); }
    for (; u < nunits; u += ustep) {
        DIL_DECODE(u, bh, br, res, lb, sh, L); const int b = bh >> 3, h = bh & 7;
        if (first) asm volatile("s_waitcnt vmcnt(0)" ::: "memory"); else asm volatile("s_waitcnt vmcnt(5)" ::: "memory");
        first = false; asm volatile("s_waitcnt lgkmcnt(0)" ::: "memory"); __builtin_amdgcn_s_barrier(); asm volatile("" ::: "memory");
        DIL_DMA_V(u);
        bf16x8 qr[4];
#pragma unroll
        for (int d0 = 0; d0 < 4; ++d0) qr[d0] = qn[d0];
        const int ql = wid * 32 + r32; const size_t qpos = ((size_t)(256 * lb + ql) << sh) + res;
        f32x16 p[5];
#pragma unroll
        for (int j = 0; j < 5; ++j) { p[j] = f32x16{}; const int row = wid * 32 + j * 32 + r32;
#pragma unroll
            for (int d0 = 0; d0 < 4; ++d0) { const bf16x8 kf = *reinterpret_cast<const bf16x8*>(K_lds + KSWZD(row, (d0 * 16 + hi * 8) * 2)); p[j] = __builtin_amdgcn_mfma_f32_32x32x16_bf16(kf, qr[d0], p[j], 0, 0, 0); } }
        const bool more = u + ustep < nunits;
        if (more) DIL_LOADQ2(u + ustep);
        const float NEG = -1e30f;
        const int klo = 64 - 256 * lb, khi = L + 64 - 256 * lb;
        { const int t0 = max(r32, klo - wid * 32) - 4 * hi, t1 = klo - wid * 32 - 32 - 4 * hi, t3 = khi - wid * 32 - 96 - 4 * hi, t4 = min(r32 + 1, khi - wid * 32 - 128) - 4 * hi;
          const bool m1 = klo - wid * 32 - 32 > 0, m3 = khi - wid * 32 - 96 < 32;
#pragma unroll
          for (int r = 0; r < 16; ++r) { const int c = (r & 3) + 8 * (r >> 2); if (c < t0) p[0][r] = NEG; if (c >= t4) p[4][r] = NEG; }
          if (!DIL2_SKIPMASK || m1) {
#pragma unroll
              for (int r = 0; r < 16; ++r) { const int c = (r & 3) + 8 * (r >> 2); if (c < t1) p[1][r] = NEG; } }
          if (!DIL2_SKIPMASK || m3) {
#pragma unroll
              for (int r = 0; r < 16; ++r) { const int c = (r & 3) + 8 * (r >> 2); if (c >= t3) p[3][r] = NEG; } } }
        float mx = rowmax32(p[0], p[1]); mx = fmaxf(mx, rowmax32(p[2], p[3]));
        { float m4 = p[4][0];
#pragma unroll
          for (int r = 1; r < 16; ++r) m4 = fmaxf(m4, p[4][r]);
          auto rr = __builtin_amdgcn_permlane32_swap(__float_as_uint(m4), __float_as_uint(m4), false, false); mx = fmaxf(mx, fmaxf(__uint_as_float(rr[0]), __uint_as_float(rr[1]))); }
        float ps = 0.f;
#pragma unroll
        for (int j = 0; j < 5; ++j)
#pragma unroll
            for (int r = 0; r < 16; ++r) { p[j][r] = __builtin_amdgcn_exp2f(p[j][r] - mx); ps += p[j][r]; }
        { auto rr = __builtin_amdgcn_permlane32_swap(__float_as_uint(ps), __float_as_uint(ps), false, false); ps = __uint_as_float(rr[0]) + __uint_as_float(rr[1]); }
        bf16x8 pa[5][2];
#pragma unroll
        for (int j = 0; j < 5; ++j) { PK4(p[j], 0, pa[j][0]); PK4(p[j], 8, pa[j][1]); }
        asm volatile("s_waitcnt vmcnt(0)" ::: "memory"); USEQ();
        asm volatile("s_waitcnt lgkmcnt(0)" ::: "memory"); __builtin_amdgcn_s_barrier(); asm volatile("" ::: "memory");
        if (more) DIL_DMA_K(u + ustep);
        asm volatile("" ::: "memory");
        f32x16 o[2] = {};
        const int vb = (int)(uintptr_t)V_lds + v_rd_base(lane) + wid * 4096;
        pv_half<0, 0 * 4096>(o[0], vb, pa[0][0], pa[0][1]); pv_half<1, 0 * 4096>(o[1], vb, pa[0][0], pa[0][1]);
        pv_half<0, 1 * 4096>(o[0], vb, pa[1][0], pa[1][1]); pv_half<1, 1 * 4096>(o[1], vb, pa[1][0], pa[1][1]);
        pv_half<0, 2 * 4096>(o[0], vb, pa[2][0], pa[2][1]); pv_half<1, 2 * 4096>(o[1], vb, pa[2][0], pa[2][1]);
        pv_half<0, 3 * 4096>(o[0], vb, pa[3][0], pa[3][1]); pv_half<1, 3 * 4096>(o[1], vb, pa[3][0], pa[3][1]);
        pv_half<0, 4 * 4096>(o[0], vb, pa[4][0], pa[4][1]); pv_half<1, 4 * 4096>(o[1], vb, pa[4][0], pa[4][1]);
        float* wsf = (float*)(lds + DL_WS) + wid * 64;
        if (hi == 0) wsf[r32] = ps;
        asm volatile("s_waitcnt lgkmcnt(0)" ::: "memory");
        float rli[16];
#pragma unroll
        for (int r = 0; r < 16; ++r) rli[r] = __builtin_amdgcn_rcpf(wsf[crow(r, hi)]);
        unsigned short* stg = (unsigned short*)(lds + DL_OST) + wid * 2048;
        unsigned short* dst = OBR + ((size_t)br * T + (size_t)b * S + (((size_t)(256 * lb + wid * 32)) << sh) + res) * 512 + h * 64;
        store_o_tile(o, rli, stg, dst, [sh](int row) { return ((size_t)row << sh) * 512; }, lane);
        LSE[((size_t)br * T + (size_t)b * S + (((size_t)(256 * lb + wid * 32 + r32) << sh) + res)) * 8 + h] = mx + __builtin_amdgcn_logf(ps);
        asm volatile("" ::: "memory");
    }
    asm volatile("s_waitcnt vmcnt(0)" ::: "memory"); __syncthreads();
    __builtin_amdgcn_s_setprio(0);
#undef GLDS16D
#undef USEQ
#undef DIL_DMA_K
#undef DIL_DMA_V
#undef DIL_LOADQ2
}
__device__ __forceinline__ void dil_combine(const unsigned short* __restrict__ OBR, const float* __restrict__ LSE, unsigned short* __restrict__ CAT, int gtid, int gthreads) {
#pragma unroll 4
    for (int i = gtid; i < T * 64; i += gthreads) { const int t = i >> 6, c8 = i & 63, h = c8 >> 3;
        const float l0 = LSE[((size_t)0 * T + t) * 8 + h], l1 = LSE[((size_t)1 * T + t) * 8 + h], l2 = LSE[((size_t)2 * T + t) * 8 + h];
        const float mx = fmaxf(l0, fmaxf(l1, l2)); float w0 = __builtin_amdgcn_exp2f(l0 - mx), w1 = __builtin_amdgcn_exp2f(l1 - mx), w2 = __builtin_amdgcn_exp2f(l2 - mx);
        const float inv = 1.f / (w0 + w1 + w2); w0 *= inv; w1 *= inv; w2 *= inv;
        const u32x4 a = *(const u32x4*)(OBR + ((size_t)0 * T + t) * 512 + c8 * 8), bb = *(const u32x4*)(OBR + ((size_t)1 * T + t) * 512 + c8 * 8), cc = *(const u32x4*)(OBR + ((size_t)2 * T + t) * 512 + c8 * 8);
        u32x4 o;
#pragma unroll
        for (int k = 0; k < 4; ++k) { const float lo = w0 * __uint_as_float(a[k] << 16) + w1 * __uint_as_float(bb[k] << 16) + w2 * __uint_as_float(cc[k] << 16);
            const float hi = w0 * __uint_as_float(a[k] & 0xffff0000u) + w1 * __uint_as_float(bb[k] & 0xffff0000u) + w2 * __uint_as_float(cc[k] & 0xffff0000u); o[k] = cvtpk(lo, hi); }
        *(u32x4*)(CAT + (size_t)t * 1024 + 512 + c8 * 8) = o; }
}
#undef SBAR
}
namespace mk {
struct SchedP4 {
    __device__ __forceinline__ void a_ready(const gm::Unit&, int, int) const {}
    __device__ __forceinline__ void done(const gm::Unit&, int) const {}
    __device__ __forceinline__ void stamp(int, const gm::Unit&, int, int) const {}
    static constexpr bool GATHER = false;
    const char* A; const char* Bt; int G, c;
    __device__ __forceinline__ bool next(int i, gm::Unit& u) const { int pm, pn; if (!static_tile(i, G, c, 64, 4, pm, pn)) return false;
        u.A = A; u.Bt = Bt; u.gidx = nullptr; u.lda2 = 2048; u.ldb2 = 2048; u.arow0 = pm * 256; u.brow0 = pn * 256; u.nt = 16; u.pm = pm; u.pn = pn; u.aux = 0; return true; }
};
#ifndef WT_STORES
#define WT_STORES 0
#endif
#ifndef NT_OUT
#define NT_OUT 0
#endif
#ifndef SLOT_EMAJOR
#define SLOT_EMAJOR 0
#endif
#ifndef TOPK_SPREAD
#define TOPK_SPREAD 0
#endif
#ifndef TOPK_AGG
#define TOPK_AGG 0
#endif
#ifndef P7_PREF
#define P7_PREF 0
#endif
#ifndef P7_BATCH
#define P7_BATCH 0
#endif
#ifndef P4B_FASTPRO
#define P4B_FASTPRO 1
#endif
#ifndef P4B_PK
#define P4B_PK 1
#endif
#ifndef P4B_TWO
#define P4B_TWO 0
#endif
#ifndef X1_BF16
#define X1_BF16 1
#endif
constexpr size_t WS_X1B = WS_Q;
struct EpiP4 {
    static constexpr bool PERM = X1_BF16 ? true : false; static constexpr bool DRAIN = false;
    const float* x; float* out; const float* modf; bf16_t* x1b;
    __device__ __forceinline__ void operator()(EPI_ARGS) const {
        const int b = (u.pm * 256) >> 13; const float* gt = modf + b * 6144 + 2048;
        if (X1_BF16) {
            const int col0 = u.pn * 256 + wc * 32 + 8 * fq;
            f32x4 g[2][2];
#pragma unroll
            for (int bj = 0; bj < 2; ++bj)
#pragma unroll
                for (int n = 0; n < 2; ++n) g[bj][n] = *(const f32x4*)(gt + col0 + bj * 128 + n * 4);
#pragma unroll
            for (int ai = 0; ai < 2; ++ai)
#pragma unroll
                for (int m = 0; m < 4; ++m) { const size_t off = (size_t)(u.pm * 256 + ai * 128 + wr * 64 + m * 16 + fr) * D + col0;
#pragma unroll
                    for (int bj = 0; bj < 2; ++bj) { const f32x4 x0 = *(const f32x4*)(x + off + bj * 128), x1 = *(const f32x4*)(x + off + bj * 128 + 4);
                        *(u32x4*)(x1b + off + bj * 128) = pack8(x0 + g[bj][0] * acc[ai][bj][m][0], x1 + g[bj][1] * acc[ai][bj][m][1]); } }
            return; }
        const int col0 = u.pn * 256 + wc * 32 + 4 * fq;
        f32x4 g[2][2];
#pragma unroll
        for (int bj = 0; bj < 2; ++bj)
#pragma unroll
            for (int n = 0; n < 2; ++n) g[bj][n] = *(const f32x4*)(gt + col0 + bj * 128 + n * 16);
#pragma unroll
        for (int ai = 0; ai < 2; ++ai)
#pragma unroll
            for (int m = 0; m < 4; ++m) { const size_t off = (size_t)(u.pm * 256 + ai * 128 + wr * 64 + m * 16 + fr) * D + col0;
#pragma unroll
                for (int bj = 0; bj < 2; ++bj)
#pragma unroll
                    for (int n = 0; n < 2; ++n) { const f32x4 xv = *(const f32x4*)(x + off + bj * 128 + n * 16); *(f32x4*)(out + off + bj * 128 + n * 16) = xv + g[bj][n] * acc[ai][bj][m][n]; } }
    }
};
__device__ __forceinline__ f32x4 bf4_to_f32(u32x2 w) { f32x4 r; r.x = __uint_as_float(w.x << 16); r.y = __uint_as_float(w.x & 0xffff0000u); r.z = __uint_as_float(w.y << 16); r.w = __uint_as_float(w.y & 0xffff0000u); return r; }
__device__ __forceinline__ void p4b_rows(Frame& F, int part = 0) {
    const int tid_ = F.wave * 64 + fresh_lane();
    LAS float* WR = (LAS float*)F.lds;
    LAS float* A1 = WR + 16384;
    LAS float* A0 = A1 + 2048;
    const float* modf = (const float*)(F.ws + WS_MODF);
    if (part != 2) {
#if P4B_FASTPRO
    {
        f32x4 wv[8]; float gg[4], sc[4], sh[4];
#pragma unroll
        for (int k = 0; k < 8; ++k) wv[k] = *(const f32x4*)(F.w_router + 4 * (size_t)(tid_ + NTHREADS * k));
#pragma unroll
        for (int k = 0; k < 4; ++k) { const int i = tid_ + NTHREADS * k, b = i >> 10, j = i & 1023; gg[k] = F.g_ffn[j]; sc[k] = modf[b * 6144 + 4096 + j]; sh[k] = modf[b * 6144 + 3072 + j]; }
#pragma unroll
        for (int k = 0; k < 8; ++k) { const int q = tid_ + NTHREADS * k, j = q >> 2, e0 = (q & 3) * 4; WR[(e0 + 0) * 1024 + j] = wv[k].x; WR[(e0 + 1) * 1024 + j] = wv[k].y; WR[(e0 + 2) * 1024 + j] = wv[k].z; WR[(e0 + 3) * 1024 + j] = wv[k].w; }
#pragma unroll
        for (int k = 0; k < 4; ++k) { const int i = tid_ + NTHREADS * k; A1[i] = gg[k] * (1.f + sc[k]); A0[i] = sh[k]; }
    }
#else
    for (int i = tid_; i < 16384; i += NTHREADS) { const int j = i >> 4, e = i & 15; WR[e * 1024 + j] = F.w_router[i]; }
    for (int i = tid_; i < 2048; i += NTHREADS) { const int b = i >> 10, j = i & 1023; A1[i] = F.g_ffn[j] * (1.f + modf[b * 6144 + 4096 + j]); A0[i] = modf[b * 6144 + 3072 + j]; }
#endif
    }
    if (part == 1) return;
    __syncthreads();
#if P4B_TWO
    {
    const int gw = F.vcu * NWAVES + F.wave, NGW = F.G * NWAVES, lane = fresh_lane();
    u32x2 nxA[4], nxB[4];
    if (gw < T) { const int mB0 = gw + NGW < T ? gw + NGW : gw; const u32x2* pa = (const u32x2*)((const bf16_t*)(F.ws + WS_X1B) + (size_t)gw * D) + lane; const u32x2* pb = (const u32x2*)((const bf16_t*)(F.ws + WS_X1B) + (size_t)mB0 * D) + lane;
#pragma unroll
        for (int j = 0; j < 4; ++j) { nxA[j] = pa[64 * j]; nxB[j] = pb[64 * j]; } }
    for (int m = gw; m < T; m += 2 * NGW) { const bool hasB = m + NGW < T; const int mA = m, mB = hasB ? m + NGW : m; const int bA = mA >> 13, bB = mB >> 13;
        f32x4 vA[4], vB[4]; float ssA = 0.f, ssB = 0.f;
#pragma unroll
        for (int j = 0; j < 4; ++j) { vA[j] = bf4_to_f32(nxA[j]); vB[j] = bf4_to_f32(nxB[j]); }
        if (m + 2 * NGW < T) { const int nA = m + 2 * NGW, nB = nA + NGW < T ? nA + NGW : nA; const u32x2* pa = (const u32x2*)((const bf16_t*)(F.ws + WS_X1B) + (size_t)nA * D) + lane; const u32x2* pb = (const u32x2*)((const bf16_t*)(F.ws + WS_X1B) + (size_t)nB * D) + lane;
#pragma unroll
            for (int j = 0; j < 4; ++j) { nxA[j] = pa[64 * j]; nxB[j] = pb[64 * j]; } }
#pragma unroll
        for (int j = 0; j < 4; ++j) { ssA += (vA[j].x * vA[j].x + vA[j].y * vA[j].y) + (vA[j].z * vA[j].z + vA[j].w * vA[j].w); ssB += (vB[j].x * vB[j].x + vB[j].y * vB[j].y) + (vB[j].z * vB[j].z + vB[j].w * vB[j].w); }
#pragma unroll
        for (int o = 1; o < 64; o <<= 1) { ssA += __shfl_xor(ssA, o); ssB += __shfl_xor(ssB, o); }
        const float rA = rsqrtf(ssA * (1.f / D) + EPS), rB = rsqrtf(ssB * (1.f / D) + EPS);
        unsigned long long* oA8 = (unsigned long long*)((bf16_t*)(F.ws + WS_HB) + (size_t)mA * D) + lane; unsigned long long* oB8 = (unsigned long long*)((bf16_t*)(F.ws + WS_HB) + (size_t)mB * D) + lane;
        float lgA[16], lgB[16];
#pragma unroll
        for (int e = 0; e < 16; ++e) { lgA[e] = 0.f; lgB[e] = 0.f; }
#pragma unroll
        for (int j = 0; j < 4; ++j) { asm volatile("" ::: "memory");
            const f32x4 a1A = *(const LAS f32x4*)(A1 + bA * 1024 + 4 * lane + 256 * j), a0A = *(const LAS f32x4*)(A0 + bA * 1024 + 4 * lane + 256 * j);
            const f32x4 a1B = *(const LAS f32x4*)(A1 + bB * 1024 + 4 * lane + 256 * j), a0B = *(const LAS f32x4*)(A0 + bB * 1024 + 4 * lane + 256 * j);
            const f32x4 oA = vA[j] * rA * a1A + a0A, oB = vB[j] * rB * a1B + a0B;
            oA8[64 * j] = (unsigned long long)pk2(oA.x, oA.y) | ((unsigned long long)pk2(oA.z, oA.w) << 32);
            if (hasB) oB8[64 * j] = (unsigned long long)pk2(oB.x, oB.y) | ((unsigned long long)pk2(oB.z, oB.w) << 32);
#pragma unroll
            for (int e0 = 0; e0 < 16; e0 += 4) { asm volatile("" ::: "memory");
#pragma unroll
                for (int e = e0; e < e0 + 4; ++e) { const f32x4 w = *(const LAS f32x4*)(WR + e * 1024 + 4 * lane + 256 * j);
                    lgA[e] += (oA.x * w.x + oA.y * w.y) + (oA.z * w.z + oA.w * w.w); lgB[e] += (oB.x * w.x + oB.y * w.y) + (oB.z * w.z + oB.w * w.w); } } }
#pragma unroll
        for (int rr = 0; rr < 2; ++rr) { if (rr == 1 && !hasB) break;
            const int mm = rr ? mB : mA, b = mm >> 13, s = mm & 8191;
            float lg[16];
#pragma unroll
            for (int e = 0; e < 16; ++e) lg[e] = rr ? lgB[e] : lgA[e];
            float w8[8], w4[4], w2[2], w1;
            { const bool up = lane & 32;
#pragma unroll
              for (int i = 0; i < 8; ++i) { const float snd = up ? lg[i] : lg[8 + i], kp = up ? lg[8 + i] : lg[i]; w8[i] = kp + __shfl_xor(snd, 32); } }
            { const bool up = lane & 16;
#pragma unroll
              for (int i = 0; i < 4; ++i) { const float snd = up ? w8[i] : w8[4 + i], kp = up ? w8[4 + i] : w8[i]; w4[i] = kp + __shfl_xor(snd, 16); } }
            { const bool up = lane & 8;
#pragma unroll
              for (int i = 0; i < 2; ++i) { const float snd = up ? w4[i] : w4[2 + i], kp = up ? w4[2 + i] : w4[i]; w2[i] = kp + __shfl_xor(snd, 8); } }
            { const bool up = lane & 4; const float snd = up ? w2[0] : w2[1], kp = up ? w2[1] : w2[0]; w1 = kp + __shfl_xor(snd, 4); }
            w1 += __shfl_xor(w1, 1); w1 += __shfl_xor(w1, 2);
            const int e = lane >> 2; const float logit = w1 + F.b_router[e];
            float mx = logit;
#pragma unroll
            for (int o = 4; o < 64; o <<= 1) mx = fmaxf(mx, __shfl_xor(mx, o));
            const float ex = __expf(logit - mx); float den = ex;
#pragma unroll
            for (int o = 4; o < 64; o <<= 1) den += __shfl_xor(den, o);
            if ((lane & 3) == 0) ((float*)(F.ws + WS_AFF))[((size_t)b * 16 + e) * S + s] = ex / den; }
    }
    }
#else
    const int gw = F.vcu * NWAVES + F.wave, NGW = F.G * NWAVES, lane = fresh_lane();
    u32x2 nx[4], ny[4];
    if (X1_BF16 && gw < T) { const u32x2* xb0 = (const u32x2*)((const bf16_t*)(F.ws + WS_X1B) + (size_t)gw * D) + lane; const u32x2* xb1 = (const u32x2*)((const bf16_t*)(F.ws + WS_X1B) + (size_t)(gw + NGW < T ? gw + NGW : gw) * D) + lane;
#pragma unroll
        for (int j = 0; j < 4; ++j) { nx[j] = xb0[64 * j]; ny[j] = xb1[64 * j]; } }
    for (int m = gw; m < T; m += NGW) { const int b = m >> 13, s = m & 8191;
        const f32x4* xr = (const f32x4*)(F.out + (size_t)m * D) + lane; f32x4 v[4]; float ss = 0.f;
        if (X1_BF16) {
#pragma unroll
            for (int j = 0; j < 4; ++j) { v[j] = bf4_to_f32(nx[j]); nx[j] = ny[j]; }
            if (m + 2 * NGW < T) { const u32x2* xbn = (const u32x2*)((const bf16_t*)(F.ws + WS_X1B) + (size_t)(m + 2 * NGW) * D) + lane;
#pragma unroll
                for (int j = 0; j < 4; ++j) ny[j] = xbn[64 * j]; } }
#pragma unroll
        for (int j = 0; j < 4; ++j) { if (!X1_BF16) v[j] = xr[64 * j]; ss += (v[j].x * v[j].x + v[j].y * v[j].y) + (v[j].z * v[j].z + v[j].w * v[j].w); }
        const float rstd = rsqrtf(wave_sum(ss) * (1.f / D) + EPS);
        unsigned long long* o8 = (unsigned long long*)((bf16_t*)(F.ws + WS_HB) + (size_t)m * D) + lane;
        float lg[16];
#if P4B_PK
        f32x2 lg2[16];
#pragma unroll
        for (int e = 0; e < 16; ++e) lg2[e] = (f32x2){0.f, 0.f};
#pragma unroll
        for (int j = 0; j < 4; ++j) { asm volatile("" ::: "memory");
            const f32x4 a1 = *(const LAS f32x4*)(A1 + b * 1024 + 4 * lane + 256 * j), a0 = *(const LAS f32x4*)(A0 + b * 1024 + 4 * lane + 256 * j);
            const f32x4 o = v[j] * rstd * a1 + a0; o8[64 * j] = (unsigned long long)pk2(o.x, o.y) | ((unsigned long long)pk2(o.z, o.w) << 32);
            const f32x2 oxy = {o.x, o.y}, ozw = {o.z, o.w};
            f32x4 w[16];
#pragma unroll
            for (int e = 0; e < 16; ++e) w[e] = *(const LAS f32x4*)(WR + e * 1024 + 4 * lane + 256 * j);
            asm volatile("s_waitcnt lgkmcnt(0)" ::: "memory");
#pragma unroll
            for (int e = 0; e < 16; ++e) { const f32x2 wxy = {w[e].x, w[e].y}, wzw = {w[e].z, w[e].w};
                lg2[e] = __builtin_elementwise_fma(oxy, wxy, lg2[e]); lg2[e] = __builtin_elementwise_fma(ozw, wzw, lg2[e]); } }
#pragma unroll
        for (int e = 0; e < 16; ++e) lg[e] = lg2[e].x + lg2[e].y;
#else
#pragma unroll
        for (int e = 0; e < 16; ++e) lg[e] = 0.f;
#pragma unroll
        for (int j = 0; j < 4; ++j) { asm volatile("" ::: "memory");
            const f32x4 a1 = *(const LAS f32x4*)(A1 + b * 1024 + 4 * lane + 256 * j), a0 = *(const LAS f32x4*)(A0 + b * 1024 + 4 * lane + 256 * j);
            const f32x4 o = v[j] * rstd * a1 + a0; o8[64 * j] = (unsigned long long)pk2(o.x, o.y) | ((unsigned long long)pk2(o.z, o.w) << 32);
#pragma unroll
            for (int e = 0; e < 16; ++e) { const f32x4 w = *(const LAS f32x4*)(WR + e * 1024 + 4 * lane + 256 * j); lg[e] += (o.x * w.x + o.y * w.y) + (o.z * w.z + o.w * w.w); } }
#endif
        float w8[8], w4[4], w2[2], w1;
        { const bool up = lane & 32;
#pragma unroll
          for (int i = 0; i < 8; ++i) { const float snd = up ? lg[i] : lg[8 + i], kp = up ? lg[8 + i] : lg[i]; w8[i] = kp + __shfl_xor(snd, 32); } }
        { const bool up = lane & 16;
#pragma unroll
          for (int i = 0; i < 4; ++i) { const float snd = up ? w8[i] : w8[4 + i], kp = up ? w8[4 + i] : w8[i]; w4[i] = kp + __shfl_xor(snd, 16); } }
        { const bool up = lane & 8;
#pragma unroll
          for (int i = 0; i < 2; ++i) { const float snd = up ? w4[i] : w4[2 + i], kp = up ? w4[2 + i] : w4[i]; w2[i] = kp + __shfl_xor(snd, 8); } }
        { const bool up = lane & 4; const float snd = up ? w2[0] : w2[1], kp = up ? w2[1] : w2[0]; w1 = kp + __shfl_xor(snd, 4); }
        w1 += __shfl_xor(w1, 1); w1 += __shfl_xor(w1, 2);
        const int e = lane >> 2; const float logit = w1 + F.b_router[e];
        float mx = logit;
#pragma unroll
        for (int o = 4; o < 64; o <<= 1) mx = fmaxf(mx, __shfl_xor(mx, o));
        const float ex = __expf(logit - mx); float den = ex;
#pragma unroll
        for (int o = 4; o < 64; o <<= 1) den += __shfl_xor(den, o);
        if ((lane & 3) == 0) ((float*)(F.ws + WS_AFF))[((size_t)b * 16 + e) * S + s] = ex / den;
    }
#endif
    __syncthreads();
}
__device__ __forceinline__ void p5_topk(Frame& F) {
    int be = F.vcu;
    if (TOPK_SPREAD && F.G == 256) {
        const int j = F.vcu & 31, x = F.vcu >> 5;
        if (j >= 4) { if (WD_IN_P5 && !WD_IN_ATTN) wd_convert(F, 32, x * 28 + j - 4, 224); return; }
        be = x * 4 + j;
    } else if (F.vcu >= 32) { if (WD_IN_P5 && !WD_IN_ATTN && F.G > 32) wd_convert(F, 32); return; }
    const int b = be >> 4, e = be & 15, tid = F.wave * 64 + fresh_lane();
    LAS unsigned* vals = (LAS unsigned*)F.lds;
    LAS unsigned* hist = vals + 8192;
    LAS unsigned* suf = hist + 256;
    LAS unsigned* misc = suf + 264;
    LAS unsigned* wtot = misc + 8;
    const float* a = (const float*)(F.ws + WS_AFF) + (size_t)be * S;
    for (int i = tid; i < 8192; i += NTHREADS) vals[i] = __float_as_uint(a[i]);
    if (tid == 0) { misc[0] = 0u; misc[1] = 1024u; }
    __syncthreads();
    for (int pass = 0; pass < 4; ++pass) {
        const int sh = 24 - 8 * pass; const unsigned prefix = misc[0], k = misc[1]; const unsigned himask = pass == 0 ? 0u : (0xffffffffu << (sh + 8));
        if (tid < 256) hist[tid] = 0u;
        __syncthreads();
        {
            const unsigned cand = (vals[0] >> sh) & 255u; unsigned nc = 0u;
            if (TOPK_AGG && pass == 0) {
                const int ln = tid & 63;
                for (int i = tid; i < 8192; i += NTHREADS) { const unsigned bn = (vals[i] >> sh) & 255u; unsigned long long m = __ballot(1);
                    while (m) { const int src = __ffsll((long long)m) - 1; const unsigned b0 = (unsigned)__shfl((int)bn, src); const unsigned long long same = __ballot(bn == b0);
                        if (ln == src) __hip_atomic_fetch_add(&hist[b0], (unsigned)__popcll(same), __ATOMIC_RELAXED, __HIP_MEMORY_SCOPE_WORKGROUP); m &= ~same; } }
            } else
            for (int i = tid; i < 8192; i += NTHREADS) { const unsigned v = vals[i]; if ((v & himask) == prefix) { const unsigned bn = (v >> sh) & 255u; if (bn == cand) ++nc; else __hip_atomic_fetch_add(&hist[bn], 1u, __ATOMIC_RELAXED, __HIP_MEMORY_SCOPE_WORKGROUP); } }
#pragma unroll
            for (int o = 1; o < 64; o <<= 1) nc += __shfl_xor(nc, o);
            if ((tid & 63) == 0 && nc) __hip_atomic_fetch_add(&hist[cand], nc, __ATOMIC_RELAXED, __HIP_MEMORY_SCOPE_WORKGROUP);
        }
        __syncthreads();
        if (tid < 64) {
            const int l = tid; const unsigned h0 = hist[4 * l], h1 = hist[4 * l + 1], h2 = hist[4 * l + 2], h3 = hist[4 * l + 3];
            const unsigned tot = (h0 + h1) + (h2 + h3); unsigned inc = tot;
#pragma unroll
            for (int o = 1; o < 64; o <<= 1) { const unsigned t = __shfl_down(inc, o); if (l + o < 64) inc += t; }
            const unsigned above = inc - tot;
            const unsigned s3 = above + h3, s2 = s3 + h2, s1 = s2 + h1, s0 = s1 + h0;
            int bin = -1; unsigned gt = 0u;
            if (s3 >= k && above < k) { bin = 4 * l + 3; gt = above; } else if (s2 >= k && s3 < k) { bin = 4 * l + 2; gt = s3; } else if (s1 >= k && s2 < k) { bin = 4 * l + 1; gt = s2; } else if (s0 >= k && s1 < k) { bin = 4 * l; gt = s1; }
            if (bin >= 0) { misc[0] = prefix | ((unsigned)bin << sh); misc[1] = k - gt; }
        }
        __syncthreads();
    }
    const unsigned thr = misc[0], need = misc[1];
    unsigned gtc = 0, eqc = 0;
#pragma unroll
    for (int i = 0; i < 16; ++i) { const unsigned v = vals[tid * 16 + i]; gtc += v > thr; eqc += v == thr; }
    unsigned gi = gtc, ei = eqc; const int lane = fresh_lane(), wv = F.wave;
#pragma unroll
    for (int o = 1; o < 64; o <<= 1) { const unsigned g2 = __shfl_up(gi, o), e2 = __shfl_up(ei, o); if (lane >= o) { gi += g2; ei += e2; } }
    if (lane == 63) { wtot[wv] = gi; wtot[8 + wv] = ei; }
    __syncthreads();
    unsigned gbase = 0, ebase = 0, gtotal = 0;
    for (int w = 0; w < 8; ++w) { const unsigned g = wtot[w], q = wtot[8 + w]; if (w < wv) { gbase += g; ebase += q; } gtotal += g; }
    unsigned gpos = gbase + gi - gtc, epos = ebase + ei - eqc;
    int* IDX = (int*)(F.ws + WS_IDX) + (e * 2 + b) * 1024; float* GATE = (float*)(F.ws + WS_GATE) + (e * 2 + b) * 1024; int* SLOT = (int*)(F.ws + WS_SLOT);
#pragma unroll
    for (int i = 0; i < 16; ++i) { const int s = tid * 16 + i; const unsigned v = vals[s]; int c = -1;
        if (v > thr) c = (int)gpos++; else if (v == thr) { if (epos < need) c = (int)(gtotal + epos); ++epos; }
        if (c >= 0) { IDX[c] = b * S + s; GATE[c] = __uint_as_float(v); }
        const int code = c >= 0 ? (e * 2 + b) * 1024 + c : -1;
        if (SLOT_EMAJOR) vals[s] = (unsigned)code; else SLOT[(size_t)(b * S + s) * 16 + e] = code; }
    if (SLOT_EMAJOR) {
        __syncthreads();
        for (int i = tid; i < 8192; i += NTHREADS) SLOT[(size_t)e * T + (size_t)b * S + i] = (int)vals[i]; }
}
struct SchedP6a {
    __device__ __forceinline__ void a_ready(const gm::Unit&, int, int) const {}
    __device__ __forceinline__ void done(const gm::Unit&, int) const {}
    __device__ __forceinline__ void stamp(int, const gm::Unit&, int, int) const {}
    static constexpr bool GATHER = true;
    const char* A; const char* W; const int* idx; int G, vcu;
    __device__ __forceinline__ bool next(int i, gm::Unit& u) const {
        int e, pmu, pn;
        if (G == 256) { if (i >= 4) return false; const int xcd = vcu >> 5, j = vcu & 31; e = xcd + 8 * (i >> 1); const int sub = (i & 1) * 32 + j; pmu = sub >> 3; pn = sub & 7; }
        else { const int L = i * G + vcu; if (L >= 1024) return false; e = L >> 6; pmu = (L >> 3) & 7; pn = L & 7; }
        u.A = A; u.gidx = idx + e * 2048 + pmu * 256; u.lda2 = 2048; u.arow0 = 0; u.Bt = W + (size_t)e * 2048 * 2048; u.brow0 = pn * 256; u.ldb2 = 2048; u.nt = 16; u.pm = e * 8 + pmu; u.pn = pn; u.aux = e; return true; }
};
#ifndef GATE_PRE
#define GATE_PRE 0
#endif
#ifndef SILU_RCP
#define SILU_RCP 1
#endif
__device__ __forceinline__ float silu_ep(float v) { return SILU_RCP ? v * __builtin_amdgcn_rcpf(1.f + __builtin_amdgcn_exp2f(-1.4426950408889634f * v)) : siluf(v); }
struct EpiP6a {
    static constexpr bool PERM = true; static constexpr bool DRAIN = false;
    bf16_t* H;
    __device__ __forceinline__ void operator()(EPI_ARGS) const {
#pragma unroll
        for (int ai = 0; ai < 2; ++ai)
#pragma unroll
            for (int m = 0; m < 4; ++m) { const size_t row = (size_t)u.pm * 256 + ai * 128 + wr * 64 + m * 16 + fr;
                f32x4 h0, h1;
#pragma unroll
                for (int j = 0; j < 4; ++j) { h0[j] = silu_ep(acc[ai][0][m][0][j]) * acc[ai][1][m][0][j]; h1[j] = silu_ep(acc[ai][0][m][1][j]) * acc[ai][1][m][1][j]; }
                if (WT_STORES) store16_sc1(H + row * 1024 + u.pn * 128 + wc * 32 + 8 * fq, pack8(h0, h1)); else *(u32x4*)(H + row * 1024 + u.pn * 128 + wc * 32 + 8 * fq) = pack8(h0, h1); }
    }
};
struct SchedP6b {
    __device__ __forceinline__ void a_ready(const gm::Unit&, int, int) const {}
    __device__ __forceinline__ void done(const gm::Unit&, int) const {}
    __device__ __forceinline__ void stamp(int, const gm::Unit&, int, int) const {}
    static constexpr bool GATHER = false;
    const char* A; const char* W; int G, vcu;
    __device__ __forceinline__ bool next(int i, gm::Unit& u) const {
        int e, pmu, pn;
        if (G == 256) { if (i >= 2) return false; const int xcd = vcu >> 5, j = vcu & 31; e = xcd + 8 * i; pmu = j >> 2; pn = j & 3; }
        else { const int L = i * G + vcu; if (L >= 512) return false; e = L >> 5; pmu = (L >> 2) & 7; pn = L & 3; }
        u.A = A; u.gidx = nullptr; u.lda2 = 2048; u.arow0 = (e * 8 + pmu) * 256; u.Bt = W + (size_t)e * 1024 * 2048; u.brow0 = pn * 256; u.ldb2 = 2048; u.nt = 16; u.pm = e * 8 + pmu; u.pn = pn; u.aux = e; return true; }
};
struct EpiP6b {
    static constexpr bool PERM = true; static constexpr bool DRAIN = false;
    bf16_t* Y; const float* gate;
    __device__ __forceinline__ void operator()(EPI_ARGS) const {
        float g8[2][4];
#pragma unroll
        for (int ai = 0; ai < 2; ++ai)
#pragma unroll
            for (int m = 0; m < 4; ++m) g8[ai][m] = gate[(size_t)u.pm * 256 + ai * 128 + wr * 64 + m * 16 + fr];
#pragma unroll
        for (int ai = 0; ai < 2; ++ai)
#pragma unroll
            for (int m = 0; m < 4; ++m) { const size_t row = (size_t)u.pm * 256 + ai * 128 + wr * 64 + m * 16 + fr; const float g = GATE_PRE ? g8[ai][m] : gate[row];
#pragma unroll
                for (int bj = 0; bj < 2; ++bj) { if (WT_STORES) store16_sc1(Y + row * 1024 + u.pn * 256 + bj * 128 + wc * 32 + 8 * fq, pack8(acc[ai][bj][m][0] * g, acc[ai][bj][m][1] * g)); else *(u32x4*)(Y + row * 1024 + u.pn * 256 + bj * 128 + wc * 32 + 8 * fq) = pack8(acc[ai][bj][m][0] * g, acc[ai][bj][m][1] * g); } }
    }
};
__device__ __forceinline__ void p7_final(Frame& F) {
    const float* modf = (const float*)(F.ws + WS_MODF); const int* SLOT = (const int*)(F.ws + WS_SLOT); const bf16_t* Y = (const bf16_t*)(F.ws + WS_Y);
    const int gw = F.vcu * NWAVES + F.wave, NGW = F.G * NWAVES, lane = fresh_lane();
#if P7_PREF
    int nsl0 = -1, nsl1 = -1; u32x2 nb0[4], nb1[4];
    if (gw < T) { const int q1 = gw + NGW < T ? gw + NGW : gw; nsl0 = lane < 16 ? SLOT[SLOT_EMAJOR ? (size_t)lane * T + gw : (size_t)gw * 16 + lane] : -1; nsl1 = lane < 16 ? SLOT[SLOT_EMAJOR ? (size_t)lane * T + q1 : (size_t)q1 * 16 + lane] : -1;
        const u32x2* pb0 = (const u32x2*)((const bf16_t*)(F.ws + WS_X1B) + (size_t)gw * D) + lane; const u32x2* pb1 = (const u32x2*)((const bf16_t*)(F.ws + WS_X1B) + (size_t)q1 * D) + lane;
#pragma unroll
        for (int j = 0; j < 4; ++j) { nb0[j] = pb0[64 * j]; nb1[j] = pb1[64 * j]; } }
#endif
    for (int m0 = gw; m0 < T; m0 += 2 * NGW) {
        const int m1 = m0 + NGW; const bool has1 = m1 < T; const int mm1 = has1 ? m1 : m0;
        f32x4* xr0 = (f32x4*)(F.out + (size_t)m0 * D) + lane; f32x4* xr1 = (f32x4*)(F.out + (size_t)mm1 * D) + lane; f32x4 v0[4], v1[4], a0[4], a1[4];
#if P7_PREF
        const int sl0 = nsl0, sl1 = nsl1;
#pragma unroll
        for (int j = 0; j < 4; ++j) { v0[j] = bf4_to_f32(nb0[j]); v1[j] = bf4_to_f32(nb1[j]); a0[j] = (f32x4){0.f, 0.f, 0.f, 0.f}; a1[j] = (f32x4){0.f, 0.f, 0.f, 0.f}; }
        if (m0 + 2 * NGW < T) { const int q0 = m0 + 2 * NGW, q1 = q0 + NGW < T ? q0 + NGW : q0; nsl0 = lane < 16 ? SLOT[SLOT_EMAJOR ? (size_t)lane * T + q0 : (size_t)q0 * 16 + lane] : -1; nsl1 = lane < 16 ? SLOT[SLOT_EMAJOR ? (size_t)lane * T + q1 : (size_t)q1 * 16 + lane] : -1;
            const u32x2* pb0 = (const u32x2*)((const bf16_t*)(F.ws + WS_X1B) + (size_t)q0 * D) + lane; const u32x2* pb1 = (const u32x2*)((const bf16_t*)(F.ws + WS_X1B) + (size_t)q1 * D) + lane;
#pragma unroll
            for (int j = 0; j < 4; ++j) { nb0[j] = pb0[64 * j]; nb1[j] = pb1[64 * j]; } }
#else
        const u32x2* xb0 = (const u32x2*)((const bf16_t*)(F.ws + WS_X1B) + (size_t)m0 * D) + lane; const u32x2* xb1 = (const u32x2*)((const bf16_t*)(F.ws + WS_X1B) + (size_t)mm1 * D) + lane;
#pragma unroll
        for (int j = 0; j < 4; ++j) { if (X1_BF16) { v0[j] = bf4_to_f32(xb0[64 * j]); v1[j] = bf4_to_f32(xb1[64 * j]); } else { v0[j] = xr0[64 * j]; v1[j] = xr1[64 * j]; } a0[j] = (f32x4){0.f, 0.f, 0.f, 0.f}; a1[j] = (f32x4){0.f, 0.f, 0.f, 0.f}; }
        const int sl0 = lane < 16 ? SLOT[SLOT_EMAJOR ? (size_t)lane * T + m0 : (size_t)m0 * 16 + lane] : -1, sl1 = lane < 16 ? SLOT[SLOT_EMAJOR ? (size_t)lane * T + mm1 : (size_t)mm1 * 16 + lane] : -1;
#endif
#if P7_BATCH
        {
            unsigned mk0 = (unsigned)__ballot(sl0 >= 0) & 0xffffu, mk1 = (unsigned)__ballot(sl1 >= 0) & 0xffffu;
            while (mk0 | mk1) {
                int s[4] = {-1, -1, -1, -1};
                if (mk0) { const int e = __builtin_ctz(mk0); mk0 &= mk0 - 1u; s[0] = __builtin_amdgcn_readlane(sl0, e); }
                if (mk0) { const int e = __builtin_ctz(mk0); mk0 &= mk0 - 1u; s[1] = __builtin_amdgcn_readlane(sl0, e); }
                if (mk1) { const int e = __builtin_ctz(mk1); mk1 &= mk1 - 1u; s[2] = __builtin_amdgcn_readlane(sl1, e); }
                if (mk1) { const int e = __builtin_ctz(mk1); mk1 &= mk1 - 1u; s[3] = __builtin_amdgcn_readlane(sl1, e); }
                u32x2 w[4][4];
#pragma unroll
                for (int q = 0; q < 4; ++q) { const u32x2* yr = (const u32x2*)(Y + (size_t)(s[q] >= 0 ? s[q] : 0) * 1024) + lane;
#pragma unroll
                    for (int j = 0; j < 4; ++j) w[q][j] = yr[64 * j]; }
#pragma unroll
                for (int q = 0; q < 4; ++q) { if (s[q] >= 0) {
#pragma unroll
                    for (int j = 0; j < 4; ++j) { const f32x4 y = bf4_to_f32(w[q][j]); if (q < 2) a0[j] = a0[j] + y; else a1[j] = a1[j] + y; } } }
            }
        }
#else
        for (int e = 0; e < 16; ++e) { const int s0 = __shfl(sl0, e), s1 = __shfl(sl1, e);
            if (s0 >= 0) { const u32x2* yr = (const u32x2*)(Y + (size_t)s0 * 1024) + lane;
#pragma unroll
                for (int j = 0; j < 4; ++j) { const u32x2 w = yr[64 * j]; a0[j].x += __uint_as_float(w.x << 16); a0[j].y += __uint_as_float(w.x & 0xffff0000u); a0[j].z += __uint_as_float(w.y << 16); a0[j].w += __uint_as_float(w.y & 0xffff0000u); } }
            if (s1 >= 0) { const u32x2* yr = (const u32x2*)(Y + (size_t)s1 * 1024) + lane;
#pragma unroll
                for (int j = 0; j < 4; ++j) { const u32x2 w = yr[64 * j]; a1[j].x += __uint_as_float(w.x << 16); a1[j].y += __uint_as_float(w.x & 0xffff0000u); a1[j].z += __uint_as_float(w.y << 16); a1[j].w += __uint_as_float(w.y & 0xffff0000u); } } }
#endif
        float ss0 = 0.f, ss1 = 0.f; const int b0 = m0 >> 13, b1 = mm1 >> 13;
#pragma unroll
        for (int j = 0; j < 4; ++j) { const f32x4 g0 = *(const f32x4*)(modf + b0 * 6144 + 5120 + 4 * lane + 256 * j), g1 = *(const f32x4*)(modf + b1 * 6144 + 5120 + 4 * lane + 256 * j);
            v0[j] = v0[j] + g0 * a0[j]; v1[j] = v1[j] + g1 * a1[j];
            ss0 += (v0[j].x * v0[j].x + v0[j].y * v0[j].y) + (v0[j].z * v0[j].z + v0[j].w * v0[j].w); ss1 += (v1[j].x * v1[j].x + v1[j].y * v1[j].y) + (v1[j].z * v1[j].z + v1[j].w * v1[j].w); }
        const float r0 = rsqrtf(wave_sum(ss0) * (1.f / D) + EPS), r1 = rsqrtf(wave_sum(ss1) * (1.f / D) + EPS);
#pragma unroll
        for (int j = 0; j < 4; ++j) { const f32x4 g = *(const f32x4*)(F.g_final + 4 * lane + 256 * j); if (NT_OUT) { __builtin_nontemporal_store(v0[j] * r0 * g, xr0 + 64 * j); if (has1) __builtin_nontemporal_store(v1[j] * r1 * g, xr1 + 64 * j); } else { xr0[64 * j] = v0[j] * r0 * g; if (has1) xr1[64 * j] = v1[j] * r1 * g; } }
    }
}
}
#ifndef MLA_STAG
#define MLA_STAG mla_unit_v9
#endif
#ifndef MLA_V4
#define MLA_V4 1
#endif
#ifndef MERGE_P12
#define MERGE_P12 1
#endif
#ifndef DIL_PIPE
#define DIL_PIPE 2
#endif
#ifndef MLA_UNIT
#define MLA_UNIT mla_unit_v2
#endif
#ifndef FUZZY_P4B
#define FUZZY_P4B 1
#endif
#ifndef FOUR_SLOTS
#define FOUR_SLOTS 0
#endif
#ifndef CSLOT_XCD
#define CSLOT_XCD 0
#endif
#ifndef EXP_SLOTS
#define EXP_SLOTS 3
#endif
#ifndef XBAR_PROBE
#define XBAR_PROBE 0
#endif
namespace mk {
namespace cg = cooperative_groups;
__global__ void __launch_bounds__(NTHREADS, 2) mega(Args args) {
    extern __shared__ __attribute__((aligned(16))) unsigned char lds_raw[];
    cg::grid_group grid = cg::this_grid();
    Frame F;
    F.lds = (LAS unsigned char*)lds_raw; F.ws = args.ws; F.out = args.out;
    F.wave = __builtin_amdgcn_readfirstlane((int)(threadIdx.x >> 6));
    F.G = gridDim.x; { const int bx = blockIdx.x; F.vcu = (F.G % 8 == 0) ? (bx % 8) * (F.G / 8) + bx / 8 : bx; }
    F.x = (const float*)args.in[0]; F.c = (const float*)args.in[1]; F.pos = (const int*)args.in[2]; F.w_ada = (const float*)args.in[3]; F.b_ada = (const float*)args.in[4];
    F.g_mix = (const float*)args.in[5]; F.w_in = (const float*)args.in[6]; F.g_q = (const float*)args.in[7]; F.w_uq = (const float*)args.in[8]; F.g_kv = (const float*)args.in[9];
    F.w_ukv = (const float*)args.in[10]; F.w_out = (const float*)args.in[11]; F.g_ffn = (const float*)args.in[12]; F.w_router = (const float*)args.in[13]; F.b_router = (const float*)args.in[14];
    F.w_gate = (const float*)args.in[15]; F.w_up = (const float*)args.in[16]; F.w_down = (const float*)args.in[17]; F.g_final = (const float*)args.in[18];
    const int lo = args.ph_lo, hi = args.ph_hi;
    volatile LAS unsigned* MISC = (volatile LAS unsigned*)(F.lds + LDS_BYTES - 256);
    { const int l0 = fresh_lane(); if (F.wave == 0) MISC[l0] = 0u; }
    __syncthreads();
    XcdBarrier xbar = xcd_barrier_post((unsigned*)(F.ws + WS_CTL) + 1024 + args.li * 4096, MISC + 8, F.wave == 0 && fresh_lane() == 0);
#define IN(k) (lo <= (k) && (k) < hi)
#ifndef CG_SEAMS
#define CG_SEAMS 0x000
#endif
#define SEAM(k) do { if (IN(k) && IN((k) + 1)) { if ((CG_SEAMS >> (k)) & 1) grid.sync(); else xcd_barrier(xbar, F.wave == 0 && fresh_lane() == 0); } } while (0)
    if (IN(0)) { p0_prologue(F); } if (!P0_MERGE) SEAM(0);
    if (IN(1)) { p0b_rows(F); } SEAM(1);
#if XBAR_PROBE
    for (int q = 0; q < XBAR_PROBE; ++q) xcd_barrier(xbar, F.wave == 0 && fresh_lane() == 0);
#endif
#if MERGE_P12
    if (IN(2)) {
#if P12_STAMP
        if (F.wave == 0 && fresh_lane() == 0) { unsigned long long* ts = (unsigned long long*)(F.ws + 128 * KiB) + (size_t)blockIdx.x * 8; ts[0] = __builtin_amdgcn_s_memrealtime(); ts[7] = 0; }
#endif
        SchedP12 S{(const char*)(F.ws + WS_HB), (const char*)(F.ws + WS_WIN), (const char*)(F.ws + WS_CQ), (const char*)(F.ws + WS_WUQ), (const char*)(F.ws + WS_WUKV), (unsigned*)(F.ws + WS_PCNT), F.G, F.vcu, (int)blockIdx.x};
        EpiP12 E{F.ws}; gm::gemm_phase<EpiP12, SchedP12>(F.lds, S, E, F.wave); } SEAM(3);
#else
    if (IN(2)) { SchedP1 S{(const char*)(F.ws + WS_HB), (const char*)(F.ws + WS_WIN), F.G, (int)blockIdx.x}; EpiP1 E{F.ws}; gm::gemm_phase<EpiP1, SchedP1>(F.lds, S, E, F.wave); } SEAM(2);
    if (IN(3)) { SchedP2 S{(const char*)(F.ws + WS_CQ), (const char*)(F.ws + WS_WUQ), (const char*)(F.ws + WS_WUKV), F.G, (int)blockIdx.x}; EpiP2 E{F.ws}; gm::gemm_phase<EpiP2, SchedP2>(F.lds, S, E, F.wave); } SEAM(3);
#endif
    if (IN(4)) {
        const unsigned short* DQ = (const unsigned short*)(F.ws + WS_DQ); const unsigned short* DK = (const unsigned short*)(F.ws + WS_DK); const unsigned short* DV = (const unsigned short*)(F.ws + WS_DV);
        unsigned short* OBR = (unsigned short*)F.out; float* LSE = (float*)(F.ws + WS_LSE);
#if EXP_SLOTS == 5
        const int cslot = (F.G == 256) ? F.vcu % 5 : (F.vcu % 3 == 0 ? 0 : F.vcu % 3 == 1 ? 2 : 3);
        if (args.pad & 1) {
            const int du0 = (F.G == 256) ? 192 * (F.vcu >> 5) + (F.vcu & 31) : F.vcu, dstep = (F.G == 256) ? 32 : F.G, dend = (F.G == 256) ? du0 + 192 : 1536, dmid = (F.G == 256) ? du0 + 96 : dend;
            for (int part = 0; part < 2; ++part) {
                if (EXP_IN_ATTN && cslot == part) exp_convert(F);
                at::dil_phase2(F.wave, part ? dmid : du0, dstep, part ? dend : dmid, DQ, DK, DV, OBR, LSE, (char*)lds_raw); }
        } else if (EXP_IN_ATTN && cslot < 2) exp_convert(F);
        if (EXP_IN_ATTN && cslot == 2) exp_convert(F);
        const bool has2 = (args.pad & 2) && (F.vcu + F.G < 512);
        if (EXP_IN_ATTN && cslot == 3 && !has2) exp_convert(F);
#define CSLOT_MID 3
#else
        const int cslot = CSLOT_XCD ? (F.vcu >> 5) % 3 : F.vcu % (FOUR_SLOTS ? 4 : 3);
        if (EXP_IN_ATTN && cslot == 0) exp_convert(F);
        if (args.pad & 1) { if (DIL_PIPE == 2) {
            const int du0 = (F.G == 256) ? 192 * (F.vcu >> 5) + (F.vcu & 31) : F.vcu, dstep = (F.G == 256) ? 32 : F.G, dend = (F.G == 256) ? du0 + 192 : 1536;
            at::dil_phase2(F.wave, du0, dstep, dend, DQ, DK, DV, OBR, LSE, (char*)lds_raw); } else if (DIL_PIPE) at::dil_phase(F.wave, F.vcu, F.G, 1536, DQ, DK, DV, OBR, LSE, (char*)lds_raw); else for (int u = F.vcu; u < 1536; u += F.G) { const int blk = u & 31, br = (u >> 5) % 3, bh = u / 96; at::dil_unit(F.wave, bh, br, blk, DQ, DK, DV, OBR, LSE, (char*)lds_raw); } }
        if (EXP_IN_ATTN && cslot == 1) exp_convert(F);
        const bool has2 = (args.pad & 2) && (F.vcu + F.G < 512);
        if (EXP_IN_ATTN && cslot == 2 && !has2) exp_convert(F);
#define CSLOT_MID 2
#endif
        if (args.pad & 2) for (int u = F.vcu; u < 512; u += F.G) { const int bh = (u >> 8) * 8 + ((u & 255) >> 5), qb = u & 31;
            if (EXP_IN_ATTN && cslot == CSLOT_MID && has2 && u == F.vcu + F.G) exp_convert(F);
            #if MLA_V4
            at::MLA_STAG(F.wave, bh, qb, (const unsigned short*)(F.ws + WS_Q), (const unsigned short*)(F.ws + WS_KN), (const unsigned short*)(F.ws + WS_KR), (const unsigned short*)(F.ws + WS_V), (unsigned short*)(F.ws + WS_HB), (const float*)(F.ws + WS_KMX), (char*)lds_raw, (u == F.vcu) ? (unsigned long long*)(F.ws + WS_CTL + 60 * 1024) : nullptr); }
#else
            at::mla_unit_v2(F.wave, bh, qb, (const unsigned short*)(F.ws + WS_Q), (const unsigned short*)(F.ws + WS_KN), (const unsigned short*)(F.ws + WS_KR), (const unsigned short*)(F.ws + WS_V), (unsigned short*)(F.ws + WS_HB), (const float*)(F.ws + WS_KMX), (char*)lds_raw, (u == F.vcu) ? (unsigned long long*)(F.ws + WS_CTL + 60 * 1024) : nullptr); }
#endif
        if (EXP_SLOTS == 5 && EXP_IN_ATTN && cslot == 4) exp_convert(F);
        if (EXP_SLOTS != 5 && FOUR_SLOTS && EXP_IN_ATTN && cslot == 3) exp_convert(F);
    } SEAM(4);
    if (IN(5)) { at::dil_combine((const unsigned short*)F.out, (const float*)(F.ws + WS_LSE), (unsigned short*)(F.ws + WS_HB), F.vcu * NTHREADS + F.wave * 64 + fresh_lane(), F.G * NTHREADS); } SEAM(5);
    if (IN(6)) { SchedP4 S{(const char*)(F.ws + WS_HB), (const char*)(F.ws + WS_WOUT), F.G, (int)blockIdx.x}; EpiP4 E{F.x, F.out, (const float*)(F.ws + WS_MODF), (bf16_t*)(F.ws + WS_X1B)}; gm::gemm_phase<EpiP4, SchedP4>(F.lds, S, E, F.wave); } if (FUZZY_P4B && IN(6) && IN(7)) xcd_barrier_fz(xbar, F.wave == 0 && fresh_lane() == 0, [&]() { p4b_rows(F, 1); }); else SEAM(6);
    if (IN(7)) { p4b_rows(F, (FUZZY_P4B && IN(6)) ? 2 : 0); } SEAM(7);
    if (IN(8)) { p5_topk(F); } SEAM(8);
    if (IN(9)) { SchedP6a S{(const char*)(F.ws + WS_HB), (const char*)(F.ws + WS_WGU), (const int*)(F.ws + WS_IDX), F.G, F.vcu}; EpiP6a E{(bf16_t*)(F.ws + WS_HBUF)}; gm::gemm_phase<EpiP6a, SchedP6a>(F.lds, S, E, F.wave); } SEAM(9);
    if (IN(10)) { SchedP6b S{(const char*)(F.ws + WS_HBUF), (const char*)(F.ws + WS_WD), F.G, F.vcu}; EpiP6b E{(bf16_t*)(F.ws + WS_Y), (const float*)(F.ws + WS_GATE)}; gm::gemm_phase<EpiP6b, SchedP6b>(F.lds, S, E, F.wave); } SEAM(10);
    if (IN(11)) { p7_final(F); }
#undef IN
#undef SEAM
}
}
extern "C" void kernel_launch(void* const* d_in, const int* in_sizes, int n_in, void* d_out, int out_size, void* d_ws, size_t ws_size, hipStream_t stream) {
    using namespace mk;
    static int grid = 0;
    if (grid == 0) {
        if (n_in != 19 || out_size != T * D || in_sizes[0] != T * D || ws_size < WS_END) { fprintf(stderr, "kernel_launch: built for 19 inputs, x/out of %d floats and >= %zu bytes of workspace; got n_in %d out %d ws %zu; nothing launched\n", T * D, (size_t)WS_END, n_in, out_size, ws_size); grid = -1; return; }
        int dev = 0, cus = 0, per_cu = 0;
        if (hipGetDevice(&dev) != hipSuccess || hipDeviceGetAttribute(&cus, hipDeviceAttributeMultiprocessorCount, dev) != hipSuccess || cus < 32) { fprintf(stderr, "kernel_launch: device query failed\n"); grid = -1; return; }
        if (hipFuncSetAttribute((const void*)mega, hipFuncAttributeMaxDynamicSharedMemorySize, LDS_BYTES) != hipSuccess) { fprintf(stderr, "kernel_launch: hipFuncSetAttribute(%d B LDS) failed\n", LDS_BYTES); grid = -1; return; }
        if (hipOccupancyMaxActiveBlocksPerMultiprocessor(&per_cu, (const void*)mega, NTHREADS, LDS_BYTES) != hipSuccess || per_cu < 1) { fprintf(stderr, "kernel_launch: occupancy query reports %d workgroups per CU\n", per_cu); grid = -1; return; }
        grid = cus;
    }
    if (grid < 0) return;
    if (hipMemsetAsync((char*)d_ws + WS_CTL, 0, 64 * KiB, stream) != hipSuccess) { fprintf(stderr, "kernel_launch: memset failed\n"); return; }
    Args a{}; for (int i = 0; i < 19; ++i) a.in[i] = d_in[i]; a.out = (float*)d_out; a.ws = (unsigned char*)d_ws;
    a.pad = 3; a.ph_lo = 0; a.ph_hi = 12; a.li = 0;
    void* kargs[] = {&a};
    const hipError_t e = hipLaunchCooperativeKernel((const void*)mega, dim3(grid), dim3(NTHREADS), kargs, LDS_BYTES, stream);
    if (e != hipSuccess) fprintf(stderr, "kernel_launch: cooperative launch failed: %s (grid %d)\n", hipGetErrorString(e), grid);
}
```
